# Optimizing an MI355X kernel written in HIP

```python
import jax
import jax.numpy as jnp
from jax import lax
import numpy as np

D_MODEL = 1024
BATCH = 2
SEQ = 8192
DEPTH = 2

CHUNK = 64
NORM_EPS = 1e-6
ROPE_BASE = 10000.0

RET_HEADS = 4
RET_DK = 128
RET_DV = 128
RET_QK_W = RET_HEADS * RET_DK
RET_W = RET_HEADS * RET_DV
RET_GN_EPS = 1e-5

RWKV_HEAD = 64
RWKV_HEADS = 8
RWKV_W = RWKV_HEADS * RWKV_HEAD
RWKV_DECAY_LORA = 64
RWKV_AAA_LORA = 64
RWKV_GATE_LORA = 160
RWKV_GN_EPS = 64e-5
RWKV_SPLITS = (RWKV_W, 2 * RWKV_W, 3 * RWKV_W, 3 * RWKV_W + RWKV_DECAY_LORA, 3 * RWKV_W + RWKV_DECAY_LORA + RWKV_AAA_LORA)
RWKV_COLS = 3 * RWKV_W + RWKV_DECAY_LORA + RWKV_AAA_LORA + RWKV_GATE_LORA

MLA_HEADS = 8
MLA_Q_LORA = 256
MLA_KV_LORA = 128
MLA_NOPE = 64
MLA_ROPE = 32
MLA_V = 64
MLA_W = MLA_HEADS * MLA_V
Q_BLOCK = 128

N_BRANCH = 3
BRANCH_W = 512

IN_SIZES = (RET_QK_W, RET_QK_W, RET_W, RET_W, RWKV_COLS, MLA_Q_LORA, MLA_KV_LORA + MLA_ROPE, N_BRANCH * D_MODEL)
IN_SPLITS = tuple(np.cumsum(IN_SIZES)[:-1].tolist())
IN_COLS = sum(IN_SIZES)

D_FF = 2816
N_EXPERTS = 8
TOP_K = 2
D_FF_EXPERT = 3584
N_DENSE = (DEPTH + 1) // 2
N_MOE = DEPTH // 2

kernel_name = "hybrid_retention_rwkv7_mla_moe_encoder"


def rms_norm(x, g):
    xf = x.astype(jnp.float32)
    y = xf * lax.rsqrt(jnp.mean(xf * xf, axis=-1, keepdims=True) + NORM_EPS)
    return (y * g.astype(jnp.float32)).astype(x.dtype)


def group_norm(x, eps):
    xc = x - jnp.mean(x, axis=-1, keepdims=True)
    return xc * lax.rsqrt(jnp.mean(xc * xc, axis=-1, keepdims=True) + eps)


def rope_tables(positions, dim):
    inv_freq = 1.0 / (ROPE_BASE ** (jnp.arange(0, dim, 2, dtype=jnp.float32) / dim))
    ang = positions.astype(jnp.float32)[..., None] * inv_freq
    return jnp.cos(ang), jnp.sin(ang)


def apply_rope(x, cos, sin):
    x1, x2 = jnp.split(x, 2, axis=-1)
    c = cos[:, :, None, :]
    s = sin[:, :, None, :]
    return jnp.concatenate([x1 * c - x2 * s, x1 * s + x2 * c], axis=-1).astype(x.dtype)


def token_shift(p):
    return jnp.pad(p, ((0, 0), (1, 0), (0, 0)))[:, :-1]


def retention_mix(q, k, v, g, cos, sin):
    f32 = jnp.float32
    B, S, _ = q.shape
    N, H = S // CHUNK, RET_HEADS
    q = apply_rope(q.reshape(B, S, H, RET_DK), cos, sin).astype(f32)
    k = apply_rope(k.reshape(B, S, H, RET_DK), cos, sin).astype(f32) * (RET_DK ** -0.5)
    v = v.reshape(B, S, H, RET_DV).astype(f32)
    log_gamma = jnp.log(1.0 - 2.0 ** (-5.0 - jnp.arange(H, dtype=f32)))
    idx = jnp.arange(CHUNK, dtype=f32)
    intra = jnp.exp(log_gamma[:, None, None] * jnp.abs(idx[:, None] - idx[None, :]))
    q_decay = jnp.exp(log_gamma[None, :] * (idx[:, None] + 1.0))
    k_decay = jnp.exp(log_gamma[None, :] * (CHUNK - 1.0 - idx[:, None]))
    chunk_decay = jnp.exp(log_gamma * CHUNK)
    qc = q.reshape(B, N, CHUNK, H, RET_DK)
    kc = k.reshape(B, N, CHUNK, H, RET_DK)
    vc = v.reshape(B, N, CHUNK, H, RET_DV)
    scores = jnp.einsum('bnihd,bnjhd->bnhij', qc, kc) * intra
    o = jnp.einsum('bnhij,bnjhe->bnihe', scores, vc)
    kv = jnp.einsum('bnjhd,bnjhe->bnhde', kc * k_decay[:, :, None], vc)

    def step(state, kv_n):
        return state * chunk_decay[None, :, None, None] + kv_n, state

    _, prev = lax.scan(step, jnp.zeros((B, H, RET_DK, RET_DV), f32), jnp.moveaxis(kv, 1, 0))
    prev = jnp.moveaxis(prev, 0, 1)
    o = o + jnp.einsum('bnihd,bnhde->bnihe', qc, prev) * q_decay[:, :, None]
    o = group_norm(o.reshape(B, S, H, RET_DV), RET_GN_EPS).reshape(B, S, RET_W)
    return o * jax.nn.silu(g.astype(f32))


def rwkv7_mix(p, mu, w0, w2, a0, a2, g2, k_k, k_a, r_k, lnx_w):
    f32 = jnp.float32
    B, S, _ = p.shape
    p = p.astype(f32)
    xs = p + (token_shift(p) - p) * mu.astype(f32)
    r, k, v, xw, xa, xg = jnp.split(xs, RWKV_SPLITS, axis=-1)
    w_log = -jax.nn.softplus(-(w0.astype(f32) + jnp.tanh(xw) @ w2.astype(f32))) - 0.5
    decay = jnp.exp(-jnp.exp(w_log))
    a = jax.nn.sigmoid(a0.astype(f32) + xa @ a2.astype(f32))
    g = jax.nn.sigmoid(xg) @ g2.astype(f32)
    shp = (B, S, RWKV_HEADS, RWKV_HEAD)
    kk = (k * k_k.astype(f32)).reshape(shp)
    kk = kk * lax.rsqrt(jnp.sum(kk * kk, axis=-1, keepdims=True) + 1e-12)
    k = k * (1.0 + (a - 1.0) * k_a.astype(f32))
    r, k, v, decay, a = (t.reshape(shp) for t in (r, k, v, decay, a))
    b = kk * a

    def step(state, inp):
        r_t, w_t, k_t, v_t, kk_t, b_t = inp
        sa = -jnp.einsum('bhvk,bhk->bhv', state, kk_t)
        state = state * w_t[:, :, None, :] + sa[..., None] * b_t[:, :, None, :] + v_t[..., None] * k_t[:, :, None, :]
        return state, jnp.einsum('bhvk,bhk->bhv', state, r_t)

    seq = tuple(jnp.moveaxis(t, 1, 0) for t in (r, decay, k, v, kk, b))
    _, y = lax.scan(step, jnp.zeros((B, RWKV_HEADS, RWKV_HEAD, RWKV_HEAD), f32), seq)
    y = jnp.moveaxis(y, 0, 1)
    y = group_norm(y, RWKV_GN_EPS) * lnx_w.astype(f32).reshape(RWKV_HEADS, RWKV_HEAD)
    y = y + jnp.sum(r * k * r_k.astype(f32), axis=-1, keepdims=True) * v
    return y.reshape(B, S, RWKV_W) * g


def mla_mix(qa, kva, q_norm, w_qb, kv_norm, w_kvb, cos, sin):
    B, S, _ = qa.shape
    q = (rms_norm(qa, q_norm) @ w_qb).reshape(B, S, MLA_HEADS, MLA_NOPE + MLA_ROPE)
    q_nope = q[..., :MLA_NOPE]
    q_pe = apply_rope(q[..., MLA_NOPE:], cos, sin)
    c_kv, k_pe = kva[..., :MLA_KV_LORA], kva[..., MLA_KV_LORA:]
    kv = (rms_norm(c_kv, kv_norm) @ w_kvb).reshape(B, S, MLA_HEADS, MLA_NOPE + MLA_V)
    k_nope, v = kv[..., :MLA_NOPE], kv[..., MLA_NOPE:]
    k_pe = apply_rope(k_pe[:, :, None, :], cos, sin)[:, :, 0, :]
    scale = (MLA_NOPE + MLA_ROPE) ** -0.5
    outs = []
    for i in range(S // Q_BLOCK):
        q0, k_end = i * Q_BLOCK, (i + 1) * Q_BLOCK
        s = (jnp.einsum('bqhd,bkhd->bhqk', q_nope[:, q0:k_end], k_nope[:, :k_end])
             + jnp.einsum('bqhr,bkr->bhqk', q_pe[:, q0:k_end], k_pe[:, :k_end])).astype(jnp.float32) * scale
        q_chunk = (q0 + np.arange(Q_BLOCK)) // CHUNK
        k_chunk = np.arange(k_end) // CHUNK
        s = jnp.where(k_chunk[None, :] <= q_chunk[:, None], s, -1e30)
        pr = jax.nn.softmax(s, axis=-1).astype(v.dtype)
        outs.append(jnp.einsum('bhqk,bkhe->bqhe', pr, v[:, :k_end]))
    return jnp.concatenate(outs, axis=1).reshape(B, S, MLA_W)


def swiglu(h, wg, wu, wd):
    return (jax.nn.silu(h @ wg) * (h @ wu)) @ wd


def moe_swiglu(h, router, wg, wu, wd):
    logits = (h @ router).astype(jnp.float32)
    top_v, top_i = lax.top_k(logits, TOP_K)
    top_w = jax.nn.softmax(top_v, axis=-1)
    comb = jnp.sum(jax.nn.one_hot(top_i, N_EXPERTS, dtype=jnp.float32) * top_w[..., None], axis=-2)
    out = jnp.zeros(h.shape, jnp.float32)
    for e in range(N_EXPERTS):
        out = out + comb[..., e:e + 1] * swiglu(h, wg[e], wu[e], wd[e]).astype(jnp.float32)
    return out.astype(h.dtype)


def setup_inputs(seed: int = 0) -> dict:
    key = jax.random.key(seed)
    ks = iter(jax.random.split(key, 40))
    f32 = jnp.float32

    def nrm(shape, scale):
        return jax.random.normal(next(ks), shape, f32) * scale

    def gain(shape):
        return 1.0 + nrm(shape, 0.05)

    L = DEPTH
    x = nrm((BATCH, SEQ, D_MODEL), 1.0)
    start = jax.random.randint(next(ks), (BATCH, 1), 0, 4096, dtype=jnp.int32)
    positions = start + jnp.arange(SEQ, dtype=jnp.int32)[None, :]
    rwkv_w0 = jnp.linspace(-6.5, -1.5, RWKV_W, dtype=f32)[None, :] + nrm((L, RWKV_W), 0.1)
    return {
        'x': x,
        'positions': positions,
        'attn_norm': gain((L, D_MODEL)),
        'w_in': nrm((L, D_MODEL, IN_COLS), D_MODEL ** -0.5),
        'rwkv_mu': jax.random.uniform(next(ks), (L, RWKV_COLS), f32),
        'rwkv_w0': rwkv_w0,
        'rwkv_w2': nrm((L, RWKV_DECAY_LORA, RWKV_W), 0.1),
        'rwkv_a0': nrm((L, RWKV_W), 0.1),
        'rwkv_a2': nrm((L, RWKV_AAA_LORA, RWKV_W), RWKV_AAA_LORA ** -0.5),
        'rwkv_g2': nrm((L, RWKV_GATE_LORA, RWKV_W), RWKV_GATE_LORA ** -0.5),
        'rwkv_k_k': 0.85 + nrm((L, RWKV_W), 0.05),
        'rwkv_k_a': gain((L, RWKV_W)),
        'rwkv_r_k': nrm((L, RWKV_HEADS, RWKV_HEAD), 0.1),
        'rwkv_lnx_w': gain((L, RWKV_W)),
        'mla_q_norm': gain((L, MLA_Q_LORA)),
        'mla_w_qb': nrm((L, MLA_Q_LORA, MLA_HEADS * (MLA_NOPE + MLA_ROPE)), MLA_Q_LORA ** -0.5),
        'mla_kv_norm': gain((L, MLA_KV_LORA)),
        'mla_w_kvb': nrm((L, MLA_KV_LORA, MLA_HEADS * (MLA_NOPE + MLA_V)), MLA_KV_LORA ** -0.5),
        'w_branch': nrm((L, N_BRANCH, BRANCH_W, D_MODEL), BRANCH_W ** -0.5),
        'w_o': nrm((L, D_MODEL, D_MODEL), D_MODEL ** -0.5),
        'ffn_norm': gain((L, D_MODEL)),
        'ffn_w_gate': nrm((N_DENSE, D_MODEL, D_FF), D_MODEL ** -0.5),
        'ffn_w_up': nrm((N_DENSE, D_MODEL, D_FF), D_MODEL ** -0.5),
        'ffn_w_down': nrm((N_DENSE, D_FF, D_MODEL), D_FF ** -0.5),
        'moe_router': nrm((N_MOE, D_MODEL, N_EXPERTS), D_MODEL ** -0.5),
        'moe_w_gate': nrm((N_MOE, N_EXPERTS, D_MODEL, D_FF_EXPERT), D_MODEL ** -0.5),
        'moe_w_up': nrm((N_MOE, N_EXPERTS, D_MODEL, D_FF_EXPERT), D_MODEL ** -0.5),
        'moe_w_down': nrm((N_MOE, N_EXPERTS, D_FF_EXPERT, D_MODEL), D_FF_EXPERT ** -0.5),
        'final_norm': gain((D_MODEL,)),
    }


def reference(x, positions, attn_norm, w_in, rwkv_mu, rwkv_w0, rwkv_w2, rwkv_a0, rwkv_a2, rwkv_g2,
              rwkv_k_k, rwkv_k_a, rwkv_r_k, rwkv_lnx_w, mla_q_norm, mla_w_qb, mla_kv_norm, mla_w_kvb,
              w_branch, w_o, ffn_norm, ffn_w_gate, ffn_w_up, ffn_w_down, moe_router, moe_w_gate,
              moe_w_up, moe_w_down, final_norm):
    B, S, _ = x.shape
    dt = x.dtype
    cos_ret, sin_ret = rope_tables(positions, RET_DK)
    cos_mla, sin_mla = rope_tables(positions, MLA_ROPE)
    h = x
    for l in range(DEPTH):
        hn = rms_norm(h, attn_norm[l])
        p = hn @ w_in[l]
        rq, rk, rv, rg, pw, qa, kva, gl = jnp.split(p, IN_SPLITS, axis=-1)
        y_ret = retention_mix(rq, rk, rv, rg, cos_ret, sin_ret)
        y_rwkv = rwkv7_mix(pw, rwkv_mu[l], rwkv_w0[l], rwkv_w2[l], rwkv_a0[l], rwkv_a2[l], rwkv_g2[l],
                           rwkv_k_k[l], rwkv_k_a[l], rwkv_r_k[l], rwkv_lnx_w[l])
        y_mla = mla_mix(qa, kva, mla_q_norm[l], mla_w_qb[l], mla_kv_norm[l], mla_w_kvb[l], cos_mla, sin_mla)
        ys = jnp.stack([y_ret.astype(dt), y_rwkv.astype(dt), y_mla.astype(dt)], axis=2)
        branch = jnp.einsum('bsnc,ncd->bsnd', ys, w_branch[l])
        gates = jax.nn.sigmoid(gl.reshape(B, S, N_BRANCH, D_MODEL))
        merged = jnp.sum(gates * branch, axis=2)
        h = h + (merged @ w_o[l]).astype(dt)
        hn = rms_norm(h, ffn_norm[l])
        if l % 2 == 0:
            f = swiglu(hn, ffn_w_gate[l // 2], ffn_w_up[l // 2], ffn_w_down[l // 2])
        else:
            f = moe_swiglu(hn, moe_router[l // 2], moe_w_gate[l // 2], moe_w_up[l // 2], moe_w_down[l // 2])
        h = h + f.astype(dt)
    return rms_norm(h, final_norm)
```

```cpp
#include <hip/hip_runtime.h>
#include <cstdio>
#include <cstdint>

#define LAS __attribute__((address_space(3)))
#define GAS __attribute__((address_space(1)))
typedef unsigned short bf16_t;
typedef short bf16x8 __attribute__((ext_vector_type(8)));
typedef short bf16x4 __attribute__((ext_vector_type(4)));
typedef float f32x4 __attribute__((ext_vector_type(4)));
typedef float f32x2 __attribute__((ext_vector_type(2)));
typedef float f32x16 __attribute__((ext_vector_type(16)));
typedef unsigned u32x4 __attribute__((ext_vector_type(4)));
typedef unsigned u32x2 __attribute__((ext_vector_type(2)));

constexpr int NB = 2, SEQ = 8192, DM = 1024, MTOK = NB * SEQ, NLAYER = 2, CH = 64, NCHUNK = SEQ / CH;
constexpr int IN_COLS = 7360, PW = 4608;
constexpr int P_RQ = 0, P_RK = 512, P_RV = 1024, P_RG = 1536, P_RW = 2048, P_QA = 4096, P_KVA = 4352;
constexpr int WIN_ROWS = 7680;
constexpr int RWKV_COLS = 1824, LORA_K = 384, LO_W = 1536;
constexpr int DFF = 2816, DFFE = 3584, NEXP = 8, DFFH = DFFE / 2;
constexpr int MAXROWS = 34816;
constexpr float NORM_EPS = 1e-6f;

constexpr size_t MiB = 1u << 20;
constexpr size_t WS_CTL = 0, CTL_BYTES = 1 * MiB;
constexpr size_t WS_WIN = 1 * MiB;
constexpr size_t WS_LORA = 31 * MiB;
constexpr size_t WS_QB = 34 * MiB;
constexpr size_t WS_KB = 35 * MiB;
constexpr size_t WS_VB = 35 * MiB + 512 * 1024;
constexpr size_t WS_BR = 36 * MiB;
constexpr size_t WS_WO = 42 * MiB;
constexpr size_t WS_FGU = 46 * MiB;
constexpr size_t WS_FD = 57 * MiB;
constexpr size_t WS_COSR = 63 * MiB, WS_SINR = 67 * MiB, WS_COSM = 71 * MiB, WS_SINM = 72 * MiB;
constexpr size_t WS_HN = 73 * MiB;
constexpr size_t WS_TOK = 105 * MiB;
constexpr size_t WS_T = 106 * MiB;
constexpr size_t WS_P = WS_T;
constexpr size_t WS_G = WS_T;
constexpr size_t WS_MRG = WS_T + 96 * MiB;
constexpr size_t WS_LO = WS_T + 144 * MiB;
constexpr size_t WS_Q = WS_T + 192 * MiB;
constexpr size_t WS_KN = WS_T + 216 * MiB;
constexpr size_t WS_VT = WS_T + 232 * MiB;
constexpr size_t WS_KPE = WS_T + 248 * MiB;
constexpr size_t WS_LIN = WS_T + 249 * MiB;
constexpr size_t WS_QN = WS_T + 261 * MiB;
constexpr size_t WS_CN = WS_T + 269 * MiB;
constexpr size_t WS_YRET = WS_T + 261 * MiB;
constexpr size_t WS_RS = WS_T + 277 * MiB;
constexpr size_t WS_YRW = WS_T + 277 * MiB;
constexpr size_t WS_YMLA = WS_T + 293 * MiB;
constexpr size_t WS_RC = WS_T + 309 * MiB;
constexpr size_t WS_ACT = WS_T;
constexpr size_t WS_MGU = WS_T;
constexpr size_t WS_MD = WS_T + 112 * MiB;
constexpr size_t WS_HS = WS_T + 168 * MiB;
constexpr size_t WS_MACT = WS_T + 236 * MiB;
constexpr size_t WS_END = WS_T + 374 * MiB;
static_assert(WS_MACT + (size_t)MAXROWS * DFFH * 2 <= WS_END, "ws map");
constexpr int CW_BAR = 4096;
constexpr int CW_ECNT = 16384;

__device__ __forceinline__ unsigned f2bf(float f) { unsigned u = __builtin_bit_cast(unsigned, f); return (u + 0x7fffu + ((u >> 16) & 1u)) >> 16; }
__device__ __forceinline__ unsigned pk2(float lo, float hi) { return f2bf(lo) | (f2bf(hi) << 16); }
__device__ __forceinline__ float bf2f(unsigned short h) { return __builtin_bit_cast(float, (unsigned)h << 16); }
__device__ __forceinline__ float bflo(unsigned w) { return __builtin_bit_cast(float, w << 16); }
__device__ __forceinline__ float bfhi(unsigned w) { return __builtin_bit_cast(float, w & 0xffff0000u); }
__device__ __forceinline__ float wave_sum(float v) {
#pragma unroll
    for (int o = 1; o < 64; o <<= 1) v += __shfl_xor(v, o);
    return v;
}
__device__ __forceinline__ float sigmoidf_(float x) { return 1.0f / (1.0f + __expf(-x)); }
#define LDS_WAIT() asm volatile("s_waitcnt lgkmcnt(0)" ::: "memory")
#define VM_WAIT() asm volatile("s_waitcnt vmcnt(0)" ::: "memory")

#define XB_TMO      128
#define XB_XCNT(j)  (256  + 64 * (j))
#define XB_XSUB(j)  (1280 + 64 * (j))
#define XB_XGEN(j)  (2304 + 64 * (j))
#define XB_TOP      3328
#define XB_TOPGEN   3392
#define XCD_BAR_WORDS 3456
#define XB_SPIN_CAP (1u << 18)
__device__ __forceinline__ unsigned xb_ld(unsigned* p)              { return __hip_atomic_load(p, __ATOMIC_RELAXED, __HIP_MEMORY_SCOPE_AGENT); }
__device__ __forceinline__ unsigned xb_add(unsigned* p, unsigned v) { return __hip_atomic_fetch_add(p, v, __ATOMIC_RELAXED, __HIP_MEMORY_SCOPE_AGENT); }
__device__ __forceinline__ unsigned xb_xcc_id() { return (unsigned)__builtin_amdgcn_s_getreg((3 << 11) | 20) & 0xFu; }
#define XB_SPIN(cond, bar) do { unsigned _sp = 0; while (cond) { __builtin_amdgcn_s_sleep(1); \
    if ((++_sp & 255u) == 0u) { if (xb_ld(&(bar)[XB_TMO])) break; if (_sp > XB_SPIN_CAP) { atomicAdd(&(bar)[XB_TMO], 1u); break; } } } } while (0)
struct XcdBarrier { unsigned* bar; unsigned x; volatile LAS unsigned* st; };
__device__ __forceinline__ XcdBarrier xcd_barrier_post(unsigned* bar, volatile LAS unsigned* st) {
    XcdBarrier b; b.bar = bar; b.x = xb_xcc_id(); b.st = st;
    if (threadIdx.x == 0) (void)xb_add(&bar[XB_XCNT(b.x)], 1u);
    return b;
}
__device__ __forceinline__ void xcd_barrier_complete(unsigned* bar, unsigned x, unsigned& nloc, unsigned& nx) {
    const unsigned G = gridDim.x * gridDim.y * gridDim.z;
    unsigned sum, cnt, mine, sp = 0u;
    for (;;) {
        sum = 0u; cnt = 0u; mine = 0u;
#pragma unroll
        for (unsigned j = 0; j < 16; ++j) { const unsigned c = xb_ld(&bar[XB_XCNT(j)]); sum += c; cnt += (c > 0u) ? 1u : 0u; mine = (j == x) ? c : mine; }
        if (sum == G) break;
        __builtin_amdgcn_s_sleep(1);
        if ((++sp & 255u) == 0u) { if (xb_ld(&bar[XB_TMO])) break; if (sp > XB_SPIN_CAP) { atomicAdd(&bar[XB_TMO], 1u); break; } }
    }
    nloc = mine > 0u ? mine : 1u; nx = cnt > 0u ? cnt : 1u;
}
__device__ __forceinline__ void xcd_barrier(const XcdBarrier& b) {
    asm volatile("s_waitcnt vmcnt(0)" ::: "memory");
    __syncthreads();
    if (threadIdx.x == 0) {
        unsigned* bar = b.bar;
        __builtin_amdgcn_s_waitcnt(0);
        unsigned nloc = b.st[0], nx = b.st[1];
        if (nloc == 0u) { xcd_barrier_complete(bar, b.x, nloc, nx); b.st[0] = nloc; b.st[1] = nx; }
        const unsigned old = xb_add(&bar[XB_XSUB(b.x)], 1u);
        const unsigned gen = old / nloc;
        if (old + 1u == (gen + 1u) * nloc) {
            __builtin_amdgcn_fence(__ATOMIC_RELEASE, "agent");
            asm volatile("s_waitcnt vmcnt(0)" ::: "memory");
            const unsigned og = xb_add(&bar[XB_TOP], 1u);
            const unsigned tg = og / nx;
            if (og + 1u == (tg + 1u) * nx) xb_add(&bar[XB_TOPGEN], 1u);
            else XB_SPIN(xb_ld(&bar[XB_TOPGEN]) == tg, bar);
            __builtin_amdgcn_fence(__ATOMIC_ACQUIRE, "agent");
            xb_add(&bar[XB_XGEN(b.x)], 1u);
            asm volatile("s_waitcnt vmcnt(0)" ::: "memory");
        } else {
            XB_SPIN(xb_ld(&bar[XB_XGEN(b.x)]) == gen, bar);
            __builtin_amdgcn_fence(__ATOMIC_ACQUIRE, "agent");
            asm volatile("s_waitcnt vmcnt(0)" ::: "memory");
        }
    }
    __syncthreads();
}

namespace pg8 {
constexpr int BM = 256, BK = 64, HALF = 128, HTB = HALF * BK * 2, STAGE_BYTES = 8 * HTB;
__device__ __forceinline__ int lds_byte(int r, int c) { const int st = (r >> 4) * 2 + (c >> 5), rr = r & 15, cc = c & 31, ob = rr * 64 + cc * 2; return st * 1024 + (ob ^ (((ob >> 9) & 1) << 5)); }
__device__ __forceinline__ void stage_rc(int b, int& R, int& C) { const int st = b / 1024, sb = b % 1024, swz = sb ^ (((sb >> 9) & 1) << 5); R = (st >> 1) * 16 + swz / 64; C = (st & 1) * 32 + (swz % 64) / 2; }
__device__ __forceinline__ int perm32(int rho) { const int n = rho >> 4, i = rho & 15; return 8 * (i >> 2) + 4 * n + (i & 3); }
struct Unit { int pm, pn, aux; const char* A; const char* B; };
__device__ __forceinline__ unsigned cvt_pk_bf16(float lo, float hi) { unsigned r; asm volatile("v_cvt_pk_bf16_f32 %0, %1, %2" : "=v"(r) : "v"(lo), "v"(hi)); return r; }

template <class Epi, class Sched>
__device__ __forceinline__ void gemm_phase(LAS unsigned char* lds, const int K, const int lda, const int ldb, const Sched& S, const Epi& E) {
    int tid_ = threadIdx.x; asm volatile("" : "+v"(tid_));
    const int tid = tid_, wid = __builtin_amdgcn_readfirstlane(tid >> 6), lane = tid & 63, wr = wid >> 2, wc = wid & 3, fr = lane & 15, fq = lane >> 4;
    const int nt = K / BK;
    unsigned voffA[2], voffB[2];
#pragma unroll
    for (int i = 0; i < 2; ++i) { int R, C; stage_rc(tid * 16 + i * 8192, R, C); const int Rb = Epi::PERM ? ((R & ~31) + perm32(R & 31)) : R;
        voffA[i] = (unsigned)(R * lda + C) * 2u; voffB[i] = (unsigned)(Rb * ldb + C) * 2u; }
    const size_t kstep = (size_t)(BK * 2);
    const size_t hstepA = (size_t)HALF * lda * 2, hstepB = (size_t)HALF * ldb * 2;
    const unsigned ldsw = (unsigned)wid * 1024u;
    const int aoff = lds_byte(wr * 64 + fr, fq * 8), boff = lds_byte(wc * 32 + fr, fq * 8);
#define PG8_SA(b, h) (((b) * 2 + (h)) * HTB)
#define PG8_SB(b, h) ((4 + (b) * 2 + (h)) * HTB)
#define PG8_STAGE(bufoff, gbase, voff) do { _Pragma("unroll") for (int _i = 0; _i < 2; ++_i) \
        __builtin_amdgcn_global_load_lds((const unsigned*)((const char*)(gbase) + (voff)[_i]), (LAS unsigned*)(lds + (bufoff) + ldsw + _i * 8192), 16, 0, 0); } while (0)
#define PG8_LDA(dst, b, h) do { _Pragma("unroll") for (int m = 0; m < 4; ++m) _Pragma("unroll") for (int k = 0; k < 2; ++k) dst[m][k] = *(const LAS bf16x8*)(lds + PG8_SA(b, h) + aoff + m * 2048 + k * 1024); } while (0)
#define PG8_LDB(dst, b, h) do { _Pragma("unroll") for (int n = 0; n < 2; ++n) _Pragma("unroll") for (int k = 0; k < 2; ++k) dst[n][k] = *(const LAS bf16x8*)(lds + PG8_SB(b, h) + boff + n * 2048 + k * 1024); } while (0)
#define PG8_MMA(ai, bj, At, Bt) do { __builtin_amdgcn_s_setprio(1); _Pragma("unroll") for (int m = 0; m < 4; ++m) _Pragma("unroll") for (int n = 0; n < 2; ++n) _Pragma("unroll") for (int k = 0; k < 2; ++k) \
        acc[ai][bj][m][n] = __builtin_amdgcn_mfma_f32_16x16x32_bf16(Bt[n][k], At[m][k], acc[ai][bj][m][n], 0, 0, 0); __builtin_amdgcn_s_setprio(0); } while (0)
#define PG8_WAIT_V(n) asm volatile("s_waitcnt vmcnt(" #n ")" ::: "memory")
#define PG8_WAIT_L(n) asm volatile("s_waitcnt lgkmcnt(" #n ")" ::: "memory")
#define PG8_BAR __builtin_amdgcn_s_barrier()
#define PG8_SCHED __builtin_amdgcn_sched_barrier(0)
    Unit cur, nxt; int ui = 0;
    if (!S.next(0, cur)) return;
    f32x4 acc[2][2][4][2];
#pragma unroll
    for (int a = 0; a < 2; ++a)
#pragma unroll
        for (int b = 0; b < 2; ++b)
#pragma unroll
            for (int m = 0; m < 4; ++m)
#pragma unroll
                for (int n = 0; n < 2; ++n) acc[a][b][m][n] = (f32x4){0.f, 0.f, 0.f, 0.f};
    bf16x8 At[4][2], B0[2][2], B1[2][2];
    const char* cA = cur.A; const char* cB = cur.B;
    PG8_STAGE(PG8_SB(0, 0), cB, voffB); PG8_STAGE(PG8_SB(0, 1), cB + hstepB, voffB); PG8_STAGE(PG8_SA(0, 0), cA, voffA); PG8_STAGE(PG8_SA(0, 1), cA + hstepA, voffA);
    if (wr == 1) PG8_BAR;
    PG8_WAIT_V(2); PG8_BAR;
    PG8_STAGE(PG8_SB(1, 0), cB + kstep, voffB); PG8_STAGE(PG8_SA(1, 0), cA + kstep, voffA); PG8_STAGE(PG8_SB(1, 1), cB + hstepB + kstep, voffB);
    PG8_WAIT_V(6); PG8_BAR;
#pragma unroll 1
    for (;;) {
        const bool has_next = S.next(ui + 1, nxt);
        const char* nA = has_next ? nxt.A : cA; const char* nB = has_next ? nxt.B : cB;
#pragma unroll 1
        for (int t = 0; t < nt; t += 2) {
            const bool last = (t == nt - 2);
            const char* a1 = cA + (size_t)(t + 1) * kstep;
            const char* a2 = last ? nA : cA + (size_t)(t + 2) * kstep; const char* b2 = last ? nB : cB + (size_t)(t + 2) * kstep;
            const char* a3 = a2 + kstep; const char* b3 = b2 + kstep;
            PG8_LDB(B0, 0, 0); PG8_LDB(B1, 0, 1); PG8_SCHED; PG8_LDA(At, 0, 0); PG8_STAGE(PG8_SA(1, 1), a1 + hstepA, voffA);
            PG8_WAIT_V(8); PG8_WAIT_L(0); PG8_BAR; PG8_MMA(0, 0, At, B0); PG8_MMA(0, 1, At, B1); PG8_BAR; PG8_SCHED;
            PG8_LDA(At, 0, 1); PG8_STAGE(PG8_SB(0, 0), b2, voffB); PG8_STAGE(PG8_SB(0, 1), b2 + hstepB, voffB); PG8_STAGE(PG8_SA(0, 0), a2, voffA);
            PG8_WAIT_V(8); PG8_WAIT_L(0); PG8_BAR; PG8_MMA(1, 0, At, B0); PG8_MMA(1, 1, At, B1); PG8_BAR; PG8_SCHED;
            PG8_LDB(B0, 1, 0); PG8_LDB(B1, 1, 1); PG8_SCHED; PG8_LDA(At, 1, 0); PG8_STAGE(PG8_SA(0, 1), a2 + hstepA, voffA);
            PG8_WAIT_V(8); PG8_WAIT_L(0); PG8_BAR; PG8_MMA(0, 0, At, B0); PG8_MMA(0, 1, At, B1); PG8_BAR; PG8_SCHED;
            PG8_LDA(At, 1, 1); PG8_STAGE(PG8_SB(1, 0), b3, voffB); PG8_STAGE(PG8_SB(1, 1), b3 + hstepB, voffB); PG8_STAGE(PG8_SA(1, 0), a3, voffA);
            PG8_WAIT_V(8); PG8_WAIT_L(0); PG8_BAR; PG8_MMA(1, 0, At, B0); PG8_MMA(1, 1, At, B1); PG8_BAR; PG8_SCHED;
        }
        if (wr == 0) PG8_BAR;
        E(acc, cur, wr, wc, fr, fq);
        if (!has_next) break;
#pragma unroll
        for (int a = 0; a < 2; ++a)
#pragma unroll
            for (int b = 0; b < 2; ++b)
#pragma unroll
                for (int m = 0; m < 4; ++m)
#pragma unroll
                    for (int n = 0; n < 2; ++n) acc[a][b][m][n] = (f32x4){0.f, 0.f, 0.f, 0.f};
        cur = nxt; cA = nA; cB = nB; ++ui;
        if (wr == 1) PG8_BAR;
    }
    PG8_WAIT_V(0);
    PG8_BAR;
#undef PG8_SA
#undef PG8_SB
#undef PG8_STAGE
#undef PG8_LDA
#undef PG8_LDB
#undef PG8_MMA
#undef PG8_WAIT_V
#undef PG8_WAIT_L
#undef PG8_BAR
#undef PG8_SCHED
}
}
constexpr int NWAVES = 8, NTHR = 512;
constexpr int RING_BYTES = 131072, LDSCTL_OFF = RING_BYTES, LDS_BYTES = 147456;
struct Params { const float* in[29]; float* out; unsigned char* ws; };
struct Frame {
    LAS unsigned char* lds; int tid, lane, wave, blk, G, vcu, gw, ngw; unsigned char* ws;
};
enum { I_X = 0, I_POS, I_ANORM, I_WIN, I_MU, I_W0, I_W2, I_A0, I_A2, I_G2, I_KK, I_KA, I_RK, I_LNX, I_QNORM, I_WQB, I_KVNORM, I_WKVB, I_WBR, I_WO, I_FNORM,
       I_FG, I_FU, I_FD, I_ROUTER, I_MG, I_MU2, I_MD, I_FINAL };

struct SchedGrid {
    int nM, nN, nwg, G, c; const char* A; const char* B; size_t astep, bstep;
    __device__ void init(int nM_, int nN_, int G_, int c_, const void* A_, size_t astep_, const void* B_, size_t bstep_) { nM = nM_; nN = nN_; nwg = nM * nN; G = G_; c = c_; A = (const char*)A_; B = (const char*)B_; astep = astep_; bstep = bstep_; }
    __device__ __forceinline__ bool next(int i, pg8::Unit& u) const {
        const long L = (long)i * G + c; if (L >= nwg) return false;
        int wgid = (int)L; { const int q = nwg / 8, r = nwg % 8, xcd = wgid % 8, off = wgid / 8; wgid = (xcd < r ? xcd * (q + 1) : r * (q + 1) + (xcd - r) * q) + off; }
        const int nig = 8 * nN, gid = wgid / nig, fm = gid * 8, gsz = (nM - fm) < 8 ? (nM - fm) : 8;
        u.pm = fm + ((wgid % nig) % gsz); u.pn = (wgid % nig) / gsz; u.aux = 0;
        u.A = A + (size_t)u.pm * astep; u.B = B + (size_t)u.pn * bstep; return true;
    }
};
struct SchedSmall {
    int G, c, layer; const char* ws;
    __device__ __forceinline__ bool next(int i, pg8::Unit& u) const {
        int L = i * G + c; if (L >= 448) return false;
        int s = 0; if (L >= 192) { L -= 192; s = 1; if (L >= 128) { L -= 128; s = 2; } }
        const int nn = s == 0 ? 3 : (s == 1 ? 2 : 64);
        u.pm = L / nn; u.pn = L % nn; u.aux = s;
        const size_t lw = (size_t)layer * 256 * 2;
        const size_t ao = s == 0 ? WS_QN : (s == 1 ? WS_CN : WS_VB + lw * 512), bo = s == 0 ? WS_QB + lw * 768 : (s == 1 ? WS_KB + lw * 512 : WS_CN);
        u.A = ws + ao + (size_t)u.pm * (256 * 256 * 2); u.B = ws + bo + (size_t)u.pn * (256 * 256 * 2); return true;
    }
};
struct SchedOwn3 {
    int c, G; const char* A; const char* B; size_t astep, bstep, a_n, b_n;
    __device__ __forceinline__ bool next(int i, pg8::Unit& u) const {
        const int t = c + (i / 3) * G; if (t >= 256) return false;
        const int n = i % 3; u.pm = t >> 2; u.pn = t & 3; u.aux = n; u.A = A + (size_t)u.pm * astep + (size_t)n * a_n; u.B = B + (size_t)u.pn * bstep + (size_t)n * b_n; return true;
    }
};
struct SchedMoe {
    int G, c, ncol, ntile; const LAS int* tab; const char* A; const char* B; size_t astep, bstep, estep;
    __device__ __forceinline__ bool next(int i, pg8::Unit& u) const {
        const int L = i * G + c; if (L >= ntile * ncol) return false;
        u.pm = L / ncol; u.pn = L % ncol; const int e = tab[u.pm]; u.aux = e;
        u.A = A + (size_t)u.pm * astep; u.B = B + (size_t)e * estep + (size_t)u.pn * bstep; return true;
    }
};

using pg8::Unit; using pg8::cvt_pk_bf16;
#define EPI_ARGS const f32x4 (&acc)[2][2][4][2], const Unit& u, int wr, int wc, int fr, int fq
struct EpiStore {
    static constexpr bool PERM = true;
    bf16_t* O; int ld;
    __device__ __forceinline__ void operator()(EPI_ARGS) const {
        const int row0 = u.pm * 256 + wr * 64 + fr, col0 = u.pn * 256 + wc * 32 + 8 * fq;
#pragma unroll
        for (int ai = 0; ai < 2; ++ai)
#pragma unroll
            for (int m = 0; m < 4; ++m) { bf16_t* rowp = O + (size_t)(row0 + ai * 128 + m * 16) * ld + col0;
#pragma unroll
                for (int bj = 0; bj < 2; ++bj) { const f32x4 v0 = acc[ai][bj][m][0], v1 = acc[ai][bj][m][1];
                    u32x4 w; w.x = cvt_pk_bf16(v0[0], v0[1]); w.y = cvt_pk_bf16(v0[2], v0[3]); w.z = cvt_pk_bf16(v1[0], v1[1]); w.w = cvt_pk_bf16(v1[2], v1[3]);
                    *(u32x4*)(rowp + bj * 128) = w; } }
    }
};
struct EpiSmall {
    static constexpr bool PERM = true;
    unsigned char* ws;
    __device__ __forceinline__ void operator()(EPI_ARGS) const {
        bf16_t* base = (bf16_t*)(ws + (u.aux == 0 ? WS_Q : (u.aux == 1 ? WS_KN : WS_VT))); const int ld = u.aux == 0 ? 768 : (u.aux == 1 ? 512 : MTOK);
        const int row0 = u.pm * 256 + wr * 64 + fr, col0 = u.pn * 256 + wc * 32 + 8 * fq;
#pragma unroll
        for (int ai = 0; ai < 2; ++ai)
#pragma unroll
            for (int m = 0; m < 4; ++m) { bf16_t* rowp = base + (size_t)(row0 + ai * 128 + m * 16) * ld + col0;
#pragma unroll
                for (int bj = 0; bj < 2; ++bj) { const f32x4 v0 = acc[ai][bj][m][0], v1 = acc[ai][bj][m][1];
                    u32x4 w; w.x = cvt_pk_bf16(v0[0], v0[1]); w.y = cvt_pk_bf16(v0[2], v0[3]); w.z = cvt_pk_bf16(v1[0], v1[1]); w.w = cvt_pk_bf16(v1[2], v1[3]);
                    *(u32x4*)(rowp + bj * 128) = w; } }
    }
};
struct EpiLora {
    static constexpr bool PERM = true;
    bf16_t* O; const float* w0; const float* a0;
    __device__ __forceinline__ void operator()(EPI_ARGS) const {
        const int seg = u.pn >> 1;
        const int row0 = u.pm * 256 + wr * 64 + fr, col0 = u.pn * 256 + wc * 32 + 8 * fq, ch0 = (u.pn & 1) * 256 + wc * 32 + 8 * fq;
        const float* bias = seg == 0 ? w0 : a0; const float sc = seg == 0 ? -0.6065306597126334f : 1.0f;
#pragma unroll
        for (int bj = 0; bj < 2; ++bj) {
            f32x4 b0 = {0.f, 0.f, 0.f, 0.f}, b1 = {0.f, 0.f, 0.f, 0.f};
            if (seg < 2) { b0 = *(const f32x4*)(bias + ch0 + bj * 128); b1 = *(const f32x4*)(bias + ch0 + bj * 128 + 4); }
#pragma unroll
            for (int ai = 0; ai < 2; ++ai)
#pragma unroll
                for (int m = 0; m < 4; ++m) { bf16_t* rowp = O + (size_t)(row0 + ai * 128 + m * 16) * LO_W + col0 + bj * 128;
                    f32x4 v0 = acc[ai][bj][m][0] + b0, v1 = acc[ai][bj][m][1] + b1;
                    if (seg < 2) {
#pragma unroll
                        for (int j = 0; j < 4; ++j) { v0[j] = sc * sigmoidf_(v0[j]); v1[j] = sc * sigmoidf_(v1[j]); }
                    }
                    u32x4 w; w.x = cvt_pk_bf16(v0[0], v0[1]); w.y = cvt_pk_bf16(v0[2], v0[3]); w.z = cvt_pk_bf16(v1[0], v1[1]); w.w = cvt_pk_bf16(v1[2], v1[3]);
                    *(u32x4*)rowp = w; }
        }
    }
};
struct EpiGate {
    static constexpr bool PERM = true;
    bf16_t* O;
    __device__ __forceinline__ void operator()(EPI_ARGS) const {
        const int row0 = u.pm * 256 + wr * 64 + fr, col0 = u.aux * 1024 + u.pn * 256 + wc * 32 + 8 * fq;
#pragma unroll
        for (int ai = 0; ai < 2; ++ai)
#pragma unroll
            for (int m = 0; m < 4; ++m) { bf16_t* rowp = O + (size_t)(row0 + ai * 128 + m * 16) * 3072 + col0;
#pragma unroll
                for (int bj = 0; bj < 2; ++bj) { f32x4 v0 = acc[ai][bj][m][0], v1 = acc[ai][bj][m][1];
#pragma unroll
                    for (int j = 0; j < 4; ++j) { v0[j] = sigmoidf_(v0[j]); v1[j] = sigmoidf_(v1[j]); }
                    u32x4 w; w.x = cvt_pk_bf16(v0[0], v0[1]); w.y = cvt_pk_bf16(v0[2], v0[3]); w.z = cvt_pk_bf16(v1[0], v1[1]); w.w = cvt_pk_bf16(v1[2], v1[3]);
                    *(u32x4*)(rowp + bj * 128) = w; } }
    }
};
struct EpiMerge {
    static constexpr bool PERM = true;
    const bf16_t* Gt; bf16_t* Mg;
    __device__ __forceinline__ void operator()(EPI_ARGS) const {
        const int n = u.aux;
        const int row0 = u.pm * 256 + wr * 64 + fr, col0 = u.pn * 256 + wc * 32 + 8 * fq;
#pragma unroll
        for (int ai = 0; ai < 2; ++ai)
#pragma unroll
            for (int m = 0; m < 4; ++m) { const size_t r = (size_t)(row0 + ai * 128 + m * 16);
#pragma unroll
                for (int bj = 0; bj < 2; ++bj) { const f32x4 v0 = acc[ai][bj][m][0], v1 = acc[ai][bj][m][1];
                    const u32x4 g = *(const u32x4*)(Gt + r * 3072 + n * 1024 + col0 + bj * 128);
                    float o[8] = {bflo(g.x) * v0[0], bfhi(g.x) * v0[1], bflo(g.y) * v0[2], bfhi(g.y) * v0[3], bflo(g.z) * v1[0], bfhi(g.z) * v1[1], bflo(g.w) * v1[2], bfhi(g.w) * v1[3]};
                    bf16_t* mp = Mg + r * 1024 + col0 + bj * 128;
                    if (n > 0) { const u32x4 p = *(const u32x4*)mp; o[0] += bflo(p.x); o[1] += bfhi(p.x); o[2] += bflo(p.y); o[3] += bfhi(p.y); o[4] += bflo(p.z); o[5] += bfhi(p.z); o[6] += bflo(p.w); o[7] += bfhi(p.w); }
                    u32x4 w; w.x = cvt_pk_bf16(o[0], o[1]); w.y = cvt_pk_bf16(o[2], o[3]); w.z = cvt_pk_bf16(o[4], o[5]); w.w = cvt_pk_bf16(o[6], o[7]);
                    *(u32x4*)mp = w; } }
    }
};
struct EpiResid {
    static constexpr bool PERM = false;
    const float* In; float* Out;
    __device__ __forceinline__ void operator()(EPI_ARGS) const {
        const int row0 = u.pm * 256 + wr * 64 + fr, col0 = u.pn * 256 + wc * 32 + 4 * fq;
#pragma unroll
        for (int ai = 0; ai < 2; ++ai)
#pragma unroll
            for (int m = 0; m < 4; ++m) { const size_t o = (size_t)(row0 + ai * 128 + m * 16) * DM + col0;
#pragma unroll
                for (int bj = 0; bj < 2; ++bj)
#pragma unroll
                    for (int n = 0; n < 2; ++n) { const f32x4 x = *(const f32x4*)(In + o + bj * 128 + n * 16); *(f32x4*)(Out + o + bj * 128 + n * 16) = x + acc[ai][bj][m][n]; } }
    }
};
struct EpiSwiglu {
    static constexpr bool PERM = true;
    bf16_t* O; int ldc; int pn_off;
    __device__ __forceinline__ void operator()(EPI_ARGS) const {
        const int row0 = u.pm * 256 + wr * 64 + fr, col0 = (u.pn - pn_off) * 128 + wc * 32 + 8 * fq;
#pragma unroll
        for (int ai = 0; ai < 2; ++ai)
#pragma unroll
            for (int m = 0; m < 4; ++m) { bf16_t* rowp = O + (size_t)(row0 + ai * 128 + m * 16) * ldc + col0;
                float o[8];
#pragma unroll
                for (int n = 0; n < 2; ++n)
#pragma unroll
                    for (int j = 0; j < 4; ++j) { const float g = acc[ai][0][m][n][j], up = acc[ai][1][m][n][j]; o[n * 4 + j] = g * sigmoidf_(g) * up; }
                u32x4 w; w.x = cvt_pk_bf16(o[0], o[1]); w.y = cvt_pk_bf16(o[2], o[3]); w.z = cvt_pk_bf16(o[4], o[5]); w.w = cvt_pk_bf16(o[6], o[7]);
                *(u32x4*)rowp = w; }
    }
};
struct EpiMoeDown {
    static constexpr bool PERM = false;
    const int* row_tok; const float* row_w; float* H;
    __device__ __forceinline__ void operator()(EPI_ARGS) const {
        const int row0 = u.pm * 256 + wr * 64 + fr, col0 = u.pn * 256 + wc * 32 + 4 * fq;
#pragma unroll
        for (int ai = 0; ai < 2; ++ai)
#pragma unroll
            for (int m = 0; m < 4; ++m) { const int r = row0 + ai * 128 + m * 16; const int tk = row_tok[r]; const float wt = row_w[r];
                if (tk >= 0) { float* hp = H + (size_t)tk * DM + col0;
#pragma unroll
                    for (int bj = 0; bj < 2; ++bj)
#pragma unroll
                        for (int n = 0; n < 2; ++n)
#pragma unroll
                            for (int j = 0; j < 4; ++j) atomicAdd(hp + bj * 128 + n * 16 + j, wt * acc[ai][bj][m][n][j]); } }
    }
};

__device__ __forceinline__ void transpose_tile(const float* W, int ldn, int k0, int n0, bf16_t* WT, int ldk, int drow, int dk0, LAS float* scr, int lane) {
#pragma unroll 8
    for (int i = 0; i < 32; ++i) { const int kk = 2 * i + (lane >> 5); scr[kk * 33 + (lane & 31)] = W[(size_t)(k0 + kk) * ldn + n0 + (lane & 31)]; }
    LDS_WAIT(); asm volatile("" ::: "memory");
    const int c = lane & 7;
#pragma unroll
    for (int j = 0; j < 4; ++j) { const int n = (lane >> 3) + 8 * j; const LAS float* s = scr + (8 * c) * 33 + n;
        u32x4 o; o.x = pk2(s[0 * 33], s[1 * 33]); o.y = pk2(s[2 * 33], s[3 * 33]); o.z = pk2(s[4 * 33], s[5 * 33]); o.w = pk2(s[6 * 33], s[7 * 33]);
        *(u32x4*)(WT + (size_t)(drow + n) * ldk + dk0 + k0 + 8 * c) = o; }
    LDS_WAIT(); asm volatile("" ::: "memory");
}
__device__ __forceinline__ void conv_plain(const float* W, int K, int N, bf16_t* WT, int ldk, int item, LAS float* scr, int lane) {
    const int nblk = N / 32, kb = item / nblk, nb = item % nblk;
    transpose_tile(W, N, kb * 64, nb * 32, WT, ldk, nb * 32, 0, scr, lane);
}
__device__ __forceinline__ int win_drow(int n0) { return n0 < 3872 ? n0 : (n0 < 4128 ? 4096 + (n0 - 3872) : (n0 < 4288 ? 4352 + (n0 - 4128) : 4608 + (n0 - 4288))); }
__device__ __forceinline__ int gu_drow(int n0, int up) { return (n0 >> 7) * 256 + (n0 & 127) + up * 128; }

__device__ void phase_prologue(const Frame& F, const Params& P) {
    LAS float* scr = (LAS float*)(F.lds + F.wave * 16384);
    unsigned char* ws = F.ws;
    constexpr int I_IN = 16 * 230, I_QB = 4 * 24, I_BRn = 8 * 32, I_WOn = 16 * 32, I_G = 16 * 88, I_D = 44 * 32;
    constexpr int NIT = NLAYER * (I_IN + I_QB + 3 * I_BRn + I_WOn) + 2 * I_G + I_D;
    for (int it = F.gw; it < NIT; it += F.ngw) {
        int r = it;
        if (r < NLAYER * I_IN) { const int l = r / I_IN; r %= I_IN; const int kb = r / 230, nb = r % 230;
            transpose_tile(P.in[I_WIN] + (size_t)l * DM * IN_COLS, IN_COLS, kb * 64, nb * 32, (bf16_t*)(ws + WS_WIN) + (size_t)l * WIN_ROWS * DM, DM, win_drow(nb * 32), 0, scr, F.lane); continue; }
        r -= NLAYER * I_IN;
        if (r < NLAYER * I_QB) { const int l = r / I_QB; r %= I_QB; conv_plain(P.in[I_WQB] + (size_t)l * 256 * 768, 256, 768, (bf16_t*)(ws + WS_QB) + (size_t)l * 768 * 256, 256, r, scr, F.lane); continue; }
        r -= NLAYER * I_QB;
        if (r < NLAYER * 3 * I_BRn) { const int ln = r / I_BRn; r %= I_BRn; conv_plain(P.in[I_WBR] + (size_t)ln * 512 * 1024, 512, 1024, (bf16_t*)(ws + WS_BR) + (size_t)ln * 1024 * 512, 512, r, scr, F.lane); continue; }
        r -= NLAYER * 3 * I_BRn;
        if (r < NLAYER * I_WOn) { const int l = r / I_WOn; r %= I_WOn; conv_plain(P.in[I_WO] + (size_t)l * DM * DM, DM, DM, (bf16_t*)(ws + WS_WO) + (size_t)l * DM * DM, DM, r, scr, F.lane); continue; }
        r -= NLAYER * I_WOn;
        if (r < 2 * I_G) { const int up = r / I_G; r %= I_G; const int kb = r / 88, nb = r % 88;
            transpose_tile(P.in[up ? I_FU : I_FG], DFF, kb * 64, nb * 32, (bf16_t*)(ws + WS_FGU), DM, gu_drow(nb * 32, up), 0, scr, F.lane); continue; }
        r -= 2 * I_G;
        conv_plain(P.in[I_FD], DFF, DM, (bf16_t*)(ws + WS_FD), DFF, r, scr, F.lane);
    }
    const int gt = F.blk * NTHR + F.tid, ngt = F.G * NTHR;
    for (int i = gt; i < NLAYER * 1536 * 384; i += ngt) { const int l = i / (1536 * 384), r = i % (1536 * 384), n = r / 384, k = r % 384; const int seg = n >> 9, c = n & 511; float v = 0.f;
        if (seg == 0 && k < 64) v = P.in[I_W2][((size_t)l * 64 + k) * 512 + c];
        else if (seg == 1 && k >= 64 && k < 128) v = P.in[I_A2][((size_t)l * 64 + (k - 64)) * 512 + c];
        else if (seg == 2 && k >= 128 && k < 288) v = P.in[I_G2][((size_t)l * 160 + (k - 128)) * 512 + c];
        ((bf16_t*)(ws + WS_LORA))[i] = (bf16_t)f2bf(v); }
    for (int i = gt; i < NLAYER * 512 * 256; i += ngt) { const int l = i / (512 * 256), r = i % (512 * 256), n = r / 256, k = r % 256; const int h = n >> 6, d = n & 63;
        float vk = 0.f, vv = 0.f; if (k < 128) { const float* w = P.in[I_WKVB] + ((size_t)l * 128 + k) * 1024 + h * 128; vk = w[d]; vv = w[64 + d]; }
        ((bf16_t*)(ws + WS_KB))[i] = (bf16_t)f2bf(vk); ((bf16_t*)(ws + WS_VB))[i] = (bf16_t)f2bf(vv); }
    for (int i = gt; i < MTOK * 80; i += ngt) { const int m = i / 80, j = i % 80; const int isr = j < 64; const int idx = isr ? j : j - 64; const double dim = isr ? 128.0 : 32.0;
        const float inv = (float)(1.0 / pow(10000.0, (2.0 * idx) / dim)); const float ang = (float)((const int*)P.in[I_POS])[m] * inv;
        const double a = (double)ang, q = rint(a * 0.15915494309189535), rr = a - q * 6.283185307179586476925;
        const float rf = (float)rr; const float cs = __cosf(rf), sn = __sinf(rf);
        if (isr) { ((float*)(ws + WS_COSR))[(size_t)m * 64 + idx] = cs; ((float*)(ws + WS_SINR))[(size_t)m * 64 + idx] = sn; }
        else { ((float*)(ws + WS_COSM))[(size_t)m * 16 + idx] = cs; ((float*)(ws + WS_SINM))[(size_t)m * 16 + idx] = sn; } }
}
__device__ void phase_moe_convert(const Frame& F, const Params& P) {
    LAS float* scr = (LAS float*)(F.lds + F.wave * 16384);
    constexpr int I_G = 16 * 112, I_D = 56 * 32;
    constexpr int NIT = NEXP * (2 * I_G + I_D);
    for (int it = F.gw; it < NIT; it += F.ngw) {
        const int e = it / (2 * I_G + I_D); int r = it % (2 * I_G + I_D);
        if (r < 2 * I_G) { const int up = r / I_G; r %= I_G; const int kb = r / 112, nb = r % 112;
            transpose_tile(P.in[up ? I_MU2 : I_MG] + (size_t)e * DM * DFFE, DFFE, kb * 64, nb * 32, (bf16_t*)(F.ws + WS_MGU) + (size_t)e * 2 * DFFE * DM, DM, gu_drow(nb * 32, up), 0, scr, F.lane); continue; }
        r -= 2 * I_G;
        conv_plain(P.in[I_MD] + (size_t)e * DFFE * DM, DFFE, DM, (bf16_t*)(F.ws + WS_MD) + (size_t)e * DM * DFFE, DFFE, r, scr, F.lane);
    }
}

template <bool MOE>
__device__ void phase_rms(const Frame& F, const float* src, const float* gain, bf16_t* hn, const float* router, unsigned* ectl, int* tok_e, int* tok_slot, float* tok_w) {
    LAS int* lcnt = (LAS int*)(F.lds);
    if (MOE) { if (F.tid < 16) lcnt[F.tid] = 0; __syncthreads(); }
    int my_e0 = 0, my_e1 = 0, my_s0 = 0, my_s1 = 0; float my_w0 = 0.f, my_w1 = 0.f;
    for (int i = 0; i < 8; ++i) {
        const int m = F.blk * 64 + F.wave * 8 + i;
        const f32x4* xr = (const f32x4*)(src + (size_t)m * DM) + F.lane;
        f32x4 v[4]; float s = 0.f;
#pragma unroll
        for (int j = 0; j < 4; ++j) { v[j] = xr[64 * j]; s += (v[j].x * v[j].x + v[j].y * v[j].y) + (v[j].z * v[j].z + v[j].w * v[j].w); }
        const float rstd = rsqrtf(wave_sum(s) * (1.0f / DM) + NORM_EPS);
#pragma unroll
        for (int j = 0; j < 4; ++j) { const f32x4 g = ((const f32x4*)gain)[F.lane + 64 * j]; v[j] = v[j] * rstd * g; }
        u32x2* o8 = (u32x2*)(hn + (size_t)m * DM) + F.lane;
#pragma unroll
        for (int j = 0; j < 4; ++j) { u32x2 w; w.x = pk2(v[j].x, v[j].y); w.y = pk2(v[j].z, v[j].w); o8[64 * j] = w; }
        if (MOE) {
            float lg[8];
#pragma unroll
            for (int e = 0; e < 8; ++e) lg[e] = 0.f;
#pragma unroll
            for (int j = 0; j < 4; ++j)
#pragma unroll
                for (int q = 0; q < 4; ++q) { const int c = 4 * F.lane + 256 * j + q; const f32x4 r0 = *(const f32x4*)(router + (size_t)c * 8), r1 = *(const f32x4*)(router + (size_t)c * 8 + 4); const float x = v[j][q];
                    lg[0] += x * r0.x; lg[1] += x * r0.y; lg[2] += x * r0.z; lg[3] += x * r0.w; lg[4] += x * r1.x; lg[5] += x * r1.y; lg[6] += x * r1.z; lg[7] += x * r1.w; }
#pragma unroll
            for (int e = 0; e < 8; ++e) lg[e] = wave_sum(lg[e]);
            int e0 = 0; float b0 = lg[0];
#pragma unroll
            for (int e = 1; e < 8; ++e) if (lg[e] > b0) { b0 = lg[e]; e0 = e; }
            int e1 = -1; float b1 = -3.0e38f;
#pragma unroll
            for (int e = 0; e < 8; ++e) if (e != e0 && lg[e] > b1) { b1 = lg[e]; e1 = e; }
            const float t = __expf(b1 - b0), w0 = 1.0f / (1.0f + t), w1 = t / (1.0f + t);
            int s0 = 0, s1 = 0;
            if (F.lane == 0) { s0 = atomicAdd((int*)&lcnt[e0], 1); s1 = atomicAdd((int*)&lcnt[e1], 1); }
            s0 = __shfl(s0, 0); s1 = __shfl(s1, 0);
            if (F.lane == i) { my_e0 = e0; my_e1 = e1; my_s0 = s0; my_s1 = s1; my_w0 = w0; my_w1 = w1; }
        }
    }
    if (MOE) {
        __syncthreads();
        if (F.tid < 8) lcnt[8 + F.tid] = (int)atomicAdd(&ectl[F.tid], (unsigned)lcnt[F.tid]);
        __syncthreads();
        if (F.lane < 8) { const int m = F.blk * 64 + F.wave * 8 + F.lane;
            tok_e[2 * m] = my_e0; tok_e[2 * m + 1] = my_e1; tok_slot[2 * m] = lcnt[8 + my_e0] + my_s0; tok_slot[2 * m + 1] = lcnt[8 + my_e1] + my_s1; tok_w[2 * m] = my_w0; tok_w[2 * m + 1] = my_w1; }
        __syncthreads();
    }
}
__device__ void phase_final(const Frame& F, float* h, const float* gain) {
    for (int m = F.gw; m < MTOK; m += F.ngw) {
        f32x4* xr = (f32x4*)(h + (size_t)m * DM) + F.lane;
        f32x4 v[4]; float s = 0.f;
#pragma unroll
        for (int j = 0; j < 4; ++j) { v[j] = xr[64 * j]; s += (v[j].x * v[j].x + v[j].y * v[j].y) + (v[j].z * v[j].z + v[j].w * v[j].w); }
        const float rstd = rsqrtf(wave_sum(s) * (1.0f / DM) + NORM_EPS);
#pragma unroll
        for (int j = 0; j < 4; ++j) { const f32x4 g = ((const f32x4*)gain)[F.lane + 64 * j]; xr[64 * j] = v[j] * rstd * g; }
    }
}
template <int KS>
__device__ __forceinline__ f32x4 mm_tile(const LAS bf16_t* P, int ldp, const LAS bf16_t* Q, int ldq, int ib, int jb, int lane, f32x4 acc) {
    const LAS bf16_t* pp = P + (ib * 16 + (lane & 15)) * ldp + 8 * (lane >> 4);
    const LAS bf16_t* qp = Q + (jb * 16 + (lane & 15)) * ldq + 8 * (lane >> 4);
#pragma unroll
    for (int ks = 0; ks < KS; ++ks) { const bf16x8 a = *(const LAS bf16x8*)(qp + ks * 32), b = *(const LAS bf16x8*)(pp + ks * 32); acc = __builtin_amdgcn_mfma_f32_16x16x32_bf16(a, b, acc, 0, 0, 0); }
    return acc;
}
__device__ __forceinline__ void st_bf4(LAS bf16_t* p, f32x4 v) { u32x2 w; w.x = pk2(v[0], v[1]); w.y = pk2(v[2], v[3]); *(LAS u32x2*)p = w; }
__device__ __forceinline__ float ret_lg(int h) { return __logf(1.0f - exp2f(-5.0f - (float)h)); }

__device__ void phase_prep(const Frame& F, const Params& P, int layer) {
    unsigned char* ws = F.ws;
    const bf16_t* p = (const bf16_t*)(ws + WS_P);
    const float* mu = P.in[I_MU] + (size_t)layer * RWKV_COLS;
    for (int m = F.gw; m < MTOK; m += F.ngw) {
        const bf16_t* pr = p + (size_t)m * PW; const bool has_prev = (m % SEQ) != 0; const bf16_t* pp = pr - PW;
        bf16_t* lin = (bf16_t*)(ws + WS_LIN) + (size_t)m * LORA_K;
#pragma unroll
        for (int jj = 0; jj < 6; ++jj) { const int c = F.lane + 64 * jj; float o = 0.f;
            if (c < 288) { const int off = 1536 + c; const float x = bf2f(pr[P_RW + off]), xp = has_prev ? bf2f(pp[P_RW + off]) : 0.f; const float xs = x + (xp - x) * mu[off];
                o = c < 64 ? tanhf(xs) : (c < 128 ? xs : sigmoidf_(xs)); }
            lin[c] = (bf16_t)f2bf(o); }
        {
            const u32x2 w = *(const u32x2*)(pr + P_QA + 4 * F.lane); float x[4] = {bflo(w.x), bfhi(w.x), bflo(w.y), bfhi(w.y)};
            const float ss = wave_sum(x[0] * x[0] + x[1] * x[1] + x[2] * x[2] + x[3] * x[3]); const float rs = rsqrtf(ss * (1.0f / 256.0f) + NORM_EPS);
            const f32x4 g = *(const f32x4*)(P.in[I_QNORM] + layer * 256 + 4 * F.lane);
            u32x2 o; o.x = pk2(x[0] * rs * g.x, x[1] * rs * g.y); o.y = pk2(x[2] * rs * g.z, x[3] * rs * g.w); *(u32x2*)((bf16_t*)(ws + WS_QN) + (size_t)m * 256 + 4 * F.lane) = o; }
        {
            const unsigned w = *(const unsigned*)(pr + P_KVA + 2 * F.lane); float x0 = bflo(w), x1 = bfhi(w);
            const float ss = wave_sum(x0 * x0 + x1 * x1); const float rs = rsqrtf(ss * (1.0f / 128.0f) + NORM_EPS);
            const f32x2 g = *(const f32x2*)(P.in[I_KVNORM] + layer * 128 + 2 * F.lane);
            unsigned* cn = (unsigned*)((bf16_t*)(ws + WS_CN) + (size_t)m * 256); cn[F.lane] = pk2(x0 * rs * g.x, x1 * rs * g.y); cn[64 + F.lane] = 0u; }
        if (F.lane < 16) {
            const float x1 = bf2f(pr[P_KVA + 128 + F.lane]), x2 = bf2f(pr[P_KVA + 144 + F.lane]);
            const float c = ((const float*)(ws + WS_COSM))[(size_t)m * 16 + F.lane], s = ((const float*)(ws + WS_SINM))[(size_t)m * 16 + F.lane];
            bf16_t* kp = (bf16_t*)(ws + WS_KPE) + (size_t)m * 32; kp[F.lane] = (bf16_t)f2bf(x1 * c - x2 * s); kp[16 + F.lane] = (bf16_t)f2bf(x1 * s + x2 * c); }
    }
    LAS bf16_t* kT = (LAS bf16_t*)F.lds;
    LAS bf16_t* vT = kT + 128 * 72;
    const int pc = F.tid & 7, j = F.tid >> 3;
    for (int u = F.blk; u < NB * NCHUNK * 4; u += F.G) {
        const int h = u & 3, n = (u >> 2) & 127, b = u >> 9; const int m = b * SEQ + n * 64 + j;
        const float lg = ret_lg(h);
        __syncthreads();
        {
            const bf16_t* kr = p + (size_t)m * PW + P_RK + h * 128 + pc * 8;
            const u32x4 a = *(const u32x4*)kr, bq = *(const u32x4*)(kr + 64);
            const float* cp = (const float*)(ws + WS_COSR) + (size_t)m * 64 + pc * 8; const float* sp = (const float*)(ws + WS_SINR) + (size_t)m * 64 + pc * 8;
            const float sc = 0.08838834764831845f * __expf(lg * (float)(63 - j));
            const unsigned aw[4] = {a.x, a.y, a.z, a.w}, bw[4] = {bq.x, bq.y, bq.z, bq.w};
#pragma unroll
            for (int i = 0; i < 8; ++i) { const float x1 = (i & 1) ? bfhi(aw[i >> 1]) : bflo(aw[i >> 1]), x2 = (i & 1) ? bfhi(bw[i >> 1]) : bflo(bw[i >> 1]); const float c = cp[i], s = sp[i];
                kT[(pc * 8 + i) * 72 + j] = (bf16_t)f2bf((x1 * c - x2 * s) * sc); kT[(64 + pc * 8 + i) * 72 + j] = (bf16_t)f2bf((x1 * s + x2 * c) * sc); }
            const bf16_t* vr = p + (size_t)m * PW + P_RV + h * 128 + pc * 8;
            const u32x4 va = *(const u32x4*)vr, vb = *(const u32x4*)(vr + 64);
            const unsigned vaw[4] = {va.x, va.y, va.z, va.w}, vbw[4] = {vb.x, vb.y, vb.z, vb.w};
#pragma unroll
            for (int i = 0; i < 8; ++i) { vT[(pc * 8 + i) * 72 + j] = (bf16_t)((i & 1) ? (vaw[i >> 1] >> 16) : (vaw[i >> 1] & 0xffffu)); vT[(64 + pc * 8 + i) * 72 + j] = (bf16_t)((i & 1) ? (vbw[i >> 1] >> 16) : (vbw[i >> 1] & 0xffffu)); }
        }
        __syncthreads();
        bf16_t* out = (bf16_t*)(ws + WS_RS) + (size_t)u * 16384;
#pragma unroll
        for (int jb = 0; jb < 8; ++jb) { f32x4 acc = {0.f, 0.f, 0.f, 0.f}; acc = mm_tile<2>(vT, 72, kT, 72, F.wave, jb, F.lane, acc);
            const int e = F.wave * 16 + (F.lane & 15), d = jb * 16 + 4 * (F.lane >> 4);
            u32x2 w; w.x = pk2(acc[0], acc[1]); w.y = pk2(acc[2], acc[3]); *(u32x2*)(out + e * 128 + d) = w; }
    }
    __syncthreads();
}

__device__ void ret_scan(const Frame& F) {
    bf16_t* rs = (bf16_t*)(F.ws + WS_RS);
    for (int idx = F.blk * NTHR + F.tid; idx < NB * 4 * 16384; idx += F.G * NTHR) {
        const int b = idx >> 16, h = (idx >> 14) & 3, ed = idx & 16383; const float cd = __expf(ret_lg(h) * 64.0f);
        bf16_t* base = rs + ((size_t)(b * 128) * 4 + h) * 16384 + ed; float s = 0.f;
        for (int n0 = 0; n0 < NCHUNK; n0 += 8) { float t[8];
#pragma unroll
            for (int i = 0; i < 8; ++i) t[i] = bf2f(base[(size_t)(n0 + i) * 65536]);
#pragma unroll
            for (int i = 0; i < 8; ++i) { base[(size_t)(n0 + i) * 65536] = (bf16_t)f2bf(s); s = s * cd + t[i]; } }
    }
}

__device__ void ret_out(const Frame& F) {
    unsigned char* ws = F.ws; const bf16_t* p = (const bf16_t*)(ws + WS_P);
    LAS bf16_t* q = (LAS bf16_t*)F.lds;
    LAS bf16_t* k = q + 64 * 136;
    LAS bf16_t* vT = k + 64 * 136;
    LAS bf16_t* pT = vT + 128 * 72;
    LAS bf16_t* sc = pT + 128 * 136;
    LAS float* st = (LAS float*)(sc + 64 * 72);
    const int pc = F.tid & 7, j = F.tid >> 3;
    for (int u = F.blk; u < NB * NCHUNK * 4; u += F.G) {
        const int h = u & 3, n = (u >> 2) & 127, b = u >> 9; const int m0 = b * SEQ + n * 64, m = m0 + j;
        const float lg = ret_lg(h);
        __syncthreads();
        {
            const float* cp = (const float*)(ws + WS_COSR) + (size_t)m * 64 + pc * 8; const float* sp = (const float*)(ws + WS_SINR) + (size_t)m * 64 + pc * 8;
            float cs[8], sn[8];
#pragma unroll
            for (int i = 0; i < 8; ++i) { cs[i] = cp[i]; sn[i] = sp[i]; }
#pragma unroll
            for (int which = 0; which < 2; ++which) {
                const bf16_t* r = p + (size_t)m * PW + (which ? P_RK : P_RQ) + h * 128 + pc * 8;
                const u32x4 a = *(const u32x4*)r, bq = *(const u32x4*)(r + 64);
                const unsigned aw[4] = {a.x, a.y, a.z, a.w}, bw[4] = {bq.x, bq.y, bq.z, bq.w}; const float sc_ = which ? 0.08838834764831845f : 1.0f;
                float o1[8], o2[8];
#pragma unroll
                for (int i = 0; i < 8; ++i) { const float x1 = (i & 1) ? bfhi(aw[i >> 1]) : bflo(aw[i >> 1]), x2 = (i & 1) ? bfhi(bw[i >> 1]) : bflo(bw[i >> 1]); o1[i] = (x1 * cs[i] - x2 * sn[i]) * sc_; o2[i] = (x1 * sn[i] + x2 * cs[i]) * sc_; }
                LAS bf16_t* dst = (which ? k : q) + j * 136 + pc * 8;
                u32x4 w1, w2; w1.x = pk2(o1[0], o1[1]); w1.y = pk2(o1[2], o1[3]); w1.z = pk2(o1[4], o1[5]); w1.w = pk2(o1[6], o1[7]); w2.x = pk2(o2[0], o2[1]); w2.y = pk2(o2[2], o2[3]); w2.z = pk2(o2[4], o2[5]); w2.w = pk2(o2[6], o2[7]);
                *(LAS u32x4*)dst = w1; *(LAS u32x4*)(dst + 64) = w2; }
            const bf16_t* vr = p + (size_t)m * PW + P_RV + h * 128 + pc * 8;
            const u32x4 va = *(const u32x4*)vr, vb = *(const u32x4*)(vr + 64);
            const unsigned vaw[4] = {va.x, va.y, va.z, va.w}, vbw[4] = {vb.x, vb.y, vb.z, vb.w};
#pragma unroll
            for (int i = 0; i < 8; ++i) { vT[(pc * 8 + i) * 72 + j] = (bf16_t)((i & 1) ? (vaw[i >> 1] >> 16) : (vaw[i >> 1] & 0xffffu)); vT[(64 + pc * 8 + i) * 72 + j] = (bf16_t)((i & 1) ? (vbw[i >> 1] >> 16) : (vbw[i >> 1] & 0xffffu)); }
            const bf16_t* ps = (const bf16_t*)(ws + WS_RS) + (size_t)u * 16384;
#pragma unroll
            for (int i = 0; i < 4; ++i) { const int pi = F.tid + i * 512; const int e = pi >> 4, c = pi & 15; *(LAS u32x4*)(pT + e * 136 + c * 8) = *(const u32x4*)(ps + e * 128 + c * 8); }
        }
        __syncthreads();
        {
            const int ib = F.wave & 3;
#pragma unroll
            for (int t = 0; t < 2; ++t) { const int jb = 2 * (F.wave >> 2) + t; f32x4 acc = {0.f, 0.f, 0.f, 0.f}; acc = mm_tile<4>(q, 136, k, 136, ib, jb, F.lane, acc);
                const int i = ib * 16 + (F.lane & 15), j0 = jb * 16 + 4 * (F.lane >> 4);
#pragma unroll
                for (int r = 0; r < 4; ++r) { const int dd = i - (j0 + r); acc[r] *= __expf(lg * (float)(dd < 0 ? -dd : dd)); }
                st_bf4(sc + i * 72 + j0, acc); }
        }
        __syncthreads();
        {
            const int ib = F.wave & 3, eh = F.wave >> 2; const int i = ib * 16 + (F.lane & 15);
            const float qd = __expf(lg * (float)(i + 1));
            f32x4 o[4]; float s1 = 0.f, s2 = 0.f;
#pragma unroll
            for (int t = 0; t < 4; ++t) { const int eb = eh * 4 + t; f32x4 ai = {0.f, 0.f, 0.f, 0.f}, ac = {0.f, 0.f, 0.f, 0.f};
                ai = mm_tile<2>(sc, 72, vT, 72, ib, eb, F.lane, ai); ac = mm_tile<4>(q, 136, pT, 136, ib, eb, F.lane, ac);
                o[t] = ai + ac * qd;
#pragma unroll
                for (int r = 0; r < 4; ++r) { s1 += o[t][r]; s2 += o[t][r] * o[t][r]; } }
            s1 += __shfl_xor(s1, 16); s1 += __shfl_xor(s1, 32); s2 += __shfl_xor(s2, 16); s2 += __shfl_xor(s2, 32);
            if (F.lane < 16) { st[(eh * 64 + i) * 2] = s1; st[(eh * 64 + i) * 2 + 1] = s2; }
            __syncthreads();
            const float t1 = st[i * 2] + st[(64 + i) * 2], t2 = st[i * 2 + 1] + st[(64 + i) * 2 + 1];
            const float mean = t1 * (1.0f / 128.0f), var = fmaxf(t2 * (1.0f / 128.0f) - mean * mean, 0.f), rstd = rsqrtf(var + 1e-5f);
            const int mrow = m0 + i;
#pragma unroll
            for (int t = 0; t < 4; ++t) { const int e = (eh * 4 + t) * 16 + 4 * (F.lane >> 4);
                const u32x2 gw = *(const u32x2*)(p + (size_t)mrow * PW + P_RG + h * 128 + e); const float g[4] = {bflo(gw.x), bfhi(gw.x), bflo(gw.y), bfhi(gw.y)};
                float y[4];
#pragma unroll
                for (int r = 0; r < 4; ++r) y[r] = (o[t][r] - mean) * rstd * (g[r] * sigmoidf_(g[r]));
                u32x2 w; w.x = pk2(y[0], y[1]); w.y = pk2(y[2], y[3]); *(u32x2*)((bf16_t*)(ws + WS_YRET) + (size_t)mrow * 512 + h * 128 + e) = w; }
        }
    }
    __syncthreads();
}

constexpr int ATT_KP = 104, ATT_VP = 72;
constexpr int ATT_KB = 64 * ATT_KP * 2, ATT_VB = 64 * ATT_VP * 2, ATT_BUF = ATT_KB + ATT_VB;
__device__ void attn_unit(const Frame& F, int b, int h, int qt) {
    unsigned char* ws = F.ws;
    const bf16_t* Qg = (const bf16_t*)(ws + WS_Q); const bf16_t* Kn = (const bf16_t*)(ws + WS_KN); const bf16_t* Kp = (const bf16_t*)(ws + WS_KPE); const bf16_t* Vt = (const bf16_t*)(ws + WS_VT);
    const int lane = F.lane, w = F.wave, ql = lane & 31, hf = lane >> 5;
    const int mq = b * SEQ + qt * 256 + w * 32 + ql;
    const float qs = 0.10206207261596577f * 1.4426950408889634f;
    bf16x8 qf[6];
    {
        const bf16_t* qr = Qg + (size_t)mq * 768 + h * 96;
#pragma unroll
        for (int s = 0; s < 4; ++s) { const u32x4 x = *(const u32x4*)(qr + 16 * s + 8 * hf); const unsigned xw[4] = {x.x, x.y, x.z, x.w}; u32x4 o; unsigned ow[4];
#pragma unroll
            for (int i = 0; i < 4; ++i) ow[i] = pk2(bflo(xw[i]) * qs, bfhi(xw[i]) * qs);
            o.x = ow[0]; o.y = ow[1]; o.z = ow[2]; o.w = ow[3]; qf[s] = __builtin_bit_cast(bf16x8, o); }
        const u32x4 x1 = *(const u32x4*)(qr + 64 + 8 * hf), x2 = *(const u32x4*)(qr + 80 + 8 * hf);
        const float* cp = (const float*)(ws + WS_COSM) + (size_t)mq * 16 + 8 * hf; const float* sp = (const float*)(ws + WS_SINM) + (size_t)mq * 16 + 8 * hf;
        const unsigned a[4] = {x1.x, x1.y, x1.z, x1.w}, c[4] = {x2.x, x2.y, x2.z, x2.w}; unsigned o1[4], o2[4];
#pragma unroll
        for (int i = 0; i < 4; ++i) { const float u0 = bflo(a[i]), u1 = bfhi(a[i]), v0 = bflo(c[i]), v1 = bfhi(c[i]); const float c0 = cp[2 * i], c1 = cp[2 * i + 1], s0 = sp[2 * i], s1 = sp[2 * i + 1];
            o1[i] = pk2((u0 * c0 - v0 * s0) * qs, (u1 * c1 - v1 * s1) * qs); o2[i] = pk2((u0 * s0 + v0 * c0) * qs, (u1 * s1 + v1 * c1) * qs); }
        u32x4 t1, t2; t1.x = o1[0]; t1.y = o1[1]; t1.z = o1[2]; t1.w = o1[3]; t2.x = o2[0]; t2.y = o2[1]; t2.z = o2[2]; t2.w = o2[3];
        qf[4] = __builtin_bit_cast(bf16x8, t1); qf[5] = __builtin_bit_cast(bf16x8, t2);
    }
    f32x16 oacc[2];
#pragma unroll
    for (int i = 0; i < 16; ++i) { oacc[0][i] = 0.f; oacc[1][i] = 0.f; }
    float mrun = -3.0e38f, lrun = 0.f;
    const int nkt = 4 * qt + 4, mylim = 4 * qt + (w >> 1);
    const int kkey = F.tid >> 3, kpc = F.tid & 7, rkey = F.tid >> 2, rpc = F.tid & 3, ve = F.tid >> 3, vpc = F.tid & 7;
    const bf16_t* knp = Kn + (size_t)(b * SEQ + kkey) * 512 + h * 64 + kpc * 8;
    const bf16_t* kpp = Kp + (size_t)(b * SEQ + rkey) * 32 + rpc * 8;
    const bf16_t* vtp = Vt + (size_t)(h * 64 + ve) * MTOK + b * SEQ + vpc * 8;
    u32x4 rk = *(const u32x4*)knp, rr = (F.tid < 256) ? *(const u32x4*)kpp : (u32x4){0u, 0u, 0u, 0u}, rv = *(const u32x4*)vtp;
    __syncthreads();
    {
        LAS unsigned char* buf = F.lds;
        *(LAS u32x4*)(buf + (kkey * ATT_KP + kpc * 8) * 2) = rk; if (F.tid < 256) *(LAS u32x4*)(buf + (rkey * ATT_KP + 64 + rpc * 8) * 2) = rr; *(LAS u32x4*)(buf + ATT_KB + (ve * ATT_VP + vpc * 8) * 2) = rv;
    }
    __syncthreads();
    for (int kt = 0; kt < nkt; ++kt) {
        const bool more = kt + 1 < nkt;
        if (more) { const size_t ko = (size_t)(kt + 1) * 64; rk = *(const u32x4*)(knp + ko * 512); if (F.tid < 256) rr = *(const u32x4*)(kpp + ko * 32); rv = *(const u32x4*)(vtp + ko); }
        if (kt <= mylim) {
            const LAS bf16_t* kb = (const LAS bf16_t*)(F.lds + (kt & 1) * ATT_BUF); const LAS bf16_t* vb = (const LAS bf16_t*)(F.lds + (kt & 1) * ATT_BUF + ATT_KB);
            f32x16 s[2];
#pragma unroll
            for (int t = 0; t < 2; ++t) {
#pragma unroll
                for (int i = 0; i < 16; ++i) s[t][i] = 0.f;
#pragma unroll
                for (int st = 0; st < 6; ++st) { const bf16x8 a = *(const LAS bf16x8*)(kb + (t * 32 + ql) * ATT_KP + 16 * st + 8 * hf); s[t] = __builtin_amdgcn_mfma_f32_32x32x16_bf16(a, qf[st], s[t], 0, 0, 0); } }
            float mx = s[0][0];
#pragma unroll
            for (int t = 0; t < 2; ++t)
#pragma unroll
                for (int i = 0; i < 16; ++i) mx = fmaxf(mx, s[t][i]);
            mx = fmaxf(mx, __shfl_xor(mx, 32));
            const float mnew = fmaxf(mrun, mx), alpha = exp2f(mrun - mnew); mrun = mnew;
            float ls = 0.f;
#pragma unroll
            for (int t = 0; t < 2; ++t)
#pragma unroll
                for (int i = 0; i < 16; ++i) { const float pv = exp2f(s[t][i] - mnew); s[t][i] = pv; ls += pv; }
            lrun = lrun * alpha + ls;
#pragma unroll
            for (int i = 0; i < 16; ++i) { oacc[0][i] *= alpha; oacc[1][i] *= alpha; }
#pragma unroll
            for (int t = 0; t < 2; ++t)
#pragma unroll
                for (int kbb = 0; kbb < 2; ++kbb) {
                    u32x4 pw; pw.x = pk2(s[t][8 * kbb + 0], s[t][8 * kbb + 1]); pw.y = pk2(s[t][8 * kbb + 2], s[t][8 * kbb + 3]); pw.z = pk2(s[t][8 * kbb + 4], s[t][8 * kbb + 5]); pw.w = pk2(s[t][8 * kbb + 6], s[t][8 * kbb + 7]);
                    const bf16x8 pf = __builtin_bit_cast(bf16x8, pw);
                    const int key0 = t * 32 + kbb * 16 + 4 * hf;
#pragma unroll
                    for (int eb = 0; eb < 2; ++eb) { const LAS bf16_t* vr = vb + (eb * 32 + ql) * ATT_VP + key0;
                        const u32x2 lo = *(const LAS u32x2*)vr, hi = *(const LAS u32x2*)(vr + 8); u32x4 vv; vv.x = lo.x; vv.y = lo.y; vv.z = hi.x; vv.w = hi.y;
                        oacc[eb] = __builtin_amdgcn_mfma_f32_32x32x16_bf16(__builtin_bit_cast(bf16x8, vv), pf, oacc[eb], 0, 0, 0); } }
        }
        if (more) { LAS unsigned char* buf = F.lds + ((kt + 1) & 1) * ATT_BUF;
            *(LAS u32x4*)(buf + (kkey * ATT_KP + kpc * 8) * 2) = rk; if (F.tid < 256) *(LAS u32x4*)(buf + (rkey * ATT_KP + 64 + rpc * 8) * 2) = rr; *(LAS u32x4*)(buf + ATT_KB + (ve * ATT_VP + vpc * 8) * 2) = rv; }
        __syncthreads();
    }
    const float lt = lrun + __shfl_xor(lrun, 32), inv = 1.0f / lt;
    bf16_t* yo = (bf16_t*)(ws + WS_YMLA) + (size_t)mq * 512 + h * 64;
#pragma unroll
    for (int eb = 0; eb < 2; ++eb)
#pragma unroll
        for (int g = 0; g < 4; ++g) { u32x2 wv; wv.x = pk2(oacc[eb][4 * g] * inv, oacc[eb][4 * g + 1] * inv); wv.y = pk2(oacc[eb][4 * g + 2] * inv, oacc[eb][4 * g + 3] * inv);
            *(u32x2*)(yo + eb * 32 + 8 * g + 4 * hf) = wv; }
}
__device__ void rwkv_seq(const Frame& F, const Params& P, int layer, int b, int h) {
    unsigned char* ws = F.ws; const bf16_t* p = (const bf16_t*)(ws + WS_P); const bf16_t* lo = (const bf16_t*)(ws + WS_LO);
    LAS float* Lr = (LAS float*)F.lds; LAS float* Lw = Lr + 4096; LAS float* Lk = Lw + 4096; LAS float* Lv = Lk + 4096; LAS float* Lkk = Lv + 4096; LAS float* Lb = Lkk + 4096; LAS float* Ly = Lb + 4096;
    const int lane = F.lane, ch = h * 64 + lane;
    const float mu_r = P.in[I_MU][(size_t)layer * RWKV_COLS + ch], mu_k = P.in[I_MU][(size_t)layer * RWKV_COLS + 512 + ch], mu_v = P.in[I_MU][(size_t)layer * RWKV_COLS + 1024 + ch];
    const float k_k = P.in[I_KK][layer * 512 + ch], k_a = P.in[I_KA][layer * 512 + ch], r_k = P.in[I_RK][layer * 512 + ch], lnx = P.in[I_LNX][layer * 512 + ch];
    const int vrow = F.tid >> 3, q = F.tid & 7;
    float s[8];
#pragma unroll
    for (int i = 0; i < 8; ++i) s[i] = 0.f;
    for (int c = 0; c < NCHUNK; ++c) {
        const int m0 = b * SEQ + c * 64;
        __syncthreads();
#pragma unroll
        for (int i = 0; i < 8; ++i) { const int t = F.wave + 8 * i, m = m0 + t; const bf16_t* pr = p + (size_t)m * PW + P_RW + ch; const bool hp = (c | t) != 0;
            const float xr = bf2f(pr[0]), xk = bf2f(pr[512]), xv = bf2f(pr[1024]);
            const float pr_ = hp ? bf2f(pr[-PW]) : 0.f, pk_ = hp ? bf2f(pr[512 - PW]) : 0.f, pv_ = hp ? bf2f(pr[1024 - PW]) : 0.f;
            const float r = xr + (pr_ - xr) * mu_r, k = xk + (pk_ - xk) * mu_k, v = xv + (pv_ - xv) * mu_v;
            const float lw = bf2f(lo[(size_t)m * LO_W + ch]), a = bf2f(lo[(size_t)m * LO_W + 512 + ch]);
            float kk = k * k_k; const float ss = wave_sum(kk * kk); kk *= rsqrtf(ss + 1e-12f);
            Lr[t * 64 + lane] = r; Lw[t * 64 + lane] = __expf(lw); Lk[t * 64 + lane] = k * (1.0f + (a - 1.0f) * k_a); Lv[t * 64 + lane] = v; Lkk[t * 64 + lane] = kk; Lb[t * 64 + lane] = kk * a; }
        __syncthreads();
        for (int t = 0; t < 64; ++t) {
            const f32x4 ka = *(const LAS f32x4*)(Lkk + t * 64 + q * 8), kb = *(const LAS f32x4*)(Lkk + t * 64 + q * 8 + 4);
            const f32x4 wa = *(const LAS f32x4*)(Lw + t * 64 + q * 8), wb = *(const LAS f32x4*)(Lw + t * 64 + q * 8 + 4);
            const f32x4 ba = *(const LAS f32x4*)(Lb + t * 64 + q * 8), bb = *(const LAS f32x4*)(Lb + t * 64 + q * 8 + 4);
            const f32x4 k2a = *(const LAS f32x4*)(Lk + t * 64 + q * 8), k2b = *(const LAS f32x4*)(Lk + t * 64 + q * 8 + 4);
            const f32x4 ra = *(const LAS f32x4*)(Lr + t * 64 + q * 8), rb = *(const LAS f32x4*)(Lr + t * 64 + q * 8 + 4);
            const float vv = Lv[t * 64 + vrow];
            float sa = 0.f;
#pragma unroll
            for (int i = 0; i < 4; ++i) { sa += s[i] * ka[i]; sa += s[4 + i] * kb[i]; }
            sa += __shfl_xor(sa, 1); sa += __shfl_xor(sa, 2); sa += __shfl_xor(sa, 4); sa = -sa;
            float y = 0.f;
#pragma unroll
            for (int i = 0; i < 4; ++i) { s[i] = s[i] * wa[i] + sa * ba[i] + vv * k2a[i]; s[4 + i] = s[4 + i] * wb[i] + sa * bb[i] + vv * k2b[i]; y += s[i] * ra[i]; y += s[4 + i] * rb[i]; }
            y += __shfl_xor(y, 1); y += __shfl_xor(y, 2); y += __shfl_xor(y, 4);
            if (q == 0) Ly[t * 64 + vrow] = y;
        }
        __syncthreads();
#pragma unroll
        for (int i = 0; i < 8; ++i) { const int t = F.wave + 8 * i, m = m0 + t;
            const float y = Ly[t * 64 + lane]; const float mean = wave_sum(y) * (1.0f / 64.0f); const float d = y - mean; const float var = wave_sum(d * d) * (1.0f / 64.0f);
            const float bon = wave_sum(Lr[t * 64 + lane] * Lk[t * 64 + lane] * r_k);
            const float g = bf2f(lo[(size_t)m * LO_W + 1024 + ch]);
            const float o = (d * rsqrtf(var + 64e-5f) * lnx + bon * Lv[t * 64 + lane]) * g;
            ((bf16_t*)(ws + WS_YRW))[(size_t)m * 512 + ch] = (bf16_t)f2bf(o); }
    }
    __syncthreads();
}

constexpr int LDS_TAB = LDSCTL_OFF + 64;
__device__ void moe_table(const Frame& F, const unsigned* ectl) {
    LAS int* tab = (LAS int*)(F.lds + LDS_TAB);
    if (F.tid == 0) { int st = 0, nt = 0;
        for (int e = 0; e < 8; ++e) { const int c = (int)__hip_atomic_load(&ectl[e], __ATOMIC_RELAXED, __HIP_MEMORY_SCOPE_AGENT); tab[1 + e] = st; const int t = (c + 255) >> 8; for (int i = 0; i < t; ++i) tab[16 + nt + i] = e; nt += t; st += t * 256; }
        tab[0] = nt; }
    __syncthreads();
}
__device__ void phase_moe_scatter(const Frame& F, const unsigned* ectl) {
    unsigned char* ws = F.ws; const LAS int* tab = (const LAS int*)(F.lds + LDS_TAB);
    const int* tok_e = (const int*)(ws + WS_TOK); const int* tok_slot = tok_e + 2 * MTOK; const float* tok_w = (const float*)(tok_slot + 2 * MTOK);
    int* row_tok = (int*)(tok_w + 2 * MTOK); float* row_w = (float*)(row_tok + MAXROWS);
    const bf16_t* hn = (const bf16_t*)(ws + WS_HN); bf16_t* hs = (bf16_t*)(ws + WS_HS);
    for (int m = F.gw; m < MTOK; m += F.ngw) {
        const u32x4 a = *(const u32x4*)(hn + (size_t)m * DM + F.lane * 8), b = *(const u32x4*)(hn + (size_t)m * DM + 512 + F.lane * 8);
#pragma unroll
        for (int sl = 0; sl < 2; ++sl) { const int e = tok_e[2 * m + sl]; const int dest = tab[1 + e] + tok_slot[2 * m + sl];
            *(u32x4*)(hs + (size_t)dest * DM + F.lane * 8) = a; *(u32x4*)(hs + (size_t)dest * DM + 512 + F.lane * 8) = b;
            if (F.lane == 0) { row_tok[dest] = m; row_w[dest] = tok_w[2 * m + sl]; } }
    }
    const int gt = F.blk * NTHR + F.tid;
    if (gt < 2048) { const int e = gt >> 8; const int c = (int)__hip_atomic_load(&ectl[e], __ATOMIC_RELAXED, __HIP_MEMORY_SCOPE_AGENT); const int r = c + (gt & 255);
        if (r < ((c + 255) & ~255)) { row_tok[tab[1 + e] + r] = -1; row_w[tab[1 + e] + r] = 0.f; } }
}

extern __shared__ __attribute__((aligned(16))) unsigned char lds_raw[];
template <class T> __device__ __forceinline__ T* uni(T* p) { const unsigned long long v = (unsigned long long)p; const unsigned lo = __builtin_amdgcn_readfirstlane((unsigned)v), hi = __builtin_amdgcn_readfirstlane((unsigned)(v >> 32)); return (T*)(((unsigned long long)hi << 32) | lo); }
__device__ __forceinline__ int uni(int v) { return __builtin_amdgcn_readfirstlane(v); }
__device__ __forceinline__ Frame mkframe(unsigned char* ws) {
    Frame F; F.lds = (LAS unsigned char*)lds_raw; int tid = threadIdx.x; asm volatile("" : "+v"(tid)); F.tid = tid; F.lane = F.tid & 63; F.wave = __builtin_amdgcn_readfirstlane(F.tid >> 6);
    int blk = blockIdx.x; asm volatile("" : "+s"(blk)); F.blk = blk; F.G = gridDim.x; F.vcu = (F.blk & 7) * (F.G >> 3) + (F.blk >> 3); F.gw = F.blk * NWAVES + F.wave; F.ngw = F.G * NWAVES; F.ws = ws; return F;
}
#define PHASE __device__ __forceinline__ void
PHASE f_moe_convert(unsigned char* ws_, const float* mg, const float* mu, const float* md) {
    unsigned char* ws = uni(ws_); const Frame F = mkframe(ws); Params P; P.in[I_MG] = uni(mg); P.in[I_MU2] = uni(mu); P.in[I_MD] = uni(md); phase_moe_convert(F, P);
}
PHASE f_rms(unsigned char* ws_, const float* src, const float* gain) { unsigned char* ws = uni(ws_); const Frame F = mkframe(ws); phase_rms<false>(F, uni(src), uni(gain), (bf16_t*)(ws + WS_HN), nullptr, nullptr, nullptr, nullptr, nullptr); }
PHASE f_rms_moe(unsigned char* ws_, const float* src, const float* gain, const float* router) {
    unsigned char* ws = uni(ws_); const Frame F = mkframe(ws); int* tok_e = (int*)(ws + WS_TOK); int* tok_slot = tok_e + 2 * MTOK; float* tok_w = (float*)(tok_slot + 2 * MTOK);
    phase_rms<true>(F, uni(src), uni(gain), (bf16_t*)(ws + WS_HN), uni(router), (unsigned*)(ws + WS_CTL) + CW_ECNT, tok_e, tok_slot, tok_w);
}
PHASE f_prep(unsigned char* ws_, const float* mu, const float* qnorm, const float* kvnorm, int layer_) {
    unsigned char* ws = uni(ws_); const Frame F = mkframe(ws); Params P; P.in[I_MU] = uni(mu); P.in[I_QNORM] = uni(qnorm); P.in[I_KVNORM] = uni(kvnorm); (void)layer_; phase_prep(F, P, 0);
}
PHASE f_ret_scan(unsigned char* ws_) { unsigned char* ws = uni(ws_); const Frame F = mkframe(ws); ret_scan(F); }
PHASE f_ret_out(unsigned char* ws_) { unsigned char* ws = uni(ws_); const Frame F = mkframe(ws); ret_out(F); }
PHASE f_rwkv_seq(unsigned char* ws_, const float* mu, const float* kk, const float* ka, const float* rk, const float* lnx, int layer_) {
    unsigned char* ws = uni(ws_); const Frame F = mkframe(ws); Params P; P.in[I_MU] = uni(mu); P.in[I_KK] = uni(kk); P.in[I_KA] = uni(ka); P.in[I_RK] = uni(rk); P.in[I_LNX] = uni(lnx);
    (void)layer_; rwkv_seq(F, P, 0, F.blk >> 3, F.blk & 7);
}
PHASE f_attn(unsigned char* ws_) { unsigned char* ws = uni(ws_); const Frame F = mkframe(ws); const int bh = F.vcu >> 4, pr = F.vcu & 15; attn_unit(F, bh >> 3, bh & 7, 31 - pr); attn_unit(F, bh >> 3, bh & 7, pr); }
PHASE f_moe_scatter(unsigned char* ws_) { unsigned char* ws = uni(ws_); const Frame F = mkframe(ws); moe_table(F, (unsigned*)(ws + WS_CTL) + CW_ECNT); phase_moe_scatter(F, (unsigned*)(ws + WS_CTL) + CW_ECNT); }
PHASE f_final(unsigned char* ws_, float* h, const float* gain) { unsigned char* ws = uni(ws_); const Frame F = mkframe(ws); phase_final(F, uni(h), uni(gain)); }
PHASE g_inproj(unsigned char* ws_, int layer_) {
    unsigned char* ws = uni(ws_); const int layer = uni(layer_); const Frame F = mkframe(ws);
    SchedGrid S; S.init(64, 18, F.G, F.blk, ws + WS_HN, (size_t)256 * DM * 2, (bf16_t*)(ws + WS_WIN) + (size_t)layer * WIN_ROWS * DM, (size_t)256 * DM * 2);
    EpiStore E; E.O = (bf16_t*)(ws + WS_P); E.ld = PW; pg8::gemm_phase(F.lds, DM, DM, DM, S, E);
}
PHASE g_lora(unsigned char* ws_, const float* w0, const float* a0, int layer_) {
    unsigned char* ws = uni(ws_); const int layer = uni(layer_); const Frame F = mkframe(ws);
    SchedGrid S; S.init(64, 6, F.G, F.blk, ws + WS_LIN, (size_t)256 * LORA_K * 2, (bf16_t*)(ws + WS_LORA) + (size_t)layer * 1536 * LORA_K, (size_t)256 * LORA_K * 2);
    EpiLora E; E.O = (bf16_t*)(ws + WS_LO); E.w0 = uni(w0); E.a0 = uni(a0); pg8::gemm_phase(F.lds, LORA_K, LORA_K, LORA_K, S, E);
}
PHASE g_small(unsigned char* ws_, int layer_) {
    unsigned char* ws = uni(ws_); const Frame F = mkframe(ws); SchedSmall S; S.G = F.G; S.c = F.blk; S.layer = uni(layer_); S.ws = (const char*)ws; EpiSmall E; E.ws = ws; pg8::gemm_phase(F.lds, 256, 256, 256, S, E);
}
PHASE g_gate(unsigned char* ws_, int layer_) {
    unsigned char* ws = uni(ws_); const int layer = uni(layer_); const Frame F = mkframe(ws);
    SchedOwn3 S; S.c = F.blk; S.G = F.G; S.A = (const char*)(ws + WS_HN); S.a_n = 0; S.astep = (size_t)256 * DM * 2; S.B = (const char*)((bf16_t*)(ws + WS_WIN) + ((size_t)layer * WIN_ROWS + PW) * DM); S.bstep = (size_t)256 * DM * 2; S.b_n = (size_t)1024 * DM * 2;
    EpiGate E; E.O = (bf16_t*)(ws + WS_G); pg8::gemm_phase(F.lds, DM, DM, DM, S, E);
}
PHASE g_merge(unsigned char* ws_, int layer_) {
    unsigned char* ws = uni(ws_); const int layer = uni(layer_); const Frame F = mkframe(ws);
    SchedOwn3 S; S.c = F.blk; S.G = F.G; S.A = (const char*)(ws + WS_YRET); S.a_n = (size_t)16 * MiB; S.astep = (size_t)256 * 512 * 2;
    S.B = (const char*)((bf16_t*)(ws + WS_BR) + (size_t)layer * 3 * 1024 * 512); S.bstep = (size_t)256 * 512 * 2; S.b_n = (size_t)1024 * 512 * 2;
    EpiMerge E; E.Gt = (const bf16_t*)(ws + WS_G); E.Mg = (bf16_t*)(ws + WS_MRG); pg8::gemm_phase(F.lds, 512, 512, 512, S, E);
}
PHASE g_wo(unsigned char* ws_, const float* hin, float* hout, int layer_) {
    unsigned char* ws = uni(ws_); const int layer = uni(layer_); const Frame F = mkframe(ws);
    SchedGrid S; S.init(64, 4, F.G, F.blk, ws + WS_MRG, (size_t)256 * DM * 2, (bf16_t*)(ws + WS_WO) + (size_t)layer * DM * DM, (size_t)256 * DM * 2);
    EpiResid E; E.In = uni(hin); E.Out = uni(hout); pg8::gemm_phase(F.lds, DM, DM, DM, S, E);
}
PHASE g_ffn_gu(unsigned char* ws_) {
    unsigned char* ws = uni(ws_); const Frame F = mkframe(ws);
    SchedGrid S; S.init(64, 22, F.G, F.blk, ws + WS_HN, (size_t)256 * DM * 2, ws + WS_FGU, (size_t)256 * DM * 2);
    EpiSwiglu E; E.O = (bf16_t*)(ws + WS_ACT); E.ldc = DFF; E.pn_off = 0; pg8::gemm_phase(F.lds, DM, DM, DM, S, E);
}
PHASE g_ffn_down(unsigned char* ws_, float* h) {
    unsigned char* ws = uni(ws_); const Frame F = mkframe(ws);
    SchedGrid S; S.init(64, 4, F.G, F.blk, ws + WS_ACT, (size_t)256 * DFF * 2, ws + WS_FD, (size_t)256 * DFF * 2);
    EpiResid E; E.In = uni(h); E.Out = E.In ? (float*)E.In : nullptr; pg8::gemm_phase(F.lds, DFF, DFF, DFF, S, E);
}
PHASE g_moe_gu(unsigned char* ws_, int hh_) {
    unsigned char* ws = uni(ws_); const int hh = uni(hh_); const Frame F = mkframe(ws); const LAS int* tab = (const LAS int*)(F.lds + LDS_TAB);
    SchedMoe S; S.G = F.G; S.c = F.blk; S.ncol = 14; S.ntile = tab[0]; S.tab = tab + 16; S.A = (const char*)(ws + WS_HS); S.astep = (size_t)256 * DM * 2;
    S.B = (const char*)(ws + WS_MGU) + (size_t)hh * 14 * 256 * DM * 2; S.bstep = (size_t)256 * DM * 2; S.estep = (size_t)2 * DFFE * DM * 2;
    EpiSwiglu E; E.O = (bf16_t*)(ws + WS_MACT); E.ldc = DFFH; E.pn_off = 0; pg8::gemm_phase(F.lds, DM, DM, DM, S, E);
}
PHASE g_moe_down(unsigned char* ws_, float* h, int hh_) {
    unsigned char* ws = uni(ws_); const int hh = uni(hh_); const Frame F = mkframe(ws); const LAS int* tab = (const LAS int*)(F.lds + LDS_TAB);
    const int* row_tok = (const int*)(ws + WS_TOK) + 6 * MTOK; const float* row_w = (const float*)(row_tok + MAXROWS);
    SchedMoe S; S.G = F.G; S.c = F.blk; S.ncol = 4; S.ntile = tab[0]; S.tab = tab + 16; S.A = (const char*)(ws + WS_MACT); S.astep = (size_t)256 * DFFH * 2;
    S.B = (const char*)(ws + WS_MD) + (size_t)hh * DFFH * 2; S.bstep = (size_t)256 * DFFE * 2; S.estep = (size_t)DM * DFFE * 2;
    EpiMoeDown E; E.row_tok = row_tok; E.row_w = row_w; E.H = uni(h); pg8::gemm_phase(F.lds, DFFH, DFFH, DFFE, S, E);
}

typedef const __attribute__((address_space(4))) Params* KPtr;
__device__ __forceinline__ KPtr kargs() { KPtr k = (KPtr)__builtin_amdgcn_kernarg_segment_ptr(); asm volatile("" : "+s"(k)); return k; }
#define KIN(i) (kargs()->in[i])
#define KWS() (kargs()->ws)
__global__ void __launch_bounds__(NTHR, 2) mega(Params P_unused) {
    LAS unsigned char* lds = (LAS unsigned char*)lds_raw;
    for (int u = threadIdx.x; u < (LDS_BYTES - LDSCTL_OFF) / 4; u += NTHR) ((LAS unsigned*)(lds + LDSCTL_OFF))[u] = 0u;
    __syncthreads();
    const XcdBarrier bar = xcd_barrier_post((unsigned*)(KWS() + WS_CTL) + CW_BAR, (volatile LAS unsigned*)(lds + LDSCTL_OFF));
#define GRID_BAR() xcd_barrier(bar)
    {
        KPtr k = kargs(); unsigned char* ws = k->ws; const Frame F = mkframe(ws);
        Params P; P.in[I_WIN] = k->in[I_WIN]; P.in[I_WQB] = k->in[I_WQB]; P.in[I_WBR] = k->in[I_WBR]; P.in[I_WO] = k->in[I_WO]; P.in[I_FG] = k->in[I_FG]; P.in[I_FU] = k->in[I_FU]; P.in[I_FD] = k->in[I_FD];
        P.in[I_W2] = k->in[I_W2]; P.in[I_A2] = k->in[I_A2]; P.in[I_G2] = k->in[I_G2]; P.in[I_WKVB] = k->in[I_WKVB]; P.in[I_POS] = k->in[I_POS];
        phase_prologue(F, P);
    }
    GRID_BAR();
#pragma unroll
    for (int layer = 0; layer < NLAYER; ++layer) {
        f_rms(KWS(), layer == 0 ? KIN(I_X) : (const float*)kargs()->out, KIN(I_ANORM) + layer * DM);
        GRID_BAR();
        g_inproj(KWS(), layer);
        GRID_BAR();
        f_prep(KWS(), KIN(I_MU) + (size_t)layer * RWKV_COLS, KIN(I_QNORM) + layer * 256, KIN(I_KVNORM) + layer * 128, layer);
        GRID_BAR();
        f_ret_scan(KWS());
        g_lora(KWS(), KIN(I_W0) + layer * 512, KIN(I_A0) + layer * 512, layer);
        g_small(KWS(), layer);
        GRID_BAR();
        f_ret_out(KWS());
        GRID_BAR();
        if (blockIdx.x < 16) f_rwkv_seq(KWS(), KIN(I_MU) + (size_t)layer * RWKV_COLS, KIN(I_KK) + layer * 512, KIN(I_KA) + layer * 512, KIN(I_RK) + layer * 512, KIN(I_LNX) + layer * 512, layer);
        f_attn(KWS());
        GRID_BAR();
        g_gate(KWS(), layer);
        g_merge(KWS(), layer);
        GRID_BAR();
        g_wo(KWS(), layer == 0 ? KIN(I_X) : (const float*)kargs()->out, kargs()->out, layer);
        GRID_BAR();
        if (layer == 0) {
            f_rms(KWS(), kargs()->out, KIN(I_FNORM) + layer * DM);
            GRID_BAR();
            g_ffn_gu(KWS());
            GRID_BAR();
            g_ffn_down(KWS(), kargs()->out);
            GRID_BAR();
        } else {
            f_rms_moe(KWS(), kargs()->out, KIN(I_FNORM) + layer * DM, KIN(I_ROUTER));
            GRID_BAR();
            f_moe_scatter(KWS());
            f_moe_convert(KWS(), KIN(I_MG), KIN(I_MU2), KIN(I_MD));
            GRID_BAR();
#pragma unroll
            for (int hh = 0; hh < 2; ++hh) {
                g_moe_gu(KWS(), hh);
                GRID_BAR();
                g_moe_down(KWS(), kargs()->out, hh);
                GRID_BAR();
            }
        }
    }
    f_final(KWS(), kargs()->out, KIN(I_FINAL));
}

extern "C" void kernel_launch(void* const* d_in, const int* in_sizes, int n_in, void* d_out, int out_size, void* d_ws, size_t ws_size, hipStream_t stream) {
    static int ready = 0;
    if (!ready) {
        if (n_in != 29 || out_size != MTOK * DM || ws_size < WS_END) { fprintf(stderr, "kernel_launch: unexpected shapes (n_in %d out %d ws %zu need %zu)\n", n_in, out_size, ws_size, (size_t)WS_END); ready = -1; return; }
        if (hipFuncSetAttribute((const void*)mega, hipFuncAttributeMaxDynamicSharedMemorySize, LDS_BYTES) != hipSuccess) { fprintf(stderr, "kernel_launch: hipFuncSetAttribute failed\n"); ready = -1; return; }
        int dev = 0, cus = 0, per_cu = 0; (void)hipGetDevice(&dev); (void)hipDeviceGetAttribute(&cus, hipDeviceAttributeMultiprocessorCount, dev);
        (void)hipOccupancyMaxActiveBlocksPerMultiprocessor(&per_cu, (const void*)mega, NTHR, LDS_BYTES);
        if (cus < 256 || per_cu < 1) { fprintf(stderr, "kernel_launch: needs 256 CUs with one resident workgroup each (cus %d, per_cu %d)\n", cus, per_cu); ready = -1; return; }
        ready = 1;
    }
    if (ready < 0) return;
    (void)hipMemsetAsync((char*)d_ws + WS_CTL, 0, CTL_BYTES, stream);
    Params p{}; for (int i = 0; i < 29; ++i) p.in[i] = (const float*)d_in[i]; p.out = (float*)d_out; p.ws = (unsigned char*)d_ws;
    hipLaunchKernelGGL(mega, dim3(256), dim3(NTHR), LDS_BYTES, stream, p);
}
```

```cpp
#include <hip/hip_runtime.h>
#include <cstdio>
#include <cstdint>

#define LAS __attribute__((address_space(3)))
#define GAS __attribute__((address_space(1)))
typedef unsigned short bf16_t;
typedef short bf16x8 __attribute__((ext_vector_type(8)));
typedef short bf16x4 __attribute__((ext_vector_type(4)));
typedef float f32x4 __attribute__((ext_vector_type(4)));
typedef float f32x2 __attribute__((ext_vector_type(2)));
typedef float f32x16 __attribute__((ext_vector_type(16)));
typedef unsigned u32x4 __attribute__((ext_vector_type(4)));
typedef unsigned u32x2 __attribute__((ext_vector_type(2)));

constexpr int NB = 2, SEQ = 8192, DM = 1024, MTOK = NB * SEQ, NLAYER = 2, CH = 64, NCHUNK = SEQ / CH;
constexpr int IN_COLS = 7360, PW = 4608;
constexpr int P_RQ = 0, P_RK = 512, P_RV = 1024, P_RG = 1536, P_RW = 2048, P_QA = 4096, P_KVA = 4352;
constexpr int WIN_ROWS = 7680;
constexpr int RWKV_COLS = 1824, LORA_K = 384, LO_W = 1536;
constexpr int DFF = 2816, DFFE = 3584, NEXP = 8, DFFH = DFFE / 2;
constexpr int MAXROWS = 34816;
constexpr float NORM_EPS = 1e-6f;

constexpr size_t MiB = 1u << 20;
constexpr size_t WS_CTL = 0, CTL_BYTES = 1 * MiB;
constexpr size_t WS_WIN = 1 * MiB;
constexpr size_t WS_LORA = 31 * MiB;
constexpr size_t WS_QB = 34 * MiB;
constexpr size_t WS_KB = 35 * MiB;
constexpr size_t WS_VB = 35 * MiB + 512 * 1024;
constexpr size_t WS_BR = 36 * MiB;
constexpr size_t WS_WO = 42 * MiB;
constexpr size_t WS_FGU = 46 * MiB;
constexpr size_t WS_FD = 57 * MiB;
constexpr size_t WS_COSR = 63 * MiB, WS_SINR = 67 * MiB, WS_COSM = 71 * MiB, WS_SINM = 72 * MiB;
constexpr size_t WS_HN = 73 * MiB;
constexpr size_t WS_TOK = 105 * MiB;
constexpr size_t WS_T = 106 * MiB;
constexpr size_t WS_P = WS_T;
constexpr size_t WS_G = WS_T;
constexpr size_t WS_MRG = WS_T + 96 * MiB;
constexpr size_t WS_LO = WS_T + 144 * MiB;
constexpr size_t WS_Q = WS_T + 192 * MiB;
constexpr size_t WS_KN = WS_T + 216 * MiB;
constexpr size_t WS_VT = WS_T + 232 * MiB;
constexpr size_t WS_KPE = WS_T + 248 * MiB;
constexpr size_t WS_LIN = WS_T + 249 * MiB;
constexpr size_t WS_QN = WS_T + 261 * MiB;
constexpr size_t WS_CN = WS_T + 269 * MiB;
constexpr size_t WS_YRET = WS_T + 261 * MiB;
constexpr size_t WS_RS = WS_T + 277 * MiB;
constexpr size_t WS_YRW = WS_T + 277 * MiB;
constexpr size_t WS_YMLA = WS_T + 293 * MiB;
constexpr size_t WS_RC = WS_T + 309 * MiB;
constexpr size_t WS_ACT = WS_T;
constexpr size_t WS_MGU = WS_T;
constexpr size_t WS_MD = WS_T + 112 * MiB;
constexpr size_t WS_HS = WS_T + 168 * MiB;
constexpr size_t WS_MACT = WS_T + 236 * MiB;
constexpr size_t WS_END = WS_T + 374 * MiB;
static_assert(WS_MACT + (size_t)MAXROWS * DFFH * 2 <= WS_END, "ws map");
constexpr int CW_BAR = 4096;
constexpr int CW_ECNT = 16384;

__device__ __forceinline__ unsigned f2bf(float f) { unsigned u = __builtin_bit_cast(unsigned, f); return (u + 0x7fffu + ((u >> 16) & 1u)) >> 16; }
__device__ __forceinline__ unsigned pk2(float lo, float hi) { return f2bf(lo) | (f2bf(hi) << 16); }
__device__ __forceinline__ float bf2f(unsigned short h) { return __builtin_bit_cast(float, (unsigned)h << 16); }
__device__ __forceinline__ float bflo(unsigned w) { return __builtin_bit_cast(float, w << 16); }
__device__ __forceinline__ float bfhi(unsigned w) { return __builtin_bit_cast(float, w & 0xffff0000u); }
__device__ __forceinline__ float wave_sum(float v) {
#pragma unroll
    for (int o = 1; o < 64; o <<= 1) v += __shfl_xor(v, o);
    return v;
}
__device__ __forceinline__ float sigmoidf_(float x) { return 1.0f / (1.0f + __expf(-x)); }
#define LDS_WAIT() asm volatile("s_waitcnt lgkmcnt(0)" ::: "memory")
#define VM_WAIT() asm volatile("s_waitcnt vmcnt(0)" ::: "memory")

#define XB_TMO      128
#define XB_XCNT(j)  (256  + 64 * (j))
#define XB_XSUB(j)  (1280 + 64 * (j))
#define XB_XGEN(j)  (2304 + 64 * (j))
#define XB_TOP      3328
#define XB_TOPGEN   3392
#define XCD_BAR_WORDS 3456
#define XB_SPIN_CAP (1u << 18)
__device__ __forceinline__ unsigned xb_ld(unsigned* p)              { return __hip_atomic_load(p, __ATOMIC_RELAXED, __HIP_MEMORY_SCOPE_AGENT); }
__device__ __forceinline__ unsigned xb_add(unsigned* p, unsigned v) { return __hip_atomic_fetch_add(p, v, __ATOMIC_RELAXED, __HIP_MEMORY_SCOPE_AGENT); }
__device__ __forceinline__ unsigned xb_xcc_id() { return (unsigned)__builtin_amdgcn_s_getreg((3 << 11) | 20) & 0xFu; }
#define XB_SPIN(cond, bar) do { unsigned _sp = 0; while (cond) { __builtin_amdgcn_s_sleep(1); \
    if ((++_sp & 255u) == 0u) { if (xb_ld(&(bar)[XB_TMO])) break; if (_sp > XB_SPIN_CAP) { atomicAdd(&(bar)[XB_TMO], 1u); break; } } } } while (0)
struct XcdBarrier { unsigned* bar; unsigned x; volatile LAS unsigned* st; int wv; };
__device__ __forceinline__ bool xb_thread0(int wv) { return wv == 0 && __builtin_amdgcn_mbcnt_hi(~0u, __builtin_amdgcn_mbcnt_lo(~0u, 0u)) == 0u; }
__device__ __forceinline__ XcdBarrier xcd_barrier_post(unsigned* bar, volatile LAS unsigned* st, int wv) {
    XcdBarrier b; b.bar = bar; b.x = xb_xcc_id(); b.st = st; b.wv = wv;
    if (xb_thread0(wv)) (void)xb_add(&bar[XB_XCNT(b.x)], 1u);
    return b;
}
__device__ __forceinline__ void xcd_barrier_complete(unsigned* bar, unsigned x, unsigned& nloc, unsigned& nx) {
    const unsigned G = gridDim.x * gridDim.y * gridDim.z;
    unsigned sum, cnt, mine, sp = 0u;
    for (;;) {
        sum = 0u; cnt = 0u; mine = 0u;
#pragma unroll
        for (unsigned j = 0; j < 16; ++j) { const unsigned c = xb_ld(&bar[XB_XCNT(j)]); sum += c; cnt += (c > 0u) ? 1u : 0u; mine = (j == x) ? c : mine; }
        if (sum == G) break;
        __builtin_amdgcn_s_sleep(1);
        if ((++sp & 255u) == 0u) { if (xb_ld(&bar[XB_TMO])) break; if (sp > XB_SPIN_CAP) { atomicAdd(&bar[XB_TMO], 1u); break; } }
    }
    nloc = mine > 0u ? mine : 1u; nx = cnt > 0u ? cnt : 1u;
}
__device__ __forceinline__ void xcd_barrier(const XcdBarrier& b) {
    asm volatile("s_waitcnt vmcnt(0)" ::: "memory");
    __syncthreads();
    if (xb_thread0(b.wv)) {
        unsigned* bar = b.bar;
        __builtin_amdgcn_s_waitcnt(0);
        unsigned nloc = b.st[0], nx = b.st[1];
        if (nloc == 0u) { xcd_barrier_complete(bar, b.x, nloc, nx); b.st[0] = nloc; b.st[1] = nx; }
        const unsigned old = xb_add(&bar[XB_XSUB(b.x)], 1u);
        const unsigned gen = old / nloc;
        if (old + 1u == (gen + 1u) * nloc) {
            __builtin_amdgcn_fence(__ATOMIC_RELEASE, "agent");
            asm volatile("s_waitcnt vmcnt(0)" ::: "memory");
            const unsigned og = xb_add(&bar[XB_TOP], 1u);
            const unsigned tg = og / nx;
            if (og + 1u == (tg + 1u) * nx) xb_add(&bar[XB_TOPGEN], 1u);
            else XB_SPIN(xb_ld(&bar[XB_TOPGEN]) == tg, bar);
            __builtin_amdgcn_fence(__ATOMIC_ACQUIRE, "agent");
            xb_add(&bar[XB_XGEN(b.x)], 1u);
            asm volatile("s_waitcnt vmcnt(0)" ::: "memory");
        } else {
            XB_SPIN(xb_ld(&bar[XB_XGEN(b.x)]) == gen, bar);
            __builtin_amdgcn_fence(__ATOMIC_ACQUIRE, "agent");
            asm volatile("s_waitcnt vmcnt(0)" ::: "memory");
        }
    }
    __syncthreads();
}

namespace pg8 {
constexpr int BM = 256, BK = 64, HALF = 128, HTB = HALF * BK * 2, STAGE_BYTES = 8 * HTB;
__device__ __forceinline__ int lds_byte(int r, int c) { const int st = (r >> 4) * 2 + (c >> 5), rr = r & 15, cc = c & 31, ob = rr * 64 + cc * 2; return st * 1024 + (ob ^ (((ob >> 9) & 1) << 5)); }
__device__ __forceinline__ void stage_rc(int b, int& R, int& C) { const int st = b / 1024, sb = b % 1024, swz = sb ^ (((sb >> 9) & 1) << 5); R = (st >> 1) * 16 + swz / 64; C = (st & 1) * 32 + (swz % 64) / 2; }
__device__ __forceinline__ int perm32(int rho) { const int n = rho >> 4, i = rho & 15; return 8 * (i >> 2) + 4 * n + (i & 3); }
struct Unit { int pm, pn, aux; const char* A; const char* B; };
__device__ __forceinline__ unsigned cvt_pk_bf16(float lo, float hi) { unsigned r; asm volatile("v_cvt_pk_bf16_f32 %0, %1, %2" : "=v"(r) : "v"(lo), "v"(hi)); return r; }

template <class Epi, class Sched>
__device__ __forceinline__ void gemm_phase(LAS unsigned char* lds, const int tid_in, const int K, const int lda, const int ldb, const Sched& S, const Epi& E) {
    int tid_ = tid_in; asm volatile("" : "+v"(tid_));
    const int tid = tid_, wid = __builtin_amdgcn_readfirstlane(tid >> 6), lane = tid & 63, wr = wid >> 2, wc = wid & 3, fr = lane & 15, fq = lane >> 4;
    const int nt = K / BK;
    unsigned voffA[2], voffB[2];
#pragma unroll
    for (int i = 0; i < 2; ++i) { int R, C; stage_rc(tid * 16 + i * 8192, R, C); const int Rb = Epi::PERM ? ((R & ~31) + perm32(R & 31)) : R;
        voffA[i] = (unsigned)(R * lda + C) * 2u; voffB[i] = (unsigned)(Rb * ldb + C) * 2u; }
    const size_t kstep = (size_t)(BK * 2);
    const size_t hstepA = (size_t)HALF * lda * 2, hstepB = (size_t)HALF * ldb * 2;
    const unsigned ldsw = (unsigned)wid * 1024u;
    const int aoff = lds_byte(wr * 64 + fr, fq * 8), boff = lds_byte(wc * 32 + fr, fq * 8);
#define PG8_SA(b, h) (((b) * 2 + (h)) * HTB)
#define PG8_SB(b, h) ((4 + (b) * 2 + (h)) * HTB)
#define PG8_STAGE(bufoff, gbase, voff) do { _Pragma("unroll") for (int _i = 0; _i < 2; ++_i) \
        __builtin_amdgcn_global_load_lds((const unsigned*)((const char*)(gbase) + (voff)[_i]), (LAS unsigned*)(lds + (bufoff) + ldsw + _i * 8192), 16, 0, 0); } while (0)
#define PG8_LDA(dst, b, h) do { _Pragma("unroll") for (int m = 0; m < 4; ++m) _Pragma("unroll") for (int k = 0; k < 2; ++k) dst[m][k] = *(const LAS bf16x8*)(lds + PG8_SA(b, h) + aoff + m * 2048 + k * 1024); } while (0)
#define PG8_LDB(dst, b, h) do { _Pragma("unroll") for (int n = 0; n < 2; ++n) _Pragma("unroll") for (int k = 0; k < 2; ++k) dst[n][k] = *(const LAS bf16x8*)(lds + PG8_SB(b, h) + boff + n * 2048 + k * 1024); } while (0)
#define PG8_MMA(ai, bj, At, Bt) do { __builtin_amdgcn_s_setprio(1); _Pragma("unroll") for (int m = 0; m < 4; ++m) _Pragma("unroll") for (int n = 0; n < 2; ++n) _Pragma("unroll") for (int k = 0; k < 2; ++k) \
        acc[ai][bj][m][n] = __builtin_amdgcn_mfma_f32_16x16x32_bf16(Bt[n][k], At[m][k], acc[ai][bj][m][n], 0, 0, 0); __builtin_amdgcn_s_setprio(0); } while (0)
#define PG8_WAIT_V(n) asm volatile("s_waitcnt vmcnt(" #n ")" ::: "memory")
#define PG8_WAIT_L(n) asm volatile("s_waitcnt lgkmcnt(" #n ")" ::: "memory")
#define PG8_BAR __builtin_amdgcn_s_barrier()
#define PG8_SCHED __builtin_amdgcn_sched_barrier(0)
    Unit cur, nxt; int ui = 0;
    if (!S.next(0, cur)) return;
    f32x4 acc[2][2][4][2];
#pragma unroll
    for (int a = 0; a < 2; ++a)
#pragma unroll
        for (int b = 0; b < 2; ++b)
#pragma unroll
            for (int m = 0; m < 4; ++m)
#pragma unroll
                for (int n = 0; n < 2; ++n) acc[a][b][m][n] = (f32x4){0.f, 0.f, 0.f, 0.f};
    bf16x8 At[4][2], B0[2][2], B1[2][2];
    const char* cA = cur.A; const char* cB = cur.B;
    PG8_STAGE(PG8_SB(0, 0), cB, voffB); PG8_STAGE(PG8_SB(0, 1), cB + hstepB, voffB); PG8_STAGE(PG8_SA(0, 0), cA, voffA); PG8_STAGE(PG8_SA(0, 1), cA + hstepA, voffA);
    if (wr == 1) PG8_BAR;
    PG8_WAIT_V(2); PG8_BAR;
    PG8_STAGE(PG8_SB(1, 0), cB + kstep, voffB); PG8_STAGE(PG8_SA(1, 0), cA + kstep, voffA); PG8_STAGE(PG8_SB(1, 1), cB + hstepB + kstep, voffB);
    PG8_WAIT_V(6); PG8_BAR;
#pragma unroll 1
    for (;;) {
        const bool has_next = S.next(ui + 1, nxt);
        const char* nA = has_next ? nxt.A : cA; const char* nB = has_next ? nxt.B : cB;
#pragma unroll 1
        for (int t = 0; t < nt; t += 2) {
            const bool last = (t == nt - 2);
            const char* a1 = cA + (size_t)(t + 1) * kstep;
            const char* a2 = last ? nA : cA + (size_t)(t + 2) * kstep; const char* b2 = last ? nB : cB + (size_t)(t + 2) * kstep;
            const char* a3 = a2 + kstep; const char* b3 = b2 + kstep;
            PG8_LDB(B0, 0, 0); PG8_LDB(B1, 0, 1); PG8_SCHED; PG8_LDA(At, 0, 0); PG8_STAGE(PG8_SA(1, 1), a1 + hstepA, voffA);
            PG8_WAIT_V(8); PG8_WAIT_L(0); PG8_BAR; PG8_MMA(0, 0, At, B0); PG8_MMA(0, 1, At, B1); PG8_BAR; PG8_SCHED;
            PG8_LDA(At, 0, 1); PG8_STAGE(PG8_SB(0, 0), b2, voffB); PG8_STAGE(PG8_SB(0, 1), b2 + hstepB, voffB); PG8_STAGE(PG8_SA(0, 0), a2, voffA);
            PG8_WAIT_V(8); PG8_WAIT_L(0); PG8_BAR; PG8_MMA(1, 0, At, B0); PG8_MMA(1, 1, At, B1); PG8_BAR; PG8_SCHED;
            PG8_LDB(B0, 1, 0); PG8_LDB(B1, 1, 1); PG8_SCHED; PG8_LDA(At, 1, 0); PG8_STAGE(PG8_SA(0, 1), a2 + hstepA, voffA);
            PG8_WAIT_V(8); PG8_WAIT_L(0); PG8_BAR; PG8_MMA(0, 0, At, B0); PG8_MMA(0, 1, At, B1); PG8_BAR; PG8_SCHED;
            PG8_LDA(At, 1, 1); PG8_STAGE(PG8_SB(1, 0), b3, voffB); PG8_STAGE(PG8_SB(1, 1), b3 + hstepB, voffB); PG8_STAGE(PG8_SA(1, 0), a3, voffA);
            PG8_WAIT_V(8); PG8_WAIT_L(0); PG8_BAR; PG8_MMA(1, 0, At, B0); PG8_MMA(1, 1, At, B1); PG8_BAR; PG8_SCHED;
        }
        if (wr == 0) PG8_BAR;
        E(acc, cur, wr, wc, fr, fq);
        if (!has_next) break;
#pragma unroll
        for (int a = 0; a < 2; ++a)
#pragma unroll
            for (int b = 0; b < 2; ++b)
#pragma unroll
                for (int m = 0; m < 4; ++m)
#pragma unroll
                    for (int n = 0; n < 2; ++n) acc[a][b][m][n] = (f32x4){0.f, 0.f, 0.f, 0.f};
        cur = nxt; cA = nA; cB = nB; ++ui;
        if (wr == 1) PG8_BAR;
    }
    PG8_WAIT_V(0);
    PG8_BAR;
#undef PG8_SA
#undef PG8_SB
#undef PG8_STAGE
#undef PG8_LDA
#undef PG8_LDB
#undef PG8_MMA
#undef PG8_WAIT_V
#undef PG8_WAIT_L
#undef PG8_BAR
#undef PG8_SCHED
}
}
constexpr int NWAVES = 8, NTHR = 512;
constexpr int RING_BYTES = 131072, LDSCTL_OFF = RING_BYTES, LDS_BYTES = 147456;
struct Params { const float* in[29]; float* out; unsigned char* ws; };
struct Frame {
    LAS unsigned char* lds; int tid, lane, wave, blk, G, vcu, gw, ngw; unsigned char* ws;
};
enum { I_X = 0, I_POS, I_ANORM, I_WIN, I_MU, I_W0, I_W2, I_A0, I_A2, I_G2, I_KK, I_KA, I_RK, I_LNX, I_QNORM, I_WQB, I_KVNORM, I_WKVB, I_WBR, I_WO, I_FNORM,
       I_FG, I_FU, I_FD, I_ROUTER, I_MG, I_MU2, I_MD, I_FINAL };

struct SchedGrid {
    int nM, nN, nwg, G, c; const char* A; const char* B; size_t astep, bstep;
    __device__ void init(int nM_, int nN_, int G_, int c_, const void* A_, size_t astep_, const void* B_, size_t bstep_) { nM = nM_; nN = nN_; nwg = nM * nN; G = G_; c = c_; A = (const char*)A_; B = (const char*)B_; astep = astep_; bstep = bstep_; }
    __device__ __forceinline__ bool next(int i, pg8::Unit& u) const {
        const long L = (long)i * G + c; if (L >= nwg) return false;
        int wgid = (int)L; { const int q = nwg / 8, r = nwg % 8, xcd = wgid % 8, off = wgid / 8; wgid = (xcd < r ? xcd * (q + 1) : r * (q + 1) + (xcd - r) * q) + off; }
        const int nig = 8 * nN, gid = wgid / nig, fm = gid * 8, gsz = (nM - fm) < 8 ? (nM - fm) : 8;
        u.pm = fm + ((wgid % nig) % gsz); u.pn = (wgid % nig) / gsz; u.aux = 0;
        u.A = A + (size_t)u.pm * astep; u.B = B + (size_t)u.pn * bstep; return true;
    }
};
struct SchedSmall {
    int G, c, layer; const char* ws;
    __device__ __forceinline__ bool next(int i, pg8::Unit& u) const {
        int L = i * G + c; if (L >= 448) return false;
        int s = 0; if (L >= 192) { L -= 192; s = 1; if (L >= 128) { L -= 128; s = 2; } }
        const int nn = s == 0 ? 3 : (s == 1 ? 2 : 64);
        u.pm = L / nn; u.pn = L % nn; u.aux = s;
        const size_t lw = (size_t)layer * 256 * 2;
        const size_t ao = s == 0 ? WS_QN : (s == 1 ? WS_CN : WS_VB + lw * 512), bo = s == 0 ? WS_QB + lw * 768 : (s == 1 ? WS_KB + lw * 512 : WS_CN);
        u.A = ws + ao + (size_t)u.pm * (256 * 256 * 2); u.B = ws + bo + (size_t)u.pn * (256 * 256 * 2); return true;
    }
};
struct SchedOwn3 {
    int c, G; const char* A; const char* B; size_t astep, bstep, a_n, b_n;
    __device__ __forceinline__ bool next(int i, pg8::Unit& u) const {
        const int t = c + (i / 3) * G; if (t >= 256) return false;
        const int n = i % 3; u.pm = t >> 2; u.pn = t & 3; u.aux = n; u.A = A + (size_t)u.pm * astep + (size_t)n * a_n; u.B = B + (size_t)u.pn * bstep + (size_t)n * b_n; return true;
    }
};
struct SchedMoe {
    int G, c, ncol, ntile; const LAS int* tab; const char* A; const char* B; size_t astep, bstep, estep;
    __device__ __forceinline__ bool next(int i, pg8::Unit& u) const {
        const int L = i * G + c; if (L >= ntile * ncol) return false;
        u.pm = L / ncol; u.pn = L % ncol; const int e = tab[u.pm]; u.aux = e;
        u.A = A + (size_t)u.pm * astep; u.B = B + (size_t)e * estep + (size_t)u.pn * bstep; return true;
    }
};

using pg8::Unit; using pg8::cvt_pk_bf16;
#define EPI_ARGS const f32x4 (&acc)[2][2][4][2], const Unit& u, int wr, int wc, int fr, int fq
struct EpiStore {
    static constexpr bool PERM = true;
    bf16_t* O; int ld;
    __device__ __forceinline__ void operator()(EPI_ARGS) const {
        const int row0 = u.pm * 256 + wr * 64 + fr, col0 = u.pn * 256 + wc * 32 + 8 * fq;
#pragma unroll
        for (int ai = 0; ai < 2; ++ai)
#pragma unroll
            for (int m = 0; m < 4; ++m) { bf16_t* rowp = O + (size_t)(row0 + ai * 128 + m * 16) * ld + col0;
#pragma unroll
                for (int bj = 0; bj < 2; ++bj) { const f32x4 v0 = acc[ai][bj][m][0], v1 = acc[ai][bj][m][1];
                    u32x4 w; w.x = cvt_pk_bf16(v0[0], v0[1]); w.y = cvt_pk_bf16(v0[2], v0[3]); w.z = cvt_pk_bf16(v1[0], v1[1]); w.w = cvt_pk_bf16(v1[2], v1[3]);
                    *(u32x4*)(rowp + bj * 128) = w; } }
    }
};
struct EpiSmall {
    static constexpr bool PERM = true;
    unsigned char* ws;
    __device__ __forceinline__ void operator()(EPI_ARGS) const {
        bf16_t* base = (bf16_t*)(ws + (u.aux == 0 ? WS_Q : (u.aux == 1 ? WS_KN : WS_VT))); const int ld = u.aux == 0 ? 768 : (u.aux == 1 ? 512 : MTOK);
        const int row0 = u.pm * 256 + wr * 64 + fr, col0 = u.pn * 256 + wc * 32 + 8 * fq;
#pragma unroll
        for (int ai = 0; ai < 2; ++ai)
#pragma unroll
            for (int m = 0; m < 4; ++m) { bf16_t* rowp = base + (size_t)(row0 + ai * 128 + m * 16) * ld + col0;
#pragma unroll
                for (int bj = 0; bj < 2; ++bj) { const f32x4 v0 = acc[ai][bj][m][0], v1 = acc[ai][bj][m][1];
                    u32x4 w; w.x = cvt_pk_bf16(v0[0], v0[1]); w.y = cvt_pk_bf16(v0[2], v0[3]); w.z = cvt_pk_bf16(v1[0], v1[1]); w.w = cvt_pk_bf16(v1[2], v1[3]);
                    *(u32x4*)(rowp + bj * 128) = w; } }
    }
};
struct EpiLora {
    static constexpr bool PERM = true;
    bf16_t* O; const float* w0; const float* a0;
    __device__ __forceinline__ void operator()(EPI_ARGS) const {
        const int seg = u.pn >> 1;
        const int row0 = u.pm * 256 + wr * 64 + fr, col0 = u.pn * 256 + wc * 32 + 8 * fq, ch0 = (u.pn & 1) * 256 + wc * 32 + 8 * fq;
        const float* bias = seg == 0 ? w0 : a0; const float sc = seg == 0 ? -0.6065306597126334f : 1.0f;
#pragma unroll
        for (int bj = 0; bj < 2; ++bj) {
            f32x4 b0 = {0.f, 0.f, 0.f, 0.f}, b1 = {0.f, 0.f, 0.f, 0.f};
            if (seg < 2) { b0 = *(const f32x4*)(bias + ch0 + bj * 128); b1 = *(const f32x4*)(bias + ch0 + bj * 128 + 4); }
#pragma unroll
            for (int ai = 0; ai < 2; ++ai)
#pragma unroll
                for (int m = 0; m < 4; ++m) { bf16_t* rowp = O + (size_t)(row0 + ai * 128 + m * 16) * LO_W + col0 + bj * 128;
                    f32x4 v0 = acc[ai][bj][m][0] + b0, v1 = acc[ai][bj][m][1] + b1;
                    if (seg < 2) {
#pragma unroll
                        for (int j = 0; j < 4; ++j) { v0[j] = sc * sigmoidf_(v0[j]); v1[j] = sc * sigmoidf_(v1[j]); }
                    }
                    u32x4 w; w.x = cvt_pk_bf16(v0[0], v0[1]); w.y = cvt_pk_bf16(v0[2], v0[3]); w.z = cvt_pk_bf16(v1[0], v1[1]); w.w = cvt_pk_bf16(v1[2], v1[3]);
                    *(u32x4*)rowp = w; }
        }
    }
};
struct EpiGate {
    static constexpr bool PERM = true;
    bf16_t* O;
    __device__ __forceinline__ void operator()(EPI_ARGS) const {
        const int row0 = u.pm * 256 + wr * 64 + fr, col0 = u.aux * 1024 + u.pn * 256 + wc * 32 + 8 * fq;
#pragma unroll
        for (int ai = 0; ai < 2; ++ai)
#pragma unroll
            for (int m = 0; m < 4; ++m) { bf16_t* rowp = O + (size_t)(row0 + ai * 128 + m * 16) * 3072 + col0;
#pragma unroll
                for (int bj = 0; bj < 2; ++bj) { f32x4 v0 = acc[ai][bj][m][0], v1 = acc[ai][bj][m][1];
#pragma unroll
                    for (int j = 0; j < 4; ++j) { v0[j] = sigmoidf_(v0[j]); v1[j] = sigmoidf_(v1[j]); }
                    u32x4 w; w.x = cvt_pk_bf16(v0[0], v0[1]); w.y = cvt_pk_bf16(v0[2], v0[3]); w.z = cvt_pk_bf16(v1[0], v1[1]); w.w = cvt_pk_bf16(v1[2], v1[3]);
                    *(u32x4*)(rowp + bj * 128) = w; } }
    }
};
struct EpiMerge {
    static constexpr bool PERM = true;
    const bf16_t* Gt; bf16_t* Mg;
    __device__ __forceinline__ void operator()(EPI_ARGS) const {
        const int n = u.aux;
        const int row0 = u.pm * 256 + wr * 64 + fr, col0 = u.pn * 256 + wc * 32 + 8 * fq;
#pragma unroll
        for (int ai = 0; ai < 2; ++ai)
#pragma unroll
            for (int m = 0; m < 4; ++m) { const size_t r = (size_t)(row0 + ai * 128 + m * 16);
#pragma unroll
                for (int bj = 0; bj < 2; ++bj) { const f32x4 v0 = acc[ai][bj][m][0], v1 = acc[ai][bj][m][1];
                    const u32x4 g = *(const u32x4*)(Gt + r * 3072 + n * 1024 + col0 + bj * 128);
                    float o[8] = {bflo(g.x) * v0[0], bfhi(g.x) * v0[1], bflo(g.y) * v0[2], bfhi(g.y) * v0[3], bflo(g.z) * v1[0], bfhi(g.z) * v1[1], bflo(g.w) * v1[2], bfhi(g.w) * v1[3]};
                    bf16_t* mp = Mg + r * 1024 + col0 + bj * 128;
                    if (n > 0) { const u32x4 p = *(const u32x4*)mp; o[0] += bflo(p.x); o[1] += bfhi(p.x); o[2] += bflo(p.y); o[3] += bfhi(p.y); o[4] += bflo(p.z); o[5] += bfhi(p.z); o[6] += bflo(p.w); o[7] += bfhi(p.w); }
                    u32x4 w; w.x = cvt_pk_bf16(o[0], o[1]); w.y = cvt_pk_bf16(o[2], o[3]); w.z = cvt_pk_bf16(o[4], o[5]); w.w = cvt_pk_bf16(o[6], o[7]);
                    *(u32x4*)mp = w; } }
    }
};
struct EpiResid {
    static constexpr bool PERM = false;
    const float* In; float* Out;
    __device__ __forceinline__ void operator()(EPI_ARGS) const {
        const int row0 = u.pm * 256 + wr * 64 + fr, col0 = u.pn * 256 + wc * 32 + 4 * fq;
#pragma unroll
        for (int ai = 0; ai < 2; ++ai)
#pragma unroll
            for (int m = 0; m < 4; ++m) { const size_t o = (size_t)(row0 + ai * 128 + m * 16) * DM + col0;
#pragma unroll
                for (int bj = 0; bj < 2; ++bj)
#pragma unroll
                    for (int n = 0; n < 2; ++n) { const f32x4 x = *(const f32x4*)(In + o + bj * 128 + n * 16); *(f32x4*)(Out + o + bj * 128 + n * 16) = x + acc[ai][bj][m][n]; } }
    }
};
struct EpiSwiglu {
    static constexpr bool PERM = true;
    bf16_t* O; int ldc; int pn_off;
    __device__ __forceinline__ void operator()(EPI_ARGS) const {
        const int row0 = u.pm * 256 + wr * 64 + fr, col0 = (u.pn - pn_off) * 128 + wc * 32 + 8 * fq;
#pragma unroll
        for (int ai = 0; ai < 2; ++ai)
#pragma unroll
            for (int m = 0; m < 4; ++m) { bf16_t* rowp = O + (size_t)(row0 + ai * 128 + m * 16) * ldc + col0;
                float o[8];
#pragma unroll
                for (int n = 0; n < 2; ++n)
#pragma unroll
                    for (int j = 0; j < 4; ++j) { const float g = acc[ai][0][m][n][j], up = acc[ai][1][m][n][j]; o[n * 4 + j] = g * sigmoidf_(g) * up; }
                u32x4 w; w.x = cvt_pk_bf16(o[0], o[1]); w.y = cvt_pk_bf16(o[2], o[3]); w.z = cvt_pk_bf16(o[4], o[5]); w.w = cvt_pk_bf16(o[6], o[7]);
                *(u32x4*)rowp = w; }
    }
};
struct EpiMoeDown {
    static constexpr bool PERM = false;
    const int* row_tok; const float* row_w; float* H;
    __device__ __forceinline__ void operator()(EPI_ARGS) const {
        const int row0 = u.pm * 256 + wr * 64 + fr, col0 = u.pn * 256 + wc * 32 + 4 * fq;
#pragma unroll
        for (int ai = 0; ai < 2; ++ai)
#pragma unroll
            for (int m = 0; m < 4; ++m) { const int r = row0 + ai * 128 + m * 16; const int tk = row_tok[r]; const float wt = row_w[r];
                if (tk >= 0) { float* hp = H + (size_t)tk * DM + col0;
#pragma unroll
                    for (int bj = 0; bj < 2; ++bj)
#pragma unroll
                        for (int n = 0; n < 2; ++n)
#pragma unroll
                            for (int j = 0; j < 4; ++j) atomicAdd(hp + bj * 128 + n * 16 + j, wt * acc[ai][bj][m][n][j]); } }
    }
};

__device__ __forceinline__ void transpose_tile(const float* W, int ldn, int k0, int n0, bf16_t* WT, int ldk, int drow, int dk0, LAS float* scr, int lane) {
#pragma unroll 8
    for (int i = 0; i < 32; ++i) { const int kk = 2 * i + (lane >> 5); scr[kk * 33 + (lane & 31)] = W[(size_t)(k0 + kk) * ldn + n0 + (lane & 31)]; }
    LDS_WAIT(); asm volatile("" ::: "memory");
    const int c = lane & 7;
#pragma unroll
    for (int j = 0; j < 4; ++j) { const int n = (lane >> 3) + 8 * j; const LAS float* s = scr + (8 * c) * 33 + n;
        u32x4 o; o.x = pk2(s[0 * 33], s[1 * 33]); o.y = pk2(s[2 * 33], s[3 * 33]); o.z = pk2(s[4 * 33], s[5 * 33]); o.w = pk2(s[6 * 33], s[7 * 33]);
        *(u32x4*)(WT + (size_t)(drow + n) * ldk + dk0 + k0 + 8 * c) = o; }
    LDS_WAIT(); asm volatile("" ::: "memory");
}
__device__ __forceinline__ void conv_plain(const float* W, int K, int N, bf16_t* WT, int ldk, int item, LAS float* scr, int lane) {
    const int nblk = N / 32, kb = item / nblk, nb = item % nblk;
    transpose_tile(W, N, kb * 64, nb * 32, WT, ldk, nb * 32, 0, scr, lane);
}
__device__ __forceinline__ int win_drow(int n0) { return n0 < 3872 ? n0 : (n0 < 4128 ? 4096 + (n0 - 3872) : (n0 < 4288 ? 4352 + (n0 - 4128) : 4608 + (n0 - 4288))); }
__device__ __forceinline__ int gu_drow(int n0, int up) { return (n0 >> 7) * 256 + (n0 & 127) + up * 128; }

__device__ __forceinline__ void phase_prologue(const Frame& F, const Params& P) {
    LAS float* scr = (LAS float*)(F.lds + F.wave * 16384);
    unsigned char* ws = F.ws;
    constexpr int I_IN = 16 * 230, I_QB = 4 * 24, I_BRn = 8 * 32, I_WOn = 16 * 32, I_G = 16 * 88, I_D = 44 * 32;
    constexpr int NIT = NLAYER * (I_IN + I_QB + 3 * I_BRn + I_WOn) + 2 * I_G + I_D;
    for (int it = F.gw; it < NIT; it += F.ngw) {
        int r = it;
        if (r < NLAYER * I_IN) { const int l = r / I_IN; r %= I_IN; const int kb = r / 230, nb = r % 230;
            transpose_tile(P.in[I_WIN] + (size_t)l * DM * IN_COLS, IN_COLS, kb * 64, nb * 32, (bf16_t*)(ws + WS_WIN) + (size_t)l * WIN_ROWS * DM, DM, win_drow(nb * 32), 0, scr, F.lane); continue; }
        r -= NLAYER * I_IN;
        if (r < NLAYER * I_QB) { const int l = r / I_QB; r %= I_QB; conv_plain(P.in[I_WQB] + (size_t)l * 256 * 768, 256, 768, (bf16_t*)(ws + WS_QB) + (size_t)l * 768 * 256, 256, r, scr, F.lane); continue; }
        r -= NLAYER * I_QB;
        if (r < NLAYER * 3 * I_BRn) { const int ln = r / I_BRn; r %= I_BRn; conv_plain(P.in[I_WBR] + (size_t)ln * 512 * 1024, 512, 1024, (bf16_t*)(ws + WS_BR) + (size_t)ln * 1024 * 512, 512, r, scr, F.lane); continue; }
        r -= NLAYER * 3 * I_BRn;
        if (r < NLAYER * I_WOn) { const int l = r / I_WOn; r %= I_WOn; conv_plain(P.in[I_WO] + (size_t)l * DM * DM, DM, DM, (bf16_t*)(ws + WS_WO) + (size_t)l * DM * DM, DM, r, scr, F.lane); continue; }
        r -= NLAYER * I_WOn;
        if (r < 2 * I_G) { const int up = r / I_G; r %= I_G; const int kb = r / 88, nb = r % 88;
            transpose_tile(P.in[up ? I_FU : I_FG], DFF, kb * 64, nb * 32, (bf16_t*)(ws + WS_FGU), DM, gu_drow(nb * 32, up), 0, scr, F.lane); continue; }
        r -= 2 * I_G;
        conv_plain(P.in[I_FD], DFF, DM, (bf16_t*)(ws + WS_FD), DFF, r, scr, F.lane);
    }
    const int gt = F.blk * NTHR + F.tid, ngt = F.G * NTHR;
    for (int i = gt; i < NLAYER * 1536 * 384; i += ngt) { const int l = i / (1536 * 384), r = i % (1536 * 384), n = r / 384, k = r % 384; const int seg = n >> 9, c = n & 511; float v = 0.f;
        if (seg == 0 && k < 64) v = P.in[I_W2][((size_t)l * 64 + k) * 512 + c];
        else if (seg == 1 && k >= 64 && k < 128) v = P.in[I_A2][((size_t)l * 64 + (k - 64)) * 512 + c];
        else if (seg == 2 && k >= 128 && k < 288) v = P.in[I_G2][((size_t)l * 160 + (k - 128)) * 512 + c];
        ((bf16_t*)(ws + WS_LORA))[i] = (bf16_t)f2bf(v); }
    for (int i = gt; i < NLAYER * 512 * 256; i += ngt) { const int l = i / (512 * 256), r = i % (512 * 256), n = r / 256, k = r % 256; const int h = n >> 6, d = n & 63;
        float vk = 0.f, vv = 0.f; if (k < 128) { const float* w = P.in[I_WKVB] + ((size_t)l * 128 + k) * 1024 + h * 128; vk = w[d]; vv = w[64 + d]; }
        ((bf16_t*)(ws + WS_KB))[i] = (bf16_t)f2bf(vk); ((bf16_t*)(ws + WS_VB))[i] = (bf16_t)f2bf(vv); }
    for (int i = gt; i < MTOK * 80; i += ngt) { const int m = i / 80, j = i % 80; const int isr = j < 64; const int idx = isr ? j : j - 64; const double dim = isr ? 128.0 : 32.0;
        const float inv = (float)(1.0 / pow(10000.0, (2.0 * idx) / dim)); const float ang = (float)((const int*)P.in[I_POS])[m] * inv;
        const double a = (double)ang, q = rint(a * 0.15915494309189535), rr = a - q * 6.283185307179586476925;
        const float rf = (float)rr; const float cs = __cosf(rf), sn = __sinf(rf);
        if (isr) { ((float*)(ws + WS_COSR))[(size_t)m * 64 + idx] = cs; ((float*)(ws + WS_SINR))[(size_t)m * 64 + idx] = sn; }
        else { ((float*)(ws + WS_COSM))[(size_t)m * 16 + idx] = cs; ((float*)(ws + WS_SINM))[(size_t)m * 16 + idx] = sn; } }
}
__device__ __forceinline__ void phase_moe_convert(const Frame& F, const Params& P) {
    LAS float* scr = (LAS float*)(F.lds + F.wave * 16384);
    constexpr int I_G = 16 * 112, I_D = 56 * 32;
    constexpr int NIT = NEXP * (2 * I_G + I_D);
    for (int it = F.gw; it < NIT; it += F.ngw) {
        const int e = it / (2 * I_G + I_D); int r = it % (2 * I_G + I_D);
        if (r < 2 * I_G) { const int up = r / I_G; r %= I_G; const int kb = r / 112, nb = r % 112;
            transpose_tile(P.in[up ? I_MU2 : I_MG] + (size_t)e * DM * DFFE, DFFE, kb * 64, nb * 32, (bf16_t*)(F.ws + WS_MGU) + (size_t)e * 2 * DFFE * DM, DM, gu_drow(nb * 32, up), 0, scr, F.lane); continue; }
        r -= 2 * I_G;
        conv_plain(P.in[I_MD] + (size_t)e * DFFE * DM, DFFE, DM, (bf16_t*)(F.ws + WS_MD) + (size_t)e * DM * DFFE, DFFE, r, scr, F.lane);
    }
}

template <bool MOE>
__device__ __forceinline__ void phase_rms(const Frame& F, const float* src, const float* gain, bf16_t* hn, const float* router, unsigned* ectl, int* tok_e, int* tok_slot, float* tok_w) {
    LAS int* lcnt = (LAS int*)(F.lds);
    if (MOE) { if (F.tid < 16) lcnt[F.tid] = 0; __syncthreads(); }
    int my_e0 = 0, my_e1 = 0, my_s0 = 0, my_s1 = 0; float my_w0 = 0.f, my_w1 = 0.f;
    for (int i = 0; i < 8; ++i) {
        const int m = F.blk * 64 + F.wave * 8 + i;
        const f32x4* xr = (const f32x4*)(src + (size_t)m * DM) + F.lane;
        f32x4 v[4]; float s = 0.f;
#pragma unroll
        for (int j = 0; j < 4; ++j) { v[j] = xr[64 * j]; s += (v[j].x * v[j].x + v[j].y * v[j].y) + (v[j].z * v[j].z + v[j].w * v[j].w); }
        const float rstd = rsqrtf(wave_sum(s) * (1.0f / DM) + NORM_EPS);
#pragma unroll
        for (int j = 0; j < 4; ++j) { const f32x4 g = ((const f32x4*)gain)[F.lane + 64 * j]; v[j] = v[j] * rstd * g; }
        u32x2* o8 = (u32x2*)(hn + (size_t)m * DM) + F.lane;
#pragma unroll
        for (int j = 0; j < 4; ++j) { u32x2 w; w.x = pk2(v[j].x, v[j].y); w.y = pk2(v[j].z, v[j].w); o8[64 * j] = w; }
        if (MOE) {
            float lg[8];
#pragma unroll
            for (int e = 0; e < 8; ++e) lg[e] = 0.f;
#pragma unroll
            for (int j = 0; j < 4; ++j)
#pragma unroll
                for (int q = 0; q < 4; ++q) { const int c = 4 * F.lane + 256 * j + q; const f32x4 r0 = *(const f32x4*)(router + (size_t)c * 8), r1 = *(const f32x4*)(router + (size_t)c * 8 + 4); const float x = v[j][q];
                    lg[0] += x * r0.x; lg[1] += x * r0.y; lg[2] += x * r0.z; lg[3] += x * r0.w; lg[4] += x * r1.x; lg[5] += x * r1.y; lg[6] += x * r1.z; lg[7] += x * r1.w; }
#pragma unroll
            for (int e = 0; e < 8; ++e) lg[e] = wave_sum(lg[e]);
            int e0 = 0; float b0 = lg[0];
#pragma unroll
            for (int e = 1; e < 8; ++e) if (lg[e] > b0) { b0 = lg[e]; e0 = e; }
            int e1 = -1; float b1 = -3.0e38f;
#pragma unroll
            for (int e = 0; e < 8; ++e) if (e != e0 && lg[e] > b1) { b1 = lg[e]; e1 = e; }
            const float t = __expf(b1 - b0), w0 = 1.0f / (1.0f + t), w1 = t / (1.0f + t);
            int s0 = 0, s1 = 0;
            if (F.lane == 0) { s0 = atomicAdd((int*)&lcnt[e0], 1); s1 = atomicAdd((int*)&lcnt[e1], 1); }
            s0 = __shfl(s0, 0); s1 = __shfl(s1, 0);
            if (F.lane == i) { my_e0 = e0; my_e1 = e1; my_s0 = s0; my_s1 = s1; my_w0 = w0; my_w1 = w1; }
        }
    }
    if (MOE) {
        __syncthreads();
        if (F.tid < 8) lcnt[8 + F.tid] = (int)atomicAdd(&ectl[F.tid], (unsigned)lcnt[F.tid]);
        __syncthreads();
        if (F.lane < 8) { const int m = F.blk * 64 + F.wave * 8 + F.lane;
            tok_e[2 * m] = my_e0; tok_e[2 * m + 1] = my_e1; tok_slot[2 * m] = lcnt[8 + my_e0] + my_s0; tok_slot[2 * m + 1] = lcnt[8 + my_e1] + my_s1; tok_w[2 * m] = my_w0; tok_w[2 * m + 1] = my_w1; }
        __syncthreads();
    }
}
__device__ __forceinline__ void phase_final(const Frame& F, float* h, const float* gain) {
    for (int m = F.gw; m < MTOK; m += F.ngw) {
        f32x4* xr = (f32x4*)(h + (size_t)m * DM) + F.lane;
        f32x4 v[4]; float s = 0.f;
#pragma unroll
        for (int j = 0; j < 4; ++j) { v[j] = xr[64 * j]; s += (v[j].x * v[j].x + v[j].y * v[j].y) + (v[j].z * v[j].z + v[j].w * v[j].w); }
        const float rstd = rsqrtf(wave_sum(s) * (1.0f / DM) + NORM_EPS);
#pragma unroll
        for (int j = 0; j < 4; ++j) { const f32x4 g = ((const f32x4*)gain)[F.lane + 64 * j]; xr[64 * j] = v[j] * rstd * g; }
    }
}
template <int KS>
__device__ __forceinline__ f32x4 mm_tile(const LAS bf16_t* P, int ldp, const LAS bf16_t* Q, int ldq, int ib, int jb, int lane, f32x4 acc) {
    const LAS bf16_t* pp = P + (ib * 16 + (lane & 15)) * ldp + 8 * (lane >> 4);
    const LAS bf16_t* qp = Q + (jb * 16 + (lane & 15)) * ldq + 8 * (lane >> 4);
#pragma unroll
    for (int ks = 0; ks < KS; ++ks) { const bf16x8 a = *(const LAS bf16x8*)(qp + ks * 32), b = *(const LAS bf16x8*)(pp + ks * 32); acc = __builtin_amdgcn_mfma_f32_16x16x32_bf16(a, b, acc, 0, 0, 0); }
    return acc;
}
__device__ __forceinline__ void st_bf4(LAS bf16_t* p, f32x4 v) { u32x2 w; w.x = pk2(v[0], v[1]); w.y = pk2(v[2], v[3]); *(LAS u32x2*)p = w; }
__device__ __forceinline__ float ret_lg(int h) { return __logf(1.0f - exp2f(-5.0f - (float)h)); }

__device__ __forceinline__ void phase_prep(const Frame& F, const Params& P, int layer) {
    unsigned char* ws = F.ws;
    const bf16_t* p = (const bf16_t*)(ws + WS_P);
    const float* mu = P.in[I_MU] + (size_t)layer * RWKV_COLS;
    for (int m = F.gw; m < MTOK; m += F.ngw) {
        const bf16_t* pr = p + (size_t)m * PW; const bool has_prev = (m % SEQ) != 0; const bf16_t* pp = pr - PW;
        bf16_t* lin = (bf16_t*)(ws + WS_LIN) + (size_t)m * LORA_K;
#pragma unroll
        for (int jj = 0; jj < 6; ++jj) { const int c = F.lane + 64 * jj; float o = 0.f;
            if (c < 288) { const int off = 1536 + c; const float x = bf2f(pr[P_RW + off]), xp = has_prev ? bf2f(pp[P_RW + off]) : 0.f; const float xs = x + (xp - x) * mu[off];
                o = c < 64 ? tanhf(xs) : (c < 128 ? xs : sigmoidf_(xs)); }
            lin[c] = (bf16_t)f2bf(o); }
        {
            const u32x2 w = *(const u32x2*)(pr + P_QA + 4 * F.lane); float x[4] = {bflo(w.x), bfhi(w.x), bflo(w.y), bfhi(w.y)};
            const float ss = wave_sum(x[0] * x[0] + x[1] * x[1] + x[2] * x[2] + x[3] * x[3]); const float rs = rsqrtf(ss * (1.0f / 256.0f) + NORM_EPS);
            const f32x4 g = *(const f32x4*)(P.in[I_QNORM] + layer * 256 + 4 * F.lane);
            u32x2 o; o.x = pk2(x[0] * rs * g.x, x[1] * rs * g.y); o.y = pk2(x[2] * rs * g.z, x[3] * rs * g.w); *(u32x2*)((bf16_t*)(ws + WS_QN) + (size_t)m * 256 + 4 * F.lane) = o; }
        {
            const unsigned w = *(const unsigned*)(pr + P_KVA + 2 * F.lane); float x0 = bflo(w), x1 = bfhi(w);
            const float ss = wave_sum(x0 * x0 + x1 * x1); const float rs = rsqrtf(ss * (1.0f / 128.0f) + NORM_EPS);
            const f32x2 g = *(const f32x2*)(P.in[I_KVNORM] + layer * 128 + 2 * F.lane);
            unsigned* cn = (unsigned*)((bf16_t*)(ws + WS_CN) + (size_t)m * 256); cn[F.lane] = pk2(x0 * rs * g.x, x1 * rs * g.y); cn[64 + F.lane] = 0u; }
        if (F.lane < 16) {
            const float x1 = bf2f(pr[P_KVA + 128 + F.lane]), x2 = bf2f(pr[P_KVA + 144 + F.lane]);
            const float c = ((const float*)(ws + WS_COSM))[(size_t)m * 16 + F.lane], s = ((const float*)(ws + WS_SINM))[(size_t)m * 16 + F.lane];
            bf16_t* kp = (bf16_t*)(ws + WS_KPE) + (size_t)m * 32; kp[F.lane] = (bf16_t)f2bf(x1 * c - x2 * s); kp[16 + F.lane] = (bf16_t)f2bf(x1 * s + x2 * c); }
    }
    LAS bf16_t* kT = (LAS bf16_t*)F.lds;
    LAS bf16_t* vT = kT + 128 * 72;
    const int pc = F.tid & 7, j = F.tid >> 3;
    for (int u = F.blk; u < NB * NCHUNK * 4; u += F.G) {
        const int h = u & 3, n = (u >> 2) & 127, b = u >> 9; const int m = b * SEQ + n * 64 + j;
        const float lg = ret_lg(h);
        __syncthreads();
        {
            const bf16_t* kr = p + (size_t)m * PW + P_RK + h * 128 + pc * 8;
            const u32x4 a = *(const u32x4*)kr, bq = *(const u32x4*)(kr + 64);
            const float* cp = (const float*)(ws + WS_COSR) + (size_t)m * 64 + pc * 8; const float* sp = (const float*)(ws + WS_SINR) + (size_t)m * 64 + pc * 8;
            const float sc = 0.08838834764831845f * __expf(lg * (float)(63 - j));
            const unsigned aw[4] = {a.x, a.y, a.z, a.w}, bw[4] = {bq.x, bq.y, bq.z, bq.w};
#pragma unroll
            for (int i = 0; i < 8; ++i) { const float x1 = (i & 1) ? bfhi(aw[i >> 1]) : bflo(aw[i >> 1]), x2 = (i & 1) ? bfhi(bw[i >> 1]) : bflo(bw[i >> 1]); const float c = cp[i], s = sp[i];
                kT[(pc * 8 + i) * 72 + j] = (bf16_t)f2bf((x1 * c - x2 * s) * sc); kT[(64 + pc * 8 + i) * 72 + j] = (bf16_t)f2bf((x1 * s + x2 * c) * sc); }
            const bf16_t* vr = p + (size_t)m * PW + P_RV + h * 128 + pc * 8;
            const u32x4 va = *(const u32x4*)vr, vb = *(const u32x4*)(vr + 64);
            const unsigned vaw[4] = {va.x, va.y, va.z, va.w}, vbw[4] = {vb.x, vb.y, vb.z, vb.w};
#pragma unroll
            for (int i = 0; i < 8; ++i) { vT[(pc * 8 + i) * 72 + j] = (bf16_t)((i & 1) ? (vaw[i >> 1] >> 16) : (vaw[i >> 1] & 0xffffu)); vT[(64 + pc * 8 + i) * 72 + j] = (bf16_t)((i & 1) ? (vbw[i >> 1] >> 16) : (vbw[i >> 1] & 0xffffu)); }
        }
        __syncthreads();
        bf16_t* out = (bf16_t*)(ws + WS_RS) + (size_t)u * 16384;
#pragma unroll
        for (int jb = 0; jb < 8; ++jb) { f32x4 acc = {0.f, 0.f, 0.f, 0.f}; acc = mm_tile<2>(vT, 72, kT, 72, F.wave, jb, F.lane, acc);
            const int e = F.wave * 16 + (F.lane & 15), d = jb * 16 + 4 * (F.lane >> 4);
            u32x2 w; w.x = pk2(acc[0], acc[1]); w.y = pk2(acc[2], acc[3]); *(u32x2*)(out + e * 128 + d) = w; }
    }
    __syncthreads();
}

__device__ __forceinline__ void ret_scan(const Frame& F) {
    bf16_t* rs = (bf16_t*)(F.ws + WS_RS);
    for (int idx = F.blk * NTHR + F.tid; idx < NB * 4 * 16384; idx += F.G * NTHR) {
        const int b = idx >> 16, h = (idx >> 14) & 3, ed = idx & 16383; const float cd = __expf(ret_lg(h) * 64.0f);
        bf16_t* base = rs + ((size_t)(b * 128) * 4 + h) * 16384 + ed; float s = 0.f;
        for (int n0 = 0; n0 < NCHUNK; n0 += 8) { float t[8];
#pragma unroll
            for (int i = 0; i < 8; ++i) t[i] = bf2f(base[(size_t)(n0 + i) * 65536]);
#pragma unroll
            for (int i = 0; i < 8; ++i) { base[(size_t)(n0 + i) * 65536] = (bf16_t)f2bf(s); s = s * cd + t[i]; } }
    }
}

__device__ __forceinline__ void ret_out(const Frame& F) {
    unsigned char* ws = F.ws; const bf16_t* p = (const bf16_t*)(ws + WS_P);
    LAS bf16_t* q = (LAS bf16_t*)F.lds;
    LAS bf16_t* k = q + 64 * 136;
    LAS bf16_t* vT = k + 64 * 136;
    LAS bf16_t* pT = vT + 128 * 72;
    LAS bf16_t* sc = pT + 128 * 136;
    LAS float* st = (LAS float*)(sc + 64 * 72);
    const int pc = F.tid & 7, j = F.tid >> 3;
    for (int u = F.blk; u < NB * NCHUNK * 4; u += F.G) {
        const int h = u & 3, n = (u >> 2) & 127, b = u >> 9; const int m0 = b * SEQ + n * 64, m = m0 + j;
        const float lg = ret_lg(h);
        __syncthreads();
        {
            const float* cp = (const float*)(ws + WS_COSR) + (size_t)m * 64 + pc * 8; const float* sp = (const float*)(ws + WS_SINR) + (size_t)m * 64 + pc * 8;
            float cs[8], sn[8];
#pragma unroll
            for (int i = 0; i < 8; ++i) { cs[i] = cp[i]; sn[i] = sp[i]; }
#pragma unroll
            for (int which = 0; which < 2; ++which) {
                const bf16_t* r = p + (size_t)m * PW + (which ? P_RK : P_RQ) + h * 128 + pc * 8;
                const u32x4 a = *(const u32x4*)r, bq = *(const u32x4*)(r + 64);
                const unsigned aw[4] = {a.x, a.y, a.z, a.w}, bw[4] = {bq.x, bq.y, bq.z, bq.w}; const float sc_ = which ? 0.08838834764831845f : 1.0f;
                float o1[8], o2[8];
#pragma unroll
                for (int i = 0; i < 8; ++i) { const float x1 = (i & 1) ? bfhi(aw[i >> 1]) : bflo(aw[i >> 1]), x2 = (i & 1) ? bfhi(bw[i >> 1]) : bflo(bw[i >> 1]); o1[i] = (x1 * cs[i] - x2 * sn[i]) * sc_; o2[i] = (x1 * sn[i] + x2 * cs[i]) * sc_; }
                LAS bf16_t* dst = (which ? k : q) + j * 136 + pc * 8;
                u32x4 w1, w2; w1.x = pk2(o1[0], o1[1]); w1.y = pk2(o1[2], o1[3]); w1.z = pk2(o1[4], o1[5]); w1.w = pk2(o1[6], o1[7]); w2.x = pk2(o2[0], o2[1]); w2.y = pk2(o2[2], o2[3]); w2.z = pk2(o2[4], o2[5]); w2.w = pk2(o2[6], o2[7]);
                *(LAS u32x4*)dst = w1; *(LAS u32x4*)(dst + 64) = w2; }
            const bf16_t* vr = p + (size_t)m * PW + P_RV + h * 128 + pc * 8;
            const u32x4 va = *(const u32x4*)vr, vb = *(const u32x4*)(vr + 64);
            const unsigned vaw[4] = {va.x, va.y, va.z, va.w}, vbw[4] = {vb.x, vb.y, vb.z, vb.w};
#pragma unroll
            for (int i = 0; i < 8; ++i) { vT[(pc * 8 + i) * 72 + j] = (bf16_t)((i & 1) ? (vaw[i >> 1] >> 16) : (vaw[i >> 1] & 0xffffu)); vT[(64 + pc * 8 + i) * 72 + j] = (bf16_t)((i & 1) ? (vbw[i >> 1] >> 16) : (vbw[i >> 1] & 0xffffu)); }
            const bf16_t* ps = (const bf16_t*)(ws + WS_RS) + (size_t)u * 16384;
#pragma unroll
            for (int i = 0; i < 4; ++i) { const int pi = F.tid + i * 512; const int e = pi >> 4, c = pi & 15; *(LAS u32x4*)(pT + e * 136 + c * 8) = *(const u32x4*)(ps + e * 128 + c * 8); }
        }
        __syncthreads();
        {
            const int ib = F.wave & 3;
#pragma unroll
            for (int t = 0; t < 2; ++t) { const int jb = 2 * (F.wave >> 2) + t; f32x4 acc = {0.f, 0.f, 0.f, 0.f}; acc = mm_tile<4>(q, 136, k, 136, ib, jb, F.lane, acc);
                const int i = ib * 16 + (F.lane & 15), j0 = jb * 16 + 4 * (F.lane >> 4);
#pragma unroll
                for (int r = 0; r < 4; ++r) { const int dd = i - (j0 + r); acc[r] *= __expf(lg * (float)(dd < 0 ? -dd : dd)); }
                st_bf4(sc + i * 72 + j0, acc); }
        }
        __syncthreads();
        {
            const int ib = F.wave & 3, eh = F.wave >> 2; const int i = ib * 16 + (F.lane & 15);
            const float qd = __expf(lg * (float)(i + 1));
            f32x4 o[4]; float s1 = 0.f, s2 = 0.f;
#pragma unroll
            for (int t = 0; t < 4; ++t) { const int eb = eh * 4 + t; f32x4 ai = {0.f, 0.f, 0.f, 0.f}, ac = {0.f, 0.f, 0.f, 0.f};
                ai = mm_tile<2>(sc, 72, vT, 72, ib, eb, F.lane, ai); ac = mm_tile<4>(q, 136, pT, 136, ib, eb, F.lane, ac);
                o[t] = ai + ac * qd;
#pragma unroll
                for (int r = 0; r < 4; ++r) { s1 += o[t][r]; s2 += o[t][r] * o[t][r]; } }
            s1 += __shfl_xor(s1, 16); s1 += __shfl_xor(s1, 32); s2 += __shfl_xor(s2, 16); s2 += __shfl_xor(s2, 32);
            if (F.lane < 16) { st[(eh * 64 + i) * 2] = s1; st[(eh * 64 + i) * 2 + 1] = s2; }
            __syncthreads();
            const float t1 = st[i * 2] + st[(64 + i) * 2], t2 = st[i * 2 + 1] + st[(64 + i) * 2 + 1];
            const float mean = t1 * (1.0f / 128.0f), var = fmaxf(t2 * (1.0f / 128.0f) - mean * mean, 0.f), rstd = rsqrtf(var + 1e-5f);
            const int mrow = m0 + i;
#pragma unroll
            for (int t = 0; t < 4; ++t) { const int e = (eh * 4 + t) * 16 + 4 * (F.lane >> 4);
                const u32x2 gw = *(const u32x2*)(p + (size_t)mrow * PW + P_RG + h * 128 + e); const float g[4] = {bflo(gw.x), bfhi(gw.x), bflo(gw.y), bfhi(gw.y)};
                float y[4];
#pragma unroll
                for (int r = 0; r < 4; ++r) y[r] = (o[t][r] - mean) * rstd * (g[r] * sigmoidf_(g[r]));
                u32x2 w; w.x = pk2(y[0], y[1]); w.y = pk2(y[2], y[3]); *(u32x2*)((bf16_t*)(ws + WS_YRET) + (size_t)mrow * 512 + h * 128 + e) = w; }
        }
    }
    __syncthreads();
}

constexpr int ATT_KP = 104, ATT_VP = 72;
constexpr int ATT_KB = 64 * ATT_KP * 2, ATT_VB = 64 * ATT_VP * 2, ATT_BUF = ATT_KB + ATT_VB;
__device__ __forceinline__ void attn_unit(const Frame& F, int b, int h, int qt) {
    unsigned char* ws = F.ws;
    const bf16_t* Qg = (const bf16_t*)(ws + WS_Q); const bf16_t* Kn = (const bf16_t*)(ws + WS_KN); const bf16_t* Kp = (const bf16_t*)(ws + WS_KPE); const bf16_t* Vt = (const bf16_t*)(ws + WS_VT);
    const int lane = F.lane, w = F.wave, ql = lane & 31, hf = lane >> 5;
    const int mq = b * SEQ + qt * 256 + w * 32 + ql;
    const float qs = 0.10206207261596577f * 1.4426950408889634f;
    bf16x8 qf[6];
    {
        const bf16_t* qr = Qg + (size_t)mq * 768 + h * 96;
#pragma unroll
        for (int s = 0; s < 4; ++s) { const u32x4 x = *(const u32x4*)(qr + 16 * s + 8 * hf); const unsigned xw[4] = {x.x, x.y, x.z, x.w}; u32x4 o; unsigned ow[4];
#pragma unroll
            for (int i = 0; i < 4; ++i) ow[i] = pk2(bflo(xw[i]) * qs, bfhi(xw[i]) * qs);
            o.x = ow[0]; o.y = ow[1]; o.z = ow[2]; o.w = ow[3]; qf[s] = __builtin_bit_cast(bf16x8, o); }
        const u32x4 x1 = *(const u32x4*)(qr + 64 + 8 * hf), x2 = *(const u32x4*)(qr + 80 + 8 * hf);
        const float* cp = (const float*)(ws + WS_COSM) + (size_t)mq * 16 + 8 * hf; const float* sp = (const float*)(ws + WS_SINM) + (size_t)mq * 16 + 8 * hf;
        const unsigned a[4] = {x1.x, x1.y, x1.z, x1.w}, c[4] = {x2.x, x2.y, x2.z, x2.w}; unsigned o1[4], o2[4];
#pragma unroll
        for (int i = 0; i < 4; ++i) { const float u0 = bflo(a[i]), u1 = bfhi(a[i]), v0 = bflo(c[i]), v1 = bfhi(c[i]); const float c0 = cp[2 * i], c1 = cp[2 * i + 1], s0 = sp[2 * i], s1 = sp[2 * i + 1];
            o1[i] = pk2((u0 * c0 - v0 * s0) * qs, (u1 * c1 - v1 * s1) * qs); o2[i] = pk2((u0 * s0 + v0 * c0) * qs, (u1 * s1 + v1 * c1) * qs); }
        u32x4 t1, t2; t1.x = o1[0]; t1.y = o1[1]; t1.z = o1[2]; t1.w = o1[3]; t2.x = o2[0]; t2.y = o2[1]; t2.z = o2[2]; t2.w = o2[3];
        qf[4] = __builtin_bit_cast(bf16x8, t1); qf[5] = __builtin_bit_cast(bf16x8, t2);
    }
    f32x16 oacc[2];
#pragma unroll
    for (int i = 0; i < 16; ++i) { oacc[0][i] = 0.f; oacc[1][i] = 0.f; }
    float mrun = -3.0e38f, lrun = 0.f;
    const int nkt = 4 * qt + 4, mylim = 4 * qt + (w >> 1);
    const int kkey = F.tid >> 3, kpc = F.tid & 7, rkey = F.tid >> 2, rpc = F.tid & 3, ve = F.tid >> 3, vpc = F.tid & 7;
    const bf16_t* knp = Kn + (size_t)(b * SEQ + kkey) * 512 + h * 64 + kpc * 8;
    const bf16_t* kpp = Kp + (size_t)(b * SEQ + rkey) * 32 + rpc * 8;
    const bf16_t* vtp = Vt + (size_t)(h * 64 + ve) * MTOK + b * SEQ + vpc * 8;
    u32x4 rk = *(const u32x4*)knp, rr = (F.tid < 256) ? *(const u32x4*)kpp : (u32x4){0u, 0u, 0u, 0u}, rv = *(const u32x4*)vtp;
    __syncthreads();
    {
        LAS unsigned char* buf = F.lds;
        *(LAS u32x4*)(buf + (kkey * ATT_KP + kpc * 8) * 2) = rk; if (F.tid < 256) *(LAS u32x4*)(buf + (rkey * ATT_KP + 64 + rpc * 8) * 2) = rr; *(LAS u32x4*)(buf + ATT_KB + (ve * ATT_VP + vpc * 8) * 2) = rv;
    }
    __syncthreads();
    for (int kt = 0; kt < nkt; ++kt) {
        const bool more = kt + 1 < nkt;
        if (more) { const size_t ko = (size_t)(kt + 1) * 64; rk = *(const u32x4*)(knp + ko * 512); if (F.tid < 256) rr = *(const u32x4*)(kpp + ko * 32); rv = *(const u32x4*)(vtp + ko); }
        if (kt <= mylim) {
            const LAS bf16_t* kb = (const LAS bf16_t*)(F.lds + (kt & 1) * ATT_BUF); const LAS bf16_t* vb = (const LAS bf16_t*)(F.lds + (kt & 1) * ATT_BUF + ATT_KB);
            f32x16 s[2];
#pragma unroll
            for (int t = 0; t < 2; ++t) {
#pragma unroll
                for (int i = 0; i < 16; ++i) s[t][i] = 0.f;
#pragma unroll
                for (int st = 0; st < 6; ++st) { const bf16x8 a = *(const LAS bf16x8*)(kb + (t * 32 + ql) * ATT_KP + 16 * st + 8 * hf); s[t] = __builtin_amdgcn_mfma_f32_32x32x16_bf16(a, qf[st], s[t], 0, 0, 0); } }
            float mx = s[0][0];
#pragma unroll
            for (int t = 0; t < 2; ++t)
#pragma unroll
                for (int i = 0; i < 16; ++i) mx = fmaxf(mx, s[t][i]);
            mx = fmaxf(mx, __shfl_xor(mx, 32));
            const float mnew = fmaxf(mrun, mx), alpha = exp2f(mrun - mnew); mrun = mnew;
            float ls = 0.f;
#pragma unroll
            for (int t = 0; t < 2; ++t)
#pragma unroll
                for (int i = 0; i < 16; ++i) { const float pv = exp2f(s[t][i] - mnew); s[t][i] = pv; ls += pv; }
            lrun = lrun * alpha + ls;
#pragma unroll
            for (int i = 0; i < 16; ++i) { oacc[0][i] *= alpha; oacc[1][i] *= alpha; }
#pragma unroll
            for (int t = 0; t < 2; ++t)
#pragma unroll
                for (int kbb = 0; kbb < 2; ++kbb) {
                    u32x4 pw; pw.x = pk2(s[t][8 * kbb + 0], s[t][8 * kbb + 1]); pw.y = pk2(s[t][8 * kbb + 2], s[t][8 * kbb + 3]); pw.z = pk2(s[t][8 * kbb + 4], s[t][8 * kbb + 5]); pw.w = pk2(s[t][8 * kbb + 6], s[t][8 * kbb + 7]);
                    const bf16x8 pf = __builtin_bit_cast(bf16x8, pw);
                    const int key0 = t * 32 + kbb * 16 + 4 * hf;
#pragma unroll
                    for (int eb = 0; eb < 2; ++eb) { const LAS bf16_t* vr = vb + (eb * 32 + ql) * ATT_VP + key0;
                        const u32x2 lo = *(const LAS u32x2*)vr, hi = *(const LAS u32x2*)(vr + 8); u32x4 vv; vv.x = lo.x; vv.y = lo.y; vv.z = hi.x; vv.w = hi.y;
                        oacc[eb] = __builtin_amdgcn_mfma_f32_32x32x16_bf16(__builtin_bit_cast(bf16x8, vv), pf, oacc[eb], 0, 0, 0); } }
        }
        if (more) { LAS unsigned char* buf = F.lds + ((kt + 1) & 1) * ATT_BUF;
            *(LAS u32x4*)(buf + (kkey * ATT_KP + kpc * 8) * 2) = rk; if (F.tid < 256) *(LAS u32x4*)(buf + (rkey * ATT_KP + 64 + rpc * 8) * 2) = rr; *(LAS u32x4*)(buf + ATT_KB + (ve * ATT_VP + vpc * 8) * 2) = rv; }
        __syncthreads();
    }
    const float lt = lrun + __shfl_xor(lrun, 32), inv = 1.0f / lt;
    bf16_t* yo = (bf16_t*)(ws + WS_YMLA) + (size_t)mq * 512 + h * 64;
#pragma unroll
    for (int eb = 0; eb < 2; ++eb)
#pragma unroll
        for (int g = 0; g < 4; ++g) { u32x2 wv; wv.x = pk2(oacc[eb][4 * g] * inv, oacc[eb][4 * g + 1] * inv); wv.y = pk2(oacc[eb][4 * g + 2] * inv, oacc[eb][4 * g + 3] * inv);
            *(u32x2*)(yo + eb * 32 + 8 * g + 4 * hf) = wv; }
}
constexpr int RP = 72;
constexpr int RMAT = 64 * RP;
constexpr size_t RC_UNIT = 32768;
constexpr size_t WS_RC2 = WS_RC + (size_t)2048 * RC_UNIT;

__device__ __forceinline__ void st_g4(bf16_t* p, f32x4 v) { u32x2 w; w.x = pk2(v[0], v[1]); w.y = pk2(v[2], v[3]); *(u32x2*)p = w; }
__device__ __forceinline__ f32x4 ld_l4(const LAS bf16_t* p) { const u32x2 w = *(const LAS u32x2*)p; return (f32x4){bflo(w.x), bfhi(w.x), bflo(w.y), bfhi(w.y)}; }

__device__ __forceinline__ void rwkv_chunk_pre(const Frame& F, const float* mu, const float* k_k_, const float* k_a_, const float* r_k_) {
    unsigned char* ws = F.ws; const bf16_t* p = (const bf16_t*)(ws + WS_P); const bf16_t* lo = (const bf16_t*)(ws + WS_LO);
    LAS bf16_t* M = (LAS bf16_t*)F.lds;
    LAS bf16_t *KKt = M, *Bt = M + RMAT, *Kt = M + 2 * RMAT, *Rt = M + 3 * RMAT, *KKtT = M + 4 * RMAT, *BhT = M + 5 * RMAT, *KhT = M + 6 * RMAT, *VcT = M + 7 * RMAT;
    LAS bf16_t *NA = M + 8 * RMAT, *NAT = M + 9 * RMAT, *TT = M + 10 * RMAT, *AkkT = M + 11 * RMAT, *AbrT = M + 12 * RMAT, *AkrT = M + 13 * RMAT;
    LAS float* LW = (LAS float*)(M + 8 * RMAT);
    LAS float* SEG = (LAS float*)(M + 10 * RMAT);
    const int lane = F.lane, w = F.wave;
    for (int u = F.blk; u < NB * 8 * NCHUNK; u += F.G) {
        const int c = u & 127, h = (u >> 7) & 7, b = u >> 10; const int m0 = b * SEQ + c * 64, ch = h * 64 + lane;
        const float mu_r = mu[ch], mu_k = mu[512 + ch], mu_v = mu[1024 + ch], k_k = k_k_[ch], k_a = k_a_[ch], r_k = r_k_[ch];
        float* aux = (float*)(ws + WS_RC2) + (size_t)u * 128;
        __syncthreads();
        float rr[8], kk8[8], k28[8], vv[8], bb[8], lw8[8];
#pragma unroll
        for (int i = 0; i < 8; ++i) { const int t = w + 8 * i, m = m0 + t; const bf16_t* pr = p + (size_t)m * PW + P_RW + ch; const bool hp = (c | t) != 0;
            const float xr = bf2f(pr[0]), xk = bf2f(pr[512]), xv = bf2f(pr[1024]);
            const float pr_ = hp ? bf2f(pr[-PW]) : 0.f, pk_ = hp ? bf2f(pr[512 - PW]) : 0.f, pv_ = hp ? bf2f(pr[1024 - PW]) : 0.f;
            const float r = xr + (pr_ - xr) * mu_r, k = xk + (pk_ - xk) * mu_k, v = xv + (pv_ - xv) * mu_v;
            const float lw = bf2f(lo[(size_t)m * LO_W + ch]), a = bf2f(lo[(size_t)m * LO_W + 512 + ch]);
            float kk = k * k_k; const float ss = wave_sum(kk * kk); kk *= rsqrtf(ss + 1e-12f);
            const float k2 = k * (1.0f + (a - 1.0f) * k_a);
            rr[i] = r; kk8[i] = kk; k28[i] = k2; vv[i] = v; bb[i] = kk * a; lw8[i] = lw; LW[t * 64 + lane] = lw;
            const float bon = wave_sum(r * k2 * r_k); if (lane == 0) aux[64 + t] = bon; }
        __syncthreads();
        { float cs = 0.f;
#pragma unroll
          for (int i = 0; i < 8; ++i) { cs += LW[(w * 8 + i) * 64 + lane]; LW[(w * 8 + i) * 64 + lane] = cs; }
          SEG[w * 64 + lane] = cs; }
        __syncthreads();
        float segp[9]; segp[0] = 0.f;
#pragma unroll
        for (int s = 0; s < 8; ++s) segp[s + 1] = segp[s] + SEG[s * 64 + lane];
        const float cumC = segp[8];
        float cum8[8];
#pragma unroll
        for (int i = 0; i < 8; ++i) cum8[i] = LW[(w + 8 * i) * 64 + lane] + segp[i];
        if (w == 0) aux[lane] = __expf(cumC);
        __syncthreads();
#pragma unroll
        for (int i = 0; i < 8; ++i) { const int t = w + 8 * i; const float cum = cum8[i];
            const float om = __expf(cum), omx = __expf(cum - lw8[i]), iom = __expf(-cum), ih = __expf(cumC - cum);
            KKt[t * RP + lane] = (bf16_t)f2bf(kk8[i] * omx); Bt[t * RP + lane] = (bf16_t)f2bf(bb[i] * iom); Kt[t * RP + lane] = (bf16_t)f2bf(k28[i] * iom); Rt[t * RP + lane] = (bf16_t)f2bf(rr[i] * om);
            KKtT[lane * RP + t] = (bf16_t)f2bf(kk8[i] * omx); BhT[lane * RP + t] = (bf16_t)f2bf(bb[i] * ih); KhT[lane * RP + t] = (bf16_t)f2bf(k28[i] * ih); VcT[lane * RP + t] = (bf16_t)f2bf(vv[i]); }
        __syncthreads();
        {
            const int ib = w >> 1;
#pragma unroll
            for (int tt = 0; tt < 2; ++tt) { const int jb = 2 * (w & 1) + tt; const int i0 = ib * 16 + (lane & 15), j0 = jb * 16 + 4 * (lane >> 4);
                const f32x4 z = {0.f, 0.f, 0.f, 0.f};
                f32x4 a_nat = z, a_kk = z, a_br = z, a_kr = z, a_na = z;
                if (jb <= ib) { a_nat = mm_tile<2>(KKt, RP, Bt, RP, ib, jb, lane, z); a_kk = mm_tile<2>(KKt, RP, Kt, RP, ib, jb, lane, z); a_br = mm_tile<2>(Rt, RP, Bt, RP, ib, jb, lane, z); a_kr = mm_tile<2>(Rt, RP, Kt, RP, ib, jb, lane, z); }
                if (jb >= ib) a_na = mm_tile<2>(Bt, RP, KKt, RP, ib, jb, lane, z);
                f32x4 o_nat, o_tt, o_kk, o_br, o_kr, o_na;
#pragma unroll
                for (int r = 0; r < 4; ++r) { const int jj = j0 + r; const bool lt = jj < i0, le = jj <= i0;
                    o_nat[r] = lt ? -a_nat[r] : 0.f; o_tt[r] = o_nat[r] + (jj == i0 ? 1.0f : 0.f); o_kk[r] = lt ? a_kk[r] : 0.f; o_br[r] = le ? a_br[r] : 0.f; o_kr[r] = le ? a_kr[r] : 0.f;
                    o_na[r] = (i0 < jj) ? -a_na[r] : 0.f; }
                st_bf4(NAT + i0 * RP + j0, o_nat); st_bf4(TT + i0 * RP + j0, o_tt); st_bf4(AkkT + i0 * RP + j0, o_kk); st_bf4(AbrT + i0 * RP + j0, o_br); st_bf4(AkrT + i0 * RP + j0, o_kr); st_bf4(NA + i0 * RP + j0, o_na); }
        }
        __syncthreads();
        LAS bf16_t* VA = Kt;
#pragma unroll 1
        for (int s = 1; s <= 6; ++s) {
            const LAS bf16_t* Yo = (s & 1) ? NAT : KKt; const LAS bf16_t* YoT = (s & 1) ? NA : Bt; LAS bf16_t* Yn = (s & 1) ? KKt : NAT; LAS bf16_t* YnT = (s & 1) ? Bt : NA;
            const f32x4 z = {0.f, 0.f, 0.f, 0.f};
            if (w < 4) {
                if (s == 1) {
#pragma unroll
                    for (int jb = 0; jb < 4; ++jb) { const f32x4 a = mm_tile<2>(VcT, RP, AkkT, RP, w, jb, lane, z); st_bf4(VA + (w * 16 + (lane & 15)) * RP + jb * 16 + 4 * (lane >> 4), a); }
                } else {
                    f32x4 a[4];
#pragma unroll
                    for (int jb = 0; jb < 4; ++jb) a[jb] = mm_tile<2>(TT, RP, YoT, RP, w, jb, lane, ld_l4(TT + (w * 16 + (lane & 15)) * RP + jb * 16 + 4 * (lane >> 4)));
                    LDS_WAIT();
#pragma unroll
                    for (int jb = 0; jb < 4; ++jb) st_bf4(TT + (w * 16 + (lane & 15)) * RP + jb * 16 + 4 * (lane >> 4), a[jb]);
                }
            } else if (s <= 5) {
                const int ib = w - 4;
#pragma unroll
                for (int jb = 0; jb < 4; ++jb) { const f32x4 a = mm_tile<2>(Yo, RP, YoT, RP, ib, jb, lane, z), bt = mm_tile<2>(YoT, RP, Yo, RP, ib, jb, lane, z);
                    st_bf4(Yn + (ib * 16 + (lane & 15)) * RP + jb * 16 + 4 * (lane >> 4), a); st_bf4(YnT + (ib * 16 + (lane & 15)) * RP + jb * 16 + 4 * (lane >> 4), bt); }
            }
            __syncthreads();
        }
        LAS bf16_t* KT = NAT; LAS bf16_t* P1 = NA;
        {
            const f32x4 z = {0.f, 0.f, 0.f, 0.f}; const int ib = w & 3; const LAS bf16_t* src = (w < 4) ? KKtT : VA; LAS bf16_t* dst = (w < 4) ? KT : P1;
#pragma unroll
            for (int jb = 0; jb < 4; ++jb) { const f32x4 a = mm_tile<2>(src, RP, TT, RP, ib, jb, lane, z); st_bf4(dst + (ib * 16 + (lane & 15)) * RP + jb * 16 + 4 * (lane >> 4), a); }
        }
        __syncthreads();
        {
            bf16_t* og = (bf16_t*)(ws + WS_RC + (size_t)u * RC_UNIT) + (w >> 1) * 4096; const int g = w >> 1; const f32x4 z = {0.f, 0.f, 0.f, 0.f};
#pragma unroll
            for (int tt = 0; tt < 2; ++tt) { const int ib = 2 * (w & 1) + tt; const int i0 = ib * 16 + (lane & 15);
#pragma unroll
                for (int jb = 0; jb < 4; ++jb) { const int j0 = jb * 16 + 4 * (lane >> 4); f32x4 o;
                    if (g == 0) o = mm_tile<2>(BhT, RP, KT, RP, ib, jb, lane, z);
                    else if (g == 1) o = mm_tile<2>(VcT, RP, KhT, RP, ib, jb, lane, z) - mm_tile<2>(P1, RP, BhT, RP, ib, jb, lane, z);
                    else if (g == 2) o = ld_l4(Rt + i0 * RP + j0) - mm_tile<2>(AbrT, RP, KT, RP, ib, jb, lane, z);
                    else o = mm_tile<2>(VcT, RP, AkrT, RP, ib, jb, lane, z) - mm_tile<2>(P1, RP, AbrT, RP, ib, jb, lane, z);
                    st_g4(og + i0 * 64 + j0, o); } }
        }
    }
    __syncthreads();
}

__device__ __forceinline__ void rwkv_scan(const Frame& F, const float* mu, const float* lnx_, int b, int h) {
    unsigned char* ws = F.ws; const bf16_t* p = (const bf16_t*)(ws + WS_P); const bf16_t* lo = (const bf16_t*)(ws + WS_LO);
    LAS bf16_t* Sb = (LAS bf16_t*)F.lds;
    LAS float* Yl = (LAS float*)(F.lds + 2 * RMAT * 2);
    const int lane = F.lane, w = F.wave, l15 = lane & 15, l4 = lane >> 4;
    for (int i = F.tid; i < 2 * RMAT / 2; i += NTHR) ((LAS unsigned*)Sb)[i] = 0u;
    const size_t u0 = (size_t)(b * 8 + h) * 128;
    f32x4 st[4];
#pragma unroll
    for (int i = 0; i < 4; ++i) st[i] = (f32x4){0.f, 0.f, 0.f, 0.f};
    const int sw = w & 3;
    u32x4 fa[2]; u32x2 ad[4]; f32x4 om4 = {0.f, 0.f, 0.f, 0.f};
    const int tl = lane >> 2, cq = lane & 3, chq = h * 64 + cq * 16;
    u32x4 pv[2], pp[2], pg[2]; float bcv = 0.f;
    auto load_ops = [&](int c) {
        const bf16_t* base = (const bf16_t*)(ws + WS_RC + (u0 + c) * RC_UNIT) + (w < 4 ? 0 : 2 * 4096);
#pragma unroll
        for (int ks = 0; ks < 2; ++ks) fa[ks] = *(const u32x4*)(base + (sw * 16 + l15) * 64 + ks * 32 + 8 * l4);
#pragma unroll
        for (int ib = 0; ib < 4; ++ib) ad[ib] = *(const u32x2*)(base + 4096 + (ib * 16 + l15) * 64 + sw * 16 + 4 * l4);
        if (w < 4) om4 = *(const f32x4*)((const float*)(ws + WS_RC2) + (u0 + c) * 128 + sw * 16 + 4 * l4);
        else { const int m = b * SEQ + c * 64 + sw * 16 + tl; const bf16_t* pr = p + (size_t)m * PW + P_RW + 1024 + chq; const bool hp = (c | sw | tl) != 0;
            pv[0] = *(const u32x4*)pr; pv[1] = *(const u32x4*)(pr + 8);
            if (hp) { pp[0] = *(const u32x4*)(pr - PW); pp[1] = *(const u32x4*)(pr - PW + 8); } else { pp[0] = (u32x4){0u, 0u, 0u, 0u}; pp[1] = pp[0]; }
            const bf16_t* gr = lo + (size_t)m * LO_W + 1024 + chq; pg[0] = *(const u32x4*)gr; pg[1] = *(const u32x4*)(gr + 8);
            bcv = ((const float*)(ws + WS_RC2))[(u0 + c) * 128 + 64 + sw * 16 + tl]; }
    };
    float muv[16], lnx[16];
#pragma unroll
    for (int i = 0; i < 16; ++i) { muv[i] = (w >= 4) ? mu[1024 + chq + i] : 0.f; lnx[i] = (w >= 4) ? lnx_[chq + i] : 0.f; }
    load_ops(0);
    __syncthreads();
#pragma unroll 1
    for (int c = 0; c < NCHUNK; ++c) {
        const LAS bf16_t* Sc = Sb + (c & 1) * RMAT; LAS bf16_t* Sn = Sb + ((c + 1) & 1) * RMAT;
        const bf16x8 a0 = __builtin_bit_cast(bf16x8, fa[0]), a1 = __builtin_bit_cast(bf16x8, fa[1]);
        f32x4 acc[4];
#pragma unroll
        for (int ib = 0; ib < 4; ++ib) { const LAS bf16_t* sp = Sc + (ib * 16 + l15) * RP + 8 * l4; const bf16x8 s0 = *(const LAS bf16x8*)sp, s1 = *(const LAS bf16x8*)(sp + 32);
            f32x4 t = {0.f, 0.f, 0.f, 0.f}; t = __builtin_amdgcn_mfma_f32_16x16x32_bf16(a0, s0, t, 0, 0, 0); t = __builtin_amdgcn_mfma_f32_16x16x32_bf16(a1, s1, t, 0, 0, 0); acc[ib] = t; }
        const u32x2 adc[4] = {ad[0], ad[1], ad[2], ad[3]}; const f32x4 omc = om4;
        const u32x4 cv0 = pv[0], cv1 = pv[1], cp0 = pp[0], cp1 = pp[1], cg0 = pg[0], cg1 = pg[1]; const float cbc = bcv;
        if (c + 1 < NCHUNK) load_ops(c + 1);
        if (w < 4) {
#pragma unroll
            for (int ib = 0; ib < 4; ++ib) { const f32x4 nn = {bflo(adc[ib].x), bfhi(adc[ib].x), bflo(adc[ib].y), bfhi(adc[ib].y)};
                st[ib] = st[ib] * omc - acc[ib] + nn; st_bf4(Sn + (ib * 16 + l15) * RP + sw * 16 + 4 * l4, st[ib]); }
        } else {
#pragma unroll
            for (int ib = 0; ib < 4; ++ib) { const f32x4 zz = {bflo(adc[ib].x), bfhi(adc[ib].x), bflo(adc[ib].y), bfhi(adc[ib].y)}; const f32x4 y = acc[ib] + zz;
#pragma unroll
                for (int r = 0; r < 4; ++r) Yl[(sw * 16 + 4 * l4 + r) * 68 + ib * 16 + l15] = y[r]; }
            LDS_WAIT(); asm volatile("" ::: "memory");
            const LAS float* yr = Yl + (sw * 16 + tl) * 68 + cq * 16;
            float y[16]; float s1 = 0.f;
#pragma unroll
            for (int i = 0; i < 4; ++i) { const f32x4 t = *(const LAS f32x4*)(yr + 4 * i); y[4 * i] = t[0]; y[4 * i + 1] = t[1]; y[4 * i + 2] = t[2]; y[4 * i + 3] = t[3]; s1 += (t[0] + t[1]) + (t[2] + t[3]); }
            s1 += __shfl_xor(s1, 1); s1 += __shfl_xor(s1, 2); const float mean = s1 * (1.0f / 64.0f); float s2 = 0.f;
#pragma unroll
            for (int i = 0; i < 16; ++i) { y[i] -= mean; s2 += y[i] * y[i]; }
            s2 += __shfl_xor(s2, 1); s2 += __shfl_xor(s2, 2); const float rstd = rsqrtf(s2 * (1.0f / 64.0f) + 64e-5f);
            const unsigned vw[8] = {cv0.x, cv0.y, cv0.z, cv0.w, cv1.x, cv1.y, cv1.z, cv1.w}, pw[8] = {cp0.x, cp0.y, cp0.z, cp0.w, cp1.x, cp1.y, cp1.z, cp1.w}, gw[8] = {cg0.x, cg0.y, cg0.z, cg0.w, cg1.x, cg1.y, cg1.z, cg1.w};
            unsigned ow[8];
#pragma unroll
            for (int i = 0; i < 8; ++i) { float o2[2];
#pragma unroll
                for (int e = 0; e < 2; ++e) { const int ci = 2 * i + e; const float xv = e ? bfhi(vw[i]) : bflo(vw[i]), xp = e ? bfhi(pw[i]) : bflo(pw[i]), g = e ? bfhi(gw[i]) : bflo(gw[i]);
                    const float v = xv + (xp - xv) * muv[ci]; o2[e] = (y[ci] * rstd * lnx[ci] + cbc * v) * g; }
                ow[i] = pk2(o2[0], o2[1]); }
            const int m = b * SEQ + c * 64 + sw * 16 + tl; bf16_t* yo = (bf16_t*)(ws + WS_YRW) + (size_t)m * 512 + chq;
            *(u32x4*)yo = (u32x4){ow[0], ow[1], ow[2], ow[3]}; *(u32x4*)(yo + 8) = (u32x4){ow[4], ow[5], ow[6], ow[7]};
        }
        __syncthreads();
    }
}
__device__ __forceinline__ void rwkv_seq(const Frame& F, const Params& P, int layer, int b, int h) {
    unsigned char* ws = F.ws; const bf16_t* p = (const bf16_t*)(ws + WS_P); const bf16_t* lo = (const bf16_t*)(ws + WS_LO);
    LAS float* Lr = (LAS float*)F.lds; LAS float* Lw = Lr + 4096; LAS float* Lk = Lw + 4096; LAS float* Lv = Lk + 4096; LAS float* Lkk = Lv + 4096; LAS float* Lb = Lkk + 4096; LAS float* Ly = Lb + 4096;
    const int lane = F.lane, ch = h * 64 + lane;
    const float mu_r = P.in[I_MU][(size_t)layer * RWKV_COLS + ch], mu_k = P.in[I_MU][(size_t)layer * RWKV_COLS + 512 + ch], mu_v = P.in[I_MU][(size_t)layer * RWKV_COLS + 1024 + ch];
    const float k_k = P.in[I_KK][layer * 512 + ch], k_a = P.in[I_KA][layer * 512 + ch], r_k = P.in[I_RK][layer * 512 + ch], lnx = P.in[I_LNX][layer * 512 + ch];
    const int vrow = F.tid >> 3, q = F.tid & 7;
    float s[8];
#pragma unroll
    for (int i = 0; i < 8; ++i) s[i] = 0.f;
    for (int c = 0; c < NCHUNK; ++c) {
        const int m0 = b * SEQ + c * 64;
        __syncthreads();
#pragma unroll
        for (int i = 0; i < 8; ++i) { const int t = F.wave + 8 * i, m = m0 + t; const bf16_t* pr = p + (size_t)m * PW + P_RW + ch; const bool hp = (c | t) != 0;
            const float xr = bf2f(pr[0]), xk = bf2f(pr[512]), xv = bf2f(pr[1024]);
            const float pr_ = hp ? bf2f(pr[-PW]) : 0.f, pk_ = hp ? bf2f(pr[512 - PW]) : 0.f, pv_ = hp ? bf2f(pr[1024 - PW]) : 0.f;
            const float r = xr + (pr_ - xr) * mu_r, k = xk + (pk_ - xk) * mu_k, v = xv + (pv_ - xv) * mu_v;
            const float lw = bf2f(lo[(size_t)m * LO_W + ch]), a = bf2f(lo[(size_t)m * LO_W + 512 + ch]);
            float kk = k * k_k; const float ss = wave_sum(kk * kk); kk *= rsqrtf(ss + 1e-12f);
            Lr[t * 64 + lane] = r; Lw[t * 64 + lane] = __expf(lw); Lk[t * 64 + lane] = k * (1.0f + (a - 1.0f) * k_a); Lv[t * 64 + lane] = v; Lkk[t * 64 + lane] = kk; Lb[t * 64 + lane] = kk * a; }
        __syncthreads();
        for (int t = 0; t < 64; ++t) {
            const f32x4 ka = *(const LAS f32x4*)(Lkk + t * 64 + q * 8), kb = *(const LAS f32x4*)(Lkk + t * 64 + q * 8 + 4);
            const f32x4 wa = *(const LAS f32x4*)(Lw + t * 64 + q * 8), wb = *(const LAS f32x4*)(Lw + t * 64 + q * 8 + 4);
            const f32x4 ba = *(const LAS f32x4*)(Lb + t * 64 + q * 8), bb = *(const LAS f32x4*)(Lb + t * 64 + q * 8 + 4);
            const f32x4 k2a = *(const LAS f32x4*)(Lk + t * 64 + q * 8), k2b = *(const LAS f32x4*)(Lk + t * 64 + q * 8 + 4);
            const f32x4 ra = *(const LAS f32x4*)(Lr + t * 64 + q * 8), rb = *(const LAS f32x4*)(Lr + t * 64 + q * 8 + 4);
            const float vv = Lv[t * 64 + vrow];
            float sa = 0.f;
#pragma unroll
            for (int i = 0; i < 4; ++i) { sa += s[i] * ka[i]; sa += s[4 + i] * kb[i]; }
            sa += __shfl_xor(sa, 1); sa += __shfl_xor(sa, 2); sa += __shfl_xor(sa, 4); sa = -sa;
            float y = 0.f;
#pragma unroll
            for (int i = 0; i < 4; ++i) { s[i] = s[i] * wa[i] + sa * ba[i] + vv * k2a[i]; s[4 + i] = s[4 + i] * wb[i] + sa * bb[i] + vv * k2b[i]; y += s[i] * ra[i]; y += s[4 + i] * rb[i]; }
            y += __shfl_xor(y, 1); y += __shfl_xor(y, 2); y += __shfl_xor(y, 4);
            if (q == 0) Ly[t * 64 + vrow] = y;
        }
        __syncthreads();
#pragma unroll
        for (int i = 0; i < 8; ++i) { const int t = F.wave + 8 * i, m = m0 + t;
            const float y = Ly[t * 64 + lane]; const float mean = wave_sum(y) * (1.0f / 64.0f); const float d = y - mean; const float var = wave_sum(d * d) * (1.0f / 64.0f);
            const float bon = wave_sum(Lr[t * 64 + lane] * Lk[t * 64 + lane] * r_k);
            const float g = bf2f(lo[(size_t)m * LO_W + 1024 + ch]);
            const float o = (d * rsqrtf(var + 64e-5f) * lnx + bon * Lv[t * 64 + lane]) * g;
            ((bf16_t*)(ws + WS_YRW))[(size_t)m * 512 + ch] = (bf16_t)f2bf(o); }
    }
    __syncthreads();
}

constexpr int LDS_TAB = LDSCTL_OFF + 64;
__device__ __forceinline__ void moe_table(const Frame& F, const unsigned* ectl) {
    LAS int* tab = (LAS int*)(F.lds + LDS_TAB);
    if (F.tid == 0) { int st = 0, nt = 0;
        for (int e = 0; e < 8; ++e) { const int c = (int)__hip_atomic_load(&ectl[e], __ATOMIC_RELAXED, __HIP_MEMORY_SCOPE_AGENT); tab[1 + e] = st; const int t = (c + 255) >> 8; for (int i = 0; i < t; ++i) tab[16 + nt + i] = e; nt += t; st += t * 256; }
        tab[0] = nt; }
    __syncthreads();
}
__device__ __forceinline__ void phase_moe_scatter(const Frame& F, const unsigned* ectl) {
    unsigned char* ws = F.ws; const LAS int* tab = (const LAS int*)(F.lds + LDS_TAB);
    const int* tok_e = (const int*)(ws + WS_TOK); const int* tok_slot = tok_e + 2 * MTOK; const float* tok_w = (const float*)(tok_slot + 2 * MTOK);
    int* row_tok = (int*)(tok_w + 2 * MTOK); float* row_w = (float*)(row_tok + MAXROWS);
    const bf16_t* hn = (const bf16_t*)(ws + WS_HN); bf16_t* hs = (bf16_t*)(ws + WS_HS);
    for (int m = F.gw; m < MTOK; m += F.ngw) {
        const u32x4 a = *(const u32x4*)(hn + (size_t)m * DM + F.lane * 8), b = *(const u32x4*)(hn + (size_t)m * DM + 512 + F.lane * 8);
#pragma unroll
        for (int sl = 0; sl < 2; ++sl) { const int e = tok_e[2 * m + sl]; const int dest = tab[1 + e] + tok_slot[2 * m + sl];
            *(u32x4*)(hs + (size_t)dest * DM + F.lane * 8) = a; *(u32x4*)(hs + (size_t)dest * DM + 512 + F.lane * 8) = b;
            if (F.lane == 0) { row_tok[dest] = m; row_w[dest] = tok_w[2 * m + sl]; } }
    }
    const int gt = F.blk * NTHR + F.tid;
    if (gt < 2048) { const int e = gt >> 8; const int c = (int)__hip_atomic_load(&ectl[e], __ATOMIC_RELAXED, __HIP_MEMORY_SCOPE_AGENT); const int r = c + (gt & 255);
        if (r < ((c + 255) & ~255)) { row_tok[tab[1 + e] + r] = -1; row_w[tab[1 + e] + r] = 0.f; } }
}

extern __shared__ __attribute__((aligned(16))) unsigned char lds_raw[];
template <class T> __device__ __forceinline__ T* uni(T* p) { const unsigned long long v = (unsigned long long)p; const unsigned lo = __builtin_amdgcn_readfirstlane((unsigned)v), hi = __builtin_amdgcn_readfirstlane((unsigned)(v >> 32)); return (T*)(((unsigned long long)hi << 32) | lo); }
__device__ __forceinline__ int uni(int v) { return __builtin_amdgcn_readfirstlane(v); }
__device__ __forceinline__ Frame mkframe(unsigned char* ws, int wv) {
    Frame F; F.lds = (LAS unsigned char*)lds_raw; int tid = wv * 64 + (int)__builtin_amdgcn_mbcnt_hi(~0u, __builtin_amdgcn_mbcnt_lo(~0u, 0u)); asm volatile("" : "+v"(tid)); F.tid = tid; F.lane = F.tid & 63; F.wave = __builtin_amdgcn_readfirstlane(F.tid >> 6);
    int blk = blockIdx.x; asm volatile("" : "+s"(blk)); F.blk = blk; F.G = gridDim.x; F.vcu = (F.blk & 7) * (F.G >> 3) + (F.blk >> 3); F.gw = F.blk * NWAVES + F.wave; F.ngw = F.G * NWAVES; F.ws = ws; return F;
}
#define PHASE __device__ __forceinline__ void
PHASE f_moe_convert(int wv, unsigned char* ws_, const float* mg, const float* mu, const float* md) {
    unsigned char* ws = uni(ws_); const Frame F = mkframe(ws, wv); Params P; P.in[I_MG] = uni(mg); P.in[I_MU2] = uni(mu); P.in[I_MD] = uni(md); phase_moe_convert(F, P);
}
PHASE f_rms(int wv, unsigned char* ws_, const float* src, const float* gain) { unsigned char* ws = uni(ws_); const Frame F = mkframe(ws, wv); phase_rms<false>(F, uni(src), uni(gain), (bf16_t*)(ws + WS_HN), nullptr, nullptr, nullptr, nullptr, nullptr); }
PHASE f_rms_moe(int wv, unsigned char* ws_, const float* src, const float* gain, const float* router) {
    unsigned char* ws = uni(ws_); const Frame F = mkframe(ws, wv); int* tok_e = (int*)(ws + WS_TOK); int* tok_slot = tok_e + 2 * MTOK; float* tok_w = (float*)(tok_slot + 2 * MTOK);
    phase_rms<true>(F, uni(src), uni(gain), (bf16_t*)(ws + WS_HN), uni(router), (unsigned*)(ws + WS_CTL) + CW_ECNT, tok_e, tok_slot, tok_w);
}
PHASE f_prep(int wv, unsigned char* ws_, const float* mu, const float* qnorm, const float* kvnorm, int layer_) {
    unsigned char* ws = uni(ws_); const Frame F = mkframe(ws, wv); Params P; P.in[I_MU] = uni(mu); P.in[I_QNORM] = uni(qnorm); P.in[I_KVNORM] = uni(kvnorm); (void)layer_; phase_prep(F, P, 0);
}
PHASE f_ret_scan(int wv, unsigned char* ws_) { unsigned char* ws = uni(ws_); const Frame F = mkframe(ws, wv); ret_scan(F); }
PHASE f_ret_out(int wv, unsigned char* ws_) { unsigned char* ws = uni(ws_); const Frame F = mkframe(ws, wv); ret_out(F); }
PHASE f_rwkv_seq(int wv, unsigned char* ws_, const float* mu, const float* kk, const float* ka, const float* rk, const float* lnx, int layer_) {
    unsigned char* ws = uni(ws_); const Frame F = mkframe(ws, wv); Params P; P.in[I_MU] = uni(mu); P.in[I_KK] = uni(kk); P.in[I_KA] = uni(ka); P.in[I_RK] = uni(rk); P.in[I_LNX] = uni(lnx);
    (void)layer_; rwkv_seq(F, P, 0, F.blk >> 3, F.blk & 7);
}
PHASE f_rwkv_pre(int wv, unsigned char* ws_, const float* mu, const float* kk, const float* ka, const float* rk) { unsigned char* ws = uni(ws_); const Frame F = mkframe(ws, wv); rwkv_chunk_pre(F, uni(mu), uni(kk), uni(ka), uni(rk)); }
PHASE f_rwkv_scan(int wv, unsigned char* ws_, const float* mu, const float* lnx) { unsigned char* ws = uni(ws_); const Frame F = mkframe(ws, wv); rwkv_scan(F, uni(mu), uni(lnx), F.blk >> 3, F.blk & 7); }
PHASE f_attn(int wv, unsigned char* ws_) { unsigned char* ws = uni(ws_); const Frame F = mkframe(ws, wv); const int bh = F.vcu >> 4, pr = F.vcu & 15; attn_unit(F, bh >> 3, bh & 7, 31 - pr); attn_unit(F, bh >> 3, bh & 7, pr); }
PHASE f_moe_scatter(int wv, unsigned char* ws_) { unsigned char* ws = uni(ws_); const Frame F = mkframe(ws, wv); moe_table(F, (unsigned*)(ws + WS_CTL) + CW_ECNT); phase_moe_scatter(F, (unsigned*)(ws + WS_CTL) + CW_ECNT); }
PHASE f_final(int wv, unsigned char* ws_, float* h, const float* gain) { unsigned char* ws = uni(ws_); const Frame F = mkframe(ws, wv); phase_final(F, uni(h), uni(gain)); }
PHASE g_inproj(int wv, unsigned char* ws_, int layer_) {
    unsigned char* ws = uni(ws_); const int layer = uni(layer_); const Frame F = mkframe(ws, wv);
    SchedGrid S; S.init(64, 18, F.G, F.blk, ws + WS_HN, (size_t)256 * DM * 2, (bf16_t*)(ws + WS_WIN) + (size_t)layer * WIN_ROWS * DM, (size_t)256 * DM * 2);
    EpiStore E; E.O = (bf16_t*)(ws + WS_P); E.ld = PW; pg8::gemm_phase(F.lds, F.tid, DM, DM, DM, S, E);
}
PHASE g_lora(int wv, unsigned char* ws_, const float* w0, const float* a0, int layer_) {
    unsigned char* ws = uni(ws_); const int layer = uni(layer_); const Frame F = mkframe(ws, wv);
    SchedGrid S; S.init(64, 6, F.G, F.blk, ws + WS_LIN, (size_t)256 * LORA_K * 2, (bf16_t*)(ws + WS_LORA) + (size_t)layer * 1536 * LORA_K, (size_t)256 * LORA_K * 2);
    EpiLora E; E.O = (bf16_t*)(ws + WS_LO); E.w0 = uni(w0); E.a0 = uni(a0); pg8::gemm_phase(F.lds, F.tid, LORA_K, LORA_K, LORA_K, S, E);
}
PHASE g_small(int wv, unsigned char* ws_, int layer_) {
    unsigned char* ws = uni(ws_); const Frame F = mkframe(ws, wv); SchedSmall S; S.G = F.G; S.c = F.blk; S.layer = uni(layer_); S.ws = (const char*)ws; EpiSmall E; E.ws = ws; pg8::gemm_phase(F.lds, F.tid, 256, 256, 256, S, E);
}
PHASE g_gate(int wv, unsigned char* ws_, int layer_) {
    unsigned char* ws = uni(ws_); const int layer = uni(layer_); const Frame F = mkframe(ws, wv);
    SchedOwn3 S; S.c = F.blk; S.G = F.G; S.A = (const char*)(ws + WS_HN); S.a_n = 0; S.astep = (size_t)256 * DM * 2; S.B = (const char*)((bf16_t*)(ws + WS_WIN) + ((size_t)layer * WIN_ROWS + PW) * DM); S.bstep = (size_t)256 * DM * 2; S.b_n = (size_t)1024 * DM * 2;
    EpiGate E; E.O = (bf16_t*)(ws + WS_G); pg8::gemm_phase(F.lds, F.tid, DM, DM, DM, S, E);
}
PHASE g_merge(int wv, unsigned char* ws_, int layer_) {
    unsigned char* ws = uni(ws_); const int layer = uni(layer_); const Frame F = mkframe(ws, wv);
    SchedOwn3 S; S.c = F.blk; S.G = F.G; S.A = (const char*)(ws + WS_YRET); S.a_n = (size_t)16 * MiB; S.astep = (size_t)256 * 512 * 2;
    S.B = (const char*)((bf16_t*)(ws + WS_BR) + (size_t)layer * 3 * 1024 * 512); S.bstep = (size_t)256 * 512 * 2; S.b_n = (size_t)1024 * 512 * 2;
    EpiMerge E; E.Gt = (const bf16_t*)(ws + WS_G); E.Mg = (bf16_t*)(ws + WS_MRG); pg8::gemm_phase(F.lds, F.tid, 512, 512, 512, S, E);
}
PHASE g_wo(int wv, unsigned char* ws_, const float* hin, float* hout, int layer_) {
    unsigned char* ws = uni(ws_); const int layer = uni(layer_); const Frame F = mkframe(ws, wv);
    SchedGrid S; S.init(64, 4, F.G, F.blk, ws + WS_MRG, (size_t)256 * DM * 2, (bf16_t*)(ws + WS_WO) + (size_t)layer * DM * DM, (size_t)256 * DM * 2);
    EpiResid E; E.In = uni(hin); E.Out = uni(hout); pg8::gemm_phase(F.lds, F.tid, DM, DM, DM, S, E);
}
PHASE g_ffn_gu(int wv, unsigned char* ws_) {
    unsigned char* ws = uni(ws_); const Frame F = mkframe(ws, wv);
    SchedGrid S; S.init(64, 22, F.G, F.blk, ws + WS_HN, (size_t)256 * DM * 2, ws + WS_FGU, (size_t)256 * DM * 2);
    EpiSwiglu E; E.O = (bf16_t*)(ws + WS_ACT); E.ldc = DFF; E.pn_off = 0; pg8::gemm_phase(F.lds, F.tid, DM, DM, DM, S, E);
}
PHASE g_ffn_down(int wv, unsigned char* ws_, float* h) {
    unsigned char* ws = uni(ws_); const Frame F = mkframe(ws, wv);
    SchedGrid S; S.init(64, 4, F.G, F.blk, ws + WS_ACT, (size_t)256 * DFF * 2, ws + WS_FD, (size_t)256 * DFF * 2);
    EpiResid E; E.In = uni(h); E.Out = E.In ? (float*)E.In : nullptr; pg8::gemm_phase(F.lds, F.tid, DFF, DFF, DFF, S, E);
}
PHASE g_moe_gu(int wv, unsigned char* ws_, int hh_) {
    unsigned char* ws = uni(ws_); const int hh = uni(hh_); const Frame F = mkframe(ws, wv); const LAS int* tab = (const LAS int*)(F.lds + LDS_TAB);
    SchedMoe S; S.G = F.G; S.c = F.blk; S.ncol = 14; S.ntile = tab[0]; S.tab = tab + 16; S.A = (const char*)(ws + WS_HS); S.astep = (size_t)256 * DM * 2;
    S.B = (const char*)(ws + WS_MGU) + (size_t)hh * 14 * 256 * DM * 2; S.bstep = (size_t)256 * DM * 2; S.estep = (size_t)2 * DFFE * DM * 2;
    EpiSwiglu E; E.O = (bf16_t*)(ws + WS_MACT); E.ldc = DFFH; E.pn_off = 0; pg8::gemm_phase(F.lds, F.tid, DM, DM, DM, S, E);
}
PHASE g_moe_down(int wv, unsigned char* ws_, float* h, int hh_) {
    unsigned char* ws = uni(ws_); const int hh = uni(hh_); const Frame F = mkframe(ws, wv); const LAS int* tab = (const LAS int*)(F.lds + LDS_TAB);
    const int* row_tok = (const int*)(ws + WS_TOK) + 6 * MTOK; const float* row_w = (const float*)(row_tok + MAXROWS);
    SchedMoe S; S.G = F.G; S.c = F.blk; S.ncol = 4; S.ntile = tab[0]; S.tab = tab + 16; S.A = (const char*)(ws + WS_MACT); S.astep = (size_t)256 * DFFH * 2;
    S.B = (const char*)(ws + WS_MD) + (size_t)hh * DFFH * 2; S.bstep = (size_t)256 * DFFE * 2; S.estep = (size_t)DM * DFFE * 2;
    EpiMoeDown E; E.row_tok = row_tok; E.row_w = row_w; E.H = uni(h); pg8::gemm_phase(F.lds, F.tid, DFFH, DFFH, DFFE, S, E);
}

typedef const __attribute__((address_space(4))) Params* KPtr;
__device__ __forceinline__ KPtr kargs() { KPtr k = (KPtr)__builtin_amdgcn_kernarg_segment_ptr(); asm volatile("" : "+s"(k)); return k; }
#define KIN(i) (kargs()->in[i])
#define KWS() (kargs()->ws)
__global__ void __launch_bounds__(NTHR, 2) mega(Params P_unused) {
    LAS unsigned char* lds = (LAS unsigned char*)lds_raw;
    const int wv = __builtin_amdgcn_readfirstlane((int)threadIdx.x >> 6);
    for (int u = threadIdx.x; u < (LDS_BYTES - LDSCTL_OFF) / 4; u += NTHR) ((LAS unsigned*)(lds + LDSCTL_OFF))[u] = 0u;
    __syncthreads();
    const XcdBarrier bar = xcd_barrier_post((unsigned*)(KWS() + WS_CTL) + CW_BAR, (volatile LAS unsigned*)(lds + LDSCTL_OFF), wv);
#define GRID_BAR() xcd_barrier(bar)
    {
        KPtr k = kargs(); unsigned char* ws = k->ws; const Frame F = mkframe(ws, wv);
        Params P; P.in[I_WIN] = k->in[I_WIN]; P.in[I_WQB] = k->in[I_WQB]; P.in[I_WBR] = k->in[I_WBR]; P.in[I_WO] = k->in[I_WO]; P.in[I_FG] = k->in[I_FG]; P.in[I_FU] = k->in[I_FU]; P.in[I_FD] = k->in[I_FD];
        P.in[I_W2] = k->in[I_W2]; P.in[I_A2] = k->in[I_A2]; P.in[I_G2] = k->in[I_G2]; P.in[I_WKVB] = k->in[I_WKVB]; P.in[I_POS] = k->in[I_POS];
        phase_prologue(F, P);
    }
    GRID_BAR();
#pragma unroll
    for (int layer = 0; layer < NLAYER; ++layer) {
        f_rms(wv, KWS(), layer == 0 ? KIN(I_X) : (const float*)kargs()->out, KIN(I_ANORM) + layer * DM);
        GRID_BAR();
        g_inproj(wv, KWS(), layer);
        GRID_BAR();
        f_prep(wv, KWS(), KIN(I_MU) + (size_t)layer * RWKV_COLS, KIN(I_QNORM) + layer * 256, KIN(I_KVNORM) + layer * 128, layer);
        GRID_BAR();
        f_ret_scan(wv, KWS());
        g_lora(wv, KWS(), KIN(I_W0) + layer * 512, KIN(I_A0) + layer * 512, layer);
        g_small(wv, KWS(), layer);
        GRID_BAR();
        f_ret_out(wv, KWS());
#ifndef RWKV_SEQ
        f_rwkv_pre(wv, KWS(), KIN(I_MU) + (size_t)layer * RWKV_COLS, KIN(I_KK) + layer * 512, KIN(I_KA) + layer * 512, KIN(I_RK) + layer * 512);
        GRID_BAR();
        if ((int)blockIdx.x < 16) f_rwkv_scan(wv, KWS(), KIN(I_MU) + (size_t)layer * RWKV_COLS, KIN(I_LNX) + layer * 512);
#else
        GRID_BAR();
        if (blockIdx.x < 16) f_rwkv_seq(wv, KWS(), KIN(I_MU) + (size_t)layer * RWKV_COLS, KIN(I_KK) + layer * 512, KIN(I_KA) + layer * 512, KIN(I_RK) + layer * 512, KIN(I_LNX) + layer * 512, layer);
#endif
        f_attn(wv, KWS());
        GRID_BAR();
        g_gate(wv, KWS(), layer);
        g_merge(wv, KWS(), layer);
        GRID_BAR();
        g_wo(wv, KWS(), layer == 0 ? KIN(I_X) : (const float*)kargs()->out, kargs()->out, layer);
        GRID_BAR();
        if (layer == 0) {
            f_rms(wv, KWS(), kargs()->out, KIN(I_FNORM) + layer * DM);
            GRID_BAR();
            g_ffn_gu(wv, KWS());
            GRID_BAR();
            g_ffn_down(wv, KWS(), kargs()->out);
            GRID_BAR();
        } else {
            f_rms_moe(wv, KWS(), kargs()->out, KIN(I_FNORM) + layer * DM, KIN(I_ROUTER));
            GRID_BAR();
            f_moe_scatter(wv, KWS());
            f_moe_convert(wv, KWS(), KIN(I_MG), KIN(I_MU2), KIN(I_MD));
            GRID_BAR();
#pragma unroll
            for (int hh = 0; hh < 2; ++hh) {
                g_moe_gu(wv, KWS(), hh);
                GRID_BAR();
                g_moe_down(wv, KWS(), kargs()->out, hh);
                GRID_BAR();
            }
        }
    }
    f_final(wv, KWS(), kargs()->out, KIN(I_FINAL));
}

extern "C" void kernel_launch(void* const* d_in, const int* in_sizes, int n_in, void* d_out, int out_size, void* d_ws, size_t ws_size, hipStream_t stream) {
    static int ready = 0;
    if (!ready) {
        if (n_in != 29 || out_size != MTOK * DM || ws_size < WS_END) { fprintf(stderr, "kernel_launch: unexpected shapes (n_in %d out %d ws %zu need %zu)\n", n_in, out_size, ws_size, (size_t)WS_END); ready = -1; return; }
        if (hipFuncSetAttribute((const void*)mega, hipFuncAttributeMaxDynamicSharedMemorySize, LDS_BYTES) != hipSuccess) { fprintf(stderr, "kernel_launch: hipFuncSetAttribute failed\n"); ready = -1; return; }
        int dev = 0, cus = 0, per_cu = 0; (void)hipGetDevice(&dev); (void)hipDeviceGetAttribute(&cus, hipDeviceAttributeMultiprocessorCount, dev);
        (void)hipOccupancyMaxActiveBlocksPerMultiprocessor(&per_cu, (const void*)mega, NTHR, LDS_BYTES);
        if (cus < 256 || per_cu < 1) { fprintf(stderr, "kernel_launch: needs 256 CUs with one resident workgroup each (cus %d, per_cu %d)\n", cus, per_cu); ready = -1; return; }
        ready = 1;
    }
    if (ready < 0) return;
    (void)hipMemsetAsync((char*)d_ws + WS_CTL, 0, CTL_BYTES, stream);
    Params p{}; for (int i = 0; i < 29; ++i) p.in[i] = (const float*)d_in[i]; p.out = (float*)d_out; p.ws = (unsigned char*)d_ws;
    hipLaunchKernelGGL(mega, dim3(256), dim3(NTHR), LDS_BYTES, stream, p);
}
```

```cpp
#include <hip/hip_runtime.h>
#include <cstdio>
#include <cstdint>

#define LAS __attribute__((address_space(3)))
#define GAS __attribute__((address_space(1)))
typedef unsigned short bf16_t;
typedef short bf16x8 __attribute__((ext_vector_type(8)));
typedef short bf16x4 __attribute__((ext_vector_type(4)));
typedef float f32x4 __attribute__((ext_vector_type(4)));
typedef float f32x2 __attribute__((ext_vector_type(2)));
typedef float f32x16 __attribute__((ext_vector_type(16)));
typedef unsigned u32x4 __attribute__((ext_vector_type(4)));
typedef unsigned u32x2 __attribute__((ext_vector_type(2)));

constexpr int NB = 2, SEQ = 8192, DM = 1024, MTOK = NB * SEQ, NLAYER = 2, CH = 64, NCHUNK = SEQ / CH;
constexpr int IN_COLS = 7360, PW = 4608;
constexpr int P_RQ = 0, P_RK = 512, P_RV = 1024, P_RG = 1536, P_RW = 2048, P_QA = 4096, P_KVA = 4352;
constexpr int WIN_ROWS = 7680;
constexpr int RWKV_COLS = 1824, LORA_K = 384, LO_W = 1536;
constexpr int DFF = 2816, DFFE = 3584, NEXP = 8, DFFH = DFFE / 2;
constexpr int MAXROWS = 34816;
constexpr float NORM_EPS = 1e-6f;

constexpr size_t MiB = 1u << 20;
constexpr size_t WS_CTL = 0, CTL_BYTES = 1 * MiB;
constexpr size_t WS_WIN = 1 * MiB;
constexpr size_t WS_LORA = 31 * MiB;
constexpr size_t WS_QB = 34 * MiB;
constexpr size_t WS_KB = 35 * MiB;
constexpr size_t WS_VB = 35 * MiB + 512 * 1024;
constexpr size_t WS_BR = 36 * MiB;
constexpr size_t WS_WO = 42 * MiB;
constexpr size_t WS_FGU = 46 * MiB;
constexpr size_t WS_FD = 57 * MiB;
constexpr size_t WS_COSR = 63 * MiB, WS_SINR = 67 * MiB, WS_COSM = 71 * MiB, WS_SINM = 72 * MiB;
constexpr size_t WS_HN = 73 * MiB;
constexpr size_t WS_TOK = 105 * MiB;
constexpr size_t WS_T = 106 * MiB;
constexpr size_t WS_P = WS_T;
constexpr size_t WS_G = WS_T;
constexpr size_t WS_MRG = WS_T + 96 * MiB;
constexpr size_t WS_LO = WS_T + 144 * MiB;
constexpr size_t WS_Q = WS_T + 192 * MiB;
constexpr size_t WS_KN = WS_T + 216 * MiB;
constexpr size_t WS_VT = WS_T + 232 * MiB;
constexpr size_t WS_KPE = WS_T + 248 * MiB;
constexpr size_t WS_LIN = WS_T + 249 * MiB;
constexpr size_t WS_QN = WS_T + 261 * MiB;
constexpr size_t WS_CN = WS_T + 269 * MiB;
constexpr size_t WS_YRET = WS_T + 261 * MiB;
constexpr size_t WS_RS = WS_T + 277 * MiB;
constexpr size_t WS_YRW = WS_T + 277 * MiB;
constexpr size_t WS_YMLA = WS_T + 293 * MiB;
constexpr size_t WS_RC = WS_T + 309 * MiB;
constexpr size_t WS_ACT = WS_T;
constexpr size_t WS_MGU = WS_T;
constexpr size_t WS_MD = WS_T + 112 * MiB;
constexpr size_t WS_MACT = WS_T + 168 * MiB;
constexpr size_t WS_OUT2 = WS_T + 287 * MiB;
constexpr size_t WS_END = WS_T + 390 * MiB;
static_assert(WS_MACT + (size_t)MAXROWS * DFFH * 2 <= WS_OUT2 && WS_OUT2 + (size_t)MAXROWS * DM * 2 <= WS_END, "ws map");
constexpr int CW_BAR = 4096;
constexpr int CW_ECNT = 16384;

__device__ __forceinline__ unsigned f2bf(float f) { unsigned u = __builtin_bit_cast(unsigned, f); return (u + 0x7fffu + ((u >> 16) & 1u)) >> 16; }
typedef __bf16 bf16n2 __attribute__((ext_vector_type(2)));
__device__ __forceinline__ unsigned pk2(float lo, float hi) { const f32x2 f = {lo, hi}; const bf16n2 v = __builtin_convertvector(f, bf16n2); return __builtin_bit_cast(unsigned, v); }
__device__ __forceinline__ float bf2f(unsigned short h) { return __builtin_bit_cast(float, (unsigned)h << 16); }
__device__ __forceinline__ float bflo(unsigned w) { return __builtin_bit_cast(float, w << 16); }
__device__ __forceinline__ float bfhi(unsigned w) { return __builtin_bit_cast(float, w & 0xffff0000u); }
template <int CTRL, int ROWMASK = 0xF>
__device__ __forceinline__ float dpp_add(float v) { const int t = __builtin_amdgcn_update_dpp(0, __builtin_bit_cast(int, v), CTRL, ROWMASK, 0xF, ROWMASK == 0xF); return v + __builtin_bit_cast(float, t); }
#ifdef NO_DPP
__device__ __forceinline__ float sum4(float v)  { v += __shfl_xor(v, 1); v += __shfl_xor(v, 2); return v; }
__device__ __forceinline__ float sum8(float v)  { v = sum4(v); v += __shfl_xor(v, 4); return v; }
__device__ __forceinline__ float sum16(float v) { v = sum8(v); v += __shfl_xor(v, 8); return v; }
__device__ __forceinline__ float wave_sum(float v) { v = sum16(v); v += __shfl_xor(v, 16); v += __shfl_xor(v, 32); return v; }
#else
__device__ __forceinline__ float sum4(float v)  { v = dpp_add<0xB1>(v); return dpp_add<0x4E>(v); }
__device__ __forceinline__ float sum8(float v)  { return dpp_add<0x141>(sum4(v)); }
__device__ __forceinline__ float sum16(float v) { return dpp_add<0x140>(sum8(v)); }
__device__ __forceinline__ float wave_sum(float v) {
    v = sum16(v); v = dpp_add<0x142, 0xA>(v); v = dpp_add<0x143, 0xC>(v);
    return __builtin_bit_cast(float, __builtin_amdgcn_readlane(__builtin_bit_cast(int, v), 63));
}
#endif
__device__ __forceinline__ float sigmoidf_(float x) { return 1.0f / (1.0f + __expf(-x)); }
#define LDS_WAIT() asm volatile("s_waitcnt lgkmcnt(0)" ::: "memory")
#define VM_WAIT() asm volatile("s_waitcnt vmcnt(0)" ::: "memory")

#define XB_TMO      128
#define XB_XCNT(j)  (256  + 64 * (j))
#define XB_XSUB(j)  (1280 + 64 * (j))
#define XB_XGEN(j)  (2304 + 64 * (j))
#define XB_TOP      3328
#define XB_TOPGEN   3392
#define XCD_BAR_WORDS 3456
#define XB_SPIN_CAP (1u << 18)
__device__ __forceinline__ unsigned xb_ld(unsigned* p)              { return __hip_atomic_load(p, __ATOMIC_RELAXED, __HIP_MEMORY_SCOPE_AGENT); }
__device__ __forceinline__ unsigned xb_add(unsigned* p, unsigned v) { return __hip_atomic_fetch_add(p, v, __ATOMIC_RELAXED, __HIP_MEMORY_SCOPE_AGENT); }
__device__ __forceinline__ unsigned xb_xcc_id() { return (unsigned)__builtin_amdgcn_s_getreg((3 << 11) | 20) & 0xFu; }
#define XB_SPIN(cond, bar) do { unsigned _sp = 0; while (cond) { __builtin_amdgcn_s_sleep(1); \
    if ((++_sp & 255u) == 0u) { if (xb_ld(&(bar)[XB_TMO])) break; if (_sp > XB_SPIN_CAP) { atomicAdd(&(bar)[XB_TMO], 1u); break; } } } } while (0)
struct XcdBarrier { unsigned* bar; unsigned x; volatile LAS unsigned* st; int wv; };
__device__ __forceinline__ int lane_id_fresh() { int l; asm volatile("v_mbcnt_lo_u32_b32 %0, -1, 0\n\tv_mbcnt_hi_u32_b32 %0, -1, %0" : "=v"(l)); return l; }
__device__ __forceinline__ bool xb_thread0(int wv) { return wv == 0 && lane_id_fresh() == 0; }
__device__ __forceinline__ XcdBarrier xcd_barrier_post(unsigned* bar, volatile LAS unsigned* st, int wv) {
    XcdBarrier b; b.bar = bar; b.x = xb_xcc_id(); b.st = st; b.wv = wv;
    if (xb_thread0(wv)) (void)xb_add(&bar[XB_XCNT(b.x)], 1u);
    return b;
}
__device__ __forceinline__ void xcd_barrier_complete(unsigned* bar, unsigned x, unsigned& nloc, unsigned& nx) {
    const unsigned G = gridDim.x * gridDim.y * gridDim.z;
    unsigned sum, cnt, mine, sp = 0u;
    for (;;) {
        sum = 0u; cnt = 0u; mine = 0u;
#pragma unroll
        for (unsigned j = 0; j < 16; ++j) { const unsigned c = xb_ld(&bar[XB_XCNT(j)]); sum += c; cnt += (c > 0u) ? 1u : 0u; mine = (j == x) ? c : mine; }
        if (sum == G) break;
        __builtin_amdgcn_s_sleep(1);
        if ((++sp & 255u) == 0u) { if (xb_ld(&bar[XB_TMO])) break; if (sp > XB_SPIN_CAP) { atomicAdd(&bar[XB_TMO], 1u); break; } }
    }
    nloc = mine > 0u ? mine : 1u; nx = cnt > 0u ? cnt : 1u;
}
__device__ __forceinline__ void xcd_barrier(const XcdBarrier& b) {
    asm volatile("s_waitcnt vmcnt(0)" ::: "memory");
    __syncthreads();
    if (xb_thread0(b.wv)) {
        unsigned* bar = b.bar;
        __builtin_amdgcn_s_waitcnt(0);
        unsigned nloc = b.st[0], nx = b.st[1];
        if (nloc == 0u) { xcd_barrier_complete(bar, b.x, nloc, nx); b.st[0] = nloc; b.st[1] = nx; }
        const unsigned old = xb_add(&bar[XB_XSUB(b.x)], 1u);
        const unsigned gen = old / nloc;
        if (old + 1u == (gen + 1u) * nloc) {
            __builtin_amdgcn_fence(__ATOMIC_RELEASE, "agent");
            asm volatile("s_waitcnt vmcnt(0)" ::: "memory");
            const unsigned og = xb_add(&bar[XB_TOP], 1u);
            const unsigned tg = og / nx;
            if (og + 1u == (tg + 1u) * nx) xb_add(&bar[XB_TOPGEN], 1u);
            else XB_SPIN(xb_ld(&bar[XB_TOPGEN]) == tg, bar);
            __builtin_amdgcn_fence(__ATOMIC_ACQUIRE, "agent");
            xb_add(&bar[XB_XGEN(b.x)], 1u);
            asm volatile("s_waitcnt vmcnt(0)" ::: "memory");
        } else {
            XB_SPIN(xb_ld(&bar[XB_XGEN(b.x)]) == gen, bar);
            __builtin_amdgcn_fence(__ATOMIC_ACQUIRE, "agent");
            asm volatile("s_waitcnt vmcnt(0)" ::: "memory");
        }
    }
    __syncthreads();
}

namespace pg8 {
constexpr int BM = 256, BK = 64, HALF = 128, HTB = HALF * BK * 2, STAGE_BYTES = 8 * HTB;
__device__ __forceinline__ int lds_byte(int r, int c) { const int st = (r >> 4) * 2 + (c >> 5), rr = r & 15, cc = c & 31, ob = rr * 64 + cc * 2; return st * 1024 + (ob ^ (((ob >> 9) & 1) << 5)); }
__device__ __forceinline__ void stage_rc(int b, int& R, int& C) { const int st = b / 1024, sb = b % 1024, swz = sb ^ (((sb >> 9) & 1) << 5); R = (st >> 1) * 16 + swz / 64; C = (st & 1) * 32 + (swz % 64) / 2; }
__device__ __forceinline__ int perm32(int rho) { const int n = rho >> 4, i = rho & 15; return 8 * (i >> 2) + 4 * n + (i & 3); }
struct Unit { int pm, pn, aux; const char* A; const char* B; };
__device__ __forceinline__ unsigned cvt_pk_bf16(float lo, float hi) { return pk2(lo, hi); }

template <class Epi, class Sched, bool GATHER = false>
__device__ __forceinline__ void gemm_phase(LAS unsigned char* lds, const int tid_in, const int K, const int lda, const int ldb, const Sched& S, const Epi& E, const LAS unsigned* gtab = nullptr) {
    int tid_ = tid_in; asm volatile("" : "+v"(tid_));
    const int tid = tid_, wid = __builtin_amdgcn_readfirstlane(tid >> 6), lane = tid & 63, wr = wid >> 2, wc = wid & 3, fr = lane & 15, fq = lane >> 4;
    const int nt = K / BK;
    unsigned voffA[2], voffB[2];
#pragma unroll
    for (int i = 0; i < 2; ++i) { int R, C; stage_rc(tid * 16 + i * 8192, R, C); const int Rb = Epi::PERM ? ((R & ~31) + perm32(R & 31)) : R;
        voffA[i] = (unsigned)(R * lda + C) * 2u; voffB[i] = (unsigned)(Rb * ldb + C) * 2u; }
    const size_t kstep = (size_t)(BK * 2);
    const size_t hstepA = GATHER ? (size_t)0 : (size_t)HALF * lda * 2, hstepB = (size_t)HALF * ldb * 2;
    int gR[2], gC[2]; unsigned gcur[2][2], gnxt[2][2];
    if constexpr (GATHER) {
#pragma unroll
        for (int i = 0; i < 2; ++i) { int R, C; stage_rc(tid * 16 + i * 8192, R, C); gR[i] = R; gC[i] = C * 2; }
    }
#define PG8_GLOAD(dst, u_) do { _Pragma("unroll") for (int _h = 0; _h < 2; ++_h) _Pragma("unroll") for (int _i = 0; _i < 2; ++_i) dst[_h][_i] = gtab[(u_) * 256 + _h * 128 + gR[_i]] + (unsigned)gC[_i]; } while (0)
    const unsigned ldsw = (unsigned)wid * 1024u;
    const int aoff = lds_byte(wr * 64 + fr, fq * 8), boff = lds_byte(wc * 32 + fr, fq * 8);
#define PG8_SA(b, h) (((b) * 2 + (h)) * HTB)
#define PG8_SB(b, h) ((4 + (b) * 2 + (h)) * HTB)
#define PG8_STAGE(bufoff, gbase, voff) do { _Pragma("unroll") for (int _i = 0; _i < 2; ++_i) \
        __builtin_amdgcn_global_load_lds((const unsigned*)((const char*)(gbase) + (voff)[_i]), (LAS unsigned*)(lds + (bufoff) + ldsw + _i * 8192), 16, 0, 0); } while (0)
#define PG8_STAGEA(bufoff, gbase, h, tab) do { if constexpr (GATHER) { PG8_STAGE(bufoff, gbase, tab[h]); } else { PG8_STAGE(bufoff, (gbase) + (h) * hstepA, voffA); } } while (0)
#define PG8_LDA(dst, b, h) do { _Pragma("unroll") for (int m = 0; m < 4; ++m) _Pragma("unroll") for (int k = 0; k < 2; ++k) dst[m][k] = *(const LAS bf16x8*)(lds + PG8_SA(b, h) + aoff + m * 2048 + k * 1024); } while (0)
#define PG8_LDB(dst, b, h) do { _Pragma("unroll") for (int n = 0; n < 2; ++n) _Pragma("unroll") for (int k = 0; k < 2; ++k) dst[n][k] = *(const LAS bf16x8*)(lds + PG8_SB(b, h) + boff + n * 2048 + k * 1024); } while (0)
#define PG8_MMA(ai, bj, At, Bt) do { __builtin_amdgcn_s_setprio(1); _Pragma("unroll") for (int m = 0; m < 4; ++m) _Pragma("unroll") for (int n = 0; n < 2; ++n) _Pragma("unroll") for (int k = 0; k < 2; ++k) \
        acc[ai][bj][m][n] = __builtin_amdgcn_mfma_f32_16x16x32_bf16(Bt[n][k], At[m][k], acc[ai][bj][m][n], 0, 0, 0); __builtin_amdgcn_s_setprio(0); } while (0)
#define PG8_WAIT_V(n) asm volatile("s_waitcnt vmcnt(" #n ")" ::: "memory")
#define PG8_WAIT_L(n) asm volatile("s_waitcnt lgkmcnt(" #n ")" ::: "memory")
#define PG8_BAR __builtin_amdgcn_s_barrier()
#define PG8_SCHED __builtin_amdgcn_sched_barrier(0)
    Unit cur, nxt; int ui = 0;
    if (!S.next(0, cur)) return;
    f32x4 acc[2][2][4][2];
#pragma unroll
    for (int a = 0; a < 2; ++a)
#pragma unroll
        for (int b = 0; b < 2; ++b)
#pragma unroll
            for (int m = 0; m < 4; ++m)
#pragma unroll
                for (int n = 0; n < 2; ++n) acc[a][b][m][n] = (f32x4){0.f, 0.f, 0.f, 0.f};
    bf16x8 At[4][2], B0[2][2], B1[2][2];
    const char* cA = cur.A; const char* cB = cur.B;
    if constexpr (GATHER) { PG8_GLOAD(gcur, 0); PG8_GLOAD(gnxt, 1); asm volatile("s_waitcnt lgkmcnt(0)" ::: "memory"); }
    PG8_STAGE(PG8_SB(0, 0), cB, voffB); PG8_STAGE(PG8_SB(0, 1), cB + hstepB, voffB); PG8_STAGEA(PG8_SA(0, 0), cA, 0, gcur); PG8_STAGEA(PG8_SA(0, 1), cA, 1, gcur);
    if (wr == 1) PG8_BAR;
    PG8_WAIT_V(2); PG8_BAR;
    PG8_STAGE(PG8_SB(1, 0), cB + kstep, voffB); PG8_STAGEA(PG8_SA(1, 0), cA + kstep, 0, gcur); PG8_STAGE(PG8_SB(1, 1), cB + hstepB + kstep, voffB);
    PG8_WAIT_V(6); PG8_BAR;
#pragma unroll 1
    for (;;) {
        const bool has_next = S.next(ui + 1, nxt);
        const char* nA = has_next ? nxt.A : cA; const char* nB = has_next ? nxt.B : cB;
#pragma unroll 1
        for (int t = 0; t < nt; t += 2) {
            const bool last = (t == nt - 2);
            const char* a1 = cA + (size_t)(t + 1) * kstep;
            const char* a2 = last ? nA : cA + (size_t)(t + 2) * kstep; const char* b2 = last ? nB : cB + (size_t)(t + 2) * kstep;
            const char* a3 = a2 + kstep; const char* b3 = b2 + kstep;
            unsigned g2[2][2];
            if constexpr (GATHER) {
#pragma unroll
                for (int _h = 0; _h < 2; ++_h)
#pragma unroll
                    for (int _i = 0; _i < 2; ++_i) g2[_h][_i] = last ? gnxt[_h][_i] : gcur[_h][_i]; }
            PG8_LDB(B0, 0, 0); PG8_LDB(B1, 0, 1); PG8_SCHED; PG8_LDA(At, 0, 0); PG8_STAGEA(PG8_SA(1, 1), a1, 1, gcur);
            PG8_WAIT_V(8); PG8_WAIT_L(0); PG8_BAR; PG8_MMA(0, 0, At, B0); PG8_MMA(0, 1, At, B1); PG8_BAR; PG8_SCHED;
            PG8_LDA(At, 0, 1); PG8_STAGE(PG8_SB(0, 0), b2, voffB); PG8_STAGE(PG8_SB(0, 1), b2 + hstepB, voffB); PG8_STAGEA(PG8_SA(0, 0), a2, 0, g2);
            PG8_WAIT_V(8); PG8_WAIT_L(0); PG8_BAR; PG8_MMA(1, 0, At, B0); PG8_MMA(1, 1, At, B1); PG8_BAR; PG8_SCHED;
            PG8_LDB(B0, 1, 0); PG8_LDB(B1, 1, 1); PG8_SCHED; PG8_LDA(At, 1, 0); PG8_STAGEA(PG8_SA(0, 1), a2, 1, g2);
            PG8_WAIT_V(8); PG8_WAIT_L(0); PG8_BAR; PG8_MMA(0, 0, At, B0); PG8_MMA(0, 1, At, B1); PG8_BAR; PG8_SCHED;
            PG8_LDA(At, 1, 1); PG8_STAGE(PG8_SB(1, 0), b3, voffB); PG8_STAGE(PG8_SB(1, 1), b3 + hstepB, voffB); PG8_STAGEA(PG8_SA(1, 0), a3, 0, g2);
            PG8_WAIT_V(8); PG8_WAIT_L(0); PG8_BAR; PG8_MMA(1, 0, At, B0); PG8_MMA(1, 1, At, B1); PG8_BAR; PG8_SCHED;
        }
        if (wr == 0) PG8_BAR;
        E(acc, cur, wr, wc, fr, fq);
        if (!has_next) break;
#pragma unroll
        for (int a = 0; a < 2; ++a)
#pragma unroll
            for (int b = 0; b < 2; ++b)
#pragma unroll
                for (int m = 0; m < 4; ++m)
#pragma unroll
                    for (int n = 0; n < 2; ++n) acc[a][b][m][n] = (f32x4){0.f, 0.f, 0.f, 0.f};
        cur = nxt; cA = nA; cB = nB; ++ui;
        if constexpr (GATHER) {
#pragma unroll
            for (int _h = 0; _h < 2; ++_h)
#pragma unroll
                for (int _i = 0; _i < 2; ++_i) gcur[_h][_i] = gnxt[_h][_i];
            PG8_GLOAD(gnxt, ui + 1); }
        if (wr == 1) PG8_BAR;
    }
    PG8_WAIT_V(0);
    PG8_BAR;
#undef PG8_SA
#undef PG8_SB
#undef PG8_STAGE
#undef PG8_STAGEA
#undef PG8_GLOAD
#undef PG8_LDA
#undef PG8_LDB
#undef PG8_MMA
#undef PG8_WAIT_V
#undef PG8_WAIT_L
#undef PG8_BAR
#undef PG8_SCHED
}
}
constexpr int NWAVES = 8, NTHR = 512;
constexpr int RING_BYTES = 131072, LDS_BYTES = 147456, LDSCTL_OFF = LDS_BYTES - 2048;
struct Params { const float* in[29]; float* out; unsigned char* ws; };
struct Frame {
    LAS unsigned char* lds; int tid, lane, wave, blk, G, vcu, gw, ngw; unsigned char* ws;
};
enum { I_X = 0, I_POS, I_ANORM, I_WIN, I_MU, I_W0, I_W2, I_A0, I_A2, I_G2, I_KK, I_KA, I_RK, I_LNX, I_QNORM, I_WQB, I_KVNORM, I_WKVB, I_WBR, I_WO, I_FNORM,
       I_FG, I_FU, I_FD, I_ROUTER, I_MG, I_MU2, I_MD, I_FINAL };

struct SchedGrid {
    int nM, nN, nwg, G, c; const char* A; const char* B; size_t astep, bstep;
    __device__ void init(int nM_, int nN_, int G_, int c_, const void* A_, size_t astep_, const void* B_, size_t bstep_) { nM = nM_; nN = nN_; nwg = nM * nN; G = G_; c = c_; A = (const char*)A_; B = (const char*)B_; astep = astep_; bstep = bstep_; }
    __device__ __forceinline__ bool next(int i, pg8::Unit& u) const {
        const long L = (long)i * G + c; if (L >= nwg) return false;
        int wgid = (int)L; { const int q = nwg / 8, r = nwg % 8, xcd = wgid % 8, off = wgid / 8; wgid = (xcd < r ? xcd * (q + 1) : r * (q + 1) + (xcd - r) * q) + off; }
        const int nig = 8 * nN, gid = wgid / nig, fm = gid * 8, gsz = (nM - fm) < 8 ? (nM - fm) : 8;
        u.pm = fm + ((wgid % nig) % gsz); u.pn = (wgid % nig) / gsz; u.aux = 0;
        u.A = A + (size_t)u.pm * astep; u.B = B + (size_t)u.pn * bstep; return true;
    }
};
struct SchedSmall {
    int G, c, layer; const char* ws;
    __device__ __forceinline__ bool next(int i, pg8::Unit& u) const {
        int L = i * G + c; if (L >= 448) return false;
        int s = 0; if (L >= 192) { L -= 192; s = 1; if (L >= 128) { L -= 128; s = 2; } }
        const int nn = s == 0 ? 3 : (s == 1 ? 2 : 64);
        u.pm = L / nn; u.pn = L % nn; u.aux = s;
        const size_t lw = (size_t)layer * 256 * 2;
        const size_t ao = s == 0 ? WS_QN : (s == 1 ? WS_CN : WS_VB + lw * 512), bo = s == 0 ? WS_QB + lw * 768 : (s == 1 ? WS_KB + lw * 512 : WS_CN);
        u.A = ws + ao + (size_t)u.pm * (256 * 256 * 2); u.B = ws + bo + (size_t)u.pn * (256 * 256 * 2); return true;
    }
};
struct SchedOwn3 {
    int c, G; const char* A; const char* B; size_t astep, bstep, a_n, b_n;
    __device__ __forceinline__ bool next(int i, pg8::Unit& u) const {
        const int t = c + (i / 3) * G; if (t >= 256) return false;
        const int n = i % 3; u.pm = t >> 2; u.pn = t & 3; u.aux = n; u.A = A + (size_t)u.pm * astep + (size_t)n * a_n; u.B = B + (size_t)u.pn * bstep + (size_t)n * b_n; return true;
    }
};
struct SchedMoe {
    int G, c, ncol, ntile; const LAS int* tab; const char* A; const char* B; size_t astep, bstep, estep;
    __device__ __forceinline__ bool next(int i, pg8::Unit& u) const {
        const int L = i * G + c; if (L >= ntile * ncol) return false;
        u.pm = L / ncol; u.pn = L % ncol; const int e = tab[u.pm]; u.aux = e;
        u.A = A + (size_t)u.pm * astep; u.B = B + (size_t)e * estep + (size_t)u.pn * bstep; return true;
    }
};

using pg8::Unit; using pg8::cvt_pk_bf16;
#define EPI_ARGS const f32x4 (&acc)[2][2][4][2], const Unit& u, int wr, int wc, int fr, int fq
struct EpiStore {
    static constexpr bool PERM = true;
    bf16_t* O; int ld;
    __device__ __forceinline__ void operator()(EPI_ARGS) const {
        const int row0 = u.pm * 256 + wr * 64 + fr, col0 = u.pn * 256 + wc * 32 + 8 * fq;
#pragma unroll
        for (int ai = 0; ai < 2; ++ai)
#pragma unroll
            for (int m = 0; m < 4; ++m) { bf16_t* rowp = O + (size_t)(row0 + ai * 128 + m * 16) * ld + col0;
#pragma unroll
                for (int bj = 0; bj < 2; ++bj) { const f32x4 v0 = acc[ai][bj][m][0], v1 = acc[ai][bj][m][1];
                    u32x4 w; w.x = cvt_pk_bf16(v0[0], v0[1]); w.y = cvt_pk_bf16(v0[2], v0[3]); w.z = cvt_pk_bf16(v1[0], v1[1]); w.w = cvt_pk_bf16(v1[2], v1[3]);
                    *(u32x4*)(rowp + bj * 128) = w; } }
    }
};
struct EpiSmall {
    static constexpr bool PERM = true;
    unsigned char* ws;
    __device__ __forceinline__ void operator()(EPI_ARGS) const {
        bf16_t* base = (bf16_t*)(ws + (u.aux == 0 ? WS_Q : (u.aux == 1 ? WS_KN : WS_VT))); const int ld = u.aux == 0 ? 768 : (u.aux == 1 ? 512 : MTOK);
        const int row0 = u.pm * 256 + wr * 64 + fr, col0 = u.pn * 256 + wc * 32 + 8 * fq;
#pragma unroll
        for (int ai = 0; ai < 2; ++ai)
#pragma unroll
            for (int m = 0; m < 4; ++m) { bf16_t* rowp = base + (size_t)(row0 + ai * 128 + m * 16) * ld + col0;
#pragma unroll
                for (int bj = 0; bj < 2; ++bj) { const f32x4 v0 = acc[ai][bj][m][0], v1 = acc[ai][bj][m][1];
                    u32x4 w; w.x = cvt_pk_bf16(v0[0], v0[1]); w.y = cvt_pk_bf16(v0[2], v0[3]); w.z = cvt_pk_bf16(v1[0], v1[1]); w.w = cvt_pk_bf16(v1[2], v1[3]);
                    *(u32x4*)(rowp + bj * 128) = w; } }
    }
};
struct EpiLora {
    static constexpr bool PERM = true;
    bf16_t* O; const float* w0; const float* a0;
    __device__ __forceinline__ void operator()(EPI_ARGS) const {
        const int seg = u.pn >> 1;
        const int row0 = u.pm * 256 + wr * 64 + fr, col0 = u.pn * 256 + wc * 32 + 8 * fq, ch0 = (u.pn & 1) * 256 + wc * 32 + 8 * fq;
        const float* bias = seg == 0 ? w0 : a0; const float sc = seg == 0 ? -0.6065306597126334f : 1.0f;
#pragma unroll
        for (int bj = 0; bj < 2; ++bj) {
            f32x4 b0 = {0.f, 0.f, 0.f, 0.f}, b1 = {0.f, 0.f, 0.f, 0.f};
            if (seg < 2) { b0 = *(const f32x4*)(bias + ch0 + bj * 128); b1 = *(const f32x4*)(bias + ch0 + bj * 128 + 4); }
#pragma unroll
            for (int ai = 0; ai < 2; ++ai)
#pragma unroll
                for (int m = 0; m < 4; ++m) { bf16_t* rowp = O + (size_t)(row0 + ai * 128 + m * 16) * LO_W + col0 + bj * 128;
                    f32x4 v0 = acc[ai][bj][m][0] + b0, v1 = acc[ai][bj][m][1] + b1;
                    if (seg < 2) {
#pragma unroll
                        for (int j = 0; j < 4; ++j) { v0[j] = sc * sigmoidf_(v0[j]); v1[j] = sc * sigmoidf_(v1[j]); }
                    }
                    u32x4 w; w.x = cvt_pk_bf16(v0[0], v0[1]); w.y = cvt_pk_bf16(v0[2], v0[3]); w.z = cvt_pk_bf16(v1[0], v1[1]); w.w = cvt_pk_bf16(v1[2], v1[3]);
                    *(u32x4*)rowp = w; }
        }
    }
};
struct EpiGate {
    static constexpr bool PERM = true;
    bf16_t* O;
    __device__ __forceinline__ void operator()(EPI_ARGS) const {
        const int row0 = u.pm * 256 + wr * 64 + fr, col0 = u.aux * 1024 + u.pn * 256 + wc * 32 + 8 * fq;
#pragma unroll
        for (int ai = 0; ai < 2; ++ai)
#pragma unroll
            for (int m = 0; m < 4; ++m) { bf16_t* rowp = O + (size_t)(row0 + ai * 128 + m * 16) * 3072 + col0;
#pragma unroll
                for (int bj = 0; bj < 2; ++bj) { f32x4 v0 = acc[ai][bj][m][0], v1 = acc[ai][bj][m][1];
#pragma unroll
                    for (int j = 0; j < 4; ++j) { v0[j] = sigmoidf_(v0[j]); v1[j] = sigmoidf_(v1[j]); }
                    u32x4 w; w.x = cvt_pk_bf16(v0[0], v0[1]); w.y = cvt_pk_bf16(v0[2], v0[3]); w.z = cvt_pk_bf16(v1[0], v1[1]); w.w = cvt_pk_bf16(v1[2], v1[3]);
                    *(u32x4*)(rowp + bj * 128) = w; } }
    }
};
struct EpiMerge {
    static constexpr bool PERM = true;
    const bf16_t* Gt; bf16_t* Mg;
    __device__ __forceinline__ void operator()(EPI_ARGS) const {
        const int n = u.aux;
        const int row0 = u.pm * 256 + wr * 64 + fr, col0 = u.pn * 256 + wc * 32 + 8 * fq;
#pragma unroll
        for (int ai = 0; ai < 2; ++ai)
#pragma unroll
            for (int m = 0; m < 4; ++m) { const size_t r = (size_t)(row0 + ai * 128 + m * 16);
#pragma unroll
                for (int bj = 0; bj < 2; ++bj) { const f32x4 v0 = acc[ai][bj][m][0], v1 = acc[ai][bj][m][1];
                    const u32x4 g = *(const u32x4*)(Gt + r * 3072 + n * 1024 + col0 + bj * 128);
                    float o[8] = {bflo(g.x) * v0[0], bfhi(g.x) * v0[1], bflo(g.y) * v0[2], bfhi(g.y) * v0[3], bflo(g.z) * v1[0], bfhi(g.z) * v1[1], bflo(g.w) * v1[2], bfhi(g.w) * v1[3]};
                    bf16_t* mp = Mg + r * 1024 + col0 + bj * 128;
                    if (n > 0) { const u32x4 p = *(const u32x4*)mp; o[0] += bflo(p.x); o[1] += bfhi(p.x); o[2] += bflo(p.y); o[3] += bfhi(p.y); o[4] += bflo(p.z); o[5] += bfhi(p.z); o[6] += bflo(p.w); o[7] += bfhi(p.w); }
                    u32x4 w; w.x = cvt_pk_bf16(o[0], o[1]); w.y = cvt_pk_bf16(o[2], o[3]); w.z = cvt_pk_bf16(o[4], o[5]); w.w = cvt_pk_bf16(o[6], o[7]);
                    *(u32x4*)mp = w; } }
    }
};
struct EpiResid {
    static constexpr bool PERM = false;
    const float* In; float* Out;
    __device__ __forceinline__ void operator()(EPI_ARGS) const {
        const int row0 = u.pm * 256 + wr * 64 + fr, col0 = u.pn * 256 + wc * 32 + 4 * fq;
#pragma unroll
        for (int ai = 0; ai < 2; ++ai)
#pragma unroll
            for (int m = 0; m < 4; ++m) { const size_t o = (size_t)(row0 + ai * 128 + m * 16) * DM + col0;
#pragma unroll
                for (int bj = 0; bj < 2; ++bj)
#pragma unroll
                    for (int n = 0; n < 2; ++n) { const f32x4 x = *(const f32x4*)(In + o + bj * 128 + n * 16); *(f32x4*)(Out + o + bj * 128 + n * 16) = x + acc[ai][bj][m][n]; } }
    }
};
struct EpiSwiglu {
    static constexpr bool PERM = true;
    bf16_t* O; int ldc; int pn_off;
    __device__ __forceinline__ void operator()(EPI_ARGS) const {
        const int row0 = u.pm * 256 + wr * 64 + fr, col0 = (u.pn - pn_off) * 128 + wc * 32 + 8 * fq;
#pragma unroll
        for (int ai = 0; ai < 2; ++ai)
#pragma unroll
            for (int m = 0; m < 4; ++m) { bf16_t* rowp = O + (size_t)(row0 + ai * 128 + m * 16) * ldc + col0;
                float o[8];
#pragma unroll
                for (int n = 0; n < 2; ++n)
#pragma unroll
                    for (int j = 0; j < 4; ++j) { const float g = acc[ai][0][m][n][j], up = acc[ai][1][m][n][j]; o[n * 4 + j] = g * sigmoidf_(g) * up; }
                u32x4 w; w.x = cvt_pk_bf16(o[0], o[1]); w.y = cvt_pk_bf16(o[2], o[3]); w.z = cvt_pk_bf16(o[4], o[5]); w.w = cvt_pk_bf16(o[6], o[7]);
                *(u32x4*)rowp = w; }
    }
};
template <bool ACCUM>
struct EpiMoeOut {
    static constexpr bool PERM = true;
    const float* row_w; bf16_t* O;
    __device__ __forceinline__ void operator()(EPI_ARGS) const {
        const int row0 = u.pm * 256 + wr * 64 + fr, col0 = u.pn * 256 + wc * 32 + 8 * fq;
#pragma unroll
        for (int ai = 0; ai < 2; ++ai)
#pragma unroll
            for (int m = 0; m < 4; ++m) { const int r = row0 + ai * 128 + m * 16; const float wt = row_w[r]; bf16_t* rowp = O + (size_t)r * DM + col0;
#pragma unroll
                for (int bj = 0; bj < 2; ++bj) { f32x4 v0 = acc[ai][bj][m][0] * wt, v1 = acc[ai][bj][m][1] * wt;
                    if (ACCUM) { const u32x4 p = *(const u32x4*)(rowp + bj * 128); v0[0] += bflo(p.x); v0[1] += bfhi(p.x); v0[2] += bflo(p.y); v0[3] += bfhi(p.y); v1[0] += bflo(p.z); v1[1] += bfhi(p.z); v1[2] += bflo(p.w); v1[3] += bfhi(p.w); }
                    u32x4 w; w.x = cvt_pk_bf16(v0[0], v0[1]); w.y = cvt_pk_bf16(v0[2], v0[3]); w.z = cvt_pk_bf16(v1[0], v1[1]); w.w = cvt_pk_bf16(v1[2], v1[3]);
                    *(u32x4*)(rowp + bj * 128) = w; } }
    }
};

__device__ __forceinline__ void transpose_tile64(const float* W, int ldn, int k0, int n0, bf16_t* WT, int ldk, int drow0, int drow1, int dk0, LAS float* scr, int lane) {
#ifdef SIMPLE_TR
    { const int c = lane & 7;
      for (int j = 0; j < 8; ++j) { const int n = (lane >> 3) + 8 * j; const float* s = W + (size_t)(k0 + 8 * c) * ldn + n0 + n;
        u32x4 o; o.x = pk2(s[0], s[(size_t)ldn]); o.y = pk2(s[(size_t)2 * ldn], s[(size_t)3 * ldn]); o.z = pk2(s[(size_t)4 * ldn], s[(size_t)5 * ldn]); o.w = pk2(s[(size_t)6 * ldn], s[(size_t)7 * ldn]);
        const int dr = n < 32 ? drow0 + n : drow1 + (n - 32);
        *(u32x4*)(WT + (size_t)dr * ldk + dk0 + k0 + 8 * c) = o; }
      return; }
#endif
    f32x4 v[16]; const int r4 = lane >> 4, c4 = (lane & 15) * 4;
#pragma unroll
    for (int i = 0; i < 16; ++i) v[i] = *(const f32x4*)(W + (size_t)(k0 + 4 * i + r4) * ldn + n0 + c4);
#pragma unroll
    for (int i = 0; i < 16; ++i) { LAS float* d = scr + (4 * i + r4) * 65 + c4; d[0] = v[i][0]; d[1] = v[i][1]; d[2] = v[i][2]; d[3] = v[i][3]; }
    LDS_WAIT(); asm volatile("" ::: "memory");
    const int c = lane & 7;
#pragma unroll
    for (int j = 0; j < 8; ++j) { const int n = (lane >> 3) + 8 * j; const LAS float* s = scr + (8 * c) * 65 + n;
        u32x4 o; o.x = pk2(s[0 * 65], s[1 * 65]); o.y = pk2(s[2 * 65], s[3 * 65]); o.z = pk2(s[4 * 65], s[5 * 65]); o.w = pk2(s[6 * 65], s[7 * 65]);
        const int dr = n < 32 ? drow0 + n : drow1 + (n - 32);
        *(u32x4*)(WT + (size_t)dr * ldk + dk0 + k0 + 8 * c) = o; }
    LDS_WAIT(); asm volatile("" ::: "memory");
}
__device__ __forceinline__ void conv_plain(const float* W, int K, int N, bf16_t* WT, int ldk, int item, LAS float* scr, int lane) {
    const int nblk = N / 64, kb = item / nblk, nb = item % nblk;
    transpose_tile64(W, N, kb * 64, nb * 64, WT, ldk, nb * 64, nb * 64 + 32, 0, scr, lane);
}
__device__ __forceinline__ int win_drow(int n0) { return n0 < 3872 ? n0 : (n0 < 4128 ? 4096 + (n0 - 3872) : (n0 < 4288 ? 4352 + (n0 - 4128) : 4608 + (n0 - 4288))); }
__device__ __forceinline__ int gu_drow(int n0, int up) { return (n0 >> 7) * 256 + (n0 & 127) + up * 128; }

__device__ __forceinline__ void phase_prologue(const Frame& F, const Params& P) {
    LAS float* scr = (LAS float*)(F.lds + F.wave * 16640);
    unsigned char* ws = F.ws;
    constexpr int I_IN = 16 * 115, I_QB = 4 * 12, I_BRn = 8 * 16, I_WOn = 16 * 16, I_G = 16 * 44, I_D = 44 * 16;
    constexpr int NIT = NLAYER * (I_IN + I_QB + 3 * I_BRn + I_WOn) + 2 * I_G + I_D;
    for (int it = F.gw; it < NIT; it += F.ngw) {
        int r = it;
        if (r < NLAYER * I_IN) { const int l = r / I_IN; r %= I_IN; const int kb = r / 115, nb = r % 115;
            transpose_tile64(P.in[I_WIN] + (size_t)l * DM * IN_COLS, IN_COLS, kb * 64, nb * 64, (bf16_t*)(ws + WS_WIN) + (size_t)l * WIN_ROWS * DM, DM, win_drow(nb * 64), win_drow(nb * 64 + 32), 0, scr, F.lane); continue; }
        r -= NLAYER * I_IN;
        if (r < NLAYER * I_QB) { const int l = r / I_QB; r %= I_QB; conv_plain(P.in[I_WQB] + (size_t)l * 256 * 768, 256, 768, (bf16_t*)(ws + WS_QB) + (size_t)l * 768 * 256, 256, r, scr, F.lane); continue; }
        r -= NLAYER * I_QB;
        if (r < NLAYER * 3 * I_BRn) { const int ln = r / I_BRn; r %= I_BRn; conv_plain(P.in[I_WBR] + (size_t)ln * 512 * 1024, 512, 1024, (bf16_t*)(ws + WS_BR) + (size_t)ln * 1024 * 512, 512, r, scr, F.lane); continue; }
        r -= NLAYER * 3 * I_BRn;
        if (r < NLAYER * I_WOn) { const int l = r / I_WOn; r %= I_WOn; conv_plain(P.in[I_WO] + (size_t)l * DM * DM, DM, DM, (bf16_t*)(ws + WS_WO) + (size_t)l * DM * DM, DM, r, scr, F.lane); continue; }
        r -= NLAYER * I_WOn;
        if (r < 2 * I_G) { const int up = r / I_G; r %= I_G; const int kb = r / 44, nb = r % 44;
            transpose_tile64(P.in[up ? I_FU : I_FG], DFF, kb * 64, nb * 64, (bf16_t*)(ws + WS_FGU), DM, gu_drow(nb * 64, up), gu_drow(nb * 64 + 32, up), 0, scr, F.lane); continue; }
        r -= 2 * I_G;
        conv_plain(P.in[I_FD], DFF, DM, (bf16_t*)(ws + WS_FD), DFF, r, scr, F.lane);
    }
    const int gt = F.blk * NTHR + F.tid, ngt = F.G * NTHR;
    for (int i = gt; i < NLAYER * 1536 * 384; i += ngt) { const int l = i / (1536 * 384), r = i % (1536 * 384), n = r / 384, k = r % 384; const int seg = n >> 9, c = n & 511; float v = 0.f;
        if (seg == 0 && k < 64) v = P.in[I_W2][((size_t)l * 64 + k) * 512 + c];
        else if (seg == 1 && k >= 64 && k < 128) v = P.in[I_A2][((size_t)l * 64 + (k - 64)) * 512 + c];
        else if (seg == 2 && k >= 128 && k < 288) v = P.in[I_G2][((size_t)l * 160 + (k - 128)) * 512 + c];
        ((bf16_t*)(ws + WS_LORA))[i] = (bf16_t)f2bf(v); }
    for (int i = gt; i < NLAYER * 512 * 256; i += ngt) { const int l = i / (512 * 256), r = i % (512 * 256), n = r / 256, k = r % 256; const int h = n >> 6, d = n & 63;
        float vk = 0.f, vv = 0.f; if (k < 128) { const float* w = P.in[I_WKVB] + ((size_t)l * 128 + k) * 1024 + h * 128; vk = w[d]; vv = w[64 + d]; }
        ((bf16_t*)(ws + WS_KB))[i] = (bf16_t)f2bf(vk); ((bf16_t*)(ws + WS_VB))[i] = (bf16_t)f2bf(vv); }
    for (int i = gt; i < MTOK * 80; i += ngt) { const int m = i / 80, j = i % 80; const int isr = j < 64; const int idx = isr ? j : j - 64; const double dim = isr ? 128.0 : 32.0;
        const float inv = (float)(1.0 / pow(10000.0, (2.0 * idx) / dim)); const float ang = (float)((const int*)P.in[I_POS])[m] * inv;
        const double a = (double)ang, q = rint(a * 0.15915494309189535), rr = a - q * 6.283185307179586476925;
        const float rf = (float)rr; const float cs = __cosf(rf), sn = __sinf(rf);
        if (isr) { ((float*)(ws + WS_COSR))[(size_t)m * 64 + idx] = cs; ((float*)(ws + WS_SINR))[(size_t)m * 64 + idx] = sn; }
        else { ((float*)(ws + WS_COSM))[(size_t)m * 16 + idx] = cs; ((float*)(ws + WS_SINM))[(size_t)m * 16 + idx] = sn; } }
}
__device__ __forceinline__ void phase_moe_convert(const Frame& F, const Params& P) {
    LAS float* scr = (LAS float*)(F.lds + F.wave * 16640);
    constexpr int I_G = 16 * 56, I_D = 56 * 16;
    constexpr int NIT = NEXP * (2 * I_G + I_D);
    for (int it = F.gw; it < NIT; it += F.ngw) {
        const int e = it / (2 * I_G + I_D); int r = it % (2 * I_G + I_D);
        if (r < 2 * I_G) { const int up = r / I_G; r %= I_G; const int kb = r / 56, nb = r % 56;
            transpose_tile64(P.in[up ? I_MU2 : I_MG] + (size_t)e * DM * DFFE, DFFE, kb * 64, nb * 64, (bf16_t*)(F.ws + WS_MGU) + (size_t)e * 2 * DFFE * DM, DM, gu_drow(nb * 64, up), gu_drow(nb * 64 + 32, up), 0, scr, F.lane); continue; }
        r -= 2 * I_G;
        conv_plain(P.in[I_MD] + (size_t)e * DFFE * DM, DFFE, DM, (bf16_t*)(F.ws + WS_MD) + (size_t)e * DM * DFFE, DFFE, r, scr, F.lane);
    }
}

template <bool MOE>
__device__ __forceinline__ void phase_rms(const Frame& F, const float* src, const float* gain, bf16_t* hn, const float* router, unsigned* ectl, int* tok_e, int* tok_slot, float* tok_w) {
    LAS int* lcnt = (LAS int*)(F.lds);
    if (MOE) { if (F.tid < 16) lcnt[F.tid] = 0; __syncthreads(); }
    int my_e0 = 0, my_e1 = 0, my_s0 = 0, my_s1 = 0; float my_w0 = 0.f, my_w1 = 0.f;
    for (int i = 0; i < 8; ++i) {
        const int m = F.blk * 64 + F.wave * 8 + i;
        const f32x4* xr = (const f32x4*)(src + (size_t)m * DM) + F.lane;
        f32x4 v[4]; float s = 0.f;
#pragma unroll
        for (int j = 0; j < 4; ++j) { v[j] = xr[64 * j]; s += (v[j].x * v[j].x + v[j].y * v[j].y) + (v[j].z * v[j].z + v[j].w * v[j].w); }
        const float rstd = rsqrtf(wave_sum(s) * (1.0f / DM) + NORM_EPS);
#pragma unroll
        for (int j = 0; j < 4; ++j) { const f32x4 g = ((const f32x4*)gain)[F.lane + 64 * j]; v[j] = v[j] * rstd * g; }
        u32x2* o8 = (u32x2*)(hn + (size_t)m * DM) + F.lane;
#pragma unroll
        for (int j = 0; j < 4; ++j) { u32x2 w; w.x = pk2(v[j].x, v[j].y); w.y = pk2(v[j].z, v[j].w); o8[64 * j] = w; }
        if (MOE) {
            float lg[8];
#pragma unroll
            for (int e = 0; e < 8; ++e) lg[e] = 0.f;
#pragma unroll
            for (int j = 0; j < 4; ++j)
#pragma unroll
                for (int q = 0; q < 4; ++q) { const int c = 4 * F.lane + 256 * j + q; const f32x4 r0 = *(const f32x4*)(router + (size_t)c * 8), r1 = *(const f32x4*)(router + (size_t)c * 8 + 4); const float x = v[j][q];
                    lg[0] += x * r0.x; lg[1] += x * r0.y; lg[2] += x * r0.z; lg[3] += x * r0.w; lg[4] += x * r1.x; lg[5] += x * r1.y; lg[6] += x * r1.z; lg[7] += x * r1.w; }
#pragma unroll
            for (int e = 0; e < 8; ++e) lg[e] = wave_sum(lg[e]);
            int e0 = 0; float b0 = lg[0];
#pragma unroll
            for (int e = 1; e < 8; ++e) if (lg[e] > b0) { b0 = lg[e]; e0 = e; }
            int e1 = -1; float b1 = -3.0e38f;
#pragma unroll
            for (int e = 0; e < 8; ++e) if (e != e0 && lg[e] > b1) { b1 = lg[e]; e1 = e; }
            const float t = __expf(b1 - b0), w0 = 1.0f / (1.0f + t), w1 = t / (1.0f + t);
            int s0 = 0, s1 = 0;
            if (F.lane == 0) { s0 = atomicAdd((int*)&lcnt[e0], 1); s1 = atomicAdd((int*)&lcnt[e1], 1); }
            s0 = __shfl(s0, 0); s1 = __shfl(s1, 0);
            if (F.lane == i) { my_e0 = e0; my_e1 = e1; my_s0 = s0; my_s1 = s1; my_w0 = w0; my_w1 = w1; }
        }
    }
    if (MOE) {
        __syncthreads();
        if (F.tid < 8) lcnt[8 + F.tid] = (int)atomicAdd(&ectl[F.tid], (unsigned)lcnt[F.tid]);
        __syncthreads();
        if (F.lane < 8) { const int m = F.blk * 64 + F.wave * 8 + F.lane;
            tok_e[2 * m] = my_e0; tok_e[2 * m + 1] = my_e1; tok_slot[2 * m] = lcnt[8 + my_e0] + my_s0; tok_slot[2 * m + 1] = lcnt[8 + my_e1] + my_s1; tok_w[2 * m] = my_w0; tok_w[2 * m + 1] = my_w1; }
        __syncthreads();
    }
}
__device__ __forceinline__ void phase_final(const Frame& F, float* h, const float* gain, const bf16_t* out2, const int* tok_pos) {
    for (int m = F.gw; m < MTOK; m += F.ngw) {
        f32x4* xr = (f32x4*)(h + (size_t)m * DM) + F.lane;
        const int p0 = tok_pos[2 * m], p1 = tok_pos[2 * m + 1];
        const u32x2* o0 = (const u32x2*)(out2 + (size_t)p0 * DM) + F.lane; const u32x2* o1 = (const u32x2*)(out2 + (size_t)p1 * DM) + F.lane;
        f32x4 v[4]; float s = 0.f;
#pragma unroll
        for (int j = 0; j < 4; ++j) { v[j] = xr[64 * j]; const u32x2 a = o0[64 * j], b = o1[64 * j];
#ifndef NO_MOE_ADD
            v[j].x += bflo(a.x) + bflo(b.x); v[j].y += bfhi(a.x) + bfhi(b.x); v[j].z += bflo(a.y) + bflo(b.y); v[j].w += bfhi(a.y) + bfhi(b.y);
#endif
            s += (v[j].x * v[j].x + v[j].y * v[j].y) + (v[j].z * v[j].z + v[j].w * v[j].w); }
        const float rstd = rsqrtf(wave_sum(s) * (1.0f / DM) + NORM_EPS);
#pragma unroll
        for (int j = 0; j < 4; ++j) { const f32x4 g = ((const f32x4*)gain)[F.lane + 64 * j]; xr[64 * j] = v[j] * rstd * g; }
    }
}
template <int KS>
__device__ __forceinline__ f32x4 mm_tile(const LAS bf16_t* P, int ldp, const LAS bf16_t* Q, int ldq, int ib, int jb, int lane, f32x4 acc) {
    const LAS bf16_t* pp = P + (ib * 16 + (lane & 15)) * ldp + 8 * (lane >> 4);
    const LAS bf16_t* qp = Q + (jb * 16 + (lane & 15)) * ldq + 8 * (lane >> 4);
#pragma unroll
    for (int ks = 0; ks < KS; ++ks) { const bf16x8 a = *(const LAS bf16x8*)(qp + ks * 32), b = *(const LAS bf16x8*)(pp + ks * 32); acc = __builtin_amdgcn_mfma_f32_16x16x32_bf16(a, b, acc, 0, 0, 0); }
    return acc;
}
__device__ __forceinline__ void st_bf4(LAS bf16_t* p, f32x4 v) { u32x2 w; w.x = pk2(v[0], v[1]); w.y = pk2(v[2], v[3]); *(LAS u32x2*)p = w; }
__device__ __forceinline__ float ret_lg(int h) { return __logf(1.0f - exp2f(-5.0f - (float)h)); }

__device__ __forceinline__ void phase_prep(const Frame& F, const Params& P, int layer) {
    unsigned char* ws = F.ws;
    const bf16_t* p = (const bf16_t*)(ws + WS_P);
    const float* mu = P.in[I_MU] + (size_t)layer * RWKV_COLS;
    for (int m = F.gw; m < MTOK; m += F.ngw) {
        const bf16_t* pr = p + (size_t)m * PW; const bool has_prev = (m % SEQ) != 0; const bf16_t* pp = pr - PW;
        bf16_t* lin = (bf16_t*)(ws + WS_LIN) + (size_t)m * LORA_K;
#pragma unroll
        for (int jj = 0; jj < 6; ++jj) { const int c = F.lane + 64 * jj; float o = 0.f;
            if (c < 288) { const int off = 1536 + c; const float x = bf2f(pr[P_RW + off]), xp = has_prev ? bf2f(pp[P_RW + off]) : 0.f; const float xs = x + (xp - x) * mu[off];
                o = c < 64 ? tanhf(xs) : (c < 128 ? xs : sigmoidf_(xs)); }
            lin[c] = (bf16_t)f2bf(o); }
        {
            const u32x2 w = *(const u32x2*)(pr + P_QA + 4 * F.lane); float x[4] = {bflo(w.x), bfhi(w.x), bflo(w.y), bfhi(w.y)};
            const float ss = wave_sum(x[0] * x[0] + x[1] * x[1] + x[2] * x[2] + x[3] * x[3]); const float rs = rsqrtf(ss * (1.0f / 256.0f) + NORM_EPS);
            const f32x4 g = *(const f32x4*)(P.in[I_QNORM] + layer * 256 + 4 * F.lane);
            u32x2 o; o.x = pk2(x[0] * rs * g.x, x[1] * rs * g.y); o.y = pk2(x[2] * rs * g.z, x[3] * rs * g.w); *(u32x2*)((bf16_t*)(ws + WS_QN) + (size_t)m * 256 + 4 * F.lane) = o; }
        {
            const unsigned w = *(const unsigned*)(pr + P_KVA + 2 * F.lane); float x0 = bflo(w), x1 = bfhi(w);
            const float ss = wave_sum(x0 * x0 + x1 * x1); const float rs = rsqrtf(ss * (1.0f / 128.0f) + NORM_EPS);
            const f32x2 g = *(const f32x2*)(P.in[I_KVNORM] + layer * 128 + 2 * F.lane);
            unsigned* cn = (unsigned*)((bf16_t*)(ws + WS_CN) + (size_t)m * 256); cn[F.lane] = pk2(x0 * rs * g.x, x1 * rs * g.y); cn[64 + F.lane] = 0u; }
        if (F.lane < 16) {
            const float x1 = bf2f(pr[P_KVA + 128 + F.lane]), x2 = bf2f(pr[P_KVA + 144 + F.lane]);
            const float c = ((const float*)(ws + WS_COSM))[(size_t)m * 16 + F.lane], s = ((const float*)(ws + WS_SINM))[(size_t)m * 16 + F.lane];
            bf16_t* kp = (bf16_t*)(ws + WS_KPE) + (size_t)m * 32; kp[F.lane] = (bf16_t)f2bf(x1 * c - x2 * s); kp[16 + F.lane] = (bf16_t)f2bf(x1 * s + x2 * c); }
    }
    LAS bf16_t* kT = (LAS bf16_t*)F.lds;
    LAS bf16_t* vT = kT + 128 * 72;
    const int pc = F.tid & 7, j = F.tid >> 3;
    for (int u = F.blk; u < NB * NCHUNK * 4; u += F.G) {
        const int h = u & 3, n = (u >> 2) & 127, b = u >> 9; const int m = b * SEQ + n * 64 + j;
        const float lg = ret_lg(h);
        __syncthreads();
        {
            const bf16_t* kr = p + (size_t)m * PW + P_RK + h * 128 + pc * 8;
            const u32x4 a = *(const u32x4*)kr, bq = *(const u32x4*)(kr + 64);
            const float* cp = (const float*)(ws + WS_COSR) + (size_t)m * 64 + pc * 8; const float* sp = (const float*)(ws + WS_SINR) + (size_t)m * 64 + pc * 8;
            const float sc = 0.08838834764831845f * __expf(lg * (float)(63 - j));
            const unsigned aw[4] = {a.x, a.y, a.z, a.w}, bw[4] = {bq.x, bq.y, bq.z, bq.w};
#pragma unroll
            for (int i = 0; i < 8; ++i) { const float x1 = (i & 1) ? bfhi(aw[i >> 1]) : bflo(aw[i >> 1]), x2 = (i & 1) ? bfhi(bw[i >> 1]) : bflo(bw[i >> 1]); const float c = cp[i], s = sp[i];
                kT[(pc * 8 + i) * 72 + j] = (bf16_t)f2bf((x1 * c - x2 * s) * sc); kT[(64 + pc * 8 + i) * 72 + j] = (bf16_t)f2bf((x1 * s + x2 * c) * sc); }
            const bf16_t* vr = p + (size_t)m * PW + P_RV + h * 128 + pc * 8;
            const u32x4 va = *(const u32x4*)vr, vb = *(const u32x4*)(vr + 64);
            const unsigned vaw[4] = {va.x, va.y, va.z, va.w}, vbw[4] = {vb.x, vb.y, vb.z, vb.w};
#pragma unroll
            for (int i = 0; i < 8; ++i) { vT[(pc * 8 + i) * 72 + j] = (bf16_t)((i & 1) ? (vaw[i >> 1] >> 16) : (vaw[i >> 1] & 0xffffu)); vT[(64 + pc * 8 + i) * 72 + j] = (bf16_t)((i & 1) ? (vbw[i >> 1] >> 16) : (vbw[i >> 1] & 0xffffu)); }
        }
        __syncthreads();
        bf16_t* out = (bf16_t*)(ws + WS_RS) + (size_t)u * 16384;
#pragma unroll
        for (int jb = 0; jb < 8; ++jb) { f32x4 acc = {0.f, 0.f, 0.f, 0.f}; acc = mm_tile<2>(vT, 72, kT, 72, F.wave, jb, F.lane, acc);
            const int e = F.wave * 16 + (F.lane & 15), d = jb * 16 + 4 * (F.lane >> 4);
            u32x2 w; w.x = pk2(acc[0], acc[1]); w.y = pk2(acc[2], acc[3]); *(u32x2*)(out + e * 128 + d) = w; }
    }
    __syncthreads();
}

__device__ __forceinline__ void ret_scan(const Frame& F) {
    bf16_t* rs = (bf16_t*)(F.ws + WS_RS);
    for (int idx = F.blk * NTHR + F.tid; idx < NB * 4 * 16384; idx += F.G * NTHR) {
        const int b = idx >> 16, h = (idx >> 14) & 3, ed = idx & 16383; const float cd = __expf(ret_lg(h) * 64.0f);
        bf16_t* base = rs + ((size_t)(b * 128) * 4 + h) * 16384 + ed; float s = 0.f;
        for (int n0 = 0; n0 < NCHUNK; n0 += 8) { float t[8];
#pragma unroll
            for (int i = 0; i < 8; ++i) t[i] = bf2f(base[(size_t)(n0 + i) * 65536]);
#pragma unroll
            for (int i = 0; i < 8; ++i) { base[(size_t)(n0 + i) * 65536] = (bf16_t)f2bf(s); s = s * cd + t[i]; } }
    }
}

__device__ __forceinline__ void ret_out(const Frame& F) {
    unsigned char* ws = F.ws; const bf16_t* p = (const bf16_t*)(ws + WS_P);
    LAS bf16_t* q = (LAS bf16_t*)F.lds;
    LAS bf16_t* k = q + 64 * 136;
    LAS bf16_t* vT = k + 64 * 136;
    LAS bf16_t* pT = vT + 128 * 72;
    LAS bf16_t* sc = pT + 128 * 136;
    LAS float* st = (LAS float*)(sc + 64 * 72);
    const int pc = F.tid & 7, j = F.tid >> 3;
    for (int u = F.blk; u < NB * NCHUNK * 4; u += F.G) {
        const int h = u & 3, n = (u >> 2) & 127, b = u >> 9; const int m0 = b * SEQ + n * 64, m = m0 + j;
        const float lg = ret_lg(h);
        __syncthreads();
        {
            const float* cp = (const float*)(ws + WS_COSR) + (size_t)m * 64 + pc * 8; const float* sp = (const float*)(ws + WS_SINR) + (size_t)m * 64 + pc * 8;
            float cs[8], sn[8];
#pragma unroll
            for (int i = 0; i < 8; ++i) { cs[i] = cp[i]; sn[i] = sp[i]; }
#pragma unroll
            for (int which = 0; which < 2; ++which) {
                const bf16_t* r = p + (size_t)m * PW + (which ? P_RK : P_RQ) + h * 128 + pc * 8;
                const u32x4 a = *(const u32x4*)r, bq = *(const u32x4*)(r + 64);
                const unsigned aw[4] = {a.x, a.y, a.z, a.w}, bw[4] = {bq.x, bq.y, bq.z, bq.w}; const float sc_ = which ? 0.08838834764831845f : 1.0f;
                float o1[8], o2[8];
#pragma unroll
                for (int i = 0; i < 8; ++i) { const float x1 = (i & 1) ? bfhi(aw[i >> 1]) : bflo(aw[i >> 1]), x2 = (i & 1) ? bfhi(bw[i >> 1]) : bflo(bw[i >> 1]); o1[i] = (x1 * cs[i] - x2 * sn[i]) * sc_; o2[i] = (x1 * sn[i] + x2 * cs[i]) * sc_; }
                LAS bf16_t* dst = (which ? k : q) + j * 136 + pc * 8;
                u32x4 w1, w2; w1.x = pk2(o1[0], o1[1]); w1.y = pk2(o1[2], o1[3]); w1.z = pk2(o1[4], o1[5]); w1.w = pk2(o1[6], o1[7]); w2.x = pk2(o2[0], o2[1]); w2.y = pk2(o2[2], o2[3]); w2.z = pk2(o2[4], o2[5]); w2.w = pk2(o2[6], o2[7]);
                *(LAS u32x4*)dst = w1; *(LAS u32x4*)(dst + 64) = w2; }
            const bf16_t* vr = p + (size_t)m * PW + P_RV + h * 128 + pc * 8;
            const u32x4 va = *(const u32x4*)vr, vb = *(const u32x4*)(vr + 64);
            const unsigned vaw[4] = {va.x, va.y, va.z, va.w}, vbw[4] = {vb.x, vb.y, vb.z, vb.w};
#pragma unroll
            for (int i = 0; i < 8; ++i) { vT[(pc * 8 + i) * 72 + j] = (bf16_t)((i & 1) ? (vaw[i >> 1] >> 16) : (vaw[i >> 1] & 0xffffu)); vT[(64 + pc * 8 + i) * 72 + j] = (bf16_t)((i & 1) ? (vbw[i >> 1] >> 16) : (vbw[i >> 1] & 0xffffu)); }
            const bf16_t* ps = (const bf16_t*)(ws + WS_RS) + (size_t)u * 16384;
#pragma unroll
            for (int i = 0; i < 4; ++i) { const int pi = F.tid + i * 512; const int e = pi >> 4, c = pi & 15; *(LAS u32x4*)(pT + e * 136 + c * 8) = *(const u32x4*)(ps + e * 128 + c * 8); }
        }
        __syncthreads();
        {
            const int ib = F.wave & 3;
#pragma unroll
            for (int t = 0; t < 2; ++t) { const int jb = 2 * (F.wave >> 2) + t; f32x4 acc = {0.f, 0.f, 0.f, 0.f}; acc = mm_tile<4>(q, 136, k, 136, ib, jb, F.lane, acc);
                const int i = ib * 16 + (F.lane & 15), j0 = jb * 16 + 4 * (F.lane >> 4);
#pragma unroll
                for (int r = 0; r < 4; ++r) { const int dd = i - (j0 + r); acc[r] *= __expf(lg * (float)(dd < 0 ? -dd : dd)); }
                st_bf4(sc + i * 72 + j0, acc); }
        }
        __syncthreads();
        {
            const int ib = F.wave & 3, eh = F.wave >> 2; const int i = ib * 16 + (F.lane & 15);
            const float qd = __expf(lg * (float)(i + 1));
            f32x4 o[4]; float s1 = 0.f, s2 = 0.f;
#pragma unroll
            for (int t = 0; t < 4; ++t) { const int eb = eh * 4 + t; f32x4 ai = {0.f, 0.f, 0.f, 0.f}, ac = {0.f, 0.f, 0.f, 0.f};
                ai = mm_tile<2>(sc, 72, vT, 72, ib, eb, F.lane, ai); ac = mm_tile<4>(q, 136, pT, 136, ib, eb, F.lane, ac);
                o[t] = ai + ac * qd;
#pragma unroll
                for (int r = 0; r < 4; ++r) { s1 += o[t][r]; s2 += o[t][r] * o[t][r]; } }
            s1 += __shfl_xor(s1, 16); s1 += __shfl_xor(s1, 32); s2 += __shfl_xor(s2, 16); s2 += __shfl_xor(s2, 32);
            if (F.lane < 16) { st[(eh * 64 + i) * 2] = s1; st[(eh * 64 + i) * 2 + 1] = s2; }
            __syncthreads();
            const float t1 = st[i * 2] + st[(64 + i) * 2], t2 = st[i * 2 + 1] + st[(64 + i) * 2 + 1];
            const float mean = t1 * (1.0f / 128.0f), var = fmaxf(t2 * (1.0f / 128.0f) - mean * mean, 0.f), rstd = rsqrtf(var + 1e-5f);
            const int mrow = m0 + i;
#pragma unroll
            for (int t = 0; t < 4; ++t) { const int e = (eh * 4 + t) * 16 + 4 * (F.lane >> 4);
                const u32x2 gw = *(const u32x2*)(p + (size_t)mrow * PW + P_RG + h * 128 + e); const float g[4] = {bflo(gw.x), bfhi(gw.x), bflo(gw.y), bfhi(gw.y)};
                float y[4];
#pragma unroll
                for (int r = 0; r < 4; ++r) y[r] = (o[t][r] - mean) * rstd * (g[r] * sigmoidf_(g[r]));
                u32x2 w; w.x = pk2(y[0], y[1]); w.y = pk2(y[2], y[3]); *(u32x2*)((bf16_t*)(ws + WS_YRET) + (size_t)mrow * 512 + h * 128 + e) = w; }
        }
    }
    __syncthreads();
}

constexpr int ATT_KP = 104, ATT_VP = 72;
constexpr int ATT_KB = 64 * ATT_KP * 2, ATT_VB = 64 * ATT_VP * 2, ATT_BUF = ATT_KB + ATT_VB;
__device__ __forceinline__ void attn_unit(const Frame& F, int b, int h, int qt) {
    unsigned char* ws = F.ws;
    const bf16_t* Qg = (const bf16_t*)(ws + WS_Q); const bf16_t* Kn = (const bf16_t*)(ws + WS_KN); const bf16_t* Kp = (const bf16_t*)(ws + WS_KPE); const bf16_t* Vt = (const bf16_t*)(ws + WS_VT);
    const int lane = F.lane, w = F.wave, ql = lane & 31, hf = lane >> 5;
    const int mq = b * SEQ + qt * 256 + w * 32 + ql;
    const float qs = 0.10206207261596577f * 1.4426950408889634f;
    bf16x8 qf[6];
    {
        const bf16_t* qr = Qg + (size_t)mq * 768 + h * 96;
#pragma unroll
        for (int s = 0; s < 4; ++s) { const u32x4 x = *(const u32x4*)(qr + 16 * s + 8 * hf); const unsigned xw[4] = {x.x, x.y, x.z, x.w}; u32x4 o; unsigned ow[4];
#pragma unroll
            for (int i = 0; i < 4; ++i) ow[i] = pk2(bflo(xw[i]) * qs, bfhi(xw[i]) * qs);
            o.x = ow[0]; o.y = ow[1]; o.z = ow[2]; o.w = ow[3]; qf[s] = __builtin_bit_cast(bf16x8, o); }
        const u32x4 x1 = *(const u32x4*)(qr + 64 + 8 * hf), x2 = *(const u32x4*)(qr + 80 + 8 * hf);
        const float* cp = (const float*)(ws + WS_COSM) + (size_t)mq * 16 + 8 * hf; const float* sp = (const float*)(ws + WS_SINM) + (size_t)mq * 16 + 8 * hf;
        const unsigned a[4] = {x1.x, x1.y, x1.z, x1.w}, c[4] = {x2.x, x2.y, x2.z, x2.w}; unsigned o1[4], o2[4];
#pragma unroll
        for (int i = 0; i < 4; ++i) { const float u0 = bflo(a[i]), u1 = bfhi(a[i]), v0 = bflo(c[i]), v1 = bfhi(c[i]); const float c0 = cp[2 * i], c1 = cp[2 * i + 1], s0 = sp[2 * i], s1 = sp[2 * i + 1];
            o1[i] = pk2((u0 * c0 - v0 * s0) * qs, (u1 * c1 - v1 * s1) * qs); o2[i] = pk2((u0 * s0 + v0 * c0) * qs, (u1 * s1 + v1 * c1) * qs); }
        u32x4 t1, t2; t1.x = o1[0]; t1.y = o1[1]; t1.z = o1[2]; t1.w = o1[3]; t2.x = o2[0]; t2.y = o2[1]; t2.z = o2[2]; t2.w = o2[3];
        qf[4] = __builtin_bit_cast(bf16x8, t1); qf[5] = __builtin_bit_cast(bf16x8, t2);
    }
    f32x16 oacc[2];
#pragma unroll
    for (int i = 0; i < 16; ++i) { oacc[0][i] = 0.f; oacc[1][i] = 0.f; }
    float mrun = -3.0e38f, lrun = 0.f;
    const int nkt = 4 * qt + 4, mylim = 4 * qt + (w >> 1);
    const int kkey = F.tid >> 3, kpc = F.tid & 7, rkey = F.tid >> 2, rpc = F.tid & 3, ve = F.tid >> 3, vpc = F.tid & 7;
    const bf16_t* knp = Kn + (size_t)(b * SEQ + kkey) * 512 + h * 64 + kpc * 8;
    const bf16_t* kpp = Kp + (size_t)(b * SEQ + rkey) * 32 + rpc * 8;
    const bf16_t* vtp = Vt + (size_t)(h * 64 + ve) * MTOK + b * SEQ + vpc * 8;
    u32x4 rk = *(const u32x4*)knp, rr = (F.tid < 256) ? *(const u32x4*)kpp : (u32x4){0u, 0u, 0u, 0u}, rv = *(const u32x4*)vtp;
    __syncthreads();
    {
        LAS unsigned char* buf = F.lds;
        *(LAS u32x4*)(buf + (kkey * ATT_KP + kpc * 8) * 2) = rk; if (F.tid < 256) *(LAS u32x4*)(buf + (rkey * ATT_KP + 64 + rpc * 8) * 2) = rr; *(LAS u32x4*)(buf + ATT_KB + (ve * ATT_VP + vpc * 8) * 2) = rv;
    }
    __syncthreads();
    for (int kt = 0; kt < nkt; ++kt) {
        const bool more = kt + 1 < nkt;
        if (more) { const size_t ko = (size_t)(kt + 1) * 64; rk = *(const u32x4*)(knp + ko * 512); if (F.tid < 256) rr = *(const u32x4*)(kpp + ko * 32); rv = *(const u32x4*)(vtp + ko); }
        if (kt <= mylim) {
            const LAS bf16_t* kb = (const LAS bf16_t*)(F.lds + (kt & 1) * ATT_BUF); const LAS bf16_t* vb = (const LAS bf16_t*)(F.lds + (kt & 1) * ATT_BUF + ATT_KB);
            f32x16 s[2];
#pragma unroll
            for (int t = 0; t < 2; ++t) {
#pragma unroll
                for (int i = 0; i < 16; ++i) s[t][i] = 0.f;
#pragma unroll
                for (int st = 0; st < 6; ++st) { const bf16x8 a = *(const LAS bf16x8*)(kb + (t * 32 + ql) * ATT_KP + 16 * st + 8 * hf); s[t] = __builtin_amdgcn_mfma_f32_32x32x16_bf16(a, qf[st], s[t], 0, 0, 0); } }
            float mx = fmaxf(s[0][0], s[1][0]);
#pragma unroll
            for (int i = 1; i < 16; ++i) mx = fmaxf(mx, fmaxf(s[0][i], s[1][i]));
#ifdef OLD_SWAP
            mx = fmaxf(mx, __shfl_xor(mx, 32));
#else
            { const int mb = __builtin_bit_cast(int, mx); const auto sw2 = __builtin_amdgcn_permlane32_swap(mb, mb, false, false); mx = fmaxf(__builtin_bit_cast(float, (int)sw2[0]), __builtin_bit_cast(float, (int)sw2[1])); }
#endif
            #ifdef ATT_ALWAYS
            {
#else
            if (__builtin_amdgcn_ballot_w64(mx > mrun + 8.0f) != 0ull) {
#endif
                const float mnew = fmaxf(mrun, mx), alpha = __builtin_amdgcn_exp2f(mrun - mnew); mrun = mnew; lrun *= alpha;
#pragma unroll
                for (int i = 0; i < 16; ++i) { oacc[0][i] *= alpha; oacc[1][i] *= alpha; }
            }
            float ls = 0.f;
#pragma unroll
            for (int t = 0; t < 2; ++t)
#pragma unroll
                for (int i = 0; i < 16; ++i) { const float pv = __builtin_amdgcn_exp2f(s[t][i] - mrun); s[t][i] = pv; ls += pv; }
            lrun += ls;
#pragma unroll
            for (int t = 0; t < 2; ++t)
#pragma unroll
                for (int kbb = 0; kbb < 2; ++kbb) {
                    u32x4 pw; pw.x = pk2(s[t][8 * kbb + 0], s[t][8 * kbb + 1]); pw.y = pk2(s[t][8 * kbb + 2], s[t][8 * kbb + 3]); pw.z = pk2(s[t][8 * kbb + 4], s[t][8 * kbb + 5]); pw.w = pk2(s[t][8 * kbb + 6], s[t][8 * kbb + 7]);
                    const bf16x8 pf = __builtin_bit_cast(bf16x8, pw);
                    const int key0 = t * 32 + kbb * 16 + 4 * hf;
#pragma unroll
                    for (int eb = 0; eb < 2; ++eb) { const LAS bf16_t* vr = vb + (eb * 32 + ql) * ATT_VP + key0;
                        const u32x2 lo = *(const LAS u32x2*)vr, hi = *(const LAS u32x2*)(vr + 8); u32x4 vv; vv.x = lo.x; vv.y = lo.y; vv.z = hi.x; vv.w = hi.y;
                        oacc[eb] = __builtin_amdgcn_mfma_f32_32x32x16_bf16(__builtin_bit_cast(bf16x8, vv), pf, oacc[eb], 0, 0, 0); } }
        }
        if (more) { LAS unsigned char* buf = F.lds + ((kt + 1) & 1) * ATT_BUF;
            *(LAS u32x4*)(buf + (kkey * ATT_KP + kpc * 8) * 2) = rk; if (F.tid < 256) *(LAS u32x4*)(buf + (rkey * ATT_KP + 64 + rpc * 8) * 2) = rr; *(LAS u32x4*)(buf + ATT_KB + (ve * ATT_VP + vpc * 8) * 2) = rv; }
        __syncthreads();
    }
    const float lt = lrun + __shfl_xor(lrun, 32), inv = 1.0f / lt;
    bf16_t* yo = (bf16_t*)(ws + WS_YMLA) + (size_t)mq * 512 + h * 64;
#pragma unroll
    for (int eb = 0; eb < 2; ++eb)
#pragma unroll
        for (int g = 0; g < 4; ++g) { u32x2 wv; wv.x = pk2(oacc[eb][4 * g] * inv, oacc[eb][4 * g + 1] * inv); wv.y = pk2(oacc[eb][4 * g + 2] * inv, oacc[eb][4 * g + 3] * inv);
            *(u32x2*)(yo + eb * 32 + 8 * g + 4 * hf) = wv; }
}
constexpr int RP = 72;
constexpr int RMAT = 64 * RP;
constexpr size_t RC_UNIT = 40960;
constexpr size_t WS_RC2 = WS_RC + (size_t)2048 * RC_UNIT;

__device__ __forceinline__ void st_g4(bf16_t* p, f32x4 v) { u32x2 w; w.x = pk2(v[0], v[1]); w.y = pk2(v[2], v[3]); *(u32x2*)p = w; }
__device__ __forceinline__ f32x4 ld_l4(const LAS bf16_t* p) { const u32x2 w = *(const LAS u32x2*)p; return (f32x4){bflo(w.x), bfhi(w.x), bflo(w.y), bfhi(w.y)}; }

__device__ __forceinline__ void rwkv_chunk_pre(const Frame& F, const float* mu, const float* k_k_, const float* k_a_, const float* r_k_) {
    unsigned char* ws = F.ws; const bf16_t* p = (const bf16_t*)(ws + WS_P); const bf16_t* lo = (const bf16_t*)(ws + WS_LO);
    LAS bf16_t* M = (LAS bf16_t*)F.lds;
    LAS bf16_t *KKt = M, *Bt = M + RMAT, *Kt = M + 2 * RMAT, *Rt = M + 3 * RMAT, *KKtT = M + 4 * RMAT, *BhT = M + 5 * RMAT, *KhT = M + 6 * RMAT, *VcT = M + 7 * RMAT;
    LAS bf16_t *NA = M + 8 * RMAT, *NAT = M + 9 * RMAT, *TT = M + 10 * RMAT, *AkkT = M + 11 * RMAT, *AbrT = M + 12 * RMAT, *AkrT = M + 13 * RMAT;
    LAS float* LW = (LAS float*)(M + 8 * RMAT);
    LAS float* SEG = (LAS float*)(M + 10 * RMAT);
    const int lane = F.lane, w = F.wave;
    for (int u = F.blk; u < NB * 8 * NCHUNK; u += F.G) {
        const int c = u & 127, h = (u >> 7) & 7, b = u >> 10; const int m0 = b * SEQ + c * 64, ch = h * 64 + lane;
        const float mu_r = mu[ch], mu_k = mu[512 + ch], mu_v = mu[1024 + ch], k_k = k_k_[ch], k_a = k_a_[ch], r_k = r_k_[ch];
        float* aux = (float*)(ws + WS_RC2) + (size_t)u * 128;
        __syncthreads();
        float rr[8], kk8[8], k28[8], vv[8], bb[8], lw8[8];
#pragma unroll
        for (int i = 0; i < 8; ++i) { const int t = w + 8 * i, m = m0 + t; const bf16_t* pr = p + (size_t)m * PW + P_RW + ch; const bool hp = (c | t) != 0;
            const float xr = bf2f(pr[0]), xk = bf2f(pr[512]), xv = bf2f(pr[1024]);
            const float pr_ = hp ? bf2f(pr[-PW]) : 0.f, pk_ = hp ? bf2f(pr[512 - PW]) : 0.f, pv_ = hp ? bf2f(pr[1024 - PW]) : 0.f;
            const float r = xr + (pr_ - xr) * mu_r, k = xk + (pk_ - xk) * mu_k, v = xv + (pv_ - xv) * mu_v;
            const float lw = bf2f(lo[(size_t)m * LO_W + ch]), a = bf2f(lo[(size_t)m * LO_W + 512 + ch]);
            float kk = k * k_k; const float ss = wave_sum(kk * kk); kk *= rsqrtf(ss + 1e-12f);
            const float k2 = k * (1.0f + (a - 1.0f) * k_a);
            rr[i] = r; kk8[i] = kk; k28[i] = k2; vv[i] = v; bb[i] = kk * a; lw8[i] = lw; LW[t * 64 + lane] = lw;
            ((bf16_t*)(ws + WS_RC + (size_t)u * RC_UNIT))[16384 + t * 64 + lane] = (bf16_t)f2bf(v);
            const float bon = wave_sum(r * k2 * r_k); if (lane == 0) aux[64 + t] = bon; }
        __syncthreads();
        { float cs = 0.f;
#pragma unroll
          for (int i = 0; i < 8; ++i) { cs += LW[(w * 8 + i) * 64 + lane]; LW[(w * 8 + i) * 64 + lane] = cs; }
          SEG[w * 64 + lane] = cs; }
        __syncthreads();
        float segp[9]; segp[0] = 0.f;
#pragma unroll
        for (int s = 0; s < 8; ++s) segp[s + 1] = segp[s] + SEG[s * 64 + lane];
        const float cumC = segp[8];
        float cum8[8];
#pragma unroll
        for (int i = 0; i < 8; ++i) cum8[i] = LW[(w + 8 * i) * 64 + lane] + segp[i];
        if (w == 0) aux[lane] = __expf(cumC);
        __syncthreads();
#pragma unroll
        for (int i = 0; i < 8; ++i) { const int t = w + 8 * i; const float cum = cum8[i];
            const float om = __expf(cum), omx = __expf(cum - lw8[i]), iom = __expf(-cum), ih = __expf(cumC - cum);
            KKt[t * RP + lane] = (bf16_t)f2bf(kk8[i] * omx); Bt[t * RP + lane] = (bf16_t)f2bf(bb[i] * iom); Kt[t * RP + lane] = (bf16_t)f2bf(k28[i] * iom); Rt[t * RP + lane] = (bf16_t)f2bf(rr[i] * om);
            KKtT[lane * RP + t] = (bf16_t)f2bf(kk8[i] * omx); BhT[lane * RP + t] = (bf16_t)f2bf(bb[i] * ih); KhT[lane * RP + t] = (bf16_t)f2bf(k28[i] * ih); VcT[lane * RP + t] = (bf16_t)f2bf(vv[i]); }
        __syncthreads();
        {
            const int ib = w >> 1;
#pragma unroll
            for (int tt = 0; tt < 2; ++tt) { const int jb = 2 * (w & 1) + tt; const int i0 = ib * 16 + (lane & 15), j0 = jb * 16 + 4 * (lane >> 4);
                const f32x4 z = {0.f, 0.f, 0.f, 0.f};
                f32x4 a_nat = z, a_kk = z, a_br = z, a_kr = z, a_na = z;
                if (jb <= ib) { a_nat = mm_tile<2>(KKt, RP, Bt, RP, ib, jb, lane, z); a_kk = mm_tile<2>(KKt, RP, Kt, RP, ib, jb, lane, z); a_br = mm_tile<2>(Rt, RP, Bt, RP, ib, jb, lane, z); a_kr = mm_tile<2>(Rt, RP, Kt, RP, ib, jb, lane, z); }
                if (jb >= ib) a_na = mm_tile<2>(Bt, RP, KKt, RP, ib, jb, lane, z);
                f32x4 o_nat, o_tt, o_kk, o_br, o_kr, o_na;
#pragma unroll
                for (int r = 0; r < 4; ++r) { const int jj = j0 + r; const bool lt = jj < i0, le = jj <= i0;
                    o_nat[r] = lt ? -a_nat[r] : 0.f; o_tt[r] = o_nat[r] + (jj == i0 ? 1.0f : 0.f); o_kk[r] = lt ? a_kk[r] : 0.f; o_br[r] = le ? a_br[r] : 0.f; o_kr[r] = le ? a_kr[r] : 0.f;
                    o_na[r] = (i0 < jj) ? -a_na[r] : 0.f; }
                st_bf4(NAT + i0 * RP + j0, o_nat); st_bf4(TT + i0 * RP + j0, o_tt); st_bf4(AkkT + i0 * RP + j0, o_kk); st_bf4(AbrT + i0 * RP + j0, o_br); st_bf4(AkrT + i0 * RP + j0, o_kr); st_bf4(NA + i0 * RP + j0, o_na); }
        }
        __syncthreads();
        LAS bf16_t* VA = Kt;
#pragma unroll 1
        for (int s = 1; s <= 6; ++s) {
            const LAS bf16_t* Yo = (s & 1) ? NAT : KKt; const LAS bf16_t* YoT = (s & 1) ? NA : Bt; LAS bf16_t* Yn = (s & 1) ? KKt : NAT; LAS bf16_t* YnT = (s & 1) ? Bt : NA;
            const f32x4 z = {0.f, 0.f, 0.f, 0.f};
            if (w < 4) {
                if (s == 1) {
#pragma unroll
                    for (int jb = 0; jb < 4; ++jb) { const f32x4 a = mm_tile<2>(VcT, RP, AkkT, RP, w, jb, lane, z); st_bf4(VA + (w * 16 + (lane & 15)) * RP + jb * 16 + 4 * (lane >> 4), a); }
                } else {
                    f32x4 a[4];
#pragma unroll
                    for (int jb = 0; jb < 4; ++jb) a[jb] = mm_tile<2>(TT, RP, YoT, RP, w, jb, lane, ld_l4(TT + (w * 16 + (lane & 15)) * RP + jb * 16 + 4 * (lane >> 4)));
                    LDS_WAIT();
#pragma unroll
                    for (int jb = 0; jb < 4; ++jb) st_bf4(TT + (w * 16 + (lane & 15)) * RP + jb * 16 + 4 * (lane >> 4), a[jb]);
                }
            } else if (s <= 5) {
                const int ib = w - 4;
#pragma unroll
                for (int jb = 0; jb < 4; ++jb) { const f32x4 a = mm_tile<2>(Yo, RP, YoT, RP, ib, jb, lane, z), bt = mm_tile<2>(YoT, RP, Yo, RP, ib, jb, lane, z);
                    st_bf4(Yn + (ib * 16 + (lane & 15)) * RP + jb * 16 + 4 * (lane >> 4), a); st_bf4(YnT + (ib * 16 + (lane & 15)) * RP + jb * 16 + 4 * (lane >> 4), bt); }
            }
            __syncthreads();
        }
        LAS bf16_t* KT = NAT; LAS bf16_t* P1 = NA;
        {
            const f32x4 z = {0.f, 0.f, 0.f, 0.f}; const int ib = w & 3; const LAS bf16_t* src = (w < 4) ? KKtT : VA; LAS bf16_t* dst = (w < 4) ? KT : P1;
#pragma unroll
            for (int jb = 0; jb < 4; ++jb) { const f32x4 a = mm_tile<2>(src, RP, TT, RP, ib, jb, lane, z); st_bf4(dst + (ib * 16 + (lane & 15)) * RP + jb * 16 + 4 * (lane >> 4), a); }
        }
        __syncthreads();
        {
            bf16_t* og = (bf16_t*)(ws + WS_RC + (size_t)u * RC_UNIT) + (w >> 1) * 4096; const int g = w >> 1; const f32x4 z = {0.f, 0.f, 0.f, 0.f};
#pragma unroll
            for (int tt = 0; tt < 2; ++tt) { const int ib = 2 * (w & 1) + tt; const int i0 = ib * 16 + (lane & 15);
#pragma unroll
                for (int jb = 0; jb < 4; ++jb) { const int j0 = jb * 16 + 4 * (lane >> 4); f32x4 o;
                    if (g == 0) o = mm_tile<2>(BhT, RP, KT, RP, ib, jb, lane, z);
                    else if (g == 1) o = mm_tile<2>(VcT, RP, KhT, RP, ib, jb, lane, z) - mm_tile<2>(P1, RP, BhT, RP, ib, jb, lane, z);
                    else if (g == 2) o = ld_l4(Rt + i0 * RP + j0) - mm_tile<2>(AbrT, RP, KT, RP, ib, jb, lane, z);
                    else o = mm_tile<2>(VcT, RP, AkrT, RP, ib, jb, lane, z) - mm_tile<2>(P1, RP, AbrT, RP, ib, jb, lane, z);
                    st_g4(og + i0 * 64 + j0, o); } }
        }
    }
    __syncthreads();
}

struct ScanOps { u32x4 fa0, fa1; u32x2 ad0, ad1; f32x4 om; };
__device__ __forceinline__ ScanOps scan_load(const unsigned char* ws, size_t u, int sk, int vh, int l15, int l4) {
    ScanOps o; const bf16_t* base = (const bf16_t*)(ws + WS_RC + u * RC_UNIT);
    o.fa0 = *(const u32x4*)(base + (sk * 16 + l15) * 64 + 8 * l4); o.fa1 = *(const u32x4*)(base + (sk * 16 + l15) * 64 + 32 + 8 * l4);
    o.ad0 = *(const u32x2*)(base + 4096 + ((2 * vh) * 16 + l15) * 64 + sk * 16 + 4 * l4); o.ad1 = *(const u32x2*)(base + 4096 + ((2 * vh + 1) * 16 + l15) * 64 + sk * 16 + 4 * l4);
    o.om = *(const f32x4*)((const float*)(ws + WS_RC2) + u * 128 + sk * 16 + 4 * l4); return o;
}
__device__ __forceinline__ void rwkv_scan(const Frame& F, int b, int h) {
    unsigned char* ws = F.ws;
    LAS bf16_t* Sb = (LAS bf16_t*)F.lds;
    const int lane = F.lane, w = F.wave, l15 = lane & 15, l4 = lane >> 4, sk = w & 3, vh = w >> 2;
    for (int i = F.tid; i < 2 * RMAT / 2; i += NTHR) ((LAS unsigned*)Sb)[i] = 0u;
    const size_t u0 = (size_t)(b * 8 + h) * 128;
    f32x4 st0 = {0.f, 0.f, 0.f, 0.f}, st1 = {0.f, 0.f, 0.f, 0.f};
    ScanOps r0 = scan_load(ws, u0 + 0, sk, vh, l15, l4), r1 = scan_load(ws, u0 + 1, sk, vh, l15, l4), r2 = scan_load(ws, u0 + 2, sk, vh, l15, l4), r3 = scan_load(ws, u0 + 3, sk, vh, l15, l4);
    __syncthreads();
#define SCAN_STEP(R, cc) do { const int c_ = (cc); \
        const LAS bf16_t* Sc = Sb + (c_ & 1) * RMAT; LAS bf16_t* Sn = Sb + ((c_ + 1) & 1) * RMAT; \
        const bf16x8 a0 = __builtin_bit_cast(bf16x8, R.fa0), a1 = __builtin_bit_cast(bf16x8, R.fa1); \
        const LAS bf16_t* sp0 = Sc + ((2 * vh) * 16 + l15) * RP + 8 * l4; const LAS bf16_t* sp1 = sp0 + 16 * RP; \
        const bf16x8 s00 = *(const LAS bf16x8*)sp0, s01 = *(const LAS bf16x8*)(sp0 + 32), s10 = *(const LAS bf16x8*)sp1, s11 = *(const LAS bf16x8*)(sp1 + 32); \
        bf16_t* sg = (bf16_t*)(ws + WS_RC + (u0 + c_) * RC_UNIT) + 4096; \
        { u32x2 w0_, w1_; w0_.x = pk2(st0[0], st0[1]); w0_.y = pk2(st0[2], st0[3]); w1_.x = pk2(st1[0], st1[1]); w1_.y = pk2(st1[2], st1[3]); \
          *(u32x2*)(sg + ((2 * vh) * 16 + l15) * 64 + sk * 16 + 4 * l4) = w0_; *(u32x2*)(sg + ((2 * vh + 1) * 16 + l15) * 64 + sk * 16 + 4 * l4) = w1_; } \
        f32x4 t0 = {0.f, 0.f, 0.f, 0.f}, t1 = {0.f, 0.f, 0.f, 0.f}; \
        t0 = __builtin_amdgcn_mfma_f32_16x16x32_bf16(a0, s00, t0, 0, 0, 0); t1 = __builtin_amdgcn_mfma_f32_16x16x32_bf16(a0, s10, t1, 0, 0, 0); \
        t0 = __builtin_amdgcn_mfma_f32_16x16x32_bf16(a1, s01, t0, 0, 0, 0); t1 = __builtin_amdgcn_mfma_f32_16x16x32_bf16(a1, s11, t1, 0, 0, 0); \
        const f32x4 n0 = {bflo(R.ad0.x), bfhi(R.ad0.x), bflo(R.ad0.y), bfhi(R.ad0.y)}, n1 = {bflo(R.ad1.x), bfhi(R.ad1.x), bflo(R.ad1.y), bfhi(R.ad1.y)}; \
        st0 = st0 * R.om - t0 + n0; st1 = st1 * R.om - t1 + n1; \
        st_bf4(Sn + ((2 * vh) * 16 + l15) * RP + sk * 16 + 4 * l4, st0); st_bf4(Sn + ((2 * vh + 1) * 16 + l15) * RP + sk * 16 + 4 * l4, st1); \
        if (c_ + 4 < NCHUNK) R = scan_load(ws, u0 + c_ + 4, sk, vh, l15, l4); \
        __syncthreads(); } while (0)
#pragma unroll 1
    for (int c = 0; c < NCHUNK; c += 4) { SCAN_STEP(r0, c); SCAN_STEP(r1, c + 1); SCAN_STEP(r2, c + 2); SCAN_STEP(r3, c + 3); }
#undef SCAN_STEP
}

__device__ __forceinline__ void rwkv_out(const Frame& F, const float* lnx_) {
    unsigned char* ws = F.ws; const bf16_t* lo = (const bf16_t*)(ws + WS_LO);
    LAS float* Yl = (LAS float*)F.lds;
    const int lane = F.lane, w = F.wave, l15 = lane & 15, l4 = lane >> 4, tb = w & 3, vh = w >> 2;
    const int tt = F.tid >> 3, c8 = (F.tid & 7) * 8;
    for (int u = F.blk; u < NB * 8 * NCHUNK; u += F.G) {
        const int c = u & 127, h = (u >> 7) & 7, b = u >> 10;
        const bf16_t* base = (const bf16_t*)(ws + WS_RC + (size_t)u * RC_UNIT);
        const bf16_t* Sg = base + 4096; const bf16_t* QT = base + 8192; const bf16_t* Z = base + 12288;
        const bf16x8 q0 = *(const bf16x8*)(QT + (tb * 16 + l15) * 64 + 8 * l4), q1 = *(const bf16x8*)(QT + (tb * 16 + l15) * 64 + 32 + 8 * l4);
        f32x4 y[2];
#pragma unroll
        for (int i = 0; i < 2; ++i) { const int ib = 2 * vh + i; const bf16_t* sp = Sg + (ib * 16 + l15) * 64 + 8 * l4; const bf16x8 s0 = *(const bf16x8*)sp, s1 = *(const bf16x8*)(sp + 32);
            const u32x2 zw = *(const u32x2*)(Z + (ib * 16 + l15) * 64 + tb * 16 + 4 * l4);
            f32x4 t = {bflo(zw.x), bfhi(zw.x), bflo(zw.y), bfhi(zw.y)};
            t = __builtin_amdgcn_mfma_f32_16x16x32_bf16(q0, s0, t, 0, 0, 0); t = __builtin_amdgcn_mfma_f32_16x16x32_bf16(q1, s1, t, 0, 0, 0); y[i] = t; }
        const int m = b * SEQ + c * 64 + tt, chq = h * 64 + c8;
        const u32x4 cv = *(const u32x4*)(base + 16384 + tt * 64 + c8), cg = *(const u32x4*)(lo + (size_t)m * LO_W + 1024 + chq);
        const float cbc = ((const float*)(ws + WS_RC2))[(size_t)u * 128 + 64 + tt];
        const f32x4 ln0 = *(const f32x4*)(lnx_ + chq), ln1 = *(const f32x4*)(lnx_ + chq + 4);
        __syncthreads();
#pragma unroll
        for (int i = 0; i < 2; ++i)
#pragma unroll
            for (int r = 0; r < 4; ++r) Yl[(tb * 16 + 4 * l4 + r) * 68 + (2 * vh + i) * 16 + l15] = y[i][r];
        __syncthreads();
        const f32x4 ya = *(const LAS f32x4*)(Yl + tt * 68 + c8), yb = *(const LAS f32x4*)(Yl + tt * 68 + c8 + 4);
        float yy[8] = {ya[0], ya[1], ya[2], ya[3], yb[0], yb[1], yb[2], yb[3]};
        float s1 = ((yy[0] + yy[1]) + (yy[2] + yy[3])) + ((yy[4] + yy[5]) + (yy[6] + yy[7]));
        s1 = sum8(s1); const float mean = s1 * (1.0f / 64.0f); float s2 = 0.f;
#pragma unroll
        for (int i = 0; i < 8; ++i) { yy[i] -= mean; s2 += yy[i] * yy[i]; }
        s2 = sum8(s2); const float rstd = rsqrtf(s2 * (1.0f / 64.0f) + 64e-5f);
        const unsigned vw[4] = {cv.x, cv.y, cv.z, cv.w}, gw[4] = {cg.x, cg.y, cg.z, cg.w};
        const float lnx[8] = {ln0[0], ln0[1], ln0[2], ln0[3], ln1[0], ln1[1], ln1[2], ln1[3]};
        unsigned ow[4];
#pragma unroll
        for (int i = 0; i < 4; ++i) { float o2[2];
#pragma unroll
            for (int e = 0; e < 2; ++e) { const int ci = 2 * i + e; const float v = e ? bfhi(vw[i]) : bflo(vw[i]), g = e ? bfhi(gw[i]) : bflo(gw[i]);
                o2[e] = (yy[ci] * rstd * lnx[ci] + cbc * v) * g; }
            ow[i] = pk2(o2[0], o2[1]); }
        *(u32x4*)((bf16_t*)(ws + WS_YRW) + (size_t)m * 512 + chq) = (u32x4){ow[0], ow[1], ow[2], ow[3]};
    }
    __syncthreads();
}
__device__ __forceinline__ void rwkv_seq(const Frame& F, const Params& P, int layer, int b, int h) {
    unsigned char* ws = F.ws; const bf16_t* p = (const bf16_t*)(ws + WS_P); const bf16_t* lo = (const bf16_t*)(ws + WS_LO);
    LAS float* Lr = (LAS float*)F.lds; LAS float* Lw = Lr + 4096; LAS float* Lk = Lw + 4096; LAS float* Lv = Lk + 4096; LAS float* Lkk = Lv + 4096; LAS float* Lb = Lkk + 4096; LAS float* Ly = Lb + 4096;
    const int lane = F.lane, ch = h * 64 + lane;
    const float mu_r = P.in[I_MU][(size_t)layer * RWKV_COLS + ch], mu_k = P.in[I_MU][(size_t)layer * RWKV_COLS + 512 + ch], mu_v = P.in[I_MU][(size_t)layer * RWKV_COLS + 1024 + ch];
    const float k_k = P.in[I_KK][layer * 512 + ch], k_a = P.in[I_KA][layer * 512 + ch], r_k = P.in[I_RK][layer * 512 + ch], lnx = P.in[I_LNX][layer * 512 + ch];
    const int vrow = F.tid >> 3, q = F.tid & 7;
    float s[8];
#pragma unroll
    for (int i = 0; i < 8; ++i) s[i] = 0.f;
    for (int c = 0; c < NCHUNK; ++c) {
        const int m0 = b * SEQ + c * 64;
        __syncthreads();
#pragma unroll
        for (int i = 0; i < 8; ++i) { const int t = F.wave + 8 * i, m = m0 + t; const bf16_t* pr = p + (size_t)m * PW + P_RW + ch; const bool hp = (c | t) != 0;
            const float xr = bf2f(pr[0]), xk = bf2f(pr[512]), xv = bf2f(pr[1024]);
            const float pr_ = hp ? bf2f(pr[-PW]) : 0.f, pk_ = hp ? bf2f(pr[512 - PW]) : 0.f, pv_ = hp ? bf2f(pr[1024 - PW]) : 0.f;
            const float r = xr + (pr_ - xr) * mu_r, k = xk + (pk_ - xk) * mu_k, v = xv + (pv_ - xv) * mu_v;
            const float lw = bf2f(lo[(size_t)m * LO_W + ch]), a = bf2f(lo[(size_t)m * LO_W + 512 + ch]);
            float kk = k * k_k; const float ss = wave_sum(kk * kk); kk *= rsqrtf(ss + 1e-12f);
            Lr[t * 64 + lane] = r; Lw[t * 64 + lane] = __expf(lw); Lk[t * 64 + lane] = k * (1.0f + (a - 1.0f) * k_a); Lv[t * 64 + lane] = v; Lkk[t * 64 + lane] = kk; Lb[t * 64 + lane] = kk * a; }
        __syncthreads();
        for (int t = 0; t < 64; ++t) {
            const f32x4 ka = *(const LAS f32x4*)(Lkk + t * 64 + q * 8), kb = *(const LAS f32x4*)(Lkk + t * 64 + q * 8 + 4);
            const f32x4 wa = *(const LAS f32x4*)(Lw + t * 64 + q * 8), wb = *(const LAS f32x4*)(Lw + t * 64 + q * 8 + 4);
            const f32x4 ba = *(const LAS f32x4*)(Lb + t * 64 + q * 8), bb = *(const LAS f32x4*)(Lb + t * 64 + q * 8 + 4);
            const f32x4 k2a = *(const LAS f32x4*)(Lk + t * 64 + q * 8), k2b = *(const LAS f32x4*)(Lk + t * 64 + q * 8 + 4);
            const f32x4 ra = *(const LAS f32x4*)(Lr + t * 64 + q * 8), rb = *(const LAS f32x4*)(Lr + t * 64 + q * 8 + 4);
            const float vv = Lv[t * 64 + vrow];
            float sa = 0.f;
#pragma unroll
            for (int i = 0; i < 4; ++i) { sa += s[i] * ka[i]; sa += s[4 + i] * kb[i]; }
            sa = sum8(sa); sa = -sa;
            float y = 0.f;
#pragma unroll
            for (int i = 0; i < 4; ++i) { s[i] = s[i] * wa[i] + sa * ba[i] + vv * k2a[i]; s[4 + i] = s[4 + i] * wb[i] + sa * bb[i] + vv * k2b[i]; y += s[i] * ra[i]; y += s[4 + i] * rb[i]; }
            y = sum8(y);
            if (q == 0) Ly[t * 64 + vrow] = y;
        }
        __syncthreads();
#pragma unroll
        for (int i = 0; i < 8; ++i) { const int t = F.wave + 8 * i, m = m0 + t;
            const float y = Ly[t * 64 + lane]; const float mean = wave_sum(y) * (1.0f / 64.0f); const float d = y - mean; const float var = wave_sum(d * d) * (1.0f / 64.0f);
            const float bon = wave_sum(Lr[t * 64 + lane] * Lk[t * 64 + lane] * r_k);
            const float g = bf2f(lo[(size_t)m * LO_W + 1024 + ch]);
            const float o = (d * rsqrtf(var + 64e-5f) * lnx + bon * Lv[t * 64 + lane]) * g;
            ((bf16_t*)(ws + WS_YRW))[(size_t)m * 512 + ch] = (bf16_t)f2bf(o); }
    }
    __syncthreads();
}

constexpr int LDS_TAB = LDSCTL_OFF + 64;
__device__ __forceinline__ void moe_table(const Frame& F, const unsigned* ectl) {
    LAS int* tab = (LAS int*)(F.lds + LDS_TAB);
    if (F.tid == 0) { int st = 0, nt = 0;
        for (int e = 0; e < 8; ++e) { const int c = (int)__hip_atomic_load(&ectl[e], __ATOMIC_RELAXED, __HIP_MEMORY_SCOPE_AGENT); tab[1 + e] = st; const int t = (c + 255) >> 8; for (int i = 0; i < t; ++i) tab[16 + nt + i] = e; nt += t; st += t * 256; }
        tab[0] = nt; }
    __syncthreads();
}
__device__ __forceinline__ void phase_moe_scatter(const Frame& F, const unsigned* ectl) {
    unsigned char* ws = F.ws; const LAS int* tab = (const LAS int*)(F.lds + LDS_TAB);
    const int* tok_e = (const int*)(ws + WS_TOK); int* tok_slot = (int*)tok_e + 2 * MTOK; const float* tok_w = (const float*)(tok_slot + 2 * MTOK);
    int* row_tok = (int*)(tok_w + 2 * MTOK); float* row_w = (float*)(row_tok + MAXROWS);
    for (int i = F.blk * NTHR + F.tid; i < 2 * MTOK; i += F.G * NTHR) { const int e = tok_e[i]; const int dest = tab[1 + e] + tok_slot[i]; row_tok[dest] = i >> 1; row_w[dest] = tok_w[i]; tok_slot[i] = dest; }
    const int gt = F.blk * NTHR + F.tid;
    if (gt < 2048) { const int e = gt >> 8; const int c = (int)__hip_atomic_load(&ectl[e], __ATOMIC_RELAXED, __HIP_MEMORY_SCOPE_AGENT); const int r = c + (gt & 255);
        if (r < ((c + 255) & ~255)) { row_tok[tab[1 + e] + r] = -1; row_w[tab[1 + e] + r] = 0.f; } }
}
constexpr int LDS_GTAB = RING_BYTES;
__device__ __forceinline__ void moe_gather_table(const Frame& F, int ncol) {
    const LAS int* tab = (const LAS int*)(F.lds + LDS_TAB); LAS unsigned* gt = (LAS unsigned*)(F.lds + LDS_GTAB);
    const int* row_tok = (const int*)(F.ws + WS_TOK) + 6 * MTOK; const int total = tab[0] * ncol;
    for (int i = F.tid; i < 9 * 256; i += NTHR) { const int u = i >> 8, r = i & 255; const int L = u * F.G + F.blk; unsigned off = 0u;
        if (L < total) { const int tk = row_tok[(L / ncol) * 256 + r]; off = tk > 0 ? (unsigned)tk * (unsigned)(DM * 2) : 0u; }
        gt[i] = off; }
    __syncthreads();
}

extern __shared__ __attribute__((aligned(16))) unsigned char lds_raw[];
template <class T> __device__ __forceinline__ T* uni(T* p) { const unsigned long long v = (unsigned long long)p; const unsigned lo = __builtin_amdgcn_readfirstlane((unsigned)v), hi = __builtin_amdgcn_readfirstlane((unsigned)(v >> 32)); return (T*)(((unsigned long long)hi << 32) | lo); }
__device__ __forceinline__ int uni(int v) { return __builtin_amdgcn_readfirstlane(v); }
__device__ __forceinline__ Frame mkframe(unsigned char* ws, int wv) {
    Frame F; F.lds = (LAS unsigned char*)lds_raw; int tid = wv * 64 + lane_id_fresh(); F.tid = tid; F.lane = F.tid & 63; F.wave = __builtin_amdgcn_readfirstlane(F.tid >> 6);
    int blk = blockIdx.x; asm volatile("" : "+s"(blk)); F.blk = blk; F.G = gridDim.x; F.vcu = (F.blk & 7) * (F.G >> 3) + (F.blk >> 3); F.gw = F.blk * NWAVES + F.wave; F.ngw = F.G * NWAVES; F.ws = ws; return F;
}
#define PHASE __device__ __forceinline__ void
PHASE f_moe_convert(int wv, unsigned char* ws_, const float* mg, const float* mu, const float* md) {
    unsigned char* ws = uni(ws_); const Frame F = mkframe(ws, wv); Params P; P.in[I_MG] = uni(mg); P.in[I_MU2] = uni(mu); P.in[I_MD] = uni(md); phase_moe_convert(F, P);
}
PHASE f_rms(int wv, unsigned char* ws_, const float* src, const float* gain) { unsigned char* ws = uni(ws_); const Frame F = mkframe(ws, wv); phase_rms<false>(F, uni(src), uni(gain), (bf16_t*)(ws + WS_HN), nullptr, nullptr, nullptr, nullptr, nullptr); }
PHASE f_rms_moe(int wv, unsigned char* ws_, const float* src, const float* gain, const float* router) {
    unsigned char* ws = uni(ws_); const Frame F = mkframe(ws, wv); int* tok_e = (int*)(ws + WS_TOK); int* tok_slot = tok_e + 2 * MTOK; float* tok_w = (float*)(tok_slot + 2 * MTOK);
    phase_rms<true>(F, uni(src), uni(gain), (bf16_t*)(ws + WS_HN), uni(router), (unsigned*)(ws + WS_CTL) + CW_ECNT, tok_e, tok_slot, tok_w);
}
PHASE f_prep(int wv, unsigned char* ws_, const float* mu, const float* qnorm, const float* kvnorm, int layer_) {
    unsigned char* ws = uni(ws_); const Frame F = mkframe(ws, wv); Params P; P.in[I_MU] = uni(mu); P.in[I_QNORM] = uni(qnorm); P.in[I_KVNORM] = uni(kvnorm); (void)layer_; phase_prep(F, P, 0);
}
PHASE f_ret_scan(int wv, unsigned char* ws_) { unsigned char* ws = uni(ws_); const Frame F = mkframe(ws, wv); ret_scan(F); }
PHASE f_ret_out(int wv, unsigned char* ws_) { unsigned char* ws = uni(ws_); const Frame F = mkframe(ws, wv); ret_out(F); }
PHASE f_rwkv_seq(int wv, unsigned char* ws_, const float* mu, const float* kk, const float* ka, const float* rk, const float* lnx, int layer_) {
    unsigned char* ws = uni(ws_); const Frame F = mkframe(ws, wv); Params P; P.in[I_MU] = uni(mu); P.in[I_KK] = uni(kk); P.in[I_KA] = uni(ka); P.in[I_RK] = uni(rk); P.in[I_LNX] = uni(lnx);
    (void)layer_; rwkv_seq(F, P, 0, F.blk >> 3, F.blk & 7);
}
PHASE f_rwkv_pre(int wv, unsigned char* ws_, const float* mu, const float* kk, const float* ka, const float* rk) { unsigned char* ws = uni(ws_); const Frame F = mkframe(ws, wv); rwkv_chunk_pre(F, uni(mu), uni(kk), uni(ka), uni(rk)); }
PHASE f_rwkv_scan(int wv, unsigned char* ws_) { unsigned char* ws = uni(ws_); const Frame F = mkframe(ws, wv); rwkv_scan(F, F.blk >> 3, F.blk & 7); }
PHASE f_rwkv_out(int wv, unsigned char* ws_, const float* lnx) { unsigned char* ws = uni(ws_); const Frame F = mkframe(ws, wv); rwkv_out(F, uni(lnx)); }
PHASE f_attn(int wv, unsigned char* ws_) { unsigned char* ws = uni(ws_); const Frame F = mkframe(ws, wv); const int bh = F.vcu >> 4, pr = F.vcu & 15; attn_unit(F, bh >> 3, bh & 7, 31 - pr); attn_unit(F, bh >> 3, bh & 7, pr); }
PHASE f_moe_scatter(int wv, unsigned char* ws_) { unsigned char* ws = uni(ws_); const Frame F = mkframe(ws, wv); moe_table(F, (unsigned*)(ws + WS_CTL) + CW_ECNT); phase_moe_scatter(F, (unsigned*)(ws + WS_CTL) + CW_ECNT); }
PHASE f_final(int wv, unsigned char* ws_, float* h, const float* gain) { unsigned char* ws = uni(ws_); const Frame F = mkframe(ws, wv); phase_final(F, uni(h), uni(gain), (const bf16_t*)(ws + WS_OUT2), (const int*)(ws + WS_TOK) + 2 * MTOK); }
PHASE g_inproj(int wv, unsigned char* ws_, int layer_) {
    unsigned char* ws = uni(ws_); const int layer = uni(layer_); const Frame F = mkframe(ws, wv);
    SchedGrid S; S.init(64, 18, F.G, F.blk, ws + WS_HN, (size_t)256 * DM * 2, (bf16_t*)(ws + WS_WIN) + (size_t)layer * WIN_ROWS * DM, (size_t)256 * DM * 2);
    EpiStore E; E.O = (bf16_t*)(ws + WS_P); E.ld = PW; pg8::gemm_phase(F.lds, F.tid, DM, DM, DM, S, E);
}
PHASE g_lora(int wv, unsigned char* ws_, const float* w0, const float* a0, int layer_) {
    unsigned char* ws = uni(ws_); const int layer = uni(layer_); const Frame F = mkframe(ws, wv);
    SchedGrid S; S.init(64, 6, F.G, F.blk, ws + WS_LIN, (size_t)256 * LORA_K * 2, (bf16_t*)(ws + WS_LORA) + (size_t)layer * 1536 * LORA_K, (size_t)256 * LORA_K * 2);
    EpiLora E; E.O = (bf16_t*)(ws + WS_LO); E.w0 = uni(w0); E.a0 = uni(a0); pg8::gemm_phase(F.lds, F.tid, LORA_K, LORA_K, LORA_K, S, E);
}
PHASE g_small(int wv, unsigned char* ws_, int layer_) {
    unsigned char* ws = uni(ws_); const Frame F = mkframe(ws, wv); SchedSmall S; S.G = F.G; S.c = F.blk; S.layer = uni(layer_); S.ws = (const char*)ws; EpiSmall E; E.ws = ws; pg8::gemm_phase(F.lds, F.tid, 256, 256, 256, S, E);
}
PHASE g_gate(int wv, unsigned char* ws_, int layer_) {
    unsigned char* ws = uni(ws_); const int layer = uni(layer_); const Frame F = mkframe(ws, wv);
    SchedOwn3 S; S.c = F.blk; S.G = F.G; S.A = (const char*)(ws + WS_HN); S.a_n = 0; S.astep = (size_t)256 * DM * 2; S.B = (const char*)((bf16_t*)(ws + WS_WIN) + ((size_t)layer * WIN_ROWS + PW) * DM); S.bstep = (size_t)256 * DM * 2; S.b_n = (size_t)1024 * DM * 2;
    EpiGate E; E.O = (bf16_t*)(ws + WS_G); pg8::gemm_phase(F.lds, F.tid, DM, DM, DM, S, E);
}
PHASE g_merge(int wv, unsigned char* ws_, int layer_) {
    unsigned char* ws = uni(ws_); const int layer = uni(layer_); const Frame F = mkframe(ws, wv);
    SchedOwn3 S; S.c = F.blk; S.G = F.G; S.A = (const char*)(ws + WS_YRET); S.a_n = (size_t)16 * MiB; S.astep = (size_t)256 * 512 * 2;
    S.B = (const char*)((bf16_t*)(ws + WS_BR) + (size_t)layer * 3 * 1024 * 512); S.bstep = (size_t)256 * 512 * 2; S.b_n = (size_t)1024 * 512 * 2;
    EpiMerge E; E.Gt = (const bf16_t*)(ws + WS_G); E.Mg = (bf16_t*)(ws + WS_MRG); pg8::gemm_phase(F.lds, F.tid, 512, 512, 512, S, E);
}
PHASE g_wo(int wv, unsigned char* ws_, const float* hin, float* hout, int layer_) {
    unsigned char* ws = uni(ws_); const int layer = uni(layer_); const Frame F = mkframe(ws, wv);
    SchedGrid S; S.init(64, 4, F.G, F.blk, ws + WS_MRG, (size_t)256 * DM * 2, (bf16_t*)(ws + WS_WO) + (size_t)layer * DM * DM, (size_t)256 * DM * 2);
    EpiResid E; E.In = uni(hin); E.Out = uni(hout); pg8::gemm_phase(F.lds, F.tid, DM, DM, DM, S, E);
}
PHASE g_ffn_gu(int wv, unsigned char* ws_) {
    unsigned char* ws = uni(ws_); const Frame F = mkframe(ws, wv);
    SchedGrid S; S.init(64, 22, F.G, F.blk, ws + WS_HN, (size_t)256 * DM * 2, ws + WS_FGU, (size_t)256 * DM * 2);
    EpiSwiglu E; E.O = (bf16_t*)(ws + WS_ACT); E.ldc = DFF; E.pn_off = 0; pg8::gemm_phase(F.lds, F.tid, DM, DM, DM, S, E);
}
PHASE g_ffn_down(int wv, unsigned char* ws_, float* h) {
    unsigned char* ws = uni(ws_); const Frame F = mkframe(ws, wv);
    SchedGrid S; S.init(64, 4, F.G, F.blk, ws + WS_ACT, (size_t)256 * DFF * 2, ws + WS_FD, (size_t)256 * DFF * 2);
    EpiResid E; E.In = uni(h); E.Out = E.In ? (float*)E.In : nullptr; pg8::gemm_phase(F.lds, F.tid, DFF, DFF, DFF, S, E);
}
PHASE g_moe_gu(int wv, unsigned char* ws_, int hh_) {
    unsigned char* ws = uni(ws_); const int hh = uni(hh_); const Frame F = mkframe(ws, wv); const LAS int* tab = (const LAS int*)(F.lds + LDS_TAB);
    moe_gather_table(F, 14);
    SchedMoe S; S.G = F.G; S.c = F.blk; S.ncol = 14; S.ntile = tab[0]; S.tab = tab + 16; S.A = (const char*)(ws + WS_HN); S.astep = 0;
    S.B = (const char*)(ws + WS_MGU) + (size_t)hh * 14 * 256 * DM * 2; S.bstep = (size_t)256 * DM * 2; S.estep = (size_t)2 * DFFE * DM * 2;
    EpiSwiglu E; E.O = (bf16_t*)(ws + WS_MACT); E.ldc = DFFH; E.pn_off = 0; pg8::gemm_phase<EpiSwiglu, SchedMoe, true>(F.lds, F.tid, DM, DM, DM, S, E, (const LAS unsigned*)(F.lds + LDS_GTAB));
}
template <bool ACCUM>
PHASE g_moe_down(int wv, unsigned char* ws_, int hh_) {
    unsigned char* ws = uni(ws_); const int hh = uni(hh_); const Frame F = mkframe(ws, wv); const LAS int* tab = (const LAS int*)(F.lds + LDS_TAB);
    const float* row_w = (const float*)((const int*)(ws + WS_TOK) + 6 * MTOK + MAXROWS);
    SchedMoe S; S.G = F.G; S.c = F.blk; S.ncol = 4; S.ntile = tab[0]; S.tab = tab + 16; S.A = (const char*)(ws + WS_MACT); S.astep = (size_t)256 * DFFH * 2;
    S.B = (const char*)(ws + WS_MD) + (size_t)hh * DFFH * 2; S.bstep = (size_t)256 * DFFE * 2; S.estep = (size_t)DM * DFFE * 2;
    EpiMoeOut<ACCUM> E; E.row_w = row_w; E.O = (bf16_t*)(ws + WS_OUT2); pg8::gemm_phase(F.lds, F.tid, DFFH, DFFH, DFFE, S, E);
}

typedef const __attribute__((address_space(4))) Params* KPtr;
__device__ __forceinline__ KPtr kargs() { KPtr k = (KPtr)__builtin_amdgcn_kernarg_segment_ptr(); asm volatile("" : "+s"(k)); return k; }
#define KIN(i) (kargs()->in[i])
#define KWS() (kargs()->ws)
struct TpState { unsigned long long tp0, tp1; int tpk; };
#define tp0 tps.tp0
#define tp1 tps.tp1
#define tpk tps.tpk
#define GRID_BAR() do { XcdBarrier b_ = bar; b_.bar = (unsigned*)(KWS() + WS_CTL) + CW_BAR; b_.x = xb_xcc_id(); xcd_barrier(b_); } while (0)
#ifdef TPH
#define TP(k) do { if ((k) == TPH) tp0 = __builtin_amdgcn_s_memrealtime(); if ((k) == TPH + TPN) tp1 = __builtin_amdgcn_s_memrealtime(); } while (0)
#define TPM() do { ++tpk; TP(tpk); } while (0)
#else
#define TP(k) do { } while (0)
#define TPM() do { } while (0)
#endif
template <int layer>
__device__ __forceinline__ void layer_body(const int wv, const XcdBarrier& bar, TpState& tps) {
        f_rms(wv, KWS(), layer == 0 ? KIN(I_X) : (const float*)kargs()->out, KIN(I_ANORM) + layer * DM);
        GRID_BAR();
        TPM();
        g_inproj(wv, KWS(), layer);
        GRID_BAR();
        TPM();
        f_prep(wv, KWS(), KIN(I_MU) + (size_t)layer * RWKV_COLS, KIN(I_QNORM) + layer * 256, KIN(I_KVNORM) + layer * 128, layer);
        GRID_BAR();
        TPM();
        f_ret_scan(wv, KWS());
        g_lora(wv, KWS(), KIN(I_W0) + layer * 512, KIN(I_A0) + layer * 512, layer);
        g_small(wv, KWS(), layer);
        GRID_BAR();
        TPM();
        f_ret_out(wv, KWS());
#ifndef RWKV_SEQ
        f_rwkv_pre(wv, KWS(), KIN(I_MU) + (size_t)layer * RWKV_COLS, KIN(I_KK) + layer * 512, KIN(I_KA) + layer * 512, KIN(I_RK) + layer * 512);
        GRID_BAR();
        TPM();
        if ((int)blockIdx.x < 16) f_rwkv_scan(wv, KWS());
#else
        GRID_BAR();
        TPM();
        if (blockIdx.x < 16) f_rwkv_seq(wv, KWS(), KIN(I_MU) + (size_t)layer * RWKV_COLS, KIN(I_KK) + layer * 512, KIN(I_KA) + layer * 512, KIN(I_RK) + layer * 512, KIN(I_LNX) + layer * 512, layer);
#endif
        f_attn(wv, KWS());
        GRID_BAR();
        TPM();
#ifndef RWKV_SEQ
        f_rwkv_out(wv, KWS(), KIN(I_LNX) + layer * 512);
#endif
        g_gate(wv, KWS(), layer);
#ifndef RWKV_SEQ
        GRID_BAR();
        TPM();
#endif
        g_merge(wv, KWS(), layer);
        GRID_BAR();
        TPM();
        g_wo(wv, KWS(), layer == 0 ? KIN(I_X) : (const float*)kargs()->out, kargs()->out, layer);
        GRID_BAR();
        TPM();
        if constexpr (layer == 0) {
            f_rms(wv, KWS(), kargs()->out, KIN(I_FNORM) + layer * DM);
            GRID_BAR();
            TPM();
            g_ffn_gu(wv, KWS());
            GRID_BAR();
            TPM();
            g_ffn_down(wv, KWS(), kargs()->out);
            GRID_BAR();
            TPM();
        } else {
            f_rms_moe(wv, KWS(), kargs()->out, KIN(I_FNORM) + layer * DM, KIN(I_ROUTER));
            GRID_BAR();
            TPM();
            f_moe_scatter(wv, KWS());
            f_moe_convert(wv, KWS(), KIN(I_MG), KIN(I_MU2), KIN(I_MD));
            GRID_BAR();
            TPM();
            g_moe_gu(wv, KWS(), 0);
            GRID_BAR();
            TPM();
            g_moe_down<false>(wv, KWS(), 0);
            GRID_BAR();
            TPM();
            g_moe_gu(wv, KWS(), 1);
            GRID_BAR();
            TPM();
            g_moe_down<true>(wv, KWS(), 1);
            GRID_BAR();
            TPM();
        }
    }
__global__ void __launch_bounds__(NTHR, 2) mega(Params P_unused) {
    LAS unsigned char* lds = (LAS unsigned char*)lds_raw;
    const int wv = __builtin_amdgcn_readfirstlane((int)threadIdx.x >> 6);
    for (int u = threadIdx.x; u < (LDS_BYTES - LDSCTL_OFF) / 4; u += NTHR) ((LAS unsigned*)(lds + LDSCTL_OFF))[u] = 0u;
    __syncthreads();
    const XcdBarrier bar = xcd_barrier_post((unsigned*)(KWS() + WS_CTL) + CW_BAR, (volatile LAS unsigned*)(lds + LDSCTL_OFF), wv);
    TpState tps = {0ull, 0ull, 0};
    TP(0);
    {
        KPtr k = kargs(); unsigned char* ws = k->ws; const Frame F = mkframe(ws, wv);
        Params P; P.in[I_WIN] = k->in[I_WIN]; P.in[I_WQB] = k->in[I_WQB]; P.in[I_WBR] = k->in[I_WBR]; P.in[I_WO] = k->in[I_WO]; P.in[I_FG] = k->in[I_FG]; P.in[I_FU] = k->in[I_FU]; P.in[I_FD] = k->in[I_FD];
        P.in[I_W2] = k->in[I_W2]; P.in[I_A2] = k->in[I_A2]; P.in[I_G2] = k->in[I_G2]; P.in[I_WKVB] = k->in[I_WKVB]; P.in[I_POS] = k->in[I_POS];
        phase_prologue(F, P);
    }
    GRID_BAR();
    TPM();
    layer_body<0>(wv, bar, tps);
    layer_body<1>(wv, bar, tps);
    f_final(wv, KWS(), kargs()->out, KIN(I_FINAL));
#ifdef TPH
    __syncthreads(); TPM();
    { const unsigned long long te = __builtin_amdgcn_s_memrealtime(), span = (tp1 - tp0) * (unsigned long long)TAMP; while (__builtin_amdgcn_s_memrealtime() - te < span) __builtin_amdgcn_s_sleep(8); }
#endif
}

extern "C" void kernel_launch(void* const* d_in, const int* in_sizes, int n_in, void* d_out, int out_size, void* d_ws, size_t ws_size, hipStream_t stream) {
    static int ready = 0;
    if (!ready) {
        if (n_in != 29 || out_size != MTOK * DM || ws_size < WS_END) { fprintf(stderr, "kernel_launch: unexpected shapes (n_in %d out %d ws %zu need %zu)\n", n_in, out_size, ws_size, (size_t)WS_END); ready = -1; return; }
        if (hipFuncSetAttribute((const void*)mega, hipFuncAttributeMaxDynamicSharedMemorySize, LDS_BYTES) != hipSuccess) { fprintf(stderr, "kernel_launch: hipFuncSetAttribute failed\n"); ready = -1; return; }
        int dev = 0, cus = 0, per_cu = 0; (void)hipGetDevice(&dev); (void)hipDeviceGetAttribute(&cus, hipDeviceAttributeMultiprocessorCount, dev);
        (void)hipOccupancyMaxActiveBlocksPerMultiprocessor(&per_cu, (const void*)mega, NTHR, LDS_BYTES);
        if (cus < 256 || per_cu < 1) { fprintf(stderr, "kernel_launch: needs 256 CUs with one resident workgroup each (cus %d, per_cu %d)\n", cus, per_cu); ready = -1; return; }
        ready = 1;
    }
    if (ready < 0) return;
    (void)hipMemsetAsync((char*)d_ws + WS_CTL, 0, CTL_BYTES, stream);
    Params p{}; for (int i = 0; i < 29; ++i) p.in[i] = (const float*)d_in[i]; p.out = (float*)d_out; p.ws = (unsigned char*)d_ws;
    hipLaunchKernelGGL(mega, dim3(256), dim3(NTHR), LDS_BYTES, stream, p);
}
```

```cpp
#include <hip/hip_runtime.h>
#include <cstdio>
#include <cstdint>

#define LAS __attribute__((address_space(3)))
#define GAS __attribute__((address_space(1)))
typedef unsigned short bf16_t;
typedef short bf16x8 __attribute__((ext_vector_type(8)));
typedef short bf16x4 __attribute__((ext_vector_type(4)));
typedef float f32x4 __attribute__((ext_vector_type(4)));
typedef float f32x2 __attribute__((ext_vector_type(2)));
typedef float f32x16 __attribute__((ext_vector_type(16)));
typedef unsigned u32x4 __attribute__((ext_vector_type(4)));
typedef unsigned u32x2 __attribute__((ext_vector_type(2)));

constexpr int NB = 2, SEQ = 8192, DM = 1024, MTOK = NB * SEQ, NLAYER = 2, CH = 64, NCHUNK = SEQ / CH;
constexpr int IN_COLS = 7360, PW = 4608;
constexpr int P_RQ = 0, P_RK = 512, P_RV = 1024, P_RG = 1536, P_RW = 2048, P_QA = 4096, P_KVA = 4352;
constexpr int WIN_ROWS = 7680;
constexpr int RWKV_COLS = 1824, LORA_K = 384, LO_W = 1536;
constexpr int DFF = 2816, DFFE = 3584, NEXP = 8, DFFH = DFFE / 2;
constexpr int MAXROWS = 34816;
constexpr float NORM_EPS = 1e-6f;

constexpr size_t MiB = 1u << 20;
constexpr size_t WS_CTL = 0, CTL_BYTES = 1 * MiB;
constexpr size_t WS_WIN = 1 * MiB;
constexpr size_t WS_LORA = 31 * MiB;
constexpr size_t WS_QB = 34 * MiB;
constexpr size_t WS_KB = 35 * MiB;
constexpr size_t WS_VB = 35 * MiB + 512 * 1024;
constexpr size_t WS_BR = 36 * MiB;
constexpr size_t WS_WO = 42 * MiB;
constexpr size_t WS_FGU = 46 * MiB;
constexpr size_t WS_FD = 57 * MiB;
constexpr size_t WS_COSR = 63 * MiB, WS_SINR = 67 * MiB, WS_COSM = 71 * MiB, WS_SINM = 72 * MiB;
constexpr size_t WS_HN = 73 * MiB;
constexpr size_t WS_TOK = 105 * MiB;
constexpr size_t WS_T = 106 * MiB;
constexpr size_t WS_P = WS_T;
constexpr size_t WS_G = WS_T;
constexpr size_t WS_MRG = WS_T + 96 * MiB;
constexpr size_t WS_LO = WS_T + 144 * MiB;
constexpr size_t WS_Q = WS_T + 192 * MiB;
constexpr size_t WS_KN = WS_T + 216 * MiB;
constexpr size_t WS_VT = WS_T + 232 * MiB;
constexpr size_t WS_KPE = WS_T + 248 * MiB;
constexpr size_t WS_LIN = WS_T + 249 * MiB;
constexpr size_t WS_QN = WS_T + 261 * MiB;
constexpr size_t WS_CN = WS_T + 269 * MiB;
constexpr size_t WS_YRET = WS_T + 261 * MiB;
constexpr size_t WS_RS = WS_T + 277 * MiB;
constexpr size_t WS_YRW = WS_T + 277 * MiB;
constexpr size_t WS_YMLA = WS_T + 293 * MiB;
constexpr size_t WS_RC = WS_T + 309 * MiB;
constexpr size_t WS_ACT = WS_T;
constexpr size_t WS_MGU = WS_T;
constexpr size_t WS_MD = WS_T + 112 * MiB;
constexpr size_t WS_MACT = WS_T + 168 * MiB;
constexpr size_t WS_OUT2 = WS_T + 287 * MiB;
constexpr size_t WS_END = WS_T + 390 * MiB;
static_assert(WS_MACT + (size_t)MAXROWS * DFFH * 2 <= WS_OUT2 && WS_OUT2 + (size_t)MAXROWS * DM * 2 <= WS_END, "ws map");
constexpr int CW_BAR = 4096;
constexpr int CW_ECNT = 16384;
constexpr int CW_ATTQ = 20480;

__device__ __forceinline__ unsigned f2bf(float f) { unsigned u = __builtin_bit_cast(unsigned, f); return (u + 0x7fffu + ((u >> 16) & 1u)) >> 16; }
typedef __bf16 bf16n2 __attribute__((ext_vector_type(2)));
__device__ __forceinline__ unsigned pk2(float lo, float hi) { const f32x2 f = {lo, hi}; const bf16n2 v = __builtin_convertvector(f, bf16n2); return __builtin_bit_cast(unsigned, v); }
__device__ __forceinline__ float bf2f(unsigned short h) { return __builtin_bit_cast(float, (unsigned)h << 16); }
__device__ __forceinline__ float bflo(unsigned w) { return __builtin_bit_cast(float, w << 16); }
__device__ __forceinline__ float bfhi(unsigned w) { return __builtin_bit_cast(float, w & 0xffff0000u); }
template <int CTRL, int ROWMASK = 0xF>
__device__ __forceinline__ float dpp_add(float v) { const int t = __builtin_amdgcn_update_dpp(0, __builtin_bit_cast(int, v), CTRL, ROWMASK, 0xF, ROWMASK == 0xF); return v + __builtin_bit_cast(float, t); }
#ifdef NO_DPP
__device__ __forceinline__ float sum4(float v)  { v += __shfl_xor(v, 1); v += __shfl_xor(v, 2); return v; }
__device__ __forceinline__ float sum8(float v)  { v = sum4(v); v += __shfl_xor(v, 4); return v; }
__device__ __forceinline__ float sum16(float v) { v = sum8(v); v += __shfl_xor(v, 8); return v; }
__device__ __forceinline__ float wave_sum(float v) { v = sum16(v); v += __shfl_xor(v, 16); v += __shfl_xor(v, 32); return v; }
#else
__device__ __forceinline__ float sum4(float v)  { v = dpp_add<0xB1>(v); return dpp_add<0x4E>(v); }
__device__ __forceinline__ float sum8(float v)  { return dpp_add<0x141>(sum4(v)); }
__device__ __forceinline__ float sum16(float v) { return dpp_add<0x140>(sum8(v)); }
__device__ __forceinline__ float wave_sum(float v) {
    v = sum16(v); v = dpp_add<0x142, 0xA>(v); v = dpp_add<0x143, 0xC>(v);
    return __builtin_bit_cast(float, __builtin_amdgcn_readlane(__builtin_bit_cast(int, v), 63));
}
#endif
__device__ __forceinline__ float sigmoidf_(float x) { return 1.0f / (1.0f + __expf(-x)); }
#define LDS_WAIT() asm volatile("s_waitcnt lgkmcnt(0)" ::: "memory")
#define LBAR() do { asm volatile("s_waitcnt lgkmcnt(0)" ::: "memory"); __builtin_amdgcn_s_barrier(); asm volatile("" ::: "memory"); } while (0)
#define VM_WAIT() asm volatile("s_waitcnt vmcnt(0)" ::: "memory")

#define XB_TMO      128
#define XB_XCNT(j)  (256  + 64 * (j))
#define XB_XSUB(j)  (1280 + 64 * (j))
#define XB_XGEN(j)  (2304 + 64 * (j))
#define XB_TOP      3328
#define XB_TOPGEN   3392
#define XCD_BAR_WORDS 3456
#define XB_SPIN_CAP (1u << 18)
__device__ __forceinline__ unsigned xb_ld(unsigned* p)              { return __hip_atomic_load(p, __ATOMIC_RELAXED, __HIP_MEMORY_SCOPE_AGENT); }
__device__ __forceinline__ unsigned xb_add(unsigned* p, unsigned v) { return __hip_atomic_fetch_add(p, v, __ATOMIC_RELAXED, __HIP_MEMORY_SCOPE_AGENT); }
__device__ __forceinline__ unsigned xb_xcc_id() { return (unsigned)__builtin_amdgcn_s_getreg((3 << 11) | 20) & 0xFu; }
#define XB_SPIN(cond, bar) do { unsigned _sp = 0; while (cond) { __builtin_amdgcn_s_sleep(1); \
    if ((++_sp & 255u) == 0u) { if (xb_ld(&(bar)[XB_TMO])) break; if (_sp > XB_SPIN_CAP) { atomicAdd(&(bar)[XB_TMO], 1u); break; } } } } while (0)
struct XcdBarrier { unsigned* bar; unsigned x; volatile LAS unsigned* st; int wv; };
__device__ __forceinline__ int lane_id_fresh() { int l; asm volatile("v_mbcnt_lo_u32_b32 %0, -1, 0\n\tv_mbcnt_hi_u32_b32 %0, -1, %0" : "=v"(l)); return l; }
__device__ __forceinline__ bool xb_thread0(int wv) { return wv == 0 && lane_id_fresh() == 0; }
__device__ __forceinline__ XcdBarrier xcd_barrier_post(unsigned* bar, volatile LAS unsigned* st, int wv) {
    XcdBarrier b; b.bar = bar; b.x = xb_xcc_id(); b.st = st; b.wv = wv;
    if (xb_thread0(wv)) (void)xb_add(&bar[XB_XCNT(b.x)], 1u);
    return b;
}
__device__ __forceinline__ void xcd_barrier_complete(unsigned* bar, unsigned x, unsigned& nloc, unsigned& nx) {
    const unsigned G = gridDim.x * gridDim.y * gridDim.z;
    unsigned sum, cnt, mine, sp = 0u;
    for (;;) {
        sum = 0u; cnt = 0u; mine = 0u;
#pragma unroll
        for (unsigned j = 0; j < 16; ++j) { const unsigned c = xb_ld(&bar[XB_XCNT(j)]); sum += c; cnt += (c > 0u) ? 1u : 0u; mine = (j == x) ? c : mine; }
        if (sum == G) break;
        __builtin_amdgcn_s_sleep(1);
        if ((++sp & 255u) == 0u) { if (xb_ld(&bar[XB_TMO])) break; if (sp > XB_SPIN_CAP) { atomicAdd(&bar[XB_TMO], 1u); break; } }
    }
    nloc = mine > 0u ? mine : 1u; nx = cnt > 0u ? cnt : 1u;
}
__device__ __forceinline__ void xcd_barrier(const XcdBarrier& b) {
    asm volatile("s_waitcnt vmcnt(0)" ::: "memory");
    __syncthreads();
    if (xb_thread0(b.wv)) {
        unsigned* bar = b.bar;
        __builtin_amdgcn_s_waitcnt(0);
        unsigned nloc = b.st[0], nx = b.st[1];
        if (nloc == 0u) { xcd_barrier_complete(bar, b.x, nloc, nx); b.st[0] = nloc; b.st[1] = nx; }
        const unsigned old = xb_add(&bar[XB_XSUB(b.x)], 1u);
        const unsigned gen = old / nloc;
        if (old + 1u == (gen + 1u) * nloc) {
            __builtin_amdgcn_fence(__ATOMIC_RELEASE, "agent");
            asm volatile("s_waitcnt vmcnt(0)" ::: "memory");
            const unsigned og = xb_add(&bar[XB_TOP], 1u);
            const unsigned tg = og / nx;
            if (og + 1u == (tg + 1u) * nx) xb_add(&bar[XB_TOPGEN], 1u);
            else XB_SPIN(xb_ld(&bar[XB_TOPGEN]) == tg, bar);
            __builtin_amdgcn_fence(__ATOMIC_ACQUIRE, "agent");
            xb_add(&bar[XB_XGEN(b.x)], 1u);
            asm volatile("s_waitcnt vmcnt(0)" ::: "memory");
        } else {
            XB_SPIN(xb_ld(&bar[XB_XGEN(b.x)]) == gen, bar);
            __builtin_amdgcn_fence(__ATOMIC_ACQUIRE, "agent");
            asm volatile("s_waitcnt vmcnt(0)" ::: "memory");
        }
    }
    __syncthreads();
}

namespace pg8 {
constexpr int BM = 256, BK = 64, HALF = 128, HTB = HALF * BK * 2, STAGE_BYTES = 8 * HTB;
__device__ __forceinline__ int lds_byte(int r, int c) { const int st = (r >> 4) * 2 + (c >> 5), rr = r & 15, cc = c & 31, ob = rr * 64 + cc * 2; return st * 1024 + (ob ^ (((ob >> 9) & 1) << 5)); }
__device__ __forceinline__ void stage_rc(int b, int& R, int& C) { const int st = b / 1024, sb = b % 1024, swz = sb ^ (((sb >> 9) & 1) << 5); R = (st >> 1) * 16 + swz / 64; C = (st & 1) * 32 + (swz % 64) / 2; }
__device__ __forceinline__ int perm32(int rho) { const int n = rho >> 4, i = rho & 15; return 8 * (i >> 2) + 4 * n + (i & 3); }
struct Unit { int pm, pn, aux; const char* A; const char* B; };
__device__ __forceinline__ unsigned cvt_pk_bf16(float lo, float hi) { return pk2(lo, hi); }

template <class Epi, class Sched, bool GATHER = false>
__device__ __forceinline__ void gemm_phase(LAS unsigned char* lds, const int tid_in, const int K, const int lda, const int ldb, const Sched& S, const Epi& E, const LAS unsigned* gtab = nullptr) {
    int tid_ = tid_in; asm volatile("" : "+v"(tid_));
    const int tid = tid_, wid = __builtin_amdgcn_readfirstlane(tid >> 6), lane = tid & 63, wr = wid >> 2, wc = wid & 3, fr = lane & 15, fq = lane >> 4;
    const int nt = K / BK;
    unsigned voffA[2], voffB[2];
#pragma unroll
    for (int i = 0; i < 2; ++i) { int R, C; stage_rc(tid * 16 + i * 8192, R, C); const int Rb = Epi::PERM ? ((R & ~31) + perm32(R & 31)) : R;
        voffA[i] = (unsigned)(R * lda + C) * 2u; voffB[i] = (unsigned)(Rb * ldb + C) * 2u; }
    const size_t kstep = (size_t)(BK * 2);
    const size_t hstepA = GATHER ? (size_t)0 : (size_t)HALF * lda * 2, hstepB = (size_t)HALF * ldb * 2;
    int gR[2], gC[2]; unsigned gcur[2][2], gnxt[2][2];
    if constexpr (GATHER) {
#pragma unroll
        for (int i = 0; i < 2; ++i) { int R, C; stage_rc(tid * 16 + i * 8192, R, C); gR[i] = R; gC[i] = C * 2; }
    }
#define PG8_GLOAD(dst, u_) do { _Pragma("unroll") for (int _h = 0; _h < 2; ++_h) _Pragma("unroll") for (int _i = 0; _i < 2; ++_i) dst[_h][_i] = gtab[(u_) * 256 + _h * 128 + gR[_i]] + (unsigned)gC[_i]; } while (0)
    const unsigned ldsw = (unsigned)wid * 1024u;
    const int aoff = lds_byte(wr * 64 + fr, fq * 8), boff = lds_byte(wc * 32 + fr, fq * 8);
#define PG8_SA(b, h) (((b) * 2 + (h)) * HTB)
#define PG8_SB(b, h) ((4 + (b) * 2 + (h)) * HTB)
#define PG8_STAGE(bufoff, gbase, voff) do { _Pragma("unroll") for (int _i = 0; _i < 2; ++_i) \
        __builtin_amdgcn_global_load_lds((const unsigned*)((const char*)(gbase) + (voff)[_i]), (LAS unsigned*)(lds + (bufoff) + ldsw + _i * 8192), 16, 0, 0); } while (0)
#define PG8_STAGEA(bufoff, gbase, h, tab) do { if constexpr (GATHER) { PG8_STAGE(bufoff, gbase, tab[h]); } else { PG8_STAGE(bufoff, (gbase) + (h) * hstepA, voffA); } } while (0)
#define PG8_LDA(dst, b, h) do { _Pragma("unroll") for (int m = 0; m < 4; ++m) _Pragma("unroll") for (int k = 0; k < 2; ++k) dst[m][k] = *(const LAS bf16x8*)(lds + PG8_SA(b, h) + aoff + m * 2048 + k * 1024); } while (0)
#define PG8_LDB(dst, b, h) do { _Pragma("unroll") for (int n = 0; n < 2; ++n) _Pragma("unroll") for (int k = 0; k < 2; ++k) dst[n][k] = *(const LAS bf16x8*)(lds + PG8_SB(b, h) + boff + n * 2048 + k * 1024); } while (0)
#define PG8_MMA(ai, bj, At, Bt) do { __builtin_amdgcn_s_setprio(1); _Pragma("unroll") for (int m = 0; m < 4; ++m) _Pragma("unroll") for (int n = 0; n < 2; ++n) _Pragma("unroll") for (int k = 0; k < 2; ++k) \
        acc[ai][bj][m][n] = __builtin_amdgcn_mfma_f32_16x16x32_bf16(Bt[n][k], At[m][k], acc[ai][bj][m][n], 0, 0, 0); __builtin_amdgcn_s_setprio(0); } while (0)
#define PG8_WAIT_V(n) asm volatile("s_waitcnt vmcnt(" #n ")" ::: "memory")
#define PG8_WAIT_L(n) asm volatile("s_waitcnt lgkmcnt(" #n ")" ::: "memory")
#define PG8_BAR __builtin_amdgcn_s_barrier()
#define PG8_SCHED __builtin_amdgcn_sched_barrier(0)
    Unit cur, nxt; int ui = 0;
    if (!S.next(0, cur)) return;
    f32x4 acc[2][2][4][2];
#pragma unroll
    for (int a = 0; a < 2; ++a)
#pragma unroll
        for (int b = 0; b < 2; ++b)
#pragma unroll
            for (int m = 0; m < 4; ++m)
#pragma unroll
                for (int n = 0; n < 2; ++n) acc[a][b][m][n] = (f32x4){0.f, 0.f, 0.f, 0.f};
    bf16x8 At[4][2], B0[2][2], B1[2][2];
    const char* cA = cur.A; const char* cB = cur.B;
    if constexpr (GATHER) { PG8_GLOAD(gcur, 0); PG8_GLOAD(gnxt, 1); asm volatile("s_waitcnt lgkmcnt(0)" ::: "memory"); }
    PG8_STAGE(PG8_SB(0, 0), cB, voffB); PG8_STAGE(PG8_SB(0, 1), cB + hstepB, voffB); PG8_STAGEA(PG8_SA(0, 0), cA, 0, gcur); PG8_STAGEA(PG8_SA(0, 1), cA, 1, gcur);
    if (wr == 1) PG8_BAR;
    PG8_WAIT_V(2); PG8_BAR;
    PG8_STAGE(PG8_SB(1, 0), cB + kstep, voffB); PG8_STAGEA(PG8_SA(1, 0), cA + kstep, 0, gcur); PG8_STAGE(PG8_SB(1, 1), cB + hstepB + kstep, voffB);
    PG8_WAIT_V(6); PG8_BAR;
#pragma unroll 1
    for (;;) {
        const bool has_next = S.next(ui + 1, nxt);
        const char* nA = has_next ? nxt.A : cA; const char* nB = has_next ? nxt.B : cB;
#pragma unroll 1
        for (int t = 0; t < nt; t += 2) {
            const bool last = (t == nt - 2);
            const char* a1 = cA + (size_t)(t + 1) * kstep;
            const char* a2 = last ? nA : cA + (size_t)(t + 2) * kstep; const char* b2 = last ? nB : cB + (size_t)(t + 2) * kstep;
            const char* a3 = a2 + kstep; const char* b3 = b2 + kstep;
            unsigned g2[2][2];
            if constexpr (GATHER) {
#pragma unroll
                for (int _h = 0; _h < 2; ++_h)
#pragma unroll
                    for (int _i = 0; _i < 2; ++_i) g2[_h][_i] = last ? gnxt[_h][_i] : gcur[_h][_i]; }
            PG8_LDB(B0, 0, 0); PG8_LDB(B1, 0, 1); PG8_SCHED; PG8_LDA(At, 0, 0); PG8_STAGEA(PG8_SA(1, 1), a1, 1, gcur);
            PG8_WAIT_V(8); PG8_WAIT_L(0); PG8_BAR; PG8_MMA(0, 0, At, B0); PG8_MMA(0, 1, At, B1); PG8_BAR; PG8_SCHED;
            PG8_LDA(At, 0, 1); PG8_STAGE(PG8_SB(0, 0), b2, voffB); PG8_STAGE(PG8_SB(0, 1), b2 + hstepB, voffB); PG8_STAGEA(PG8_SA(0, 0), a2, 0, g2);
            PG8_WAIT_V(8); PG8_WAIT_L(0); PG8_BAR; PG8_MMA(1, 0, At, B0); PG8_MMA(1, 1, At, B1); PG8_BAR; PG8_SCHED;
            PG8_LDB(B0, 1, 0); PG8_LDB(B1, 1, 1); PG8_SCHED; PG8_LDA(At, 1, 0); PG8_STAGEA(PG8_SA(0, 1), a2, 1, g2);
            PG8_WAIT_V(8); PG8_WAIT_L(0); PG8_BAR; PG8_MMA(0, 0, At, B0); PG8_MMA(0, 1, At, B1); PG8_BAR; PG8_SCHED;
            PG8_LDA(At, 1, 1); PG8_STAGE(PG8_SB(1, 0), b3, voffB); PG8_STAGE(PG8_SB(1, 1), b3 + hstepB, voffB); PG8_STAGEA(PG8_SA(1, 0), a3, 0, g2);
            PG8_WAIT_V(8); PG8_WAIT_L(0); PG8_BAR; PG8_MMA(1, 0, At, B0); PG8_MMA(1, 1, At, B1); PG8_BAR; PG8_SCHED;
        }
        if (wr == 0) PG8_BAR;
        E(acc, cur, wr, wc, fr, fq);
        if (!has_next) break;
#pragma unroll
        for (int a = 0; a < 2; ++a)
#pragma unroll
            for (int b = 0; b < 2; ++b)
#pragma unroll
                for (int m = 0; m < 4; ++m)
#pragma unroll
                    for (int n = 0; n < 2; ++n) acc[a][b][m][n] = (f32x4){0.f, 0.f, 0.f, 0.f};
        cur = nxt; cA = nA; cB = nB; ++ui;
        if constexpr (GATHER) {
#pragma unroll
            for (int _h = 0; _h < 2; ++_h)
#pragma unroll
                for (int _i = 0; _i < 2; ++_i) gcur[_h][_i] = gnxt[_h][_i];
            PG8_GLOAD(gnxt, ui + 1); }
        if (wr == 1) PG8_BAR;
    }
    PG8_WAIT_V(0);
    PG8_BAR;
#undef PG8_SA
#undef PG8_SB
#undef PG8_STAGE
#undef PG8_STAGEA
#undef PG8_GLOAD
#undef PG8_LDA
#undef PG8_LDB
#undef PG8_MMA
#undef PG8_WAIT_V
#undef PG8_WAIT_L
#undef PG8_BAR
#undef PG8_SCHED
}
}
constexpr int NWAVES = 8, NTHR = 512;
constexpr int RING_BYTES = 131072, LDS_BYTES = 147456, LDSCTL_OFF = LDS_BYTES - 2048;
struct Params { const float* in[29]; float* out; unsigned char* ws; };
struct Frame {
    LAS unsigned char* lds; int tid, lane, wave, blk, G, vcu, gw, ngw; unsigned char* ws;
};
enum { I_X = 0, I_POS, I_ANORM, I_WIN, I_MU, I_W0, I_W2, I_A0, I_A2, I_G2, I_KK, I_KA, I_RK, I_LNX, I_QNORM, I_WQB, I_KVNORM, I_WKVB, I_WBR, I_WO, I_FNORM,
       I_FG, I_FU, I_FD, I_ROUTER, I_MG, I_MU2, I_MD, I_FINAL };

struct SchedGrid {
    int nM, nN, nwg, G, c; const char* A; const char* B; size_t astep, bstep;
    __device__ void init(int nM_, int nN_, int G_, int c_, const void* A_, size_t astep_, const void* B_, size_t bstep_) { nM = nM_; nN = nN_; nwg = nM * nN; G = G_; c = c_; A = (const char*)A_; B = (const char*)B_; astep = astep_; bstep = bstep_; }
    __device__ __forceinline__ bool next(int i, pg8::Unit& u) const {
        const long L = (long)i * G + c; if (L >= nwg) return false;
        int wgid = (int)L; { const int q = nwg / 8, r = nwg % 8, xcd = wgid % 8, off = wgid / 8; wgid = (xcd < r ? xcd * (q + 1) : r * (q + 1) + (xcd - r) * q) + off; }
        const int nig = 8 * nN, gid = wgid / nig, fm = gid * 8, gsz = (nM - fm) < 8 ? (nM - fm) : 8;
        u.pm = fm + ((wgid % nig) % gsz); u.pn = (wgid % nig) / gsz; u.aux = 0;
        u.A = A + (size_t)u.pm * astep; u.B = B + (size_t)u.pn * bstep; return true;
    }
};
struct SchedSmall {
    int G, c, layer; const char* ws;
    __device__ __forceinline__ bool next(int i, pg8::Unit& u) const {
        int L = i * G + c; if (L >= 448) return false;
        int s = 0; if (L >= 192) { L -= 192; s = 1; if (L >= 128) { L -= 128; s = 2; } }
        const int nn = s == 0 ? 3 : (s == 1 ? 2 : 64);
        u.pm = L / nn; u.pn = L % nn; u.aux = s;
        const size_t lw = (size_t)layer * 256 * 2;
        const size_t ao = s == 0 ? WS_QN : (s == 1 ? WS_CN : WS_VB + lw * 512), bo = s == 0 ? WS_QB + lw * 768 : (s == 1 ? WS_KB + lw * 512 : WS_CN);
        u.A = ws + ao + (size_t)u.pm * (256 * 256 * 2); u.B = ws + bo + (size_t)u.pn * (256 * 256 * 2); return true;
    }
};
struct SchedOwn3 {
    int c, G; const char* A; const char* B; size_t astep, bstep, a_n, b_n;
    __device__ __forceinline__ bool next(int i, pg8::Unit& u) const {
        const int t = c + (i / 3) * G; if (t >= 256) return false;
        const int n = i % 3; u.pm = t >> 2; u.pn = t & 3; u.aux = n; u.A = A + (size_t)u.pm * astep + (size_t)n * a_n; u.B = B + (size_t)u.pn * bstep + (size_t)n * b_n; return true;
    }
};
struct SchedMoe {
    int G, c, ncol, ntile; const LAS int* tab; const char* A; const char* B; size_t astep, bstep, estep;
    __device__ __forceinline__ bool next(int i, pg8::Unit& u) const {
        const int L = i * G + c; if (L >= ntile * ncol) return false;
        u.pm = L / ncol; u.pn = L % ncol; const int e = tab[u.pm]; u.aux = e;
        u.A = A + (size_t)u.pm * astep; u.B = B + (size_t)e * estep + (size_t)u.pn * bstep; return true;
    }
};

using pg8::Unit; using pg8::cvt_pk_bf16;
#define EPI_ARGS const f32x4 (&acc)[2][2][4][2], const Unit& u, int wr, int wc, int fr, int fq
struct EpiStore {
    static constexpr bool PERM = true;
    bf16_t* O; int ld;
    __device__ __forceinline__ void operator()(EPI_ARGS) const {
        const int row0 = u.pm * 256 + wr * 64 + fr, col0 = u.pn * 256 + wc * 32 + 8 * fq;
#pragma unroll
        for (int ai = 0; ai < 2; ++ai)
#pragma unroll
            for (int m = 0; m < 4; ++m) { bf16_t* rowp = O + (size_t)(row0 + ai * 128 + m * 16) * ld + col0;
#pragma unroll
                for (int bj = 0; bj < 2; ++bj) { const f32x4 v0 = acc[ai][bj][m][0], v1 = acc[ai][bj][m][1];
                    u32x4 w; w.x = cvt_pk_bf16(v0[0], v0[1]); w.y = cvt_pk_bf16(v0[2], v0[3]); w.z = cvt_pk_bf16(v1[0], v1[1]); w.w = cvt_pk_bf16(v1[2], v1[3]);
                    *(u32x4*)(rowp + bj * 128) = w; } }
    }
};
struct EpiSmall {
    static constexpr bool PERM = true;
    unsigned char* ws;
    __device__ __forceinline__ void operator()(EPI_ARGS) const {
        bf16_t* base = (bf16_t*)(ws + (u.aux == 0 ? WS_Q : (u.aux == 1 ? WS_KN : WS_VT))); const int ld = u.aux == 0 ? 768 : (u.aux == 1 ? 512 : MTOK);
        const int row0 = u.pm * 256 + wr * 64 + fr, col0 = u.pn * 256 + wc * 32 + 8 * fq;
#pragma unroll
        for (int ai = 0; ai < 2; ++ai)
#pragma unroll
            for (int m = 0; m < 4; ++m) { bf16_t* rowp = base + (size_t)(row0 + ai * 128 + m * 16) * ld + col0;
#pragma unroll
                for (int bj = 0; bj < 2; ++bj) { const f32x4 v0 = acc[ai][bj][m][0], v1 = acc[ai][bj][m][1];
                    u32x4 w; w.x = cvt_pk_bf16(v0[0], v0[1]); w.y = cvt_pk_bf16(v0[2], v0[3]); w.z = cvt_pk_bf16(v1[0], v1[1]); w.w = cvt_pk_bf16(v1[2], v1[3]);
                    *(u32x4*)(rowp + bj * 128) = w; } }
    }
};
struct EpiLora {
    static constexpr bool PERM = true;
    bf16_t* O; const float* w0; const float* a0;
    __device__ __forceinline__ void operator()(EPI_ARGS) const {
        const int seg = u.pn >> 1;
        const int row0 = u.pm * 256 + wr * 64 + fr, col0 = u.pn * 256 + wc * 32 + 8 * fq, ch0 = (u.pn & 1) * 256 + wc * 32 + 8 * fq;
        const float* bias = seg == 0 ? w0 : a0; const float sc = seg == 0 ? -0.6065306597126334f : 1.0f;
#pragma unroll
        for (int bj = 0; bj < 2; ++bj) {
            f32x4 b0 = {0.f, 0.f, 0.f, 0.f}, b1 = {0.f, 0.f, 0.f, 0.f};
            if (seg < 2) { b0 = *(const f32x4*)(bias + ch0 + bj * 128); b1 = *(const f32x4*)(bias + ch0 + bj * 128 + 4); }
#pragma unroll
            for (int ai = 0; ai < 2; ++ai)
#pragma unroll
                for (int m = 0; m < 4; ++m) { bf16_t* rowp = O + (size_t)(row0 + ai * 128 + m * 16) * LO_W + col0 + bj * 128;
                    f32x4 v0 = acc[ai][bj][m][0] + b0, v1 = acc[ai][bj][m][1] + b1;
                    if (seg < 2) {
#pragma unroll
                        for (int j = 0; j < 4; ++j) { v0[j] = sc * sigmoidf_(v0[j]); v1[j] = sc * sigmoidf_(v1[j]); }
                    }
                    u32x4 w; w.x = cvt_pk_bf16(v0[0], v0[1]); w.y = cvt_pk_bf16(v0[2], v0[3]); w.z = cvt_pk_bf16(v1[0], v1[1]); w.w = cvt_pk_bf16(v1[2], v1[3]);
                    *(u32x4*)rowp = w; }
        }
    }
};
struct EpiGate {
    static constexpr bool PERM = true;
    bf16_t* O;
    __device__ __forceinline__ void operator()(EPI_ARGS) const {
        const int row0 = u.pm * 256 + wr * 64 + fr, col0 = u.aux * 1024 + u.pn * 256 + wc * 32 + 8 * fq;
#pragma unroll
        for (int ai = 0; ai < 2; ++ai)
#pragma unroll
            for (int m = 0; m < 4; ++m) { bf16_t* rowp = O + (size_t)(row0 + ai * 128 + m * 16) * 3072 + col0;
#pragma unroll
                for (int bj = 0; bj < 2; ++bj) { f32x4 v0 = acc[ai][bj][m][0], v1 = acc[ai][bj][m][1];
#pragma unroll
                    for (int j = 0; j < 4; ++j) { v0[j] = sigmoidf_(v0[j]); v1[j] = sigmoidf_(v1[j]); }
                    u32x4 w; w.x = cvt_pk_bf16(v0[0], v0[1]); w.y = cvt_pk_bf16(v0[2], v0[3]); w.z = cvt_pk_bf16(v1[0], v1[1]); w.w = cvt_pk_bf16(v1[2], v1[3]);
                    *(u32x4*)(rowp + bj * 128) = w; } }
    }
};
struct EpiMerge {
    static constexpr bool PERM = true;
    const bf16_t* Gt; bf16_t* Mg;
    __device__ __forceinline__ void operator()(EPI_ARGS) const {
        const int n = u.aux;
        const int row0 = u.pm * 256 + wr * 64 + fr, col0 = u.pn * 256 + wc * 32 + 8 * fq;
#pragma unroll
        for (int ai = 0; ai < 2; ++ai)
#pragma unroll
            for (int m = 0; m < 4; ++m) { const size_t r = (size_t)(row0 + ai * 128 + m * 16);
#pragma unroll
                for (int bj = 0; bj < 2; ++bj) { const f32x4 v0 = acc[ai][bj][m][0], v1 = acc[ai][bj][m][1];
                    const u32x4 g = *(const u32x4*)(Gt + r * 3072 + n * 1024 + col0 + bj * 128);
                    float o[8] = {bflo(g.x) * v0[0], bfhi(g.x) * v0[1], bflo(g.y) * v0[2], bfhi(g.y) * v0[3], bflo(g.z) * v1[0], bfhi(g.z) * v1[1], bflo(g.w) * v1[2], bfhi(g.w) * v1[3]};
                    bf16_t* mp = Mg + r * 1024 + col0 + bj * 128;
                    if (n > 0) { const u32x4 p = *(const u32x4*)mp; o[0] += bflo(p.x); o[1] += bfhi(p.x); o[2] += bflo(p.y); o[3] += bfhi(p.y); o[4] += bflo(p.z); o[5] += bfhi(p.z); o[6] += bflo(p.w); o[7] += bfhi(p.w); }
                    u32x4 w; w.x = cvt_pk_bf16(o[0], o[1]); w.y = cvt_pk_bf16(o[2], o[3]); w.z = cvt_pk_bf16(o[4], o[5]); w.w = cvt_pk_bf16(o[6], o[7]);
                    *(u32x4*)mp = w; } }
    }
};
struct EpiResid {
    static constexpr bool PERM = false;
    const float* In; float* Out;
    __device__ __forceinline__ void operator()(EPI_ARGS) const {
        const int row0 = u.pm * 256 + wr * 64 + fr, col0 = u.pn * 256 + wc * 32 + 4 * fq;
#pragma unroll
        for (int ai = 0; ai < 2; ++ai)
#pragma unroll
            for (int m = 0; m < 4; ++m) { const size_t o = (size_t)(row0 + ai * 128 + m * 16) * DM + col0;
#pragma unroll
                for (int bj = 0; bj < 2; ++bj)
#pragma unroll
                    for (int n = 0; n < 2; ++n) { const f32x4 x = *(const f32x4*)(In + o + bj * 128 + n * 16); *(f32x4*)(Out + o + bj * 128 + n * 16) = x + acc[ai][bj][m][n]; } }
    }
};
struct EpiSwiglu {
    static constexpr bool PERM = true;
    bf16_t* O; int ldc; int pn_off;
    __device__ __forceinline__ void operator()(EPI_ARGS) const {
        const int row0 = u.pm * 256 + wr * 64 + fr, col0 = (u.pn - pn_off) * 128 + wc * 32 + 8 * fq;
#pragma unroll
        for (int ai = 0; ai < 2; ++ai)
#pragma unroll
            for (int m = 0; m < 4; ++m) { bf16_t* rowp = O + (size_t)(row0 + ai * 128 + m * 16) * ldc + col0;
                float o[8];
#pragma unroll
                for (int n = 0; n < 2; ++n)
#pragma unroll
                    for (int j = 0; j < 4; ++j) { const float g = acc[ai][0][m][n][j], up = acc[ai][1][m][n][j]; o[n * 4 + j] = g * sigmoidf_(g) * up; }
                u32x4 w; w.x = cvt_pk_bf16(o[0], o[1]); w.y = cvt_pk_bf16(o[2], o[3]); w.z = cvt_pk_bf16(o[4], o[5]); w.w = cvt_pk_bf16(o[6], o[7]);
                *(u32x4*)rowp = w; }
    }
};
template <bool ACCUM>
struct EpiMoeOut {
    static constexpr bool PERM = true;
    const float* row_w; bf16_t* O;
    __device__ __forceinline__ void operator()(EPI_ARGS) const {
        const int row0 = u.pm * 256 + wr * 64 + fr, col0 = u.pn * 256 + wc * 32 + 8 * fq;
#pragma unroll
        for (int ai = 0; ai < 2; ++ai)
#pragma unroll
            for (int m = 0; m < 4; ++m) { const int r = row0 + ai * 128 + m * 16; const float wt = row_w[r]; bf16_t* rowp = O + (size_t)r * DM + col0;
#pragma unroll
                for (int bj = 0; bj < 2; ++bj) { f32x4 v0 = acc[ai][bj][m][0] * wt, v1 = acc[ai][bj][m][1] * wt;
                    if (ACCUM) { const u32x4 p = *(const u32x4*)(rowp + bj * 128); v0[0] += bflo(p.x); v0[1] += bfhi(p.x); v0[2] += bflo(p.y); v0[3] += bfhi(p.y); v1[0] += bflo(p.z); v1[1] += bfhi(p.z); v1[2] += bflo(p.w); v1[3] += bfhi(p.w); }
                    u32x4 w; w.x = cvt_pk_bf16(v0[0], v0[1]); w.y = cvt_pk_bf16(v0[2], v0[3]); w.z = cvt_pk_bf16(v1[0], v1[1]); w.w = cvt_pk_bf16(v1[2], v1[3]);
                    *(u32x4*)(rowp + bj * 128) = w; } }
    }
};

__device__ __forceinline__ void transpose_tile64(const float* W, int ldn, int k0, int n0, bf16_t* WT, int ldk, int drow0, int drow1, int dk0, LAS float* scr, int lane) {
#ifdef SIMPLE_TR
    { const int c = lane & 7;
      for (int j = 0; j < 8; ++j) { const int n = (lane >> 3) + 8 * j; const float* s = W + (size_t)(k0 + 8 * c) * ldn + n0 + n;
        u32x4 o; o.x = pk2(s[0], s[(size_t)ldn]); o.y = pk2(s[(size_t)2 * ldn], s[(size_t)3 * ldn]); o.z = pk2(s[(size_t)4 * ldn], s[(size_t)5 * ldn]); o.w = pk2(s[(size_t)6 * ldn], s[(size_t)7 * ldn]);
        const int dr = n < 32 ? drow0 + n : drow1 + (n - 32);
        *(u32x4*)(WT + (size_t)dr * ldk + dk0 + k0 + 8 * c) = o; }
      return; }
#endif
    f32x4 v[16]; const int r4 = lane >> 4, c4 = (lane & 15) * 4;
#pragma unroll
    for (int i = 0; i < 16; ++i) v[i] = *(const f32x4*)(W + (size_t)(k0 + 4 * i + r4) * ldn + n0 + c4);
#pragma unroll
    for (int i = 0; i < 16; ++i) { LAS float* d = scr + (4 * i + r4) * 65 + c4; d[0] = v[i][0]; d[1] = v[i][1]; d[2] = v[i][2]; d[3] = v[i][3]; }
    LDS_WAIT(); asm volatile("" ::: "memory");
    const int c = lane & 7;
#pragma unroll
    for (int j = 0; j < 8; ++j) { const int n = (lane >> 3) + 8 * j; const LAS float* s = scr + (8 * c) * 65 + n;
        u32x4 o; o.x = pk2(s[0 * 65], s[1 * 65]); o.y = pk2(s[2 * 65], s[3 * 65]); o.z = pk2(s[4 * 65], s[5 * 65]); o.w = pk2(s[6 * 65], s[7 * 65]);
        const int dr = n < 32 ? drow0 + n : drow1 + (n - 32);
        *(u32x4*)(WT + (size_t)dr * ldk + dk0 + k0 + 8 * c) = o; }
    LDS_WAIT(); asm volatile("" ::: "memory");
}
__device__ __forceinline__ void conv_plain(const float* W, int K, int N, bf16_t* WT, int ldk, int item, LAS float* scr, int lane) {
    const int nblk = N / 64, kb = item / nblk, nb = item % nblk;
    transpose_tile64(W, N, kb * 64, nb * 64, WT, ldk, nb * 64, nb * 64 + 32, 0, scr, lane);
}
__device__ __forceinline__ int win_drow(int n0) { return n0 < 3872 ? n0 : (n0 < 4128 ? 4096 + (n0 - 3872) : (n0 < 4288 ? 4352 + (n0 - 4128) : 4608 + (n0 - 4288))); }
__device__ __forceinline__ int gu_drow(int n0, int up) { return (n0 >> 7) * 256 + (n0 & 127) + up * 128; }

__device__ __forceinline__ void phase_prologue(const Frame& F, const Params& P) {
    LAS float* scr = (LAS float*)(F.lds + F.wave * 16640);
    unsigned char* ws = F.ws;
    constexpr int I_IN = 16 * 115, I_QB = 4 * 12, I_BRn = 8 * 16, I_WOn = 16 * 16, I_G = 16 * 44, I_D = 44 * 16;
    constexpr int NIT = NLAYER * (I_IN + I_QB + 3 * I_BRn + I_WOn) + 2 * I_G + I_D;
    for (int it = F.gw; it < NIT; it += F.ngw) {
        int r = it;
        if (r < NLAYER * I_IN) { const int l = r / I_IN; r %= I_IN; const int kb = r / 115, nb = r % 115;
            transpose_tile64(P.in[I_WIN] + (size_t)l * DM * IN_COLS, IN_COLS, kb * 64, nb * 64, (bf16_t*)(ws + WS_WIN) + (size_t)l * WIN_ROWS * DM, DM, win_drow(nb * 64), win_drow(nb * 64 + 32), 0, scr, F.lane); continue; }
        r -= NLAYER * I_IN;
        if (r < NLAYER * I_QB) { const int l = r / I_QB; r %= I_QB; conv_plain(P.in[I_WQB] + (size_t)l * 256 * 768, 256, 768, (bf16_t*)(ws + WS_QB) + (size_t)l * 768 * 256, 256, r, scr, F.lane); continue; }
        r -= NLAYER * I_QB;
        if (r < NLAYER * 3 * I_BRn) { const int ln = r / I_BRn; r %= I_BRn; conv_plain(P.in[I_WBR] + (size_t)ln * 512 * 1024, 512, 1024, (bf16_t*)(ws + WS_BR) + (size_t)ln * 1024 * 512, 512, r, scr, F.lane); continue; }
        r -= NLAYER * 3 * I_BRn;
        if (r < NLAYER * I_WOn) { const int l = r / I_WOn; r %= I_WOn; conv_plain(P.in[I_WO] + (size_t)l * DM * DM, DM, DM, (bf16_t*)(ws + WS_WO) + (size_t)l * DM * DM, DM, r, scr, F.lane); continue; }
        r -= NLAYER * I_WOn;
        if (r < 2 * I_G) { const int up = r / I_G; r %= I_G; const int kb = r / 44, nb = r % 44;
            transpose_tile64(P.in[up ? I_FU : I_FG], DFF, kb * 64, nb * 64, (bf16_t*)(ws + WS_FGU), DM, gu_drow(nb * 64, up), gu_drow(nb * 64 + 32, up), 0, scr, F.lane); continue; }
        r -= 2 * I_G;
        conv_plain(P.in[I_FD], DFF, DM, (bf16_t*)(ws + WS_FD), DFF, r, scr, F.lane);
    }
    const int gt = F.blk * NTHR + F.tid, ngt = F.G * NTHR;
    for (int i = gt; i < NLAYER * 1536 * 384; i += ngt) { const int l = i / (1536 * 384), r = i % (1536 * 384), n = r / 384, k = r % 384; const int seg = n >> 9, c = n & 511; float v = 0.f;
        if (seg == 0 && k < 64) v = P.in[I_W2][((size_t)l * 64 + k) * 512 + c];
        else if (seg == 1 && k >= 64 && k < 128) v = P.in[I_A2][((size_t)l * 64 + (k - 64)) * 512 + c];
        else if (seg == 2 && k >= 128 && k < 288) v = P.in[I_G2][((size_t)l * 160 + (k - 128)) * 512 + c];
        ((bf16_t*)(ws + WS_LORA))[i] = (bf16_t)f2bf(v); }
    for (int i = gt; i < NLAYER * 512 * 256; i += ngt) { const int l = i / (512 * 256), r = i % (512 * 256), n = r / 256, k = r % 256; const int h = n >> 6, d = n & 63;
        float vk = 0.f, vv = 0.f; if (k < 128) { const float* w = P.in[I_WKVB] + ((size_t)l * 128 + k) * 1024 + h * 128; vk = w[d]; vv = w[64 + d]; }
        ((bf16_t*)(ws + WS_KB))[i] = (bf16_t)f2bf(vk); ((bf16_t*)(ws + WS_VB))[i] = (bf16_t)f2bf(vv); }
    for (int i = gt; i < MTOK * 80; i += ngt) { const int m = i / 80, j = i % 80; const int isr = j < 64; const int idx = isr ? j : j - 64; const double dim = isr ? 128.0 : 32.0;
        const float inv = (float)(1.0 / pow(10000.0, (2.0 * idx) / dim)); const float ang = (float)((const int*)P.in[I_POS])[m] * inv;
        const double a = (double)ang, q = rint(a * 0.15915494309189535), rr = a - q * 6.283185307179586476925;
        const float rf = (float)rr; const float cs = __cosf(rf), sn = __sinf(rf);
        if (isr) { ((float*)(ws + WS_COSR))[(size_t)m * 64 + idx] = cs; ((float*)(ws + WS_SINR))[(size_t)m * 64 + idx] = sn; }
        else { ((float*)(ws + WS_COSM))[(size_t)m * 16 + idx] = cs; ((float*)(ws + WS_SINM))[(size_t)m * 16 + idx] = sn; } }
}
__device__ __forceinline__ void phase_moe_convert(const Frame& F, const Params& P) {
    LAS float* scr = (LAS float*)(F.lds + F.wave * 16640);
    constexpr int I_G = 16 * 56, I_D = 56 * 16;
    constexpr int NIT = NEXP * (2 * I_G + I_D);
    for (int it = F.gw; it < NIT; it += F.ngw) {
        const int e = it / (2 * I_G + I_D); int r = it % (2 * I_G + I_D);
        if (r < 2 * I_G) { const int up = r / I_G; r %= I_G; const int kb = r / 56, nb = r % 56;
            transpose_tile64(P.in[up ? I_MU2 : I_MG] + (size_t)e * DM * DFFE, DFFE, kb * 64, nb * 64, (bf16_t*)(F.ws + WS_MGU) + (size_t)e * 2 * DFFE * DM, DM, gu_drow(nb * 64, up), gu_drow(nb * 64 + 32, up), 0, scr, F.lane); continue; }
        r -= 2 * I_G;
        conv_plain(P.in[I_MD] + (size_t)e * DFFE * DM, DFFE, DM, (bf16_t*)(F.ws + WS_MD) + (size_t)e * DM * DFFE, DFFE, r, scr, F.lane);
    }
}

template <bool MOE>
__device__ __forceinline__ void phase_rms(const Frame& F, const float* src, const float* gain, bf16_t* hn, const float* router, unsigned* ectl, int* tok_e, int* tok_slot, float* tok_w) {
    LAS int* lcnt = (LAS int*)(F.lds);
    if (MOE) { if (F.tid < 16) lcnt[F.tid] = 0; __syncthreads(); }
    int my_e0 = 0, my_e1 = 0, my_s0 = 0, my_s1 = 0; float my_w0 = 0.f, my_w1 = 0.f;
    for (int i = 0; i < 8; ++i) {
        const int m = F.blk * 64 + F.wave * 8 + i;
        const f32x4* xr = (const f32x4*)(src + (size_t)m * DM) + F.lane;
        f32x4 v[4]; float s = 0.f;
#pragma unroll
        for (int j = 0; j < 4; ++j) { v[j] = xr[64 * j]; s += (v[j].x * v[j].x + v[j].y * v[j].y) + (v[j].z * v[j].z + v[j].w * v[j].w); }
        const float rstd = rsqrtf(wave_sum(s) * (1.0f / DM) + NORM_EPS);
#pragma unroll
        for (int j = 0; j < 4; ++j) { const f32x4 g = ((const f32x4*)gain)[F.lane + 64 * j]; v[j] = v[j] * rstd * g; }
        u32x2* o8 = (u32x2*)(hn + (size_t)m * DM) + F.lane;
#pragma unroll
        for (int j = 0; j < 4; ++j) { u32x2 w; w.x = pk2(v[j].x, v[j].y); w.y = pk2(v[j].z, v[j].w); o8[64 * j] = w; }
        if (MOE) {
            float lg[8];
#pragma unroll
            for (int e = 0; e < 8; ++e) lg[e] = 0.f;
#pragma unroll
            for (int j = 0; j < 4; ++j)
#pragma unroll
                for (int q = 0; q < 4; ++q) { const int c = 4 * F.lane + 256 * j + q; const f32x4 r0 = *(const f32x4*)(router + (size_t)c * 8), r1 = *(const f32x4*)(router + (size_t)c * 8 + 4); const float x = v[j][q];
                    lg[0] += x * r0.x; lg[1] += x * r0.y; lg[2] += x * r0.z; lg[3] += x * r0.w; lg[4] += x * r1.x; lg[5] += x * r1.y; lg[6] += x * r1.z; lg[7] += x * r1.w; }
#pragma unroll
            for (int e = 0; e < 8; ++e) lg[e] = wave_sum(lg[e]);
            int e0 = 0; float b0 = lg[0];
#pragma unroll
            for (int e = 1; e < 8; ++e) if (lg[e] > b0) { b0 = lg[e]; e0 = e; }
            int e1 = -1; float b1 = -3.0e38f;
#pragma unroll
            for (int e = 0; e < 8; ++e) if (e != e0 && lg[e] > b1) { b1 = lg[e]; e1 = e; }
            const float t = __expf(b1 - b0), w0 = 1.0f / (1.0f + t), w1 = t / (1.0f + t);
            int s0 = 0, s1 = 0;
            if (F.lane == 0) { s0 = atomicAdd((int*)&lcnt[e0], 1); s1 = atomicAdd((int*)&lcnt[e1], 1); }
            s0 = __shfl(s0, 0); s1 = __shfl(s1, 0);
            if (F.lane == i) { my_e0 = e0; my_e1 = e1; my_s0 = s0; my_s1 = s1; my_w0 = w0; my_w1 = w1; }
        }
    }
    if (MOE) {
        __syncthreads();
        if (F.tid < 8) lcnt[8 + F.tid] = (int)atomicAdd(&ectl[F.tid], (unsigned)lcnt[F.tid]);
        __syncthreads();
        if (F.lane < 8) { const int m = F.blk * 64 + F.wave * 8 + F.lane;
            tok_e[2 * m] = my_e0; tok_e[2 * m + 1] = my_e1; tok_slot[2 * m] = lcnt[8 + my_e0] + my_s0; tok_slot[2 * m + 1] = lcnt[8 + my_e1] + my_s1; tok_w[2 * m] = my_w0; tok_w[2 * m + 1] = my_w1; }
        __syncthreads();
    }
}
__device__ __forceinline__ void phase_final(const Frame& F, float* h, const float* gain, const bf16_t* out2, const int* tok_pos) {
    for (int m = F.gw; m < MTOK; m += F.ngw) {
        f32x4* xr = (f32x4*)(h + (size_t)m * DM) + F.lane;
        const int p0 = tok_pos[2 * m], p1 = tok_pos[2 * m + 1];
        const u32x2* o0 = (const u32x2*)(out2 + (size_t)p0 * DM) + F.lane; const u32x2* o1 = (const u32x2*)(out2 + (size_t)p1 * DM) + F.lane;
        f32x4 v[4]; float s = 0.f;
#pragma unroll
        for (int j = 0; j < 4; ++j) { v[j] = xr[64 * j]; const u32x2 a = o0[64 * j], b = o1[64 * j];
#ifndef NO_MOE_ADD
            v[j].x += bflo(a.x) + bflo(b.x); v[j].y += bfhi(a.x) + bfhi(b.x); v[j].z += bflo(a.y) + bflo(b.y); v[j].w += bfhi(a.y) + bfhi(b.y);
#endif
            s += (v[j].x * v[j].x + v[j].y * v[j].y) + (v[j].z * v[j].z + v[j].w * v[j].w); }
        const float rstd = rsqrtf(wave_sum(s) * (1.0f / DM) + NORM_EPS);
#pragma unroll
        for (int j = 0; j < 4; ++j) { const f32x4 g = ((const f32x4*)gain)[F.lane + 64 * j]; xr[64 * j] = v[j] * rstd * g; }
    }
}
template <int KS>
__device__ __forceinline__ f32x4 mm_tile(const LAS bf16_t* P, int ldp, const LAS bf16_t* Q, int ldq, int ib, int jb, int lane, f32x4 acc) {
    const LAS bf16_t* pp = P + (ib * 16 + (lane & 15)) * ldp + 8 * (lane >> 4);
    const LAS bf16_t* qp = Q + (jb * 16 + (lane & 15)) * ldq + 8 * (lane >> 4);
#pragma unroll
    for (int ks = 0; ks < KS; ++ks) { const bf16x8 a = *(const LAS bf16x8*)(qp + ks * 32), b = *(const LAS bf16x8*)(pp + ks * 32); acc = __builtin_amdgcn_mfma_f32_16x16x32_bf16(a, b, acc, 0, 0, 0); }
    return acc;
}
__device__ __forceinline__ void st_bf4(LAS bf16_t* p, f32x4 v) { u32x2 w; w.x = pk2(v[0], v[1]); w.y = pk2(v[2], v[3]); *(LAS u32x2*)p = w; }
__device__ __forceinline__ float ret_lg(int h) { return __logf(1.0f - exp2f(-5.0f - (float)h)); }

__device__ __forceinline__ void phase_prep(const Frame& F, const Params& P, int layer) {
    unsigned char* ws = F.ws;
    const bf16_t* p = (const bf16_t*)(ws + WS_P);
    const float* mu = P.in[I_MU] + (size_t)layer * RWKV_COLS;
    for (int m = F.gw; m < MTOK; m += F.ngw) {
        const bf16_t* pr = p + (size_t)m * PW; const bool has_prev = (m % SEQ) != 0; const bf16_t* pp = pr - PW;
        bf16_t* lin = (bf16_t*)(ws + WS_LIN) + (size_t)m * LORA_K;
#pragma unroll
        for (int jj = 0; jj < 6; ++jj) { const int c = F.lane + 64 * jj; float o = 0.f;
            if (c < 288) { const int off = 1536 + c; const float x = bf2f(pr[P_RW + off]), xp = has_prev ? bf2f(pp[P_RW + off]) : 0.f; const float xs = x + (xp - x) * mu[off];
                o = c < 64 ? tanhf(xs) : (c < 128 ? xs : sigmoidf_(xs)); }
            lin[c] = (bf16_t)f2bf(o); }
        {
            const u32x2 w = *(const u32x2*)(pr + P_QA + 4 * F.lane); float x[4] = {bflo(w.x), bfhi(w.x), bflo(w.y), bfhi(w.y)};
            const float ss = wave_sum(x[0] * x[0] + x[1] * x[1] + x[2] * x[2] + x[3] * x[3]); const float rs = rsqrtf(ss * (1.0f / 256.0f) + NORM_EPS);
            const f32x4 g = *(const f32x4*)(P.in[I_QNORM] + layer * 256 + 4 * F.lane);
            u32x2 o; o.x = pk2(x[0] * rs * g.x, x[1] * rs * g.y); o.y = pk2(x[2] * rs * g.z, x[3] * rs * g.w); *(u32x2*)((bf16_t*)(ws + WS_QN) + (size_t)m * 256 + 4 * F.lane) = o; }
        {
            const unsigned w = *(const unsigned*)(pr + P_KVA + 2 * F.lane); float x0 = bflo(w), x1 = bfhi(w);
            const float ss = wave_sum(x0 * x0 + x1 * x1); const float rs = rsqrtf(ss * (1.0f / 128.0f) + NORM_EPS);
            const f32x2 g = *(const f32x2*)(P.in[I_KVNORM] + layer * 128 + 2 * F.lane);
            unsigned* cn = (unsigned*)((bf16_t*)(ws + WS_CN) + (size_t)m * 256); cn[F.lane] = pk2(x0 * rs * g.x, x1 * rs * g.y); cn[64 + F.lane] = 0u; }
        if (F.lane < 16) {
            const float x1 = bf2f(pr[P_KVA + 128 + F.lane]), x2 = bf2f(pr[P_KVA + 144 + F.lane]);
            const float c = ((const float*)(ws + WS_COSM))[(size_t)m * 16 + F.lane], s = ((const float*)(ws + WS_SINM))[(size_t)m * 16 + F.lane];
            bf16_t* kp = (bf16_t*)(ws + WS_KPE) + (size_t)m * 32; kp[F.lane] = (bf16_t)f2bf(x1 * c - x2 * s); kp[16 + F.lane] = (bf16_t)f2bf(x1 * s + x2 * c); }
    }
    LAS bf16_t* kT = (LAS bf16_t*)F.lds;
    LAS bf16_t* vT = kT + 128 * 72;
    const int pc = F.tid & 7, j = F.tid >> 3;
    for (int u = F.blk; u < NB * NCHUNK * 4; u += F.G) {
        const int h = u & 3, n = (u >> 2) & 127, b = u >> 9; const int m = b * SEQ + n * 64 + j;
        const float lg = ret_lg(h);
        __syncthreads();
        {
            const bf16_t* kr = p + (size_t)m * PW + P_RK + h * 128 + pc * 8;
            const u32x4 a = *(const u32x4*)kr, bq = *(const u32x4*)(kr + 64);
            const float* cp = (const float*)(ws + WS_COSR) + (size_t)m * 64 + pc * 8; const float* sp = (const float*)(ws + WS_SINR) + (size_t)m * 64 + pc * 8;
            const float sc = 0.08838834764831845f * __expf(lg * (float)(63 - j));
            const unsigned aw[4] = {a.x, a.y, a.z, a.w}, bw[4] = {bq.x, bq.y, bq.z, bq.w};
#pragma unroll
            for (int i = 0; i < 8; ++i) { const float x1 = (i & 1) ? bfhi(aw[i >> 1]) : bflo(aw[i >> 1]), x2 = (i & 1) ? bfhi(bw[i >> 1]) : bflo(bw[i >> 1]); const float c = cp[i], s = sp[i];
                kT[(pc * 8 + i) * 72 + j] = (bf16_t)f2bf((x1 * c - x2 * s) * sc); kT[(64 + pc * 8 + i) * 72 + j] = (bf16_t)f2bf((x1 * s + x2 * c) * sc); }
            const bf16_t* vr = p + (size_t)m * PW + P_RV + h * 128 + pc * 8;
            const u32x4 va = *(const u32x4*)vr, vb = *(const u32x4*)(vr + 64);
            const unsigned vaw[4] = {va.x, va.y, va.z, va.w}, vbw[4] = {vb.x, vb.y, vb.z, vb.w};
#pragma unroll
            for (int i = 0; i < 8; ++i) { vT[(pc * 8 + i) * 72 + j] = (bf16_t)((i & 1) ? (vaw[i >> 1] >> 16) : (vaw[i >> 1] & 0xffffu)); vT[(64 + pc * 8 + i) * 72 + j] = (bf16_t)((i & 1) ? (vbw[i >> 1] >> 16) : (vbw[i >> 1] & 0xffffu)); }
        }
        __syncthreads();
        bf16_t* out = (bf16_t*)(ws + WS_RS) + (size_t)u * 16384;
#pragma unroll
        for (int jb = 0; jb < 8; ++jb) { f32x4 acc = {0.f, 0.f, 0.f, 0.f}; acc = mm_tile<2>(vT, 72, kT, 72, F.wave, jb, F.lane, acc);
            const int e = F.wave * 16 + (F.lane & 15), d = jb * 16 + 4 * (F.lane >> 4);
            u32x2 w; w.x = pk2(acc[0], acc[1]); w.y = pk2(acc[2], acc[3]); *(u32x2*)(out + e * 128 + d) = w; }
    }
    __syncthreads();
}

__device__ __forceinline__ void ret_scan(const Frame& F) {
    bf16_t* rs = (bf16_t*)(F.ws + WS_RS);
    for (int idx = F.blk * NTHR + F.tid; idx < NB * 4 * 16384; idx += F.G * NTHR) {
        const int b = idx >> 16, h = (idx >> 14) & 3, ed = idx & 16383; const float cd = __expf(ret_lg(h) * 64.0f);
        bf16_t* base = rs + ((size_t)(b * 128) * 4 + h) * 16384 + ed; float s = 0.f;
        for (int n0 = 0; n0 < NCHUNK; n0 += 8) { float t[8];
#pragma unroll
            for (int i = 0; i < 8; ++i) t[i] = bf2f(base[(size_t)(n0 + i) * 65536]);
#pragma unroll
            for (int i = 0; i < 8; ++i) { base[(size_t)(n0 + i) * 65536] = (bf16_t)f2bf(s); s = s * cd + t[i]; } }
    }
}

__device__ __forceinline__ void ret_out(const Frame& F) {
    unsigned char* ws = F.ws; const bf16_t* p = (const bf16_t*)(ws + WS_P);
    LAS bf16_t* q = (LAS bf16_t*)F.lds;
    LAS bf16_t* k = q + 64 * 136;
    LAS bf16_t* vT = k + 64 * 136;
    LAS bf16_t* pT = vT + 128 * 72;
    LAS bf16_t* sc = pT + 128 * 136;
    LAS float* st = (LAS float*)(sc + 64 * 72);
    const int pc = F.tid & 7, j = F.tid >> 3;
    for (int u = F.blk; u < NB * NCHUNK * 4; u += F.G) {
        const int h = u & 3, n = (u >> 2) & 127, b = u >> 9; const int m0 = b * SEQ + n * 64, m = m0 + j;
        const float lg = ret_lg(h);
        LBAR();
        {
            const float* cp = (const float*)(ws + WS_COSR) + (size_t)m * 64 + pc * 8; const float* sp = (const float*)(ws + WS_SINR) + (size_t)m * 64 + pc * 8;
            float cs[8], sn[8];
#pragma unroll
            for (int i = 0; i < 8; ++i) { cs[i] = cp[i]; sn[i] = sp[i]; }
#pragma unroll
            for (int which = 0; which < 2; ++which) {
                const bf16_t* r = p + (size_t)m * PW + (which ? P_RK : P_RQ) + h * 128 + pc * 8;
                const u32x4 a = *(const u32x4*)r, bq = *(const u32x4*)(r + 64);
                const unsigned aw[4] = {a.x, a.y, a.z, a.w}, bw[4] = {bq.x, bq.y, bq.z, bq.w}; const float sc_ = which ? 0.08838834764831845f : 1.0f;
                float o1[8], o2[8];
#pragma unroll
                for (int i = 0; i < 8; ++i) { const float x1 = (i & 1) ? bfhi(aw[i >> 1]) : bflo(aw[i >> 1]), x2 = (i & 1) ? bfhi(bw[i >> 1]) : bflo(bw[i >> 1]); o1[i] = (x1 * cs[i] - x2 * sn[i]) * sc_; o2[i] = (x1 * sn[i] + x2 * cs[i]) * sc_; }
                LAS bf16_t* dst = (which ? k : q) + j * 136 + pc * 8;
                u32x4 w1, w2; w1.x = pk2(o1[0], o1[1]); w1.y = pk2(o1[2], o1[3]); w1.z = pk2(o1[4], o1[5]); w1.w = pk2(o1[6], o1[7]); w2.x = pk2(o2[0], o2[1]); w2.y = pk2(o2[2], o2[3]); w2.z = pk2(o2[4], o2[5]); w2.w = pk2(o2[6], o2[7]);
                *(LAS u32x4*)dst = w1; *(LAS u32x4*)(dst + 64) = w2; }
            const bf16_t* vr = p + (size_t)m * PW + P_RV + h * 128 + pc * 8;
            const u32x4 va = *(const u32x4*)vr, vb = *(const u32x4*)(vr + 64);
            const unsigned vaw[4] = {va.x, va.y, va.z, va.w}, vbw[4] = {vb.x, vb.y, vb.z, vb.w};
#pragma unroll
            for (int i = 0; i < 8; ++i) { vT[(pc * 8 + i) * 72 + j] = (bf16_t)((i & 1) ? (vaw[i >> 1] >> 16) : (vaw[i >> 1] & 0xffffu)); vT[(64 + pc * 8 + i) * 72 + j] = (bf16_t)((i & 1) ? (vbw[i >> 1] >> 16) : (vbw[i >> 1] & 0xffffu)); }
            const bf16_t* ps = (const bf16_t*)(ws + WS_RS) + (size_t)u * 16384;
#pragma unroll
            for (int i = 0; i < 4; ++i) { const int pi = F.tid + i * 512; const int e = pi >> 4, c = pi & 15; *(LAS u32x4*)(pT + e * 136 + c * 8) = *(const u32x4*)(ps + e * 128 + c * 8); }
        }
        LBAR();
        {
            const int ib = F.wave & 3;
#pragma unroll
            for (int t = 0; t < 2; ++t) { const int jb = 2 * (F.wave >> 2) + t; f32x4 acc = {0.f, 0.f, 0.f, 0.f}; acc = mm_tile<4>(q, 136, k, 136, ib, jb, F.lane, acc);
                const int i = ib * 16 + (F.lane & 15), j0 = jb * 16 + 4 * (F.lane >> 4);
#pragma unroll
                for (int r = 0; r < 4; ++r) { const int dd = i - (j0 + r); acc[r] *= __expf(lg * (float)(dd < 0 ? -dd : dd)); }
                st_bf4(sc + i * 72 + j0, acc); }
        }
        LBAR();
        {
            const int ib = F.wave & 3, eh = F.wave >> 2; const int i = ib * 16 + (F.lane & 15);
            const float qd = __expf(lg * (float)(i + 1));
            f32x4 o[4]; float s1 = 0.f, s2 = 0.f;
#pragma unroll
            for (int t = 0; t < 4; ++t) { const int eb = eh * 4 + t; f32x4 ai = {0.f, 0.f, 0.f, 0.f}, ac = {0.f, 0.f, 0.f, 0.f};
                ai = mm_tile<2>(sc, 72, vT, 72, ib, eb, F.lane, ai); ac = mm_tile<4>(q, 136, pT, 136, ib, eb, F.lane, ac);
                o[t] = ai + ac * qd;
#pragma unroll
                for (int r = 0; r < 4; ++r) { s1 += o[t][r]; s2 += o[t][r] * o[t][r]; } }
            s1 += __shfl_xor(s1, 16); s1 += __shfl_xor(s1, 32); s2 += __shfl_xor(s2, 16); s2 += __shfl_xor(s2, 32);
            if (F.lane < 16) { st[(eh * 64 + i) * 2] = s1; st[(eh * 64 + i) * 2 + 1] = s2; }
            LBAR();
            const float t1 = st[i * 2] + st[(64 + i) * 2], t2 = st[i * 2 + 1] + st[(64 + i) * 2 + 1];
            const float mean = t1 * (1.0f / 128.0f), var = fmaxf(t2 * (1.0f / 128.0f) - mean * mean, 0.f), rstd = rsqrtf(var + 1e-5f);
            const int mrow = m0 + i;
#pragma unroll
            for (int t = 0; t < 4; ++t) { const int e = (eh * 4 + t) * 16 + 4 * (F.lane >> 4);
                const u32x2 gw = *(const u32x2*)(p + (size_t)mrow * PW + P_RG + h * 128 + e); const float g[4] = {bflo(gw.x), bfhi(gw.x), bflo(gw.y), bfhi(gw.y)};
                float y[4];
#pragma unroll
                for (int r = 0; r < 4; ++r) y[r] = (o[t][r] - mean) * rstd * (g[r] * sigmoidf_(g[r]));
                u32x2 w; w.x = pk2(y[0], y[1]); w.y = pk2(y[2], y[3]); *(u32x2*)((bf16_t*)(ws + WS_YRET) + (size_t)mrow * 512 + h * 128 + e) = w; }
        }
    }
    __syncthreads();
}

constexpr int ATT_KP = 104, ATT_VP = 72;
constexpr int ATT_KB = 64 * ATT_KP * 2, ATT_VB = 64 * ATT_VP * 2;
constexpr int ATT_K0 = 0, ATT_V0 = 2 * ATT_KB;
__device__ __forceinline__ void attn_unit(const Frame& F, int b, int h, int qt) {
    unsigned char* ws = F.ws;
    const bf16_t* Qg = (const bf16_t*)(ws + WS_Q); const bf16_t* Kn = (const bf16_t*)(ws + WS_KN); const bf16_t* Kp = (const bf16_t*)(ws + WS_KPE); const bf16_t* Vt = (const bf16_t*)(ws + WS_VT);
    const int lane = F.lane, w = F.wave, ql = lane & 31, hf = lane >> 5;
    const int mq = b * SEQ + qt * 256 + w * 32 + ql;
    const float qs = 0.10206207261596577f * 1.4426950408889634f;
    bf16x8 qf[6];
    {
        const bf16_t* qr = Qg + (size_t)mq * 768 + h * 96;
#pragma unroll
        for (int s = 0; s < 4; ++s) { const u32x4 x = *(const u32x4*)(qr + 16 * s + 8 * hf); const unsigned xw[4] = {x.x, x.y, x.z, x.w}; u32x4 o; unsigned ow[4];
#pragma unroll
            for (int i = 0; i < 4; ++i) ow[i] = pk2(bflo(xw[i]) * qs, bfhi(xw[i]) * qs);
            o.x = ow[0]; o.y = ow[1]; o.z = ow[2]; o.w = ow[3]; qf[s] = __builtin_bit_cast(bf16x8, o); }
        const u32x4 x1 = *(const u32x4*)(qr + 64 + 8 * hf), x2 = *(const u32x4*)(qr + 80 + 8 * hf);
        const float* cp = (const float*)(ws + WS_COSM) + (size_t)mq * 16 + 8 * hf; const float* sp = (const float*)(ws + WS_SINM) + (size_t)mq * 16 + 8 * hf;
        const unsigned a[4] = {x1.x, x1.y, x1.z, x1.w}, c[4] = {x2.x, x2.y, x2.z, x2.w}; unsigned o1[4], o2[4];
#pragma unroll
        for (int i = 0; i < 4; ++i) { const float u0 = bflo(a[i]), u1 = bfhi(a[i]), v0 = bflo(c[i]), v1 = bfhi(c[i]); const float c0 = cp[2 * i], c1 = cp[2 * i + 1], s0 = sp[2 * i], s1 = sp[2 * i + 1];
            o1[i] = pk2((u0 * c0 - v0 * s0) * qs, (u1 * c1 - v1 * s1) * qs); o2[i] = pk2((u0 * s0 + v0 * c0) * qs, (u1 * s1 + v1 * c1) * qs); }
        u32x4 t1, t2; t1.x = o1[0]; t1.y = o1[1]; t1.z = o1[2]; t1.w = o1[3]; t2.x = o2[0]; t2.y = o2[1]; t2.z = o2[2]; t2.w = o2[3];
        qf[4] = __builtin_bit_cast(bf16x8, t1); qf[5] = __builtin_bit_cast(bf16x8, t2);
    }
    f32x16 oacc[2];
#pragma unroll
    for (int i = 0; i < 16; ++i) { oacc[0][i] = 0.f; oacc[1][i] = 0.f; }
    float mrun = 0.f; f32x2 lsum = {0.f, 0.f};
    const int nkt = 4 * qt + 4, mylim = 4 * qt + (w >> 1);
    const int half = w >> 2;
    const int kkey = F.tid >> 3, kpc = F.tid & 7, rkey = F.tid >> 2, rpc = F.tid & 3, ve = F.tid >> 3, vpc = F.tid & 7;
    const bf16_t* knp = Kn + (size_t)(b * SEQ + kkey) * 512 + h * 64 + kpc * 8;
    const bf16_t* kpp = Kp + (size_t)(b * SEQ + rkey) * 32 + rpc * 8;
    const bf16_t* vtp = Vt + (size_t)(h * 64 + ve) * MTOK + b * SEQ + vpc * 8;
    const int kofs = (kkey * ATT_KP + kpc * 8) * 2, rofs = (rkey * ATT_KP + 64 + rpc * 8) * 2, vofs = (ve * ATT_VP + vpc * 8) * 2;
    const bool rp = F.tid < 256;
#define ATT_QK(sv, kbuf, init) do { _Pragma("unroll") for (int t_ = 0; t_ < 2; ++t_) { _Pragma("unroll") for (int i_ = 0; i_ < 16; ++i_) sv[t_][i_] = (init); } \
        _Pragma("unroll") for (int st_ = 0; st_ < 6; ++st_) { _Pragma("unroll") for (int t_ = 0; t_ < 2; ++t_) { const bf16x8 a_ = *(const LAS bf16x8*)((kbuf) + (t_ * 32 + ql) * ATT_KP + 16 * st_ + 8 * hf); sv[t_] = __builtin_amdgcn_mfma_f32_32x32x16_bf16(a_, qf[st_], sv[t_], 0, 0, 0); } } } while (0)
    u32x4 ak, ar = {0u, 0u, 0u, 0u}, av, bk, br = {0u, 0u, 0u, 0u}, bv;
#define ATT_LOAD(K_, R_, V_, kt_) do { const int kk_ = (kt_) + 2 < nkt ? (kt_) + 2 : nkt - 1, vv_ = (kt_) + 1 < nkt ? (kt_) + 1 : nkt - 1; \
        K_ = *(const u32x4*)(knp + (size_t)kk_ * 64 * 512); if (rp) R_ = *(const u32x4*)(kpp + (size_t)kk_ * 64 * 32); V_ = *(const u32x4*)(vtp + (size_t)vv_ * 64); } while (0)
#define ATT_STAGE(K_, R_, V_, kt_) do { if ((kt_) + 2 < nkt) { LAS unsigned char* kb2_ = F.lds + ATT_K0 + ((kt_) & 1) * ATT_KB; *(LAS u32x4*)(kb2_ + kofs) = K_; if (rp) *(LAS u32x4*)(kb2_ + rofs) = R_; } \
        if ((kt_) + 1 < nkt) *(LAS u32x4*)(F.lds + ATT_V0 + (((kt_) + 1) & 1) * ATT_VB + vofs) = V_; ATT_LOAD(K_, R_, V_, (kt_) + 2); } while (0)
    __syncthreads();
    {
        ak = *(const u32x4*)knp; if (rp) ar = *(const u32x4*)kpp; av = *(const u32x4*)vtp;
        bk = *(const u32x4*)(knp + (size_t)64 * 512); if (rp) br = *(const u32x4*)(kpp + (size_t)64 * 32);
        *(LAS u32x4*)(F.lds + ATT_K0 + kofs) = ak; if (rp) *(LAS u32x4*)(F.lds + ATT_K0 + rofs) = ar; *(LAS u32x4*)(F.lds + ATT_V0 + vofs) = av;
        *(LAS u32x4*)(F.lds + ATT_K0 + ATT_KB + kofs) = bk; if (rp) *(LAS u32x4*)(F.lds + ATT_K0 + ATT_KB + rofs) = br;
        ATT_LOAD(ak, ar, av, 0); ATT_LOAD(bk, br, bv, 1);
    }
    __syncthreads();
    f32x16 sc[2], sn[2];
    ATT_QK(sc, (const LAS bf16_t*)(F.lds + ATT_K0), 0.f);
    if (half == 1) LBAR();
#define ATT_SEG1(kt_) do { if ((kt_) + 1 <= mylim) ATT_QK(sn, (const LAS bf16_t*)(F.lds + ATT_K0 + (((kt_) + 1) & 1) * ATT_KB), -mrun); } while (0)
#define ATT_SEG2(kt_) do { if ((kt_) <= mylim) { const bool do_next = (kt_) + 1 <= mylim; \
            const LAS bf16_t* vb = (const LAS bf16_t*)(F.lds + ATT_V0 + ((kt_) & 1) * ATT_VB); \
            int mi = __builtin_bit_cast(int, sc[0][0]); \
            _Pragma("unroll") for (int i = 0; i < 16; ++i) { const int a_ = __builtin_bit_cast(int, sc[0][i]), b_ = __builtin_bit_cast(int, sc[1][i]); mi = max(max(mi, a_), b_); } \
            if ((kt_) == 0 || __builtin_amdgcn_ballot_w64(__builtin_bit_cast(float, mi) > 8.0f) != 0ull) { \
                float mx = fmaxf(sc[0][0], sc[1][0]); \
                _Pragma("unroll") for (int i = 1; i < 16; ++i) mx = fmaxf(mx, fmaxf(sc[0][i], sc[1][i])); \
                { const int mb = __builtin_bit_cast(int, mx); const auto sw2 = __builtin_amdgcn_permlane32_swap(mb, mb, false, false); mx = fmaxf(__builtin_bit_cast(float, (int)sw2[0]), __builtin_bit_cast(float, (int)sw2[1])); } \
                const float delta = ((kt_) == 0) ? mx : fmaxf(mx, 0.f); \
                const float alpha = ((kt_) == 0) ? 1.0f : __builtin_amdgcn_exp2f(-delta); mrun += delta; lsum *= alpha; \
                _Pragma("unroll") for (int i = 0; i < 16; ++i) { oacc[0][i] *= alpha; oacc[1][i] *= alpha; sc[0][i] -= delta; sc[1][i] -= delta; } \
                if (do_next) { _Pragma("unroll") for (int i = 0; i < 16; ++i) { sn[0][i] -= delta; sn[1][i] -= delta; } } } \
            _Pragma("unroll") for (int t = 0; t < 2; ++t) _Pragma("unroll") for (int i = 0; i < 16; i += 2) { const float p0 = __builtin_amdgcn_exp2f(sc[t][i]), p1 = __builtin_amdgcn_exp2f(sc[t][i + 1]); sc[t][i] = p0; sc[t][i + 1] = p1; lsum += (f32x2){p0, p1}; } \
            _Pragma("unroll") for (int t = 0; t < 2; ++t) _Pragma("unroll") for (int kbb = 0; kbb < 2; ++kbb) { \
                    u32x4 pw; pw.x = pk2(sc[t][8 * kbb + 0], sc[t][8 * kbb + 1]); pw.y = pk2(sc[t][8 * kbb + 2], sc[t][8 * kbb + 3]); pw.z = pk2(sc[t][8 * kbb + 4], sc[t][8 * kbb + 5]); pw.w = pk2(sc[t][8 * kbb + 6], sc[t][8 * kbb + 7]); \
                    const bf16x8 pf = __builtin_bit_cast(bf16x8, pw); const int key0 = t * 32 + kbb * 16 + 4 * hf; \
                    _Pragma("unroll") for (int eb = 0; eb < 2; ++eb) { const LAS bf16_t* vr = vb + (eb * 32 + ql) * ATT_VP + key0; \
                        const u32x2 lo = *(const LAS u32x2*)vr, hi = *(const LAS u32x2*)(vr + 8); u32x4 vv; vv.x = lo.x; vv.y = lo.y; vv.z = hi.x; vv.w = hi.y; \
                        oacc[eb] = __builtin_amdgcn_mfma_f32_32x32x16_bf16(__builtin_bit_cast(bf16x8, vv), pf, oacc[eb], 0, 0, 0); } } \
            if (do_next) { sc[0] = sn[0]; sc[1] = sn[1]; } } } while (0)
#pragma unroll 1
    for (int kt = 0; kt < nkt; kt += 2) {
        if (half == 1) ATT_STAGE(ak, ar, av, kt);
        ATT_SEG1(kt); LBAR();
        if (half == 0) ATT_STAGE(ak, ar, av, kt);
        ATT_SEG2(kt); LBAR();
        if (half == 1) ATT_STAGE(bk, br, bv, kt + 1);
        ATT_SEG1(kt + 1); LBAR();
        if (half == 0) ATT_STAGE(bk, br, bv, kt + 1);
        ATT_SEG2(kt + 1); LBAR();
    }
    if (half == 0) LBAR();
#undef ATT_QK
#undef ATT_LOAD
#undef ATT_STAGE
#undef ATT_SEG1
#undef ATT_SEG2
    float lrun = lsum[0] + lsum[1];
    const float lt = lrun + __shfl_xor(lrun, 32), inv = 1.0f / lt;
    bf16_t* yo = (bf16_t*)(ws + WS_YMLA) + (size_t)mq * 512 + h * 64;
#pragma unroll
    for (int eb = 0; eb < 2; ++eb)
#pragma unroll
        for (int g = 0; g < 4; ++g) { u32x2 wv; wv.x = pk2(oacc[eb][4 * g] * inv, oacc[eb][4 * g + 1] * inv); wv.y = pk2(oacc[eb][4 * g + 2] * inv, oacc[eb][4 * g + 3] * inv);
            *(u32x2*)(yo + eb * 32 + 8 * g + 4 * hf) = wv; }
}
constexpr int RP = 72;
constexpr int RMAT = 64 * RP;
constexpr size_t RC_UNIT = 40960;
constexpr size_t WS_RC2 = WS_RC + (size_t)2048 * RC_UNIT;

__device__ __forceinline__ void st_g4(bf16_t* p, f32x4 v) { u32x2 w; w.x = pk2(v[0], v[1]); w.y = pk2(v[2], v[3]); *(u32x2*)p = w; }
__device__ __forceinline__ f32x4 ld_l4(const LAS bf16_t* p) { const u32x2 w = *(const LAS u32x2*)p; return (f32x4){bflo(w.x), bfhi(w.x), bflo(w.y), bfhi(w.y)}; }

__device__ __forceinline__ void rwkv_chunk_pre(const Frame& F, const float* mu, const float* k_k_, const float* k_a_, const float* r_k_) {
    unsigned char* ws = F.ws; const bf16_t* p = (const bf16_t*)(ws + WS_P); const bf16_t* lo = (const bf16_t*)(ws + WS_LO);
    LAS bf16_t* M = (LAS bf16_t*)F.lds;
    LAS bf16_t *KKt = M, *Bt = M + RMAT, *Kt = M + 2 * RMAT, *Rt = M + 3 * RMAT, *KKtT = M + 4 * RMAT, *BhT = M + 5 * RMAT, *KhT = M + 6 * RMAT, *VcT = M + 7 * RMAT;
    LAS bf16_t *NA = M + 8 * RMAT, *NAT = M + 9 * RMAT, *TT = M + 10 * RMAT, *AkkT = M + 11 * RMAT, *AbrT = M + 12 * RMAT, *AkrT = M + 13 * RMAT;
    LAS float* LW = (LAS float*)(M + 8 * RMAT);
    LAS float* SEG = (LAS float*)(M + 10 * RMAT);
    const int lane = F.lane, w = F.wave;
    for (int u = F.blk; u < NB * 8 * NCHUNK; u += F.G) {
        const int c = u & 127, h = (u >> 7) & 7, b = u >> 10; const int m0 = b * SEQ + c * 64, ch = h * 64 + lane;
        const float mu_r = mu[ch], mu_k = mu[512 + ch], mu_v = mu[1024 + ch], k_k = k_k_[ch], k_a = k_a_[ch], r_k = r_k_[ch];
        float* aux = (float*)(ws + WS_RC2) + (size_t)u * 128;
        LBAR();
        float rr[8], kk8[8], k28[8], vv[8], bb[8], lw8[8];
#pragma unroll
        for (int i = 0; i < 8; ++i) { const int t = w + 8 * i, m = m0 + t; const bf16_t* pr = p + (size_t)m * PW + P_RW + ch; const bool hp = (c | t) != 0;
            const float xr = bf2f(pr[0]), xk = bf2f(pr[512]), xv = bf2f(pr[1024]);
            const float pr_ = hp ? bf2f(pr[-PW]) : 0.f, pk_ = hp ? bf2f(pr[512 - PW]) : 0.f, pv_ = hp ? bf2f(pr[1024 - PW]) : 0.f;
            const float r = xr + (pr_ - xr) * mu_r, k = xk + (pk_ - xk) * mu_k, v = xv + (pv_ - xv) * mu_v;
            const float lw = bf2f(lo[(size_t)m * LO_W + ch]), a = bf2f(lo[(size_t)m * LO_W + 512 + ch]);
            float kk = k * k_k; const float ss = wave_sum(kk * kk); kk *= rsqrtf(ss + 1e-12f);
            const float k2 = k * (1.0f + (a - 1.0f) * k_a);
            rr[i] = r; kk8[i] = kk; k28[i] = k2; vv[i] = v; bb[i] = kk * a; lw8[i] = lw; LW[t * 64 + lane] = lw;
            ((bf16_t*)(ws + WS_RC + (size_t)u * RC_UNIT))[16384 + t * 64 + lane] = (bf16_t)f2bf(v);
            const float bon = wave_sum(r * k2 * r_k); if (lane == 0) aux[64 + t] = bon; }
        LBAR();
        { float cs = 0.f;
#pragma unroll
          for (int i = 0; i < 8; ++i) { cs += LW[(w * 8 + i) * 64 + lane]; LW[(w * 8 + i) * 64 + lane] = cs; }
          SEG[w * 64 + lane] = cs; }
        LBAR();
        float segp[9]; segp[0] = 0.f;
#pragma unroll
        for (int s = 0; s < 8; ++s) segp[s + 1] = segp[s] + SEG[s * 64 + lane];
        const float cumC = segp[8];
        float cum8[8];
#pragma unroll
        for (int i = 0; i < 8; ++i) cum8[i] = LW[(w + 8 * i) * 64 + lane] + segp[i];
        if (w == 0) aux[lane] = __expf(cumC);
        LBAR();
#pragma unroll
        for (int i = 0; i < 8; ++i) { const int t = w + 8 * i; const float cum = cum8[i];
            const float om = __expf(cum), omx = __expf(cum - lw8[i]), iom = __expf(-cum), ih = __expf(cumC - cum);
            KKt[t * RP + lane] = (bf16_t)f2bf(kk8[i] * omx); Bt[t * RP + lane] = (bf16_t)f2bf(bb[i] * iom); Kt[t * RP + lane] = (bf16_t)f2bf(k28[i] * iom); Rt[t * RP + lane] = (bf16_t)f2bf(rr[i] * om);
            KKtT[lane * RP + t] = (bf16_t)f2bf(kk8[i] * omx); BhT[lane * RP + t] = (bf16_t)f2bf(bb[i] * ih); KhT[lane * RP + t] = (bf16_t)f2bf(k28[i] * ih); VcT[lane * RP + t] = (bf16_t)f2bf(vv[i]); }
        LBAR();
        {
            const int ib = w >> 1;
#pragma unroll
            for (int tt = 0; tt < 2; ++tt) { const int jb = 2 * (w & 1) + tt; const int i0 = ib * 16 + (lane & 15), j0 = jb * 16 + 4 * (lane >> 4);
                const f32x4 z = {0.f, 0.f, 0.f, 0.f};
                f32x4 a_nat = z, a_kk = z, a_br = z, a_kr = z, a_na = z;
                if (jb <= ib) { a_nat = mm_tile<2>(KKt, RP, Bt, RP, ib, jb, lane, z); a_kk = mm_tile<2>(KKt, RP, Kt, RP, ib, jb, lane, z); a_br = mm_tile<2>(Rt, RP, Bt, RP, ib, jb, lane, z); a_kr = mm_tile<2>(Rt, RP, Kt, RP, ib, jb, lane, z); }
                if (jb >= ib) a_na = mm_tile<2>(Bt, RP, KKt, RP, ib, jb, lane, z);
                f32x4 o_nat, o_tt, o_kk, o_br, o_kr, o_na;
#pragma unroll
                for (int r = 0; r < 4; ++r) { const int jj = j0 + r; const bool lt = jj < i0, le = jj <= i0;
                    o_nat[r] = lt ? -a_nat[r] : 0.f; o_tt[r] = o_nat[r] + (jj == i0 ? 1.0f : 0.f); o_kk[r] = lt ? a_kk[r] : 0.f; o_br[r] = le ? a_br[r] : 0.f; o_kr[r] = le ? a_kr[r] : 0.f;
                    o_na[r] = (i0 < jj) ? -a_na[r] : 0.f; }
                st_bf4(NAT + i0 * RP + j0, o_nat); st_bf4(TT + i0 * RP + j0, o_tt); st_bf4(AkkT + i0 * RP + j0, o_kk); st_bf4(AbrT + i0 * RP + j0, o_br); st_bf4(AkrT + i0 * RP + j0, o_kr); st_bf4(NA + i0 * RP + j0, o_na); }
        }
        LBAR();
        LAS bf16_t* VA = Kt;
#pragma unroll 1
        for (int s = 1; s <= 6; ++s) {
            const LAS bf16_t* Yo = (s & 1) ? NAT : KKt; const LAS bf16_t* YoT = (s & 1) ? NA : Bt; LAS bf16_t* Yn = (s & 1) ? KKt : NAT; LAS bf16_t* YnT = (s & 1) ? Bt : NA;
            const f32x4 z = {0.f, 0.f, 0.f, 0.f};
            if (w < 4) {
                if (s == 1) {
#pragma unroll
                    for (int jb = 0; jb < 4; ++jb) { const f32x4 a = mm_tile<2>(VcT, RP, AkkT, RP, w, jb, lane, z); st_bf4(VA + (w * 16 + (lane & 15)) * RP + jb * 16 + 4 * (lane >> 4), a); }
                } else {
                    f32x4 a[4];
#pragma unroll
                    for (int jb = 0; jb < 4; ++jb) a[jb] = mm_tile<2>(TT, RP, YoT, RP, w, jb, lane, ld_l4(TT + (w * 16 + (lane & 15)) * RP + jb * 16 + 4 * (lane >> 4)));
                    LDS_WAIT();
#pragma unroll
                    for (int jb = 0; jb < 4; ++jb) st_bf4(TT + (w * 16 + (lane & 15)) * RP + jb * 16 + 4 * (lane >> 4), a[jb]);
                }
            } else if (s <= 5) {
                const int ib = w - 4;
#pragma unroll
                for (int jb = 0; jb < 4; ++jb) { const f32x4 a = mm_tile<2>(Yo, RP, YoT, RP, ib, jb, lane, z), bt = mm_tile<2>(YoT, RP, Yo, RP, ib, jb, lane, z);
                    st_bf4(Yn + (ib * 16 + (lane & 15)) * RP + jb * 16 + 4 * (lane >> 4), a); st_bf4(YnT + (ib * 16 + (lane & 15)) * RP + jb * 16 + 4 * (lane >> 4), bt); }
            }
            LBAR();
        }
        LAS bf16_t* KT = NAT; LAS bf16_t* P1 = NA;
        {
            const f32x4 z = {0.f, 0.f, 0.f, 0.f}; const int ib = w & 3; const LAS bf16_t* src = (w < 4) ? KKtT : VA; LAS bf16_t* dst = (w < 4) ? KT : P1;
#pragma unroll
            for (int jb = 0; jb < 4; ++jb) { const f32x4 a = mm_tile<2>(src, RP, TT, RP, ib, jb, lane, z); st_bf4(dst + (ib * 16 + (lane & 15)) * RP + jb * 16 + 4 * (lane >> 4), a); }
        }
        LBAR();
        {
            bf16_t* og = (bf16_t*)(ws + WS_RC + (size_t)u * RC_UNIT) + (w >> 1) * 4096; const int g = w >> 1; const f32x4 z = {0.f, 0.f, 0.f, 0.f};
#pragma unroll
            for (int tt = 0; tt < 2; ++tt) { const int ib = 2 * (w & 1) + tt; const int i0 = ib * 16 + (lane & 15);
#pragma unroll
                for (int jb = 0; jb < 4; ++jb) { const int j0 = jb * 16 + 4 * (lane >> 4); f32x4 o;
                    if (g == 0) o = mm_tile<2>(BhT, RP, KT, RP, ib, jb, lane, z);
                    else if (g == 1) o = mm_tile<2>(VcT, RP, KhT, RP, ib, jb, lane, z) - mm_tile<2>(P1, RP, BhT, RP, ib, jb, lane, z);
                    else if (g == 2) o = ld_l4(Rt + i0 * RP + j0) - mm_tile<2>(AbrT, RP, KT, RP, ib, jb, lane, z);
                    else o = mm_tile<2>(VcT, RP, AkrT, RP, ib, jb, lane, z) - mm_tile<2>(P1, RP, AbrT, RP, ib, jb, lane, z);
                    st_g4(og + i0 * 64 + j0, o); } }
        }
    }
    __syncthreads();
}

struct ScanOps { u32x4 fa0, fa1; u32x2 ad0, ad1; f32x4 om; };
__device__ __forceinline__ ScanOps scan_load(const unsigned char* ws, size_t u, int sk, int vh, int l15, int l4) {
    ScanOps o; const bf16_t* base = (const bf16_t*)(ws + WS_RC + u * RC_UNIT);
    o.fa0 = *(const u32x4*)(base + (sk * 16 + l15) * 64 + 8 * l4); o.fa1 = *(const u32x4*)(base + (sk * 16 + l15) * 64 + 32 + 8 * l4);
    o.ad0 = *(const u32x2*)(base + 4096 + ((2 * vh) * 16 + l15) * 64 + sk * 16 + 4 * l4); o.ad1 = *(const u32x2*)(base + 4096 + ((2 * vh + 1) * 16 + l15) * 64 + sk * 16 + 4 * l4);
    o.om = *(const f32x4*)((const float*)(ws + WS_RC2) + u * 128 + sk * 16 + 4 * l4); return o;
}
template <bool STORE>
__device__ __forceinline__ void rwkv_scan(const Frame& F, int b, int h) {
    unsigned char* ws = F.ws;
    LAS bf16_t* Sb = (LAS bf16_t*)F.lds;
    const int lane = F.lane, w = F.wave, l15 = lane & 15, l4 = lane >> 4, sk = w & 3, vh = w >> 2;
    for (int i = F.tid; i < 2 * RMAT / 2; i += NTHR) ((LAS unsigned*)Sb)[i] = 0u;
    const size_t u0 = (size_t)(b * 8 + h) * 128;
    f32x4 st0 = {0.f, 0.f, 0.f, 0.f}, st1 = {0.f, 0.f, 0.f, 0.f};
    ScanOps r0 = scan_load(ws, u0 + 0, sk, vh, l15, l4), r1 = scan_load(ws, u0 + 1, sk, vh, l15, l4), r2 = scan_load(ws, u0 + 2, sk, vh, l15, l4), r3 = scan_load(ws, u0 + 3, sk, vh, l15, l4);
    __syncthreads();
#define SCAN_STEP(R, cc) do { const int c_ = (cc); \
        const LAS bf16_t* Sc = Sb + (c_ & 1) * RMAT; LAS bf16_t* Sn = Sb + ((c_ + 1) & 1) * RMAT; \
        const bf16x8 a0 = __builtin_bit_cast(bf16x8, R.fa0), a1 = __builtin_bit_cast(bf16x8, R.fa1); \
        const LAS bf16_t* sp0 = Sc + ((2 * vh) * 16 + l15) * RP + 8 * l4; const LAS bf16_t* sp1 = sp0 + 16 * RP; \
        const bf16x8 s00 = *(const LAS bf16x8*)sp0, s01 = *(const LAS bf16x8*)(sp0 + 32), s10 = *(const LAS bf16x8*)sp1, s11 = *(const LAS bf16x8*)(sp1 + 32); \
        bf16_t* sg = (bf16_t*)(ws + WS_RC + (u0 + c_) * RC_UNIT) + 4096; \
        if (STORE) *(u32x4*)(sg + (F.tid >> 3) * 64 + (F.tid & 7) * 8) = *(const LAS u32x4*)(Sc + (F.tid >> 3) * RP + (F.tid & 7) * 8);     \
        f32x4 t0 = {0.f, 0.f, 0.f, 0.f}, t1 = {0.f, 0.f, 0.f, 0.f}; \
        t0 = __builtin_amdgcn_mfma_f32_16x16x32_bf16(a0, s00, t0, 0, 0, 0); t1 = __builtin_amdgcn_mfma_f32_16x16x32_bf16(a0, s10, t1, 0, 0, 0); \
        t0 = __builtin_amdgcn_mfma_f32_16x16x32_bf16(a1, s01, t0, 0, 0, 0); t1 = __builtin_amdgcn_mfma_f32_16x16x32_bf16(a1, s11, t1, 0, 0, 0); \
        const f32x4 n0 = {bflo(R.ad0.x), bfhi(R.ad0.x), bflo(R.ad0.y), bfhi(R.ad0.y)}, n1 = {bflo(R.ad1.x), bfhi(R.ad1.x), bflo(R.ad1.y), bfhi(R.ad1.y)}; \
        st0 = st0 * R.om - t0 + n0; st1 = st1 * R.om - t1 + n1; \
        st_bf4(Sn + ((2 * vh) * 16 + l15) * RP + sk * 16 + 4 * l4, st0); st_bf4(Sn + ((2 * vh + 1) * 16 + l15) * RP + sk * 16 + 4 * l4, st1); \
        R = scan_load(ws, u0 + (c_ + 4 < NCHUNK ? c_ + 4 : NCHUNK - 1), sk, vh, l15, l4);     \
        LBAR(); } while (0)
#pragma unroll 1
    for (int c = 0; c < NCHUNK; c += 16) {
#pragma unroll
        for (int j = 0; j < 16; j += 4) { SCAN_STEP(r0, c + j); SCAN_STEP(r1, c + j + 1); SCAN_STEP(r2, c + j + 2); SCAN_STEP(r3, c + j + 3); } }
#undef SCAN_STEP
}

__device__ __forceinline__ void rwkv_out(const Frame& F, const float* lnx_) {
    unsigned char* ws = F.ws; const bf16_t* lo = (const bf16_t*)(ws + WS_LO);
    LAS float* Yl = (LAS float*)F.lds;
    const int lane = F.lane, w = F.wave, l15 = lane & 15, l4 = lane >> 4, tb = w & 3, vh = w >> 2;
    const int tt = F.tid >> 3, c8 = (F.tid & 7) * 8;
    for (int u = F.blk; u < NB * 8 * NCHUNK; u += F.G) {
        const int c = u & 127, h = (u >> 7) & 7, b = u >> 10;
        const bf16_t* base = (const bf16_t*)(ws + WS_RC + (size_t)u * RC_UNIT);
        const bf16_t* Sg = base + 4096; const bf16_t* QT = base + 8192; const bf16_t* Z = base + 12288;
        const bf16x8 q0 = *(const bf16x8*)(QT + (tb * 16 + l15) * 64 + 8 * l4), q1 = *(const bf16x8*)(QT + (tb * 16 + l15) * 64 + 32 + 8 * l4);
        f32x4 y[2];
#pragma unroll
        for (int i = 0; i < 2; ++i) { const int ib = 2 * vh + i; const bf16_t* sp = Sg + (ib * 16 + l15) * 64 + 8 * l4; const bf16x8 s0 = *(const bf16x8*)sp, s1 = *(const bf16x8*)(sp + 32);
            const u32x2 zw = *(const u32x2*)(Z + (ib * 16 + l15) * 64 + tb * 16 + 4 * l4);
            f32x4 t = {bflo(zw.x), bfhi(zw.x), bflo(zw.y), bfhi(zw.y)};
            t = __builtin_amdgcn_mfma_f32_16x16x32_bf16(q0, s0, t, 0, 0, 0); t = __builtin_amdgcn_mfma_f32_16x16x32_bf16(q1, s1, t, 0, 0, 0); y[i] = t; }
        const int m = b * SEQ + c * 64 + tt, chq = h * 64 + c8;
        const u32x4 cv = *(const u32x4*)(base + 16384 + tt * 64 + c8), cg = *(const u32x4*)(lo + (size_t)m * LO_W + 1024 + chq);
        const float cbc = ((const float*)(ws + WS_RC2))[(size_t)u * 128 + 64 + tt];
        const f32x4 ln0 = *(const f32x4*)(lnx_ + chq), ln1 = *(const f32x4*)(lnx_ + chq + 4);
        LBAR();
#pragma unroll
        for (int i = 0; i < 2; ++i)
#pragma unroll
            for (int r = 0; r < 4; ++r) Yl[(tb * 16 + 4 * l4 + r) * 68 + (2 * vh + i) * 16 + l15] = y[i][r];
        LBAR();
        const f32x4 ya = *(const LAS f32x4*)(Yl + tt * 68 + c8), yb = *(const LAS f32x4*)(Yl + tt * 68 + c8 + 4);
        float yy[8] = {ya[0], ya[1], ya[2], ya[3], yb[0], yb[1], yb[2], yb[3]};
        float s1 = ((yy[0] + yy[1]) + (yy[2] + yy[3])) + ((yy[4] + yy[5]) + (yy[6] + yy[7]));
        s1 = sum8(s1); const float mean = s1 * (1.0f / 64.0f); float s2 = 0.f;
#pragma unroll
        for (int i = 0; i < 8; ++i) { yy[i] -= mean; s2 += yy[i] * yy[i]; }
        s2 = sum8(s2); const float rstd = rsqrtf(s2 * (1.0f / 64.0f) + 64e-5f);
        const unsigned vw[4] = {cv.x, cv.y, cv.z, cv.w}, gw[4] = {cg.x, cg.y, cg.z, cg.w};
        const float lnx[8] = {ln0[0], ln0[1], ln0[2], ln0[3], ln1[0], ln1[1], ln1[2], ln1[3]};
        unsigned ow[4];
#pragma unroll
        for (int i = 0; i < 4; ++i) { float o2[2];
#pragma unroll
            for (int e = 0; e < 2; ++e) { const int ci = 2 * i + e; const float v = e ? bfhi(vw[i]) : bflo(vw[i]), g = e ? bfhi(gw[i]) : bflo(gw[i]);
                o2[e] = (yy[ci] * rstd * lnx[ci] + cbc * v) * g; }
            ow[i] = pk2(o2[0], o2[1]); }
        *(u32x4*)((bf16_t*)(ws + WS_YRW) + (size_t)m * 512 + chq) = (u32x4){ow[0], ow[1], ow[2], ow[3]};
    }
    __syncthreads();
}
__device__ __forceinline__ void rwkv_seq(const Frame& F, const Params& P, int layer, int b, int h) {
    unsigned char* ws = F.ws; const bf16_t* p = (const bf16_t*)(ws + WS_P); const bf16_t* lo = (const bf16_t*)(ws + WS_LO);
    LAS float* Lr = (LAS float*)F.lds; LAS float* Lw = Lr + 4096; LAS float* Lk = Lw + 4096; LAS float* Lv = Lk + 4096; LAS float* Lkk = Lv + 4096; LAS float* Lb = Lkk + 4096; LAS float* Ly = Lb + 4096;
    const int lane = F.lane, ch = h * 64 + lane;
    const float mu_r = P.in[I_MU][(size_t)layer * RWKV_COLS + ch], mu_k = P.in[I_MU][(size_t)layer * RWKV_COLS + 512 + ch], mu_v = P.in[I_MU][(size_t)layer * RWKV_COLS + 1024 + ch];
    const float k_k = P.in[I_KK][layer * 512 + ch], k_a = P.in[I_KA][layer * 512 + ch], r_k = P.in[I_RK][layer * 512 + ch], lnx = P.in[I_LNX][layer * 512 + ch];
    const int vrow = F.tid >> 3, q = F.tid & 7;
    float s[8];
#pragma unroll
    for (int i = 0; i < 8; ++i) s[i] = 0.f;
    for (int c = 0; c < NCHUNK; ++c) {
        const int m0 = b * SEQ + c * 64;
        __syncthreads();
#pragma unroll
        for (int i = 0; i < 8; ++i) { const int t = F.wave + 8 * i, m = m0 + t; const bf16_t* pr = p + (size_t)m * PW + P_RW + ch; const bool hp = (c | t) != 0;
            const float xr = bf2f(pr[0]), xk = bf2f(pr[512]), xv = bf2f(pr[1024]);
            const float pr_ = hp ? bf2f(pr[-PW]) : 0.f, pk_ = hp ? bf2f(pr[512 - PW]) : 0.f, pv_ = hp ? bf2f(pr[1024 - PW]) : 0.f;
            const float r = xr + (pr_ - xr) * mu_r, k = xk + (pk_ - xk) * mu_k, v = xv + (pv_ - xv) * mu_v;
            const float lw = bf2f(lo[(size_t)m * LO_W + ch]), a = bf2f(lo[(size_t)m * LO_W + 512 + ch]);
            float kk = k * k_k; const float ss = wave_sum(kk * kk); kk *= rsqrtf(ss + 1e-12f);
            Lr[t * 64 + lane] = r; Lw[t * 64 + lane] = __expf(lw); Lk[t * 64 + lane] = k * (1.0f + (a - 1.0f) * k_a); Lv[t * 64 + lane] = v; Lkk[t * 64 + lane] = kk; Lb[t * 64 + lane] = kk * a; }
        __syncthreads();
        for (int t = 0; t < 64; ++t) {
            const f32x4 ka = *(const LAS f32x4*)(Lkk + t * 64 + q * 8), kb = *(const LAS f32x4*)(Lkk + t * 64 + q * 8 + 4);
            const f32x4 wa = *(const LAS f32x4*)(Lw + t * 64 + q * 8), wb = *(const LAS f32x4*)(Lw + t * 64 + q * 8 + 4);
            const f32x4 ba = *(const LAS f32x4*)(Lb + t * 64 + q * 8), bb = *(const LAS f32x4*)(Lb + t * 64 + q * 8 + 4);
            const f32x4 k2a = *(const LAS f32x4*)(Lk + t * 64 + q * 8), k2b = *(const LAS f32x4*)(Lk + t * 64 + q * 8 + 4);
            const f32x4 ra = *(const LAS f32x4*)(Lr + t * 64 + q * 8), rb = *(const LAS f32x4*)(Lr + t * 64 + q * 8 + 4);
            const float vv = Lv[t * 64 + vrow];
            float sa = 0.f;
#pragma unroll
            for (int i = 0; i < 4; ++i) { sa += s[i] * ka[i]; sa += s[4 + i] * kb[i]; }
            sa = sum8(sa); sa = -sa;
            float y = 0.f;
#pragma unroll
            for (int i = 0; i < 4; ++i) { s[i] = s[i] * wa[i] + sa * ba[i] + vv * k2a[i]; s[4 + i] = s[4 + i] * wb[i] + sa * bb[i] + vv * k2b[i]; y += s[i] * ra[i]; y += s[4 + i] * rb[i]; }
            y = sum8(y);
            if (q == 0) Ly[t * 64 + vrow] = y;
        }
        __syncthreads();
#pragma unroll
        for (int i = 0; i < 8; ++i) { const int t = F.wave + 8 * i, m = m0 + t;
            const float y = Ly[t * 64 + lane]; const float mean = wave_sum(y) * (1.0f / 64.0f); const float d = y - mean; const float var = wave_sum(d * d) * (1.0f / 64.0f);
            const float bon = wave_sum(Lr[t * 64 + lane] * Lk[t * 64 + lane] * r_k);
            const float g = bf2f(lo[(size_t)m * LO_W + 1024 + ch]);
            const float o = (d * rsqrtf(var + 64e-5f) * lnx + bon * Lv[t * 64 + lane]) * g;
            ((bf16_t*)(ws + WS_YRW))[(size_t)m * 512 + ch] = (bf16_t)f2bf(o); }
    }
    __syncthreads();
}

constexpr int LDS_TAB = LDSCTL_OFF + 64;
__device__ __forceinline__ void moe_table(const Frame& F, const unsigned* ectl) {
    LAS int* tab = (LAS int*)(F.lds + LDS_TAB);
    if (F.tid == 0) { int st = 0, nt = 0;
        for (int e = 0; e < 8; ++e) { const int c = (int)__hip_atomic_load(&ectl[e], __ATOMIC_RELAXED, __HIP_MEMORY_SCOPE_AGENT); tab[1 + e] = st; const int t = (c + 255) >> 8; for (int i = 0; i < t; ++i) tab[16 + nt + i] = e; nt += t; st += t * 256; }
        tab[0] = nt; }
    __syncthreads();
}
__device__ __forceinline__ void phase_moe_scatter(const Frame& F, const unsigned* ectl) {
    unsigned char* ws = F.ws; const LAS int* tab = (const LAS int*)(F.lds + LDS_TAB);
    const int* tok_e = (const int*)(ws + WS_TOK); int* tok_slot = (int*)tok_e + 2 * MTOK; const float* tok_w = (const float*)(tok_slot + 2 * MTOK);
    int* row_tok = (int*)(tok_w + 2 * MTOK); float* row_w = (float*)(row_tok + MAXROWS);
    for (int i = F.blk * NTHR + F.tid; i < 2 * MTOK; i += F.G * NTHR) { const int e = tok_e[i]; const int dest = tab[1 + e] + tok_slot[i]; row_tok[dest] = i >> 1; row_w[dest] = tok_w[i]; tok_slot[i] = dest; }
    const int gt = F.blk * NTHR + F.tid;
    if (gt < 2048) { const int e = gt >> 8; const int c = (int)__hip_atomic_load(&ectl[e], __ATOMIC_RELAXED, __HIP_MEMORY_SCOPE_AGENT); const int r = c + (gt & 255);
        if (r < ((c + 255) & ~255)) { row_tok[tab[1 + e] + r] = -1; row_w[tab[1 + e] + r] = 0.f; } }
}
constexpr int LDS_GTAB = RING_BYTES;
__device__ __forceinline__ void moe_gather_table(const Frame& F, int ncol) {
    const LAS int* tab = (const LAS int*)(F.lds + LDS_TAB); LAS unsigned* gt = (LAS unsigned*)(F.lds + LDS_GTAB);
    const int* row_tok = (const int*)(F.ws + WS_TOK) + 6 * MTOK; const int total = tab[0] * ncol;
    for (int i = F.tid; i < 9 * 256; i += NTHR) { const int u = i >> 8, r = i & 255; const int L = u * F.G + F.blk; unsigned off = 0u;
        if (L < total) { const int tk = row_tok[(L / ncol) * 256 + r]; off = tk > 0 ? (unsigned)tk * (unsigned)(DM * 2) : 0u; }
        gt[i] = off; }
    __syncthreads();
}

extern __shared__ __attribute__((aligned(16))) unsigned char lds_raw[];
template <class T> __device__ __forceinline__ T* uni(T* p) { const unsigned long long v = (unsigned long long)p; const unsigned lo = __builtin_amdgcn_readfirstlane((unsigned)v), hi = __builtin_amdgcn_readfirstlane((unsigned)(v >> 32)); return (T*)(((unsigned long long)hi << 32) | lo); }
__device__ __forceinline__ int uni(int v) { return __builtin_amdgcn_readfirstlane(v); }
__device__ __forceinline__ Frame mkframe(unsigned char* ws, int wv) {
    Frame F; F.lds = (LAS unsigned char*)lds_raw; int tid = wv * 64 + lane_id_fresh(); F.tid = tid; F.lane = F.tid & 63; F.wave = __builtin_amdgcn_readfirstlane(F.tid >> 6);
    int blk = blockIdx.x; asm volatile("" : "+s"(blk)); F.blk = blk; F.G = gridDim.x; F.vcu = (F.blk & 7) * (F.G >> 3) + (F.blk >> 3); F.gw = F.blk * NWAVES + F.wave; F.ngw = F.G * NWAVES; F.ws = ws; return F;
}
#define PHASE __device__ __forceinline__ void
PHASE f_moe_convert(int wv, unsigned char* ws_, const float* mg, const float* mu, const float* md) {
    unsigned char* ws = uni(ws_); const Frame F = mkframe(ws, wv); Params P; P.in[I_MG] = uni(mg); P.in[I_MU2] = uni(mu); P.in[I_MD] = uni(md); phase_moe_convert(F, P);
}
PHASE f_rms(int wv, unsigned char* ws_, const float* src, const float* gain) { unsigned char* ws = uni(ws_); const Frame F = mkframe(ws, wv); phase_rms<false>(F, uni(src), uni(gain), (bf16_t*)(ws + WS_HN), nullptr, nullptr, nullptr, nullptr, nullptr); }
PHASE f_rms_moe(int wv, unsigned char* ws_, const float* src, const float* gain, const float* router) {
    unsigned char* ws = uni(ws_); const Frame F = mkframe(ws, wv); int* tok_e = (int*)(ws + WS_TOK); int* tok_slot = tok_e + 2 * MTOK; float* tok_w = (float*)(tok_slot + 2 * MTOK);
    phase_rms<true>(F, uni(src), uni(gain), (bf16_t*)(ws + WS_HN), uni(router), (unsigned*)(ws + WS_CTL) + CW_ECNT, tok_e, tok_slot, tok_w);
}
PHASE f_prep(int wv, unsigned char* ws_, const float* mu, const float* qnorm, const float* kvnorm, int layer_) {
    unsigned char* ws = uni(ws_); const Frame F = mkframe(ws, wv); Params P; P.in[I_MU] = uni(mu); P.in[I_QNORM] = uni(qnorm); P.in[I_KVNORM] = uni(kvnorm); (void)layer_; phase_prep(F, P, 0);
}
PHASE f_ret_scan(int wv, unsigned char* ws_) { unsigned char* ws = uni(ws_); const Frame F = mkframe(ws, wv); ret_scan(F); }
PHASE f_ret_out(int wv, unsigned char* ws_) { unsigned char* ws = uni(ws_); const Frame F = mkframe(ws, wv); ret_out(F); }
PHASE f_rwkv_seq(int wv, unsigned char* ws_, const float* mu, const float* kk, const float* ka, const float* rk, const float* lnx, int layer_) {
    unsigned char* ws = uni(ws_); const Frame F = mkframe(ws, wv); Params P; P.in[I_MU] = uni(mu); P.in[I_KK] = uni(kk); P.in[I_KA] = uni(ka); P.in[I_RK] = uni(rk); P.in[I_LNX] = uni(lnx);
    (void)layer_; rwkv_seq(F, P, 0, F.blk >> 3, F.blk & 7);
}
PHASE f_rwkv_pre(int wv, unsigned char* ws_, const float* mu, const float* kk, const float* ka, const float* rk) { unsigned char* ws = uni(ws_); const Frame F = mkframe(ws, wv); rwkv_chunk_pre(F, uni(mu), uni(kk), uni(ka), uni(rk)); }
PHASE f_rwkv_scan(int wv, unsigned char* ws_) { unsigned char* ws = uni(ws_); const Frame F = mkframe(ws, wv); rwkv_scan<true>(F, F.blk >> 3, F.blk & 7);
#ifdef SCAN_TWICE
    __syncthreads(); rwkv_scan<false>(F, F.blk >> 3, F.blk & 7);
#endif
}
PHASE f_rwkv_out(int wv, unsigned char* ws_, const float* lnx) { unsigned char* ws = uni(ws_); const Frame F = mkframe(ws, wv); rwkv_out(F, uni(lnx)); }
PHASE f_attn(int wv, unsigned char* ws_, int layer_) {
    unsigned char* ws = uni(ws_); const int layer = uni(layer_); const Frame F = mkframe(ws, wv);
    unsigned* qh = (unsigned*)(ws + WS_CTL) + CW_ATTQ + layer * 512; volatile LAS unsigned* slot = (volatile LAS unsigned*)(F.lds + LDSCTL_OFF + 32);
    const int my = (int)(xb_xcc_id() & 7u);
    for (int k = 0; k < 8; ++k) { const int q = (my + k) & 7;
        for (;;) {
            if (F.tid == 0) *slot = __hip_atomic_fetch_add(qh + q * 64, 1u, __ATOMIC_RELAXED, __HIP_MEMORY_SCOPE_AGENT);
            __syncthreads();
            const int idx = (int)*slot;
            __syncthreads();
            if (idx >= 64) break;
            const int bh = 2 * q + (idx & 1), qt = 31 - (idx >> 1);
            attn_unit(F, bh >> 3, bh & 7, qt);
        } }
}
PHASE f_moe_scatter(int wv, unsigned char* ws_) { unsigned char* ws = uni(ws_); const Frame F = mkframe(ws, wv); moe_table(F, (unsigned*)(ws + WS_CTL) + CW_ECNT); phase_moe_scatter(F, (unsigned*)(ws + WS_CTL) + CW_ECNT); }
PHASE f_final(int wv, unsigned char* ws_, float* h, const float* gain) { unsigned char* ws = uni(ws_); const Frame F = mkframe(ws, wv); phase_final(F, uni(h), uni(gain), (const bf16_t*)(ws + WS_OUT2), (const int*)(ws + WS_TOK) + 2 * MTOK); }
PHASE g_inproj(int wv, unsigned char* ws_, int layer_) {
    unsigned char* ws = uni(ws_); const int layer = uni(layer_); const Frame F = mkframe(ws, wv);
    SchedGrid S; S.init(64, 18, F.G, F.blk, ws + WS_HN, (size_t)256 * DM * 2, (bf16_t*)(ws + WS_WIN) + (size_t)layer * WIN_ROWS * DM, (size_t)256 * DM * 2);
    EpiStore E; E.O = (bf16_t*)(ws + WS_P); E.ld = PW; pg8::gemm_phase(F.lds, F.tid, DM, DM, DM, S, E);
}
PHASE g_lora(int wv, unsigned char* ws_, const float* w0, const float* a0, int layer_) {
    unsigned char* ws = uni(ws_); const int layer = uni(layer_); const Frame F = mkframe(ws, wv);
    SchedGrid S; S.init(64, 6, F.G, F.blk, ws + WS_LIN, (size_t)256 * LORA_K * 2, (bf16_t*)(ws + WS_LORA) + (size_t)layer * 1536 * LORA_K, (size_t)256 * LORA_K * 2);
    EpiLora E; E.O = (bf16_t*)(ws + WS_LO); E.w0 = uni(w0); E.a0 = uni(a0); pg8::gemm_phase(F.lds, F.tid, LORA_K, LORA_K, LORA_K, S, E);
}
PHASE g_small(int wv, unsigned char* ws_, int layer_) {
    unsigned char* ws = uni(ws_); const Frame F = mkframe(ws, wv); SchedSmall S; S.G = F.G; S.c = F.blk; S.layer = uni(layer_); S.ws = (const char*)ws; EpiSmall E; E.ws = ws; pg8::gemm_phase(F.lds, F.tid, 256, 256, 256, S, E);
}
PHASE g_gate(int wv, unsigned char* ws_, int layer_) {
    unsigned char* ws = uni(ws_); const int layer = uni(layer_); const Frame F = mkframe(ws, wv);
    SchedOwn3 S; S.c = F.blk; S.G = F.G; S.A = (const char*)(ws + WS_HN); S.a_n = 0; S.astep = (size_t)256 * DM * 2; S.B = (const char*)((bf16_t*)(ws + WS_WIN) + ((size_t)layer * WIN_ROWS + PW) * DM); S.bstep = (size_t)256 * DM * 2; S.b_n = (size_t)1024 * DM * 2;
    EpiGate E; E.O = (bf16_t*)(ws + WS_G); pg8::gemm_phase(F.lds, F.tid, DM, DM, DM, S, E);
}
PHASE g_merge(int wv, unsigned char* ws_, int layer_) {
    unsigned char* ws = uni(ws_); const int layer = uni(layer_); const Frame F = mkframe(ws, wv);
    SchedOwn3 S; S.c = F.blk; S.G = F.G; S.A = (const char*)(ws + WS_YRET); S.a_n = (size_t)16 * MiB; S.astep = (size_t)256 * 512 * 2;
    S.B = (const char*)((bf16_t*)(ws + WS_BR) + (size_t)layer * 3 * 1024 * 512); S.bstep = (size_t)256 * 512 * 2; S.b_n = (size_t)1024 * 512 * 2;
    EpiMerge E; E.Gt = (const bf16_t*)(ws + WS_G); E.Mg = (bf16_t*)(ws + WS_MRG); pg8::gemm_phase(F.lds, F.tid, 512, 512, 512, S, E);
}
PHASE g_wo(int wv, unsigned char* ws_, const float* hin, float* hout, int layer_) {
    unsigned char* ws = uni(ws_); const int layer = uni(layer_); const Frame F = mkframe(ws, wv);
    SchedGrid S; S.init(64, 4, F.G, F.blk, ws + WS_MRG, (size_t)256 * DM * 2, (bf16_t*)(ws + WS_WO) + (size_t)layer * DM * DM, (size_t)256 * DM * 2);
    EpiResid E; E.In = uni(hin); E.Out = uni(hout); pg8::gemm_phase(F.lds, F.tid, DM, DM, DM, S, E);
}
PHASE g_ffn_gu(int wv, unsigned char* ws_) {
    unsigned char* ws = uni(ws_); const Frame F = mkframe(ws, wv);
    SchedGrid S; S.init(64, 22, F.G, F.blk, ws + WS_HN, (size_t)256 * DM * 2, ws + WS_FGU, (size_t)256 * DM * 2);
    EpiSwiglu E; E.O = (bf16_t*)(ws + WS_ACT); E.ldc = DFF; E.pn_off = 0; pg8::gemm_phase(F.lds, F.tid, DM, DM, DM, S, E);
}
PHASE g_ffn_down(int wv, unsigned char* ws_, float* h) {
    unsigned char* ws = uni(ws_); const Frame F = mkframe(ws, wv);
    SchedGrid S; S.init(64, 4, F.G, F.blk, ws + WS_ACT, (size_t)256 * DFF * 2, ws + WS_FD, (size_t)256 * DFF * 2);
    EpiResid E; E.In = uni(h); E.Out = E.In ? (float*)E.In : nullptr; pg8::gemm_phase(F.lds, F.tid, DFF, DFF, DFF, S, E);
}
PHASE g_moe_gu(int wv, unsigned char* ws_, int hh_) {
    unsigned char* ws = uni(ws_); const int hh = uni(hh_); const Frame F = mkframe(ws, wv); const LAS int* tab = (const LAS int*)(F.lds + LDS_TAB);
    moe_gather_table(F, 14);
    SchedMoe S; S.G = F.G; S.c = F.blk; S.ncol = 14; S.ntile = tab[0]; S.tab = tab + 16; S.A = (const char*)(ws + WS_HN); S.astep = 0;
    S.B = (const char*)(ws + WS_MGU) + (size_t)hh * 14 * 256 * DM * 2; S.bstep = (size_t)256 * DM * 2; S.estep = (size_t)2 * DFFE * DM * 2;
    EpiSwiglu E; E.O = (bf16_t*)(ws + WS_MACT); E.ldc = DFFH; E.pn_off = 0; pg8::gemm_phase<EpiSwiglu, SchedMoe, true>(F.lds, F.tid, DM, DM, DM, S, E, (const LAS unsigned*)(F.lds + LDS_GTAB));
}
template <bool ACCUM>
PHASE g_moe_down(int wv, unsigned char* ws_, int hh_) {
    unsigned char* ws = uni(ws_); const int hh = uni(hh_); const Frame F = mkframe(ws, wv); const LAS int* tab = (const LAS int*)(F.lds + LDS_TAB);
    const float* row_w = (const float*)((const int*)(ws + WS_TOK) + 6 * MTOK + MAXROWS);
    SchedMoe S; S.G = F.G; S.c = F.blk; S.ncol = 4; S.ntile = tab[0]; S.tab = tab + 16; S.A = (const char*)(ws + WS_MACT); S.astep = (size_t)256 * DFFH * 2;
    S.B = (const char*)(ws + WS_MD) + (size_t)hh * DFFH * 2; S.bstep = (size_t)256 * DFFE * 2; S.estep = (size_t)DM * DFFE * 2;
    EpiMoeOut<ACCUM> E; E.row_w = row_w; E.O = (bf16_t*)(ws + WS_OUT2); pg8::gemm_phase(F.lds, F.tid, DFFH, DFFH, DFFE, S, E);
}

typedef const __attribute__((address_space(4))) Params* KPtr;
__device__ __forceinline__ KPtr kargs() { KPtr k = (KPtr)__builtin_amdgcn_kernarg_segment_ptr(); asm volatile("" : "+s"(k)); return k; }
#define KIN(i) (kargs()->in[i])
#define KWS() (kargs()->ws)
struct TpState { unsigned long long tp0, tp1; int tpk; };
#define tp0 tps.tp0
#define tp1 tps.tp1
#define tpk tps.tpk
#define GRID_BAR() do { XcdBarrier b_ = bar; b_.bar = (unsigned*)(KWS() + WS_CTL) + CW_BAR; b_.x = xb_xcc_id(); xcd_barrier(b_); } while (0)
#ifdef TPH
#define TP(k) do { if ((k) == TPH) tp0 = __builtin_amdgcn_s_memrealtime(); if ((k) == TPH + TPN) tp1 = __builtin_amdgcn_s_memrealtime(); } while (0)
#define TPM() do { ++tpk; TP(tpk); } while (0)
#else
#define TP(k) do { } while (0)
#define TPM() do { } while (0)
#endif
template <int layer>
__device__ __forceinline__ void layer_body(const int wv, const XcdBarrier& bar, TpState& tps) {
        f_rms(wv, KWS(), layer == 0 ? KIN(I_X) : (const float*)kargs()->out, KIN(I_ANORM) + layer * DM);
        GRID_BAR();
        TPM();
        g_inproj(wv, KWS(), layer);
        GRID_BAR();
        TPM();
        f_prep(wv, KWS(), KIN(I_MU) + (size_t)layer * RWKV_COLS, KIN(I_QNORM) + layer * 256, KIN(I_KVNORM) + layer * 128, layer);
        GRID_BAR();
        TPM();
        f_ret_scan(wv, KWS());
        g_lora(wv, KWS(), KIN(I_W0) + layer * 512, KIN(I_A0) + layer * 512, layer);
        g_small(wv, KWS(), layer);
        GRID_BAR();
        TPM();
        f_ret_out(wv, KWS());
#ifdef SPLIT5
        GRID_BAR();
        TPM();
#endif
#ifndef RWKV_SEQ
        f_rwkv_pre(wv, KWS(), KIN(I_MU) + (size_t)layer * RWKV_COLS, KIN(I_KK) + layer * 512, KIN(I_KA) + layer * 512, KIN(I_RK) + layer * 512);
        GRID_BAR();
        TPM();
        if ((int)blockIdx.x < 16) f_rwkv_scan(wv, KWS());
#ifdef SPLIT6
        GRID_BAR();
        TPM();
#endif
#else
        GRID_BAR();
        TPM();
        if (blockIdx.x < 16) f_rwkv_seq(wv, KWS(), KIN(I_MU) + (size_t)layer * RWKV_COLS, KIN(I_KK) + layer * 512, KIN(I_KA) + layer * 512, KIN(I_RK) + layer * 512, KIN(I_LNX) + layer * 512, layer);
#endif
        f_attn(wv, KWS(), layer);
        GRID_BAR();
        TPM();
#ifndef RWKV_SEQ
        f_rwkv_out(wv, KWS(), KIN(I_LNX) + layer * 512);
#endif
        g_gate(wv, KWS(), layer);
#ifndef RWKV_SEQ
        GRID_BAR();
        TPM();
#endif
        g_merge(wv, KWS(), layer);
        GRID_BAR();
        TPM();
        g_wo(wv, KWS(), layer == 0 ? KIN(I_X) : (const float*)kargs()->out, kargs()->out, layer);
        GRID_BAR();
        TPM();
        if constexpr (layer == 0) {
            f_rms(wv, KWS(), kargs()->out, KIN(I_FNORM) + layer * DM);
            GRID_BAR();
            TPM();
            g_ffn_gu(wv, KWS());
            GRID_BAR();
            TPM();
            g_ffn_down(wv, KWS(), kargs()->out);
            GRID_BAR();
            TPM();
        } else {
            f_rms_moe(wv, KWS(), kargs()->out, KIN(I_FNORM) + layer * DM, KIN(I_ROUTER));
            GRID_BAR();
            TPM();
            f_moe_scatter(wv, KWS());
            f_moe_convert(wv, KWS(), KIN(I_MG), KIN(I_MU2), KIN(I_MD));
            GRID_BAR();
            TPM();
            g_moe_gu(wv, KWS(), 0);
            GRID_BAR();
            TPM();
            g_moe_down<false>(wv, KWS(), 0);
            GRID_BAR();
            TPM();
            g_moe_gu(wv, KWS(), 1);
            GRID_BAR();
            TPM();
            g_moe_down<true>(wv, KWS(), 1);
            GRID_BAR();
            TPM();
        }
    }
__global__ void __launch_bounds__(NTHR, 2) mega(Params P_unused) {
    LAS unsigned char* lds = (LAS unsigned char*)lds_raw;
    const int wv = __builtin_amdgcn_readfirstlane((int)threadIdx.x >> 6);
    for (int u = threadIdx.x; u < (LDS_BYTES - LDSCTL_OFF) / 4; u += NTHR) ((LAS unsigned*)(lds + LDSCTL_OFF))[u] = 0u;
    __syncthreads();
    const XcdBarrier bar = xcd_barrier_post((unsigned*)(KWS() + WS_CTL) + CW_BAR, (volatile LAS unsigned*)(lds + LDSCTL_OFF), wv);
    TpState tps = {0ull, 0ull, 0};
    TP(0);
    {
        KPtr k = kargs(); unsigned char* ws = k->ws; const Frame F = mkframe(ws, wv);
        Params P; P.in[I_WIN] = k->in[I_WIN]; P.in[I_WQB] = k->in[I_WQB]; P.in[I_WBR] = k->in[I_WBR]; P.in[I_WO] = k->in[I_WO]; P.in[I_FG] = k->in[I_FG]; P.in[I_FU] = k->in[I_FU]; P.in[I_FD] = k->in[I_FD];
        P.in[I_W2] = k->in[I_W2]; P.in[I_A2] = k->in[I_A2]; P.in[I_G2] = k->in[I_G2]; P.in[I_WKVB] = k->in[I_WKVB]; P.in[I_POS] = k->in[I_POS];
        phase_prologue(F, P);
    }
    GRID_BAR();
    TPM();
    layer_body<0>(wv, bar, tps);
    layer_body<1>(wv, bar, tps);
    f_final(wv, KWS(), kargs()->out, KIN(I_FINAL));
#ifdef TPH
    __syncthreads(); TPM();
    { const unsigned long long te = __builtin_amdgcn_s_memrealtime(), span = (tp1 - tp0) * (unsigned long long)TAMP; while (__builtin_amdgcn_s_memrealtime() - te < span) __builtin_amdgcn_s_sleep(8); }
#endif
}

extern "C" void kernel_launch(void* const* d_in, const int* in_sizes, int n_in, void* d_out, int out_size, void* d_ws, size_t ws_size, hipStream_t stream) {
    static int ready = 0;
    if (!ready) {
        if (n_in != 29 || out_size != MTOK * DM || ws_size < WS_END) { fprintf(stderr, "kernel_launch: unexpected shapes (n_in %d out %d ws %zu need %zu)\n", n_in, out_size, ws_size, (size_t)WS_END); ready = -1; return; }
        if (hipFuncSetAttribute((const void*)mega, hipFuncAttributeMaxDynamicSharedMemorySize, LDS_BYTES) != hipSuccess) { fprintf(stderr, "kernel_launch: hipFuncSetAttribute failed\n"); ready = -1; return; }
        int dev = 0, cus = 0, per_cu = 0; (void)hipGetDevice(&dev); (void)hipDeviceGetAttribute(&cus, hipDeviceAttributeMultiprocessorCount, dev);
        (void)hipOccupancyMaxActiveBlocksPerMultiprocessor(&per_cu, (const void*)mega, NTHR, LDS_BYTES);
        if (cus < 256 || per_cu < 1) { fprintf(stderr, "kernel_launch: needs 256 CUs with one resident workgroup each (cus %d, per_cu %d)\n", cus, per_cu); ready = -1; return; }
        ready = 1;
    }
    if (ready < 0) return;
    (void)hipMemsetAsync((char*)d_ws + WS_CTL, 0, CTL_BYTES, stream);
    Params p{}; for (int i = 0; i < 29; ++i) p.in[i] = (const float*)d_in[i]; p.out = (float*)d_out; p.ws = (unsigned char*)d_ws;
    hipLaunchKernelGGL(mega, dim3(256), dim3(NTHR), LDS_BYTES, stream, p);
}
```

```cpp
#include <hip/hip_runtime.h>
#include <cstdio>
#include <cstdint>

#define LAS __attribute__((address_space(3)))
#define GAS __attribute__((address_space(1)))
typedef unsigned short bf16_t;
typedef short bf16x8 __attribute__((ext_vector_type(8)));
typedef short bf16x4 __attribute__((ext_vector_type(4)));
typedef float f32x4 __attribute__((ext_vector_type(4)));
typedef float f32x2 __attribute__((ext_vector_type(2)));
typedef float f32x16 __attribute__((ext_vector_type(16)));
typedef unsigned u32x4 __attribute__((ext_vector_type(4)));
typedef unsigned u32x2 __attribute__((ext_vector_type(2)));

constexpr int NB = 2, SEQ = 8192, DM = 1024, MTOK = NB * SEQ, NLAYER = 2, CH = 64, NCHUNK = SEQ / CH;
constexpr int IN_COLS = 7360, PW = 4608;
constexpr int P_RQ = 0, P_RK = 512, P_RV = 1024, P_RG = 1536, P_RW = 2048, P_QA = 4096, P_KVA = 4352;
constexpr int WIN_ROWS = 7680;
constexpr int RWKV_COLS = 1824, LORA_K = 384, LO_W = 1536;
constexpr int DFF = 2816, DFFE = 3584, NEXP = 8, DFFH = DFFE / 2;
constexpr int MAXROWS = 34816;
constexpr float NORM_EPS = 1e-6f;

constexpr size_t MiB = 1u << 20;
constexpr size_t WS_CTL = 0, CTL_BYTES = 1 * MiB;
constexpr size_t WS_WIN = 1 * MiB;
constexpr size_t WS_LORA = 31 * MiB;
constexpr size_t WS_QB = 34 * MiB;
constexpr size_t WS_KB = 35 * MiB;
constexpr size_t WS_VB = 35 * MiB + 512 * 1024;
constexpr size_t WS_BR = 36 * MiB;
constexpr size_t WS_WO = 42 * MiB;
constexpr size_t WS_FGU = 46 * MiB;
constexpr size_t WS_FD = 57 * MiB;
constexpr size_t WS_COSR = 63 * MiB, WS_SINR = 67 * MiB, WS_COSM = 71 * MiB, WS_SINM = 72 * MiB;
constexpr size_t WS_HN = 73 * MiB;
constexpr size_t WS_TOK = 105 * MiB;
constexpr size_t WS_T = 106 * MiB;
constexpr size_t WS_P = WS_T;
constexpr size_t WS_G = WS_T;
constexpr size_t WS_MRG = WS_T + 96 * MiB;
constexpr size_t WS_LO = WS_T + 144 * MiB;
constexpr size_t WS_Q = WS_T + 192 * MiB;
constexpr size_t WS_KN = WS_T + 216 * MiB;
constexpr size_t WS_VT = WS_T + 232 * MiB;
constexpr size_t WS_KPE = WS_T + 248 * MiB;
constexpr size_t WS_LIN = WS_T + 249 * MiB;
constexpr size_t WS_QN = WS_T + 261 * MiB;
constexpr size_t WS_CN = WS_T + 269 * MiB;
constexpr size_t WS_YRET = WS_T + 261 * MiB;
constexpr size_t WS_RS = WS_T + 277 * MiB;
constexpr size_t WS_YRW = WS_T + 277 * MiB;
constexpr size_t WS_YMLA = WS_T + 293 * MiB;
constexpr size_t WS_RC = WS_T + 309 * MiB;
constexpr size_t WS_ACT = WS_T;
constexpr size_t WS_MGU = WS_T;
constexpr size_t WS_MD = WS_T + 112 * MiB;
constexpr size_t WS_MACT = WS_T + 168 * MiB;
constexpr size_t WS_OUT2 = WS_T + 287 * MiB;
constexpr size_t WS_SS = WS_T + 390 * MiB;
constexpr size_t WS_END = WS_T + 391 * MiB;
static_assert(WS_MACT + (size_t)MAXROWS * DFFH * 2 <= WS_OUT2 && WS_OUT2 + (size_t)MAXROWS * DM * 2 <= WS_END, "ws map");
constexpr int CW_BAR = 4096;
constexpr int CW_ECNT = 16384;
constexpr int CW_ATTQ = 20480;

__device__ __forceinline__ unsigned f2bf(float f) { unsigned u = __builtin_bit_cast(unsigned, f); return (u + 0x7fffu + ((u >> 16) & 1u)) >> 16; }
typedef __bf16 bf16n2 __attribute__((ext_vector_type(2)));
__device__ __forceinline__ unsigned pk2(float lo, float hi) { const f32x2 f = {lo, hi}; const bf16n2 v = __builtin_convertvector(f, bf16n2); return __builtin_bit_cast(unsigned, v); }
__device__ __forceinline__ float bf2f(unsigned short h) { return __builtin_bit_cast(float, (unsigned)h << 16); }
__device__ __forceinline__ float bflo(unsigned w) { return __builtin_bit_cast(float, w << 16); }
__device__ __forceinline__ float bfhi(unsigned w) { return __builtin_bit_cast(float, w & 0xffff0000u); }
template <int CTRL, int ROWMASK = 0xF>
__device__ __forceinline__ float dpp_add(float v) { const int t = __builtin_amdgcn_update_dpp(0, __builtin_bit_cast(int, v), CTRL, ROWMASK, 0xF, ROWMASK == 0xF); return v + __builtin_bit_cast(float, t); }
#ifdef NO_DPP
__device__ __forceinline__ float sum4(float v)  { v += __shfl_xor(v, 1); v += __shfl_xor(v, 2); return v; }
__device__ __forceinline__ float sum8(float v)  { v = sum4(v); v += __shfl_xor(v, 4); return v; }
__device__ __forceinline__ float sum16(float v) { v = sum8(v); v += __shfl_xor(v, 8); return v; }
__device__ __forceinline__ float wave_sum(float v) { v = sum16(v); v += __shfl_xor(v, 16); v += __shfl_xor(v, 32); return v; }
#else
__device__ __forceinline__ float sum4(float v)  { v = dpp_add<0xB1>(v); return dpp_add<0x4E>(v); }
__device__ __forceinline__ float sum8(float v)  { return dpp_add<0x141>(sum4(v)); }
__device__ __forceinline__ float sum16(float v) { return dpp_add<0x140>(sum8(v)); }
__device__ __forceinline__ float wave_sum(float v) {
    v = sum16(v); v = dpp_add<0x142, 0xA>(v); v = dpp_add<0x143, 0xC>(v);
    return __builtin_bit_cast(float, __builtin_amdgcn_readlane(__builtin_bit_cast(int, v), 63));
}
#endif
__device__ __forceinline__ float sigmoidf_(float x) { return 1.0f / (1.0f + __expf(-x)); }
#define LDS_WAIT() asm volatile("s_waitcnt lgkmcnt(0)" ::: "memory")
#define LBAR() do { asm volatile("s_waitcnt lgkmcnt(0)" ::: "memory"); __builtin_amdgcn_s_barrier(); asm volatile("" ::: "memory"); } while (0)
#define VM_WAIT() asm volatile("s_waitcnt vmcnt(0)" ::: "memory")

#define XB_TMO      128
#define XB_XCNT(j)  (256  + 64 * (j))
#define XB_XSUB(j)  (1280 + 64 * (j))
#define XB_XGEN(j)  (2304 + 64 * (j))
#define XB_TOP      3328
#define XB_TOPGEN   3392
#define XCD_BAR_WORDS 3456
#define XB_SPIN_CAP (1u << 18)
__device__ __forceinline__ unsigned xb_ld(unsigned* p)              { return __hip_atomic_load(p, __ATOMIC_RELAXED, __HIP_MEMORY_SCOPE_AGENT); }
__device__ __forceinline__ unsigned xb_add(unsigned* p, unsigned v) { return __hip_atomic_fetch_add(p, v, __ATOMIC_RELAXED, __HIP_MEMORY_SCOPE_AGENT); }
__device__ __forceinline__ unsigned xb_xcc_id() { return (unsigned)__builtin_amdgcn_s_getreg((3 << 11) | 20) & 0xFu; }
#define XB_SPIN(cond, bar) do { unsigned _sp = 0; while (cond) { __builtin_amdgcn_s_sleep(1); \
    if ((++_sp & 255u) == 0u) { if (xb_ld(&(bar)[XB_TMO])) break; if (_sp > XB_SPIN_CAP) { atomicAdd(&(bar)[XB_TMO], 1u); break; } } } } while (0)
struct XcdBarrier { unsigned* bar; unsigned x; volatile LAS unsigned* st; int wv; };
__device__ __forceinline__ int lane_id_fresh() { int l; asm volatile("v_mbcnt_lo_u32_b32 %0, -1, 0\n\tv_mbcnt_hi_u32_b32 %0, -1, %0" : "=v"(l)); return l; }
__device__ __forceinline__ bool xb_thread0(int wv) { return wv == 0 && lane_id_fresh() == 0; }
__device__ __forceinline__ XcdBarrier xcd_barrier_post(unsigned* bar, volatile LAS unsigned* st, int wv) {
    XcdBarrier b; b.bar = bar; b.x = xb_xcc_id(); b.st = st; b.wv = wv;
    if (xb_thread0(wv)) (void)xb_add(&bar[XB_XCNT(b.x)], 1u);
    return b;
}
__device__ __forceinline__ void xcd_barrier_complete(unsigned* bar, unsigned x, unsigned& nloc, unsigned& nx) {
    const unsigned G = gridDim.x * gridDim.y * gridDim.z;
    unsigned sum, cnt, mine, sp = 0u;
    for (;;) {
        sum = 0u; cnt = 0u; mine = 0u;
#pragma unroll
        for (unsigned j = 0; j < 16; ++j) { const unsigned c = xb_ld(&bar[XB_XCNT(j)]); sum += c; cnt += (c > 0u) ? 1u : 0u; mine = (j == x) ? c : mine; }
        if (sum == G) break;
        __builtin_amdgcn_s_sleep(1);
        if ((++sp & 255u) == 0u) { if (xb_ld(&bar[XB_TMO])) break; if (sp > XB_SPIN_CAP) { atomicAdd(&bar[XB_TMO], 1u); break; } }
    }
    nloc = mine > 0u ? mine : 1u; nx = cnt > 0u ? cnt : 1u;
}
__device__ __forceinline__ void xcd_barrier(const XcdBarrier& b) {
    asm volatile("s_waitcnt vmcnt(0)" ::: "memory");
    __syncthreads();
    if (xb_thread0(b.wv)) {
        unsigned* bar = b.bar;
        __builtin_amdgcn_s_waitcnt(0);
        unsigned nloc = b.st[0], nx = b.st[1];
        if (nloc == 0u) { xcd_barrier_complete(bar, b.x, nloc, nx); b.st[0] = nloc; b.st[1] = nx; }
        const unsigned old = xb_add(&bar[XB_XSUB(b.x)], 1u);
        const unsigned gen = old / nloc;
        if (old + 1u == (gen + 1u) * nloc) {
            __builtin_amdgcn_fence(__ATOMIC_RELEASE, "agent");
            asm volatile("s_waitcnt vmcnt(0)" ::: "memory");
            const unsigned og = xb_add(&bar[XB_TOP], 1u);
            const unsigned tg = og / nx;
            if (og + 1u == (tg + 1u) * nx) xb_add(&bar[XB_TOPGEN], 1u);
            else XB_SPIN(xb_ld(&bar[XB_TOPGEN]) == tg, bar);
            __builtin_amdgcn_fence(__ATOMIC_ACQUIRE, "agent");
            xb_add(&bar[XB_XGEN(b.x)], 1u);
            asm volatile("s_waitcnt vmcnt(0)" ::: "memory");
        } else {
            XB_SPIN(xb_ld(&bar[XB_XGEN(b.x)]) == gen, bar);
            __builtin_amdgcn_fence(__ATOMIC_ACQUIRE, "agent");
            asm volatile("s_waitcnt vmcnt(0)" ::: "memory");
        }
    }
    __syncthreads();
}

namespace pg8 {
constexpr int BM = 256, BK = 64, HALF = 128, HTB = HALF * BK * 2, STAGE_BYTES = 8 * HTB;
__device__ __forceinline__ int lds_byte(int r, int c) { const int st = (r >> 4) * 2 + (c >> 5), rr = r & 15, cc = c & 31, ob = rr * 64 + cc * 2; return st * 1024 + (ob ^ (((ob >> 9) & 1) << 5)); }
__device__ __forceinline__ void stage_rc(int b, int& R, int& C) { const int st = b / 1024, sb = b % 1024, swz = sb ^ (((sb >> 9) & 1) << 5); R = (st >> 1) * 16 + swz / 64; C = (st & 1) * 32 + (swz % 64) / 2; }
__device__ __forceinline__ int perm32(int rho) { const int n = rho >> 4, i = rho & 15; return 8 * (i >> 2) + 4 * n + (i & 3); }
struct Unit { int pm, pn, aux; const char* A; const char* B; };
__device__ __forceinline__ unsigned cvt_pk_bf16(float lo, float hi) { return pk2(lo, hi); }

template <class Epi, class Sched, bool GATHER = false>
__device__ __forceinline__ void gemm_phase(LAS unsigned char* lds, const int tid_in, const int K, const int lda, const int ldb, const Sched& S, const Epi& E, const LAS unsigned* gtab = nullptr) {
    int tid_ = tid_in; asm volatile("" : "+v"(tid_));
    const int tid = tid_, wid = __builtin_amdgcn_readfirstlane(tid >> 6), lane = tid & 63, wr = wid >> 2, wc = wid & 3, fr = lane & 15, fq = lane >> 4;
    const int nt = K / BK;
    unsigned voffA[2], voffB[2];
#pragma unroll
    for (int i = 0; i < 2; ++i) { int R, C; stage_rc(tid * 16 + i * 8192, R, C); const int Rb = Epi::PERM ? ((R & ~31) + perm32(R & 31)) : R;
        voffA[i] = (unsigned)(R * lda + C) * 2u; voffB[i] = (unsigned)(Rb * ldb + C) * 2u; }
    const size_t kstep = (size_t)(BK * 2);
    const size_t hstepA = GATHER ? (size_t)0 : (size_t)HALF * lda * 2, hstepB = (size_t)HALF * ldb * 2;
    int gR[2], gC[2]; unsigned gcur[2][2], gnxt[2][2];
    if constexpr (GATHER) {
#pragma unroll
        for (int i = 0; i < 2; ++i) { int R, C; stage_rc(tid * 16 + i * 8192, R, C); gR[i] = R; gC[i] = C * 2; }
    }
#define PG8_GLOAD(dst, u_) do { _Pragma("unroll") for (int _h = 0; _h < 2; ++_h) _Pragma("unroll") for (int _i = 0; _i < 2; ++_i) dst[_h][_i] = gtab[(u_) * 256 + _h * 128 + gR[_i]] + (unsigned)gC[_i]; } while (0)
    const unsigned ldsw = (unsigned)wid * 1024u;
    const int aoff = lds_byte(wr * 64 + fr, fq * 8), boff = lds_byte(wc * 32 + fr, fq * 8);
#define PG8_SA(b, h) (((b) * 2 + (h)) * HTB)
#define PG8_SB(b, h) ((4 + (b) * 2 + (h)) * HTB)
#define PG8_STAGE(bufoff, gbase, voff) do { _Pragma("unroll") for (int _i = 0; _i < 2; ++_i) \
        __builtin_amdgcn_global_load_lds((const unsigned*)((const char*)(gbase) + (voff)[_i]), (LAS unsigned*)(lds + (bufoff) + ldsw + _i * 8192), 16, 0, 0); } while (0)
#define PG8_STAGEA(bufoff, gbase, h, tab) do { if constexpr (GATHER) { PG8_STAGE(bufoff, gbase, tab[h]); } else { PG8_STAGE(bufoff, (gbase) + (h) * hstepA, voffA); } } while (0)
#define PG8_LDA(dst, b, h) do { _Pragma("unroll") for (int m = 0; m < 4; ++m) _Pragma("unroll") for (int k = 0; k < 2; ++k) dst[m][k] = *(const LAS bf16x8*)(lds + PG8_SA(b, h) + aoff + m * 2048 + k * 1024); } while (0)
#define PG8_LDB(dst, b, h) do { _Pragma("unroll") for (int n = 0; n < 2; ++n) _Pragma("unroll") for (int k = 0; k < 2; ++k) dst[n][k] = *(const LAS bf16x8*)(lds + PG8_SB(b, h) + boff + n * 2048 + k * 1024); } while (0)
#define PG8_MMA(ai, bj, At, Bt) do { __builtin_amdgcn_s_setprio(1); _Pragma("unroll") for (int m = 0; m < 4; ++m) _Pragma("unroll") for (int n = 0; n < 2; ++n) _Pragma("unroll") for (int k = 0; k < 2; ++k) \
        acc[ai][bj][m][n] = __builtin_amdgcn_mfma_f32_16x16x32_bf16(Bt[n][k], At[m][k], acc[ai][bj][m][n], 0, 0, 0); __builtin_amdgcn_s_setprio(0); } while (0)
#define PG8_WAIT_V(n) asm volatile("s_waitcnt vmcnt(" #n ")" ::: "memory")
#define PG8_WAIT_L(n) asm volatile("s_waitcnt lgkmcnt(" #n ")" ::: "memory")
#define PG8_BAR __builtin_amdgcn_s_barrier()
#define PG8_SCHED __builtin_amdgcn_sched_barrier(0)
    Unit cur, nxt; int ui = 0;
    if (!S.next(0, cur)) return;
    f32x4 acc[2][2][4][2];
#pragma unroll
    for (int a = 0; a < 2; ++a)
#pragma unroll
        for (int b = 0; b < 2; ++b)
#pragma unroll
            for (int m = 0; m < 4; ++m)
#pragma unroll
                for (int n = 0; n < 2; ++n) acc[a][b][m][n] = (f32x4){0.f, 0.f, 0.f, 0.f};
    bf16x8 At[4][2], B0[2][2], B1[2][2];
    const char* cA = cur.A; const char* cB = cur.B;
    if constexpr (GATHER) { PG8_GLOAD(gcur, 0); PG8_GLOAD(gnxt, 1); asm volatile("s_waitcnt lgkmcnt(0)" ::: "memory"); }
    PG8_STAGE(PG8_SB(0, 0), cB, voffB); PG8_STAGE(PG8_SB(0, 1), cB + hstepB, voffB); PG8_STAGEA(PG8_SA(0, 0), cA, 0, gcur); PG8_STAGEA(PG8_SA(0, 1), cA, 1, gcur);
    if (wr == 1) PG8_BAR;
    PG8_WAIT_V(2); PG8_BAR;
    PG8_STAGE(PG8_SB(1, 0), cB + kstep, voffB); PG8_STAGEA(PG8_SA(1, 0), cA + kstep, 0, gcur); PG8_STAGE(PG8_SB(1, 1), cB + hstepB + kstep, voffB);
    PG8_WAIT_V(6); PG8_BAR;
#pragma unroll 1
    for (;;) {
        const bool has_next = S.next(ui + 1, nxt);
        const char* nA = has_next ? nxt.A : cA; const char* nB = has_next ? nxt.B : cB;
#pragma unroll 1
        for (int t = 0; t < nt; t += 2) {
            const bool last = (t == nt - 2);
            const char* a1 = cA + (size_t)(t + 1) * kstep;
            const char* a2 = last ? nA : cA + (size_t)(t + 2) * kstep; const char* b2 = last ? nB : cB + (size_t)(t + 2) * kstep;
            const char* a3 = a2 + kstep; const char* b3 = b2 + kstep;
            unsigned g2[2][2];
            if constexpr (GATHER) {
#pragma unroll
                for (int _h = 0; _h < 2; ++_h)
#pragma unroll
                    for (int _i = 0; _i < 2; ++_i) g2[_h][_i] = last ? gnxt[_h][_i] : gcur[_h][_i]; }
            PG8_LDB(B0, 0, 0); PG8_LDB(B1, 0, 1); PG8_SCHED; PG8_LDA(At, 0, 0); PG8_STAGEA(PG8_SA(1, 1), a1, 1, gcur);
            PG8_WAIT_V(8); PG8_WAIT_L(0); PG8_BAR; PG8_MMA(0, 0, At, B0); PG8_MMA(0, 1, At, B1); PG8_BAR; PG8_SCHED;
            PG8_LDA(At, 0, 1); PG8_STAGE(PG8_SB(0, 0), b2, voffB); PG8_STAGE(PG8_SB(0, 1), b2 + hstepB, voffB); PG8_STAGEA(PG8_SA(0, 0), a2, 0, g2);
            PG8_WAIT_V(8); PG8_WAIT_L(0); PG8_BAR; PG8_MMA(1, 0, At, B0); PG8_MMA(1, 1, At, B1); PG8_BAR; PG8_SCHED;
            PG8_LDB(B0, 1, 0); PG8_LDB(B1, 1, 1); PG8_SCHED; PG8_LDA(At, 1, 0); PG8_STAGEA(PG8_SA(0, 1), a2, 1, g2);
            PG8_WAIT_V(8); PG8_WAIT_L(0); PG8_BAR; PG8_MMA(0, 0, At, B0); PG8_MMA(0, 1, At, B1); PG8_BAR; PG8_SCHED;
            PG8_LDA(At, 1, 1); PG8_STAGE(PG8_SB(1, 0), b3, voffB); PG8_STAGE(PG8_SB(1, 1), b3 + hstepB, voffB); PG8_STAGEA(PG8_SA(1, 0), a3, 0, g2);
            PG8_WAIT_V(8); PG8_WAIT_L(0); PG8_BAR; PG8_MMA(1, 0, At, B0); PG8_MMA(1, 1, At, B1); PG8_BAR; PG8_SCHED;
        }
        if (wr == 0) PG8_BAR;
        E(acc, cur, wr, wc, fr, fq);
        if (!has_next) break;
#pragma unroll
        for (int a = 0; a < 2; ++a)
#pragma unroll
            for (int b = 0; b < 2; ++b)
#pragma unroll
                for (int m = 0; m < 4; ++m)
#pragma unroll
                    for (int n = 0; n < 2; ++n) acc[a][b][m][n] = (f32x4){0.f, 0.f, 0.f, 0.f};
        cur = nxt; cA = nA; cB = nB; ++ui;
        if constexpr (GATHER) {
#pragma unroll
            for (int _h = 0; _h < 2; ++_h)
#pragma unroll
                for (int _i = 0; _i < 2; ++_i) gcur[_h][_i] = gnxt[_h][_i];
            PG8_GLOAD(gnxt, ui + 1); }
        if (wr == 1) PG8_BAR;
    }
    PG8_WAIT_V(0);
    PG8_BAR;
#undef PG8_SA
#undef PG8_SB
#undef PG8_STAGE
#undef PG8_STAGEA
#undef PG8_GLOAD
#undef PG8_LDA
#undef PG8_LDB
#undef PG8_MMA
#undef PG8_WAIT_V
#undef PG8_WAIT_L
#undef PG8_BAR
#undef PG8_SCHED
}
}
constexpr int NWAVES = 8, NTHR = 512;
constexpr int RING_BYTES = 131072, LDS_BYTES = 147456, LDSCTL_OFF = LDS_BYTES - 2048;
struct Params { const float* in[29]; float* out; unsigned char* ws; };
struct Frame {
    LAS unsigned char* lds; int tid, lane, wave, blk, G, vcu, gw, ngw; unsigned char* ws;
};
enum { I_X = 0, I_POS, I_ANORM, I_WIN, I_MU, I_W0, I_W2, I_A0, I_A2, I_G2, I_KK, I_KA, I_RK, I_LNX, I_QNORM, I_WQB, I_KVNORM, I_WKVB, I_WBR, I_WO, I_FNORM,
       I_FG, I_FU, I_FD, I_ROUTER, I_MG, I_MU2, I_MD, I_FINAL };

struct SchedGrid {
    int nM, nN, nwg, G, c; const char* A; const char* B; size_t astep, bstep;
    __device__ void init(int nM_, int nN_, int G_, int c_, const void* A_, size_t astep_, const void* B_, size_t bstep_) { nM = nM_; nN = nN_; nwg = nM * nN; G = G_; c = c_; A = (const char*)A_; B = (const char*)B_; astep = astep_; bstep = bstep_; }
    __device__ __forceinline__ bool next(int i, pg8::Unit& u) const {
        const long L = (long)i * G + c; if (L >= nwg) return false;
        int wgid = (int)L; { const int q = nwg / 8, r = nwg % 8, xcd = wgid % 8, off = wgid / 8; wgid = (xcd < r ? xcd * (q + 1) : r * (q + 1) + (xcd - r) * q) + off; }
        const int nig = 8 * nN, gid = wgid / nig, fm = gid * 8, gsz = (nM - fm) < 8 ? (nM - fm) : 8;
        u.pm = fm + ((wgid % nig) % gsz); u.pn = (wgid % nig) / gsz; u.aux = 0;
        u.A = A + (size_t)u.pm * astep; u.B = B + (size_t)u.pn * bstep; return true;
    }
};
struct SchedSmall {
    int G, c, layer; const char* ws;
    __device__ __forceinline__ bool next(int i, pg8::Unit& u) const {
        int L = i * G + c; if (L >= 448) return false;
        int s = 0; if (L >= 192) { L -= 192; s = 1; if (L >= 128) { L -= 128; s = 2; } }
        const int nn = s == 0 ? 3 : (s == 1 ? 2 : 64);
        u.pm = L / nn; u.pn = L % nn; u.aux = s;
        const size_t lw = (size_t)layer * 256 * 2;
        const size_t ao = s == 0 ? WS_QN : (s == 1 ? WS_CN : WS_VB + lw * 512), bo = s == 0 ? WS_QB + lw * 768 : (s == 1 ? WS_KB + lw * 512 : WS_CN);
        u.A = ws + ao + (size_t)u.pm * (256 * 256 * 2); u.B = ws + bo + (size_t)u.pn * (256 * 256 * 2); return true;
    }
};
struct SchedOwn3 {
    int c, G; const char* A; const char* B; size_t astep, bstep, a_n, b_n;
    __device__ __forceinline__ bool next(int i, pg8::Unit& u) const {
        const int t = c + (i / 3) * G; if (t >= 256) return false;
        const int n = i % 3; u.pm = t >> 2; u.pn = t & 3; u.aux = n; u.A = A + (size_t)u.pm * astep + (size_t)n * a_n; u.B = B + (size_t)u.pn * bstep + (size_t)n * b_n; return true;
    }
};
struct SchedMoe {
    int G, c, ncol, ntile; const LAS int* tab; const char* A; const char* B; size_t astep, bstep, estep;
    __device__ __forceinline__ bool next(int i, pg8::Unit& u) const {
        const int L = i * G + c; if (L >= ntile * ncol) return false;
        u.pm = L / ncol; u.pn = L % ncol; const int e = tab[u.pm]; u.aux = e;
        u.A = A + (size_t)u.pm * astep; u.B = B + (size_t)e * estep + (size_t)u.pn * bstep; return true;
    }
};

using pg8::Unit; using pg8::cvt_pk_bf16;
#define EPI_ARGS const f32x4 (&acc)[2][2][4][2], const Unit& u, int wr, int wc, int fr, int fq
__device__ __forceinline__ float row_rstd(const float* SS, int row) {
    const f32x4* s = (const f32x4*)(SS + (size_t)row * 16); const f32x4 a = s[0], b = s[1], c = s[2], d = s[3];
    const float t = ((a.x + a.y) + (a.z + a.w)) + ((b.x + b.y) + (b.z + b.w)) + ((c.x + c.y) + (c.z + c.w)) + ((d.x + d.y) + (d.z + d.w));
    return rsqrtf(t * (1.0f / DM) + NORM_EPS);
}
__device__ __forceinline__ void panel_rstd(const float* SS, int pm, int tid, LAS float* rl) {
    if (tid < 256) rl[tid] = row_rstd(SS, pm * 256 + tid);
    asm volatile("s_waitcnt lgkmcnt(0)" ::: "memory"); __builtin_amdgcn_s_barrier(); asm volatile("" ::: "memory");
}
struct EpiStore {
    static constexpr bool PERM = true;
    bf16_t* O; int ld; const float* SS; LAS float* rl; int tid;
    __device__ __forceinline__ void operator()(EPI_ARGS) const {
        const int row0 = u.pm * 256 + wr * 64 + fr, col0 = u.pn * 256 + wc * 32 + 8 * fq;
        if (SS) panel_rstd(SS, u.pm, tid, rl);
#pragma unroll
        for (int ai = 0; ai < 2; ++ai)
#pragma unroll
            for (int m = 0; m < 4; ++m) { bf16_t* rowp = O + (size_t)(row0 + ai * 128 + m * 16) * ld + col0; const float rs = SS ? rl[wr * 64 + fr + ai * 128 + m * 16] : 1.0f;
#pragma unroll
                for (int bj = 0; bj < 2; ++bj) { const f32x4 v0 = acc[ai][bj][m][0] * rs, v1 = acc[ai][bj][m][1] * rs;
                    u32x4 w; w.x = cvt_pk_bf16(v0[0], v0[1]); w.y = cvt_pk_bf16(v0[2], v0[3]); w.z = cvt_pk_bf16(v1[0], v1[1]); w.w = cvt_pk_bf16(v1[2], v1[3]);
                    *(u32x4*)(rowp + bj * 128) = w; } }
    }
};
struct EpiSmall {
    static constexpr bool PERM = true;
    unsigned char* ws;
    __device__ __forceinline__ void operator()(EPI_ARGS) const {
        bf16_t* base = (bf16_t*)(ws + (u.aux == 0 ? WS_Q : (u.aux == 1 ? WS_KN : WS_VT))); const int ld = u.aux == 0 ? 768 : (u.aux == 1 ? 512 : MTOK);
        const int row0 = u.pm * 256 + wr * 64 + fr, col0 = u.pn * 256 + wc * 32 + 8 * fq;
#pragma unroll
        for (int ai = 0; ai < 2; ++ai)
#pragma unroll
            for (int m = 0; m < 4; ++m) { bf16_t* rowp = base + (size_t)(row0 + ai * 128 + m * 16) * ld + col0;
#pragma unroll
                for (int bj = 0; bj < 2; ++bj) { const f32x4 v0 = acc[ai][bj][m][0], v1 = acc[ai][bj][m][1];
                    u32x4 w; w.x = cvt_pk_bf16(v0[0], v0[1]); w.y = cvt_pk_bf16(v0[2], v0[3]); w.z = cvt_pk_bf16(v1[0], v1[1]); w.w = cvt_pk_bf16(v1[2], v1[3]);
                    *(u32x4*)(rowp + bj * 128) = w; } }
    }
};
struct EpiLora {
    static constexpr bool PERM = true;
    bf16_t* O; const float* w0; const float* a0;
    __device__ __forceinline__ void operator()(EPI_ARGS) const {
        const int seg = u.pn >> 1;
        const int row0 = u.pm * 256 + wr * 64 + fr, col0 = u.pn * 256 + wc * 32 + 8 * fq, ch0 = (u.pn & 1) * 256 + wc * 32 + 8 * fq;
        const float* bias = seg == 0 ? w0 : a0; const float sc = seg == 0 ? -0.6065306597126334f : 1.0f;
#pragma unroll
        for (int bj = 0; bj < 2; ++bj) {
            f32x4 b0 = {0.f, 0.f, 0.f, 0.f}, b1 = {0.f, 0.f, 0.f, 0.f};
            if (seg < 2) { b0 = *(const f32x4*)(bias + ch0 + bj * 128); b1 = *(const f32x4*)(bias + ch0 + bj * 128 + 4); }
#pragma unroll
            for (int ai = 0; ai < 2; ++ai)
#pragma unroll
                for (int m = 0; m < 4; ++m) { bf16_t* rowp = O + (size_t)(row0 + ai * 128 + m * 16) * LO_W + col0 + bj * 128;
                    f32x4 v0 = acc[ai][bj][m][0] + b0, v1 = acc[ai][bj][m][1] + b1;
                    if (seg < 2) {
#pragma unroll
                        for (int j = 0; j < 4; ++j) { v0[j] = sc * sigmoidf_(v0[j]); v1[j] = sc * sigmoidf_(v1[j]); }
                    }
                    u32x4 w; w.x = cvt_pk_bf16(v0[0], v0[1]); w.y = cvt_pk_bf16(v0[2], v0[3]); w.z = cvt_pk_bf16(v1[0], v1[1]); w.w = cvt_pk_bf16(v1[2], v1[3]);
                    *(u32x4*)rowp = w; }
        }
    }
};
struct EpiGate {
    static constexpr bool PERM = true;
    bf16_t* O; const float* SS; LAS float* rl; int tid;
    __device__ __forceinline__ void operator()(EPI_ARGS) const {
        const int row0 = u.pm * 256 + wr * 64 + fr, col0 = u.aux * 1024 + u.pn * 256 + wc * 32 + 8 * fq;
        panel_rstd(SS, u.pm, tid, rl);
#pragma unroll
        for (int ai = 0; ai < 2; ++ai)
#pragma unroll
            for (int m = 0; m < 4; ++m) { bf16_t* rowp = O + (size_t)(row0 + ai * 128 + m * 16) * 3072 + col0; const float rs = rl[wr * 64 + fr + ai * 128 + m * 16];
#pragma unroll
                for (int bj = 0; bj < 2; ++bj) { f32x4 v0 = acc[ai][bj][m][0] * rs, v1 = acc[ai][bj][m][1] * rs;
#pragma unroll
                    for (int j = 0; j < 4; ++j) { v0[j] = sigmoidf_(v0[j]); v1[j] = sigmoidf_(v1[j]); }
                    u32x4 w; w.x = cvt_pk_bf16(v0[0], v0[1]); w.y = cvt_pk_bf16(v0[2], v0[3]); w.z = cvt_pk_bf16(v1[0], v1[1]); w.w = cvt_pk_bf16(v1[2], v1[3]);
                    *(u32x4*)(rowp + bj * 128) = w; } }
    }
};
struct EpiMerge {
    static constexpr bool PERM = true;
    const bf16_t* Gt; bf16_t* Mg;
    __device__ __forceinline__ void operator()(EPI_ARGS) const {
        const int n = u.aux;
        const int row0 = u.pm * 256 + wr * 64 + fr, col0 = u.pn * 256 + wc * 32 + 8 * fq;
#pragma unroll
        for (int ai = 0; ai < 2; ++ai)
#pragma unroll
            for (int m = 0; m < 4; ++m) { const size_t r = (size_t)(row0 + ai * 128 + m * 16);
#pragma unroll
                for (int bj = 0; bj < 2; ++bj) { const f32x4 v0 = acc[ai][bj][m][0], v1 = acc[ai][bj][m][1];
                    const u32x4 g = *(const u32x4*)(Gt + r * 3072 + n * 1024 + col0 + bj * 128);
                    float o[8] = {bflo(g.x) * v0[0], bfhi(g.x) * v0[1], bflo(g.y) * v0[2], bfhi(g.y) * v0[3], bflo(g.z) * v1[0], bfhi(g.z) * v1[1], bflo(g.w) * v1[2], bfhi(g.w) * v1[3]};
                    bf16_t* mp = Mg + r * 1024 + col0 + bj * 128;
                    if (n > 0) { const u32x4 p = *(const u32x4*)mp; o[0] += bflo(p.x); o[1] += bfhi(p.x); o[2] += bflo(p.y); o[3] += bfhi(p.y); o[4] += bflo(p.z); o[5] += bfhi(p.z); o[6] += bflo(p.w); o[7] += bfhi(p.w); }
                    u32x4 w; w.x = cvt_pk_bf16(o[0], o[1]); w.y = cvt_pk_bf16(o[2], o[3]); w.z = cvt_pk_bf16(o[4], o[5]); w.w = cvt_pk_bf16(o[6], o[7]);
                    *(u32x4*)mp = w; } }
    }
};
template <bool EMIT>
struct EpiResid {
    static constexpr bool PERM = false;
    const float* In; float* Out; const float* gain; bf16_t* Hg; float* SS;
    __device__ __forceinline__ void operator()(EPI_ARGS) const {
        const int row0 = u.pm * 256 + wr * 64 + fr, col0 = u.pn * 256 + wc * 32 + 4 * fq;
        f32x4 gv[2][2];
        if (EMIT) {
#pragma unroll
            for (int bj = 0; bj < 2; ++bj)
#pragma unroll
                for (int n = 0; n < 2; ++n) gv[bj][n] = *(const f32x4*)(gain + col0 + bj * 128 + n * 16); }
#pragma unroll
        for (int ai = 0; ai < 2; ++ai)
#pragma unroll
            for (int m = 0; m < 4; ++m) { const int row = row0 + ai * 128 + m * 16; const size_t o = (size_t)row * DM + col0; float sq = 0.f;
#pragma unroll
                for (int bj = 0; bj < 2; ++bj)
#pragma unroll
                    for (int n = 0; n < 2; ++n) { const f32x4 x = *(const f32x4*)(In + o + bj * 128 + n * 16) + acc[ai][bj][m][n]; *(f32x4*)(Out + o + bj * 128 + n * 16) = x;
                        if (EMIT) { sq += (x[0] * x[0] + x[1] * x[1]) + (x[2] * x[2] + x[3] * x[3]); const f32x4 y = x * gv[bj][n]; u32x2 w; w.x = cvt_pk_bf16(y[0], y[1]); w.y = cvt_pk_bf16(y[2], y[3]); *(u32x2*)(Hg + o + bj * 128 + n * 16) = w; } }
                if (EMIT) { sq += __shfl_xor(sq, 16); sq += __shfl_xor(sq, 32); if (fq == 0) SS[(size_t)row * 16 + u.pn * 4 + wc] = sq; } }
    }
};
struct EpiSwiglu {
    static constexpr bool PERM = true;
    bf16_t* O; int ldc; int pn_off; const float* SS; LAS float* rl; int tid;
    __device__ __forceinline__ void operator()(EPI_ARGS) const {
        const int row0 = u.pm * 256 + wr * 64 + fr, col0 = (u.pn - pn_off) * 128 + wc * 32 + 8 * fq;
        if (SS) panel_rstd(SS, u.pm, tid, rl);
#pragma unroll
        for (int ai = 0; ai < 2; ++ai)
#pragma unroll
            for (int m = 0; m < 4; ++m) { bf16_t* rowp = O + (size_t)(row0 + ai * 128 + m * 16) * ldc + col0; const float rs = SS ? rl[wr * 64 + fr + ai * 128 + m * 16] : 1.0f;
                float o[8];
#pragma unroll
                for (int n = 0; n < 2; ++n)
#pragma unroll
                    for (int j = 0; j < 4; ++j) { const float g = acc[ai][0][m][n][j] * rs, up = acc[ai][1][m][n][j] * rs; o[n * 4 + j] = g * sigmoidf_(g) * up; }
                u32x4 w; w.x = cvt_pk_bf16(o[0], o[1]); w.y = cvt_pk_bf16(o[2], o[3]); w.z = cvt_pk_bf16(o[4], o[5]); w.w = cvt_pk_bf16(o[6], o[7]);
                *(u32x4*)rowp = w; }
    }
};
template <bool ACCUM>
struct EpiMoeOut {
    static constexpr bool PERM = true;
    const float* row_w; bf16_t* O;
    __device__ __forceinline__ void operator()(EPI_ARGS) const {
        const int row0 = u.pm * 256 + wr * 64 + fr, col0 = u.pn * 256 + wc * 32 + 8 * fq;
#pragma unroll
        for (int ai = 0; ai < 2; ++ai)
#pragma unroll
            for (int m = 0; m < 4; ++m) { const int r = row0 + ai * 128 + m * 16; const float wt = row_w[r]; bf16_t* rowp = O + (size_t)r * DM + col0;
#pragma unroll
                for (int bj = 0; bj < 2; ++bj) { f32x4 v0 = acc[ai][bj][m][0] * wt, v1 = acc[ai][bj][m][1] * wt;
                    if (ACCUM) { const u32x4 p = *(const u32x4*)(rowp + bj * 128); v0[0] += bflo(p.x); v0[1] += bfhi(p.x); v0[2] += bflo(p.y); v0[3] += bfhi(p.y); v1[0] += bflo(p.z); v1[1] += bfhi(p.z); v1[2] += bflo(p.w); v1[3] += bfhi(p.w); }
                    u32x4 w; w.x = cvt_pk_bf16(v0[0], v0[1]); w.y = cvt_pk_bf16(v0[2], v0[3]); w.z = cvt_pk_bf16(v1[0], v1[1]); w.w = cvt_pk_bf16(v1[2], v1[3]);
                    *(u32x4*)(rowp + bj * 128) = w; } }
    }
};

__device__ __forceinline__ void transpose_tile64(const float* W, int ldn, int k0, int n0, bf16_t* WT, int ldk, int drow0, int drow1, int dk0, LAS float* scr, int lane) {
#ifdef SIMPLE_TR
    { const int c = lane & 7;
      for (int j = 0; j < 8; ++j) { const int n = (lane >> 3) + 8 * j; const float* s = W + (size_t)(k0 + 8 * c) * ldn + n0 + n;
        u32x4 o; o.x = pk2(s[0], s[(size_t)ldn]); o.y = pk2(s[(size_t)2 * ldn], s[(size_t)3 * ldn]); o.z = pk2(s[(size_t)4 * ldn], s[(size_t)5 * ldn]); o.w = pk2(s[(size_t)6 * ldn], s[(size_t)7 * ldn]);
        const int dr = n < 32 ? drow0 + n : drow1 + (n - 32);
        *(u32x4*)(WT + (size_t)dr * ldk + dk0 + k0 + 8 * c) = o; }
      return; }
#endif
    f32x4 v[16]; const int r4 = lane >> 4, c4 = (lane & 15) * 4;
#pragma unroll
    for (int i = 0; i < 16; ++i) v[i] = *(const f32x4*)(W + (size_t)(k0 + 4 * i + r4) * ldn + n0 + c4);
#pragma unroll
    for (int i = 0; i < 16; ++i) { LAS float* d = scr + (4 * i + r4) * 65 + c4; d[0] = v[i][0]; d[1] = v[i][1]; d[2] = v[i][2]; d[3] = v[i][3]; }
    LDS_WAIT(); asm volatile("" ::: "memory");
    const int c = lane & 7;
#pragma unroll
    for (int j = 0; j < 8; ++j) { const int n = (lane >> 3) + 8 * j; const LAS float* s = scr + (8 * c) * 65 + n;
        u32x4 o; o.x = pk2(s[0 * 65], s[1 * 65]); o.y = pk2(s[2 * 65], s[3 * 65]); o.z = pk2(s[4 * 65], s[5 * 65]); o.w = pk2(s[6 * 65], s[7 * 65]);
        const int dr = n < 32 ? drow0 + n : drow1 + (n - 32);
        *(u32x4*)(WT + (size_t)dr * ldk + dk0 + k0 + 8 * c) = o; }
    LDS_WAIT(); asm volatile("" ::: "memory");
}
__device__ __forceinline__ void conv_plain(const float* W, int K, int N, bf16_t* WT, int ldk, int item, LAS float* scr, int lane) {
    const int nblk = N / 64, kb = item / nblk, nb = item % nblk;
    transpose_tile64(W, N, kb * 64, nb * 64, WT, ldk, nb * 64, nb * 64 + 32, 0, scr, lane);
}
__device__ __forceinline__ int win_drow(int n0) { return n0 < 3872 ? n0 : (n0 < 4128 ? 4096 + (n0 - 3872) : (n0 < 4288 ? 4352 + (n0 - 4128) : 4608 + (n0 - 4288))); }
__device__ __forceinline__ int gu_drow(int n0, int up) { return (n0 >> 7) * 256 + (n0 & 127) + up * 128; }

__device__ __forceinline__ void phase_prologue(const Frame& F, const Params& P) {
    LAS float* scr = (LAS float*)(F.lds + F.wave * 16640);
    unsigned char* ws = F.ws;
    constexpr int I_IN = 16 * 115, I_QB = 4 * 12, I_BRn = 8 * 16, I_WOn = 16 * 16, I_G = 16 * 44, I_D = 44 * 16;
    constexpr int NIT = NLAYER * (I_IN + I_QB + 3 * I_BRn + I_WOn) + 2 * I_G + I_D;
    for (int it = F.gw; it < NIT; it += F.ngw) {
        int r = it;
        if (r < NLAYER * I_IN) { const int l = r / I_IN; r %= I_IN; const int kb = r / 115, nb = r % 115;
            transpose_tile64(P.in[I_WIN] + (size_t)l * DM * IN_COLS, IN_COLS, kb * 64, nb * 64, (bf16_t*)(ws + WS_WIN) + (size_t)l * WIN_ROWS * DM, DM, win_drow(nb * 64), win_drow(nb * 64 + 32), 0, scr, F.lane); continue; }
        r -= NLAYER * I_IN;
        if (r < NLAYER * I_QB) { const int l = r / I_QB; r %= I_QB; conv_plain(P.in[I_WQB] + (size_t)l * 256 * 768, 256, 768, (bf16_t*)(ws + WS_QB) + (size_t)l * 768 * 256, 256, r, scr, F.lane); continue; }
        r -= NLAYER * I_QB;
        if (r < NLAYER * 3 * I_BRn) { const int ln = r / I_BRn; r %= I_BRn; conv_plain(P.in[I_WBR] + (size_t)ln * 512 * 1024, 512, 1024, (bf16_t*)(ws + WS_BR) + (size_t)ln * 1024 * 512, 512, r, scr, F.lane); continue; }
        r -= NLAYER * 3 * I_BRn;
        if (r < NLAYER * I_WOn) { const int l = r / I_WOn; r %= I_WOn; conv_plain(P.in[I_WO] + (size_t)l * DM * DM, DM, DM, (bf16_t*)(ws + WS_WO) + (size_t)l * DM * DM, DM, r, scr, F.lane); continue; }
        r -= NLAYER * I_WOn;
        if (r < 2 * I_G) { const int up = r / I_G; r %= I_G; const int kb = r / 44, nb = r % 44;
            transpose_tile64(P.in[up ? I_FU : I_FG], DFF, kb * 64, nb * 64, (bf16_t*)(ws + WS_FGU), DM, gu_drow(nb * 64, up), gu_drow(nb * 64 + 32, up), 0, scr, F.lane); continue; }
        r -= 2 * I_G;
        conv_plain(P.in[I_FD], DFF, DM, (bf16_t*)(ws + WS_FD), DFF, r, scr, F.lane);
    }
    const int gt = F.blk * NTHR + F.tid, ngt = F.G * NTHR;
    for (int i = gt; i < NLAYER * 1536 * 384; i += ngt) { const int l = i / (1536 * 384), r = i % (1536 * 384), n = r / 384, k = r % 384; const int seg = n >> 9, c = n & 511; float v = 0.f;
        if (seg == 0 && k < 64) v = P.in[I_W2][((size_t)l * 64 + k) * 512 + c];
        else if (seg == 1 && k >= 64 && k < 128) v = P.in[I_A2][((size_t)l * 64 + (k - 64)) * 512 + c];
        else if (seg == 2 && k >= 128 && k < 288) v = P.in[I_G2][((size_t)l * 160 + (k - 128)) * 512 + c];
        ((bf16_t*)(ws + WS_LORA))[i] = (bf16_t)f2bf(v); }
    for (int i = gt; i < NLAYER * 512 * 256; i += ngt) { const int l = i / (512 * 256), r = i % (512 * 256), n = r / 256, k = r % 256; const int h = n >> 6, d = n & 63;
        float vk = 0.f, vv = 0.f; if (k < 128) { const float* w = P.in[I_WKVB] + ((size_t)l * 128 + k) * 1024 + h * 128; vk = w[d]; vv = w[64 + d]; }
        ((bf16_t*)(ws + WS_KB))[i] = (bf16_t)f2bf(vk); ((bf16_t*)(ws + WS_VB))[i] = (bf16_t)f2bf(vv); }
    for (int m = F.gw; m < MTOK; m += F.ngw) {
        const f32x4* xr = (const f32x4*)(P.in[I_X] + (size_t)m * DM) + F.lane; f32x4 v[4]; float s = 0.f;
#pragma unroll
        for (int j = 0; j < 4; ++j) { v[j] = xr[64 * j]; s += (v[j].x * v[j].x + v[j].y * v[j].y) + (v[j].z * v[j].z + v[j].w * v[j].w); }
        s = wave_sum(s);
        u32x2* o8 = (u32x2*)((bf16_t*)(ws + WS_HN) + (size_t)m * DM) + F.lane;
#pragma unroll
        for (int j = 0; j < 4; ++j) { const f32x4 g = ((const f32x4*)P.in[I_ANORM])[F.lane + 64 * j]; const f32x4 y = v[j] * g; u32x2 w; w.x = pk2(y.x, y.y); w.y = pk2(y.z, y.w); o8[64 * j] = w; }
        if (F.lane < 16) ((float*)(ws + WS_SS))[(size_t)m * 16 + F.lane] = F.lane == 0 ? s : 0.f;
    }
    for (int i = gt; i < MTOK * 80; i += ngt) { const int m = i / 80, j = i % 80; const int isr = j < 64; const int idx = isr ? j : j - 64; const double dim = isr ? 128.0 : 32.0;
        const float inv = (float)(1.0 / pow(10000.0, (2.0 * idx) / dim)); const float ang = (float)((const int*)P.in[I_POS])[m] * inv;
        const double a = (double)ang, q = rint(a * 0.15915494309189535), rr = a - q * 6.283185307179586476925;
        const float rf = (float)rr; const float cs = __cosf(rf), sn = __sinf(rf);
        if (isr) { ((float*)(ws + WS_COSR))[(size_t)m * 64 + idx] = cs; ((float*)(ws + WS_SINR))[(size_t)m * 64 + idx] = sn; }
        else { ((float*)(ws + WS_COSM))[(size_t)m * 16 + idx] = cs; ((float*)(ws + WS_SINM))[(size_t)m * 16 + idx] = sn; } }
}
__device__ __forceinline__ void phase_moe_convert(const Frame& F, const Params& P) {
    LAS float* scr = (LAS float*)(F.lds + F.wave * 16640);
    constexpr int I_G = 16 * 56, I_D = 56 * 16;
    constexpr int NIT = NEXP * (2 * I_G + I_D);
    for (int it = F.gw; it < NIT; it += F.ngw) {
        const int e = it / (2 * I_G + I_D); int r = it % (2 * I_G + I_D);
        if (r < 2 * I_G) { const int up = r / I_G; r %= I_G; const int kb = r / 56, nb = r % 56;
            transpose_tile64(P.in[up ? I_MU2 : I_MG] + (size_t)e * DM * DFFE, DFFE, kb * 64, nb * 64, (bf16_t*)(F.ws + WS_MGU) + (size_t)e * 2 * DFFE * DM, DM, gu_drow(nb * 64, up), gu_drow(nb * 64 + 32, up), 0, scr, F.lane); continue; }
        r -= 2 * I_G;
        conv_plain(P.in[I_MD] + (size_t)e * DFFE * DM, DFFE, DM, (bf16_t*)(F.ws + WS_MD) + (size_t)e * DM * DFFE, DFFE, r, scr, F.lane);
    }
}

template <bool MOE>
__device__ __forceinline__ void phase_rms(const Frame& F, const float* src, const float* gain, bf16_t* hn, const float* router, unsigned* ectl, int* tok_e, int* tok_slot, float* tok_w) {
    LAS int* lcnt = (LAS int*)(F.lds);
    if (MOE) { if (F.tid < 16) lcnt[F.tid] = 0; __syncthreads(); }
    int my_e0 = 0, my_e1 = 0, my_s0 = 0, my_s1 = 0; float my_w0 = 0.f, my_w1 = 0.f;
    f32x4 rw[MOE ? 32 : 1];
    if (MOE) {
#pragma unroll
        for (int j = 0; j < 4; ++j)
#pragma unroll
            for (int q = 0; q < 4; ++q) { const int c = 4 * F.lane + 256 * j + q; rw[(j * 4 + q) * 2] = *(const f32x4*)(router + (size_t)c * 8); rw[(j * 4 + q) * 2 + 1] = *(const f32x4*)(router + (size_t)c * 8 + 4); } }
    for (int i = 0; i < 8; ++i) {
        const int m = F.blk * 64 + F.wave * 8 + i;
        const f32x4* xr = (const f32x4*)(src + (size_t)m * DM) + F.lane;
        f32x4 v[4]; float s = 0.f;
#pragma unroll
        for (int j = 0; j < 4; ++j) { v[j] = xr[64 * j]; s += (v[j].x * v[j].x + v[j].y * v[j].y) + (v[j].z * v[j].z + v[j].w * v[j].w); }
        const float rstd = rsqrtf(wave_sum(s) * (1.0f / DM) + NORM_EPS);
#pragma unroll
        for (int j = 0; j < 4; ++j) { const f32x4 g = ((const f32x4*)gain)[F.lane + 64 * j]; v[j] = v[j] * rstd * g; }
        u32x2* o8 = (u32x2*)(hn + (size_t)m * DM) + F.lane;
#pragma unroll
        for (int j = 0; j < 4; ++j) { u32x2 w; w.x = pk2(v[j].x, v[j].y); w.y = pk2(v[j].z, v[j].w); o8[64 * j] = w; }
        if (MOE) {
            float lg[8];
#pragma unroll
            for (int e = 0; e < 8; ++e) lg[e] = 0.f;
#pragma unroll
            for (int j = 0; j < 4; ++j)
#pragma unroll
                for (int q = 0; q < 4; ++q) { const f32x4 r0 = rw[(j * 4 + q) * 2], r1 = rw[(j * 4 + q) * 2 + 1]; const float x = v[j][q];
                    lg[0] += x * r0.x; lg[1] += x * r0.y; lg[2] += x * r0.z; lg[3] += x * r0.w; lg[4] += x * r1.x; lg[5] += x * r1.y; lg[6] += x * r1.z; lg[7] += x * r1.w; }
#pragma unroll
            for (int e = 0; e < 8; ++e) lg[e] = wave_sum(lg[e]);
            int e0 = 0; float b0 = lg[0];
#pragma unroll
            for (int e = 1; e < 8; ++e) if (lg[e] > b0) { b0 = lg[e]; e0 = e; }
            int e1 = -1; float b1 = -3.0e38f;
#pragma unroll
            for (int e = 0; e < 8; ++e) if (e != e0 && lg[e] > b1) { b1 = lg[e]; e1 = e; }
            const float t = __expf(b1 - b0), w0 = 1.0f / (1.0f + t), w1 = t / (1.0f + t);
            int s0 = 0, s1 = 0;
            if (F.lane == 0) { s0 = atomicAdd((int*)&lcnt[e0], 1); s1 = atomicAdd((int*)&lcnt[e1], 1); }
            s0 = __shfl(s0, 0); s1 = __shfl(s1, 0);
            if (F.lane == i) { my_e0 = e0; my_e1 = e1; my_s0 = s0; my_s1 = s1; my_w0 = w0; my_w1 = w1; }
        }
    }
    if (MOE) {
        __syncthreads();
        if (F.tid < 8) lcnt[8 + F.tid] = (int)atomicAdd(&ectl[F.tid], (unsigned)lcnt[F.tid]);
        __syncthreads();
        if (F.lane < 8) { const int m = F.blk * 64 + F.wave * 8 + F.lane;
            tok_e[2 * m] = my_e0; tok_e[2 * m + 1] = my_e1; tok_slot[2 * m] = lcnt[8 + my_e0] + my_s0; tok_slot[2 * m + 1] = lcnt[8 + my_e1] + my_s1; tok_w[2 * m] = my_w0; tok_w[2 * m + 1] = my_w1; }
        __syncthreads();
    }
}
__device__ __forceinline__ void phase_final(const Frame& F, float* h, const float* gain, const bf16_t* out2, const int* tok_pos) {
    for (int m = F.gw; m < MTOK; m += F.ngw) {
        f32x4* xr = (f32x4*)(h + (size_t)m * DM) + F.lane;
        const int p0 = tok_pos[2 * m], p1 = tok_pos[2 * m + 1];
        const u32x2* o0 = (const u32x2*)(out2 + (size_t)p0 * DM) + F.lane; const u32x2* o1 = (const u32x2*)(out2 + (size_t)p1 * DM) + F.lane;
        f32x4 v[4]; float s = 0.f;
#pragma unroll
        for (int j = 0; j < 4; ++j) { v[j] = xr[64 * j]; const u32x2 a = o0[64 * j], b = o1[64 * j];
#ifndef NO_MOE_ADD
            v[j].x += bflo(a.x) + bflo(b.x); v[j].y += bfhi(a.x) + bfhi(b.x); v[j].z += bflo(a.y) + bflo(b.y); v[j].w += bfhi(a.y) + bfhi(b.y);
#endif
            s += (v[j].x * v[j].x + v[j].y * v[j].y) + (v[j].z * v[j].z + v[j].w * v[j].w); }
        const float rstd = rsqrtf(wave_sum(s) * (1.0f / DM) + NORM_EPS);
#pragma unroll
        for (int j = 0; j < 4; ++j) { const f32x4 g = ((const f32x4*)gain)[F.lane + 64 * j]; xr[64 * j] = v[j] * rstd * g; }
    }
}
template <int KS>
__device__ __forceinline__ f32x4 mm_tile(const LAS bf16_t* P, int ldp, const LAS bf16_t* Q, int ldq, int ib, int jb, int lane, f32x4 acc) {
    const LAS bf16_t* pp = P + (ib * 16 + (lane & 15)) * ldp + 8 * (lane >> 4);
    const LAS bf16_t* qp = Q + (jb * 16 + (lane & 15)) * ldq + 8 * (lane >> 4);
#pragma unroll
    for (int ks = 0; ks < KS; ++ks) { const bf16x8 a = *(const LAS bf16x8*)(qp + ks * 32), b = *(const LAS bf16x8*)(pp + ks * 32); acc = __builtin_amdgcn_mfma_f32_16x16x32_bf16(a, b, acc, 0, 0, 0); }
    return acc;
}
__device__ __forceinline__ void st_bf4(LAS bf16_t* p, f32x4 v) { u32x2 w; w.x = pk2(v[0], v[1]); w.y = pk2(v[2], v[3]); *(LAS u32x2*)p = w; }
__device__ __forceinline__ float ret_lg(int h) { return __logf(1.0f - exp2f(-5.0f - (float)h)); }

__device__ __forceinline__ void phase_prep(const Frame& F, const Params& P, int layer) {
    unsigned char* ws = F.ws;
    const bf16_t* p = (const bf16_t*)(ws + WS_P);
    const float* mu = P.in[I_MU] + (size_t)layer * RWKV_COLS;
    for (int m = F.gw; m < MTOK; m += F.ngw) {
        const bf16_t* pr = p + (size_t)m * PW; const bool has_prev = (m % SEQ) != 0; const bf16_t* pp = pr - PW;
        bf16_t* lin = (bf16_t*)(ws + WS_LIN) + (size_t)m * LORA_K;
#pragma unroll
        for (int jj = 0; jj < 6; ++jj) { const int c = F.lane + 64 * jj; float o = 0.f;
            if (c < 288) { const int off = 1536 + c; const float x = bf2f(pr[P_RW + off]), xp = has_prev ? bf2f(pp[P_RW + off]) : 0.f; const float xs = x + (xp - x) * mu[off];
                o = c < 64 ? tanhf(xs) : (c < 128 ? xs : sigmoidf_(xs)); }
            lin[c] = (bf16_t)f2bf(o); }
        {
            const u32x2 w = *(const u32x2*)(pr + P_QA + 4 * F.lane); float x[4] = {bflo(w.x), bfhi(w.x), bflo(w.y), bfhi(w.y)};
            const float ss = wave_sum(x[0] * x[0] + x[1] * x[1] + x[2] * x[2] + x[3] * x[3]); const float rs = rsqrtf(ss * (1.0f / 256.0f) + NORM_EPS);
            const f32x4 g = *(const f32x4*)(P.in[I_QNORM] + layer * 256 + 4 * F.lane);
            u32x2 o; o.x = pk2(x[0] * rs * g.x, x[1] * rs * g.y); o.y = pk2(x[2] * rs * g.z, x[3] * rs * g.w); *(u32x2*)((bf16_t*)(ws + WS_QN) + (size_t)m * 256 + 4 * F.lane) = o; }
        {
            const unsigned w = *(const unsigned*)(pr + P_KVA + 2 * F.lane); float x0 = bflo(w), x1 = bfhi(w);
            const float ss = wave_sum(x0 * x0 + x1 * x1); const float rs = rsqrtf(ss * (1.0f / 128.0f) + NORM_EPS);
            const f32x2 g = *(const f32x2*)(P.in[I_KVNORM] + layer * 128 + 2 * F.lane);
            unsigned* cn = (unsigned*)((bf16_t*)(ws + WS_CN) + (size_t)m * 256); cn[F.lane] = pk2(x0 * rs * g.x, x1 * rs * g.y); cn[64 + F.lane] = 0u; }
        if (F.lane < 16) {
            const float x1 = bf2f(pr[P_KVA + 128 + F.lane]), x2 = bf2f(pr[P_KVA + 144 + F.lane]);
            const float c = ((const float*)(ws + WS_COSM))[(size_t)m * 16 + F.lane], s = ((const float*)(ws + WS_SINM))[(size_t)m * 16 + F.lane];
            bf16_t* kp = (bf16_t*)(ws + WS_KPE) + (size_t)m * 32; kp[F.lane] = (bf16_t)f2bf(x1 * c - x2 * s); kp[16 + F.lane] = (bf16_t)f2bf(x1 * s + x2 * c); }
    }
    LAS bf16_t* kT = (LAS bf16_t*)F.lds;
    LAS bf16_t* vT = kT + 128 * 72;
    const int pc = F.tid & 7, j = F.tid >> 3;
    for (int u = F.blk; u < NB * NCHUNK * 4; u += F.G) {
        const int h = u & 3, n = (u >> 2) & 127, b = u >> 9; const int m = b * SEQ + n * 64 + j;
        const float lg = ret_lg(h);
        __syncthreads();
        {
            const bf16_t* kr = p + (size_t)m * PW + P_RK + h * 128 + pc * 8;
            const u32x4 a = *(const u32x4*)kr, bq = *(const u32x4*)(kr + 64);
            const float* cp = (const float*)(ws + WS_COSR) + (size_t)m * 64 + pc * 8; const float* sp = (const float*)(ws + WS_SINR) + (size_t)m * 64 + pc * 8;
            const float sc = 0.08838834764831845f * __expf(lg * (float)(63 - j));
            const unsigned aw[4] = {a.x, a.y, a.z, a.w}, bw[4] = {bq.x, bq.y, bq.z, bq.w};
#pragma unroll
            for (int i = 0; i < 8; ++i) { const float x1 = (i & 1) ? bfhi(aw[i >> 1]) : bflo(aw[i >> 1]), x2 = (i & 1) ? bfhi(bw[i >> 1]) : bflo(bw[i >> 1]); const float c = cp[i], s = sp[i];
                kT[(pc * 8 + i) * 72 + j] = (bf16_t)f2bf((x1 * c - x2 * s) * sc); kT[(64 + pc * 8 + i) * 72 + j] = (bf16_t)f2bf((x1 * s + x2 * c) * sc); }
            const bf16_t* vr = p + (size_t)m * PW + P_RV + h * 128 + pc * 8;
            const u32x4 va = *(const u32x4*)vr, vb = *(const u32x4*)(vr + 64);
            const unsigned vaw[4] = {va.x, va.y, va.z, va.w}, vbw[4] = {vb.x, vb.y, vb.z, vb.w};
#pragma unroll
            for (int i = 0; i < 8; ++i) { vT[(pc * 8 + i) * 72 + j] = (bf16_t)((i & 1) ? (vaw[i >> 1] >> 16) : (vaw[i >> 1] & 0xffffu)); vT[(64 + pc * 8 + i) * 72 + j] = (bf16_t)((i & 1) ? (vbw[i >> 1] >> 16) : (vbw[i >> 1] & 0xffffu)); }
        }
        __syncthreads();
        bf16_t* out = (bf16_t*)(ws + WS_RS) + (size_t)u * 16384;
#pragma unroll
        for (int jb = 0; jb < 8; ++jb) { f32x4 acc = {0.f, 0.f, 0.f, 0.f}; acc = mm_tile<2>(vT, 72, kT, 72, F.wave, jb, F.lane, acc);
            const int e = F.wave * 16 + (F.lane & 15), d = jb * 16 + 4 * (F.lane >> 4);
            u32x2 w; w.x = pk2(acc[0], acc[1]); w.y = pk2(acc[2], acc[3]); *(u32x2*)(out + e * 128 + d) = w; }
    }
    __syncthreads();
}

__device__ __forceinline__ void ret_scan(const Frame& F) {
    bf16_t* rs = (bf16_t*)(F.ws + WS_RS);
    for (int idx = F.blk * NTHR + F.tid; idx < NB * 4 * 16384; idx += F.G * NTHR) {
        const int b = idx >> 16, h = (idx >> 14) & 3, ed = idx & 16383; const float cd = __expf(ret_lg(h) * 64.0f);
        bf16_t* base = rs + ((size_t)(b * 128) * 4 + h) * 16384 + ed; float s = 0.f;
        for (int n0 = 0; n0 < NCHUNK; n0 += 32) { unsigned short t[32];
#pragma unroll
            for (int i = 0; i < 32; ++i) t[i] = base[(size_t)(n0 + i) * 65536];
#pragma unroll
            for (int i = 0; i < 32; ++i) { base[(size_t)(n0 + i) * 65536] = (bf16_t)f2bf(s); s = s * cd + bf2f(t[i]); } }
    }
}

__device__ __forceinline__ void ret_out(const Frame& F) {
    unsigned char* ws = F.ws; const bf16_t* p = (const bf16_t*)(ws + WS_P);
    LAS bf16_t* q = (LAS bf16_t*)F.lds;
    LAS bf16_t* k = q + 64 * 136;
    LAS bf16_t* vT = k + 64 * 136;
    LAS bf16_t* pT = vT + 128 * 72;
    LAS bf16_t* sc = pT + 128 * 136;
    LAS float* st = (LAS float*)(sc + 64 * 72);
    const int pc = F.tid & 7, j = F.tid >> 3;
    for (int u = F.blk; u < NB * NCHUNK * 4; u += F.G) {
        const int h = u & 3, n = (u >> 2) & 127, b = u >> 9; const int m0 = b * SEQ + n * 64, m = m0 + j;
        const float lg = ret_lg(h);
        LBAR();
        {
            const float* cp = (const float*)(ws + WS_COSR) + (size_t)m * 64 + pc * 8; const float* sp = (const float*)(ws + WS_SINR) + (size_t)m * 64 + pc * 8;
            float cs[8], sn[8];
#pragma unroll
            for (int i = 0; i < 8; ++i) { cs[i] = cp[i]; sn[i] = sp[i]; }
#pragma unroll
            for (int which = 0; which < 2; ++which) {
                const bf16_t* r = p + (size_t)m * PW + (which ? P_RK : P_RQ) + h * 128 + pc * 8;
                const u32x4 a = *(const u32x4*)r, bq = *(const u32x4*)(r + 64);
                const unsigned aw[4] = {a.x, a.y, a.z, a.w}, bw[4] = {bq.x, bq.y, bq.z, bq.w}; const float sc_ = which ? 0.08838834764831845f : 1.0f;
                float o1[8], o2[8];
#pragma unroll
                for (int i = 0; i < 8; ++i) { const float x1 = (i & 1) ? bfhi(aw[i >> 1]) : bflo(aw[i >> 1]), x2 = (i & 1) ? bfhi(bw[i >> 1]) : bflo(bw[i >> 1]); o1[i] = (x1 * cs[i] - x2 * sn[i]) * sc_; o2[i] = (x1 * sn[i] + x2 * cs[i]) * sc_; }
                LAS bf16_t* dst = (which ? k : q) + j * 136 + pc * 8;
                u32x4 w1, w2; w1.x = pk2(o1[0], o1[1]); w1.y = pk2(o1[2], o1[3]); w1.z = pk2(o1[4], o1[5]); w1.w = pk2(o1[6], o1[7]); w2.x = pk2(o2[0], o2[1]); w2.y = pk2(o2[2], o2[3]); w2.z = pk2(o2[4], o2[5]); w2.w = pk2(o2[6], o2[7]);
                *(LAS u32x4*)dst = w1; *(LAS u32x4*)(dst + 64) = w2; }
            const bf16_t* vr = p + (size_t)m * PW + P_RV + h * 128 + pc * 8;
            const u32x4 va = *(const u32x4*)vr, vb = *(const u32x4*)(vr + 64);
            const unsigned vaw[4] = {va.x, va.y, va.z, va.w}, vbw[4] = {vb.x, vb.y, vb.z, vb.w};
#pragma unroll
            for (int i = 0; i < 8; ++i) { vT[(pc * 8 + i) * 72 + j] = (bf16_t)((i & 1) ? (vaw[i >> 1] >> 16) : (vaw[i >> 1] & 0xffffu)); vT[(64 + pc * 8 + i) * 72 + j] = (bf16_t)((i & 1) ? (vbw[i >> 1] >> 16) : (vbw[i >> 1] & 0xffffu)); }
            const bf16_t* ps = (const bf16_t*)(ws + WS_RS) + (size_t)u * 16384;
#pragma unroll
            for (int i = 0; i < 4; ++i) { const int pi = F.tid + i * 512; const int e = pi >> 4, c = pi & 15; *(LAS u32x4*)(pT + e * 136 + c * 8) = *(const u32x4*)(ps + e * 128 + c * 8); }
        }
        LBAR();
        {
            const int ib = F.wave & 3;
#pragma unroll
            for (int t = 0; t < 2; ++t) { const int jb = 2 * (F.wave >> 2) + t; f32x4 acc = {0.f, 0.f, 0.f, 0.f}; acc = mm_tile<4>(q, 136, k, 136, ib, jb, F.lane, acc);
                const int i = ib * 16 + (F.lane & 15), j0 = jb * 16 + 4 * (F.lane >> 4);
#pragma unroll
                for (int r = 0; r < 4; ++r) { const int dd = i - (j0 + r); acc[r] *= __expf(lg * (float)(dd < 0 ? -dd : dd)); }
                st_bf4(sc + i * 72 + j0, acc); }
        }
        LBAR();
        {
            const int ib = F.wave & 3, eh = F.wave >> 2; const int i = ib * 16 + (F.lane & 15);
            const float qd = __expf(lg * (float)(i + 1));
            f32x4 o[4]; float s1 = 0.f, s2 = 0.f;
#pragma unroll
            for (int t = 0; t < 4; ++t) { const int eb = eh * 4 + t; f32x4 ai = {0.f, 0.f, 0.f, 0.f}, ac = {0.f, 0.f, 0.f, 0.f};
                ai = mm_tile<2>(sc, 72, vT, 72, ib, eb, F.lane, ai); ac = mm_tile<4>(q, 136, pT, 136, ib, eb, F.lane, ac);
                o[t] = ai + ac * qd;
#pragma unroll
                for (int r = 0; r < 4; ++r) { s1 += o[t][r]; s2 += o[t][r] * o[t][r]; } }
            s1 += __shfl_xor(s1, 16); s1 += __shfl_xor(s1, 32); s2 += __shfl_xor(s2, 16); s2 += __shfl_xor(s2, 32);
            if (F.lane < 16) { st[(eh * 64 + i) * 2] = s1; st[(eh * 64 + i) * 2 + 1] = s2; }
            LBAR();
            const float t1 = st[i * 2] + st[(64 + i) * 2], t2 = st[i * 2 + 1] + st[(64 + i) * 2 + 1];
            const float mean = t1 * (1.0f / 128.0f), var = fmaxf(t2 * (1.0f / 128.0f) - mean * mean, 0.f), rstd = rsqrtf(var + 1e-5f);
            const int mrow = m0 + i;
#pragma unroll
            for (int t = 0; t < 4; ++t) { const int e = (eh * 4 + t) * 16 + 4 * (F.lane >> 4);
                const u32x2 gw = *(const u32x2*)(p + (size_t)mrow * PW + P_RG + h * 128 + e); const float g[4] = {bflo(gw.x), bfhi(gw.x), bflo(gw.y), bfhi(gw.y)};
                float y[4];
#pragma unroll
                for (int r = 0; r < 4; ++r) y[r] = (o[t][r] - mean) * rstd * (g[r] * sigmoidf_(g[r]));
                u32x2 w; w.x = pk2(y[0], y[1]); w.y = pk2(y[2], y[3]); *(u32x2*)((bf16_t*)(ws + WS_YRET) + (size_t)mrow * 512 + h * 128 + e) = w; }
        }
    }
    __syncthreads();
}

constexpr int ATT_KP = 104, ATT_VP = 72;
constexpr int ATT_KB = 64 * ATT_KP * 2, ATT_VB = 64 * ATT_VP * 2;
constexpr int ATT_K0 = 0, ATT_V0 = 2 * ATT_KB;
__device__ __forceinline__ void attn_unit(const Frame& F, int b, int h, int qt) {
    unsigned char* ws = F.ws;
    const bf16_t* Qg = (const bf16_t*)(ws + WS_Q); const bf16_t* Kn = (const bf16_t*)(ws + WS_KN); const bf16_t* Kp = (const bf16_t*)(ws + WS_KPE); const bf16_t* Vt = (const bf16_t*)(ws + WS_VT);
    const int lane = F.lane, w = F.wave, ql = lane & 31, hf = lane >> 5;
    const int mq = b * SEQ + qt * 256 + w * 32 + ql;
    const float qs = 0.10206207261596577f * 1.4426950408889634f;
    bf16x8 qf[6];
    {
        const bf16_t* qr = Qg + (size_t)mq * 768 + h * 96;
#pragma unroll
        for (int s = 0; s < 4; ++s) { const u32x4 x = *(const u32x4*)(qr + 16 * s + 8 * hf); const unsigned xw[4] = {x.x, x.y, x.z, x.w}; u32x4 o; unsigned ow[4];
#pragma unroll
            for (int i = 0; i < 4; ++i) ow[i] = pk2(bflo(xw[i]) * qs, bfhi(xw[i]) * qs);
            o.x = ow[0]; o.y = ow[1]; o.z = ow[2]; o.w = ow[3]; qf[s] = __builtin_bit_cast(bf16x8, o); }
        const u32x4 x1 = *(const u32x4*)(qr + 64 + 8 * hf), x2 = *(const u32x4*)(qr + 80 + 8 * hf);
        const float* cp = (const float*)(ws + WS_COSM) + (size_t)mq * 16 + 8 * hf; const float* sp = (const float*)(ws + WS_SINM) + (size_t)mq * 16 + 8 * hf;
        const unsigned a[4] = {x1.x, x1.y, x1.z, x1.w}, c[4] = {x2.x, x2.y, x2.z, x2.w}; unsigned o1[4], o2[4];
#pragma unroll
        for (int i = 0; i < 4; ++i) { const float u0 = bflo(a[i]), u1 = bfhi(a[i]), v0 = bflo(c[i]), v1 = bfhi(c[i]); const float c0 = cp[2 * i], c1 = cp[2 * i + 1], s0 = sp[2 * i], s1 = sp[2 * i + 1];
            o1[i] = pk2((u0 * c0 - v0 * s0) * qs, (u1 * c1 - v1 * s1) * qs); o2[i] = pk2((u0 * s0 + v0 * c0) * qs, (u1 * s1 + v1 * c1) * qs); }
        u32x4 t1, t2; t1.x = o1[0]; t1.y = o1[1]; t1.z = o1[2]; t1.w = o1[3]; t2.x = o2[0]; t2.y = o2[1]; t2.z = o2[2]; t2.w = o2[3];
        qf[4] = __builtin_bit_cast(bf16x8, t1); qf[5] = __builtin_bit_cast(bf16x8, t2);
    }
    f32x16 oacc[2];
#pragma unroll
    for (int i = 0; i < 16; ++i) { oacc[0][i] = 0.f; oacc[1][i] = 0.f; }
    float mrun = 0.f; f32x2 lsum = {0.f, 0.f};
    const int nkt = 4 * qt + 4, mylim = 4 * qt + (w >> 1);
    const int half = w >> 2;
    const int kkey = F.tid >> 3, kpc = F.tid & 7, rkey = (F.tid & 255) >> 2, rpc = F.tid & 3, ve = F.tid >> 3, vpc = F.tid & 7;
    const bf16_t* knp = Kn + (size_t)(b * SEQ + kkey) * 512 + h * 64 + kpc * 8;
    const bf16_t* kpp = Kp + (size_t)(b * SEQ + rkey) * 32 + rpc * 8;
    const bf16_t* vtp = Vt + (size_t)(h * 64 + ve) * MTOK + b * SEQ + vpc * 8;
    const int kofs = (kkey * ATT_KP + kpc * 8) * 2, rofs = (rkey * ATT_KP + 64 + rpc * 8) * 2, vofs = (ve * ATT_VP + vpc * 8) * 2;
    constexpr bool rp = true;
#define ATT_QK(sv, kbuf, init) do { _Pragma("unroll") for (int t_ = 0; t_ < 2; ++t_) { _Pragma("unroll") for (int i_ = 0; i_ < 16; ++i_) sv[t_][i_] = (init); } \
        _Pragma("unroll") for (int st_ = 0; st_ < 6; ++st_) { _Pragma("unroll") for (int t_ = 0; t_ < 2; ++t_) { const bf16x8 a_ = *(const LAS bf16x8*)((kbuf) + (t_ * 32 + ql) * ATT_KP + 16 * st_ + 8 * hf); sv[t_] = __builtin_amdgcn_mfma_f32_32x32x16_bf16(a_, qf[st_], sv[t_], 0, 0, 0); } } } while (0)
    u32x4 ak, ar, av, bk, br, bv;
#define ATT_LOAD(K_, R_, V_, t_) do { const int tt_ = (t_) < nkt ? (t_) : nkt - 1; \
        K_ = *(const u32x4*)(knp + (size_t)tt_ * 64 * 512); R_ = *(const u32x4*)(kpp + (size_t)tt_ * 64 * 32); V_ = *(const u32x4*)(vtp + (size_t)tt_ * 64); } while (0)
#define ATT_STAGE(K_, R_, V_, kt_) do { { LAS unsigned char* kb2_ = F.lds + ATT_K0 + (((kt_) + 1) & 1) * ATT_KB; *(LAS u32x4*)(kb2_ + kofs) = K_; *(LAS u32x4*)(kb2_ + rofs) = R_; } \
        *(LAS u32x4*)(F.lds + ATT_V0 + (((kt_) + 1) & 1) * ATT_VB + vofs) = V_; ATT_LOAD(K_, R_, V_, (kt_) + 3); } while (0)
    __syncthreads();
    {
        ak = *(const u32x4*)knp; ar = *(const u32x4*)kpp; av = *(const u32x4*)vtp;
        *(LAS u32x4*)(F.lds + ATT_K0 + kofs) = ak; *(LAS u32x4*)(F.lds + ATT_K0 + rofs) = ar; *(LAS u32x4*)(F.lds + ATT_V0 + vofs) = av;
        ATT_LOAD(ak, ar, av, 1); ATT_LOAD(bk, br, bv, 2);
    }
    __syncthreads();
    f32x16 sc[2];
    if (half == 1) LBAR();
#define ATT_SEG1(kt_, ALL) do { if ((ALL) || (kt_) <= mylim) ATT_QK(sc, (const LAS bf16_t*)(F.lds + ATT_K0 + ((kt_) & 1) * ATT_KB), -mrun); } while (0)
#define ATT_SEG2(kt_, ALL) do { if ((ALL) || (kt_) <= mylim) { \
            const LAS bf16_t* vb = (const LAS bf16_t*)(F.lds + ATT_V0 + ((kt_) & 1) * ATT_VB); \
            int mi = __builtin_bit_cast(int, sc[0][0]); \
            _Pragma("unroll") for (int i = 0; i < 16; ++i) { const int a_ = __builtin_bit_cast(int, sc[0][i]), b_ = __builtin_bit_cast(int, sc[1][i]); mi = max(max(mi, a_), b_); } \
            if ((kt_) == 0 || __builtin_amdgcn_ballot_w64(__builtin_bit_cast(float, mi) > 8.0f) != 0ull) { \
                float mx = fmaxf(sc[0][0], sc[1][0]); \
                _Pragma("unroll") for (int i = 1; i < 16; ++i) mx = fmaxf(mx, fmaxf(sc[0][i], sc[1][i])); \
                { const int mb = __builtin_bit_cast(int, mx); const auto sw2 = __builtin_amdgcn_permlane32_swap(mb, mb, false, false); mx = fmaxf(__builtin_bit_cast(float, (int)sw2[0]), __builtin_bit_cast(float, (int)sw2[1])); } \
                const float delta = ((kt_) == 0) ? mx : fmaxf(mx, 0.f); \
                const float alpha = ((kt_) == 0) ? 1.0f : __builtin_amdgcn_exp2f(-delta); mrun += delta; lsum *= alpha; \
                _Pragma("unroll") for (int i = 0; i < 16; ++i) { oacc[0][i] *= alpha; oacc[1][i] *= alpha; sc[0][i] -= delta; sc[1][i] -= delta; } } \
            _Pragma("unroll") for (int t = 0; t < 2; ++t) _Pragma("unroll") for (int i = 0; i < 16; i += 2) { const float p0 = __builtin_amdgcn_exp2f(sc[t][i]), p1 = __builtin_amdgcn_exp2f(sc[t][i + 1]); sc[t][i] = p0; sc[t][i + 1] = p1; lsum += (f32x2){p0, p1}; } \
            _Pragma("unroll") for (int t = 0; t < 2; ++t) _Pragma("unroll") for (int kbb = 0; kbb < 2; ++kbb) { \
                    u32x4 pw; pw.x = pk2(sc[t][8 * kbb + 0], sc[t][8 * kbb + 1]); pw.y = pk2(sc[t][8 * kbb + 2], sc[t][8 * kbb + 3]); pw.z = pk2(sc[t][8 * kbb + 4], sc[t][8 * kbb + 5]); pw.w = pk2(sc[t][8 * kbb + 6], sc[t][8 * kbb + 7]); \
                    const bf16x8 pf = __builtin_bit_cast(bf16x8, pw); const int key0 = t * 32 + kbb * 16 + 4 * hf; \
                    _Pragma("unroll") for (int eb = 0; eb < 2; ++eb) { const LAS bf16_t* vr = vb + (eb * 32 + ql) * ATT_VP + key0; \
                        const u32x2 lo = *(const LAS u32x2*)vr, hi = *(const LAS u32x2*)(vr + 8); u32x4 vv; vv.x = lo.x; vv.y = lo.y; vv.z = hi.x; vv.w = hi.y; \
                        oacc[eb] = __builtin_amdgcn_mfma_f32_32x32x16_bf16(__builtin_bit_cast(bf16x8, vv), pf, oacc[eb], 0, 0, 0); } } } } while (0)
    const int nall = 4 * qt;
#define ATT_TRIP_L(kt_, ALL) do { ATT_SEG1(kt_, ALL); LBAR(); ATT_STAGE(ak, ar, av, kt_); ATT_SEG2(kt_, ALL); LBAR(); \
                                  ATT_SEG1((kt_) + 1, ALL); LBAR(); ATT_STAGE(bk, br, bv, (kt_) + 1); ATT_SEG2((kt_) + 1, ALL); LBAR(); } while (0)
#define ATT_TRIP_T(kt_, ALL) do { ATT_STAGE(ak, ar, av, kt_); ATT_SEG1(kt_, ALL); LBAR(); ATT_SEG2(kt_, ALL); LBAR(); \
                                  ATT_STAGE(bk, br, bv, (kt_) + 1); ATT_SEG1((kt_) + 1, ALL); LBAR(); ATT_SEG2((kt_) + 1, ALL); LBAR(); } while (0)
    if (half == 0) {
#pragma unroll 1
        for (int kt = 0; kt < nall; kt += 2) ATT_TRIP_L(kt, true);
#pragma unroll 1
        for (int kt = nall; kt < nkt; kt += 2) ATT_TRIP_L(kt, false);
        LBAR();
    } else {
#pragma unroll 1
        for (int kt = 0; kt < nall; kt += 2) ATT_TRIP_T(kt, true);
#pragma unroll 1
        for (int kt = nall; kt < nkt; kt += 2) ATT_TRIP_T(kt, false);
    }
#undef ATT_TRIP_L
#undef ATT_TRIP_T
#undef ATT_QK
#undef ATT_LOAD
#undef ATT_STAGE
#undef ATT_SEG1
#undef ATT_SEG2
    float lrun = lsum[0] + lsum[1];
    const float lt = lrun + __shfl_xor(lrun, 32), inv = 1.0f / lt;
    bf16_t* yo = (bf16_t*)(ws + WS_YMLA) + (size_t)mq * 512 + h * 64;
#pragma unroll
    for (int eb = 0; eb < 2; ++eb)
#pragma unroll
        for (int g = 0; g < 4; ++g) { u32x2 wv; wv.x = pk2(oacc[eb][4 * g] * inv, oacc[eb][4 * g + 1] * inv); wv.y = pk2(oacc[eb][4 * g + 2] * inv, oacc[eb][4 * g + 3] * inv);
            *(u32x2*)(yo + eb * 32 + 8 * g + 4 * hf) = wv; }
}
constexpr int RP = 72;
constexpr int RMAT = 64 * RP;
constexpr size_t RC_UNIT = 40960;
constexpr size_t WS_RC2 = WS_RC + (size_t)2048 * RC_UNIT;

__device__ __forceinline__ void st_g4(bf16_t* p, f32x4 v) { u32x2 w; w.x = pk2(v[0], v[1]); w.y = pk2(v[2], v[3]); *(u32x2*)p = w; }
__device__ __forceinline__ f32x4 ld_l4(const LAS bf16_t* p) { const u32x2 w = *(const LAS u32x2*)p; return (f32x4){bflo(w.x), bfhi(w.x), bflo(w.y), bfhi(w.y)}; }

template <int KS>
__device__ __forceinline__ f32x16 mm32(const LAS bf16_t* P, const LAS bf16_t* Q, int ib, int jb, int lane, f32x16 acc) {
    const LAS bf16_t* pp = P + (ib * 32 + (lane & 31)) * RP + 8 * (lane >> 5);
    const LAS bf16_t* qp = Q + (jb * 32 + (lane & 31)) * RP + 8 * (lane >> 5);
#pragma unroll
    for (int ks = 0; ks < KS; ++ks) { const bf16x8 a = *(const LAS bf16x8*)(qp + ks * 16), b = *(const LAS bf16x8*)(pp + ks * 16); acc = __builtin_amdgcn_mfma_f32_32x32x16_bf16(a, b, acc, 0, 0, 0); }
    return acc;
}
__device__ __forceinline__ f32x16 zero16() { f32x16 z; for (int i = 0; i < 16; ++i) z[i] = 0.f; return z; }
__device__ __forceinline__ void st32_lds(LAS bf16_t* O, int ib, int jb, int lane, const f32x16& a) {
    LAS bf16_t* o = O + (ib * 32 + (lane & 31)) * RP + jb * 32 + 4 * (lane >> 5);
#pragma unroll
    for (int g = 0; g < 4; ++g) st_bf4(o + 8 * g, (f32x4){a[4 * g], a[4 * g + 1], a[4 * g + 2], a[4 * g + 3]});
}
__device__ __forceinline__ void st32_glb(bf16_t* O, int ib, int jb, int lane, const f32x16& a) {
    bf16_t* o = O + (ib * 32 + (lane & 31)) * 64 + jb * 32 + 4 * (lane >> 5);
#pragma unroll
    for (int g = 0; g < 4; ++g) st_g4(o + 8 * g, (f32x4){a[4 * g], a[4 * g + 1], a[4 * g + 2], a[4 * g + 3]});
}
struct PreIn { unsigned short r[8], rp[8], k[8], kp[8], v[8], vp[8], lw[8], a[8]; };
__device__ __forceinline__ void pre_load(PreIn& x, const bf16_t* p, const bf16_t* lo, int u, int w, int lane) {
    const int c = u & 127, h = (u >> 7) & 7, b = u >> 10; const int m0 = b * SEQ + c * 64, ch = h * 64 + lane;
#pragma unroll
    for (int i = 0; i < 8; ++i) { const int t = w + 8 * i, m = m0 + t; const bf16_t* pr = p + (size_t)m * PW + P_RW + ch; const bool hp = (c | t) != 0;
        x.r[i] = pr[0]; x.k[i] = pr[512]; x.v[i] = pr[1024];
        x.rp[i] = hp ? pr[-PW] : (unsigned short)0; x.kp[i] = hp ? pr[512 - PW] : (unsigned short)0; x.vp[i] = hp ? pr[1024 - PW] : (unsigned short)0;
        x.lw[i] = lo[(size_t)m * LO_W + ch]; x.a[i] = lo[(size_t)m * LO_W + 512 + ch]; }
}
__device__ __forceinline__ void rwkv_chunk_pre(const Frame& F, const float* mu, const float* k_k_, const float* k_a_, const float* r_k_) {
    unsigned char* ws = F.ws; const bf16_t* p = (const bf16_t*)(ws + WS_P); const bf16_t* lo = (const bf16_t*)(ws + WS_LO);
    LAS bf16_t* M = (LAS bf16_t*)F.lds;
    LAS bf16_t *KKt = M, *Bt = M + RMAT, *Kt = M + 2 * RMAT, *Rt = M + 3 * RMAT, *KKtT = M + 4 * RMAT, *BhT = M + 5 * RMAT, *KhT = M + 6 * RMAT, *VcT = M + 7 * RMAT;
    LAS bf16_t *NA = M + 8 * RMAT, *NAT = M + 9 * RMAT, *TT = M + 10 * RMAT, *AkkT = M + 11 * RMAT, *AbrT = M + 12 * RMAT, *AkrT = M + 13 * RMAT;
    LAS float* LW = (LAS float*)(M + 8 * RMAT);
    LAS float* SEG = (LAS float*)(M + 10 * RMAT);
    const int lane = F.lane, w = F.wave, pr_ = w >> 1, ib = w & 1;
    const int i0 = ib * 32 + (lane & 31), jq = 4 * (lane >> 5);
    PreIn cur;
    if (F.blk < NB * 8 * NCHUNK) pre_load(cur, p, lo, F.blk, w, lane);
    for (int u = F.blk; u < NB * 8 * NCHUNK; u += F.G) {
        const int h = (u >> 7) & 7; const int ch = h * 64 + lane;
        const float mu_r = mu[ch], mu_k = mu[512 + ch], mu_v = mu[1024 + ch], k_k = k_k_[ch], k_a = k_a_[ch], r_k = r_k_[ch];
        float* aux = (float*)(ws + WS_RC2) + (size_t)u * 128;
        LBAR();
        float rr[8], kk8[8], k28[8], vv[8], bb[8], lw8[8];
#pragma unroll
        for (int i = 0; i < 8; ++i) { const int t = w + 8 * i;
            const float xr = bf2f(cur.r[i]), xk = bf2f(cur.k[i]), xv = bf2f(cur.v[i]);
            const float r = xr + (bf2f(cur.rp[i]) - xr) * mu_r, k = xk + (bf2f(cur.kp[i]) - xk) * mu_k, v = xv + (bf2f(cur.vp[i]) - xv) * mu_v;
            const float lw = bf2f(cur.lw[i]), a = bf2f(cur.a[i]);
            float kk = k * k_k; const float ss = wave_sum(kk * kk); kk *= rsqrtf(ss + 1e-12f);
            const float k2 = k * (1.0f + (a - 1.0f) * k_a);
            rr[i] = r; kk8[i] = kk; k28[i] = k2; vv[i] = v; bb[i] = kk * a; lw8[i] = lw; LW[t * 64 + lane] = lw;
            ((bf16_t*)(ws + WS_RC + (size_t)u * RC_UNIT))[16384 + t * 64 + lane] = (bf16_t)f2bf(v);
            const float bon = wave_sum(r * k2 * r_k); if (lane == 0) aux[64 + t] = bon; }
        if (u + F.G < NB * 8 * NCHUNK) pre_load(cur, p, lo, u + F.G, w, lane);
        LBAR();
        { float cs = 0.f;
#pragma unroll
          for (int i = 0; i < 8; ++i) { cs += LW[(w * 8 + i) * 64 + lane]; LW[(w * 8 + i) * 64 + lane] = cs; }
          SEG[w * 64 + lane] = cs; }
        LBAR();
        float segp[9]; segp[0] = 0.f;
#pragma unroll
        for (int s = 0; s < 8; ++s) segp[s + 1] = segp[s] + SEG[s * 64 + lane];
        const float cumC = segp[8];
        float cum8[8];
#pragma unroll
        for (int i = 0; i < 8; ++i) cum8[i] = LW[(w + 8 * i) * 64 + lane] + segp[i];
        if (w == 0) aux[lane] = __expf(cumC);
        LBAR();
#pragma unroll
        for (int i = 0; i < 8; ++i) { const int t = w + 8 * i; const float cum = cum8[i];
            const float om = __expf(cum), omx = __expf(cum - lw8[i]), iom = __expf(-cum), ih = __expf(cumC - cum);
            KKt[t * RP + lane] = (bf16_t)f2bf(kk8[i] * omx); Bt[t * RP + lane] = (bf16_t)f2bf(bb[i] * iom); Kt[t * RP + lane] = (bf16_t)f2bf(k28[i] * iom); Rt[t * RP + lane] = (bf16_t)f2bf(rr[i] * om);
            KKtT[lane * RP + t] = (bf16_t)f2bf(kk8[i] * omx); BhT[lane * RP + t] = (bf16_t)f2bf(bb[i] * ih); KhT[lane * RP + t] = (bf16_t)f2bf(k28[i] * ih); VcT[lane * RP + t] = (bf16_t)f2bf(vv[i]); }
        LBAR();
        {
            const LAS bf16_t* Pm = pr_ < 2 ? KKt : Rt; const LAS bf16_t* Qm = (pr_ == 0 || pr_ == 2) ? Bt : Kt; LAS bf16_t* Om = pr_ == 0 ? NAT : (pr_ == 1 ? AkkT : (pr_ == 2 ? AbrT : AkrT));
            const bool incl = pr_ >= 2; const float sgn = pr_ == 0 ? -1.0f : 1.0f;
#pragma unroll
            for (int jb = 0; jb < 2; ++jb) { f32x16 a = zero16(); if (jb <= ib) a = mm32<4>(Pm, Qm, ib, jb, lane, a);
#pragma unroll
                for (int g = 0; g < 4; ++g)
#pragma unroll
                    for (int r = 0; r < 4; ++r) { const int jj = jb * 32 + 8 * g + jq + r; const bool keep = incl ? (jj <= i0) : (jj < i0); a[4 * g + r] = keep ? sgn * a[4 * g + r] : 0.f; }
                st32_lds(Om, ib, jb, lane, a);
                if (pr_ == 0) {
#pragma unroll
                    for (int g = 0; g < 4; ++g)
#pragma unroll
                        for (int r = 0; r < 4; ++r) { const int jj = jb * 32 + 8 * g + jq + r; a[4 * g + r] += (jj == i0) ? 1.0f : 0.f; }
                    st32_lds(TT, ib, jb, lane, a); } }
            if (pr_ == 0) {
#pragma unroll
                for (int jb = 0; jb < 2; ++jb) { f32x16 a = zero16(); if (jb >= ib) a = mm32<4>(Bt, KKt, ib, jb, lane, a);
#pragma unroll
                    for (int g = 0; g < 4; ++g)
#pragma unroll
                        for (int r = 0; r < 4; ++r) { const int jj = jb * 32 + 8 * g + jq + r; a[4 * g + r] = (i0 < jj) ? -a[4 * g + r] : 0.f; }
                    st32_lds(NA, ib, jb, lane, a); } }
        }
        LBAR();
        LAS bf16_t* VA = Kt;
#pragma unroll 1
        for (int s = 1; s <= 6; ++s) {
            const LAS bf16_t* Yo = (s & 1) ? NAT : KKt; const LAS bf16_t* YoT = (s & 1) ? NA : Bt; LAS bf16_t* Yn = (s & 1) ? KKt : NAT; LAS bf16_t* YnT = (s & 1) ? Bt : NA;
            if (pr_ == 0) {
                if (s == 1) { const f32x16 a0 = mm32<4>(VcT, AkkT, ib, 0, lane, zero16()), a1 = mm32<4>(VcT, AkkT, ib, 1, lane, zero16()); st32_lds(VA, ib, 0, lane, a0); st32_lds(VA, ib, 1, lane, a1); }
                else {
                    f32x16 c0, c1; const LAS bf16_t* tr = TT + i0 * RP + jq;
#pragma unroll
                    for (int g = 0; g < 4; ++g) { const f32x4 x0 = ld_l4(tr + 8 * g), x1 = ld_l4(tr + 32 + 8 * g);
#pragma unroll
                        for (int r = 0; r < 4; ++r) { c0[4 * g + r] = x0[r]; c1[4 * g + r] = x1[r]; } }
                    c0 = mm32<4>(TT, YoT, ib, 0, lane, c0); c1 = mm32<4>(TT, YoT, ib, 1, lane, c1);
                    LDS_WAIT();
                    st32_lds(TT, ib, 0, lane, c0); st32_lds(TT, ib, 1, lane, c1); }
            } else if (pr_ <= 2 && s <= 5) {
                const LAS bf16_t* Pm = pr_ == 1 ? Yo : YoT; const LAS bf16_t* Qm = pr_ == 1 ? YoT : Yo; LAS bf16_t* Om = pr_ == 1 ? Yn : YnT;
                const f32x16 a0 = mm32<4>(Pm, Qm, ib, 0, lane, zero16()), a1 = mm32<4>(Pm, Qm, ib, 1, lane, zero16()); st32_lds(Om, ib, 0, lane, a0); st32_lds(Om, ib, 1, lane, a1);
            }
            LBAR();
        }
        LAS bf16_t* KT = NAT; LAS bf16_t* P1 = NA;
        if (pr_ < 2) { const LAS bf16_t* src = pr_ == 0 ? KKtT : VA; LAS bf16_t* dst = pr_ == 0 ? KT : P1;
            const f32x16 a0 = mm32<4>(src, TT, ib, 0, lane, zero16()), a1 = mm32<4>(src, TT, ib, 1, lane, zero16()); st32_lds(dst, ib, 0, lane, a0); st32_lds(dst, ib, 1, lane, a1); }
        LBAR();
        {
            bf16_t* og = (bf16_t*)(ws + WS_RC + (size_t)u * RC_UNIT) + pr_ * 4096;
#pragma unroll
            for (int jb = 0; jb < 2; ++jb) { f32x16 o;
                if (pr_ == 0) o = mm32<4>(BhT, KT, ib, jb, lane, zero16());
                else if (pr_ == 1) { const f32x16 x = mm32<4>(VcT, KhT, ib, jb, lane, zero16()), y = mm32<4>(P1, BhT, ib, jb, lane, zero16()); o = x - y; }
                else if (pr_ == 2) { const f32x16 y = mm32<4>(AbrT, KT, ib, jb, lane, zero16()); const LAS bf16_t* rt = Rt + i0 * RP + jb * 32 + jq;
#pragma unroll
                    for (int g = 0; g < 4; ++g) { const f32x4 x = ld_l4(rt + 8 * g);
#pragma unroll
                        for (int r = 0; r < 4; ++r) o[4 * g + r] = x[r] - y[4 * g + r]; } }
                else { const f32x16 x = mm32<4>(VcT, AkrT, ib, jb, lane, zero16()), y = mm32<4>(P1, AbrT, ib, jb, lane, zero16()); o = x - y; }
                st32_glb(og, ib, jb, lane, o); }
        }
    }
    __syncthreads();
}

struct ScanOps { u32x4 fa0, fa1; u32x2 ad0, ad1; f32x4 om; };
__device__ __forceinline__ ScanOps scan_load(const unsigned char* ws, size_t u, int sk, int vh, int l15, int l4) {
    ScanOps o; const bf16_t* base = (const bf16_t*)(ws + WS_RC + u * RC_UNIT);
    o.fa0 = *(const u32x4*)(base + (sk * 16 + l15) * 64 + 8 * l4); o.fa1 = *(const u32x4*)(base + (sk * 16 + l15) * 64 + 32 + 8 * l4);
    o.ad0 = *(const u32x2*)(base + 4096 + ((2 * vh) * 16 + l15) * 64 + sk * 16 + 4 * l4); o.ad1 = *(const u32x2*)(base + 4096 + ((2 * vh + 1) * 16 + l15) * 64 + sk * 16 + 4 * l4);
    o.om = *(const f32x4*)((const float*)(ws + WS_RC2) + u * 128 + sk * 16 + 4 * l4); return o;
}
template <bool STORE>
__device__ __forceinline__ void rwkv_scan(const Frame& F, int b, int h) {
    unsigned char* ws = F.ws;
    LAS bf16_t* Sb = (LAS bf16_t*)F.lds;
    const int lane = F.lane, w = F.wave, l15 = lane & 15, l4 = lane >> 4, sk = w & 3, vh = w >> 2;
    for (int i = F.tid; i < 2 * RMAT / 2; i += NTHR) ((LAS unsigned*)Sb)[i] = 0u;
    const size_t u0 = (size_t)(b * 8 + h) * 128;
    f32x4 st0 = {0.f, 0.f, 0.f, 0.f}, st1 = {0.f, 0.f, 0.f, 0.f};
    ScanOps r0 = scan_load(ws, u0 + 0, sk, vh, l15, l4), r1 = scan_load(ws, u0 + 1, sk, vh, l15, l4), r2 = scan_load(ws, u0 + 2, sk, vh, l15, l4), r3 = scan_load(ws, u0 + 3, sk, vh, l15, l4);
    __syncthreads();
#define SCAN_STEP(R, cc) do { const int c_ = (cc); \
        const LAS bf16_t* Sc = Sb + (c_ & 1) * RMAT; LAS bf16_t* Sn = Sb + ((c_ + 1) & 1) * RMAT; \
        const bf16x8 a0 = __builtin_bit_cast(bf16x8, R.fa0), a1 = __builtin_bit_cast(bf16x8, R.fa1); \
        const LAS bf16_t* sp0 = Sc + ((2 * vh) * 16 + l15) * RP + 8 * l4; const LAS bf16_t* sp1 = sp0 + 16 * RP; \
        const bf16x8 s00 = *(const LAS bf16x8*)sp0, s01 = *(const LAS bf16x8*)(sp0 + 32), s10 = *(const LAS bf16x8*)sp1, s11 = *(const LAS bf16x8*)(sp1 + 32); \
        bf16_t* sg = (bf16_t*)(ws + WS_RC + (u0 + c_ - 1) * RC_UNIT) + 4096;     \
        if (STORE && c_ > 0) *(u32x4*)(sg + (F.tid >> 3) * 64 + (F.tid & 7) * 8) = *(const LAS u32x4*)(Sc + (F.tid >> 3) * RP + (F.tid & 7) * 8);     \
        f32x4 t0 = {0.f, 0.f, 0.f, 0.f}, t1 = {0.f, 0.f, 0.f, 0.f}; \
        t0 = __builtin_amdgcn_mfma_f32_16x16x32_bf16(a0, s00, t0, 0, 0, 0); t1 = __builtin_amdgcn_mfma_f32_16x16x32_bf16(a0, s10, t1, 0, 0, 0); \
        t0 = __builtin_amdgcn_mfma_f32_16x16x32_bf16(a1, s01, t0, 0, 0, 0); t1 = __builtin_amdgcn_mfma_f32_16x16x32_bf16(a1, s11, t1, 0, 0, 0); \
        const f32x4 n0 = {bflo(R.ad0.x), bfhi(R.ad0.x), bflo(R.ad0.y), bfhi(R.ad0.y)}, n1 = {bflo(R.ad1.x), bfhi(R.ad1.x), bflo(R.ad1.y), bfhi(R.ad1.y)}; \
        st0 = st0 * R.om - t0 + n0; st1 = st1 * R.om - t1 + n1; \
        st_bf4(Sn + ((2 * vh) * 16 + l15) * RP + sk * 16 + 4 * l4, st0); st_bf4(Sn + ((2 * vh + 1) * 16 + l15) * RP + sk * 16 + 4 * l4, st1); \
        R = scan_load(ws, u0 + (c_ + 4 < NCHUNK ? c_ + 4 : NCHUNK - 1), sk, vh, l15, l4);     \
        LBAR(); } while (0)
#pragma unroll 1
    for (int c = 0; c < NCHUNK; c += 16) {
#pragma unroll
        for (int j = 0; j < 16; j += 4) { SCAN_STEP(r0, c + j); SCAN_STEP(r1, c + j + 1); SCAN_STEP(r2, c + j + 2); SCAN_STEP(r3, c + j + 3); } }
#undef SCAN_STEP
}

__device__ __forceinline__ void rwkv_out(const Frame& F, const float* lnx_) {
    unsigned char* ws = F.ws; const bf16_t* lo = (const bf16_t*)(ws + WS_LO);
    LAS float* Yl = (LAS float*)F.lds;
    const int lane = F.lane, w = F.wave, l15 = lane & 15, l4 = lane >> 4, tb = w & 3, vh = w >> 2;
    const int tt = F.tid >> 3, c8 = (F.tid & 7) * 8;
    for (int u = F.blk; u < NB * 8 * NCHUNK; u += F.G) {
        const int c = u & 127, h = (u >> 7) & 7, b = u >> 10;
        const bf16_t* base = (const bf16_t*)(ws + WS_RC + (size_t)u * RC_UNIT);
        const bf16_t* Sg = (const bf16_t*)(ws + WS_RC + (size_t)(u > 0 ? u - 1 : 0) * RC_UNIT) + 4096; const bf16_t* QT = base + 8192; const bf16_t* Z = base + 12288;
        const bf16x8 q0 = *(const bf16x8*)(QT + (tb * 16 + l15) * 64 + 8 * l4), q1 = *(const bf16x8*)(QT + (tb * 16 + l15) * 64 + 32 + 8 * l4);
        f32x4 y[2];
#pragma unroll
        for (int i = 0; i < 2; ++i) { const int ib = 2 * vh + i; const bf16_t* sp = Sg + (ib * 16 + l15) * 64 + 8 * l4; const bf16x8 s0 = *(const bf16x8*)sp, s1 = *(const bf16x8*)(sp + 32);
            const u32x2 zw = *(const u32x2*)(Z + (ib * 16 + l15) * 64 + tb * 16 + 4 * l4);
            f32x4 t = {bflo(zw.x), bfhi(zw.x), bflo(zw.y), bfhi(zw.y)};
            if (c > 0) { t = __builtin_amdgcn_mfma_f32_16x16x32_bf16(q0, s0, t, 0, 0, 0); t = __builtin_amdgcn_mfma_f32_16x16x32_bf16(q1, s1, t, 0, 0, 0); }
            y[i] = t; }
        const int m = b * SEQ + c * 64 + tt, chq = h * 64 + c8;
        const u32x4 cv = *(const u32x4*)(base + 16384 + tt * 64 + c8), cg = *(const u32x4*)(lo + (size_t)m * LO_W + 1024 + chq);
        const float cbc = ((const float*)(ws + WS_RC2))[(size_t)u * 128 + 64 + tt];
        const f32x4 ln0 = *(const f32x4*)(lnx_ + chq), ln1 = *(const f32x4*)(lnx_ + chq + 4);
        LBAR();
#pragma unroll
        for (int i = 0; i < 2; ++i)
#pragma unroll
            for (int r = 0; r < 4; ++r) Yl[(tb * 16 + 4 * l4 + r) * 68 + (2 * vh + i) * 16 + l15] = y[i][r];
        LBAR();
        const f32x4 ya = *(const LAS f32x4*)(Yl + tt * 68 + c8), yb = *(const LAS f32x4*)(Yl + tt * 68 + c8 + 4);
        float yy[8] = {ya[0], ya[1], ya[2], ya[3], yb[0], yb[1], yb[2], yb[3]};
        float s1 = ((yy[0] + yy[1]) + (yy[2] + yy[3])) + ((yy[4] + yy[5]) + (yy[6] + yy[7]));
        s1 = sum8(s1); const float mean = s1 * (1.0f / 64.0f); float s2 = 0.f;
#pragma unroll
        for (int i = 0; i < 8; ++i) { yy[i] -= mean; s2 += yy[i] * yy[i]; }
        s2 = sum8(s2); const float rstd = rsqrtf(s2 * (1.0f / 64.0f) + 64e-5f);
        const unsigned vw[4] = {cv.x, cv.y, cv.z, cv.w}, gw[4] = {cg.x, cg.y, cg.z, cg.w};
        const float lnx[8] = {ln0[0], ln0[1], ln0[2], ln0[3], ln1[0], ln1[1], ln1[2], ln1[3]};
        unsigned ow[4];
#pragma unroll
        for (int i = 0; i < 4; ++i) { float o2[2];
#pragma unroll
            for (int e = 0; e < 2; ++e) { const int ci = 2 * i + e; const float v = e ? bfhi(vw[i]) : bflo(vw[i]), g = e ? bfhi(gw[i]) : bflo(gw[i]);
                o2[e] = (yy[ci] * rstd * lnx[ci] + cbc * v) * g; }
            ow[i] = pk2(o2[0], o2[1]); }
        *(u32x4*)((bf16_t*)(ws + WS_YRW) + (size_t)m * 512 + chq) = (u32x4){ow[0], ow[1], ow[2], ow[3]};
    }
    __syncthreads();
}
__device__ __forceinline__ void rwkv_seq(const Frame& F, const Params& P, int layer, int b, int h) {
    unsigned char* ws = F.ws; const bf16_t* p = (const bf16_t*)(ws + WS_P); const bf16_t* lo = (const bf16_t*)(ws + WS_LO);
    LAS float* Lr = (LAS float*)F.lds; LAS float* Lw = Lr + 4096; LAS float* Lk = Lw + 4096; LAS float* Lv = Lk + 4096; LAS float* Lkk = Lv + 4096; LAS float* Lb = Lkk + 4096; LAS float* Ly = Lb + 4096;
    const int lane = F.lane, ch = h * 64 + lane;
    const float mu_r = P.in[I_MU][(size_t)layer * RWKV_COLS + ch], mu_k = P.in[I_MU][(size_t)layer * RWKV_COLS + 512 + ch], mu_v = P.in[I_MU][(size_t)layer * RWKV_COLS + 1024 + ch];
    const float k_k = P.in[I_KK][layer * 512 + ch], k_a = P.in[I_KA][layer * 512 + ch], r_k = P.in[I_RK][layer * 512 + ch], lnx = P.in[I_LNX][layer * 512 + ch];
    const int vrow = F.tid >> 3, q = F.tid & 7;
    float s[8];
#pragma unroll
    for (int i = 0; i < 8; ++i) s[i] = 0.f;
    for (int c = 0; c < NCHUNK; ++c) {
        const int m0 = b * SEQ + c * 64;
        __syncthreads();
#pragma unroll
        for (int i = 0; i < 8; ++i) { const int t = F.wave + 8 * i, m = m0 + t; const bf16_t* pr = p + (size_t)m * PW + P_RW + ch; const bool hp = (c | t) != 0;
            const float xr = bf2f(pr[0]), xk = bf2f(pr[512]), xv = bf2f(pr[1024]);
            const float pr_ = hp ? bf2f(pr[-PW]) : 0.f, pk_ = hp ? bf2f(pr[512 - PW]) : 0.f, pv_ = hp ? bf2f(pr[1024 - PW]) : 0.f;
            const float r = xr + (pr_ - xr) * mu_r, k = xk + (pk_ - xk) * mu_k, v = xv + (pv_ - xv) * mu_v;
            const float lw = bf2f(lo[(size_t)m * LO_W + ch]), a = bf2f(lo[(size_t)m * LO_W + 512 + ch]);
            float kk = k * k_k; const float ss = wave_sum(kk * kk); kk *= rsqrtf(ss + 1e-12f);
            Lr[t * 64 + lane] = r; Lw[t * 64 + lane] = __expf(lw); Lk[t * 64 + lane] = k * (1.0f + (a - 1.0f) * k_a); Lv[t * 64 + lane] = v; Lkk[t * 64 + lane] = kk; Lb[t * 64 + lane] = kk * a; }
        __syncthreads();
        for (int t = 0; t < 64; ++t) {
            const f32x4 ka = *(const LAS f32x4*)(Lkk + t * 64 + q * 8), kb = *(const LAS f32x4*)(Lkk + t * 64 + q * 8 + 4);
            const f32x4 wa = *(const LAS f32x4*)(Lw + t * 64 + q * 8), wb = *(const LAS f32x4*)(Lw + t * 64 + q * 8 + 4);
            const f32x4 ba = *(const LAS f32x4*)(Lb + t * 64 + q * 8), bb = *(const LAS f32x4*)(Lb + t * 64 + q * 8 + 4);
            const f32x4 k2a = *(const LAS f32x4*)(Lk + t * 64 + q * 8), k2b = *(const LAS f32x4*)(Lk + t * 64 + q * 8 + 4);
            const f32x4 ra = *(const LAS f32x4*)(Lr + t * 64 + q * 8), rb = *(const LAS f32x4*)(Lr + t * 64 + q * 8 + 4);
            const float vv = Lv[t * 64 + vrow];
            float sa = 0.f;
#pragma unroll
            for (int i = 0; i < 4; ++i) { sa += s[i] * ka[i]; sa += s[4 + i] * kb[i]; }
            sa = sum8(sa); sa = -sa;
            float y = 0.f;
#pragma unroll
            for (int i = 0; i < 4; ++i) { s[i] = s[i] * wa[i] + sa * ba[i] + vv * k2a[i]; s[4 + i] = s[4 + i] * wb[i] + sa * bb[i] + vv * k2b[i]; y += s[i] * ra[i]; y += s[4 + i] * rb[i]; }
            y = sum8(y);
            if (q == 0) Ly[t * 64 + vrow] = y;
        }
        __syncthreads();
#pragma unroll
        for (int i = 0; i < 8; ++i) { const int t = F.wave + 8 * i, m = m0 + t;
            const float y = Ly[t * 64 + lane]; const float mean = wave_sum(y) * (1.0f / 64.0f); const float d = y - mean; const float var = wave_sum(d * d) * (1.0f / 64.0f);
            const float bon = wave_sum(Lr[t * 64 + lane] * Lk[t * 64 + lane] * r_k);
            const float g = bf2f(lo[(size_t)m * LO_W + 1024 + ch]);
            const float o = (d * rsqrtf(var + 64e-5f) * lnx + bon * Lv[t * 64 + lane]) * g;
            ((bf16_t*)(ws + WS_YRW))[(size_t)m * 512 + ch] = (bf16_t)f2bf(o); }
    }
    __syncthreads();
}

constexpr int LDS_TAB = LDSCTL_OFF + 64;
__device__ __forceinline__ void moe_table(const Frame& F, const unsigned* ectl) {
    LAS int* tab = (LAS int*)(F.lds + LDS_TAB);
    if (F.tid == 0) { int st = 0, nt = 0;
        for (int e = 0; e < 8; ++e) { const int c = (int)__hip_atomic_load(&ectl[e], __ATOMIC_RELAXED, __HIP_MEMORY_SCOPE_AGENT); tab[1 + e] = st; const int t = (c + 255) >> 8; for (int i = 0; i < t; ++i) tab[16 + nt + i] = e; nt += t; st += t * 256; }
        tab[0] = nt; }
    __syncthreads();
}
__device__ __forceinline__ void phase_moe_scatter(const Frame& F, const unsigned* ectl) {
    unsigned char* ws = F.ws; const LAS int* tab = (const LAS int*)(F.lds + LDS_TAB);
    const int* tok_e = (const int*)(ws + WS_TOK); int* tok_slot = (int*)tok_e + 2 * MTOK; const float* tok_w = (const float*)(tok_slot + 2 * MTOK);
    int* row_tok = (int*)(tok_w + 2 * MTOK); float* row_w = (float*)(row_tok + MAXROWS);
    for (int i = F.blk * NTHR + F.tid; i < 2 * MTOK; i += F.G * NTHR) { const int e = tok_e[i]; const int dest = tab[1 + e] + tok_slot[i]; row_tok[dest] = i >> 1; row_w[dest] = tok_w[i]; tok_slot[i] = dest; }
    const int gt = F.blk * NTHR + F.tid;
    if (gt < 2048) { const int e = gt >> 8; const int c = (int)__hip_atomic_load(&ectl[e], __ATOMIC_RELAXED, __HIP_MEMORY_SCOPE_AGENT); const int r = c + (gt & 255);
        if (r < ((c + 255) & ~255)) { row_tok[tab[1 + e] + r] = -1; row_w[tab[1 + e] + r] = 0.f; } }
}
constexpr int LDS_GTAB = RING_BYTES;
__device__ __forceinline__ void moe_gather_table(const Frame& F, int ncol) {
    const LAS int* tab = (const LAS int*)(F.lds + LDS_TAB); LAS unsigned* gt = (LAS unsigned*)(F.lds + LDS_GTAB);
    const int* row_tok = (const int*)(F.ws + WS_TOK) + 6 * MTOK; const int total = tab[0] * ncol;
    for (int i = F.tid; i < 9 * 256; i += NTHR) { const int u = i >> 8, r = i & 255; const int L = u * F.G + F.blk; unsigned off = 0u;
        if (L < total) { const int tk = row_tok[(L / ncol) * 256 + r]; off = tk > 0 ? (unsigned)tk * (unsigned)(DM * 2) : 0u; }
        gt[i] = off; }
    __syncthreads();
}

extern __shared__ __attribute__((aligned(16))) unsigned char lds_raw[];
template <class T> __device__ __forceinline__ T* uni(T* p) { const unsigned long long v = (unsigned long long)p; const unsigned lo = __builtin_amdgcn_readfirstlane((unsigned)v), hi = __builtin_amdgcn_readfirstlane((unsigned)(v >> 32)); return (T*)(((unsigned long long)hi << 32) | lo); }
__device__ __forceinline__ int uni(int v) { return __builtin_amdgcn_readfirstlane(v); }
__device__ __forceinline__ Frame mkframe(unsigned char* ws, int wv) {
    Frame F; F.lds = (LAS unsigned char*)lds_raw; int tid = wv * 64 + lane_id_fresh(); F.tid = tid; F.lane = F.tid & 63; F.wave = __builtin_amdgcn_readfirstlane(F.tid >> 6);
    int blk = blockIdx.x; asm volatile("" : "+s"(blk)); F.blk = blk; F.G = gridDim.x; F.vcu = (F.blk & 7) * (F.G >> 3) + (F.blk >> 3); F.gw = F.blk * NWAVES + F.wave; F.ngw = F.G * NWAVES; F.ws = ws; return F;
}
#define PHASE __device__ __forceinline__ void
PHASE f_moe_convert(int wv, unsigned char* ws_, const float* mg, const float* mu, const float* md) {
    unsigned char* ws = uni(ws_); const Frame F = mkframe(ws, wv); Params P; P.in[I_MG] = uni(mg); P.in[I_MU2] = uni(mu); P.in[I_MD] = uni(md); phase_moe_convert(F, P);
}
PHASE f_rms(int wv, unsigned char* ws_, const float* src, const float* gain) { unsigned char* ws = uni(ws_); const Frame F = mkframe(ws, wv); phase_rms<false>(F, uni(src), uni(gain), (bf16_t*)(ws + WS_HN), nullptr, nullptr, nullptr, nullptr, nullptr); }
PHASE f_rms_moe(int wv, unsigned char* ws_, const float* src, const float* gain, const float* router) {
    unsigned char* ws = uni(ws_); const Frame F = mkframe(ws, wv); int* tok_e = (int*)(ws + WS_TOK); int* tok_slot = tok_e + 2 * MTOK; float* tok_w = (float*)(tok_slot + 2 * MTOK);
    phase_rms<true>(F, uni(src), uni(gain), (bf16_t*)(ws + WS_HN), uni(router), (unsigned*)(ws + WS_CTL) + CW_ECNT, tok_e, tok_slot, tok_w);
}
PHASE f_prep(int wv, unsigned char* ws_, const float* mu, const float* qnorm, const float* kvnorm, int layer_) {
    unsigned char* ws = uni(ws_); const Frame F = mkframe(ws, wv); Params P; P.in[I_MU] = uni(mu); P.in[I_QNORM] = uni(qnorm); P.in[I_KVNORM] = uni(kvnorm); (void)layer_; phase_prep(F, P, 0);
}
PHASE f_ret_scan(int wv, unsigned char* ws_) { unsigned char* ws = uni(ws_); const Frame F = mkframe(ws, wv); ret_scan(F); }
PHASE f_ret_out(int wv, unsigned char* ws_) { unsigned char* ws = uni(ws_); const Frame F = mkframe(ws, wv); ret_out(F); }
PHASE f_rwkv_seq(int wv, unsigned char* ws_, const float* mu, const float* kk, const float* ka, const float* rk, const float* lnx, int layer_) {
    unsigned char* ws = uni(ws_); const Frame F = mkframe(ws, wv); Params P; P.in[I_MU] = uni(mu); P.in[I_KK] = uni(kk); P.in[I_KA] = uni(ka); P.in[I_RK] = uni(rk); P.in[I_LNX] = uni(lnx);
    (void)layer_; rwkv_seq(F, P, 0, F.blk >> 3, F.blk & 7);
}
PHASE f_rwkv_pre(int wv, unsigned char* ws_, const float* mu, const float* kk, const float* ka, const float* rk) { unsigned char* ws = uni(ws_); const Frame F = mkframe(ws, wv); rwkv_chunk_pre(F, uni(mu), uni(kk), uni(ka), uni(rk)); }
PHASE f_rwkv_scan(int wv, unsigned char* ws_) { unsigned char* ws = uni(ws_); const Frame F = mkframe(ws, wv); rwkv_scan<true>(F, F.blk >> 3, F.blk & 7);
#ifdef SCAN_TWICE
    __syncthreads(); rwkv_scan<false>(F, F.blk >> 3, F.blk & 7);
#endif
}
PHASE f_rwkv_out(int wv, unsigned char* ws_, const float* lnx) { unsigned char* ws = uni(ws_); const Frame F = mkframe(ws, wv); rwkv_out(F, uni(lnx)); }
PHASE f_attn(int wv, unsigned char* ws_, int layer_) {
    unsigned char* ws = uni(ws_); const int layer = uni(layer_); const Frame F = mkframe(ws, wv);
    unsigned* qh = (unsigned*)(ws + WS_CTL) + CW_ATTQ + layer * 512; volatile LAS unsigned* slot = (volatile LAS unsigned*)(F.lds + LDSCTL_OFF + 32);
    const int my = (int)(xb_xcc_id() & 7u);
    for (int k = 0; k < 8; ++k) { const int q = (my + k) & 7;
        for (;;) {
            if (F.tid == 0) *slot = __hip_atomic_fetch_add(qh + q * 64, 1u, __ATOMIC_RELAXED, __HIP_MEMORY_SCOPE_AGENT);
            __syncthreads();
            const int idx = (int)*slot;
            __syncthreads();
            if (idx >= 64) break;
            const int bh = 2 * q + (idx & 1), qt = 31 - (idx >> 1);
            attn_unit(F, bh >> 3, bh & 7, qt);
        } }
}
PHASE f_moe_scatter(int wv, unsigned char* ws_) { unsigned char* ws = uni(ws_); const Frame F = mkframe(ws, wv); moe_table(F, (unsigned*)(ws + WS_CTL) + CW_ECNT); phase_moe_scatter(F, (unsigned*)(ws + WS_CTL) + CW_ECNT); }
PHASE f_final(int wv, unsigned char* ws_, float* h, const float* gain) { unsigned char* ws = uni(ws_); const Frame F = mkframe(ws, wv); phase_final(F, uni(h), uni(gain), (const bf16_t*)(ws + WS_OUT2), (const int*)(ws + WS_TOK) + 2 * MTOK); }
PHASE g_inproj(int wv, unsigned char* ws_, int layer_) {
    unsigned char* ws = uni(ws_); const int layer = uni(layer_); const Frame F = mkframe(ws, wv);
    SchedGrid S; S.init(64, 18, F.G, F.blk, ws + WS_HN, (size_t)256 * DM * 2, (bf16_t*)(ws + WS_WIN) + (size_t)layer * WIN_ROWS * DM, (size_t)256 * DM * 2);
    EpiStore E; E.O = (bf16_t*)(ws + WS_P); E.ld = PW; E.SS = (const float*)(ws + WS_SS); E.rl = (LAS float*)(F.lds + RING_BYTES); E.tid = F.tid; pg8::gemm_phase(F.lds, F.tid, DM, DM, DM, S, E);
}
PHASE g_lora(int wv, unsigned char* ws_, const float* w0, const float* a0, int layer_) {
    unsigned char* ws = uni(ws_); const int layer = uni(layer_); const Frame F = mkframe(ws, wv);
    SchedGrid S; S.init(64, 6, F.G, F.blk, ws + WS_LIN, (size_t)256 * LORA_K * 2, (bf16_t*)(ws + WS_LORA) + (size_t)layer * 1536 * LORA_K, (size_t)256 * LORA_K * 2);
    EpiLora E; E.O = (bf16_t*)(ws + WS_LO); E.w0 = uni(w0); E.a0 = uni(a0); pg8::gemm_phase(F.lds, F.tid, LORA_K, LORA_K, LORA_K, S, E);
}
PHASE g_small(int wv, unsigned char* ws_, int layer_) {
    unsigned char* ws = uni(ws_); const Frame F = mkframe(ws, wv); SchedSmall S; S.G = F.G; S.c = F.blk; S.layer = uni(layer_); S.ws = (const char*)ws; EpiSmall E; E.ws = ws; pg8::gemm_phase(F.lds, F.tid, 256, 256, 256, S, E);
}
PHASE g_gate(int wv, unsigned char* ws_, int layer_) {
    unsigned char* ws = uni(ws_); const int layer = uni(layer_); const Frame F = mkframe(ws, wv);
    SchedOwn3 S; S.c = F.blk; S.G = F.G; S.A = (const char*)(ws + WS_HN); S.a_n = 0; S.astep = (size_t)256 * DM * 2; S.B = (const char*)((bf16_t*)(ws + WS_WIN) + ((size_t)layer * WIN_ROWS + PW) * DM); S.bstep = (size_t)256 * DM * 2; S.b_n = (size_t)1024 * DM * 2;
    EpiGate E; E.O = (bf16_t*)(ws + WS_G); E.SS = (const float*)(ws + WS_SS); E.rl = (LAS float*)(F.lds + RING_BYTES); E.tid = F.tid; pg8::gemm_phase(F.lds, F.tid, DM, DM, DM, S, E);
}
PHASE g_merge(int wv, unsigned char* ws_, int layer_) {
    unsigned char* ws = uni(ws_); const int layer = uni(layer_); const Frame F = mkframe(ws, wv);
    SchedOwn3 S; S.c = F.blk; S.G = F.G; S.A = (const char*)(ws + WS_YRET); S.a_n = (size_t)16 * MiB; S.astep = (size_t)256 * 512 * 2;
    S.B = (const char*)((bf16_t*)(ws + WS_BR) + (size_t)layer * 3 * 1024 * 512); S.bstep = (size_t)256 * 512 * 2; S.b_n = (size_t)1024 * 512 * 2;
    EpiMerge E; E.Gt = (const bf16_t*)(ws + WS_G); E.Mg = (bf16_t*)(ws + WS_MRG); pg8::gemm_phase(F.lds, F.tid, 512, 512, 512, S, E);
}
template <bool EMIT>
PHASE g_wo(int wv, unsigned char* ws_, const float* hin, float* hout, const float* gain, int layer_) {
    unsigned char* ws = uni(ws_); const int layer = uni(layer_); const Frame F = mkframe(ws, wv);
    SchedGrid S; S.init(64, 4, F.G, F.blk, ws + WS_MRG, (size_t)256 * DM * 2, (bf16_t*)(ws + WS_WO) + (size_t)layer * DM * DM, (size_t)256 * DM * 2);
    EpiResid<EMIT> E; E.In = uni(hin); E.Out = uni(hout); E.gain = uni(gain); E.Hg = (bf16_t*)(ws + WS_HN); E.SS = (float*)(ws + WS_SS); pg8::gemm_phase(F.lds, F.tid, DM, DM, DM, S, E);
}
PHASE g_ffn_gu(int wv, unsigned char* ws_) {
    unsigned char* ws = uni(ws_); const Frame F = mkframe(ws, wv);
    SchedGrid S; S.init(64, 22, F.G, F.blk, ws + WS_HN, (size_t)256 * DM * 2, ws + WS_FGU, (size_t)256 * DM * 2);
    EpiSwiglu E; E.O = (bf16_t*)(ws + WS_ACT); E.ldc = DFF; E.pn_off = 0; E.SS = (const float*)(ws + WS_SS); E.rl = (LAS float*)(F.lds + RING_BYTES); E.tid = F.tid; pg8::gemm_phase(F.lds, F.tid, DM, DM, DM, S, E);
}
PHASE g_ffn_down(int wv, unsigned char* ws_, float* h, const float* gain) {
    unsigned char* ws = uni(ws_); const Frame F = mkframe(ws, wv);
    SchedGrid S; S.init(64, 4, F.G, F.blk, ws + WS_ACT, (size_t)256 * DFF * 2, ws + WS_FD, (size_t)256 * DFF * 2);
    EpiResid<true> E; E.In = uni(h); E.Out = (float*)E.In; E.gain = uni(gain); E.Hg = (bf16_t*)(ws + WS_HN); E.SS = (float*)(ws + WS_SS); pg8::gemm_phase(F.lds, F.tid, DFF, DFF, DFF, S, E);
}
PHASE g_moe_gu(int wv, unsigned char* ws_, int hh_) {
    unsigned char* ws = uni(ws_); const int hh = uni(hh_); const Frame F = mkframe(ws, wv); const LAS int* tab = (const LAS int*)(F.lds + LDS_TAB);
    moe_gather_table(F, 14);
    SchedMoe S; S.G = F.G; S.c = F.blk; S.ncol = 14; S.ntile = tab[0]; S.tab = tab + 16; S.A = (const char*)(ws + WS_HN); S.astep = 0;
    S.B = (const char*)(ws + WS_MGU) + (size_t)hh * 14 * 256 * DM * 2; S.bstep = (size_t)256 * DM * 2; S.estep = (size_t)2 * DFFE * DM * 2;
    EpiSwiglu E; E.O = (bf16_t*)(ws + WS_MACT); E.ldc = DFFH; E.pn_off = 0; E.SS = nullptr; E.rl = nullptr; E.tid = 0; pg8::gemm_phase<EpiSwiglu, SchedMoe, true>(F.lds, F.tid, DM, DM, DM, S, E, (const LAS unsigned*)(F.lds + LDS_GTAB));
}
template <bool ACCUM>
PHASE g_moe_down(int wv, unsigned char* ws_, int hh_) {
    unsigned char* ws = uni(ws_); const int hh = uni(hh_); const Frame F = mkframe(ws, wv); const LAS int* tab = (const LAS int*)(F.lds + LDS_TAB);
    const float* row_w = (const float*)((const int*)(ws + WS_TOK) + 6 * MTOK + MAXROWS);
    SchedMoe S; S.G = F.G; S.c = F.blk; S.ncol = 4; S.ntile = tab[0]; S.tab = tab + 16; S.A = (const char*)(ws + WS_MACT); S.astep = (size_t)256 * DFFH * 2;
    S.B = (const char*)(ws + WS_MD) + (size_t)hh * DFFH * 2; S.bstep = (size_t)256 * DFFE * 2; S.estep = (size_t)DM * DFFE * 2;
    EpiMoeOut<ACCUM> E; E.row_w = row_w; E.O = (bf16_t*)(ws + WS_OUT2); pg8::gemm_phase(F.lds, F.tid, DFFH, DFFH, DFFE, S, E);
}

typedef const __attribute__((address_space(4))) Params* KPtr;
__device__ __forceinline__ KPtr kargs() { KPtr k = (KPtr)__builtin_amdgcn_kernarg_segment_ptr(); asm volatile("" : "+s"(k)); return k; }
#define KIN(i) (kargs()->in[i])
#define KWS() (kargs()->ws)
struct TpState { unsigned long long tp0, tp1; int tpk; };
#define tp0 tps.tp0
#define tp1 tps.tp1
#define tpk tps.tpk
#define GRID_BAR() do { XcdBarrier b_ = bar; b_.bar = (unsigned*)(KWS() + WS_CTL) + CW_BAR; b_.x = xb_xcc_id(); xcd_barrier(b_); } while (0)
#ifdef TPH
#define TP(k) do { if ((k) == TPH) tp0 = __builtin_amdgcn_s_memrealtime(); if ((k) == TPH + TPN) tp1 = __builtin_amdgcn_s_memrealtime(); } while (0)
#define TPM() do { ++tpk; TP(tpk); } while (0)
#else
#define TP(k) do { } while (0)
#define TPM() do { } while (0)
#endif
template <int layer>
__device__ __forceinline__ void layer_body(const int wv, const XcdBarrier& bar, TpState& tps) {
        g_inproj(wv, KWS(), layer);
        GRID_BAR();
        TPM();
        f_prep(wv, KWS(), KIN(I_MU) + (size_t)layer * RWKV_COLS, KIN(I_QNORM) + layer * 256, KIN(I_KVNORM) + layer * 128, layer);
        GRID_BAR();
        TPM();
        f_ret_scan(wv, KWS());
        g_lora(wv, KWS(), KIN(I_W0) + layer * 512, KIN(I_A0) + layer * 512, layer);
        g_small(wv, KWS(), layer);
        GRID_BAR();
        TPM();
        f_ret_out(wv, KWS());
#ifdef SPLIT5
        GRID_BAR();
        TPM();
#endif
#ifndef RWKV_SEQ
        f_rwkv_pre(wv, KWS(), KIN(I_MU) + (size_t)layer * RWKV_COLS, KIN(I_KK) + layer * 512, KIN(I_KA) + layer * 512, KIN(I_RK) + layer * 512);
        GRID_BAR();
        TPM();
        if ((int)blockIdx.x < 16) f_rwkv_scan(wv, KWS());
#ifdef SPLIT6
        GRID_BAR();
        TPM();
#endif
#else
        GRID_BAR();
        TPM();
        if (blockIdx.x < 16) f_rwkv_seq(wv, KWS(), KIN(I_MU) + (size_t)layer * RWKV_COLS, KIN(I_KK) + layer * 512, KIN(I_KA) + layer * 512, KIN(I_RK) + layer * 512, KIN(I_LNX) + layer * 512, layer);
#endif
        f_attn(wv, KWS(), layer);
        GRID_BAR();
        TPM();
#ifndef RWKV_SEQ
        f_rwkv_out(wv, KWS(), KIN(I_LNX) + layer * 512);
#endif
        g_gate(wv, KWS(), layer);
#ifndef RWKV_SEQ
        GRID_BAR();
        TPM();
#endif
        g_merge(wv, KWS(), layer);
        GRID_BAR();
        TPM();
        g_wo<layer == 0>(wv, KWS(), layer == 0 ? KIN(I_X) : (const float*)kargs()->out, kargs()->out, KIN(I_FNORM) + layer * DM, layer);
        GRID_BAR();
        TPM();
        if constexpr (layer == 0) {
            g_ffn_gu(wv, KWS());
            GRID_BAR();
            TPM();
            g_ffn_down(wv, KWS(), kargs()->out, KIN(I_ANORM) + DM);
            GRID_BAR();
            TPM();
        } else {
            f_rms_moe(wv, KWS(), kargs()->out, KIN(I_FNORM) + layer * DM, KIN(I_ROUTER));
            GRID_BAR();
            TPM();
            f_moe_scatter(wv, KWS());
            f_moe_convert(wv, KWS(), KIN(I_MG), KIN(I_MU2), KIN(I_MD));
            GRID_BAR();
            TPM();
            g_moe_gu(wv, KWS(), 0);
            GRID_BAR();
            TPM();
            g_moe_down<false>(wv, KWS(), 0);
            GRID_BAR();
            TPM();
            g_moe_gu(wv, KWS(), 1);
            GRID_BAR();
            TPM();
            g_moe_down<true>(wv, KWS(), 1);
            GRID_BAR();
            TPM();
        }
    }
__global__ void __launch_bounds__(NTHR, 2) mega(Params P_unused) {
    LAS unsigned char* lds = (LAS unsigned char*)lds_raw;
    const int wv = __builtin_amdgcn_readfirstlane((int)threadIdx.x >> 6);
    for (int u = threadIdx.x; u < (LDS_BYTES - LDSCTL_OFF) / 4; u += NTHR) ((LAS unsigned*)(lds + LDSCTL_OFF))[u] = 0u;
    __syncthreads();
    const XcdBarrier bar = xcd_barrier_post((unsigned*)(KWS() + WS_CTL) + CW_BAR, (volatile LAS unsigned*)(lds + LDSCTL_OFF), wv);
    TpState tps = {0ull, 0ull, 0};
    TP(0);
    {
        KPtr k = kargs(); unsigned char* ws = k->ws; const Frame F = mkframe(ws, wv);
        Params P; P.in[I_WIN] = k->in[I_WIN]; P.in[I_WQB] = k->in[I_WQB]; P.in[I_WBR] = k->in[I_WBR]; P.in[I_WO] = k->in[I_WO]; P.in[I_FG] = k->in[I_FG]; P.in[I_FU] = k->in[I_FU]; P.in[I_FD] = k->in[I_FD];
        P.in[I_W2] = k->in[I_W2]; P.in[I_A2] = k->in[I_A2]; P.in[I_G2] = k->in[I_G2]; P.in[I_WKVB] = k->in[I_WKVB]; P.in[I_POS] = k->in[I_POS]; P.in[I_X] = k->in[I_X]; P.in[I_ANORM] = k->in[I_ANORM];
        phase_prologue(F, P);
    }
    GRID_BAR();
    TPM();
    layer_body<0>(wv, bar, tps);
    layer_body<1>(wv, bar, tps);
    f_final(wv, KWS(), kargs()->out, KIN(I_FINAL));
#ifdef TPH
    __syncthreads(); TPM();
    { const unsigned long long te = __builtin_amdgcn_s_memrealtime(), span = (tp1 - tp0) * (unsigned long long)TAMP; while (__builtin_amdgcn_s_memrealtime() - te < span) __builtin_amdgcn_s_sleep(8); }
#endif
}

extern "C" void kernel_launch(void* const* d_in, const int* in_sizes, int n_in, void* d_out, int out_size, void* d_ws, size_t ws_size, hipStream_t stream) {
    static int ready = 0;
    if (!ready) {
        if (n_in != 29 || out_size != MTOK * DM || ws_size < WS_END) { fprintf(stderr, "kernel_launch: unexpected shapes (n_in %d out %d ws %zu need %zu)\n", n_in, out_size, ws_size, (size_t)WS_END); ready = -1; return; }
        if (hipFuncSetAttribute((const void*)mega, hipFuncAttributeMaxDynamicSharedMemorySize, LDS_BYTES) != hipSuccess) { fprintf(stderr, "kernel_launch: hipFuncSetAttribute failed\n"); ready = -1; return; }
        int dev = 0, cus = 0, per_cu = 0; (void)hipGetDevice(&dev); (void)hipDeviceGetAttribute(&cus, hipDeviceAttributeMultiprocessorCount, dev);
        (void)hipOccupancyMaxActiveBlocksPerMultiprocessor(&per_cu, (const void*)mega, NTHR, LDS_BYTES);
        if (cus < 256 || per_cu < 1) { fprintf(stderr, "kernel_launch: needs 256 CUs with one resident workgroup each (cus %d, per_cu %d)\n", cus, per_cu); ready = -1; return; }
        ready = 1;
    }
    if (ready < 0) return;
    (void)hipMemsetAsync((char*)d_ws + WS_CTL, 0, CTL_BYTES, stream);
    Params p{}; for (int i = 0; i < 29; ++i) p.in[i] = (const float*)d_in[i]; p.out = (float*)d_out; p.ws = (unsigned char*)d_ws;
    hipLaunchKernelGGL(mega, dim3(256), dim3(NTHR), LDS_BYTES, stream, p);
}
```

```cpp
#include <hip/hip_runtime.h>
#include <cstdio>
#include <cstdint>

#define LAS __attribute__((address_space(3)))
#define GAS __attribute__((address_space(1)))
typedef unsigned short bf16_t;
typedef short bf16x8 __attribute__((ext_vector_type(8)));
typedef short bf16x4 __attribute__((ext_vector_type(4)));
typedef float f32x4 __attribute__((ext_vector_type(4)));
typedef float f32x2 __attribute__((ext_vector_type(2)));
typedef float f32x16 __attribute__((ext_vector_type(16)));
typedef unsigned u32x4 __attribute__((ext_vector_type(4)));
typedef unsigned u32x2 __attribute__((ext_vector_type(2)));

constexpr int NB = 2, SEQ = 8192, DM = 1024, MTOK = NB * SEQ, NLAYER = 2, CH = 64, NCHUNK = SEQ / CH;
constexpr int IN_COLS = 7360, PW = 4608;
constexpr int P_RQ = 0, P_RK = 512, P_RV = 1024, P_RG = 1536, P_RW = 2048, P_QA = 4096, P_KVA = 4352;
constexpr int WIN_ROWS = 7680;
constexpr int RWKV_COLS = 1824, LORA_K = 384, LO_W = 1536;
constexpr int DFF = 2816, DFFE = 3584, NEXP = 8, DFFH = DFFE / 2;
constexpr int MAXROWS = 34816;
constexpr float NORM_EPS = 1e-6f;

constexpr size_t MiB = 1u << 20;
constexpr size_t WS_CTL = 0, CTL_BYTES = 1 * MiB;
constexpr size_t WS_WIN = 1 * MiB;
constexpr size_t WS_LORA = 31 * MiB;
constexpr size_t WS_QB = 34 * MiB;
constexpr size_t WS_KB = 35 * MiB;
constexpr size_t WS_VB = 35 * MiB + 512 * 1024;
constexpr size_t WS_BR = 36 * MiB;
constexpr size_t WS_WO = 42 * MiB;
constexpr size_t WS_FGU = 46 * MiB;
constexpr size_t WS_FD = 57 * MiB;
constexpr size_t WS_COSR = 63 * MiB, WS_SINR = 67 * MiB, WS_COSM = 71 * MiB, WS_SINM = 72 * MiB;
constexpr size_t WS_HN = 73 * MiB;
constexpr size_t WS_TOK = 105 * MiB;
constexpr size_t WS_T = 106 * MiB;
constexpr size_t WS_P = WS_T;
constexpr size_t WS_G = WS_T;
constexpr size_t WS_MRG = WS_T + 96 * MiB;
constexpr size_t WS_LO = WS_T + 144 * MiB;
constexpr size_t WS_Q = WS_T + 192 * MiB;
constexpr size_t WS_KN = WS_T + 216 * MiB;
constexpr size_t WS_VT = WS_T + 232 * MiB;
constexpr size_t WS_KPE = WS_T + 248 * MiB;
constexpr size_t WS_LIN = WS_T + 249 * MiB;
constexpr size_t WS_QN = WS_T + 261 * MiB;
constexpr size_t WS_CN = WS_T + 269 * MiB;
constexpr size_t WS_YRET = WS_T + 261 * MiB;
constexpr size_t WS_RS = WS_T + 277 * MiB;
constexpr size_t WS_YRW = WS_T + 277 * MiB;
constexpr size_t WS_YMLA = WS_T + 293 * MiB;
constexpr size_t WS_RC = WS_T + 309 * MiB;
constexpr size_t WS_ACT = WS_T;
constexpr size_t WS_MGU = WS_T;
constexpr size_t WS_MD = WS_T + 112 * MiB;
constexpr size_t WS_MACT = WS_T + 168 * MiB;
constexpr size_t WS_OUT2 = WS_T + 287 * MiB;
constexpr size_t WS_SS = WS_T + 390 * MiB;
constexpr size_t WS_END = WS_T + 391 * MiB;
static_assert(WS_MACT + (size_t)MAXROWS * DFFH * 2 <= WS_OUT2 && WS_OUT2 + (size_t)MAXROWS * DM * 2 <= WS_END, "ws map");
constexpr int CW_BAR = 4096;
constexpr int CW_ECNT = 16384;
constexpr int CW_ATTQ = 20480;

__device__ __forceinline__ unsigned f2bf(float f) { unsigned u = __builtin_bit_cast(unsigned, f); return (u + 0x7fffu + ((u >> 16) & 1u)) >> 16; }
typedef __bf16 bf16n2 __attribute__((ext_vector_type(2)));
__device__ __forceinline__ unsigned pk2(float lo, float hi) { const f32x2 f = {lo, hi}; const bf16n2 v = __builtin_convertvector(f, bf16n2); return __builtin_bit_cast(unsigned, v); }
__device__ __forceinline__ float bf2f(unsigned short h) { return __builtin_bit_cast(float, (unsigned)h << 16); }
__device__ __forceinline__ float bflo(unsigned w) { return __builtin_bit_cast(float, w << 16); }
__device__ __forceinline__ float bfhi(unsigned w) { return __builtin_bit_cast(float, w & 0xffff0000u); }
template <int CTRL, int ROWMASK = 0xF>
__device__ __forceinline__ float dpp_add(float v) { const int t = __builtin_amdgcn_update_dpp(0, __builtin_bit_cast(int, v), CTRL, ROWMASK, 0xF, ROWMASK == 0xF); return v + __builtin_bit_cast(float, t); }
#ifdef NO_DPP
__device__ __forceinline__ float sum4(float v)  { v += __shfl_xor(v, 1); v += __shfl_xor(v, 2); return v; }
__device__ __forceinline__ float sum8(float v)  { v = sum4(v); v += __shfl_xor(v, 4); return v; }
__device__ __forceinline__ float sum16(float v) { v = sum8(v); v += __shfl_xor(v, 8); return v; }
__device__ __forceinline__ float wave_sum(float v) { v = sum16(v); v += __shfl_xor(v, 16); v += __shfl_xor(v, 32); return v; }
#else
__device__ __forceinline__ float sum4(float v)  { v = dpp_add<0xB1>(v); return dpp_add<0x4E>(v); }
__device__ __forceinline__ float sum8(float v)  { return dpp_add<0x141>(sum4(v)); }
__device__ __forceinline__ float sum16(float v) { return dpp_add<0x140>(sum8(v)); }
__device__ __forceinline__ float wave_sum(float v) {
    v = sum16(v); v = dpp_add<0x142, 0xA>(v); v = dpp_add<0x143, 0xC>(v);
    return __builtin_bit_cast(float, __builtin_amdgcn_readlane(__builtin_bit_cast(int, v), 63));
}
#endif
__device__ __forceinline__ float sigmoidf_(float x) { return 1.0f / (1.0f + __expf(-x)); }
#define LDS_WAIT() asm volatile("s_waitcnt lgkmcnt(0)" ::: "memory")
#define LBAR() do { asm volatile("s_waitcnt lgkmcnt(0)" ::: "memory"); __builtin_amdgcn_s_barrier(); asm volatile("" ::: "memory"); } while (0)
#define VM_WAIT() asm volatile("s_waitcnt vmcnt(0)" ::: "memory")

#define XB_TMO      128
#define XB_XCNT(j)  (256  + 64 * (j))
#define XB_XSUB(j)  (1280 + 64 * (j))
#define XB_XGEN(j)  (2304 + 64 * (j))
#define XB_TOP      3328
#define XB_TOPGEN   3392
#define XCD_BAR_WORDS 3456
#define XB_SPIN_CAP (1u << 18)
__device__ __forceinline__ unsigned xb_ld(unsigned* p)              { return __hip_atomic_load(p, __ATOMIC_RELAXED, __HIP_MEMORY_SCOPE_AGENT); }
__device__ __forceinline__ unsigned xb_add(unsigned* p, unsigned v) { return __hip_atomic_fetch_add(p, v, __ATOMIC_RELAXED, __HIP_MEMORY_SCOPE_AGENT); }
__device__ __forceinline__ unsigned xb_xcc_id() { return (unsigned)__builtin_amdgcn_s_getreg((3 << 11) | 20) & 0xFu; }
#define XB_SPIN(cond, bar) do { unsigned _sp = 0; while (cond) { __builtin_amdgcn_s_sleep(1); \
    if ((++_sp & 255u) == 0u) { if (xb_ld(&(bar)[XB_TMO])) break; if (_sp > XB_SPIN_CAP) { atomicAdd(&(bar)[XB_TMO], 1u); break; } } } } while (0)
struct XcdBarrier { unsigned* bar; unsigned x; volatile LAS unsigned* st; int wv; };
__device__ __forceinline__ int lane_id_fresh() { int l; asm volatile("v_mbcnt_lo_u32_b32 %0, -1, 0\n\tv_mbcnt_hi_u32_b32 %0, -1, %0" : "=v"(l)); return l; }
__device__ __forceinline__ bool xb_thread0(int wv) { return wv == 0 && lane_id_fresh() == 0; }
__device__ __forceinline__ XcdBarrier xcd_barrier_post(unsigned* bar, volatile LAS unsigned* st, int wv) {
    XcdBarrier b; b.bar = bar; b.x = xb_xcc_id(); b.st = st; b.wv = wv;
    if (xb_thread0(wv)) (void)xb_add(&bar[XB_XCNT(b.x)], 1u);
    return b;
}
__device__ __forceinline__ void xcd_barrier_complete(unsigned* bar, unsigned x, unsigned& nloc, unsigned& nx) {
    const unsigned G = gridDim.x * gridDim.y * gridDim.z;
    unsigned sum, cnt, mine, sp = 0u;
    for (;;) {
        sum = 0u; cnt = 0u; mine = 0u;
#pragma unroll
        for (unsigned j = 0; j < 16; ++j) { const unsigned c = xb_ld(&bar[XB_XCNT(j)]); sum += c; cnt += (c > 0u) ? 1u : 0u; mine = (j == x) ? c : mine; }
        if (sum == G) break;
        __builtin_amdgcn_s_sleep(1);
        if ((++sp & 255u) == 0u) { if (xb_ld(&bar[XB_TMO])) break; if (sp > XB_SPIN_CAP) { atomicAdd(&bar[XB_TMO], 1u); break; } }
    }
    nloc = mine > 0u ? mine : 1u; nx = cnt > 0u ? cnt : 1u;
}
__device__ __forceinline__ void xcd_barrier(const XcdBarrier& b) {
    asm volatile("s_waitcnt vmcnt(0)" ::: "memory");
    __syncthreads();
    if (xb_thread0(b.wv)) {
        unsigned* bar = b.bar;
        __builtin_amdgcn_s_waitcnt(0);
        unsigned nloc = b.st[0], nx = b.st[1];
        if (nloc == 0u) { xcd_barrier_complete(bar, b.x, nloc, nx); b.st[0] = nloc; b.st[1] = nx; }
        const unsigned old = xb_add(&bar[XB_XSUB(b.x)], 1u);
        const unsigned gen = old / nloc;
        if (old + 1u == (gen + 1u) * nloc) {
            __builtin_amdgcn_fence(__ATOMIC_RELEASE, "agent");
            asm volatile("s_waitcnt vmcnt(0)" ::: "memory");
            const unsigned og = xb_add(&bar[XB_TOP], 1u);
            const unsigned tg = og / nx;
            if (og + 1u == (tg + 1u) * nx) xb_add(&bar[XB_TOPGEN], 1u);
            else XB_SPIN(xb_ld(&bar[XB_TOPGEN]) == tg, bar);
            __builtin_amdgcn_fence(__ATOMIC_ACQUIRE, "agent");
            xb_add(&bar[XB_XGEN(b.x)], 1u);
            asm volatile("s_waitcnt vmcnt(0)" ::: "memory");
        } else {
            XB_SPIN(xb_ld(&bar[XB_XGEN(b.x)]) == gen, bar);
            __builtin_amdgcn_fence(__ATOMIC_ACQUIRE, "agent");
            asm volatile("s_waitcnt vmcnt(0)" ::: "memory");
        }
    }
    __syncthreads();
}

namespace pg8 {
constexpr int BM = 256, BK = 64, HALF = 128, HTB = HALF * BK * 2, STAGE_BYTES = 8 * HTB;
__device__ __forceinline__ int lds_byte(int r, int c) { const int st = (r >> 4) * 2 + (c >> 5), rr = r & 15, cc = c & 31, ob = rr * 64 + cc * 2; return st * 1024 + (ob ^ (((ob >> 9) & 1) << 5)); }
__device__ __forceinline__ void stage_rc(int b, int& R, int& C) { const int st = b / 1024, sb = b % 1024, swz = sb ^ (((sb >> 9) & 1) << 5); R = (st >> 1) * 16 + swz / 64; C = (st & 1) * 32 + (swz % 64) / 2; }
__device__ __forceinline__ int perm32(int rho) { const int n = rho >> 4, i = rho & 15; return 8 * (i >> 2) + 4 * n + (i & 3); }
struct Unit { int pm, pn, aux; const char* A; const char* B; };
__device__ __forceinline__ unsigned cvt_pk_bf16(float lo, float hi) { return pk2(lo, hi); }

template <class Epi, class Sched, bool GATHER = false>
__device__ __forceinline__ void gemm_phase(LAS unsigned char* lds, const int tid_in, const int K, const int lda, const int ldb, const Sched& S, const Epi& E, const LAS unsigned* gtab = nullptr) {
    int tid_ = tid_in; asm volatile("" : "+v"(tid_));
    const int tid = tid_, wid = __builtin_amdgcn_readfirstlane(tid >> 6), lane = tid & 63, wr = wid >> 2, wc = wid & 3, fr = lane & 15, fq = lane >> 4;
    const int nt = K / BK;
    unsigned voffA[2], voffB[2];
#pragma unroll
    for (int i = 0; i < 2; ++i) { int R, C; stage_rc(tid * 16 + i * 8192, R, C); const int Rb = Epi::PERM ? ((R & ~31) + perm32(R & 31)) : R;
        voffA[i] = (unsigned)(R * lda + C) * 2u; voffB[i] = (unsigned)(Rb * ldb + C) * 2u; }
    const size_t kstep = (size_t)(BK * 2);
    const size_t hstepA = GATHER ? (size_t)0 : (size_t)HALF * lda * 2, hstepB = (size_t)HALF * ldb * 2;
    int gR[2], gC[2]; unsigned gcur[2][2], gnxt[2][2];
    if constexpr (GATHER) {
#pragma unroll
        for (int i = 0; i < 2; ++i) { int R, C; stage_rc(tid * 16 + i * 8192, R, C); gR[i] = R; gC[i] = C * 2; }
    }
#define PG8_GLOAD(dst, u_) do { _Pragma("unroll") for (int _h = 0; _h < 2; ++_h) _Pragma("unroll") for (int _i = 0; _i < 2; ++_i) dst[_h][_i] = gtab[(u_) * 256 + _h * 128 + gR[_i]] + (unsigned)gC[_i]; } while (0)
    const unsigned ldsw = (unsigned)wid * 1024u;
    const int aoff = lds_byte(wr * 64 + fr, fq * 8), boff = lds_byte(wc * 32 + fr, fq * 8);
#define PG8_SA(b, h) (((b) * 2 + (h)) * HTB)
#define PG8_SB(b, h) ((4 + (b) * 2 + (h)) * HTB)
#define PG8_STAGE(bufoff, gbase, voff) do { _Pragma("unroll") for (int _i = 0; _i < 2; ++_i) \
        __builtin_amdgcn_global_load_lds((const unsigned*)((const char*)(gbase) + (voff)[_i]), (LAS unsigned*)(lds + (bufoff) + ldsw + _i * 8192), 16, 0, 0); } while (0)
#define PG8_STAGEA(bufoff, gbase, h, tab) do { if constexpr (GATHER) { PG8_STAGE(bufoff, gbase, tab[h]); } else { PG8_STAGE(bufoff, (gbase) + (h) * hstepA, voffA); } } while (0)
#define PG8_LDA(dst, b, h) do { _Pragma("unroll") for (int m = 0; m < 4; ++m) _Pragma("unroll") for (int k = 0; k < 2; ++k) dst[m][k] = *(const LAS bf16x8*)(lds + PG8_SA(b, h) + aoff + m * 2048 + k * 1024); } while (0)
#define PG8_LDB(dst, b, h) do { _Pragma("unroll") for (int n = 0; n < 2; ++n) _Pragma("unroll") for (int k = 0; k < 2; ++k) dst[n][k] = *(const LAS bf16x8*)(lds + PG8_SB(b, h) + boff + n * 2048 + k * 1024); } while (0)
#define PG8_MMA(ai, bj, At, Bt) do { __builtin_amdgcn_s_setprio(1); _Pragma("unroll") for (int m = 0; m < 4; ++m) _Pragma("unroll") for (int n = 0; n < 2; ++n) _Pragma("unroll") for (int k = 0; k < 2; ++k) \
        acc[ai][bj][m][n] = __builtin_amdgcn_mfma_f32_16x16x32_bf16(Bt[n][k], At[m][k], acc[ai][bj][m][n], 0, 0, 0); __builtin_amdgcn_s_setprio(0); } while (0)
#define PG8_WAIT_V(n) asm volatile("s_waitcnt vmcnt(" #n ")" ::: "memory")
#define PG8_WAIT_L(n) asm volatile("s_waitcnt lgkmcnt(" #n ")" ::: "memory")
#define PG8_BAR __builtin_amdgcn_s_barrier()
#define PG8_SCHED __builtin_amdgcn_sched_barrier(0)
    Unit cur, nxt; int ui = 0;
    if (!S.next(0, cur)) return;
    f32x4 acc[2][2][4][2];
#pragma unroll
    for (int a = 0; a < 2; ++a)
#pragma unroll
        for (int b = 0; b < 2; ++b)
#pragma unroll
            for (int m = 0; m < 4; ++m)
#pragma unroll
                for (int n = 0; n < 2; ++n) acc[a][b][m][n] = (f32x4){0.f, 0.f, 0.f, 0.f};
    bf16x8 At[4][2], B0[2][2], B1[2][2];
    const char* cA = cur.A; const char* cB = cur.B;
    if constexpr (GATHER) { PG8_GLOAD(gcur, 0); PG8_GLOAD(gnxt, 1); asm volatile("s_waitcnt lgkmcnt(0)" ::: "memory"); }
    PG8_STAGE(PG8_SB(0, 0), cB, voffB); PG8_STAGE(PG8_SB(0, 1), cB + hstepB, voffB); PG8_STAGEA(PG8_SA(0, 0), cA, 0, gcur); PG8_STAGEA(PG8_SA(0, 1), cA, 1, gcur);
    if (wr == 1) PG8_BAR;
    PG8_WAIT_V(2); PG8_BAR;
    PG8_STAGE(PG8_SB(1, 0), cB + kstep, voffB); PG8_STAGEA(PG8_SA(1, 0), cA + kstep, 0, gcur); PG8_STAGE(PG8_SB(1, 1), cB + hstepB + kstep, voffB);
    PG8_WAIT_V(6); PG8_BAR;
#pragma unroll 1
    for (;;) {
        const bool has_next = S.next(ui + 1, nxt);
        const char* nA = has_next ? nxt.A : cA; const char* nB = has_next ? nxt.B : cB;
#pragma unroll 1
        for (int t = 0; t < nt; t += 2) {
            const bool last = (t == nt - 2);
            const char* a1 = cA + (size_t)(t + 1) * kstep;
            const char* a2 = last ? nA : cA + (size_t)(t + 2) * kstep; const char* b2 = last ? nB : cB + (size_t)(t + 2) * kstep;
            const char* a3 = a2 + kstep; const char* b3 = b2 + kstep;
            unsigned g2[2][2];
            if constexpr (GATHER) {
#pragma unroll
                for (int _h = 0; _h < 2; ++_h)
#pragma unroll
                    for (int _i = 0; _i < 2; ++_i) g2[_h][_i] = last ? gnxt[_h][_i] : gcur[_h][_i]; }
            PG8_LDB(B0, 0, 0); PG8_LDB(B1, 0, 1); PG8_SCHED; PG8_LDA(At, 0, 0); PG8_STAGEA(PG8_SA(1, 1), a1, 1, gcur);
            PG8_WAIT_V(8); PG8_WAIT_L(0); PG8_BAR; PG8_MMA(0, 0, At, B0); PG8_MMA(0, 1, At, B1); PG8_BAR; PG8_SCHED;
            PG8_LDA(At, 0, 1); PG8_STAGE(PG8_SB(0, 0), b2, voffB); PG8_STAGE(PG8_SB(0, 1), b2 + hstepB, voffB); PG8_STAGEA(PG8_SA(0, 0), a2, 0, g2);
            PG8_WAIT_V(8); PG8_WAIT_L(0); PG8_BAR; PG8_MMA(1, 0, At, B0); PG8_MMA(1, 1, At, B1); PG8_BAR; PG8_SCHED;
            PG8_LDB(B0, 1, 0); PG8_LDB(B1, 1, 1); PG8_SCHED; PG8_LDA(At, 1, 0); PG8_STAGEA(PG8_SA(0, 1), a2, 1, g2);
            PG8_WAIT_V(8); PG8_WAIT_L(0); PG8_BAR; PG8_MMA(0, 0, At, B0); PG8_MMA(0, 1, At, B1); PG8_BAR; PG8_SCHED;
            PG8_LDA(At, 1, 1); PG8_STAGE(PG8_SB(1, 0), b3, voffB); PG8_STAGE(PG8_SB(1, 1), b3 + hstepB, voffB); PG8_STAGEA(PG8_SA(1, 0), a3, 0, g2);
            PG8_WAIT_V(8); PG8_WAIT_L(0); PG8_BAR; PG8_MMA(1, 0, At, B0); PG8_MMA(1, 1, At, B1); PG8_BAR; PG8_SCHED;
        }
        if (wr == 0) PG8_BAR;
        E(acc, cur, wr, wc, fr, fq);
        if (!has_next) break;
#pragma unroll
        for (int a = 0; a < 2; ++a)
#pragma unroll
            for (int b = 0; b < 2; ++b)
#pragma unroll
                for (int m = 0; m < 4; ++m)
#pragma unroll
                    for (int n = 0; n < 2; ++n) acc[a][b][m][n] = (f32x4){0.f, 0.f, 0.f, 0.f};
        cur = nxt; cA = nA; cB = nB; ++ui;
        if constexpr (GATHER) {
#pragma unroll
            for (int _h = 0; _h < 2; ++_h)
#pragma unroll
                for (int _i = 0; _i < 2; ++_i) gcur[_h][_i] = gnxt[_h][_i];
            PG8_GLOAD(gnxt, ui + 1); }
        if (wr == 1) PG8_BAR;
    }
    PG8_WAIT_V(0);
    PG8_BAR;
#undef PG8_SA
#undef PG8_SB
#undef PG8_STAGE
#undef PG8_STAGEA
#undef PG8_GLOAD
#undef PG8_LDA
#undef PG8_LDB
#undef PG8_MMA
#undef PG8_WAIT_V
#undef PG8_WAIT_L
#undef PG8_BAR
#undef PG8_SCHED
}
}
constexpr int NWAVES = 8, NTHR = 512;
constexpr int RING_BYTES = 131072, LDS_BYTES = 147456, LDSCTL_OFF = LDS_BYTES - 2048;
struct Params { const float* in[29]; float* out; unsigned char* ws; };
struct Frame {
    LAS unsigned char* lds; int tid, lane, wave, blk, G, vcu, gw, ngw; unsigned char* ws;
};
enum { I_X = 0, I_POS, I_ANORM, I_WIN, I_MU, I_W0, I_W2, I_A0, I_A2, I_G2, I_KK, I_KA, I_RK, I_LNX, I_QNORM, I_WQB, I_KVNORM, I_WKVB, I_WBR, I_WO, I_FNORM,
       I_FG, I_FU, I_FD, I_ROUTER, I_MG, I_MU2, I_MD, I_FINAL };

struct SchedGrid {
    int nM, nN, nwg, G, c; const char* A; const char* B; size_t astep, bstep;
    __device__ void init(int nM_, int nN_, int G_, int c_, const void* A_, size_t astep_, const void* B_, size_t bstep_) { nM = nM_; nN = nN_; nwg = nM * nN; G = G_; c = c_; A = (const char*)A_; B = (const char*)B_; astep = astep_; bstep = bstep_; }
    __device__ __forceinline__ bool next(int i, pg8::Unit& u) const {
        const long L = (long)i * G + c; if (L >= nwg) return false;
        int wgid = (int)L; { const int q = nwg / 8, r = nwg % 8, xcd = wgid % 8, off = wgid / 8; wgid = (xcd < r ? xcd * (q + 1) : r * (q + 1) + (xcd - r) * q) + off; }
        const int nig = 8 * nN, gid = wgid / nig, fm = gid * 8, gsz = (nM - fm) < 8 ? (nM - fm) : 8;
        u.pm = fm + ((wgid % nig) % gsz); u.pn = (wgid % nig) / gsz; u.aux = 0;
        u.A = A + (size_t)u.pm * astep; u.B = B + (size_t)u.pn * bstep; return true;
    }
};
struct SchedSmall {
    int G, c, layer; const char* ws;
    __device__ __forceinline__ bool next(int i, pg8::Unit& u) const {
        int L = i * G + c; if (L >= 448) return false;
        int s = 0; if (L >= 192) { L -= 192; s = 1; if (L >= 128) { L -= 128; s = 2; } }
        const int nn = s == 0 ? 3 : (s == 1 ? 2 : 64);
        u.pm = L / nn; u.pn = L % nn; u.aux = s;
        const size_t lw = (size_t)layer * 256 * 2;
        const size_t ao = s == 0 ? WS_QN : (s == 1 ? WS_CN : WS_VB + lw * 512), bo = s == 0 ? WS_QB + lw * 768 : (s == 1 ? WS_KB + lw * 512 : WS_CN);
        u.A = ws + ao + (size_t)u.pm * (256 * 256 * 2); u.B = ws + bo + (size_t)u.pn * (256 * 256 * 2); return true;
    }
};
struct SchedOwn3 {
    int c, G; const char* A; const char* B; size_t astep, bstep, a_n, b_n;
    __device__ __forceinline__ bool next(int i, pg8::Unit& u) const {
        const int t = c + (i / 3) * G; if (t >= 256) return false;
        const int n = i % 3; u.pm = t >> 2; u.pn = t & 3; u.aux = n; u.A = A + (size_t)u.pm * astep + (size_t)n * a_n; u.B = B + (size_t)u.pn * bstep + (size_t)n * b_n; return true;
    }
};
struct SchedMoe {
    int G, c, ncol, ntile; const LAS int* tab; const char* A; const char* B; size_t astep, bstep, estep;
    __device__ __forceinline__ bool next(int i, pg8::Unit& u) const {
        const int L = i * G + c; if (L >= ntile * ncol) return false;
        u.pm = L / ncol; u.pn = L % ncol; const int e = tab[u.pm]; u.aux = e;
        u.A = A + (size_t)u.pm * astep; u.B = B + (size_t)e * estep + (size_t)u.pn * bstep; return true;
    }
};

using pg8::Unit; using pg8::cvt_pk_bf16;
#define EPI_ARGS const f32x4 (&acc)[2][2][4][2], const Unit& u, int wr, int wc, int fr, int fq
__device__ __forceinline__ float row_rstd(const float* SS, int row) {
    const f32x4* s = (const f32x4*)(SS + (size_t)row * 16); const f32x4 a = s[0], b = s[1], c = s[2], d = s[3];
    const float t = ((a.x + a.y) + (a.z + a.w)) + ((b.x + b.y) + (b.z + b.w)) + ((c.x + c.y) + (c.z + c.w)) + ((d.x + d.y) + (d.z + d.w));
    return rsqrtf(t * (1.0f / DM) + NORM_EPS);
}
__device__ __forceinline__ void panel_rstd(const float* SS, int pm, int tid, LAS float* rl) {
    if (tid < 256) rl[tid] = row_rstd(SS, pm * 256 + tid);
    asm volatile("s_waitcnt lgkmcnt(0)" ::: "memory"); __builtin_amdgcn_s_barrier(); asm volatile("" ::: "memory");
}
struct EpiStore {
    static constexpr bool PERM = true;
    bf16_t* O; int ld; const float* SS; LAS float* rl; int tid;
    __device__ __forceinline__ void operator()(EPI_ARGS) const {
        const int row0 = u.pm * 256 + wr * 64 + fr, col0 = u.pn * 256 + wc * 32 + 8 * fq;
        if (SS) panel_rstd(SS, u.pm, tid, rl);
#pragma unroll
        for (int ai = 0; ai < 2; ++ai)
#pragma unroll
            for (int m = 0; m < 4; ++m) { bf16_t* rowp = O + (size_t)(row0 + ai * 128 + m * 16) * ld + col0; const float rs = SS ? rl[wr * 64 + fr + ai * 128 + m * 16] : 1.0f;
#pragma unroll
                for (int bj = 0; bj < 2; ++bj) { const f32x4 v0 = acc[ai][bj][m][0] * rs, v1 = acc[ai][bj][m][1] * rs;
                    u32x4 w; w.x = cvt_pk_bf16(v0[0], v0[1]); w.y = cvt_pk_bf16(v0[2], v0[3]); w.z = cvt_pk_bf16(v1[0], v1[1]); w.w = cvt_pk_bf16(v1[2], v1[3]);
                    *(u32x4*)(rowp + bj * 128) = w; } }
    }
};
struct EpiSmall {
    static constexpr bool PERM = true;
    unsigned char* ws;
    __device__ __forceinline__ void operator()(EPI_ARGS) const {
        bf16_t* base = (bf16_t*)(ws + (u.aux == 0 ? WS_Q : (u.aux == 1 ? WS_KN : WS_VT))); const int ld = u.aux == 0 ? 768 : (u.aux == 1 ? 512 : MTOK);
        const int row0 = u.pm * 256 + wr * 64 + fr, col0 = u.pn * 256 + wc * 32 + 8 * fq;
#pragma unroll
        for (int ai = 0; ai < 2; ++ai)
#pragma unroll
            for (int m = 0; m < 4; ++m) { bf16_t* rowp = base + (size_t)(row0 + ai * 128 + m * 16) * ld + col0;
#pragma unroll
                for (int bj = 0; bj < 2; ++bj) { const f32x4 v0 = acc[ai][bj][m][0], v1 = acc[ai][bj][m][1];
                    u32x4 w; w.x = cvt_pk_bf16(v0[0], v0[1]); w.y = cvt_pk_bf16(v0[2], v0[3]); w.z = cvt_pk_bf16(v1[0], v1[1]); w.w = cvt_pk_bf16(v1[2], v1[3]);
                    *(u32x4*)(rowp + bj * 128) = w; } }
    }
};
struct EpiLora {
    static constexpr bool PERM = true;
    bf16_t* O; const float* w0; const float* a0;
    __device__ __forceinline__ void operator()(EPI_ARGS) const {
        const int seg = u.pn >> 1;
        const int row0 = u.pm * 256 + wr * 64 + fr, col0 = u.pn * 256 + wc * 32 + 8 * fq, ch0 = (u.pn & 1) * 256 + wc * 32 + 8 * fq;
        const float* bias = seg == 0 ? w0 : a0; const float sc = seg == 0 ? -0.6065306597126334f : 1.0f;
#pragma unroll
        for (int bj = 0; bj < 2; ++bj) {
            f32x4 b0 = {0.f, 0.f, 0.f, 0.f}, b1 = {0.f, 0.f, 0.f, 0.f};
            if (seg < 2) { b0 = *(const f32x4*)(bias + ch0 + bj * 128); b1 = *(const f32x4*)(bias + ch0 + bj * 128 + 4); }
#pragma unroll
            for (int ai = 0; ai < 2; ++ai)
#pragma unroll
                for (int m = 0; m < 4; ++m) { bf16_t* rowp = O + (size_t)(row0 + ai * 128 + m * 16) * LO_W + col0 + bj * 128;
                    f32x4 v0 = acc[ai][bj][m][0] + b0, v1 = acc[ai][bj][m][1] + b1;
                    if (seg < 2) {
#pragma unroll
                        for (int j = 0; j < 4; ++j) { v0[j] = sc * sigmoidf_(v0[j]); v1[j] = sc * sigmoidf_(v1[j]); }
                    }
                    u32x4 w; w.x = cvt_pk_bf16(v0[0], v0[1]); w.y = cvt_pk_bf16(v0[2], v0[3]); w.z = cvt_pk_bf16(v1[0], v1[1]); w.w = cvt_pk_bf16(v1[2], v1[3]);
                    *(u32x4*)rowp = w; }
        }
    }
};
struct EpiGate {
    static constexpr bool PERM = true;
    bf16_t* O; const float* SS; LAS float* rl; int tid;
    __device__ __forceinline__ void operator()(EPI_ARGS) const {
        const int row0 = u.pm * 256 + wr * 64 + fr, col0 = u.aux * 1024 + u.pn * 256 + wc * 32 + 8 * fq;
        panel_rstd(SS, u.pm, tid, rl);
#pragma unroll
        for (int ai = 0; ai < 2; ++ai)
#pragma unroll
            for (int m = 0; m < 4; ++m) { bf16_t* rowp = O + (size_t)(row0 + ai * 128 + m * 16) * 3072 + col0; const float rs = rl[wr * 64 + fr + ai * 128 + m * 16];
#pragma unroll
                for (int bj = 0; bj < 2; ++bj) { f32x4 v0 = acc[ai][bj][m][0] * rs, v1 = acc[ai][bj][m][1] * rs;
#pragma unroll
                    for (int j = 0; j < 4; ++j) { v0[j] = sigmoidf_(v0[j]); v1[j] = sigmoidf_(v1[j]); }
                    u32x4 w; w.x = cvt_pk_bf16(v0[0], v0[1]); w.y = cvt_pk_bf16(v0[2], v0[3]); w.z = cvt_pk_bf16(v1[0], v1[1]); w.w = cvt_pk_bf16(v1[2], v1[3]);
                    *(u32x4*)(rowp + bj * 128) = w; } }
    }
};
struct EpiMerge {
    static constexpr bool PERM = true;
    const bf16_t* Gt; bf16_t* Mg;
    __device__ __forceinline__ void operator()(EPI_ARGS) const {
        const int n = u.aux;
        const int row0 = u.pm * 256 + wr * 64 + fr, col0 = u.pn * 256 + wc * 32 + 8 * fq;
#pragma unroll
        for (int ai = 0; ai < 2; ++ai)
#pragma unroll
            for (int m = 0; m < 4; ++m) { const size_t r = (size_t)(row0 + ai * 128 + m * 16);
#pragma unroll
                for (int bj = 0; bj < 2; ++bj) { const f32x4 v0 = acc[ai][bj][m][0], v1 = acc[ai][bj][m][1];
                    const u32x4 g = *(const u32x4*)(Gt + r * 3072 + n * 1024 + col0 + bj * 128);
                    float o[8] = {bflo(g.x) * v0[0], bfhi(g.x) * v0[1], bflo(g.y) * v0[2], bfhi(g.y) * v0[3], bflo(g.z) * v1[0], bfhi(g.z) * v1[1], bflo(g.w) * v1[2], bfhi(g.w) * v1[3]};
                    bf16_t* mp = Mg + r * 1024 + col0 + bj * 128;
                    if (n > 0) { const u32x4 p = *(const u32x4*)mp; o[0] += bflo(p.x); o[1] += bfhi(p.x); o[2] += bflo(p.y); o[3] += bfhi(p.y); o[4] += bflo(p.z); o[5] += bfhi(p.z); o[6] += bflo(p.w); o[7] += bfhi(p.w); }
                    u32x4 w; w.x = cvt_pk_bf16(o[0], o[1]); w.y = cvt_pk_bf16(o[2], o[3]); w.z = cvt_pk_bf16(o[4], o[5]); w.w = cvt_pk_bf16(o[6], o[7]);
                    *(u32x4*)mp = w; } }
    }
};
template <bool EMIT>
struct EpiResid {
    static constexpr bool PERM = false;
    const float* In; float* Out; const float* gain; bf16_t* Hg; float* SS;
    __device__ __forceinline__ void operator()(EPI_ARGS) const {
        const int row0 = u.pm * 256 + wr * 64 + fr, col0 = u.pn * 256 + wc * 32 + 4 * fq;
        f32x4 gv[2][2];
        if (EMIT) {
#pragma unroll
            for (int bj = 0; bj < 2; ++bj)
#pragma unroll
                for (int n = 0; n < 2; ++n) gv[bj][n] = *(const f32x4*)(gain + col0 + bj * 128 + n * 16); }
#pragma unroll
        for (int ai = 0; ai < 2; ++ai)
#pragma unroll
            for (int m = 0; m < 4; ++m) { const int row = row0 + ai * 128 + m * 16; const size_t o = (size_t)row * DM + col0; float sq = 0.f;
#pragma unroll
                for (int bj = 0; bj < 2; ++bj)
#pragma unroll
                    for (int n = 0; n < 2; ++n) { const f32x4 x = *(const f32x4*)(In + o + bj * 128 + n * 16) + acc[ai][bj][m][n]; *(f32x4*)(Out + o + bj * 128 + n * 16) = x;
                        if (EMIT) { sq += (x[0] * x[0] + x[1] * x[1]) + (x[2] * x[2] + x[3] * x[3]); const f32x4 y = x * gv[bj][n]; u32x2 w; w.x = cvt_pk_bf16(y[0], y[1]); w.y = cvt_pk_bf16(y[2], y[3]); *(u32x2*)(Hg + o + bj * 128 + n * 16) = w; } }
                if (EMIT) { sq += __shfl_xor(sq, 16); sq += __shfl_xor(sq, 32); if (fq == 0) SS[(size_t)row * 16 + u.pn * 4 + wc] = sq; } }
    }
};
struct EpiSwiglu {
    static constexpr bool PERM = true;
    bf16_t* O; int ldc; int pn_off; const float* SS; LAS float* rl; int tid;
    __device__ __forceinline__ void operator()(EPI_ARGS) const {
        const int row0 = u.pm * 256 + wr * 64 + fr, col0 = (u.pn - pn_off) * 128 + wc * 32 + 8 * fq;
        if (SS) panel_rstd(SS, u.pm, tid, rl);
#pragma unroll
        for (int ai = 0; ai < 2; ++ai)
#pragma unroll
            for (int m = 0; m < 4; ++m) { bf16_t* rowp = O + (size_t)(row0 + ai * 128 + m * 16) * ldc + col0; const float rs = SS ? rl[wr * 64 + fr + ai * 128 + m * 16] : 1.0f;
                float o[8];
#pragma unroll
                for (int n = 0; n < 2; ++n)
#pragma unroll
                    for (int j = 0; j < 4; ++j) { const float g = acc[ai][0][m][n][j] * rs, up = acc[ai][1][m][n][j] * rs; o[n * 4 + j] = g * sigmoidf_(g) * up; }
                u32x4 w; w.x = cvt_pk_bf16(o[0], o[1]); w.y = cvt_pk_bf16(o[2], o[3]); w.z = cvt_pk_bf16(o[4], o[5]); w.w = cvt_pk_bf16(o[6], o[7]);
                *(u32x4*)rowp = w; }
    }
};
template <bool ACCUM>
struct EpiMoeOut {
    static constexpr bool PERM = true;
    const float* row_w; bf16_t* O;
    __device__ __forceinline__ void operator()(EPI_ARGS) const {
        const int row0 = u.pm * 256 + wr * 64 + fr, col0 = u.pn * 256 + wc * 32 + 8 * fq;
#pragma unroll
        for (int ai = 0; ai < 2; ++ai)
#pragma unroll
            for (int m = 0; m < 4; ++m) { const int r = row0 + ai * 128 + m * 16; const float wt = row_w[r]; bf16_t* rowp = O + (size_t)r * DM + col0;
#pragma unroll
                for (int bj = 0; bj < 2; ++bj) { f32x4 v0 = acc[ai][bj][m][0] * wt, v1 = acc[ai][bj][m][1] * wt;
                    if (ACCUM) { const u32x4 p = *(const u32x4*)(rowp + bj * 128); v0[0] += bflo(p.x); v0[1] += bfhi(p.x); v0[2] += bflo(p.y); v0[3] += bfhi(p.y); v1[0] += bflo(p.z); v1[1] += bfhi(p.z); v1[2] += bflo(p.w); v1[3] += bfhi(p.w); }
                    u32x4 w; w.x = cvt_pk_bf16(v0[0], v0[1]); w.y = cvt_pk_bf16(v0[2], v0[3]); w.z = cvt_pk_bf16(v1[0], v1[1]); w.w = cvt_pk_bf16(v1[2], v1[3]);
                    *(u32x4*)(rowp + bj * 128) = w; } }
    }
};

__device__ __forceinline__ void transpose_tile64(const float* W, int ldn, int k0, int n0, bf16_t* WT, int ldk, int drow0, int drow1, int dk0, LAS float* scr, int lane) {
#ifdef SIMPLE_TR
    { const int c = lane & 7;
      for (int j = 0; j < 8; ++j) { const int n = (lane >> 3) + 8 * j; const float* s = W + (size_t)(k0 + 8 * c) * ldn + n0 + n;
        u32x4 o; o.x = pk2(s[0], s[(size_t)ldn]); o.y = pk2(s[(size_t)2 * ldn], s[(size_t)3 * ldn]); o.z = pk2(s[(size_t)4 * ldn], s[(size_t)5 * ldn]); o.w = pk2(s[(size_t)6 * ldn], s[(size_t)7 * ldn]);
        const int dr = n < 32 ? drow0 + n : drow1 + (n - 32);
        *(u32x4*)(WT + (size_t)dr * ldk + dk0 + k0 + 8 * c) = o; }
      return; }
#endif
    f32x4 v[16]; const int r4 = lane >> 4, c4 = (lane & 15) * 4;
#pragma unroll
    for (int i = 0; i < 16; ++i) v[i] = *(const f32x4*)(W + (size_t)(k0 + 4 * i + r4) * ldn + n0 + c4);
#pragma unroll
    for (int i = 0; i < 16; ++i) { LAS float* d = scr + (4 * i + r4) * 65 + c4; d[0] = v[i][0]; d[1] = v[i][1]; d[2] = v[i][2]; d[3] = v[i][3]; }
    LDS_WAIT(); asm volatile("" ::: "memory");
    const int c = lane & 7;
#pragma unroll
    for (int j = 0; j < 8; ++j) { const int n = (lane >> 3) + 8 * j; const LAS float* s = scr + (8 * c) * 65 + n;
        u32x4 o; o.x = pk2(s[0 * 65], s[1 * 65]); o.y = pk2(s[2 * 65], s[3 * 65]); o.z = pk2(s[4 * 65], s[5 * 65]); o.w = pk2(s[6 * 65], s[7 * 65]);
        const int dr = n < 32 ? drow0 + n : drow1 + (n - 32);
        *(u32x4*)(WT + (size_t)dr * ldk + dk0 + k0 + 8 * c) = o; }
    LDS_WAIT(); asm volatile("" ::: "memory");
}
__device__ __forceinline__ void conv_plain(const float* W, int K, int N, bf16_t* WT, int ldk, int item, LAS float* scr, int lane) {
    const int nblk = N / 64, kb = item / nblk, nb = item % nblk;
    transpose_tile64(W, N, kb * 64, nb * 64, WT, ldk, nb * 64, nb * 64 + 32, 0, scr, lane);
}
__device__ __forceinline__ int win_drow(int n0) { return n0 < 3872 ? n0 : (n0 < 4128 ? 4096 + (n0 - 3872) : (n0 < 4288 ? 4352 + (n0 - 4128) : 4608 + (n0 - 4288))); }
__device__ __forceinline__ int gu_drow(int n0, int up) { return (n0 >> 7) * 256 + (n0 & 127) + up * 128; }

__device__ __forceinline__ void phase_prologue(const Frame& F, const Params& P) {
    LAS float* scr = (LAS float*)(F.lds + F.wave * 16640);
    unsigned char* ws = F.ws;
    constexpr int I_IN = 16 * 115, I_QB = 4 * 12, I_BRn = 8 * 16, I_WOn = 16 * 16, I_G = 16 * 44, I_D = 44 * 16;
    constexpr int NIT = NLAYER * (I_IN + I_QB + 3 * I_BRn + I_WOn) + 2 * I_G + I_D;
    for (int it = F.gw; it < NIT; it += F.ngw) {
        int r = it;
        if (r < NLAYER * I_IN) { const int l = r / I_IN; r %= I_IN; const int kb = r / 115, nb = r % 115;
            transpose_tile64(P.in[I_WIN] + (size_t)l * DM * IN_COLS, IN_COLS, kb * 64, nb * 64, (bf16_t*)(ws + WS_WIN) + (size_t)l * WIN_ROWS * DM, DM, win_drow(nb * 64), win_drow(nb * 64 + 32), 0, scr, F.lane); continue; }
        r -= NLAYER * I_IN;
        if (r < NLAYER * I_QB) { const int l = r / I_QB; r %= I_QB; conv_plain(P.in[I_WQB] + (size_t)l * 256 * 768, 256, 768, (bf16_t*)(ws + WS_QB) + (size_t)l * 768 * 256, 256, r, scr, F.lane); continue; }
        r -= NLAYER * I_QB;
        if (r < NLAYER * 3 * I_BRn) { const int ln = r / I_BRn; r %= I_BRn; conv_plain(P.in[I_WBR] + (size_t)ln * 512 * 1024, 512, 1024, (bf16_t*)(ws + WS_BR) + (size_t)ln * 1024 * 512, 512, r, scr, F.lane); continue; }
        r -= NLAYER * 3 * I_BRn;
        if (r < NLAYER * I_WOn) { const int l = r / I_WOn; r %= I_WOn; conv_plain(P.in[I_WO] + (size_t)l * DM * DM, DM, DM, (bf16_t*)(ws + WS_WO) + (size_t)l * DM * DM, DM, r, scr, F.lane); continue; }
        r -= NLAYER * I_WOn;
        if (r < 2 * I_G) { const int up = r / I_G; r %= I_G; const int kb = r / 44, nb = r % 44;
            transpose_tile64(P.in[up ? I_FU : I_FG], DFF, kb * 64, nb * 64, (bf16_t*)(ws + WS_FGU), DM, gu_drow(nb * 64, up), gu_drow(nb * 64 + 32, up), 0, scr, F.lane); continue; }
        r -= 2 * I_G;
        conv_plain(P.in[I_FD], DFF, DM, (bf16_t*)(ws + WS_FD), DFF, r, scr, F.lane);
    }
    const int gt = F.blk * NTHR + F.tid, ngt = F.G * NTHR;
    for (int i = gt; i < NLAYER * 1536 * 384; i += ngt) { const int l = i / (1536 * 384), r = i % (1536 * 384), n = r / 384, k = r % 384; const int seg = n >> 9, c = n & 511; float v = 0.f;
        if (seg == 0 && k < 64) v = P.in[I_W2][((size_t)l * 64 + k) * 512 + c];
        else if (seg == 1 && k >= 64 && k < 128) v = P.in[I_A2][((size_t)l * 64 + (k - 64)) * 512 + c];
        else if (seg == 2 && k >= 128 && k < 288) v = P.in[I_G2][((size_t)l * 160 + (k - 128)) * 512 + c];
        ((bf16_t*)(ws + WS_LORA))[i] = (bf16_t)f2bf(v); }
    for (int i = gt; i < NLAYER * 512 * 256; i += ngt) { const int l = i / (512 * 256), r = i % (512 * 256), n = r / 256, k = r % 256; const int h = n >> 6, d = n & 63;
        float vk = 0.f, vv = 0.f; if (k < 128) { const float* w = P.in[I_WKVB] + ((size_t)l * 128 + k) * 1024 + h * 128; vk = w[d]; vv = w[64 + d]; }
        ((bf16_t*)(ws + WS_KB))[i] = (bf16_t)f2bf(vk); ((bf16_t*)(ws + WS_VB))[i] = (bf16_t)f2bf(vv); }
    for (int m = F.gw; m < MTOK; m += F.ngw) {
        const f32x4* xr = (const f32x4*)(P.in[I_X] + (size_t)m * DM) + F.lane; f32x4 v[4]; float s = 0.f;
#pragma unroll
        for (int j = 0; j < 4; ++j) { v[j] = xr[64 * j]; s += (v[j].x * v[j].x + v[j].y * v[j].y) + (v[j].z * v[j].z + v[j].w * v[j].w); }
        s = wave_sum(s);
        u32x2* o8 = (u32x2*)((bf16_t*)(ws + WS_HN) + (size_t)m * DM) + F.lane;
#pragma unroll
        for (int j = 0; j < 4; ++j) { const f32x4 g = ((const f32x4*)P.in[I_ANORM])[F.lane + 64 * j]; const f32x4 y = v[j] * g; u32x2 w; w.x = pk2(y.x, y.y); w.y = pk2(y.z, y.w); o8[64 * j] = w; }
        if (F.lane < 16) ((float*)(ws + WS_SS))[(size_t)m * 16 + F.lane] = F.lane == 0 ? s : 0.f;
    }
    for (int i = gt; i < MTOK * 80; i += ngt) { const int m = i / 80, j = i % 80; const int isr = j < 64; const int idx = isr ? j : j - 64; const double dim = isr ? 128.0 : 32.0;
        const float inv = (float)(1.0 / pow(10000.0, (2.0 * idx) / dim)); const float ang = (float)((const int*)P.in[I_POS])[m] * inv;
        const double a = (double)ang, q = rint(a * 0.15915494309189535), rr = a - q * 6.283185307179586476925;
        const float rf = (float)rr; const float cs = __cosf(rf), sn = __sinf(rf);
        if (isr) { ((float*)(ws + WS_COSR))[(size_t)m * 64 + idx] = cs; ((float*)(ws + WS_SINR))[(size_t)m * 64 + idx] = sn; }
        else { ((float*)(ws + WS_COSM))[(size_t)m * 16 + idx] = cs; ((float*)(ws + WS_SINM))[(size_t)m * 16 + idx] = sn; } }
}
template <int PART>
__device__ __forceinline__ void phase_moe_convert(const Frame& F, const Params& P, int w0, int nw) {
    LAS float* scr = (LAS float*)(F.lds + F.wave * 16640);
    constexpr int I_GH = 16 * 28, I_D = 56 * 16;
    constexpr int PER_E = PART == 0 ? 2 * I_GH + I_D : 2 * I_GH;
    for (int it = w0; it < NEXP * PER_E; it += nw) {
        const int e = it / PER_E; int r = it % PER_E;
        if (r < 2 * I_GH) { const int up = r / I_GH; r %= I_GH; const int kb = r / 28, nb = PART * 28 + r % 28;
            transpose_tile64(P.in[up ? I_MU2 : I_MG] + (size_t)e * DM * DFFE, DFFE, kb * 64, nb * 64, (bf16_t*)(F.ws + WS_MGU) + (size_t)e * 2 * DFFE * DM, DM, gu_drow(nb * 64, up), gu_drow(nb * 64 + 32, up), 0, scr, F.lane); continue; }
        r -= 2 * I_GH;
        conv_plain(P.in[I_MD] + (size_t)e * DFFE * DM, DFFE, DM, (bf16_t*)(F.ws + WS_MD) + (size_t)e * DM * DFFE, DFFE, r, scr, F.lane);
    }
}

template <bool MOE>
__device__ __forceinline__ void phase_rms(const Frame& F, const float* src, const float* gain, bf16_t* hn, const float* router, unsigned* ectl, int* tok_e, int* tok_slot, float* tok_w) {
    LAS int* lcnt = (LAS int*)(F.lds);
    if (MOE) { if (F.tid < 16) lcnt[F.tid] = 0; __syncthreads(); }
    int my_e0 = 0, my_e1 = 0, my_s0 = 0, my_s1 = 0; float my_w0 = 0.f, my_w1 = 0.f;
    f32x4 rw[MOE ? 32 : 1];
    if (MOE) {
#pragma unroll
        for (int j = 0; j < 4; ++j)
#pragma unroll
            for (int q = 0; q < 4; ++q) { const int c = 4 * F.lane + 256 * j + q; rw[(j * 4 + q) * 2] = *(const f32x4*)(router + (size_t)c * 8); rw[(j * 4 + q) * 2 + 1] = *(const f32x4*)(router + (size_t)c * 8 + 4); } }
    for (int i = 0; i < 8; ++i) {
        const int m = F.blk * 64 + F.wave * 8 + i;
        const f32x4* xr = (const f32x4*)(src + (size_t)m * DM) + F.lane;
        f32x4 v[4]; float s = 0.f;
#pragma unroll
        for (int j = 0; j < 4; ++j) { v[j] = xr[64 * j]; s += (v[j].x * v[j].x + v[j].y * v[j].y) + (v[j].z * v[j].z + v[j].w * v[j].w); }
        const float rstd = rsqrtf(wave_sum(s) * (1.0f / DM) + NORM_EPS);
#pragma unroll
        for (int j = 0; j < 4; ++j) { const f32x4 g = ((const f32x4*)gain)[F.lane + 64 * j]; v[j] = v[j] * rstd * g; }
        u32x2* o8 = (u32x2*)(hn + (size_t)m * DM) + F.lane;
#pragma unroll
        for (int j = 0; j < 4; ++j) { u32x2 w; w.x = pk2(v[j].x, v[j].y); w.y = pk2(v[j].z, v[j].w); o8[64 * j] = w; }
        if (MOE) {
            float lg[8];
#pragma unroll
            for (int e = 0; e < 8; ++e) lg[e] = 0.f;
#pragma unroll
            for (int j = 0; j < 4; ++j)
#pragma unroll
                for (int q = 0; q < 4; ++q) { const f32x4 r0 = rw[(j * 4 + q) * 2], r1 = rw[(j * 4 + q) * 2 + 1]; const float x = v[j][q];
                    lg[0] += x * r0.x; lg[1] += x * r0.y; lg[2] += x * r0.z; lg[3] += x * r0.w; lg[4] += x * r1.x; lg[5] += x * r1.y; lg[6] += x * r1.z; lg[7] += x * r1.w; }
#pragma unroll
            for (int e = 0; e < 8; ++e) lg[e] = wave_sum(lg[e]);
            int e0 = 0; float b0 = lg[0];
#pragma unroll
            for (int e = 1; e < 8; ++e) if (lg[e] > b0) { b0 = lg[e]; e0 = e; }
            int e1 = -1; float b1 = -3.0e38f;
#pragma unroll
            for (int e = 0; e < 8; ++e) if (e != e0 && lg[e] > b1) { b1 = lg[e]; e1 = e; }
            const float t = __expf(b1 - b0), w0 = 1.0f / (1.0f + t), w1 = t / (1.0f + t);
            int s0 = 0, s1 = 0;
            if (F.lane == 0) { s0 = atomicAdd((int*)&lcnt[e0], 1); s1 = atomicAdd((int*)&lcnt[e1], 1); }
            s0 = __shfl(s0, 0); s1 = __shfl(s1, 0);
            if (F.lane == i) { my_e0 = e0; my_e1 = e1; my_s0 = s0; my_s1 = s1; my_w0 = w0; my_w1 = w1; }
        }
    }
    if (MOE) {
        __syncthreads();
        if (F.tid < 8) lcnt[8 + F.tid] = (int)atomicAdd(&ectl[F.tid], (unsigned)lcnt[F.tid]);
        __syncthreads();
        if (F.lane < 8) { const int m = F.blk * 64 + F.wave * 8 + F.lane;
            tok_e[2 * m] = my_e0; tok_e[2 * m + 1] = my_e1; tok_slot[2 * m] = lcnt[8 + my_e0] + my_s0; tok_slot[2 * m + 1] = lcnt[8 + my_e1] + my_s1; tok_w[2 * m] = my_w0; tok_w[2 * m + 1] = my_w1; }
        __syncthreads();
    }
}
__device__ __forceinline__ void phase_final(const Frame& F, float* h, const float* gain, const bf16_t* out2, const int* tok_pos) {
    for (int m = F.gw; m < MTOK; m += F.ngw) {
        f32x4* xr = (f32x4*)(h + (size_t)m * DM) + F.lane;
        const int p0 = tok_pos[2 * m], p1 = tok_pos[2 * m + 1];
        const u32x2* o0 = (const u32x2*)(out2 + (size_t)p0 * DM) + F.lane; const u32x2* o1 = (const u32x2*)(out2 + (size_t)p1 * DM) + F.lane;
        f32x4 v[4]; float s = 0.f;
#pragma unroll
        for (int j = 0; j < 4; ++j) { v[j] = xr[64 * j]; const u32x2 a = o0[64 * j], b = o1[64 * j];
#ifndef NO_MOE_ADD
            v[j].x += bflo(a.x) + bflo(b.x); v[j].y += bfhi(a.x) + bfhi(b.x); v[j].z += bflo(a.y) + bflo(b.y); v[j].w += bfhi(a.y) + bfhi(b.y);
#endif
            s += (v[j].x * v[j].x + v[j].y * v[j].y) + (v[j].z * v[j].z + v[j].w * v[j].w); }
        const float rstd = rsqrtf(wave_sum(s) * (1.0f / DM) + NORM_EPS);
#pragma unroll
        for (int j = 0; j < 4; ++j) { const f32x4 g = ((const f32x4*)gain)[F.lane + 64 * j]; xr[64 * j] = v[j] * rstd * g; }
    }
}
template <int KS>
__device__ __forceinline__ f32x4 mm_tile(const LAS bf16_t* P, int ldp, const LAS bf16_t* Q, int ldq, int ib, int jb, int lane, f32x4 acc) {
    const LAS bf16_t* pp = P + (ib * 16 + (lane & 15)) * ldp + 8 * (lane >> 4);
    const LAS bf16_t* qp = Q + (jb * 16 + (lane & 15)) * ldq + 8 * (lane >> 4);
#pragma unroll
    for (int ks = 0; ks < KS; ++ks) { const bf16x8 a = *(const LAS bf16x8*)(qp + ks * 32), b = *(const LAS bf16x8*)(pp + ks * 32); acc = __builtin_amdgcn_mfma_f32_16x16x32_bf16(a, b, acc, 0, 0, 0); }
    return acc;
}
__device__ __forceinline__ void st_bf4(LAS bf16_t* p, f32x4 v) { u32x2 w; w.x = pk2(v[0], v[1]); w.y = pk2(v[2], v[3]); *(LAS u32x2*)p = w; }
__device__ __forceinline__ float ret_lg(int h) { return __logf(1.0f - exp2f(-5.0f - (float)h)); }

__device__ __forceinline__ void phase_prep(const Frame& F, const Params& P, int layer) {
    unsigned char* ws = F.ws;
    const bf16_t* p = (const bf16_t*)(ws + WS_P);
    const float* mu = P.in[I_MU] + (size_t)layer * RWKV_COLS;
    for (int m = F.gw; m < MTOK; m += F.ngw) {
        const bf16_t* pr = p + (size_t)m * PW; const bool has_prev = (m % SEQ) != 0; const bf16_t* pp = pr - PW;
        bf16_t* lin = (bf16_t*)(ws + WS_LIN) + (size_t)m * LORA_K;
#pragma unroll
        for (int jj = 0; jj < 6; ++jj) { const int c = F.lane + 64 * jj; float o = 0.f;
            if (c < 288) { const int off = 1536 + c; const float x = bf2f(pr[P_RW + off]), xp = has_prev ? bf2f(pp[P_RW + off]) : 0.f; const float xs = x + (xp - x) * mu[off];
                o = c < 64 ? tanhf(xs) : (c < 128 ? xs : sigmoidf_(xs)); }
            lin[c] = (bf16_t)f2bf(o); }
        {
            const u32x2 w = *(const u32x2*)(pr + P_QA + 4 * F.lane); float x[4] = {bflo(w.x), bfhi(w.x), bflo(w.y), bfhi(w.y)};
            const float ss = wave_sum(x[0] * x[0] + x[1] * x[1] + x[2] * x[2] + x[3] * x[3]); const float rs = rsqrtf(ss * (1.0f / 256.0f) + NORM_EPS);
            const f32x4 g = *(const f32x4*)(P.in[I_QNORM] + layer * 256 + 4 * F.lane);
            u32x2 o; o.x = pk2(x[0] * rs * g.x, x[1] * rs * g.y); o.y = pk2(x[2] * rs * g.z, x[3] * rs * g.w); *(u32x2*)((bf16_t*)(ws + WS_QN) + (size_t)m * 256 + 4 * F.lane) = o; }
        {
            const unsigned w = *(const unsigned*)(pr + P_KVA + 2 * F.lane); float x0 = bflo(w), x1 = bfhi(w);
            const float ss = wave_sum(x0 * x0 + x1 * x1); const float rs = rsqrtf(ss * (1.0f / 128.0f) + NORM_EPS);
            const f32x2 g = *(const f32x2*)(P.in[I_KVNORM] + layer * 128 + 2 * F.lane);
            unsigned* cn = (unsigned*)((bf16_t*)(ws + WS_CN) + (size_t)m * 256); cn[F.lane] = pk2(x0 * rs * g.x, x1 * rs * g.y); cn[64 + F.lane] = 0u; }
        if (F.lane < 16) {
            const float x1 = bf2f(pr[P_KVA + 128 + F.lane]), x2 = bf2f(pr[P_KVA + 144 + F.lane]);
            const float c = ((const float*)(ws + WS_COSM))[(size_t)m * 16 + F.lane], s = ((const float*)(ws + WS_SINM))[(size_t)m * 16 + F.lane];
            bf16_t* kp = (bf16_t*)(ws + WS_KPE) + (size_t)m * 32; kp[F.lane] = (bf16_t)f2bf(x1 * c - x2 * s); kp[16 + F.lane] = (bf16_t)f2bf(x1 * s + x2 * c); }
    }
    LAS bf16_t* kT = (LAS bf16_t*)F.lds;
    LAS bf16_t* vT = kT + 128 * 72;
    const int pc = F.tid & 7, j = F.tid >> 3;
    for (int u = F.blk; u < NB * NCHUNK * 4; u += F.G) {
        const int h = u & 3, n = (u >> 2) & 127, b = u >> 9; const int m = b * SEQ + n * 64 + j;
        const float lg = ret_lg(h);
        __syncthreads();
        {
            const bf16_t* kr = p + (size_t)m * PW + P_RK + h * 128 + pc * 8;
            const u32x4 a = *(const u32x4*)kr, bq = *(const u32x4*)(kr + 64);
            const float* cp = (const float*)(ws + WS_COSR) + (size_t)m * 64 + pc * 8; const float* sp = (const float*)(ws + WS_SINR) + (size_t)m * 64 + pc * 8;
            const float sc = 0.08838834764831845f * __expf(lg * (float)(63 - j));
            const unsigned aw[4] = {a.x, a.y, a.z, a.w}, bw[4] = {bq.x, bq.y, bq.z, bq.w};
#pragma unroll
            for (int i = 0; i < 8; ++i) { const float x1 = (i & 1) ? bfhi(aw[i >> 1]) : bflo(aw[i >> 1]), x2 = (i & 1) ? bfhi(bw[i >> 1]) : bflo(bw[i >> 1]); const float c = cp[i], s = sp[i];
                kT[(pc * 8 + i) * 72 + j] = (bf16_t)f2bf((x1 * c - x2 * s) * sc); kT[(64 + pc * 8 + i) * 72 + j] = (bf16_t)f2bf((x1 * s + x2 * c) * sc); }
            const bf16_t* vr = p + (size_t)m * PW + P_RV + h * 128 + pc * 8;
            const u32x4 va = *(const u32x4*)vr, vb = *(const u32x4*)(vr + 64);
            const unsigned vaw[4] = {va.x, va.y, va.z, va.w}, vbw[4] = {vb.x, vb.y, vb.z, vb.w};
#pragma unroll
            for (int i = 0; i < 8; ++i) { vT[(pc * 8 + i) * 72 + j] = (bf16_t)((i & 1) ? (vaw[i >> 1] >> 16) : (vaw[i >> 1] & 0xffffu)); vT[(64 + pc * 8 + i) * 72 + j] = (bf16_t)((i & 1) ? (vbw[i >> 1] >> 16) : (vbw[i >> 1] & 0xffffu)); }
        }
        __syncthreads();
        bf16_t* out = (bf16_t*)(ws + WS_RS) + (size_t)u * 16384;
#pragma unroll
        for (int jb = 0; jb < 8; ++jb) { f32x4 acc = {0.f, 0.f, 0.f, 0.f}; acc = mm_tile<2>(vT, 72, kT, 72, F.wave, jb, F.lane, acc);
            const int e = F.wave * 16 + (F.lane & 15), d = jb * 16 + 4 * (F.lane >> 4);
            u32x2 w; w.x = pk2(acc[0], acc[1]); w.y = pk2(acc[2], acc[3]); *(u32x2*)(out + e * 128 + d) = w; }
    }
    __syncthreads();
}

__device__ __forceinline__ void ret_scan(const Frame& F) {
    bf16_t* rs = (bf16_t*)(F.ws + WS_RS);
    for (int idx = F.blk * NTHR + F.tid; idx < NB * 4 * 16384; idx += F.G * NTHR) {
        const int b = idx >> 16, h = (idx >> 14) & 3, ed = idx & 16383; const float cd = __expf(ret_lg(h) * 64.0f);
        bf16_t* base = rs + ((size_t)(b * 128) * 4 + h) * 16384 + ed; float s = 0.f;
        for (int n0 = 0; n0 < NCHUNK; n0 += 32) { unsigned short t[32];
#pragma unroll
            for (int i = 0; i < 32; ++i) t[i] = base[(size_t)(n0 + i) * 65536];
#pragma unroll
            for (int i = 0; i < 32; ++i) { base[(size_t)(n0 + i) * 65536] = (bf16_t)f2bf(s); s = s * cd + bf2f(t[i]); } }
    }
}

__device__ __forceinline__ void ret_out(const Frame& F) {
    unsigned char* ws = F.ws; const bf16_t* p = (const bf16_t*)(ws + WS_P);
    LAS bf16_t* q = (LAS bf16_t*)F.lds;
    LAS bf16_t* k = q + 64 * 136;
    LAS bf16_t* vT = k + 64 * 136;
    LAS bf16_t* pT = vT + 128 * 72;
    LAS bf16_t* sc = pT + 128 * 136;
    LAS float* st = (LAS float*)(sc + 64 * 72);
    const int pc = F.tid & 7, j = F.tid >> 3;
    for (int u = F.blk; u < NB * NCHUNK * 4; u += F.G) {
        const int h = u & 3, n = (u >> 2) & 127, b = u >> 9; const int m0 = b * SEQ + n * 64, m = m0 + j;
        const float lg = ret_lg(h);
        LBAR();
        {
            const float* cp = (const float*)(ws + WS_COSR) + (size_t)m * 64 + pc * 8; const float* sp = (const float*)(ws + WS_SINR) + (size_t)m * 64 + pc * 8;
            float cs[8], sn[8];
#pragma unroll
            for (int i = 0; i < 8; ++i) { cs[i] = cp[i]; sn[i] = sp[i]; }
#pragma unroll
            for (int which = 0; which < 2; ++which) {
                const bf16_t* r = p + (size_t)m * PW + (which ? P_RK : P_RQ) + h * 128 + pc * 8;
                const u32x4 a = *(const u32x4*)r, bq = *(const u32x4*)(r + 64);
                const unsigned aw[4] = {a.x, a.y, a.z, a.w}, bw[4] = {bq.x, bq.y, bq.z, bq.w}; const float sc_ = which ? 0.08838834764831845f : 1.0f;
                float o1[8], o2[8];
#pragma unroll
                for (int i = 0; i < 8; ++i) { const float x1 = (i & 1) ? bfhi(aw[i >> 1]) : bflo(aw[i >> 1]), x2 = (i & 1) ? bfhi(bw[i >> 1]) : bflo(bw[i >> 1]); o1[i] = (x1 * cs[i] - x2 * sn[i]) * sc_; o2[i] = (x1 * sn[i] + x2 * cs[i]) * sc_; }
                LAS bf16_t* dst = (which ? k : q) + j * 136 + pc * 8;
                u32x4 w1, w2; w1.x = pk2(o1[0], o1[1]); w1.y = pk2(o1[2], o1[3]); w1.z = pk2(o1[4], o1[5]); w1.w = pk2(o1[6], o1[7]); w2.x = pk2(o2[0], o2[1]); w2.y = pk2(o2[2], o2[3]); w2.z = pk2(o2[4], o2[5]); w2.w = pk2(o2[6], o2[7]);
                *(LAS u32x4*)dst = w1; *(LAS u32x4*)(dst + 64) = w2; }
            const bf16_t* vr = p + (size_t)m * PW + P_RV + h * 128 + pc * 8;
            const u32x4 va = *(const u32x4*)vr, vb = *(const u32x4*)(vr + 64);
            const unsigned vaw[4] = {va.x, va.y, va.z, va.w}, vbw[4] = {vb.x, vb.y, vb.z, vb.w};
#pragma unroll
            for (int i = 0; i < 8; ++i) { vT[(pc * 8 + i) * 72 + j] = (bf16_t)((i & 1) ? (vaw[i >> 1] >> 16) : (vaw[i >> 1] & 0xffffu)); vT[(64 + pc * 8 + i) * 72 + j] = (bf16_t)((i & 1) ? (vbw[i >> 1] >> 16) : (vbw[i >> 1] & 0xffffu)); }
            const bf16_t* ps = (const bf16_t*)(ws + WS_RS) + (size_t)u * 16384;
#pragma unroll
            for (int i = 0; i < 4; ++i) { const int pi = F.tid + i * 512; const int e = pi >> 4, c = pi & 15; *(LAS u32x4*)(pT + e * 136 + c * 8) = *(const u32x4*)(ps + e * 128 + c * 8); }
        }
        LBAR();
        {
            const int ib = F.wave & 3;
#pragma unroll
            for (int t = 0; t < 2; ++t) { const int jb = 2 * (F.wave >> 2) + t; f32x4 acc = {0.f, 0.f, 0.f, 0.f}; acc = mm_tile<4>(q, 136, k, 136, ib, jb, F.lane, acc);
                const int i = ib * 16 + (F.lane & 15), j0 = jb * 16 + 4 * (F.lane >> 4);
#pragma unroll
                for (int r = 0; r < 4; ++r) { const int dd = i - (j0 + r); acc[r] *= __expf(lg * (float)(dd < 0 ? -dd : dd)); }
                st_bf4(sc + i * 72 + j0, acc); }
        }
        LBAR();
        {
            const int ib = F.wave & 3, eh = F.wave >> 2; const int i = ib * 16 + (F.lane & 15);
            const float qd = __expf(lg * (float)(i + 1));
            f32x4 o[4]; float s1 = 0.f, s2 = 0.f;
#pragma unroll
            for (int t = 0; t < 4; ++t) { const int eb = eh * 4 + t; f32x4 ai = {0.f, 0.f, 0.f, 0.f}, ac = {0.f, 0.f, 0.f, 0.f};
                ai = mm_tile<2>(sc, 72, vT, 72, ib, eb, F.lane, ai); ac = mm_tile<4>(q, 136, pT, 136, ib, eb, F.lane, ac);
                o[t] = ai + ac * qd;
#pragma unroll
                for (int r = 0; r < 4; ++r) { s1 += o[t][r]; s2 += o[t][r] * o[t][r]; } }
            s1 += __shfl_xor(s1, 16); s1 += __shfl_xor(s1, 32); s2 += __shfl_xor(s2, 16); s2 += __shfl_xor(s2, 32);
            if (F.lane < 16) { st[(eh * 64 + i) * 2] = s1; st[(eh * 64 + i) * 2 + 1] = s2; }
            LBAR();
            const float t1 = st[i * 2] + st[(64 + i) * 2], t2 = st[i * 2 + 1] + st[(64 + i) * 2 + 1];
            const float mean = t1 * (1.0f / 128.0f), var = fmaxf(t2 * (1.0f / 128.0f) - mean * mean, 0.f), rstd = rsqrtf(var + 1e-5f);
            const int mrow = m0 + i;
#pragma unroll
            for (int t = 0; t < 4; ++t) { const int e = (eh * 4 + t) * 16 + 4 * (F.lane >> 4);
                const u32x2 gw = *(const u32x2*)(p + (size_t)mrow * PW + P_RG + h * 128 + e); const float g[4] = {bflo(gw.x), bfhi(gw.x), bflo(gw.y), bfhi(gw.y)};
                float y[4];
#pragma unroll
                for (int r = 0; r < 4; ++r) y[r] = (o[t][r] - mean) * rstd * (g[r] * sigmoidf_(g[r]));
                u32x2 w; w.x = pk2(y[0], y[1]); w.y = pk2(y[2], y[3]); *(u32x2*)((bf16_t*)(ws + WS_YRET) + (size_t)mrow * 512 + h * 128 + e) = w; }
        }
    }
    __syncthreads();
}

constexpr int ATT_KP = 104, ATT_VP = 72;
constexpr int ATT_KB = 64 * ATT_KP * 2, ATT_VB = 64 * ATT_VP * 2;
constexpr int ATT_K0 = 0, ATT_V0 = 2 * ATT_KB;
__device__ __forceinline__ void attn_unit(const Frame& F, int b, int h, int qt) {
    unsigned char* ws = F.ws;
    const bf16_t* Qg = (const bf16_t*)(ws + WS_Q); const bf16_t* Kn = (const bf16_t*)(ws + WS_KN); const bf16_t* Kp = (const bf16_t*)(ws + WS_KPE); const bf16_t* Vt = (const bf16_t*)(ws + WS_VT);
    const int lane = F.lane, w = F.wave, ql = lane & 31, hf = lane >> 5;
    const int mq = b * SEQ + qt * 256 + w * 32 + ql;
    const float qs = 0.10206207261596577f * 1.4426950408889634f;
    bf16x8 qf[6];
    {
        const bf16_t* qr = Qg + (size_t)mq * 768 + h * 96;
#pragma unroll
        for (int s = 0; s < 4; ++s) { const u32x4 x = *(const u32x4*)(qr + 16 * s + 8 * hf); const unsigned xw[4] = {x.x, x.y, x.z, x.w}; u32x4 o; unsigned ow[4];
#pragma unroll
            for (int i = 0; i < 4; ++i) ow[i] = pk2(bflo(xw[i]) * qs, bfhi(xw[i]) * qs);
            o.x = ow[0]; o.y = ow[1]; o.z = ow[2]; o.w = ow[3]; qf[s] = __builtin_bit_cast(bf16x8, o); }
        const u32x4 x1 = *(const u32x4*)(qr + 64 + 8 * hf), x2 = *(const u32x4*)(qr + 80 + 8 * hf);
        const float* cp = (const float*)(ws + WS_COSM) + (size_t)mq * 16 + 8 * hf; const float* sp = (const float*)(ws + WS_SINM) + (size_t)mq * 16 + 8 * hf;
        const unsigned a[4] = {x1.x, x1.y, x1.z, x1.w}, c[4] = {x2.x, x2.y, x2.z, x2.w}; unsigned o1[4], o2[4];
#pragma unroll
        for (int i = 0; i < 4; ++i) { const float u0 = bflo(a[i]), u1 = bfhi(a[i]), v0 = bflo(c[i]), v1 = bfhi(c[i]); const float c0 = cp[2 * i], c1 = cp[2 * i + 1], s0 = sp[2 * i], s1 = sp[2 * i + 1];
            o1[i] = pk2((u0 * c0 - v0 * s0) * qs, (u1 * c1 - v1 * s1) * qs); o2[i] = pk2((u0 * s0 + v0 * c0) * qs, (u1 * s1 + v1 * c1) * qs); }
        u32x4 t1, t2; t1.x = o1[0]; t1.y = o1[1]; t1.z = o1[2]; t1.w = o1[3]; t2.x = o2[0]; t2.y = o2[1]; t2.z = o2[2]; t2.w = o2[3];
        qf[4] = __builtin_bit_cast(bf16x8, t1); qf[5] = __builtin_bit_cast(bf16x8, t2);
    }
    f32x16 oacc[2];
#pragma unroll
    for (int i = 0; i < 16; ++i) { oacc[0][i] = 0.f; oacc[1][i] = 0.f; }
    float mrun = 0.f; f32x2 lsum = {0.f, 0.f};
    const int nkt = 4 * qt + 4, mylim = 4 * qt + (w >> 1);
    const int half = w >> 2;
    const int kkey = F.tid >> 3, kpc = F.tid & 7, rkey = (F.tid & 255) >> 2, rpc = F.tid & 3, ve = F.tid >> 3, vpc = F.tid & 7;
    const bf16_t* knp = Kn + (size_t)(b * SEQ + kkey) * 512 + h * 64 + kpc * 8;
    const bf16_t* kpp = Kp + (size_t)(b * SEQ + rkey) * 32 + rpc * 8;
    const bf16_t* vtp = Vt + (size_t)(h * 64 + ve) * MTOK + b * SEQ + vpc * 8;
    const int kofs = (kkey * ATT_KP + kpc * 8) * 2, rofs = (rkey * ATT_KP + 64 + rpc * 8) * 2, vofs = (ve * ATT_VP + vpc * 8) * 2;
    constexpr bool rp = true;
#define ATT_QK(sv, kbuf, init) do { _Pragma("unroll") for (int t_ = 0; t_ < 2; ++t_) { _Pragma("unroll") for (int i_ = 0; i_ < 16; ++i_) sv[t_][i_] = (init); } \
        const LAS bf16_t* kr_ = (kbuf) + ql * ATT_KP + 8 * hf; bf16x8 ka_ = *(const LAS bf16x8*)kr_, kb_ = *(const LAS bf16x8*)(kr_ + 32 * ATT_KP); \
        _Pragma("unroll") for (int st_ = 0; st_ < 6; ++st_) { bf16x8 na_ = ka_, nb_ = kb_; \
            if (st_ < 5) { na_ = *(const LAS bf16x8*)(kr_ + 16 * (st_ + 1)); nb_ = *(const LAS bf16x8*)(kr_ + 32 * ATT_KP + 16 * (st_ + 1)); } \
            sv[0] = __builtin_amdgcn_mfma_f32_32x32x16_bf16(ka_, qf[st_], sv[0], 0, 0, 0); sv[1] = __builtin_amdgcn_mfma_f32_32x32x16_bf16(kb_, qf[st_], sv[1], 0, 0, 0); \
            ka_ = na_; kb_ = nb_; __builtin_amdgcn_sched_barrier(0); } } while (0)
    u32x4 ak, ar, av, bk, br, bv;
#define ATT_LOAD(K_, R_, V_, t_) do { const int tt_ = (t_) < nkt ? (t_) : nkt - 1; \
        K_ = *(const u32x4*)(knp + (size_t)tt_ * 64 * 512); R_ = *(const u32x4*)(kpp + (size_t)tt_ * 64 * 32); V_ = *(const u32x4*)(vtp + (size_t)tt_ * 64); } while (0)
#define ATT_STAGE(K_, R_, V_, kt_) do { { LAS unsigned char* kb2_ = F.lds + ATT_K0 + (((kt_) + 1) & 1) * ATT_KB; *(LAS u32x4*)(kb2_ + kofs) = K_; *(LAS u32x4*)(kb2_ + rofs) = R_; } \
        *(LAS u32x4*)(F.lds + ATT_V0 + (((kt_) + 1) & 1) * ATT_VB + vofs) = V_; ATT_LOAD(K_, R_, V_, (kt_) + 3); } while (0)
    __syncthreads();
    {
        ak = *(const u32x4*)knp; ar = *(const u32x4*)kpp; av = *(const u32x4*)vtp;
        *(LAS u32x4*)(F.lds + ATT_K0 + kofs) = ak; *(LAS u32x4*)(F.lds + ATT_K0 + rofs) = ar; *(LAS u32x4*)(F.lds + ATT_V0 + vofs) = av;
        ATT_LOAD(ak, ar, av, 1); ATT_LOAD(bk, br, bv, 2);
    }
    __syncthreads();
    f32x16 sc[2];
    if (half == 1) LBAR();
#define ATT_SEG1(kt_, ALL) do { if ((ALL) || (kt_) <= mylim) ATT_QK(sc, (const LAS bf16_t*)(F.lds + ATT_K0 + ((kt_) & 1) * ATT_KB), -mrun); } while (0)
#define ATT_SEG2(kt_, ALL) do { if ((ALL) || (kt_) <= mylim) { \
            const LAS bf16_t* vb = (const LAS bf16_t*)(F.lds + ATT_V0 + ((kt_) & 1) * ATT_VB); \
            int mi = __builtin_bit_cast(int, sc[0][0]); \
            _Pragma("unroll") for (int i = 0; i < 16; ++i) { const int a_ = __builtin_bit_cast(int, sc[0][i]), b_ = __builtin_bit_cast(int, sc[1][i]); mi = max(max(mi, a_), b_); } \
            if ((kt_) == 0 || __builtin_amdgcn_ballot_w64(__builtin_bit_cast(float, mi) > 8.0f) != 0ull) { \
                float mx = fmaxf(sc[0][0], sc[1][0]); \
                _Pragma("unroll") for (int i = 1; i < 16; ++i) mx = fmaxf(mx, fmaxf(sc[0][i], sc[1][i])); \
                { const int mb = __builtin_bit_cast(int, mx); const auto sw2 = __builtin_amdgcn_permlane32_swap(mb, mb, false, false); mx = fmaxf(__builtin_bit_cast(float, (int)sw2[0]), __builtin_bit_cast(float, (int)sw2[1])); } \
                const float delta = ((kt_) == 0) ? mx : fmaxf(mx, 0.f); \
                const float alpha = ((kt_) == 0) ? 1.0f : __builtin_amdgcn_exp2f(-delta); mrun += delta; lsum *= alpha; \
                _Pragma("unroll") for (int i = 0; i < 16; ++i) { oacc[0][i] *= alpha; oacc[1][i] *= alpha; sc[0][i] -= delta; sc[1][i] -= delta; } } \
            _Pragma("unroll") for (int t = 0; t < 2; ++t) _Pragma("unroll") for (int i = 0; i < 16; i += 2) { const float p0 = __builtin_amdgcn_exp2f(sc[t][i]), p1 = __builtin_amdgcn_exp2f(sc[t][i + 1]); sc[t][i] = p0; sc[t][i + 1] = p1; lsum += (f32x2){p0, p1}; } \
            _Pragma("unroll") for (int t = 0; t < 2; ++t) _Pragma("unroll") for (int kbb = 0; kbb < 2; ++kbb) { \
                    u32x4 pw; pw.x = pk2(sc[t][8 * kbb + 0], sc[t][8 * kbb + 1]); pw.y = pk2(sc[t][8 * kbb + 2], sc[t][8 * kbb + 3]); pw.z = pk2(sc[t][8 * kbb + 4], sc[t][8 * kbb + 5]); pw.w = pk2(sc[t][8 * kbb + 6], sc[t][8 * kbb + 7]); \
                    const bf16x8 pf = __builtin_bit_cast(bf16x8, pw); const int key0 = t * 32 + kbb * 16 + 4 * hf; \
                    _Pragma("unroll") for (int eb = 0; eb < 2; ++eb) { const LAS bf16_t* vr = vb + (eb * 32 + ql) * ATT_VP + key0; \
                        const u32x2 lo = *(const LAS u32x2*)vr, hi = *(const LAS u32x2*)(vr + 8); u32x4 vv; vv.x = lo.x; vv.y = lo.y; vv.z = hi.x; vv.w = hi.y; \
                        oacc[eb] = __builtin_amdgcn_mfma_f32_32x32x16_bf16(__builtin_bit_cast(bf16x8, vv), pf, oacc[eb], 0, 0, 0); } } } } while (0)
    const int nall = 4 * qt;
#define ATT_TRIP_L(kt_, ALL) do { ATT_SEG1(kt_, ALL); LBAR(); ATT_STAGE(ak, ar, av, kt_); ATT_SEG2(kt_, ALL); LBAR(); \
                                  ATT_SEG1((kt_) + 1, ALL); LBAR(); ATT_STAGE(bk, br, bv, (kt_) + 1); ATT_SEG2((kt_) + 1, ALL); LBAR(); } while (0)
#define ATT_TRIP_T(kt_, ALL) do { ATT_STAGE(ak, ar, av, kt_); ATT_SEG1(kt_, ALL); LBAR(); ATT_SEG2(kt_, ALL); LBAR(); \
                                  ATT_STAGE(bk, br, bv, (kt_) + 1); ATT_SEG1((kt_) + 1, ALL); LBAR(); ATT_SEG2((kt_) + 1, ALL); LBAR(); } while (0)
    if (half == 0) {
#pragma unroll 1
        for (int kt = 0; kt < nall; kt += 2) ATT_TRIP_L(kt, true);
#pragma unroll 1
        for (int kt = nall; kt < nkt; kt += 2) ATT_TRIP_L(kt, false);
        LBAR();
    } else {
#pragma unroll 1
        for (int kt = 0; kt < nall; kt += 2) ATT_TRIP_T(kt, true);
#pragma unroll 1
        for (int kt = nall; kt < nkt; kt += 2) ATT_TRIP_T(kt, false);
    }
#undef ATT_TRIP_L
#undef ATT_TRIP_T
#undef ATT_QK
#undef ATT_LOAD
#undef ATT_STAGE
#undef ATT_SEG1
#undef ATT_SEG2
    float lrun = lsum[0] + lsum[1];
    const float lt = lrun + __shfl_xor(lrun, 32), inv = 1.0f / lt;
    bf16_t* yo = (bf16_t*)(ws + WS_YMLA) + (size_t)mq * 512 + h * 64;
#pragma unroll
    for (int eb = 0; eb < 2; ++eb)
#pragma unroll
        for (int g = 0; g < 4; ++g) { u32x2 wv; wv.x = pk2(oacc[eb][4 * g] * inv, oacc[eb][4 * g + 1] * inv); wv.y = pk2(oacc[eb][4 * g + 2] * inv, oacc[eb][4 * g + 3] * inv);
            *(u32x2*)(yo + eb * 32 + 8 * g + 4 * hf) = wv; }
}
constexpr int RP = 72;
constexpr int RMAT = 64 * RP;
constexpr size_t RC_UNIT = 40960;
constexpr size_t WS_RC2 = WS_RC + (size_t)2048 * RC_UNIT;

__device__ __forceinline__ void st_g4(bf16_t* p, f32x4 v) { u32x2 w; w.x = pk2(v[0], v[1]); w.y = pk2(v[2], v[3]); *(u32x2*)p = w; }
__device__ __forceinline__ f32x4 ld_l4(const LAS bf16_t* p) { const u32x2 w = *(const LAS u32x2*)p; return (f32x4){bflo(w.x), bfhi(w.x), bflo(w.y), bfhi(w.y)}; }

template <int KS>
__device__ __forceinline__ f32x16 mm32(const LAS bf16_t* P, const LAS bf16_t* Q, int ib, int jb, int lane, f32x16 acc) {
    const LAS bf16_t* pp = P + (ib * 32 + (lane & 31)) * RP + 8 * (lane >> 5);
    const LAS bf16_t* qp = Q + (jb * 32 + (lane & 31)) * RP + 8 * (lane >> 5);
#pragma unroll
    for (int ks = 0; ks < KS; ++ks) { const bf16x8 a = *(const LAS bf16x8*)(qp + ks * 16), b = *(const LAS bf16x8*)(pp + ks * 16); acc = __builtin_amdgcn_mfma_f32_32x32x16_bf16(a, b, acc, 0, 0, 0); }
    return acc;
}
__device__ __forceinline__ f32x16 zero16() { f32x16 z; for (int i = 0; i < 16; ++i) z[i] = 0.f; return z; }
__device__ __forceinline__ void st32_lds(LAS bf16_t* O, int ib, int jb, int lane, const f32x16& a) {
    LAS bf16_t* o = O + (ib * 32 + (lane & 31)) * RP + jb * 32 + 4 * (lane >> 5);
#pragma unroll
    for (int g = 0; g < 4; ++g) st_bf4(o + 8 * g, (f32x4){a[4 * g], a[4 * g + 1], a[4 * g + 2], a[4 * g + 3]});
}
__device__ __forceinline__ void st32_glb(bf16_t* O, int ib, int jb, int lane, const f32x16& a) {
    bf16_t* o = O + (ib * 32 + (lane & 31)) * 64 + jb * 32 + 4 * (lane >> 5);
#pragma unroll
    for (int g = 0; g < 4; ++g) st_g4(o + 8 * g, (f32x4){a[4 * g], a[4 * g + 1], a[4 * g + 2], a[4 * g + 3]});
}
struct PreIn { unsigned short r[8], rp[8], k[8], kp[8], v[8], vp[8], lw[8], a[8]; };
__device__ __forceinline__ void pre_load(PreIn& x, const bf16_t* p, const bf16_t* lo, int u, int w, int lane) {
    const int c = u & 127, h = (u >> 7) & 7, b = u >> 10; const int m0 = b * SEQ + c * 64, ch = h * 64 + lane;
#pragma unroll
    for (int i = 0; i < 8; ++i) { const int t = 8 * w + i, m = m0 + t; const bf16_t* pr = p + (size_t)m * PW + P_RW + ch; const bool hp = (c | t) != 0;
        x.r[i] = pr[0]; x.k[i] = pr[512]; x.v[i] = pr[1024];
        x.rp[i] = hp ? pr[-PW] : (unsigned short)0; x.kp[i] = hp ? pr[512 - PW] : (unsigned short)0; x.vp[i] = hp ? pr[1024 - PW] : (unsigned short)0;
        x.lw[i] = lo[(size_t)m * LO_W + ch]; x.a[i] = lo[(size_t)m * LO_W + 512 + ch]; }
}
#ifdef PRE_T
#define PRE_MARK(k) do { if (F.tid == 0) { volatile LAS unsigned long long* tq_ = (volatile LAS unsigned long long*)(F.lds + LDSCTL_OFF + 48); const unsigned long long now_ = __builtin_amdgcn_s_memrealtime(); \
        if ((k) == PRE_T) tq_[1] += now_ - tq_[2]; tq_[2] = now_; } } while (0)
#else
#define PRE_MARK(k) do { } while (0)
#endif
template <int DIAG = 0>
__device__ __forceinline__ void rwkv_chunk_pre(const Frame& F, const float* mu, const float* k_k_, const float* k_a_, const float* r_k_) {
    unsigned char* ws = F.ws; const bf16_t* p = (const bf16_t*)(ws + WS_P); const bf16_t* lo = (const bf16_t*)(ws + WS_LO);
    LAS bf16_t* M = (LAS bf16_t*)F.lds;
    LAS bf16_t *KKt = M, *Bt = M + RMAT, *Kt = M + 2 * RMAT, *Rt = M + 3 * RMAT, *KKtT = M + 4 * RMAT, *BhT = M + 5 * RMAT, *KhT = M + 6 * RMAT, *VcT = M + 7 * RMAT;
    LAS bf16_t *NA = M + 8 * RMAT, *NAT = M + 9 * RMAT, *TT = M + 10 * RMAT, *AkkT = M + 11 * RMAT, *AbrT = M + 12 * RMAT, *AkrT = M + 13 * RMAT;
    LAS float* SEG = (LAS float*)(M + 10 * RMAT);
    const int lane = F.lane, w = F.wave, pr_ = w >> 1, ib = w & 1;
    const int i0 = ib * 32 + (lane & 31), jq = 4 * (lane >> 5);
    PreIn cur;
    if (F.blk < NB * 8 * NCHUNK) pre_load(cur, p, lo, F.blk, w, lane);
    for (int u = F.blk; u < NB * 8 * NCHUNK; u += F.G) {
        const int h = (u >> 7) & 7; const int ch = h * 64 + lane;
        const float mu_r = mu[ch], mu_k = mu[512 + ch], mu_v = mu[1024 + ch], k_k = k_k_[ch], k_a = k_a_[ch], r_k = r_k_[ch];
        float* aux = DIAG ? (float*)(ws + WS_YMLA) + (size_t)(u & 255) * 128 : (float*)(ws + WS_RC2) + (size_t)u * 128;
        LBAR();
        PRE_MARK(0);
        if (DIAG != 2) {
        float rr[8], kk8[8], k28[8], vv[8], bb[8], lw8[8], cs8[8]; float cs = 0.f;
#pragma unroll
        for (int i = 0; i < 8; ++i) { const int t = 8 * w + i;
            const float xr = bf2f(cur.r[i]), xk = bf2f(cur.k[i]), xv = bf2f(cur.v[i]);
            const float r = xr + (bf2f(cur.rp[i]) - xr) * mu_r, k = xk + (bf2f(cur.kp[i]) - xk) * mu_k, v = xv + (bf2f(cur.vp[i]) - xv) * mu_v;
            const float lw = bf2f(cur.lw[i]), a = bf2f(cur.a[i]);
            float kk = k * k_k; const float ss = wave_sum(kk * kk); kk *= rsqrtf(ss + 1e-12f);
            const float k2 = k * (1.0f + (a - 1.0f) * k_a);
            rr[i] = r; kk8[i] = kk; k28[i] = k2; vv[i] = v; bb[i] = kk * a; lw8[i] = lw; cs += lw; cs8[i] = cs;
            (DIAG ? (bf16_t*)(ws + WS_YRW) + (size_t)(u & 255) * 4096 : (bf16_t*)(ws + WS_RC + (size_t)u * RC_UNIT) + 16384)[t * 64 + lane] = (bf16_t)f2bf(v);
            const float bon = wave_sum(r * k2 * r_k); if (lane == 0) aux[64 + t] = bon; }
        SEG[w * 64 + lane] = cs;
        if (u + F.G < NB * 8 * NCHUNK) pre_load(cur, p, lo, u + F.G, w, lane);
        LBAR();
        float off = 0.f, cumC = 0.f;
#pragma unroll
        for (int s = 0; s < 8; ++s) { const float sv = SEG[s * 64 + lane]; cumC += sv; off += (s < w) ? sv : 0.f; }
        if (w == 0) aux[lane] = __expf(cumC);
        LBAR();
        unsigned pkk[4], pbh[4], pkh[4], pvc[4];
#pragma unroll
        for (int i = 0; i < 8; i += 2) { float o_kk[2], o_bh[2], o_kh[2];
#pragma unroll
            for (int e = 0; e < 2; ++e) { const int t = 8 * w + i + e; const float cum = cs8[i + e] + off;
                const float om = __expf(cum), omx = __expf(cum - lw8[i + e]), iom = __expf(-cum), ih = __expf(cumC - cum);
                o_kk[e] = kk8[i + e] * omx; o_bh[e] = bb[i + e] * ih; o_kh[e] = k28[i + e] * ih;
                KKt[t * RP + lane] = (bf16_t)f2bf(o_kk[e]); Bt[t * RP + lane] = (bf16_t)f2bf(bb[i + e] * iom); Kt[t * RP + lane] = (bf16_t)f2bf(k28[i + e] * iom); Rt[t * RP + lane] = (bf16_t)f2bf(rr[i + e] * om); }
            pkk[i >> 1] = pk2(o_kk[0], o_kk[1]); pbh[i >> 1] = pk2(o_bh[0], o_bh[1]); pkh[i >> 1] = pk2(o_kh[0], o_kh[1]); pvc[i >> 1] = pk2(vv[i], vv[i + 1]); }
        *(LAS u32x4*)(KKtT + lane * RP + 8 * w) = (u32x4){pkk[0], pkk[1], pkk[2], pkk[3]}; *(LAS u32x4*)(BhT + lane * RP + 8 * w) = (u32x4){pbh[0], pbh[1], pbh[2], pbh[3]};
        *(LAS u32x4*)(KhT + lane * RP + 8 * w) = (u32x4){pkh[0], pkh[1], pkh[2], pkh[3]}; *(LAS u32x4*)(VcT + lane * RP + 8 * w) = (u32x4){pvc[0], pvc[1], pvc[2], pvc[3]};
        }
        LBAR();
        PRE_MARK(1);
        if (DIAG != 1) {
        {
            const LAS bf16_t* Pm = pr_ < 2 ? KKt : Rt; const LAS bf16_t* Qm = (pr_ == 0 || pr_ == 2) ? Bt : Kt; LAS bf16_t* Om = pr_ == 0 ? NAT : (pr_ == 1 ? AkkT : (pr_ == 2 ? AbrT : AkrT));
            const bool incl = pr_ >= 2; const float sgn = pr_ == 0 ? -1.0f : 1.0f;
#pragma unroll
            for (int jb = 0; jb < 2; ++jb) { f32x16 a = zero16(); if (jb <= ib) a = mm32<4>(Pm, Qm, ib, jb, lane, a);
#pragma unroll
                for (int g = 0; g < 4; ++g)
#pragma unroll
                    for (int r = 0; r < 4; ++r) { const int jj = jb * 32 + 8 * g + jq + r; const bool keep = incl ? (jj <= i0) : (jj < i0); a[4 * g + r] = keep ? sgn * a[4 * g + r] : 0.f; }
                st32_lds(Om, ib, jb, lane, a);
                if (pr_ == 0) {
#pragma unroll
                    for (int g = 0; g < 4; ++g)
#pragma unroll
                        for (int r = 0; r < 4; ++r) { const int jj = jb * 32 + 8 * g + jq + r; a[4 * g + r] += (jj == i0) ? 1.0f : 0.f; }
                    st32_lds(TT, ib, jb, lane, a); } }
            if (pr_ == 0) {
#pragma unroll
                for (int jb = 0; jb < 2; ++jb) { f32x16 a = zero16(); if (jb >= ib) a = mm32<4>(Bt, KKt, ib, jb, lane, a);
#pragma unroll
                    for (int g = 0; g < 4; ++g)
#pragma unroll
                        for (int r = 0; r < 4; ++r) { const int jj = jb * 32 + 8 * g + jq + r; a[4 * g + r] = (i0 < jj) ? -a[4 * g + r] : 0.f; }
                    st32_lds(NA, ib, jb, lane, a); } }
        }
        LBAR();
        PRE_MARK(2);
        LAS bf16_t* VA = Kt;
#pragma unroll 1
        for (int s = 1; s <= 6; ++s) {
            const LAS bf16_t* Yo = (s & 1) ? NAT : KKt; const LAS bf16_t* YoT = (s & 1) ? NA : Bt; LAS bf16_t* Yn = (s & 1) ? KKt : NAT; LAS bf16_t* YnT = (s & 1) ? Bt : NA;
            if (pr_ == 0) {
                if (s == 1) { const f32x16 a0 = mm32<4>(VcT, AkkT, ib, 0, lane, zero16()), a1 = mm32<4>(VcT, AkkT, ib, 1, lane, zero16()); st32_lds(VA, ib, 0, lane, a0); st32_lds(VA, ib, 1, lane, a1); }
                else {
                    f32x16 c0, c1; const LAS bf16_t* tr = TT + i0 * RP + jq;
#pragma unroll
                    for (int g = 0; g < 4; ++g) { const f32x4 x0 = ld_l4(tr + 8 * g), x1 = ld_l4(tr + 32 + 8 * g);
#pragma unroll
                        for (int r = 0; r < 4; ++r) { c0[4 * g + r] = x0[r]; c1[4 * g + r] = x1[r]; } }
                    c0 = mm32<4>(TT, YoT, ib, 0, lane, c0); c1 = mm32<4>(TT, YoT, ib, 1, lane, c1);
                    LDS_WAIT();
                    st32_lds(TT, ib, 0, lane, c0); st32_lds(TT, ib, 1, lane, c1); }
            } else if (pr_ <= 2 && s <= 5) {
                const LAS bf16_t* Pm = pr_ == 1 ? Yo : YoT; const LAS bf16_t* Qm = pr_ == 1 ? YoT : Yo; LAS bf16_t* Om = pr_ == 1 ? Yn : YnT;
                const f32x16 a0 = mm32<4>(Pm, Qm, ib, 0, lane, zero16()), a1 = mm32<4>(Pm, Qm, ib, 1, lane, zero16()); st32_lds(Om, ib, 0, lane, a0); st32_lds(Om, ib, 1, lane, a1);
            }
            LBAR();
        }
        PRE_MARK(3);
        LAS bf16_t* KT = NAT; LAS bf16_t* P1 = NA;
        if (pr_ < 2) { const LAS bf16_t* src = pr_ == 0 ? KKtT : VA; LAS bf16_t* dst = pr_ == 0 ? KT : P1;
            const f32x16 a0 = mm32<4>(src, TT, ib, 0, lane, zero16()), a1 = mm32<4>(src, TT, ib, 1, lane, zero16()); st32_lds(dst, ib, 0, lane, a0); st32_lds(dst, ib, 1, lane, a1); }
        LBAR();
        {
            bf16_t* og = DIAG ? (bf16_t*)(ws + WS_YRW) + (size_t)(u & 255) * 4096 : (bf16_t*)(ws + WS_RC + (size_t)u * RC_UNIT) + pr_ * 4096;
#pragma unroll
            for (int jb = 0; jb < 2; ++jb) { f32x16 o;
                if (pr_ == 0) o = mm32<4>(BhT, KT, ib, jb, lane, zero16());
                else if (pr_ == 1) { const f32x16 x = mm32<4>(VcT, KhT, ib, jb, lane, zero16()), y = mm32<4>(P1, BhT, ib, jb, lane, zero16()); o = x - y; }
                else if (pr_ == 2) { const f32x16 y = mm32<4>(AbrT, KT, ib, jb, lane, zero16()); const LAS bf16_t* rt = Rt + i0 * RP + jb * 32 + jq;
#pragma unroll
                    for (int g = 0; g < 4; ++g) { const f32x4 x = ld_l4(rt + 8 * g);
#pragma unroll
                        for (int r = 0; r < 4; ++r) o[4 * g + r] = x[r] - y[4 * g + r]; } }
                else { const f32x16 x = mm32<4>(VcT, AkrT, ib, jb, lane, zero16()), y = mm32<4>(P1, AbrT, ib, jb, lane, zero16()); o = x - y; }
                st32_glb(og, ib, jb, lane, o); }
        }
        }
        PRE_MARK(4);
    }
    __syncthreads();
}

struct ScanOps { u32x4 fa0, fa1; u32x2 ad0, ad1; f32x4 om; };
__device__ __forceinline__ ScanOps scan_load(const unsigned char* ws, size_t u, int sk, int vh, int l15, int l4) {
    ScanOps o; const bf16_t* base = (const bf16_t*)(ws + WS_RC + u * RC_UNIT);
    o.fa0 = *(const u32x4*)(base + (sk * 16 + l15) * 64 + 8 * l4); o.fa1 = *(const u32x4*)(base + (sk * 16 + l15) * 64 + 32 + 8 * l4);
    o.ad0 = *(const u32x2*)(base + 4096 + ((2 * vh) * 16 + l15) * 64 + sk * 16 + 4 * l4); o.ad1 = *(const u32x2*)(base + 4096 + ((2 * vh + 1) * 16 + l15) * 64 + sk * 16 + 4 * l4);
    o.om = *(const f32x4*)((const float*)(ws + WS_RC2) + u * 128 + sk * 16 + 4 * l4); return o;
}
template <bool STORE>
__device__ __forceinline__ void rwkv_scan(const Frame& F, int b, int h) {
    unsigned char* ws = F.ws;
    LAS bf16_t* Sb = (LAS bf16_t*)F.lds;
    const int lane = F.lane, w = F.wave, l15 = lane & 15, l4 = lane >> 4, sk = w & 3, vh = w >> 2;
    for (int i = F.tid; i < 2 * RMAT / 2; i += NTHR) ((LAS unsigned*)Sb)[i] = 0u;
    const size_t u0 = (size_t)(b * 8 + h) * 128;
    f32x4 st0 = {0.f, 0.f, 0.f, 0.f}, st1 = {0.f, 0.f, 0.f, 0.f};
    ScanOps r0 = scan_load(ws, u0 + 0, sk, vh, l15, l4), r1 = scan_load(ws, u0 + 1, sk, vh, l15, l4), r2 = scan_load(ws, u0 + 2, sk, vh, l15, l4), r3 = scan_load(ws, u0 + 3, sk, vh, l15, l4);
    __syncthreads();
#define SCAN_STEP(R, cc) do { const int c_ = (cc); \
        const LAS bf16_t* Sc = Sb + (c_ & 1) * RMAT; LAS bf16_t* Sn = Sb + ((c_ + 1) & 1) * RMAT; \
        const bf16x8 a0 = __builtin_bit_cast(bf16x8, R.fa0), a1 = __builtin_bit_cast(bf16x8, R.fa1); \
        const LAS bf16_t* sp0 = Sc + ((2 * vh) * 16 + l15) * RP + 8 * l4; const LAS bf16_t* sp1 = sp0 + 16 * RP; \
        const bf16x8 s00 = *(const LAS bf16x8*)sp0, s01 = *(const LAS bf16x8*)(sp0 + 32), s10 = *(const LAS bf16x8*)sp1, s11 = *(const LAS bf16x8*)(sp1 + 32); \
        bf16_t* sg = (bf16_t*)(ws + WS_RC + (u0 + c_ - 1) * RC_UNIT) + 4096;     \
        if (STORE && c_ > 0) *(u32x4*)(sg + (F.tid >> 3) * 64 + (F.tid & 7) * 8) = *(const LAS u32x4*)(Sc + (F.tid >> 3) * RP + (F.tid & 7) * 8);     \
        f32x4 t0 = {0.f, 0.f, 0.f, 0.f}, t1 = {0.f, 0.f, 0.f, 0.f}; \
        t0 = __builtin_amdgcn_mfma_f32_16x16x32_bf16(a0, s00, t0, 0, 0, 0); t1 = __builtin_amdgcn_mfma_f32_16x16x32_bf16(a0, s10, t1, 0, 0, 0); \
        t0 = __builtin_amdgcn_mfma_f32_16x16x32_bf16(a1, s01, t0, 0, 0, 0); t1 = __builtin_amdgcn_mfma_f32_16x16x32_bf16(a1, s11, t1, 0, 0, 0); \
        const f32x4 n0 = {bflo(R.ad0.x), bfhi(R.ad0.x), bflo(R.ad0.y), bfhi(R.ad0.y)}, n1 = {bflo(R.ad1.x), bfhi(R.ad1.x), bflo(R.ad1.y), bfhi(R.ad1.y)}; \
        st0 = st0 * R.om - t0 + n0; st1 = st1 * R.om - t1 + n1; \
        st_bf4(Sn + ((2 * vh) * 16 + l15) * RP + sk * 16 + 4 * l4, st0); st_bf4(Sn + ((2 * vh + 1) * 16 + l15) * RP + sk * 16 + 4 * l4, st1); \
        R = scan_load(ws, u0 + (c_ + 4 < NCHUNK ? c_ + 4 : NCHUNK - 1), sk, vh, l15, l4);     \
        LBAR(); } while (0)
#pragma unroll 1
    for (int c = 0; c < NCHUNK; c += 16) {
#pragma unroll
        for (int j = 0; j < 16; j += 4) { SCAN_STEP(r0, c + j); SCAN_STEP(r1, c + j + 1); SCAN_STEP(r2, c + j + 2); SCAN_STEP(r3, c + j + 3); } }
#undef SCAN_STEP
}

__device__ __forceinline__ void rwkv_out(const Frame& F, const float* lnx_) {
    unsigned char* ws = F.ws; const bf16_t* lo = (const bf16_t*)(ws + WS_LO);
    LAS float* Yl = (LAS float*)F.lds;
    const int lane = F.lane, w = F.wave, l15 = lane & 15, l4 = lane >> 4, tb = w & 3, vh = w >> 2;
    const int tt = F.tid >> 3, c8 = (F.tid & 7) * 8;
    for (int u = F.blk; u < NB * 8 * NCHUNK; u += F.G) {
        const int c = u & 127, h = (u >> 7) & 7, b = u >> 10;
        const bf16_t* base = (const bf16_t*)(ws + WS_RC + (size_t)u * RC_UNIT);
        const bf16_t* Sg = (const bf16_t*)(ws + WS_RC + (size_t)(u > 0 ? u - 1 : 0) * RC_UNIT) + 4096; const bf16_t* QT = base + 8192; const bf16_t* Z = base + 12288;
        const bf16x8 q0 = *(const bf16x8*)(QT + (tb * 16 + l15) * 64 + 8 * l4), q1 = *(const bf16x8*)(QT + (tb * 16 + l15) * 64 + 32 + 8 * l4);
        f32x4 y[2];
#pragma unroll
        for (int i = 0; i < 2; ++i) { const int ib = 2 * vh + i; const bf16_t* sp = Sg + (ib * 16 + l15) * 64 + 8 * l4; const bf16x8 s0 = *(const bf16x8*)sp, s1 = *(const bf16x8*)(sp + 32);
            const u32x2 zw = *(const u32x2*)(Z + (ib * 16 + l15) * 64 + tb * 16 + 4 * l4);
            f32x4 t = {bflo(zw.x), bfhi(zw.x), bflo(zw.y), bfhi(zw.y)};
            if (c > 0) { t = __builtin_amdgcn_mfma_f32_16x16x32_bf16(q0, s0, t, 0, 0, 0); t = __builtin_amdgcn_mfma_f32_16x16x32_bf16(q1, s1, t, 0, 0, 0); }
            y[i] = t; }
        const int m = b * SEQ + c * 64 + tt, chq = h * 64 + c8;
        const u32x4 cv = *(const u32x4*)(base + 16384 + tt * 64 + c8), cg = *(const u32x4*)(lo + (size_t)m * LO_W + 1024 + chq);
        const float cbc = ((const float*)(ws + WS_RC2))[(size_t)u * 128 + 64 + tt];
        const f32x4 ln0 = *(const f32x4*)(lnx_ + chq), ln1 = *(const f32x4*)(lnx_ + chq + 4);
        LBAR();
#pragma unroll
        for (int i = 0; i < 2; ++i)
#pragma unroll
            for (int r = 0; r < 4; ++r) Yl[(tb * 16 + 4 * l4 + r) * 68 + (2 * vh + i) * 16 + l15] = y[i][r];
        LBAR();
        const f32x4 ya = *(const LAS f32x4*)(Yl + tt * 68 + c8), yb = *(const LAS f32x4*)(Yl + tt * 68 + c8 + 4);
        float yy[8] = {ya[0], ya[1], ya[2], ya[3], yb[0], yb[1], yb[2], yb[3]};
        float s1 = ((yy[0] + yy[1]) + (yy[2] + yy[3])) + ((yy[4] + yy[5]) + (yy[6] + yy[7]));
        s1 = sum8(s1); const float mean = s1 * (1.0f / 64.0f); float s2 = 0.f;
#pragma unroll
        for (int i = 0; i < 8; ++i) { yy[i] -= mean; s2 += yy[i] * yy[i]; }
        s2 = sum8(s2); const float rstd = rsqrtf(s2 * (1.0f / 64.0f) + 64e-5f);
        const unsigned vw[4] = {cv.x, cv.y, cv.z, cv.w}, gw[4] = {cg.x, cg.y, cg.z, cg.w};
        const float lnx[8] = {ln0[0], ln0[1], ln0[2], ln0[3], ln1[0], ln1[1], ln1[2], ln1[3]};
        unsigned ow[4];
#pragma unroll
        for (int i = 0; i < 4; ++i) { float o2[2];
#pragma unroll
            for (int e = 0; e < 2; ++e) { const int ci = 2 * i + e; const float v = e ? bfhi(vw[i]) : bflo(vw[i]), g = e ? bfhi(gw[i]) : bflo(gw[i]);
                o2[e] = (yy[ci] * rstd * lnx[ci] + cbc * v) * g; }
            ow[i] = pk2(o2[0], o2[1]); }
        *(u32x4*)((bf16_t*)(ws + WS_YRW) + (size_t)m * 512 + chq) = (u32x4){ow[0], ow[1], ow[2], ow[3]};
    }
    __syncthreads();
}
__device__ __forceinline__ void rwkv_seq(const Frame& F, const Params& P, int layer, int b, int h) {
    unsigned char* ws = F.ws; const bf16_t* p = (const bf16_t*)(ws + WS_P); const bf16_t* lo = (const bf16_t*)(ws + WS_LO);
    LAS float* Lr = (LAS float*)F.lds; LAS float* Lw = Lr + 4096; LAS float* Lk = Lw + 4096; LAS float* Lv = Lk + 4096; LAS float* Lkk = Lv + 4096; LAS float* Lb = Lkk + 4096; LAS float* Ly = Lb + 4096;
    const int lane = F.lane, ch = h * 64 + lane;
    const float mu_r = P.in[I_MU][(size_t)layer * RWKV_COLS + ch], mu_k = P.in[I_MU][(size_t)layer * RWKV_COLS + 512 + ch], mu_v = P.in[I_MU][(size_t)layer * RWKV_COLS + 1024 + ch];
    const float k_k = P.in[I_KK][layer * 512 + ch], k_a = P.in[I_KA][layer * 512 + ch], r_k = P.in[I_RK][layer * 512 + ch], lnx = P.in[I_LNX][layer * 512 + ch];
    const int vrow = F.tid >> 3, q = F.tid & 7;
    float s[8];
#pragma unroll
    for (int i = 0; i < 8; ++i) s[i] = 0.f;
    for (int c = 0; c < NCHUNK; ++c) {
        const int m0 = b * SEQ + c * 64;
        __syncthreads();
#pragma unroll
        for (int i = 0; i < 8; ++i) { const int t = F.wave + 8 * i, m = m0 + t; const bf16_t* pr = p + (size_t)m * PW + P_RW + ch; const bool hp = (c | t) != 0;
            const float xr = bf2f(pr[0]), xk = bf2f(pr[512]), xv = bf2f(pr[1024]);
            const float pr_ = hp ? bf2f(pr[-PW]) : 0.f, pk_ = hp ? bf2f(pr[512 - PW]) : 0.f, pv_ = hp ? bf2f(pr[1024 - PW]) : 0.f;
            const float r = xr + (pr_ - xr) * mu_r, k = xk + (pk_ - xk) * mu_k, v = xv + (pv_ - xv) * mu_v;
            const float lw = bf2f(lo[(size_t)m * LO_W + ch]), a = bf2f(lo[(size_t)m * LO_W + 512 + ch]);
            float kk = k * k_k; const float ss = wave_sum(kk * kk); kk *= rsqrtf(ss + 1e-12f);
            Lr[t * 64 + lane] = r; Lw[t * 64 + lane] = __expf(lw); Lk[t * 64 + lane] = k * (1.0f + (a - 1.0f) * k_a); Lv[t * 64 + lane] = v; Lkk[t * 64 + lane] = kk; Lb[t * 64 + lane] = kk * a; }
        __syncthreads();
        for (int t = 0; t < 64; ++t) {
            const f32x4 ka = *(const LAS f32x4*)(Lkk + t * 64 + q * 8), kb = *(const LAS f32x4*)(Lkk + t * 64 + q * 8 + 4);
            const f32x4 wa = *(const LAS f32x4*)(Lw + t * 64 + q * 8), wb = *(const LAS f32x4*)(Lw + t * 64 + q * 8 + 4);
            const f32x4 ba = *(const LAS f32x4*)(Lb + t * 64 + q * 8), bb = *(const LAS f32x4*)(Lb + t * 64 + q * 8 + 4);
            const f32x4 k2a = *(const LAS f32x4*)(Lk + t * 64 + q * 8), k2b = *(const LAS f32x4*)(Lk + t * 64 + q * 8 + 4);
            const f32x4 ra = *(const LAS f32x4*)(Lr + t * 64 + q * 8), rb = *(const LAS f32x4*)(Lr + t * 64 + q * 8 + 4);
            const float vv = Lv[t * 64 + vrow];
            float sa = 0.f;
#pragma unroll
            for (int i = 0; i < 4; ++i) { sa += s[i] * ka[i]; sa += s[4 + i] * kb[i]; }
            sa = sum8(sa); sa = -sa;
            float y = 0.f;
#pragma unroll
            for (int i = 0; i < 4; ++i) { s[i] = s[i] * wa[i] + sa * ba[i] + vv * k2a[i]; s[4 + i] = s[4 + i] * wb[i] + sa * bb[i] + vv * k2b[i]; y += s[i] * ra[i]; y += s[4 + i] * rb[i]; }
            y = sum8(y);
            if (q == 0) Ly[t * 64 + vrow] = y;
        }
        __syncthreads();
#pragma unroll
        for (int i = 0; i < 8; ++i) { const int t = F.wave + 8 * i, m = m0 + t;
            const float y = Ly[t * 64 + lane]; const float mean = wave_sum(y) * (1.0f / 64.0f); const float d = y - mean; const float var = wave_sum(d * d) * (1.0f / 64.0f);
            const float bon = wave_sum(Lr[t * 64 + lane] * Lk[t * 64 + lane] * r_k);
            const float g = bf2f(lo[(size_t)m * LO_W + 1024 + ch]);
            const float o = (d * rsqrtf(var + 64e-5f) * lnx + bon * Lv[t * 64 + lane]) * g;
            ((bf16_t*)(ws + WS_YRW))[(size_t)m * 512 + ch] = (bf16_t)f2bf(o); }
    }
    __syncthreads();
}

constexpr int LDS_TAB = LDSCTL_OFF + 64;
__device__ __forceinline__ void moe_table(const Frame& F, const unsigned* ectl) {
    LAS int* tab = (LAS int*)(F.lds + LDS_TAB);
    if (F.tid == 0) { int st = 0, nt = 0;
        for (int e = 0; e < 8; ++e) { const int c = (int)__hip_atomic_load(&ectl[e], __ATOMIC_RELAXED, __HIP_MEMORY_SCOPE_AGENT); tab[1 + e] = st; const int t = (c + 255) >> 8; for (int i = 0; i < t; ++i) tab[16 + nt + i] = e; nt += t; st += t * 256; }
        tab[0] = nt; }
    __syncthreads();
}
__device__ __forceinline__ void phase_moe_scatter(const Frame& F, const unsigned* ectl) {
    unsigned char* ws = F.ws; const LAS int* tab = (const LAS int*)(F.lds + LDS_TAB);
    const int* tok_e = (const int*)(ws + WS_TOK); int* tok_slot = (int*)tok_e + 2 * MTOK; const float* tok_w = (const float*)(tok_slot + 2 * MTOK);
    int* row_tok = (int*)(tok_w + 2 * MTOK); float* row_w = (float*)(row_tok + MAXROWS);
    for (int i = F.blk * NTHR + F.tid; i < 2 * MTOK; i += F.G * NTHR) { const int e = tok_e[i]; const int dest = tab[1 + e] + tok_slot[i]; row_tok[dest] = i >> 1; row_w[dest] = tok_w[i]; tok_slot[i] = dest; }
    const int gt = F.blk * NTHR + F.tid;
    if (gt < 2048) { const int e = gt >> 8; const int c = (int)__hip_atomic_load(&ectl[e], __ATOMIC_RELAXED, __HIP_MEMORY_SCOPE_AGENT); const int r = c + (gt & 255);
        if (r < ((c + 255) & ~255)) { row_tok[tab[1 + e] + r] = -1; row_w[tab[1 + e] + r] = 0.f; } }
}
constexpr int LDS_GTAB = RING_BYTES;
__device__ __forceinline__ void moe_gather_table(const Frame& F, int ncol) {
    const LAS int* tab = (const LAS int*)(F.lds + LDS_TAB); LAS unsigned* gt = (LAS unsigned*)(F.lds + LDS_GTAB);
    const int* row_tok = (const int*)(F.ws + WS_TOK) + 6 * MTOK; const int total = tab[0] * ncol;
    for (int i = F.tid; i < 9 * 256; i += NTHR) { const int u = i >> 8, r = i & 255; const int L = u * F.G + F.blk; unsigned off = 0u;
        if (L < total) { const int tk = row_tok[(L / ncol) * 256 + r]; off = tk > 0 ? (unsigned)tk * (unsigned)(DM * 2) : 0u; }
        gt[i] = off; }
    __syncthreads();
}

extern __shared__ __attribute__((aligned(16))) unsigned char lds_raw[];
template <class T> __device__ __forceinline__ T* uni(T* p) { const unsigned long long v = (unsigned long long)p; const unsigned lo = __builtin_amdgcn_readfirstlane((unsigned)v), hi = __builtin_amdgcn_readfirstlane((unsigned)(v >> 32)); return (T*)(((unsigned long long)hi << 32) | lo); }
__device__ __forceinline__ int uni(int v) { return __builtin_amdgcn_readfirstlane(v); }
__device__ __forceinline__ Frame mkframe(unsigned char* ws, int wv) {
    Frame F; F.lds = (LAS unsigned char*)lds_raw; int tid = wv * 64 + lane_id_fresh(); F.tid = tid; F.lane = F.tid & 63; F.wave = __builtin_amdgcn_readfirstlane(F.tid >> 6);
    int blk = blockIdx.x; asm volatile("" : "+s"(blk)); F.blk = blk; F.G = gridDim.x; F.vcu = (F.blk & 7) * (F.G >> 3) + (F.blk >> 3); F.gw = F.blk * NWAVES + F.wave; F.ngw = F.G * NWAVES; F.ws = ws; return F;
}
#define PHASE __device__ __forceinline__ void
template <int PART>
PHASE f_moe_convert(int wv, unsigned char* ws_, const float* mg, const float* mu, const float* md) {
    unsigned char* ws = uni(ws_); const Frame F = mkframe(ws, wv); Params P; P.in[I_MG] = uni(mg); P.in[I_MU2] = uni(mu); P.in[I_MD] = uni(md);
    if (PART == 0) { __syncthreads(); phase_moe_convert<0>(F, P, F.gw, F.ngw); }
    else if (F.blk >= 32) { __syncthreads(); phase_moe_convert<1>(F, P, (F.blk - 32) * NWAVES + F.wave, (F.G - 32) * NWAVES); }
}
PHASE f_rms(int wv, unsigned char* ws_, const float* src, const float* gain) { unsigned char* ws = uni(ws_); const Frame F = mkframe(ws, wv); phase_rms<false>(F, uni(src), uni(gain), (bf16_t*)(ws + WS_HN), nullptr, nullptr, nullptr, nullptr, nullptr); }
PHASE f_rms_moe(int wv, unsigned char* ws_, const float* src, const float* gain, const float* router) {
    unsigned char* ws = uni(ws_); const Frame F = mkframe(ws, wv); int* tok_e = (int*)(ws + WS_TOK); int* tok_slot = tok_e + 2 * MTOK; float* tok_w = (float*)(tok_slot + 2 * MTOK);
    phase_rms<true>(F, uni(src), uni(gain), (bf16_t*)(ws + WS_HN), uni(router), (unsigned*)(ws + WS_CTL) + CW_ECNT, tok_e, tok_slot, tok_w);
}
PHASE f_prep(int wv, unsigned char* ws_, const float* mu, const float* qnorm, const float* kvnorm, int layer_) {
    unsigned char* ws = uni(ws_); const Frame F = mkframe(ws, wv); Params P; P.in[I_MU] = uni(mu); P.in[I_QNORM] = uni(qnorm); P.in[I_KVNORM] = uni(kvnorm); (void)layer_; phase_prep(F, P, 0);
}
PHASE f_ret_scan(int wv, unsigned char* ws_) { unsigned char* ws = uni(ws_); const Frame F = mkframe(ws, wv); ret_scan(F); }
PHASE f_ret_out(int wv, unsigned char* ws_) { unsigned char* ws = uni(ws_); const Frame F = mkframe(ws, wv); ret_out(F); }
PHASE f_rwkv_seq(int wv, unsigned char* ws_, const float* mu, const float* kk, const float* ka, const float* rk, const float* lnx, int layer_) {
    unsigned char* ws = uni(ws_); const Frame F = mkframe(ws, wv); Params P; P.in[I_MU] = uni(mu); P.in[I_KK] = uni(kk); P.in[I_KA] = uni(ka); P.in[I_RK] = uni(rk); P.in[I_LNX] = uni(lnx);
    (void)layer_; rwkv_seq(F, P, 0, F.blk >> 3, F.blk & 7);
}
PHASE f_rwkv_pre(int wv, unsigned char* ws_, const float* mu, const float* kk, const float* ka, const float* rk) { unsigned char* ws = uni(ws_); const Frame F = mkframe(ws, wv); rwkv_chunk_pre<0>(F, uni(mu), uni(kk), uni(ka), uni(rk));
#ifdef PRE_DIAG
    rwkv_chunk_pre<PRE_DIAG>(F, uni(mu), uni(kk), uni(ka), uni(rk));
#endif
}
PHASE f_rwkv_scan(int wv, unsigned char* ws_) { unsigned char* ws = uni(ws_); const Frame F = mkframe(ws, wv); rwkv_scan<true>(F, F.blk >> 3, F.blk & 7);
#ifdef SCAN_TWICE
    __syncthreads(); rwkv_scan<false>(F, F.blk >> 3, F.blk & 7);
#endif
}
PHASE f_rwkv_out(int wv, unsigned char* ws_, const float* lnx) { unsigned char* ws = uni(ws_); const Frame F = mkframe(ws, wv); rwkv_out(F, uni(lnx)); }
PHASE f_attn(int wv, unsigned char* ws_, int layer_) {
    unsigned char* ws = uni(ws_); const int layer = uni(layer_); const Frame F = mkframe(ws, wv);
    unsigned* qh = (unsigned*)(ws + WS_CTL) + CW_ATTQ + layer * 512; volatile LAS unsigned* slot = (volatile LAS unsigned*)(F.lds + LDSCTL_OFF + 32);
    const int my = (int)(xb_xcc_id() & 7u);
    for (int k = 0; k < 8; ++k) { const int q = (my + k) & 7;
        for (;;) {
            if (F.tid == 0) *slot = __hip_atomic_fetch_add(qh + q * 64, 1u, __ATOMIC_RELAXED, __HIP_MEMORY_SCOPE_AGENT);
            __syncthreads();
            const int idx = (int)*slot;
            __syncthreads();
            if (idx >= 64) break;
            const int bh = 2 * q + (idx & 1), qt = 31 - (idx >> 1);
            attn_unit(F, bh >> 3, bh & 7, qt);
        } }
}
PHASE f_moe_scatter(int wv, unsigned char* ws_) { unsigned char* ws = uni(ws_); const Frame F = mkframe(ws, wv); moe_table(F, (unsigned*)(ws + WS_CTL) + CW_ECNT); phase_moe_scatter(F, (unsigned*)(ws + WS_CTL) + CW_ECNT); }
PHASE f_final(int wv, unsigned char* ws_, float* h, const float* gain) { unsigned char* ws = uni(ws_); const Frame F = mkframe(ws, wv); phase_final(F, uni(h), uni(gain), (const bf16_t*)(ws + WS_OUT2), (const int*)(ws + WS_TOK) + 2 * MTOK); }
PHASE g_inproj(int wv, unsigned char* ws_, int layer_) {
    unsigned char* ws = uni(ws_); const int layer = uni(layer_); const Frame F = mkframe(ws, wv);
    SchedGrid S; S.init(64, 18, F.G, F.blk, ws + WS_HN, (size_t)256 * DM * 2, (bf16_t*)(ws + WS_WIN) + (size_t)layer * WIN_ROWS * DM, (size_t)256 * DM * 2);
    EpiStore E; E.O = (bf16_t*)(ws + WS_P); E.ld = PW; E.SS = (const float*)(ws + WS_SS); E.rl = (LAS float*)(F.lds + RING_BYTES); E.tid = F.tid; pg8::gemm_phase(F.lds, F.tid, DM, DM, DM, S, E);
}
PHASE g_lora(int wv, unsigned char* ws_, const float* w0, const float* a0, int layer_) {
    unsigned char* ws = uni(ws_); const int layer = uni(layer_); const Frame F = mkframe(ws, wv);
    SchedGrid S; S.init(64, 6, F.G, F.blk, ws + WS_LIN, (size_t)256 * LORA_K * 2, (bf16_t*)(ws + WS_LORA) + (size_t)layer * 1536 * LORA_K, (size_t)256 * LORA_K * 2);
    EpiLora E; E.O = (bf16_t*)(ws + WS_LO); E.w0 = uni(w0); E.a0 = uni(a0); pg8::gemm_phase(F.lds, F.tid, LORA_K, LORA_K, LORA_K, S, E);
}
PHASE g_small(int wv, unsigned char* ws_, int layer_) {
    unsigned char* ws = uni(ws_); const Frame F = mkframe(ws, wv); SchedSmall S; S.G = F.G; S.c = F.blk; S.layer = uni(layer_); S.ws = (const char*)ws; EpiSmall E; E.ws = ws; pg8::gemm_phase(F.lds, F.tid, 256, 256, 256, S, E);
}
PHASE g_gate(int wv, unsigned char* ws_, int layer_) {
    unsigned char* ws = uni(ws_); const int layer = uni(layer_); const Frame F = mkframe(ws, wv);
    SchedOwn3 S; S.c = F.blk; S.G = F.G; S.A = (const char*)(ws + WS_HN); S.a_n = 0; S.astep = (size_t)256 * DM * 2; S.B = (const char*)((bf16_t*)(ws + WS_WIN) + ((size_t)layer * WIN_ROWS + PW) * DM); S.bstep = (size_t)256 * DM * 2; S.b_n = (size_t)1024 * DM * 2;
    EpiGate E; E.O = (bf16_t*)(ws + WS_G); E.SS = (const float*)(ws + WS_SS); E.rl = (LAS float*)(F.lds + RING_BYTES); E.tid = F.tid; pg8::gemm_phase(F.lds, F.tid, DM, DM, DM, S, E);
}
PHASE g_merge(int wv, unsigned char* ws_, int layer_) {
    unsigned char* ws = uni(ws_); const int layer = uni(layer_); const Frame F = mkframe(ws, wv);
    SchedOwn3 S; S.c = F.blk; S.G = F.G; S.A = (const char*)(ws + WS_YRET); S.a_n = (size_t)16 * MiB; S.astep = (size_t)256 * 512 * 2;
    S.B = (const char*)((bf16_t*)(ws + WS_BR) + (size_t)layer * 3 * 1024 * 512); S.bstep = (size_t)256 * 512 * 2; S.b_n = (size_t)1024 * 512 * 2;
    EpiMerge E; E.Gt = (const bf16_t*)(ws + WS_G); E.Mg = (bf16_t*)(ws + WS_MRG); pg8::gemm_phase(F.lds, F.tid, 512, 512, 512, S, E);
}
template <bool EMIT>
PHASE g_wo(int wv, unsigned char* ws_, const float* hin, float* hout, const float* gain, int layer_) {
    unsigned char* ws = uni(ws_); const int layer = uni(layer_); const Frame F = mkframe(ws, wv);
    SchedGrid S; S.init(64, 4, F.G, F.blk, ws + WS_MRG, (size_t)256 * DM * 2, (bf16_t*)(ws + WS_WO) + (size_t)layer * DM * DM, (size_t)256 * DM * 2);
    EpiResid<EMIT> E; E.In = uni(hin); E.Out = uni(hout); E.gain = uni(gain); E.Hg = (bf16_t*)(ws + WS_HN); E.SS = (float*)(ws + WS_SS); pg8::gemm_phase(F.lds, F.tid, DM, DM, DM, S, E);
}
PHASE g_ffn_gu(int wv, unsigned char* ws_) {
    unsigned char* ws = uni(ws_); const Frame F = mkframe(ws, wv);
    SchedGrid S; S.init(64, 22, F.G, F.blk, ws + WS_HN, (size_t)256 * DM * 2, ws + WS_FGU, (size_t)256 * DM * 2);
    EpiSwiglu E; E.O = (bf16_t*)(ws + WS_ACT); E.ldc = DFF; E.pn_off = 0; E.SS = (const float*)(ws + WS_SS); E.rl = (LAS float*)(F.lds + RING_BYTES); E.tid = F.tid; pg8::gemm_phase(F.lds, F.tid, DM, DM, DM, S, E);
}
PHASE g_ffn_down(int wv, unsigned char* ws_, float* h, const float* gain) {
    unsigned char* ws = uni(ws_); const Frame F = mkframe(ws, wv);
    SchedGrid S; S.init(64, 4, F.G, F.blk, ws + WS_ACT, (size_t)256 * DFF * 2, ws + WS_FD, (size_t)256 * DFF * 2);
    EpiResid<true> E; E.In = uni(h); E.Out = (float*)E.In; E.gain = uni(gain); E.Hg = (bf16_t*)(ws + WS_HN); E.SS = (float*)(ws + WS_SS); pg8::gemm_phase(F.lds, F.tid, DFF, DFF, DFF, S, E);
}
PHASE g_moe_gu(int wv, unsigned char* ws_, int hh_) {
    unsigned char* ws = uni(ws_); const int hh = uni(hh_); const Frame F = mkframe(ws, wv); const LAS int* tab = (const LAS int*)(F.lds + LDS_TAB);
    moe_gather_table(F, 14);
    SchedMoe S; S.G = F.G; S.c = F.blk; S.ncol = 14; S.ntile = tab[0]; S.tab = tab + 16; S.A = (const char*)(ws + WS_HN); S.astep = 0;
    S.B = (const char*)(ws + WS_MGU) + (size_t)hh * 14 * 256 * DM * 2; S.bstep = (size_t)256 * DM * 2; S.estep = (size_t)2 * DFFE * DM * 2;
    EpiSwiglu E; E.O = (bf16_t*)(ws + WS_MACT); E.ldc = DFFH; E.pn_off = 0; E.SS = nullptr; E.rl = nullptr; E.tid = 0; pg8::gemm_phase<EpiSwiglu, SchedMoe, true>(F.lds, F.tid, DM, DM, DM, S, E, (const LAS unsigned*)(F.lds + LDS_GTAB));
}
template <bool ACCUM>
PHASE g_moe_down(int wv, unsigned char* ws_, int hh_) {
    unsigned char* ws = uni(ws_); const int hh = uni(hh_); const Frame F = mkframe(ws, wv); const LAS int* tab = (const LAS int*)(F.lds + LDS_TAB);
    const float* row_w = (const float*)((const int*)(ws + WS_TOK) + 6 * MTOK + MAXROWS);
    SchedMoe S; S.G = F.G; S.c = F.blk; S.ncol = 4; S.ntile = tab[0]; S.tab = tab + 16; S.A = (const char*)(ws + WS_MACT); S.astep = (size_t)256 * DFFH * 2;
    S.B = (const char*)(ws + WS_MD) + (size_t)hh * DFFH * 2; S.bstep = (size_t)256 * DFFE * 2; S.estep = (size_t)DM * DFFE * 2;
    EpiMoeOut<ACCUM> E; E.row_w = row_w; E.O = (bf16_t*)(ws + WS_OUT2); pg8::gemm_phase(F.lds, F.tid, DFFH, DFFH, DFFE, S, E);
}

typedef const __attribute__((address_space(4))) Params* KPtr;
__device__ __forceinline__ KPtr kargs() { KPtr k = (KPtr)__builtin_amdgcn_kernarg_segment_ptr(); asm volatile("" : "+s"(k)); return k; }
#define KIN(i) (kargs()->in[i])
#define KWS() (kargs()->ws)
struct TpState { unsigned long long tp0, tp1; int tpk; };
#define tp0 tps.tp0
#define tp1 tps.tp1
#define tpk tps.tpk
#define GRID_BAR() do { XcdBarrier b_ = bar; b_.bar = (unsigned*)(KWS() + WS_CTL) + CW_BAR; b_.x = xb_xcc_id(); xcd_barrier(b_); } while (0)
#ifdef TPH
#define TP(k) do { volatile LAS unsigned long long* tpl_ = (volatile LAS unsigned long long*)(lds_raw + LDSCTL_OFF + 48); if ((k) == TPH) tpl_[0] = __builtin_amdgcn_s_memrealtime(); if ((k) == TPH + TPN) tpl_[1] = __builtin_amdgcn_s_memrealtime(); } while (0)
#define TPM() do { ++tpk; TP(tpk); } while (0)
#else
#define TP(k) do { } while (0)
#define TPM() do { } while (0)
#endif
template <int layer>
__device__ __forceinline__ void layer_body(const int wv, const XcdBarrier& bar, TpState& tps) {
        g_inproj(wv, KWS(), layer);
        GRID_BAR();
        TPM();
        f_prep(wv, KWS(), KIN(I_MU) + (size_t)layer * RWKV_COLS, KIN(I_QNORM) + layer * 256, KIN(I_KVNORM) + layer * 128, layer);
        GRID_BAR();
        TPM();
        f_ret_scan(wv, KWS());
        g_lora(wv, KWS(), KIN(I_W0) + layer * 512, KIN(I_A0) + layer * 512, layer);
        g_small(wv, KWS(), layer);
        GRID_BAR();
        TPM();
        f_ret_out(wv, KWS());
#ifdef SPLIT5
        GRID_BAR();
        TPM();
#endif
#ifndef RWKV_SEQ
        f_rwkv_pre(wv, KWS(), KIN(I_MU) + (size_t)layer * RWKV_COLS, KIN(I_KK) + layer * 512, KIN(I_KA) + layer * 512, KIN(I_RK) + layer * 512);
        GRID_BAR();
        TPM();
        if ((int)blockIdx.x < 16) f_rwkv_scan(wv, KWS());
#ifdef SPLIT6
        GRID_BAR();
        TPM();
#endif
#else
        GRID_BAR();
        TPM();
        if (blockIdx.x < 16) f_rwkv_seq(wv, KWS(), KIN(I_MU) + (size_t)layer * RWKV_COLS, KIN(I_KK) + layer * 512, KIN(I_KA) + layer * 512, KIN(I_RK) + layer * 512, KIN(I_LNX) + layer * 512, layer);
#endif
        f_attn(wv, KWS(), layer);
        GRID_BAR();
        TPM();
#ifndef RWKV_SEQ
        f_rwkv_out(wv, KWS(), KIN(I_LNX) + layer * 512);
#endif
        g_gate(wv, KWS(), layer);
#ifndef RWKV_SEQ
        GRID_BAR();
        TPM();
#endif
        g_merge(wv, KWS(), layer);
        GRID_BAR();
        TPM();
        g_wo<layer == 0>(wv, KWS(), layer == 0 ? KIN(I_X) : (const float*)kargs()->out, kargs()->out, KIN(I_FNORM) + layer * DM, layer);
        GRID_BAR();
        TPM();
        if constexpr (layer == 0) {
            g_ffn_gu(wv, KWS());
            GRID_BAR();
            TPM();
            g_ffn_down(wv, KWS(), kargs()->out, KIN(I_ANORM) + DM);
            GRID_BAR();
            TPM();
        } else {
            f_rms_moe(wv, KWS(), kargs()->out, KIN(I_FNORM) + layer * DM, KIN(I_ROUTER));
            f_moe_convert<0>(wv, KWS(), KIN(I_MG), KIN(I_MU2), KIN(I_MD));
            GRID_BAR();
            TPM();
            f_moe_scatter(wv, KWS());
            GRID_BAR();
            TPM();
            g_moe_gu(wv, KWS(), 0);
            GRID_BAR();
            TPM();
            g_moe_down<false>(wv, KWS(), 0);
            f_moe_convert<1>(wv, KWS(), KIN(I_MG), KIN(I_MU2), KIN(I_MD));
            GRID_BAR();
            TPM();
            g_moe_gu(wv, KWS(), 1);
            GRID_BAR();
            TPM();
            g_moe_down<true>(wv, KWS(), 1);
            GRID_BAR();
            TPM();
        }
    }
__global__ void __launch_bounds__(NTHR, 2) mega(Params P_unused) {
    LAS unsigned char* lds = (LAS unsigned char*)lds_raw;
    const int wv = __builtin_amdgcn_readfirstlane((int)threadIdx.x >> 6);
    for (int u = threadIdx.x; u < (LDS_BYTES - LDSCTL_OFF) / 4; u += NTHR) ((LAS unsigned*)(lds + LDSCTL_OFF))[u] = 0u;
    __syncthreads();
    const XcdBarrier bar = xcd_barrier_post((unsigned*)(KWS() + WS_CTL) + CW_BAR, (volatile LAS unsigned*)(lds + LDSCTL_OFF), wv);
    TpState tps = {0ull, 0ull, 0};
    TP(0);
    {
        KPtr k = kargs(); unsigned char* ws = k->ws; const Frame F = mkframe(ws, wv);
        Params P; P.in[I_WIN] = k->in[I_WIN]; P.in[I_WQB] = k->in[I_WQB]; P.in[I_WBR] = k->in[I_WBR]; P.in[I_WO] = k->in[I_WO]; P.in[I_FG] = k->in[I_FG]; P.in[I_FU] = k->in[I_FU]; P.in[I_FD] = k->in[I_FD];
        P.in[I_W2] = k->in[I_W2]; P.in[I_A2] = k->in[I_A2]; P.in[I_G2] = k->in[I_G2]; P.in[I_WKVB] = k->in[I_WKVB]; P.in[I_POS] = k->in[I_POS]; P.in[I_X] = k->in[I_X]; P.in[I_ANORM] = k->in[I_ANORM];
        phase_prologue(F, P);
    }
    GRID_BAR();
    TPM();
    layer_body<0>(wv, bar, tps);
    layer_body<1>(wv, bar, tps);
    f_final(wv, KWS(), kargs()->out, KIN(I_FINAL));
#ifdef PRE_T
    __syncthreads();
    { volatile LAS unsigned long long* tq_ = (volatile LAS unsigned long long*)(lds_raw + LDSCTL_OFF + 48); const unsigned long long te = __builtin_amdgcn_s_memrealtime(), span = tq_[1] * 8ull; while (__builtin_amdgcn_s_memrealtime() - te < span) __builtin_amdgcn_s_sleep(8); }
#endif
#ifdef TPH
    __syncthreads(); TPM();
    { volatile LAS unsigned long long* tpl_ = (volatile LAS unsigned long long*)(lds_raw + LDSCTL_OFF + 48); const unsigned long long te = __builtin_amdgcn_s_memrealtime(), span = (tpl_[1] - tpl_[0]) * (unsigned long long)TAMP; while (__builtin_amdgcn_s_memrealtime() - te < span) __builtin_amdgcn_s_sleep(8); }
#endif
}

extern "C" void kernel_launch(void* const* d_in, const int* in_sizes, int n_in, void* d_out, int out_size, void* d_ws, size_t ws_size, hipStream_t stream) {
    static int ready = 0;
    if (!ready) {
        if (n_in != 29 || out_size != MTOK * DM || ws_size < WS_END) { fprintf(stderr, "kernel_launch: unexpected shapes (n_in %d out %d ws %zu need %zu)\n", n_in, out_size, ws_size, (size_t)WS_END); ready = -1; return; }
        if (hipFuncSetAttribute((const void*)mega, hipFuncAttributeMaxDynamicSharedMemorySize, LDS_BYTES) != hipSuccess) { fprintf(stderr, "kernel_launch: hipFuncSetAttribute failed\n"); ready = -1; return; }
        int dev = 0, cus = 0, per_cu = 0; (void)hipGetDevice(&dev); (void)hipDeviceGetAttribute(&cus, hipDeviceAttributeMultiprocessorCount, dev);
        (void)hipOccupancyMaxActiveBlocksPerMultiprocessor(&per_cu, (const void*)mega, NTHR, LDS_BYTES);
        if (cus < 256 || per_cu < 1) { fprintf(stderr, "kernel_launch: needs 256 CUs with one resident workgroup each (cus %d, per_cu %d)\n", cus, per_cu); ready = -1; return; }
        ready = 1;
    }
    if (ready < 0) return;
    (void)hipMemsetAsync((char*)d_ws + WS_CTL, 0, CTL_BYTES, stream);
    Params p{}; for (int i = 0; i < 29; ++i) p.in[i] = (const float*)d_in[i]; p.out = (float*)d_out; p.ws = (unsigned char*)d_ws;
    hipLaunchKernelGGL(mega, dim3(256), dim3(NTHR), LDS_BYTES, stream, p);
}
```

```cpp
#include <hip/hip_runtime.h>
#include <cstdio>
#include <cstdint>

#define LAS __attribute__((address_space(3)))
#define GAS __attribute__((address_space(1)))
typedef unsigned short bf16_t;
typedef short bf16x8 __attribute__((ext_vector_type(8)));
typedef short bf16x4 __attribute__((ext_vector_type(4)));
typedef float f32x4 __attribute__((ext_vector_type(4)));
typedef float f32x2 __attribute__((ext_vector_type(2)));
typedef float f32x16 __attribute__((ext_vector_type(16)));
typedef unsigned u32x4 __attribute__((ext_vector_type(4)));
typedef unsigned u32x2 __attribute__((ext_vector_type(2)));

constexpr int NB = 2, SEQ = 8192, DM = 1024, MTOK = NB * SEQ, NLAYER = 2, CH = 64, NCHUNK = SEQ / CH;
constexpr int IN_COLS = 7360, PW = 4608;
constexpr int P_RQ = 0, P_RK = 512, P_RV = 1024, P_RG = 1536, P_RW = 2048, P_QA = 4096, P_KVA = 4352;
constexpr int WIN_ROWS = 7680;
constexpr int RWKV_COLS = 1824, LORA_K = 384, LO_W = 1536;
constexpr int DFF = 2816, DFFE = 3584, NEXP = 8, DFFH = DFFE / 2;
constexpr int MAXROWS = 34816;
constexpr float NORM_EPS = 1e-6f;

constexpr size_t MiB = 1u << 20;
constexpr size_t WS_CTL = 0, CTL_BYTES = 1 * MiB;
constexpr size_t WS_WIN = 1 * MiB;
constexpr size_t WS_LORA = 31 * MiB;
constexpr size_t WS_QB = 34 * MiB;
constexpr size_t WS_KB = 35 * MiB;
constexpr size_t WS_VB = 35 * MiB + 512 * 1024;
constexpr size_t WS_BR = 36 * MiB;
constexpr size_t WS_WO = 42 * MiB;
constexpr size_t WS_FGU = 46 * MiB;
constexpr size_t WS_FD = 57 * MiB;
constexpr size_t WS_COSR = 63 * MiB, WS_SINR = 67 * MiB, WS_COSM = 71 * MiB, WS_SINM = 72 * MiB;
constexpr size_t WS_HN = 73 * MiB;
constexpr size_t WS_TOK = 105 * MiB;
constexpr size_t WS_T = 106 * MiB;
constexpr size_t WS_P = WS_T;
constexpr size_t WS_G = WS_T;
constexpr size_t WS_MRG = WS_T + 96 * MiB;
constexpr size_t WS_LO = WS_T + 144 * MiB;
constexpr size_t WS_Q = WS_T + 192 * MiB;
constexpr size_t WS_KN = WS_T + 216 * MiB;
constexpr size_t WS_VT = WS_T + 232 * MiB;
constexpr size_t WS_KPE = WS_T + 248 * MiB;
constexpr size_t WS_LIN = WS_T + 249 * MiB;
constexpr size_t WS_QN = WS_T + 261 * MiB;
constexpr size_t WS_CN = WS_T + 269 * MiB;
constexpr size_t WS_YRET = WS_T + 261 * MiB;
constexpr size_t WS_RS = WS_T + 277 * MiB;
constexpr size_t WS_YRW = WS_T + 277 * MiB;
constexpr size_t WS_YMLA = WS_T + 293 * MiB;
constexpr size_t WS_RC = WS_T + 309 * MiB;
constexpr size_t WS_ACT = WS_T;
constexpr size_t WS_MGU = WS_T;
constexpr size_t WS_MD = WS_T + 112 * MiB;
constexpr size_t WS_MACT = WS_T + 168 * MiB;
constexpr size_t WS_OUT2 = WS_T + 287 * MiB;
constexpr size_t WS_SS = WS_T + 390 * MiB;
constexpr size_t WS_END = WS_T + 391 * MiB;
static_assert(WS_MACT + (size_t)MAXROWS * DFFH * 2 <= WS_OUT2 && WS_OUT2 + (size_t)MAXROWS * DM * 2 <= WS_END, "ws map");
constexpr int CW_BAR = 4096;
constexpr int CW_ECNT = 16384;
constexpr int CW_ATTQ = 20480;

__device__ __forceinline__ unsigned f2bf(float f) { unsigned u = __builtin_bit_cast(unsigned, f); return (u + 0x7fffu + ((u >> 16) & 1u)) >> 16; }
typedef __bf16 bf16n2 __attribute__((ext_vector_type(2)));
__device__ __forceinline__ unsigned pk2(float lo, float hi) { const f32x2 f = {lo, hi}; const bf16n2 v = __builtin_convertvector(f, bf16n2); return __builtin_bit_cast(unsigned, v); }
__device__ __forceinline__ float bf2f(unsigned short h) { return __builtin_bit_cast(float, (unsigned)h << 16); }
__device__ __forceinline__ float bflo(unsigned w) { return __builtin_bit_cast(float, w << 16); }
__device__ __forceinline__ float bfhi(unsigned w) { return __builtin_bit_cast(float, w & 0xffff0000u); }
template <int CTRL, int ROWMASK = 0xF>
__device__ __forceinline__ float dpp_add(float v) { const int t = __builtin_amdgcn_update_dpp(0, __builtin_bit_cast(int, v), CTRL, ROWMASK, 0xF, ROWMASK == 0xF); return v + __builtin_bit_cast(float, t); }
#ifdef NO_DPP
__device__ __forceinline__ float sum4(float v)  { v += __shfl_xor(v, 1); v += __shfl_xor(v, 2); return v; }
__device__ __forceinline__ float sum8(float v)  { v = sum4(v); v += __shfl_xor(v, 4); return v; }
__device__ __forceinline__ float sum16(float v) { v = sum8(v); v += __shfl_xor(v, 8); return v; }
__device__ __forceinline__ float wave_sum(float v) { v = sum16(v); v += __shfl_xor(v, 16); v += __shfl_xor(v, 32); return v; }
#else
__device__ __forceinline__ float sum4(float v)  { v = dpp_add<0xB1>(v); return dpp_add<0x4E>(v); }
__device__ __forceinline__ float sum8(float v)  { return dpp_add<0x141>(sum4(v)); }
__device__ __forceinline__ float sum16(float v) { return dpp_add<0x140>(sum8(v)); }
__device__ __forceinline__ float wave_sum(float v) {
    v = sum16(v); v = dpp_add<0x142, 0xA>(v); v = dpp_add<0x143, 0xC>(v);
    return __builtin_bit_cast(float, __builtin_amdgcn_readlane(__builtin_bit_cast(int, v), 63));
}
#endif
__device__ __forceinline__ float sigmoidf_(float x) { return 1.0f / (1.0f + __expf(-x)); }
#define LDS_WAIT() asm volatile("s_waitcnt lgkmcnt(0)" ::: "memory")
#define LBAR() do { asm volatile("s_waitcnt lgkmcnt(0)" ::: "memory"); __builtin_amdgcn_s_barrier(); asm volatile("" ::: "memory"); } while (0)
#define VM_WAIT() asm volatile("s_waitcnt vmcnt(0)" ::: "memory")

#define XB_TMO      128
#define XB_XCNT(j)  (256  + 64 * (j))
#define XB_XSUB(j)  (1280 + 64 * (j))
#define XB_XGEN(j)  (2304 + 64 * (j))
#define XB_TOP      3328
#define XB_TOPGEN   3392
#define XCD_BAR_WORDS 3456
#define XB_SPIN_CAP (1u << 18)
__device__ __forceinline__ unsigned xb_ld(unsigned* p)              { return __hip_atomic_load(p, __ATOMIC_RELAXED, __HIP_MEMORY_SCOPE_AGENT); }
__device__ __forceinline__ unsigned xb_add(unsigned* p, unsigned v) { return __hip_atomic_fetch_add(p, v, __ATOMIC_RELAXED, __HIP_MEMORY_SCOPE_AGENT); }
__device__ __forceinline__ unsigned xb_xcc_id() { return (unsigned)__builtin_amdgcn_s_getreg((3 << 11) | 20) & 0xFu; }
#define XB_SPIN(cond, bar) do { unsigned _sp = 0; while (cond) { __builtin_amdgcn_s_sleep(1); \
    if ((++_sp & 255u) == 0u) { if (xb_ld(&(bar)[XB_TMO])) break; if (_sp > XB_SPIN_CAP) { atomicAdd(&(bar)[XB_TMO], 1u); break; } } } } while (0)
struct XcdBarrier { unsigned* bar; unsigned x; volatile LAS unsigned* st; int wv; };
__device__ __forceinline__ int lane_id_fresh() { int l; asm volatile("v_mbcnt_lo_u32_b32 %0, -1, 0\n\tv_mbcnt_hi_u32_b32 %0, -1, %0" : "=v"(l)); return l; }
__device__ __forceinline__ bool xb_thread0(int wv) { return wv == 0 && lane_id_fresh() == 0; }
__device__ __forceinline__ XcdBarrier xcd_barrier_post(unsigned* bar, volatile LAS unsigned* st, int wv) {
    XcdBarrier b; b.bar = bar; b.x = xb_xcc_id(); b.st = st; b.wv = wv;
    if (xb_thread0(wv)) (void)xb_add(&bar[XB_XCNT(b.x)], 1u);
    return b;
}
__device__ __forceinline__ void xcd_barrier_complete(unsigned* bar, unsigned x, unsigned& nloc, unsigned& nx) {
    const unsigned G = gridDim.x * gridDim.y * gridDim.z;
    unsigned sum, cnt, mine, sp = 0u;
    for (;;) {
        sum = 0u; cnt = 0u; mine = 0u;
#pragma unroll
        for (unsigned j = 0; j < 16; ++j) { const unsigned c = xb_ld(&bar[XB_XCNT(j)]); sum += c; cnt += (c > 0u) ? 1u : 0u; mine = (j == x) ? c : mine; }
        if (sum == G) break;
        __builtin_amdgcn_s_sleep(1);
        if ((++sp & 255u) == 0u) { if (xb_ld(&bar[XB_TMO])) break; if (sp > XB_SPIN_CAP) { atomicAdd(&bar[XB_TMO], 1u); break; } }
    }
    nloc = mine > 0u ? mine : 1u; nx = cnt > 0u ? cnt : 1u;
}
__device__ __forceinline__ void xcd_barrier(const XcdBarrier& b) {
    asm volatile("s_waitcnt vmcnt(0)" ::: "memory");
    __syncthreads();
    if (xb_thread0(b.wv)) {
        unsigned* bar = b.bar;
        __builtin_amdgcn_s_waitcnt(0);
        unsigned nloc = b.st[0], nx = b.st[1];
        if (nloc == 0u) { xcd_barrier_complete(bar, b.x, nloc, nx); b.st[0] = nloc; b.st[1] = nx; }
        const unsigned old = xb_add(&bar[XB_XSUB(b.x)], 1u);
        const unsigned gen = old / nloc;
        if (old + 1u == (gen + 1u) * nloc) {
            __builtin_amdgcn_fence(__ATOMIC_RELEASE, "agent");
            asm volatile("s_waitcnt vmcnt(0)" ::: "memory");
            const unsigned og = xb_add(&bar[XB_TOP], 1u);
            const unsigned tg = og / nx;
            if (og + 1u == (tg + 1u) * nx) xb_add(&bar[XB_TOPGEN], 1u);
            else XB_SPIN(xb_ld(&bar[XB_TOPGEN]) == tg, bar);
            __builtin_amdgcn_fence(__ATOMIC_ACQUIRE, "agent");
            xb_add(&bar[XB_XGEN(b.x)], 1u);
            asm volatile("s_waitcnt vmcnt(0)" ::: "memory");
        } else {
            XB_SPIN(xb_ld(&bar[XB_XGEN(b.x)]) == gen, bar);
            __builtin_amdgcn_fence(__ATOMIC_ACQUIRE, "agent");
            asm volatile("s_waitcnt vmcnt(0)" ::: "memory");
        }
    }
    __syncthreads();
}

namespace pg8 {
constexpr int BM = 256, BK = 64, HALF = 128, HTB = HALF * BK * 2, STAGE_BYTES = 8 * HTB;
__device__ __forceinline__ int lds_byte(int r, int c) { const int st = (r >> 4) * 2 + (c >> 5), rr = r & 15, cc = c & 31, ob = rr * 64 + cc * 2; return st * 1024 + (ob ^ (((ob >> 9) & 1) << 5)); }
__device__ __forceinline__ void stage_rc(int b, int& R, int& C) { const int st = b / 1024, sb = b % 1024, swz = sb ^ (((sb >> 9) & 1) << 5); R = (st >> 1) * 16 + swz / 64; C = (st & 1) * 32 + (swz % 64) / 2; }
__device__ __forceinline__ int perm32(int rho) { const int n = rho >> 4, i = rho & 15; return 8 * (i >> 2) + 4 * n + (i & 3); }
struct Unit { int pm, pn, aux; const char* A; const char* B; };
__device__ __forceinline__ unsigned cvt_pk_bf16(float lo, float hi) { return pk2(lo, hi); }

template <class Epi, class Sched, bool GATHER = false>
__device__ __forceinline__ void gemm_phase(LAS unsigned char* lds, const int tid_in, const int K, const int lda, const int ldb, const Sched& S, const Epi& E, const LAS unsigned* gtab = nullptr) {
    int tid_ = tid_in; asm volatile("" : "+v"(tid_));
    const int tid = tid_, wid = __builtin_amdgcn_readfirstlane(tid >> 6), lane = tid & 63, wr = wid >> 2, wc = wid & 3, fr = lane & 15, fq = lane >> 4;
    const int nt = K / BK;
    unsigned voffA[2], voffB[2];
#pragma unroll
    for (int i = 0; i < 2; ++i) { int R, C; stage_rc(tid * 16 + i * 8192, R, C); const int Rb = Epi::PERM ? ((R & ~31) + perm32(R & 31)) : R;
        voffA[i] = (unsigned)(R * lda + C) * 2u; voffB[i] = (unsigned)(Rb * ldb + C) * 2u; }
    const size_t kstep = (size_t)(BK * 2);
    const size_t hstepA = GATHER ? (size_t)0 : (size_t)HALF * lda * 2, hstepB = (size_t)HALF * ldb * 2;
    int gR[2], gC[2]; unsigned gcur[2][2], gnxt[2][2];
    if constexpr (GATHER) {
#pragma unroll
        for (int i = 0; i < 2; ++i) { int R, C; stage_rc(tid * 16 + i * 8192, R, C); gR[i] = R; gC[i] = C * 2; }
    }
#define PG8_GLOAD(dst, u_) do { _Pragma("unroll") for (int _h = 0; _h < 2; ++_h) _Pragma("unroll") for (int _i = 0; _i < 2; ++_i) dst[_h][_i] = gtab[(u_) * 256 + _h * 128 + gR[_i]] + (unsigned)gC[_i]; } while (0)
    const unsigned ldsw = (unsigned)wid * 1024u;
    const int aoff = lds_byte(wr * 64 + fr, fq * 8), boff = lds_byte(wc * 32 + fr, fq * 8);
#define PG8_SA(b, h) (((b) * 2 + (h)) * HTB)
#define PG8_SB(b, h) ((4 + (b) * 2 + (h)) * HTB)
#define PG8_STAGE(bufoff, gbase, voff) do { _Pragma("unroll") for (int _i = 0; _i < 2; ++_i) \
        __builtin_amdgcn_global_load_lds((const unsigned*)((const char*)(gbase) + (voff)[_i]), (LAS unsigned*)(lds + (bufoff) + ldsw + _i * 8192), 16, 0, 0); } while (0)
#define PG8_STAGEA(bufoff, gbase, h, tab) do { if constexpr (GATHER) { PG8_STAGE(bufoff, gbase, tab[h]); } else { PG8_STAGE(bufoff, (gbase) + (h) * hstepA, voffA); } } while (0)
#define PG8_LDA(dst, b, h) do { _Pragma("unroll") for (int m = 0; m < 4; ++m) _Pragma("unroll") for (int k = 0; k < 2; ++k) dst[m][k] = *(const LAS bf16x8*)(lds + PG8_SA(b, h) + aoff + m * 2048 + k * 1024); } while (0)
#define PG8_LDB(dst, b, h) do { _Pragma("unroll") for (int n = 0; n < 2; ++n) _Pragma("unroll") for (int k = 0; k < 2; ++k) dst[n][k] = *(const LAS bf16x8*)(lds + PG8_SB(b, h) + boff + n * 2048 + k * 1024); } while (0)
#define PG8_MMA(ai, bj, At, Bt) do { __builtin_amdgcn_s_setprio(1); _Pragma("unroll") for (int m = 0; m < 4; ++m) _Pragma("unroll") for (int n = 0; n < 2; ++n) _Pragma("unroll") for (int k = 0; k < 2; ++k) \
        acc[ai][bj][m][n] = __builtin_amdgcn_mfma_f32_16x16x32_bf16(Bt[n][k], At[m][k], acc[ai][bj][m][n], 0, 0, 0); __builtin_amdgcn_s_setprio(0); } while (0)
#define PG8_WAIT_V(n) asm volatile("s_waitcnt vmcnt(" #n ")" ::: "memory")
#define PG8_WAIT_L(n) asm volatile("s_waitcnt lgkmcnt(" #n ")" ::: "memory")
#define PG8_BAR __builtin_amdgcn_s_barrier()
#define PG8_SCHED __builtin_amdgcn_sched_barrier(0)
    Unit cur, nxt; int ui = 0;
    if (!S.next(0, cur)) return;
    f32x4 acc[2][2][4][2];
#pragma unroll
    for (int a = 0; a < 2; ++a)
#pragma unroll
        for (int b = 0; b < 2; ++b)
#pragma unroll
            for (int m = 0; m < 4; ++m)
#pragma unroll
                for (int n = 0; n < 2; ++n) acc[a][b][m][n] = (f32x4){0.f, 0.f, 0.f, 0.f};
    bf16x8 At[4][2], B0[2][2], B1[2][2];
    const char* cA = cur.A; const char* cB = cur.B;
    if constexpr (GATHER) { PG8_GLOAD(gcur, 0); PG8_GLOAD(gnxt, 1); asm volatile("s_waitcnt lgkmcnt(0)" ::: "memory"); }
    PG8_STAGE(PG8_SB(0, 0), cB, voffB); PG8_STAGE(PG8_SB(0, 1), cB + hstepB, voffB); PG8_STAGEA(PG8_SA(0, 0), cA, 0, gcur); PG8_STAGEA(PG8_SA(0, 1), cA, 1, gcur);
    if (wr == 1) PG8_BAR;
    PG8_WAIT_V(2); PG8_BAR;
    PG8_STAGE(PG8_SB(1, 0), cB + kstep, voffB); PG8_STAGEA(PG8_SA(1, 0), cA + kstep, 0, gcur); PG8_STAGE(PG8_SB(1, 1), cB + hstepB + kstep, voffB);
    PG8_WAIT_V(6); PG8_BAR;
#pragma unroll 1
    for (;;) {
        const bool has_next = S.next(ui + 1, nxt);
        const char* nA = has_next ? nxt.A : cA; const char* nB = has_next ? nxt.B : cB;
#pragma unroll 1
        for (int t = 0; t < nt; t += 2) {
            const bool last = (t == nt - 2);
            const char* a1 = cA + (size_t)(t + 1) * kstep;
            const char* a2 = last ? nA : cA + (size_t)(t + 2) * kstep; const char* b2 = last ? nB : cB + (size_t)(t + 2) * kstep;
            const char* a3 = a2 + kstep; const char* b3 = b2 + kstep;
            unsigned g2[2][2];
            if constexpr (GATHER) {
#pragma unroll
                for (int _h = 0; _h < 2; ++_h)
#pragma unroll
                    for (int _i = 0; _i < 2; ++_i) g2[_h][_i] = last ? gnxt[_h][_i] : gcur[_h][_i]; }
            PG8_LDB(B0, 0, 0); PG8_LDB(B1, 0, 1); PG8_SCHED; PG8_LDA(At, 0, 0); PG8_STAGEA(PG8_SA(1, 1), a1, 1, gcur);
            PG8_WAIT_V(8); PG8_WAIT_L(0); PG8_BAR; PG8_MMA(0, 0, At, B0); PG8_MMA(0, 1, At, B1); PG8_BAR; PG8_SCHED;
            PG8_LDA(At, 0, 1); PG8_STAGE(PG8_SB(0, 0), b2, voffB); PG8_STAGE(PG8_SB(0, 1), b2 + hstepB, voffB); PG8_STAGEA(PG8_SA(0, 0), a2, 0, g2);
            PG8_WAIT_V(8); PG8_WAIT_L(0); PG8_BAR; PG8_MMA(1, 0, At, B0); PG8_MMA(1, 1, At, B1); PG8_BAR; PG8_SCHED;
            PG8_LDB(B0, 1, 0); PG8_LDB(B1, 1, 1); PG8_SCHED; PG8_LDA(At, 1, 0); PG8_STAGEA(PG8_SA(0, 1), a2, 1, g2);
            PG8_WAIT_V(8); PG8_WAIT_L(0); PG8_BAR; PG8_MMA(0, 0, At, B0); PG8_MMA(0, 1, At, B1); PG8_BAR; PG8_SCHED;
            PG8_LDA(At, 1, 1); PG8_STAGE(PG8_SB(1, 0), b3, voffB); PG8_STAGE(PG8_SB(1, 1), b3 + hstepB, voffB); PG8_STAGEA(PG8_SA(1, 0), a3, 0, g2);
            PG8_WAIT_V(8); PG8_WAIT_L(0); PG8_BAR; PG8_MMA(1, 0, At, B0); PG8_MMA(1, 1, At, B1); PG8_BAR; PG8_SCHED;
        }
        if (wr == 0) PG8_BAR;
        E(acc, cur, wr, wc, fr, fq);
        if (!has_next) break;
#pragma unroll
        for (int a = 0; a < 2; ++a)
#pragma unroll
            for (int b = 0; b < 2; ++b)
#pragma unroll
                for (int m = 0; m < 4; ++m)
#pragma unroll
                    for (int n = 0; n < 2; ++n) acc[a][b][m][n] = (f32x4){0.f, 0.f, 0.f, 0.f};
        cur = nxt; cA = nA; cB = nB; ++ui;
        if constexpr (GATHER) {
#pragma unroll
            for (int _h = 0; _h < 2; ++_h)
#pragma unroll
                for (int _i = 0; _i < 2; ++_i) gcur[_h][_i] = gnxt[_h][_i];
            PG8_GLOAD(gnxt, ui + 1); }
        if (wr == 1) PG8_BAR;
    }
    PG8_WAIT_V(0);
    PG8_BAR;
#undef PG8_SA
#undef PG8_SB
#undef PG8_STAGE
#undef PG8_STAGEA
#undef PG8_GLOAD
#undef PG8_LDA
#undef PG8_LDB
#undef PG8_MMA
#undef PG8_WAIT_V
#undef PG8_WAIT_L
#undef PG8_BAR
#undef PG8_SCHED
}
}
constexpr int NWAVES = 8, NTHR = 512;
constexpr int RING_BYTES = 131072, LDS_BYTES = 147456, LDSCTL_OFF = LDS_BYTES - 2048;
struct Params { const float* in[29]; float* out; unsigned char* ws; };
struct Frame {
    LAS unsigned char* lds; int tid, lane, wave, blk, G, vcu, gw, ngw; unsigned char* ws;
};
enum { I_X = 0, I_POS, I_ANORM, I_WIN, I_MU, I_W0, I_W2, I_A0, I_A2, I_G2, I_KK, I_KA, I_RK, I_LNX, I_QNORM, I_WQB, I_KVNORM, I_WKVB, I_WBR, I_WO, I_FNORM,
       I_FG, I_FU, I_FD, I_ROUTER, I_MG, I_MU2, I_MD, I_FINAL };

struct SchedGrid {
    int nM, nN, nwg, G, c; const char* A; const char* B; size_t astep, bstep;
    __device__ void init(int nM_, int nN_, int G_, int c_, const void* A_, size_t astep_, const void* B_, size_t bstep_) { nM = nM_; nN = nN_; nwg = nM * nN; G = G_; c = c_; A = (const char*)A_; B = (const char*)B_; astep = astep_; bstep = bstep_; }
    __device__ __forceinline__ bool next(int i, pg8::Unit& u) const {
        const long L = (long)i * G + c; if (L >= nwg) return false;
        int wgid = (int)L; { const int q = nwg / 8, r = nwg % 8, xcd = wgid % 8, off = wgid / 8; wgid = (xcd < r ? xcd * (q + 1) : r * (q + 1) + (xcd - r) * q) + off; }
        const int nig = 8 * nN, gid = wgid / nig, fm = gid * 8, gsz = (nM - fm) < 8 ? (nM - fm) : 8;
        u.pm = fm + ((wgid % nig) % gsz); u.pn = (wgid % nig) / gsz; u.aux = 0;
        u.A = A + (size_t)u.pm * astep; u.B = B + (size_t)u.pn * bstep; return true;
    }
};
struct SchedSmall {
    int G, c, layer; const char* ws;
    __device__ __forceinline__ bool next(int i, pg8::Unit& u) const {
        int L = i * G + c; if (L >= 448) return false;
        int s = 0; if (L >= 192) { L -= 192; s = 1; if (L >= 128) { L -= 128; s = 2; } }
        const int nn = s == 0 ? 3 : (s == 1 ? 2 : 64);
        u.pm = L / nn; u.pn = L % nn; u.aux = s;
        const size_t lw = (size_t)layer * 256 * 2;
        const size_t ao = s == 0 ? WS_QN : (s == 1 ? WS_CN : WS_VB + lw * 512), bo = s == 0 ? WS_QB + lw * 768 : (s == 1 ? WS_KB + lw * 512 : WS_CN);
        u.A = ws + ao + (size_t)u.pm * (256 * 256 * 2); u.B = ws + bo + (size_t)u.pn * (256 * 256 * 2); return true;
    }
};
struct SchedOwn3 {
    int c, G; const char* A; const char* B; size_t astep, bstep, a_n, b_n;
    __device__ __forceinline__ bool next(int i, pg8::Unit& u) const {
        const int t = c + (i / 3) * G; if (t >= 256) return false;
        const int n = i % 3; u.pm = t >> 2; u.pn = t & 3; u.aux = n; u.A = A + (size_t)u.pm * astep + (size_t)n * a_n; u.B = B + (size_t)u.pn * bstep + (size_t)n * b_n; return true;
    }
};
struct SchedMoe {
    int G, c, ncol, ntile; const LAS int* tab; const char* A; const char* B; size_t astep, bstep, estep;
    __device__ __forceinline__ bool next(int i, pg8::Unit& u) const {
        const int L = i * G + c; if (L >= ntile * ncol) return false;
        u.pm = L / ncol; u.pn = L % ncol; const int e = tab[u.pm]; u.aux = e;
        u.A = A + (size_t)u.pm * astep; u.B = B + (size_t)e * estep + (size_t)u.pn * bstep; return true;
    }
};

using pg8::Unit; using pg8::cvt_pk_bf16;
#define EPI_ARGS const f32x4 (&acc)[2][2][4][2], const Unit& u, int wr, int wc, int fr, int fq
__device__ __forceinline__ float row_rstd(const float* SS, int row) {
    const f32x4* s = (const f32x4*)(SS + (size_t)row * 16); const f32x4 a = s[0], b = s[1], c = s[2], d = s[3];
    const float t = ((a.x + a.y) + (a.z + a.w)) + ((b.x + b.y) + (b.z + b.w)) + ((c.x + c.y) + (c.z + c.w)) + ((d.x + d.y) + (d.z + d.w));
    return rsqrtf(t * (1.0f / DM) + NORM_EPS);
}
__device__ __forceinline__ void panel_rstd(const float* SS, int pm, int tid, LAS float* rl) {
    if (tid < 256) rl[tid] = row_rstd(SS, pm * 256 + tid);
    asm volatile("s_waitcnt lgkmcnt(0)" ::: "memory"); __builtin_amdgcn_s_barrier(); asm volatile("" ::: "memory");
}
struct EpiStore {
    static constexpr bool PERM = true;
    bf16_t* O; int ld; const float* SS; LAS float* rl; int tid;
    __device__ __forceinline__ void operator()(EPI_ARGS) const {
        const int row0 = u.pm * 256 + wr * 64 + fr, col0 = u.pn * 256 + wc * 32 + 8 * fq;
        if (SS) panel_rstd(SS, u.pm, tid, rl);
#pragma unroll
        for (int ai = 0; ai < 2; ++ai)
#pragma unroll
            for (int m = 0; m < 4; ++m) { bf16_t* rowp = O + (size_t)(row0 + ai * 128 + m * 16) * ld + col0; const float rs = SS ? rl[wr * 64 + fr + ai * 128 + m * 16] : 1.0f;
#pragma unroll
                for (int bj = 0; bj < 2; ++bj) { const f32x4 v0 = acc[ai][bj][m][0] * rs, v1 = acc[ai][bj][m][1] * rs;
                    u32x4 w; w.x = cvt_pk_bf16(v0[0], v0[1]); w.y = cvt_pk_bf16(v0[2], v0[3]); w.z = cvt_pk_bf16(v1[0], v1[1]); w.w = cvt_pk_bf16(v1[2], v1[3]);
                    *(u32x4*)(rowp + bj * 128) = w; } }
    }
};
struct EpiSmall {
    static constexpr bool PERM = true;
    unsigned char* ws;
    __device__ __forceinline__ void operator()(EPI_ARGS) const {
        bf16_t* base = (bf16_t*)(ws + (u.aux == 0 ? WS_Q : (u.aux == 1 ? WS_KN : WS_VT))); const int ld = u.aux == 0 ? 768 : (u.aux == 1 ? 512 : MTOK);
        const int row0 = u.pm * 256 + wr * 64 + fr, col0 = u.pn * 256 + wc * 32 + 8 * fq;
#pragma unroll
        for (int ai = 0; ai < 2; ++ai)
#pragma unroll
            for (int m = 0; m < 4; ++m) { bf16_t* rowp = base + (size_t)(row0 + ai * 128 + m * 16) * ld + col0;
#pragma unroll
                for (int bj = 0; bj < 2; ++bj) { const f32x4 v0 = acc[ai][bj][m][0], v1 = acc[ai][bj][m][1];
                    u32x4 w; w.x = cvt_pk_bf16(v0[0], v0[1]); w.y = cvt_pk_bf16(v0[2], v0[3]); w.z = cvt_pk_bf16(v1[0], v1[1]); w.w = cvt_pk_bf16(v1[2], v1[3]);
                    *(u32x4*)(rowp + bj * 128) = w; } }
    }
};
struct EpiLora {
    static constexpr bool PERM = true;
    bf16_t* O; const float* w0; const float* a0;
    __device__ __forceinline__ void operator()(EPI_ARGS) const {
        const int seg = u.pn >> 1;
        const int row0 = u.pm * 256 + wr * 64 + fr, col0 = u.pn * 256 + wc * 32 + 8 * fq, ch0 = (u.pn & 1) * 256 + wc * 32 + 8 * fq;
        const float* bias = seg == 0 ? w0 : a0; const float sc = seg == 0 ? -0.6065306597126334f : 1.0f;
#pragma unroll
        for (int bj = 0; bj < 2; ++bj) {
            f32x4 b0 = {0.f, 0.f, 0.f, 0.f}, b1 = {0.f, 0.f, 0.f, 0.f};
            if (seg < 2) { b0 = *(const f32x4*)(bias + ch0 + bj * 128); b1 = *(const f32x4*)(bias + ch0 + bj * 128 + 4); }
#pragma unroll
            for (int ai = 0; ai < 2; ++ai)
#pragma unroll
                for (int m = 0; m < 4; ++m) { bf16_t* rowp = O + (size_t)(row0 + ai * 128 + m * 16) * LO_W + col0 + bj * 128;
                    f32x4 v0 = acc[ai][bj][m][0] + b0, v1 = acc[ai][bj][m][1] + b1;
                    if (seg < 2) {
#pragma unroll
                        for (int j = 0; j < 4; ++j) { v0[j] = sc * sigmoidf_(v0[j]); v1[j] = sc * sigmoidf_(v1[j]); }
                    }
                    u32x4 w; w.x = cvt_pk_bf16(v0[0], v0[1]); w.y = cvt_pk_bf16(v0[2], v0[3]); w.z = cvt_pk_bf16(v1[0], v1[1]); w.w = cvt_pk_bf16(v1[2], v1[3]);
                    *(u32x4*)rowp = w; }
        }
    }
};
struct EpiGate {
    static constexpr bool PERM = true;
    bf16_t* O; const float* SS; LAS float* rl; int tid;
    __device__ __forceinline__ void operator()(EPI_ARGS) const {
        const int row0 = u.pm * 256 + wr * 64 + fr, col0 = u.aux * 1024 + u.pn * 256 + wc * 32 + 8 * fq;
        panel_rstd(SS, u.pm, tid, rl);
#pragma unroll
        for (int ai = 0; ai < 2; ++ai)
#pragma unroll
            for (int m = 0; m < 4; ++m) { bf16_t* rowp = O + (size_t)(row0 + ai * 128 + m * 16) * 3072 + col0; const float rs = rl[wr * 64 + fr + ai * 128 + m * 16];
#pragma unroll
                for (int bj = 0; bj < 2; ++bj) { f32x4 v0 = acc[ai][bj][m][0] * rs, v1 = acc[ai][bj][m][1] * rs;
#pragma unroll
                    for (int j = 0; j < 4; ++j) { v0[j] = sigmoidf_(v0[j]); v1[j] = sigmoidf_(v1[j]); }
                    u32x4 w; w.x = cvt_pk_bf16(v0[0], v0[1]); w.y = cvt_pk_bf16(v0[2], v0[3]); w.z = cvt_pk_bf16(v1[0], v1[1]); w.w = cvt_pk_bf16(v1[2], v1[3]);
                    *(u32x4*)(rowp + bj * 128) = w; } }
    }
};
struct EpiMerge {
    static constexpr bool PERM = true;
    const bf16_t* Gt; bf16_t* Mg;
    __device__ __forceinline__ void operator()(EPI_ARGS) const {
        const int n = u.aux;
        const int row0 = u.pm * 256 + wr * 64 + fr, col0 = u.pn * 256 + wc * 32 + 8 * fq;
#pragma unroll
        for (int ai = 0; ai < 2; ++ai)
#pragma unroll
            for (int m = 0; m < 4; ++m) { const size_t r = (size_t)(row0 + ai * 128 + m * 16);
#pragma unroll
                for (int bj = 0; bj < 2; ++bj) { const f32x4 v0 = acc[ai][bj][m][0], v1 = acc[ai][bj][m][1];
                    const u32x4 g = *(const u32x4*)(Gt + r * 3072 + n * 1024 + col0 + bj * 128);
                    float o[8] = {bflo(g.x) * v0[0], bfhi(g.x) * v0[1], bflo(g.y) * v0[2], bfhi(g.y) * v0[3], bflo(g.z) * v1[0], bfhi(g.z) * v1[1], bflo(g.w) * v1[2], bfhi(g.w) * v1[3]};
                    bf16_t* mp = Mg + r * 1024 + col0 + bj * 128;
                    if (n > 0) { const u32x4 p = *(const u32x4*)mp; o[0] += bflo(p.x); o[1] += bfhi(p.x); o[2] += bflo(p.y); o[3] += bfhi(p.y); o[4] += bflo(p.z); o[5] += bfhi(p.z); o[6] += bflo(p.w); o[7] += bfhi(p.w); }
                    u32x4 w; w.x = cvt_pk_bf16(o[0], o[1]); w.y = cvt_pk_bf16(o[2], o[3]); w.z = cvt_pk_bf16(o[4], o[5]); w.w = cvt_pk_bf16(o[6], o[7]);
                    *(u32x4*)mp = w; } }
    }
};
template <bool EMIT>
struct EpiResid {
    static constexpr bool PERM = false;
    const float* In; float* Out; const float* gain; bf16_t* Hg; float* SS;
    __device__ __forceinline__ void operator()(EPI_ARGS) const {
        const int row0 = u.pm * 256 + wr * 64 + fr, col0 = u.pn * 256 + wc * 32 + 4 * fq;
        f32x4 gv[2][2];
        if (EMIT) {
#pragma unroll
            for (int bj = 0; bj < 2; ++bj)
#pragma unroll
                for (int n = 0; n < 2; ++n) gv[bj][n] = *(const f32x4*)(gain + col0 + bj * 128 + n * 16); }
#pragma unroll
        for (int ai = 0; ai < 2; ++ai)
#pragma unroll
            for (int m = 0; m < 4; ++m) { const int row = row0 + ai * 128 + m * 16; const size_t o = (size_t)row * DM + col0; float sq = 0.f;
#pragma unroll
                for (int bj = 0; bj < 2; ++bj)
#pragma unroll
                    for (int n = 0; n < 2; ++n) { const f32x4 x = *(const f32x4*)(In + o + bj * 128 + n * 16) + acc[ai][bj][m][n]; *(f32x4*)(Out + o + bj * 128 + n * 16) = x;
                        if (EMIT) { sq += (x[0] * x[0] + x[1] * x[1]) + (x[2] * x[2] + x[3] * x[3]); const f32x4 y = x * gv[bj][n]; u32x2 w; w.x = cvt_pk_bf16(y[0], y[1]); w.y = cvt_pk_bf16(y[2], y[3]); *(u32x2*)(Hg + o + bj * 128 + n * 16) = w; } }
                if (EMIT) { sq += __shfl_xor(sq, 16); sq += __shfl_xor(sq, 32); if (fq == 0) SS[(size_t)row * 16 + u.pn * 4 + wc] = sq; } }
    }
};
struct EpiSwiglu {
    static constexpr bool PERM = true;
    bf16_t* O; int ldc; int pn_off; const float* SS; LAS float* rl; int tid;
    __device__ __forceinline__ void operator()(EPI_ARGS) const {
        const int row0 = u.pm * 256 + wr * 64 + fr, col0 = (u.pn - pn_off) * 128 + wc * 32 + 8 * fq;
        if (SS) panel_rstd(SS, u.pm, tid, rl);
#pragma unroll
        for (int ai = 0; ai < 2; ++ai)
#pragma unroll
            for (int m = 0; m < 4; ++m) { bf16_t* rowp = O + (size_t)(row0 + ai * 128 + m * 16) * ldc + col0; const float rs = SS ? rl[wr * 64 + fr + ai * 128 + m * 16] : 1.0f;
                float o[8];
#pragma unroll
                for (int n = 0; n < 2; ++n)
#pragma unroll
                    for (int j = 0; j < 4; ++j) { const float g = acc[ai][0][m][n][j] * rs, up = acc[ai][1][m][n][j] * rs; o[n * 4 + j] = g * sigmoidf_(g) * up; }
                u32x4 w; w.x = cvt_pk_bf16(o[0], o[1]); w.y = cvt_pk_bf16(o[2], o[3]); w.z = cvt_pk_bf16(o[4], o[5]); w.w = cvt_pk_bf16(o[6], o[7]);
                *(u32x4*)rowp = w; }
    }
};
template <bool ACCUM>
struct EpiMoeOut {
    static constexpr bool PERM = true;
    const float* row_w; bf16_t* O;
    __device__ __forceinline__ void operator()(EPI_ARGS) const {
        const int row0 = u.pm * 256 + wr * 64 + fr, col0 = u.pn * 256 + wc * 32 + 8 * fq;
#pragma unroll
        for (int ai = 0; ai < 2; ++ai)
#pragma unroll
            for (int m = 0; m < 4; ++m) { const int r = row0 + ai * 128 + m * 16; const float wt = row_w[r]; bf16_t* rowp = O + (size_t)r * DM + col0;
#pragma unroll
                for (int bj = 0; bj < 2; ++bj) { f32x4 v0 = acc[ai][bj][m][0] * wt, v1 = acc[ai][bj][m][1] * wt;
                    if (ACCUM) { const u32x4 p = *(const u32x4*)(rowp + bj * 128); v0[0] += bflo(p.x); v0[1] += bfhi(p.x); v0[2] += bflo(p.y); v0[3] += bfhi(p.y); v1[0] += bflo(p.z); v1[1] += bfhi(p.z); v1[2] += bflo(p.w); v1[3] += bfhi(p.w); }
                    u32x4 w; w.x = cvt_pk_bf16(v0[0], v0[1]); w.y = cvt_pk_bf16(v0[2], v0[3]); w.z = cvt_pk_bf16(v1[0], v1[1]); w.w = cvt_pk_bf16(v1[2], v1[3]);
                    *(u32x4*)(rowp + bj * 128) = w; } }
    }
};

__device__ __forceinline__ void transpose_tile64(const float* W, int ldn, int k0, int n0, bf16_t* WT, int ldk, int drow0, int drow1, int dk0, LAS float* scr, int lane) {
#ifdef SIMPLE_TR
    { const int c = lane & 7;
      for (int j = 0; j < 8; ++j) { const int n = (lane >> 3) + 8 * j; const float* s = W + (size_t)(k0 + 8 * c) * ldn + n0 + n;
        u32x4 o; o.x = pk2(s[0], s[(size_t)ldn]); o.y = pk2(s[(size_t)2 * ldn], s[(size_t)3 * ldn]); o.z = pk2(s[(size_t)4 * ldn], s[(size_t)5 * ldn]); o.w = pk2(s[(size_t)6 * ldn], s[(size_t)7 * ldn]);
        const int dr = n < 32 ? drow0 + n : drow1 + (n - 32);
        *(u32x4*)(WT + (size_t)dr * ldk + dk0 + k0 + 8 * c) = o; }
      return; }
#endif
    f32x4 v[16]; const int r4 = lane >> 4, c4 = (lane & 15) * 4;
#pragma unroll
    for (int i = 0; i < 16; ++i) v[i] = *(const f32x4*)(W + (size_t)(k0 + 4 * i + r4) * ldn + n0 + c4);
#pragma unroll
    for (int i = 0; i < 16; ++i) { LAS float* d = scr + (4 * i + r4) * 65 + c4; d[0] = v[i][0]; d[1] = v[i][1]; d[2] = v[i][2]; d[3] = v[i][3]; }
    LDS_WAIT(); asm volatile("" ::: "memory");
    const int c = lane & 7;
#pragma unroll
    for (int j = 0; j < 8; ++j) { const int n = (lane >> 3) + 8 * j; const LAS float* s = scr + (8 * c) * 65 + n;
        u32x4 o; o.x = pk2(s[0 * 65], s[1 * 65]); o.y = pk2(s[2 * 65], s[3 * 65]); o.z = pk2(s[4 * 65], s[5 * 65]); o.w = pk2(s[6 * 65], s[7 * 65]);
        const int dr = n < 32 ? drow0 + n : drow1 + (n - 32);
        *(u32x4*)(WT + (size_t)dr * ldk + dk0 + k0 + 8 * c) = o; }
    LDS_WAIT(); asm volatile("" ::: "memory");
}
__device__ __forceinline__ void conv_plain(const float* W, int K, int N, bf16_t* WT, int ldk, int item, LAS float* scr, int lane) {
    const int nblk = N / 64, kb = item / nblk, nb = item % nblk;
    transpose_tile64(W, N, kb * 64, nb * 64, WT, ldk, nb * 64, nb * 64 + 32, 0, scr, lane);
}
__device__ __forceinline__ int win_drow(int n0) { return n0 < 3872 ? n0 : (n0 < 4128 ? 4096 + (n0 - 3872) : (n0 < 4288 ? 4352 + (n0 - 4128) : 4608 + (n0 - 4288))); }
__device__ __forceinline__ int gu_drow(int n0, int up) { return (n0 >> 7) * 256 + (n0 & 127) + up * 128; }

__device__ __forceinline__ void phase_prologue(const Frame& F, const Params& P) {
    LAS float* scr = (LAS float*)(F.lds + F.wave * 16640);
    unsigned char* ws = F.ws;
    constexpr int I_IN = 16 * 115, I_QB = 4 * 12, I_BRn = 8 * 16, I_WOn = 16 * 16, I_G = 16 * 44, I_D = 44 * 16;
    constexpr int NIT = NLAYER * (I_IN + I_QB + 3 * I_BRn + I_WOn) + 2 * I_G + I_D;
    for (int it = F.gw; it < NIT; it += F.ngw) {
        int r = it;
        if (r < NLAYER * I_IN) { const int l = r / I_IN; r %= I_IN; const int kb = r / 115, nb = r % 115;
            transpose_tile64(P.in[I_WIN] + (size_t)l * DM * IN_COLS, IN_COLS, kb * 64, nb * 64, (bf16_t*)(ws + WS_WIN) + (size_t)l * WIN_ROWS * DM, DM, win_drow(nb * 64), win_drow(nb * 64 + 32), 0, scr, F.lane); continue; }
        r -= NLAYER * I_IN;
        if (r < NLAYER * I_QB) { const int l = r / I_QB; r %= I_QB; conv_plain(P.in[I_WQB] + (size_t)l * 256 * 768, 256, 768, (bf16_t*)(ws + WS_QB) + (size_t)l * 768 * 256, 256, r, scr, F.lane); continue; }
        r -= NLAYER * I_QB;
        if (r < NLAYER * 3 * I_BRn) { const int ln = r / I_BRn; r %= I_BRn; conv_plain(P.in[I_WBR] + (size_t)ln * 512 * 1024, 512, 1024, (bf16_t*)(ws + WS_BR) + (size_t)ln * 1024 * 512, 512, r, scr, F.lane); continue; }
        r -= NLAYER * 3 * I_BRn;
        if (r < NLAYER * I_WOn) { const int l = r / I_WOn; r %= I_WOn; conv_plain(P.in[I_WO] + (size_t)l * DM * DM, DM, DM, (bf16_t*)(ws + WS_WO) + (size_t)l * DM * DM, DM, r, scr, F.lane); continue; }
        r -= NLAYER * I_WOn;
        if (r < 2 * I_G) { const int up = r / I_G; r %= I_G; const int kb = r / 44, nb = r % 44;
            transpose_tile64(P.in[up ? I_FU : I_FG], DFF, kb * 64, nb * 64, (bf16_t*)(ws + WS_FGU), DM, gu_drow(nb * 64, up), gu_drow(nb * 64 + 32, up), 0, scr, F.lane); continue; }
        r -= 2 * I_G;
        conv_plain(P.in[I_FD], DFF, DM, (bf16_t*)(ws + WS_FD), DFF, r, scr, F.lane);
    }
    const int gt = F.blk * NTHR + F.tid, ngt = F.G * NTHR;
    for (int i = gt; i < NLAYER * 1536 * 384; i += ngt) { const int l = i / (1536 * 384), r = i % (1536 * 384), n = r / 384, k = r % 384; const int seg = n >> 9, c = n & 511; float v = 0.f;
        if (seg == 0 && k < 64) v = P.in[I_W2][((size_t)l * 64 + k) * 512 + c];
        else if (seg == 1 && k >= 64 && k < 128) v = P.in[I_A2][((size_t)l * 64 + (k - 64)) * 512 + c];
        else if (seg == 2 && k >= 128 && k < 288) v = P.in[I_G2][((size_t)l * 160 + (k - 128)) * 512 + c];
        ((bf16_t*)(ws + WS_LORA))[i] = (bf16_t)f2bf(v); }
    for (int i = gt; i < NLAYER * 512 * 256; i += ngt) { const int l = i / (512 * 256), r = i % (512 * 256), n = r / 256, k = r % 256; const int h = n >> 6, d = n & 63;
        float vk = 0.f, vv = 0.f; if (k < 128) { const float* w = P.in[I_WKVB] + ((size_t)l * 128 + k) * 1024 + h * 128; vk = w[d]; vv = w[64 + d]; }
        ((bf16_t*)(ws + WS_KB))[i] = (bf16_t)f2bf(vk); ((bf16_t*)(ws + WS_VB))[i] = (bf16_t)f2bf(vv); }
    for (int m = F.gw; m < MTOK; m += F.ngw) {
        const f32x4* xr = (const f32x4*)(P.in[I_X] + (size_t)m * DM) + F.lane; f32x4 v[4]; float s = 0.f;
#pragma unroll
        for (int j = 0; j < 4; ++j) { v[j] = xr[64 * j]; s += (v[j].x * v[j].x + v[j].y * v[j].y) + (v[j].z * v[j].z + v[j].w * v[j].w); }
        s = wave_sum(s);
        u32x2* o8 = (u32x2*)((bf16_t*)(ws + WS_HN) + (size_t)m * DM) + F.lane;
#pragma unroll
        for (int j = 0; j < 4; ++j) { const f32x4 g = ((const f32x4*)P.in[I_ANORM])[F.lane + 64 * j]; const f32x4 y = v[j] * g; u32x2 w; w.x = pk2(y.x, y.y); w.y = pk2(y.z, y.w); o8[64 * j] = w; }
        if (F.lane < 16) ((float*)(ws + WS_SS))[(size_t)m * 16 + F.lane] = F.lane == 0 ? s : 0.f;
    }
    for (int i = gt; i < MTOK * 80; i += ngt) { const int m = i / 80, j = i % 80; const int isr = j < 64; const int idx = isr ? j : j - 64; const double dim = isr ? 128.0 : 32.0;
        const float inv = (float)(1.0 / pow(10000.0, (2.0 * idx) / dim)); const float ang = (float)((const int*)P.in[I_POS])[m] * inv;
        const double a = (double)ang, q = rint(a * 0.15915494309189535), rr = a - q * 6.283185307179586476925;
        const float rf = (float)rr; const float cs = __cosf(rf), sn = __sinf(rf);
        if (isr) { ((float*)(ws + WS_COSR))[(size_t)m * 64 + idx] = cs; ((float*)(ws + WS_SINR))[(size_t)m * 64 + idx] = sn; }
        else { ((float*)(ws + WS_COSM))[(size_t)m * 16 + idx] = cs; ((float*)(ws + WS_SINM))[(size_t)m * 16 + idx] = sn; } }
}
template <int PART>
__device__ __forceinline__ void phase_moe_convert(const Frame& F, const Params& P, int w0, int nw) {
    LAS float* scr = (LAS float*)(F.lds + F.wave * 16640);
    constexpr int I_GH = 16 * 28, I_D = 56 * 16;
    constexpr int PER_E = PART == 0 ? 2 * I_GH + I_D : 2 * I_GH;
    for (int it = w0; it < NEXP * PER_E; it += nw) {
        const int e = it / PER_E; int r = it % PER_E;
        if (r < 2 * I_GH) { const int up = r / I_GH; r %= I_GH; const int kb = r / 28, nb = PART * 28 + r % 28;
            transpose_tile64(P.in[up ? I_MU2 : I_MG] + (size_t)e * DM * DFFE, DFFE, kb * 64, nb * 64, (bf16_t*)(F.ws + WS_MGU) + (size_t)e * 2 * DFFE * DM, DM, gu_drow(nb * 64, up), gu_drow(nb * 64 + 32, up), 0, scr, F.lane); continue; }
        r -= 2 * I_GH;
        conv_plain(P.in[I_MD] + (size_t)e * DFFE * DM, DFFE, DM, (bf16_t*)(F.ws + WS_MD) + (size_t)e * DM * DFFE, DFFE, r, scr, F.lane);
    }
}

template <bool MOE>
__device__ __forceinline__ void phase_rms(const Frame& F, const float* src, const float* gain, bf16_t* hn, const float* router, unsigned* ectl, int* tok_e, int* tok_slot, float* tok_w) {
    LAS int* lcnt = (LAS int*)(F.lds);
    if (MOE) { if (F.tid < 16) lcnt[F.tid] = 0; __syncthreads(); }
    int my_e0 = 0, my_e1 = 0, my_s0 = 0, my_s1 = 0; float my_w0 = 0.f, my_w1 = 0.f;
    f32x4 rw[MOE ? 32 : 1];
    if (MOE) {
#pragma unroll
        for (int j = 0; j < 4; ++j)
#pragma unroll
            for (int q = 0; q < 4; ++q) { const int c = 4 * F.lane + 256 * j + q; rw[(j * 4 + q) * 2] = *(const f32x4*)(router + (size_t)c * 8); rw[(j * 4 + q) * 2 + 1] = *(const f32x4*)(router + (size_t)c * 8 + 4); } }
    for (int i = 0; i < 8; ++i) {
        const int m = F.blk * 64 + F.wave * 8 + i;
        const f32x4* xr = (const f32x4*)(src + (size_t)m * DM) + F.lane;
        f32x4 v[4]; float s = 0.f;
#pragma unroll
        for (int j = 0; j < 4; ++j) { v[j] = xr[64 * j]; s += (v[j].x * v[j].x + v[j].y * v[j].y) + (v[j].z * v[j].z + v[j].w * v[j].w); }
        const float rstd = rsqrtf(wave_sum(s) * (1.0f / DM) + NORM_EPS);
#pragma unroll
        for (int j = 0; j < 4; ++j) { const f32x4 g = ((const f32x4*)gain)[F.lane + 64 * j]; v[j] = v[j] * rstd * g; }
        u32x2* o8 = (u32x2*)(hn + (size_t)m * DM) + F.lane;
#pragma unroll
        for (int j = 0; j < 4; ++j) { u32x2 w; w.x = pk2(v[j].x, v[j].y); w.y = pk2(v[j].z, v[j].w); o8[64 * j] = w; }
        if (MOE) {
            float lg[8];
#pragma unroll
            for (int e = 0; e < 8; ++e) lg[e] = 0.f;
#pragma unroll
            for (int j = 0; j < 4; ++j)
#pragma unroll
                for (int q = 0; q < 4; ++q) { const f32x4 r0 = rw[(j * 4 + q) * 2], r1 = rw[(j * 4 + q) * 2 + 1]; const float x = v[j][q];
                    lg[0] += x * r0.x; lg[1] += x * r0.y; lg[2] += x * r0.z; lg[3] += x * r0.w; lg[4] += x * r1.x; lg[5] += x * r1.y; lg[6] += x * r1.z; lg[7] += x * r1.w; }
#pragma unroll
            for (int e = 0; e < 8; ++e) lg[e] = wave_sum(lg[e]);
            int e0 = 0; float b0 = lg[0];
#pragma unroll
            for (int e = 1; e < 8; ++e) if (lg[e] > b0) { b0 = lg[e]; e0 = e; }
            int e1 = -1; float b1 = -3.0e38f;
#pragma unroll
            for (int e = 0; e < 8; ++e) if (e != e0 && lg[e] > b1) { b1 = lg[e]; e1 = e; }
            const float t = __expf(b1 - b0), w0 = 1.0f / (1.0f + t), w1 = t / (1.0f + t);
            int s0 = 0, s1 = 0;
            if (F.lane == 0) { s0 = atomicAdd((int*)&lcnt[e0], 1); s1 = atomicAdd((int*)&lcnt[e1], 1); }
            s0 = __shfl(s0, 0); s1 = __shfl(s1, 0);
            if (F.lane == i) { my_e0 = e0; my_e1 = e1; my_s0 = s0; my_s1 = s1; my_w0 = w0; my_w1 = w1; }
        }
    }
    if (MOE) {
        __syncthreads();
        if (F.tid < 8) lcnt[8 + F.tid] = (int)atomicAdd(&ectl[F.tid], (unsigned)lcnt[F.tid]);
        __syncthreads();
        if (F.lane < 8) { const int m = F.blk * 64 + F.wave * 8 + F.lane;
            tok_e[2 * m] = my_e0; tok_e[2 * m + 1] = my_e1; tok_slot[2 * m] = lcnt[8 + my_e0] + my_s0; tok_slot[2 * m + 1] = lcnt[8 + my_e1] + my_s1; tok_w[2 * m] = my_w0; tok_w[2 * m + 1] = my_w1; }
        __syncthreads();
    }
}
__device__ __forceinline__ void phase_final(const Frame& F, float* h, const float* gain, const bf16_t* out2, const int* tok_pos) {
    for (int m = F.gw; m < MTOK; m += F.ngw) {
        f32x4* xr = (f32x4*)(h + (size_t)m * DM) + F.lane;
        const int p0 = tok_pos[2 * m], p1 = tok_pos[2 * m + 1];
        const u32x2* o0 = (const u32x2*)(out2 + (size_t)p0 * DM) + F.lane; const u32x2* o1 = (const u32x2*)(out2 + (size_t)p1 * DM) + F.lane;
        f32x4 v[4]; float s = 0.f;
#pragma unroll
        for (int j = 0; j < 4; ++j) { v[j] = xr[64 * j]; const u32x2 a = o0[64 * j], b = o1[64 * j];
#ifndef NO_MOE_ADD
            v[j].x += bflo(a.x) + bflo(b.x); v[j].y += bfhi(a.x) + bfhi(b.x); v[j].z += bflo(a.y) + bflo(b.y); v[j].w += bfhi(a.y) + bfhi(b.y);
#endif
            s += (v[j].x * v[j].x + v[j].y * v[j].y) + (v[j].z * v[j].z + v[j].w * v[j].w); }
        const float rstd = rsqrtf(wave_sum(s) * (1.0f / DM) + NORM_EPS);
#pragma unroll
        for (int j = 0; j < 4; ++j) { const f32x4 g = ((const f32x4*)gain)[F.lane + 64 * j]; xr[64 * j] = v[j] * rstd * g; }
    }
}
template <int KS>
__device__ __forceinline__ f32x4 mm_tile(const LAS bf16_t* P, int ldp, const LAS bf16_t* Q, int ldq, int ib, int jb, int lane, f32x4 acc) {
    const LAS bf16_t* pp = P + (ib * 16 + (lane & 15)) * ldp + 8 * (lane >> 4);
    const LAS bf16_t* qp = Q + (jb * 16 + (lane & 15)) * ldq + 8 * (lane >> 4);
#pragma unroll
    for (int ks = 0; ks < KS; ++ks) { const bf16x8 a = *(const LAS bf16x8*)(qp + ks * 32), b = *(const LAS bf16x8*)(pp + ks * 32); acc = __builtin_amdgcn_mfma_f32_16x16x32_bf16(a, b, acc, 0, 0, 0); }
    return acc;
}
__device__ __forceinline__ void st_bf4(LAS bf16_t* p, f32x4 v) { u32x2 w; w.x = pk2(v[0], v[1]); w.y = pk2(v[2], v[3]); *(LAS u32x2*)p = w; }
__device__ __forceinline__ float ret_lg(int h) { return __logf(1.0f - exp2f(-5.0f - (float)h)); }

__device__ __forceinline__ void phase_prep(const Frame& F, const Params& P, int layer) {
    unsigned char* ws = F.ws;
    const bf16_t* p = (const bf16_t*)(ws + WS_P);
    const float* mu = P.in[I_MU] + (size_t)layer * RWKV_COLS;
    for (int m = F.gw; m < MTOK; m += F.ngw) {
        const bf16_t* pr = p + (size_t)m * PW; const bool has_prev = (m % SEQ) != 0; const bf16_t* pp = pr - PW;
        bf16_t* lin = (bf16_t*)(ws + WS_LIN) + (size_t)m * LORA_K;
#pragma unroll
        for (int jj = 0; jj < 6; ++jj) { const int c = F.lane + 64 * jj; float o = 0.f;
            if (c < 288) { const int off = 1536 + c; const float x = bf2f(pr[P_RW + off]), xp = has_prev ? bf2f(pp[P_RW + off]) : 0.f; const float xs = x + (xp - x) * mu[off];
                o = c < 64 ? tanhf(xs) : (c < 128 ? xs : sigmoidf_(xs)); }
            lin[c] = (bf16_t)f2bf(o); }
        {
            const u32x2 w = *(const u32x2*)(pr + P_QA + 4 * F.lane); float x[4] = {bflo(w.x), bfhi(w.x), bflo(w.y), bfhi(w.y)};
            const float ss = wave_sum(x[0] * x[0] + x[1] * x[1] + x[2] * x[2] + x[3] * x[3]); const float rs = rsqrtf(ss * (1.0f / 256.0f) + NORM_EPS);
            const f32x4 g = *(const f32x4*)(P.in[I_QNORM] + layer * 256 + 4 * F.lane);
            u32x2 o; o.x = pk2(x[0] * rs * g.x, x[1] * rs * g.y); o.y = pk2(x[2] * rs * g.z, x[3] * rs * g.w); *(u32x2*)((bf16_t*)(ws + WS_QN) + (size_t)m * 256 + 4 * F.lane) = o; }
        {
            const unsigned w = *(const unsigned*)(pr + P_KVA + 2 * F.lane); float x0 = bflo(w), x1 = bfhi(w);
            const float ss = wave_sum(x0 * x0 + x1 * x1); const float rs = rsqrtf(ss * (1.0f / 128.0f) + NORM_EPS);
            const f32x2 g = *(const f32x2*)(P.in[I_KVNORM] + layer * 128 + 2 * F.lane);
            unsigned* cn = (unsigned*)((bf16_t*)(ws + WS_CN) + (size_t)m * 256); cn[F.lane] = pk2(x0 * rs * g.x, x1 * rs * g.y); cn[64 + F.lane] = 0u; }
        if (F.lane < 16) {
            const float x1 = bf2f(pr[P_KVA + 128 + F.lane]), x2 = bf2f(pr[P_KVA + 144 + F.lane]);
            const float c = ((const float*)(ws + WS_COSM))[(size_t)m * 16 + F.lane], s = ((const float*)(ws + WS_SINM))[(size_t)m * 16 + F.lane];
            bf16_t* kp = (bf16_t*)(ws + WS_KPE) + (size_t)m * 32; kp[F.lane] = (bf16_t)f2bf(x1 * c - x2 * s); kp[16 + F.lane] = (bf16_t)f2bf(x1 * s + x2 * c); }
    }
    LAS bf16_t* kT = (LAS bf16_t*)F.lds;
    LAS bf16_t* vT = kT + 128 * 72;
    const int pc = F.tid & 7, j = F.tid >> 3;
    for (int u = F.blk; u < NB * NCHUNK * 4; u += F.G) {
        const int h = u & 3, n = (u >> 2) & 127, b = u >> 9; const int m = b * SEQ + n * 64 + j;
        const float lg = ret_lg(h);
        __syncthreads();
        {
            const bf16_t* kr = p + (size_t)m * PW + P_RK + h * 128 + pc * 8;
            const u32x4 a = *(const u32x4*)kr, bq = *(const u32x4*)(kr + 64);
            const float* cp = (const float*)(ws + WS_COSR) + (size_t)m * 64 + pc * 8; const float* sp = (const float*)(ws + WS_SINR) + (size_t)m * 64 + pc * 8;
            const float sc = 0.08838834764831845f * __expf(lg * (float)(63 - j));
            const unsigned aw[4] = {a.x, a.y, a.z, a.w}, bw[4] = {bq.x, bq.y, bq.z, bq.w};
#pragma unroll
            for (int i = 0; i < 8; ++i) { const float x1 = (i & 1) ? bfhi(aw[i >> 1]) : bflo(aw[i >> 1]), x2 = (i & 1) ? bfhi(bw[i >> 1]) : bflo(bw[i >> 1]); const float c = cp[i], s = sp[i];
                kT[(pc * 8 + i) * 72 + j] = (bf16_t)f2bf((x1 * c - x2 * s) * sc); kT[(64 + pc * 8 + i) * 72 + j] = (bf16_t)f2bf((x1 * s + x2 * c) * sc); }
            const bf16_t* vr = p + (size_t)m * PW + P_RV + h * 128 + pc * 8;
            const u32x4 va = *(const u32x4*)vr, vb = *(const u32x4*)(vr + 64);
            const unsigned vaw[4] = {va.x, va.y, va.z, va.w}, vbw[4] = {vb.x, vb.y, vb.z, vb.w};
#pragma unroll
            for (int i = 0; i < 8; ++i) { vT[(pc * 8 + i) * 72 + j] = (bf16_t)((i & 1) ? (vaw[i >> 1] >> 16) : (vaw[i >> 1] & 0xffffu)); vT[(64 + pc * 8 + i) * 72 + j] = (bf16_t)((i & 1) ? (vbw[i >> 1] >> 16) : (vbw[i >> 1] & 0xffffu)); }
        }
        __syncthreads();
        bf16_t* out = (bf16_t*)(ws + WS_RS) + (size_t)u * 16384;
#pragma unroll
        for (int jb = 0; jb < 8; ++jb) { f32x4 acc = {0.f, 0.f, 0.f, 0.f}; acc = mm_tile<2>(vT, 72, kT, 72, F.wave, jb, F.lane, acc);
            const int e = F.wave * 16 + (F.lane & 15), d = jb * 16 + 4 * (F.lane >> 4);
            u32x2 w; w.x = pk2(acc[0], acc[1]); w.y = pk2(acc[2], acc[3]); *(u32x2*)(out + e * 128 + d) = w; }
    }
    __syncthreads();
}

__device__ __forceinline__ void ret_scan(const Frame& F) {
    bf16_t* rs = (bf16_t*)(F.ws + WS_RS);
    for (int idx = F.blk * NTHR + F.tid; idx < NB * 4 * 16384; idx += F.G * NTHR) {
        const int b = idx >> 16, h = (idx >> 14) & 3, ed = idx & 16383; const float cd = __expf(ret_lg(h) * 64.0f);
        bf16_t* base = rs + ((size_t)(b * 128) * 4 + h) * 16384 + ed; float s = 0.f;
        for (int n0 = 0; n0 < NCHUNK; n0 += 32) { unsigned short t[32];
#pragma unroll
            for (int i = 0; i < 32; ++i) t[i] = base[(size_t)(n0 + i) * 65536];
#pragma unroll
            for (int i = 0; i < 32; ++i) { base[(size_t)(n0 + i) * 65536] = (bf16_t)f2bf(s); s = s * cd + bf2f(t[i]); } }
    }
}

__device__ __forceinline__ void ret_out(const Frame& F) {
    unsigned char* ws = F.ws; const bf16_t* p = (const bf16_t*)(ws + WS_P);
    LAS bf16_t* q = (LAS bf16_t*)F.lds;
    LAS bf16_t* k = q + 64 * 136;
    LAS bf16_t* vT = k + 64 * 136;
    LAS bf16_t* pT = vT + 128 * 72;
    LAS bf16_t* sc = pT + 128 * 136;
    LAS float* st = (LAS float*)(sc + 64 * 72);
    const int pc = F.tid & 7, j = F.tid >> 3;
    for (int u = F.blk; u < NB * NCHUNK * 4; u += F.G) {
        const int h = u & 3, n = (u >> 2) & 127, b = u >> 9; const int m0 = b * SEQ + n * 64, m = m0 + j;
        const float lg = ret_lg(h);
        LBAR();
        {
            const float* cp = (const float*)(ws + WS_COSR) + (size_t)m * 64 + pc * 8; const float* sp = (const float*)(ws + WS_SINR) + (size_t)m * 64 + pc * 8;
            float cs[8], sn[8];
#pragma unroll
            for (int i = 0; i < 8; ++i) { cs[i] = cp[i]; sn[i] = sp[i]; }
#pragma unroll
            for (int which = 0; which < 2; ++which) {
                const bf16_t* r = p + (size_t)m * PW + (which ? P_RK : P_RQ) + h * 128 + pc * 8;
                const u32x4 a = *(const u32x4*)r, bq = *(const u32x4*)(r + 64);
                const unsigned aw[4] = {a.x, a.y, a.z, a.w}, bw[4] = {bq.x, bq.y, bq.z, bq.w}; const float sc_ = which ? 0.08838834764831845f : 1.0f;
                float o1[8], o2[8];
#pragma unroll
                for (int i = 0; i < 8; ++i) { const float x1 = (i & 1) ? bfhi(aw[i >> 1]) : bflo(aw[i >> 1]), x2 = (i & 1) ? bfhi(bw[i >> 1]) : bflo(bw[i >> 1]); o1[i] = (x1 * cs[i] - x2 * sn[i]) * sc_; o2[i] = (x1 * sn[i] + x2 * cs[i]) * sc_; }
                LAS bf16_t* dst = (which ? k : q) + j * 136 + pc * 8;
                u32x4 w1, w2; w1.x = pk2(o1[0], o1[1]); w1.y = pk2(o1[2], o1[3]); w1.z = pk2(o1[4], o1[5]); w1.w = pk2(o1[6], o1[7]); w2.x = pk2(o2[0], o2[1]); w2.y = pk2(o2[2], o2[3]); w2.z = pk2(o2[4], o2[5]); w2.w = pk2(o2[6], o2[7]);
                *(LAS u32x4*)dst = w1; *(LAS u32x4*)(dst + 64) = w2; }
            const bf16_t* vr = p + (size_t)m * PW + P_RV + h * 128 + pc * 8;
            const u32x4 va = *(const u32x4*)vr, vb = *(const u32x4*)(vr + 64);
            const unsigned vaw[4] = {va.x, va.y, va.z, va.w}, vbw[4] = {vb.x, vb.y, vb.z, vb.w};
#pragma unroll
            for (int i = 0; i < 8; ++i) { vT[(pc * 8 + i) * 72 + j] = (bf16_t)((i & 1) ? (vaw[i >> 1] >> 16) : (vaw[i >> 1] & 0xffffu)); vT[(64 + pc * 8 + i) * 72 + j] = (bf16_t)((i & 1) ? (vbw[i >> 1] >> 16) : (vbw[i >> 1] & 0xffffu)); }
            const bf16_t* ps = (const bf16_t*)(ws + WS_RS) + (size_t)u * 16384;
#pragma unroll
            for (int i = 0; i < 4; ++i) { const int pi = F.tid + i * 512; const int e = pi >> 4, c = pi & 15; *(LAS u32x4*)(pT + e * 136 + c * 8) = *(const u32x4*)(ps + e * 128 + c * 8); }
        }
        LBAR();
        {
            const int ib = F.wave & 3;
#pragma unroll
            for (int t = 0; t < 2; ++t) { const int jb = 2 * (F.wave >> 2) + t; f32x4 acc = {0.f, 0.f, 0.f, 0.f}; acc = mm_tile<4>(q, 136, k, 136, ib, jb, F.lane, acc);
                const int i = ib * 16 + (F.lane & 15), j0 = jb * 16 + 4 * (F.lane >> 4);
#pragma unroll
                for (int r = 0; r < 4; ++r) { const int dd = i - (j0 + r); acc[r] *= __expf(lg * (float)(dd < 0 ? -dd : dd)); }
                st_bf4(sc + i * 72 + j0, acc); }
        }
        LBAR();
        {
            const int ib = F.wave & 3, eh = F.wave >> 2; const int i = ib * 16 + (F.lane & 15);
            const float qd = __expf(lg * (float)(i + 1));
            f32x4 o[4]; float s1 = 0.f, s2 = 0.f;
#pragma unroll
            for (int t = 0; t < 4; ++t) { const int eb = eh * 4 + t; f32x4 ai = {0.f, 0.f, 0.f, 0.f}, ac = {0.f, 0.f, 0.f, 0.f};
                ai = mm_tile<2>(sc, 72, vT, 72, ib, eb, F.lane, ai); ac = mm_tile<4>(q, 136, pT, 136, ib, eb, F.lane, ac);
                o[t] = ai + ac * qd;
#pragma unroll
                for (int r = 0; r < 4; ++r) { s1 += o[t][r]; s2 += o[t][r] * o[t][r]; } }
            s1 += __shfl_xor(s1, 16); s1 += __shfl_xor(s1, 32); s2 += __shfl_xor(s2, 16); s2 += __shfl_xor(s2, 32);
            if (F.lane < 16) { st[(eh * 64 + i) * 2] = s1; st[(eh * 64 + i) * 2 + 1] = s2; }
            LBAR();
            const float t1 = st[i * 2] + st[(64 + i) * 2], t2 = st[i * 2 + 1] + st[(64 + i) * 2 + 1];
            const float mean = t1 * (1.0f / 128.0f), var = fmaxf(t2 * (1.0f / 128.0f) - mean * mean, 0.f), rstd = rsqrtf(var + 1e-5f);
            const int mrow = m0 + i;
#pragma unroll
            for (int t = 0; t < 4; ++t) { const int e = (eh * 4 + t) * 16 + 4 * (F.lane >> 4);
                const u32x2 gw = *(const u32x2*)(p + (size_t)mrow * PW + P_RG + h * 128 + e); const float g[4] = {bflo(gw.x), bfhi(gw.x), bflo(gw.y), bfhi(gw.y)};
                float y[4];
#pragma unroll
                for (int r = 0; r < 4; ++r) y[r] = (o[t][r] - mean) * rstd * (g[r] * sigmoidf_(g[r]));
                u32x2 w; w.x = pk2(y[0], y[1]); w.y = pk2(y[2], y[3]); *(u32x2*)((bf16_t*)(ws + WS_YRET) + (size_t)mrow * 512 + h * 128 + e) = w; }
        }
    }
    __syncthreads();
}

constexpr int ATT_KP = 104, ATT_VP = 72;
constexpr int ATT_KB = 64 * ATT_KP * 2, ATT_VB = 64 * ATT_VP * 2;
constexpr int ATT_K0 = 0, ATT_V0 = 2 * ATT_KB;
__device__ __forceinline__ void attn_unit(const Frame& F, int b, int h, int qt) {
    unsigned char* ws = F.ws;
    const bf16_t* Qg = (const bf16_t*)(ws + WS_Q); const bf16_t* Kn = (const bf16_t*)(ws + WS_KN); const bf16_t* Kp = (const bf16_t*)(ws + WS_KPE); const bf16_t* Vt = (const bf16_t*)(ws + WS_VT);
    const int lane = F.lane, w = F.wave, ql = lane & 31, hf = lane >> 5;
    const int mq = b * SEQ + qt * 256 + w * 32 + ql;
    const float qs = 0.10206207261596577f * 1.4426950408889634f;
    bf16x8 qf[6];
    {
        const bf16_t* qr = Qg + (size_t)mq * 768 + h * 96;
#pragma unroll
        for (int s = 0; s < 4; ++s) { const u32x4 x = *(const u32x4*)(qr + 16 * s + 8 * hf); const unsigned xw[4] = {x.x, x.y, x.z, x.w}; u32x4 o; unsigned ow[4];
#pragma unroll
            for (int i = 0; i < 4; ++i) ow[i] = pk2(bflo(xw[i]) * qs, bfhi(xw[i]) * qs);
            o.x = ow[0]; o.y = ow[1]; o.z = ow[2]; o.w = ow[3]; qf[s] = __builtin_bit_cast(bf16x8, o); }
        const u32x4 x1 = *(const u32x4*)(qr + 64 + 8 * hf), x2 = *(const u32x4*)(qr + 80 + 8 * hf);
        const float* cp = (const float*)(ws + WS_COSM) + (size_t)mq * 16 + 8 * hf; const float* sp = (const float*)(ws + WS_SINM) + (size_t)mq * 16 + 8 * hf;
        const unsigned a[4] = {x1.x, x1.y, x1.z, x1.w}, c[4] = {x2.x, x2.y, x2.z, x2.w}; unsigned o1[4], o2[4];
#pragma unroll
        for (int i = 0; i < 4; ++i) { const float u0 = bflo(a[i]), u1 = bfhi(a[i]), v0 = bflo(c[i]), v1 = bfhi(c[i]); const float c0 = cp[2 * i], c1 = cp[2 * i + 1], s0 = sp[2 * i], s1 = sp[2 * i + 1];
            o1[i] = pk2((u0 * c0 - v0 * s0) * qs, (u1 * c1 - v1 * s1) * qs); o2[i] = pk2((u0 * s0 + v0 * c0) * qs, (u1 * s1 + v1 * c1) * qs); }
        u32x4 t1, t2; t1.x = o1[0]; t1.y = o1[1]; t1.z = o1[2]; t1.w = o1[3]; t2.x = o2[0]; t2.y = o2[1]; t2.z = o2[2]; t2.w = o2[3];
        qf[4] = __builtin_bit_cast(bf16x8, t1); qf[5] = __builtin_bit_cast(bf16x8, t2);
    }
    f32x16 oacc[2];
#pragma unroll
    for (int i = 0; i < 16; ++i) { oacc[0][i] = 0.f; oacc[1][i] = 0.f; }
    float mrun = 0.f; f32x2 lsum = {0.f, 0.f};
    const int nkt = 4 * qt + 4, mylim = 4 * qt + (w >> 1);
    const int half = w >> 2;
    const int kkey = F.tid >> 3, kpc = F.tid & 7, rkey = (F.tid & 255) >> 2, rpc = F.tid & 3, ve = F.tid >> 3, vpc = F.tid & 7;
    const bf16_t* knp = Kn + (size_t)(b * SEQ + kkey) * 512 + h * 64 + kpc * 8;
    const bf16_t* kpp = Kp + (size_t)(b * SEQ + rkey) * 32 + rpc * 8;
    const bf16_t* vtp = Vt + (size_t)(h * 64 + ve) * MTOK + b * SEQ + vpc * 8;
    const int kofs = (kkey * ATT_KP + kpc * 8) * 2, rofs = (rkey * ATT_KP + 64 + rpc * 8) * 2, vofs = (ve * ATT_VP + vpc * 8) * 2;
    constexpr bool rp = true;
#define ATT_QK(sv, kbuf, init) do { _Pragma("unroll") for (int t_ = 0; t_ < 2; ++t_) { _Pragma("unroll") for (int i_ = 0; i_ < 16; ++i_) sv[t_][i_] = (init); } \
        const LAS bf16_t* kr_ = (kbuf) + ql * ATT_KP + 8 * hf; bf16x8 ka_ = *(const LAS bf16x8*)kr_, kb_ = *(const LAS bf16x8*)(kr_ + 32 * ATT_KP); \
        _Pragma("unroll") for (int st_ = 0; st_ < 6; ++st_) { bf16x8 na_ = ka_, nb_ = kb_; \
            if (st_ < 5) { na_ = *(const LAS bf16x8*)(kr_ + 16 * (st_ + 1)); nb_ = *(const LAS bf16x8*)(kr_ + 32 * ATT_KP + 16 * (st_ + 1)); } \
            sv[0] = __builtin_amdgcn_mfma_f32_32x32x16_bf16(ka_, qf[st_], sv[0], 0, 0, 0); sv[1] = __builtin_amdgcn_mfma_f32_32x32x16_bf16(kb_, qf[st_], sv[1], 0, 0, 0); \
            ka_ = na_; kb_ = nb_; __builtin_amdgcn_sched_barrier(0); } } while (0)
    u32x4 ak, ar, av, bk, br, bv;
#define ATT_LOAD(K_, R_, V_, t_) do { const int tt_ = (t_) < nkt ? (t_) : nkt - 1; \
        K_ = *(const u32x4*)(knp + (size_t)tt_ * 64 * 512); R_ = *(const u32x4*)(kpp + (size_t)tt_ * 64 * 32); V_ = *(const u32x4*)(vtp + (size_t)tt_ * 64); } while (0)
#define ATT_STAGE(K_, R_, V_, kt_) do { { LAS unsigned char* kb2_ = F.lds + ATT_K0 + (((kt_) + 1) & 1) * ATT_KB; *(LAS u32x4*)(kb2_ + kofs) = K_; *(LAS u32x4*)(kb2_ + rofs) = R_; } \
        *(LAS u32x4*)(F.lds + ATT_V0 + (((kt_) + 1) & 1) * ATT_VB + vofs) = V_; ATT_LOAD(K_, R_, V_, (kt_) + 3); } while (0)
    __syncthreads();
    {
        ak = *(const u32x4*)knp; ar = *(const u32x4*)kpp; av = *(const u32x4*)vtp;
        *(LAS u32x4*)(F.lds + ATT_K0 + kofs) = ak; *(LAS u32x4*)(F.lds + ATT_K0 + rofs) = ar; *(LAS u32x4*)(F.lds + ATT_V0 + vofs) = av;
        ATT_LOAD(ak, ar, av, 1); ATT_LOAD(bk, br, bv, 2);
    }
    __syncthreads();
    f32x16 sc[2];
    if (half == 1) LBAR();
#define ATT_SEG1(kt_, ALL) do { if ((ALL) || (kt_) <= mylim) ATT_QK(sc, (const LAS bf16_t*)(F.lds + ATT_K0 + ((kt_) & 1) * ATT_KB), -mrun); } while (0)
#define ATT_SEG2(kt_, ALL) do { if ((ALL) || (kt_) <= mylim) { \
            const LAS bf16_t* vb = (const LAS bf16_t*)(F.lds + ATT_V0 + ((kt_) & 1) * ATT_VB); \
            int mi = __builtin_bit_cast(int, sc[0][0]); \
            _Pragma("unroll") for (int i = 0; i < 16; ++i) { const int a_ = __builtin_bit_cast(int, sc[0][i]), b_ = __builtin_bit_cast(int, sc[1][i]); mi = max(max(mi, a_), b_); } \
            if ((kt_) == 0 || __builtin_amdgcn_ballot_w64(__builtin_bit_cast(float, mi) > 8.0f) != 0ull) { \
                float mx = fmaxf(sc[0][0], sc[1][0]); \
                _Pragma("unroll") for (int i = 1; i < 16; ++i) mx = fmaxf(mx, fmaxf(sc[0][i], sc[1][i])); \
                { const int mb = __builtin_bit_cast(int, mx); const auto sw2 = __builtin_amdgcn_permlane32_swap(mb, mb, false, false); mx = fmaxf(__builtin_bit_cast(float, (int)sw2[0]), __builtin_bit_cast(float, (int)sw2[1])); } \
                const float delta = ((kt_) == 0) ? mx : fmaxf(mx, 0.f); \
                const float alpha = ((kt_) == 0) ? 1.0f : __builtin_amdgcn_exp2f(-delta); mrun += delta; lsum *= alpha; \
                _Pragma("unroll") for (int i = 0; i < 16; ++i) { oacc[0][i] *= alpha; oacc[1][i] *= alpha; sc[0][i] -= delta; sc[1][i] -= delta; } } \
            _Pragma("unroll") for (int t = 0; t < 2; ++t) _Pragma("unroll") for (int i = 0; i < 16; i += 2) { const float p0 = __builtin_amdgcn_exp2f(sc[t][i]), p1 = __builtin_amdgcn_exp2f(sc[t][i + 1]); sc[t][i] = p0; sc[t][i + 1] = p1; lsum += (f32x2){p0, p1}; } \
            _Pragma("unroll") for (int t = 0; t < 2; ++t) _Pragma("unroll") for (int kbb = 0; kbb < 2; ++kbb) { \
                    u32x4 pw; pw.x = pk2(sc[t][8 * kbb + 0], sc[t][8 * kbb + 1]); pw.y = pk2(sc[t][8 * kbb + 2], sc[t][8 * kbb + 3]); pw.z = pk2(sc[t][8 * kbb + 4], sc[t][8 * kbb + 5]); pw.w = pk2(sc[t][8 * kbb + 6], sc[t][8 * kbb + 7]); \
                    const bf16x8 pf = __builtin_bit_cast(bf16x8, pw); const int key0 = t * 32 + kbb * 16 + 4 * hf; \
                    _Pragma("unroll") for (int eb = 0; eb < 2; ++eb) { const LAS bf16_t* vr = vb + (eb * 32 + ql) * ATT_VP + key0; \
                        const u32x2 lo = *(const LAS u32x2*)vr, hi = *(const LAS u32x2*)(vr + 8); u32x4 vv; vv.x = lo.x; vv.y = lo.y; vv.z = hi.x; vv.w = hi.y; \
                        oacc[eb] = __builtin_amdgcn_mfma_f32_32x32x16_bf16(__builtin_bit_cast(bf16x8, vv), pf, oacc[eb], 0, 0, 0); } } } } while (0)
    const int nall = 4 * qt;
#define ATT_TRIP_L(kt_, ALL) do { ATT_SEG1(kt_, ALL); LBAR(); ATT_STAGE(ak, ar, av, kt_); ATT_SEG2(kt_, ALL); LBAR(); \
                                  ATT_SEG1((kt_) + 1, ALL); LBAR(); ATT_STAGE(bk, br, bv, (kt_) + 1); ATT_SEG2((kt_) + 1, ALL); LBAR(); } while (0)
#define ATT_TRIP_T(kt_, ALL) do { ATT_STAGE(ak, ar, av, kt_); ATT_SEG1(kt_, ALL); LBAR(); ATT_SEG2(kt_, ALL); LBAR(); \
                                  ATT_STAGE(bk, br, bv, (kt_) + 1); ATT_SEG1((kt_) + 1, ALL); LBAR(); ATT_SEG2((kt_) + 1, ALL); LBAR(); } while (0)
    if (half == 0) {
#pragma unroll 1
        for (int kt = 0; kt < nall; kt += 2) ATT_TRIP_L(kt, true);
#pragma unroll 1
        for (int kt = nall; kt < nkt; kt += 2) ATT_TRIP_L(kt, false);
        LBAR();
    } else {
#pragma unroll 1
        for (int kt = 0; kt < nall; kt += 2) ATT_TRIP_T(kt, true);
#pragma unroll 1
        for (int kt = nall; kt < nkt; kt += 2) ATT_TRIP_T(kt, false);
    }
#undef ATT_TRIP_L
#undef ATT_TRIP_T
#undef ATT_QK
#undef ATT_LOAD
#undef ATT_STAGE
#undef ATT_SEG1
#undef ATT_SEG2
    float lrun = lsum[0] + lsum[1];
    const float lt = lrun + __shfl_xor(lrun, 32), inv = 1.0f / lt;
    bf16_t* yo = (bf16_t*)(ws + WS_YMLA) + (size_t)mq * 512 + h * 64;
#pragma unroll
    for (int eb = 0; eb < 2; ++eb)
#pragma unroll
        for (int g = 0; g < 4; ++g) { u32x2 wv; wv.x = pk2(oacc[eb][4 * g] * inv, oacc[eb][4 * g + 1] * inv); wv.y = pk2(oacc[eb][4 * g + 2] * inv, oacc[eb][4 * g + 3] * inv);
            *(u32x2*)(yo + eb * 32 + 8 * g + 4 * hf) = wv; }
}
constexpr int RP = 72;
constexpr int RMAT = 64 * RP;
constexpr size_t RC_UNIT = 40960;
constexpr size_t WS_RC2 = WS_RC + (size_t)2048 * RC_UNIT;

__device__ __forceinline__ void st_g4(bf16_t* p, f32x4 v) { u32x2 w; w.x = pk2(v[0], v[1]); w.y = pk2(v[2], v[3]); *(u32x2*)p = w; }
__device__ __forceinline__ f32x4 ld_l4(const LAS bf16_t* p) { const u32x2 w = *(const LAS u32x2*)p; return (f32x4){bflo(w.x), bfhi(w.x), bflo(w.y), bfhi(w.y)}; }

template <int KS>
__device__ __forceinline__ f32x16 mm32(const LAS bf16_t* P, const LAS bf16_t* Q, int ib, int jb, int lane, f32x16 acc) {
    const LAS bf16_t* pp = P + (ib * 32 + (lane & 31)) * RP + 8 * (lane >> 5);
    const LAS bf16_t* qp = Q + (jb * 32 + (lane & 31)) * RP + 8 * (lane >> 5);
#pragma unroll
    for (int ks = 0; ks < KS; ++ks) { const bf16x8 a = *(const LAS bf16x8*)(qp + ks * 16), b = *(const LAS bf16x8*)(pp + ks * 16); acc = __builtin_amdgcn_mfma_f32_32x32x16_bf16(a, b, acc, 0, 0, 0); }
    return acc;
}
__device__ __forceinline__ f32x16 zero16() { f32x16 z; for (int i = 0; i < 16; ++i) z[i] = 0.f; return z; }
__device__ __forceinline__ void st32_lds(LAS bf16_t* O, int ib, int jb, int lane, const f32x16& a) {
    LAS bf16_t* o = O + (ib * 32 + (lane & 31)) * RP + jb * 32 + 4 * (lane >> 5);
#pragma unroll
    for (int g = 0; g < 4; ++g) st_bf4(o + 8 * g, (f32x4){a[4 * g], a[4 * g + 1], a[4 * g + 2], a[4 * g + 3]});
}
__device__ __forceinline__ void st32_glb(bf16_t* O, int ib, int jb, int lane, const f32x16& a) {
    bf16_t* o = O + (ib * 32 + (lane & 31)) * 64 + jb * 32 + 4 * (lane >> 5);
#pragma unroll
    for (int g = 0; g < 4; ++g) st_g4(o + 8 * g, (f32x4){a[4 * g], a[4 * g + 1], a[4 * g + 2], a[4 * g + 3]});
}
struct PreIn { unsigned short r[8], rp[8], k[8], kp[8], v[8], vp[8], lw[8], a[8]; };
__device__ __forceinline__ void pre_load(PreIn& x, const bf16_t* p, const bf16_t* lo, int u, int w, int lane) {
    const int c = u & 127, h = (u >> 7) & 7, b = u >> 10; const int m0 = b * SEQ + c * 64, ch = h * 64 + lane;
#pragma unroll
    for (int i = 0; i < 8; ++i) { const int t = 8 * w + i, m = m0 + t; const bf16_t* pr = p + (size_t)m * PW + P_RW + ch; const bool hp = (c | t) != 0;
        x.r[i] = pr[0]; x.k[i] = pr[512]; x.v[i] = pr[1024];
        x.rp[i] = hp ? pr[-PW] : (unsigned short)0; x.kp[i] = hp ? pr[512 - PW] : (unsigned short)0; x.vp[i] = hp ? pr[1024 - PW] : (unsigned short)0;
        x.lw[i] = lo[(size_t)m * LO_W + ch]; x.a[i] = lo[(size_t)m * LO_W + 512 + ch]; }
}
#ifdef PRE_T
#define PRE_MARK(k) do { if (F.tid == 0) { volatile LAS unsigned long long* tq_ = (volatile LAS unsigned long long*)(F.lds + LDSCTL_OFF + 48); const unsigned long long now_ = __builtin_amdgcn_s_memrealtime(); \
        if ((k) == PRE_T) tq_[1] += now_ - tq_[2]; tq_[2] = now_; } } while (0)
#else
#define PRE_MARK(k) do { } while (0)
#endif
template <int DIAG = 0>
__device__ __forceinline__ void rwkv_chunk_pre(const Frame& F, const float* mu, const float* k_k_, const float* k_a_, const float* r_k_) {
    unsigned char* ws = F.ws; const bf16_t* p = (const bf16_t*)(ws + WS_P); const bf16_t* lo = (const bf16_t*)(ws + WS_LO);
    LAS bf16_t* M = (LAS bf16_t*)F.lds;
    LAS bf16_t *KKt = M, *Bt = M + RMAT, *Kt = M + 2 * RMAT, *Rt = M + 3 * RMAT, *KKtT = M + 4 * RMAT, *BhT = M + 5 * RMAT, *KhT = M + 6 * RMAT, *VcT = M + 7 * RMAT;
    LAS bf16_t *NA = M + 8 * RMAT, *NAT = M + 9 * RMAT, *TT = M + 10 * RMAT, *AkkT = M + 11 * RMAT, *AbrT = M + 12 * RMAT, *AkrT = M + 13 * RMAT;
    LAS float* SEG = (LAS float*)(M + 10 * RMAT);
    const int lane = F.lane, w = F.wave, pr_ = w >> 1, ib = w & 1;
    const int i0 = ib * 32 + (lane & 31), jq = 4 * (lane >> 5);
    PreIn cur;
    if (F.blk < NB * 8 * NCHUNK) pre_load(cur, p, lo, F.blk, w, lane);
    for (int u = F.blk; u < NB * 8 * NCHUNK; u += F.G) {
        const int h = (u >> 7) & 7; const int ch = h * 64 + lane;
        const float mu_r = mu[ch], mu_k = mu[512 + ch], mu_v = mu[1024 + ch], k_k = k_k_[ch], k_a = k_a_[ch], r_k = r_k_[ch];
        float* aux = DIAG ? (float*)(ws + WS_YMLA) + (size_t)(u & 255) * 128 : (float*)(ws + WS_RC2) + (size_t)u * 128;
        LBAR();
        PRE_MARK(0);
        if (DIAG != 2) {
        float rr[8], kk8[8], k28[8], vv[8], bb[8], lw8[8], cs8[8]; float cs = 0.f;
#pragma unroll
        for (int i = 0; i < 8; ++i) { const int t = 8 * w + i;
            const float xr = bf2f(cur.r[i]), xk = bf2f(cur.k[i]), xv = bf2f(cur.v[i]);
            const float r = xr + (bf2f(cur.rp[i]) - xr) * mu_r, k = xk + (bf2f(cur.kp[i]) - xk) * mu_k, v = xv + (bf2f(cur.vp[i]) - xv) * mu_v;
            const float lw = bf2f(cur.lw[i]), a = bf2f(cur.a[i]);
            float kk = k * k_k; const float ss = wave_sum(kk * kk); kk *= rsqrtf(ss + 1e-12f);
            const float k2 = k * (1.0f + (a - 1.0f) * k_a);
            rr[i] = r; kk8[i] = kk; k28[i] = k2; vv[i] = v; bb[i] = kk * a; lw8[i] = lw; cs += lw; cs8[i] = cs;
            (DIAG ? (bf16_t*)(ws + WS_YRW) + (size_t)(u & 255) * 4096 : (bf16_t*)(ws + WS_RC + (size_t)u * RC_UNIT) + 16384)[t * 64 + lane] = (bf16_t)f2bf(v);
            const float bon = wave_sum(r * k2 * r_k); if (lane == 0) aux[64 + t] = bon; }
        SEG[w * 64 + lane] = cs;
        if (u + F.G < NB * 8 * NCHUNK) pre_load(cur, p, lo, u + F.G, w, lane);
        LBAR();
        float off = 0.f, cumC = 0.f;
#pragma unroll
        for (int s = 0; s < 8; ++s) { const float sv = SEG[s * 64 + lane]; cumC += sv; off += (s < w) ? sv : 0.f; }
        if (w == 0) aux[lane] = __expf(cumC);
        LBAR();
        unsigned pkk[4], pbh[4], pkh[4], pvc[4];
#pragma unroll
        for (int i = 0; i < 8; i += 2) { float o_kk[2], o_bh[2], o_kh[2];
#pragma unroll
            for (int e = 0; e < 2; ++e) { const int t = 8 * w + i + e; const float cum = cs8[i + e] + off;
                const float om = __expf(cum), omx = __expf(cum - lw8[i + e]), iom = __expf(-cum), ih = __expf(cumC - cum);
                o_kk[e] = kk8[i + e] * omx; o_bh[e] = bb[i + e] * ih; o_kh[e] = k28[i + e] * ih;
                KKt[t * RP + lane] = (bf16_t)f2bf(o_kk[e]); Bt[t * RP + lane] = (bf16_t)f2bf(bb[i + e] * iom); Kt[t * RP + lane] = (bf16_t)f2bf(k28[i + e] * iom); Rt[t * RP + lane] = (bf16_t)f2bf(rr[i + e] * om); }
            pkk[i >> 1] = pk2(o_kk[0], o_kk[1]); pbh[i >> 1] = pk2(o_bh[0], o_bh[1]); pkh[i >> 1] = pk2(o_kh[0], o_kh[1]); pvc[i >> 1] = pk2(vv[i], vv[i + 1]); }
        *(LAS u32x4*)(KKtT + lane * RP + 8 * w) = (u32x4){pkk[0], pkk[1], pkk[2], pkk[3]}; *(LAS u32x4*)(BhT + lane * RP + 8 * w) = (u32x4){pbh[0], pbh[1], pbh[2], pbh[3]};
        *(LAS u32x4*)(KhT + lane * RP + 8 * w) = (u32x4){pkh[0], pkh[1], pkh[2], pkh[3]}; *(LAS u32x4*)(VcT + lane * RP + 8 * w) = (u32x4){pvc[0], pvc[1], pvc[2], pvc[3]};
        }
        LBAR();
        PRE_MARK(1);
        if (DIAG != 1) {
        {
            const LAS bf16_t* Pm = pr_ < 2 ? KKt : Rt; const LAS bf16_t* Qm = (pr_ == 0 || pr_ == 2) ? Bt : Kt; LAS bf16_t* Om = pr_ == 0 ? NAT : (pr_ == 1 ? AkkT : (pr_ == 2 ? AbrT : AkrT));
            const bool incl = pr_ >= 2; const float sgn = pr_ == 0 ? -1.0f : 1.0f;
#pragma unroll
            for (int jb = 0; jb < 2; ++jb) { f32x16 a = zero16(); if (jb <= ib) a = mm32<4>(Pm, Qm, ib, jb, lane, a);
#pragma unroll
                for (int g = 0; g < 4; ++g)
#pragma unroll
                    for (int r = 0; r < 4; ++r) { const int jj = jb * 32 + 8 * g + jq + r; const bool keep = incl ? (jj <= i0) : (jj < i0); a[4 * g + r] = keep ? sgn * a[4 * g + r] : 0.f; }
                st32_lds(Om, ib, jb, lane, a);
                if (pr_ == 0) {
#pragma unroll
                    for (int g = 0; g < 4; ++g)
#pragma unroll
                        for (int r = 0; r < 4; ++r) { const int jj = jb * 32 + 8 * g + jq + r; a[4 * g + r] += (jj == i0) ? 1.0f : 0.f; }
                    st32_lds(TT, ib, jb, lane, a); } }
            if (pr_ == 0) {
#pragma unroll
                for (int jb = 0; jb < 2; ++jb) { f32x16 a = zero16(); if (jb >= ib) a = mm32<4>(Bt, KKt, ib, jb, lane, a);
#pragma unroll
                    for (int g = 0; g < 4; ++g)
#pragma unroll
                        for (int r = 0; r < 4; ++r) { const int jj = jb * 32 + 8 * g + jq + r; a[4 * g + r] = (i0 < jj) ? -a[4 * g + r] : 0.f; }
                    st32_lds(NA, ib, jb, lane, a); } }
        }
        LBAR();
        PRE_MARK(2);
        LAS bf16_t* VA = Kt;
#pragma unroll 1
        for (int s = 1; s <= 6; ++s) {
            const LAS bf16_t* Yo = (s & 1) ? NAT : KKt; const LAS bf16_t* YoT = (s & 1) ? NA : Bt; LAS bf16_t* Yn = (s & 1) ? KKt : NAT; LAS bf16_t* YnT = (s & 1) ? Bt : NA;
            if (pr_ == 0) {
                if (s == 1) { const f32x16 a0 = mm32<4>(VcT, AkkT, ib, 0, lane, zero16()), a1 = mm32<4>(VcT, AkkT, ib, 1, lane, zero16()); st32_lds(VA, ib, 0, lane, a0); st32_lds(VA, ib, 1, lane, a1); }
                else {
                    f32x16 c0, c1; const LAS bf16_t* tr = TT + i0 * RP + jq;
#pragma unroll
                    for (int g = 0; g < 4; ++g) { const f32x4 x0 = ld_l4(tr + 8 * g), x1 = ld_l4(tr + 32 + 8 * g);
#pragma unroll
                        for (int r = 0; r < 4; ++r) { c0[4 * g + r] = x0[r]; c1[4 * g + r] = x1[r]; } }
                    c0 = mm32<4>(TT, YoT, ib, 0, lane, c0); c1 = mm32<4>(TT, YoT, ib, 1, lane, c1);
                    LDS_WAIT();
                    st32_lds(TT, ib, 0, lane, c0); st32_lds(TT, ib, 1, lane, c1); }
            } else if (pr_ <= 2 && s <= 5) {
                const LAS bf16_t* Pm = pr_ == 1 ? Yo : YoT; const LAS bf16_t* Qm = pr_ == 1 ? YoT : Yo; LAS bf16_t* Om = pr_ == 1 ? Yn : YnT;
                const f32x16 a0 = mm32<4>(Pm, Qm, ib, 0, lane, zero16()), a1 = mm32<4>(Pm, Qm, ib, 1, lane, zero16()); st32_lds(Om, ib, 0, lane, a0); st32_lds(Om, ib, 1, lane, a1);
            }
            LBAR();
        }
        PRE_MARK(3);
        LAS bf16_t* KT = NAT; LAS bf16_t* P1 = NA;
        if (pr_ < 2) { const LAS bf16_t* src = pr_ == 0 ? KKtT : VA; LAS bf16_t* dst = pr_ == 0 ? KT : P1;
            const f32x16 a0 = mm32<4>(src, TT, ib, 0, lane, zero16()), a1 = mm32<4>(src, TT, ib, 1, lane, zero16()); st32_lds(dst, ib, 0, lane, a0); st32_lds(dst, ib, 1, lane, a1); }
        LBAR();
        {
            bf16_t* og = DIAG ? (bf16_t*)(ws + WS_YRW) + (size_t)(u & 255) * 4096 : (bf16_t*)(ws + WS_RC + (size_t)u * RC_UNIT) + pr_ * 4096;
#pragma unroll
            for (int jb = 0; jb < 2; ++jb) { f32x16 o;
                if (pr_ == 0) o = mm32<4>(BhT, KT, ib, jb, lane, zero16());
                else if (pr_ == 1) { const f32x16 x = mm32<4>(VcT, KhT, ib, jb, lane, zero16()), y = mm32<4>(P1, BhT, ib, jb, lane, zero16()); o = x - y; }
                else if (pr_ == 2) { const f32x16 y = mm32<4>(AbrT, KT, ib, jb, lane, zero16()); const LAS bf16_t* rt = Rt + i0 * RP + jb * 32 + jq;
#pragma unroll
                    for (int g = 0; g < 4; ++g) { const f32x4 x = ld_l4(rt + 8 * g);
#pragma unroll
                        for (int r = 0; r < 4; ++r) o[4 * g + r] = x[r] - y[4 * g + r]; } }
                else { const f32x16 x = mm32<4>(VcT, AkrT, ib, jb, lane, zero16()), y = mm32<4>(P1, AbrT, ib, jb, lane, zero16()); o = x - y; }
                st32_glb(og, ib, jb, lane, o); }
        }
        }
        PRE_MARK(4);
    }
    __syncthreads();
}

struct ScanOps { u32x4 fa0, fa1; u32x2 ad0, ad1; f32x4 om; };
__device__ __forceinline__ ScanOps scan_load(const unsigned char* ws, size_t u, int sk, int vh, int l15, int l4) {
    ScanOps o; const bf16_t* base = (const bf16_t*)(ws + WS_RC + u * RC_UNIT);
    o.fa0 = *(const u32x4*)(base + (sk * 16 + l15) * 64 + 8 * l4); o.fa1 = *(const u32x4*)(base + (sk * 16 + l15) * 64 + 32 + 8 * l4);
    o.ad0 = *(const u32x2*)(base + 4096 + ((2 * vh) * 16 + l15) * 64 + sk * 16 + 4 * l4); o.ad1 = *(const u32x2*)(base + 4096 + ((2 * vh + 1) * 16 + l15) * 64 + sk * 16 + 4 * l4);
    o.om = *(const f32x4*)((const float*)(ws + WS_RC2) + u * 128 + sk * 16 + 4 * l4); return o;
}
template <bool STORE>
__device__ __forceinline__ void rwkv_scan(const Frame& F, int b, int h) {
    unsigned char* ws = F.ws;
    LAS bf16_t* Sb = (LAS bf16_t*)F.lds;
    const int lane = F.lane, w = F.wave, l15 = lane & 15, l4 = lane >> 4, sk = w & 3, vh = w >> 2;
    for (int i = F.tid; i < 2 * RMAT / 2; i += NTHR) ((LAS unsigned*)Sb)[i] = 0u;
    const size_t u0 = (size_t)(b * 8 + h) * 128;
    f32x4 st0 = {0.f, 0.f, 0.f, 0.f}, st1 = {0.f, 0.f, 0.f, 0.f};
    ScanOps r0 = scan_load(ws, u0 + 0, sk, vh, l15, l4), r1 = scan_load(ws, u0 + 1, sk, vh, l15, l4), r2 = scan_load(ws, u0 + 2, sk, vh, l15, l4), r3 = scan_load(ws, u0 + 3, sk, vh, l15, l4);
    __syncthreads();
#define SCAN_STEP(R, cc) do { const int c_ = (cc); \
        const LAS bf16_t* Sc = Sb + (c_ & 1) * RMAT; LAS bf16_t* Sn = Sb + ((c_ + 1) & 1) * RMAT; \
        const bf16x8 a0 = __builtin_bit_cast(bf16x8, R.fa0), a1 = __builtin_bit_cast(bf16x8, R.fa1); \
        const LAS bf16_t* sp0 = Sc + ((2 * vh) * 16 + l15) * RP + 8 * l4; const LAS bf16_t* sp1 = sp0 + 16 * RP; \
        const bf16x8 s00 = *(const LAS bf16x8*)sp0, s01 = *(const LAS bf16x8*)(sp0 + 32), s10 = *(const LAS bf16x8*)sp1, s11 = *(const LAS bf16x8*)(sp1 + 32); \
        bf16_t* sg = (bf16_t*)(ws + WS_RC + (u0 + c_ - 1) * RC_UNIT) + 4096;     \
        if (STORE && c_ > 0) *(u32x4*)(sg + (F.tid >> 3) * 64 + (F.tid & 7) * 8) = *(const LAS u32x4*)(Sc + (F.tid >> 3) * RP + (F.tid & 7) * 8);     \
        f32x4 t0 = {0.f, 0.f, 0.f, 0.f}, t1 = {0.f, 0.f, 0.f, 0.f}; \
        t0 = __builtin_amdgcn_mfma_f32_16x16x32_bf16(a0, s00, t0, 0, 0, 0); t1 = __builtin_amdgcn_mfma_f32_16x16x32_bf16(a0, s10, t1, 0, 0, 0); \
        t0 = __builtin_amdgcn_mfma_f32_16x16x32_bf16(a1, s01, t0, 0, 0, 0); t1 = __builtin_amdgcn_mfma_f32_16x16x32_bf16(a1, s11, t1, 0, 0, 0); \
        const f32x4 n0 = {bflo(R.ad0.x), bfhi(R.ad0.x), bflo(R.ad0.y), bfhi(R.ad0.y)}, n1 = {bflo(R.ad1.x), bfhi(R.ad1.x), bflo(R.ad1.y), bfhi(R.ad1.y)}; \
        st0 = st0 * R.om - t0 + n0; st1 = st1 * R.om - t1 + n1; \
        st_bf4(Sn + ((2 * vh) * 16 + l15) * RP + sk * 16 + 4 * l4, st0); st_bf4(Sn + ((2 * vh + 1) * 16 + l15) * RP + sk * 16 + 4 * l4, st1); \
        R = scan_load(ws, u0 + (c_ + 4 < NCHUNK ? c_ + 4 : NCHUNK - 1), sk, vh, l15, l4);     \
        LBAR(); } while (0)
#pragma unroll 1
    for (int c = 0; c < NCHUNK; c += 16) {
#pragma unroll
        for (int j = 0; j < 16; j += 4) { SCAN_STEP(r0, c + j); SCAN_STEP(r1, c + j + 1); SCAN_STEP(r2, c + j + 2); SCAN_STEP(r3, c + j + 3); } }
#undef SCAN_STEP
}

struct OutOps { bf16x8 q0, q1, s00, s01, s10, s11; u32x2 z0, z1; u32x4 cv, cg; float cbc; };
__device__ __forceinline__ OutOps out_load(const unsigned char* ws, int u, int tb, int vh, int l15, int l4, int tt, int c8) {
    OutOps o; const int c = u & 127, h = (u >> 7) & 7, b = u >> 10;
    const bf16_t* base = (const bf16_t*)(ws + WS_RC + (size_t)u * RC_UNIT);
    const bf16_t* Sg = (const bf16_t*)(ws + WS_RC + (size_t)(u > 0 ? u - 1 : 0) * RC_UNIT) + 4096; const bf16_t* QT = base + 8192; const bf16_t* Z = base + 12288;
    o.q0 = *(const bf16x8*)(QT + (tb * 16 + l15) * 64 + 8 * l4); o.q1 = *(const bf16x8*)(QT + (tb * 16 + l15) * 64 + 32 + 8 * l4);
    const bf16_t* sp0 = Sg + ((2 * vh) * 16 + l15) * 64 + 8 * l4; const bf16_t* sp1 = sp0 + 16 * 64;
    o.s00 = *(const bf16x8*)sp0; o.s01 = *(const bf16x8*)(sp0 + 32); o.s10 = *(const bf16x8*)sp1; o.s11 = *(const bf16x8*)(sp1 + 32);
    o.z0 = *(const u32x2*)(Z + ((2 * vh) * 16 + l15) * 64 + tb * 16 + 4 * l4); o.z1 = *(const u32x2*)(Z + ((2 * vh + 1) * 16 + l15) * 64 + tb * 16 + 4 * l4);
    const int m = b * SEQ + c * 64 + tt, chq = h * 64 + c8;
    o.cv = *(const u32x4*)(base + 16384 + tt * 64 + c8); o.cg = *(const u32x4*)((const bf16_t*)(ws + WS_LO) + (size_t)m * LO_W + 1024 + chq);
    o.cbc = ((const float*)(ws + WS_RC2))[(size_t)u * 128 + 64 + tt]; return o;
}
__device__ __forceinline__ void rwkv_out(const Frame& F, const float* lnx_) {
    unsigned char* ws = F.ws;
    LAS float* Yl = (LAS float*)F.lds;
    const int lane = F.lane, w = F.wave, l15 = lane & 15, l4 = lane >> 4, tb = w & 3, vh = w >> 2;
    const int tt = F.tid >> 3, c8 = (F.tid & 7) * 8;
    OutOps cur = out_load(ws, F.blk, tb, vh, l15, l4, tt, c8);
    for (int u = F.blk; u < NB * 8 * NCHUNK; u += F.G) {
        const int c = u & 127, h = (u >> 7) & 7, b = u >> 10;
        const OutOps o = cur;
        { const int un = u + F.G < NB * 8 * NCHUNK ? u + F.G : u; cur = out_load(ws, un, tb, vh, l15, l4, tt, c8); }
        f32x4 y0 = {bflo(o.z0.x), bfhi(o.z0.x), bflo(o.z0.y), bfhi(o.z0.y)}, y1 = {bflo(o.z1.x), bfhi(o.z1.x), bflo(o.z1.y), bfhi(o.z1.y)};
        if (c > 0) {
            y0 = __builtin_amdgcn_mfma_f32_16x16x32_bf16(o.q0, o.s00, y0, 0, 0, 0); y1 = __builtin_amdgcn_mfma_f32_16x16x32_bf16(o.q0, o.s10, y1, 0, 0, 0);
            y0 = __builtin_amdgcn_mfma_f32_16x16x32_bf16(o.q1, o.s01, y0, 0, 0, 0); y1 = __builtin_amdgcn_mfma_f32_16x16x32_bf16(o.q1, o.s11, y1, 0, 0, 0); }
        const int m = b * SEQ + c * 64 + tt, chq = h * 64 + c8;
        const f32x4 ln0 = *(const f32x4*)(lnx_ + chq), ln1 = *(const f32x4*)(lnx_ + chq + 4);
        LBAR();
#pragma unroll
        for (int r = 0; r < 4; ++r) { Yl[(tb * 16 + 4 * l4 + r) * 68 + (2 * vh) * 16 + l15] = y0[r]; Yl[(tb * 16 + 4 * l4 + r) * 68 + (2 * vh + 1) * 16 + l15] = y1[r]; }
        LBAR();
        const f32x4 ya = *(const LAS f32x4*)(Yl + tt * 68 + c8), yb = *(const LAS f32x4*)(Yl + tt * 68 + c8 + 4);
        float yy[8] = {ya[0], ya[1], ya[2], ya[3], yb[0], yb[1], yb[2], yb[3]};
        float s1 = ((yy[0] + yy[1]) + (yy[2] + yy[3])) + ((yy[4] + yy[5]) + (yy[6] + yy[7]));
        s1 = sum8(s1); const float mean = s1 * (1.0f / 64.0f); float s2 = 0.f;
#pragma unroll
        for (int i = 0; i < 8; ++i) { yy[i] -= mean; s2 += yy[i] * yy[i]; }
        s2 = sum8(s2); const float rstd = rsqrtf(s2 * (1.0f / 64.0f) + 64e-5f);
        const unsigned vw[4] = {o.cv.x, o.cv.y, o.cv.z, o.cv.w}, gw[4] = {o.cg.x, o.cg.y, o.cg.z, o.cg.w};
        const float lnx[8] = {ln0[0], ln0[1], ln0[2], ln0[3], ln1[0], ln1[1], ln1[2], ln1[3]};
        unsigned ow[4];
#pragma unroll
        for (int i = 0; i < 4; ++i) { float o2[2];
#pragma unroll
            for (int e = 0; e < 2; ++e) { const int ci = 2 * i + e; const float v = e ? bfhi(vw[i]) : bflo(vw[i]), g = e ? bfhi(gw[i]) : bflo(gw[i]);
                o2[e] = (yy[ci] * rstd * lnx[ci] + o.cbc * v) * g; }
            ow[i] = pk2(o2[0], o2[1]); }
        *(u32x4*)((bf16_t*)(ws + WS_YRW) + (size_t)m * 512 + chq) = (u32x4){ow[0], ow[1], ow[2], ow[3]};
    }
    __syncthreads();
}
__device__ __forceinline__ void rwkv_seq(const Frame& F, const Params& P, int layer, int b, int h) {
    unsigned char* ws = F.ws; const bf16_t* p = (const bf16_t*)(ws + WS_P); const bf16_t* lo = (const bf16_t*)(ws + WS_LO);
    LAS float* Lr = (LAS float*)F.lds; LAS float* Lw = Lr + 4096; LAS float* Lk = Lw + 4096; LAS float* Lv = Lk + 4096; LAS float* Lkk = Lv + 4096; LAS float* Lb = Lkk + 4096; LAS float* Ly = Lb + 4096;
    const int lane = F.lane, ch = h * 64 + lane;
    const float mu_r = P.in[I_MU][(size_t)layer * RWKV_COLS + ch], mu_k = P.in[I_MU][(size_t)layer * RWKV_COLS + 512 + ch], mu_v = P.in[I_MU][(size_t)layer * RWKV_COLS + 1024 + ch];
    const float k_k = P.in[I_KK][layer * 512 + ch], k_a = P.in[I_KA][layer * 512 + ch], r_k = P.in[I_RK][layer * 512 + ch], lnx = P.in[I_LNX][layer * 512 + ch];
    const int vrow = F.tid >> 3, q = F.tid & 7;
    float s[8];
#pragma unroll
    for (int i = 0; i < 8; ++i) s[i] = 0.f;
    for (int c = 0; c < NCHUNK; ++c) {
        const int m0 = b * SEQ + c * 64;
        __syncthreads();
#pragma unroll
        for (int i = 0; i < 8; ++i) { const int t = F.wave + 8 * i, m = m0 + t; const bf16_t* pr = p + (size_t)m * PW + P_RW + ch; const bool hp = (c | t) != 0;
            const float xr = bf2f(pr[0]), xk = bf2f(pr[512]), xv = bf2f(pr[1024]);
            const float pr_ = hp ? bf2f(pr[-PW]) : 0.f, pk_ = hp ? bf2f(pr[512 - PW]) : 0.f, pv_ = hp ? bf2f(pr[1024 - PW]) : 0.f;
            const float r = xr + (pr_ - xr) * mu_r, k = xk + (pk_ - xk) * mu_k, v = xv + (pv_ - xv) * mu_v;
            const float lw = bf2f(lo[(size_t)m * LO_W + ch]), a = bf2f(lo[(size_t)m * LO_W + 512 + ch]);
            float kk = k * k_k; const float ss = wave_sum(kk * kk); kk *= rsqrtf(ss + 1e-12f);
            Lr[t * 64 + lane] = r; Lw[t * 64 + lane] = __expf(lw); Lk[t * 64 + lane] = k * (1.0f + (a - 1.0f) * k_a); Lv[t * 64 + lane] = v; Lkk[t * 64 + lane] = kk; Lb[t * 64 + lane] = kk * a; }
        __syncthreads();
        for (int t = 0; t < 64; ++t) {
            const f32x4 ka = *(const LAS f32x4*)(Lkk + t * 64 + q * 8), kb = *(const LAS f32x4*)(Lkk + t * 64 + q * 8 + 4);
            const f32x4 wa = *(const LAS f32x4*)(Lw + t * 64 + q * 8), wb = *(const LAS f32x4*)(Lw + t * 64 + q * 8 + 4);
            const f32x4 ba = *(const LAS f32x4*)(Lb + t * 64 + q * 8), bb = *(const LAS f32x4*)(Lb + t * 64 + q * 8 + 4);
            const f32x4 k2a = *(const LAS f32x4*)(Lk + t * 64 + q * 8), k2b = *(const LAS f32x4*)(Lk + t * 64 + q * 8 + 4);
            const f32x4 ra = *(const LAS f32x4*)(Lr + t * 64 + q * 8), rb = *(const LAS f32x4*)(Lr + t * 64 + q * 8 + 4);
            const float vv = Lv[t * 64 + vrow];
            float sa = 0.f;
#pragma unroll
            for (int i = 0; i < 4; ++i) { sa += s[i] * ka[i]; sa += s[4 + i] * kb[i]; }
            sa = sum8(sa); sa = -sa;
            float y = 0.f;
#pragma unroll
            for (int i = 0; i < 4; ++i) { s[i] = s[i] * wa[i] + sa * ba[i] + vv * k2a[i]; s[4 + i] = s[4 + i] * wb[i] + sa * bb[i] + vv * k2b[i]; y += s[i] * ra[i]; y += s[4 + i] * rb[i]; }
            y = sum8(y);
            if (q == 0) Ly[t * 64 + vrow] = y;
        }
        __syncthreads();
#pragma unroll
        for (int i = 0; i < 8; ++i) { const int t = F.wave + 8 * i, m = m0 + t;
            const float y = Ly[t * 64 + lane]; const float mean = wave_sum(y) * (1.0f / 64.0f); const float d = y - mean; const float var = wave_sum(d * d) * (1.0f / 64.0f);
            const float bon = wave_sum(Lr[t * 64 + lane] * Lk[t * 64 + lane] * r_k);
            const float g = bf2f(lo[(size_t)m * LO_W + 1024 + ch]);
            const float o = (d * rsqrtf(var + 64e-5f) * lnx + bon * Lv[t * 64 + lane]) * g;
            ((bf16_t*)(ws + WS_YRW))[(size_t)m * 512 + ch] = (bf16_t)f2bf(o); }
    }
    __syncthreads();
}

constexpr int LDS_TAB = LDSCTL_OFF + 64;
__device__ __forceinline__ void moe_table(const Frame& F, const unsigned* ectl) {
    LAS int* tab = (LAS int*)(F.lds + LDS_TAB);
    if (F.tid == 0) { int st = 0, nt = 0;
        for (int e = 0; e < 8; ++e) { const int c = (int)__hip_atomic_load(&ectl[e], __ATOMIC_RELAXED, __HIP_MEMORY_SCOPE_AGENT); tab[1 + e] = st; const int t = (c + 255) >> 8; for (int i = 0; i < t; ++i) tab[16 + nt + i] = e; nt += t; st += t * 256; }
        tab[0] = nt; }
    __syncthreads();
}
__device__ __forceinline__ void phase_moe_scatter(const Frame& F, const unsigned* ectl) {
    unsigned char* ws = F.ws; const LAS int* tab = (const LAS int*)(F.lds + LDS_TAB);
    const int* tok_e = (const int*)(ws + WS_TOK); int* tok_slot = (int*)tok_e + 2 * MTOK; const float* tok_w = (const float*)(tok_slot + 2 * MTOK);
    int* row_tok = (int*)(tok_w + 2 * MTOK); float* row_w = (float*)(row_tok + MAXROWS);
    for (int i = F.blk * NTHR + F.tid; i < 2 * MTOK; i += F.G * NTHR) { const int e = tok_e[i]; const int dest = tab[1 + e] + tok_slot[i]; row_tok[dest] = i >> 1; row_w[dest] = tok_w[i]; tok_slot[i] = dest; }
    const int gt = F.blk * NTHR + F.tid;
    if (gt < 2048) { const int e = gt >> 8; const int c = (int)__hip_atomic_load(&ectl[e], __ATOMIC_RELAXED, __HIP_MEMORY_SCOPE_AGENT); const int r = c + (gt & 255);
        if (r < ((c + 255) & ~255)) { row_tok[tab[1 + e] + r] = -1; row_w[tab[1 + e] + r] = 0.f; } }
}
constexpr int LDS_GTAB = RING_BYTES;
__device__ __forceinline__ void moe_gather_table(const Frame& F, int ncol) {
    const LAS int* tab = (const LAS int*)(F.lds + LDS_TAB); LAS unsigned* gt = (LAS unsigned*)(F.lds + LDS_GTAB);
    const int* row_tok = (const int*)(F.ws + WS_TOK) + 6 * MTOK; const int total = tab[0] * ncol;
    for (int i = F.tid; i < 9 * 256; i += NTHR) { const int u = i >> 8, r = i & 255; const int L = u * F.G + F.blk; unsigned off = 0u;
        if (L < total) { const int tk = row_tok[(L / ncol) * 256 + r]; off = tk > 0 ? (unsigned)tk * (unsigned)(DM * 2) : 0u; }
        gt[i] = off; }
    __syncthreads();
}

extern __shared__ __attribute__((aligned(16))) unsigned char lds_raw[];
template <class T> __device__ __forceinline__ T* uni(T* p) { const unsigned long long v = (unsigned long long)p; const unsigned lo = __builtin_amdgcn_readfirstlane((unsigned)v), hi = __builtin_amdgcn_readfirstlane((unsigned)(v >> 32)); return (T*)(((unsigned long long)hi << 32) | lo); }
__device__ __forceinline__ int uni(int v) { return __builtin_amdgcn_readfirstlane(v); }
__device__ __forceinline__ Frame mkframe(unsigned char* ws, int wv) {
    Frame F; F.lds = (LAS unsigned char*)lds_raw; int tid = wv * 64 + lane_id_fresh(); F.tid = tid; F.lane = F.tid & 63; F.wave = __builtin_amdgcn_readfirstlane(F.tid >> 6);
    int blk = blockIdx.x; asm volatile("" : "+s"(blk)); F.blk = blk; F.G = gridDim.x; F.vcu = (F.blk & 7) * (F.G >> 3) + (F.blk >> 3); F.gw = F.blk * NWAVES + F.wave; F.ngw = F.G * NWAVES; F.ws = ws; return F;
}
#define PHASE __device__ __forceinline__ void
template <int PART>
PHASE f_moe_convert(int wv, unsigned char* ws_, const float* mg, const float* mu, const float* md) {
    unsigned char* ws = uni(ws_); const Frame F = mkframe(ws, wv); Params P; P.in[I_MG] = uni(mg); P.in[I_MU2] = uni(mu); P.in[I_MD] = uni(md);
    if (PART == 0) { __syncthreads(); phase_moe_convert<0>(F, P, F.gw, F.ngw); }
    else if (F.blk >= 32) { __syncthreads(); phase_moe_convert<1>(F, P, (F.blk - 32) * NWAVES + F.wave, (F.G - 32) * NWAVES); }
}
PHASE f_rms(int wv, unsigned char* ws_, const float* src, const float* gain) { unsigned char* ws = uni(ws_); const Frame F = mkframe(ws, wv); phase_rms<false>(F, uni(src), uni(gain), (bf16_t*)(ws + WS_HN), nullptr, nullptr, nullptr, nullptr, nullptr); }
PHASE f_rms_moe(int wv, unsigned char* ws_, const float* src, const float* gain, const float* router) {
    unsigned char* ws = uni(ws_); const Frame F = mkframe(ws, wv); int* tok_e = (int*)(ws + WS_TOK); int* tok_slot = tok_e + 2 * MTOK; float* tok_w = (float*)(tok_slot + 2 * MTOK);
    phase_rms<true>(F, uni(src), uni(gain), (bf16_t*)(ws + WS_HN), uni(router), (unsigned*)(ws + WS_CTL) + CW_ECNT, tok_e, tok_slot, tok_w);
}
PHASE f_prep(int wv, unsigned char* ws_, const float* mu, const float* qnorm, const float* kvnorm, int layer_) {
    unsigned char* ws = uni(ws_); const Frame F = mkframe(ws, wv); Params P; P.in[I_MU] = uni(mu); P.in[I_QNORM] = uni(qnorm); P.in[I_KVNORM] = uni(kvnorm); (void)layer_; phase_prep(F, P, 0);
}
PHASE f_ret_scan(int wv, unsigned char* ws_) { unsigned char* ws = uni(ws_); const Frame F = mkframe(ws, wv); ret_scan(F); }
PHASE f_ret_out(int wv, unsigned char* ws_) { unsigned char* ws = uni(ws_); const Frame F = mkframe(ws, wv); ret_out(F); }
PHASE f_rwkv_seq(int wv, unsigned char* ws_, const float* mu, const float* kk, const float* ka, const float* rk, const float* lnx, int layer_) {
    unsigned char* ws = uni(ws_); const Frame F = mkframe(ws, wv); Params P; P.in[I_MU] = uni(mu); P.in[I_KK] = uni(kk); P.in[I_KA] = uni(ka); P.in[I_RK] = uni(rk); P.in[I_LNX] = uni(lnx);
    (void)layer_; rwkv_seq(F, P, 0, F.blk >> 3, F.blk & 7);
}
PHASE f_rwkv_pre(int wv, unsigned char* ws_, const float* mu, const float* kk, const float* ka, const float* rk) { unsigned char* ws = uni(ws_); const Frame F = mkframe(ws, wv); rwkv_chunk_pre<0>(F, uni(mu), uni(kk), uni(ka), uni(rk));
#ifdef PRE_DIAG
    rwkv_chunk_pre<PRE_DIAG>(F, uni(mu), uni(kk), uni(ka), uni(rk));
#endif
}
PHASE f_rwkv_scan(int wv, unsigned char* ws_) { unsigned char* ws = uni(ws_); const Frame F = mkframe(ws, wv); rwkv_scan<true>(F, F.blk >> 3, F.blk & 7);
#ifdef SCAN_TWICE
    __syncthreads(); rwkv_scan<false>(F, F.blk >> 3, F.blk & 7);
#endif
}
PHASE f_rwkv_out(int wv, unsigned char* ws_, const float* lnx) { unsigned char* ws = uni(ws_); const Frame F = mkframe(ws, wv); rwkv_out(F, uni(lnx)); }
PHASE f_attn(int wv, unsigned char* ws_, int layer_) {
    unsigned char* ws = uni(ws_); const int layer = uni(layer_); const Frame F = mkframe(ws, wv);
    unsigned* qh = (unsigned*)(ws + WS_CTL) + CW_ATTQ + layer * 512; volatile LAS unsigned* slot = (volatile LAS unsigned*)(F.lds + LDSCTL_OFF + 32);
    const int my = (int)(xb_xcc_id() & 7u);
    for (int k = 0; k < 8; ++k) { const int q = (my + k) & 7;
        for (;;) {
            if (F.tid == 0) *slot = __hip_atomic_fetch_add(qh + q * 64, 1u, __ATOMIC_RELAXED, __HIP_MEMORY_SCOPE_AGENT);
            __syncthreads();
            const int idx = (int)*slot;
            __syncthreads();
            if (idx >= 64) break;
            const int bh = 2 * q + (idx & 1), qt = 31 - (idx >> 1);
            attn_unit(F, bh >> 3, bh & 7, qt);
        } }
}
PHASE f_moe_scatter(int wv, unsigned char* ws_) { unsigned char* ws = uni(ws_); const Frame F = mkframe(ws, wv); moe_table(F, (unsigned*)(ws + WS_CTL) + CW_ECNT); phase_moe_scatter(F, (unsigned*)(ws + WS_CTL) + CW_ECNT); }
PHASE f_final(int wv, unsigned char* ws_, float* h, const float* gain) { unsigned char* ws = uni(ws_); const Frame F = mkframe(ws, wv); phase_final(F, uni(h), uni(gain), (const bf16_t*)(ws + WS_OUT2), (const int*)(ws + WS_TOK) + 2 * MTOK); }
PHASE g_inproj(int wv, unsigned char* ws_, int layer_) {
    unsigned char* ws = uni(ws_); const int layer = uni(layer_); const Frame F = mkframe(ws, wv);
    SchedGrid S; S.init(64, 18, F.G, F.blk, ws + WS_HN, (size_t)256 * DM * 2, (bf16_t*)(ws + WS_WIN) + (size_t)layer * WIN_ROWS * DM, (size_t)256 * DM * 2);
    EpiStore E; E.O = (bf16_t*)(ws + WS_P); E.ld = PW; E.SS = (const float*)(ws + WS_SS); E.rl = (LAS float*)(F.lds + RING_BYTES); E.tid = F.tid; pg8::gemm_phase(F.lds, F.tid, DM, DM, DM, S, E);
}
PHASE g_lora(int wv, unsigned char* ws_, const float* w0, const float* a0, int layer_) {
    unsigned char* ws = uni(ws_); const int layer = uni(layer_); const Frame F = mkframe(ws, wv);
    SchedGrid S; S.init(64, 6, F.G, F.blk, ws + WS_LIN, (size_t)256 * LORA_K * 2, (bf16_t*)(ws + WS_LORA) + (size_t)layer * 1536 * LORA_K, (size_t)256 * LORA_K * 2);
    EpiLora E; E.O = (bf16_t*)(ws + WS_LO); E.w0 = uni(w0); E.a0 = uni(a0); pg8::gemm_phase(F.lds, F.tid, LORA_K, LORA_K, LORA_K, S, E);
}
PHASE g_small(int wv, unsigned char* ws_, int layer_) {
    unsigned char* ws = uni(ws_); const Frame F = mkframe(ws, wv); SchedSmall S; S.G = F.G; S.c = F.blk; S.layer = uni(layer_); S.ws = (const char*)ws; EpiSmall E; E.ws = ws; pg8::gemm_phase(F.lds, F.tid, 256, 256, 256, S, E);
}
PHASE g_gate(int wv, unsigned char* ws_, int layer_) {
    unsigned char* ws = uni(ws_); const int layer = uni(layer_); const Frame F = mkframe(ws, wv);
    SchedOwn3 S; S.c = F.blk; S.G = F.G; S.A = (const char*)(ws + WS_HN); S.a_n = 0; S.astep = (size_t)256 * DM * 2; S.B = (const char*)((bf16_t*)(ws + WS_WIN) + ((size_t)layer * WIN_ROWS + PW) * DM); S.bstep = (size_t)256 * DM * 2; S.b_n = (size_t)1024 * DM * 2;
    EpiGate E; E.O = (bf16_t*)(ws + WS_G); E.SS = (const float*)(ws + WS_SS); E.rl = (LAS float*)(F.lds + RING_BYTES); E.tid = F.tid; pg8::gemm_phase(F.lds, F.tid, DM, DM, DM, S, E);
}
PHASE g_merge(int wv, unsigned char* ws_, int layer_) {
    unsigned char* ws = uni(ws_); const int layer = uni(layer_); const Frame F = mkframe(ws, wv);
    SchedOwn3 S; S.c = F.blk; S.G = F.G; S.A = (const char*)(ws + WS_YRET); S.a_n = (size_t)16 * MiB; S.astep = (size_t)256 * 512 * 2;
    S.B = (const char*)((bf16_t*)(ws + WS_BR) + (size_t)layer * 3 * 1024 * 512); S.bstep = (size_t)256 * 512 * 2; S.b_n = (size_t)1024 * 512 * 2;
    EpiMerge E; E.Gt = (const bf16_t*)(ws + WS_G); E.Mg = (bf16_t*)(ws + WS_MRG); pg8::gemm_phase(F.lds, F.tid, 512, 512, 512, S, E);
}
template <bool EMIT>
PHASE g_wo(int wv, unsigned char* ws_, const float* hin, float* hout, const float* gain, int layer_) {
    unsigned char* ws = uni(ws_); const int layer = uni(layer_); const Frame F = mkframe(ws, wv);
    SchedGrid S; S.init(64, 4, F.G, F.blk, ws + WS_MRG, (size_t)256 * DM * 2, (bf16_t*)(ws + WS_WO) + (size_t)layer * DM * DM, (size_t)256 * DM * 2);
    EpiResid<EMIT> E; E.In = uni(hin); E.Out = uni(hout); E.gain = uni(gain); E.Hg = (bf16_t*)(ws + WS_HN); E.SS = (float*)(ws + WS_SS); pg8::gemm_phase(F.lds, F.tid, DM, DM, DM, S, E);
}
PHASE g_ffn_gu(int wv, unsigned char* ws_) {
    unsigned char* ws = uni(ws_); const Frame F = mkframe(ws, wv);
    SchedGrid S; S.init(64, 22, F.G, F.blk, ws + WS_HN, (size_t)256 * DM * 2, ws + WS_FGU, (size_t)256 * DM * 2);
    EpiSwiglu E; E.O = (bf16_t*)(ws + WS_ACT); E.ldc = DFF; E.pn_off = 0; E.SS = (const float*)(ws + WS_SS); E.rl = (LAS float*)(F.lds + RING_BYTES); E.tid = F.tid; pg8::gemm_phase(F.lds, F.tid, DM, DM, DM, S, E);
}
PHASE g_ffn_down(int wv, unsigned char* ws_, float* h, const float* gain) {
    unsigned char* ws = uni(ws_); const Frame F = mkframe(ws, wv);
    SchedGrid S; S.init(64, 4, F.G, F.blk, ws + WS_ACT, (size_t)256 * DFF * 2, ws + WS_FD, (size_t)256 * DFF * 2);
    EpiResid<true> E; E.In = uni(h); E.Out = (float*)E.In; E.gain = uni(gain); E.Hg = (bf16_t*)(ws + WS_HN); E.SS = (float*)(ws + WS_SS); pg8::gemm_phase(F.lds, F.tid, DFF, DFF, DFF, S, E);
}
PHASE g_moe_gu(int wv, unsigned char* ws_, int hh_) {
    unsigned char* ws = uni(ws_); const int hh = uni(hh_); const Frame F = mkframe(ws, wv); const LAS int* tab = (const LAS int*)(F.lds + LDS_TAB);
    moe_gather_table(F, 14);
    SchedMoe S; S.G = F.G; S.c = F.blk; S.ncol = 14; S.ntile = tab[0]; S.tab = tab + 16; S.A = (const char*)(ws + WS_HN); S.astep = 0;
    S.B = (const char*)(ws + WS_MGU) + (size_t)hh * 14 * 256 * DM * 2; S.bstep = (size_t)256 * DM * 2; S.estep = (size_t)2 * DFFE * DM * 2;
    EpiSwiglu E; E.O = (bf16_t*)(ws + WS_MACT); E.ldc = DFFH; E.pn_off = 0; E.SS = nullptr; E.rl = nullptr; E.tid = 0; pg8::gemm_phase<EpiSwiglu, SchedMoe, true>(F.lds, F.tid, DM, DM, DM, S, E, (const LAS unsigned*)(F.lds + LDS_GTAB));
}
template <bool ACCUM>
PHASE g_moe_down(int wv, unsigned char* ws_, int hh_) {
    unsigned char* ws = uni(ws_); const int hh = uni(hh_); const Frame F = mkframe(ws, wv); const LAS int* tab = (const LAS int*)(F.lds + LDS_TAB);
    const float* row_w = (const float*)((const int*)(ws + WS_TOK) + 6 * MTOK + MAXROWS);
    SchedMoe S; S.G = F.G; S.c = F.blk; S.ncol = 4; S.ntile = tab[0]; S.tab = tab + 16; S.A = (const char*)(ws + WS_MACT); S.astep = (size_t)256 * DFFH * 2;
    S.B = (const char*)(ws + WS_MD) + (size_t)hh * DFFH * 2; S.bstep = (size_t)256 * DFFE * 2; S.estep = (size_t)DM * DFFE * 2;
    EpiMoeOut<ACCUM> E; E.row_w = row_w; E.O = (bf16_t*)(ws + WS_OUT2); pg8::gemm_phase(F.lds, F.tid, DFFH, DFFH, DFFE, S, E);
}

typedef const __attribute__((address_space(4))) Params* KPtr;
__device__ __forceinline__ KPtr kargs() { KPtr k = (KPtr)__builtin_amdgcn_kernarg_segment_ptr(); asm volatile("" : "+s"(k)); return k; }
#define KIN(i) (kargs()->in[i])
#define KWS() (kargs()->ws)
struct TpState { unsigned long long tp0, tp1; int tpk; };
#define tp0 tps.tp0
#define tp1 tps.tp1
#define tpk tps.tpk
#define GRID_BAR() do { XcdBarrier b_ = bar; b_.bar = (unsigned*)(KWS() + WS_CTL) + CW_BAR; b_.x = xb_xcc_id(); xcd_barrier(b_); } while (0)
#ifdef TPH
#define TP(k) do { volatile LAS unsigned long long* tpl_ = (volatile LAS unsigned long long*)(lds_raw + LDSCTL_OFF + 48); if ((k) == TPH) tpl_[0] = __builtin_amdgcn_s_memrealtime(); if ((k) == TPH + TPN) tpl_[1] = __builtin_amdgcn_s_memrealtime(); } while (0)
#define TPM() do { ++tpk; TP(tpk); } while (0)
#else
#define TP(k) do { } while (0)
#define TPM() do { } while (0)
#endif
template <int layer>
__device__ __forceinline__ void layer_body(const int wv, const XcdBarrier& bar, TpState& tps) {
        g_inproj(wv, KWS(), layer);
        GRID_BAR();
        TPM();
        f_prep(wv, KWS(), KIN(I_MU) + (size_t)layer * RWKV_COLS, KIN(I_QNORM) + layer * 256, KIN(I_KVNORM) + layer * 128, layer);
        GRID_BAR();
        TPM();
        f_ret_scan(wv, KWS());
        g_lora(wv, KWS(), KIN(I_W0) + layer * 512, KIN(I_A0) + layer * 512, layer);
        g_small(wv, KWS(), layer);
        GRID_BAR();
        TPM();
        f_ret_out(wv, KWS());
#ifdef SPLIT5
        GRID_BAR();
        TPM();
#endif
#ifndef RWKV_SEQ
        f_rwkv_pre(wv, KWS(), KIN(I_MU) + (size_t)layer * RWKV_COLS, KIN(I_KK) + layer * 512, KIN(I_KA) + layer * 512, KIN(I_RK) + layer * 512);
        GRID_BAR();
        TPM();
        if ((int)blockIdx.x < 16) f_rwkv_scan(wv, KWS());
#ifdef SPLIT6
        GRID_BAR();
        TPM();
#endif
#else
        GRID_BAR();
        TPM();
        if (blockIdx.x < 16) f_rwkv_seq(wv, KWS(), KIN(I_MU) + (size_t)layer * RWKV_COLS, KIN(I_KK) + layer * 512, KIN(I_KA) + layer * 512, KIN(I_RK) + layer * 512, KIN(I_LNX) + layer * 512, layer);
#endif
        f_attn(wv, KWS(), layer);
        GRID_BAR();
        TPM();
#ifndef RWKV_SEQ
        f_rwkv_out(wv, KWS(), KIN(I_LNX) + layer * 512);
#endif
        g_gate(wv, KWS(), layer);
#ifndef RWKV_SEQ
        GRID_BAR();
        TPM();
#endif
        g_merge(wv, KWS(), layer);
        GRID_BAR();
        TPM();
        g_wo<layer == 0>(wv, KWS(), layer == 0 ? KIN(I_X) : (const float*)kargs()->out, kargs()->out, KIN(I_FNORM) + layer * DM, layer);
        GRID_BAR();
        TPM();
        if constexpr (layer == 0) {
            g_ffn_gu(wv, KWS());
            GRID_BAR();
            TPM();
            g_ffn_down(wv, KWS(), kargs()->out, KIN(I_ANORM) + DM);
            GRID_BAR();
            TPM();
        } else {
            f_rms_moe(wv, KWS(), kargs()->out, KIN(I_FNORM) + layer * DM, KIN(I_ROUTER));
            f_moe_convert<0>(wv, KWS(), KIN(I_MG), KIN(I_MU2), KIN(I_MD));
            GRID_BAR();
            TPM();
            f_moe_scatter(wv, KWS());
            GRID_BAR();
            TPM();
            g_moe_gu(wv, KWS(), 0);
            GRID_BAR();
            TPM();
            g_moe_down<false>(wv, KWS(), 0);
            f_moe_convert<1>(wv, KWS(), KIN(I_MG), KIN(I_MU2), KIN(I_MD));
            GRID_BAR();
            TPM();
            g_moe_gu(wv, KWS(), 1);
            GRID_BAR();
            TPM();
            g_moe_down<true>(wv, KWS(), 1);
            GRID_BAR();
            TPM();
        }
    }
__global__ void __launch_bounds__(NTHR, 2) mega(Params P_unused) {
    LAS unsigned char* lds = (LAS unsigned char*)lds_raw;
    const int wv = __builtin_amdgcn_readfirstlane((int)threadIdx.x >> 6);
    for (int u = threadIdx.x; u < (LDS_BYTES - LDSCTL_OFF) / 4; u += NTHR) ((LAS unsigned*)(lds + LDSCTL_OFF))[u] = 0u;
    __syncthreads();
    const XcdBarrier bar = xcd_barrier_post((unsigned*)(KWS() + WS_CTL) + CW_BAR, (volatile LAS unsigned*)(lds + LDSCTL_OFF), wv);
    TpState tps = {0ull, 0ull, 0};
    TP(0);
    {
        KPtr k = kargs(); unsigned char* ws = k->ws; const Frame F = mkframe(ws, wv);
        Params P; P.in[I_WIN] = k->in[I_WIN]; P.in[I_WQB] = k->in[I_WQB]; P.in[I_WBR] = k->in[I_WBR]; P.in[I_WO] = k->in[I_WO]; P.in[I_FG] = k->in[I_FG]; P.in[I_FU] = k->in[I_FU]; P.in[I_FD] = k->in[I_FD];
        P.in[I_W2] = k->in[I_W2]; P.in[I_A2] = k->in[I_A2]; P.in[I_G2] = k->in[I_G2]; P.in[I_WKVB] = k->in[I_WKVB]; P.in[I_POS] = k->in[I_POS]; P.in[I_X] = k->in[I_X]; P.in[I_ANORM] = k->in[I_ANORM];
        phase_prologue(F, P);
    }
    GRID_BAR();
    TPM();
    layer_body<0>(wv, bar, tps);
    layer_body<1>(wv, bar, tps);
    f_final(wv, KWS(), kargs()->out, KIN(I_FINAL));
#ifdef PRE_T
    __syncthreads();
    { volatile LAS unsigned long long* tq_ = (volatile LAS unsigned long long*)(lds_raw + LDSCTL_OFF + 48); const unsigned long long te = __builtin_amdgcn_s_memrealtime(), span = tq_[1] * 8ull; while (__builtin_amdgcn_s_memrealtime() - te < span) __builtin_amdgcn_s_sleep(8); }
#endif
#ifdef TPH
    __syncthreads(); TPM();
    { volatile LAS unsigned long long* tpl_ = (volatile LAS unsigned long long*)(lds_raw + LDSCTL_OFF + 48); const unsigned long long te = __builtin_amdgcn_s_memrealtime(), span = (tpl_[1] - tpl_[0]) * (unsigned long long)TAMP; while (__builtin_amdgcn_s_memrealtime() - te < span) __builtin_amdgcn_s_sleep(8); }
#endif
}

extern "C" void kernel_launch(void* const* d_in, const int* in_sizes, int n_in, void* d_out, int out_size, void* d_ws, size_t ws_size, hipStream_t stream) {
    static int ready = 0;
    if (!ready) {
        if (n_in != 29 || out_size != MTOK * DM || ws_size < WS_END) { fprintf(stderr, "kernel_launch: unexpected shapes (n_in %d out %d ws %zu need %zu)\n", n_in, out_size, ws_size, (size_t)WS_END); ready = -1; return; }
        if (hipFuncSetAttribute((const void*)mega, hipFuncAttributeMaxDynamicSharedMemorySize, LDS_BYTES) != hipSuccess) { fprintf(stderr, "kernel_launch: hipFuncSetAttribute failed\n"); ready = -1; return; }
        int dev = 0, cus = 0, per_cu = 0; (void)hipGetDevice(&dev); (void)hipDeviceGetAttribute(&cus, hipDeviceAttributeMultiprocessorCount, dev);
        (void)hipOccupancyMaxActiveBlocksPerMultiprocessor(&per_cu, (const void*)mega, NTHR, LDS_BYTES);
        if (cus < 256 || per_cu < 1) { fprintf(stderr, "kernel_launch: needs 256 CUs with one resident workgroup each (cus %d, per_cu %d)\n", cus, per_cu); ready = -1; return; }
        ready = 1;
    }
    if (ready < 0) return;
    (void)hipMemsetAsync((char*)d_ws + WS_CTL, 0, CTL_BYTES, stream);
    Params p{}; for (int i = 0; i < 29; ++i) p.in[i] = (const float*)d_in[i]; p.out = (float*)d_out; p.ws = (unsigned char*)d_ws;
    hipLaunchKernelGGL(mega, dim3(256), dim3(NTHR), LDS_BYTES, stream, p);
}
```

```cpp
#include <hip/hip_runtime.h>
#include <cstdio>
#include <cstdint>

#define LAS __attribute__((address_space(3)))
#define GAS __attribute__((address_space(1)))
typedef unsigned short bf16_t;
typedef short bf16x8 __attribute__((ext_vector_type(8)));
typedef short bf16x4 __attribute__((ext_vector_type(4)));
typedef float f32x4 __attribute__((ext_vector_type(4)));
typedef float f32x2 __attribute__((ext_vector_type(2)));
typedef float f32x16 __attribute__((ext_vector_type(16)));
typedef unsigned u32x4 __attribute__((ext_vector_type(4)));
typedef unsigned u32x2 __attribute__((ext_vector_type(2)));

constexpr int NB = 2, SEQ = 8192, DM = 1024, MTOK = NB * SEQ, NLAYER = 2, CH = 64, NCHUNK = SEQ / CH;
constexpr int IN_COLS = 7360, PW = 4608;
constexpr int P_RQ = 0, P_RK = 512, P_RV = 1024, P_RG = 1536, P_RW = 2048, P_QA = 4096, P_KVA = 4352;
constexpr int WIN_ROWS = 7680;
constexpr int RWKV_COLS = 1824, LORA_K = 384, LO_W = 1536;
constexpr int DFF = 2816, DFFE = 3584, NEXP = 8, DFFH = DFFE / 2;
constexpr int MAXROWS = 34816;
constexpr float NORM_EPS = 1e-6f;

constexpr size_t MiB = 1u << 20;
constexpr size_t WS_CTL = 0, CTL_BYTES = 1 * MiB;
constexpr size_t WS_WIN = 1 * MiB;
constexpr size_t WS_LORA = 31 * MiB;
constexpr size_t WS_QB = 34 * MiB;
constexpr size_t WS_KB = 35 * MiB;
constexpr size_t WS_VB = 35 * MiB + 512 * 1024;
constexpr size_t WS_BR = 36 * MiB;
constexpr size_t WS_WO = 42 * MiB;
constexpr size_t WS_FGU = 46 * MiB;
constexpr size_t WS_FD = 57 * MiB;
constexpr size_t WS_COSR = 63 * MiB, WS_SINR = 67 * MiB, WS_COSM = 71 * MiB, WS_SINM = 72 * MiB;
constexpr size_t WS_HN = 73 * MiB;
constexpr size_t WS_TOK = 105 * MiB;
constexpr size_t WS_T = 106 * MiB;
constexpr size_t WS_P = WS_T;
constexpr size_t WS_G = WS_T;
constexpr size_t WS_MRG = WS_T + 96 * MiB;
constexpr size_t WS_LO = WS_T + 144 * MiB;
constexpr size_t WS_Q = WS_T + 192 * MiB;
constexpr size_t WS_KN = WS_T + 216 * MiB;
constexpr size_t WS_VT = WS_T + 232 * MiB;
constexpr size_t WS_KPE = WS_T + 248 * MiB;
constexpr size_t WS_LIN = WS_T + 249 * MiB;
constexpr size_t WS_QN = WS_T + 261 * MiB;
constexpr size_t WS_CN = WS_T + 269 * MiB;
constexpr size_t WS_YRET = WS_T + 261 * MiB;
constexpr size_t WS_RS = WS_T + 277 * MiB;
constexpr size_t WS_YRW = WS_T + 277 * MiB;
constexpr size_t WS_YMLA = WS_T + 293 * MiB;
constexpr size_t WS_RC = WS_T + 309 * MiB;
constexpr size_t WS_ACT = WS_T;
constexpr size_t WS_MGU = WS_T;
constexpr size_t WS_MD = WS_T + 112 * MiB;
constexpr size_t WS_MACT = WS_T + 168 * MiB;
constexpr size_t WS_OUT2 = WS_T + 287 * MiB;
constexpr size_t WS_SS = WS_T + 390 * MiB;
constexpr size_t WS_END = WS_T + 391 * MiB;
static_assert(WS_MACT + (size_t)MAXROWS * DFFH * 2 <= WS_OUT2 && WS_OUT2 + (size_t)MAXROWS * DM * 2 <= WS_END, "ws map");
constexpr int CW_BAR = 4096;
constexpr int CW_ECNT = 16384;
constexpr int CW_ATTQ = 20480;

__device__ __forceinline__ unsigned f2bf(float f) { unsigned u = __builtin_bit_cast(unsigned, f); return (u + 0x7fffu + ((u >> 16) & 1u)) >> 16; }
typedef __bf16 bf16n2 __attribute__((ext_vector_type(2)));
__device__ __forceinline__ unsigned pk2(float lo, float hi) { const f32x2 f = {lo, hi}; const bf16n2 v = __builtin_convertvector(f, bf16n2); return __builtin_bit_cast(unsigned, v); }
__device__ __forceinline__ float bf2f(unsigned short h) { return __builtin_bit_cast(float, (unsigned)h << 16); }
__device__ __forceinline__ float bflo(unsigned w) { return __builtin_bit_cast(float, w << 16); }
__device__ __forceinline__ float bfhi(unsigned w) { return __builtin_bit_cast(float, w & 0xffff0000u); }
template <int CTRL, int ROWMASK = 0xF>
__device__ __forceinline__ float dpp_add(float v) { const int t = __builtin_amdgcn_update_dpp(0, __builtin_bit_cast(int, v), CTRL, ROWMASK, 0xF, ROWMASK == 0xF); return v + __builtin_bit_cast(float, t); }
#ifdef NO_DPP
__device__ __forceinline__ float sum4(float v)  { v += __shfl_xor(v, 1); v += __shfl_xor(v, 2); return v; }
__device__ __forceinline__ float sum8(float v)  { v = sum4(v); v += __shfl_xor(v, 4); return v; }
__device__ __forceinline__ float sum16(float v) { v = sum8(v); v += __shfl_xor(v, 8); return v; }
__device__ __forceinline__ float wave_sum(float v) { v = sum16(v); v += __shfl_xor(v, 16); v += __shfl_xor(v, 32); return v; }
#else
__device__ __forceinline__ float sum4(float v)  { v = dpp_add<0xB1>(v); return dpp_add<0x4E>(v); }
__device__ __forceinline__ float sum8(float v)  { return dpp_add<0x141>(sum4(v)); }
__device__ __forceinline__ float sum16(float v) { return dpp_add<0x140>(sum8(v)); }
__device__ __forceinline__ float wave_sum(float v) {
    v = sum16(v); v = dpp_add<0x142, 0xA>(v); v = dpp_add<0x143, 0xC>(v);
    return __builtin_bit_cast(float, __builtin_amdgcn_readlane(__builtin_bit_cast(int, v), 63));
}
#endif
__device__ __forceinline__ float sigmoidf_(float x) { return 1.0f / (1.0f + __expf(-x)); }
#define LDS_WAIT() asm volatile("s_waitcnt lgkmcnt(0)" ::: "memory")
#define LBAR() do { asm volatile("s_waitcnt lgkmcnt(0)" ::: "memory"); __builtin_amdgcn_s_barrier(); asm volatile("" ::: "memory"); } while (0)
#define VM_WAIT() asm volatile("s_waitcnt vmcnt(0)" ::: "memory")

#define XB_TMO      128
#define XB_XCNT(j)  (256  + 64 * (j))
#define XB_XSUB(j)  (1280 + 64 * (j))
#define XB_XGEN(j)  (2304 + 64 * (j))
#define XB_TOP      3328
#define XB_TOPGEN   3392
#define XCD_BAR_WORDS 3456
#define XB_SPIN_CAP (1u << 18)
__device__ __forceinline__ unsigned xb_ld(unsigned* p)              { return __hip_atomic_load(p, __ATOMIC_RELAXED, __HIP_MEMORY_SCOPE_AGENT); }
__device__ __forceinline__ unsigned xb_add(unsigned* p, unsigned v) { return __hip_atomic_fetch_add(p, v, __ATOMIC_RELAXED, __HIP_MEMORY_SCOPE_AGENT); }
__device__ __forceinline__ unsigned xb_xcc_id() { return (unsigned)__builtin_amdgcn_s_getreg((3 << 11) | 20) & 0xFu; }
#define XB_SPIN(cond, bar) do { unsigned _sp = 0; while (cond) { __builtin_amdgcn_s_sleep(1); \
    if ((++_sp & 255u) == 0u) { if (xb_ld(&(bar)[XB_TMO])) break; if (_sp > XB_SPIN_CAP) { atomicAdd(&(bar)[XB_TMO], 1u); break; } } } } while (0)
struct XcdBarrier { unsigned* bar; unsigned x; volatile LAS unsigned* st; int wv; };
__device__ __forceinline__ int lane_id_fresh() { int l; asm volatile("v_mbcnt_lo_u32_b32 %0, -1, 0\n\tv_mbcnt_hi_u32_b32 %0, -1, %0" : "=v"(l)); return l; }
__device__ __forceinline__ bool xb_thread0(int wv) { return wv == 0 && lane_id_fresh() == 0; }
__device__ __forceinline__ XcdBarrier xcd_barrier_post(unsigned* bar, volatile LAS unsigned* st, int wv) {
    XcdBarrier b; b.bar = bar; b.x = xb_xcc_id(); b.st = st; b.wv = wv;
    if (xb_thread0(wv)) (void)xb_add(&bar[XB_XCNT(b.x)], 1u);
    return b;
}
__device__ __forceinline__ void xcd_barrier_complete(unsigned* bar, unsigned x, unsigned& nloc, unsigned& nx) {
    const unsigned G = gridDim.x * gridDim.y * gridDim.z;
    unsigned sum, cnt, mine, sp = 0u;
    for (;;) {
        sum = 0u; cnt = 0u; mine = 0u;
#pragma unroll
        for (unsigned j = 0; j < 16; ++j) { const unsigned c = xb_ld(&bar[XB_XCNT(j)]); sum += c; cnt += (c > 0u) ? 1u : 0u; mine = (j == x) ? c : mine; }
        if (sum == G) break;
        __builtin_amdgcn_s_sleep(1);
        if ((++sp & 255u) == 0u) { if (xb_ld(&bar[XB_TMO])) break; if (sp > XB_SPIN_CAP) { atomicAdd(&bar[XB_TMO], 1u); break; } }
    }
    nloc = mine > 0u ? mine : 1u; nx = cnt > 0u ? cnt : 1u;
}
__device__ __forceinline__ void xcd_barrier(const XcdBarrier& b) {
    asm volatile("s_waitcnt vmcnt(0)" ::: "memory");
    __syncthreads();
    if (xb_thread0(b.wv)) {
        unsigned* bar = b.bar;
        __builtin_amdgcn_s_waitcnt(0);
        unsigned nloc = b.st[0], nx = b.st[1];
        if (nloc == 0u) { xcd_barrier_complete(bar, b.x, nloc, nx); b.st[0] = nloc; b.st[1] = nx; }
        const unsigned old = xb_add(&bar[XB_XSUB(b.x)], 1u);
        const unsigned gen = old / nloc;
        if (old + 1u == (gen + 1u) * nloc) {
            __builtin_amdgcn_fence(__ATOMIC_RELEASE, "agent");
            asm volatile("s_waitcnt vmcnt(0)" ::: "memory");
            const unsigned og = xb_add(&bar[XB_TOP], 1u);
            const unsigned tg = og / nx;
            if (og + 1u == (tg + 1u) * nx) xb_add(&bar[XB_TOPGEN], 1u);
            else XB_SPIN(xb_ld(&bar[XB_TOPGEN]) == tg, bar);
            __builtin_amdgcn_fence(__ATOMIC_ACQUIRE, "agent");
            xb_add(&bar[XB_XGEN(b.x)], 1u);
            asm volatile("s_waitcnt vmcnt(0)" ::: "memory");
        } else {
            XB_SPIN(xb_ld(&bar[XB_XGEN(b.x)]) == gen, bar);
            __builtin_amdgcn_fence(__ATOMIC_ACQUIRE, "agent");
            asm volatile("s_waitcnt vmcnt(0)" ::: "memory");
        }
    }
    __syncthreads();
}

namespace pg8 {
constexpr int BM = 256, BK = 64, HALF = 128, HTB = HALF * BK * 2, STAGE_BYTES = 8 * HTB;
__device__ __forceinline__ int lds_byte(int r, int c) { const int st = (r >> 4) * 2 + (c >> 5), rr = r & 15, cc = c & 31, ob = rr * 64 + cc * 2; return st * 1024 + (ob ^ (((ob >> 9) & 1) << 5)); }
__device__ __forceinline__ void stage_rc(int b, int& R, int& C) { const int st = b / 1024, sb = b % 1024, swz = sb ^ (((sb >> 9) & 1) << 5); R = (st >> 1) * 16 + swz / 64; C = (st & 1) * 32 + (swz % 64) / 2; }
__device__ __forceinline__ int perm32(int rho) { const int n = rho >> 4, i = rho & 15; return 8 * (i >> 2) + 4 * n + (i & 3); }
struct Unit { int pm, pn, aux; const char* A; const char* B; };
__device__ __forceinline__ unsigned cvt_pk_bf16(float lo, float hi) { return pk2(lo, hi); }

template <class Epi, class Sched, bool GATHER = false>
__device__ __forceinline__ void gemm_phase(LAS unsigned char* lds, const int tid_in, const int K, const int lda, const int ldb, const Sched& S, const Epi& E, const LAS unsigned* gtab = nullptr) {
    int tid_ = tid_in; asm volatile("" : "+v"(tid_));
    const int tid = tid_, wid = __builtin_amdgcn_readfirstlane(tid >> 6), lane = tid & 63, wr = wid >> 2, wc = wid & 3, fr = lane & 15, fq = lane >> 4;
    const int nt = K / BK;
    unsigned voffA[2], voffB[2];
#pragma unroll
    for (int i = 0; i < 2; ++i) { int R, C; stage_rc(tid * 16 + i * 8192, R, C); const int Rb = Epi::PERM ? ((R & ~31) + perm32(R & 31)) : R;
        voffA[i] = (unsigned)(R * lda + C) * 2u; voffB[i] = (unsigned)(Rb * ldb + C) * 2u; }
    const size_t kstep = (size_t)(BK * 2);
    const size_t hstepA = GATHER ? (size_t)0 : (size_t)HALF * lda * 2, hstepB = (size_t)HALF * ldb * 2;
    int gR[2], gC[2]; unsigned gcur[2][2], gnxt[2][2];
    if constexpr (GATHER) {
#pragma unroll
        for (int i = 0; i < 2; ++i) { int R, C; stage_rc(tid * 16 + i * 8192, R, C); gR[i] = R; gC[i] = C * 2; }
    }
#define PG8_GLOAD(dst, u_) do { _Pragma("unroll") for (int _h = 0; _h < 2; ++_h) _Pragma("unroll") for (int _i = 0; _i < 2; ++_i) dst[_h][_i] = gtab[(u_) * 256 + _h * 128 + gR[_i]] + (unsigned)gC[_i]; } while (0)
    const unsigned ldsw = (unsigned)wid * 1024u;
    const int aoff = lds_byte(wr * 64 + fr, fq * 8), boff = lds_byte(wc * 32 + fr, fq * 8);
#define PG8_SA(b, h) (((b) * 2 + (h)) * HTB)
#define PG8_SB(b, h) ((4 + (b) * 2 + (h)) * HTB)
#define PG8_STAGE(bufoff, gbase, voff) do { _Pragma("unroll") for (int _i = 0; _i < 2; ++_i) \
        __builtin_amdgcn_global_load_lds((const unsigned*)((const char*)(gbase) + (voff)[_i]), (LAS unsigned*)(lds + (bufoff) + ldsw + _i * 8192), 16, 0, 0); } while (0)
#define PG8_STAGEA(bufoff, gbase, h, tab) do { if constexpr (GATHER) { PG8_STAGE(bufoff, gbase, tab[h]); } else { PG8_STAGE(bufoff, (gbase) + (h) * hstepA, voffA); } } while (0)
#define PG8_LDA(dst, b, h) do { _Pragma("unroll") for (int m = 0; m < 4; ++m) _Pragma("unroll") for (int k = 0; k < 2; ++k) dst[m][k] = *(const LAS bf16x8*)(lds + PG8_SA(b, h) + aoff + m * 2048 + k * 1024); } while (0)
#define PG8_LDB(dst, b, h) do { _Pragma("unroll") for (int n = 0; n < 2; ++n) _Pragma("unroll") for (int k = 0; k < 2; ++k) dst[n][k] = *(const LAS bf16x8*)(lds + PG8_SB(b, h) + boff + n * 2048 + k * 1024); } while (0)
#define PG8_MMA(ai, bj, At, Bt) do { __builtin_amdgcn_s_setprio(1); _Pragma("unroll") for (int m = 0; m < 4; ++m) _Pragma("unroll") for (int n = 0; n < 2; ++n) _Pragma("unroll") for (int k = 0; k < 2; ++k) \
        acc[ai][bj][m][n] = __builtin_amdgcn_mfma_f32_16x16x32_bf16(Bt[n][k], At[m][k], acc[ai][bj][m][n], 0, 0, 0); __builtin_amdgcn_s_setprio(0); } while (0)
#define PG8_WAIT_V(n) asm volatile("s_waitcnt vmcnt(" #n ")" ::: "memory")
#define PG8_WAIT_L(n) asm volatile("s_waitcnt lgkmcnt(" #n ")" ::: "memory")
#define PG8_BAR __builtin_amdgcn_s_barrier()
#define PG8_SCHED __builtin_amdgcn_sched_barrier(0)
    Unit cur, nxt; int ui = 0;
    if (!S.next(0, cur)) return;
    f32x4 acc[2][2][4][2];
#pragma unroll
    for (int a = 0; a < 2; ++a)
#pragma unroll
        for (int b = 0; b < 2; ++b)
#pragma unroll
            for (int m = 0; m < 4; ++m)
#pragma unroll
                for (int n = 0; n < 2; ++n) acc[a][b][m][n] = (f32x4){0.f, 0.f, 0.f, 0.f};
    bf16x8 At[4][2], B0[2][2], B1[2][2];
    const char* cA = cur.A; const char* cB = cur.B;
    if constexpr (GATHER) { PG8_GLOAD(gcur, 0); PG8_GLOAD(gnxt, 1); asm volatile("s_waitcnt lgkmcnt(0)" ::: "memory"); }
    PG8_STAGE(PG8_SB(0, 0), cB, voffB); PG8_STAGE(PG8_SB(0, 1), cB + hstepB, voffB); PG8_STAGEA(PG8_SA(0, 0), cA, 0, gcur); PG8_STAGEA(PG8_SA(0, 1), cA, 1, gcur);
    if (wr == 1) PG8_BAR;
    PG8_WAIT_V(2); PG8_BAR;
    PG8_STAGE(PG8_SB(1, 0), cB + kstep, voffB); PG8_STAGEA(PG8_SA(1, 0), cA + kstep, 0, gcur); PG8_STAGE(PG8_SB(1, 1), cB + hstepB + kstep, voffB);
    PG8_WAIT_V(6); PG8_BAR;
#pragma unroll 1
    for (;;) {
        const bool has_next = S.next(ui + 1, nxt);
        const char* nA = has_next ? nxt.A : cA; const char* nB = has_next ? nxt.B : cB;
#pragma unroll 1
        for (int t = 0; t < nt; t += 2) {
            const bool last = (t == nt - 2);
            const char* a1 = cA + (size_t)(t + 1) * kstep;
            const char* a2 = last ? nA : cA + (size_t)(t + 2) * kstep; const char* b2 = last ? nB : cB + (size_t)(t + 2) * kstep;
            const char* a3 = a2 + kstep; const char* b3 = b2 + kstep;
            unsigned g2[2][2];
            if constexpr (GATHER) {
#pragma unroll
                for (int _h = 0; _h < 2; ++_h)
#pragma unroll
                    for (int _i = 0; _i < 2; ++_i) g2[_h][_i] = last ? gnxt[_h][_i] : gcur[_h][_i]; }
            PG8_LDB(B0, 0, 0); PG8_LDB(B1, 0, 1); PG8_SCHED; PG8_LDA(At, 0, 0); PG8_STAGEA(PG8_SA(1, 1), a1, 1, gcur);
            PG8_WAIT_V(8); PG8_WAIT_L(0); PG8_BAR; PG8_MMA(0, 0, At, B0); PG8_MMA(0, 1, At, B1); PG8_BAR; PG8_SCHED;
            PG8_LDA(At, 0, 1); PG8_STAGE(PG8_SB(0, 0), b2, voffB); PG8_STAGE(PG8_SB(0, 1), b2 + hstepB, voffB); PG8_STAGEA(PG8_SA(0, 0), a2, 0, g2);
            PG8_WAIT_V(8); PG8_WAIT_L(0); PG8_BAR; PG8_MMA(1, 0, At, B0); PG8_MMA(1, 1, At, B1); PG8_BAR; PG8_SCHED;
            PG8_LDB(B0, 1, 0); PG8_LDB(B1, 1, 1); PG8_SCHED; PG8_LDA(At, 1, 0); PG8_STAGEA(PG8_SA(0, 1), a2, 1, g2);
            PG8_WAIT_V(8); PG8_WAIT_L(0); PG8_BAR; PG8_MMA(0, 0, At, B0); PG8_MMA(0, 1, At, B1); PG8_BAR; PG8_SCHED;
            PG8_LDA(At, 1, 1); PG8_STAGE(PG8_SB(1, 0), b3, voffB); PG8_STAGE(PG8_SB(1, 1), b3 + hstepB, voffB); PG8_STAGEA(PG8_SA(1, 0), a3, 0, g2);
            PG8_WAIT_V(8); PG8_WAIT_L(0); PG8_BAR; PG8_MMA(1, 0, At, B0); PG8_MMA(1, 1, At, B1); PG8_BAR; PG8_SCHED;
        }
        if (wr == 0) PG8_BAR;
        E(acc, cur, wr, wc, fr, fq);
        if (!has_next) break;
#pragma unroll
        for (int a = 0; a < 2; ++a)
#pragma unroll
            for (int b = 0; b < 2; ++b)
#pragma unroll
                for (int m = 0; m < 4; ++m)
#pragma unroll
                    for (int n = 0; n < 2; ++n) acc[a][b][m][n] = (f32x4){0.f, 0.f, 0.f, 0.f};
        cur = nxt; cA = nA; cB = nB; ++ui;
        if constexpr (GATHER) {
#pragma unroll
            for (int _h = 0; _h < 2; ++_h)
#pragma unroll
                for (int _i = 0; _i < 2; ++_i) gcur[_h][_i] = gnxt[_h][_i];
            PG8_GLOAD(gnxt, ui + 1); }
        if (wr == 1) PG8_BAR;
    }
    PG8_WAIT_V(0);
    PG8_BAR;
#undef PG8_SA
#undef PG8_SB
#undef PG8_STAGE
#undef PG8_STAGEA
#undef PG8_GLOAD
#undef PG8_LDA
#undef PG8_LDB
#undef PG8_MMA
#undef PG8_WAIT_V
#undef PG8_WAIT_L
#undef PG8_BAR
#undef PG8_SCHED
}
}
constexpr int NWAVES = 8, NTHR = 512;
constexpr int RING_BYTES = 131072, LDS_BYTES = 147456, LDSCTL_OFF = LDS_BYTES - 2048;
struct Params { const float* in[29]; float* out; unsigned char* ws; };
struct Frame {
    LAS unsigned char* lds; int tid, lane, wave, blk, G, vcu, gw, ngw; unsigned char* ws;
};
enum { I_X = 0, I_POS, I_ANORM, I_WIN, I_MU, I_W0, I_W2, I_A0, I_A2, I_G2, I_KK, I_KA, I_RK, I_LNX, I_QNORM, I_WQB, I_KVNORM, I_WKVB, I_WBR, I_WO, I_FNORM,
       I_FG, I_FU, I_FD, I_ROUTER, I_MG, I_MU2, I_MD, I_FINAL };

struct SchedGrid {
    int nM, nN, nwg, G, c; const char* A; const char* B; size_t astep, bstep;
    __device__ void init(int nM_, int nN_, int G_, int c_, const void* A_, size_t astep_, const void* B_, size_t bstep_) { nM = nM_; nN = nN_; nwg = nM * nN; G = G_; c = c_; A = (const char*)A_; B = (const char*)B_; astep = astep_; bstep = bstep_; }
    __device__ __forceinline__ bool next(int i, pg8::Unit& u) const {
        const long L = (long)i * G + c; if (L >= nwg) return false;
        int wgid = (int)L; { const int q = nwg / 8, r = nwg % 8, xcd = wgid % 8, off = wgid / 8; wgid = (xcd < r ? xcd * (q + 1) : r * (q + 1) + (xcd - r) * q) + off; }
        const int nig = 8 * nN, gid = wgid / nig, fm = gid * 8, gsz = (nM - fm) < 8 ? (nM - fm) : 8;
        u.pm = fm + ((wgid % nig) % gsz); u.pn = (wgid % nig) / gsz; u.aux = 0;
        u.A = A + (size_t)u.pm * astep; u.B = B + (size_t)u.pn * bstep; return true;
    }
};
struct SchedSmall {
    int G, c, layer; const char* ws;
    __device__ __forceinline__ bool next(int i, pg8::Unit& u) const {
        int L = i * G + c; if (L >= 448) return false;
        int s = 0; if (L >= 192) { L -= 192; s = 1; if (L >= 128) { L -= 128; s = 2; } }
        const int nn = s == 0 ? 3 : (s == 1 ? 2 : 64);
        u.pm = L / nn; u.pn = L % nn; u.aux = s;
        const size_t lw = (size_t)layer * 256 * 2;
        const size_t ao = s == 0 ? WS_QN : (s == 1 ? WS_CN : WS_VB + lw * 512), bo = s == 0 ? WS_QB + lw * 768 : (s == 1 ? WS_KB + lw * 512 : WS_CN);
        u.A = ws + ao + (size_t)u.pm * (256 * 256 * 2); u.B = ws + bo + (size_t)u.pn * (256 * 256 * 2); return true;
    }
};
struct SchedOwn3 {
    int c, G; const char* A; const char* B; size_t astep, bstep, a_n, b_n;
    __device__ __forceinline__ bool next(int i, pg8::Unit& u) const {
        const int t = c + (i / 3) * G; if (t >= 256) return false;
        const int n = i % 3; u.pm = t >> 2; u.pn = t & 3; u.aux = n; u.A = A + (size_t)u.pm * astep + (size_t)n * a_n; u.B = B + (size_t)u.pn * bstep + (size_t)n * b_n; return true;
    }
};
struct SchedMoe {
    int G, c, ncol, ntile; const LAS int* tab; const char* A; const char* B; size_t astep, bstep, estep;
    __device__ __forceinline__ bool next(int i, pg8::Unit& u) const {
        const int L = i * G + c; if (L >= ntile * ncol) return false;
        u.pm = L / ncol; u.pn = L % ncol; const int e = tab[u.pm]; u.aux = e;
        u.A = A + (size_t)u.pm * astep; u.B = B + (size_t)e * estep + (size_t)u.pn * bstep; return true;
    }
};

using pg8::Unit; using pg8::cvt_pk_bf16;
#define EPI_ARGS const f32x4 (&acc)[2][2][4][2], const Unit& u, int wr, int wc, int fr, int fq
__device__ __forceinline__ float row_rstd(const float* SS, int row) {
    const f32x4* s = (const f32x4*)(SS + (size_t)row * 16); const f32x4 a = s[0], b = s[1], c = s[2], d = s[3];
    const float t = ((a.x + a.y) + (a.z + a.w)) + ((b.x + b.y) + (b.z + b.w)) + ((c.x + c.y) + (c.z + c.w)) + ((d.x + d.y) + (d.z + d.w));
    return rsqrtf(t * (1.0f / DM) + NORM_EPS);
}
__device__ __forceinline__ void panel_rstd(const float* SS, int pm, int tid, LAS float* rl) {
    if (tid < 256) rl[tid] = row_rstd(SS, pm * 256 + tid);
    asm volatile("s_waitcnt lgkmcnt(0)" ::: "memory"); __builtin_amdgcn_s_barrier(); asm volatile("" ::: "memory");
}
struct EpiStore {
    static constexpr bool PERM = true;
    bf16_t* O; int ld; const float* SS; LAS float* rl; int tid;
    __device__ __forceinline__ void operator()(EPI_ARGS) const {
        const int row0 = u.pm * 256 + wr * 64 + fr, col0 = u.pn * 256 + wc * 32 + 8 * fq;
        if (SS) panel_rstd(SS, u.pm, tid, rl);
#pragma unroll
        for (int ai = 0; ai < 2; ++ai)
#pragma unroll
            for (int m = 0; m < 4; ++m) { bf16_t* rowp = O + (size_t)(row0 + ai * 128 + m * 16) * ld + col0; const float rs = SS ? rl[wr * 64 + fr + ai * 128 + m * 16] : 1.0f;
#pragma unroll
                for (int bj = 0; bj < 2; ++bj) { const f32x4 v0 = acc[ai][bj][m][0] * rs, v1 = acc[ai][bj][m][1] * rs;
                    u32x4 w; w.x = cvt_pk_bf16(v0[0], v0[1]); w.y = cvt_pk_bf16(v0[2], v0[3]); w.z = cvt_pk_bf16(v1[0], v1[1]); w.w = cvt_pk_bf16(v1[2], v1[3]);
                    *(u32x4*)(rowp + bj * 128) = w; } }
    }
};
struct EpiSmall {
    static constexpr bool PERM = true;
    unsigned char* ws;
    __device__ __forceinline__ void operator()(EPI_ARGS) const {
        bf16_t* base = (bf16_t*)(ws + (u.aux == 0 ? WS_Q : (u.aux == 1 ? WS_KN : WS_VT))); const int ld = u.aux == 0 ? 768 : (u.aux == 1 ? 512 : MTOK);
        const int row0 = u.pm * 256 + wr * 64 + fr, col0 = u.pn * 256 + wc * 32 + 8 * fq;
#pragma unroll
        for (int ai = 0; ai < 2; ++ai)
#pragma unroll
            for (int m = 0; m < 4; ++m) { bf16_t* rowp = base + (size_t)(row0 + ai * 128 + m * 16) * ld + col0;
#pragma unroll
                for (int bj = 0; bj < 2; ++bj) { const f32x4 v0 = acc[ai][bj][m][0], v1 = acc[ai][bj][m][1];
                    u32x4 w; w.x = cvt_pk_bf16(v0[0], v0[1]); w.y = cvt_pk_bf16(v0[2], v0[3]); w.z = cvt_pk_bf16(v1[0], v1[1]); w.w = cvt_pk_bf16(v1[2], v1[3]);
                    *(u32x4*)(rowp + bj * 128) = w; } }
    }
};
struct EpiLora {
    static constexpr bool PERM = true;
    bf16_t* O; const float* w0; const float* a0;
    __device__ __forceinline__ void operator()(EPI_ARGS) const {
        const int seg = u.pn >> 1;
        const int row0 = u.pm * 256 + wr * 64 + fr, col0 = u.pn * 256 + wc * 32 + 8 * fq, ch0 = (u.pn & 1) * 256 + wc * 32 + 8 * fq;
        const float* bias = seg == 0 ? w0 : a0; const float sc = seg == 0 ? -0.6065306597126334f : 1.0f;
#pragma unroll
        for (int bj = 0; bj < 2; ++bj) {
            f32x4 b0 = {0.f, 0.f, 0.f, 0.f}, b1 = {0.f, 0.f, 0.f, 0.f};
            if (seg < 2) { b0 = *(const f32x4*)(bias + ch0 + bj * 128); b1 = *(const f32x4*)(bias + ch0 + bj * 128 + 4); }
#pragma unroll
            for (int ai = 0; ai < 2; ++ai)
#pragma unroll
                for (int m = 0; m < 4; ++m) { bf16_t* rowp = O + (size_t)(row0 + ai * 128 + m * 16) * LO_W + col0 + bj * 128;
                    f32x4 v0 = acc[ai][bj][m][0] + b0, v1 = acc[ai][bj][m][1] + b1;
                    if (seg < 2) {
#pragma unroll
                        for (int j = 0; j < 4; ++j) { v0[j] = sc * sigmoidf_(v0[j]); v1[j] = sc * sigmoidf_(v1[j]); }
                    }
                    u32x4 w; w.x = cvt_pk_bf16(v0[0], v0[1]); w.y = cvt_pk_bf16(v0[2], v0[3]); w.z = cvt_pk_bf16(v1[0], v1[1]); w.w = cvt_pk_bf16(v1[2], v1[3]);
                    *(u32x4*)rowp = w; }
        }
    }
};
struct EpiGate {
    static constexpr bool PERM = true;
    bf16_t* O; const float* SS; LAS float* rl; int tid;
    __device__ __forceinline__ void operator()(EPI_ARGS) const {
        const int row0 = u.pm * 256 + wr * 64 + fr, col0 = u.aux * 1024 + u.pn * 256 + wc * 32 + 8 * fq;
        panel_rstd(SS, u.pm, tid, rl);
#pragma unroll
        for (int ai = 0; ai < 2; ++ai)
#pragma unroll
            for (int m = 0; m < 4; ++m) { bf16_t* rowp = O + (size_t)(row0 + ai * 128 + m * 16) * 3072 + col0; const float rs = rl[wr * 64 + fr + ai * 128 + m * 16];
#pragma unroll
                for (int bj = 0; bj < 2; ++bj) { f32x4 v0 = acc[ai][bj][m][0] * rs, v1 = acc[ai][bj][m][1] * rs;
#pragma unroll
                    for (int j = 0; j < 4; ++j) { v0[j] = sigmoidf_(v0[j]); v1[j] = sigmoidf_(v1[j]); }
                    u32x4 w; w.x = cvt_pk_bf16(v0[0], v0[1]); w.y = cvt_pk_bf16(v0[2], v0[3]); w.z = cvt_pk_bf16(v1[0], v1[1]); w.w = cvt_pk_bf16(v1[2], v1[3]);
                    *(u32x4*)(rowp + bj * 128) = w; } }
    }
};
struct EpiMerge {
    static constexpr bool PERM = true;
    const bf16_t* Gt; bf16_t* Mg;
    __device__ __forceinline__ void operator()(EPI_ARGS) const {
        const int n = u.aux;
        const int row0 = u.pm * 256 + wr * 64 + fr, col0 = u.pn * 256 + wc * 32 + 8 * fq;
#pragma unroll
        for (int ai = 0; ai < 2; ++ai)
#pragma unroll
            for (int m = 0; m < 4; ++m) { const size_t r = (size_t)(row0 + ai * 128 + m * 16);
#pragma unroll
                for (int bj = 0; bj < 2; ++bj) { const f32x4 v0 = acc[ai][bj][m][0], v1 = acc[ai][bj][m][1];
                    const u32x4 g = *(const u32x4*)(Gt + r * 3072 + n * 1024 + col0 + bj * 128);
                    float o[8] = {bflo(g.x) * v0[0], bfhi(g.x) * v0[1], bflo(g.y) * v0[2], bfhi(g.y) * v0[3], bflo(g.z) * v1[0], bfhi(g.z) * v1[1], bflo(g.w) * v1[2], bfhi(g.w) * v1[3]};
                    bf16_t* mp = Mg + r * 1024 + col0 + bj * 128;
                    if (n > 0) { const u32x4 p = *(const u32x4*)mp; o[0] += bflo(p.x); o[1] += bfhi(p.x); o[2] += bflo(p.y); o[3] += bfhi(p.y); o[4] += bflo(p.z); o[5] += bfhi(p.z); o[6] += bflo(p.w); o[7] += bfhi(p.w); }
                    u32x4 w; w.x = cvt_pk_bf16(o[0], o[1]); w.y = cvt_pk_bf16(o[2], o[3]); w.z = cvt_pk_bf16(o[4], o[5]); w.w = cvt_pk_bf16(o[6], o[7]);
                    *(u32x4*)mp = w; } }
    }
};
template <bool EMIT>
struct EpiResid {
    static constexpr bool PERM = false;
    const float* In; float* Out; const float* gain; bf16_t* Hg; float* SS;
    __device__ __forceinline__ void operator()(EPI_ARGS) const {
        const int row0 = u.pm * 256 + wr * 64 + fr, col0 = u.pn * 256 + wc * 32 + 4 * fq;
        f32x4 gv[2][2];
        if (EMIT) {
#pragma unroll
            for (int bj = 0; bj < 2; ++bj)
#pragma unroll
                for (int n = 0; n < 2; ++n) gv[bj][n] = *(const f32x4*)(gain + col0 + bj * 128 + n * 16); }
#pragma unroll
        for (int ai = 0; ai < 2; ++ai)
#pragma unroll
            for (int m = 0; m < 4; ++m) { const int row = row0 + ai * 128 + m * 16; const size_t o = (size_t)row * DM + col0; float sq = 0.f;
#pragma unroll
                for (int bj = 0; bj < 2; ++bj)
#pragma unroll
                    for (int n = 0; n < 2; ++n) { const f32x4 x = *(const f32x4*)(In + o + bj * 128 + n * 16) + acc[ai][bj][m][n]; *(f32x4*)(Out + o + bj * 128 + n * 16) = x;
                        if (EMIT) { sq += (x[0] * x[0] + x[1] * x[1]) + (x[2] * x[2] + x[3] * x[3]); const f32x4 y = x * gv[bj][n]; u32x2 w; w.x = cvt_pk_bf16(y[0], y[1]); w.y = cvt_pk_bf16(y[2], y[3]); *(u32x2*)(Hg + o + bj * 128 + n * 16) = w; } }
                if (EMIT) { sq += __shfl_xor(sq, 16); sq += __shfl_xor(sq, 32); if (fq == 0) SS[(size_t)row * 16 + u.pn * 4 + wc] = sq; } }
    }
};
struct EpiSwiglu {
    static constexpr bool PERM = true;
    bf16_t* O; int ldc; int pn_off; const float* SS; LAS float* rl; int tid;
    __device__ __forceinline__ void operator()(EPI_ARGS) const {
        const int row0 = u.pm * 256 + wr * 64 + fr, col0 = (u.pn - pn_off) * 128 + wc * 32 + 8 * fq;
        if (SS) panel_rstd(SS, u.pm, tid, rl);
#pragma unroll
        for (int ai = 0; ai < 2; ++ai)
#pragma unroll
            for (int m = 0; m < 4; ++m) { bf16_t* rowp = O + (size_t)(row0 + ai * 128 + m * 16) * ldc + col0; const float rs = SS ? rl[wr * 64 + fr + ai * 128 + m * 16] : 1.0f;
                float o[8];
#pragma unroll
                for (int n = 0; n < 2; ++n)
#pragma unroll
                    for (int j = 0; j < 4; ++j) { const float g = acc[ai][0][m][n][j] * rs, up = acc[ai][1][m][n][j] * rs; o[n * 4 + j] = g * sigmoidf_(g) * up; }
                u32x4 w; w.x = cvt_pk_bf16(o[0], o[1]); w.y = cvt_pk_bf16(o[2], o[3]); w.z = cvt_pk_bf16(o[4], o[5]); w.w = cvt_pk_bf16(o[6], o[7]);
                *(u32x4*)rowp = w; }
    }
};
template <bool ACCUM>
struct EpiMoeOut {
    static constexpr bool PERM = true;
    const float* row_w; bf16_t* O;
    __device__ __forceinline__ void operator()(EPI_ARGS) const {
        const int row0 = u.pm * 256 + wr * 64 + fr, col0 = u.pn * 256 + wc * 32 + 8 * fq;
#pragma unroll
        for (int ai = 0; ai < 2; ++ai)
#pragma unroll
            for (int m = 0; m < 4; ++m) { const int r = row0 + ai * 128 + m * 16; const float wt = row_w[r]; bf16_t* rowp = O + (size_t)r * DM + col0;
#pragma unroll
                for (int bj = 0; bj < 2; ++bj) { f32x4 v0 = acc[ai][bj][m][0] * wt, v1 = acc[ai][bj][m][1] * wt;
                    if (ACCUM) { const u32x4 p = *(const u32x4*)(rowp + bj * 128); v0[0] += bflo(p.x); v0[1] += bfhi(p.x); v0[2] += bflo(p.y); v0[3] += bfhi(p.y); v1[0] += bflo(p.z); v1[1] += bfhi(p.z); v1[2] += bflo(p.w); v1[3] += bfhi(p.w); }
                    u32x4 w; w.x = cvt_pk_bf16(v0[0], v0[1]); w.y = cvt_pk_bf16(v0[2], v0[3]); w.z = cvt_pk_bf16(v1[0], v1[1]); w.w = cvt_pk_bf16(v1[2], v1[3]);
                    *(u32x4*)(rowp + bj * 128) = w; } }
    }
};

__device__ __forceinline__ void transpose_tile64(const float* W, int ldn, int k0, int n0, bf16_t* WT, int ldk, int drow0, int drow1, int dk0, LAS float* scr, int lane) {
#ifdef SIMPLE_TR
    { const int c = lane & 7;
      for (int j = 0; j < 8; ++j) { const int n = (lane >> 3) + 8 * j; const float* s = W + (size_t)(k0 + 8 * c) * ldn + n0 + n;
        u32x4 o; o.x = pk2(s[0], s[(size_t)ldn]); o.y = pk2(s[(size_t)2 * ldn], s[(size_t)3 * ldn]); o.z = pk2(s[(size_t)4 * ldn], s[(size_t)5 * ldn]); o.w = pk2(s[(size_t)6 * ldn], s[(size_t)7 * ldn]);
        const int dr = n < 32 ? drow0 + n : drow1 + (n - 32);
        *(u32x4*)(WT + (size_t)dr * ldk + dk0 + k0 + 8 * c) = o; }
      return; }
#endif
    f32x4 v[16]; const int r4 = lane >> 4, c4 = (lane & 15) * 4;
#pragma unroll
    for (int i = 0; i < 16; ++i) v[i] = *(const f32x4*)(W + (size_t)(k0 + 4 * i + r4) * ldn + n0 + c4);
#pragma unroll
    for (int i = 0; i < 16; ++i) { LAS float* d = scr + (4 * i + r4) * 65 + c4; d[0] = v[i][0]; d[1] = v[i][1]; d[2] = v[i][2]; d[3] = v[i][3]; }
    LDS_WAIT(); asm volatile("" ::: "memory");
    const int c = lane & 7;
#pragma unroll
    for (int j = 0; j < 8; ++j) { const int n = (lane >> 3) + 8 * j; const LAS float* s = scr + (8 * c) * 65 + n;
        u32x4 o; o.x = pk2(s[0 * 65], s[1 * 65]); o.y = pk2(s[2 * 65], s[3 * 65]); o.z = pk2(s[4 * 65], s[5 * 65]); o.w = pk2(s[6 * 65], s[7 * 65]);
        const int dr = n < 32 ? drow0 + n : drow1 + (n - 32);
        *(u32x4*)(WT + (size_t)dr * ldk + dk0 + k0 + 8 * c) = o; }
    LDS_WAIT(); asm volatile("" ::: "memory");
}
__device__ __forceinline__ void conv_plain(const float* W, int K, int N, bf16_t* WT, int ldk, int item, LAS float* scr, int lane) {
    const int nblk = N / 64, kb = item / nblk, nb = item % nblk;
    transpose_tile64(W, N, kb * 64, nb * 64, WT, ldk, nb * 64, nb * 64 + 32, 0, scr, lane);
}
__device__ __forceinline__ int win_drow(int n0) { return n0 < 3872 ? n0 : (n0 < 4128 ? 4096 + (n0 - 3872) : (n0 < 4288 ? 4352 + (n0 - 4128) : 4608 + (n0 - 4288))); }
__device__ __forceinline__ int gu_drow(int n0, int up) { return (n0 >> 7) * 256 + (n0 & 127) + up * 128; }

struct TrD { const float* src; bf16_t* d0; bf16_t* d1; int ldn, ldk; };
__device__ __forceinline__ TrD tr_desc(const float* W, int ldn, int k0, int n0, bf16_t* WT, int ldk, int drow0, int drow1, int dk0) {
    TrD d; d.src = W + (size_t)k0 * ldn + n0; d.ldn = ldn; d.ldk = ldk; d.d0 = WT + (size_t)drow0 * ldk + dk0 + k0; d.d1 = WT + (size_t)drow1 * ldk + dk0 + k0; return d;
}
__device__ __forceinline__ void tr_load(f32x4 (&v)[16], const TrD& d, int lane) {
    const float* s = d.src + (size_t)(lane >> 4) * d.ldn + (lane & 15) * 4;
#pragma unroll
    for (int i = 0; i < 16; ++i) v[i] = *(const f32x4*)(s + (size_t)(4 * i) * d.ldn);
}
__device__ __forceinline__ void tr_store(const f32x4 (&v)[16], const TrD& d, LAS float* scr, int lane) {
    const int r4 = lane >> 4, c4 = (lane & 15) * 4;
#pragma unroll
    for (int i = 0; i < 16; ++i) { LAS float* q = scr + (4 * i + r4) * 65 + c4; q[0] = v[i][0]; q[1] = v[i][1]; q[2] = v[i][2]; q[3] = v[i][3]; }
    LDS_WAIT(); asm volatile("" ::: "memory");
    const int c = lane & 7;
#pragma unroll
    for (int j = 0; j < 8; ++j) { const int n = (lane >> 3) + 8 * j; const LAS float* s = scr + (8 * c) * 65 + n;
        u32x4 o; o.x = pk2(s[0 * 65], s[1 * 65]); o.y = pk2(s[2 * 65], s[3 * 65]); o.z = pk2(s[4 * 65], s[5 * 65]); o.w = pk2(s[6 * 65], s[7 * 65]);
        bf16_t* dr = n < 32 ? d.d0 + (size_t)n * d.ldk : d.d1 + (size_t)(n - 32) * d.ldk;
        *(u32x4*)(dr + 8 * c) = o; }
    LDS_WAIT(); asm volatile("" ::: "memory");
}
__device__ __forceinline__ TrD desc_plain(const float* W, int K, int N, bf16_t* WT, int ldk, int item) {
    const int nblk = N / 64, kb = item / nblk, nb = item % nblk; (void)K;
    return tr_desc(W, N, kb * 64, nb * 64, WT, ldk, nb * 64, nb * 64 + 32, 0);
}
#define TR_PIPE(DESC, IT0, STEP, NT, TAIL, SCR, LANE) do { \
    f32x4 v_[2][16]; TrD d_[2]; const int i0_ = (IT0), st_ = (STEP); const bool tail_ = (TAIL); \
    d_[0] = DESC(i0_); tr_load(v_[0], d_[0], LANE); \
    _Pragma("unroll") for (int k_ = 0; k_ < (NT); ++k_) { \
        if (k_ + 1 < (NT) || tail_) { d_[(k_ + 1) & 1] = DESC(i0_ + (k_ + 1) * st_); tr_load(v_[(k_ + 1) & 1], d_[(k_ + 1) & 1], LANE); } \
        asm volatile("" ::: "memory"); \
        tr_store(v_[k_ & 1], d_[k_ & 1], SCR, LANE); } \
    if (tail_) tr_store(v_[(NT) & 1], d_[(NT) & 1], SCR, LANE); } while (0)
namespace pro {
constexpr int I_IN = 16 * 115, I_QB = 4 * 12, I_BRn = 8 * 16, I_WOn = 16 * 16, I_G = 16 * 44, I_D = 44 * 16;
constexpr int NIT = NLAYER * (I_IN + I_QB + 3 * I_BRn + I_WOn) + 2 * I_G + I_D;
}
__device__ __forceinline__ TrD pro_desc(const Params& P, unsigned char* ws, int it) {
    using namespace pro;
    int r = it;
    if (r < NLAYER * I_IN) { const int l = r / I_IN; r %= I_IN; const int kb = r / 115, nb = r % 115;
        return tr_desc(P.in[I_WIN] + (size_t)l * DM * IN_COLS, IN_COLS, kb * 64, nb * 64, (bf16_t*)(ws + WS_WIN) + (size_t)l * WIN_ROWS * DM, DM, win_drow(nb * 64), win_drow(nb * 64 + 32), 0); }
    r -= NLAYER * I_IN;
    if (r < NLAYER * I_QB) { const int l = r / I_QB; r %= I_QB; return desc_plain(P.in[I_WQB] + (size_t)l * 256 * 768, 256, 768, (bf16_t*)(ws + WS_QB) + (size_t)l * 768 * 256, 256, r); }
    r -= NLAYER * I_QB;
    if (r < NLAYER * 3 * I_BRn) { const int ln = r / I_BRn; r %= I_BRn; return desc_plain(P.in[I_WBR] + (size_t)ln * 512 * 1024, 512, 1024, (bf16_t*)(ws + WS_BR) + (size_t)ln * 1024 * 512, 512, r); }
    r -= NLAYER * 3 * I_BRn;
    if (r < NLAYER * I_WOn) { const int l = r / I_WOn; r %= I_WOn; return desc_plain(P.in[I_WO] + (size_t)l * DM * DM, DM, DM, (bf16_t*)(ws + WS_WO) + (size_t)l * DM * DM, DM, r); }
    r -= NLAYER * I_WOn;
    if (r < 2 * I_G) { const int up = r / I_G; r %= I_G; const int kb = r / 44, nb = r % 44;
        return tr_desc(up ? P.in[I_FU] : P.in[I_FG], DFF, kb * 64, nb * 64, (bf16_t*)(ws + WS_FGU), DM, gu_drow(nb * 64, up), gu_drow(nb * 64 + 32, up), 0); }
    r -= 2 * I_G;
    return desc_plain(P.in[I_FD], DFF, DM, (bf16_t*)(ws + WS_FD), DFF, r);
}

#define PRO_DESC_(x) pro_desc(P, ws, (x))
template <int NT>
__device__ __forceinline__ void pro_tiles(const Frame& F, const Params& P, int lo, int w0, int nw, int tail) {
    LAS float* scr = (LAS float*)(F.lds + F.wave * 16640);
    unsigned char* ws = F.ws;
    if constexpr (NT == 0) { if (w0 < tail) { f32x4 v[16]; const TrD d = pro_desc(P, ws, lo + w0); tr_load(v, d, F.lane); tr_store(v, d, scr, F.lane); } }
    else TR_PIPE(PRO_DESC_, lo + w0, nw, NT, w0 < tail, scr, F.lane);
}
__device__ __forceinline__ void pro_small(const Frame& F, const Params& P, int gt, int ngt, int vb0, int nvb) {
    unsigned char* ws = F.ws;
    for (int i = gt; i < NLAYER * 3 * 48 * 512; i += ngt) { const int c = i & 511; int r = i >> 9; const int k = 8 * (r % 48); r /= 48; const int seg = r % 3, l = r / 3;
        const float* src = nullptr;
        if (seg == 0 && k < 64) src = P.in[I_W2] + ((size_t)l * 64 + k) * 512 + c;
        else if (seg == 1 && k >= 64 && k < 128) src = P.in[I_A2] + ((size_t)l * 64 + (k - 64)) * 512 + c;
        else if (seg == 2 && k >= 128 && k < 288) src = P.in[I_G2] + ((size_t)l * 160 + (k - 128)) * 512 + c;
        const bool live = src != nullptr; if (!live) src = P.in[I_W2] + c;
        float v[8];
#pragma unroll
        for (int q = 0; q < 8; ++q) v[q] = src[q * 512];
#pragma unroll
        for (int q = 0; q < 8; ++q) v[q] = live ? v[q] : 0.f;
        u32x4 o; o.x = pk2(v[0], v[1]); o.y = pk2(v[2], v[3]); o.z = pk2(v[4], v[5]); o.w = pk2(v[6], v[7]);
        *(u32x4*)((bf16_t*)(ws + WS_LORA) + ((size_t)l * 1536 + seg * 512 + c) * 384 + k) = o; }
    for (int i = gt; i < NLAYER * 32 * 512; i += ngt) { const int n = i & 511; int r = i >> 9; const int k = 8 * (r & 31), l = r >> 5; const int h = n >> 6, dd = n & 63;
        float vk[8], vv[8]; const float* w = P.in[I_WKVB] + ((size_t)l * 128 + (k < 128 ? k : 0)) * 1024 + h * 128 + dd;
#pragma unroll
        for (int q = 0; q < 8; ++q) { vk[q] = w[q * 1024]; vv[q] = w[q * 1024 + 64]; }
#pragma unroll
        for (int q = 0; q < 8; ++q) { vk[q] = k < 128 ? vk[q] : 0.f; vv[q] = k < 128 ? vv[q] : 0.f; }
        u32x4 o; o.x = pk2(vk[0], vk[1]); o.y = pk2(vk[2], vk[3]); o.z = pk2(vk[4], vk[5]); o.w = pk2(vk[6], vk[7]);
        *(u32x4*)((bf16_t*)(ws + WS_KB) + ((size_t)l * 512 + n) * 256 + k) = o;
        o.x = pk2(vv[0], vv[1]); o.y = pk2(vv[2], vv[3]); o.z = pk2(vv[4], vv[5]); o.w = pk2(vv[6], vv[7]);
        *(u32x4*)((bf16_t*)(ws + WS_VB) + ((size_t)l * 512 + n) * 256 + k) = o; }
    {
        const int j = F.tid & 127, r0 = F.tid >> 7;
        if (j < 80) { const int isr = j < 64; const int idx = isr ? j : j - 64; const double dim = isr ? 128.0 : 32.0;
            const float inv = (float)(1.0 / pow(10000.0, (2.0 * idx) / dim));
            for (int vb = vb0; vb < MTOK / 64; vb += nvb) {
                int pos[16];
#pragma unroll
                for (int k = 0; k < 16; ++k) pos[k] = ((const int*)P.in[I_POS])[vb * 64 + r0 + 4 * k];
                asm volatile("" ::: "memory");
#pragma unroll
                for (int k = 0; k < 16; ++k) { const int m = vb * 64 + r0 + 4 * k;
                    const float ang = (float)pos[k] * inv;
                    const double a = (double)ang, q = rint(a * 0.15915494309189535), rr = a - q * 6.283185307179586476925;
                    const float rf = (float)rr; const float cs = __cosf(rf), sn = __sinf(rf);
                    if (isr) { ((float*)(ws + WS_COSR))[(size_t)m * 64 + idx] = cs; ((float*)(ws + WS_SINR))[(size_t)m * 64 + idx] = sn; }
                    else { ((float*)(ws + WS_COSM))[(size_t)m * 16 + idx] = cs; ((float*)(ws + WS_SINM))[(size_t)m * 16 + idx] = sn; } } } }
    }
}
__device__ __forceinline__ void phase_prologue(const Frame& F, const Params& P) {
    unsigned char* ws = F.ws;
    pro_tiles<0>(F, P, 0, F.gw, 2048, pro::I_IN);
    for (int m = F.gw; m < MTOK; m += F.ngw) {
        const f32x4* xr = (const f32x4*)(P.in[I_X] + (size_t)m * DM) + F.lane; f32x4 v[4]; float s = 0.f;
#pragma unroll
        for (int j = 0; j < 4; ++j) { v[j] = xr[64 * j]; s += (v[j].x * v[j].x + v[j].y * v[j].y) + (v[j].z * v[j].z + v[j].w * v[j].w); }
        s = wave_sum(s);
        u32x2* o8 = (u32x2*)((bf16_t*)(ws + WS_HN) + (size_t)m * DM) + F.lane;
#pragma unroll
        for (int j = 0; j < 4; ++j) { const f32x4 g = ((const f32x4*)P.in[I_ANORM])[F.lane + 64 * j]; const f32x4 y = v[j] * g; u32x2 w; w.x = pk2(y.x, y.y); w.y = pk2(y.z, y.w); o8[64 * j] = w; }
        if (F.lane < 16) ((float*)(ws + WS_SS))[(size_t)m * 16 + F.lane] = F.lane == 0 ? s : 0.f;
    }
}
template <int PART>
__device__ __forceinline__ void phase_moe_convert(const Frame& F, const Params& P, int w0, int nw) {
    LAS float* scr = (LAS float*)(F.lds + F.wave * 16640);
    constexpr int I_GH = 16 * 28, I_D = 56 * 16;
    constexpr int PER_E = PART == 0 ? 2 * I_GH + I_D : 2 * I_GH;
    for (int it = w0; it < NEXP * PER_E; it += nw) {
        const int e = it / PER_E; int r = it % PER_E;
        if (r < 2 * I_GH) { const int up = r / I_GH; r %= I_GH; const int kb = r / 28, nb = PART * 28 + r % 28;
            transpose_tile64(P.in[up ? I_MU2 : I_MG] + (size_t)e * DM * DFFE, DFFE, kb * 64, nb * 64, (bf16_t*)(F.ws + WS_MGU) + (size_t)e * 2 * DFFE * DM, DM, gu_drow(nb * 64, up), gu_drow(nb * 64 + 32, up), 0, scr, F.lane); continue; }
        r -= 2 * I_GH;
        conv_plain(P.in[I_MD] + (size_t)e * DFFE * DM, DFFE, DM, (bf16_t*)(F.ws + WS_MD) + (size_t)e * DM * DFFE, DFFE, r, scr, F.lane);
    }
}

template <bool MOE>
__device__ __forceinline__ void phase_rms(const Frame& F, const float* src, const float* gain, bf16_t* hn, const float* router, unsigned* ectl, int* tok_e, int* tok_slot, float* tok_w) {
    LAS int* lcnt = (LAS int*)(F.lds);
    if (MOE) { if (F.tid < 16) lcnt[F.tid] = 0; __syncthreads(); }
    int my_e0 = 0, my_e1 = 0, my_s0 = 0, my_s1 = 0; float my_w0 = 0.f, my_w1 = 0.f;
    f32x4 rw[MOE ? 32 : 1];
    if (MOE) {
#pragma unroll
        for (int j = 0; j < 4; ++j)
#pragma unroll
            for (int q = 0; q < 4; ++q) { const int c = 4 * F.lane + 256 * j + q; rw[(j * 4 + q) * 2] = *(const f32x4*)(router + (size_t)c * 8); rw[(j * 4 + q) * 2 + 1] = *(const f32x4*)(router + (size_t)c * 8 + 4); } }
    for (int i = 0; i < 8; ++i) {
        const int m = F.blk * 64 + F.wave * 8 + i;
        const f32x4* xr = (const f32x4*)(src + (size_t)m * DM) + F.lane;
        f32x4 v[4]; float s = 0.f;
#pragma unroll
        for (int j = 0; j < 4; ++j) { v[j] = xr[64 * j]; s += (v[j].x * v[j].x + v[j].y * v[j].y) + (v[j].z * v[j].z + v[j].w * v[j].w); }
        const float rstd = rsqrtf(wave_sum(s) * (1.0f / DM) + NORM_EPS);
#pragma unroll
        for (int j = 0; j < 4; ++j) { const f32x4 g = ((const f32x4*)gain)[F.lane + 64 * j]; v[j] = v[j] * rstd * g; }
        u32x2* o8 = (u32x2*)(hn + (size_t)m * DM) + F.lane;
#pragma unroll
        for (int j = 0; j < 4; ++j) { u32x2 w; w.x = pk2(v[j].x, v[j].y); w.y = pk2(v[j].z, v[j].w); o8[64 * j] = w; }
        if (MOE) {
            float lg[8];
#pragma unroll
            for (int e = 0; e < 8; ++e) lg[e] = 0.f;
#pragma unroll
            for (int j = 0; j < 4; ++j)
#pragma unroll
                for (int q = 0; q < 4; ++q) { const f32x4 r0 = rw[(j * 4 + q) * 2], r1 = rw[(j * 4 + q) * 2 + 1]; const float x = v[j][q];
                    lg[0] += x * r0.x; lg[1] += x * r0.y; lg[2] += x * r0.z; lg[3] += x * r0.w; lg[4] += x * r1.x; lg[5] += x * r1.y; lg[6] += x * r1.z; lg[7] += x * r1.w; }
#pragma unroll
            for (int e = 0; e < 8; ++e) lg[e] = wave_sum(lg[e]);
            int e0 = 0; float b0 = lg[0];
#pragma unroll
            for (int e = 1; e < 8; ++e) if (lg[e] > b0) { b0 = lg[e]; e0 = e; }
            int e1 = -1; float b1 = -3.0e38f;
#pragma unroll
            for (int e = 0; e < 8; ++e) if (e != e0 && lg[e] > b1) { b1 = lg[e]; e1 = e; }
            const float t = __expf(b1 - b0), w0 = 1.0f / (1.0f + t), w1 = t / (1.0f + t);
            int s0 = 0, s1 = 0;
            if (F.lane == 0) { s0 = atomicAdd((int*)&lcnt[e0], 1); s1 = atomicAdd((int*)&lcnt[e1], 1); }
            s0 = __shfl(s0, 0); s1 = __shfl(s1, 0);
            if (F.lane == i) { my_e0 = e0; my_e1 = e1; my_s0 = s0; my_s1 = s1; my_w0 = w0; my_w1 = w1; }
        }
    }
    if (MOE) {
        __syncthreads();
        if (F.tid < 8) lcnt[8 + F.tid] = (int)atomicAdd(&ectl[F.tid], (unsigned)lcnt[F.tid]);
        __syncthreads();
        if (F.lane < 8) { const int m = F.blk * 64 + F.wave * 8 + F.lane;
            tok_e[2 * m] = my_e0; tok_e[2 * m + 1] = my_e1; tok_slot[2 * m] = lcnt[8 + my_e0] + my_s0; tok_slot[2 * m + 1] = lcnt[8 + my_e1] + my_s1; tok_w[2 * m] = my_w0; tok_w[2 * m + 1] = my_w1; }
        __syncthreads();
    }
}
__device__ __forceinline__ void phase_final(const Frame& F, float* h, const float* gain, const bf16_t* out2, const int* tok_pos) {
    for (int m = F.gw; m < MTOK; m += F.ngw) {
        f32x4* xr = (f32x4*)(h + (size_t)m * DM) + F.lane;
        const int p0 = tok_pos[2 * m], p1 = tok_pos[2 * m + 1];
        const u32x2* o0 = (const u32x2*)(out2 + (size_t)p0 * DM) + F.lane; const u32x2* o1 = (const u32x2*)(out2 + (size_t)p1 * DM) + F.lane;
        f32x4 v[4]; float s = 0.f;
#pragma unroll
        for (int j = 0; j < 4; ++j) { v[j] = xr[64 * j]; const u32x2 a = o0[64 * j], b = o1[64 * j];
#ifndef NO_MOE_ADD
            v[j].x += bflo(a.x) + bflo(b.x); v[j].y += bfhi(a.x) + bfhi(b.x); v[j].z += bflo(a.y) + bflo(b.y); v[j].w += bfhi(a.y) + bfhi(b.y);
#endif
            s += (v[j].x * v[j].x + v[j].y * v[j].y) + (v[j].z * v[j].z + v[j].w * v[j].w); }
        const float rstd = rsqrtf(wave_sum(s) * (1.0f / DM) + NORM_EPS);
#pragma unroll
        for (int j = 0; j < 4; ++j) { const f32x4 g = ((const f32x4*)gain)[F.lane + 64 * j]; xr[64 * j] = v[j] * rstd * g; }
    }
}
template <int KS>
__device__ __forceinline__ f32x4 mm_tile(const LAS bf16_t* P, int ldp, const LAS bf16_t* Q, int ldq, int ib, int jb, int lane, f32x4 acc) {
    const LAS bf16_t* pp = P + (ib * 16 + (lane & 15)) * ldp + 8 * (lane >> 4);
    const LAS bf16_t* qp = Q + (jb * 16 + (lane & 15)) * ldq + 8 * (lane >> 4);
#pragma unroll
    for (int ks = 0; ks < KS; ++ks) { const bf16x8 a = *(const LAS bf16x8*)(qp + ks * 32), b = *(const LAS bf16x8*)(pp + ks * 32); acc = __builtin_amdgcn_mfma_f32_16x16x32_bf16(a, b, acc, 0, 0, 0); }
    return acc;
}
__device__ __forceinline__ void st_bf4(LAS bf16_t* p, f32x4 v) { u32x2 w; w.x = pk2(v[0], v[1]); w.y = pk2(v[2], v[3]); *(LAS u32x2*)p = w; }
__device__ __forceinline__ float ret_lg(int h) { return __logf(1.0f - exp2f(-5.0f - (float)h)); }

__device__ __forceinline__ void phase_prep(const Frame& F, const Params& P, int layer) {
    unsigned char* ws = F.ws;
    const bf16_t* p = (const bf16_t*)(ws + WS_P);
    const float* mu = P.in[I_MU] + (size_t)layer * RWKV_COLS;
    for (int m = F.gw; m < MTOK; m += F.ngw) {
        const bf16_t* pr = p + (size_t)m * PW; const bool has_prev = (m % SEQ) != 0; const bf16_t* pp = pr - PW;
        bf16_t* lin = (bf16_t*)(ws + WS_LIN) + (size_t)m * LORA_K;
#pragma unroll
        for (int jj = 0; jj < 6; ++jj) { const int c = F.lane + 64 * jj; float o = 0.f;
            if (c < 288) { const int off = 1536 + c; const float x = bf2f(pr[P_RW + off]), xp = has_prev ? bf2f(pp[P_RW + off]) : 0.f; const float xs = x + (xp - x) * mu[off];
                o = c < 64 ? tanhf(xs) : (c < 128 ? xs : sigmoidf_(xs)); }
            lin[c] = (bf16_t)f2bf(o); }
        {
            const u32x2 w = *(const u32x2*)(pr + P_QA + 4 * F.lane); float x[4] = {bflo(w.x), bfhi(w.x), bflo(w.y), bfhi(w.y)};
            const float ss = wave_sum(x[0] * x[0] + x[1] * x[1] + x[2] * x[2] + x[3] * x[3]); const float rs = rsqrtf(ss * (1.0f / 256.0f) + NORM_EPS);
            const f32x4 g = *(const f32x4*)(P.in[I_QNORM] + layer * 256 + 4 * F.lane);
            u32x2 o; o.x = pk2(x[0] * rs * g.x, x[1] * rs * g.y); o.y = pk2(x[2] * rs * g.z, x[3] * rs * g.w); *(u32x2*)((bf16_t*)(ws + WS_QN) + (size_t)m * 256 + 4 * F.lane) = o; }
        {
            const unsigned w = *(const unsigned*)(pr + P_KVA + 2 * F.lane); float x0 = bflo(w), x1 = bfhi(w);
            const float ss = wave_sum(x0 * x0 + x1 * x1); const float rs = rsqrtf(ss * (1.0f / 128.0f) + NORM_EPS);
            const f32x2 g = *(const f32x2*)(P.in[I_KVNORM] + layer * 128 + 2 * F.lane);
            unsigned* cn = (unsigned*)((bf16_t*)(ws + WS_CN) + (size_t)m * 256); cn[F.lane] = pk2(x0 * rs * g.x, x1 * rs * g.y); cn[64 + F.lane] = 0u; }
        if (F.lane < 16) {
            const float x1 = bf2f(pr[P_KVA + 128 + F.lane]), x2 = bf2f(pr[P_KVA + 144 + F.lane]);
            const float c = ((const float*)(ws + WS_COSM))[(size_t)m * 16 + F.lane], s = ((const float*)(ws + WS_SINM))[(size_t)m * 16 + F.lane];
            bf16_t* kp = (bf16_t*)(ws + WS_KPE) + (size_t)m * 32; kp[F.lane] = (bf16_t)f2bf(x1 * c - x2 * s); kp[16 + F.lane] = (bf16_t)f2bf(x1 * s + x2 * c); }
    }
    LAS bf16_t* kT = (LAS bf16_t*)F.lds;
    LAS bf16_t* vT = kT + 128 * 72;
    const int pc = F.tid & 7, j = F.tid >> 3;
    for (int u = F.blk; u < NB * NCHUNK * 4; u += F.G) {
        const int h = u & 3, n = (u >> 2) & 127, b = u >> 9; const int m = b * SEQ + n * 64 + j;
        const float lg = ret_lg(h);
        __syncthreads();
        {
            const bf16_t* kr = p + (size_t)m * PW + P_RK + h * 128 + pc * 8;
            const u32x4 a = *(const u32x4*)kr, bq = *(const u32x4*)(kr + 64);
            const float* cp = (const float*)(ws + WS_COSR) + (size_t)m * 64 + pc * 8; const float* sp = (const float*)(ws + WS_SINR) + (size_t)m * 64 + pc * 8;
            const float sc = 0.08838834764831845f * __expf(lg * (float)(63 - j));
            const unsigned aw[4] = {a.x, a.y, a.z, a.w}, bw[4] = {bq.x, bq.y, bq.z, bq.w};
#pragma unroll
            for (int i = 0; i < 8; ++i) { const float x1 = (i & 1) ? bfhi(aw[i >> 1]) : bflo(aw[i >> 1]), x2 = (i & 1) ? bfhi(bw[i >> 1]) : bflo(bw[i >> 1]); const float c = cp[i], s = sp[i];
                kT[(pc * 8 + i) * 72 + j] = (bf16_t)f2bf((x1 * c - x2 * s) * sc); kT[(64 + pc * 8 + i) * 72 + j] = (bf16_t)f2bf((x1 * s + x2 * c) * sc); }
            const bf16_t* vr = p + (size_t)m * PW + P_RV + h * 128 + pc * 8;
            const u32x4 va = *(const u32x4*)vr, vb = *(const u32x4*)(vr + 64);
            const unsigned vaw[4] = {va.x, va.y, va.z, va.w}, vbw[4] = {vb.x, vb.y, vb.z, vb.w};
#pragma unroll
            for (int i = 0; i < 8; ++i) { vT[(pc * 8 + i) * 72 + j] = (bf16_t)((i & 1) ? (vaw[i >> 1] >> 16) : (vaw[i >> 1] & 0xffffu)); vT[(64 + pc * 8 + i) * 72 + j] = (bf16_t)((i & 1) ? (vbw[i >> 1] >> 16) : (vbw[i >> 1] & 0xffffu)); }
        }
        __syncthreads();
        bf16_t* out = (bf16_t*)(ws + WS_RS) + (size_t)u * 16384;
#pragma unroll
        for (int jb = 0; jb < 8; ++jb) { f32x4 acc = {0.f, 0.f, 0.f, 0.f}; acc = mm_tile<2>(vT, 72, kT, 72, F.wave, jb, F.lane, acc);
            const int e = F.wave * 16 + (F.lane & 15), d = jb * 16 + 4 * (F.lane >> 4);
            u32x2 w; w.x = pk2(acc[0], acc[1]); w.y = pk2(acc[2], acc[3]); *(u32x2*)(out + e * 128 + d) = w; }
    }
    __syncthreads();
}

__device__ __forceinline__ void ret_scan(const Frame& F) {
    bf16_t* rs = (bf16_t*)(F.ws + WS_RS);
    for (int idx = F.blk * NTHR + F.tid; idx < NB * 4 * 16384; idx += F.G * NTHR) {
        const int b = idx >> 16, h = (idx >> 14) & 3, ed = idx & 16383; const float cd = __expf(ret_lg(h) * 64.0f);
        bf16_t* base = rs + ((size_t)(b * 128) * 4 + h) * 16384 + ed; float s = 0.f;
        for (int n0 = 0; n0 < NCHUNK; n0 += 32) { unsigned short t[32];
#pragma unroll
            for (int i = 0; i < 32; ++i) t[i] = base[(size_t)(n0 + i) * 65536];
#pragma unroll
            for (int i = 0; i < 32; ++i) { base[(size_t)(n0 + i) * 65536] = (bf16_t)f2bf(s); s = s * cd + bf2f(t[i]); } }
    }
}

__device__ __forceinline__ void ret_out(const Frame& F) {
    unsigned char* ws = F.ws; const bf16_t* p = (const bf16_t*)(ws + WS_P);
    LAS bf16_t* q = (LAS bf16_t*)F.lds;
    LAS bf16_t* k = q + 64 * 136;
    LAS bf16_t* vT = k + 64 * 136;
    LAS bf16_t* pT = vT + 128 * 72;
    LAS bf16_t* sc = pT + 128 * 136;
    LAS float* st = (LAS float*)(sc + 64 * 72);
    const int pc = F.tid & 7, j = F.tid >> 3;
    for (int u = F.blk; u < NB * NCHUNK * 4; u += F.G) {
        const int h = u & 3, n = (u >> 2) & 127, b = u >> 9; const int m0 = b * SEQ + n * 64, m = m0 + j;
        const float lg = ret_lg(h);
        LBAR();
        {
            const float* cp = (const float*)(ws + WS_COSR) + (size_t)m * 64 + pc * 8; const float* sp = (const float*)(ws + WS_SINR) + (size_t)m * 64 + pc * 8;
            float cs[8], sn[8];
#pragma unroll
            for (int i = 0; i < 8; ++i) { cs[i] = cp[i]; sn[i] = sp[i]; }
#pragma unroll
            for (int which = 0; which < 2; ++which) {
                const bf16_t* r = p + (size_t)m * PW + (which ? P_RK : P_RQ) + h * 128 + pc * 8;
                const u32x4 a = *(const u32x4*)r, bq = *(const u32x4*)(r + 64);
                const unsigned aw[4] = {a.x, a.y, a.z, a.w}, bw[4] = {bq.x, bq.y, bq.z, bq.w}; const float sc_ = which ? 0.08838834764831845f : 1.0f;
                float o1[8], o2[8];
#pragma unroll
                for (int i = 0; i < 8; ++i) { const float x1 = (i & 1) ? bfhi(aw[i >> 1]) : bflo(aw[i >> 1]), x2 = (i & 1) ? bfhi(bw[i >> 1]) : bflo(bw[i >> 1]); o1[i] = (x1 * cs[i] - x2 * sn[i]) * sc_; o2[i] = (x1 * sn[i] + x2 * cs[i]) * sc_; }
                LAS bf16_t* dst = (which ? k : q) + j * 136 + pc * 8;
                u32x4 w1, w2; w1.x = pk2(o1[0], o1[1]); w1.y = pk2(o1[2], o1[3]); w1.z = pk2(o1[4], o1[5]); w1.w = pk2(o1[6], o1[7]); w2.x = pk2(o2[0], o2[1]); w2.y = pk2(o2[2], o2[3]); w2.z = pk2(o2[4], o2[5]); w2.w = pk2(o2[6], o2[7]);
                *(LAS u32x4*)dst = w1; *(LAS u32x4*)(dst + 64) = w2; }
            const bf16_t* vr = p + (size_t)m * PW + P_RV + h * 128 + pc * 8;
            const u32x4 va = *(const u32x4*)vr, vb = *(const u32x4*)(vr + 64);
            const unsigned vaw[4] = {va.x, va.y, va.z, va.w}, vbw[4] = {vb.x, vb.y, vb.z, vb.w};
#pragma unroll
            for (int i = 0; i < 8; ++i) { vT[(pc * 8 + i) * 72 + j] = (bf16_t)((i & 1) ? (vaw[i >> 1] >> 16) : (vaw[i >> 1] & 0xffffu)); vT[(64 + pc * 8 + i) * 72 + j] = (bf16_t)((i & 1) ? (vbw[i >> 1] >> 16) : (vbw[i >> 1] & 0xffffu)); }
            const bf16_t* ps = (const bf16_t*)(ws + WS_RS) + (size_t)u * 16384;
#pragma unroll
            for (int i = 0; i < 4; ++i) { const int pi = F.tid + i * 512; const int e = pi >> 4, c = pi & 15; *(LAS u32x4*)(pT + e * 136 + c * 8) = *(const u32x4*)(ps + e * 128 + c * 8); }
        }
        LBAR();
        {
            const int ib = F.wave & 3;
#pragma unroll
            for (int t = 0; t < 2; ++t) { const int jb = 2 * (F.wave >> 2) + t; f32x4 acc = {0.f, 0.f, 0.f, 0.f}; acc = mm_tile<4>(q, 136, k, 136, ib, jb, F.lane, acc);
                const int i = ib * 16 + (F.lane & 15), j0 = jb * 16 + 4 * (F.lane >> 4);
#pragma unroll
                for (int r = 0; r < 4; ++r) { const int dd = i - (j0 + r); acc[r] *= __expf(lg * (float)(dd < 0 ? -dd : dd)); }
                st_bf4(sc + i * 72 + j0, acc); }
        }
        LBAR();
        {
            const int ib = F.wave & 3, eh = F.wave >> 2; const int i = ib * 16 + (F.lane & 15);
            const float qd = __expf(lg * (float)(i + 1));
            f32x4 o[4]; float s1 = 0.f, s2 = 0.f;
#pragma unroll
            for (int t = 0; t < 4; ++t) { const int eb = eh * 4 + t; f32x4 ai = {0.f, 0.f, 0.f, 0.f}, ac = {0.f, 0.f, 0.f, 0.f};
                ai = mm_tile<2>(sc, 72, vT, 72, ib, eb, F.lane, ai); ac = mm_tile<4>(q, 136, pT, 136, ib, eb, F.lane, ac);
                o[t] = ai + ac * qd;
#pragma unroll
                for (int r = 0; r < 4; ++r) { s1 += o[t][r]; s2 += o[t][r] * o[t][r]; } }
            s1 += __shfl_xor(s1, 16); s1 += __shfl_xor(s1, 32); s2 += __shfl_xor(s2, 16); s2 += __shfl_xor(s2, 32);
            if (F.lane < 16) { st[(eh * 64 + i) * 2] = s1; st[(eh * 64 + i) * 2 + 1] = s2; }
            LBAR();
            const float t1 = st[i * 2] + st[(64 + i) * 2], t2 = st[i * 2 + 1] + st[(64 + i) * 2 + 1];
            const float mean = t1 * (1.0f / 128.0f), var = fmaxf(t2 * (1.0f / 128.0f) - mean * mean, 0.f), rstd = rsqrtf(var + 1e-5f);
            const int mrow = m0 + i;
#pragma unroll
            for (int t = 0; t < 4; ++t) { const int e = (eh * 4 + t) * 16 + 4 * (F.lane >> 4);
                const u32x2 gw = *(const u32x2*)(p + (size_t)mrow * PW + P_RG + h * 128 + e); const float g[4] = {bflo(gw.x), bfhi(gw.x), bflo(gw.y), bfhi(gw.y)};
                float y[4];
#pragma unroll
                for (int r = 0; r < 4; ++r) y[r] = (o[t][r] - mean) * rstd * (g[r] * sigmoidf_(g[r]));
                u32x2 w; w.x = pk2(y[0], y[1]); w.y = pk2(y[2], y[3]); *(u32x2*)((bf16_t*)(ws + WS_YRET) + (size_t)mrow * 512 + h * 128 + e) = w; }
        }
    }
    __syncthreads();
}

constexpr int ATT_KP = 104, ATT_VP = 72;
constexpr int ATT_KB = 64 * ATT_KP * 2, ATT_VB = 64 * ATT_VP * 2;
constexpr int ATT_K0 = 0, ATT_V0 = 2 * ATT_KB;
__device__ __forceinline__ void attn_unit(const Frame& F, int b, int h, int qt) {
    unsigned char* ws = F.ws;
    const bf16_t* Qg = (const bf16_t*)(ws + WS_Q); const bf16_t* Kn = (const bf16_t*)(ws + WS_KN); const bf16_t* Kp = (const bf16_t*)(ws + WS_KPE); const bf16_t* Vt = (const bf16_t*)(ws + WS_VT);
    const int lane = F.lane, w = F.wave, ql = lane & 31, hf = lane >> 5;
    const int mq = b * SEQ + qt * 256 + w * 32 + ql;
    const float qs = 0.10206207261596577f * 1.4426950408889634f;
    bf16x8 qf[6];
    {
        const bf16_t* qr = Qg + (size_t)mq * 768 + h * 96;
#pragma unroll
        for (int s = 0; s < 4; ++s) { const u32x4 x = *(const u32x4*)(qr + 16 * s + 8 * hf); const unsigned xw[4] = {x.x, x.y, x.z, x.w}; u32x4 o; unsigned ow[4];
#pragma unroll
            for (int i = 0; i < 4; ++i) ow[i] = pk2(bflo(xw[i]) * qs, bfhi(xw[i]) * qs);
            o.x = ow[0]; o.y = ow[1]; o.z = ow[2]; o.w = ow[3]; qf[s] = __builtin_bit_cast(bf16x8, o); }
        const u32x4 x1 = *(const u32x4*)(qr + 64 + 8 * hf), x2 = *(const u32x4*)(qr + 80 + 8 * hf);
        const float* cp = (const float*)(ws + WS_COSM) + (size_t)mq * 16 + 8 * hf; const float* sp = (const float*)(ws + WS_SINM) + (size_t)mq * 16 + 8 * hf;
        const unsigned a[4] = {x1.x, x1.y, x1.z, x1.w}, c[4] = {x2.x, x2.y, x2.z, x2.w}; unsigned o1[4], o2[4];
#pragma unroll
        for (int i = 0; i < 4; ++i) { const float u0 = bflo(a[i]), u1 = bfhi(a[i]), v0 = bflo(c[i]), v1 = bfhi(c[i]); const float c0 = cp[2 * i], c1 = cp[2 * i + 1], s0 = sp[2 * i], s1 = sp[2 * i + 1];
            o1[i] = pk2((u0 * c0 - v0 * s0) * qs, (u1 * c1 - v1 * s1) * qs); o2[i] = pk2((u0 * s0 + v0 * c0) * qs, (u1 * s1 + v1 * c1) * qs); }
        u32x4 t1, t2; t1.x = o1[0]; t1.y = o1[1]; t1.z = o1[2]; t1.w = o1[3]; t2.x = o2[0]; t2.y = o2[1]; t2.z = o2[2]; t2.w = o2[3];
        qf[4] = __builtin_bit_cast(bf16x8, t1); qf[5] = __builtin_bit_cast(bf16x8, t2);
    }
    f32x16 oacc[2];
#pragma unroll
    for (int i = 0; i < 16; ++i) { oacc[0][i] = 0.f; oacc[1][i] = 0.f; }
    float mrun = 0.f; f32x2 lsum = {0.f, 0.f};
    const int nkt = 4 * qt + 4, mylim = 4 * qt + (w >> 1);
    const int half = w >> 2;
    const int kkey = F.tid >> 3, kpc = F.tid & 7, rkey = (F.tid & 255) >> 2, rpc = F.tid & 3, ve = F.tid >> 3, vpc = F.tid & 7;
    const bf16_t* knp = Kn + (size_t)(b * SEQ + kkey) * 512 + h * 64 + kpc * 8;
    const bf16_t* kpp = Kp + (size_t)(b * SEQ + rkey) * 32 + rpc * 8;
    const bf16_t* vtp = Vt + (size_t)(h * 64 + ve) * MTOK + b * SEQ + vpc * 8;
    const int kofs = (kkey * ATT_KP + kpc * 8) * 2, rofs = (rkey * ATT_KP + 64 + rpc * 8) * 2, vofs = (ve * ATT_VP + vpc * 8) * 2;
    constexpr bool rp = true;
#define ATT_QK(sv, kbuf, init) do { _Pragma("unroll") for (int t_ = 0; t_ < 2; ++t_) { _Pragma("unroll") for (int i_ = 0; i_ < 16; ++i_) sv[t_][i_] = (init); } \
        const LAS bf16_t* kr_ = (kbuf) + ql * ATT_KP + 8 * hf; bf16x8 ka_ = *(const LAS bf16x8*)kr_, kb_ = *(const LAS bf16x8*)(kr_ + 32 * ATT_KP); \
        _Pragma("unroll") for (int st_ = 0; st_ < 6; ++st_) { bf16x8 na_ = ka_, nb_ = kb_; \
            if (st_ < 5) { na_ = *(const LAS bf16x8*)(kr_ + 16 * (st_ + 1)); nb_ = *(const LAS bf16x8*)(kr_ + 32 * ATT_KP + 16 * (st_ + 1)); } \
            sv[0] = __builtin_amdgcn_mfma_f32_32x32x16_bf16(ka_, qf[st_], sv[0], 0, 0, 0); sv[1] = __builtin_amdgcn_mfma_f32_32x32x16_bf16(kb_, qf[st_], sv[1], 0, 0, 0); \
            ka_ = na_; kb_ = nb_; __builtin_amdgcn_sched_barrier(0); } } while (0)
    u32x4 ak, ar, av, bk, br, bv;
#define ATT_LOAD(K_, R_, V_, t_) do { const int tt_ = (t_) < nkt ? (t_) : nkt - 1; \
        K_ = *(const u32x4*)(knp + (size_t)tt_ * 64 * 512); R_ = *(const u32x4*)(kpp + (size_t)tt_ * 64 * 32); V_ = *(const u32x4*)(vtp + (size_t)tt_ * 64); } while (0)
#define ATT_STAGE(K_, R_, V_, kt_) do { { LAS unsigned char* kb2_ = F.lds + ATT_K0 + (((kt_) + 1) & 1) * ATT_KB; *(LAS u32x4*)(kb2_ + kofs) = K_; *(LAS u32x4*)(kb2_ + rofs) = R_; } \
        *(LAS u32x4*)(F.lds + ATT_V0 + (((kt_) + 1) & 1) * ATT_VB + vofs) = V_; ATT_LOAD(K_, R_, V_, (kt_) + 3); } while (0)
    __syncthreads();
    {
        ak = *(const u32x4*)knp; ar = *(const u32x4*)kpp; av = *(const u32x4*)vtp;
        *(LAS u32x4*)(F.lds + ATT_K0 + kofs) = ak; *(LAS u32x4*)(F.lds + ATT_K0 + rofs) = ar; *(LAS u32x4*)(F.lds + ATT_V0 + vofs) = av;
        ATT_LOAD(ak, ar, av, 1); ATT_LOAD(bk, br, bv, 2);
    }
    __syncthreads();
    f32x16 sc[2];
    if (half == 1) LBAR();
#define ATT_SEG1(kt_, ALL) do { if ((ALL) || (kt_) <= mylim) ATT_QK(sc, (const LAS bf16_t*)(F.lds + ATT_K0 + ((kt_) & 1) * ATT_KB), -mrun); } while (0)
#define ATT_SEG2(kt_, ALL) do { if ((ALL) || (kt_) <= mylim) { \
            const LAS bf16_t* vb = (const LAS bf16_t*)(F.lds + ATT_V0 + ((kt_) & 1) * ATT_VB); \
            int mi = __builtin_bit_cast(int, sc[0][0]); \
            _Pragma("unroll") for (int i = 0; i < 16; ++i) { const int a_ = __builtin_bit_cast(int, sc[0][i]), b_ = __builtin_bit_cast(int, sc[1][i]); mi = max(max(mi, a_), b_); } \
            if ((kt_) == 0 || __builtin_amdgcn_ballot_w64(__builtin_bit_cast(float, mi) > 8.0f) != 0ull) { \
                float mx = fmaxf(sc[0][0], sc[1][0]); \
                _Pragma("unroll") for (int i = 1; i < 16; ++i) mx = fmaxf(mx, fmaxf(sc[0][i], sc[1][i])); \
                { const int mb = __builtin_bit_cast(int, mx); const auto sw2 = __builtin_amdgcn_permlane32_swap(mb, mb, false, false); mx = fmaxf(__builtin_bit_cast(float, (int)sw2[0]), __builtin_bit_cast(float, (int)sw2[1])); } \
                const float delta = ((kt_) == 0) ? mx : fmaxf(mx, 0.f); \
                const float alpha = ((kt_) == 0) ? 1.0f : __builtin_amdgcn_exp2f(-delta); mrun += delta; lsum *= alpha; \
                _Pragma("unroll") for (int i = 0; i < 16; ++i) { oacc[0][i] *= alpha; oacc[1][i] *= alpha; sc[0][i] -= delta; sc[1][i] -= delta; } } \
            _Pragma("unroll") for (int t = 0; t < 2; ++t) _Pragma("unroll") for (int i = 0; i < 16; i += 2) { const float p0 = __builtin_amdgcn_exp2f(sc[t][i]), p1 = __builtin_amdgcn_exp2f(sc[t][i + 1]); sc[t][i] = p0; sc[t][i + 1] = p1; lsum += (f32x2){p0, p1}; } \
            _Pragma("unroll") for (int t = 0; t < 2; ++t) _Pragma("unroll") for (int kbb = 0; kbb < 2; ++kbb) { \
                    u32x4 pw; pw.x = pk2(sc[t][8 * kbb + 0], sc[t][8 * kbb + 1]); pw.y = pk2(sc[t][8 * kbb + 2], sc[t][8 * kbb + 3]); pw.z = pk2(sc[t][8 * kbb + 4], sc[t][8 * kbb + 5]); pw.w = pk2(sc[t][8 * kbb + 6], sc[t][8 * kbb + 7]); \
                    const bf16x8 pf = __builtin_bit_cast(bf16x8, pw); const int key0 = t * 32 + kbb * 16 + 4 * hf; \
                    _Pragma("unroll") for (int eb = 0; eb < 2; ++eb) { const LAS bf16_t* vr = vb + (eb * 32 + ql) * ATT_VP + key0; \
                        const u32x2 lo = *(const LAS u32x2*)vr, hi = *(const LAS u32x2*)(vr + 8); u32x4 vv; vv.x = lo.x; vv.y = lo.y; vv.z = hi.x; vv.w = hi.y; \
                        oacc[eb] = __builtin_amdgcn_mfma_f32_32x32x16_bf16(__builtin_bit_cast(bf16x8, vv), pf, oacc[eb], 0, 0, 0); } } } } while (0)
    const int nall = 4 * qt;
#define ATT_TRIP_L(kt_, ALL) do { ATT_SEG1(kt_, ALL); LBAR(); ATT_STAGE(ak, ar, av, kt_); ATT_SEG2(kt_, ALL); LBAR(); \
                                  ATT_SEG1((kt_) + 1, ALL); LBAR(); ATT_STAGE(bk, br, bv, (kt_) + 1); ATT_SEG2((kt_) + 1, ALL); LBAR(); } while (0)
#define ATT_TRIP_T(kt_, ALL) do { ATT_STAGE(ak, ar, av, kt_); ATT_SEG1(kt_, ALL); LBAR(); ATT_SEG2(kt_, ALL); LBAR(); \
                                  ATT_STAGE(bk, br, bv, (kt_) + 1); ATT_SEG1((kt_) + 1, ALL); LBAR(); ATT_SEG2((kt_) + 1, ALL); LBAR(); } while (0)
    if (half == 0) {
#pragma unroll 1
        for (int kt = 0; kt < nall; kt += 2) ATT_TRIP_L(kt, true);
#pragma unroll 1
        for (int kt = nall; kt < nkt; kt += 2) ATT_TRIP_L(kt, false);
        LBAR();
    } else {
#pragma unroll 1
        for (int kt = 0; kt < nall; kt += 2) ATT_TRIP_T(kt, true);
#pragma unroll 1
        for (int kt = nall; kt < nkt; kt += 2) ATT_TRIP_T(kt, false);
    }
#undef ATT_TRIP_L
#undef ATT_TRIP_T
#undef ATT_QK
#undef ATT_LOAD
#undef ATT_STAGE
#undef ATT_SEG1
#undef ATT_SEG2
    float lrun = lsum[0] + lsum[1];
    const float lt = lrun + __shfl_xor(lrun, 32), inv = 1.0f / lt;
    bf16_t* yo = (bf16_t*)(ws + WS_YMLA) + (size_t)mq * 512 + h * 64;
#pragma unroll
    for (int eb = 0; eb < 2; ++eb)
#pragma unroll
        for (int g = 0; g < 4; ++g) { u32x2 wv; wv.x = pk2(oacc[eb][4 * g] * inv, oacc[eb][4 * g + 1] * inv); wv.y = pk2(oacc[eb][4 * g + 2] * inv, oacc[eb][4 * g + 3] * inv);
            *(u32x2*)(yo + eb * 32 + 8 * g + 4 * hf) = wv; }
}
constexpr int RP = 72;
constexpr int RMAT = 64 * RP;
constexpr size_t RC_UNIT = 40960;
constexpr size_t WS_RC2 = WS_RC + (size_t)2048 * RC_UNIT;

__device__ __forceinline__ void st_g4(bf16_t* p, f32x4 v) { u32x2 w; w.x = pk2(v[0], v[1]); w.y = pk2(v[2], v[3]); *(u32x2*)p = w; }
__device__ __forceinline__ f32x4 ld_l4(const LAS bf16_t* p) { const u32x2 w = *(const LAS u32x2*)p; return (f32x4){bflo(w.x), bfhi(w.x), bflo(w.y), bfhi(w.y)}; }

template <int KS>
__device__ __forceinline__ f32x16 mm32(const LAS bf16_t* P, const LAS bf16_t* Q, int ib, int jb, int lane, f32x16 acc) {
    const LAS bf16_t* pp = P + (ib * 32 + (lane & 31)) * RP + 8 * (lane >> 5);
    const LAS bf16_t* qp = Q + (jb * 32 + (lane & 31)) * RP + 8 * (lane >> 5);
#pragma unroll
    for (int ks = 0; ks < KS; ++ks) { const bf16x8 a = *(const LAS bf16x8*)(qp + ks * 16), b = *(const LAS bf16x8*)(pp + ks * 16); acc = __builtin_amdgcn_mfma_f32_32x32x16_bf16(a, b, acc, 0, 0, 0); }
    return acc;
}
__device__ __forceinline__ f32x16 zero16() { f32x16 z; for (int i = 0; i < 16; ++i) z[i] = 0.f; return z; }
__device__ __forceinline__ void st32_lds(LAS bf16_t* O, int ib, int jb, int lane, const f32x16& a) {
    LAS bf16_t* o = O + (ib * 32 + (lane & 31)) * RP + jb * 32 + 4 * (lane >> 5);
#pragma unroll
    for (int g = 0; g < 4; ++g) st_bf4(o + 8 * g, (f32x4){a[4 * g], a[4 * g + 1], a[4 * g + 2], a[4 * g + 3]});
}
__device__ __forceinline__ void st32_glb(bf16_t* O, int ib, int jb, int lane, const f32x16& a) {
    bf16_t* o = O + (ib * 32 + (lane & 31)) * 64 + jb * 32 + 4 * (lane >> 5);
#pragma unroll
    for (int g = 0; g < 4; ++g) st_g4(o + 8 * g, (f32x4){a[4 * g], a[4 * g + 1], a[4 * g + 2], a[4 * g + 3]});
}
struct PreIn { unsigned short r[8], rp[8], k[8], kp[8], v[8], vp[8], lw[8], a[8]; };
__device__ __forceinline__ void pre_load(PreIn& x, const bf16_t* p, const bf16_t* lo, int u, int w, int lane) {
    const int c = u & 127, h = (u >> 7) & 7, b = u >> 10; const int m0 = b * SEQ + c * 64, ch = h * 64 + lane;
#pragma unroll
    for (int i = 0; i < 8; ++i) { const int t = 8 * w + i, m = m0 + t; const bf16_t* pr = p + (size_t)m * PW + P_RW + ch; const bool hp = (c | t) != 0;
        x.r[i] = pr[0]; x.k[i] = pr[512]; x.v[i] = pr[1024];
        x.rp[i] = hp ? pr[-PW] : (unsigned short)0; x.kp[i] = hp ? pr[512 - PW] : (unsigned short)0; x.vp[i] = hp ? pr[1024 - PW] : (unsigned short)0;
        x.lw[i] = lo[(size_t)m * LO_W + ch]; x.a[i] = lo[(size_t)m * LO_W + 512 + ch]; }
}
#ifdef PRE_T
#define PRE_MARK(k) do { if (F.tid == 0) { volatile LAS unsigned long long* tq_ = (volatile LAS unsigned long long*)(F.lds + LDSCTL_OFF + 48); const unsigned long long now_ = __builtin_amdgcn_s_memrealtime(); \
        if ((k) == PRE_T) tq_[1] += now_ - tq_[2]; tq_[2] = now_; } } while (0)
#else
#define PRE_MARK(k) do { } while (0)
#endif
template <int DIAG = 0>
__device__ __forceinline__ void rwkv_chunk_pre(const Frame& F, const float* mu, const float* k_k_, const float* k_a_, const float* r_k_) {
    unsigned char* ws = F.ws; const bf16_t* p = (const bf16_t*)(ws + WS_P); const bf16_t* lo = (const bf16_t*)(ws + WS_LO);
    LAS bf16_t* M = (LAS bf16_t*)F.lds;
    LAS bf16_t *KKt = M, *Bt = M + RMAT, *Kt = M + 2 * RMAT, *Rt = M + 3 * RMAT, *KKtT = M + 4 * RMAT, *BhT = M + 5 * RMAT, *KhT = M + 6 * RMAT, *VcT = M + 7 * RMAT;
    LAS bf16_t *NA = M + 8 * RMAT, *NAT = M + 9 * RMAT, *TT = M + 10 * RMAT, *AkkT = M + 11 * RMAT, *AbrT = M + 12 * RMAT, *AkrT = M + 13 * RMAT;
    LAS float* SEG = (LAS float*)(M + 10 * RMAT);
    const int lane = F.lane, w = F.wave, pr_ = w >> 1, ib = w & 1;
    const int i0 = ib * 32 + (lane & 31), jq = 4 * (lane >> 5);
    PreIn cur;
    if (F.blk < NB * 8 * NCHUNK) pre_load(cur, p, lo, F.blk, w, lane);
    for (int u = F.blk; u < NB * 8 * NCHUNK; u += F.G) {
        const int h = (u >> 7) & 7; const int ch = h * 64 + lane;
        const float mu_r = mu[ch], mu_k = mu[512 + ch], mu_v = mu[1024 + ch], k_k = k_k_[ch], k_a = k_a_[ch], r_k = r_k_[ch];
        float* aux = DIAG ? (float*)(ws + WS_YMLA) + (size_t)(u & 255) * 128 : (float*)(ws + WS_RC2) + (size_t)u * 128;
        LBAR();
        PRE_MARK(0);
        if (DIAG != 2) {
        float rr[8], kk8[8], k28[8], vv[8], bb[8], lw8[8], cs8[8]; float cs = 0.f;
#pragma unroll
        for (int i = 0; i < 8; ++i) { const int t = 8 * w + i;
            const float xr = bf2f(cur.r[i]), xk = bf2f(cur.k[i]), xv = bf2f(cur.v[i]);
            const float r = xr + (bf2f(cur.rp[i]) - xr) * mu_r, k = xk + (bf2f(cur.kp[i]) - xk) * mu_k, v = xv + (bf2f(cur.vp[i]) - xv) * mu_v;
            const float lw = bf2f(cur.lw[i]), a = bf2f(cur.a[i]);
            float kk = k * k_k; const float ss = wave_sum(kk * kk); kk *= rsqrtf(ss + 1e-12f);
            const float k2 = k * (1.0f + (a - 1.0f) * k_a);
            rr[i] = r; kk8[i] = kk; k28[i] = k2; vv[i] = v; bb[i] = kk * a; lw8[i] = lw; cs += lw; cs8[i] = cs;
            (DIAG ? (bf16_t*)(ws + WS_YRW) + (size_t)(u & 255) * 4096 : (bf16_t*)(ws + WS_RC + (size_t)u * RC_UNIT) + 16384)[t * 64 + lane] = (bf16_t)f2bf(v);
            const float bon = wave_sum(r * k2 * r_k); if (lane == 0) aux[64 + t] = bon; }
        SEG[w * 64 + lane] = cs;
        if (u + F.G < NB * 8 * NCHUNK) pre_load(cur, p, lo, u + F.G, w, lane);
        LBAR();
        float off = 0.f, cumC = 0.f;
#pragma unroll
        for (int s = 0; s < 8; ++s) { const float sv = SEG[s * 64 + lane]; cumC += sv; off += (s < w) ? sv : 0.f; }
        if (w == 0) aux[lane] = __expf(cumC);
        LBAR();
        unsigned pkk[4], pbh[4], pkh[4], pvc[4];
#pragma unroll
        for (int i = 0; i < 8; i += 2) { float o_kk[2], o_bh[2], o_kh[2];
#pragma unroll
            for (int e = 0; e < 2; ++e) { const int t = 8 * w + i + e; const float cum = cs8[i + e] + off;
                const float om = __expf(cum), omx = __expf(cum - lw8[i + e]), iom = __expf(-cum), ih = __expf(cumC - cum);
                o_kk[e] = kk8[i + e] * omx; o_bh[e] = bb[i + e] * ih; o_kh[e] = k28[i + e] * ih;
                KKt[t * RP + lane] = (bf16_t)f2bf(o_kk[e]); Bt[t * RP + lane] = (bf16_t)f2bf(bb[i + e] * iom); Kt[t * RP + lane] = (bf16_t)f2bf(k28[i + e] * iom); Rt[t * RP + lane] = (bf16_t)f2bf(rr[i + e] * om); }
            pkk[i >> 1] = pk2(o_kk[0], o_kk[1]); pbh[i >> 1] = pk2(o_bh[0], o_bh[1]); pkh[i >> 1] = pk2(o_kh[0], o_kh[1]); pvc[i >> 1] = pk2(vv[i], vv[i + 1]); }
        *(LAS u32x4*)(KKtT + lane * RP + 8 * w) = (u32x4){pkk[0], pkk[1], pkk[2], pkk[3]}; *(LAS u32x4*)(BhT + lane * RP + 8 * w) = (u32x4){pbh[0], pbh[1], pbh[2], pbh[3]};
        *(LAS u32x4*)(KhT + lane * RP + 8 * w) = (u32x4){pkh[0], pkh[1], pkh[2], pkh[3]}; *(LAS u32x4*)(VcT + lane * RP + 8 * w) = (u32x4){pvc[0], pvc[1], pvc[2], pvc[3]};
        }
        LBAR();
        PRE_MARK(1);
        if (DIAG != 1) {
        {
            const LAS bf16_t* Pm = pr_ < 2 ? KKt : Rt; const LAS bf16_t* Qm = (pr_ == 0 || pr_ == 2) ? Bt : Kt; LAS bf16_t* Om = pr_ == 0 ? NAT : (pr_ == 1 ? AkkT : (pr_ == 2 ? AbrT : AkrT));
            const bool incl = pr_ >= 2; const float sgn = pr_ == 0 ? -1.0f : 1.0f;
#pragma unroll
            for (int jb = 0; jb < 2; ++jb) { f32x16 a = zero16(); if (jb <= ib) a = mm32<4>(Pm, Qm, ib, jb, lane, a);
#pragma unroll
                for (int g = 0; g < 4; ++g)
#pragma unroll
                    for (int r = 0; r < 4; ++r) { const int jj = jb * 32 + 8 * g + jq + r; const bool keep = incl ? (jj <= i0) : (jj < i0); a[4 * g + r] = keep ? sgn * a[4 * g + r] : 0.f; }
                st32_lds(Om, ib, jb, lane, a);
                if (pr_ == 0) {
#pragma unroll
                    for (int g = 0; g < 4; ++g)
#pragma unroll
                        for (int r = 0; r < 4; ++r) { const int jj = jb * 32 + 8 * g + jq + r; a[4 * g + r] += (jj == i0) ? 1.0f : 0.f; }
                    st32_lds(TT, ib, jb, lane, a); } }
            if (pr_ == 0) {
#pragma unroll
                for (int jb = 0; jb < 2; ++jb) { f32x16 a = zero16(); if (jb >= ib) a = mm32<4>(Bt, KKt, ib, jb, lane, a);
#pragma unroll
                    for (int g = 0; g < 4; ++g)
#pragma unroll
                        for (int r = 0; r < 4; ++r) { const int jj = jb * 32 + 8 * g + jq + r; a[4 * g + r] = (i0 < jj) ? -a[4 * g + r] : 0.f; }
                    st32_lds(NA, ib, jb, lane, a); } }
        }
        LBAR();
        PRE_MARK(2);
        LAS bf16_t* VA = Kt;
#pragma unroll 1
        for (int s = 1; s <= 6; ++s) {
            const LAS bf16_t* Yo = (s & 1) ? NAT : KKt; const LAS bf16_t* YoT = (s & 1) ? NA : Bt; LAS bf16_t* Yn = (s & 1) ? KKt : NAT; LAS bf16_t* YnT = (s & 1) ? Bt : NA;
            if (pr_ == 0) {
                if (s == 1) { const f32x16 a0 = mm32<4>(VcT, AkkT, ib, 0, lane, zero16()), a1 = mm32<4>(VcT, AkkT, ib, 1, lane, zero16()); st32_lds(VA, ib, 0, lane, a0); st32_lds(VA, ib, 1, lane, a1); }
                else {
                    f32x16 c0, c1; const LAS bf16_t* tr = TT + i0 * RP + jq;
#pragma unroll
                    for (int g = 0; g < 4; ++g) { const f32x4 x0 = ld_l4(tr + 8 * g), x1 = ld_l4(tr + 32 + 8 * g);
#pragma unroll
                        for (int r = 0; r < 4; ++r) { c0[4 * g + r] = x0[r]; c1[4 * g + r] = x1[r]; } }
                    c0 = mm32<4>(TT, YoT, ib, 0, lane, c0); c1 = mm32<4>(TT, YoT, ib, 1, lane, c1);
                    LDS_WAIT();
                    st32_lds(TT, ib, 0, lane, c0); st32_lds(TT, ib, 1, lane, c1); }
            } else if (pr_ <= 2 && s <= 5) {
                const LAS bf16_t* Pm = pr_ == 1 ? Yo : YoT; const LAS bf16_t* Qm = pr_ == 1 ? YoT : Yo; LAS bf16_t* Om = pr_ == 1 ? Yn : YnT;
                const f32x16 a0 = mm32<4>(Pm, Qm, ib, 0, lane, zero16()), a1 = mm32<4>(Pm, Qm, ib, 1, lane, zero16()); st32_lds(Om, ib, 0, lane, a0); st32_lds(Om, ib, 1, lane, a1);
            }
            LBAR();
        }
        PRE_MARK(3);
        LAS bf16_t* KT = NAT; LAS bf16_t* P1 = NA;
        if (pr_ < 2) { const LAS bf16_t* src = pr_ == 0 ? KKtT : VA; LAS bf16_t* dst = pr_ == 0 ? KT : P1;
            const f32x16 a0 = mm32<4>(src, TT, ib, 0, lane, zero16()), a1 = mm32<4>(src, TT, ib, 1, lane, zero16()); st32_lds(dst, ib, 0, lane, a0); st32_lds(dst, ib, 1, lane, a1); }
        LBAR();
        {
            bf16_t* og = DIAG ? (bf16_t*)(ws + WS_YRW) + (size_t)(u & 255) * 4096 : (bf16_t*)(ws + WS_RC + (size_t)u * RC_UNIT) + pr_ * 4096;
#pragma unroll
            for (int jb = 0; jb < 2; ++jb) { f32x16 o;
                if (pr_ == 0) o = mm32<4>(BhT, KT, ib, jb, lane, zero16());
                else if (pr_ == 1) { const f32x16 x = mm32<4>(VcT, KhT, ib, jb, lane, zero16()), y = mm32<4>(P1, BhT, ib, jb, lane, zero16()); o = x - y; }
                else if (pr_ == 2) { const f32x16 y = mm32<4>(AbrT, KT, ib, jb, lane, zero16()); const LAS bf16_t* rt = Rt + i0 * RP + jb * 32 + jq;
#pragma unroll
                    for (int g = 0; g < 4; ++g) { const f32x4 x = ld_l4(rt + 8 * g);
#pragma unroll
                        for (int r = 0; r < 4; ++r) o[4 * g + r] = x[r] - y[4 * g + r]; } }
                else { const f32x16 x = mm32<4>(VcT, AkrT, ib, jb, lane, zero16()), y = mm32<4>(P1, AbrT, ib, jb, lane, zero16()); o = x - y; }
                st32_glb(og, ib, jb, lane, o); }
        }
        }
        PRE_MARK(4);
    }
    __syncthreads();
}

struct ScanOps { u32x4 fa0, fa1; u32x2 ad0, ad1; f32x4 om; };
__device__ __forceinline__ ScanOps scan_load(const unsigned char* ws, size_t u, int sk, int vh, int l15, int l4) {
    ScanOps o; const bf16_t* base = (const bf16_t*)(ws + WS_RC + u * RC_UNIT);
    o.fa0 = *(const u32x4*)(base + (sk * 16 + l15) * 64 + 8 * l4); o.fa1 = *(const u32x4*)(base + (sk * 16 + l15) * 64 + 32 + 8 * l4);
    o.ad0 = *(const u32x2*)(base + 4096 + ((2 * vh) * 16 + l15) * 64 + sk * 16 + 4 * l4); o.ad1 = *(const u32x2*)(base + 4096 + ((2 * vh + 1) * 16 + l15) * 64 + sk * 16 + 4 * l4);
    o.om = *(const f32x4*)((const float*)(ws + WS_RC2) + u * 128 + sk * 16 + 4 * l4); return o;
}
template <bool STORE>
__device__ __forceinline__ void rwkv_scan(const Frame& F, int b, int h) {
    unsigned char* ws = F.ws;
    LAS bf16_t* Sb = (LAS bf16_t*)F.lds;
    const int lane = F.lane, w = F.wave, l15 = lane & 15, l4 = lane >> 4, sk = w & 3, vh = w >> 2;
    for (int i = F.tid; i < 2 * RMAT / 2; i += NTHR) ((LAS unsigned*)Sb)[i] = 0u;
    const size_t u0 = (size_t)(b * 8 + h) * 128;
    f32x4 st0 = {0.f, 0.f, 0.f, 0.f}, st1 = {0.f, 0.f, 0.f, 0.f};
    ScanOps r0 = scan_load(ws, u0 + 0, sk, vh, l15, l4), r1 = scan_load(ws, u0 + 1, sk, vh, l15, l4), r2 = scan_load(ws, u0 + 2, sk, vh, l15, l4), r3 = scan_load(ws, u0 + 3, sk, vh, l15, l4);
    __syncthreads();
#define SCAN_STEP(R, cc) do { const int c_ = (cc); \
        const LAS bf16_t* Sc = Sb + (c_ & 1) * RMAT; LAS bf16_t* Sn = Sb + ((c_ + 1) & 1) * RMAT; \
        const bf16x8 a0 = __builtin_bit_cast(bf16x8, R.fa0), a1 = __builtin_bit_cast(bf16x8, R.fa1); \
        const LAS bf16_t* sp0 = Sc + ((2 * vh) * 16 + l15) * RP + 8 * l4; const LAS bf16_t* sp1 = sp0 + 16 * RP; \
        const bf16x8 s00 = *(const LAS bf16x8*)sp0, s01 = *(const LAS bf16x8*)(sp0 + 32), s10 = *(const LAS bf16x8*)sp1, s11 = *(const LAS bf16x8*)(sp1 + 32); \
        bf16_t* sg = (bf16_t*)(ws + WS_RC + (u0 + c_ - 1) * RC_UNIT) + 4096;     \
        if (STORE && c_ > 0) *(u32x4*)(sg + (F.tid >> 3) * 64 + (F.tid & 7) * 8) = *(const LAS u32x4*)(Sc + (F.tid >> 3) * RP + (F.tid & 7) * 8);     \
        f32x4 t0 = {0.f, 0.f, 0.f, 0.f}, t1 = {0.f, 0.f, 0.f, 0.f}; \
        t0 = __builtin_amdgcn_mfma_f32_16x16x32_bf16(a0, s00, t0, 0, 0, 0); t1 = __builtin_amdgcn_mfma_f32_16x16x32_bf16(a0, s10, t1, 0, 0, 0); \
        t0 = __builtin_amdgcn_mfma_f32_16x16x32_bf16(a1, s01, t0, 0, 0, 0); t1 = __builtin_amdgcn_mfma_f32_16x16x32_bf16(a1, s11, t1, 0, 0, 0); \
        const f32x4 n0 = {bflo(R.ad0.x), bfhi(R.ad0.x), bflo(R.ad0.y), bfhi(R.ad0.y)}, n1 = {bflo(R.ad1.x), bfhi(R.ad1.x), bflo(R.ad1.y), bfhi(R.ad1.y)}; \
        st0 = st0 * R.om - t0 + n0; st1 = st1 * R.om - t1 + n1; \
        st_bf4(Sn + ((2 * vh) * 16 + l15) * RP + sk * 16 + 4 * l4, st0); st_bf4(Sn + ((2 * vh + 1) * 16 + l15) * RP + sk * 16 + 4 * l4, st1); \
        R = scan_load(ws, u0 + (c_ + 4 < NCHUNK ? c_ + 4 : NCHUNK - 1), sk, vh, l15, l4);     \
        LBAR(); } while (0)
#pragma unroll 1
    for (int c = 0; c < NCHUNK; c += 16) {
#pragma unroll
        for (int j = 0; j < 16; j += 4) { SCAN_STEP(r0, c + j); SCAN_STEP(r1, c + j + 1); SCAN_STEP(r2, c + j + 2); SCAN_STEP(r3, c + j + 3); } }
#undef SCAN_STEP
}

struct OutOps { bf16x8 q0, q1, s00, s01, s10, s11; u32x2 z0, z1; u32x4 cv, cg; float cbc; };
__device__ __forceinline__ OutOps out_load(const unsigned char* ws, int u, int tb, int vh, int l15, int l4, int tt, int c8) {
    OutOps o; const int c = u & 127, h = (u >> 7) & 7, b = u >> 10;
    const bf16_t* base = (const bf16_t*)(ws + WS_RC + (size_t)u * RC_UNIT);
    const bf16_t* Sg = (const bf16_t*)(ws + WS_RC + (size_t)(u > 0 ? u - 1 : 0) * RC_UNIT) + 4096; const bf16_t* QT = base + 8192; const bf16_t* Z = base + 12288;
    o.q0 = *(const bf16x8*)(QT + (tb * 16 + l15) * 64 + 8 * l4); o.q1 = *(const bf16x8*)(QT + (tb * 16 + l15) * 64 + 32 + 8 * l4);
    const bf16_t* sp0 = Sg + ((2 * vh) * 16 + l15) * 64 + 8 * l4; const bf16_t* sp1 = sp0 + 16 * 64;
    o.s00 = *(const bf16x8*)sp0; o.s01 = *(const bf16x8*)(sp0 + 32); o.s10 = *(const bf16x8*)sp1; o.s11 = *(const bf16x8*)(sp1 + 32);
    o.z0 = *(const u32x2*)(Z + ((2 * vh) * 16 + l15) * 64 + tb * 16 + 4 * l4); o.z1 = *(const u32x2*)(Z + ((2 * vh + 1) * 16 + l15) * 64 + tb * 16 + 4 * l4);
    const int m = b * SEQ + c * 64 + tt, chq = h * 64 + c8;
    o.cv = *(const u32x4*)(base + 16384 + tt * 64 + c8); o.cg = *(const u32x4*)((const bf16_t*)(ws + WS_LO) + (size_t)m * LO_W + 1024 + chq);
    o.cbc = ((const float*)(ws + WS_RC2))[(size_t)u * 128 + 64 + tt]; return o;
}
__device__ __forceinline__ void rwkv_out(const Frame& F, const float* lnx_) {
    unsigned char* ws = F.ws;
    LAS float* Yl = (LAS float*)F.lds;
    const int lane = F.lane, w = F.wave, l15 = lane & 15, l4 = lane >> 4, tb = w & 3, vh = w >> 2;
    const int tt = F.tid >> 3, c8 = (F.tid & 7) * 8;
    OutOps cur = out_load(ws, F.blk, tb, vh, l15, l4, tt, c8);
    for (int u = F.blk; u < NB * 8 * NCHUNK; u += F.G) {
        const int c = u & 127, h = (u >> 7) & 7, b = u >> 10;
        const OutOps o = cur;
        { const int un = u + F.G < NB * 8 * NCHUNK ? u + F.G : u; cur = out_load(ws, un, tb, vh, l15, l4, tt, c8); }
        f32x4 y0 = {bflo(o.z0.x), bfhi(o.z0.x), bflo(o.z0.y), bfhi(o.z0.y)}, y1 = {bflo(o.z1.x), bfhi(o.z1.x), bflo(o.z1.y), bfhi(o.z1.y)};
        if (c > 0) {
            y0 = __builtin_amdgcn_mfma_f32_16x16x32_bf16(o.q0, o.s00, y0, 0, 0, 0); y1 = __builtin_amdgcn_mfma_f32_16x16x32_bf16(o.q0, o.s10, y1, 0, 0, 0);
            y0 = __builtin_amdgcn_mfma_f32_16x16x32_bf16(o.q1, o.s01, y0, 0, 0, 0); y1 = __builtin_amdgcn_mfma_f32_16x16x32_bf16(o.q1, o.s11, y1, 0, 0, 0); }
        const int m = b * SEQ + c * 64 + tt, chq = h * 64 + c8;
        const f32x4 ln0 = *(const f32x4*)(lnx_ + chq), ln1 = *(const f32x4*)(lnx_ + chq + 4);
        LBAR();
#pragma unroll
        for (int r = 0; r < 4; ++r) { Yl[(tb * 16 + 4 * l4 + r) * 68 + (2 * vh) * 16 + l15] = y0[r]; Yl[(tb * 16 + 4 * l4 + r) * 68 + (2 * vh + 1) * 16 + l15] = y1[r]; }
        LBAR();
        const f32x4 ya = *(const LAS f32x4*)(Yl + tt * 68 + c8), yb = *(const LAS f32x4*)(Yl + tt * 68 + c8 + 4);
        float yy[8] = {ya[0], ya[1], ya[2], ya[3], yb[0], yb[1], yb[2], yb[3]};
        float s1 = ((yy[0] + yy[1]) + (yy[2] + yy[3])) + ((yy[4] + yy[5]) + (yy[6] + yy[7]));
        s1 = sum8(s1); const float mean = s1 * (1.0f / 64.0f); float s2 = 0.f;
#pragma unroll
        for (int i = 0; i < 8; ++i) { yy[i] -= mean; s2 += yy[i] * yy[i]; }
        s2 = sum8(s2); const float rstd = rsqrtf(s2 * (1.0f / 64.0f) + 64e-5f);
        const unsigned vw[4] = {o.cv.x, o.cv.y, o.cv.z, o.cv.w}, gw[4] = {o.cg.x, o.cg.y, o.cg.z, o.cg.w};
        const float lnx[8] = {ln0[0], ln0[1], ln0[2], ln0[3], ln1[0], ln1[1], ln1[2], ln1[3]};
        unsigned ow[4];
#pragma unroll
        for (int i = 0; i < 4; ++i) { float o2[2];
#pragma unroll
            for (int e = 0; e < 2; ++e) { const int ci = 2 * i + e; const float v = e ? bfhi(vw[i]) : bflo(vw[i]), g = e ? bfhi(gw[i]) : bflo(gw[i]);
                o2[e] = (yy[ci] * rstd * lnx[ci] + o.cbc * v) * g; }
            ow[i] = pk2(o2[0], o2[1]); }
        *(u32x4*)((bf16_t*)(ws + WS_YRW) + (size_t)m * 512 + chq) = (u32x4){ow[0], ow[1], ow[2], ow[3]};
    }
    __syncthreads();
}
__device__ __forceinline__ void rwkv_seq(const Frame& F, const Params& P, int layer, int b, int h) {
    unsigned char* ws = F.ws; const bf16_t* p = (const bf16_t*)(ws + WS_P); const bf16_t* lo = (const bf16_t*)(ws + WS_LO);
    LAS float* Lr = (LAS float*)F.lds; LAS float* Lw = Lr + 4096; LAS float* Lk = Lw + 4096; LAS float* Lv = Lk + 4096; LAS float* Lkk = Lv + 4096; LAS float* Lb = Lkk + 4096; LAS float* Ly = Lb + 4096;
    const int lane = F.lane, ch = h * 64 + lane;
    const float mu_r = P.in[I_MU][(size_t)layer * RWKV_COLS + ch], mu_k = P.in[I_MU][(size_t)layer * RWKV_COLS + 512 + ch], mu_v = P.in[I_MU][(size_t)layer * RWKV_COLS + 1024 + ch];
    const float k_k = P.in[I_KK][layer * 512 + ch], k_a = P.in[I_KA][layer * 512 + ch], r_k = P.in[I_RK][layer * 512 + ch], lnx = P.in[I_LNX][layer * 512 + ch];
    const int vrow = F.tid >> 3, q = F.tid & 7;
    float s[8];
#pragma unroll
    for (int i = 0; i < 8; ++i) s[i] = 0.f;
    for (int c = 0; c < NCHUNK; ++c) {
        const int m0 = b * SEQ + c * 64;
        __syncthreads();
#pragma unroll
        for (int i = 0; i < 8; ++i) { const int t = F.wave + 8 * i, m = m0 + t; const bf16_t* pr = p + (size_t)m * PW + P_RW + ch; const bool hp = (c | t) != 0;
            const float xr = bf2f(pr[0]), xk = bf2f(pr[512]), xv = bf2f(pr[1024]);
            const float pr_ = hp ? bf2f(pr[-PW]) : 0.f, pk_ = hp ? bf2f(pr[512 - PW]) : 0.f, pv_ = hp ? bf2f(pr[1024 - PW]) : 0.f;
            const float r = xr + (pr_ - xr) * mu_r, k = xk + (pk_ - xk) * mu_k, v = xv + (pv_ - xv) * mu_v;
            const float lw = bf2f(lo[(size_t)m * LO_W + ch]), a = bf2f(lo[(size_t)m * LO_W + 512 + ch]);
            float kk = k * k_k; const float ss = wave_sum(kk * kk); kk *= rsqrtf(ss + 1e-12f);
            Lr[t * 64 + lane] = r; Lw[t * 64 + lane] = __expf(lw); Lk[t * 64 + lane] = k * (1.0f + (a - 1.0f) * k_a); Lv[t * 64 + lane] = v; Lkk[t * 64 + lane] = kk; Lb[t * 64 + lane] = kk * a; }
        __syncthreads();
        for (int t = 0; t < 64; ++t) {
            const f32x4 ka = *(const LAS f32x4*)(Lkk + t * 64 + q * 8), kb = *(const LAS f32x4*)(Lkk + t * 64 + q * 8 + 4);
            const f32x4 wa = *(const LAS f32x4*)(Lw + t * 64 + q * 8), wb = *(const LAS f32x4*)(Lw + t * 64 + q * 8 + 4);
            const f32x4 ba = *(const LAS f32x4*)(Lb + t * 64 + q * 8), bb = *(const LAS f32x4*)(Lb + t * 64 + q * 8 + 4);
            const f32x4 k2a = *(const LAS f32x4*)(Lk + t * 64 + q * 8), k2b = *(const LAS f32x4*)(Lk + t * 64 + q * 8 + 4);
            const f32x4 ra = *(const LAS f32x4*)(Lr + t * 64 + q * 8), rb = *(const LAS f32x4*)(Lr + t * 64 + q * 8 + 4);
            const float vv = Lv[t * 64 + vrow];
            float sa = 0.f;
#pragma unroll
            for (int i = 0; i < 4; ++i) { sa += s[i] * ka[i]; sa += s[4 + i] * kb[i]; }
            sa = sum8(sa); sa = -sa;
            float y = 0.f;
#pragma unroll
            for (int i = 0; i < 4; ++i) { s[i] = s[i] * wa[i] + sa * ba[i] + vv * k2a[i]; s[4 + i] = s[4 + i] * wb[i] + sa * bb[i] + vv * k2b[i]; y += s[i] * ra[i]; y += s[4 + i] * rb[i]; }
            y = sum8(y);
            if (q == 0) Ly[t * 64 + vrow] = y;
        }
        __syncthreads();
#pragma unroll
        for (int i = 0; i < 8; ++i) { const int t = F.wave + 8 * i, m = m0 + t;
            const float y = Ly[t * 64 + lane]; const float mean = wave_sum(y) * (1.0f / 64.0f); const float d = y - mean; const float var = wave_sum(d * d) * (1.0f / 64.0f);
            const float bon = wave_sum(Lr[t * 64 + lane] * Lk[t * 64 + lane] * r_k);
            const float g = bf2f(lo[(size_t)m * LO_W + 1024 + ch]);
            const float o = (d * rsqrtf(var + 64e-5f) * lnx + bon * Lv[t * 64 + lane]) * g;
            ((bf16_t*)(ws + WS_YRW))[(size_t)m * 512 + ch] = (bf16_t)f2bf(o); }
    }
    __syncthreads();
}

constexpr int LDS_TAB = LDSCTL_OFF + 64;
__device__ __forceinline__ void moe_table(const Frame& F, const unsigned* ectl) {
    LAS int* tab = (LAS int*)(F.lds + LDS_TAB);
    if (F.tid == 0) { int st = 0, nt = 0;
        for (int e = 0; e < 8; ++e) { const int c = (int)__hip_atomic_load(&ectl[e], __ATOMIC_RELAXED, __HIP_MEMORY_SCOPE_AGENT); tab[1 + e] = st; const int t = (c + 255) >> 8; for (int i = 0; i < t; ++i) tab[16 + nt + i] = e; nt += t; st += t * 256; }
        tab[0] = nt; }
    __syncthreads();
}
__device__ __forceinline__ void phase_moe_scatter(const Frame& F, const unsigned* ectl) {
    unsigned char* ws = F.ws; const LAS int* tab = (const LAS int*)(F.lds + LDS_TAB);
    const int* tok_e = (const int*)(ws + WS_TOK); int* tok_slot = (int*)tok_e + 2 * MTOK; const float* tok_w = (const float*)(tok_slot + 2 * MTOK);
    int* row_tok = (int*)(tok_w + 2 * MTOK); float* row_w = (float*)(row_tok + MAXROWS);
    for (int i = F.blk * NTHR + F.tid; i < 2 * MTOK; i += F.G * NTHR) { const int e = tok_e[i]; const int dest = tab[1 + e] + tok_slot[i]; row_tok[dest] = i >> 1; row_w[dest] = tok_w[i]; tok_slot[i] = dest; }
    const int gt = F.blk * NTHR + F.tid;
    if (gt < 2048) { const int e = gt >> 8; const int c = (int)__hip_atomic_load(&ectl[e], __ATOMIC_RELAXED, __HIP_MEMORY_SCOPE_AGENT); const int r = c + (gt & 255);
        if (r < ((c + 255) & ~255)) { row_tok[tab[1 + e] + r] = -1; row_w[tab[1 + e] + r] = 0.f; } }
}
constexpr int LDS_GTAB = RING_BYTES;
__device__ __forceinline__ void moe_gather_table(const Frame& F, int ncol) {
    const LAS int* tab = (const LAS int*)(F.lds + LDS_TAB); LAS unsigned* gt = (LAS unsigned*)(F.lds + LDS_GTAB);
    const int* row_tok = (const int*)(F.ws + WS_TOK) + 6 * MTOK; const int total = tab[0] * ncol;
    for (int i = F.tid; i < 9 * 256; i += NTHR) { const int u = i >> 8, r = i & 255; const int L = u * F.G + F.blk; unsigned off = 0u;
        if (L < total) { const int tk = row_tok[(L / ncol) * 256 + r]; off = tk > 0 ? (unsigned)tk * (unsigned)(DM * 2) : 0u; }
        gt[i] = off; }
    __syncthreads();
}

extern __shared__ __attribute__((aligned(16))) unsigned char lds_raw[];
template <class T> __device__ __forceinline__ T* uni(T* p) { const unsigned long long v = (unsigned long long)p; const unsigned lo = __builtin_amdgcn_readfirstlane((unsigned)v), hi = __builtin_amdgcn_readfirstlane((unsigned)(v >> 32)); return (T*)(((unsigned long long)hi << 32) | lo); }
__device__ __forceinline__ int uni(int v) { return __builtin_amdgcn_readfirstlane(v); }
__device__ __forceinline__ Frame mkframe(unsigned char* ws, int wv) {
    Frame F; F.lds = (LAS unsigned char*)lds_raw; int tid = wv * 64 + lane_id_fresh(); F.tid = tid; F.lane = F.tid & 63; F.wave = __builtin_amdgcn_readfirstlane(F.tid >> 6);
    int blk = blockIdx.x; asm volatile("" : "+s"(blk)); F.blk = blk; F.G = gridDim.x; F.vcu = (F.blk & 7) * (F.G >> 3) + (F.blk >> 3); F.gw = F.blk * NWAVES + F.wave; F.ngw = F.G * NWAVES; F.ws = ws; return F;
}
#define PHASE __device__ __forceinline__ void
template <int PART>
PHASE f_moe_convert(int wv, unsigned char* ws_, const float* mg, const float* mu, const float* md) {
    unsigned char* ws = uni(ws_); const Frame F = mkframe(ws, wv); Params P; P.in[I_MG] = uni(mg); P.in[I_MU2] = uni(mu); P.in[I_MD] = uni(md);
    if (PART == 0) { __syncthreads(); phase_moe_convert<0>(F, P, F.gw, F.ngw); }
    else if (F.blk >= 32) { __syncthreads(); phase_moe_convert<1>(F, P, (F.blk - 32) * NWAVES + F.wave, (F.G - 32) * NWAVES); }
}
PHASE f_rms(int wv, unsigned char* ws_, const float* src, const float* gain) { unsigned char* ws = uni(ws_); const Frame F = mkframe(ws, wv); phase_rms<false>(F, uni(src), uni(gain), (bf16_t*)(ws + WS_HN), nullptr, nullptr, nullptr, nullptr, nullptr); }
PHASE f_rms_moe(int wv, unsigned char* ws_, const float* src, const float* gain, const float* router) {
    unsigned char* ws = uni(ws_); const Frame F = mkframe(ws, wv); int* tok_e = (int*)(ws + WS_TOK); int* tok_slot = tok_e + 2 * MTOK; float* tok_w = (float*)(tok_slot + 2 * MTOK);
    phase_rms<true>(F, uni(src), uni(gain), (bf16_t*)(ws + WS_HN), uni(router), (unsigned*)(ws + WS_CTL) + CW_ECNT, tok_e, tok_slot, tok_w);
}
PHASE f_prep(int wv, unsigned char* ws_, const float* mu, const float* qnorm, const float* kvnorm, int layer_) {
    unsigned char* ws = uni(ws_); const Frame F = mkframe(ws, wv); Params P; P.in[I_MU] = uni(mu); P.in[I_QNORM] = uni(qnorm); P.in[I_KVNORM] = uni(kvnorm); (void)layer_; phase_prep(F, P, 0);
}
PHASE f_ret_scan(int wv, unsigned char* ws_) { unsigned char* ws = uni(ws_); const Frame F = mkframe(ws, wv); ret_scan(F); }
PHASE f_ret_out(int wv, unsigned char* ws_) { unsigned char* ws = uni(ws_); const Frame F = mkframe(ws, wv); ret_out(F); }
PHASE f_rwkv_seq(int wv, unsigned char* ws_, const float* mu, const float* kk, const float* ka, const float* rk, const float* lnx, int layer_) {
    unsigned char* ws = uni(ws_); const Frame F = mkframe(ws, wv); Params P; P.in[I_MU] = uni(mu); P.in[I_KK] = uni(kk); P.in[I_KA] = uni(ka); P.in[I_RK] = uni(rk); P.in[I_LNX] = uni(lnx);
    (void)layer_; rwkv_seq(F, P, 0, F.blk >> 3, F.blk & 7);
}
PHASE f_rwkv_pre(int wv, unsigned char* ws_, const float* mu, const float* kk, const float* ka, const float* rk) { unsigned char* ws = uni(ws_); const Frame F = mkframe(ws, wv); rwkv_chunk_pre<0>(F, uni(mu), uni(kk), uni(ka), uni(rk));
#ifdef PRE_DIAG
    rwkv_chunk_pre<PRE_DIAG>(F, uni(mu), uni(kk), uni(ka), uni(rk));
#endif
}
PHASE f_rwkv_scan(int wv, unsigned char* ws_) { unsigned char* ws = uni(ws_); const Frame F = mkframe(ws, wv); rwkv_scan<true>(F, F.blk >> 3, F.blk & 7);
#ifdef SCAN_TWICE
    __syncthreads(); rwkv_scan<false>(F, F.blk >> 3, F.blk & 7);
#endif
}
PHASE f_rwkv_out(int wv, unsigned char* ws_, const float* lnx) { unsigned char* ws = uni(ws_); const Frame F = mkframe(ws, wv); rwkv_out(F, uni(lnx)); }
PHASE f_attn(int wv, unsigned char* ws_, int layer_) {
    unsigned char* ws = uni(ws_); const int layer = uni(layer_); const Frame F = mkframe(ws, wv);
    unsigned* qh = (unsigned*)(ws + WS_CTL) + CW_ATTQ + layer * 512; volatile LAS unsigned* slot = (volatile LAS unsigned*)(F.lds + LDSCTL_OFF + 32);
    const int my = (int)(xb_xcc_id() & 7u);
    for (int k = 0; k < 8; ++k) { const int q = (my + k) & 7;
        for (;;) {
            if (F.tid == 0) *slot = __hip_atomic_fetch_add(qh + q * 64, 1u, __ATOMIC_RELAXED, __HIP_MEMORY_SCOPE_AGENT);
            __syncthreads();
            const int idx = (int)*slot;
            __syncthreads();
            if (idx >= 64) break;
            const int bh = 2 * q + (idx & 1), qt = 31 - (idx >> 1);
            attn_unit(F, bh >> 3, bh & 7, qt);
        } }
}
PHASE f_moe_scatter(int wv, unsigned char* ws_) { unsigned char* ws = uni(ws_); const Frame F = mkframe(ws, wv); moe_table(F, (unsigned*)(ws + WS_CTL) + CW_ECNT); phase_moe_scatter(F, (unsigned*)(ws + WS_CTL) + CW_ECNT); }
PHASE f_final(int wv, unsigned char* ws_, float* h, const float* gain) { unsigned char* ws = uni(ws_); const Frame F = mkframe(ws, wv); phase_final(F, uni(h), uni(gain), (const bf16_t*)(ws + WS_OUT2), (const int*)(ws + WS_TOK) + 2 * MTOK); }
constexpr int DEFER_BLK0 = 128;
PHASE f_defer_a(int wv, unsigned char* ws_, const float* wqb, const float* wbr, const float* wo, const float* fg, const float* fu, const float* fd, const float* w2, const float* a2, const float* g2, const float* wkvb, const float* pos) {
    unsigned char* ws = uni(ws_); const Frame F = mkframe(ws, wv); Params P; P.in[I_WIN] = nullptr; P.in[I_WQB] = uni(wqb); P.in[I_WBR] = uni(wbr); P.in[I_WO] = uni(wo); P.in[I_FG] = uni(fg); P.in[I_FU] = uni(fu); P.in[I_FD] = uni(fd);
    P.in[I_W2] = uni(w2); P.in[I_A2] = uni(a2); P.in[I_G2] = uni(g2); P.in[I_WKVB] = uni(wkvb); P.in[I_POS] = uni(pos);
    __syncthreads();
    constexpr int NW = (256 - DEFER_BLK0) * NWAVES, NA = pro::NIT - 2 * pro::I_IN;
    pro_tiles<NA / NW>(F, P, 2 * pro::I_IN, (F.blk - DEFER_BLK0) * NWAVES + F.wave, NW, NA % NW);
    pro_small(F, P, (F.blk - DEFER_BLK0) * NTHR + F.tid, (256 - DEFER_BLK0) * NTHR, F.blk - DEFER_BLK0, 256 - DEFER_BLK0);
}
PHASE f_defer_b(int wv, unsigned char* ws_, const float* win) {
    unsigned char* ws = uni(ws_); const Frame F = mkframe(ws, wv); Params P; P.in[I_WIN] = uni(win); P.in[I_WQB] = nullptr; P.in[I_WBR] = nullptr; P.in[I_WO] = nullptr; P.in[I_FG] = nullptr; P.in[I_FU] = nullptr; P.in[I_FD] = nullptr;
    __syncthreads();
    constexpr int NW = (256 - DEFER_BLK0) * NWAVES;
    pro_tiles<pro::I_IN / NW>(F, P, pro::I_IN, (F.blk - DEFER_BLK0) * NWAVES + F.wave, NW, pro::I_IN % NW);
}
PHASE g_inproj(int wv, unsigned char* ws_, int layer_) {
    unsigned char* ws = uni(ws_); const int layer = uni(layer_); const Frame F = mkframe(ws, wv);
    SchedGrid S; S.init(64, 18, F.G, F.blk, ws + WS_HN, (size_t)256 * DM * 2, (bf16_t*)(ws + WS_WIN) + (size_t)layer * WIN_ROWS * DM, (size_t)256 * DM * 2);
    EpiStore E; E.O = (bf16_t*)(ws + WS_P); E.ld = PW; E.SS = (const float*)(ws + WS_SS); E.rl = (LAS float*)(F.lds + RING_BYTES); E.tid = F.tid; pg8::gemm_phase(F.lds, F.tid, DM, DM, DM, S, E);
}
PHASE g_lora(int wv, unsigned char* ws_, const float* w0, const float* a0, int layer_) {
    unsigned char* ws = uni(ws_); const int layer = uni(layer_); const Frame F = mkframe(ws, wv);
    SchedGrid S; S.init(64, 6, F.G, F.blk, ws + WS_LIN, (size_t)256 * LORA_K * 2, (bf16_t*)(ws + WS_LORA) + (size_t)layer * 1536 * LORA_K, (size_t)256 * LORA_K * 2);
    EpiLora E; E.O = (bf16_t*)(ws + WS_LO); E.w0 = uni(w0); E.a0 = uni(a0); pg8::gemm_phase(F.lds, F.tid, LORA_K, LORA_K, LORA_K, S, E);
}
PHASE g_small(int wv, unsigned char* ws_, int layer_) {
    unsigned char* ws = uni(ws_); const Frame F = mkframe(ws, wv); SchedSmall S; S.G = F.G; S.c = F.blk; S.layer = uni(layer_); S.ws = (const char*)ws; EpiSmall E; E.ws = ws; pg8::gemm_phase(F.lds, F.tid, 256, 256, 256, S, E);
}
PHASE g_gate(int wv, unsigned char* ws_, int layer_) {
    unsigned char* ws = uni(ws_); const int layer = uni(layer_); const Frame F = mkframe(ws, wv);
    SchedOwn3 S; S.c = F.blk; S.G = F.G; S.A = (const char*)(ws + WS_HN); S.a_n = 0; S.astep = (size_t)256 * DM * 2; S.B = (const char*)((bf16_t*)(ws + WS_WIN) + ((size_t)layer * WIN_ROWS + PW) * DM); S.bstep = (size_t)256 * DM * 2; S.b_n = (size_t)1024 * DM * 2;
    EpiGate E; E.O = (bf16_t*)(ws + WS_G); E.SS = (const float*)(ws + WS_SS); E.rl = (LAS float*)(F.lds + RING_BYTES); E.tid = F.tid; pg8::gemm_phase(F.lds, F.tid, DM, DM, DM, S, E);
}
PHASE g_merge(int wv, unsigned char* ws_, int layer_) {
    unsigned char* ws = uni(ws_); const int layer = uni(layer_); const Frame F = mkframe(ws, wv);
    SchedOwn3 S; S.c = F.blk; S.G = F.G; S.A = (const char*)(ws + WS_YRET); S.a_n = (size_t)16 * MiB; S.astep = (size_t)256 * 512 * 2;
    S.B = (const char*)((bf16_t*)(ws + WS_BR) + (size_t)layer * 3 * 1024 * 512); S.bstep = (size_t)256 * 512 * 2; S.b_n = (size_t)1024 * 512 * 2;
    EpiMerge E; E.Gt = (const bf16_t*)(ws + WS_G); E.Mg = (bf16_t*)(ws + WS_MRG); pg8::gemm_phase(F.lds, F.tid, 512, 512, 512, S, E);
}
template <bool EMIT>
PHASE g_wo(int wv, unsigned char* ws_, const float* hin, float* hout, const float* gain, int layer_) {
    unsigned char* ws = uni(ws_); const int layer = uni(layer_); const Frame F = mkframe(ws, wv);
    SchedGrid S; S.init(64, 4, F.G, F.blk, ws + WS_MRG, (size_t)256 * DM * 2, (bf16_t*)(ws + WS_WO) + (size_t)layer * DM * DM, (size_t)256 * DM * 2);
    EpiResid<EMIT> E; E.In = uni(hin); E.Out = uni(hout); E.gain = uni(gain); E.Hg = (bf16_t*)(ws + WS_HN); E.SS = (float*)(ws + WS_SS); pg8::gemm_phase(F.lds, F.tid, DM, DM, DM, S, E);
}
PHASE g_ffn_gu(int wv, unsigned char* ws_) {
    unsigned char* ws = uni(ws_); const Frame F = mkframe(ws, wv);
    SchedGrid S; S.init(64, 22, F.G, F.blk, ws + WS_HN, (size_t)256 * DM * 2, ws + WS_FGU, (size_t)256 * DM * 2);
    EpiSwiglu E; E.O = (bf16_t*)(ws + WS_ACT); E.ldc = DFF; E.pn_off = 0; E.SS = (const float*)(ws + WS_SS); E.rl = (LAS float*)(F.lds + RING_BYTES); E.tid = F.tid; pg8::gemm_phase(F.lds, F.tid, DM, DM, DM, S, E);
}
PHASE g_ffn_down(int wv, unsigned char* ws_, float* h, const float* gain) {
    unsigned char* ws = uni(ws_); const Frame F = mkframe(ws, wv);
    SchedGrid S; S.init(64, 4, F.G, F.blk, ws + WS_ACT, (size_t)256 * DFF * 2, ws + WS_FD, (size_t)256 * DFF * 2);
    EpiResid<true> E; E.In = uni(h); E.Out = (float*)E.In; E.gain = uni(gain); E.Hg = (bf16_t*)(ws + WS_HN); E.SS = (float*)(ws + WS_SS); pg8::gemm_phase(F.lds, F.tid, DFF, DFF, DFF, S, E);
}
PHASE g_moe_gu(int wv, unsigned char* ws_, int hh_) {
    unsigned char* ws = uni(ws_); const int hh = uni(hh_); const Frame F = mkframe(ws, wv); const LAS int* tab = (const LAS int*)(F.lds + LDS_TAB);
    moe_gather_table(F, 14);
    SchedMoe S; S.G = F.G; S.c = F.blk; S.ncol = 14; S.ntile = tab[0]; S.tab = tab + 16; S.A = (const char*)(ws + WS_HN); S.astep = 0;
    S.B = (const char*)(ws + WS_MGU) + (size_t)hh * 14 * 256 * DM * 2; S.bstep = (size_t)256 * DM * 2; S.estep = (size_t)2 * DFFE * DM * 2;
    EpiSwiglu E; E.O = (bf16_t*)(ws + WS_MACT); E.ldc = DFFH; E.pn_off = 0; E.SS = nullptr; E.rl = nullptr; E.tid = 0; pg8::gemm_phase<EpiSwiglu, SchedMoe, true>(F.lds, F.tid, DM, DM, DM, S, E, (const LAS unsigned*)(F.lds + LDS_GTAB));
}
template <bool ACCUM>
PHASE g_moe_down(int wv, unsigned char* ws_, int hh_) {
    unsigned char* ws = uni(ws_); const int hh = uni(hh_); const Frame F = mkframe(ws, wv); const LAS int* tab = (const LAS int*)(F.lds + LDS_TAB);
    const float* row_w = (const float*)((const int*)(ws + WS_TOK) + 6 * MTOK + MAXROWS);
    SchedMoe S; S.G = F.G; S.c = F.blk; S.ncol = 4; S.ntile = tab[0]; S.tab = tab + 16; S.A = (const char*)(ws + WS_MACT); S.astep = (size_t)256 * DFFH * 2;
    S.B = (const char*)(ws + WS_MD) + (size_t)hh * DFFH * 2; S.bstep = (size_t)256 * DFFE * 2; S.estep = (size_t)DM * DFFE * 2;
    EpiMoeOut<ACCUM> E; E.row_w = row_w; E.O = (bf16_t*)(ws + WS_OUT2); pg8::gemm_phase(F.lds, F.tid, DFFH, DFFH, DFFE, S, E);
}

typedef const __attribute__((address_space(4))) Params* KPtr;
__device__ __forceinline__ KPtr kargs() { KPtr k = (KPtr)__builtin_amdgcn_kernarg_segment_ptr(); asm volatile("" : "+s"(k)); return k; }
#define KIN(i) (kargs()->in[i])
#define KWS() (kargs()->ws)
struct TpState { unsigned long long tp0, tp1; int tpk; };
#define tp0 tps.tp0
#define tp1 tps.tp1
#define tpk tps.tpk
#define GRID_BAR() do { XcdBarrier b_ = bar; b_.bar = (unsigned*)(KWS() + WS_CTL) + CW_BAR; b_.x = xb_xcc_id(); xcd_barrier(b_); } while (0)
#ifdef TPH
#define TP(k) do { volatile LAS unsigned long long* tpl_ = (volatile LAS unsigned long long*)(lds_raw + LDSCTL_OFF + 48); if ((k) == TPH) tpl_[0] = __builtin_amdgcn_s_memrealtime(); if ((k) == TPH + TPN) tpl_[1] = __builtin_amdgcn_s_memrealtime(); } while (0)
#define TPM() do { ++tpk; TP(tpk); } while (0)
#else
#define TP(k) do { } while (0)
#define TPM() do { } while (0)
#endif
template <int layer>
__device__ __forceinline__ void layer_body(const int wv, const XcdBarrier& bar, TpState& tps) {
        g_inproj(wv, KWS(), layer);
        if constexpr (layer == 0) { if ((int)blockIdx.x >= DEFER_BLK0) f_defer_a(wv, KWS(), KIN(I_WQB), KIN(I_WBR), KIN(I_WO), KIN(I_FG), KIN(I_FU), KIN(I_FD), KIN(I_W2), KIN(I_A2), KIN(I_G2), KIN(I_WKVB), KIN(I_POS)); }
        GRID_BAR();
        TPM();
        f_prep(wv, KWS(), KIN(I_MU) + (size_t)layer * RWKV_COLS, KIN(I_QNORM) + layer * 256, KIN(I_KVNORM) + layer * 128, layer);
        GRID_BAR();
        TPM();
        f_ret_scan(wv, KWS());
        g_lora(wv, KWS(), KIN(I_W0) + layer * 512, KIN(I_A0) + layer * 512, layer);
        g_small(wv, KWS(), layer);
        GRID_BAR();
        TPM();
        f_ret_out(wv, KWS());
#ifdef SPLIT5
        GRID_BAR();
        TPM();
#endif
#ifndef RWKV_SEQ
        f_rwkv_pre(wv, KWS(), KIN(I_MU) + (size_t)layer * RWKV_COLS, KIN(I_KK) + layer * 512, KIN(I_KA) + layer * 512, KIN(I_RK) + layer * 512);
        GRID_BAR();
        TPM();
        if ((int)blockIdx.x < 16) f_rwkv_scan(wv, KWS());
#ifdef SPLIT6
        GRID_BAR();
        TPM();
#endif
#else
        GRID_BAR();
        TPM();
        if (blockIdx.x < 16) f_rwkv_seq(wv, KWS(), KIN(I_MU) + (size_t)layer * RWKV_COLS, KIN(I_KK) + layer * 512, KIN(I_KA) + layer * 512, KIN(I_RK) + layer * 512, KIN(I_LNX) + layer * 512, layer);
#endif
        f_attn(wv, KWS(), layer);
        GRID_BAR();
        TPM();
#ifndef RWKV_SEQ
        f_rwkv_out(wv, KWS(), KIN(I_LNX) + layer * 512);
#endif
        g_gate(wv, KWS(), layer);
#ifndef RWKV_SEQ
        GRID_BAR();
        TPM();
#endif
        g_merge(wv, KWS(), layer);
        GRID_BAR();
        TPM();
        g_wo<layer == 0>(wv, KWS(), layer == 0 ? KIN(I_X) : (const float*)kargs()->out, kargs()->out, KIN(I_FNORM) + layer * DM, layer);
        GRID_BAR();
        TPM();
        if constexpr (layer == 0) {
            g_ffn_gu(wv, KWS());
            if ((int)blockIdx.x >= DEFER_BLK0) f_defer_b(wv, KWS(), KIN(I_WIN));
            GRID_BAR();
            TPM();
            g_ffn_down(wv, KWS(), kargs()->out, KIN(I_ANORM) + DM);
            GRID_BAR();
            TPM();
        } else {
            f_rms_moe(wv, KWS(), kargs()->out, KIN(I_FNORM) + layer * DM, KIN(I_ROUTER));
            f_moe_convert<0>(wv, KWS(), KIN(I_MG), KIN(I_MU2), KIN(I_MD));
            GRID_BAR();
            TPM();
            f_moe_scatter(wv, KWS());
            GRID_BAR();
            TPM();
            g_moe_gu(wv, KWS(), 0);
            GRID_BAR();
            TPM();
            g_moe_down<false>(wv, KWS(), 0);
            f_moe_convert<1>(wv, KWS(), KIN(I_MG), KIN(I_MU2), KIN(I_MD));
            GRID_BAR();
            TPM();
            g_moe_gu(wv, KWS(), 1);
            GRID_BAR();
            TPM();
            g_moe_down<true>(wv, KWS(), 1);
            GRID_BAR();
            TPM();
        }
    }
__global__ void __launch_bounds__(NTHR, 2) mega(Params P_unused) {
    LAS unsigned char* lds = (LAS unsigned char*)lds_raw;
    const int wv = __builtin_amdgcn_readfirstlane((int)threadIdx.x >> 6);
    for (int u = threadIdx.x; u < (LDS_BYTES - LDSCTL_OFF) / 4; u += NTHR) ((LAS unsigned*)(lds + LDSCTL_OFF))[u] = 0u;
    __syncthreads();
    const XcdBarrier bar = xcd_barrier_post((unsigned*)(KWS() + WS_CTL) + CW_BAR, (volatile LAS unsigned*)(lds + LDSCTL_OFF), wv);
    TpState tps = {0ull, 0ull, 0};
    TP(0);
    {
        KPtr k = kargs(); unsigned char* ws = k->ws; const Frame F = mkframe(ws, wv);
        Params P; P.in[I_WIN] = k->in[I_WIN]; P.in[I_WQB] = k->in[I_WQB]; P.in[I_WBR] = k->in[I_WBR]; P.in[I_WO] = k->in[I_WO]; P.in[I_FG] = k->in[I_FG]; P.in[I_FU] = k->in[I_FU]; P.in[I_FD] = k->in[I_FD];
        P.in[I_W2] = k->in[I_W2]; P.in[I_A2] = k->in[I_A2]; P.in[I_G2] = k->in[I_G2]; P.in[I_WKVB] = k->in[I_WKVB]; P.in[I_POS] = k->in[I_POS]; P.in[I_X] = k->in[I_X]; P.in[I_ANORM] = k->in[I_ANORM];
        phase_prologue(F, P);
    }
    GRID_BAR();
    TPM();
    layer_body<0>(wv, bar, tps);
    layer_body<1>(wv, bar, tps);
    f_final(wv, KWS(), kargs()->out, KIN(I_FINAL));
#ifdef PRE_T
    __syncthreads();
    { volatile LAS unsigned long long* tq_ = (volatile LAS unsigned long long*)(lds_raw + LDSCTL_OFF + 48); const unsigned long long te = __builtin_amdgcn_s_memrealtime(), span = tq_[1] * 8ull; while (__builtin_amdgcn_s_memrealtime() - te < span) __builtin_amdgcn_s_sleep(8); }
#endif
#ifdef TPH
    __syncthreads(); TPM();
    { volatile LAS unsigned long long* tpl_ = (volatile LAS unsigned long long*)(lds_raw + LDSCTL_OFF + 48); const unsigned long long te = __builtin_amdgcn_s_memrealtime(), span = (tpl_[1] - tpl_[0]) * (unsigned long long)TAMP; while (__builtin_amdgcn_s_memrealtime() - te < span) __builtin_amdgcn_s_sleep(8); }
#endif
}

extern "C" void kernel_launch(void* const* d_in, const int* in_sizes, int n_in, void* d_out, int out_size, void* d_ws, size_t ws_size, hipStream_t stream) {
    static int ready = 0;
    if (!ready) {
        if (n_in != 29 || out_size != MTOK * DM || ws_size < WS_END) { fprintf(stderr, "kernel_launch: unexpected shapes (n_in %d out %d ws %zu need %zu)\n", n_in, out_size, ws_size, (size_t)WS_END); ready = -1; return; }
        if (hipFuncSetAttribute((const void*)mega, hipFuncAttributeMaxDynamicSharedMemorySize, LDS_BYTES) != hipSuccess) { fprintf(stderr, "kernel_launch: hipFuncSetAttribute failed\n"); ready = -1; return; }
        int dev = 0, cus = 0, per_cu = 0; (void)hipGetDevice(&dev); (void)hipDeviceGetAttribute(&cus, hipDeviceAttributeMultiprocessorCount, dev);
        (void)hipOccupancyMaxActiveBlocksPerMultiprocessor(&per_cu, (const void*)mega, NTHR, LDS_BYTES);
        if (cus < 256 || per_cu < 1) { fprintf(stderr, "kernel_launch: needs 256 CUs with one resident workgroup each (cus %d, per_cu %d)\n", cus, per_cu); ready = -1; return; }
        ready = 1;
    }
    if (ready < 0) return;
    (void)hipMemsetAsync((char*)d_ws + WS_CTL, 0, CTL_BYTES, stream);
    Params p{}; for (int i = 0; i < 29; ++i) p.in[i] = (const float*)d_in[i]; p.out = (float*)d_out; p.ws = (unsigned char*)d_ws;
    hipLaunchKernelGGL(mega, dim3(256), dim3(NTHR), LDS_BYTES, stream, p);
}
```

```cpp
#include <hip/hip_runtime.h>
#include <cstdio>
#include <cstdint>

#define LAS __attribute__((address_space(3)))
#define GAS __attribute__((address_space(1)))
typedef unsigned short bf16_t;
typedef short bf16x8 __attribute__((ext_vector_type(8)));
typedef short bf16x4 __attribute__((ext_vector_type(4)));
typedef float f32x4 __attribute__((ext_vector_type(4)));
typedef float f32x2 __attribute__((ext_vector_type(2)));
typedef float f32x16 __attribute__((ext_vector_type(16)));
typedef unsigned u32x4 __attribute__((ext_vector_type(4)));
typedef unsigned u32x2 __attribute__((ext_vector_type(2)));

constexpr int NB = 2, SEQ = 8192, DM = 1024, MTOK = NB * SEQ, NLAYER = 2, CH = 64, NCHUNK = SEQ / CH;
constexpr int IN_COLS = 7360, PW = 4608;
constexpr int P_RQ = 0, P_RK = 512, P_RV = 1024, P_RG = 1536, P_RW = 2048, P_QA = 4096, P_KVA = 4352;
constexpr int WIN_ROWS = 7680;
constexpr int RWKV_COLS = 1824, LORA_K = 384, LO_W = 1536;
constexpr int DFF = 2816, DFFE = 3584, NEXP = 8, DFFH = DFFE / 2;
constexpr int MAXROWS = 34816;
constexpr float NORM_EPS = 1e-6f;

constexpr size_t MiB = 1u << 20;
constexpr size_t WS_CTL = 0, CTL_BYTES = 1 * MiB;
constexpr size_t WS_WIN = 1 * MiB;
constexpr size_t WS_LORA = 31 * MiB;
constexpr size_t WS_QB = 34 * MiB;
constexpr size_t WS_KB = 35 * MiB;
constexpr size_t WS_VB = 35 * MiB + 512 * 1024;
constexpr size_t WS_BR = 36 * MiB;
constexpr size_t WS_WO = 42 * MiB;
constexpr size_t WS_FGU = 46 * MiB;
constexpr size_t WS_FD = 57 * MiB;
constexpr size_t WS_COSR = 63 * MiB, WS_SINR = 67 * MiB, WS_COSM = 71 * MiB, WS_SINM = 72 * MiB;
constexpr size_t WS_HN = 73 * MiB;
constexpr size_t WS_TOK = 105 * MiB;
constexpr size_t WS_T = 106 * MiB;
constexpr size_t WS_P = WS_T;
constexpr size_t WS_G = WS_T;
constexpr size_t WS_MRG = WS_T + 96 * MiB;
constexpr size_t WS_LO = WS_T + 144 * MiB;
constexpr size_t WS_Q = WS_T + 192 * MiB;
constexpr size_t WS_KN = WS_T + 216 * MiB;
constexpr size_t WS_VT = WS_T + 232 * MiB;
constexpr size_t WS_KPE = WS_T + 248 * MiB;
constexpr size_t WS_LIN = WS_T + 249 * MiB;
constexpr size_t WS_QN = WS_T + 261 * MiB;
constexpr size_t WS_CN = WS_T + 269 * MiB;
constexpr size_t WS_YRET = WS_T + 261 * MiB;
constexpr size_t WS_RS = WS_T + 277 * MiB;
constexpr size_t WS_YRW = WS_T + 277 * MiB;
constexpr size_t WS_YMLA = WS_T + 293 * MiB;
constexpr size_t WS_RC = WS_T + 309 * MiB;
constexpr size_t WS_ACT = WS_T;
constexpr size_t WS_MGU = WS_T;
constexpr size_t WS_MD = WS_T + 112 * MiB;
constexpr size_t WS_MACT = WS_T + 168 * MiB;
constexpr size_t WS_OUT2 = WS_T + 287 * MiB;
constexpr size_t WS_SS = WS_T + 390 * MiB;
constexpr size_t WS_END = WS_T + 391 * MiB;
static_assert(WS_MACT + (size_t)MAXROWS * DFFH * 2 <= WS_OUT2 && WS_OUT2 + (size_t)MAXROWS * DM * 2 <= WS_END, "ws map");
constexpr int CW_BAR = 4096;
constexpr int CW_ECNT = 16384;
constexpr int CW_ATTQ = 20480;

__device__ __forceinline__ unsigned f2bf(float f) { unsigned u = __builtin_bit_cast(unsigned, f); return (u + 0x7fffu + ((u >> 16) & 1u)) >> 16; }
typedef __bf16 bf16n2 __attribute__((ext_vector_type(2)));
__device__ __forceinline__ unsigned pk2(float lo, float hi) { const f32x2 f = {lo, hi}; const bf16n2 v = __builtin_convertvector(f, bf16n2); return __builtin_bit_cast(unsigned, v); }
__device__ __forceinline__ float bf2f(unsigned short h) { return __builtin_bit_cast(float, (unsigned)h << 16); }
__device__ __forceinline__ float bflo(unsigned w) { return __builtin_bit_cast(float, w << 16); }
__device__ __forceinline__ float bfhi(unsigned w) { return __builtin_bit_cast(float, w & 0xffff0000u); }
template <int CTRL, int ROWMASK = 0xF>
__device__ __forceinline__ float dpp_add(float v) { const int t = __builtin_amdgcn_update_dpp(0, __builtin_bit_cast(int, v), CTRL, ROWMASK, 0xF, ROWMASK == 0xF); return v + __builtin_bit_cast(float, t); }
#ifdef NO_DPP
__device__ __forceinline__ float sum4(float v)  { v += __shfl_xor(v, 1); v += __shfl_xor(v, 2); return v; }
__device__ __forceinline__ float sum8(float v)  { v = sum4(v); v += __shfl_xor(v, 4); return v; }
__device__ __forceinline__ float sum16(float v) { v = sum8(v); v += __shfl_xor(v, 8); return v; }
__device__ __forceinline__ float wave_sum(float v) { v = sum16(v); v += __shfl_xor(v, 16); v += __shfl_xor(v, 32); return v; }
#else
__device__ __forceinline__ float sum4(float v)  { v = dpp_add<0xB1>(v); return dpp_add<0x4E>(v); }
__device__ __forceinline__ float sum8(float v)  { return dpp_add<0x141>(sum4(v)); }
__device__ __forceinline__ float sum16(float v) { return dpp_add<0x140>(sum8(v)); }
__device__ __forceinline__ float wave_sum(float v) {
    v = sum16(v); v = dpp_add<0x142, 0xA>(v); v = dpp_add<0x143, 0xC>(v);
    return __builtin_bit_cast(float, __builtin_amdgcn_readlane(__builtin_bit_cast(int, v), 63));
}
#endif
__device__ __forceinline__ float sigmoidf_(float x) { return 1.0f / (1.0f + __expf(-x)); }
#define LDS_WAIT() asm volatile("s_waitcnt lgkmcnt(0)" ::: "memory")
#define LBAR() do { asm volatile("s_waitcnt lgkmcnt(0)" ::: "memory"); __builtin_amdgcn_s_barrier(); asm volatile("" ::: "memory"); } while (0)
#define VM_WAIT() asm volatile("s_waitcnt vmcnt(0)" ::: "memory")

#define XB_TMO      128
#define XB_XCNT(j)  (256  + 64 * (j))
#define XB_XSUB(j)  (1280 + 64 * (j))
#define XB_XGEN(j)  (2304 + 64 * (j))
#define XB_TOP      3328
#define XB_TOPGEN   3392
#define XCD_BAR_WORDS 3456
#define XB_SPIN_CAP (1u << 18)
__device__ __forceinline__ unsigned xb_ld(unsigned* p)              { return __hip_atomic_load(p, __ATOMIC_RELAXED, __HIP_MEMORY_SCOPE_AGENT); }
__device__ __forceinline__ unsigned xb_add(unsigned* p, unsigned v) { return __hip_atomic_fetch_add(p, v, __ATOMIC_RELAXED, __HIP_MEMORY_SCOPE_AGENT); }
__device__ __forceinline__ unsigned xb_xcc_id() { return (unsigned)__builtin_amdgcn_s_getreg((3 << 11) | 20) & 0xFu; }
#define XB_SPIN(cond, bar) do { unsigned _sp = 0; while (cond) { __builtin_amdgcn_s_sleep(1); \
    if ((++_sp & 255u) == 0u) { if (xb_ld(&(bar)[XB_TMO])) break; if (_sp > XB_SPIN_CAP) { atomicAdd(&(bar)[XB_TMO], 1u); break; } } } } while (0)
struct XcdBarrier { unsigned* bar; unsigned x; volatile LAS unsigned* st; int wv; };
__device__ __forceinline__ int lane_id_fresh() { int l; asm volatile("v_mbcnt_lo_u32_b32 %0, -1, 0\n\tv_mbcnt_hi_u32_b32 %0, -1, %0" : "=v"(l)); return l; }
__device__ __forceinline__ bool xb_thread0(int wv) { return wv == 0 && lane_id_fresh() == 0; }
__device__ __forceinline__ XcdBarrier xcd_barrier_post(unsigned* bar, volatile LAS unsigned* st, int wv) {
    XcdBarrier b; b.bar = bar; b.x = xb_xcc_id(); b.st = st; b.wv = wv;
    if (xb_thread0(wv)) (void)xb_add(&bar[XB_XCNT(b.x)], 1u);
    return b;
}
__device__ __forceinline__ void xcd_barrier_complete(unsigned* bar, unsigned x, unsigned& nloc, unsigned& nx) {
    const unsigned G = gridDim.x * gridDim.y * gridDim.z;
    unsigned sum, cnt, mine, sp = 0u;
    for (;;) {
        sum = 0u; cnt = 0u; mine = 0u;
#pragma unroll
        for (unsigned j = 0; j < 16; ++j) { const unsigned c = xb_ld(&bar[XB_XCNT(j)]); sum += c; cnt += (c > 0u) ? 1u : 0u; mine = (j == x) ? c : mine; }
        if (sum == G) break;
        __builtin_amdgcn_s_sleep(1);
        if ((++sp & 255u) == 0u) { if (xb_ld(&bar[XB_TMO])) break; if (sp > XB_SPIN_CAP) { atomicAdd(&bar[XB_TMO], 1u); break; } }
    }
    nloc = mine > 0u ? mine : 1u; nx = cnt > 0u ? cnt : 1u;
}
__device__ __forceinline__ void xcd_barrier(const XcdBarrier& b) {
    asm volatile("s_waitcnt vmcnt(0)" ::: "memory");
    __syncthreads();
    if (xb_thread0(b.wv)) {
        unsigned* bar = b.bar;
        __builtin_amdgcn_s_waitcnt(0);
        unsigned nloc = b.st[0], nx = b.st[1];
        if (nloc == 0u) { xcd_barrier_complete(bar, b.x, nloc, nx); b.st[0] = nloc; b.st[1] = nx; }
        const unsigned old = xb_add(&bar[XB_XSUB(b.x)], 1u);
        const unsigned gen = old / nloc;
        if (old + 1u == (gen + 1u) * nloc) {
            __builtin_amdgcn_fence(__ATOMIC_RELEASE, "agent");
            asm volatile("s_waitcnt vmcnt(0)" ::: "memory");
            const unsigned og = xb_add(&bar[XB_TOP], 1u);
            const unsigned tg = og / nx;
            if (og + 1u == (tg + 1u) * nx) xb_add(&bar[XB_TOPGEN], 1u);
            else XB_SPIN(xb_ld(&bar[XB_TOPGEN]) == tg, bar);
            __builtin_amdgcn_fence(__ATOMIC_ACQUIRE, "agent");
            xb_add(&bar[XB_XGEN(b.x)], 1u);
            asm volatile("s_waitcnt vmcnt(0)" ::: "memory");
        } else {
            XB_SPIN(xb_ld(&bar[XB_XGEN(b.x)]) == gen, bar);
            __builtin_amdgcn_fence(__ATOMIC_ACQUIRE, "agent");
            asm volatile("s_waitcnt vmcnt(0)" ::: "memory");
        }
    }
    __syncthreads();
}

namespace pg8 {
constexpr int BM = 256, BK = 64, HALF = 128, HTB = HALF * BK * 2, STAGE_BYTES = 8 * HTB;
__device__ __forceinline__ int lds_byte(int r, int c) { const int st = (r >> 4) * 2 + (c >> 5), rr = r & 15, cc = c & 31, ob = rr * 64 + cc * 2; return st * 1024 + (ob ^ (((ob >> 9) & 1) << 5)); }
__device__ __forceinline__ void stage_rc(int b, int& R, int& C) { const int st = b / 1024, sb = b % 1024, swz = sb ^ (((sb >> 9) & 1) << 5); R = (st >> 1) * 16 + swz / 64; C = (st & 1) * 32 + (swz % 64) / 2; }
__device__ __forceinline__ int perm32(int rho) { const int n = rho >> 4, i = rho & 15; return 8 * (i >> 2) + 4 * n + (i & 3); }
struct Unit { int pm, pn, aux; const char* A; const char* B; };
__device__ __forceinline__ unsigned cvt_pk_bf16(float lo, float hi) { return pk2(lo, hi); }

template <class Epi, class Sched, bool GATHER = false>
__device__ __forceinline__ void gemm_phase(LAS unsigned char* lds, const int tid_in, const int K, const int lda, const int ldb, const Sched& S, const Epi& E, const LAS unsigned* gtab = nullptr) {
    int tid_ = tid_in; asm volatile("" : "+v"(tid_));
    const int tid = tid_, wid = __builtin_amdgcn_readfirstlane(tid >> 6), lane = tid & 63, wr = wid >> 2, wc = wid & 3, fr = lane & 15, fq = lane >> 4;
    const int nt = K / BK;
    unsigned voffA[2], voffB[2];
#pragma unroll
    for (int i = 0; i < 2; ++i) { int R, C; stage_rc(tid * 16 + i * 8192, R, C); const int Rb = Epi::PERM ? ((R & ~31) + perm32(R & 31)) : R;
        voffA[i] = (unsigned)(R * lda + C) * 2u; voffB[i] = (unsigned)(Rb * ldb + C) * 2u; }
    const size_t kstep = (size_t)(BK * 2);
    const size_t hstepA = GATHER ? (size_t)0 : (size_t)HALF * lda * 2, hstepB = (size_t)HALF * ldb * 2;
    int gR[2], gC[2]; unsigned gcur[2][2], gnxt[2][2];
    if constexpr (GATHER) {
#pragma unroll
        for (int i = 0; i < 2; ++i) { int R, C; stage_rc(tid * 16 + i * 8192, R, C); gR[i] = R; gC[i] = C * 2; }
    }
#define PG8_GLOAD(dst, u_) do { _Pragma("unroll") for (int _h = 0; _h < 2; ++_h) _Pragma("unroll") for (int _i = 0; _i < 2; ++_i) dst[_h][_i] = gtab[(u_) * 256 + _h * 128 + gR[_i]] + (unsigned)gC[_i]; } while (0)
    const unsigned ldsw = (unsigned)wid * 1024u;
    const int aoff = lds_byte(wr * 64 + fr, fq * 8), boff = lds_byte(wc * 32 + fr, fq * 8);
#define PG8_SA(b, h) (((b) * 2 + (h)) * HTB)
#define PG8_SB(b, h) ((4 + (b) * 2 + (h)) * HTB)
#define PG8_STAGE(bufoff, gbase, voff) do { _Pragma("unroll") for (int _i = 0; _i < 2; ++_i) \
        __builtin_amdgcn_global_load_lds((const unsigned*)((const char*)(gbase) + (voff)[_i]), (LAS unsigned*)(lds + (bufoff) + ldsw + _i * 8192), 16, 0, 0); } while (0)
#define PG8_STAGEA(bufoff, gbase, h, tab) do { if constexpr (GATHER) { PG8_STAGE(bufoff, gbase, tab[h]); } else { PG8_STAGE(bufoff, (gbase) + (h) * hstepA, voffA); } } while (0)
#define PG8_LDA(dst, b, h) do { _Pragma("unroll") for (int m = 0; m < 4; ++m) _Pragma("unroll") for (int k = 0; k < 2; ++k) dst[m][k] = *(const LAS bf16x8*)(lds + PG8_SA(b, h) + aoff + m * 2048 + k * 1024); } while (0)
#define PG8_LDB(dst, b, h) do { _Pragma("unroll") for (int n = 0; n < 2; ++n) _Pragma("unroll") for (int k = 0; k < 2; ++k) dst[n][k] = *(const LAS bf16x8*)(lds + PG8_SB(b, h) + boff + n * 2048 + k * 1024); } while (0)
#define PG8_MMA(ai, bj, At, Bt) do { __builtin_amdgcn_s_setprio(1); _Pragma("unroll") for (int m = 0; m < 4; ++m) _Pragma("unroll") for (int n = 0; n < 2; ++n) _Pragma("unroll") for (int k = 0; k < 2; ++k) \
        acc[ai][bj][m][n] = __builtin_amdgcn_mfma_f32_16x16x32_bf16(Bt[n][k], At[m][k], acc[ai][bj][m][n], 0, 0, 0); __builtin_amdgcn_s_setprio(0); } while (0)
#define PG8_WAIT_V(n) asm volatile("s_waitcnt vmcnt(" #n ")" ::: "memory")
#define PG8_WAIT_L(n) asm volatile("s_waitcnt lgkmcnt(" #n ")" ::: "memory")
#define PG8_BAR __builtin_amdgcn_s_barrier()
#define PG8_SCHED __builtin_amdgcn_sched_barrier(0)
    Unit cur, nxt; int ui = 0;
    if (!S.next(0, cur)) return;
    f32x4 acc[2][2][4][2];
#pragma unroll
    for (int a = 0; a < 2; ++a)
#pragma unroll
        for (int b = 0; b < 2; ++b)
#pragma unroll
            for (int m = 0; m < 4; ++m)
#pragma unroll
                for (int n = 0; n < 2; ++n) acc[a][b][m][n] = (f32x4){0.f, 0.f, 0.f, 0.f};
    bf16x8 At[4][2], B0[2][2], B1[2][2];
    const char* cA = cur.A; const char* cB = cur.B;
    if constexpr (GATHER) { PG8_GLOAD(gcur, 0); PG8_GLOAD(gnxt, 1); asm volatile("s_waitcnt lgkmcnt(0)" ::: "memory"); }
    PG8_STAGE(PG8_SB(0, 0), cB, voffB); PG8_STAGE(PG8_SB(0, 1), cB + hstepB, voffB); PG8_STAGEA(PG8_SA(0, 0), cA, 0, gcur); PG8_STAGEA(PG8_SA(0, 1), cA, 1, gcur);
    if (wr == 1) PG8_BAR;
    PG8_WAIT_V(2); PG8_BAR;
    PG8_STAGE(PG8_SB(1, 0), cB + kstep, voffB); PG8_STAGEA(PG8_SA(1, 0), cA + kstep, 0, gcur); PG8_STAGE(PG8_SB(1, 1), cB + hstepB + kstep, voffB);
    PG8_WAIT_V(6); PG8_BAR;
#pragma unroll 1
    for (;;) {
        const bool has_next = S.next(ui + 1, nxt);
        const char* nA = has_next ? nxt.A : cA; const char* nB = has_next ? nxt.B : cB;
#pragma unroll 1
        for (int t = 0; t < nt; t += 2) {
            const bool last = (t == nt - 2);
            const char* a1 = cA + (size_t)(t + 1) * kstep;
            const char* a2 = last ? nA : cA + (size_t)(t + 2) * kstep; const char* b2 = last ? nB : cB + (size_t)(t + 2) * kstep;
            const char* a3 = a2 + kstep; const char* b3 = b2 + kstep;
            unsigned g2[2][2];
            if constexpr (GATHER) {
#pragma unroll
                for (int _h = 0; _h < 2; ++_h)
#pragma unroll
                    for (int _i = 0; _i < 2; ++_i) g2[_h][_i] = last ? gnxt[_h][_i] : gcur[_h][_i]; }
            PG8_LDB(B0, 0, 0); PG8_LDB(B1, 0, 1); PG8_SCHED; PG8_LDA(At, 0, 0); PG8_STAGEA(PG8_SA(1, 1), a1, 1, gcur);
            PG8_WAIT_V(8); PG8_WAIT_L(0); PG8_BAR; PG8_MMA(0, 0, At, B0); PG8_MMA(0, 1, At, B1); PG8_BAR; PG8_SCHED;
            PG8_LDA(At, 0, 1); PG8_STAGE(PG8_SB(0, 0), b2, voffB); PG8_STAGE(PG8_SB(0, 1), b2 + hstepB, voffB); PG8_STAGEA(PG8_SA(0, 0), a2, 0, g2);
            PG8_WAIT_V(8); PG8_WAIT_L(0); PG8_BAR; PG8_MMA(1, 0, At, B0); PG8_MMA(1, 1, At, B1); PG8_BAR; PG8_SCHED;
            PG8_LDB(B0, 1, 0); PG8_LDB(B1, 1, 1); PG8_SCHED; PG8_LDA(At, 1, 0); PG8_STAGEA(PG8_SA(0, 1), a2, 1, g2);
            PG8_WAIT_V(8); PG8_WAIT_L(0); PG8_BAR; PG8_MMA(0, 0, At, B0); PG8_MMA(0, 1, At, B1); PG8_BAR; PG8_SCHED;
            PG8_LDA(At, 1, 1); PG8_STAGE(PG8_SB(1, 0), b3, voffB); PG8_STAGE(PG8_SB(1, 1), b3 + hstepB, voffB); PG8_STAGEA(PG8_SA(1, 0), a3, 0, g2);
            PG8_WAIT_V(8); PG8_WAIT_L(0); PG8_BAR; PG8_MMA(1, 0, At, B0); PG8_MMA(1, 1, At, B1); PG8_BAR; PG8_SCHED;
        }
        if (wr == 0) PG8_BAR;
        E(acc, cur, wr, wc, fr, fq);
        if (!has_next) break;
#pragma unroll
        for (int a = 0; a < 2; ++a)
#pragma unroll
            for (int b = 0; b < 2; ++b)
#pragma unroll
                for (int m = 0; m < 4; ++m)
#pragma unroll
                    for (int n = 0; n < 2; ++n) acc[a][b][m][n] = (f32x4){0.f, 0.f, 0.f, 0.f};
        cur = nxt; cA = nA; cB = nB; ++ui;
        if constexpr (GATHER) {
#pragma unroll
            for (int _h = 0; _h < 2; ++_h)
#pragma unroll
                for (int _i = 0; _i < 2; ++_i) gcur[_h][_i] = gnxt[_h][_i];
            PG8_GLOAD(gnxt, ui + 1); }
        if (wr == 1) PG8_BAR;
    }
    PG8_WAIT_V(0);
    PG8_BAR;
#undef PG8_SA
#undef PG8_SB
#undef PG8_STAGE
#undef PG8_STAGEA
#undef PG8_GLOAD
#undef PG8_LDA
#undef PG8_LDB
#undef PG8_MMA
#undef PG8_WAIT_V
#undef PG8_WAIT_L
#undef PG8_BAR
#undef PG8_SCHED
}
}
constexpr int NWAVES = 8, NTHR = 512;
constexpr int RING_BYTES = 131072, LDS_BYTES = 147456, LDSCTL_OFF = LDS_BYTES - 2048;
struct Params { const float* in[29]; float* out; unsigned char* ws; };
struct Frame {
    LAS unsigned char* lds; int tid, lane, wave, blk, G, vcu, gw, ngw; unsigned char* ws;
};
enum { I_X = 0, I_POS, I_ANORM, I_WIN, I_MU, I_W0, I_W2, I_A0, I_A2, I_G2, I_KK, I_KA, I_RK, I_LNX, I_QNORM, I_WQB, I_KVNORM, I_WKVB, I_WBR, I_WO, I_FNORM,
       I_FG, I_FU, I_FD, I_ROUTER, I_MG, I_MU2, I_MD, I_FINAL };

struct SchedGrid {
    int nM, nN, nwg, G, c; const char* A; const char* B; size_t astep, bstep;
    __device__ void init(int nM_, int nN_, int G_, int c_, const void* A_, size_t astep_, const void* B_, size_t bstep_) { nM = nM_; nN = nN_; nwg = nM * nN; G = G_; c = c_; A = (const char*)A_; B = (const char*)B_; astep = astep_; bstep = bstep_; }
    __device__ __forceinline__ bool next(int i, pg8::Unit& u) const {
        const long L = (long)i * G + c; if (L >= nwg) return false;
        int wgid = (int)L; { const int q = nwg / 8, r = nwg % 8, xcd = wgid % 8, off = wgid / 8; wgid = (xcd < r ? xcd * (q + 1) : r * (q + 1) + (xcd - r) * q) + off; }
        const int nig = 8 * nN, gid = wgid / nig, fm = gid * 8, gsz = (nM - fm) < 8 ? (nM - fm) : 8;
        u.pm = fm + ((wgid % nig) % gsz); u.pn = (wgid % nig) / gsz; u.aux = 0;
        u.A = A + (size_t)u.pm * astep; u.B = B + (size_t)u.pn * bstep; return true;
    }
};
struct SchedSmall {
    int G, c, layer; const char* ws;
    __device__ __forceinline__ bool next(int i, pg8::Unit& u) const {
        int L = i * G + c; if (L >= 448) return false;
        int s = 0; if (L >= 192) { L -= 192; s = 1; if (L >= 128) { L -= 128; s = 2; } }
        const int nn = s == 0 ? 3 : (s == 1 ? 2 : 64);
        u.pm = L / nn; u.pn = L % nn; u.aux = s;
        const size_t lw = (size_t)layer * 256 * 2;
        const size_t ao = s == 0 ? WS_QN : (s == 1 ? WS_CN : WS_VB + lw * 512), bo = s == 0 ? WS_QB + lw * 768 : (s == 1 ? WS_KB + lw * 512 : WS_CN);
        u.A = ws + ao + (size_t)u.pm * (256 * 256 * 2); u.B = ws + bo + (size_t)u.pn * (256 * 256 * 2); return true;
    }
};
struct SchedOwn3 {
    int c, G; const char* A; const char* B; size_t astep, bstep, a_n, b_n;
    __device__ __forceinline__ bool next(int i, pg8::Unit& u) const {
        const int t = c + (i / 3) * G; if (t >= 256) return false;
        const int n = i % 3; u.pm = t >> 2; u.pn = t & 3; u.aux = n; u.A = A + (size_t)u.pm * astep + (size_t)n * a_n; u.B = B + (size_t)u.pn * bstep + (size_t)n * b_n; return true;
    }
};
struct SchedMoe {
    int G, c, ncol, ntile; const LAS int* tab; const char* A; const char* B; size_t astep, bstep, estep;
    __device__ __forceinline__ bool next(int i, pg8::Unit& u) const {
        const int L = i * G + c; if (L >= ntile * ncol) return false;
        u.pm = L / ncol; u.pn = L % ncol; const int e = tab[u.pm]; u.aux = e;
        u.A = A + (size_t)u.pm * astep; u.B = B + (size_t)e * estep + (size_t)u.pn * bstep; return true;
    }
};

using pg8::Unit; using pg8::cvt_pk_bf16;
#define EPI_ARGS const f32x4 (&acc)[2][2][4][2], const Unit& u, int wr, int wc, int fr, int fq
__device__ __forceinline__ float row_rstd(const float* SS, int row) {
    const f32x4* s = (const f32x4*)(SS + (size_t)row * 16); const f32x4 a = s[0], b = s[1], c = s[2], d = s[3];
    const float t = ((a.x + a.y) + (a.z + a.w)) + ((b.x + b.y) + (b.z + b.w)) + ((c.x + c.y) + (c.z + c.w)) + ((d.x + d.y) + (d.z + d.w));
    return rsqrtf(t * (1.0f / DM) + NORM_EPS);
}
__device__ __forceinline__ void panel_rstd(const float* SS, int pm, int tid, LAS float* rl) {
    if (tid < 256) rl[tid] = row_rstd(SS, pm * 256 + tid);
    asm volatile("s_waitcnt lgkmcnt(0)" ::: "memory"); __builtin_amdgcn_s_barrier(); asm volatile("" ::: "memory");
}
struct EpiStore {
    static constexpr bool PERM = true;
    bf16_t* O; int ld; const float* SS; LAS float* rl; int tid;
    __device__ __forceinline__ void operator()(EPI_ARGS) const {
        const int row0 = u.pm * 256 + wr * 64 + fr, col0 = u.pn * 256 + wc * 32 + 8 * fq;
        if (SS) panel_rstd(SS, u.pm, tid, rl);
#pragma unroll
        for (int ai = 0; ai < 2; ++ai)
#pragma unroll
            for (int m = 0; m < 4; ++m) { bf16_t* rowp = O + (size_t)(row0 + ai * 128 + m * 16) * ld + col0; const float rs = SS ? rl[wr * 64 + fr + ai * 128 + m * 16] : 1.0f;
#pragma unroll
                for (int bj = 0; bj < 2; ++bj) { const f32x4 v0 = acc[ai][bj][m][0] * rs, v1 = acc[ai][bj][m][1] * rs;
                    u32x4 w; w.x = cvt_pk_bf16(v0[0], v0[1]); w.y = cvt_pk_bf16(v0[2], v0[3]); w.z = cvt_pk_bf16(v1[0], v1[1]); w.w = cvt_pk_bf16(v1[2], v1[3]);
                    *(u32x4*)(rowp + bj * 128) = w; } }
    }
};
struct EpiSmall {
    static constexpr bool PERM = true;
    unsigned char* ws;
    __device__ __forceinline__ void operator()(EPI_ARGS) const {
        bf16_t* base = (bf16_t*)(ws + (u.aux == 0 ? WS_Q : (u.aux == 1 ? WS_KN : WS_VT))); const int ld = u.aux == 0 ? 768 : (u.aux == 1 ? 512 : MTOK);
        const int row0 = u.pm * 256 + wr * 64 + fr, col0 = u.pn * 256 + wc * 32 + 8 * fq;
#pragma unroll
        for (int ai = 0; ai < 2; ++ai)
#pragma unroll
            for (int m = 0; m < 4; ++m) { bf16_t* rowp = base + (size_t)(row0 + ai * 128 + m * 16) * ld + col0;
#pragma unroll
                for (int bj = 0; bj < 2; ++bj) { const f32x4 v0 = acc[ai][bj][m][0], v1 = acc[ai][bj][m][1];
                    u32x4 w; w.x = cvt_pk_bf16(v0[0], v0[1]); w.y = cvt_pk_bf16(v0[2], v0[3]); w.z = cvt_pk_bf16(v1[0], v1[1]); w.w = cvt_pk_bf16(v1[2], v1[3]);
                    *(u32x4*)(rowp + bj * 128) = w; } }
    }
};
struct EpiLora {
    static constexpr bool PERM = true;
    bf16_t* O; const float* w0; const float* a0;
    __device__ __forceinline__ void operator()(EPI_ARGS) const {
        const int seg = u.pn >> 1;
        const int row0 = u.pm * 256 + wr * 64 + fr, col0 = u.pn * 256 + wc * 32 + 8 * fq, ch0 = (u.pn & 1) * 256 + wc * 32 + 8 * fq;
        const float* bias = seg == 0 ? w0 : a0; const float sc = seg == 0 ? -0.6065306597126334f : 1.0f;
#pragma unroll
        for (int bj = 0; bj < 2; ++bj) {
            f32x4 b0 = {0.f, 0.f, 0.f, 0.f}, b1 = {0.f, 0.f, 0.f, 0.f};
            if (seg < 2) { b0 = *(const f32x4*)(bias + ch0 + bj * 128); b1 = *(const f32x4*)(bias + ch0 + bj * 128 + 4); }
#pragma unroll
            for (int ai = 0; ai < 2; ++ai)
#pragma unroll
                for (int m = 0; m < 4; ++m) { bf16_t* rowp = O + (size_t)(row0 + ai * 128 + m * 16) * LO_W + col0 + bj * 128;
                    f32x4 v0 = acc[ai][bj][m][0] + b0, v1 = acc[ai][bj][m][1] + b1;
                    if (seg < 2) {
#pragma unroll
                        for (int j = 0; j < 4; ++j) { v0[j] = sc * sigmoidf_(v0[j]); v1[j] = sc * sigmoidf_(v1[j]); }
                    }
                    u32x4 w; w.x = cvt_pk_bf16(v0[0], v0[1]); w.y = cvt_pk_bf16(v0[2], v0[3]); w.z = cvt_pk_bf16(v1[0], v1[1]); w.w = cvt_pk_bf16(v1[2], v1[3]);
                    *(u32x4*)rowp = w; }
        }
    }
};
struct EpiGate {
    static constexpr bool PERM = true;
    bf16_t* O; const float* SS; LAS float* rl; int tid;
    __device__ __forceinline__ void operator()(EPI_ARGS) const {
        const int row0 = u.pm * 256 + wr * 64 + fr, col0 = u.aux * 1024 + u.pn * 256 + wc * 32 + 8 * fq;
        panel_rstd(SS, u.pm, tid, rl);
#pragma unroll
        for (int ai = 0; ai < 2; ++ai)
#pragma unroll
            for (int m = 0; m < 4; ++m) { bf16_t* rowp = O + (size_t)(row0 + ai * 128 + m * 16) * 3072 + col0; const float rs = rl[wr * 64 + fr + ai * 128 + m * 16];
#pragma unroll
                for (int bj = 0; bj < 2; ++bj) { f32x4 v0 = acc[ai][bj][m][0] * rs, v1 = acc[ai][bj][m][1] * rs;
#pragma unroll
                    for (int j = 0; j < 4; ++j) { v0[j] = sigmoidf_(v0[j]); v1[j] = sigmoidf_(v1[j]); }
                    u32x4 w; w.x = cvt_pk_bf16(v0[0], v0[1]); w.y = cvt_pk_bf16(v0[2], v0[3]); w.z = cvt_pk_bf16(v1[0], v1[1]); w.w = cvt_pk_bf16(v1[2], v1[3]);
                    *(u32x4*)(rowp + bj * 128) = w; } }
    }
};
struct EpiMerge {
    static constexpr bool PERM = true;
    const bf16_t* Gt; bf16_t* Mg;
    __device__ __forceinline__ void operator()(EPI_ARGS) const {
        const int n = u.aux;
        const int row0 = u.pm * 256 + wr * 64 + fr, col0 = u.pn * 256 + wc * 32 + 8 * fq;
#pragma unroll
        for (int ai = 0; ai < 2; ++ai)
#pragma unroll
            for (int m = 0; m < 4; ++m) { const size_t r = (size_t)(row0 + ai * 128 + m * 16);
#pragma unroll
                for (int bj = 0; bj < 2; ++bj) { const f32x4 v0 = acc[ai][bj][m][0], v1 = acc[ai][bj][m][1];
                    const u32x4 g = *(const u32x4*)(Gt + r * 3072 + n * 1024 + col0 + bj * 128);
                    float o[8] = {bflo(g.x) * v0[0], bfhi(g.x) * v0[1], bflo(g.y) * v0[2], bfhi(g.y) * v0[3], bflo(g.z) * v1[0], bfhi(g.z) * v1[1], bflo(g.w) * v1[2], bfhi(g.w) * v1[3]};
                    bf16_t* mp = Mg + r * 1024 + col0 + bj * 128;
                    if (n > 0) { const u32x4 p = *(const u32x4*)mp; o[0] += bflo(p.x); o[1] += bfhi(p.x); o[2] += bflo(p.y); o[3] += bfhi(p.y); o[4] += bflo(p.z); o[5] += bfhi(p.z); o[6] += bflo(p.w); o[7] += bfhi(p.w); }
                    u32x4 w; w.x = cvt_pk_bf16(o[0], o[1]); w.y = cvt_pk_bf16(o[2], o[3]); w.z = cvt_pk_bf16(o[4], o[5]); w.w = cvt_pk_bf16(o[6], o[7]);
                    *(u32x4*)mp = w; } }
    }
};
constexpr int HLD = 2 * DM;
template <bool EMIT, bool IN_F32>
struct EpiResid {
    static constexpr bool PERM = true;
    const void* In; bf16_t* Out; const float* gain; bf16_t* Hg; float* SS;
    __device__ __forceinline__ void operator()(EPI_ARGS) const {
        const int row0 = u.pm * 256 + wr * 64 + fr, col0 = u.pn * 256 + wc * 32 + 8 * fq;
        f32x4 gv[2][2];
        if (EMIT) {
#pragma unroll
            for (int bj = 0; bj < 2; ++bj)
#pragma unroll
                for (int n = 0; n < 2; ++n) gv[bj][n] = *(const f32x4*)(gain + col0 + bj * 128 + n * 4); }
#pragma unroll
        for (int ai = 0; ai < 2; ++ai)
#pragma unroll
            for (int m = 0; m < 4; ++m) { const int row = row0 + ai * 128 + m * 16; float sq = 0.f;
#pragma unroll
                for (int bj = 0; bj < 2; ++bj) { const int col = col0 + bj * 128; f32x4 x0, x1;
                    if (IN_F32) { const float* ip = (const float*)In + (size_t)row * DM + col; x0 = *(const f32x4*)ip; x1 = *(const f32x4*)(ip + 4); }
                    else { const u32x4 p = *(const u32x4*)((const bf16_t*)In + (size_t)row * HLD + col); x0 = (f32x4){bflo(p.x), bfhi(p.x), bflo(p.y), bfhi(p.y)}; x1 = (f32x4){bflo(p.z), bfhi(p.z), bflo(p.w), bfhi(p.w)}; }
                    x0 += acc[ai][bj][m][0]; x1 += acc[ai][bj][m][1];
                    u32x4 w; w.x = cvt_pk_bf16(x0[0], x0[1]); w.y = cvt_pk_bf16(x0[2], x0[3]); w.z = cvt_pk_bf16(x1[0], x1[1]); w.w = cvt_pk_bf16(x1[2], x1[3]);
                    *(u32x4*)(Out + (size_t)row * HLD + col) = w;
                    if (EMIT) { sq += ((x0[0] * x0[0] + x0[1] * x0[1]) + (x0[2] * x0[2] + x0[3] * x0[3])) + ((x1[0] * x1[0] + x1[1] * x1[1]) + (x1[2] * x1[2] + x1[3] * x1[3]));
                        const f32x4 y0 = x0 * gv[bj][0], y1 = x1 * gv[bj][1];
                        u32x4 g; g.x = cvt_pk_bf16(y0[0], y0[1]); g.y = cvt_pk_bf16(y0[2], y0[3]); g.z = cvt_pk_bf16(y1[0], y1[1]); g.w = cvt_pk_bf16(y1[2], y1[3]);
                        *(u32x4*)(Hg + (size_t)row * DM + col) = g; } }
                if (EMIT) { sq += __shfl_xor(sq, 16); sq += __shfl_xor(sq, 32); if (fq == 0) SS[(size_t)row * 16 + u.pn * 4 + wc] = sq; } }
    }
};
struct EpiSwiglu {
    static constexpr bool PERM = true;
    bf16_t* O; int ldc; int pn_off; const float* SS; LAS float* rl; int tid;
    __device__ __forceinline__ void operator()(EPI_ARGS) const {
        const int row0 = u.pm * 256 + wr * 64 + fr, col0 = (u.pn - pn_off) * 128 + wc * 32 + 8 * fq;
        if (SS) panel_rstd(SS, u.pm, tid, rl);
#pragma unroll
        for (int ai = 0; ai < 2; ++ai)
#pragma unroll
            for (int m = 0; m < 4; ++m) { bf16_t* rowp = O + (size_t)(row0 + ai * 128 + m * 16) * ldc + col0; const float rs = SS ? rl[wr * 64 + fr + ai * 128 + m * 16] : 1.0f;
                float o[8];
#pragma unroll
                for (int n = 0; n < 2; ++n)
#pragma unroll
                    for (int j = 0; j < 4; ++j) { const float g = acc[ai][0][m][n][j] * rs, up = acc[ai][1][m][n][j] * rs; o[n * 4 + j] = g * sigmoidf_(g) * up; }
                u32x4 w; w.x = cvt_pk_bf16(o[0], o[1]); w.y = cvt_pk_bf16(o[2], o[3]); w.z = cvt_pk_bf16(o[4], o[5]); w.w = cvt_pk_bf16(o[6], o[7]);
                *(u32x4*)rowp = w; }
    }
};
template <bool ACCUM>
struct EpiMoeOut {
    static constexpr bool PERM = true;
    const float* row_w; bf16_t* O;
    __device__ __forceinline__ void operator()(EPI_ARGS) const {
        const int row0 = u.pm * 256 + wr * 64 + fr, col0 = u.pn * 256 + wc * 32 + 8 * fq;
#pragma unroll
        for (int ai = 0; ai < 2; ++ai)
#pragma unroll
            for (int m = 0; m < 4; ++m) { const int r = row0 + ai * 128 + m * 16; const float wt = row_w[r]; bf16_t* rowp = O + (size_t)r * DM + col0;
#pragma unroll
                for (int bj = 0; bj < 2; ++bj) { f32x4 v0 = acc[ai][bj][m][0] * wt, v1 = acc[ai][bj][m][1] * wt;
                    if (ACCUM) { const u32x4 p = *(const u32x4*)(rowp + bj * 128); v0[0] += bflo(p.x); v0[1] += bfhi(p.x); v0[2] += bflo(p.y); v0[3] += bfhi(p.y); v1[0] += bflo(p.z); v1[1] += bfhi(p.z); v1[2] += bflo(p.w); v1[3] += bfhi(p.w); }
                    u32x4 w; w.x = cvt_pk_bf16(v0[0], v0[1]); w.y = cvt_pk_bf16(v0[2], v0[3]); w.z = cvt_pk_bf16(v1[0], v1[1]); w.w = cvt_pk_bf16(v1[2], v1[3]);
                    *(u32x4*)(rowp + bj * 128) = w; } }
    }
};

__device__ __forceinline__ void transpose_tile64(const float* W, int ldn, int k0, int n0, bf16_t* WT, int ldk, int drow0, int drow1, int dk0, LAS float* scr, int lane) {
#ifdef SIMPLE_TR
    { const int c = lane & 7;
      for (int j = 0; j < 8; ++j) { const int n = (lane >> 3) + 8 * j; const float* s = W + (size_t)(k0 + 8 * c) * ldn + n0 + n;
        u32x4 o; o.x = pk2(s[0], s[(size_t)ldn]); o.y = pk2(s[(size_t)2 * ldn], s[(size_t)3 * ldn]); o.z = pk2(s[(size_t)4 * ldn], s[(size_t)5 * ldn]); o.w = pk2(s[(size_t)6 * ldn], s[(size_t)7 * ldn]);
        const int dr = n < 32 ? drow0 + n : drow1 + (n - 32);
        *(u32x4*)(WT + (size_t)dr * ldk + dk0 + k0 + 8 * c) = o; }
      return; }
#endif
    f32x4 v[16]; const int r4 = lane >> 4, c4 = (lane & 15) * 4;
#pragma unroll
    for (int i = 0; i < 16; ++i) v[i] = *(const f32x4*)(W + (size_t)(k0 + 4 * i + r4) * ldn + n0 + c4);
#pragma unroll
    for (int i = 0; i < 16; ++i) { LAS float* d = scr + (4 * i + r4) * 65 + c4; d[0] = v[i][0]; d[1] = v[i][1]; d[2] = v[i][2]; d[3] = v[i][3]; }
    LDS_WAIT(); asm volatile("" ::: "memory");
    const int c = lane & 7;
#pragma unroll
    for (int j = 0; j < 8; ++j) { const int n = (lane >> 3) + 8 * j; const LAS float* s = scr + (8 * c) * 65 + n;
        u32x4 o; o.x = pk2(s[0 * 65], s[1 * 65]); o.y = pk2(s[2 * 65], s[3 * 65]); o.z = pk2(s[4 * 65], s[5 * 65]); o.w = pk2(s[6 * 65], s[7 * 65]);
        const int dr = n < 32 ? drow0 + n : drow1 + (n - 32);
        *(u32x4*)(WT + (size_t)dr * ldk + dk0 + k0 + 8 * c) = o; }
    LDS_WAIT(); asm volatile("" ::: "memory");
}
__device__ __forceinline__ void conv_plain(const float* W, int K, int N, bf16_t* WT, int ldk, int item, LAS float* scr, int lane) {
    const int nblk = N / 64, kb = item / nblk, nb = item % nblk;
    transpose_tile64(W, N, kb * 64, nb * 64, WT, ldk, nb * 64, nb * 64 + 32, 0, scr, lane);
}
__device__ __forceinline__ int win_drow(int n0) { return n0 < 3872 ? n0 : (n0 < 4128 ? 4096 + (n0 - 3872) : (n0 < 4288 ? 4352 + (n0 - 4128) : 4608 + (n0 - 4288))); }
__device__ __forceinline__ int gu_drow(int n0, int up) { return (n0 >> 7) * 256 + (n0 & 127) + up * 128; }

struct TrD { const float* src; bf16_t* d0; bf16_t* d1; int ldn, ldk; };
__device__ __forceinline__ TrD tr_desc(const float* W, int ldn, int k0, int n0, bf16_t* WT, int ldk, int drow0, int drow1, int dk0) {
    TrD d; d.src = W + (size_t)k0 * ldn + n0; d.ldn = ldn; d.ldk = ldk; d.d0 = WT + (size_t)drow0 * ldk + dk0 + k0; d.d1 = WT + (size_t)drow1 * ldk + dk0 + k0; return d;
}
__device__ __forceinline__ void tr_load(f32x4 (&v)[16], const TrD& d, int lane) {
    const float* s = d.src + (size_t)(lane >> 4) * d.ldn + (lane & 15) * 4;
#pragma unroll
    for (int i = 0; i < 16; ++i) v[i] = *(const f32x4*)(s + (size_t)(4 * i) * d.ldn);
}
__device__ __forceinline__ void tr_store(const f32x4 (&v)[16], const TrD& d, LAS float* scr, int lane) {
    const int r4 = lane >> 4, c4 = (lane & 15) * 4;
#pragma unroll
    for (int i = 0; i < 16; ++i) { LAS float* q = scr + (4 * i + r4) * 65 + c4; q[0] = v[i][0]; q[1] = v[i][1]; q[2] = v[i][2]; q[3] = v[i][3]; }
    LDS_WAIT(); asm volatile("" ::: "memory");
    const int c = lane & 7;
#pragma unroll
    for (int j = 0; j < 8; ++j) { const int n = (lane >> 3) + 8 * j; const LAS float* s = scr + (8 * c) * 65 + n;
        u32x4 o; o.x = pk2(s[0 * 65], s[1 * 65]); o.y = pk2(s[2 * 65], s[3 * 65]); o.z = pk2(s[4 * 65], s[5 * 65]); o.w = pk2(s[6 * 65], s[7 * 65]);
        bf16_t* dr = n < 32 ? d.d0 + (size_t)n * d.ldk : d.d1 + (size_t)(n - 32) * d.ldk;
        *(u32x4*)(dr + 8 * c) = o; }
    LDS_WAIT(); asm volatile("" ::: "memory");
}
__device__ __forceinline__ TrD desc_plain(const float* W, int K, int N, bf16_t* WT, int ldk, int item) {
    const int nblk = N / 64, kb = item / nblk, nb = item % nblk; (void)K;
    return tr_desc(W, N, kb * 64, nb * 64, WT, ldk, nb * 64, nb * 64 + 32, 0);
}
#define TR_PIPE(DESC, IT0, STEP, NT, TAIL, SCR, LANE) do { \
    f32x4 v_[2][16]; TrD d_[2]; const int i0_ = (IT0), st_ = (STEP); const bool tail_ = (TAIL); \
    d_[0] = DESC(i0_); tr_load(v_[0], d_[0], LANE); \
    _Pragma("unroll") for (int k_ = 0; k_ < (NT); ++k_) { \
        if (k_ + 1 < (NT) || tail_) { d_[(k_ + 1) & 1] = DESC(i0_ + (k_ + 1) * st_); tr_load(v_[(k_ + 1) & 1], d_[(k_ + 1) & 1], LANE); } \
        asm volatile("" ::: "memory"); \
        tr_store(v_[k_ & 1], d_[k_ & 1], SCR, LANE); } \
    if (tail_) tr_store(v_[(NT) & 1], d_[(NT) & 1], SCR, LANE); } while (0)
namespace pro {
constexpr int I_IN = 16 * 115, I_QB = 4 * 12, I_BRn = 8 * 16, I_WOn = 16 * 16, I_G = 16 * 44, I_D = 44 * 16;
constexpr int NIT = NLAYER * (I_IN + I_QB + 3 * I_BRn + I_WOn) + 2 * I_G + I_D;
}
__device__ __forceinline__ TrD pro_desc(const Params& P, unsigned char* ws, int it) {
    using namespace pro;
    int r = it;
    if (r < NLAYER * I_IN) { const int l = r / I_IN; r %= I_IN; const int kb = r / 115, nb = r % 115;
        return tr_desc(P.in[I_WIN] + (size_t)l * DM * IN_COLS, IN_COLS, kb * 64, nb * 64, (bf16_t*)(ws + WS_WIN) + (size_t)l * WIN_ROWS * DM, DM, win_drow(nb * 64), win_drow(nb * 64 + 32), 0); }
    r -= NLAYER * I_IN;
    if (r < NLAYER * I_QB) { const int l = r / I_QB; r %= I_QB; return desc_plain(P.in[I_WQB] + (size_t)l * 256 * 768, 256, 768, (bf16_t*)(ws + WS_QB) + (size_t)l * 768 * 256, 256, r); }
    r -= NLAYER * I_QB;
    if (r < NLAYER * 3 * I_BRn) { const int ln = r / I_BRn; r %= I_BRn; return desc_plain(P.in[I_WBR] + (size_t)ln * 512 * 1024, 512, 1024, (bf16_t*)(ws + WS_BR) + (size_t)ln * 1024 * 512, 512, r); }
    r -= NLAYER * 3 * I_BRn;
    if (r < NLAYER * I_WOn) { const int l = r / I_WOn; r %= I_WOn; return desc_plain(P.in[I_WO] + (size_t)l * DM * DM, DM, DM, (bf16_t*)(ws + WS_WO) + (size_t)l * DM * DM, DM, r); }
    r -= NLAYER * I_WOn;
    if (r < 2 * I_G) { const int up = r / I_G; r %= I_G; const int kb = r / 44, nb = r % 44;
        return tr_desc(up ? P.in[I_FU] : P.in[I_FG], DFF, kb * 64, nb * 64, (bf16_t*)(ws + WS_FGU), DM, gu_drow(nb * 64, up), gu_drow(nb * 64 + 32, up), 0); }
    r -= 2 * I_G;
    return desc_plain(P.in[I_FD], DFF, DM, (bf16_t*)(ws + WS_FD), DFF, r);
}

#define PRO_DESC_(x) pro_desc(P, ws, (x))
template <int NT>
__device__ __forceinline__ void pro_tiles(const Frame& F, const Params& P, int lo, int w0, int nw, int tail) {
    LAS float* scr = (LAS float*)(F.lds + F.wave * 16640);
    unsigned char* ws = F.ws;
    if constexpr (NT == 0) { if (w0 < tail) { f32x4 v[16]; const TrD d = pro_desc(P, ws, lo + w0); tr_load(v, d, F.lane); tr_store(v, d, scr, F.lane); } }
    else TR_PIPE(PRO_DESC_, lo + w0, nw, NT, w0 < tail, scr, F.lane);
}
__device__ __forceinline__ void pro_small(const Frame& F, const Params& P, int gt, int ngt, int vb0, int nvb) {
    unsigned char* ws = F.ws;
    for (int i = gt; i < NLAYER * 3 * 48 * 512; i += ngt) { const int c = i & 511; int r = i >> 9; const int k = 8 * (r % 48); r /= 48; const int seg = r % 3, l = r / 3;
        const float* src = nullptr;
        if (seg == 0 && k < 64) src = P.in[I_W2] + ((size_t)l * 64 + k) * 512 + c;
        else if (seg == 1 && k >= 64 && k < 128) src = P.in[I_A2] + ((size_t)l * 64 + (k - 64)) * 512 + c;
        else if (seg == 2 && k >= 128 && k < 288) src = P.in[I_G2] + ((size_t)l * 160 + (k - 128)) * 512 + c;
        const bool live = src != nullptr; if (!live) src = P.in[I_W2] + c;
        float v[8];
#pragma unroll
        for (int q = 0; q < 8; ++q) v[q] = src[q * 512];
#pragma unroll
        for (int q = 0; q < 8; ++q) v[q] = live ? v[q] : 0.f;
        u32x4 o; o.x = pk2(v[0], v[1]); o.y = pk2(v[2], v[3]); o.z = pk2(v[4], v[5]); o.w = pk2(v[6], v[7]);
        *(u32x4*)((bf16_t*)(ws + WS_LORA) + ((size_t)l * 1536 + seg * 512 + c) * 384 + k) = o; }
    for (int i = gt; i < NLAYER * 32 * 512; i += ngt) { const int n = i & 511; int r = i >> 9; const int k = 8 * (r & 31), l = r >> 5; const int h = n >> 6, dd = n & 63;
        float vk[8], vv[8]; const float* w = P.in[I_WKVB] + ((size_t)l * 128 + (k < 128 ? k : 0)) * 1024 + h * 128 + dd;
#pragma unroll
        for (int q = 0; q < 8; ++q) { vk[q] = w[q * 1024]; vv[q] = w[q * 1024 + 64]; }
#pragma unroll
        for (int q = 0; q < 8; ++q) { vk[q] = k < 128 ? vk[q] : 0.f; vv[q] = k < 128 ? vv[q] : 0.f; }
        u32x4 o; o.x = pk2(vk[0], vk[1]); o.y = pk2(vk[2], vk[3]); o.z = pk2(vk[4], vk[5]); o.w = pk2(vk[6], vk[7]);
        *(u32x4*)((bf16_t*)(ws + WS_KB) + ((size_t)l * 512 + n) * 256 + k) = o;
        o.x = pk2(vv[0], vv[1]); o.y = pk2(vv[2], vv[3]); o.z = pk2(vv[4], vv[5]); o.w = pk2(vv[6], vv[7]);
        *(u32x4*)((bf16_t*)(ws + WS_VB) + ((size_t)l * 512 + n) * 256 + k) = o; }
    {
        const int j = F.tid & 127, r0 = F.tid >> 7;
        if (j < 80) { const int isr = j < 64; const int idx = isr ? j : j - 64; const double dim = isr ? 128.0 : 32.0;
            const float inv = (float)(1.0 / pow(10000.0, (2.0 * idx) / dim));
            for (int vb = vb0; vb < MTOK / 64; vb += nvb) {
                int pos[16];
#pragma unroll
                for (int k = 0; k < 16; ++k) pos[k] = ((const int*)P.in[I_POS])[vb * 64 + r0 + 4 * k];
                asm volatile("" ::: "memory");
#pragma unroll
                for (int k = 0; k < 16; ++k) { const int m = vb * 64 + r0 + 4 * k;
                    const float ang = (float)pos[k] * inv;
                    const double a = (double)ang, q = rint(a * 0.15915494309189535), rr = a - q * 6.283185307179586476925;
                    const float rf = (float)rr; const float cs = __cosf(rf), sn = __sinf(rf);
                    if (isr) { ((float*)(ws + WS_COSR))[(size_t)m * 64 + idx] = cs; ((float*)(ws + WS_SINR))[(size_t)m * 64 + idx] = sn; }
                    else { ((float*)(ws + WS_COSM))[(size_t)m * 16 + idx] = cs; ((float*)(ws + WS_SINM))[(size_t)m * 16 + idx] = sn; } } } }
    }
}
__device__ __forceinline__ void phase_prologue(const Frame& F, const Params& P) {
    unsigned char* ws = F.ws;
    pro_tiles<0>(F, P, 0, F.gw, 2048, pro::I_IN);
    for (int m = F.gw; m < MTOK; m += F.ngw) {
        const f32x4* xr = (const f32x4*)(P.in[I_X] + (size_t)m * DM) + F.lane; f32x4 v[4]; float s = 0.f;
#pragma unroll
        for (int j = 0; j < 4; ++j) { v[j] = xr[64 * j]; s += (v[j].x * v[j].x + v[j].y * v[j].y) + (v[j].z * v[j].z + v[j].w * v[j].w); }
        s = wave_sum(s);
        u32x2* o8 = (u32x2*)((bf16_t*)(ws + WS_HN) + (size_t)m * DM) + F.lane;
#pragma unroll
        for (int j = 0; j < 4; ++j) { const f32x4 g = ((const f32x4*)P.in[I_ANORM])[F.lane + 64 * j]; const f32x4 y = v[j] * g; u32x2 w; w.x = pk2(y.x, y.y); w.y = pk2(y.z, y.w); o8[64 * j] = w; }
        if (F.lane < 16) ((float*)(ws + WS_SS))[(size_t)m * 16 + F.lane] = F.lane == 0 ? s : 0.f;
    }
}
template <int PART>
__device__ __forceinline__ void phase_moe_convert(const Frame& F, const Params& P, int w0, int nw) {
    LAS float* scr = (LAS float*)(F.lds + F.wave * 16640);
    constexpr int I_GH = 16 * 28, I_D = 56 * 16;
    constexpr int PER_E = PART == 0 ? 2 * I_GH + I_D : 2 * I_GH;
    for (int it = w0; it < NEXP * PER_E; it += nw) {
        const int e = it / PER_E; int r = it % PER_E;
        if (r < 2 * I_GH) { const int up = r / I_GH; r %= I_GH; const int kb = r / 28, nb = PART * 28 + r % 28;
            transpose_tile64(P.in[up ? I_MU2 : I_MG] + (size_t)e * DM * DFFE, DFFE, kb * 64, nb * 64, (bf16_t*)(F.ws + WS_MGU) + (size_t)e * 2 * DFFE * DM, DM, gu_drow(nb * 64, up), gu_drow(nb * 64 + 32, up), 0, scr, F.lane); continue; }
        r -= 2 * I_GH;
        conv_plain(P.in[I_MD] + (size_t)e * DFFE * DM, DFFE, DM, (bf16_t*)(F.ws + WS_MD) + (size_t)e * DM * DFFE, DFFE, r, scr, F.lane);
    }
}

template <bool MOE>
__device__ __forceinline__ void phase_rms(const Frame& F, const bf16_t* src, const float* gain, bf16_t* hn, const float* router, unsigned* ectl, int* tok_e, int* tok_slot, float* tok_w) {
    LAS int* lcnt = (LAS int*)(F.lds);
    if (MOE) { if (F.tid < 16) lcnt[F.tid] = 0; __syncthreads(); }
    int my_e0 = 0, my_e1 = 0, my_s0 = 0, my_s1 = 0; float my_w0 = 0.f, my_w1 = 0.f;
    f32x4 rw[MOE ? 32 : 1];
    if (MOE) {
#pragma unroll
        for (int j = 0; j < 4; ++j)
#pragma unroll
            for (int q = 0; q < 4; ++q) { const int c = 4 * F.lane + 256 * j + q; rw[(j * 4 + q) * 2] = *(const f32x4*)(router + (size_t)c * 8); rw[(j * 4 + q) * 2 + 1] = *(const f32x4*)(router + (size_t)c * 8 + 4); } }
    for (int i = 0; i < 8; ++i) {
        const int m = F.blk * 64 + F.wave * 8 + i;
        const u32x2* xr = (const u32x2*)(src + (size_t)m * HLD) + F.lane;
        f32x4 v[4]; float s = 0.f;
#pragma unroll
        for (int j = 0; j < 4; ++j) { const u32x2 p = xr[64 * j]; v[j] = (f32x4){bflo(p.x), bfhi(p.x), bflo(p.y), bfhi(p.y)}; s += (v[j].x * v[j].x + v[j].y * v[j].y) + (v[j].z * v[j].z + v[j].w * v[j].w); }
        const float rstd = rsqrtf(wave_sum(s) * (1.0f / DM) + NORM_EPS);
#pragma unroll
        for (int j = 0; j < 4; ++j) { const f32x4 g = ((const f32x4*)gain)[F.lane + 64 * j]; v[j] = v[j] * rstd * g; }
        u32x2* o8 = (u32x2*)(hn + (size_t)m * DM) + F.lane;
#pragma unroll
        for (int j = 0; j < 4; ++j) { u32x2 w; w.x = pk2(v[j].x, v[j].y); w.y = pk2(v[j].z, v[j].w); o8[64 * j] = w; }
        if (MOE) {
            float lg[8];
#pragma unroll
            for (int e = 0; e < 8; ++e) lg[e] = 0.f;
#pragma unroll
            for (int j = 0; j < 4; ++j)
#pragma unroll
                for (int q = 0; q < 4; ++q) { const f32x4 r0 = rw[(j * 4 + q) * 2], r1 = rw[(j * 4 + q) * 2 + 1]; const float x = v[j][q];
                    lg[0] += x * r0.x; lg[1] += x * r0.y; lg[2] += x * r0.z; lg[3] += x * r0.w; lg[4] += x * r1.x; lg[5] += x * r1.y; lg[6] += x * r1.z; lg[7] += x * r1.w; }
#pragma unroll
            for (int e = 0; e < 8; ++e) lg[e] = wave_sum(lg[e]);
            int e0 = 0; float b0 = lg[0];
#pragma unroll
            for (int e = 1; e < 8; ++e) if (lg[e] > b0) { b0 = lg[e]; e0 = e; }
            int e1 = -1; float b1 = -3.0e38f;
#pragma unroll
            for (int e = 0; e < 8; ++e) if (e != e0 && lg[e] > b1) { b1 = lg[e]; e1 = e; }
            const float t = __expf(b1 - b0), w0 = 1.0f / (1.0f + t), w1 = t / (1.0f + t);
            int s0 = 0, s1 = 0;
            if (F.lane == 0) { s0 = atomicAdd((int*)&lcnt[e0], 1); s1 = atomicAdd((int*)&lcnt[e1], 1); }
            s0 = __shfl(s0, 0); s1 = __shfl(s1, 0);
            if (F.lane == i) { my_e0 = e0; my_e1 = e1; my_s0 = s0; my_s1 = s1; my_w0 = w0; my_w1 = w1; }
        }
    }
    if (MOE) {
        __syncthreads();
        if (F.tid < 8) lcnt[8 + F.tid] = (int)atomicAdd(&ectl[F.tid], (unsigned)lcnt[F.tid]);
        __syncthreads();
        if (F.lane < 8) { const int m = F.blk * 64 + F.wave * 8 + F.lane;
            tok_e[2 * m] = my_e0; tok_e[2 * m + 1] = my_e1; tok_slot[2 * m] = lcnt[8 + my_e0] + my_s0; tok_slot[2 * m + 1] = lcnt[8 + my_e1] + my_s1; tok_w[2 * m] = my_w0; tok_w[2 * m + 1] = my_w1; }
        __syncthreads();
    }
}
__device__ __forceinline__ void phase_final(const Frame& F, float* h, const float* gain, const bf16_t* out2, const int* tok_pos) {
    for (int m = F.gw; m < MTOK; m += F.ngw) {
        f32x4* xr = (f32x4*)(h + (size_t)m * DM) + F.lane;
        const u32x2* hr = (const u32x2*)((const bf16_t*)h + (size_t)m * HLD) + F.lane;
        const int p0 = tok_pos[2 * m], p1 = tok_pos[2 * m + 1];
        const u32x2* o0 = (const u32x2*)(out2 + (size_t)p0 * DM) + F.lane; const u32x2* o1 = (const u32x2*)(out2 + (size_t)p1 * DM) + F.lane;
        f32x4 v[4]; float s = 0.f;
#pragma unroll
        for (int j = 0; j < 4; ++j) { const u32x2 p = hr[64 * j]; v[j] = (f32x4){bflo(p.x), bfhi(p.x), bflo(p.y), bfhi(p.y)}; const u32x2 a = o0[64 * j], b = o1[64 * j];
#ifndef NO_MOE_ADD
            v[j].x += bflo(a.x) + bflo(b.x); v[j].y += bfhi(a.x) + bfhi(b.x); v[j].z += bflo(a.y) + bflo(b.y); v[j].w += bfhi(a.y) + bfhi(b.y);
#endif
            s += (v[j].x * v[j].x + v[j].y * v[j].y) + (v[j].z * v[j].z + v[j].w * v[j].w); }
        const float rstd = rsqrtf(wave_sum(s) * (1.0f / DM) + NORM_EPS);
#pragma unroll
        for (int j = 0; j < 4; ++j) { const f32x4 g = ((const f32x4*)gain)[F.lane + 64 * j]; xr[64 * j] = v[j] * rstd * g; }
    }
}
template <int KS>
__device__ __forceinline__ f32x4 mm_tile(const LAS bf16_t* P, int ldp, const LAS bf16_t* Q, int ldq, int ib, int jb, int lane, f32x4 acc) {
    const LAS bf16_t* pp = P + (ib * 16 + (lane & 15)) * ldp + 8 * (lane >> 4);
    const LAS bf16_t* qp = Q + (jb * 16 + (lane & 15)) * ldq + 8 * (lane >> 4);
#pragma unroll
    for (int ks = 0; ks < KS; ++ks) { const bf16x8 a = *(const LAS bf16x8*)(qp + ks * 32), b = *(const LAS bf16x8*)(pp + ks * 32); acc = __builtin_amdgcn_mfma_f32_16x16x32_bf16(a, b, acc, 0, 0, 0); }
    return acc;
}
__device__ __forceinline__ void st_bf4(LAS bf16_t* p, f32x4 v) { u32x2 w; w.x = pk2(v[0], v[1]); w.y = pk2(v[2], v[3]); *(LAS u32x2*)p = w; }
__device__ __forceinline__ float ret_lg(int h) { return __logf(1.0f - exp2f(-5.0f - (float)h)); }

__device__ __forceinline__ void phase_prep(const Frame& F, const Params& P, int layer) {
    unsigned char* ws = F.ws;
    const bf16_t* p = (const bf16_t*)(ws + WS_P);
    const float* mu = P.in[I_MU] + (size_t)layer * RWKV_COLS;
    for (int m = F.gw; m < MTOK; m += F.ngw) {
        const bf16_t* pr = p + (size_t)m * PW; const bool has_prev = (m % SEQ) != 0; const bf16_t* pp = pr - PW;
        bf16_t* lin = (bf16_t*)(ws + WS_LIN) + (size_t)m * LORA_K;
#pragma unroll
        for (int jj = 0; jj < 6; ++jj) { const int c = F.lane + 64 * jj; float o = 0.f;
            if (c < 288) { const int off = 1536 + c; const float x = bf2f(pr[P_RW + off]), xp = has_prev ? bf2f(pp[P_RW + off]) : 0.f; const float xs = x + (xp - x) * mu[off];
                o = c < 64 ? tanhf(xs) : (c < 128 ? xs : sigmoidf_(xs)); }
            lin[c] = (bf16_t)f2bf(o); }
        {
            const u32x2 w = *(const u32x2*)(pr + P_QA + 4 * F.lane); float x[4] = {bflo(w.x), bfhi(w.x), bflo(w.y), bfhi(w.y)};
            const float ss = wave_sum(x[0] * x[0] + x[1] * x[1] + x[2] * x[2] + x[3] * x[3]); const float rs = rsqrtf(ss * (1.0f / 256.0f) + NORM_EPS);
            const f32x4 g = *(const f32x4*)(P.in[I_QNORM] + layer * 256 + 4 * F.lane);
            u32x2 o; o.x = pk2(x[0] * rs * g.x, x[1] * rs * g.y); o.y = pk2(x[2] * rs * g.z, x[3] * rs * g.w); *(u32x2*)((bf16_t*)(ws + WS_QN) + (size_t)m * 256 + 4 * F.lane) = o; }
        {
            const unsigned w = *(const unsigned*)(pr + P_KVA + 2 * F.lane); float x0 = bflo(w), x1 = bfhi(w);
            const float ss = wave_sum(x0 * x0 + x1 * x1); const float rs = rsqrtf(ss * (1.0f / 128.0f) + NORM_EPS);
            const f32x2 g = *(const f32x2*)(P.in[I_KVNORM] + layer * 128 + 2 * F.lane);
            unsigned* cn = (unsigned*)((bf16_t*)(ws + WS_CN) + (size_t)m * 256); cn[F.lane] = pk2(x0 * rs * g.x, x1 * rs * g.y); cn[64 + F.lane] = 0u; }
        if (F.lane < 16) {
            const float x1 = bf2f(pr[P_KVA + 128 + F.lane]), x2 = bf2f(pr[P_KVA + 144 + F.lane]);
            const float c = ((const float*)(ws + WS_COSM))[(size_t)m * 16 + F.lane], s = ((const float*)(ws + WS_SINM))[(size_t)m * 16 + F.lane];
            bf16_t* kp = (bf16_t*)(ws + WS_KPE) + (size_t)m * 32; kp[F.lane] = (bf16_t)f2bf(x1 * c - x2 * s); kp[16 + F.lane] = (bf16_t)f2bf(x1 * s + x2 * c); }
    }
    LAS bf16_t* kT = (LAS bf16_t*)F.lds;
    LAS bf16_t* vT = kT + 128 * 72;
    const int pc = F.tid & 7, j = F.tid >> 3;
    for (int u = F.blk; u < NB * NCHUNK * 4; u += F.G) {
        const int h = u & 3, n = (u >> 2) & 127, b = u >> 9; const int m = b * SEQ + n * 64 + j;
        const float lg = ret_lg(h);
        __syncthreads();
        {
            const bf16_t* kr = p + (size_t)m * PW + P_RK + h * 128 + pc * 8;
            const u32x4 a = *(const u32x4*)kr, bq = *(const u32x4*)(kr + 64);
            const float* cp = (const float*)(ws + WS_COSR) + (size_t)m * 64 + pc * 8; const float* sp = (const float*)(ws + WS_SINR) + (size_t)m * 64 + pc * 8;
            const float sc = 0.08838834764831845f * __expf(lg * (float)(63 - j));
            const unsigned aw[4] = {a.x, a.y, a.z, a.w}, bw[4] = {bq.x, bq.y, bq.z, bq.w};
#pragma unroll
            for (int i = 0; i < 8; ++i) { const float x1 = (i & 1) ? bfhi(aw[i >> 1]) : bflo(aw[i >> 1]), x2 = (i & 1) ? bfhi(bw[i >> 1]) : bflo(bw[i >> 1]); const float c = cp[i], s = sp[i];
                kT[(pc * 8 + i) * 72 + j] = (bf16_t)f2bf((x1 * c - x2 * s) * sc); kT[(64 + pc * 8 + i) * 72 + j] = (bf16_t)f2bf((x1 * s + x2 * c) * sc); }
            const bf16_t* vr = p + (size_t)m * PW + P_RV + h * 128 + pc * 8;
            const u32x4 va = *(const u32x4*)vr, vb = *(const u32x4*)(vr + 64);
            const unsigned vaw[4] = {va.x, va.y, va.z, va.w}, vbw[4] = {vb.x, vb.y, vb.z, vb.w};
#pragma unroll
            for (int i = 0; i < 8; ++i) { vT[(pc * 8 + i) * 72 + j] = (bf16_t)((i & 1) ? (vaw[i >> 1] >> 16) : (vaw[i >> 1] & 0xffffu)); vT[(64 + pc * 8 + i) * 72 + j] = (bf16_t)((i & 1) ? (vbw[i >> 1] >> 16) : (vbw[i >> 1] & 0xffffu)); }
        }
        __syncthreads();
        bf16_t* out = (bf16_t*)(ws + WS_RS) + (size_t)u * 16384;
#pragma unroll
        for (int jb = 0; jb < 8; ++jb) { f32x4 acc = {0.f, 0.f, 0.f, 0.f}; acc = mm_tile<2>(vT, 72, kT, 72, F.wave, jb, F.lane, acc);
            const int e = F.wave * 16 + (F.lane & 15), d = jb * 16 + 4 * (F.lane >> 4);
            u32x2 w; w.x = pk2(acc[0], acc[1]); w.y = pk2(acc[2], acc[3]); *(u32x2*)(out + e * 128 + d) = w; }
    }
    __syncthreads();
}

__device__ __forceinline__ void ret_scan(const Frame& F) {
    bf16_t* rs = (bf16_t*)(F.ws + WS_RS);
    for (int idx = F.blk * NTHR + F.tid; idx < NB * 4 * 16384; idx += F.G * NTHR) {
        const int b = idx >> 16, h = (idx >> 14) & 3, ed = idx & 16383; const float cd = __expf(ret_lg(h) * 64.0f);
        bf16_t* base = rs + ((size_t)(b * 128) * 4 + h) * 16384 + ed; float s = 0.f;
        for (int n0 = 0; n0 < NCHUNK; n0 += 32) { unsigned short t[32];
#pragma unroll
            for (int i = 0; i < 32; ++i) t[i] = base[(size_t)(n0 + i) * 65536];
#pragma unroll
            for (int i = 0; i < 32; ++i) { base[(size_t)(n0 + i) * 65536] = (bf16_t)f2bf(s); s = s * cd + bf2f(t[i]); } }
    }
}

__device__ __forceinline__ void ret_out(const Frame& F) {
    unsigned char* ws = F.ws; const bf16_t* p = (const bf16_t*)(ws + WS_P);
    LAS bf16_t* q = (LAS bf16_t*)F.lds;
    LAS bf16_t* k = q + 64 * 136;
    LAS bf16_t* vT = k + 64 * 136;
    LAS bf16_t* pT = vT + 128 * 72;
    LAS bf16_t* sc = pT + 128 * 136;
    LAS float* st = (LAS float*)(sc + 64 * 72);
    const int pc = F.tid & 7, j = F.tid >> 3;
    for (int u = F.blk; u < NB * NCHUNK * 4; u += F.G) {
        const int h = u & 3, n = (u >> 2) & 127, b = u >> 9; const int m0 = b * SEQ + n * 64, m = m0 + j;
        const float lg = ret_lg(h);
        LBAR();
        {
            const float* cp = (const float*)(ws + WS_COSR) + (size_t)m * 64 + pc * 8; const float* sp = (const float*)(ws + WS_SINR) + (size_t)m * 64 + pc * 8;
            float cs[8], sn[8];
#pragma unroll
            for (int i = 0; i < 8; ++i) { cs[i] = cp[i]; sn[i] = sp[i]; }
#pragma unroll
            for (int which = 0; which < 2; ++which) {
                const bf16_t* r = p + (size_t)m * PW + (which ? P_RK : P_RQ) + h * 128 + pc * 8;
                const u32x4 a = *(const u32x4*)r, bq = *(const u32x4*)(r + 64);
                const unsigned aw[4] = {a.x, a.y, a.z, a.w}, bw[4] = {bq.x, bq.y, bq.z, bq.w}; const float sc_ = which ? 0.08838834764831845f : 1.0f;
                float o1[8], o2[8];
#pragma unroll
                for (int i = 0; i < 8; ++i) { const float x1 = (i & 1) ? bfhi(aw[i >> 1]) : bflo(aw[i >> 1]), x2 = (i & 1) ? bfhi(bw[i >> 1]) : bflo(bw[i >> 1]); o1[i] = (x1 * cs[i] - x2 * sn[i]) * sc_; o2[i] = (x1 * sn[i] + x2 * cs[i]) * sc_; }
                LAS bf16_t* dst = (which ? k : q) + j * 136 + pc * 8;
                u32x4 w1, w2; w1.x = pk2(o1[0], o1[1]); w1.y = pk2(o1[2], o1[3]); w1.z = pk2(o1[4], o1[5]); w1.w = pk2(o1[6], o1[7]); w2.x = pk2(o2[0], o2[1]); w2.y = pk2(o2[2], o2[3]); w2.z = pk2(o2[4], o2[5]); w2.w = pk2(o2[6], o2[7]);
                *(LAS u32x4*)dst = w1; *(LAS u32x4*)(dst + 64) = w2; }
            const bf16_t* vr = p + (size_t)m * PW + P_RV + h * 128 + pc * 8;
            const u32x4 va = *(const u32x4*)vr, vb = *(const u32x4*)(vr + 64);
            const unsigned vaw[4] = {va.x, va.y, va.z, va.w}, vbw[4] = {vb.x, vb.y, vb.z, vb.w};
#pragma unroll
            for (int i = 0; i < 8; ++i) { vT[(pc * 8 + i) * 72 + j] = (bf16_t)((i & 1) ? (vaw[i >> 1] >> 16) : (vaw[i >> 1] & 0xffffu)); vT[(64 + pc * 8 + i) * 72 + j] = (bf16_t)((i & 1) ? (vbw[i >> 1] >> 16) : (vbw[i >> 1] & 0xffffu)); }
            const bf16_t* ps = (const bf16_t*)(ws + WS_RS) + (size_t)u * 16384;
#pragma unroll
            for (int i = 0; i < 4; ++i) { const int pi = F.tid + i * 512; const int e = pi >> 4, c = pi & 15; *(LAS u32x4*)(pT + e * 136 + c * 8) = *(const u32x4*)(ps + e * 128 + c * 8); }
        }
        LBAR();
        {
            const int ib = F.wave & 3;
#pragma unroll
            for (int t = 0; t < 2; ++t) { const int jb = 2 * (F.wave >> 2) + t; f32x4 acc = {0.f, 0.f, 0.f, 0.f}; acc = mm_tile<4>(q, 136, k, 136, ib, jb, F.lane, acc);
                const int i = ib * 16 + (F.lane & 15), j0 = jb * 16 + 4 * (F.lane >> 4);
#pragma unroll
                for (int r = 0; r < 4; ++r) { const int dd = i - (j0 + r); acc[r] *= __expf(lg * (float)(dd < 0 ? -dd : dd)); }
                st_bf4(sc + i * 72 + j0, acc); }
        }
        LBAR();
        {
            const int ib = F.wave & 3, eh = F.wave >> 2; const int i = ib * 16 + (F.lane & 15);
            const float qd = __expf(lg * (float)(i + 1));
            f32x4 o[4]; float s1 = 0.f, s2 = 0.f;
#pragma unroll
            for (int t = 0; t < 4; ++t) { const int eb = eh * 4 + t; f32x4 ai = {0.f, 0.f, 0.f, 0.f}, ac = {0.f, 0.f, 0.f, 0.f};
                ai = mm_tile<2>(sc, 72, vT, 72, ib, eb, F.lane, ai); ac = mm_tile<4>(q, 136, pT, 136, ib, eb, F.lane, ac);
                o[t] = ai + ac * qd;
#pragma unroll
                for (int r = 0; r < 4; ++r) { s1 += o[t][r]; s2 += o[t][r] * o[t][r]; } }
            s1 += __shfl_xor(s1, 16); s1 += __shfl_xor(s1, 32); s2 += __shfl_xor(s2, 16); s2 += __shfl_xor(s2, 32);
            if (F.lane < 16) { st[(eh * 64 + i) * 2] = s1; st[(eh * 64 + i) * 2 + 1] = s2; }
            LBAR();
            const float t1 = st[i * 2] + st[(64 + i) * 2], t2 = st[i * 2 + 1] + st[(64 + i) * 2 + 1];
            const float mean = t1 * (1.0f / 128.0f), var = fmaxf(t2 * (1.0f / 128.0f) - mean * mean, 0.f), rstd = rsqrtf(var + 1e-5f);
            const int mrow = m0 + i;
#pragma unroll
            for (int t = 0; t < 4; ++t) { const int e = (eh * 4 + t) * 16 + 4 * (F.lane >> 4);
                const u32x2 gw = *(const u32x2*)(p + (size_t)mrow * PW + P_RG + h * 128 + e); const float g[4] = {bflo(gw.x), bfhi(gw.x), bflo(gw.y), bfhi(gw.y)};
                float y[4];
#pragma unroll
                for (int r = 0; r < 4; ++r) y[r] = (o[t][r] - mean) * rstd * (g[r] * sigmoidf_(g[r]));
                u32x2 w; w.x = pk2(y[0], y[1]); w.y = pk2(y[2], y[3]); *(u32x2*)((bf16_t*)(ws + WS_YRET) + (size_t)mrow * 512 + h * 128 + e) = w; }
        }
    }
    __syncthreads();
}

constexpr int ATT_KP = 104, ATT_VP = 72;
constexpr int ATT_KB = 64 * ATT_KP * 2, ATT_VB = 64 * ATT_VP * 2;
constexpr int ATT_K0 = 0, ATT_V0 = 2 * ATT_KB;
__device__ __forceinline__ void attn_unit(const Frame& F, int b, int h, int qt) {
    unsigned char* ws = F.ws;
    const bf16_t* Qg = (const bf16_t*)(ws + WS_Q); const bf16_t* Kn = (const bf16_t*)(ws + WS_KN); const bf16_t* Kp = (const bf16_t*)(ws + WS_KPE); const bf16_t* Vt = (const bf16_t*)(ws + WS_VT);
    const int lane = F.lane, w = F.wave, ql = lane & 31, hf = lane >> 5;
    const int mq = b * SEQ + qt * 256 + w * 32 + ql;
    const float qs = 0.10206207261596577f * 1.4426950408889634f;
    bf16x8 qf[6];
    {
        const bf16_t* qr = Qg + (size_t)mq * 768 + h * 96;
#pragma unroll
        for (int s = 0; s < 4; ++s) { const u32x4 x = *(const u32x4*)(qr + 16 * s + 8 * hf); const unsigned xw[4] = {x.x, x.y, x.z, x.w}; u32x4 o; unsigned ow[4];
#pragma unroll
            for (int i = 0; i < 4; ++i) ow[i] = pk2(bflo(xw[i]) * qs, bfhi(xw[i]) * qs);
            o.x = ow[0]; o.y = ow[1]; o.z = ow[2]; o.w = ow[3]; qf[s] = __builtin_bit_cast(bf16x8, o); }
        const u32x4 x1 = *(const u32x4*)(qr + 64 + 8 * hf), x2 = *(const u32x4*)(qr + 80 + 8 * hf);
        const float* cp = (const float*)(ws + WS_COSM) + (size_t)mq * 16 + 8 * hf; const float* sp = (const float*)(ws + WS_SINM) + (size_t)mq * 16 + 8 * hf;
        const unsigned a[4] = {x1.x, x1.y, x1.z, x1.w}, c[4] = {x2.x, x2.y, x2.z, x2.w}; unsigned o1[4], o2[4];
#pragma unroll
        for (int i = 0; i < 4; ++i) { const float u0 = bflo(a[i]), u1 = bfhi(a[i]), v0 = bflo(c[i]), v1 = bfhi(c[i]); const float c0 = cp[2 * i], c1 = cp[2 * i + 1], s0 = sp[2 * i], s1 = sp[2 * i + 1];
            o1[i] = pk2((u0 * c0 - v0 * s0) * qs, (u1 * c1 - v1 * s1) * qs); o2[i] = pk2((u0 * s0 + v0 * c0) * qs, (u1 * s1 + v1 * c1) * qs); }
        u32x4 t1, t2; t1.x = o1[0]; t1.y = o1[1]; t1.z = o1[2]; t1.w = o1[3]; t2.x = o2[0]; t2.y = o2[1]; t2.z = o2[2]; t2.w = o2[3];
        qf[4] = __builtin_bit_cast(bf16x8, t1); qf[5] = __builtin_bit_cast(bf16x8, t2);
    }
    f32x16 oacc[2];
#pragma unroll
    for (int i = 0; i < 16; ++i) { oacc[0][i] = 0.f; oacc[1][i] = 0.f; }
    float mrun = 0.f; f32x2 lsum = {0.f, 0.f};
    const int nkt = 4 * qt + 4, mylim = 4 * qt + (w >> 1);
    const int half = w >> 2;
    const int kkey = F.tid >> 3, kpc = F.tid & 7, rkey = (F.tid & 255) >> 2, rpc = F.tid & 3, ve = F.tid >> 3, vpc = F.tid & 7;
    const bf16_t* knp = Kn + (size_t)(b * SEQ + kkey) * 512 + h * 64 + kpc * 8;
    const bf16_t* kpp = Kp + (size_t)(b * SEQ + rkey) * 32 + rpc * 8;
    const bf16_t* vtp = Vt + (size_t)(h * 64 + ve) * MTOK + b * SEQ + vpc * 8;
    const int kofs = (kkey * ATT_KP + kpc * 8) * 2, rofs = (rkey * ATT_KP + 64 + rpc * 8) * 2, vofs = (ve * ATT_VP + vpc * 8) * 2;
    constexpr bool rp = true;
#define ATT_QK(sv, kbuf, init) do { _Pragma("unroll") for (int t_ = 0; t_ < 2; ++t_) { _Pragma("unroll") for (int i_ = 0; i_ < 16; ++i_) sv[t_][i_] = (init); } \
        const LAS bf16_t* kr_ = (kbuf) + ql * ATT_KP + 8 * hf; bf16x8 ka_ = *(const LAS bf16x8*)kr_, kb_ = *(const LAS bf16x8*)(kr_ + 32 * ATT_KP); \
        _Pragma("unroll") for (int st_ = 0; st_ < 6; ++st_) { bf16x8 na_ = ka_, nb_ = kb_; \
            if (st_ < 5) { na_ = *(const LAS bf16x8*)(kr_ + 16 * (st_ + 1)); nb_ = *(const LAS bf16x8*)(kr_ + 32 * ATT_KP + 16 * (st_ + 1)); } \
            sv[0] = __builtin_amdgcn_mfma_f32_32x32x16_bf16(ka_, qf[st_], sv[0], 0, 0, 0); sv[1] = __builtin_amdgcn_mfma_f32_32x32x16_bf16(kb_, qf[st_], sv[1], 0, 0, 0); \
            ka_ = na_; kb_ = nb_; __builtin_amdgcn_sched_barrier(0); } } while (0)
    u32x4 ak, ar, av, bk, br, bv;
#define ATT_LOAD(K_, R_, V_, t_) do { const int tt_ = (t_) < nkt ? (t_) : nkt - 1; \
        K_ = *(const u32x4*)(knp + (size_t)tt_ * 64 * 512); R_ = *(const u32x4*)(kpp + (size_t)tt_ * 64 * 32); V_ = *(const u32x4*)(vtp + (size_t)tt_ * 64); } while (0)
#define ATT_STAGE(K_, R_, V_, kt_) do { { LAS unsigned char* kb2_ = F.lds + ATT_K0 + (((kt_) + 1) & 1) * ATT_KB; *(LAS u32x4*)(kb2_ + kofs) = K_; *(LAS u32x4*)(kb2_ + rofs) = R_; } \
        *(LAS u32x4*)(F.lds + ATT_V0 + (((kt_) + 1) & 1) * ATT_VB + vofs) = V_; ATT_LOAD(K_, R_, V_, (kt_) + 3); } while (0)
    __syncthreads();
    {
        ak = *(const u32x4*)knp; ar = *(const u32x4*)kpp; av = *(const u32x4*)vtp;
        *(LAS u32x4*)(F.lds + ATT_K0 + kofs) = ak; *(LAS u32x4*)(F.lds + ATT_K0 + rofs) = ar; *(LAS u32x4*)(F.lds + ATT_V0 + vofs) = av;
        ATT_LOAD(ak, ar, av, 1); ATT_LOAD(bk, br, bv, 2);
    }
    __syncthreads();
    f32x16 sc[2];
    if (half == 1) LBAR();
#define ATT_SEG1(kt_, ALL) do { if ((ALL) || (kt_) <= mylim) ATT_QK(sc, (const LAS bf16_t*)(F.lds + ATT_K0 + ((kt_) & 1) * ATT_KB), -mrun); } while (0)
#define ATT_SEG2(kt_, ALL) do { if ((ALL) || (kt_) <= mylim) { \
            const LAS bf16_t* vb = (const LAS bf16_t*)(F.lds + ATT_V0 + ((kt_) & 1) * ATT_VB); \
            int mi = __builtin_bit_cast(int, sc[0][0]); \
            _Pragma("unroll") for (int i = 0; i < 16; ++i) { const int a_ = __builtin_bit_cast(int, sc[0][i]), b_ = __builtin_bit_cast(int, sc[1][i]); mi = max(max(mi, a_), b_); } \
            if ((kt_) == 0 || __builtin_amdgcn_ballot_w64(__builtin_bit_cast(float, mi) > 8.0f) != 0ull) { \
                float mx = fmaxf(sc[0][0], sc[1][0]); \
                _Pragma("unroll") for (int i = 1; i < 16; ++i) mx = fmaxf(mx, fmaxf(sc[0][i], sc[1][i])); \
                { const int mb = __builtin_bit_cast(int, mx); const auto sw2 = __builtin_amdgcn_permlane32_swap(mb, mb, false, false); mx = fmaxf(__builtin_bit_cast(float, (int)sw2[0]), __builtin_bit_cast(float, (int)sw2[1])); } \
                const float delta = ((kt_) == 0) ? mx : fmaxf(mx, 0.f); \
                const float alpha = ((kt_) == 0) ? 1.0f : __builtin_amdgcn_exp2f(-delta); mrun += delta; lsum *= alpha; \
                _Pragma("unroll") for (int i = 0; i < 16; ++i) { oacc[0][i] *= alpha; oacc[1][i] *= alpha; sc[0][i] -= delta; sc[1][i] -= delta; } } \
            _Pragma("unroll") for (int t = 0; t < 2; ++t) _Pragma("unroll") for (int i = 0; i < 16; i += 2) { const float p0 = __builtin_amdgcn_exp2f(sc[t][i]), p1 = __builtin_amdgcn_exp2f(sc[t][i + 1]); sc[t][i] = p0; sc[t][i + 1] = p1; lsum += (f32x2){p0, p1}; } \
            _Pragma("unroll") for (int t = 0; t < 2; ++t) _Pragma("unroll") for (int kbb = 0; kbb < 2; ++kbb) { \
                    u32x4 pw; pw.x = pk2(sc[t][8 * kbb + 0], sc[t][8 * kbb + 1]); pw.y = pk2(sc[t][8 * kbb + 2], sc[t][8 * kbb + 3]); pw.z = pk2(sc[t][8 * kbb + 4], sc[t][8 * kbb + 5]); pw.w = pk2(sc[t][8 * kbb + 6], sc[t][8 * kbb + 7]); \
                    const bf16x8 pf = __builtin_bit_cast(bf16x8, pw); const int key0 = t * 32 + kbb * 16 + 4 * hf; \
                    _Pragma("unroll") for (int eb = 0; eb < 2; ++eb) { const LAS bf16_t* vr = vb + (eb * 32 + ql) * ATT_VP + key0; \
                        const u32x2 lo = *(const LAS u32x2*)vr, hi = *(const LAS u32x2*)(vr + 8); u32x4 vv; vv.x = lo.x; vv.y = lo.y; vv.z = hi.x; vv.w = hi.y; \
                        oacc[eb] = __builtin_amdgcn_mfma_f32_32x32x16_bf16(__builtin_bit_cast(bf16x8, vv), pf, oacc[eb], 0, 0, 0); } } } } while (0)
    const int nall = 4 * qt;
#define ATT_TRIP_L(kt_, ALL) do { ATT_SEG1(kt_, ALL); LBAR(); ATT_STAGE(ak, ar, av, kt_); ATT_SEG2(kt_, ALL); LBAR(); \
                                  ATT_SEG1((kt_) + 1, ALL); LBAR(); ATT_STAGE(bk, br, bv, (kt_) + 1); ATT_SEG2((kt_) + 1, ALL); LBAR(); } while (0)
#define ATT_TRIP_T(kt_, ALL) do { ATT_STAGE(ak, ar, av, kt_); ATT_SEG1(kt_, ALL); LBAR(); ATT_SEG2(kt_, ALL); LBAR(); \
                                  ATT_STAGE(bk, br, bv, (kt_) + 1); ATT_SEG1((kt_) + 1, ALL); LBAR(); ATT_SEG2((kt_) + 1, ALL); LBAR(); } while (0)
    if (half == 0) {
#pragma unroll 1
        for (int kt = 0; kt < nall; kt += 2) ATT_TRIP_L(kt, true);
#pragma unroll 1
        for (int kt = nall; kt < nkt; kt += 2) ATT_TRIP_L(kt, false);
        LBAR();
    } else {
#pragma unroll 1
        for (int kt = 0; kt < nall; kt += 2) ATT_TRIP_T(kt, true);
#pragma unroll 1
        for (int kt = nall; kt < nkt; kt += 2) ATT_TRIP_T(kt, false);
    }
#undef ATT_TRIP_L
#undef ATT_TRIP_T
#undef ATT_QK
#undef ATT_LOAD
#undef ATT_STAGE
#undef ATT_SEG1
#undef ATT_SEG2
    float lrun = lsum[0] + lsum[1];
    const float lt = lrun + __shfl_xor(lrun, 32), inv = 1.0f / lt;
    bf16_t* yo = (bf16_t*)(ws + WS_YMLA) + (size_t)mq * 512 + h * 64;
#pragma unroll
    for (int eb = 0; eb < 2; ++eb)
#pragma unroll
        for (int g = 0; g < 4; ++g) { u32x2 wv; wv.x = pk2(oacc[eb][4 * g] * inv, oacc[eb][4 * g + 1] * inv); wv.y = pk2(oacc[eb][4 * g + 2] * inv, oacc[eb][4 * g + 3] * inv);
            *(u32x2*)(yo + eb * 32 + 8 * g + 4 * hf) = wv; }
}
constexpr int RP = 72;
constexpr int RMAT = 64 * RP;
constexpr size_t RC_UNIT = 40960;
constexpr size_t WS_RC2 = WS_RC + (size_t)2048 * RC_UNIT;

__device__ __forceinline__ void st_g4(bf16_t* p, f32x4 v) { u32x2 w; w.x = pk2(v[0], v[1]); w.y = pk2(v[2], v[3]); *(u32x2*)p = w; }
__device__ __forceinline__ f32x4 ld_l4(const LAS bf16_t* p) { const u32x2 w = *(const LAS u32x2*)p; return (f32x4){bflo(w.x), bfhi(w.x), bflo(w.y), bfhi(w.y)}; }

template <int KS>
__device__ __forceinline__ f32x16 mm32(const LAS bf16_t* P, const LAS bf16_t* Q, int ib, int jb, int lane, f32x16 acc) {
    const LAS bf16_t* pp = P + (ib * 32 + (lane & 31)) * RP + 8 * (lane >> 5);
    const LAS bf16_t* qp = Q + (jb * 32 + (lane & 31)) * RP + 8 * (lane >> 5);
#pragma unroll
    for (int ks = 0; ks < KS; ++ks) { const bf16x8 a = *(const LAS bf16x8*)(qp + ks * 16), b = *(const LAS bf16x8*)(pp + ks * 16); acc = __builtin_amdgcn_mfma_f32_32x32x16_bf16(a, b, acc, 0, 0, 0); }
    return acc;
}
__device__ __forceinline__ f32x16 zero16() { f32x16 z; for (int i = 0; i < 16; ++i) z[i] = 0.f; return z; }
__device__ __forceinline__ void st32_lds(LAS bf16_t* O, int ib, int jb, int lane, const f32x16& a) {
    LAS bf16_t* o = O + (ib * 32 + (lane & 31)) * RP + jb * 32 + 4 * (lane >> 5);
#pragma unroll
    for (int g = 0; g < 4; ++g) st_bf4(o + 8 * g, (f32x4){a[4 * g], a[4 * g + 1], a[4 * g + 2], a[4 * g + 3]});
}
__device__ __forceinline__ void st32_glb(bf16_t* O, int ib, int jb, int lane, const f32x16& a) {
    bf16_t* o = O + (ib * 32 + (lane & 31)) * 64 + jb * 32 + 4 * (lane >> 5);
#pragma unroll
    for (int g = 0; g < 4; ++g) st_g4(o + 8 * g, (f32x4){a[4 * g], a[4 * g + 1], a[4 * g + 2], a[4 * g + 3]});
}
struct PreIn { unsigned short r[8], rp[8], k[8], kp[8], v[8], vp[8], lw[8], a[8]; };
__device__ __forceinline__ void pre_load(PreIn& x, const bf16_t* p, const bf16_t* lo, int u, int w, int lane) {
    const int c = u & 127, h = (u >> 7) & 7, b = u >> 10; const int m0 = b * SEQ + c * 64, ch = h * 64 + lane;
#pragma unroll
    for (int i = 0; i < 8; ++i) { const int t = 8 * w + i, m = m0 + t; const bf16_t* pr = p + (size_t)m * PW + P_RW + ch; const bool hp = (c | t) != 0;
        x.r[i] = pr[0]; x.k[i] = pr[512]; x.v[i] = pr[1024];
        x.rp[i] = hp ? pr[-PW] : (unsigned short)0; x.kp[i] = hp ? pr[512 - PW] : (unsigned short)0; x.vp[i] = hp ? pr[1024 - PW] : (unsigned short)0;
        x.lw[i] = lo[(size_t)m * LO_W + ch]; x.a[i] = lo[(size_t)m * LO_W + 512 + ch]; }
}
#ifdef PRE_T
#define PRE_MARK(k) do { if (F.tid == 0) { volatile LAS unsigned long long* tq_ = (volatile LAS unsigned long long*)(F.lds + LDSCTL_OFF + 48); const unsigned long long now_ = __builtin_amdgcn_s_memrealtime(); \
        if ((k) == PRE_T) tq_[1] += now_ - tq_[2]; tq_[2] = now_; } } while (0)
#else
#define PRE_MARK(k) do { } while (0)
#endif
template <int DIAG = 0>
__device__ __forceinline__ void rwkv_chunk_pre(const Frame& F, const float* mu, const float* k_k_, const float* k_a_, const float* r_k_) {
    unsigned char* ws = F.ws; const bf16_t* p = (const bf16_t*)(ws + WS_P); const bf16_t* lo = (const bf16_t*)(ws + WS_LO);
    LAS bf16_t* M = (LAS bf16_t*)F.lds;
    LAS bf16_t *KKt = M, *Bt = M + RMAT, *Kt = M + 2 * RMAT, *Rt = M + 3 * RMAT, *KKtT = M + 4 * RMAT, *BhT = M + 5 * RMAT, *KhT = M + 6 * RMAT, *VcT = M + 7 * RMAT;
    LAS bf16_t *NA = M + 8 * RMAT, *NAT = M + 9 * RMAT, *TT = M + 10 * RMAT, *AkkT = M + 11 * RMAT, *AbrT = M + 12 * RMAT, *AkrT = M + 13 * RMAT;
    LAS float* SEG = (LAS float*)(M + 10 * RMAT);
    const int lane = F.lane, w = F.wave, pr_ = w >> 1, ib = w & 1;
    const int i0 = ib * 32 + (lane & 31), jq = 4 * (lane >> 5);
    PreIn cur;
    if (F.blk < NB * 8 * NCHUNK) pre_load(cur, p, lo, F.blk, w, lane);
    for (int u = F.blk; u < NB * 8 * NCHUNK; u += F.G) {
        const int h = (u >> 7) & 7; const int ch = h * 64 + lane;
        const float mu_r = mu[ch], mu_k = mu[512 + ch], mu_v = mu[1024 + ch], k_k = k_k_[ch], k_a = k_a_[ch], r_k = r_k_[ch];
        float* aux = DIAG ? (float*)(ws + WS_YMLA) + (size_t)(u & 255) * 128 : (float*)(ws + WS_RC2) + (size_t)u * 128;
        LBAR();
        PRE_MARK(0);
        if (DIAG != 2) {
        float rr[8], kk8[8], k28[8], vv[8], bb[8], lw8[8], cs8[8]; float cs = 0.f;
#pragma unroll
        for (int i = 0; i < 8; ++i) { const int t = 8 * w + i;
            const float xr = bf2f(cur.r[i]), xk = bf2f(cur.k[i]), xv = bf2f(cur.v[i]);
            const float r = xr + (bf2f(cur.rp[i]) - xr) * mu_r, k = xk + (bf2f(cur.kp[i]) - xk) * mu_k, v = xv + (bf2f(cur.vp[i]) - xv) * mu_v;
            const float lw = bf2f(cur.lw[i]), a = bf2f(cur.a[i]);
            float kk = k * k_k; const float ss = wave_sum(kk * kk); kk *= rsqrtf(ss + 1e-12f);
            const float k2 = k * (1.0f + (a - 1.0f) * k_a);
            rr[i] = r; kk8[i] = kk; k28[i] = k2; vv[i] = v; bb[i] = kk * a; lw8[i] = lw; cs += lw; cs8[i] = cs;
            (DIAG ? (bf16_t*)(ws + WS_YRW) + (size_t)(u & 255) * 4096 : (bf16_t*)(ws + WS_RC + (size_t)u * RC_UNIT) + 16384)[t * 64 + lane] = (bf16_t)f2bf(v);
            const float bon = wave_sum(r * k2 * r_k); if (lane == 0) aux[64 + t] = bon; }
        SEG[w * 64 + lane] = cs;
        if (u + F.G < NB * 8 * NCHUNK) pre_load(cur, p, lo, u + F.G, w, lane);
        LBAR();
        float off = 0.f, cumC = 0.f;
#pragma unroll
        for (int s = 0; s < 8; ++s) { const float sv = SEG[s * 64 + lane]; cumC += sv; off += (s < w) ? sv : 0.f; }
        if (w == 0) aux[lane] = __expf(cumC);
        LBAR();
        unsigned pkk[4], pbh[4], pkh[4], pvc[4];
#pragma unroll
        for (int i = 0; i < 8; i += 2) { float o_kk[2], o_bh[2], o_kh[2];
#pragma unroll
            for (int e = 0; e < 2; ++e) { const int t = 8 * w + i + e; const float cum = cs8[i + e] + off;
                const float om = __expf(cum), omx = __expf(cum - lw8[i + e]), iom = __expf(-cum), ih = __expf(cumC - cum);
                o_kk[e] = kk8[i + e] * omx; o_bh[e] = bb[i + e] * ih; o_kh[e] = k28[i + e] * ih;
                KKt[t * RP + lane] = (bf16_t)f2bf(o_kk[e]); Bt[t * RP + lane] = (bf16_t)f2bf(bb[i + e] * iom); Kt[t * RP + lane] = (bf16_t)f2bf(k28[i + e] * iom); Rt[t * RP + lane] = (bf16_t)f2bf(rr[i + e] * om); }
            pkk[i >> 1] = pk2(o_kk[0], o_kk[1]); pbh[i >> 1] = pk2(o_bh[0], o_bh[1]); pkh[i >> 1] = pk2(o_kh[0], o_kh[1]); pvc[i >> 1] = pk2(vv[i], vv[i + 1]); }
        *(LAS u32x4*)(KKtT + lane * RP + 8 * w) = (u32x4){pkk[0], pkk[1], pkk[2], pkk[3]}; *(LAS u32x4*)(BhT + lane * RP + 8 * w) = (u32x4){pbh[0], pbh[1], pbh[2], pbh[3]};
        *(LAS u32x4*)(KhT + lane * RP + 8 * w) = (u32x4){pkh[0], pkh[1], pkh[2], pkh[3]}; *(LAS u32x4*)(VcT + lane * RP + 8 * w) = (u32x4){pvc[0], pvc[1], pvc[2], pvc[3]};
        }
        LBAR();
        PRE_MARK(1);
        if (DIAG != 1) {
        {
            const LAS bf16_t* Pm = pr_ < 2 ? KKt : Rt; const LAS bf16_t* Qm = (pr_ == 0 || pr_ == 2) ? Bt : Kt; LAS bf16_t* Om = pr_ == 0 ? NAT : (pr_ == 1 ? AkkT : (pr_ == 2 ? AbrT : AkrT));
            const bool incl = pr_ >= 2; const float sgn = pr_ == 0 ? -1.0f : 1.0f;
#pragma unroll
            for (int jb = 0; jb < 2; ++jb) { f32x16 a = zero16(); if (jb <= ib) a = mm32<4>(Pm, Qm, ib, jb, lane, a);
#pragma unroll
                for (int g = 0; g < 4; ++g)
#pragma unroll
                    for (int r = 0; r < 4; ++r) { const int jj = jb * 32 + 8 * g + jq + r; const bool keep = incl ? (jj <= i0) : (jj < i0); a[4 * g + r] = keep ? sgn * a[4 * g + r] : 0.f; }
                st32_lds(Om, ib, jb, lane, a);
                if (pr_ == 0) {
#pragma unroll
                    for (int g = 0; g < 4; ++g)
#pragma unroll
                        for (int r = 0; r < 4; ++r) { const int jj = jb * 32 + 8 * g + jq + r; a[4 * g + r] += (jj == i0) ? 1.0f : 0.f; }
                    st32_lds(TT, ib, jb, lane, a); } }
            if (pr_ == 0) {
#pragma unroll
                for (int jb = 0; jb < 2; ++jb) { f32x16 a = zero16(); if (jb >= ib) a = mm32<4>(Bt, KKt, ib, jb, lane, a);
#pragma unroll
                    for (int g = 0; g < 4; ++g)
#pragma unroll
                        for (int r = 0; r < 4; ++r) { const int jj = jb * 32 + 8 * g + jq + r; a[4 * g + r] = (i0 < jj) ? -a[4 * g + r] : 0.f; }
                    st32_lds(NA, ib, jb, lane, a); } }
        }
        LBAR();
        PRE_MARK(2);
        LAS bf16_t* VA = Kt;
#pragma unroll 1
        for (int s = 1; s <= 6; ++s) {
            const LAS bf16_t* Yo = (s & 1) ? NAT : KKt; const LAS bf16_t* YoT = (s & 1) ? NA : Bt; LAS bf16_t* Yn = (s & 1) ? KKt : NAT; LAS bf16_t* YnT = (s & 1) ? Bt : NA;
            if (pr_ == 0) {
                if (s == 1) { const f32x16 a0 = mm32<4>(VcT, AkkT, ib, 0, lane, zero16()), a1 = mm32<4>(VcT, AkkT, ib, 1, lane, zero16()); st32_lds(VA, ib, 0, lane, a0); st32_lds(VA, ib, 1, lane, a1); }
                else {
                    f32x16 c0, c1; const LAS bf16_t* tr = TT + i0 * RP + jq;
#pragma unroll
                    for (int g = 0; g < 4; ++g) { const f32x4 x0 = ld_l4(tr + 8 * g), x1 = ld_l4(tr + 32 + 8 * g);
#pragma unroll
                        for (int r = 0; r < 4; ++r) { c0[4 * g + r] = x0[r]; c1[4 * g + r] = x1[r]; } }
                    c0 = mm32<4>(TT, YoT, ib, 0, lane, c0); c1 = mm32<4>(TT, YoT, ib, 1, lane, c1);
                    LDS_WAIT();
                    st32_lds(TT, ib, 0, lane, c0); st32_lds(TT, ib, 1, lane, c1); }
            } else if (pr_ <= 2 && s <= 5) {
                const LAS bf16_t* Pm = pr_ == 1 ? Yo : YoT; const LAS bf16_t* Qm = pr_ == 1 ? YoT : Yo; LAS bf16_t* Om = pr_ == 1 ? Yn : YnT;
                const f32x16 a0 = mm32<4>(Pm, Qm, ib, 0, lane, zero16()), a1 = mm32<4>(Pm, Qm, ib, 1, lane, zero16()); st32_lds(Om, ib, 0, lane, a0); st32_lds(Om, ib, 1, lane, a1);
            }
            LBAR();
        }
        PRE_MARK(3);
        LAS bf16_t* KT = NAT; LAS bf16_t* P1 = NA;
        if (pr_ < 2) { const LAS bf16_t* src = pr_ == 0 ? KKtT : VA; LAS bf16_t* dst = pr_ == 0 ? KT : P1;
            const f32x16 a0 = mm32<4>(src, TT, ib, 0, lane, zero16()), a1 = mm32<4>(src, TT, ib, 1, lane, zero16()); st32_lds(dst, ib, 0, lane, a0); st32_lds(dst, ib, 1, lane, a1); }
        LBAR();
        {
            bf16_t* og = DIAG ? (bf16_t*)(ws + WS_YRW) + (size_t)(u & 255) * 4096 : (bf16_t*)(ws + WS_RC + (size_t)u * RC_UNIT) + pr_ * 4096;
#pragma unroll
            for (int jb = 0; jb < 2; ++jb) { f32x16 o;
                if (pr_ == 0) o = mm32<4>(BhT, KT, ib, jb, lane, zero16());
                else if (pr_ == 1) { const f32x16 x = mm32<4>(VcT, KhT, ib, jb, lane, zero16()), y = mm32<4>(P1, BhT, ib, jb, lane, zero16()); o = x - y; }
                else if (pr_ == 2) { const f32x16 y = mm32<4>(AbrT, KT, ib, jb, lane, zero16()); const LAS bf16_t* rt = Rt + i0 * RP + jb * 32 + jq;
#pragma unroll
                    for (int g = 0; g < 4; ++g) { const f32x4 x = ld_l4(rt + 8 * g);
#pragma unroll
                        for (int r = 0; r < 4; ++r) o[4 * g + r] = x[r] - y[4 * g + r]; } }
                else { const f32x16 x = mm32<4>(VcT, AkrT, ib, jb, lane, zero16()), y = mm32<4>(P1, AbrT, ib, jb, lane, zero16()); o = x - y; }
                st32_glb(og, ib, jb, lane, o); }
        }
        }
        PRE_MARK(4);
    }
    __syncthreads();
}

struct ScanOps { u32x4 fa0, fa1; u32x2 ad0, ad1; f32x4 om; };
__device__ __forceinline__ ScanOps scan_load(const unsigned char* ws, size_t u, int sk, int vh, int l15, int l4) {
    ScanOps o; const bf16_t* base = (const bf16_t*)(ws + WS_RC + u * RC_UNIT);
    o.fa0 = *(const u32x4*)(base + (sk * 16 + l15) * 64 + 8 * l4); o.fa1 = *(const u32x4*)(base + (sk * 16 + l15) * 64 + 32 + 8 * l4);
    o.ad0 = *(const u32x2*)(base + 4096 + ((2 * vh) * 16 + l15) * 64 + sk * 16 + 4 * l4); o.ad1 = *(const u32x2*)(base + 4096 + ((2 * vh + 1) * 16 + l15) * 64 + sk * 16 + 4 * l4);
    o.om = *(const f32x4*)((const float*)(ws + WS_RC2) + u * 128 + sk * 16 + 4 * l4); return o;
}
template <bool STORE>
__device__ __forceinline__ void rwkv_scan(const Frame& F, int b, int h) {
    unsigned char* ws = F.ws;
    LAS bf16_t* Sb = (LAS bf16_t*)F.lds;
    const int lane = F.lane, w = F.wave, l15 = lane & 15, l4 = lane >> 4, sk = w & 3, vh = w >> 2;
    for (int i = F.tid; i < 2 * RMAT / 2; i += NTHR) ((LAS unsigned*)Sb)[i] = 0u;
    const size_t u0 = (size_t)(b * 8 + h) * 128;
    f32x4 st0 = {0.f, 0.f, 0.f, 0.f}, st1 = {0.f, 0.f, 0.f, 0.f};
    ScanOps r0 = scan_load(ws, u0 + 0, sk, vh, l15, l4), r1 = scan_load(ws, u0 + 1, sk, vh, l15, l4), r2 = scan_load(ws, u0 + 2, sk, vh, l15, l4), r3 = scan_load(ws, u0 + 3, sk, vh, l15, l4);
    __syncthreads();
#define SCAN_STEP(R, cc) do { const int c_ = (cc); \
        const LAS bf16_t* Sc = Sb + (c_ & 1) * RMAT; LAS bf16_t* Sn = Sb + ((c_ + 1) & 1) * RMAT; \
        const bf16x8 a0 = __builtin_bit_cast(bf16x8, R.fa0), a1 = __builtin_bit_cast(bf16x8, R.fa1); \
        const LAS bf16_t* sp0 = Sc + ((2 * vh) * 16 + l15) * RP + 8 * l4; const LAS bf16_t* sp1 = sp0 + 16 * RP; \
        const bf16x8 s00 = *(const LAS bf16x8*)sp0, s01 = *(const LAS bf16x8*)(sp0 + 32), s10 = *(const LAS bf16x8*)sp1, s11 = *(const LAS bf16x8*)(sp1 + 32); \
        bf16_t* sg = (bf16_t*)(ws + WS_RC + (u0 + c_ - 1) * RC_UNIT) + 4096;     \
        if (STORE && c_ > 0) *(u32x4*)(sg + (F.tid >> 3) * 64 + (F.tid & 7) * 8) = *(const LAS u32x4*)(Sc + (F.tid >> 3) * RP + (F.tid & 7) * 8);     \
        f32x4 t0 = {0.f, 0.f, 0.f, 0.f}, t1 = {0.f, 0.f, 0.f, 0.f}; \
        t0 = __builtin_amdgcn_mfma_f32_16x16x32_bf16(a0, s00, t0, 0, 0, 0); t1 = __builtin_amdgcn_mfma_f32_16x16x32_bf16(a0, s10, t1, 0, 0, 0); \
        t0 = __builtin_amdgcn_mfma_f32_16x16x32_bf16(a1, s01, t0, 0, 0, 0); t1 = __builtin_amdgcn_mfma_f32_16x16x32_bf16(a1, s11, t1, 0, 0, 0); \
        const f32x4 n0 = {bflo(R.ad0.x), bfhi(R.ad0.x), bflo(R.ad0.y), bfhi(R.ad0.y)}, n1 = {bflo(R.ad1.x), bfhi(R.ad1.x), bflo(R.ad1.y), bfhi(R.ad1.y)}; \
        st0 = st0 * R.om - t0 + n0; st1 = st1 * R.om - t1 + n1; \
        st_bf4(Sn + ((2 * vh) * 16 + l15) * RP + sk * 16 + 4 * l4, st0); st_bf4(Sn + ((2 * vh + 1) * 16 + l15) * RP + sk * 16 + 4 * l4, st1); \
        R = scan_load(ws, u0 + (c_ + 4 < NCHUNK ? c_ + 4 : NCHUNK - 1), sk, vh, l15, l4);     \
        LBAR(); } while (0)
#pragma unroll 1
    for (int c = 0; c < NCHUNK; c += 16) {
#pragma unroll
        for (int j = 0; j < 16; j += 4) { SCAN_STEP(r0, c + j); SCAN_STEP(r1, c + j + 1); SCAN_STEP(r2, c + j + 2); SCAN_STEP(r3, c + j + 3); } }
#undef SCAN_STEP
}

struct OutOps { bf16x8 q0, q1, s00, s01, s10, s11; u32x2 z0, z1; u32x4 cv, cg; float cbc; };
__device__ __forceinline__ OutOps out_load(const unsigned char* ws, int u, int tb, int vh, int l15, int l4, int tt, int c8) {
    OutOps o; const int c = u & 127, h = (u >> 7) & 7, b = u >> 10;
    const bf16_t* base = (const bf16_t*)(ws + WS_RC + (size_t)u * RC_UNIT);
    const bf16_t* Sg = (const bf16_t*)(ws + WS_RC + (size_t)(u > 0 ? u - 1 : 0) * RC_UNIT) + 4096; const bf16_t* QT = base + 8192; const bf16_t* Z = base + 12288;
    o.q0 = *(const bf16x8*)(QT + (tb * 16 + l15) * 64 + 8 * l4); o.q1 = *(const bf16x8*)(QT + (tb * 16 + l15) * 64 + 32 + 8 * l4);
    const bf16_t* sp0 = Sg + ((2 * vh) * 16 + l15) * 64 + 8 * l4; const bf16_t* sp1 = sp0 + 16 * 64;
    o.s00 = *(const bf16x8*)sp0; o.s01 = *(const bf16x8*)(sp0 + 32); o.s10 = *(const bf16x8*)sp1; o.s11 = *(const bf16x8*)(sp1 + 32);
    o.z0 = *(const u32x2*)(Z + ((2 * vh) * 16 + l15) * 64 + tb * 16 + 4 * l4); o.z1 = *(const u32x2*)(Z + ((2 * vh + 1) * 16 + l15) * 64 + tb * 16 + 4 * l4);
    const int m = b * SEQ + c * 64 + tt, chq = h * 64 + c8;
    o.cv = *(const u32x4*)(base + 16384 + tt * 64 + c8); o.cg = *(const u32x4*)((const bf16_t*)(ws + WS_LO) + (size_t)m * LO_W + 1024 + chq);
    o.cbc = ((const float*)(ws + WS_RC2))[(size_t)u * 128 + 64 + tt]; return o;
}
__device__ __forceinline__ void rwkv_out(const Frame& F, const float* lnx_) {
    unsigned char* ws = F.ws;
    LAS float* Yl = (LAS float*)F.lds;
    const int lane = F.lane, w = F.wave, l15 = lane & 15, l4 = lane >> 4, tb = w & 3, vh = w >> 2;
    const int tt = F.tid >> 3, c8 = (F.tid & 7) * 8;
    OutOps cur = out_load(ws, F.blk, tb, vh, l15, l4, tt, c8);
    for (int u = F.blk; u < NB * 8 * NCHUNK; u += F.G) {
        const int c = u & 127, h = (u >> 7) & 7, b = u >> 10;
        const OutOps o = cur;
        { const int un = u + F.G < NB * 8 * NCHUNK ? u + F.G : u; cur = out_load(ws, un, tb, vh, l15, l4, tt, c8); }
        f32x4 y0 = {bflo(o.z0.x), bfhi(o.z0.x), bflo(o.z0.y), bfhi(o.z0.y)}, y1 = {bflo(o.z1.x), bfhi(o.z1.x), bflo(o.z1.y), bfhi(o.z1.y)};
        if (c > 0) {
            y0 = __builtin_amdgcn_mfma_f32_16x16x32_bf16(o.q0, o.s00, y0, 0, 0, 0); y1 = __builtin_amdgcn_mfma_f32_16x16x32_bf16(o.q0, o.s10, y1, 0, 0, 0);
            y0 = __builtin_amdgcn_mfma_f32_16x16x32_bf16(o.q1, o.s01, y0, 0, 0, 0); y1 = __builtin_amdgcn_mfma_f32_16x16x32_bf16(o.q1, o.s11, y1, 0, 0, 0); }
        const int m = b * SEQ + c * 64 + tt, chq = h * 64 + c8;
        const f32x4 ln0 = *(const f32x4*)(lnx_ + chq), ln1 = *(const f32x4*)(lnx_ + chq + 4);
        LBAR();
#pragma unroll
        for (int r = 0; r < 4; ++r) { Yl[(tb * 16 + 4 * l4 + r) * 68 + (2 * vh) * 16 + l15] = y0[r]; Yl[(tb * 16 + 4 * l4 + r) * 68 + (2 * vh + 1) * 16 + l15] = y1[r]; }
        LBAR();
        const f32x4 ya = *(const LAS f32x4*)(Yl + tt * 68 + c8), yb = *(const LAS f32x4*)(Yl + tt * 68 + c8 + 4);
        float yy[8] = {ya[0], ya[1], ya[2], ya[3], yb[0], yb[1], yb[2], yb[3]};
        float s1 = ((yy[0] + yy[1]) + (yy[2] + yy[3])) + ((yy[4] + yy[5]) + (yy[6] + yy[7]));
        s1 = sum8(s1); const float mean = s1 * (1.0f / 64.0f); float s2 = 0.f;
#pragma unroll
        for (int i = 0; i < 8; ++i) { yy[i] -= mean; s2 += yy[i] * yy[i]; }
        s2 = sum8(s2); const float rstd = rsqrtf(s2 * (1.0f / 64.0f) + 64e-5f);
        const unsigned vw[4] = {o.cv.x, o.cv.y, o.cv.z, o.cv.w}, gw[4] = {o.cg.x, o.cg.y, o.cg.z, o.cg.w};
        const float lnx[8] = {ln0[0], ln0[1], ln0[2], ln0[3], ln1[0], ln1[1], ln1[2], ln1[3]};
        unsigned ow[4];
#pragma unroll
        for (int i = 0; i < 4; ++i) { float o2[2];
#pragma unroll
            for (int e = 0; e < 2; ++e) { const int ci = 2 * i + e; const float v = e ? bfhi(vw[i]) : bflo(vw[i]), g = e ? bfhi(gw[i]) : bflo(gw[i]);
                o2[e] = (yy[ci] * rstd * lnx[ci] + o.cbc * v) * g; }
            ow[i] = pk2(o2[0], o2[1]); }
        *(u32x4*)((bf16_t*)(ws + WS_YRW) + (size_t)m * 512 + chq) = (u32x4){ow[0], ow[1], ow[2], ow[3]};
    }
    __syncthreads();
}
__device__ __forceinline__ void rwkv_seq(const Frame& F, const Params& P, int layer, int b, int h) {
    unsigned char* ws = F.ws; const bf16_t* p = (const bf16_t*)(ws + WS_P); const bf16_t* lo = (const bf16_t*)(ws + WS_LO);
    LAS float* Lr = (LAS float*)F.lds; LAS float* Lw = Lr + 4096; LAS float* Lk = Lw + 4096; LAS float* Lv = Lk + 4096; LAS float* Lkk = Lv + 4096; LAS float* Lb = Lkk + 4096; LAS float* Ly = Lb + 4096;
    const int lane = F.lane, ch = h * 64 + lane;
    const float mu_r = P.in[I_MU][(size_t)layer * RWKV_COLS + ch], mu_k = P.in[I_MU][(size_t)layer * RWKV_COLS + 512 + ch], mu_v = P.in[I_MU][(size_t)layer * RWKV_COLS + 1024 + ch];
    const float k_k = P.in[I_KK][layer * 512 + ch], k_a = P.in[I_KA][layer * 512 + ch], r_k = P.in[I_RK][layer * 512 + ch], lnx = P.in[I_LNX][layer * 512 + ch];
    const int vrow = F.tid >> 3, q = F.tid & 7;
    float s[8];
#pragma unroll
    for (int i = 0; i < 8; ++i) s[i] = 0.f;
    for (int c = 0; c < NCHUNK; ++c) {
        const int m0 = b * SEQ + c * 64;
        __syncthreads();
#pragma unroll
        for (int i = 0; i < 8; ++i) { const int t = F.wave + 8 * i, m = m0 + t; const bf16_t* pr = p + (size_t)m * PW + P_RW + ch; const bool hp = (c | t) != 0;
            const float xr = bf2f(pr[0]), xk = bf2f(pr[512]), xv = bf2f(pr[1024]);
            const float pr_ = hp ? bf2f(pr[-PW]) : 0.f, pk_ = hp ? bf2f(pr[512 - PW]) : 0.f, pv_ = hp ? bf2f(pr[1024 - PW]) : 0.f;
            const float r = xr + (pr_ - xr) * mu_r, k = xk + (pk_ - xk) * mu_k, v = xv + (pv_ - xv) * mu_v;
            const float lw = bf2f(lo[(size_t)m * LO_W + ch]), a = bf2f(lo[(size_t)m * LO_W + 512 + ch]);
            float kk = k * k_k; const float ss = wave_sum(kk * kk); kk *= rsqrtf(ss + 1e-12f);
            Lr[t * 64 + lane] = r; Lw[t * 64 + lane] = __expf(lw); Lk[t * 64 + lane] = k * (1.0f + (a - 1.0f) * k_a); Lv[t * 64 + lane] = v; Lkk[t * 64 + lane] = kk; Lb[t * 64 + lane] = kk * a; }
        __syncthreads();
        for (int t = 0; t < 64; ++t) {
            const f32x4 ka = *(const LAS f32x4*)(Lkk + t * 64 + q * 8), kb = *(const LAS f32x4*)(Lkk + t * 64 + q * 8 + 4);
            const f32x4 wa = *(const LAS f32x4*)(Lw + t * 64 + q * 8), wb = *(const LAS f32x4*)(Lw + t * 64 + q * 8 + 4);
            const f32x4 ba = *(const LAS f32x4*)(Lb + t * 64 + q * 8), bb = *(const LAS f32x4*)(Lb + t * 64 + q * 8 + 4);
            const f32x4 k2a = *(const LAS f32x4*)(Lk + t * 64 + q * 8), k2b = *(const LAS f32x4*)(Lk + t * 64 + q * 8 + 4);
            const f32x4 ra = *(const LAS f32x4*)(Lr + t * 64 + q * 8), rb = *(const LAS f32x4*)(Lr + t * 64 + q * 8 + 4);
            const float vv = Lv[t * 64 + vrow];
            float sa = 0.f;
#pragma unroll
            for (int i = 0; i < 4; ++i) { sa += s[i] * ka[i]; sa += s[4 + i] * kb[i]; }
            sa = sum8(sa); sa = -sa;
            float y = 0.f;
#pragma unroll
            for (int i = 0; i < 4; ++i) { s[i] = s[i] * wa[i] + sa * ba[i] + vv * k2a[i]; s[4 + i] = s[4 + i] * wb[i] + sa * bb[i] + vv * k2b[i]; y += s[i] * ra[i]; y += s[4 + i] * rb[i]; }
            y = sum8(y);
            if (q == 0) Ly[t * 64 + vrow] = y;
        }
        __syncthreads();
#pragma unroll
        for (int i = 0; i < 8; ++i) { const int t = F.wave + 8 * i, m = m0 + t;
            const float y = Ly[t * 64 + lane]; const float mean = wave_sum(y) * (1.0f / 64.0f); const float d = y - mean; const float var = wave_sum(d * d) * (1.0f / 64.0f);
            const float bon = wave_sum(Lr[t * 64 + lane] * Lk[t * 64 + lane] * r_k);
            const float g = bf2f(lo[(size_t)m * LO_W + 1024 + ch]);
            const float o = (d * rsqrtf(var + 64e-5f) * lnx + bon * Lv[t * 64 + lane]) * g;
            ((bf16_t*)(ws + WS_YRW))[(size_t)m * 512 + ch] = (bf16_t)f2bf(o); }
    }
    __syncthreads();
}

constexpr int LDS_TAB = LDSCTL_OFF + 64;
__device__ __forceinline__ void moe_table(const Frame& F, const unsigned* ectl) {
    LAS int* tab = (LAS int*)(F.lds + LDS_TAB);
    if (F.tid == 0) { int st = 0, nt = 0;
        for (int e = 0; e < 8; ++e) { const int c = (int)__hip_atomic_load(&ectl[e], __ATOMIC_RELAXED, __HIP_MEMORY_SCOPE_AGENT); tab[1 + e] = st; const int t = (c + 255) >> 8; for (int i = 0; i < t; ++i) tab[16 + nt + i] = e; nt += t; st += t * 256; }
        tab[0] = nt; }
    __syncthreads();
}
__device__ __forceinline__ void phase_moe_scatter(const Frame& F, const unsigned* ectl) {
    unsigned char* ws = F.ws; const LAS int* tab = (const LAS int*)(F.lds + LDS_TAB);
    const int* tok_e = (const int*)(ws + WS_TOK); int* tok_slot = (int*)tok_e + 2 * MTOK; const float* tok_w = (const float*)(tok_slot + 2 * MTOK);
    int* row_tok = (int*)(tok_w + 2 * MTOK); float* row_w = (float*)(row_tok + MAXROWS);
    for (int i = F.blk * NTHR + F.tid; i < 2 * MTOK; i += F.G * NTHR) { const int e = tok_e[i]; const int dest = tab[1 + e] + tok_slot[i]; row_tok[dest] = i >> 1; row_w[dest] = tok_w[i]; tok_slot[i] = dest; }
    const int gt = F.blk * NTHR + F.tid;
    if (gt < 2048) { const int e = gt >> 8; const int c = (int)__hip_atomic_load(&ectl[e], __ATOMIC_RELAXED, __HIP_MEMORY_SCOPE_AGENT); const int r = c + (gt & 255);
        if (r < ((c + 255) & ~255)) { row_tok[tab[1 + e] + r] = -1; row_w[tab[1 + e] + r] = 0.f; } }
}
constexpr int LDS_GTAB = RING_BYTES;
__device__ __forceinline__ void moe_gather_table(const Frame& F, int ncol) {
    const LAS int* tab = (const LAS int*)(F.lds + LDS_TAB); LAS unsigned* gt = (LAS unsigned*)(F.lds + LDS_GTAB);
    const int* row_tok = (const int*)(F.ws + WS_TOK) + 6 * MTOK; const int total = tab[0] * ncol;
    for (int i = F.tid; i < 9 * 256; i += NTHR) { const int u = i >> 8, r = i & 255; const int L = u * F.G + F.blk; unsigned off = 0u;
        if (L < total) { const int tk = row_tok[(L / ncol) * 256 + r]; off = tk > 0 ? (unsigned)tk * (unsigned)(DM * 2) : 0u; }
        gt[i] = off; }
    __syncthreads();
}

extern __shared__ __attribute__((aligned(16))) unsigned char lds_raw[];
template <class T> __device__ __forceinline__ T* uni(T* p) { const unsigned long long v = (unsigned long long)p; const unsigned lo = __builtin_amdgcn_readfirstlane((unsigned)v), hi = __builtin_amdgcn_readfirstlane((unsigned)(v >> 32)); return (T*)(((unsigned long long)hi << 32) | lo); }
__device__ __forceinline__ int uni(int v) { return __builtin_amdgcn_readfirstlane(v); }
__device__ __forceinline__ Frame mkframe(unsigned char* ws, int wv) {
    Frame F; F.lds = (LAS unsigned char*)lds_raw; int tid = wv * 64 + lane_id_fresh(); F.tid = tid; F.lane = F.tid & 63; F.wave = __builtin_amdgcn_readfirstlane(F.tid >> 6);
    int blk = blockIdx.x; asm volatile("" : "+s"(blk)); F.blk = blk; F.G = gridDim.x; F.vcu = (F.blk & 7) * (F.G >> 3) + (F.blk >> 3); F.gw = F.blk * NWAVES + F.wave; F.ngw = F.G * NWAVES; F.ws = ws; return F;
}
#define PHASE __device__ __forceinline__ void
template <int PART>
PHASE f_moe_convert(int wv, unsigned char* ws_, const float* mg, const float* mu, const float* md) {
    unsigned char* ws = uni(ws_); const Frame F = mkframe(ws, wv); Params P; P.in[I_MG] = uni(mg); P.in[I_MU2] = uni(mu); P.in[I_MD] = uni(md);
    if (PART == 0) { __syncthreads(); phase_moe_convert<0>(F, P, F.gw, F.ngw); }
    else if (F.blk >= 32) { __syncthreads(); phase_moe_convert<1>(F, P, (F.blk - 32) * NWAVES + F.wave, (F.G - 32) * NWAVES); }
}
PHASE f_rms_moe(int wv, unsigned char* ws_, const bf16_t* src, const float* gain, const float* router) {
    unsigned char* ws = uni(ws_); const Frame F = mkframe(ws, wv); int* tok_e = (int*)(ws + WS_TOK); int* tok_slot = tok_e + 2 * MTOK; float* tok_w = (float*)(tok_slot + 2 * MTOK);
    phase_rms<true>(F, uni(src), uni(gain), (bf16_t*)(ws + WS_HN), uni(router), (unsigned*)(ws + WS_CTL) + CW_ECNT, tok_e, tok_slot, tok_w);
}
PHASE f_prep(int wv, unsigned char* ws_, const float* mu, const float* qnorm, const float* kvnorm, int layer_) {
    unsigned char* ws = uni(ws_); const Frame F = mkframe(ws, wv); Params P; P.in[I_MU] = uni(mu); P.in[I_QNORM] = uni(qnorm); P.in[I_KVNORM] = uni(kvnorm); (void)layer_; phase_prep(F, P, 0);
}
PHASE f_ret_scan(int wv, unsigned char* ws_) { unsigned char* ws = uni(ws_); const Frame F = mkframe(ws, wv); ret_scan(F); }
PHASE f_ret_out(int wv, unsigned char* ws_) { unsigned char* ws = uni(ws_); const Frame F = mkframe(ws, wv); ret_out(F); }
PHASE f_rwkv_seq(int wv, unsigned char* ws_, const float* mu, const float* kk, const float* ka, const float* rk, const float* lnx, int layer_) {
    unsigned char* ws = uni(ws_); const Frame F = mkframe(ws, wv); Params P; P.in[I_MU] = uni(mu); P.in[I_KK] = uni(kk); P.in[I_KA] = uni(ka); P.in[I_RK] = uni(rk); P.in[I_LNX] = uni(lnx);
    (void)layer_; rwkv_seq(F, P, 0, F.blk >> 3, F.blk & 7);
}
PHASE f_rwkv_pre(int wv, unsigned char* ws_, const float* mu, const float* kk, const float* ka, const float* rk) { unsigned char* ws = uni(ws_); const Frame F = mkframe(ws, wv); rwkv_chunk_pre<0>(F, uni(mu), uni(kk), uni(ka), uni(rk));
#ifdef PRE_DIAG
    rwkv_chunk_pre<PRE_DIAG>(F, uni(mu), uni(kk), uni(ka), uni(rk));
#endif
}
PHASE f_rwkv_scan(int wv, unsigned char* ws_) { unsigned char* ws = uni(ws_); const Frame F = mkframe(ws, wv); rwkv_scan<true>(F, F.blk >> 3, F.blk & 7);
#ifdef SCAN_TWICE
    __syncthreads(); rwkv_scan<false>(F, F.blk >> 3, F.blk & 7);
#endif
}
PHASE f_rwkv_out(int wv, unsigned char* ws_, const float* lnx) { unsigned char* ws = uni(ws_); const Frame F = mkframe(ws, wv); rwkv_out(F, uni(lnx)); }
PHASE f_attn(int wv, unsigned char* ws_, int layer_) {
    unsigned char* ws = uni(ws_); const int layer = uni(layer_); const Frame F = mkframe(ws, wv);
    unsigned* qh = (unsigned*)(ws + WS_CTL) + CW_ATTQ + layer * 512; volatile LAS unsigned* slot = (volatile LAS unsigned*)(F.lds + LDSCTL_OFF + 32);
    const int my = (int)(xb_xcc_id() & 7u);
    for (int k = 0; k < 8; ++k) { const int q = (my + k) & 7;
        for (;;) {
            if (F.tid == 0) *slot = __hip_atomic_fetch_add(qh + q * 64, 1u, __ATOMIC_RELAXED, __HIP_MEMORY_SCOPE_AGENT);
            __syncthreads();
            const int idx = (int)*slot;
            __syncthreads();
            if (idx >= 64) break;
            const int bh = 2 * q + (idx & 1), qt = 31 - (idx >> 1);
            attn_unit(F, bh >> 3, bh & 7, qt);
        } }
}
PHASE f_moe_scatter(int wv, unsigned char* ws_) { unsigned char* ws = uni(ws_); const Frame F = mkframe(ws, wv); moe_table(F, (unsigned*)(ws + WS_CTL) + CW_ECNT); phase_moe_scatter(F, (unsigned*)(ws + WS_CTL) + CW_ECNT); }
PHASE f_final(int wv, unsigned char* ws_, float* h, const float* gain) { unsigned char* ws = uni(ws_); const Frame F = mkframe(ws, wv); phase_final(F, uni(h), uni(gain), (const bf16_t*)(ws + WS_OUT2), (const int*)(ws + WS_TOK) + 2 * MTOK); }
constexpr int DEFER_BLK0 = 128;
PHASE f_defer_a(int wv, unsigned char* ws_, const float* wqb, const float* wbr, const float* wo, const float* fg, const float* fu, const float* fd, const float* w2, const float* a2, const float* g2, const float* wkvb, const float* pos) {
    unsigned char* ws = uni(ws_); const Frame F = mkframe(ws, wv); Params P; P.in[I_WIN] = nullptr; P.in[I_WQB] = uni(wqb); P.in[I_WBR] = uni(wbr); P.in[I_WO] = uni(wo); P.in[I_FG] = uni(fg); P.in[I_FU] = uni(fu); P.in[I_FD] = uni(fd);
    P.in[I_W2] = uni(w2); P.in[I_A2] = uni(a2); P.in[I_G2] = uni(g2); P.in[I_WKVB] = uni(wkvb); P.in[I_POS] = uni(pos);
    __syncthreads();
    constexpr int NW = (256 - DEFER_BLK0) * NWAVES, NA = pro::NIT - 2 * pro::I_IN;
    pro_tiles<NA / NW>(F, P, 2 * pro::I_IN, (F.blk - DEFER_BLK0) * NWAVES + F.wave, NW, NA % NW);
    pro_small(F, P, (F.blk - DEFER_BLK0) * NTHR + F.tid, (256 - DEFER_BLK0) * NTHR, F.blk - DEFER_BLK0, 256 - DEFER_BLK0);
}
PHASE f_defer_b(int wv, unsigned char* ws_, const float* win) {
    unsigned char* ws = uni(ws_); const Frame F = mkframe(ws, wv); Params P; P.in[I_WIN] = uni(win); P.in[I_WQB] = nullptr; P.in[I_WBR] = nullptr; P.in[I_WO] = nullptr; P.in[I_FG] = nullptr; P.in[I_FU] = nullptr; P.in[I_FD] = nullptr;
    __syncthreads();
    constexpr int NW = (256 - DEFER_BLK0) * NWAVES;
    pro_tiles<pro::I_IN / NW>(F, P, pro::I_IN, (F.blk - DEFER_BLK0) * NWAVES + F.wave, NW, pro::I_IN % NW);
}
PHASE g_inproj(int wv, unsigned char* ws_, int layer_) {
    unsigned char* ws = uni(ws_); const int layer = uni(layer_); const Frame F = mkframe(ws, wv);
    SchedGrid S; S.init(64, 18, F.G, F.blk, ws + WS_HN, (size_t)256 * DM * 2, (bf16_t*)(ws + WS_WIN) + (size_t)layer * WIN_ROWS * DM, (size_t)256 * DM * 2);
    EpiStore E; E.O = (bf16_t*)(ws + WS_P); E.ld = PW; E.SS = (const float*)(ws + WS_SS); E.rl = (LAS float*)(F.lds + RING_BYTES); E.tid = F.tid; pg8::gemm_phase(F.lds, F.tid, DM, DM, DM, S, E);
}
PHASE g_lora(int wv, unsigned char* ws_, const float* w0, const float* a0, int layer_) {
    unsigned char* ws = uni(ws_); const int layer = uni(layer_); const Frame F = mkframe(ws, wv);
    SchedGrid S; S.init(64, 6, F.G, F.blk, ws + WS_LIN, (size_t)256 * LORA_K * 2, (bf16_t*)(ws + WS_LORA) + (size_t)layer * 1536 * LORA_K, (size_t)256 * LORA_K * 2);
    EpiLora E; E.O = (bf16_t*)(ws + WS_LO); E.w0 = uni(w0); E.a0 = uni(a0); pg8::gemm_phase(F.lds, F.tid, LORA_K, LORA_K, LORA_K, S, E);
}
PHASE g_small(int wv, unsigned char* ws_, int layer_) {
    unsigned char* ws = uni(ws_); const Frame F = mkframe(ws, wv); SchedSmall S; S.G = F.G; S.c = F.blk; S.layer = uni(layer_); S.ws = (const char*)ws; EpiSmall E; E.ws = ws; pg8::gemm_phase(F.lds, F.tid, 256, 256, 256, S, E);
}
PHASE g_gate(int wv, unsigned char* ws_, int layer_) {
    unsigned char* ws = uni(ws_); const int layer = uni(layer_); const Frame F = mkframe(ws, wv);
    SchedOwn3 S; S.c = F.blk; S.G = F.G; S.A = (const char*)(ws + WS_HN); S.a_n = 0; S.astep = (size_t)256 * DM * 2; S.B = (const char*)((bf16_t*)(ws + WS_WIN) + ((size_t)layer * WIN_ROWS + PW) * DM); S.bstep = (size_t)256 * DM * 2; S.b_n = (size_t)1024 * DM * 2;
    EpiGate E; E.O = (bf16_t*)(ws + WS_G); E.SS = (const float*)(ws + WS_SS); E.rl = (LAS float*)(F.lds + RING_BYTES); E.tid = F.tid; pg8::gemm_phase(F.lds, F.tid, DM, DM, DM, S, E);
}
PHASE g_merge(int wv, unsigned char* ws_, int layer_) {
    unsigned char* ws = uni(ws_); const int layer = uni(layer_); const Frame F = mkframe(ws, wv);
    SchedOwn3 S; S.c = F.blk; S.G = F.G; S.A = (const char*)(ws + WS_YRET); S.a_n = (size_t)16 * MiB; S.astep = (size_t)256 * 512 * 2;
    S.B = (const char*)((bf16_t*)(ws + WS_BR) + (size_t)layer * 3 * 1024 * 512); S.bstep = (size_t)256 * 512 * 2; S.b_n = (size_t)1024 * 512 * 2;
    EpiMerge E; E.Gt = (const bf16_t*)(ws + WS_G); E.Mg = (bf16_t*)(ws + WS_MRG); pg8::gemm_phase(F.lds, F.tid, 512, 512, 512, S, E);
}
template <bool EMIT, bool IN_F32>
PHASE g_wo(int wv, unsigned char* ws_, const void* hin, bf16_t* hout, const float* gain, int layer_) {
    unsigned char* ws = uni(ws_); const int layer = uni(layer_); const Frame F = mkframe(ws, wv);
    SchedGrid S; S.init(64, 4, F.G, F.blk, ws + WS_MRG, (size_t)256 * DM * 2, (bf16_t*)(ws + WS_WO) + (size_t)layer * DM * DM, (size_t)256 * DM * 2);
    EpiResid<EMIT, IN_F32> E; E.In = uni(hin); E.Out = uni(hout); E.gain = uni(gain); E.Hg = (bf16_t*)(ws + WS_HN); E.SS = (float*)(ws + WS_SS); pg8::gemm_phase(F.lds, F.tid, DM, DM, DM, S, E);
}
PHASE g_ffn_gu(int wv, unsigned char* ws_) {
    unsigned char* ws = uni(ws_); const Frame F = mkframe(ws, wv);
    SchedGrid S; S.init(64, 22, F.G, F.blk, ws + WS_HN, (size_t)256 * DM * 2, ws + WS_FGU, (size_t)256 * DM * 2);
    EpiSwiglu E; E.O = (bf16_t*)(ws + WS_ACT); E.ldc = DFF; E.pn_off = 0; E.SS = (const float*)(ws + WS_SS); E.rl = (LAS float*)(F.lds + RING_BYTES); E.tid = F.tid; pg8::gemm_phase(F.lds, F.tid, DM, DM, DM, S, E);
}
PHASE g_ffn_down(int wv, unsigned char* ws_, bf16_t* h, const float* gain) {
    unsigned char* ws = uni(ws_); const Frame F = mkframe(ws, wv);
    SchedGrid S; S.init(64, 4, F.G, F.blk, ws + WS_ACT, (size_t)256 * DFF * 2, ws + WS_FD, (size_t)256 * DFF * 2);
    EpiResid<true, false> E; E.Out = uni(h); E.In = E.Out; E.gain = uni(gain); E.Hg = (bf16_t*)(ws + WS_HN); E.SS = (float*)(ws + WS_SS); pg8::gemm_phase(F.lds, F.tid, DFF, DFF, DFF, S, E);
}
PHASE g_moe_gu(int wv, unsigned char* ws_, int hh_) {
    unsigned char* ws = uni(ws_); const int hh = uni(hh_); const Frame F = mkframe(ws, wv); const LAS int* tab = (const LAS int*)(F.lds + LDS_TAB);
    moe_gather_table(F, 14);
    SchedMoe S; S.G = F.G; S.c = F.blk; S.ncol = 14; S.ntile = tab[0]; S.tab = tab + 16; S.A = (const char*)(ws + WS_HN); S.astep = 0;
    S.B = (const char*)(ws + WS_MGU) + (size_t)hh * 14 * 256 * DM * 2; S.bstep = (size_t)256 * DM * 2; S.estep = (size_t)2 * DFFE * DM * 2;
    EpiSwiglu E; E.O = (bf16_t*)(ws + WS_MACT); E.ldc = DFFH; E.pn_off = 0; E.SS = nullptr; E.rl = nullptr; E.tid = 0; pg8::gemm_phase<EpiSwiglu, SchedMoe, true>(F.lds, F.tid, DM, DM, DM, S, E, (const LAS unsigned*)(F.lds + LDS_GTAB));
}
template <bool ACCUM>
PHASE g_moe_down(int wv, unsigned char* ws_, int hh_) {
    unsigned char* ws = uni(ws_); const int hh = uni(hh_); const Frame F = mkframe(ws, wv); const LAS int* tab = (const LAS int*)(F.lds + LDS_TAB);
    const float* row_w = (const float*)((const int*)(ws + WS_TOK) + 6 * MTOK + MAXROWS);
    SchedMoe S; S.G = F.G; S.c = F.blk; S.ncol = 4; S.ntile = tab[0]; S.tab = tab + 16; S.A = (const char*)(ws + WS_MACT); S.astep = (size_t)256 * DFFH * 2;
    S.B = (const char*)(ws + WS_MD) + (size_t)hh * DFFH * 2; S.bstep = (size_t)256 * DFFE * 2; S.estep = (size_t)DM * DFFE * 2;
    EpiMoeOut<ACCUM> E; E.row_w = row_w; E.O = (bf16_t*)(ws + WS_OUT2); pg8::gemm_phase(F.lds, F.tid, DFFH, DFFH, DFFE, S, E);
}

typedef const __attribute__((address_space(4))) Params* KPtr;
__device__ __forceinline__ KPtr kargs() { KPtr k = (KPtr)__builtin_amdgcn_kernarg_segment_ptr(); asm volatile("" : "+s"(k)); return k; }
#define KIN(i) (kargs()->in[i])
#define KWS() (kargs()->ws)
struct TpState { unsigned long long tp0, tp1; int tpk; };
#define tp0 tps.tp0
#define tp1 tps.tp1
#define tpk tps.tpk
#define GRID_BAR() do { XcdBarrier b_ = bar; b_.bar = (unsigned*)(KWS() + WS_CTL) + CW_BAR; b_.x = xb_xcc_id(); xcd_barrier(b_); } while (0)
#ifdef TPH
#define TP(k) do { volatile LAS unsigned long long* tpl_ = (volatile LAS unsigned long long*)(lds_raw + LDSCTL_OFF + 48); if ((k) == TPH) tpl_[0] = __builtin_amdgcn_s_memrealtime(); if ((k) == TPH + TPN) tpl_[1] = __builtin_amdgcn_s_memrealtime(); } while (0)
#define TPM() do { ++tpk; TP(tpk); } while (0)
#else
#define TP(k) do { } while (0)
#define TPM() do { } while (0)
#endif
template <int layer>
__device__ __forceinline__ void layer_body(const int wv, const XcdBarrier& bar, TpState& tps) {
        g_inproj(wv, KWS(), layer);
        if constexpr (layer == 0) { if ((int)blockIdx.x >= DEFER_BLK0) f_defer_a(wv, KWS(), KIN(I_WQB), KIN(I_WBR), KIN(I_WO), KIN(I_FG), KIN(I_FU), KIN(I_FD), KIN(I_W2), KIN(I_A2), KIN(I_G2), KIN(I_WKVB), KIN(I_POS)); }
        GRID_BAR();
        TPM();
        f_prep(wv, KWS(), KIN(I_MU) + (size_t)layer * RWKV_COLS, KIN(I_QNORM) + layer * 256, KIN(I_KVNORM) + layer * 128, layer);
        GRID_BAR();
        TPM();
        f_ret_scan(wv, KWS());
        g_lora(wv, KWS(), KIN(I_W0) + layer * 512, KIN(I_A0) + layer * 512, layer);
        g_small(wv, KWS(), layer);
        GRID_BAR();
        TPM();
        f_ret_out(wv, KWS());
#ifdef SPLIT5
        GRID_BAR();
        TPM();
#endif
#ifndef RWKV_SEQ
        f_rwkv_pre(wv, KWS(), KIN(I_MU) + (size_t)layer * RWKV_COLS, KIN(I_KK) + layer * 512, KIN(I_KA) + layer * 512, KIN(I_RK) + layer * 512);
        GRID_BAR();
        TPM();
        if ((int)blockIdx.x < 16) f_rwkv_scan(wv, KWS());
#ifdef SPLIT6
        GRID_BAR();
        TPM();
#endif
#else
        GRID_BAR();
        TPM();
        if (blockIdx.x < 16) f_rwkv_seq(wv, KWS(), KIN(I_MU) + (size_t)layer * RWKV_COLS, KIN(I_KK) + layer * 512, KIN(I_KA) + layer * 512, KIN(I_RK) + layer * 512, KIN(I_LNX) + layer * 512, layer);
#endif
        f_attn(wv, KWS(), layer);
        GRID_BAR();
        TPM();
#ifndef RWKV_SEQ
        f_rwkv_out(wv, KWS(), KIN(I_LNX) + layer * 512);
#endif
        g_gate(wv, KWS(), layer);
#ifndef RWKV_SEQ
        GRID_BAR();
        TPM();
#endif
        g_merge(wv, KWS(), layer);
        GRID_BAR();
        TPM();
        g_wo<layer == 0, layer == 0>(wv, KWS(), layer == 0 ? (const void*)KIN(I_X) : (const void*)kargs()->out, (bf16_t*)kargs()->out, KIN(I_FNORM) + layer * DM, layer);
        GRID_BAR();
        TPM();
        if constexpr (layer == 0) {
            g_ffn_gu(wv, KWS());
            if ((int)blockIdx.x >= DEFER_BLK0) f_defer_b(wv, KWS(), KIN(I_WIN));
            GRID_BAR();
            TPM();
            g_ffn_down(wv, KWS(), (bf16_t*)kargs()->out, KIN(I_ANORM) + DM);
            GRID_BAR();
            TPM();
        } else {
            f_rms_moe(wv, KWS(), (const bf16_t*)kargs()->out, KIN(I_FNORM) + layer * DM, KIN(I_ROUTER));
            f_moe_convert<0>(wv, KWS(), KIN(I_MG), KIN(I_MU2), KIN(I_MD));
            GRID_BAR();
            TPM();
            f_moe_scatter(wv, KWS());
            GRID_BAR();
            TPM();
            g_moe_gu(wv, KWS(), 0);
            GRID_BAR();
            TPM();
            g_moe_down<false>(wv, KWS(), 0);
            f_moe_convert<1>(wv, KWS(), KIN(I_MG), KIN(I_MU2), KIN(I_MD));
            GRID_BAR();
            TPM();
            g_moe_gu(wv, KWS(), 1);
            GRID_BAR();
            TPM();
            g_moe_down<true>(wv, KWS(), 1);
            GRID_BAR();
            TPM();
        }
    }
__global__ void __launch_bounds__(NTHR, 2) mega(Params P_unused) {
    LAS unsigned char* lds = (LAS unsigned char*)lds_raw;
    const int wv = __builtin_amdgcn_readfirstlane((int)threadIdx.x >> 6);
    for (int u = threadIdx.x; u < (LDS_BYTES - LDSCTL_OFF) / 4; u += NTHR) ((LAS unsigned*)(lds + LDSCTL_OFF))[u] = 0u;
    __syncthreads();
    const XcdBarrier bar = xcd_barrier_post((unsigned*)(KWS() + WS_CTL) + CW_BAR, (volatile LAS unsigned*)(lds + LDSCTL_OFF), wv);
    TpState tps = {0ull, 0ull, 0};
    TP(0);
    {
        KPtr k = kargs(); unsigned char* ws = k->ws; const Frame F = mkframe(ws, wv);
        Params P; P.in[I_WIN] = k->in[I_WIN]; P.in[I_WQB] = k->in[I_WQB]; P.in[I_WBR] = k->in[I_WBR]; P.in[I_WO] = k->in[I_WO]; P.in[I_FG] = k->in[I_FG]; P.in[I_FU] = k->in[I_FU]; P.in[I_FD] = k->in[I_FD];
        P.in[I_W2] = k->in[I_W2]; P.in[I_A2] = k->in[I_A2]; P.in[I_G2] = k->in[I_G2]; P.in[I_WKVB] = k->in[I_WKVB]; P.in[I_POS] = k->in[I_POS]; P.in[I_X] = k->in[I_X]; P.in[I_ANORM] = k->in[I_ANORM];
        phase_prologue(F, P);
#ifdef PRO_SPIN
        { const unsigned long long t0_ = __builtin_amdgcn_s_memrealtime(); while (__builtin_amdgcn_s_memrealtime() - t0_ < (unsigned long long)PRO_SPIN) __builtin_amdgcn_s_sleep(8); }
#endif
    }
    GRID_BAR();
    TPM();
    layer_body<0>(wv, bar, tps);
    layer_body<1>(wv, bar, tps);
    f_final(wv, KWS(), kargs()->out, KIN(I_FINAL));
#ifdef PRE_T
    __syncthreads();
    { volatile LAS unsigned long long* tq_ = (volatile LAS unsigned long long*)(lds_raw + LDSCTL_OFF + 48); const unsigned long long te = __builtin_amdgcn_s_memrealtime(), span = tq_[1] * 8ull; while (__builtin_amdgcn_s_memrealtime() - te < span) __builtin_amdgcn_s_sleep(8); }
#endif
#ifdef TPH
    __syncthreads(); TPM();
    { volatile LAS unsigned long long* tpl_ = (volatile LAS unsigned long long*)(lds_raw + LDSCTL_OFF + 48); const unsigned long long te = __builtin_amdgcn_s_memrealtime(), span = (tpl_[1] - tpl_[0]) * (unsigned long long)TAMP; while (__builtin_amdgcn_s_memrealtime() - te < span) __builtin_amdgcn_s_sleep(8); }
#endif
}

extern "C" void kernel_launch(void* const* d_in, const int* in_sizes, int n_in, void* d_out, int out_size, void* d_ws, size_t ws_size, hipStream_t stream) {
    static int ready = 0;
    if (!ready) {
        if (n_in != 29 || out_size != MTOK * DM || ws_size < WS_END) { fprintf(stderr, "kernel_launch: unexpected shapes (n_in %d out %d ws %zu need %zu)\n", n_in, out_size, ws_size, (size_t)WS_END); ready = -1; return; }
        if (hipFuncSetAttribute((const void*)mega, hipFuncAttributeMaxDynamicSharedMemorySize, LDS_BYTES) != hipSuccess) { fprintf(stderr, "kernel_launch: hipFuncSetAttribute failed\n"); ready = -1; return; }
        int dev = 0, cus = 0, per_cu = 0; (void)hipGetDevice(&dev); (void)hipDeviceGetAttribute(&cus, hipDeviceAttributeMultiprocessorCount, dev);
        (void)hipOccupancyMaxActiveBlocksPerMultiprocessor(&per_cu, (const void*)mega, NTHR, LDS_BYTES);
        if (cus < 256 || per_cu < 1) { fprintf(stderr, "kernel_launch: needs 256 CUs with one resident workgroup each (cus %d, per_cu %d)\n", cus, per_cu); ready = -1; return; }
        ready = 1;
    }
    if (ready < 0) return;
    (void)hipMemsetAsync((char*)d_ws + WS_CTL, 0, CTL_BYTES, stream);
    Params p{}; for (int i = 0; i < 29; ++i) p.in[i] = (const float*)d_in[i]; p.out = (float*)d_out; p.ws = (unsigned char*)d_ws;
    hipLaunchKernelGGL(mega, dim3(256), dim3(NTHR), LDS_BYTES, stream, p);
}
```

```cpp
#include <hip/hip_runtime.h>
#include <cstdio>
#include <cstdint>

#define LAS __attribute__((address_space(3)))
#define GAS __attribute__((address_space(1)))
typedef unsigned short bf16_t;
typedef short bf16x8 __attribute__((ext_vector_type(8)));
typedef short bf16x4 __attribute__((ext_vector_type(4)));
typedef float f32x4 __attribute__((ext_vector_type(4)));
typedef float f32x2 __attribute__((ext_vector_type(2)));
typedef float f32x16 __attribute__((ext_vector_type(16)));
typedef unsigned u32x4 __attribute__((ext_vector_type(4)));
typedef unsigned u32x2 __attribute__((ext_vector_type(2)));

constexpr int NB = 2, SEQ = 8192, DM = 1024, MTOK = NB * SEQ, NLAYER = 2, CH = 64, NCHUNK = SEQ / CH;
constexpr int IN_COLS = 7360, PW = 4608;
constexpr int P_RQ = 0, P_RK = 512, P_RV = 1024, P_RG = 1536, P_RW = 2048, P_QA = 4096, P_KVA = 4352;
constexpr int WIN_ROWS = 7680;
constexpr int RWKV_COLS = 1824, LORA_K = 384, LO_W = 1536;
constexpr int DFF = 2816, DFFE = 3584, NEXP = 8, DFFH = DFFE / 2;
constexpr int MAXROWS = 34816;
constexpr float NORM_EPS = 1e-6f;

constexpr size_t MiB = 1u << 20;
constexpr size_t WS_CTL = 0, CTL_BYTES = 1 * MiB;
constexpr size_t WS_WIN = 1 * MiB;
constexpr size_t WS_LORA = 31 * MiB;
constexpr size_t WS_QB = 34 * MiB;
constexpr size_t WS_KB = 35 * MiB;
constexpr size_t WS_VB = 35 * MiB + 512 * 1024;
constexpr size_t WS_BR = 36 * MiB;
constexpr size_t WS_WO = 42 * MiB;
constexpr size_t WS_FGU = 46 * MiB;
constexpr size_t WS_FD = 57 * MiB;
constexpr size_t WS_COSR = 63 * MiB, WS_SINR = 67 * MiB, WS_COSM = 71 * MiB, WS_SINM = 72 * MiB;
constexpr size_t WS_HN = 73 * MiB;
constexpr size_t WS_TOK = 105 * MiB;
constexpr size_t WS_T = 106 * MiB;
constexpr size_t WS_P = WS_T;
constexpr size_t WS_G = WS_T;
constexpr size_t WS_MRG = WS_T + 96 * MiB;
constexpr size_t WS_LO = WS_T + 144 * MiB;
constexpr size_t WS_Q = WS_T + 192 * MiB;
constexpr size_t WS_KN = WS_T + 216 * MiB;
constexpr size_t WS_VT = WS_T + 232 * MiB;
constexpr size_t WS_KPE = WS_T + 248 * MiB;
constexpr size_t WS_LIN = WS_T + 249 * MiB;
constexpr size_t WS_QN = WS_T + 261 * MiB;
constexpr size_t WS_CN = WS_T + 269 * MiB;
constexpr size_t WS_YRET = WS_T + 261 * MiB;
constexpr size_t WS_RS = WS_T + 277 * MiB;
constexpr size_t WS_YRW = WS_T + 277 * MiB;
constexpr size_t WS_YMLA = WS_T + 293 * MiB;
constexpr size_t WS_RC = WS_T + 309 * MiB;
constexpr size_t WS_ACT = WS_T;
constexpr size_t WS_MGU = WS_T;
constexpr size_t WS_MD = WS_T + 112 * MiB;
constexpr size_t WS_MACT = WS_T + 168 * MiB;
constexpr size_t WS_OUT2 = WS_T + 287 * MiB;
constexpr size_t WS_SS = WS_T + 390 * MiB;
constexpr size_t WS_END = WS_T + 391 * MiB;
static_assert(WS_MACT + (size_t)MAXROWS * DFFH * 2 <= WS_OUT2 && WS_OUT2 + (size_t)MAXROWS * DM * 2 <= WS_END, "ws map");
constexpr int CW_BAR = 4096;
constexpr int CW_ECNT = 16384;
constexpr int CW_ATTQ = 20480;

__device__ __forceinline__ unsigned f2bf(float f) { unsigned u = __builtin_bit_cast(unsigned, f); return (u + 0x7fffu + ((u >> 16) & 1u)) >> 16; }
typedef __bf16 bf16n2 __attribute__((ext_vector_type(2)));
__device__ __forceinline__ unsigned pk2(float lo, float hi) { const f32x2 f = {lo, hi}; const bf16n2 v = __builtin_convertvector(f, bf16n2); return __builtin_bit_cast(unsigned, v); }
__device__ __forceinline__ float bf2f(unsigned short h) { return __builtin_bit_cast(float, (unsigned)h << 16); }
__device__ __forceinline__ float bflo(unsigned w) { return __builtin_bit_cast(float, w << 16); }
__device__ __forceinline__ float bfhi(unsigned w) { return __builtin_bit_cast(float, w & 0xffff0000u); }
template <int CTRL, int ROWMASK = 0xF>
__device__ __forceinline__ float dpp_add(float v) { const int t = __builtin_amdgcn_update_dpp(0, __builtin_bit_cast(int, v), CTRL, ROWMASK, 0xF, ROWMASK == 0xF); return v + __builtin_bit_cast(float, t); }
#ifdef NO_DPP
__device__ __forceinline__ float sum4(float v)  { v += __shfl_xor(v, 1); v += __shfl_xor(v, 2); return v; }
__device__ __forceinline__ float sum8(float v)  { v = sum4(v); v += __shfl_xor(v, 4); return v; }
__device__ __forceinline__ float sum16(float v) { v = sum8(v); v += __shfl_xor(v, 8); return v; }
__device__ __forceinline__ float wave_sum(float v) { v = sum16(v); v += __shfl_xor(v, 16); v += __shfl_xor(v, 32); return v; }
#else
__device__ __forceinline__ float sum4(float v)  { v = dpp_add<0xB1>(v); return dpp_add<0x4E>(v); }
__device__ __forceinline__ float sum8(float v)  { return dpp_add<0x141>(sum4(v)); }
__device__ __forceinline__ float sum16(float v) { return dpp_add<0x140>(sum8(v)); }
__device__ __forceinline__ float wave_sum(float v) {
    v = sum16(v); v = dpp_add<0x142, 0xA>(v); v = dpp_add<0x143, 0xC>(v);
    return __builtin_bit_cast(float, __builtin_amdgcn_readlane(__builtin_bit_cast(int, v), 63));
}
#endif
__device__ __forceinline__ float sigmoidf_(float x) { return 1.0f / (1.0f + __expf(-x)); }
#define LDS_WAIT() asm volatile("s_waitcnt lgkmcnt(0)" ::: "memory")
#define LBAR() do { asm volatile("s_waitcnt lgkmcnt(0)" ::: "memory"); __builtin_amdgcn_s_barrier(); asm volatile("" ::: "memory"); } while (0)
#define VM_WAIT() asm volatile("s_waitcnt vmcnt(0)" ::: "memory")

#define XB_TMO      128
#define XB_XCNT(j)  (256  + 64 * (j))
#define XB_XSUB(j)  (1280 + 64 * (j))
#define XB_XGEN(j)  (2304 + 64 * (j))
#define XB_TOP      3328
#define XB_TOPGEN   3392
#define XCD_BAR_WORDS 3456
#define XB_SPIN_CAP (1u << 18)
__device__ __forceinline__ unsigned xb_ld(unsigned* p)              { return __hip_atomic_load(p, __ATOMIC_RELAXED, __HIP_MEMORY_SCOPE_AGENT); }
__device__ __forceinline__ unsigned xb_add(unsigned* p, unsigned v) { return __hip_atomic_fetch_add(p, v, __ATOMIC_RELAXED, __HIP_MEMORY_SCOPE_AGENT); }
__device__ __forceinline__ unsigned xb_xcc_id() { return (unsigned)__builtin_amdgcn_s_getreg((3 << 11) | 20) & 0xFu; }
#define XB_SPIN(cond, bar) do { unsigned _sp = 0; while (cond) { __builtin_amdgcn_s_sleep(1); \
    if ((++_sp & 255u) == 0u) { if (xb_ld(&(bar)[XB_TMO])) break; if (_sp > XB_SPIN_CAP) { atomicAdd(&(bar)[XB_TMO], 1u); break; } } } } while (0)
struct XcdBarrier { unsigned* bar; unsigned x; volatile LAS unsigned* st; int wv; };
__device__ __forceinline__ int lane_id_fresh() { int l; asm volatile("v_mbcnt_lo_u32_b32 %0, -1, 0\n\tv_mbcnt_hi_u32_b32 %0, -1, %0" : "=v"(l)); return l; }
__device__ __forceinline__ bool xb_thread0(int wv) { return wv == 0 && lane_id_fresh() == 0; }
__device__ __forceinline__ XcdBarrier xcd_barrier_post(unsigned* bar, volatile LAS unsigned* st, int wv) {
    XcdBarrier b; b.bar = bar; b.x = xb_xcc_id(); b.st = st; b.wv = wv;
    if (xb_thread0(wv)) (void)xb_add(&bar[XB_XCNT(b.x)], 1u);
    return b;
}
__device__ __forceinline__ void xcd_barrier_complete(unsigned* bar, unsigned x, unsigned& nloc, unsigned& nx) {
    const unsigned G = gridDim.x * gridDim.y * gridDim.z;
    unsigned sum, cnt, mine, sp = 0u;
    for (;;) {
        sum = 0u; cnt = 0u; mine = 0u;
#pragma unroll
        for (unsigned j = 0; j < 16; ++j) { const unsigned c = xb_ld(&bar[XB_XCNT(j)]); sum += c; cnt += (c > 0u) ? 1u : 0u; mine = (j == x) ? c : mine; }
        if (sum == G) break;
        __builtin_amdgcn_s_sleep(1);
        if ((++sp & 255u) == 0u) { if (xb_ld(&bar[XB_TMO])) break; if (sp > XB_SPIN_CAP) { atomicAdd(&bar[XB_TMO], 1u); break; } }
    }
    nloc = mine > 0u ? mine : 1u; nx = cnt > 0u ? cnt : 1u;
}
__device__ __forceinline__ void xcd_barrier(const XcdBarrier& b) {
    asm volatile("s_waitcnt vmcnt(0)" ::: "memory");
    __syncthreads();
    if (xb_thread0(b.wv)) {
        unsigned* bar = b.bar;
        __builtin_amdgcn_s_waitcnt(0);
        unsigned nloc = b.st[0], nx = b.st[1];
        if (nloc == 0u) { xcd_barrier_complete(bar, b.x, nloc, nx); b.st[0] = nloc; b.st[1] = nx; }
        const unsigned old = xb_add(&bar[XB_XSUB(b.x)], 1u);
        const unsigned gen = old / nloc;
        if (old + 1u == (gen + 1u) * nloc) {
            __builtin_amdgcn_fence(__ATOMIC_RELEASE, "agent");
            asm volatile("s_waitcnt vmcnt(0)" ::: "memory");
            const unsigned og = xb_add(&bar[XB_TOP], 1u);
            const unsigned tg = og / nx;
            if (og + 1u == (tg + 1u) * nx) xb_add(&bar[XB_TOPGEN], 1u);
            else XB_SPIN(xb_ld(&bar[XB_TOPGEN]) == tg, bar);
            __builtin_amdgcn_fence(__ATOMIC_ACQUIRE, "agent");
            xb_add(&bar[XB_XGEN(b.x)], 1u);
            asm volatile("s_waitcnt vmcnt(0)" ::: "memory");
        } else {
            XB_SPIN(xb_ld(&bar[XB_XGEN(b.x)]) == gen, bar);
            __builtin_amdgcn_fence(__ATOMIC_ACQUIRE, "agent");
            asm volatile("s_waitcnt vmcnt(0)" ::: "memory");
        }
    }
    __syncthreads();
}

namespace pg8 {
constexpr int BM = 256, BK = 64, HALF = 128, HTB = HALF * BK * 2, STAGE_BYTES = 8 * HTB;
__device__ __forceinline__ int lds_byte(int r, int c) { const int st = (r >> 4) * 2 + (c >> 5), rr = r & 15, cc = c & 31, ob = rr * 64 + cc * 2; return st * 1024 + (ob ^ (((ob >> 9) & 1) << 5)); }
__device__ __forceinline__ void stage_rc(int b, int& R, int& C) { const int st = b / 1024, sb = b % 1024, swz = sb ^ (((sb >> 9) & 1) << 5); R = (st >> 1) * 16 + swz / 64; C = (st & 1) * 32 + (swz % 64) / 2; }
__device__ __forceinline__ int perm32(int rho) { const int n = rho >> 4, i = rho & 15; return 8 * (i >> 2) + 4 * n + (i & 3); }
struct Unit { int pm, pn, aux; const char* A; const char* B; };
__device__ __forceinline__ unsigned cvt_pk_bf16(float lo, float hi) { return pk2(lo, hi); }

template <class Epi, class Sched, bool GATHER = false>
__device__ __forceinline__ void gemm_phase(LAS unsigned char* lds, const int tid_in, const int K, const int lda, const int ldb, const Sched& S, const Epi& E, const LAS unsigned* gtab = nullptr) {
    int tid_ = tid_in; asm volatile("" : "+v"(tid_));
    const int tid = tid_, wid = __builtin_amdgcn_readfirstlane(tid >> 6), lane = tid & 63, wr = wid >> 2, wc = wid & 3, fr = lane & 15, fq = lane >> 4;
    const int nt = K / BK;
    unsigned voffA[2], voffB[2];
#pragma unroll
    for (int i = 0; i < 2; ++i) { int R, C; stage_rc(tid * 16 + i * 8192, R, C); const int Rb = Epi::PERM ? ((R & ~31) + perm32(R & 31)) : R;
        voffA[i] = (unsigned)(R * lda + C) * 2u; voffB[i] = (unsigned)(Rb * ldb + C) * 2u; }
    const size_t kstep = (size_t)(BK * 2);
    const size_t hstepA = GATHER ? (size_t)0 : (size_t)HALF * lda * 2, hstepB = (size_t)HALF * ldb * 2;
    int gR[2], gC[2]; unsigned gcur[2][2], gnxt[2][2];
    if constexpr (GATHER) {
#pragma unroll
        for (int i = 0; i < 2; ++i) { int R, C; stage_rc(tid * 16 + i * 8192, R, C); gR[i] = R; gC[i] = C * 2; }
    }
#define PG8_GLOAD(dst, u_) do { _Pragma("unroll") for (int _h = 0; _h < 2; ++_h) _Pragma("unroll") for (int _i = 0; _i < 2; ++_i) dst[_h][_i] = gtab[(u_) * 256 + _h * 128 + gR[_i]] + (unsigned)gC[_i]; } while (0)
    const unsigned ldsw = (unsigned)wid * 1024u;
    const int aoff = lds_byte(wr * 64 + fr, fq * 8), boff = lds_byte(wc * 32 + fr, fq * 8);
#define PG8_SA(b, h) (((b) * 2 + (h)) * HTB)
#define PG8_SB(b, h) ((4 + (b) * 2 + (h)) * HTB)
#define PG8_STAGE(bufoff, gbase, voff) do { _Pragma("unroll") for (int _i = 0; _i < 2; ++_i) \
        __builtin_amdgcn_global_load_lds((const unsigned*)((const char*)(gbase) + (voff)[_i]), (LAS unsigned*)(lds + (bufoff) + ldsw + _i * 8192), 16, 0, 0); } while (0)
#define PG8_STAGEA(bufoff, gbase, h, tab) do { if constexpr (GATHER) { PG8_STAGE(bufoff, gbase, tab[h]); } else { PG8_STAGE(bufoff, (gbase) + (h) * hstepA, voffA); } } while (0)
#define PG8_LDA(dst, b, h) do { _Pragma("unroll") for (int m = 0; m < 4; ++m) _Pragma("unroll") for (int k = 0; k < 2; ++k) dst[m][k] = *(const LAS bf16x8*)(lds + PG8_SA(b, h) + aoff + m * 2048 + k * 1024); } while (0)
#define PG8_LDB(dst, b, h) do { _Pragma("unroll") for (int n = 0; n < 2; ++n) _Pragma("unroll") for (int k = 0; k < 2; ++k) dst[n][k] = *(const LAS bf16x8*)(lds + PG8_SB(b, h) + boff + n * 2048 + k * 1024); } while (0)
#define PG8_MMA(ai, bj, At, Bt) do { __builtin_amdgcn_s_setprio(1); _Pragma("unroll") for (int m = 0; m < 4; ++m) _Pragma("unroll") for (int n = 0; n < 2; ++n) _Pragma("unroll") for (int k = 0; k < 2; ++k) \
        acc[ai][bj][m][n] = __builtin_amdgcn_mfma_f32_16x16x32_bf16(Bt[n][k], At[m][k], acc[ai][bj][m][n], 0, 0, 0); __builtin_amdgcn_s_setprio(0); } while (0)
#define PG8_WAIT_V(n) asm volatile("s_waitcnt vmcnt(" #n ")" ::: "memory")
#define PG8_WAIT_L(n) asm volatile("s_waitcnt lgkmcnt(" #n ")" ::: "memory")
#define PG8_BAR __builtin_amdgcn_s_barrier()
#define PG8_SCHED __builtin_amdgcn_sched_barrier(0)
    Unit cur, nxt; int ui = 0;
    if (!S.next(0, cur)) return;
    f32x4 acc[2][2][4][2];
#pragma unroll
    for (int a = 0; a < 2; ++a)
#pragma unroll
        for (int b = 0; b < 2; ++b)
#pragma unroll
            for (int m = 0; m < 4; ++m)
#pragma unroll
                for (int n = 0; n < 2; ++n) acc[a][b][m][n] = (f32x4){0.f, 0.f, 0.f, 0.f};
    bf16x8 At[4][2], B0[2][2], B1[2][2];
    const char* cA = cur.A; const char* cB = cur.B;
    if constexpr (GATHER) { PG8_GLOAD(gcur, 0); PG8_GLOAD(gnxt, 1); asm volatile("s_waitcnt lgkmcnt(0)" ::: "memory"); }
    PG8_STAGE(PG8_SB(0, 0), cB, voffB); PG8_STAGE(PG8_SB(0, 1), cB + hstepB, voffB); PG8_STAGEA(PG8_SA(0, 0), cA, 0, gcur); PG8_STAGEA(PG8_SA(0, 1), cA, 1, gcur);
    if (wr == 1) PG8_BAR;
    PG8_WAIT_V(2); PG8_BAR;
    PG8_STAGE(PG8_SB(1, 0), cB + kstep, voffB); PG8_STAGEA(PG8_SA(1, 0), cA + kstep, 0, gcur); PG8_STAGE(PG8_SB(1, 1), cB + hstepB + kstep, voffB);
    PG8_WAIT_V(6); PG8_BAR;
#pragma unroll 1
    for (;;) {
        const bool has_next = S.next(ui + 1, nxt);
        const char* nA = has_next ? nxt.A : cA; const char* nB = has_next ? nxt.B : cB;
#pragma unroll 1
        for (int t = 0; t < nt; t += 2) {
            const bool last = (t == nt - 2);
            const char* a1 = cA + (size_t)(t + 1) * kstep;
            const char* a2 = last ? nA : cA + (size_t)(t + 2) * kstep; const char* b2 = last ? nB : cB + (size_t)(t + 2) * kstep;
            const char* a3 = a2 + kstep; const char* b3 = b2 + kstep;
            unsigned g2[2][2];
            if constexpr (GATHER) {
#pragma unroll
                for (int _h = 0; _h < 2; ++_h)
#pragma unroll
                    for (int _i = 0; _i < 2; ++_i) g2[_h][_i] = last ? gnxt[_h][_i] : gcur[_h][_i]; }
            PG8_LDB(B0, 0, 0); PG8_LDB(B1, 0, 1); PG8_SCHED; PG8_LDA(At, 0, 0); PG8_STAGEA(PG8_SA(1, 1), a1, 1, gcur);
            PG8_WAIT_V(8); PG8_WAIT_L(0); PG8_BAR; PG8_MMA(0, 0, At, B0); PG8_MMA(0, 1, At, B1); PG8_BAR; PG8_SCHED;
            PG8_LDA(At, 0, 1); PG8_STAGE(PG8_SB(0, 0), b2, voffB); PG8_STAGE(PG8_SB(0, 1), b2 + hstepB, voffB); PG8_STAGEA(PG8_SA(0, 0), a2, 0, g2);
            PG8_WAIT_V(8); PG8_WAIT_L(0); PG8_BAR; PG8_MMA(1, 0, At, B0); PG8_MMA(1, 1, At, B1); PG8_BAR; PG8_SCHED;
            PG8_LDB(B0, 1, 0); PG8_LDB(B1, 1, 1); PG8_SCHED; PG8_LDA(At, 1, 0); PG8_STAGEA(PG8_SA(0, 1), a2, 1, g2);
            PG8_WAIT_V(8); PG8_WAIT_L(0); PG8_BAR; PG8_MMA(0, 0, At, B0); PG8_MMA(0, 1, At, B1); PG8_BAR; PG8_SCHED;
            PG8_LDA(At, 1, 1); PG8_STAGE(PG8_SB(1, 0), b3, voffB); PG8_STAGE(PG8_SB(1, 1), b3 + hstepB, voffB); PG8_STAGEA(PG8_SA(1, 0), a3, 0, g2);
            PG8_WAIT_V(8); PG8_WAIT_L(0); PG8_BAR; PG8_MMA(1, 0, At, B0); PG8_MMA(1, 1, At, B1); PG8_BAR; PG8_SCHED;
        }
        if (wr == 0) PG8_BAR;
        E(acc, cur, wr, wc, fr, fq);
        if (!has_next) break;
#pragma unroll
        for (int a = 0; a < 2; ++a)
#pragma unroll
            for (int b = 0; b < 2; ++b)
#pragma unroll
                for (int m = 0; m < 4; ++m)
#pragma unroll
                    for (int n = 0; n < 2; ++n) acc[a][b][m][n] = (f32x4){0.f, 0.f, 0.f, 0.f};
        cur = nxt; cA = nA; cB = nB; ++ui;
        if constexpr (GATHER) {
#pragma unroll
            for (int _h = 0; _h < 2; ++_h)
#pragma unroll
                for (int _i = 0; _i < 2; ++_i) gcur[_h][_i] = gnxt[_h][_i];
            PG8_GLOAD(gnxt, ui + 1); }
        if (wr == 1) PG8_BAR;
    }
    PG8_WAIT_V(0);
    PG8_BAR;
#undef PG8_SA
#undef PG8_SB
#undef PG8_STAGE
#undef PG8_STAGEA
#undef PG8_GLOAD
#undef PG8_LDA
#undef PG8_LDB
#undef PG8_MMA
#undef PG8_WAIT_V
#undef PG8_WAIT_L
#undef PG8_BAR
#undef PG8_SCHED
}
}
constexpr int NWAVES = 8, NTHR = 512;
constexpr int RING_BYTES = 131072, LDS_BYTES = 147456, LDSCTL_OFF = LDS_BYTES - 2048;
struct Params { const float* in[29]; float* out; unsigned char* ws; };
struct Frame {
    LAS unsigned char* lds; int tid, lane, wave, blk, G, vcu, gw, ngw; unsigned char* ws;
};
enum { I_X = 0, I_POS, I_ANORM, I_WIN, I_MU, I_W0, I_W2, I_A0, I_A2, I_G2, I_KK, I_KA, I_RK, I_LNX, I_QNORM, I_WQB, I_KVNORM, I_WKVB, I_WBR, I_WO, I_FNORM,
       I_FG, I_FU, I_FD, I_ROUTER, I_MG, I_MU2, I_MD, I_FINAL };

struct SchedGrid {
    int nM, nN, nwg, G, c; const char* A; const char* B; size_t astep, bstep;
    __device__ void init(int nM_, int nN_, int G_, int c_, const void* A_, size_t astep_, const void* B_, size_t bstep_) { nM = nM_; nN = nN_; nwg = nM * nN; G = G_; c = c_; A = (const char*)A_; B = (const char*)B_; astep = astep_; bstep = bstep_; }
    __device__ __forceinline__ bool next(int i, pg8::Unit& u) const {
        const long L = (long)i * G + c; if (L >= nwg) return false;
        int wgid = (int)L; { const int q = nwg / 8, r = nwg % 8, xcd = wgid % 8, off = wgid / 8; wgid = (xcd < r ? xcd * (q + 1) : r * (q + 1) + (xcd - r) * q) + off; }
        const int nig = 8 * nN, gid = wgid / nig, fm = gid * 8, gsz = (nM - fm) < 8 ? (nM - fm) : 8;
        u.pm = fm + ((wgid % nig) % gsz); u.pn = (wgid % nig) / gsz; u.aux = 0;
        u.A = A + (size_t)u.pm * astep; u.B = B + (size_t)u.pn * bstep; return true;
    }
};
struct SchedSmall {
    int G, c, layer; const char* ws;
    __device__ __forceinline__ bool next(int i, pg8::Unit& u) const {
        int L = i * G + c; if (L >= 448) return false;
        int s = 0; if (L >= 192) { L -= 192; s = 1; if (L >= 128) { L -= 128; s = 2; } }
        const int nn = s == 0 ? 3 : (s == 1 ? 2 : 64);
        u.pm = L / nn; u.pn = L % nn; u.aux = s;
        const size_t lw = (size_t)layer * 256 * 2;
        const size_t ao = s == 0 ? WS_QN : (s == 1 ? WS_CN : WS_VB + lw * 512), bo = s == 0 ? WS_QB + lw * 768 : (s == 1 ? WS_KB + lw * 512 : WS_CN);
        u.A = ws + ao + (size_t)u.pm * (256 * 256 * 2); u.B = ws + bo + (size_t)u.pn * (256 * 256 * 2); return true;
    }
};
struct SchedOwn3 {
    int c, G; const char* A; const char* B; size_t astep, bstep, a_n, b_n;
    __device__ __forceinline__ bool next(int i, pg8::Unit& u) const {
        const int t = c + (i / 3) * G; if (t >= 256) return false;
        const int n = i % 3; u.pm = t >> 2; u.pn = t & 3; u.aux = n; u.A = A + (size_t)u.pm * astep + (size_t)n * a_n; u.B = B + (size_t)u.pn * bstep + (size_t)n * b_n; return true;
    }
};
struct SchedMoe {
    int G, c, ncol, ntile; const LAS int* tab; const char* A; const char* B; size_t astep, bstep, estep;
    __device__ __forceinline__ bool next(int i, pg8::Unit& u) const {
        const int L = i * G + c; if (L >= ntile * ncol) return false;
        u.pm = L / ncol; u.pn = L % ncol; const int e = tab[u.pm]; u.aux = e;
        u.A = A + (size_t)u.pm * astep; u.B = B + (size_t)e * estep + (size_t)u.pn * bstep; return true;
    }
};

using pg8::Unit; using pg8::cvt_pk_bf16;
#define EPI_ARGS const f32x4 (&acc)[2][2][4][2], const Unit& u, int wr, int wc, int fr, int fq
__device__ __forceinline__ float row_rstd(const float* SS, int row) {
    const f32x4* s = (const f32x4*)(SS + (size_t)row * 16); const f32x4 a = s[0], b = s[1], c = s[2], d = s[3];
    const float t = ((a.x + a.y) + (a.z + a.w)) + ((b.x + b.y) + (b.z + b.w)) + ((c.x + c.y) + (c.z + c.w)) + ((d.x + d.y) + (d.z + d.w));
    return rsqrtf(t * (1.0f / DM) + NORM_EPS);
}
__device__ __forceinline__ void panel_rstd(const float* SS, int pm, int tid, LAS float* rl) {
    if (tid < 256) rl[tid] = row_rstd(SS, pm * 256 + tid);
    asm volatile("s_waitcnt lgkmcnt(0)" ::: "memory"); __builtin_amdgcn_s_barrier(); asm volatile("" ::: "memory");
}
struct EpiStore {
    static constexpr bool PERM = true;
    bf16_t* O; int ld; const float* SS; LAS float* rl; int tid;
    __device__ __forceinline__ void operator()(EPI_ARGS) const {
        const int row0 = u.pm * 256 + wr * 64 + fr, col0 = u.pn * 256 + wc * 32 + 8 * fq;
        if (SS) panel_rstd(SS, u.pm, tid, rl);
#pragma unroll
        for (int ai = 0; ai < 2; ++ai)
#pragma unroll
            for (int m = 0; m < 4; ++m) { bf16_t* rowp = O + (size_t)(row0 + ai * 128 + m * 16) * ld + col0; const float rs = SS ? rl[wr * 64 + fr + ai * 128 + m * 16] : 1.0f;
#pragma unroll
                for (int bj = 0; bj < 2; ++bj) { const f32x4 v0 = acc[ai][bj][m][0] * rs, v1 = acc[ai][bj][m][1] * rs;
                    u32x4 w; w.x = cvt_pk_bf16(v0[0], v0[1]); w.y = cvt_pk_bf16(v0[2], v0[3]); w.z = cvt_pk_bf16(v1[0], v1[1]); w.w = cvt_pk_bf16(v1[2], v1[3]);
                    *(u32x4*)(rowp + bj * 128) = w; } }
    }
};
struct EpiSmall {
    static constexpr bool PERM = true;
    unsigned char* ws;
    __device__ __forceinline__ void operator()(EPI_ARGS) const {
        bf16_t* base = (bf16_t*)(ws + (u.aux == 0 ? WS_Q : (u.aux == 1 ? WS_KN : WS_VT))); const int ld = u.aux == 0 ? 768 : (u.aux == 1 ? 512 : MTOK);
        const int row0 = u.pm * 256 + wr * 64 + fr, col0 = u.pn * 256 + wc * 32 + 8 * fq;
#pragma unroll
        for (int ai = 0; ai < 2; ++ai)
#pragma unroll
            for (int m = 0; m < 4; ++m) { bf16_t* rowp = base + (size_t)(row0 + ai * 128 + m * 16) * ld + col0;
#pragma unroll
                for (int bj = 0; bj < 2; ++bj) { const f32x4 v0 = acc[ai][bj][m][0], v1 = acc[ai][bj][m][1];
                    u32x4 w; w.x = cvt_pk_bf16(v0[0], v0[1]); w.y = cvt_pk_bf16(v0[2], v0[3]); w.z = cvt_pk_bf16(v1[0], v1[1]); w.w = cvt_pk_bf16(v1[2], v1[3]);
                    *(u32x4*)(rowp + bj * 128) = w; } }
    }
};
struct EpiLora {
    static constexpr bool PERM = true;
    bf16_t* O; const float* w0; const float* a0;
    __device__ __forceinline__ void operator()(EPI_ARGS) const {
        const int seg = u.pn >> 1;
        const int row0 = u.pm * 256 + wr * 64 + fr, col0 = u.pn * 256 + wc * 32 + 8 * fq, ch0 = (u.pn & 1) * 256 + wc * 32 + 8 * fq;
        const float* bias = seg == 0 ? w0 : a0; const float sc = seg == 0 ? -0.6065306597126334f : 1.0f;
#pragma unroll
        for (int bj = 0; bj < 2; ++bj) {
            f32x4 b0 = {0.f, 0.f, 0.f, 0.f}, b1 = {0.f, 0.f, 0.f, 0.f};
            if (seg < 2) { b0 = *(const f32x4*)(bias + ch0 + bj * 128); b1 = *(const f32x4*)(bias + ch0 + bj * 128 + 4); }
#pragma unroll
            for (int ai = 0; ai < 2; ++ai)
#pragma unroll
                for (int m = 0; m < 4; ++m) { bf16_t* rowp = O + (size_t)(row0 + ai * 128 + m * 16) * LO_W + col0 + bj * 128;
                    f32x4 v0 = acc[ai][bj][m][0] + b0, v1 = acc[ai][bj][m][1] + b1;
                    if (seg < 2) {
#pragma unroll
                        for (int j = 0; j < 4; ++j) { v0[j] = sc * sigmoidf_(v0[j]); v1[j] = sc * sigmoidf_(v1[j]); }
                    }
                    u32x4 w; w.x = cvt_pk_bf16(v0[0], v0[1]); w.y = cvt_pk_bf16(v0[2], v0[3]); w.z = cvt_pk_bf16(v1[0], v1[1]); w.w = cvt_pk_bf16(v1[2], v1[3]);
                    *(u32x4*)rowp = w; }
        }
    }
};
struct EpiGate {
    static constexpr bool PERM = true;
    bf16_t* O; const float* SS; LAS float* rl; int tid;
    __device__ __forceinline__ void operator()(EPI_ARGS) const {
        const int row0 = u.pm * 256 + wr * 64 + fr, col0 = u.aux * 1024 + u.pn * 256 + wc * 32 + 8 * fq;
        panel_rstd(SS, u.pm, tid, rl);
#pragma unroll
        for (int ai = 0; ai < 2; ++ai)
#pragma unroll
            for (int m = 0; m < 4; ++m) { bf16_t* rowp = O + (size_t)(row0 + ai * 128 + m * 16) * 3072 + col0; const float rs = rl[wr * 64 + fr + ai * 128 + m * 16];
#pragma unroll
                for (int bj = 0; bj < 2; ++bj) { f32x4 v0 = acc[ai][bj][m][0] * rs, v1 = acc[ai][bj][m][1] * rs;
#pragma unroll
                    for (int j = 0; j < 4; ++j) { v0[j] = sigmoidf_(v0[j]); v1[j] = sigmoidf_(v1[j]); }
                    u32x4 w; w.x = cvt_pk_bf16(v0[0], v0[1]); w.y = cvt_pk_bf16(v0[2], v0[3]); w.z = cvt_pk_bf16(v1[0], v1[1]); w.w = cvt_pk_bf16(v1[2], v1[3]);
                    *(u32x4*)(rowp + bj * 128) = w; } }
    }
};
struct EpiMerge {
    static constexpr bool PERM = true;
    const bf16_t* Gt; bf16_t* Mg;
    __device__ __forceinline__ void operator()(EPI_ARGS) const {
        const int n = u.aux;
        const int row0 = u.pm * 256 + wr * 64 + fr, col0 = u.pn * 256 + wc * 32 + 8 * fq;
#pragma unroll
        for (int ai = 0; ai < 2; ++ai)
#pragma unroll
            for (int m = 0; m < 4; ++m) { const size_t r = (size_t)(row0 + ai * 128 + m * 16);
#pragma unroll
                for (int bj = 0; bj < 2; ++bj) { const f32x4 v0 = acc[ai][bj][m][0], v1 = acc[ai][bj][m][1];
                    const u32x4 g = *(const u32x4*)(Gt + r * 3072 + n * 1024 + col0 + bj * 128);
                    float o[8] = {bflo(g.x) * v0[0], bfhi(g.x) * v0[1], bflo(g.y) * v0[2], bfhi(g.y) * v0[3], bflo(g.z) * v1[0], bfhi(g.z) * v1[1], bflo(g.w) * v1[2], bfhi(g.w) * v1[3]};
                    bf16_t* mp = Mg + r * 1024 + col0 + bj * 128;
                    if (n > 0) { const u32x4 p = *(const u32x4*)mp; o[0] += bflo(p.x); o[1] += bfhi(p.x); o[2] += bflo(p.y); o[3] += bfhi(p.y); o[4] += bflo(p.z); o[5] += bfhi(p.z); o[6] += bflo(p.w); o[7] += bfhi(p.w); }
                    u32x4 w; w.x = cvt_pk_bf16(o[0], o[1]); w.y = cvt_pk_bf16(o[2], o[3]); w.z = cvt_pk_bf16(o[4], o[5]); w.w = cvt_pk_bf16(o[6], o[7]);
                    *(u32x4*)mp = w; } }
    }
};
constexpr int HLD = 2 * DM;
template <bool EMIT, bool IN_F32>
struct EpiResid {
    static constexpr bool PERM = true;
    const void* In; bf16_t* Out; const float* gain; bf16_t* Hg; float* SS;
    __device__ __forceinline__ void operator()(EPI_ARGS) const {
        const int row0 = u.pm * 256 + wr * 64 + fr, col0 = u.pn * 256 + wc * 32 + 8 * fq;
        f32x4 gv[2][2];
        if (EMIT) {
#pragma unroll
            for (int bj = 0; bj < 2; ++bj)
#pragma unroll
                for (int n = 0; n < 2; ++n) gv[bj][n] = *(const f32x4*)(gain + col0 + bj * 128 + n * 4); }
#pragma unroll
        for (int ai = 0; ai < 2; ++ai)
#pragma unroll
            for (int m = 0; m < 4; ++m) { const int row = row0 + ai * 128 + m * 16; float sq = 0.f;
#pragma unroll
                for (int bj = 0; bj < 2; ++bj) { const int col = col0 + bj * 128; f32x4 x0, x1;
                    if (IN_F32) { const float* ip = (const float*)In + (size_t)row * DM + col; x0 = *(const f32x4*)ip; x1 = *(const f32x4*)(ip + 4); }
                    else { const u32x4 p = *(const u32x4*)((const bf16_t*)In + (size_t)row * HLD + col); x0 = (f32x4){bflo(p.x), bfhi(p.x), bflo(p.y), bfhi(p.y)}; x1 = (f32x4){bflo(p.z), bfhi(p.z), bflo(p.w), bfhi(p.w)}; }
                    x0 += acc[ai][bj][m][0]; x1 += acc[ai][bj][m][1];
                    u32x4 w; w.x = cvt_pk_bf16(x0[0], x0[1]); w.y = cvt_pk_bf16(x0[2], x0[3]); w.z = cvt_pk_bf16(x1[0], x1[1]); w.w = cvt_pk_bf16(x1[2], x1[3]);
                    *(u32x4*)(Out + (size_t)row * HLD + col) = w;
                    if (EMIT) { sq += ((x0[0] * x0[0] + x0[1] * x0[1]) + (x0[2] * x0[2] + x0[3] * x0[3])) + ((x1[0] * x1[0] + x1[1] * x1[1]) + (x1[2] * x1[2] + x1[3] * x1[3]));
                        const f32x4 y0 = x0 * gv[bj][0], y1 = x1 * gv[bj][1];
                        u32x4 g; g.x = cvt_pk_bf16(y0[0], y0[1]); g.y = cvt_pk_bf16(y0[2], y0[3]); g.z = cvt_pk_bf16(y1[0], y1[1]); g.w = cvt_pk_bf16(y1[2], y1[3]);
                        *(u32x4*)(Hg + (size_t)row * DM + col) = g; } }
                if (EMIT) { sq += __shfl_xor(sq, 16); sq += __shfl_xor(sq, 32); if (fq == 0) SS[(size_t)row * 16 + u.pn * 4 + wc] = sq; } }
    }
};
struct EpiSwiglu {
    static constexpr bool PERM = true;
    bf16_t* O; int ldc; int pn_off; const float* SS; LAS float* rl; int tid;
    __device__ __forceinline__ void operator()(EPI_ARGS) const {
        const int row0 = u.pm * 256 + wr * 64 + fr, col0 = (u.pn - pn_off) * 128 + wc * 32 + 8 * fq;
        if (SS) panel_rstd(SS, u.pm, tid, rl);
#pragma unroll
        for (int ai = 0; ai < 2; ++ai)
#pragma unroll
            for (int m = 0; m < 4; ++m) { bf16_t* rowp = O + (size_t)(row0 + ai * 128 + m * 16) * ldc + col0; const float rs = SS ? rl[wr * 64 + fr + ai * 128 + m * 16] : 1.0f;
                float o[8];
#pragma unroll
                for (int n = 0; n < 2; ++n)
#pragma unroll
                    for (int j = 0; j < 4; ++j) { const float g = acc[ai][0][m][n][j] * rs, up = acc[ai][1][m][n][j] * rs; o[n * 4 + j] = g * sigmoidf_(g) * up; }
                u32x4 w; w.x = cvt_pk_bf16(o[0], o[1]); w.y = cvt_pk_bf16(o[2], o[3]); w.z = cvt_pk_bf16(o[4], o[5]); w.w = cvt_pk_bf16(o[6], o[7]);
                *(u32x4*)rowp = w; }
    }
};
template <bool ACCUM>
struct EpiMoeOut {
    static constexpr bool PERM = true;
    const float* row_w; bf16_t* O;
    __device__ __forceinline__ void operator()(EPI_ARGS) const {
        const int row0 = u.pm * 256 + wr * 64 + fr, col0 = u.pn * 256 + wc * 32 + 8 * fq;
#pragma unroll
        for (int ai = 0; ai < 2; ++ai)
#pragma unroll
            for (int m = 0; m < 4; ++m) { const int r = row0 + ai * 128 + m * 16; const float wt = row_w[r]; bf16_t* rowp = O + (size_t)r * DM + col0;
#pragma unroll
                for (int bj = 0; bj < 2; ++bj) { f32x4 v0 = acc[ai][bj][m][0] * wt, v1 = acc[ai][bj][m][1] * wt;
                    if (ACCUM) { const u32x4 p = *(const u32x4*)(rowp + bj * 128); v0[0] += bflo(p.x); v0[1] += bfhi(p.x); v0[2] += bflo(p.y); v0[3] += bfhi(p.y); v1[0] += bflo(p.z); v1[1] += bfhi(p.z); v1[2] += bflo(p.w); v1[3] += bfhi(p.w); }
                    u32x4 w; w.x = cvt_pk_bf16(v0[0], v0[1]); w.y = cvt_pk_bf16(v0[2], v0[3]); w.z = cvt_pk_bf16(v1[0], v1[1]); w.w = cvt_pk_bf16(v1[2], v1[3]);
                    *(u32x4*)(rowp + bj * 128) = w; } }
    }
};

__device__ __forceinline__ void transpose_tile64(const float* W, int ldn, int k0, int n0, bf16_t* WT, int ldk, int drow0, int drow1, int dk0, LAS float* scr, int lane) {
#ifdef SIMPLE_TR
    { const int c = lane & 7;
      for (int j = 0; j < 8; ++j) { const int n = (lane >> 3) + 8 * j; const float* s = W + (size_t)(k0 + 8 * c) * ldn + n0 + n;
        u32x4 o; o.x = pk2(s[0], s[(size_t)ldn]); o.y = pk2(s[(size_t)2 * ldn], s[(size_t)3 * ldn]); o.z = pk2(s[(size_t)4 * ldn], s[(size_t)5 * ldn]); o.w = pk2(s[(size_t)6 * ldn], s[(size_t)7 * ldn]);
        const int dr = n < 32 ? drow0 + n : drow1 + (n - 32);
        *(u32x4*)(WT + (size_t)dr * ldk + dk0 + k0 + 8 * c) = o; }
      return; }
#endif
    f32x4 v[16]; const int r4 = lane >> 4, c4 = (lane & 15) * 4;
#pragma unroll
    for (int i = 0; i < 16; ++i) v[i] = *(const f32x4*)(W + (size_t)(k0 + 4 * i + r4) * ldn + n0 + c4);
#pragma unroll
    for (int i = 0; i < 16; ++i) { LAS float* d = scr + (4 * i + r4) * 65 + c4; d[0] = v[i][0]; d[1] = v[i][1]; d[2] = v[i][2]; d[3] = v[i][3]; }
    LDS_WAIT(); asm volatile("" ::: "memory");
    const int c = lane & 7;
#pragma unroll
    for (int j = 0; j < 8; ++j) { const int n = (lane >> 3) + 8 * j; const LAS float* s = scr + (8 * c) * 65 + n;
        u32x4 o; o.x = pk2(s[0 * 65], s[1 * 65]); o.y = pk2(s[2 * 65], s[3 * 65]); o.z = pk2(s[4 * 65], s[5 * 65]); o.w = pk2(s[6 * 65], s[7 * 65]);
        const int dr = n < 32 ? drow0 + n : drow1 + (n - 32);
        *(u32x4*)(WT + (size_t)dr * ldk + dk0 + k0 + 8 * c) = o; }
    LDS_WAIT(); asm volatile("" ::: "memory");
}
__device__ __forceinline__ void conv_plain(const float* W, int K, int N, bf16_t* WT, int ldk, int item, LAS float* scr, int lane) {
    const int nblk = N / 64, kb = item / nblk, nb = item % nblk;
    transpose_tile64(W, N, kb * 64, nb * 64, WT, ldk, nb * 64, nb * 64 + 32, 0, scr, lane);
}
__device__ __forceinline__ int win_drow(int n0) { return n0 < 3872 ? n0 : (n0 < 4128 ? 4096 + (n0 - 3872) : (n0 < 4288 ? 4352 + (n0 - 4128) : 4608 + (n0 - 4288))); }
__device__ __forceinline__ int gu_drow(int n0, int up) { return (n0 >> 7) * 256 + (n0 & 127) + up * 128; }

struct TrD { const float* src; bf16_t* d0; bf16_t* d1; int ldn, ldk; };
__device__ __forceinline__ TrD tr_desc(const float* W, int ldn, int k0, int n0, bf16_t* WT, int ldk, int drow0, int drow1, int dk0) {
    TrD d; d.src = W + (size_t)k0 * ldn + n0; d.ldn = ldn; d.ldk = ldk; d.d0 = WT + (size_t)drow0 * ldk + dk0 + k0; d.d1 = WT + (size_t)drow1 * ldk + dk0 + k0; return d;
}
__device__ __forceinline__ void tr_load(f32x4 (&v)[16], const TrD& d, int lane) {
    const float* s = d.src + (size_t)(lane >> 4) * d.ldn + (lane & 15) * 4;
#pragma unroll
    for (int i = 0; i < 16; ++i) v[i] = *(const f32x4*)(s + (size_t)(4 * i) * d.ldn);
}
__device__ __forceinline__ void tr_store(const f32x4 (&v)[16], const TrD& d, LAS float* scr, int lane) {
    const int r4 = lane >> 4, c4 = (lane & 15) * 4;
#pragma unroll
    for (int i = 0; i < 16; ++i) { LAS float* q = scr + (4 * i + r4) * 65 + c4; q[0] = v[i][0]; q[1] = v[i][1]; q[2] = v[i][2]; q[3] = v[i][3]; }
    LDS_WAIT(); asm volatile("" ::: "memory");
    const int c = lane & 7;
#pragma unroll
    for (int j = 0; j < 8; ++j) { const int n = (lane >> 3) + 8 * j; const LAS float* s = scr + (8 * c) * 65 + n;
        u32x4 o; o.x = pk2(s[0 * 65], s[1 * 65]); o.y = pk2(s[2 * 65], s[3 * 65]); o.z = pk2(s[4 * 65], s[5 * 65]); o.w = pk2(s[6 * 65], s[7 * 65]);
        bf16_t* dr = n < 32 ? d.d0 + (size_t)n * d.ldk : d.d1 + (size_t)(n - 32) * d.ldk;
        *(u32x4*)(dr + 8 * c) = o; }
    LDS_WAIT(); asm volatile("" ::: "memory");
}
__device__ __forceinline__ TrD desc_plain(const float* W, int K, int N, bf16_t* WT, int ldk, int item) {
    const int nblk = N / 64, kb = item / nblk, nb = item % nblk; (void)K;
    return tr_desc(W, N, kb * 64, nb * 64, WT, ldk, nb * 64, nb * 64 + 32, 0);
}
#define TR_PIPE(DESC, IT0, STEP, NT, TAIL, SCR, LANE) do { \
    f32x4 v_[2][16]; TrD d_[2]; const int i0_ = (IT0), st_ = (STEP); const bool tail_ = (TAIL); \
    d_[0] = DESC(i0_); tr_load(v_[0], d_[0], LANE); \
    _Pragma("unroll") for (int k_ = 0; k_ < (NT); ++k_) { \
        if (k_ + 1 < (NT) || tail_) { d_[(k_ + 1) & 1] = DESC(i0_ + (k_ + 1) * st_); tr_load(v_[(k_ + 1) & 1], d_[(k_ + 1) & 1], LANE); } \
        asm volatile("" ::: "memory"); \
        tr_store(v_[k_ & 1], d_[k_ & 1], SCR, LANE); } \
    if (tail_) tr_store(v_[(NT) & 1], d_[(NT) & 1], SCR, LANE); } while (0)
namespace pro {
constexpr int I_IN = 16 * 115, I_QB = 4 * 12, I_BRn = 8 * 16, I_WOn = 16 * 16, I_G = 16 * 44, I_D = 44 * 16;
constexpr int NIT = NLAYER * (I_IN + I_QB + 3 * I_BRn + I_WOn) + 2 * I_G + I_D;
}
__device__ __forceinline__ TrD pro_desc(const Params& P, unsigned char* ws, int it) {
    using namespace pro;
    int r = it;
    if (r < NLAYER * I_IN) { const int l = r / I_IN; r %= I_IN; const int kb = r / 115, nb = r % 115;
        return tr_desc(P.in[I_WIN] + (size_t)l * DM * IN_COLS, IN_COLS, kb * 64, nb * 64, (bf16_t*)(ws + WS_WIN) + (size_t)l * WIN_ROWS * DM, DM, win_drow(nb * 64), win_drow(nb * 64 + 32), 0); }
    r -= NLAYER * I_IN;
    if (r < NLAYER * I_QB) { const int l = r / I_QB; r %= I_QB; return desc_plain(P.in[I_WQB] + (size_t)l * 256 * 768, 256, 768, (bf16_t*)(ws + WS_QB) + (size_t)l * 768 * 256, 256, r); }
    r -= NLAYER * I_QB;
    if (r < NLAYER * 3 * I_BRn) { const int ln = r / I_BRn; r %= I_BRn; return desc_plain(P.in[I_WBR] + (size_t)ln * 512 * 1024, 512, 1024, (bf16_t*)(ws + WS_BR) + (size_t)ln * 1024 * 512, 512, r); }
    r -= NLAYER * 3 * I_BRn;
    if (r < NLAYER * I_WOn) { const int l = r / I_WOn; r %= I_WOn; return desc_plain(P.in[I_WO] + (size_t)l * DM * DM, DM, DM, (bf16_t*)(ws + WS_WO) + (size_t)l * DM * DM, DM, r); }
    r -= NLAYER * I_WOn;
    if (r < 2 * I_G) { const int up = r / I_G; r %= I_G; const int kb = r / 44, nb = r % 44;
        return tr_desc(up ? P.in[I_FU] : P.in[I_FG], DFF, kb * 64, nb * 64, (bf16_t*)(ws + WS_FGU), DM, gu_drow(nb * 64, up), gu_drow(nb * 64 + 32, up), 0); }
    r -= 2 * I_G;
    return desc_plain(P.in[I_FD], DFF, DM, (bf16_t*)(ws + WS_FD), DFF, r);
}

#define PRO_DESC_(x) pro_desc(P, ws, (x))
template <int NT>
__device__ __forceinline__ void pro_tiles(const Frame& F, const Params& P, int lo, int w0, int nw, int tail) {
    LAS float* scr = (LAS float*)(F.lds + F.wave * 16640);
    unsigned char* ws = F.ws;
    if constexpr (NT == 0) { if (w0 < tail) { f32x4 v[16]; const TrD d = pro_desc(P, ws, lo + w0); tr_load(v, d, F.lane); tr_store(v, d, scr, F.lane); } }
    else TR_PIPE(PRO_DESC_, lo + w0, nw, NT, w0 < tail, scr, F.lane);
}
__device__ __forceinline__ void pro_small(const Frame& F, const Params& P, int gt, int ngt, int vb0, int nvb) {
    unsigned char* ws = F.ws;
    for (int i = gt; i < NLAYER * 3 * 48 * 512; i += ngt) { const int c = i & 511; int r = i >> 9; const int k = 8 * (r % 48); r /= 48; const int seg = r % 3, l = r / 3;
        const float* src = nullptr;
        if (seg == 0 && k < 64) src = P.in[I_W2] + ((size_t)l * 64 + k) * 512 + c;
        else if (seg == 1 && k >= 64 && k < 128) src = P.in[I_A2] + ((size_t)l * 64 + (k - 64)) * 512 + c;
        else if (seg == 2 && k >= 128 && k < 288) src = P.in[I_G2] + ((size_t)l * 160 + (k - 128)) * 512 + c;
        const bool live = src != nullptr; if (!live) src = P.in[I_W2] + c;
        float v[8];
#pragma unroll
        for (int q = 0; q < 8; ++q) v[q] = src[q * 512];
#pragma unroll
        for (int q = 0; q < 8; ++q) v[q] = live ? v[q] : 0.f;
        u32x4 o; o.x = pk2(v[0], v[1]); o.y = pk2(v[2], v[3]); o.z = pk2(v[4], v[5]); o.w = pk2(v[6], v[7]);
        *(u32x4*)((bf16_t*)(ws + WS_LORA) + ((size_t)l * 1536 + seg * 512 + c) * 384 + k) = o; }
    for (int i = gt; i < NLAYER * 32 * 512; i += ngt) { const int n = i & 511; int r = i >> 9; const int k = 8 * (r & 31), l = r >> 5; const int h = n >> 6, dd = n & 63;
        float vk[8], vv[8]; const float* w = P.in[I_WKVB] + ((size_t)l * 128 + (k < 128 ? k : 0)) * 1024 + h * 128 + dd;
#pragma unroll
        for (int q = 0; q < 8; ++q) { vk[q] = w[q * 1024]; vv[q] = w[q * 1024 + 64]; }
#pragma unroll
        for (int q = 0; q < 8; ++q) { vk[q] = k < 128 ? vk[q] : 0.f; vv[q] = k < 128 ? vv[q] : 0.f; }
        u32x4 o; o.x = pk2(vk[0], vk[1]); o.y = pk2(vk[2], vk[3]); o.z = pk2(vk[4], vk[5]); o.w = pk2(vk[6], vk[7]);
        *(u32x4*)((bf16_t*)(ws + WS_KB) + ((size_t)l * 512 + n) * 256 + k) = o;
        o.x = pk2(vv[0], vv[1]); o.y = pk2(vv[2], vv[3]); o.z = pk2(vv[4], vv[5]); o.w = pk2(vv[6], vv[7]);
        *(u32x4*)((bf16_t*)(ws + WS_VB) + ((size_t)l * 512 + n) * 256 + k) = o; }
    {
        const int j = F.tid & 127, r0 = F.tid >> 7;
        if (j < 80) { const int isr = j < 64; const int idx = isr ? j : j - 64; const double dim = isr ? 128.0 : 32.0;
            const float inv = (float)(1.0 / pow(10000.0, (2.0 * idx) / dim));
            for (int vb = vb0; vb < MTOK / 64; vb += nvb) {
                int pos[16];
#pragma unroll
                for (int k = 0; k < 16; ++k) pos[k] = ((const int*)P.in[I_POS])[vb * 64 + r0 + 4 * k];
                asm volatile("" ::: "memory");
#pragma unroll
                for (int k = 0; k < 16; ++k) { const int m = vb * 64 + r0 + 4 * k;
                    const float ang = (float)pos[k] * inv;
                    const double a = (double)ang, q = rint(a * 0.15915494309189535), rr = a - q * 6.283185307179586476925;
                    const float rf = (float)rr; const float cs = __cosf(rf), sn = __sinf(rf);
                    if (isr) { ((float*)(ws + WS_COSR))[(size_t)m * 64 + idx] = cs; ((float*)(ws + WS_SINR))[(size_t)m * 64 + idx] = sn; }
                    else { ((float*)(ws + WS_COSM))[(size_t)m * 16 + idx] = cs; ((float*)(ws + WS_SINM))[(size_t)m * 16 + idx] = sn; } } } }
    }
}
__device__ __forceinline__ void phase_prologue(const Frame& F, const Params& P) {
    unsigned char* ws = F.ws;
    pro_tiles<0>(F, P, 0, F.gw, 2048, pro::I_IN);
    for (int m = F.gw; m < MTOK; m += F.ngw) {
        const f32x4* xr = (const f32x4*)(P.in[I_X] + (size_t)m * DM) + F.lane; f32x4 v[4]; float s = 0.f;
#pragma unroll
        for (int j = 0; j < 4; ++j) { v[j] = xr[64 * j]; s += (v[j].x * v[j].x + v[j].y * v[j].y) + (v[j].z * v[j].z + v[j].w * v[j].w); }
        s = wave_sum(s);
        u32x2* o8 = (u32x2*)((bf16_t*)(ws + WS_HN) + (size_t)m * DM) + F.lane;
#pragma unroll
        for (int j = 0; j < 4; ++j) { const f32x4 g = ((const f32x4*)P.in[I_ANORM])[F.lane + 64 * j]; const f32x4 y = v[j] * g; u32x2 w; w.x = pk2(y.x, y.y); w.y = pk2(y.z, y.w); o8[64 * j] = w; }
        if (F.lane < 16) ((float*)(ws + WS_SS))[(size_t)m * 16 + F.lane] = F.lane == 0 ? s : 0.f;
    }
}
template <int PART>
__device__ __forceinline__ void phase_moe_convert(const Frame& F, const Params& P, int w0, int nw) {
    LAS float* scr = (LAS float*)(F.lds + F.wave * 16640);
    constexpr int I_GH = 16 * 28, I_D = 56 * 16;
    constexpr int PER_E = PART == 0 ? 2 * I_GH + I_D : 2 * I_GH;
    for (int it = w0; it < NEXP * PER_E; it += nw) {
        const int e = it / PER_E; int r = it % PER_E;
        if (r < 2 * I_GH) { const int up = r / I_GH; r %= I_GH; const int kb = r / 28, nb = PART * 28 + r % 28;
            transpose_tile64(P.in[up ? I_MU2 : I_MG] + (size_t)e * DM * DFFE, DFFE, kb * 64, nb * 64, (bf16_t*)(F.ws + WS_MGU) + (size_t)e * 2 * DFFE * DM, DM, gu_drow(nb * 64, up), gu_drow(nb * 64 + 32, up), 0, scr, F.lane); continue; }
        r -= 2 * I_GH;
        conv_plain(P.in[I_MD] + (size_t)e * DFFE * DM, DFFE, DM, (bf16_t*)(F.ws + WS_MD) + (size_t)e * DM * DFFE, DFFE, r, scr, F.lane);
    }
}

template <bool MOE>
__device__ __forceinline__ void phase_rms(const Frame& F, const bf16_t* src, const float* gain, bf16_t* hn, const float* router, unsigned* ectl, int* tok_e, int* tok_slot, float* tok_w) {
    LAS int* lcnt = (LAS int*)(F.lds);
    if (MOE) { if (F.tid < 16) lcnt[F.tid] = 0; __syncthreads(); }
    int my_e0 = 0, my_e1 = 0, my_s0 = 0, my_s1 = 0; float my_w0 = 0.f, my_w1 = 0.f;
    f32x4 rw[MOE ? 32 : 1];
    if (MOE) {
#pragma unroll
        for (int j = 0; j < 4; ++j)
#pragma unroll
            for (int q = 0; q < 4; ++q) { const int c = 4 * F.lane + 256 * j + q; rw[(j * 4 + q) * 2] = *(const f32x4*)(router + (size_t)c * 8); rw[(j * 4 + q) * 2 + 1] = *(const f32x4*)(router + (size_t)c * 8 + 4); } }
    f32x4 gn[4];
#pragma unroll
    for (int j = 0; j < 4; ++j) gn[j] = ((const f32x4*)gain)[F.lane + 64 * j];
    for (int i0 = 0; i0 < 8; i0 += 4) {
    u32x2 raw[4][4];
#pragma unroll
    for (int r = 0; r < 4; ++r) { const u32x2* xr = (const u32x2*)(src + (size_t)(F.blk * 64 + F.wave * 8 + i0 + r) * HLD) + F.lane;
#pragma unroll
        for (int j = 0; j < 4; ++j) raw[r][j] = xr[64 * j]; }
    asm volatile("" ::: "memory");
#pragma unroll
    for (int r = 0; r < 4; ++r) {
        const int i = i0 + r, m = F.blk * 64 + F.wave * 8 + i;
        f32x4 v[4]; float s = 0.f;
#pragma unroll
        for (int j = 0; j < 4; ++j) { const u32x2 p = raw[r][j]; v[j] = (f32x4){bflo(p.x), bfhi(p.x), bflo(p.y), bfhi(p.y)}; s += (v[j].x * v[j].x + v[j].y * v[j].y) + (v[j].z * v[j].z + v[j].w * v[j].w); }
        const float rstd = rsqrtf(wave_sum(s) * (1.0f / DM) + NORM_EPS);
#pragma unroll
        for (int j = 0; j < 4; ++j) v[j] = v[j] * rstd * gn[j];
        u32x2* o8 = (u32x2*)(hn + (size_t)m * DM) + F.lane;
#pragma unroll
        for (int j = 0; j < 4; ++j) { u32x2 w; w.x = pk2(v[j].x, v[j].y); w.y = pk2(v[j].z, v[j].w); o8[64 * j] = w; }
        if (MOE) {
            float lg[8];
#pragma unroll
            for (int e = 0; e < 8; ++e) lg[e] = 0.f;
#pragma unroll
            for (int j = 0; j < 4; ++j)
#pragma unroll
                for (int q = 0; q < 4; ++q) { const f32x4 r0 = rw[(j * 4 + q) * 2], r1 = rw[(j * 4 + q) * 2 + 1]; const float x = v[j][q];
                    lg[0] += x * r0.x; lg[1] += x * r0.y; lg[2] += x * r0.z; lg[3] += x * r0.w; lg[4] += x * r1.x; lg[5] += x * r1.y; lg[6] += x * r1.z; lg[7] += x * r1.w; }
#pragma unroll
            for (int e = 0; e < 8; ++e) lg[e] = wave_sum(lg[e]);
            int e0 = 0; float b0 = lg[0];
#pragma unroll
            for (int e = 1; e < 8; ++e) if (lg[e] > b0) { b0 = lg[e]; e0 = e; }
            int e1 = -1; float b1 = -3.0e38f;
#pragma unroll
            for (int e = 0; e < 8; ++e) if (e != e0 && lg[e] > b1) { b1 = lg[e]; e1 = e; }
            const float t = __expf(b1 - b0), w0 = 1.0f / (1.0f + t), w1 = t / (1.0f + t);
            int s0 = 0, s1 = 0;
            if (F.lane == 0) { s0 = atomicAdd((int*)&lcnt[e0], 1); s1 = atomicAdd((int*)&lcnt[e1], 1); }
            s0 = __shfl(s0, 0); s1 = __shfl(s1, 0);
            if (F.lane == i) { my_e0 = e0; my_e1 = e1; my_s0 = s0; my_s1 = s1; my_w0 = w0; my_w1 = w1; }
        }
    }
    }
    if (MOE) {
        __syncthreads();
        if (F.tid < 8) lcnt[8 + F.tid] = (int)atomicAdd(&ectl[F.tid], (unsigned)lcnt[F.tid]);
        __syncthreads();
        if (F.lane < 8) { const int m = F.blk * 64 + F.wave * 8 + F.lane;
            tok_e[2 * m] = my_e0; tok_e[2 * m + 1] = my_e1; tok_slot[2 * m] = lcnt[8 + my_e0] + my_s0; tok_slot[2 * m + 1] = lcnt[8 + my_e1] + my_s1; tok_w[2 * m] = my_w0; tok_w[2 * m + 1] = my_w1; }
        __syncthreads();
    }
}
__device__ __forceinline__ void phase_final(const Frame& F, float* h, const float* gain, const bf16_t* out2, const int* tok_pos) {
    int pos[8][2];
#pragma unroll
    for (int k = 0; k < 8; ++k) { const int m = F.gw + k * F.ngw; pos[k][0] = tok_pos[2 * m]; pos[k][1] = tok_pos[2 * m + 1]; }
    f32x4 gn[4];
#pragma unroll
    for (int j = 0; j < 4; ++j) gn[j] = ((const f32x4*)gain)[F.lane + 64 * j];
#pragma unroll
    for (int k0 = 0; k0 < 8; k0 += 4) {
        u32x2 hv[4][4], av[4][4], bv[4][4];
#pragma unroll
        for (int r = 0; r < 4; ++r) { const int m = F.gw + (k0 + r) * F.ngw;
            const u32x2* hr = (const u32x2*)((const bf16_t*)h + (size_t)m * HLD) + F.lane;
            const u32x2* o0 = (const u32x2*)(out2 + (size_t)pos[k0 + r][0] * DM) + F.lane; const u32x2* o1 = (const u32x2*)(out2 + (size_t)pos[k0 + r][1] * DM) + F.lane;
#pragma unroll
            for (int j = 0; j < 4; ++j) { hv[r][j] = hr[64 * j]; av[r][j] = o0[64 * j]; bv[r][j] = o1[64 * j]; } }
        asm volatile("" ::: "memory");
#pragma unroll
        for (int r = 0; r < 4; ++r) { const int m = F.gw + (k0 + r) * F.ngw;
            f32x4* xr = (f32x4*)(h + (size_t)m * DM) + F.lane;
            f32x4 v[4]; float s = 0.f;
#pragma unroll
            for (int j = 0; j < 4; ++j) { const u32x2 p = hv[r][j]; v[j] = (f32x4){bflo(p.x), bfhi(p.x), bflo(p.y), bfhi(p.y)}; const u32x2 a = av[r][j], b = bv[r][j];
                v[j].x += bflo(a.x) + bflo(b.x); v[j].y += bfhi(a.x) + bfhi(b.x); v[j].z += bflo(a.y) + bflo(b.y); v[j].w += bfhi(a.y) + bfhi(b.y);
                s += (v[j].x * v[j].x + v[j].y * v[j].y) + (v[j].z * v[j].z + v[j].w * v[j].w); }
            const float rstd = rsqrtf(wave_sum(s) * (1.0f / DM) + NORM_EPS);
#pragma unroll
            for (int j = 0; j < 4; ++j) xr[64 * j] = v[j] * rstd * gn[j]; }
    }
}
template <int KS>
__device__ __forceinline__ f32x4 mm_tile(const LAS bf16_t* P, int ldp, const LAS bf16_t* Q, int ldq, int ib, int jb, int lane, f32x4 acc) {
    const LAS bf16_t* pp = P + (ib * 16 + (lane & 15)) * ldp + 8 * (lane >> 4);
    const LAS bf16_t* qp = Q + (jb * 16 + (lane & 15)) * ldq + 8 * (lane >> 4);
#pragma unroll
    for (int ks = 0; ks < KS; ++ks) { const bf16x8 a = *(const LAS bf16x8*)(qp + ks * 32), b = *(const LAS bf16x8*)(pp + ks * 32); acc = __builtin_amdgcn_mfma_f32_16x16x32_bf16(a, b, acc, 0, 0, 0); }
    return acc;
}
__device__ __forceinline__ void st_bf4(LAS bf16_t* p, f32x4 v) { u32x2 w; w.x = pk2(v[0], v[1]); w.y = pk2(v[2], v[3]); *(LAS u32x2*)p = w; }
__device__ __forceinline__ float ret_lg(int h) { return __logf(1.0f - exp2f(-5.0f - (float)h)); }

__device__ __forceinline__ void phase_prep(const Frame& F, const Params& P, int layer) {
    unsigned char* ws = F.ws;
    const bf16_t* p = (const bf16_t*)(ws + WS_P);
    const float* mu = P.in[I_MU] + (size_t)layer * RWKV_COLS;
    float mu5[5];
#pragma unroll
    for (int jj = 0; jj < 5; ++jj) { const int c = F.lane + 64 * jj; mu5[jj] = mu[1536 + (c < 288 ? c : 0)]; }
    const f32x4 gq = *(const f32x4*)(P.in[I_QNORM] + layer * 256 + 4 * F.lane);
    const f32x2 gk = *(const f32x2*)(P.in[I_KVNORM] + layer * 128 + 2 * F.lane);
    for (int m0 = F.gw; m0 < MTOK; m0 += 4 * F.ngw) {
        unsigned short lx[4][5], lp[4][5], kx1[4], kx2[4]; u32x2 qa[4]; unsigned kva[4]; float kc[4], ks[4];
#pragma unroll
        for (int r = 0; r < 4; ++r) { const int m = m0 + r * F.ngw; const bf16_t* pr = p + (size_t)m * PW; const bool has_prev = (m % SEQ) != 0; const bf16_t* pp = has_prev ? pr - PW : pr;
#pragma unroll
            for (int jj = 0; jj < 5; ++jj) { const int c = F.lane + 64 * jj; const int off = 1536 + (c < 288 ? c : 0); lx[r][jj] = pr[P_RW + off]; lp[r][jj] = pp[P_RW + off]; }
            qa[r] = *(const u32x2*)(pr + P_QA + 4 * F.lane); kva[r] = *(const unsigned*)(pr + P_KVA + 2 * F.lane);
            const int l16 = F.lane & 15; kx1[r] = pr[P_KVA + 128 + l16]; kx2[r] = pr[P_KVA + 144 + l16];
            kc[r] = ((const float*)(ws + WS_COSM))[(size_t)m * 16 + l16]; ks[r] = ((const float*)(ws + WS_SINM))[(size_t)m * 16 + l16]; }
        asm volatile("" ::: "memory");
#pragma unroll
        for (int r = 0; r < 4; ++r) { const int m = m0 + r * F.ngw; const bool has_prev = (m % SEQ) != 0;
            bf16_t* lin = (bf16_t*)(ws + WS_LIN) + (size_t)m * LORA_K;
#pragma unroll
            for (int jj = 0; jj < 6; ++jj) { const int c = F.lane + 64 * jj; float o = 0.f;
                if (jj < 5) { const float x = bf2f(lx[r][jj < 5 ? jj : 0]), xp = has_prev ? bf2f(lp[r][jj < 5 ? jj : 0]) : 0.f; const float xs = x + (xp - x) * mu5[jj < 5 ? jj : 0];
                    const float oo = c < 64 ? tanhf(xs) : (c < 128 ? xs : sigmoidf_(xs)); o = c < 288 ? oo : 0.f; }
                lin[c] = (bf16_t)f2bf(o); }
            {
                const u32x2 w = qa[r]; float x[4] = {bflo(w.x), bfhi(w.x), bflo(w.y), bfhi(w.y)};
                const float ss = wave_sum(x[0] * x[0] + x[1] * x[1] + x[2] * x[2] + x[3] * x[3]); const float rs = rsqrtf(ss * (1.0f / 256.0f) + NORM_EPS);
                u32x2 o; o.x = pk2(x[0] * rs * gq.x, x[1] * rs * gq.y); o.y = pk2(x[2] * rs * gq.z, x[3] * rs * gq.w); *(u32x2*)((bf16_t*)(ws + WS_QN) + (size_t)m * 256 + 4 * F.lane) = o; }
            {
                const unsigned w = kva[r]; float x0 = bflo(w), x1 = bfhi(w);
                const float ss = wave_sum(x0 * x0 + x1 * x1); const float rs = rsqrtf(ss * (1.0f / 128.0f) + NORM_EPS);
                unsigned* cn = (unsigned*)((bf16_t*)(ws + WS_CN) + (size_t)m * 256); cn[F.lane] = pk2(x0 * rs * gk.x, x1 * rs * gk.y); cn[64 + F.lane] = 0u; }
            if (F.lane < 16) {
                const float x1 = bf2f(kx1[r]), x2 = bf2f(kx2[r]); const float c = kc[r], s = ks[r];
                bf16_t* kp = (bf16_t*)(ws + WS_KPE) + (size_t)m * 32; kp[F.lane] = (bf16_t)f2bf(x1 * c - x2 * s); kp[16 + F.lane] = (bf16_t)f2bf(x1 * s + x2 * c); } }
    }
    LAS bf16_t* kT = (LAS bf16_t*)F.lds;
    LAS bf16_t* vT = kT + 128 * 72;
    const int pc = F.tid & 7, j = F.tid >> 3;
    for (int u = F.blk; u < NB * NCHUNK * 4; u += F.G) {
        const int h = u & 3, n = (u >> 2) & 127, b = u >> 9; const int m = b * SEQ + n * 64 + j;
        const float lg = ret_lg(h);
        __syncthreads();
        {
            const bf16_t* kr = p + (size_t)m * PW + P_RK + h * 128 + pc * 8;
            const u32x4 a = *(const u32x4*)kr, bq = *(const u32x4*)(kr + 64);
            const float* cp = (const float*)(ws + WS_COSR) + (size_t)m * 64 + pc * 8; const float* sp = (const float*)(ws + WS_SINR) + (size_t)m * 64 + pc * 8;
            const float sc = 0.08838834764831845f * __expf(lg * (float)(63 - j));
            const unsigned aw[4] = {a.x, a.y, a.z, a.w}, bw[4] = {bq.x, bq.y, bq.z, bq.w};
#pragma unroll
            for (int i = 0; i < 8; ++i) { const float x1 = (i & 1) ? bfhi(aw[i >> 1]) : bflo(aw[i >> 1]), x2 = (i & 1) ? bfhi(bw[i >> 1]) : bflo(bw[i >> 1]); const float c = cp[i], s = sp[i];
                kT[(pc * 8 + i) * 72 + j] = (bf16_t)f2bf((x1 * c - x2 * s) * sc); kT[(64 + pc * 8 + i) * 72 + j] = (bf16_t)f2bf((x1 * s + x2 * c) * sc); }
            const bf16_t* vr = p + (size_t)m * PW + P_RV + h * 128 + pc * 8;
            const u32x4 va = *(const u32x4*)vr, vb = *(const u32x4*)(vr + 64);
            const unsigned vaw[4] = {va.x, va.y, va.z, va.w}, vbw[4] = {vb.x, vb.y, vb.z, vb.w};
#pragma unroll
            for (int i = 0; i < 8; ++i) { vT[(pc * 8 + i) * 72 + j] = (bf16_t)((i & 1) ? (vaw[i >> 1] >> 16) : (vaw[i >> 1] & 0xffffu)); vT[(64 + pc * 8 + i) * 72 + j] = (bf16_t)((i & 1) ? (vbw[i >> 1] >> 16) : (vbw[i >> 1] & 0xffffu)); }
        }
        __syncthreads();
        bf16_t* out = (bf16_t*)(ws + WS_RS) + (size_t)u * 16384;
#pragma unroll
        for (int jb = 0; jb < 8; ++jb) { f32x4 acc = {0.f, 0.f, 0.f, 0.f}; acc = mm_tile<2>(vT, 72, kT, 72, F.wave, jb, F.lane, acc);
            const int e = F.wave * 16 + (F.lane & 15), d = jb * 16 + 4 * (F.lane >> 4);
            u32x2 w; w.x = pk2(acc[0], acc[1]); w.y = pk2(acc[2], acc[3]); *(u32x2*)(out + e * 128 + d) = w; }
    }
    __syncthreads();
}

__device__ __forceinline__ void ret_scan(const Frame& F) {
    bf16_t* rs = (bf16_t*)(F.ws + WS_RS);
    for (int idx = F.blk * NTHR + F.tid; idx < NB * 4 * 16384; idx += F.G * NTHR) {
        const int b = idx >> 16, h = (idx >> 14) & 3, ed = idx & 16383; const float cd = __expf(ret_lg(h) * 64.0f);
        bf16_t* base = rs + ((size_t)(b * 128) * 4 + h) * 16384 + ed; float s = 0.f;
        for (int n0 = 0; n0 < NCHUNK; n0 += 32) { unsigned short t[32];
#pragma unroll
            for (int i = 0; i < 32; ++i) t[i] = base[(size_t)(n0 + i) * 65536];
#pragma unroll
            for (int i = 0; i < 32; ++i) { base[(size_t)(n0 + i) * 65536] = (bf16_t)f2bf(s); s = s * cd + bf2f(t[i]); } }
    }
}

__device__ __forceinline__ void ret_out(const Frame& F) {
    unsigned char* ws = F.ws; const bf16_t* p = (const bf16_t*)(ws + WS_P);
    LAS bf16_t* q = (LAS bf16_t*)F.lds;
    LAS bf16_t* k = q + 64 * 136;
    LAS bf16_t* vT = k + 64 * 136;
    LAS bf16_t* pT = vT + 128 * 72;
    LAS bf16_t* sc = pT + 128 * 136;
    LAS float* st = (LAS float*)(sc + 64 * 72);
    const int pc = F.tid & 7, j = F.tid >> 3;
    for (int u = F.blk; u < NB * NCHUNK * 4; u += F.G) {
        const int h = u & 3, n = (u >> 2) & 127, b = u >> 9; const int m0 = b * SEQ + n * 64, m = m0 + j;
        const float lg = ret_lg(h);
        LBAR();
        {
            const float* cp = (const float*)(ws + WS_COSR) + (size_t)m * 64 + pc * 8; const float* sp = (const float*)(ws + WS_SINR) + (size_t)m * 64 + pc * 8;
            float cs[8], sn[8];
#pragma unroll
            for (int i = 0; i < 8; ++i) { cs[i] = cp[i]; sn[i] = sp[i]; }
#pragma unroll
            for (int which = 0; which < 2; ++which) {
                const bf16_t* r = p + (size_t)m * PW + (which ? P_RK : P_RQ) + h * 128 + pc * 8;
                const u32x4 a = *(const u32x4*)r, bq = *(const u32x4*)(r + 64);
                const unsigned aw[4] = {a.x, a.y, a.z, a.w}, bw[4] = {bq.x, bq.y, bq.z, bq.w}; const float sc_ = which ? 0.08838834764831845f : 1.0f;
                float o1[8], o2[8];
#pragma unroll
                for (int i = 0; i < 8; ++i) { const float x1 = (i & 1) ? bfhi(aw[i >> 1]) : bflo(aw[i >> 1]), x2 = (i & 1) ? bfhi(bw[i >> 1]) : bflo(bw[i >> 1]); o1[i] = (x1 * cs[i] - x2 * sn[i]) * sc_; o2[i] = (x1 * sn[i] + x2 * cs[i]) * sc_; }
                LAS bf16_t* dst = (which ? k : q) + j * 136 + pc * 8;
                u32x4 w1, w2; w1.x = pk2(o1[0], o1[1]); w1.y = pk2(o1[2], o1[3]); w1.z = pk2(o1[4], o1[5]); w1.w = pk2(o1[6], o1[7]); w2.x = pk2(o2[0], o2[1]); w2.y = pk2(o2[2], o2[3]); w2.z = pk2(o2[4], o2[5]); w2.w = pk2(o2[6], o2[7]);
                *(LAS u32x4*)dst = w1; *(LAS u32x4*)(dst + 64) = w2; }
            const bf16_t* vr = p + (size_t)m * PW + P_RV + h * 128 + pc * 8;
            const u32x4 va = *(const u32x4*)vr, vb = *(const u32x4*)(vr + 64);
            const unsigned vaw[4] = {va.x, va.y, va.z, va.w}, vbw[4] = {vb.x, vb.y, vb.z, vb.w};
#pragma unroll
            for (int i = 0; i < 8; ++i) { vT[(pc * 8 + i) * 72 + j] = (bf16_t)((i & 1) ? (vaw[i >> 1] >> 16) : (vaw[i >> 1] & 0xffffu)); vT[(64 + pc * 8 + i) * 72 + j] = (bf16_t)((i & 1) ? (vbw[i >> 1] >> 16) : (vbw[i >> 1] & 0xffffu)); }
            const bf16_t* ps = (const bf16_t*)(ws + WS_RS) + (size_t)u * 16384;
#pragma unroll
            for (int i = 0; i < 4; ++i) { const int pi = F.tid + i * 512; const int e = pi >> 4, c = pi & 15; *(LAS u32x4*)(pT + e * 136 + c * 8) = *(const u32x4*)(ps + e * 128 + c * 8); }
        }
        LBAR();
        {
            const int ib = F.wave & 3;
#pragma unroll
            for (int t = 0; t < 2; ++t) { const int jb = 2 * (F.wave >> 2) + t; f32x4 acc = {0.f, 0.f, 0.f, 0.f}; acc = mm_tile<4>(q, 136, k, 136, ib, jb, F.lane, acc);
                const int i = ib * 16 + (F.lane & 15), j0 = jb * 16 + 4 * (F.lane >> 4);
#pragma unroll
                for (int r = 0; r < 4; ++r) { const int dd = i - (j0 + r); acc[r] *= __expf(lg * (float)(dd < 0 ? -dd : dd)); }
                st_bf4(sc + i * 72 + j0, acc); }
        }
        LBAR();
        {
            const int ib = F.wave & 3, eh = F.wave >> 2; const int i = ib * 16 + (F.lane & 15);
            const float qd = __expf(lg * (float)(i + 1));
            f32x4 o[4]; float s1 = 0.f, s2 = 0.f;
#pragma unroll
            for (int t = 0; t < 4; ++t) { const int eb = eh * 4 + t; f32x4 ai = {0.f, 0.f, 0.f, 0.f}, ac = {0.f, 0.f, 0.f, 0.f};
                ai = mm_tile<2>(sc, 72, vT, 72, ib, eb, F.lane, ai); ac = mm_tile<4>(q, 136, pT, 136, ib, eb, F.lane, ac);
                o[t] = ai + ac * qd;
#pragma unroll
                for (int r = 0; r < 4; ++r) { s1 += o[t][r]; s2 += o[t][r] * o[t][r]; } }
            s1 += __shfl_xor(s1, 16); s1 += __shfl_xor(s1, 32); s2 += __shfl_xor(s2, 16); s2 += __shfl_xor(s2, 32);
            if (F.lane < 16) { st[(eh * 64 + i) * 2] = s1; st[(eh * 64 + i) * 2 + 1] = s2; }
            LBAR();
            const float t1 = st[i * 2] + st[(64 + i) * 2], t2 = st[i * 2 + 1] + st[(64 + i) * 2 + 1];
            const float mean = t1 * (1.0f / 128.0f), var = fmaxf(t2 * (1.0f / 128.0f) - mean * mean, 0.f), rstd = rsqrtf(var + 1e-5f);
            const int mrow = m0 + i;
#pragma unroll
            for (int t = 0; t < 4; ++t) { const int e = (eh * 4 + t) * 16 + 4 * (F.lane >> 4);
                const u32x2 gw = *(const u32x2*)(p + (size_t)mrow * PW + P_RG + h * 128 + e); const float g[4] = {bflo(gw.x), bfhi(gw.x), bflo(gw.y), bfhi(gw.y)};
                float y[4];
#pragma unroll
                for (int r = 0; r < 4; ++r) y[r] = (o[t][r] - mean) * rstd * (g[r] * sigmoidf_(g[r]));
                u32x2 w; w.x = pk2(y[0], y[1]); w.y = pk2(y[2], y[3]); *(u32x2*)((bf16_t*)(ws + WS_YRET) + (size_t)mrow * 512 + h * 128 + e) = w; }
        }
    }
    __syncthreads();
}

constexpr int ATT_KP = 104, ATT_VP = 72;
constexpr int ATT_KB = 64 * ATT_KP * 2, ATT_VB = 64 * ATT_VP * 2;
constexpr int ATT_K0 = 0, ATT_V0 = 2 * ATT_KB;
__device__ __forceinline__ void attn_unit(const Frame& F, int b, int h, int qt) {
    unsigned char* ws = F.ws;
    const bf16_t* Qg = (const bf16_t*)(ws + WS_Q); const bf16_t* Kn = (const bf16_t*)(ws + WS_KN); const bf16_t* Kp = (const bf16_t*)(ws + WS_KPE); const bf16_t* Vt = (const bf16_t*)(ws + WS_VT);
    const int lane = F.lane, w = F.wave, ql = lane & 31, hf = lane >> 5;
    const int mq = b * SEQ + qt * 256 + w * 32 + ql;
    const float qs = 0.10206207261596577f * 1.4426950408889634f;
    bf16x8 qf[6];
    {
        const bf16_t* qr = Qg + (size_t)mq * 768 + h * 96;
#pragma unroll
        for (int s = 0; s < 4; ++s) { const u32x4 x = *(const u32x4*)(qr + 16 * s + 8 * hf); const unsigned xw[4] = {x.x, x.y, x.z, x.w}; u32x4 o; unsigned ow[4];
#pragma unroll
            for (int i = 0; i < 4; ++i) ow[i] = pk2(bflo(xw[i]) * qs, bfhi(xw[i]) * qs);
            o.x = ow[0]; o.y = ow[1]; o.z = ow[2]; o.w = ow[3]; qf[s] = __builtin_bit_cast(bf16x8, o); }
        const u32x4 x1 = *(const u32x4*)(qr + 64 + 8 * hf), x2 = *(const u32x4*)(qr + 80 + 8 * hf);
        const float* cp = (const float*)(ws + WS_COSM) + (size_t)mq * 16 + 8 * hf; const float* sp = (const float*)(ws + WS_SINM) + (size_t)mq * 16 + 8 * hf;
        const unsigned a[4] = {x1.x, x1.y, x1.z, x1.w}, c[4] = {x2.x, x2.y, x2.z, x2.w}; unsigned o1[4], o2[4];
#pragma unroll
        for (int i = 0; i < 4; ++i) { const float u0 = bflo(a[i]), u1 = bfhi(a[i]), v0 = bflo(c[i]), v1 = bfhi(c[i]); const float c0 = cp[2 * i], c1 = cp[2 * i + 1], s0 = sp[2 * i], s1 = sp[2 * i + 1];
            o1[i] = pk2((u0 * c0 - v0 * s0) * qs, (u1 * c1 - v1 * s1) * qs); o2[i] = pk2((u0 * s0 + v0 * c0) * qs, (u1 * s1 + v1 * c1) * qs); }
        u32x4 t1, t2; t1.x = o1[0]; t1.y = o1[1]; t1.z = o1[2]; t1.w = o1[3]; t2.x = o2[0]; t2.y = o2[1]; t2.z = o2[2]; t2.w = o2[3];
        qf[4] = __builtin_bit_cast(bf16x8, t1); qf[5] = __builtin_bit_cast(bf16x8, t2);
    }
    f32x16 oacc[2];
#pragma unroll
    for (int i = 0; i < 16; ++i) { oacc[0][i] = 0.f; oacc[1][i] = 0.f; }
    float mrun = 0.f; f32x2 lsum = {0.f, 0.f};
    const int nkt = 4 * qt + 4, mylim = 4 * qt + (w >> 1);
    const int half = w >> 2;
    const int kkey = F.tid >> 3, kpc = F.tid & 7, rkey = (F.tid & 255) >> 2, rpc = F.tid & 3, ve = F.tid >> 3, vpc = F.tid & 7;
    const bf16_t* knp = Kn + (size_t)(b * SEQ + kkey) * 512 + h * 64 + kpc * 8;
    const bf16_t* kpp = Kp + (size_t)(b * SEQ + rkey) * 32 + rpc * 8;
    const bf16_t* vtp = Vt + (size_t)(h * 64 + ve) * MTOK + b * SEQ + vpc * 8;
    const int kofs = (kkey * ATT_KP + kpc * 8) * 2, rofs = (rkey * ATT_KP + 64 + rpc * 8) * 2, vofs = (ve * ATT_VP + vpc * 8) * 2;
    constexpr bool rp = true;
#define ATT_QK(sv, kbuf, init) do { _Pragma("unroll") for (int t_ = 0; t_ < 2; ++t_) { _Pragma("unroll") for (int i_ = 0; i_ < 16; ++i_) sv[t_][i_] = (init); } \
        const LAS bf16_t* kr_ = (kbuf) + ql * ATT_KP + 8 * hf; bf16x8 ka_ = *(const LAS bf16x8*)kr_, kb_ = *(const LAS bf16x8*)(kr_ + 32 * ATT_KP); \
        _Pragma("unroll") for (int st_ = 0; st_ < 6; ++st_) { bf16x8 na_ = ka_, nb_ = kb_; \
            if (st_ < 5) { na_ = *(const LAS bf16x8*)(kr_ + 16 * (st_ + 1)); nb_ = *(const LAS bf16x8*)(kr_ + 32 * ATT_KP + 16 * (st_ + 1)); } \
            sv[0] = __builtin_amdgcn_mfma_f32_32x32x16_bf16(ka_, qf[st_], sv[0], 0, 0, 0); sv[1] = __builtin_amdgcn_mfma_f32_32x32x16_bf16(kb_, qf[st_], sv[1], 0, 0, 0); \
            ka_ = na_; kb_ = nb_; __builtin_amdgcn_sched_barrier(0); } } while (0)
    u32x4 ak, ar, av, bk, br, bv;
#define ATT_LOAD(K_, R_, V_, t_) do { const int tt_ = (t_) < nkt ? (t_) : nkt - 1; \
        K_ = *(const u32x4*)(knp + (size_t)tt_ * 64 * 512); R_ = *(const u32x4*)(kpp + (size_t)tt_ * 64 * 32); V_ = *(const u32x4*)(vtp + (size_t)tt_ * 64); } while (0)
#define ATT_STAGE(K_, R_, V_, kt_) do { { LAS unsigned char* kb2_ = F.lds + ATT_K0 + (((kt_) + 1) & 1) * ATT_KB; *(LAS u32x4*)(kb2_ + kofs) = K_; *(LAS u32x4*)(kb2_ + rofs) = R_; } \
        *(LAS u32x4*)(F.lds + ATT_V0 + (((kt_) + 1) & 1) * ATT_VB + vofs) = V_; ATT_LOAD(K_, R_, V_, (kt_) + 3); } while (0)
    __syncthreads();
    {
        ak = *(const u32x4*)knp; ar = *(const u32x4*)kpp; av = *(const u32x4*)vtp;
        *(LAS u32x4*)(F.lds + ATT_K0 + kofs) = ak; *(LAS u32x4*)(F.lds + ATT_K0 + rofs) = ar; *(LAS u32x4*)(F.lds + ATT_V0 + vofs) = av;
        ATT_LOAD(ak, ar, av, 1); ATT_LOAD(bk, br, bv, 2);
    }
    __syncthreads();
    f32x16 sc[2];
    if (half == 1) LBAR();
#define ATT_SEG1(kt_, ALL) do { if ((ALL) || (kt_) <= mylim) ATT_QK(sc, (const LAS bf16_t*)(F.lds + ATT_K0 + ((kt_) & 1) * ATT_KB), -mrun); } while (0)
#define ATT_SEG2(kt_, ALL) do { if ((ALL) || (kt_) <= mylim) { \
            const LAS bf16_t* vb = (const LAS bf16_t*)(F.lds + ATT_V0 + ((kt_) & 1) * ATT_VB); \
            int mi = __builtin_bit_cast(int, sc[0][0]); \
            _Pragma("unroll") for (int i = 0; i < 16; ++i) { const int a_ = __builtin_bit_cast(int, sc[0][i]), b_ = __builtin_bit_cast(int, sc[1][i]); mi = max(max(mi, a_), b_); } \
            if ((kt_) == 0 || __builtin_amdgcn_ballot_w64(__builtin_bit_cast(float, mi) > 8.0f) != 0ull) { \
                float mx = fmaxf(sc[0][0], sc[1][0]); \
                _Pragma("unroll") for (int i = 1; i < 16; ++i) mx = fmaxf(mx, fmaxf(sc[0][i], sc[1][i])); \
                { const int mb = __builtin_bit_cast(int, mx); const auto sw2 = __builtin_amdgcn_permlane32_swap(mb, mb, false, false); mx = fmaxf(__builtin_bit_cast(float, (int)sw2[0]), __builtin_bit_cast(float, (int)sw2[1])); } \
                const float delta = ((kt_) == 0) ? mx : fmaxf(mx, 0.f); \
                const float alpha = ((kt_) == 0) ? 1.0f : __builtin_amdgcn_exp2f(-delta); mrun += delta; lsum *= alpha; \
                _Pragma("unroll") for (int i = 0; i < 16; ++i) { oacc[0][i] *= alpha; oacc[1][i] *= alpha; sc[0][i] -= delta; sc[1][i] -= delta; } } \
            _Pragma("unroll") for (int t = 0; t < 2; ++t) _Pragma("unroll") for (int i = 0; i < 16; i += 2) { const float p0 = __builtin_amdgcn_exp2f(sc[t][i]), p1 = __builtin_amdgcn_exp2f(sc[t][i + 1]); sc[t][i] = p0; sc[t][i + 1] = p1; lsum += (f32x2){p0, p1}; } \
            _Pragma("unroll") for (int t = 0; t < 2; ++t) _Pragma("unroll") for (int kbb = 0; kbb < 2; ++kbb) { \
                    u32x4 pw; pw.x = pk2(sc[t][8 * kbb + 0], sc[t][8 * kbb + 1]); pw.y = pk2(sc[t][8 * kbb + 2], sc[t][8 * kbb + 3]); pw.z = pk2(sc[t][8 * kbb + 4], sc[t][8 * kbb + 5]); pw.w = pk2(sc[t][8 * kbb + 6], sc[t][8 * kbb + 7]); \
                    const bf16x8 pf = __builtin_bit_cast(bf16x8, pw); const int key0 = t * 32 + kbb * 16 + 4 * hf; \
                    _Pragma("unroll") for (int eb = 0; eb < 2; ++eb) { const LAS bf16_t* vr = vb + (eb * 32 + ql) * ATT_VP + key0; \
                        const u32x2 lo = *(const LAS u32x2*)vr, hi = *(const LAS u32x2*)(vr + 8); u32x4 vv; vv.x = lo.x; vv.y = lo.y; vv.z = hi.x; vv.w = hi.y; \
                        oacc[eb] = __builtin_amdgcn_mfma_f32_32x32x16_bf16(__builtin_bit_cast(bf16x8, vv), pf, oacc[eb], 0, 0, 0); } } } } while (0)
    const int nall = 4 * qt;
#define ATT_TRIP_L(kt_, ALL) do { ATT_SEG1(kt_, ALL); LBAR(); ATT_STAGE(ak, ar, av, kt_); ATT_SEG2(kt_, ALL); LBAR(); \
                                  ATT_SEG1((kt_) + 1, ALL); LBAR(); ATT_STAGE(bk, br, bv, (kt_) + 1); ATT_SEG2((kt_) + 1, ALL); LBAR(); } while (0)
#define ATT_TRIP_T(kt_, ALL) do { ATT_STAGE(ak, ar, av, kt_); ATT_SEG1(kt_, ALL); LBAR(); ATT_SEG2(kt_, ALL); LBAR(); \
                                  ATT_STAGE(bk, br, bv, (kt_) + 1); ATT_SEG1((kt_) + 1, ALL); LBAR(); ATT_SEG2((kt_) + 1, ALL); LBAR(); } while (0)
    if (half == 0) {
#pragma unroll 1
        for (int kt = 0; kt < nall; kt += 2) ATT_TRIP_L(kt, true);
#pragma unroll 1
        for (int kt = nall; kt < nkt; kt += 2) ATT_TRIP_L(kt, false);
        LBAR();
    } else {
#pragma unroll 1
        for (int kt = 0; kt < nall; kt += 2) ATT_TRIP_T(kt, true);
#pragma unroll 1
        for (int kt = nall; kt < nkt; kt += 2) ATT_TRIP_T(kt, false);
    }
#undef ATT_TRIP_L
#undef ATT_TRIP_T
#undef ATT_QK
#undef ATT_LOAD
#undef ATT_STAGE
#undef ATT_SEG1
#undef ATT_SEG2
    float lrun = lsum[0] + lsum[1];
    const float lt = lrun + __shfl_xor(lrun, 32), inv = 1.0f / lt;
    bf16_t* yo = (bf16_t*)(ws + WS_YMLA) + (size_t)mq * 512 + h * 64;
#pragma unroll
    for (int eb = 0; eb < 2; ++eb)
#pragma unroll
        for (int g = 0; g < 4; ++g) { u32x2 wv; wv.x = pk2(oacc[eb][4 * g] * inv, oacc[eb][4 * g + 1] * inv); wv.y = pk2(oacc[eb][4 * g + 2] * inv, oacc[eb][4 * g + 3] * inv);
            *(u32x2*)(yo + eb * 32 + 8 * g + 4 * hf) = wv; }
}
constexpr int RP = 72;
constexpr int RMAT = 64 * RP;
constexpr size_t RC_UNIT = 40960;
constexpr size_t WS_RC2 = WS_RC + (size_t)2048 * RC_UNIT;

__device__ __forceinline__ void st_g4(bf16_t* p, f32x4 v) { u32x2 w; w.x = pk2(v[0], v[1]); w.y = pk2(v[2], v[3]); *(u32x2*)p = w; }
__device__ __forceinline__ f32x4 ld_l4(const LAS bf16_t* p) { const u32x2 w = *(const LAS u32x2*)p; return (f32x4){bflo(w.x), bfhi(w.x), bflo(w.y), bfhi(w.y)}; }

template <int KS>
__device__ __forceinline__ f32x16 mm32(const LAS bf16_t* P, const LAS bf16_t* Q, int ib, int jb, int lane, f32x16 acc) {
    const LAS bf16_t* pp = P + (ib * 32 + (lane & 31)) * RP + 8 * (lane >> 5);
    const LAS bf16_t* qp = Q + (jb * 32 + (lane & 31)) * RP + 8 * (lane >> 5);
#pragma unroll
    for (int ks = 0; ks < KS; ++ks) { const bf16x8 a = *(const LAS bf16x8*)(qp + ks * 16), b = *(const LAS bf16x8*)(pp + ks * 16); acc = __builtin_amdgcn_mfma_f32_32x32x16_bf16(a, b, acc, 0, 0, 0); }
    return acc;
}
__device__ __forceinline__ f32x16 zero16() { f32x16 z; for (int i = 0; i < 16; ++i) z[i] = 0.f; return z; }
__device__ __forceinline__ void st32_lds(LAS bf16_t* O, int ib, int jb, int lane, const f32x16& a) {
    LAS bf16_t* o = O + (ib * 32 + (lane & 31)) * RP + jb * 32 + 4 * (lane >> 5);
#pragma unroll
    for (int g = 0; g < 4; ++g) st_bf4(o + 8 * g, (f32x4){a[4 * g], a[4 * g + 1], a[4 * g + 2], a[4 * g + 3]});
}
__device__ __forceinline__ void st32_glb(bf16_t* O, int ib, int jb, int lane, const f32x16& a) {
    bf16_t* o = O + (ib * 32 + (lane & 31)) * 64 + jb * 32 + 4 * (lane >> 5);
#pragma unroll
    for (int g = 0; g < 4; ++g) st_g4(o + 8 * g, (f32x4){a[4 * g], a[4 * g + 1], a[4 * g + 2], a[4 * g + 3]});
}
struct PreIn { unsigned short r[8], rp[8], k[8], kp[8], v[8], vp[8], lw[8], a[8]; };
__device__ __forceinline__ void pre_load(PreIn& x, const bf16_t* p, const bf16_t* lo, int u, int w, int lane) {
    const int c = u & 127, h = (u >> 7) & 7, b = u >> 10; const int m0 = b * SEQ + c * 64, ch = h * 64 + lane;
#pragma unroll
    for (int i = 0; i < 8; ++i) { const int t = 8 * w + i, m = m0 + t; const bf16_t* pr = p + (size_t)m * PW + P_RW + ch; const bool hp = (c | t) != 0;
        x.r[i] = pr[0]; x.k[i] = pr[512]; x.v[i] = pr[1024];
        x.rp[i] = hp ? pr[-PW] : (unsigned short)0; x.kp[i] = hp ? pr[512 - PW] : (unsigned short)0; x.vp[i] = hp ? pr[1024 - PW] : (unsigned short)0;
        x.lw[i] = lo[(size_t)m * LO_W + ch]; x.a[i] = lo[(size_t)m * LO_W + 512 + ch]; }
}
#ifdef PRE_T
#define PRE_MARK(k) do { if (F.tid == 0) { volatile LAS unsigned long long* tq_ = (volatile LAS unsigned long long*)(F.lds + LDSCTL_OFF + 48); const unsigned long long now_ = __builtin_amdgcn_s_memrealtime(); \
        if ((k) == PRE_T) tq_[1] += now_ - tq_[2]; tq_[2] = now_; } } while (0)
#else
#define PRE_MARK(k) do { } while (0)
#endif
template <int DIAG = 0>
__device__ __forceinline__ void rwkv_chunk_pre(const Frame& F, const float* mu, const float* k_k_, const float* k_a_, const float* r_k_) {
    unsigned char* ws = F.ws; const bf16_t* p = (const bf16_t*)(ws + WS_P); const bf16_t* lo = (const bf16_t*)(ws + WS_LO);
    LAS bf16_t* M = (LAS bf16_t*)F.lds;
    LAS bf16_t *KKt = M, *Bt = M + RMAT, *Kt = M + 2 * RMAT, *Rt = M + 3 * RMAT, *KKtT = M + 4 * RMAT, *BhT = M + 5 * RMAT, *KhT = M + 6 * RMAT, *VcT = M + 7 * RMAT;
    LAS bf16_t *NA = M + 8 * RMAT, *NAT = M + 9 * RMAT, *TT = M + 10 * RMAT, *AkkT = M + 11 * RMAT, *AbrT = M + 12 * RMAT, *AkrT = M + 13 * RMAT;
    LAS float* SEG = (LAS float*)(M + 10 * RMAT);
    const int lane = F.lane, w = F.wave, pr_ = w >> 1, ib = w & 1;
    const int i0 = ib * 32 + (lane & 31), jq = 4 * (lane >> 5);
    PreIn cur;
    if (F.blk < NB * 8 * NCHUNK) pre_load(cur, p, lo, F.blk, w, lane);
    for (int u = F.blk; u < NB * 8 * NCHUNK; u += F.G) {
        const int h = (u >> 7) & 7; const int ch = h * 64 + lane;
        const float mu_r = mu[ch], mu_k = mu[512 + ch], mu_v = mu[1024 + ch], k_k = k_k_[ch], k_a = k_a_[ch], r_k = r_k_[ch];
        float* aux = DIAG ? (float*)(ws + WS_YMLA) + (size_t)(u & 255) * 128 : (float*)(ws + WS_RC2) + (size_t)u * 128;
        LBAR();
        PRE_MARK(0);
        if (DIAG != 2) {
        float rr[8], kk8[8], k28[8], vv[8], bb[8], lw8[8], cs8[8]; float cs = 0.f;
#pragma unroll
        for (int i = 0; i < 8; ++i) { const int t = 8 * w + i;
            const float xr = bf2f(cur.r[i]), xk = bf2f(cur.k[i]), xv = bf2f(cur.v[i]);
            const float r = xr + (bf2f(cur.rp[i]) - xr) * mu_r, k = xk + (bf2f(cur.kp[i]) - xk) * mu_k, v = xv + (bf2f(cur.vp[i]) - xv) * mu_v;
            const float lw = bf2f(cur.lw[i]), a = bf2f(cur.a[i]);
            float kk = k * k_k; const float ss = wave_sum(kk * kk); kk *= rsqrtf(ss + 1e-12f);
            const float k2 = k * (1.0f + (a - 1.0f) * k_a);
            rr[i] = r; kk8[i] = kk; k28[i] = k2; vv[i] = v; bb[i] = kk * a; lw8[i] = lw; cs += lw; cs8[i] = cs;
            (DIAG ? (bf16_t*)(ws + WS_YRW) + (size_t)(u & 255) * 4096 : (bf16_t*)(ws + WS_RC + (size_t)u * RC_UNIT) + 16384)[t * 64 + lane] = (bf16_t)f2bf(v);
            const float bon = wave_sum(r * k2 * r_k); if (lane == 0) aux[64 + t] = bon; }
        SEG[w * 64 + lane] = cs;
        if (u + F.G < NB * 8 * NCHUNK) pre_load(cur, p, lo, u + F.G, w, lane);
        LBAR();
        float off = 0.f, cumC = 0.f;
#pragma unroll
        for (int s = 0; s < 8; ++s) { const float sv = SEG[s * 64 + lane]; cumC += sv; off += (s < w) ? sv : 0.f; }
        if (w == 0) aux[lane] = __expf(cumC);
        LBAR();
        unsigned pkk[4], pbh[4], pkh[4], pvc[4];
#pragma unroll
        for (int i = 0; i < 8; i += 2) { float o_kk[2], o_bh[2], o_kh[2];
#pragma unroll
            for (int e = 0; e < 2; ++e) { const int t = 8 * w + i + e; const float cum = cs8[i + e] + off;
                const float om = __expf(cum), omx = __expf(cum - lw8[i + e]), iom = __expf(-cum), ih = __expf(cumC - cum);
                o_kk[e] = kk8[i + e] * omx; o_bh[e] = bb[i + e] * ih; o_kh[e] = k28[i + e] * ih;
                KKt[t * RP + lane] = (bf16_t)f2bf(o_kk[e]); Bt[t * RP + lane] = (bf16_t)f2bf(bb[i + e] * iom); Kt[t * RP + lane] = (bf16_t)f2bf(k28[i + e] * iom); Rt[t * RP + lane] = (bf16_t)f2bf(rr[i + e] * om); }
            pkk[i >> 1] = pk2(o_kk[0], o_kk[1]); pbh[i >> 1] = pk2(o_bh[0], o_bh[1]); pkh[i >> 1] = pk2(o_kh[0], o_kh[1]); pvc[i >> 1] = pk2(vv[i], vv[i + 1]); }
        *(LAS u32x4*)(KKtT + lane * RP + 8 * w) = (u32x4){pkk[0], pkk[1], pkk[2], pkk[3]}; *(LAS u32x4*)(BhT + lane * RP + 8 * w) = (u32x4){pbh[0], pbh[1], pbh[2], pbh[3]};
        *(LAS u32x4*)(KhT + lane * RP + 8 * w) = (u32x4){pkh[0], pkh[1], pkh[2], pkh[3]}; *(LAS u32x4*)(VcT + lane * RP + 8 * w) = (u32x4){pvc[0], pvc[1], pvc[2], pvc[3]};
        }
        LBAR();
        PRE_MARK(1);
        if (DIAG != 1) {
        {
            const LAS bf16_t* Pm = pr_ < 2 ? KKt : Rt; const LAS bf16_t* Qm = (pr_ == 0 || pr_ == 2) ? Bt : Kt; LAS bf16_t* Om = pr_ == 0 ? NAT : (pr_ == 1 ? AkkT : (pr_ == 2 ? AbrT : AkrT));
            const bool incl = pr_ >= 2; const float sgn = pr_ == 0 ? -1.0f : 1.0f;
#pragma unroll
            for (int jb = 0; jb < 2; ++jb) { f32x16 a = zero16(); if (jb <= ib) a = mm32<4>(Pm, Qm, ib, jb, lane, a);
#pragma unroll
                for (int g = 0; g < 4; ++g)
#pragma unroll
                    for (int r = 0; r < 4; ++r) { const int jj = jb * 32 + 8 * g + jq + r; const bool keep = incl ? (jj <= i0) : (jj < i0); a[4 * g + r] = keep ? sgn * a[4 * g + r] : 0.f; }
                st32_lds(Om, ib, jb, lane, a);
                if (pr_ == 0) {
#pragma unroll
                    for (int g = 0; g < 4; ++g)
#pragma unroll
                        for (int r = 0; r < 4; ++r) { const int jj = jb * 32 + 8 * g + jq + r; a[4 * g + r] += (jj == i0) ? 1.0f : 0.f; }
                    st32_lds(TT, ib, jb, lane, a); } }
            if (pr_ == 0) {
#pragma unroll
                for (int jb = 0; jb < 2; ++jb) { f32x16 a = zero16(); if (jb >= ib) a = mm32<4>(Bt, KKt, ib, jb, lane, a);
#pragma unroll
                    for (int g = 0; g < 4; ++g)
#pragma unroll
                        for (int r = 0; r < 4; ++r) { const int jj = jb * 32 + 8 * g + jq + r; a[4 * g + r] = (i0 < jj) ? -a[4 * g + r] : 0.f; }
                    st32_lds(NA, ib, jb, lane, a); } }
        }
        LBAR();
        PRE_MARK(2);
        LAS bf16_t* VA = Kt;
#pragma unroll 1
        for (int s = 1; s <= 6; ++s) {
            const LAS bf16_t* Yo = (s & 1) ? NAT : KKt; const LAS bf16_t* YoT = (s & 1) ? NA : Bt; LAS bf16_t* Yn = (s & 1) ? KKt : NAT; LAS bf16_t* YnT = (s & 1) ? Bt : NA;
            if (pr_ == 0) {
                if (s == 1) { const f32x16 a0 = mm32<4>(VcT, AkkT, ib, 0, lane, zero16()), a1 = mm32<4>(VcT, AkkT, ib, 1, lane, zero16()); st32_lds(VA, ib, 0, lane, a0); st32_lds(VA, ib, 1, lane, a1); }
                else {
                    f32x16 c0, c1; const LAS bf16_t* tr = TT + i0 * RP + jq;
#pragma unroll
                    for (int g = 0; g < 4; ++g) { const f32x4 x0 = ld_l4(tr + 8 * g), x1 = ld_l4(tr + 32 + 8 * g);
#pragma unroll
                        for (int r = 0; r < 4; ++r) { c0[4 * g + r] = x0[r]; c1[4 * g + r] = x1[r]; } }
                    c0 = mm32<4>(TT, YoT, ib, 0, lane, c0); c1 = mm32<4>(TT, YoT, ib, 1, lane, c1);
                    LDS_WAIT();
                    st32_lds(TT, ib, 0, lane, c0); st32_lds(TT, ib, 1, lane, c1); }
            } else if (pr_ <= 2 && s <= 5) {
                const LAS bf16_t* Pm = pr_ == 1 ? Yo : YoT; const LAS bf16_t* Qm = pr_ == 1 ? YoT : Yo; LAS bf16_t* Om = pr_ == 1 ? Yn : YnT;
                const f32x16 a0 = mm32<4>(Pm, Qm, ib, 0, lane, zero16()), a1 = mm32<4>(Pm, Qm, ib, 1, lane, zero16()); st32_lds(Om, ib, 0, lane, a0); st32_lds(Om, ib, 1, lane, a1);
            }
            LBAR();
        }
        PRE_MARK(3);
        LAS bf16_t* KT = NAT; LAS bf16_t* P1 = NA;
        if (pr_ < 2) { const LAS bf16_t* src = pr_ == 0 ? KKtT : VA; LAS bf16_t* dst = pr_ == 0 ? KT : P1;
            const f32x16 a0 = mm32<4>(src, TT, ib, 0, lane, zero16()), a1 = mm32<4>(src, TT, ib, 1, lane, zero16()); st32_lds(dst, ib, 0, lane, a0); st32_lds(dst, ib, 1, lane, a1); }
        LBAR();
        {
            bf16_t* og = DIAG ? (bf16_t*)(ws + WS_YRW) + (size_t)(u & 255) * 4096 : (bf16_t*)(ws + WS_RC + (size_t)u * RC_UNIT) + pr_ * 4096;
#pragma unroll
            for (int jb = 0; jb < 2; ++jb) { f32x16 o;
                if (pr_ == 0) o = mm32<4>(BhT, KT, ib, jb, lane, zero16());
                else if (pr_ == 1) { const f32x16 x = mm32<4>(VcT, KhT, ib, jb, lane, zero16()), y = mm32<4>(P1, BhT, ib, jb, lane, zero16()); o = x - y; }
                else if (pr_ == 2) { const f32x16 y = mm32<4>(AbrT, KT, ib, jb, lane, zero16()); const LAS bf16_t* rt = Rt + i0 * RP + jb * 32 + jq;
#pragma unroll
                    for (int g = 0; g < 4; ++g) { const f32x4 x = ld_l4(rt + 8 * g);
#pragma unroll
                        for (int r = 0; r < 4; ++r) o[4 * g + r] = x[r] - y[4 * g + r]; } }
                else { const f32x16 x = mm32<4>(VcT, AkrT, ib, jb, lane, zero16()), y = mm32<4>(P1, AbrT, ib, jb, lane, zero16()); o = x - y; }
                st32_glb(og, ib, jb, lane, o); }
        }
        }
        PRE_MARK(4);
    }
    __syncthreads();
}

struct ScanOps { u32x4 fa0, fa1; u32x2 ad0, ad1; f32x4 om; };
__device__ __forceinline__ ScanOps scan_load(const unsigned char* ws, size_t u, int sk, int vh, int l15, int l4) {
    ScanOps o; const bf16_t* base = (const bf16_t*)(ws + WS_RC + u * RC_UNIT);
    o.fa0 = *(const u32x4*)(base + (sk * 16 + l15) * 64 + 8 * l4); o.fa1 = *(const u32x4*)(base + (sk * 16 + l15) * 64 + 32 + 8 * l4);
    o.ad0 = *(const u32x2*)(base + 4096 + ((2 * vh) * 16 + l15) * 64 + sk * 16 + 4 * l4); o.ad1 = *(const u32x2*)(base + 4096 + ((2 * vh + 1) * 16 + l15) * 64 + sk * 16 + 4 * l4);
    o.om = *(const f32x4*)((const float*)(ws + WS_RC2) + u * 128 + sk * 16 + 4 * l4); return o;
}
template <bool STORE>
__device__ __forceinline__ void rwkv_scan(const Frame& F, int b, int h) {
    unsigned char* ws = F.ws;
    LAS bf16_t* Sb = (LAS bf16_t*)F.lds;
    const int lane = F.lane, w = F.wave, l15 = lane & 15, l4 = lane >> 4, sk = w & 3, vh = w >> 2;
    for (int i = F.tid; i < 2 * RMAT / 2; i += NTHR) ((LAS unsigned*)Sb)[i] = 0u;
    const size_t u0 = (size_t)(b * 8 + h) * 128;
    f32x4 st0 = {0.f, 0.f, 0.f, 0.f}, st1 = {0.f, 0.f, 0.f, 0.f};
    ScanOps r0 = scan_load(ws, u0 + 0, sk, vh, l15, l4), r1 = scan_load(ws, u0 + 1, sk, vh, l15, l4), r2 = scan_load(ws, u0 + 2, sk, vh, l15, l4), r3 = scan_load(ws, u0 + 3, sk, vh, l15, l4);
    __syncthreads();
#define SCAN_STEP(R, cc) do { const int c_ = (cc); \
        const LAS bf16_t* Sc = Sb + (c_ & 1) * RMAT; LAS bf16_t* Sn = Sb + ((c_ + 1) & 1) * RMAT; \
        const bf16x8 a0 = __builtin_bit_cast(bf16x8, R.fa0), a1 = __builtin_bit_cast(bf16x8, R.fa1); \
        const LAS bf16_t* sp0 = Sc + ((2 * vh) * 16 + l15) * RP + 8 * l4; const LAS bf16_t* sp1 = sp0 + 16 * RP; \
        const bf16x8 s00 = *(const LAS bf16x8*)sp0, s01 = *(const LAS bf16x8*)(sp0 + 32), s10 = *(const LAS bf16x8*)sp1, s11 = *(const LAS bf16x8*)(sp1 + 32); \
        bf16_t* sg = (bf16_t*)(ws + WS_RC + (u0 + c_ - 1) * RC_UNIT) + 4096;     \
        if (STORE && c_ > 0) *(u32x4*)(sg + (F.tid >> 3) * 64 + (F.tid & 7) * 8) = *(const LAS u32x4*)(Sc + (F.tid >> 3) * RP + (F.tid & 7) * 8);     \
        f32x4 t0 = {0.f, 0.f, 0.f, 0.f}, t1 = {0.f, 0.f, 0.f, 0.f}; \
        t0 = __builtin_amdgcn_mfma_f32_16x16x32_bf16(a0, s00, t0, 0, 0, 0); t1 = __builtin_amdgcn_mfma_f32_16x16x32_bf16(a0, s10, t1, 0, 0, 0); \
        t0 = __builtin_amdgcn_mfma_f32_16x16x32_bf16(a1, s01, t0, 0, 0, 0); t1 = __builtin_amdgcn_mfma_f32_16x16x32_bf16(a1, s11, t1, 0, 0, 0); \
        const f32x4 n0 = {bflo(R.ad0.x), bfhi(R.ad0.x), bflo(R.ad0.y), bfhi(R.ad0.y)}, n1 = {bflo(R.ad1.x), bfhi(R.ad1.x), bflo(R.ad1.y), bfhi(R.ad1.y)}; \
        st0 = st0 * R.om - t0 + n0; st1 = st1 * R.om - t1 + n1; \
        st_bf4(Sn + ((2 * vh) * 16 + l15) * RP + sk * 16 + 4 * l4, st0); st_bf4(Sn + ((2 * vh + 1) * 16 + l15) * RP + sk * 16 + 4 * l4, st1); \
        R = scan_load(ws, u0 + (c_ + 4 < NCHUNK ? c_ + 4 : NCHUNK - 1), sk, vh, l15, l4);     \
        LBAR(); } while (0)
#pragma unroll 1
    for (int c = 0; c < NCHUNK; c += 16) {
#pragma unroll
        for (int j = 0; j < 16; j += 4) { SCAN_STEP(r0, c + j); SCAN_STEP(r1, c + j + 1); SCAN_STEP(r2, c + j + 2); SCAN_STEP(r3, c + j + 3); } }
#undef SCAN_STEP
}

struct OutOps { bf16x8 q0, q1, s00, s01, s10, s11; u32x2 z0, z1; u32x4 cv, cg; float cbc; };
__device__ __forceinline__ OutOps out_load(const unsigned char* ws, int u, int tb, int vh, int l15, int l4, int tt, int c8) {
    OutOps o; const int c = u & 127, h = (u >> 7) & 7, b = u >> 10;
    const bf16_t* base = (const bf16_t*)(ws + WS_RC + (size_t)u * RC_UNIT);
    const bf16_t* Sg = (const bf16_t*)(ws + WS_RC + (size_t)(u > 0 ? u - 1 : 0) * RC_UNIT) + 4096; const bf16_t* QT = base + 8192; const bf16_t* Z = base + 12288;
    o.q0 = *(const bf16x8*)(QT + (tb * 16 + l15) * 64 + 8 * l4); o.q1 = *(const bf16x8*)(QT + (tb * 16 + l15) * 64 + 32 + 8 * l4);
    const bf16_t* sp0 = Sg + ((2 * vh) * 16 + l15) * 64 + 8 * l4; const bf16_t* sp1 = sp0 + 16 * 64;
    o.s00 = *(const bf16x8*)sp0; o.s01 = *(const bf16x8*)(sp0 + 32); o.s10 = *(const bf16x8*)sp1; o.s11 = *(const bf16x8*)(sp1 + 32);
    o.z0 = *(const u32x2*)(Z + ((2 * vh) * 16 + l15) * 64 + tb * 16 + 4 * l4); o.z1 = *(const u32x2*)(Z + ((2 * vh + 1) * 16 + l15) * 64 + tb * 16 + 4 * l4);
    const int m = b * SEQ + c * 64 + tt, chq = h * 64 + c8;
    o.cv = *(const u32x4*)(base + 16384 + tt * 64 + c8); o.cg = *(const u32x4*)((const bf16_t*)(ws + WS_LO) + (size_t)m * LO_W + 1024 + chq);
    o.cbc = ((const float*)(ws + WS_RC2))[(size_t)u * 128 + 64 + tt]; return o;
}
__device__ __forceinline__ void rwkv_out(const Frame& F, const float* lnx_) {
    unsigned char* ws = F.ws;
    LAS float* Yl = (LAS float*)F.lds;
    const int lane = F.lane, w = F.wave, l15 = lane & 15, l4 = lane >> 4, tb = w & 3, vh = w >> 2;
    const int tt = F.tid >> 3, c8 = (F.tid & 7) * 8;
    OutOps cur = out_load(ws, F.blk, tb, vh, l15, l4, tt, c8);
    for (int u = F.blk; u < NB * 8 * NCHUNK; u += F.G) {
        const int c = u & 127, h = (u >> 7) & 7, b = u >> 10;
        const OutOps o = cur;
        { const int un = u + F.G < NB * 8 * NCHUNK ? u + F.G : u; cur = out_load(ws, un, tb, vh, l15, l4, tt, c8); }
        f32x4 y0 = {bflo(o.z0.x), bfhi(o.z0.x), bflo(o.z0.y), bfhi(o.z0.y)}, y1 = {bflo(o.z1.x), bfhi(o.z1.x), bflo(o.z1.y), bfhi(o.z1.y)};
        if (c > 0) {
            y0 = __builtin_amdgcn_mfma_f32_16x16x32_bf16(o.q0, o.s00, y0, 0, 0, 0); y1 = __builtin_amdgcn_mfma_f32_16x16x32_bf16(o.q0, o.s10, y1, 0, 0, 0);
            y0 = __builtin_amdgcn_mfma_f32_16x16x32_bf16(o.q1, o.s01, y0, 0, 0, 0); y1 = __builtin_amdgcn_mfma_f32_16x16x32_bf16(o.q1, o.s11, y1, 0, 0, 0); }
        const int m = b * SEQ + c * 64 + tt, chq = h * 64 + c8;
        const f32x4 ln0 = *(const f32x4*)(lnx_ + chq), ln1 = *(const f32x4*)(lnx_ + chq + 4);
        LBAR();
#pragma unroll
        for (int r = 0; r < 4; ++r) { Yl[(tb * 16 + 4 * l4 + r) * 68 + (2 * vh) * 16 + l15] = y0[r]; Yl[(tb * 16 + 4 * l4 + r) * 68 + (2 * vh + 1) * 16 + l15] = y1[r]; }
        LBAR();
        const f32x4 ya = *(const LAS f32x4*)(Yl + tt * 68 + c8), yb = *(const LAS f32x4*)(Yl + tt * 68 + c8 + 4);
        float yy[8] = {ya[0], ya[1], ya[2], ya[3], yb[0], yb[1], yb[2], yb[3]};
        float s1 = ((yy[0] + yy[1]) + (yy[2] + yy[3])) + ((yy[4] + yy[5]) + (yy[6] + yy[7]));
        s1 = sum8(s1); const float mean = s1 * (1.0f / 64.0f); float s2 = 0.f;
#pragma unroll
        for (int i = 0; i < 8; ++i) { yy[i] -= mean; s2 += yy[i] * yy[i]; }
        s2 = sum8(s2); const float rstd = rsqrtf(s2 * (1.0f / 64.0f) + 64e-5f);
        const unsigned vw[4] = {o.cv.x, o.cv.y, o.cv.z, o.cv.w}, gw[4] = {o.cg.x, o.cg.y, o.cg.z, o.cg.w};
        const float lnx[8] = {ln0[0], ln0[1], ln0[2], ln0[3], ln1[0], ln1[1], ln1[2], ln1[3]};
        unsigned ow[4];
#pragma unroll
        for (int i = 0; i < 4; ++i) { float o2[2];
#pragma unroll
            for (int e = 0; e < 2; ++e) { const int ci = 2 * i + e; const float v = e ? bfhi(vw[i]) : bflo(vw[i]), g = e ? bfhi(gw[i]) : bflo(gw[i]);
                o2[e] = (yy[ci] * rstd * lnx[ci] + o.cbc * v) * g; }
            ow[i] = pk2(o2[0], o2[1]); }
        *(u32x4*)((bf16_t*)(ws + WS_YRW) + (size_t)m * 512 + chq) = (u32x4){ow[0], ow[1], ow[2], ow[3]};
    }
    __syncthreads();
}
__device__ __forceinline__ void rwkv_seq(const Frame& F, const Params& P, int layer, int b, int h) {
    unsigned char* ws = F.ws; const bf16_t* p = (const bf16_t*)(ws + WS_P); const bf16_t* lo = (const bf16_t*)(ws + WS_LO);
    LAS float* Lr = (LAS float*)F.lds; LAS float* Lw = Lr + 4096; LAS float* Lk = Lw + 4096; LAS float* Lv = Lk + 4096; LAS float* Lkk = Lv + 4096; LAS float* Lb = Lkk + 4096; LAS float* Ly = Lb + 4096;
    const int lane = F.lane, ch = h * 64 + lane;
    const float mu_r = P.in[I_MU][(size_t)layer * RWKV_COLS + ch], mu_k = P.in[I_MU][(size_t)layer * RWKV_COLS + 512 + ch], mu_v = P.in[I_MU][(size_t)layer * RWKV_COLS + 1024 + ch];
    const float k_k = P.in[I_KK][layer * 512 + ch], k_a = P.in[I_KA][layer * 512 + ch], r_k = P.in[I_RK][layer * 512 + ch], lnx = P.in[I_LNX][layer * 512 + ch];
    const int vrow = F.tid >> 3, q = F.tid & 7;
    float s[8];
#pragma unroll
    for (int i = 0; i < 8; ++i) s[i] = 0.f;
    for (int c = 0; c < NCHUNK; ++c) {
        const int m0 = b * SEQ + c * 64;
        __syncthreads();
#pragma unroll
        for (int i = 0; i < 8; ++i) { const int t = F.wave + 8 * i, m = m0 + t; const bf16_t* pr = p + (size_t)m * PW + P_RW + ch; const bool hp = (c | t) != 0;
            const float xr = bf2f(pr[0]), xk = bf2f(pr[512]), xv = bf2f(pr[1024]);
            const float pr_ = hp ? bf2f(pr[-PW]) : 0.f, pk_ = hp ? bf2f(pr[512 - PW]) : 0.f, pv_ = hp ? bf2f(pr[1024 - PW]) : 0.f;
            const float r = xr + (pr_ - xr) * mu_r, k = xk + (pk_ - xk) * mu_k, v = xv + (pv_ - xv) * mu_v;
            const float lw = bf2f(lo[(size_t)m * LO_W + ch]), a = bf2f(lo[(size_t)m * LO_W + 512 + ch]);
            float kk = k * k_k; const float ss = wave_sum(kk * kk); kk *= rsqrtf(ss + 1e-12f);
            Lr[t * 64 + lane] = r; Lw[t * 64 + lane] = __expf(lw); Lk[t * 64 + lane] = k * (1.0f + (a - 1.0f) * k_a); Lv[t * 64 + lane] = v; Lkk[t * 64 + lane] = kk; Lb[t * 64 + lane] = kk * a; }
        __syncthreads();
        for (int t = 0; t < 64; ++t) {
            const f32x4 ka = *(const LAS f32x4*)(Lkk + t * 64 + q * 8), kb = *(const LAS f32x4*)(Lkk + t * 64 + q * 8 + 4);
            const f32x4 wa = *(const LAS f32x4*)(Lw + t * 64 + q * 8), wb = *(const LAS f32x4*)(Lw + t * 64 + q * 8 + 4);
            const f32x4 ba = *(const LAS f32x4*)(Lb + t * 64 + q * 8), bb = *(const LAS f32x4*)(Lb + t * 64 + q * 8 + 4);
            const f32x4 k2a = *(const LAS f32x4*)(Lk + t * 64 + q * 8), k2b = *(const LAS f32x4*)(Lk + t * 64 + q * 8 + 4);
            const f32x4 ra = *(const LAS f32x4*)(Lr + t * 64 + q * 8), rb = *(const LAS f32x4*)(Lr + t * 64 + q * 8 + 4);
            const float vv = Lv[t * 64 + vrow];
            float sa = 0.f;
#pragma unroll
            for (int i = 0; i < 4; ++i) { sa += s[i] * ka[i]; sa += s[4 + i] * kb[i]; }
            sa = sum8(sa); sa = -sa;
            float y = 0.f;
#pragma unroll
            for (int i = 0; i < 4; ++i) { s[i] = s[i] * wa[i] + sa * ba[i] + vv * k2a[i]; s[4 + i] = s[4 + i] * wb[i] + sa * bb[i] + vv * k2b[i]; y += s[i] * ra[i]; y += s[4 + i] * rb[i]; }
            y = sum8(y);
            if (q == 0) Ly[t * 64 + vrow] = y;
        }
        __syncthreads();
#pragma unroll
        for (int i = 0; i < 8; ++i) { const int t = F.wave + 8 * i, m = m0 + t;
            const float y = Ly[t * 64 + lane]; const float mean = wave_sum(y) * (1.0f / 64.0f); const float d = y - mean; const float var = wave_sum(d * d) * (1.0f / 64.0f);
            const float bon = wave_sum(Lr[t * 64 + lane] * Lk[t * 64 + lane] * r_k);
            const float g = bf2f(lo[(size_t)m * LO_W + 1024 + ch]);
            const float o = (d * rsqrtf(var + 64e-5f) * lnx + bon * Lv[t * 64 + lane]) * g;
            ((bf16_t*)(ws + WS_YRW))[(size_t)m * 512 + ch] = (bf16_t)f2bf(o); }
    }
    __syncthreads();
}

constexpr int LDS_TAB = LDSCTL_OFF + 64;
__device__ __forceinline__ void moe_table(const Frame& F, const unsigned* ectl) {
    LAS int* tab = (LAS int*)(F.lds + LDS_TAB);
    if (F.tid == 0) { int st = 0, nt = 0;
        for (int e = 0; e < 8; ++e) { const int c = (int)__hip_atomic_load(&ectl[e], __ATOMIC_RELAXED, __HIP_MEMORY_SCOPE_AGENT); tab[1 + e] = st; const int t = (c + 255) >> 8; for (int i = 0; i < t; ++i) tab[16 + nt + i] = e; nt += t; st += t * 256; }
        tab[0] = nt; }
    __syncthreads();
}
__device__ __forceinline__ void phase_moe_scatter(const Frame& F, const unsigned* ectl) {
    unsigned char* ws = F.ws; const LAS int* tab = (const LAS int*)(F.lds + LDS_TAB);
    const int* tok_e = (const int*)(ws + WS_TOK); int* tok_slot = (int*)tok_e + 2 * MTOK; const float* tok_w = (const float*)(tok_slot + 2 * MTOK);
    int* row_tok = (int*)(tok_w + 2 * MTOK); float* row_w = (float*)(row_tok + MAXROWS);
    for (int i = F.blk * NTHR + F.tid; i < 2 * MTOK; i += F.G * NTHR) { const int e = tok_e[i]; const int dest = tab[1 + e] + tok_slot[i]; row_tok[dest] = i >> 1; row_w[dest] = tok_w[i]; tok_slot[i] = dest; }
    const int gt = F.blk * NTHR + F.tid;
    if (gt < 2048) { const int e = gt >> 8; const int c = (int)__hip_atomic_load(&ectl[e], __ATOMIC_RELAXED, __HIP_MEMORY_SCOPE_AGENT); const int r = c + (gt & 255);
        if (r < ((c + 255) & ~255)) { row_tok[tab[1 + e] + r] = -1; row_w[tab[1 + e] + r] = 0.f; } }
}
constexpr int LDS_GTAB = RING_BYTES;
__device__ __forceinline__ void moe_gather_table(const Frame& F, int ncol) {
    const LAS int* tab = (const LAS int*)(F.lds + LDS_TAB); LAS unsigned* gt = (LAS unsigned*)(F.lds + LDS_GTAB);
    const int* row_tok = (const int*)(F.ws + WS_TOK) + 6 * MTOK; const int total = tab[0] * ncol;
    for (int i = F.tid; i < 9 * 256; i += NTHR) { const int u = i >> 8, r = i & 255; const int L = u * F.G + F.blk; unsigned off = 0u;
        if (L < total) { const int tk = row_tok[(L / ncol) * 256 + r]; off = tk > 0 ? (unsigned)tk * (unsigned)(DM * 2) : 0u; }
        gt[i] = off; }
    __syncthreads();
}

extern __shared__ __attribute__((aligned(16))) unsigned char lds_raw[];
template <class T> __device__ __forceinline__ T* uni(T* p) { const unsigned long long v = (unsigned long long)p; const unsigned lo = __builtin_amdgcn_readfirstlane((unsigned)v), hi = __builtin_amdgcn_readfirstlane((unsigned)(v >> 32)); return (T*)(((unsigned long long)hi << 32) | lo); }
__device__ __forceinline__ int uni(int v) { return __builtin_amdgcn_readfirstlane(v); }
__device__ __forceinline__ Frame mkframe(unsigned char* ws, int wv) {
    Frame F; F.lds = (LAS unsigned char*)lds_raw; int tid = wv * 64 + lane_id_fresh(); F.tid = tid; F.lane = F.tid & 63; F.wave = __builtin_amdgcn_readfirstlane(F.tid >> 6);
    int blk = blockIdx.x; asm volatile("" : "+s"(blk)); F.blk = blk; F.G = gridDim.x; F.vcu = (F.blk & 7) * (F.G >> 3) + (F.blk >> 3); F.gw = F.blk * NWAVES + F.wave; F.ngw = F.G * NWAVES; F.ws = ws; return F;
}
#define PHASE __device__ __forceinline__ void
template <int PART>
PHASE f_moe_convert(int wv, unsigned char* ws_, const float* mg, const float* mu, const float* md) {
    unsigned char* ws = uni(ws_); const Frame F = mkframe(ws, wv); Params P; P.in[I_MG] = uni(mg); P.in[I_MU2] = uni(mu); P.in[I_MD] = uni(md);
    if (PART == 0) { __syncthreads(); phase_moe_convert<0>(F, P, F.gw, F.ngw); }
    else if (F.blk >= 32) { __syncthreads(); phase_moe_convert<1>(F, P, (F.blk - 32) * NWAVES + F.wave, (F.G - 32) * NWAVES); }
}
PHASE f_rms_moe(int wv, unsigned char* ws_, const bf16_t* src, const float* gain, const float* router) {
    unsigned char* ws = uni(ws_); const Frame F = mkframe(ws, wv); int* tok_e = (int*)(ws + WS_TOK); int* tok_slot = tok_e + 2 * MTOK; float* tok_w = (float*)(tok_slot + 2 * MTOK);
    phase_rms<true>(F, uni(src), uni(gain), (bf16_t*)(ws + WS_HN), uni(router), (unsigned*)(ws + WS_CTL) + CW_ECNT, tok_e, tok_slot, tok_w);
}
PHASE f_prep(int wv, unsigned char* ws_, const float* mu, const float* qnorm, const float* kvnorm, int layer_) {
    unsigned char* ws = uni(ws_); const Frame F = mkframe(ws, wv); Params P; P.in[I_MU] = uni(mu); P.in[I_QNORM] = uni(qnorm); P.in[I_KVNORM] = uni(kvnorm); (void)layer_; phase_prep(F, P, 0);
}
PHASE f_ret_scan(int wv, unsigned char* ws_) { unsigned char* ws = uni(ws_); const Frame F = mkframe(ws, wv); ret_scan(F); }
PHASE f_ret_out(int wv, unsigned char* ws_) { unsigned char* ws = uni(ws_); const Frame F = mkframe(ws, wv); ret_out(F); }
PHASE f_rwkv_seq(int wv, unsigned char* ws_, const float* mu, const float* kk, const float* ka, const float* rk, const float* lnx, int layer_) {
    unsigned char* ws = uni(ws_); const Frame F = mkframe(ws, wv); Params P; P.in[I_MU] = uni(mu); P.in[I_KK] = uni(kk); P.in[I_KA] = uni(ka); P.in[I_RK] = uni(rk); P.in[I_LNX] = uni(lnx);
    (void)layer_; rwkv_seq(F, P, 0, F.blk >> 3, F.blk & 7);
}
PHASE f_rwkv_pre(int wv, unsigned char* ws_, const float* mu, const float* kk, const float* ka, const float* rk) { unsigned char* ws = uni(ws_); const Frame F = mkframe(ws, wv); rwkv_chunk_pre<0>(F, uni(mu), uni(kk), uni(ka), uni(rk));
#ifdef PRE_DIAG
    rwkv_chunk_pre<PRE_DIAG>(F, uni(mu), uni(kk), uni(ka), uni(rk));
#endif
}
PHASE f_rwkv_scan(int wv, unsigned char* ws_) { unsigned char* ws = uni(ws_); const Frame F = mkframe(ws, wv); rwkv_scan<true>(F, F.blk >> 3, F.blk & 7);
#ifdef SCAN_TWICE
    __syncthreads(); rwkv_scan<false>(F, F.blk >> 3, F.blk & 7);
#endif
}
PHASE f_rwkv_out(int wv, unsigned char* ws_, const float* lnx) { unsigned char* ws = uni(ws_); const Frame F = mkframe(ws, wv); rwkv_out(F, uni(lnx)); }
PHASE f_attn(int wv, unsigned char* ws_, int layer_) {
    unsigned char* ws = uni(ws_); const int layer = uni(layer_); const Frame F = mkframe(ws, wv);
    unsigned* qh = (unsigned*)(ws + WS_CTL) + CW_ATTQ + layer * 512; volatile LAS unsigned* slot = (volatile LAS unsigned*)(F.lds + LDSCTL_OFF + 32);
    const int my = (int)(xb_xcc_id() & 7u);
    for (int k = 0; k < 8; ++k) { const int q = (my + k) & 7;
        for (;;) {
            if (F.tid == 0) *slot = __hip_atomic_fetch_add(qh + q * 64, 1u, __ATOMIC_RELAXED, __HIP_MEMORY_SCOPE_AGENT);
            __syncthreads();
            const int idx = (int)*slot;
            __syncthreads();
            if (idx >= 64) break;
            const int bh = 2 * q + (idx & 1), qt = 31 - (idx >> 1);
            attn_unit(F, bh >> 3, bh & 7, qt);
        } }
}
PHASE f_moe_scatter(int wv, unsigned char* ws_) { unsigned char* ws = uni(ws_); const Frame F = mkframe(ws, wv); moe_table(F, (unsigned*)(ws + WS_CTL) + CW_ECNT); phase_moe_scatter(F, (unsigned*)(ws + WS_CTL) + CW_ECNT); }
PHASE f_final(int wv, unsigned char* ws_, float* h, const float* gain) { unsigned char* ws = uni(ws_); const Frame F = mkframe(ws, wv); phase_final(F, uni(h), uni(gain), (const bf16_t*)(ws + WS_OUT2), (const int*)(ws + WS_TOK) + 2 * MTOK); }
constexpr int DEFER_BLK0 = 128;
PHASE f_defer_a(int wv, unsigned char* ws_, const float* wqb, const float* wbr, const float* wo, const float* fg, const float* fu, const float* fd, const float* w2, const float* a2, const float* g2, const float* wkvb, const float* pos) {
    unsigned char* ws = uni(ws_); const Frame F = mkframe(ws, wv); Params P; P.in[I_WIN] = nullptr; P.in[I_WQB] = uni(wqb); P.in[I_WBR] = uni(wbr); P.in[I_WO] = uni(wo); P.in[I_FG] = uni(fg); P.in[I_FU] = uni(fu); P.in[I_FD] = uni(fd);
    P.in[I_W2] = uni(w2); P.in[I_A2] = uni(a2); P.in[I_G2] = uni(g2); P.in[I_WKVB] = uni(wkvb); P.in[I_POS] = uni(pos);
    __syncthreads();
    constexpr int NW = (256 - DEFER_BLK0) * NWAVES, NA = pro::NIT - 2 * pro::I_IN;
    pro_tiles<NA / NW>(F, P, 2 * pro::I_IN, (F.blk - DEFER_BLK0) * NWAVES + F.wave, NW, NA % NW);
    pro_small(F, P, (F.blk - DEFER_BLK0) * NTHR + F.tid, (256 - DEFER_BLK0) * NTHR, F.blk - DEFER_BLK0, 256 - DEFER_BLK0);
}
PHASE f_defer_b(int wv, unsigned char* ws_, const float* win) {
    unsigned char* ws = uni(ws_); const Frame F = mkframe(ws, wv); Params P; P.in[I_WIN] = uni(win); P.in[I_WQB] = nullptr; P.in[I_WBR] = nullptr; P.in[I_WO] = nullptr; P.in[I_FG] = nullptr; P.in[I_FU] = nullptr; P.in[I_FD] = nullptr;
    __syncthreads();
    constexpr int NW = (256 - DEFER_BLK0) * NWAVES;
    pro_tiles<pro::I_IN / NW>(F, P, pro::I_IN, (F.blk - DEFER_BLK0) * NWAVES + F.wave, NW, pro::I_IN % NW);
}
PHASE g_inproj(int wv, unsigned char* ws_, int layer_) {
    unsigned char* ws = uni(ws_); const int layer = uni(layer_); const Frame F = mkframe(ws, wv);
    SchedGrid S; S.init(64, 18, F.G, F.blk, ws + WS_HN, (size_t)256 * DM * 2, (bf16_t*)(ws + WS_WIN) + (size_t)layer * WIN_ROWS * DM, (size_t)256 * DM * 2);
    EpiStore E; E.O = (bf16_t*)(ws + WS_P); E.ld = PW; E.SS = (const float*)(ws + WS_SS); E.rl = (LAS float*)(F.lds + RING_BYTES); E.tid = F.tid; pg8::gemm_phase(F.lds, F.tid, DM, DM, DM, S, E);
}
PHASE g_lora(int wv, unsigned char* ws_, const float* w0, const float* a0, int layer_) {
    unsigned char* ws = uni(ws_); const int layer = uni(layer_); const Frame F = mkframe(ws, wv);
    SchedGrid S; S.init(64, 6, F.G, F.blk, ws + WS_LIN, (size_t)256 * LORA_K * 2, (bf16_t*)(ws + WS_LORA) + (size_t)layer * 1536 * LORA_K, (size_t)256 * LORA_K * 2);
    EpiLora E; E.O = (bf16_t*)(ws + WS_LO); E.w0 = uni(w0); E.a0 = uni(a0); pg8::gemm_phase(F.lds, F.tid, LORA_K, LORA_K, LORA_K, S, E);
}
PHASE g_small(int wv, unsigned char* ws_, int layer_) {
    unsigned char* ws = uni(ws_); const Frame F = mkframe(ws, wv); SchedSmall S; S.G = F.G; S.c = F.blk; S.layer = uni(layer_); S.ws = (const char*)ws; EpiSmall E; E.ws = ws; pg8::gemm_phase(F.lds, F.tid, 256, 256, 256, S, E);
}
PHASE g_gate(int wv, unsigned char* ws_, int layer_) {
    unsigned char* ws = uni(ws_); const int layer = uni(layer_); const Frame F = mkframe(ws, wv);
    SchedOwn3 S; S.c = F.blk; S.G = F.G; S.A = (const char*)(ws + WS_HN); S.a_n = 0; S.astep = (size_t)256 * DM * 2; S.B = (const char*)((bf16_t*)(ws + WS_WIN) + ((size_t)layer * WIN_ROWS + PW) * DM); S.bstep = (size_t)256 * DM * 2; S.b_n = (size_t)1024 * DM * 2;
    EpiGate E; E.O = (bf16_t*)(ws + WS_G); E.SS = (const float*)(ws + WS_SS); E.rl = (LAS float*)(F.lds + RING_BYTES); E.tid = F.tid; pg8::gemm_phase(F.lds, F.tid, DM, DM, DM, S, E);
}
PHASE g_merge(int wv, unsigned char* ws_, int layer_) {
    unsigned char* ws = uni(ws_); const int layer = uni(layer_); const Frame F = mkframe(ws, wv);
    SchedOwn3 S; S.c = F.blk; S.G = F.G; S.A = (const char*)(ws + WS_YRET); S.a_n = (size_t)16 * MiB; S.astep = (size_t)256 * 512 * 2;
    S.B = (const char*)((bf16_t*)(ws + WS_BR) + (size_t)layer * 3 * 1024 * 512); S.bstep = (size_t)256 * 512 * 2; S.b_n = (size_t)1024 * 512 * 2;
    EpiMerge E; E.Gt = (const bf16_t*)(ws + WS_G); E.Mg = (bf16_t*)(ws + WS_MRG); pg8::gemm_phase(F.lds, F.tid, 512, 512, 512, S, E);
}
template <bool EMIT, bool IN_F32>
PHASE g_wo(int wv, unsigned char* ws_, const void* hin, bf16_t* hout, const float* gain, int layer_) {
    unsigned char* ws = uni(ws_); const int layer = uni(layer_); const Frame F = mkframe(ws, wv);
    SchedGrid S; S.init(64, 4, F.G, F.blk, ws + WS_MRG, (size_t)256 * DM * 2, (bf16_t*)(ws + WS_WO) + (size_t)layer * DM * DM, (size_t)256 * DM * 2);
    EpiResid<EMIT, IN_F32> E; E.In = uni(hin); E.Out = uni(hout); E.gain = uni(gain); E.Hg = (bf16_t*)(ws + WS_HN); E.SS = (float*)(ws + WS_SS); pg8::gemm_phase(F.lds, F.tid, DM, DM, DM, S, E);
}
PHASE g_ffn_gu(int wv, unsigned char* ws_) {
    unsigned char* ws = uni(ws_); const Frame F = mkframe(ws, wv);
    SchedGrid S; S.init(64, 22, F.G, F.blk, ws + WS_HN, (size_t)256 * DM * 2, ws + WS_FGU, (size_t)256 * DM * 2);
    EpiSwiglu E; E.O = (bf16_t*)(ws + WS_ACT); E.ldc = DFF; E.pn_off = 0; E.SS = (const float*)(ws + WS_SS); E.rl = (LAS float*)(F.lds + RING_BYTES); E.tid = F.tid; pg8::gemm_phase(F.lds, F.tid, DM, DM, DM, S, E);
}
PHASE g_ffn_down(int wv, unsigned char* ws_, bf16_t* h, const float* gain) {
    unsigned char* ws = uni(ws_); const Frame F = mkframe(ws, wv);
    SchedGrid S; S.init(64, 4, F.G, F.blk, ws + WS_ACT, (size_t)256 * DFF * 2, ws + WS_FD, (size_t)256 * DFF * 2);
    EpiResid<true, false> E; E.Out = uni(h); E.In = E.Out; E.gain = uni(gain); E.Hg = (bf16_t*)(ws + WS_HN); E.SS = (float*)(ws + WS_SS); pg8::gemm_phase(F.lds, F.tid, DFF, DFF, DFF, S, E);
}
PHASE g_moe_gu(int wv, unsigned char* ws_, int hh_) {
    unsigned char* ws = uni(ws_); const int hh = uni(hh_); const Frame F = mkframe(ws, wv); const LAS int* tab = (const LAS int*)(F.lds + LDS_TAB);
    moe_gather_table(F, 14);
    SchedMoe S; S.G = F.G; S.c = F.blk; S.ncol = 14; S.ntile = tab[0]; S.tab = tab + 16; S.A = (const char*)(ws + WS_HN); S.astep = 0;
    S.B = (const char*)(ws + WS_MGU) + (size_t)hh * 14 * 256 * DM * 2; S.bstep = (size_t)256 * DM * 2; S.estep = (size_t)2 * DFFE * DM * 2;
    EpiSwiglu E; E.O = (bf16_t*)(ws + WS_MACT); E.ldc = DFFH; E.pn_off = 0; E.SS = nullptr; E.rl = nullptr; E.tid = 0; pg8::gemm_phase<EpiSwiglu, SchedMoe, true>(F.lds, F.tid, DM, DM, DM, S, E, (const LAS unsigned*)(F.lds + LDS_GTAB));
}
template <bool ACCUM>
PHASE g_moe_down(int wv, unsigned char* ws_, int hh_) {
    unsigned char* ws = uni(ws_); const int hh = uni(hh_); const Frame F = mkframe(ws, wv); const LAS int* tab = (const LAS int*)(F.lds + LDS_TAB);
    const float* row_w = (const float*)((const int*)(ws + WS_TOK) + 6 * MTOK + MAXROWS);
    SchedMoe S; S.G = F.G; S.c = F.blk; S.ncol = 4; S.ntile = tab[0]; S.tab = tab + 16; S.A = (const char*)(ws + WS_MACT); S.astep = (size_t)256 * DFFH * 2;
    S.B = (const char*)(ws + WS_MD) + (size_t)hh * DFFH * 2; S.bstep = (size_t)256 * DFFE * 2; S.estep = (size_t)DM * DFFE * 2;
    EpiMoeOut<ACCUM> E; E.row_w = row_w; E.O = (bf16_t*)(ws + WS_OUT2); pg8::gemm_phase(F.lds, F.tid, DFFH, DFFH, DFFE, S, E);
}

typedef const __attribute__((address_space(4))) Params* KPtr;
__device__ __forceinline__ KPtr kargs() { KPtr k = (KPtr)__builtin_amdgcn_kernarg_segment_ptr(); asm volatile("" : "+s"(k)); return k; }
#define KIN(i) (kargs()->in[i])
#define KWS() (kargs()->ws)
struct TpState { unsigned long long tp0, tp1; int tpk; };
#define tp0 tps.tp0
#define tp1 tps.tp1
#define tpk tps.tpk
#define GRID_BAR() do { XcdBarrier b_ = bar; b_.bar = (unsigned*)(KWS() + WS_CTL) + CW_BAR; b_.x = xb_xcc_id(); xcd_barrier(b_); } while (0)
#ifdef TPH
#define TP(k) do { volatile LAS unsigned long long* tpl_ = (volatile LAS unsigned long long*)(lds_raw + LDSCTL_OFF + 48); if ((k) == TPH) tpl_[0] = __builtin_amdgcn_s_memrealtime(); if ((k) == TPH + TPN) tpl_[1] = __builtin_amdgcn_s_memrealtime(); } while (0)
#define TPM() do { ++tpk; TP(tpk); } while (0)
#else
#define TP(k) do { } while (0)
#define TPM() do { } while (0)
#endif
template <int layer>
__device__ __forceinline__ void layer_body(const int wv, const XcdBarrier& bar, TpState& tps) {
        g_inproj(wv, KWS(), layer);
        if constexpr (layer == 0) { if ((int)blockIdx.x >= DEFER_BLK0) f_defer_a(wv, KWS(), KIN(I_WQB), KIN(I_WBR), KIN(I_WO), KIN(I_FG), KIN(I_FU), KIN(I_FD), KIN(I_W2), KIN(I_A2), KIN(I_G2), KIN(I_WKVB), KIN(I_POS)); }
        GRID_BAR();
        TPM();
        f_prep(wv, KWS(), KIN(I_MU) + (size_t)layer * RWKV_COLS, KIN(I_QNORM) + layer * 256, KIN(I_KVNORM) + layer * 128, layer);
        GRID_BAR();
        TPM();
        f_ret_scan(wv, KWS());
        g_lora(wv, KWS(), KIN(I_W0) + layer * 512, KIN(I_A0) + layer * 512, layer);
        g_small(wv, KWS(), layer);
        GRID_BAR();
        TPM();
        f_ret_out(wv, KWS());
#ifdef SPLIT5
        GRID_BAR();
        TPM();
#endif
#ifndef RWKV_SEQ
        f_rwkv_pre(wv, KWS(), KIN(I_MU) + (size_t)layer * RWKV_COLS, KIN(I_KK) + layer * 512, KIN(I_KA) + layer * 512, KIN(I_RK) + layer * 512);
        GRID_BAR();
        TPM();
        if ((int)blockIdx.x < 16) f_rwkv_scan(wv, KWS());
#ifdef SPLIT6
        GRID_BAR();
        TPM();
#endif
#else
        GRID_BAR();
        TPM();
        if (blockIdx.x < 16) f_rwkv_seq(wv, KWS(), KIN(I_MU) + (size_t)layer * RWKV_COLS, KIN(I_KK) + layer * 512, KIN(I_KA) + layer * 512, KIN(I_RK) + layer * 512, KIN(I_LNX) + layer * 512, layer);
#endif
        f_attn(wv, KWS(), layer);
        GRID_BAR();
        TPM();
#ifndef RWKV_SEQ
        f_rwkv_out(wv, KWS(), KIN(I_LNX) + layer * 512);
#endif
        g_gate(wv, KWS(), layer);
#ifndef RWKV_SEQ
        GRID_BAR();
        TPM();
#endif
        g_merge(wv, KWS(), layer);
        GRID_BAR();
        TPM();
        g_wo<layer == 0, layer == 0>(wv, KWS(), layer == 0 ? (const void*)KIN(I_X) : (const void*)kargs()->out, (bf16_t*)kargs()->out, KIN(I_FNORM) + layer * DM, layer);
        GRID_BAR();
        TPM();
        if constexpr (layer == 0) {
            g_ffn_gu(wv, KWS());
            if ((int)blockIdx.x >= DEFER_BLK0) f_defer_b(wv, KWS(), KIN(I_WIN));
            GRID_BAR();
            TPM();
            g_ffn_down(wv, KWS(), (bf16_t*)kargs()->out, KIN(I_ANORM) + DM);
            GRID_BAR();
            TPM();
        } else {
            f_rms_moe(wv, KWS(), (const bf16_t*)kargs()->out, KIN(I_FNORM) + layer * DM, KIN(I_ROUTER));
            f_moe_convert<0>(wv, KWS(), KIN(I_MG), KIN(I_MU2), KIN(I_MD));
            GRID_BAR();
            TPM();
            f_moe_scatter(wv, KWS());
            GRID_BAR();
            TPM();
            g_moe_gu(wv, KWS(), 0);
            GRID_BAR();
            TPM();
            g_moe_down<false>(wv, KWS(), 0);
            f_moe_convert<1>(wv, KWS(), KIN(I_MG), KIN(I_MU2), KIN(I_MD));
            GRID_BAR();
            TPM();
            g_moe_gu(wv, KWS(), 1);
            GRID_BAR();
            TPM();
            g_moe_down<true>(wv, KWS(), 1);
            GRID_BAR();
            TPM();
        }
    }
__global__ void __launch_bounds__(NTHR, 2) mega(Params P_unused) {
    LAS unsigned char* lds = (LAS unsigned char*)lds_raw;
    const int wv = __builtin_amdgcn_readfirstlane((int)threadIdx.x >> 6);
    for (int u = threadIdx.x; u < (LDS_BYTES - LDSCTL_OFF) / 4; u += NTHR) ((LAS unsigned*)(lds + LDSCTL_OFF))[u] = 0u;
    __syncthreads();
    const XcdBarrier bar = xcd_barrier_post((unsigned*)(KWS() + WS_CTL) + CW_BAR, (volatile LAS unsigned*)(lds + LDSCTL_OFF), wv);
    TpState tps = {0ull, 0ull, 0};
    TP(0);
    {
        KPtr k = kargs(); unsigned char* ws = k->ws; const Frame F = mkframe(ws, wv);
        Params P; P.in[I_WIN] = k->in[I_WIN]; P.in[I_WQB] = k->in[I_WQB]; P.in[I_WBR] = k->in[I_WBR]; P.in[I_WO] = k->in[I_WO]; P.in[I_FG] = k->in[I_FG]; P.in[I_FU] = k->in[I_FU]; P.in[I_FD] = k->in[I_FD];
        P.in[I_W2] = k->in[I_W2]; P.in[I_A2] = k->in[I_A2]; P.in[I_G2] = k->in[I_G2]; P.in[I_WKVB] = k->in[I_WKVB]; P.in[I_POS] = k->in[I_POS]; P.in[I_X] = k->in[I_X]; P.in[I_ANORM] = k->in[I_ANORM];
        phase_prologue(F, P);
#ifdef PRO_SPIN
        { const unsigned long long t0_ = __builtin_amdgcn_s_memrealtime(); while (__builtin_amdgcn_s_memrealtime() - t0_ < (unsigned long long)PRO_SPIN) __builtin_amdgcn_s_sleep(8); }
#endif
    }
    GRID_BAR();
    TPM();
    layer_body<0>(wv, bar, tps);
    layer_body<1>(wv, bar, tps);
    f_final(wv, KWS(), kargs()->out, KIN(I_FINAL));
#ifdef PRE_T
    __syncthreads();
    { volatile LAS unsigned long long* tq_ = (volatile LAS unsigned long long*)(lds_raw + LDSCTL_OFF + 48); const unsigned long long te = __builtin_amdgcn_s_memrealtime(), span = tq_[1] * 8ull; while (__builtin_amdgcn_s_memrealtime() - te < span) __builtin_amdgcn_s_sleep(8); }
#endif
#ifdef TPH
    __syncthreads(); TPM();
    { volatile LAS unsigned long long* tpl_ = (volatile LAS unsigned long long*)(lds_raw + LDSCTL_OFF + 48); const unsigned long long te = __builtin_amdgcn_s_memrealtime(), span = (tpl_[1] - tpl_[0]) * (unsigned long long)TAMP; while (__builtin_amdgcn_s_memrealtime() - te < span) __builtin_amdgcn_s_sleep(8); }
#endif
}

extern "C" void kernel_launch(void* const* d_in, const int* in_sizes, int n_in, void* d_out, int out_size, void* d_ws, size_t ws_size, hipStream_t stream) {
    static int ready = 0;
    if (!ready) {
        if (n_in != 29 || out_size != MTOK * DM || ws_size < WS_END) { fprintf(stderr, "kernel_launch: unexpected shapes (n_in %d out %d ws %zu need %zu)\n", n_in, out_size, ws_size, (size_t)WS_END); ready = -1; return; }
        if (hipFuncSetAttribute((const void*)mega, hipFuncAttributeMaxDynamicSharedMemorySize, LDS_BYTES) != hipSuccess) { fprintf(stderr, "kernel_launch: hipFuncSetAttribute failed\n"); ready = -1; return; }
        int dev = 0, cus = 0, per_cu = 0; (void)hipGetDevice(&dev); (void)hipDeviceGetAttribute(&cus, hipDeviceAttributeMultiprocessorCount, dev);
        (void)hipOccupancyMaxActiveBlocksPerMultiprocessor(&per_cu, (const void*)mega, NTHR, LDS_BYTES);
        if (cus < 256 || per_cu < 1) { fprintf(stderr, "kernel_launch: needs 256 CUs with one resident workgroup each (cus %d, per_cu %d)\n", cus, per_cu); ready = -1; return; }
        ready = 1;
    }
    if (ready < 0) return;
    (void)hipMemsetAsync((char*)d_ws + WS_CTL, 0, CTL_BYTES, stream);
    Params p{}; for (int i = 0; i < 29; ++i) p.in[i] = (const float*)d_in[i]; p.out = (float*)d_out; p.ws = (unsigned char*)d_ws;
    hipLaunchKernelGGL(mega, dim3(256), dim3(NTHR), LDS_BYTES, stream, p);
}
```

```cpp
#include <hip/hip_runtime.h>
#include <cstdio>
#include <cstdint>

#define LAS __attribute__((address_space(3)))
#define GAS __attribute__((address_space(1)))
typedef unsigned short bf16_t;
typedef short bf16x8 __attribute__((ext_vector_type(8)));
typedef short bf16x4 __attribute__((ext_vector_type(4)));
typedef float f32x4 __attribute__((ext_vector_type(4)));
typedef float f32x2 __attribute__((ext_vector_type(2)));
typedef float f32x16 __attribute__((ext_vector_type(16)));
typedef unsigned u32x4 __attribute__((ext_vector_type(4)));
typedef unsigned u32x2 __attribute__((ext_vector_type(2)));

constexpr int NB = 2, SEQ = 8192, DM = 1024, MTOK = NB * SEQ, NLAYER = 2, CH = 64, NCHUNK = SEQ / CH;
constexpr int IN_COLS = 7360, PW = 4608;
constexpr int P_RQ = 0, P_RK = 512, P_RV = 1024, P_RG = 1536, P_RW = 2048, P_QA = 4096, P_KVA = 4352;
constexpr int WIN_ROWS = 7680;
constexpr int RWKV_COLS = 1824, LORA_K = 384, LO_W = 1536;
constexpr int DFF = 2816, DFFE = 3584, NEXP = 8, DFFH = DFFE / 2;
constexpr int MAXROWS = 34816;
constexpr float NORM_EPS = 1e-6f;

constexpr size_t MiB = 1u << 20;
constexpr size_t WS_CTL = 0, CTL_BYTES = 1 * MiB;
constexpr size_t WS_WIN = 1 * MiB;
constexpr size_t WS_LORA = 31 * MiB;
constexpr size_t WS_QB = 34 * MiB;
constexpr size_t WS_KB = 35 * MiB;
constexpr size_t WS_VB = 35 * MiB + 512 * 1024;
constexpr size_t WS_BR = 36 * MiB;
constexpr size_t WS_WO = 42 * MiB;
constexpr size_t WS_FGU = 46 * MiB;
constexpr size_t WS_FD = 57 * MiB;
constexpr size_t WS_COSR = 63 * MiB, WS_SINR = 67 * MiB, WS_COSM = 71 * MiB, WS_SINM = 72 * MiB;
constexpr size_t WS_HN = 73 * MiB;
constexpr size_t WS_TOK = 105 * MiB;
constexpr size_t WS_T = 106 * MiB;
constexpr size_t WS_P = WS_T;
constexpr size_t WS_G = WS_T;
constexpr size_t WS_MRG = WS_T + 96 * MiB;
constexpr size_t WS_LO = WS_T + 144 * MiB;
constexpr size_t WS_Q = WS_T + 192 * MiB;
constexpr size_t WS_KN = WS_T + 216 * MiB;
constexpr size_t WS_VT = WS_T + 232 * MiB;
constexpr size_t WS_KPE = WS_T + 248 * MiB;
constexpr size_t WS_LIN = WS_T + 249 * MiB;
constexpr size_t WS_QN = WS_T + 261 * MiB;
constexpr size_t WS_CN = WS_T + 269 * MiB;
constexpr size_t WS_YRET = WS_T + 261 * MiB;
constexpr size_t WS_RS = WS_T + 277 * MiB;
constexpr size_t WS_YRW = WS_T + 277 * MiB;
constexpr size_t WS_YMLA = WS_T + 293 * MiB;
constexpr size_t WS_RC = WS_T + 309 * MiB;
constexpr size_t WS_ACT = WS_T;
constexpr size_t WS_MGU = WS_T;
constexpr size_t WS_MD = WS_T + 112 * MiB;
constexpr size_t WS_MACT = WS_T + 168 * MiB;
constexpr size_t WS_OUT2 = WS_T + 287 * MiB;
constexpr size_t WS_SS = WS_T + 390 * MiB;
constexpr size_t WS_END = WS_T + 391 * MiB;
static_assert(WS_MACT + (size_t)MAXROWS * DFFH * 2 <= WS_OUT2 && WS_OUT2 + (size_t)MAXROWS * DM * 2 <= WS_END, "ws map");
constexpr int CW_BAR = 4096;
constexpr int CW_ECNT = 16384;
constexpr int CW_ATTQ = 20480;

__device__ __forceinline__ unsigned f2bf(float f) { unsigned u = __builtin_bit_cast(unsigned, f); return (u + 0x7fffu + ((u >> 16) & 1u)) >> 16; }
typedef __bf16 bf16n2 __attribute__((ext_vector_type(2)));
__device__ __forceinline__ unsigned pk2(float lo, float hi) { const f32x2 f = {lo, hi}; const bf16n2 v = __builtin_convertvector(f, bf16n2); return __builtin_bit_cast(unsigned, v); }
__device__ __forceinline__ float bf2f(unsigned short h) { return __builtin_bit_cast(float, (unsigned)h << 16); }
__device__ __forceinline__ float bflo(unsigned w) { return __builtin_bit_cast(float, w << 16); }
__device__ __forceinline__ float bfhi(unsigned w) { return __builtin_bit_cast(float, w & 0xffff0000u); }
template <int CTRL, int ROWMASK = 0xF>
__device__ __forceinline__ float dpp_add(float v) { const int t = __builtin_amdgcn_update_dpp(0, __builtin_bit_cast(int, v), CTRL, ROWMASK, 0xF, ROWMASK == 0xF); return v + __builtin_bit_cast(float, t); }
#ifdef NO_DPP
__device__ __forceinline__ float sum4(float v)  { v += __shfl_xor(v, 1); v += __shfl_xor(v, 2); return v; }
__device__ __forceinline__ float sum8(float v)  { v = sum4(v); v += __shfl_xor(v, 4); return v; }
__device__ __forceinline__ float sum16(float v) { v = sum8(v); v += __shfl_xor(v, 8); return v; }
__device__ __forceinline__ float wave_sum(float v) { v = sum16(v); v += __shfl_xor(v, 16); v += __shfl_xor(v, 32); return v; }
#else
__device__ __forceinline__ float sum4(float v)  { v = dpp_add<0xB1>(v); return dpp_add<0x4E>(v); }
__device__ __forceinline__ float sum8(float v)  { return dpp_add<0x141>(sum4(v)); }
__device__ __forceinline__ float sum16(float v) { return dpp_add<0x140>(sum8(v)); }
__device__ __forceinline__ float wave_sum(float v) {
    v = sum16(v); v = dpp_add<0x142, 0xA>(v); v = dpp_add<0x143, 0xC>(v);
    return __builtin_bit_cast(float, __builtin_amdgcn_readlane(__builtin_bit_cast(int, v), 63));
}
#endif
__device__ __forceinline__ float sigmoidf_(float x) { return 1.0f / (1.0f + __expf(-x)); }
#define LDS_WAIT() asm volatile("s_waitcnt lgkmcnt(0)" ::: "memory")
#define LBAR() do { asm volatile("s_waitcnt lgkmcnt(0)" ::: "memory"); __builtin_amdgcn_s_barrier(); asm volatile("" ::: "memory"); } while (0)
#define VM_WAIT() asm volatile("s_waitcnt vmcnt(0)" ::: "memory")

#define XB_TMO      128
#define XB_XCNT(j)  (256  + 64 * (j))
#define XB_XSUB(j)  (1280 + 64 * (j))
#define XB_XGEN(j)  (2304 + 64 * (j))
#define XB_TOP      3328
#define XB_TOPGEN   3392
#define XCD_BAR_WORDS 3456
#define XB_SPIN_CAP (1u << 18)
__device__ __forceinline__ unsigned xb_ld(unsigned* p)              { return __hip_atomic_load(p, __ATOMIC_RELAXED, __HIP_MEMORY_SCOPE_AGENT); }
__device__ __forceinline__ unsigned xb_add(unsigned* p, unsigned v) { return __hip_atomic_fetch_add(p, v, __ATOMIC_RELAXED, __HIP_MEMORY_SCOPE_AGENT); }
__device__ __forceinline__ unsigned xb_xcc_id() { return (unsigned)__builtin_amdgcn_s_getreg((3 << 11) | 20) & 0xFu; }
#define XB_SPIN(cond, bar) do { unsigned _sp = 0; while (cond) { __builtin_amdgcn_s_sleep(1); \
    if ((++_sp & 255u) == 0u) { if (xb_ld(&(bar)[XB_TMO])) break; if (_sp > XB_SPIN_CAP) { atomicAdd(&(bar)[XB_TMO], 1u); break; } } } } while (0)
struct XcdBarrier { unsigned* bar; unsigned x; volatile LAS unsigned* st; int wv; };
__device__ __forceinline__ int lane_id_fresh() { int l; asm volatile("v_mbcnt_lo_u32_b32 %0, -1, 0\n\tv_mbcnt_hi_u32_b32 %0, -1, %0" : "=v"(l)); return l; }
__device__ __forceinline__ bool xb_thread0(int wv) { return wv == 0 && lane_id_fresh() == 0; }
__device__ __forceinline__ XcdBarrier xcd_barrier_post(unsigned* bar, volatile LAS unsigned* st, int wv) {
    XcdBarrier b; b.bar = bar; b.x = xb_xcc_id(); b.st = st; b.wv = wv;
    if (xb_thread0(wv)) (void)xb_add(&bar[XB_XCNT(b.x)], 1u);
    return b;
}
__device__ __forceinline__ void xcd_barrier_complete(unsigned* bar, unsigned x, unsigned& nloc, unsigned& nx) {
    const unsigned G = gridDim.x * gridDim.y * gridDim.z;
    unsigned sum, cnt, mine, sp = 0u;
    for (;;) {
        sum = 0u; cnt = 0u; mine = 0u;
#pragma unroll
        for (unsigned j = 0; j < 16; ++j) { const unsigned c = xb_ld(&bar[XB_XCNT(j)]); sum += c; cnt += (c > 0u) ? 1u : 0u; mine = (j == x) ? c : mine; }
        if (sum == G) break;
        __builtin_amdgcn_s_sleep(1);
        if ((++sp & 255u) == 0u) { if (xb_ld(&bar[XB_TMO])) break; if (sp > XB_SPIN_CAP) { atomicAdd(&bar[XB_TMO], 1u); break; } }
    }
    nloc = mine > 0u ? mine : 1u; nx = cnt > 0u ? cnt : 1u;
}
__device__ __forceinline__ void xcd_barrier(const XcdBarrier& b) {
    asm volatile("s_waitcnt vmcnt(0)" ::: "memory");
    __syncthreads();
    if (xb_thread0(b.wv)) {
        unsigned* bar = b.bar;
        __builtin_amdgcn_s_waitcnt(0);
        unsigned nloc = b.st[0], nx = b.st[1];
        if (nloc == 0u) { xcd_barrier_complete(bar, b.x, nloc, nx); b.st[0] = nloc; b.st[1] = nx; }
        const unsigned old = xb_add(&bar[XB_XSUB(b.x)], 1u);
        const unsigned gen = old / nloc;
        if (old + 1u == (gen + 1u) * nloc) {
            __builtin_amdgcn_fence(__ATOMIC_RELEASE, "agent");
            asm volatile("s_waitcnt vmcnt(0)" ::: "memory");
            const unsigned og = xb_add(&bar[XB_TOP], 1u);
            const unsigned tg = og / nx;
            if (og + 1u == (tg + 1u) * nx) xb_add(&bar[XB_TOPGEN], 1u);
            else XB_SPIN(xb_ld(&bar[XB_TOPGEN]) == tg, bar);
            __builtin_amdgcn_fence(__ATOMIC_ACQUIRE, "agent");
            xb_add(&bar[XB_XGEN(b.x)], 1u);
            asm volatile("s_waitcnt vmcnt(0)" ::: "memory");
        } else {
            XB_SPIN(xb_ld(&bar[XB_XGEN(b.x)]) == gen, bar);
            __builtin_amdgcn_fence(__ATOMIC_ACQUIRE, "agent");
            asm volatile("s_waitcnt vmcnt(0)" ::: "memory");
        }
    }
    __syncthreads();
}

namespace pg8 {
constexpr int BM = 256, BK = 64, HALF = 128, HTB = HALF * BK * 2, STAGE_BYTES = 8 * HTB;
__device__ __forceinline__ int lds_byte(int r, int c) { const int st = (r >> 4) * 2 + (c >> 5), rr = r & 15, cc = c & 31, ob = rr * 64 + cc * 2; return st * 1024 + (ob ^ (((ob >> 9) & 1) << 5)); }
__device__ __forceinline__ void stage_rc(int b, int& R, int& C) { const int st = b / 1024, sb = b % 1024, swz = sb ^ (((sb >> 9) & 1) << 5); R = (st >> 1) * 16 + swz / 64; C = (st & 1) * 32 + (swz % 64) / 2; }
__device__ __forceinline__ int perm32(int rho) { const int n = rho >> 4, i = rho & 15; return 8 * (i >> 2) + 4 * n + (i & 3); }
struct Unit { int pm, pn, aux; const char* A; const char* B; };
__device__ __forceinline__ unsigned cvt_pk_bf16(float lo, float hi) { return pk2(lo, hi); }

template <class Epi, class Sched, bool GATHER = false>
__device__ __forceinline__ void gemm_phase(LAS unsigned char* lds, const int tid_in, const int K, const int lda, const int ldb, const Sched& S, const Epi& E, const LAS unsigned* gtab = nullptr) {
    int tid_ = tid_in; asm volatile("" : "+v"(tid_));
    const int tid = tid_, wid = __builtin_amdgcn_readfirstlane(tid >> 6), lane = tid & 63, wr = wid >> 2, wc = wid & 3, fr = lane & 15, fq = lane >> 4;
    const int nt = K / BK;
    unsigned voffA[2], voffB[2];
#pragma unroll
    for (int i = 0; i < 2; ++i) { int R, C; stage_rc(tid * 16 + i * 8192, R, C); const int Rb = Epi::PERM ? ((R & ~31) + perm32(R & 31)) : R;
        voffA[i] = (unsigned)(R * lda + C) * 2u; voffB[i] = (unsigned)(Rb * ldb + C) * 2u; }
    const size_t kstep = (size_t)(BK * 2);
    const size_t hstepA = GATHER ? (size_t)0 : (size_t)HALF * lda * 2, hstepB = (size_t)HALF * ldb * 2;
    int gR[2], gC[2]; unsigned gcur[2][2], gnxt[2][2];
    if constexpr (GATHER) {
#pragma unroll
        for (int i = 0; i < 2; ++i) { int R, C; stage_rc(tid * 16 + i * 8192, R, C); gR[i] = R; gC[i] = C * 2; }
    }
#define PG8_GLOAD(dst, u_) do { _Pragma("unroll") for (int _h = 0; _h < 2; ++_h) _Pragma("unroll") for (int _i = 0; _i < 2; ++_i) dst[_h][_i] = gtab[(u_) * 256 + _h * 128 + gR[_i]] + (unsigned)gC[_i]; } while (0)
    const unsigned ldsw = (unsigned)wid * 1024u;
    const int aoff = lds_byte(wr * 64 + fr, fq * 8), boff = lds_byte(wc * 32 + fr, fq * 8);
#define PG8_SA(b, h) (((b) * 2 + (h)) * HTB)
#define PG8_SB(b, h) ((4 + (b) * 2 + (h)) * HTB)
#define PG8_STAGE(bufoff, gbase, voff) do { _Pragma("unroll") for (int _i = 0; _i < 2; ++_i) \
        __builtin_amdgcn_global_load_lds((const unsigned*)((const char*)(gbase) + (voff)[_i]), (LAS unsigned*)(lds + (bufoff) + ldsw + _i * 8192), 16, 0, 0); } while (0)
#define PG8_STAGEA(bufoff, gbase, h, tab) do { if constexpr (GATHER) { PG8_STAGE(bufoff, gbase, tab[h]); } else { PG8_STAGE(bufoff, (gbase) + (h) * hstepA, voffA); } } while (0)
#define PG8_LDA(dst, b, h) do { _Pragma("unroll") for (int m = 0; m < 4; ++m) _Pragma("unroll") for (int k = 0; k < 2; ++k) dst[m][k] = *(const LAS bf16x8*)(lds + PG8_SA(b, h) + aoff + m * 2048 + k * 1024); } while (0)
#define PG8_LDB(dst, b, h) do { _Pragma("unroll") for (int n = 0; n < 2; ++n) _Pragma("unroll") for (int k = 0; k < 2; ++k) dst[n][k] = *(const LAS bf16x8*)(lds + PG8_SB(b, h) + boff + n * 2048 + k * 1024); } while (0)
#define PG8_MMA(ai, bj, At, Bt) do { __builtin_amdgcn_s_setprio(1); _Pragma("unroll") for (int m = 0; m < 4; ++m) _Pragma("unroll") for (int n = 0; n < 2; ++n) _Pragma("unroll") for (int k = 0; k < 2; ++k) \
        acc[ai][bj][m][n] = __builtin_amdgcn_mfma_f32_16x16x32_bf16(Bt[n][k], At[m][k], acc[ai][bj][m][n], 0, 0, 0); __builtin_amdgcn_s_setprio(0); } while (0)
#define PG8_WAIT_V(n) asm volatile("s_waitcnt vmcnt(" #n ")" ::: "memory")
#define PG8_WAIT_L(n) asm volatile("s_waitcnt lgkmcnt(" #n ")" ::: "memory")
#define PG8_BAR __builtin_amdgcn_s_barrier()
#define PG8_SCHED __builtin_amdgcn_sched_barrier(0)
    Unit cur, nxt; int ui = 0;
    if (!S.next(0, cur)) return;
    f32x4 acc[2][2][4][2];
#pragma unroll
    for (int a = 0; a < 2; ++a)
#pragma unroll
        for (int b = 0; b < 2; ++b)
#pragma unroll
            for (int m = 0; m < 4; ++m)
#pragma unroll
                for (int n = 0; n < 2; ++n) acc[a][b][m][n] = (f32x4){0.f, 0.f, 0.f, 0.f};
    bf16x8 At[4][2], B0[2][2], B1[2][2];
    const char* cA = cur.A; const char* cB = cur.B;
    if constexpr (GATHER) { PG8_GLOAD(gcur, 0); PG8_GLOAD(gnxt, 1); asm volatile("s_waitcnt lgkmcnt(0)" ::: "memory"); }
    PG8_STAGE(PG8_SB(0, 0), cB, voffB); PG8_STAGE(PG8_SB(0, 1), cB + hstepB, voffB); PG8_STAGEA(PG8_SA(0, 0), cA, 0, gcur); PG8_STAGEA(PG8_SA(0, 1), cA, 1, gcur);
    if (wr == 1) PG8_BAR;
    PG8_WAIT_V(2); PG8_BAR;
    PG8_STAGE(PG8_SB(1, 0), cB + kstep, voffB); PG8_STAGEA(PG8_SA(1, 0), cA + kstep, 0, gcur); PG8_STAGE(PG8_SB(1, 1), cB + hstepB + kstep, voffB);
    PG8_WAIT_V(6); PG8_BAR;
#pragma unroll 1
    for (;;) {
        const bool has_next = S.next(ui + 1, nxt);
        const char* nA = has_next ? nxt.A : cA; const char* nB = has_next ? nxt.B : cB;
#pragma unroll 1
        for (int t = 0; t < nt; t += 2) {
            const bool last = (t == nt - 2);
            const char* a1 = cA + (size_t)(t + 1) * kstep;
            const char* a2 = last ? nA : cA + (size_t)(t + 2) * kstep; const char* b2 = last ? nB : cB + (size_t)(t + 2) * kstep;
            const char* a3 = a2 + kstep; const char* b3 = b2 + kstep;
            unsigned g2[2][2];
            if constexpr (GATHER) {
#pragma unroll
                for (int _h = 0; _h < 2; ++_h)
#pragma unroll
                    for (int _i = 0; _i < 2; ++_i) g2[_h][_i] = last ? gnxt[_h][_i] : gcur[_h][_i]; }
            PG8_LDB(B0, 0, 0); PG8_LDB(B1, 0, 1); PG8_SCHED; PG8_LDA(At, 0, 0); PG8_STAGEA(PG8_SA(1, 1), a1, 1, gcur);
            PG8_WAIT_V(8); PG8_WAIT_L(0); PG8_BAR; PG8_MMA(0, 0, At, B0); PG8_MMA(0, 1, At, B1); PG8_BAR; PG8_SCHED;
            PG8_LDA(At, 0, 1); PG8_STAGE(PG8_SB(0, 0), b2, voffB); PG8_STAGE(PG8_SB(0, 1), b2 + hstepB, voffB); PG8_STAGEA(PG8_SA(0, 0), a2, 0, g2);
            PG8_WAIT_V(8); PG8_WAIT_L(0); PG8_BAR; PG8_MMA(1, 0, At, B0); PG8_MMA(1, 1, At, B1); PG8_BAR; PG8_SCHED;
            PG8_LDB(B0, 1, 0); PG8_LDB(B1, 1, 1); PG8_SCHED; PG8_LDA(At, 1, 0); PG8_STAGEA(PG8_SA(0, 1), a2, 1, g2);
            PG8_WAIT_V(8); PG8_WAIT_L(0); PG8_BAR; PG8_MMA(0, 0, At, B0); PG8_MMA(0, 1, At, B1); PG8_BAR; PG8_SCHED;
            PG8_LDA(At, 1, 1); PG8_STAGE(PG8_SB(1, 0), b3, voffB); PG8_STAGE(PG8_SB(1, 1), b3 + hstepB, voffB); PG8_STAGEA(PG8_SA(1, 0), a3, 0, g2);
            PG8_WAIT_V(8); PG8_WAIT_L(0); PG8_BAR; PG8_MMA(1, 0, At, B0); PG8_MMA(1, 1, At, B1); PG8_BAR; PG8_SCHED;
        }
        if (wr == 0) PG8_BAR;
        E(acc, cur, wr, wc, fr, fq);
        if (!has_next) break;
#pragma unroll
        for (int a = 0; a < 2; ++a)
#pragma unroll
            for (int b = 0; b < 2; ++b)
#pragma unroll
                for (int m = 0; m < 4; ++m)
#pragma unroll
                    for (int n = 0; n < 2; ++n) acc[a][b][m][n] = (f32x4){0.f, 0.f, 0.f, 0.f};
        cur = nxt; cA = nA; cB = nB; ++ui;
        if constexpr (GATHER) {
#pragma unroll
            for (int _h = 0; _h < 2; ++_h)
#pragma unroll
                for (int _i = 0; _i < 2; ++_i) gcur[_h][_i] = gnxt[_h][_i];
            PG8_GLOAD(gnxt, ui + 1); }
        if (wr == 1) PG8_BAR;
    }
    PG8_WAIT_V(0);
    PG8_BAR;
#undef PG8_SA
#undef PG8_SB
#undef PG8_STAGE
#undef PG8_STAGEA
#undef PG8_GLOAD
#undef PG8_LDA
#undef PG8_LDB
#undef PG8_MMA
#undef PG8_WAIT_V
#undef PG8_WAIT_L
#undef PG8_BAR
#undef PG8_SCHED
}
}
constexpr int NWAVES = 8, NTHR = 512;
constexpr int RING_BYTES = 131072, LDS_BYTES = 147456, LDSCTL_OFF = LDS_BYTES - 2048;
struct Params { const float* in[29]; float* out; unsigned char* ws; };
struct Frame {
    LAS unsigned char* lds; int tid, lane, wave, blk, G, vcu, gw, ngw; unsigned char* ws;
};
enum { I_X = 0, I_POS, I_ANORM, I_WIN, I_MU, I_W0, I_W2, I_A0, I_A2, I_G2, I_KK, I_KA, I_RK, I_LNX, I_QNORM, I_WQB, I_KVNORM, I_WKVB, I_WBR, I_WO, I_FNORM,
       I_FG, I_FU, I_FD, I_ROUTER, I_MG, I_MU2, I_MD, I_FINAL };

struct SchedGrid {
    int nM, nN, nwg, G, c; const char* A; const char* B; size_t astep, bstep;
    __device__ void init(int nM_, int nN_, int G_, int c_, const void* A_, size_t astep_, const void* B_, size_t bstep_) { nM = nM_; nN = nN_; nwg = nM * nN; G = G_; c = c_; A = (const char*)A_; B = (const char*)B_; astep = astep_; bstep = bstep_; }
    __device__ __forceinline__ bool next(int i, pg8::Unit& u) const {
        const long L = (long)i * G + c; if (L >= nwg) return false;
        int wgid = (int)L; { const int q = nwg / 8, r = nwg % 8, xcd = wgid % 8, off = wgid / 8; wgid = (xcd < r ? xcd * (q + 1) : r * (q + 1) + (xcd - r) * q) + off; }
        const int nig = 8 * nN, gid = wgid / nig, fm = gid * 8, gsz = (nM - fm) < 8 ? (nM - fm) : 8;
        u.pm = fm + ((wgid % nig) % gsz); u.pn = (wgid % nig) / gsz; u.aux = 0;
        u.A = A + (size_t)u.pm * astep; u.B = B + (size_t)u.pn * bstep; return true;
    }
};
struct SchedSmall {
    int G, c, layer; const char* ws;
    __device__ __forceinline__ bool next(int i, pg8::Unit& u) const {
        int L = i * G + c; if (L >= 448) return false;
        int s = 0; if (L >= 192) { L -= 192; s = 1; if (L >= 128) { L -= 128; s = 2; } }
        const int nn = s == 0 ? 3 : (s == 1 ? 2 : 64);
        u.pm = L / nn; u.pn = L % nn; u.aux = s;
        const size_t lw = (size_t)layer * 256 * 2;
        const size_t ao = s == 0 ? WS_QN : (s == 1 ? WS_CN : WS_VB + lw * 512), bo = s == 0 ? WS_QB + lw * 768 : (s == 1 ? WS_KB + lw * 512 : WS_CN);
        u.A = ws + ao + (size_t)u.pm * (256 * 256 * 2); u.B = ws + bo + (size_t)u.pn * (256 * 256 * 2); return true;
    }
};
struct SchedOwn3 {
    int c, G; const char* A; const char* B; size_t astep, bstep, a_n, b_n;
    __device__ __forceinline__ bool next(int i, pg8::Unit& u) const {
        const int t = c + (i / 3) * G; if (t >= 256) return false;
        const int n = i % 3; u.pm = t >> 2; u.pn = t & 3; u.aux = n; u.A = A + (size_t)u.pm * astep + (size_t)n * a_n; u.B = B + (size_t)u.pn * bstep + (size_t)n * b_n; return true;
    }
};
struct SchedMoe {
    int G, c, ncol, ntile; const LAS int* tab; const char* A; const char* B; size_t astep, bstep, estep;
    __device__ __forceinline__ bool next(int i, pg8::Unit& u) const {
        const int L = i * G + c; if (L >= ntile * ncol) return false;
        u.pm = L / ncol; u.pn = L % ncol; const int e = tab[u.pm]; u.aux = e;
        u.A = A + (size_t)u.pm * astep; u.B = B + (size_t)e * estep + (size_t)u.pn * bstep; return true;
    }
};

using pg8::Unit; using pg8::cvt_pk_bf16;
#define EPI_ARGS const f32x4 (&acc)[2][2][4][2], const Unit& u, int wr, int wc, int fr, int fq
__device__ __forceinline__ float row_rstd(const float* SS, int row) {
    const f32x4* s = (const f32x4*)(SS + (size_t)row * 16); const f32x4 a = s[0], b = s[1], c = s[2], d = s[3];
    const float t = ((a.x + a.y) + (a.z + a.w)) + ((b.x + b.y) + (b.z + b.w)) + ((c.x + c.y) + (c.z + c.w)) + ((d.x + d.y) + (d.z + d.w));
    return rsqrtf(t * (1.0f / DM) + NORM_EPS);
}
__device__ __forceinline__ void panel_rstd(const float* SS, int pm, int tid, LAS float* rl) {
    if (tid < 256) rl[tid] = row_rstd(SS, pm * 256 + tid);
    asm volatile("s_waitcnt lgkmcnt(0)" ::: "memory"); __builtin_amdgcn_s_barrier(); asm volatile("" ::: "memory");
}
struct EpiStore {
    static constexpr bool PERM = true;
    bf16_t* O; int ld; const float* SS; LAS float* rl; int tid;
    __device__ __forceinline__ void operator()(EPI_ARGS) const {
        const int row0 = u.pm * 256 + wr * 64 + fr, col0 = u.pn * 256 + wc * 32 + 8 * fq;
        if (SS) panel_rstd(SS, u.pm, tid, rl);
#pragma unroll
        for (int ai = 0; ai < 2; ++ai)
#pragma unroll
            for (int m = 0; m < 4; ++m) { bf16_t* rowp = O + (size_t)(row0 + ai * 128 + m * 16) * ld + col0; const float rs = SS ? rl[wr * 64 + fr + ai * 128 + m * 16] : 1.0f;
#pragma unroll
                for (int bj = 0; bj < 2; ++bj) { const f32x4 v0 = acc[ai][bj][m][0] * rs, v1 = acc[ai][bj][m][1] * rs;
                    u32x4 w; w.x = cvt_pk_bf16(v0[0], v0[1]); w.y = cvt_pk_bf16(v0[2], v0[3]); w.z = cvt_pk_bf16(v1[0], v1[1]); w.w = cvt_pk_bf16(v1[2], v1[3]);
                    *(u32x4*)(rowp + bj * 128) = w; } }
    }
};
struct EpiSmall {
    static constexpr bool PERM = true;
    unsigned char* ws;
    __device__ __forceinline__ void operator()(EPI_ARGS) const {
        bf16_t* base = (bf16_t*)(ws + (u.aux == 0 ? WS_Q : (u.aux == 1 ? WS_KN : WS_VT))); const int ld = u.aux == 0 ? 768 : (u.aux == 1 ? 512 : MTOK);
        const int row0 = u.pm * 256 + wr * 64 + fr, col0 = u.pn * 256 + wc * 32 + 8 * fq;
#pragma unroll
        for (int ai = 0; ai < 2; ++ai)
#pragma unroll
            for (int m = 0; m < 4; ++m) { bf16_t* rowp = base + (size_t)(row0 + ai * 128 + m * 16) * ld + col0;
#pragma unroll
                for (int bj = 0; bj < 2; ++bj) { const f32x4 v0 = acc[ai][bj][m][0], v1 = acc[ai][bj][m][1];
                    u32x4 w; w.x = cvt_pk_bf16(v0[0], v0[1]); w.y = cvt_pk_bf16(v0[2], v0[3]); w.z = cvt_pk_bf16(v1[0], v1[1]); w.w = cvt_pk_bf16(v1[2], v1[3]);
                    *(u32x4*)(rowp + bj * 128) = w; } }
    }
};
struct EpiLora {
    static constexpr bool PERM = true;
    bf16_t* O; const float* w0; const float* a0;
    __device__ __forceinline__ void operator()(EPI_ARGS) const {
        const int seg = u.pn >> 1;
        const int row0 = u.pm * 256 + wr * 64 + fr, col0 = u.pn * 256 + wc * 32 + 8 * fq, ch0 = (u.pn & 1) * 256 + wc * 32 + 8 * fq;
        const float* bias = seg == 0 ? w0 : a0; const float sc = seg == 0 ? -0.6065306597126334f : 1.0f;
#pragma unroll
        for (int bj = 0; bj < 2; ++bj) {
            f32x4 b0 = {0.f, 0.f, 0.f, 0.f}, b1 = {0.f, 0.f, 0.f, 0.f};
            if (seg < 2) { b0 = *(const f32x4*)(bias + ch0 + bj * 128); b1 = *(const f32x4*)(bias + ch0 + bj * 128 + 4); }
#pragma unroll
            for (int ai = 0; ai < 2; ++ai)
#pragma unroll
                for (int m = 0; m < 4; ++m) { bf16_t* rowp = O + (size_t)(row0 + ai * 128 + m * 16) * LO_W + col0 + bj * 128;
                    f32x4 v0 = acc[ai][bj][m][0] + b0, v1 = acc[ai][bj][m][1] + b1;
                    if (seg < 2) {
#pragma unroll
                        for (int j = 0; j < 4; ++j) { v0[j] = sc * sigmoidf_(v0[j]); v1[j] = sc * sigmoidf_(v1[j]); }
                    }
                    u32x4 w; w.x = cvt_pk_bf16(v0[0], v0[1]); w.y = cvt_pk_bf16(v0[2], v0[3]); w.z = cvt_pk_bf16(v1[0], v1[1]); w.w = cvt_pk_bf16(v1[2], v1[3]);
                    *(u32x4*)rowp = w; }
        }
    }
};
struct EpiGate {
    static constexpr bool PERM = true;
    bf16_t* O; const float* SS; LAS float* rl; int tid;
    __device__ __forceinline__ void operator()(EPI_ARGS) const {
        const int row0 = u.pm * 256 + wr * 64 + fr, col0 = u.aux * 1024 + u.pn * 256 + wc * 32 + 8 * fq;
        panel_rstd(SS, u.pm, tid, rl);
#pragma unroll
        for (int ai = 0; ai < 2; ++ai)
#pragma unroll
            for (int m = 0; m < 4; ++m) { bf16_t* rowp = O + (size_t)(row0 + ai * 128 + m * 16) * 3072 + col0; const float rs = rl[wr * 64 + fr + ai * 128 + m * 16];
#pragma unroll
                for (int bj = 0; bj < 2; ++bj) { f32x4 v0 = acc[ai][bj][m][0] * rs, v1 = acc[ai][bj][m][1] * rs;
#pragma unroll
                    for (int j = 0; j < 4; ++j) { v0[j] = sigmoidf_(v0[j]); v1[j] = sigmoidf_(v1[j]); }
                    u32x4 w; w.x = cvt_pk_bf16(v0[0], v0[1]); w.y = cvt_pk_bf16(v0[2], v0[3]); w.z = cvt_pk_bf16(v1[0], v1[1]); w.w = cvt_pk_bf16(v1[2], v1[3]);
                    *(u32x4*)(rowp + bj * 128) = w; } }
    }
};
struct EpiMerge {
    static constexpr bool PERM = true;
    const bf16_t* Gt; bf16_t* Mg;
    template <bool RMW>
    __device__ __forceinline__ void half(EPI_ARGS, int ai) const {
        const int n = u.aux;
        const int row0 = u.pm * 256 + wr * 64 + fr + ai * 128, col0 = u.pn * 256 + wc * 32 + 8 * fq;
        u32x4 g[4][2], p[4][2];
#pragma unroll
        for (int m = 0; m < 4; ++m)
#pragma unroll
            for (int bj = 0; bj < 2; ++bj) { const size_t r = (size_t)(row0 + m * 16); g[m][bj] = *(const u32x4*)(Gt + r * 3072 + n * 1024 + col0 + bj * 128); if (RMW) p[m][bj] = *(const u32x4*)(Mg + r * 1024 + col0 + bj * 128); }
        asm volatile("" ::: "memory");
#pragma unroll
        for (int m = 0; m < 4; ++m)
#pragma unroll
            for (int bj = 0; bj < 2; ++bj) { const size_t r = (size_t)(row0 + m * 16); const f32x4 v0 = acc[ai][bj][m][0], v1 = acc[ai][bj][m][1]; const u32x4 gg = g[m][bj];
                float o[8] = {bflo(gg.x) * v0[0], bfhi(gg.x) * v0[1], bflo(gg.y) * v0[2], bfhi(gg.y) * v0[3], bflo(gg.z) * v1[0], bfhi(gg.z) * v1[1], bflo(gg.w) * v1[2], bfhi(gg.w) * v1[3]};
                if (RMW) { const u32x4 q = p[m][bj]; o[0] += bflo(q.x); o[1] += bfhi(q.x); o[2] += bflo(q.y); o[3] += bfhi(q.y); o[4] += bflo(q.z); o[5] += bfhi(q.z); o[6] += bflo(q.w); o[7] += bfhi(q.w); }
                u32x4 w; w.x = cvt_pk_bf16(o[0], o[1]); w.y = cvt_pk_bf16(o[2], o[3]); w.z = cvt_pk_bf16(o[4], o[5]); w.w = cvt_pk_bf16(o[6], o[7]);
                *(u32x4*)(Mg + r * 1024 + col0 + bj * 128) = w; }
    }
    __device__ __forceinline__ void operator()(EPI_ARGS) const {
        if (u.aux > 0) { half<true>(acc, u, wr, wc, fr, fq, 0); half<true>(acc, u, wr, wc, fr, fq, 1); }
        else { half<false>(acc, u, wr, wc, fr, fq, 0); half<false>(acc, u, wr, wc, fr, fq, 1); }
    }
};
constexpr int HLD = 2 * DM;
template <bool EMIT, bool IN_F32>
struct EpiResid {
    static constexpr bool PERM = true;
    const void* In; bf16_t* Out; const float* gain; bf16_t* Hg; float* SS;
    __device__ __forceinline__ void operator()(EPI_ARGS) const {
        const int row0 = u.pm * 256 + wr * 64 + fr, col0 = u.pn * 256 + wc * 32 + 8 * fq;
        f32x4 gv[2][2];
        if (EMIT) {
#pragma unroll
            for (int bj = 0; bj < 2; ++bj)
#pragma unroll
                for (int n = 0; n < 2; ++n) gv[bj][n] = *(const f32x4*)(gain + col0 + bj * 128 + n * 4); }
#pragma unroll
        for (int ai = 0; ai < 2; ++ai)
#pragma unroll
            for (int m = 0; m < 4; ++m) { const int row = row0 + ai * 128 + m * 16; float sq = 0.f;
#pragma unroll
                for (int bj = 0; bj < 2; ++bj) { const int col = col0 + bj * 128; f32x4 x0, x1;
                    if (IN_F32) { const float* ip = (const float*)In + (size_t)row * DM + col; x0 = *(const f32x4*)ip; x1 = *(const f32x4*)(ip + 4); }
                    else { const u32x4 p = *(const u32x4*)((const bf16_t*)In + (size_t)row * HLD + col); x0 = (f32x4){bflo(p.x), bfhi(p.x), bflo(p.y), bfhi(p.y)}; x1 = (f32x4){bflo(p.z), bfhi(p.z), bflo(p.w), bfhi(p.w)}; }
                    x0 += acc[ai][bj][m][0]; x1 += acc[ai][bj][m][1];
                    u32x4 w; w.x = cvt_pk_bf16(x0[0], x0[1]); w.y = cvt_pk_bf16(x0[2], x0[3]); w.z = cvt_pk_bf16(x1[0], x1[1]); w.w = cvt_pk_bf16(x1[2], x1[3]);
                    *(u32x4*)(Out + (size_t)row * HLD + col) = w;
                    if (EMIT) { sq += ((x0[0] * x0[0] + x0[1] * x0[1]) + (x0[2] * x0[2] + x0[3] * x0[3])) + ((x1[0] * x1[0] + x1[1] * x1[1]) + (x1[2] * x1[2] + x1[3] * x1[3]));
                        const f32x4 y0 = x0 * gv[bj][0], y1 = x1 * gv[bj][1];
                        u32x4 g; g.x = cvt_pk_bf16(y0[0], y0[1]); g.y = cvt_pk_bf16(y0[2], y0[3]); g.z = cvt_pk_bf16(y1[0], y1[1]); g.w = cvt_pk_bf16(y1[2], y1[3]);
                        *(u32x4*)(Hg + (size_t)row * DM + col) = g; } }
                if (EMIT) { sq += __shfl_xor(sq, 16); sq += __shfl_xor(sq, 32); if (fq == 0) SS[(size_t)row * 16 + u.pn * 4 + wc] = sq; } }
    }
};
struct EpiSwiglu {
    static constexpr bool PERM = true;
    bf16_t* O; int ldc; int pn_off; const float* SS; LAS float* rl; int tid;
    __device__ __forceinline__ void operator()(EPI_ARGS) const {
        const int row0 = u.pm * 256 + wr * 64 + fr, col0 = (u.pn - pn_off) * 128 + wc * 32 + 8 * fq;
        if (SS) panel_rstd(SS, u.pm, tid, rl);
#pragma unroll
        for (int ai = 0; ai < 2; ++ai)
#pragma unroll
            for (int m = 0; m < 4; ++m) { bf16_t* rowp = O + (size_t)(row0 + ai * 128 + m * 16) * ldc + col0; const float rs = SS ? rl[wr * 64 + fr + ai * 128 + m * 16] : 1.0f;
                float o[8];
#pragma unroll
                for (int n = 0; n < 2; ++n)
#pragma unroll
                    for (int j = 0; j < 4; ++j) { const float g = acc[ai][0][m][n][j] * rs, up = acc[ai][1][m][n][j] * rs; o[n * 4 + j] = g * sigmoidf_(g) * up; }
                u32x4 w; w.x = cvt_pk_bf16(o[0], o[1]); w.y = cvt_pk_bf16(o[2], o[3]); w.z = cvt_pk_bf16(o[4], o[5]); w.w = cvt_pk_bf16(o[6], o[7]);
                *(u32x4*)rowp = w; }
    }
};
template <bool ACCUM>
struct EpiMoeOut {
    static constexpr bool PERM = true;
    const float* row_w; bf16_t* O;
    __device__ __forceinline__ void operator()(EPI_ARGS) const {
        const int row0 = u.pm * 256 + wr * 64 + fr, col0 = u.pn * 256 + wc * 32 + 8 * fq;
#pragma unroll
        for (int ai = 0; ai < 2; ++ai)
#pragma unroll
            for (int m = 0; m < 4; ++m) { const int r = row0 + ai * 128 + m * 16; const float wt = row_w[r]; bf16_t* rowp = O + (size_t)r * DM + col0;
#pragma unroll
                for (int bj = 0; bj < 2; ++bj) { f32x4 v0 = acc[ai][bj][m][0] * wt, v1 = acc[ai][bj][m][1] * wt;
                    if (ACCUM) { const u32x4 p = *(const u32x4*)(rowp + bj * 128); v0[0] += bflo(p.x); v0[1] += bfhi(p.x); v0[2] += bflo(p.y); v0[3] += bfhi(p.y); v1[0] += bflo(p.z); v1[1] += bfhi(p.z); v1[2] += bflo(p.w); v1[3] += bfhi(p.w); }
                    u32x4 w; w.x = cvt_pk_bf16(v0[0], v0[1]); w.y = cvt_pk_bf16(v0[2], v0[3]); w.z = cvt_pk_bf16(v1[0], v1[1]); w.w = cvt_pk_bf16(v1[2], v1[3]);
                    *(u32x4*)(rowp + bj * 128) = w; } }
    }
};

__device__ __forceinline__ void transpose_tile64(const float* W, int ldn, int k0, int n0, bf16_t* WT, int ldk, int drow0, int drow1, int dk0, LAS float* scr, int lane) {
#ifdef SIMPLE_TR
    { const int c = lane & 7;
      for (int j = 0; j < 8; ++j) { const int n = (lane >> 3) + 8 * j; const float* s = W + (size_t)(k0 + 8 * c) * ldn + n0 + n;
        u32x4 o; o.x = pk2(s[0], s[(size_t)ldn]); o.y = pk2(s[(size_t)2 * ldn], s[(size_t)3 * ldn]); o.z = pk2(s[(size_t)4 * ldn], s[(size_t)5 * ldn]); o.w = pk2(s[(size_t)6 * ldn], s[(size_t)7 * ldn]);
        const int dr = n < 32 ? drow0 + n : drow1 + (n - 32);
        *(u32x4*)(WT + (size_t)dr * ldk + dk0 + k0 + 8 * c) = o; }
      return; }
#endif
    f32x4 v[16]; const int r4 = lane >> 4, c4 = (lane & 15) * 4;
#pragma unroll
    for (int i = 0; i < 16; ++i) v[i] = *(const f32x4*)(W + (size_t)(k0 + 4 * i + r4) * ldn + n0 + c4);
#pragma unroll
    for (int i = 0; i < 16; ++i) { LAS float* d = scr + (4 * i + r4) * 65 + c4; d[0] = v[i][0]; d[1] = v[i][1]; d[2] = v[i][2]; d[3] = v[i][3]; }
    LDS_WAIT(); asm volatile("" ::: "memory");
    const int c = lane & 7;
#pragma unroll
    for (int j = 0; j < 8; ++j) { const int n = (lane >> 3) + 8 * j; const LAS float* s = scr + (8 * c) * 65 + n;
        u32x4 o; o.x = pk2(s[0 * 65], s[1 * 65]); o.y = pk2(s[2 * 65], s[3 * 65]); o.z = pk2(s[4 * 65], s[5 * 65]); o.w = pk2(s[6 * 65], s[7 * 65]);
        const int dr = n < 32 ? drow0 + n : drow1 + (n - 32);
        *(u32x4*)(WT + (size_t)dr * ldk + dk0 + k0 + 8 * c) = o; }
    LDS_WAIT(); asm volatile("" ::: "memory");
}
__device__ __forceinline__ void conv_plain(const float* W, int K, int N, bf16_t* WT, int ldk, int item, LAS float* scr, int lane) {
    const int nblk = N / 64, kb = item / nblk, nb = item % nblk;
    transpose_tile64(W, N, kb * 64, nb * 64, WT, ldk, nb * 64, nb * 64 + 32, 0, scr, lane);
}
__device__ __forceinline__ int win_drow(int n0) { return n0 < 3872 ? n0 : (n0 < 4128 ? 4096 + (n0 - 3872) : (n0 < 4288 ? 4352 + (n0 - 4128) : 4608 + (n0 - 4288))); }
__device__ __forceinline__ int gu_drow(int n0, int up) { return (n0 >> 7) * 256 + (n0 & 127) + up * 128; }

struct TrD { const float* src; bf16_t* d0; bf16_t* d1; int ldn, ldk; };
__device__ __forceinline__ TrD tr_desc(const float* W, int ldn, int k0, int n0, bf16_t* WT, int ldk, int drow0, int drow1, int dk0) {
    TrD d; d.src = W + (size_t)k0 * ldn + n0; d.ldn = ldn; d.ldk = ldk; d.d0 = WT + (size_t)drow0 * ldk + dk0 + k0; d.d1 = WT + (size_t)drow1 * ldk + dk0 + k0; return d;
}
__device__ __forceinline__ void tr_load(f32x4 (&v)[16], const TrD& d, int lane) {
    const float* s = d.src + (size_t)(lane >> 4) * d.ldn + (lane & 15) * 4;
#pragma unroll
    for (int i = 0; i < 16; ++i) v[i] = *(const f32x4*)(s + (size_t)(4 * i) * d.ldn);
}
__device__ __forceinline__ void tr_store(const f32x4 (&v)[16], const TrD& d, LAS float* scr, int lane) {
    const int r4 = lane >> 4, c4 = (lane & 15) * 4;
#pragma unroll
    for (int i = 0; i < 16; ++i) { LAS float* q = scr + (4 * i + r4) * 65 + c4; q[0] = v[i][0]; q[1] = v[i][1]; q[2] = v[i][2]; q[3] = v[i][3]; }
    LDS_WAIT(); asm volatile("" ::: "memory");
    const int c = lane & 7;
#pragma unroll
    for (int j = 0; j < 8; ++j) { const int n = (lane >> 3) + 8 * j; const LAS float* s = scr + (8 * c) * 65 + n;
        u32x4 o; o.x = pk2(s[0 * 65], s[1 * 65]); o.y = pk2(s[2 * 65], s[3 * 65]); o.z = pk2(s[4 * 65], s[5 * 65]); o.w = pk2(s[6 * 65], s[7 * 65]);
        bf16_t* dr = n < 32 ? d.d0 + (size_t)n * d.ldk : d.d1 + (size_t)(n - 32) * d.ldk;
        *(u32x4*)(dr + 8 * c) = o; }
    LDS_WAIT(); asm volatile("" ::: "memory");
}
__device__ __forceinline__ TrD desc_plain(const float* W, int K, int N, bf16_t* WT, int ldk, int item) {
    const int nblk = N / 64, kb = item / nblk, nb = item % nblk; (void)K;
    return tr_desc(W, N, kb * 64, nb * 64, WT, ldk, nb * 64, nb * 64 + 32, 0);
}
#define TR_PIPE(DESC, IT0, STEP, NT, TAIL, SCR, LANE) do { \
    f32x4 v_[2][16]; TrD d_[2]; const int i0_ = (IT0), st_ = (STEP); const bool tail_ = (TAIL); \
    d_[0] = DESC(i0_); tr_load(v_[0], d_[0], LANE); \
    _Pragma("unroll") for (int k_ = 0; k_ < (NT); ++k_) { \
        if (k_ + 1 < (NT) || tail_) { d_[(k_ + 1) & 1] = DESC(i0_ + (k_ + 1) * st_); tr_load(v_[(k_ + 1) & 1], d_[(k_ + 1) & 1], LANE); } \
        asm volatile("" ::: "memory"); \
        tr_store(v_[k_ & 1], d_[k_ & 1], SCR, LANE); } \
    if (tail_) tr_store(v_[(NT) & 1], d_[(NT) & 1], SCR, LANE); } while (0)
namespace pro {
constexpr int I_IN = 16 * 115, I_QB = 4 * 12, I_BRn = 8 * 16, I_WOn = 16 * 16, I_G = 16 * 44, I_D = 44 * 16;
constexpr int NIT = NLAYER * (I_IN + I_QB + 3 * I_BRn + I_WOn) + 2 * I_G + I_D;
}
__device__ __forceinline__ TrD pro_desc(const Params& P, unsigned char* ws, int it) {
    using namespace pro;
    int r = it;
    if (r < NLAYER * I_IN) { const int l = r / I_IN; r %= I_IN; const int kb = r / 115, nb = r % 115;
        return tr_desc(P.in[I_WIN] + (size_t)l * DM * IN_COLS, IN_COLS, kb * 64, nb * 64, (bf16_t*)(ws + WS_WIN) + (size_t)l * WIN_ROWS * DM, DM, win_drow(nb * 64), win_drow(nb * 64 + 32), 0); }
    r -= NLAYER * I_IN;
    if (r < NLAYER * I_QB) { const int l = r / I_QB; r %= I_QB; return desc_plain(P.in[I_WQB] + (size_t)l * 256 * 768, 256, 768, (bf16_t*)(ws + WS_QB) + (size_t)l * 768 * 256, 256, r); }
    r -= NLAYER * I_QB;
    if (r < NLAYER * 3 * I_BRn) { const int ln = r / I_BRn; r %= I_BRn; return desc_plain(P.in[I_WBR] + (size_t)ln * 512 * 1024, 512, 1024, (bf16_t*)(ws + WS_BR) + (size_t)ln * 1024 * 512, 512, r); }
    r -= NLAYER * 3 * I_BRn;
    if (r < NLAYER * I_WOn) { const int l = r / I_WOn; r %= I_WOn; return desc_plain(P.in[I_WO] + (size_t)l * DM * DM, DM, DM, (bf16_t*)(ws + WS_WO) + (size_t)l * DM * DM, DM, r); }
    r -= NLAYER * I_WOn;
    if (r < 2 * I_G) { const int up = r / I_G; r %= I_G; const int kb = r / 44, nb = r % 44;
        return tr_desc(up ? P.in[I_FU] : P.in[I_FG], DFF, kb * 64, nb * 64, (bf16_t*)(ws + WS_FGU), DM, gu_drow(nb * 64, up), gu_drow(nb * 64 + 32, up), 0); }
    r -= 2 * I_G;
    return desc_plain(P.in[I_FD], DFF, DM, (bf16_t*)(ws + WS_FD), DFF, r);
}

#define PRO_DESC_(x) pro_desc(P, ws, (x))
template <int NT>
__device__ __forceinline__ void pro_tiles(const Frame& F, const Params& P, int lo, int w0, int nw, int tail) {
    LAS float* scr = (LAS float*)(F.lds + F.wave * 16640);
    unsigned char* ws = F.ws;
    if constexpr (NT == 0) { if (w0 < tail) { f32x4 v[16]; const TrD d = pro_desc(P, ws, lo + w0); tr_load(v, d, F.lane); tr_store(v, d, scr, F.lane); } }
    else TR_PIPE(PRO_DESC_, lo + w0, nw, NT, w0 < tail, scr, F.lane);
}
__device__ __forceinline__ void pro_small(const Frame& F, const Params& P, int gt, int ngt, int vb0, int nvb) {
    unsigned char* ws = F.ws;
    for (int i = gt; i < NLAYER * 3 * 48 * 512; i += ngt) { const int c = i & 511; int r = i >> 9; const int k = 8 * (r % 48); r /= 48; const int seg = r % 3, l = r / 3;
        const float* src = nullptr;
        if (seg == 0 && k < 64) src = P.in[I_W2] + ((size_t)l * 64 + k) * 512 + c;
        else if (seg == 1 && k >= 64 && k < 128) src = P.in[I_A2] + ((size_t)l * 64 + (k - 64)) * 512 + c;
        else if (seg == 2 && k >= 128 && k < 288) src = P.in[I_G2] + ((size_t)l * 160 + (k - 128)) * 512 + c;
        const bool live = src != nullptr; if (!live) src = P.in[I_W2] + c;
        float v[8];
#pragma unroll
        for (int q = 0; q < 8; ++q) v[q] = src[q * 512];
#pragma unroll
        for (int q = 0; q < 8; ++q) v[q] = live ? v[q] : 0.f;
        u32x4 o; o.x = pk2(v[0], v[1]); o.y = pk2(v[2], v[3]); o.z = pk2(v[4], v[5]); o.w = pk2(v[6], v[7]);
        *(u32x4*)((bf16_t*)(ws + WS_LORA) + ((size_t)l * 1536 + seg * 512 + c) * 384 + k) = o; }
    for (int i = gt; i < NLAYER * 32 * 512; i += ngt) { const int n = i & 511; int r = i >> 9; const int k = 8 * (r & 31), l = r >> 5; const int h = n >> 6, dd = n & 63;
        float vk[8], vv[8]; const float* w = P.in[I_WKVB] + ((size_t)l * 128 + (k < 128 ? k : 0)) * 1024 + h * 128 + dd;
#pragma unroll
        for (int q = 0; q < 8; ++q) { vk[q] = w[q * 1024]; vv[q] = w[q * 1024 + 64]; }
#pragma unroll
        for (int q = 0; q < 8; ++q) { vk[q] = k < 128 ? vk[q] : 0.f; vv[q] = k < 128 ? vv[q] : 0.f; }
        u32x4 o; o.x = pk2(vk[0], vk[1]); o.y = pk2(vk[2], vk[3]); o.z = pk2(vk[4], vk[5]); o.w = pk2(vk[6], vk[7]);
        *(u32x4*)((bf16_t*)(ws + WS_KB) + ((size_t)l * 512 + n) * 256 + k) = o;
        o.x = pk2(vv[0], vv[1]); o.y = pk2(vv[2], vv[3]); o.z = pk2(vv[4], vv[5]); o.w = pk2(vv[6], vv[7]);
        *(u32x4*)((bf16_t*)(ws + WS_VB) + ((size_t)l * 512 + n) * 256 + k) = o; }
    {
        const int j = F.tid & 127, r0 = F.tid >> 7;
        if (j < 80) { const int isr = j < 64; const int idx = isr ? j : j - 64; const double dim = isr ? 128.0 : 32.0;
            const float inv = (float)(1.0 / pow(10000.0, (2.0 * idx) / dim));
            for (int vb = vb0; vb < MTOK / 64; vb += nvb) {
                int pos[16];
#pragma unroll
                for (int k = 0; k < 16; ++k) pos[k] = ((const int*)P.in[I_POS])[vb * 64 + r0 + 4 * k];
                asm volatile("" ::: "memory");
#pragma unroll
                for (int k = 0; k < 16; ++k) { const int m = vb * 64 + r0 + 4 * k;
                    const float ang = (float)pos[k] * inv;
                    const double a = (double)ang, q = rint(a * 0.15915494309189535), rr = a - q * 6.283185307179586476925;
                    const float rf = (float)rr; const float cs = __cosf(rf), sn = __sinf(rf);
                    if (isr) { ((float*)(ws + WS_COSR))[(size_t)m * 64 + idx] = cs; ((float*)(ws + WS_SINR))[(size_t)m * 64 + idx] = sn; }
                    else { ((float*)(ws + WS_COSM))[(size_t)m * 16 + idx] = cs; ((float*)(ws + WS_SINM))[(size_t)m * 16 + idx] = sn; } } } }
    }
}
__device__ __forceinline__ void phase_prologue(const Frame& F, const Params& P) {
    unsigned char* ws = F.ws;
    pro_tiles<0>(F, P, 0, F.gw, 2048, pro::I_IN);
    for (int m = F.gw; m < MTOK; m += F.ngw) {
        const f32x4* xr = (const f32x4*)(P.in[I_X] + (size_t)m * DM) + F.lane; f32x4 v[4]; float s = 0.f;
#pragma unroll
        for (int j = 0; j < 4; ++j) { v[j] = xr[64 * j]; s += (v[j].x * v[j].x + v[j].y * v[j].y) + (v[j].z * v[j].z + v[j].w * v[j].w); }
        s = wave_sum(s);
        u32x2* o8 = (u32x2*)((bf16_t*)(ws + WS_HN) + (size_t)m * DM) + F.lane;
#pragma unroll
        for (int j = 0; j < 4; ++j) { const f32x4 g = ((const f32x4*)P.in[I_ANORM])[F.lane + 64 * j]; const f32x4 y = v[j] * g; u32x2 w; w.x = pk2(y.x, y.y); w.y = pk2(y.z, y.w); o8[64 * j] = w; }
        if (F.lane < 16) ((float*)(ws + WS_SS))[(size_t)m * 16 + F.lane] = F.lane == 0 ? s : 0.f;
    }
}
template <int PART>
__device__ __forceinline__ void phase_moe_convert(const Frame& F, const Params& P, int w0, int nw) {
    LAS float* scr = (LAS float*)(F.lds + F.wave * 16640);
    constexpr int I_GH = 16 * 28, I_D = 56 * 16;
    constexpr int PER_E = PART == 0 ? 2 * I_GH + I_D : 2 * I_GH;
    for (int it = w0; it < NEXP * PER_E; it += nw) {
        const int e = it / PER_E; int r = it % PER_E;
        if (r < 2 * I_GH) { const int up = r / I_GH; r %= I_GH; const int kb = r / 28, nb = PART * 28 + r % 28;
            transpose_tile64(P.in[up ? I_MU2 : I_MG] + (size_t)e * DM * DFFE, DFFE, kb * 64, nb * 64, (bf16_t*)(F.ws + WS_MGU) + (size_t)e * 2 * DFFE * DM, DM, gu_drow(nb * 64, up), gu_drow(nb * 64 + 32, up), 0, scr, F.lane); continue; }
        r -= 2 * I_GH;
        conv_plain(P.in[I_MD] + (size_t)e * DFFE * DM, DFFE, DM, (bf16_t*)(F.ws + WS_MD) + (size_t)e * DM * DFFE, DFFE, r, scr, F.lane);
    }
}

template <bool MOE>
__device__ __forceinline__ void phase_rms(const Frame& F, const bf16_t* src, const float* gain, bf16_t* hn, const float* router, unsigned* ectl, int* tok_e, int* tok_slot, float* tok_w) {
    LAS int* lcnt = (LAS int*)(F.lds);
    if (MOE) { if (F.tid < 16) lcnt[F.tid] = 0; __syncthreads(); }
    int my_e0 = 0, my_e1 = 0, my_s0 = 0, my_s1 = 0; float my_w0 = 0.f, my_w1 = 0.f;
    f32x4 rw[MOE ? 32 : 1];
    if (MOE) {
#pragma unroll
        for (int j = 0; j < 4; ++j)
#pragma unroll
            for (int q = 0; q < 4; ++q) { const int c = 4 * F.lane + 256 * j + q; rw[(j * 4 + q) * 2] = *(const f32x4*)(router + (size_t)c * 8); rw[(j * 4 + q) * 2 + 1] = *(const f32x4*)(router + (size_t)c * 8 + 4); } }
    f32x4 gn[4];
#pragma unroll
    for (int j = 0; j < 4; ++j) gn[j] = ((const f32x4*)gain)[F.lane + 64 * j];
    for (int i0 = 0; i0 < 8; i0 += 4) {
    u32x2 raw[4][4];
#pragma unroll
    for (int r = 0; r < 4; ++r) { const u32x2* xr = (const u32x2*)(src + (size_t)(F.blk * 64 + F.wave * 8 + i0 + r) * HLD) + F.lane;
#pragma unroll
        for (int j = 0; j < 4; ++j) raw[r][j] = xr[64 * j]; }
    asm volatile("" ::: "memory");
#pragma unroll
    for (int r = 0; r < 4; ++r) {
        const int i = i0 + r, m = F.blk * 64 + F.wave * 8 + i;
        f32x4 v[4]; float s = 0.f;
#pragma unroll
        for (int j = 0; j < 4; ++j) { const u32x2 p = raw[r][j]; v[j] = (f32x4){bflo(p.x), bfhi(p.x), bflo(p.y), bfhi(p.y)}; s += (v[j].x * v[j].x + v[j].y * v[j].y) + (v[j].z * v[j].z + v[j].w * v[j].w); }
        const float rstd = rsqrtf(wave_sum(s) * (1.0f / DM) + NORM_EPS);
#pragma unroll
        for (int j = 0; j < 4; ++j) v[j] = v[j] * rstd * gn[j];
        u32x2* o8 = (u32x2*)(hn + (size_t)m * DM) + F.lane;
#pragma unroll
        for (int j = 0; j < 4; ++j) { u32x2 w; w.x = pk2(v[j].x, v[j].y); w.y = pk2(v[j].z, v[j].w); o8[64 * j] = w; }
        if (MOE) {
            float lg[8];
#pragma unroll
            for (int e = 0; e < 8; ++e) lg[e] = 0.f;
#pragma unroll
            for (int j = 0; j < 4; ++j)
#pragma unroll
                for (int q = 0; q < 4; ++q) { const f32x4 r0 = rw[(j * 4 + q) * 2], r1 = rw[(j * 4 + q) * 2 + 1]; const float x = v[j][q];
                    lg[0] += x * r0.x; lg[1] += x * r0.y; lg[2] += x * r0.z; lg[3] += x * r0.w; lg[4] += x * r1.x; lg[5] += x * r1.y; lg[6] += x * r1.z; lg[7] += x * r1.w; }
#pragma unroll
            for (int e = 0; e < 8; ++e) lg[e] = wave_sum(lg[e]);
            int e0 = 0; float b0 = lg[0];
#pragma unroll
            for (int e = 1; e < 8; ++e) if (lg[e] > b0) { b0 = lg[e]; e0 = e; }
            int e1 = -1; float b1 = -3.0e38f;
#pragma unroll
            for (int e = 0; e < 8; ++e) if (e != e0 && lg[e] > b1) { b1 = lg[e]; e1 = e; }
            const float t = __expf(b1 - b0), w0 = 1.0f / (1.0f + t), w1 = t / (1.0f + t);
            int s0 = 0, s1 = 0;
            if (F.lane == 0) { s0 = atomicAdd((int*)&lcnt[e0], 1); s1 = atomicAdd((int*)&lcnt[e1], 1); }
            s0 = __shfl(s0, 0); s1 = __shfl(s1, 0);
            if (F.lane == i) { my_e0 = e0; my_e1 = e1; my_s0 = s0; my_s1 = s1; my_w0 = w0; my_w1 = w1; }
        }
    }
    }
    if (MOE) {
        __syncthreads();
        if (F.tid < 8) lcnt[8 + F.tid] = (int)atomicAdd(&ectl[F.tid], (unsigned)lcnt[F.tid]);
        __syncthreads();
        if (F.lane < 8) { const int m = F.blk * 64 + F.wave * 8 + F.lane;
            tok_e[2 * m] = my_e0; tok_e[2 * m + 1] = my_e1; tok_slot[2 * m] = lcnt[8 + my_e0] + my_s0; tok_slot[2 * m + 1] = lcnt[8 + my_e1] + my_s1; tok_w[2 * m] = my_w0; tok_w[2 * m + 1] = my_w1; }
        __syncthreads();
    }
}
__device__ __forceinline__ void phase_final(const Frame& F, float* h, const float* gain, const bf16_t* out2, const int* tok_pos) {
    int pos[8][2];
#pragma unroll
    for (int k = 0; k < 8; ++k) { const int m = F.gw + k * F.ngw; pos[k][0] = tok_pos[2 * m]; pos[k][1] = tok_pos[2 * m + 1]; }
    f32x4 gn[4];
#pragma unroll
    for (int j = 0; j < 4; ++j) gn[j] = ((const f32x4*)gain)[F.lane + 64 * j];
#pragma unroll
    for (int k0 = 0; k0 < 8; k0 += 4) {
        u32x2 hv[4][4], av[4][4], bv[4][4];
#pragma unroll
        for (int r = 0; r < 4; ++r) { const int m = F.gw + (k0 + r) * F.ngw;
            const u32x2* hr = (const u32x2*)((const bf16_t*)h + (size_t)m * HLD) + F.lane;
            const u32x2* o0 = (const u32x2*)(out2 + (size_t)pos[k0 + r][0] * DM) + F.lane; const u32x2* o1 = (const u32x2*)(out2 + (size_t)pos[k0 + r][1] * DM) + F.lane;
#pragma unroll
            for (int j = 0; j < 4; ++j) { hv[r][j] = hr[64 * j]; av[r][j] = o0[64 * j]; bv[r][j] = o1[64 * j]; } }
        asm volatile("" ::: "memory");
#pragma unroll
        for (int r = 0; r < 4; ++r) { const int m = F.gw + (k0 + r) * F.ngw;
            f32x4* xr = (f32x4*)(h + (size_t)m * DM) + F.lane;
            f32x4 v[4]; float s = 0.f;
#pragma unroll
            for (int j = 0; j < 4; ++j) { const u32x2 p = hv[r][j]; v[j] = (f32x4){bflo(p.x), bfhi(p.x), bflo(p.y), bfhi(p.y)}; const u32x2 a = av[r][j], b = bv[r][j];
                v[j].x += bflo(a.x) + bflo(b.x); v[j].y += bfhi(a.x) + bfhi(b.x); v[j].z += bflo(a.y) + bflo(b.y); v[j].w += bfhi(a.y) + bfhi(b.y);
                s += (v[j].x * v[j].x + v[j].y * v[j].y) + (v[j].z * v[j].z + v[j].w * v[j].w); }
            const float rstd = rsqrtf(wave_sum(s) * (1.0f / DM) + NORM_EPS);
#pragma unroll
            for (int j = 0; j < 4; ++j) xr[64 * j] = v[j] * rstd * gn[j]; }
    }
}
template <int KS>
__device__ __forceinline__ f32x4 mm_tile(const LAS bf16_t* P, int ldp, const LAS bf16_t* Q, int ldq, int ib, int jb, int lane, f32x4 acc) {
    const LAS bf16_t* pp = P + (ib * 16 + (lane & 15)) * ldp + 8 * (lane >> 4);
    const LAS bf16_t* qp = Q + (jb * 16 + (lane & 15)) * ldq + 8 * (lane >> 4);
#pragma unroll
    for (int ks = 0; ks < KS; ++ks) { const bf16x8 a = *(const LAS bf16x8*)(qp + ks * 32), b = *(const LAS bf16x8*)(pp + ks * 32); acc = __builtin_amdgcn_mfma_f32_16x16x32_bf16(a, b, acc, 0, 0, 0); }
    return acc;
}
__device__ __forceinline__ void st_bf4(LAS bf16_t* p, f32x4 v) { u32x2 w; w.x = pk2(v[0], v[1]); w.y = pk2(v[2], v[3]); *(LAS u32x2*)p = w; }
__device__ __forceinline__ float ret_lg(int h) { return __logf(1.0f - exp2f(-5.0f - (float)h)); }

__device__ __forceinline__ void phase_prep(const Frame& F, const Params& P, int layer) {
    unsigned char* ws = F.ws;
    const bf16_t* p = (const bf16_t*)(ws + WS_P);
    const float* mu = P.in[I_MU] + (size_t)layer * RWKV_COLS;
    float mu5[5];
#pragma unroll
    for (int jj = 0; jj < 5; ++jj) { const int c = F.lane + 64 * jj; mu5[jj] = mu[1536 + (c < 288 ? c : 0)]; }
    const f32x4 gq = *(const f32x4*)(P.in[I_QNORM] + layer * 256 + 4 * F.lane);
    const f32x2 gk = *(const f32x2*)(P.in[I_KVNORM] + layer * 128 + 2 * F.lane);
    for (int m0 = F.gw; m0 < MTOK; m0 += 4 * F.ngw) {
        unsigned short lx[4][5], lp[4][5], kx1[4], kx2[4]; u32x2 qa[4]; unsigned kva[4]; float kc[4], ks[4];
#pragma unroll
        for (int r = 0; r < 4; ++r) { const int m = m0 + r * F.ngw; const bf16_t* pr = p + (size_t)m * PW; const bool has_prev = (m % SEQ) != 0; const bf16_t* pp = has_prev ? pr - PW : pr;
#pragma unroll
            for (int jj = 0; jj < 5; ++jj) { const int c = F.lane + 64 * jj; const int off = 1536 + (c < 288 ? c : 0); lx[r][jj] = pr[P_RW + off]; lp[r][jj] = pp[P_RW + off]; }
            qa[r] = *(const u32x2*)(pr + P_QA + 4 * F.lane); kva[r] = *(const unsigned*)(pr + P_KVA + 2 * F.lane);
            const int l16 = F.lane & 15; kx1[r] = pr[P_KVA + 128 + l16]; kx2[r] = pr[P_KVA + 144 + l16];
            kc[r] = ((const float*)(ws + WS_COSM))[(size_t)m * 16 + l16]; ks[r] = ((const float*)(ws + WS_SINM))[(size_t)m * 16 + l16]; }
        asm volatile("" ::: "memory");
#pragma unroll
        for (int r = 0; r < 4; ++r) { const int m = m0 + r * F.ngw; const bool has_prev = (m % SEQ) != 0;
            bf16_t* lin = (bf16_t*)(ws + WS_LIN) + (size_t)m * LORA_K;
#pragma unroll
            for (int jj = 0; jj < 6; ++jj) { const int c = F.lane + 64 * jj; float o = 0.f;
                if (jj < 5) { const float x = bf2f(lx[r][jj < 5 ? jj : 0]), xp = has_prev ? bf2f(lp[r][jj < 5 ? jj : 0]) : 0.f; const float xs = x + (xp - x) * mu5[jj < 5 ? jj : 0];
                    const float oo = c < 64 ? tanhf(xs) : (c < 128 ? xs : sigmoidf_(xs)); o = c < 288 ? oo : 0.f; }
                lin[c] = (bf16_t)f2bf(o); }
            {
                const u32x2 w = qa[r]; float x[4] = {bflo(w.x), bfhi(w.x), bflo(w.y), bfhi(w.y)};
                const float ss = wave_sum(x[0] * x[0] + x[1] * x[1] + x[2] * x[2] + x[3] * x[3]); const float rs = rsqrtf(ss * (1.0f / 256.0f) + NORM_EPS);
                u32x2 o; o.x = pk2(x[0] * rs * gq.x, x[1] * rs * gq.y); o.y = pk2(x[2] * rs * gq.z, x[3] * rs * gq.w); *(u32x2*)((bf16_t*)(ws + WS_QN) + (size_t)m * 256 + 4 * F.lane) = o; }
            {
                const unsigned w = kva[r]; float x0 = bflo(w), x1 = bfhi(w);
                const float ss = wave_sum(x0 * x0 + x1 * x1); const float rs = rsqrtf(ss * (1.0f / 128.0f) + NORM_EPS);
                unsigned* cn = (unsigned*)((bf16_t*)(ws + WS_CN) + (size_t)m * 256); cn[F.lane] = pk2(x0 * rs * gk.x, x1 * rs * gk.y); cn[64 + F.lane] = 0u; }
            if (F.lane < 16) {
                const float x1 = bf2f(kx1[r]), x2 = bf2f(kx2[r]); const float c = kc[r], s = ks[r];
                bf16_t* kp = (bf16_t*)(ws + WS_KPE) + (size_t)m * 32; kp[F.lane] = (bf16_t)f2bf(x1 * c - x2 * s); kp[16 + F.lane] = (bf16_t)f2bf(x1 * s + x2 * c); } }
    }
    LAS bf16_t* kT = (LAS bf16_t*)F.lds;
    LAS bf16_t* vT = kT + 128 * 72;
    const int pc = F.tid & 7, j = F.tid >> 3;
    constexpr int NU = NB * NCHUNK * 4;
    u32x4 xa, xb, xva, xvb; f32x4 xc0, xc1, xs0, xs1;
#define PREP_LOAD(uu) do { const int h_ = (uu) & 3, n_ = ((uu) >> 2) & 127, b_ = (uu) >> 9; const int m_ = b_ * SEQ + n_ * 64 + j; \
        const bf16_t* kr_ = p + (size_t)m_ * PW + P_RK + h_ * 128 + pc * 8; xa = *(const u32x4*)kr_; xb = *(const u32x4*)(kr_ + 64); \
        const bf16_t* vr_ = p + (size_t)m_ * PW + P_RV + h_ * 128 + pc * 8; xva = *(const u32x4*)vr_; xvb = *(const u32x4*)(vr_ + 64); \
        const f32x4* cp_ = (const f32x4*)((const float*)(ws + WS_COSR) + (size_t)m_ * 64 + pc * 8); const f32x4* sp_ = (const f32x4*)((const float*)(ws + WS_SINR) + (size_t)m_ * 64 + pc * 8); \
        xc0 = cp_[0]; xc1 = cp_[1]; xs0 = sp_[0]; xs1 = sp_[1]; } while (0)
    if (F.blk < NU) PREP_LOAD(F.blk);
    for (int u = F.blk; u < NU; u += F.G) {
        const int h = u & 3;
        const float lg = ret_lg(h);
        __syncthreads();
        {
            const u32x4 a = xa, bq = xb;
            const float cp[8] = {xc0.x, xc0.y, xc0.z, xc0.w, xc1.x, xc1.y, xc1.z, xc1.w}, sp[8] = {xs0.x, xs0.y, xs0.z, xs0.w, xs1.x, xs1.y, xs1.z, xs1.w};
            const float sc = 0.08838834764831845f * __expf(lg * (float)(63 - j));
            const unsigned aw[4] = {a.x, a.y, a.z, a.w}, bw[4] = {bq.x, bq.y, bq.z, bq.w};
#pragma unroll
            for (int i = 0; i < 8; ++i) { const float x1 = (i & 1) ? bfhi(aw[i >> 1]) : bflo(aw[i >> 1]), x2 = (i & 1) ? bfhi(bw[i >> 1]) : bflo(bw[i >> 1]); const float c = cp[i], s = sp[i];
                kT[(pc * 8 + i) * 72 + j] = (bf16_t)f2bf((x1 * c - x2 * s) * sc); kT[(64 + pc * 8 + i) * 72 + j] = (bf16_t)f2bf((x1 * s + x2 * c) * sc); }
            const u32x4 va = xva, vb = xvb;
            const unsigned vaw[4] = {va.x, va.y, va.z, va.w}, vbw[4] = {vb.x, vb.y, vb.z, vb.w};
#pragma unroll
            for (int i = 0; i < 8; ++i) { vT[(pc * 8 + i) * 72 + j] = (bf16_t)((i & 1) ? (vaw[i >> 1] >> 16) : (vaw[i >> 1] & 0xffffu)); vT[(64 + pc * 8 + i) * 72 + j] = (bf16_t)((i & 1) ? (vbw[i >> 1] >> 16) : (vbw[i >> 1] & 0xffffu)); }
        }
        { const int un = u + F.G < NU ? u + F.G : u; PREP_LOAD(un); }
        __syncthreads();
        bf16_t* out = (bf16_t*)(ws + WS_RS) + (size_t)u * 16384;
#pragma unroll
        for (int jb = 0; jb < 8; ++jb) { f32x4 acc = {0.f, 0.f, 0.f, 0.f}; acc = mm_tile<2>(vT, 72, kT, 72, F.wave, jb, F.lane, acc);
            const int e = F.wave * 16 + (F.lane & 15), d = jb * 16 + 4 * (F.lane >> 4);
            u32x2 w; w.x = pk2(acc[0], acc[1]); w.y = pk2(acc[2], acc[3]); *(u32x2*)(out + e * 128 + d) = w; }
    }
    __syncthreads();
#undef PREP_LOAD
}

__device__ __forceinline__ void ret_scan(const Frame& F) {
    bf16_t* rs = (bf16_t*)(F.ws + WS_RS);
    for (int idx = F.blk * NTHR + F.tid; idx < NB * 4 * 16384; idx += F.G * NTHR) {
        const int b = idx >> 16, h = (idx >> 14) & 3, ed = idx & 16383; const float cd = __expf(ret_lg(h) * 64.0f);
        bf16_t* base = rs + ((size_t)(b * 128) * 4 + h) * 16384 + ed; float s = 0.f;
        for (int n0 = 0; n0 < NCHUNK; n0 += 64) { unsigned short t[64];
#pragma unroll
            for (int i = 0; i < 64; ++i) t[i] = base[(size_t)(n0 + i) * 65536];
            asm volatile("" ::: "memory");
#pragma unroll
            for (int i = 0; i < 64; ++i) { base[(size_t)(n0 + i) * 65536] = (bf16_t)f2bf(s); s = s * cd + bf2f(t[i]); } }
    }
}

__device__ __forceinline__ void ret_out(const Frame& F) {
    unsigned char* ws = F.ws; const bf16_t* p = (const bf16_t*)(ws + WS_P);
    LAS bf16_t* q = (LAS bf16_t*)F.lds;
    LAS bf16_t* k = q + 64 * 136;
    LAS bf16_t* vT = k + 64 * 136;
    LAS bf16_t* pT = vT + 128 * 72;
    LAS bf16_t* sc = pT + 128 * 136;
    LAS float* st = (LAS float*)(sc + 64 * 72);
    const int pc = F.tid & 7, j = F.tid >> 3;
    constexpr int NU = NB * NCHUNK * 4;
    f32x4 xc0, xc1, xs0, xs1; u32x4 xqa, xqb, xka, xkb, xva, xvb, xp0, xp1, xp2, xp3;
#define RET_LOAD(uu) do { const int h_ = (uu) & 3, n_ = ((uu) >> 2) & 127, b_ = (uu) >> 9; const int m_ = b_ * SEQ + n_ * 64 + j; \
        const f32x4* cp_ = (const f32x4*)((const float*)(ws + WS_COSR) + (size_t)m_ * 64 + pc * 8); const f32x4* sp_ = (const f32x4*)((const float*)(ws + WS_SINR) + (size_t)m_ * 64 + pc * 8); \
        xc0 = cp_[0]; xc1 = cp_[1]; xs0 = sp_[0]; xs1 = sp_[1]; \
        const bf16_t* r_ = p + (size_t)m_ * PW + h_ * 128 + pc * 8; xqa = *(const u32x4*)(r_ + P_RQ); xqb = *(const u32x4*)(r_ + P_RQ + 64); xka = *(const u32x4*)(r_ + P_RK); xkb = *(const u32x4*)(r_ + P_RK + 64); \
        xva = *(const u32x4*)(r_ + P_RV); xvb = *(const u32x4*)(r_ + P_RV + 64); \
        const bf16_t* ps_ = (const bf16_t*)(ws + WS_RS) + (size_t)(uu) * 16384 + (F.tid >> 4) * 128 + (F.tid & 15) * 8; \
        xp0 = *(const u32x4*)ps_; xp1 = *(const u32x4*)(ps_ + 32 * 128); xp2 = *(const u32x4*)(ps_ + 64 * 128); xp3 = *(const u32x4*)(ps_ + 96 * 128); } while (0)
    if (F.blk < NU) RET_LOAD(F.blk);
    for (int u = F.blk; u < NU; u += F.G) {
        const int h = u & 3, n = (u >> 2) & 127, b = u >> 9; const int m0 = b * SEQ + n * 64;
        const float lg = ret_lg(h);
        u32x2 gw4[4];
        LBAR();
        {
            const float cs[8] = {xc0.x, xc0.y, xc0.z, xc0.w, xc1.x, xc1.y, xc1.z, xc1.w}, sn[8] = {xs0.x, xs0.y, xs0.z, xs0.w, xs1.x, xs1.y, xs1.z, xs1.w};
#pragma unroll
            for (int which = 0; which < 2; ++which) {
                const u32x4 a = which ? xka : xqa, bq = which ? xkb : xqb;
                const unsigned aw[4] = {a.x, a.y, a.z, a.w}, bw[4] = {bq.x, bq.y, bq.z, bq.w}; const float sc_ = which ? 0.08838834764831845f : 1.0f;
                float o1[8], o2[8];
#pragma unroll
                for (int i = 0; i < 8; ++i) { const float x1 = (i & 1) ? bfhi(aw[i >> 1]) : bflo(aw[i >> 1]), x2 = (i & 1) ? bfhi(bw[i >> 1]) : bflo(bw[i >> 1]); o1[i] = (x1 * cs[i] - x2 * sn[i]) * sc_; o2[i] = (x1 * sn[i] + x2 * cs[i]) * sc_; }
                LAS bf16_t* dst = (which ? k : q) + j * 136 + pc * 8;
                u32x4 w1, w2; w1.x = pk2(o1[0], o1[1]); w1.y = pk2(o1[2], o1[3]); w1.z = pk2(o1[4], o1[5]); w1.w = pk2(o1[6], o1[7]); w2.x = pk2(o2[0], o2[1]); w2.y = pk2(o2[2], o2[3]); w2.z = pk2(o2[4], o2[5]); w2.w = pk2(o2[6], o2[7]);
                *(LAS u32x4*)dst = w1; *(LAS u32x4*)(dst + 64) = w2; }
            const u32x4 va = xva, vb = xvb;
            const unsigned vaw[4] = {va.x, va.y, va.z, va.w}, vbw[4] = {vb.x, vb.y, vb.z, vb.w};
#pragma unroll
            for (int i = 0; i < 8; ++i) { vT[(pc * 8 + i) * 72 + j] = (bf16_t)((i & 1) ? (vaw[i >> 1] >> 16) : (vaw[i >> 1] & 0xffffu)); vT[(64 + pc * 8 + i) * 72 + j] = (bf16_t)((i & 1) ? (vbw[i >> 1] >> 16) : (vbw[i >> 1] & 0xffffu)); }
            { const int e0 = F.tid >> 4, c = F.tid & 15; *(LAS u32x4*)(pT + e0 * 136 + c * 8) = xp0; *(LAS u32x4*)(pT + (e0 + 32) * 136 + c * 8) = xp1; *(LAS u32x4*)(pT + (e0 + 64) * 136 + c * 8) = xp2; *(LAS u32x4*)(pT + (e0 + 96) * 136 + c * 8) = xp3; }
            { const int mrow_ = m0 + (F.wave & 3) * 16 + (F.lane & 15);
#pragma unroll
              for (int t = 0; t < 4; ++t) gw4[t] = *(const u32x2*)(p + (size_t)mrow_ * PW + P_RG + h * 128 + ((F.wave >> 2) * 4 + t) * 16 + 4 * (F.lane >> 4)); }
            { const int un = u + F.G < NU ? u + F.G : u; RET_LOAD(un); }
        }
        LBAR();
        {
            const int ib = F.wave & 3;
#pragma unroll
            for (int t = 0; t < 2; ++t) { const int jb = 2 * (F.wave >> 2) + t; f32x4 acc = {0.f, 0.f, 0.f, 0.f}; acc = mm_tile<4>(q, 136, k, 136, ib, jb, F.lane, acc);
                const int i = ib * 16 + (F.lane & 15), j0 = jb * 16 + 4 * (F.lane >> 4);
#pragma unroll
                for (int r = 0; r < 4; ++r) { const int dd = i - (j0 + r); acc[r] *= __expf(lg * (float)(dd < 0 ? -dd : dd)); }
                st_bf4(sc + i * 72 + j0, acc); }
        }
        LBAR();
        {
            const int ib = F.wave & 3, eh = F.wave >> 2; const int i = ib * 16 + (F.lane & 15);
            const float qd = __expf(lg * (float)(i + 1));
            f32x4 o[4]; float s1 = 0.f, s2 = 0.f;
#pragma unroll
            for (int t = 0; t < 4; ++t) { const int eb = eh * 4 + t; f32x4 ai = {0.f, 0.f, 0.f, 0.f}, ac = {0.f, 0.f, 0.f, 0.f};
                ai = mm_tile<2>(sc, 72, vT, 72, ib, eb, F.lane, ai); ac = mm_tile<4>(q, 136, pT, 136, ib, eb, F.lane, ac);
                o[t] = ai + ac * qd;
#pragma unroll
                for (int r = 0; r < 4; ++r) { s1 += o[t][r]; s2 += o[t][r] * o[t][r]; } }
            s1 += __shfl_xor(s1, 16); s1 += __shfl_xor(s1, 32); s2 += __shfl_xor(s2, 16); s2 += __shfl_xor(s2, 32);
            if (F.lane < 16) { st[(eh * 64 + i) * 2] = s1; st[(eh * 64 + i) * 2 + 1] = s2; }
            LBAR();
            const float t1 = st[i * 2] + st[(64 + i) * 2], t2 = st[i * 2 + 1] + st[(64 + i) * 2 + 1];
            const float mean = t1 * (1.0f / 128.0f), var = fmaxf(t2 * (1.0f / 128.0f) - mean * mean, 0.f), rstd = rsqrtf(var + 1e-5f);
            const int mrow = m0 + i;
#pragma unroll
            for (int t = 0; t < 4; ++t) { const int e = (eh * 4 + t) * 16 + 4 * (F.lane >> 4);
                const u32x2 gw = gw4[t]; const float g[4] = {bflo(gw.x), bfhi(gw.x), bflo(gw.y), bfhi(gw.y)};
                float y[4];
#pragma unroll
                for (int r = 0; r < 4; ++r) y[r] = (o[t][r] - mean) * rstd * (g[r] * sigmoidf_(g[r]));
                u32x2 w; w.x = pk2(y[0], y[1]); w.y = pk2(y[2], y[3]); *(u32x2*)((bf16_t*)(ws + WS_YRET) + (size_t)mrow * 512 + h * 128 + e) = w; }
        }
    }
    __syncthreads();
#undef RET_LOAD
}

constexpr int ATT_KP = 104, ATT_VP = 72;
constexpr int ATT_KB = 64 * ATT_KP * 2, ATT_VB = 64 * ATT_VP * 2;
constexpr int ATT_K0 = 0, ATT_V0 = 2 * ATT_KB;
__device__ __forceinline__ void attn_unit(const Frame& F, int b, int h, int qt) {
    unsigned char* ws = F.ws;
    const bf16_t* Qg = (const bf16_t*)(ws + WS_Q); const bf16_t* Kn = (const bf16_t*)(ws + WS_KN); const bf16_t* Kp = (const bf16_t*)(ws + WS_KPE); const bf16_t* Vt = (const bf16_t*)(ws + WS_VT);
    const int lane = F.lane, w = F.wave, ql = lane & 31, hf = lane >> 5;
    const int mq = b * SEQ + qt * 256 + w * 32 + ql;
    const float qs = 0.10206207261596577f * 1.4426950408889634f;
    bf16x8 qf[6];
    {
        const bf16_t* qr = Qg + (size_t)mq * 768 + h * 96;
#pragma unroll
        for (int s = 0; s < 4; ++s) { const u32x4 x = *(const u32x4*)(qr + 16 * s + 8 * hf); const unsigned xw[4] = {x.x, x.y, x.z, x.w}; u32x4 o; unsigned ow[4];
#pragma unroll
            for (int i = 0; i < 4; ++i) ow[i] = pk2(bflo(xw[i]) * qs, bfhi(xw[i]) * qs);
            o.x = ow[0]; o.y = ow[1]; o.z = ow[2]; o.w = ow[3]; qf[s] = __builtin_bit_cast(bf16x8, o); }
        const u32x4 x1 = *(const u32x4*)(qr + 64 + 8 * hf), x2 = *(const u32x4*)(qr + 80 + 8 * hf);
        const float* cp = (const float*)(ws + WS_COSM) + (size_t)mq * 16 + 8 * hf; const float* sp = (const float*)(ws + WS_SINM) + (size_t)mq * 16 + 8 * hf;
        const unsigned a[4] = {x1.x, x1.y, x1.z, x1.w}, c[4] = {x2.x, x2.y, x2.z, x2.w}; unsigned o1[4], o2[4];
#pragma unroll
        for (int i = 0; i < 4; ++i) { const float u0 = bflo(a[i]), u1 = bfhi(a[i]), v0 = bflo(c[i]), v1 = bfhi(c[i]); const float c0 = cp[2 * i], c1 = cp[2 * i + 1], s0 = sp[2 * i], s1 = sp[2 * i + 1];
            o1[i] = pk2((u0 * c0 - v0 * s0) * qs, (u1 * c1 - v1 * s1) * qs); o2[i] = pk2((u0 * s0 + v0 * c0) * qs, (u1 * s1 + v1 * c1) * qs); }
        u32x4 t1, t2; t1.x = o1[0]; t1.y = o1[1]; t1.z = o1[2]; t1.w = o1[3]; t2.x = o2[0]; t2.y = o2[1]; t2.z = o2[2]; t2.w = o2[3];
        qf[4] = __builtin_bit_cast(bf16x8, t1); qf[5] = __builtin_bit_cast(bf16x8, t2);
    }
    f32x16 oacc[2];
#pragma unroll
    for (int i = 0; i < 16; ++i) { oacc[0][i] = 0.f; oacc[1][i] = 0.f; }
    float mrun = 0.f; f32x2 lsum = {0.f, 0.f};
    const int nkt = 4 * qt + 4, mylim = 4 * qt + (w >> 1);
    const int half = w >> 2;
    const int kkey = F.tid >> 3, kpc = F.tid & 7, rkey = (F.tid & 255) >> 2, rpc = F.tid & 3, ve = F.tid >> 3, vpc = F.tid & 7;
    const bf16_t* knp = Kn + (size_t)(b * SEQ + kkey) * 512 + h * 64 + kpc * 8;
    const bf16_t* kpp = Kp + (size_t)(b * SEQ + rkey) * 32 + rpc * 8;
    const bf16_t* vtp = Vt + (size_t)(h * 64 + ve) * MTOK + b * SEQ + vpc * 8;
    const int kofs = (kkey * ATT_KP + kpc * 8) * 2, rofs = (rkey * ATT_KP + 64 + rpc * 8) * 2, vofs = (ve * ATT_VP + vpc * 8) * 2;
    constexpr bool rp = true;
#define ATT_QK(sv, kbuf, init) do { _Pragma("unroll") for (int t_ = 0; t_ < 2; ++t_) { _Pragma("unroll") for (int i_ = 0; i_ < 16; ++i_) sv[t_][i_] = (init); } \
        const LAS bf16_t* kr_ = (kbuf) + ql * ATT_KP + 8 * hf; bf16x8 ka_ = *(const LAS bf16x8*)kr_, kb_ = *(const LAS bf16x8*)(kr_ + 32 * ATT_KP); \
        _Pragma("unroll") for (int st_ = 0; st_ < 6; ++st_) { bf16x8 na_ = ka_, nb_ = kb_; \
            if (st_ < 5) { na_ = *(const LAS bf16x8*)(kr_ + 16 * (st_ + 1)); nb_ = *(const LAS bf16x8*)(kr_ + 32 * ATT_KP + 16 * (st_ + 1)); } \
            sv[0] = __builtin_amdgcn_mfma_f32_32x32x16_bf16(ka_, qf[st_], sv[0], 0, 0, 0); sv[1] = __builtin_amdgcn_mfma_f32_32x32x16_bf16(kb_, qf[st_], sv[1], 0, 0, 0); \
            ka_ = na_; kb_ = nb_; __builtin_amdgcn_sched_barrier(0); } } while (0)
    u32x4 ak, ar, av, bk, br, bv;
#define ATT_LOAD(K_, R_, V_, t_) do { const int tt_ = (t_) < nkt ? (t_) : nkt - 1; \
        K_ = *(const u32x4*)(knp + (size_t)tt_ * 64 * 512); R_ = *(const u32x4*)(kpp + (size_t)tt_ * 64 * 32); V_ = *(const u32x4*)(vtp + (size_t)tt_ * 64); } while (0)
#define ATT_STAGE(K_, R_, V_, kt_) do { { LAS unsigned char* kb2_ = F.lds + ATT_K0 + (((kt_) + 1) & 1) * ATT_KB; *(LAS u32x4*)(kb2_ + kofs) = K_; *(LAS u32x4*)(kb2_ + rofs) = R_; } \
        *(LAS u32x4*)(F.lds + ATT_V0 + (((kt_) + 1) & 1) * ATT_VB + vofs) = V_; ATT_LOAD(K_, R_, V_, (kt_) + 3); } while (0)
    __syncthreads();
    {
        ak = *(const u32x4*)knp; ar = *(const u32x4*)kpp; av = *(const u32x4*)vtp;
        *(LAS u32x4*)(F.lds + ATT_K0 + kofs) = ak; *(LAS u32x4*)(F.lds + ATT_K0 + rofs) = ar; *(LAS u32x4*)(F.lds + ATT_V0 + vofs) = av;
        ATT_LOAD(ak, ar, av, 1); ATT_LOAD(bk, br, bv, 2);
    }
    __syncthreads();
    f32x16 sc[2];
    if (half == 1) LBAR();
#define ATT_SEG1(kt_, ALL) do { if ((ALL) || (kt_) <= mylim) ATT_QK(sc, (const LAS bf16_t*)(F.lds + ATT_K0 + ((kt_) & 1) * ATT_KB), -mrun); } while (0)
#define ATT_SEG2(kt_, ALL) do { if ((ALL) || (kt_) <= mylim) { \
            const LAS bf16_t* vb = (const LAS bf16_t*)(F.lds + ATT_V0 + ((kt_) & 1) * ATT_VB); \
            int mi = __builtin_bit_cast(int, sc[0][0]); \
            _Pragma("unroll") for (int i = 0; i < 16; ++i) { const int a_ = __builtin_bit_cast(int, sc[0][i]), b_ = __builtin_bit_cast(int, sc[1][i]); mi = max(max(mi, a_), b_); } \
            if ((kt_) == 0 || __builtin_amdgcn_ballot_w64(__builtin_bit_cast(float, mi) > 8.0f) != 0ull) { \
                float mx = fmaxf(sc[0][0], sc[1][0]); \
                _Pragma("unroll") for (int i = 1; i < 16; ++i) mx = fmaxf(mx, fmaxf(sc[0][i], sc[1][i])); \
                { const int mb = __builtin_bit_cast(int, mx); const auto sw2 = __builtin_amdgcn_permlane32_swap(mb, mb, false, false); mx = fmaxf(__builtin_bit_cast(float, (int)sw2[0]), __builtin_bit_cast(float, (int)sw2[1])); } \
                const float delta = ((kt_) == 0) ? mx : fmaxf(mx, 0.f); \
                const float alpha = ((kt_) == 0) ? 1.0f : __builtin_amdgcn_exp2f(-delta); mrun += delta; lsum *= alpha; \
                _Pragma("unroll") for (int i = 0; i < 16; ++i) { oacc[0][i] *= alpha; oacc[1][i] *= alpha; sc[0][i] -= delta; sc[1][i] -= delta; } } \
            _Pragma("unroll") for (int t = 0; t < 2; ++t) _Pragma("unroll") for (int i = 0; i < 16; i += 2) { const float p0 = __builtin_amdgcn_exp2f(sc[t][i]), p1 = __builtin_amdgcn_exp2f(sc[t][i + 1]); sc[t][i] = p0; sc[t][i + 1] = p1; lsum += (f32x2){p0, p1}; } \
            _Pragma("unroll") for (int t = 0; t < 2; ++t) _Pragma("unroll") for (int kbb = 0; kbb < 2; ++kbb) { \
                    u32x4 pw; pw.x = pk2(sc[t][8 * kbb + 0], sc[t][8 * kbb + 1]); pw.y = pk2(sc[t][8 * kbb + 2], sc[t][8 * kbb + 3]); pw.z = pk2(sc[t][8 * kbb + 4], sc[t][8 * kbb + 5]); pw.w = pk2(sc[t][8 * kbb + 6], sc[t][8 * kbb + 7]); \
                    const bf16x8 pf = __builtin_bit_cast(bf16x8, pw); const int key0 = t * 32 + kbb * 16 + 4 * hf; \
                    _Pragma("unroll") for (int eb = 0; eb < 2; ++eb) { const LAS bf16_t* vr = vb + (eb * 32 + ql) * ATT_VP + key0; \
                        const u32x2 lo = *(const LAS u32x2*)vr, hi = *(const LAS u32x2*)(vr + 8); u32x4 vv; vv.x = lo.x; vv.y = lo.y; vv.z = hi.x; vv.w = hi.y; \
                        oacc[eb] = __builtin_amdgcn_mfma_f32_32x32x16_bf16(__builtin_bit_cast(bf16x8, vv), pf, oacc[eb], 0, 0, 0); } } } } while (0)
    const int nall = 4 * qt;
#define ATT_TRIP_L(kt_, ALL) do { ATT_SEG1(kt_, ALL); LBAR(); ATT_STAGE(ak, ar, av, kt_); ATT_SEG2(kt_, ALL); LBAR(); \
                                  ATT_SEG1((kt_) + 1, ALL); LBAR(); ATT_STAGE(bk, br, bv, (kt_) + 1); ATT_SEG2((kt_) + 1, ALL); LBAR(); } while (0)
#define ATT_TRIP_T(kt_, ALL) do { ATT_STAGE(ak, ar, av, kt_); ATT_SEG1(kt_, ALL); LBAR(); ATT_SEG2(kt_, ALL); LBAR(); \
                                  ATT_STAGE(bk, br, bv, (kt_) + 1); ATT_SEG1((kt_) + 1, ALL); LBAR(); ATT_SEG2((kt_) + 1, ALL); LBAR(); } while (0)
    if (half == 0) {
#pragma unroll 1
        for (int kt = 0; kt < nall; kt += 2) ATT_TRIP_L(kt, true);
#pragma unroll 1
        for (int kt = nall; kt < nkt; kt += 2) ATT_TRIP_L(kt, false);
        LBAR();
    } else {
#pragma unroll 1
        for (int kt = 0; kt < nall; kt += 2) ATT_TRIP_T(kt, true);
#pragma unroll 1
        for (int kt = nall; kt < nkt; kt += 2) ATT_TRIP_T(kt, false);
    }
#undef ATT_TRIP_L
#undef ATT_TRIP_T
#undef ATT_QK
#undef ATT_LOAD
#undef ATT_STAGE
#undef ATT_SEG1
#undef ATT_SEG2
    float lrun = lsum[0] + lsum[1];
    const float lt = lrun + __shfl_xor(lrun, 32), inv = 1.0f / lt;
    bf16_t* yo = (bf16_t*)(ws + WS_YMLA) + (size_t)mq * 512 + h * 64;
#pragma unroll
    for (int eb = 0; eb < 2; ++eb)
#pragma unroll
        for (int g = 0; g < 4; ++g) { u32x2 wv; wv.x = pk2(oacc[eb][4 * g] * inv, oacc[eb][4 * g + 1] * inv); wv.y = pk2(oacc[eb][4 * g + 2] * inv, oacc[eb][4 * g + 3] * inv);
            *(u32x2*)(yo + eb * 32 + 8 * g + 4 * hf) = wv; }
}
constexpr int RP = 72;
constexpr int RMAT = 64 * RP;
constexpr size_t RC_UNIT = 40960;
constexpr size_t WS_RC2 = WS_RC + (size_t)2048 * RC_UNIT;

__device__ __forceinline__ void st_g4(bf16_t* p, f32x4 v) { u32x2 w; w.x = pk2(v[0], v[1]); w.y = pk2(v[2], v[3]); *(u32x2*)p = w; }
__device__ __forceinline__ f32x4 ld_l4(const LAS bf16_t* p) { const u32x2 w = *(const LAS u32x2*)p; return (f32x4){bflo(w.x), bfhi(w.x), bflo(w.y), bfhi(w.y)}; }

template <int KS>
__device__ __forceinline__ f32x16 mm32(const LAS bf16_t* P, const LAS bf16_t* Q, int ib, int jb, int lane, f32x16 acc) {
    const LAS bf16_t* pp = P + (ib * 32 + (lane & 31)) * RP + 8 * (lane >> 5);
    const LAS bf16_t* qp = Q + (jb * 32 + (lane & 31)) * RP + 8 * (lane >> 5);
#pragma unroll
    for (int ks = 0; ks < KS; ++ks) { const bf16x8 a = *(const LAS bf16x8*)(qp + ks * 16), b = *(const LAS bf16x8*)(pp + ks * 16); acc = __builtin_amdgcn_mfma_f32_32x32x16_bf16(a, b, acc, 0, 0, 0); }
    return acc;
}
__device__ __forceinline__ f32x16 zero16() { f32x16 z; for (int i = 0; i < 16; ++i) z[i] = 0.f; return z; }
__device__ __forceinline__ void st32_lds(LAS bf16_t* O, int ib, int jb, int lane, const f32x16& a) {
    LAS bf16_t* o = O + (ib * 32 + (lane & 31)) * RP + jb * 32 + 4 * (lane >> 5);
#pragma unroll
    for (int g = 0; g < 4; ++g) st_bf4(o + 8 * g, (f32x4){a[4 * g], a[4 * g + 1], a[4 * g + 2], a[4 * g + 3]});
}
__device__ __forceinline__ void st32_glb(bf16_t* O, int ib, int jb, int lane, const f32x16& a) {
    bf16_t* o = O + (ib * 32 + (lane & 31)) * 64 + jb * 32 + 4 * (lane >> 5);
#pragma unroll
    for (int g = 0; g < 4; ++g) st_g4(o + 8 * g, (f32x4){a[4 * g], a[4 * g + 1], a[4 * g + 2], a[4 * g + 3]});
}
struct PreIn { unsigned short r[8], rp[8], k[8], kp[8], v[8], vp[8], lw[8], a[8]; };
__device__ __forceinline__ void pre_load(PreIn& x, const bf16_t* p, const bf16_t* lo, int u, int w, int lane) {
    const int c = u & 127, h = (u >> 7) & 7, b = u >> 10; const int m0 = b * SEQ + c * 64, ch = h * 64 + lane;
#pragma unroll
    for (int i = 0; i < 8; ++i) { const int t = 8 * w + i, m = m0 + t; const bf16_t* pr = p + (size_t)m * PW + P_RW + ch; const bool hp = (c | t) != 0;
        x.r[i] = pr[0]; x.k[i] = pr[512]; x.v[i] = pr[1024];
        x.rp[i] = hp ? pr[-PW] : (unsigned short)0; x.kp[i] = hp ? pr[512 - PW] : (unsigned short)0; x.vp[i] = hp ? pr[1024 - PW] : (unsigned short)0;
        x.lw[i] = lo[(size_t)m * LO_W + ch]; x.a[i] = lo[(size_t)m * LO_W + 512 + ch]; }
}
#ifdef PRE_T
#define PRE_MARK(k) do { if (F.tid == 0) { volatile LAS unsigned long long* tq_ = (volatile LAS unsigned long long*)(F.lds + LDSCTL_OFF + 48); const unsigned long long now_ = __builtin_amdgcn_s_memrealtime(); \
        if ((k) == PRE_T) tq_[1] += now_ - tq_[2]; tq_[2] = now_; } } while (0)
#else
#define PRE_MARK(k) do { } while (0)
#endif
template <int DIAG = 0>
__device__ __forceinline__ void rwkv_chunk_pre(const Frame& F, const float* mu, const float* k_k_, const float* k_a_, const float* r_k_) {
    unsigned char* ws = F.ws; const bf16_t* p = (const bf16_t*)(ws + WS_P); const bf16_t* lo = (const bf16_t*)(ws + WS_LO);
    LAS bf16_t* M = (LAS bf16_t*)F.lds;
    LAS bf16_t *KKt = M, *Bt = M + RMAT, *Kt = M + 2 * RMAT, *Rt = M + 3 * RMAT, *KKtT = M + 4 * RMAT, *BhT = M + 5 * RMAT, *KhT = M + 6 * RMAT, *VcT = M + 7 * RMAT;
    LAS bf16_t *NA = M + 8 * RMAT, *NAT = M + 9 * RMAT, *TT = M + 10 * RMAT, *AkkT = M + 11 * RMAT, *AbrT = M + 12 * RMAT, *AkrT = M + 13 * RMAT;
    LAS float* SEG = (LAS float*)(M + 10 * RMAT);
    const int lane = F.lane, w = F.wave, pr_ = w >> 1, ib = w & 1;
    const int i0 = ib * 32 + (lane & 31), jq = 4 * (lane >> 5);
    PreIn cur;
    if (F.blk < NB * 8 * NCHUNK) pre_load(cur, p, lo, F.blk, w, lane);
    for (int u = F.blk; u < NB * 8 * NCHUNK; u += F.G) {
        const int h = (u >> 7) & 7; const int ch = h * 64 + lane;
        const float mu_r = mu[ch], mu_k = mu[512 + ch], mu_v = mu[1024 + ch], k_k = k_k_[ch], k_a = k_a_[ch], r_k = r_k_[ch];
        float* aux = DIAG ? (float*)(ws + WS_YMLA) + (size_t)(u & 255) * 128 : (float*)(ws + WS_RC2) + (size_t)u * 128;
        LBAR();
        PRE_MARK(0);
        if (DIAG != 2) {
        float rr[8], kk8[8], k28[8], vv[8], bb[8], lw8[8], cs8[8]; float cs = 0.f;
#pragma unroll
        for (int i = 0; i < 8; ++i) { const int t = 8 * w + i;
            const float xr = bf2f(cur.r[i]), xk = bf2f(cur.k[i]), xv = bf2f(cur.v[i]);
            const float r = xr + (bf2f(cur.rp[i]) - xr) * mu_r, k = xk + (bf2f(cur.kp[i]) - xk) * mu_k, v = xv + (bf2f(cur.vp[i]) - xv) * mu_v;
            const float lw = bf2f(cur.lw[i]), a = bf2f(cur.a[i]);
            float kk = k * k_k; const float ss = wave_sum(kk * kk); kk *= rsqrtf(ss + 1e-12f);
            const float k2 = k * (1.0f + (a - 1.0f) * k_a);
            rr[i] = r; kk8[i] = kk; k28[i] = k2; vv[i] = v; bb[i] = kk * a; lw8[i] = lw; cs += lw; cs8[i] = cs;
            (DIAG ? (bf16_t*)(ws + WS_YRW) + (size_t)(u & 255) * 4096 : (bf16_t*)(ws + WS_RC + (size_t)u * RC_UNIT) + 16384)[t * 64 + lane] = (bf16_t)f2bf(v);
            const float bon = wave_sum(r * k2 * r_k); if (lane == 0) aux[64 + t] = bon; }
        SEG[w * 64 + lane] = cs;
        if (u + F.G < NB * 8 * NCHUNK) pre_load(cur, p, lo, u + F.G, w, lane);
        LBAR();
        float off = 0.f, cumC = 0.f;
#pragma unroll
        for (int s = 0; s < 8; ++s) { const float sv = SEG[s * 64 + lane]; cumC += sv; off += (s < w) ? sv : 0.f; }
        if (w == 0) aux[lane] = __expf(cumC);
        LBAR();
        unsigned pkk[4], pbh[4], pkh[4], pvc[4];
#pragma unroll
        for (int i = 0; i < 8; i += 2) { float o_kk[2], o_bh[2], o_kh[2];
#pragma unroll
            for (int e = 0; e < 2; ++e) { const int t = 8 * w + i + e; const float cum = cs8[i + e] + off;
                const float om = __expf(cum), omx = __expf(cum - lw8[i + e]), iom = __expf(-cum), ih = __expf(cumC - cum);
                o_kk[e] = kk8[i + e] * omx; o_bh[e] = bb[i + e] * ih; o_kh[e] = k28[i + e] * ih;
                KKt[t * RP + lane] = (bf16_t)f2bf(o_kk[e]); Bt[t * RP + lane] = (bf16_t)f2bf(bb[i + e] * iom); Kt[t * RP + lane] = (bf16_t)f2bf(k28[i + e] * iom); Rt[t * RP + lane] = (bf16_t)f2bf(rr[i + e] * om); }
            pkk[i >> 1] = pk2(o_kk[0], o_kk[1]); pbh[i >> 1] = pk2(o_bh[0], o_bh[1]); pkh[i >> 1] = pk2(o_kh[0], o_kh[1]); pvc[i >> 1] = pk2(vv[i], vv[i + 1]); }
        *(LAS u32x4*)(KKtT + lane * RP + 8 * w) = (u32x4){pkk[0], pkk[1], pkk[2], pkk[3]}; *(LAS u32x4*)(BhT + lane * RP + 8 * w) = (u32x4){pbh[0], pbh[1], pbh[2], pbh[3]};
        *(LAS u32x4*)(KhT + lane * RP + 8 * w) = (u32x4){pkh[0], pkh[1], pkh[2], pkh[3]}; *(LAS u32x4*)(VcT + lane * RP + 8 * w) = (u32x4){pvc[0], pvc[1], pvc[2], pvc[3]};
        }
        LBAR();
        PRE_MARK(1);
        if (DIAG != 1) {
        {
            const LAS bf16_t* Pm = pr_ < 2 ? KKt : Rt; const LAS bf16_t* Qm = (pr_ == 0 || pr_ == 2) ? Bt : Kt; LAS bf16_t* Om = pr_ == 0 ? NAT : (pr_ == 1 ? AkkT : (pr_ == 2 ? AbrT : AkrT));
            const bool incl = pr_ >= 2; const float sgn = pr_ == 0 ? -1.0f : 1.0f;
#pragma unroll
            for (int jb = 0; jb < 2; ++jb) { f32x16 a = zero16(); if (jb <= ib) a = mm32<4>(Pm, Qm, ib, jb, lane, a);
#pragma unroll
                for (int g = 0; g < 4; ++g)
#pragma unroll
                    for (int r = 0; r < 4; ++r) { const int jj = jb * 32 + 8 * g + jq + r; const bool keep = incl ? (jj <= i0) : (jj < i0); a[4 * g + r] = keep ? sgn * a[4 * g + r] : 0.f; }
                st32_lds(Om, ib, jb, lane, a);
                if (pr_ == 0) {
#pragma unroll
                    for (int g = 0; g < 4; ++g)
#pragma unroll
                        for (int r = 0; r < 4; ++r) { const int jj = jb * 32 + 8 * g + jq + r; a[4 * g + r] += (jj == i0) ? 1.0f : 0.f; }
                    st32_lds(TT, ib, jb, lane, a); } }
            if (pr_ == 0) {
#pragma unroll
                for (int jb = 0; jb < 2; ++jb) { f32x16 a = zero16(); if (jb >= ib) a = mm32<4>(Bt, KKt, ib, jb, lane, a);
#pragma unroll
                    for (int g = 0; g < 4; ++g)
#pragma unroll
                        for (int r = 0; r < 4; ++r) { const int jj = jb * 32 + 8 * g + jq + r; a[4 * g + r] = (i0 < jj) ? -a[4 * g + r] : 0.f; }
                    st32_lds(NA, ib, jb, lane, a); } }
        }
        LBAR();
        PRE_MARK(2);
        LAS bf16_t* VA = Kt;
#pragma unroll 1
        for (int s = 1; s <= 6; ++s) {
            const LAS bf16_t* Yo = (s & 1) ? NAT : KKt; const LAS bf16_t* YoT = (s & 1) ? NA : Bt; LAS bf16_t* Yn = (s & 1) ? KKt : NAT; LAS bf16_t* YnT = (s & 1) ? Bt : NA;
            if (pr_ == 0) {
                if (s == 1) { const f32x16 a0 = mm32<4>(VcT, AkkT, ib, 0, lane, zero16()), a1 = mm32<4>(VcT, AkkT, ib, 1, lane, zero16()); st32_lds(VA, ib, 0, lane, a0); st32_lds(VA, ib, 1, lane, a1); }
                else {
                    f32x16 c0, c1; const LAS bf16_t* tr = TT + i0 * RP + jq;
#pragma unroll
                    for (int g = 0; g < 4; ++g) { const f32x4 x0 = ld_l4(tr + 8 * g), x1 = ld_l4(tr + 32 + 8 * g);
#pragma unroll
                        for (int r = 0; r < 4; ++r) { c0[4 * g + r] = x0[r]; c1[4 * g + r] = x1[r]; } }
                    c0 = mm32<4>(TT, YoT, ib, 0, lane, c0); c1 = mm32<4>(TT, YoT, ib, 1, lane, c1);
                    LDS_WAIT();
                    st32_lds(TT, ib, 0, lane, c0); st32_lds(TT, ib, 1, lane, c1); }
            } else if (pr_ <= 2 && s <= 5) {
                const LAS bf16_t* Pm = pr_ == 1 ? Yo : YoT; const LAS bf16_t* Qm = pr_ == 1 ? YoT : Yo; LAS bf16_t* Om = pr_ == 1 ? Yn : YnT;
                const f32x16 a0 = mm32<4>(Pm, Qm, ib, 0, lane, zero16()), a1 = mm32<4>(Pm, Qm, ib, 1, lane, zero16()); st32_lds(Om, ib, 0, lane, a0); st32_lds(Om, ib, 1, lane, a1);
            }
            LBAR();
        }
        PRE_MARK(3);
        LAS bf16_t* KT = NAT; LAS bf16_t* P1 = NA;
        if (pr_ < 2) { const LAS bf16_t* src = pr_ == 0 ? KKtT : VA; LAS bf16_t* dst = pr_ == 0 ? KT : P1;
            const f32x16 a0 = mm32<4>(src, TT, ib, 0, lane, zero16()), a1 = mm32<4>(src, TT, ib, 1, lane, zero16()); st32_lds(dst, ib, 0, lane, a0); st32_lds(dst, ib, 1, lane, a1); }
        LBAR();
        {
            bf16_t* og = DIAG ? (bf16_t*)(ws + WS_YRW) + (size_t)(u & 255) * 4096 : (bf16_t*)(ws + WS_RC + (size_t)u * RC_UNIT) + pr_ * 4096;
#pragma unroll
            for (int jb = 0; jb < 2; ++jb) { f32x16 o;
                if (pr_ == 0) o = mm32<4>(BhT, KT, ib, jb, lane, zero16());
                else if (pr_ == 1) { const f32x16 x = mm32<4>(VcT, KhT, ib, jb, lane, zero16()), y = mm32<4>(P1, BhT, ib, jb, lane, zero16()); o = x - y; }
                else if (pr_ == 2) { const f32x16 y = mm32<4>(AbrT, KT, ib, jb, lane, zero16()); const LAS bf16_t* rt = Rt + i0 * RP + jb * 32 + jq;
#pragma unroll
                    for (int g = 0; g < 4; ++g) { const f32x4 x = ld_l4(rt + 8 * g);
#pragma unroll
                        for (int r = 0; r < 4; ++r) o[4 * g + r] = x[r] - y[4 * g + r]; } }
                else { const f32x16 x = mm32<4>(VcT, AkrT, ib, jb, lane, zero16()), y = mm32<4>(P1, AbrT, ib, jb, lane, zero16()); o = x - y; }
                st32_glb(og, ib, jb, lane, o); }
        }
        }
        PRE_MARK(4);
    }
    __syncthreads();
}

struct ScanOps { u32x4 fa0, fa1; u32x2 ad0, ad1; f32x4 om; };
__device__ __forceinline__ ScanOps scan_load(const unsigned char* ws, size_t u, int sk, int vh, int l15, int l4) {
    ScanOps o; const bf16_t* base = (const bf16_t*)(ws + WS_RC + u * RC_UNIT);
    o.fa0 = *(const u32x4*)(base + (sk * 16 + l15) * 64 + 8 * l4); o.fa1 = *(const u32x4*)(base + (sk * 16 + l15) * 64 + 32 + 8 * l4);
    o.ad0 = *(const u32x2*)(base + 4096 + ((2 * vh) * 16 + l15) * 64 + sk * 16 + 4 * l4); o.ad1 = *(const u32x2*)(base + 4096 + ((2 * vh + 1) * 16 + l15) * 64 + sk * 16 + 4 * l4);
    o.om = *(const f32x4*)((const float*)(ws + WS_RC2) + u * 128 + sk * 16 + 4 * l4); return o;
}
template <bool STORE>
__device__ __forceinline__ void rwkv_scan(const Frame& F, int b, int h) {
    unsigned char* ws = F.ws;
    LAS bf16_t* Sb = (LAS bf16_t*)F.lds;
    const int lane = F.lane, w = F.wave, l15 = lane & 15, l4 = lane >> 4, sk = w & 3, vh = w >> 2;
    for (int i = F.tid; i < 2 * RMAT / 2; i += NTHR) ((LAS unsigned*)Sb)[i] = 0u;
    const size_t u0 = (size_t)(b * 8 + h) * 128;
    f32x4 st0 = {0.f, 0.f, 0.f, 0.f}, st1 = {0.f, 0.f, 0.f, 0.f};
    ScanOps r0 = scan_load(ws, u0 + 0, sk, vh, l15, l4), r1 = scan_load(ws, u0 + 1, sk, vh, l15, l4), r2 = scan_load(ws, u0 + 2, sk, vh, l15, l4), r3 = scan_load(ws, u0 + 3, sk, vh, l15, l4);
    __syncthreads();
#define SCAN_STEP(R, cc) do { const int c_ = (cc); \
        const LAS bf16_t* Sc = Sb + (c_ & 1) * RMAT; LAS bf16_t* Sn = Sb + ((c_ + 1) & 1) * RMAT; \
        const bf16x8 a0 = __builtin_bit_cast(bf16x8, R.fa0), a1 = __builtin_bit_cast(bf16x8, R.fa1); \
        const LAS bf16_t* sp0 = Sc + ((2 * vh) * 16 + l15) * RP + 8 * l4; const LAS bf16_t* sp1 = sp0 + 16 * RP; \
        const bf16x8 s00 = *(const LAS bf16x8*)sp0, s01 = *(const LAS bf16x8*)(sp0 + 32), s10 = *(const LAS bf16x8*)sp1, s11 = *(const LAS bf16x8*)(sp1 + 32); \
        bf16_t* sg = (bf16_t*)(ws + WS_RC + (u0 + c_ - 1) * RC_UNIT) + 4096;     \
        if (STORE && c_ > 0) *(u32x4*)(sg + (F.tid >> 3) * 64 + (F.tid & 7) * 8) = *(const LAS u32x4*)(Sc + (F.tid >> 3) * RP + (F.tid & 7) * 8);     \
        f32x4 t0 = {0.f, 0.f, 0.f, 0.f}, t1 = {0.f, 0.f, 0.f, 0.f}; \
        t0 = __builtin_amdgcn_mfma_f32_16x16x32_bf16(a0, s00, t0, 0, 0, 0); t1 = __builtin_amdgcn_mfma_f32_16x16x32_bf16(a0, s10, t1, 0, 0, 0); \
        t0 = __builtin_amdgcn_mfma_f32_16x16x32_bf16(a1, s01, t0, 0, 0, 0); t1 = __builtin_amdgcn_mfma_f32_16x16x32_bf16(a1, s11, t1, 0, 0, 0); \
        const f32x4 n0 = {bflo(R.ad0.x), bfhi(R.ad0.x), bflo(R.ad0.y), bfhi(R.ad0.y)}, n1 = {bflo(R.ad1.x), bfhi(R.ad1.x), bflo(R.ad1.y), bfhi(R.ad1.y)}; \
        st0 = st0 * R.om - t0 + n0; st1 = st1 * R.om - t1 + n1; \
        st_bf4(Sn + ((2 * vh) * 16 + l15) * RP + sk * 16 + 4 * l4, st0); st_bf4(Sn + ((2 * vh + 1) * 16 + l15) * RP + sk * 16 + 4 * l4, st1); \
        R = scan_load(ws, u0 + (c_ + 4 < NCHUNK ? c_ + 4 : NCHUNK - 1), sk, vh, l15, l4);     \
        LBAR(); } while (0)
#pragma unroll 1
    for (int c = 0; c < NCHUNK; c += 16) {
#pragma unroll
        for (int j = 0; j < 16; j += 4) { SCAN_STEP(r0, c + j); SCAN_STEP(r1, c + j + 1); SCAN_STEP(r2, c + j + 2); SCAN_STEP(r3, c + j + 3); } }
#undef SCAN_STEP
}

struct OutOps { bf16x8 q0, q1, s00, s01, s10, s11; u32x2 z0, z1; u32x4 cv, cg; float cbc; };
__device__ __forceinline__ OutOps out_load(const unsigned char* ws, int u, int tb, int vh, int l15, int l4, int tt, int c8) {
    OutOps o; const int c = u & 127, h = (u >> 7) & 7, b = u >> 10;
    const bf16_t* base = (const bf16_t*)(ws + WS_RC + (size_t)u * RC_UNIT);
    const bf16_t* Sg = (const bf16_t*)(ws + WS_RC + (size_t)(u > 0 ? u - 1 : 0) * RC_UNIT) + 4096; const bf16_t* QT = base + 8192; const bf16_t* Z = base + 12288;
    o.q0 = *(const bf16x8*)(QT + (tb * 16 + l15) * 64 + 8 * l4); o.q1 = *(const bf16x8*)(QT + (tb * 16 + l15) * 64 + 32 + 8 * l4);
    const bf16_t* sp0 = Sg + ((2 * vh) * 16 + l15) * 64 + 8 * l4; const bf16_t* sp1 = sp0 + 16 * 64;
    o.s00 = *(const bf16x8*)sp0; o.s01 = *(const bf16x8*)(sp0 + 32); o.s10 = *(const bf16x8*)sp1; o.s11 = *(const bf16x8*)(sp1 + 32);
    o.z0 = *(const u32x2*)(Z + ((2 * vh) * 16 + l15) * 64 + tb * 16 + 4 * l4); o.z1 = *(const u32x2*)(Z + ((2 * vh + 1) * 16 + l15) * 64 + tb * 16 + 4 * l4);
    const int m = b * SEQ + c * 64 + tt, chq = h * 64 + c8;
    o.cv = *(const u32x4*)(base + 16384 + tt * 64 + c8); o.cg = *(const u32x4*)((const bf16_t*)(ws + WS_LO) + (size_t)m * LO_W + 1024 + chq);
    o.cbc = ((const float*)(ws + WS_RC2))[(size_t)u * 128 + 64 + tt]; return o;
}
__device__ __forceinline__ void rwkv_out(const Frame& F, const float* lnx_) {
    unsigned char* ws = F.ws;
    LAS float* Yl = (LAS float*)F.lds;
    const int lane = F.lane, w = F.wave, l15 = lane & 15, l4 = lane >> 4, tb = w & 3, vh = w >> 2;
    const int tt = F.tid >> 3, c8 = (F.tid & 7) * 8;
    OutOps cur = out_load(ws, F.blk, tb, vh, l15, l4, tt, c8);
    for (int u = F.blk; u < NB * 8 * NCHUNK; u += F.G) {
        const int c = u & 127, h = (u >> 7) & 7, b = u >> 10;
        const OutOps o = cur;
        { const int un = u + F.G < NB * 8 * NCHUNK ? u + F.G : u; cur = out_load(ws, un, tb, vh, l15, l4, tt, c8); }
        f32x4 y0 = {bflo(o.z0.x), bfhi(o.z0.x), bflo(o.z0.y), bfhi(o.z0.y)}, y1 = {bflo(o.z1.x), bfhi(o.z1.x), bflo(o.z1.y), bfhi(o.z1.y)};
        if (c > 0) {
            y0 = __builtin_amdgcn_mfma_f32_16x16x32_bf16(o.q0, o.s00, y0, 0, 0, 0); y1 = __builtin_amdgcn_mfma_f32_16x16x32_bf16(o.q0, o.s10, y1, 0, 0, 0);
            y0 = __builtin_amdgcn_mfma_f32_16x16x32_bf16(o.q1, o.s01, y0, 0, 0, 0); y1 = __builtin_amdgcn_mfma_f32_16x16x32_bf16(o.q1, o.s11, y1, 0, 0, 0); }
        const int m = b * SEQ + c * 64 + tt, chq = h * 64 + c8;
        const f32x4 ln0 = *(const f32x4*)(lnx_ + chq), ln1 = *(const f32x4*)(lnx_ + chq + 4);
        LBAR();
#pragma unroll
        for (int r = 0; r < 4; ++r) { Yl[(tb * 16 + 4 * l4 + r) * 68 + (2 * vh) * 16 + l15] = y0[r]; Yl[(tb * 16 + 4 * l4 + r) * 68 + (2 * vh + 1) * 16 + l15] = y1[r]; }
        LBAR();
        const f32x4 ya = *(const LAS f32x4*)(Yl + tt * 68 + c8), yb = *(const LAS f32x4*)(Yl + tt * 68 + c8 + 4);
        float yy[8] = {ya[0], ya[1], ya[2], ya[3], yb[0], yb[1], yb[2], yb[3]};
        float s1 = ((yy[0] + yy[1]) + (yy[2] + yy[3])) + ((yy[4] + yy[5]) + (yy[6] + yy[7]));
        s1 = sum8(s1); const float mean = s1 * (1.0f / 64.0f); float s2 = 0.f;
#pragma unroll
        for (int i = 0; i < 8; ++i) { yy[i] -= mean; s2 += yy[i] * yy[i]; }
        s2 = sum8(s2); const float rstd = rsqrtf(s2 * (1.0f / 64.0f) + 64e-5f);
        const unsigned vw[4] = {o.cv.x, o.cv.y, o.cv.z, o.cv.w}, gw[4] = {o.cg.x, o.cg.y, o.cg.z, o.cg.w};
        const float lnx[8] = {ln0[0], ln0[1], ln0[2], ln0[3], ln1[0], ln1[1], ln1[2], ln1[3]};
        unsigned ow[4];
#pragma unroll
        for (int i = 0; i < 4; ++i) { float o2[2];
#pragma unroll
            for (int e = 0; e < 2; ++e) { const int ci = 2 * i + e; const float v = e ? bfhi(vw[i]) : bflo(vw[i]), g = e ? bfhi(gw[i]) : bflo(gw[i]);
                o2[e] = (yy[ci] * rstd * lnx[ci] + o.cbc * v) * g; }
            ow[i] = pk2(o2[0], o2[1]); }
        *(u32x4*)((bf16_t*)(ws + WS_YRW) + (size_t)m * 512 + chq) = (u32x4){ow[0], ow[1], ow[2], ow[3]};
    }
    __syncthreads();
}
__device__ __forceinline__ void rwkv_seq(const Frame& F, const Params& P, int layer, int b, int h) {
    unsigned char* ws = F.ws; const bf16_t* p = (const bf16_t*)(ws + WS_P); const bf16_t* lo = (const bf16_t*)(ws + WS_LO);
    LAS float* Lr = (LAS float*)F.lds; LAS float* Lw = Lr + 4096; LAS float* Lk = Lw + 4096; LAS float* Lv = Lk + 4096; LAS float* Lkk = Lv + 4096; LAS float* Lb = Lkk + 4096; LAS float* Ly = Lb + 4096;
    const int lane = F.lane, ch = h * 64 + lane;
    const float mu_r = P.in[I_MU][(size_t)layer * RWKV_COLS + ch], mu_k = P.in[I_MU][(size_t)layer * RWKV_COLS + 512 + ch], mu_v = P.in[I_MU][(size_t)layer * RWKV_COLS + 1024 + ch];
    const float k_k = P.in[I_KK][layer * 512 + ch], k_a = P.in[I_KA][layer * 512 + ch], r_k = P.in[I_RK][layer * 512 + ch], lnx = P.in[I_LNX][layer * 512 + ch];
    const int vrow = F.tid >> 3, q = F.tid & 7;
    float s[8];
#pragma unroll
    for (int i = 0; i < 8; ++i) s[i] = 0.f;
    for (int c = 0; c < NCHUNK; ++c) {
        const int m0 = b * SEQ + c * 64;
        __syncthreads();
#pragma unroll
        for (int i = 0; i < 8; ++i) { const int t = F.wave + 8 * i, m = m0 + t; const bf16_t* pr = p + (size_t)m * PW + P_RW + ch; const bool hp = (c | t) != 0;
            const float xr = bf2f(pr[0]), xk = bf2f(pr[512]), xv = bf2f(pr[1024]);
            const float pr_ = hp ? bf2f(pr[-PW]) : 0.f, pk_ = hp ? bf2f(pr[512 - PW]) : 0.f, pv_ = hp ? bf2f(pr[1024 - PW]) : 0.f;
            const float r = xr + (pr_ - xr) * mu_r, k = xk + (pk_ - xk) * mu_k, v = xv + (pv_ - xv) * mu_v;
            const float lw = bf2f(lo[(size_t)m * LO_W + ch]), a = bf2f(lo[(size_t)m * LO_W + 512 + ch]);
            float kk = k * k_k; const float ss = wave_sum(kk * kk); kk *= rsqrtf(ss + 1e-12f);
            Lr[t * 64 + lane] = r; Lw[t * 64 + lane] = __expf(lw); Lk[t * 64 + lane] = k * (1.0f + (a - 1.0f) * k_a); Lv[t * 64 + lane] = v; Lkk[t * 64 + lane] = kk; Lb[t * 64 + lane] = kk * a; }
        __syncthreads();
        for (int t = 0; t < 64; ++t) {
            const f32x4 ka = *(const LAS f32x4*)(Lkk + t * 64 + q * 8), kb = *(const LAS f32x4*)(Lkk + t * 64 + q * 8 + 4);
            const f32x4 wa = *(const LAS f32x4*)(Lw + t * 64 + q * 8), wb = *(const LAS f32x4*)(Lw + t * 64 + q * 8 + 4);
            const f32x4 ba = *(const LAS f32x4*)(Lb + t * 64 + q * 8), bb = *(const LAS f32x4*)(Lb + t * 64 + q * 8 + 4);
            const f32x4 k2a = *(const LAS f32x4*)(Lk + t * 64 + q * 8), k2b = *(const LAS f32x4*)(Lk + t * 64 + q * 8 + 4);
            const f32x4 ra = *(const LAS f32x4*)(Lr + t * 64 + q * 8), rb = *(const LAS f32x4*)(Lr + t * 64 + q * 8 + 4);
            const float vv = Lv[t * 64 + vrow];
            float sa = 0.f;
#pragma unroll
            for (int i = 0; i < 4; ++i) { sa += s[i] * ka[i]; sa += s[4 + i] * kb[i]; }
            sa = sum8(sa); sa = -sa;
            float y = 0.f;
#pragma unroll
            for (int i = 0; i < 4; ++i) { s[i] = s[i] * wa[i] + sa * ba[i] + vv * k2a[i]; s[4 + i] = s[4 + i] * wb[i] + sa * bb[i] + vv * k2b[i]; y += s[i] * ra[i]; y += s[4 + i] * rb[i]; }
            y = sum8(y);
            if (q == 0) Ly[t * 64 + vrow] = y;
        }
        __syncthreads();
#pragma unroll
        for (int i = 0; i < 8; ++i) { const int t = F.wave + 8 * i, m = m0 + t;
            const float y = Ly[t * 64 + lane]; const float mean = wave_sum(y) * (1.0f / 64.0f); const float d = y - mean; const float var = wave_sum(d * d) * (1.0f / 64.0f);
            const float bon = wave_sum(Lr[t * 64 + lane] * Lk[t * 64 + lane] * r_k);
            const float g = bf2f(lo[(size_t)m * LO_W + 1024 + ch]);
            const float o = (d * rsqrtf(var + 64e-5f) * lnx + bon * Lv[t * 64 + lane]) * g;
            ((bf16_t*)(ws + WS_YRW))[(size_t)m * 512 + ch] = (bf16_t)f2bf(o); }
    }
    __syncthreads();
}

constexpr int LDS_TAB = LDSCTL_OFF + 64;
__device__ __forceinline__ void moe_table(const Frame& F, const unsigned* ectl) {
    LAS int* tab = (LAS int*)(F.lds + LDS_TAB);
    if (F.tid < 64) {
        const int cl = (int)__hip_atomic_load(&ectl[F.tid & 7], __ATOMIC_RELAXED, __HIP_MEMORY_SCOPE_AGENT);
        int st = 0, nt = 0;
#pragma unroll
        for (int e = 0; e < 8; ++e) { const int c = __shfl(cl, e); const int t = (c + 255) >> 8;
            if (F.tid == 0) { tab[1 + e] = st; for (int i = 0; i < t; ++i) tab[16 + nt + i] = e; }
            nt += t; st += t * 256; }
        if (F.tid == 0) tab[0] = nt; }
    __syncthreads();
}
__device__ __forceinline__ void phase_moe_scatter(const Frame& F, const unsigned* ectl) {
    unsigned char* ws = F.ws; const LAS int* tab = (const LAS int*)(F.lds + LDS_TAB);
    const int* tok_e = (const int*)(ws + WS_TOK); int* tok_slot = (int*)tok_e + 2 * MTOK; const float* tok_w = (const float*)(tok_slot + 2 * MTOK);
    int* row_tok = (int*)(tok_w + 2 * MTOK); float* row_w = (float*)(row_tok + MAXROWS);
    for (int i = F.blk * NTHR + F.tid; i < 2 * MTOK; i += F.G * NTHR) { const int e = tok_e[i]; const int dest = tab[1 + e] + tok_slot[i]; row_tok[dest] = i >> 1; row_w[dest] = tok_w[i]; tok_slot[i] = dest; }
    const int gt = F.blk * NTHR + F.tid;
    if (gt < 2048) { const int e = gt >> 8; const int c = (int)__hip_atomic_load(&ectl[e], __ATOMIC_RELAXED, __HIP_MEMORY_SCOPE_AGENT); const int r = c + (gt & 255);
        if (r < ((c + 255) & ~255)) { row_tok[tab[1 + e] + r] = -1; row_w[tab[1 + e] + r] = 0.f; } }
}
constexpr int LDS_GTAB = RING_BYTES;
__device__ __forceinline__ void moe_gather_table(const Frame& F, int ncol) {
    const LAS int* tab = (const LAS int*)(F.lds + LDS_TAB); LAS unsigned* gt = (LAS unsigned*)(F.lds + LDS_GTAB);
    const int* row_tok = (const int*)(F.ws + WS_TOK) + 6 * MTOK; const int total = tab[0] * ncol;
    int tk5[5];
#pragma unroll
    for (int k = 0; k < 5; ++k) { const int i = F.tid + k * NTHR; const int u = i >> 8, r = i & 255; const int L = u * F.G + F.blk; const bool ok = i < 9 * 256 && L < total;
        tk5[k] = row_tok[ok ? (L / ncol) * 256 + r : 0]; tk5[k] = ok ? tk5[k] : 0; }
#pragma unroll
    for (int k = 0; k < 5; ++k) { const int i = F.tid + k * NTHR; if (i < 9 * 256) gt[i] = tk5[k] > 0 ? (unsigned)tk5[k] * (unsigned)(DM * 2) : 0u; }
    __syncthreads();
}

extern __shared__ __attribute__((aligned(16))) unsigned char lds_raw[];
template <class T> __device__ __forceinline__ T* uni(T* p) { const unsigned long long v = (unsigned long long)p; const unsigned lo = __builtin_amdgcn_readfirstlane((unsigned)v), hi = __builtin_amdgcn_readfirstlane((unsigned)(v >> 32)); return (T*)(((unsigned long long)hi << 32) | lo); }
__device__ __forceinline__ int uni(int v) { return __builtin_amdgcn_readfirstlane(v); }
__device__ __forceinline__ Frame mkframe(unsigned char* ws, int wv) {
    Frame F; F.lds = (LAS unsigned char*)lds_raw; int tid = wv * 64 + lane_id_fresh(); F.tid = tid; F.lane = F.tid & 63; F.wave = __builtin_amdgcn_readfirstlane(F.tid >> 6);
    int blk = blockIdx.x; asm volatile("" : "+s"(blk)); F.blk = blk; F.G = gridDim.x; F.vcu = (F.blk & 7) * (F.G >> 3) + (F.blk >> 3); F.gw = F.blk * NWAVES + F.wave; F.ngw = F.G * NWAVES; F.ws = ws; return F;
}
#define PHASE __device__ __forceinline__ void
template <int PART>
PHASE f_moe_convert(int wv, unsigned char* ws_, const float* mg, const float* mu, const float* md) {
    unsigned char* ws = uni(ws_); const Frame F = mkframe(ws, wv); Params P; P.in[I_MG] = uni(mg); P.in[I_MU2] = uni(mu); P.in[I_MD] = uni(md);
    if (PART == 0) { __syncthreads(); phase_moe_convert<0>(F, P, F.gw, F.ngw); }
    else if (F.blk >= 32) { __syncthreads(); phase_moe_convert<1>(F, P, (F.blk - 32) * NWAVES + F.wave, (F.G - 32) * NWAVES); }
}
PHASE f_rms_moe(int wv, unsigned char* ws_, const bf16_t* src, const float* gain, const float* router) {
    unsigned char* ws = uni(ws_); const Frame F = mkframe(ws, wv); int* tok_e = (int*)(ws + WS_TOK); int* tok_slot = tok_e + 2 * MTOK; float* tok_w = (float*)(tok_slot + 2 * MTOK);
    phase_rms<true>(F, uni(src), uni(gain), (bf16_t*)(ws + WS_HN), uni(router), (unsigned*)(ws + WS_CTL) + CW_ECNT, tok_e, tok_slot, tok_w);
}
PHASE f_prep(int wv, unsigned char* ws_, const float* mu, const float* qnorm, const float* kvnorm, int layer_) {
    unsigned char* ws = uni(ws_); const Frame F = mkframe(ws, wv); Params P; P.in[I_MU] = uni(mu); P.in[I_QNORM] = uni(qnorm); P.in[I_KVNORM] = uni(kvnorm); (void)layer_; phase_prep(F, P, 0);
}
PHASE f_ret_scan(int wv, unsigned char* ws_) { unsigned char* ws = uni(ws_); const Frame F = mkframe(ws, wv); ret_scan(F); }
PHASE f_ret_out(int wv, unsigned char* ws_) { unsigned char* ws = uni(ws_); const Frame F = mkframe(ws, wv); ret_out(F); }
PHASE f_rwkv_seq(int wv, unsigned char* ws_, const float* mu, const float* kk, const float* ka, const float* rk, const float* lnx, int layer_) {
    unsigned char* ws = uni(ws_); const Frame F = mkframe(ws, wv); Params P; P.in[I_MU] = uni(mu); P.in[I_KK] = uni(kk); P.in[I_KA] = uni(ka); P.in[I_RK] = uni(rk); P.in[I_LNX] = uni(lnx);
    (void)layer_; rwkv_seq(F, P, 0, F.blk >> 3, F.blk & 7);
}
PHASE f_rwkv_pre(int wv, unsigned char* ws_, const float* mu, const float* kk, const float* ka, const float* rk) { unsigned char* ws = uni(ws_); const Frame F = mkframe(ws, wv); rwkv_chunk_pre<0>(F, uni(mu), uni(kk), uni(ka), uni(rk));
#ifdef PRE_DIAG
    rwkv_chunk_pre<PRE_DIAG>(F, uni(mu), uni(kk), uni(ka), uni(rk));
#endif
}
PHASE f_rwkv_scan(int wv, unsigned char* ws_) { unsigned char* ws = uni(ws_); const Frame F = mkframe(ws, wv); rwkv_scan<true>(F, F.blk >> 3, F.blk & 7);
#ifdef SCAN_TWICE
    __syncthreads(); rwkv_scan<false>(F, F.blk >> 3, F.blk & 7);
#endif
}
PHASE f_rwkv_out(int wv, unsigned char* ws_, const float* lnx) { unsigned char* ws = uni(ws_); const Frame F = mkframe(ws, wv); rwkv_out(F, uni(lnx)); }
PHASE f_attn(int wv, unsigned char* ws_, int layer_) {
    unsigned char* ws = uni(ws_); const int layer = uni(layer_); const Frame F = mkframe(ws, wv);
    unsigned* qh = (unsigned*)(ws + WS_CTL) + CW_ATTQ + layer * 512; volatile LAS unsigned* slot = (volatile LAS unsigned*)(F.lds + LDSCTL_OFF + 32);
    const int my = (int)(xb_xcc_id() & 7u);
    for (int k = 0; k < 8; ++k) { const int q = (my + k) & 7;
        for (;;) {
            if (F.tid == 0) *slot = __hip_atomic_fetch_add(qh + q * 64, 1u, __ATOMIC_RELAXED, __HIP_MEMORY_SCOPE_AGENT);
            __syncthreads();
            const int idx = (int)*slot;
            __syncthreads();
            if (idx >= 64) break;
            const int bh = 2 * q + (idx & 1), qt = 31 - (idx >> 1);
            attn_unit(F, bh >> 3, bh & 7, qt);
        } }
}
PHASE f_moe_scatter(int wv, unsigned char* ws_) { unsigned char* ws = uni(ws_); const Frame F = mkframe(ws, wv); moe_table(F, (unsigned*)(ws + WS_CTL) + CW_ECNT); phase_moe_scatter(F, (unsigned*)(ws + WS_CTL) + CW_ECNT); }
PHASE f_final(int wv, unsigned char* ws_, float* h, const float* gain) { unsigned char* ws = uni(ws_); const Frame F = mkframe(ws, wv); phase_final(F, uni(h), uni(gain), (const bf16_t*)(ws + WS_OUT2), (const int*)(ws + WS_TOK) + 2 * MTOK); }
constexpr int DEFER_BLK0 = 128;
PHASE f_defer_a(int wv, unsigned char* ws_, const float* wqb, const float* wbr, const float* wo, const float* fg, const float* fu, const float* fd, const float* w2, const float* a2, const float* g2, const float* wkvb, const float* pos) {
    unsigned char* ws = uni(ws_); const Frame F = mkframe(ws, wv); Params P; P.in[I_WIN] = nullptr; P.in[I_WQB] = uni(wqb); P.in[I_WBR] = uni(wbr); P.in[I_WO] = uni(wo); P.in[I_FG] = uni(fg); P.in[I_FU] = uni(fu); P.in[I_FD] = uni(fd);
    P.in[I_W2] = uni(w2); P.in[I_A2] = uni(a2); P.in[I_G2] = uni(g2); P.in[I_WKVB] = uni(wkvb); P.in[I_POS] = uni(pos);
    __syncthreads();
    constexpr int NW = (256 - DEFER_BLK0) * NWAVES, NA = pro::NIT - 2 * pro::I_IN;
    pro_tiles<NA / NW>(F, P, 2 * pro::I_IN, (F.blk - DEFER_BLK0) * NWAVES + F.wave, NW, NA % NW);
    pro_small(F, P, (F.blk - DEFER_BLK0) * NTHR + F.tid, (256 - DEFER_BLK0) * NTHR, F.blk - DEFER_BLK0, 256 - DEFER_BLK0);
}
PHASE f_defer_b(int wv, unsigned char* ws_, const float* win) {
    unsigned char* ws = uni(ws_); const Frame F = mkframe(ws, wv); Params P; P.in[I_WIN] = uni(win); P.in[I_WQB] = nullptr; P.in[I_WBR] = nullptr; P.in[I_WO] = nullptr; P.in[I_FG] = nullptr; P.in[I_FU] = nullptr; P.in[I_FD] = nullptr;
    __syncthreads();
    constexpr int NW = (256 - DEFER_BLK0) * NWAVES;
    pro_tiles<pro::I_IN / NW>(F, P, pro::I_IN, (F.blk - DEFER_BLK0) * NWAVES + F.wave, NW, pro::I_IN % NW);
}
PHASE g_inproj(int wv, unsigned char* ws_, int layer_) {
    unsigned char* ws = uni(ws_); const int layer = uni(layer_); const Frame F = mkframe(ws, wv);
    SchedGrid S; S.init(64, 18, F.G, F.blk, ws + WS_HN, (size_t)256 * DM * 2, (bf16_t*)(ws + WS_WIN) + (size_t)layer * WIN_ROWS * DM, (size_t)256 * DM * 2);
    EpiStore E; E.O = (bf16_t*)(ws + WS_P); E.ld = PW; E.SS = (const float*)(ws + WS_SS); E.rl = (LAS float*)(F.lds + RING_BYTES); E.tid = F.tid; pg8::gemm_phase(F.lds, F.tid, DM, DM, DM, S, E);
}
PHASE g_lora(int wv, unsigned char* ws_, const float* w0, const float* a0, int layer_) {
    unsigned char* ws = uni(ws_); const int layer = uni(layer_); const Frame F = mkframe(ws, wv);
    SchedGrid S; S.init(64, 6, F.G, F.blk, ws + WS_LIN, (size_t)256 * LORA_K * 2, (bf16_t*)(ws + WS_LORA) + (size_t)layer * 1536 * LORA_K, (size_t)256 * LORA_K * 2);
    EpiLora E; E.O = (bf16_t*)(ws + WS_LO); E.w0 = uni(w0); E.a0 = uni(a0); pg8::gemm_phase(F.lds, F.tid, LORA_K, LORA_K, LORA_K, S, E);
}
PHASE g_small(int wv, unsigned char* ws_, int layer_) {
    unsigned char* ws = uni(ws_); const Frame F = mkframe(ws, wv); SchedSmall S; S.G = F.G; S.c = F.blk; S.layer = uni(layer_); S.ws = (const char*)ws; EpiSmall E; E.ws = ws; pg8::gemm_phase(F.lds, F.tid, 256, 256, 256, S, E);
}
PHASE g_gate(int wv, unsigned char* ws_, int layer_) {
    unsigned char* ws = uni(ws_); const int layer = uni(layer_); const Frame F = mkframe(ws, wv);
    SchedOwn3 S; S.c = F.blk; S.G = F.G; S.A = (const char*)(ws + WS_HN); S.a_n = 0; S.astep = (size_t)256 * DM * 2; S.B = (const char*)((bf16_t*)(ws + WS_WIN) + ((size_t)layer * WIN_ROWS + PW) * DM); S.bstep = (size_t)256 * DM * 2; S.b_n = (size_t)1024 * DM * 2;
    EpiGate E; E.O = (bf16_t*)(ws + WS_G); E.SS = (const float*)(ws + WS_SS); E.rl = (LAS float*)(F.lds + RING_BYTES); E.tid = F.tid; pg8::gemm_phase(F.lds, F.tid, DM, DM, DM, S, E);
}
PHASE g_merge(int wv, unsigned char* ws_, int layer_) {
    unsigned char* ws = uni(ws_); const int layer = uni(layer_); const Frame F = mkframe(ws, wv);
    SchedOwn3 S; S.c = F.blk; S.G = F.G; S.A = (const char*)(ws + WS_YRET); S.a_n = (size_t)16 * MiB; S.astep = (size_t)256 * 512 * 2;
    S.B = (const char*)((bf16_t*)(ws + WS_BR) + (size_t)layer * 3 * 1024 * 512); S.bstep = (size_t)256 * 512 * 2; S.b_n = (size_t)1024 * 512 * 2;
    EpiMerge E; E.Gt = (const bf16_t*)(ws + WS_G); E.Mg = (bf16_t*)(ws + WS_MRG); pg8::gemm_phase(F.lds, F.tid, 512, 512, 512, S, E);
}
template <bool EMIT, bool IN_F32>
PHASE g_wo(int wv, unsigned char* ws_, const void* hin, bf16_t* hout, const float* gain, int layer_) {
    unsigned char* ws = uni(ws_); const int layer = uni(layer_); const Frame F = mkframe(ws, wv);
    SchedGrid S; S.init(64, 4, F.G, F.blk, ws + WS_MRG, (size_t)256 * DM * 2, (bf16_t*)(ws + WS_WO) + (size_t)layer * DM * DM, (size_t)256 * DM * 2);
    EpiResid<EMIT, IN_F32> E; E.In = uni(hin); E.Out = uni(hout); E.gain = uni(gain); E.Hg = (bf16_t*)(ws + WS_HN); E.SS = (float*)(ws + WS_SS); pg8::gemm_phase(F.lds, F.tid, DM, DM, DM, S, E);
}
PHASE g_ffn_gu(int wv, unsigned char* ws_) {
    unsigned char* ws = uni(ws_); const Frame F = mkframe(ws, wv);
    SchedGrid S; S.init(64, 22, F.G, F.blk, ws + WS_HN, (size_t)256 * DM * 2, ws + WS_FGU, (size_t)256 * DM * 2);
    EpiSwiglu E; E.O = (bf16_t*)(ws + WS_ACT); E.ldc = DFF; E.pn_off = 0; E.SS = (const float*)(ws + WS_SS); E.rl = (LAS float*)(F.lds + RING_BYTES); E.tid = F.tid; pg8::gemm_phase(F.lds, F.tid, DM, DM, DM, S, E);
}
PHASE g_ffn_down(int wv, unsigned char* ws_, bf16_t* h, const float* gain) {
    unsigned char* ws = uni(ws_); const Frame F = mkframe(ws, wv);
    SchedGrid S; S.init(64, 4, F.G, F.blk, ws + WS_ACT, (size_t)256 * DFF * 2, ws + WS_FD, (size_t)256 * DFF * 2);
    EpiResid<true, false> E; E.Out = uni(h); E.In = E.Out; E.gain = uni(gain); E.Hg = (bf16_t*)(ws + WS_HN); E.SS = (float*)(ws + WS_SS); pg8::gemm_phase(F.lds, F.tid, DFF, DFF, DFF, S, E);
}
PHASE g_moe_gu(int wv, unsigned char* ws_, int hh_) {
    unsigned char* ws = uni(ws_); const int hh = uni(hh_); const Frame F = mkframe(ws, wv); const LAS int* tab = (const LAS int*)(F.lds + LDS_TAB);
    moe_gather_table(F, 14);
    SchedMoe S; S.G = F.G; S.c = F.blk; S.ncol = 14; S.ntile = tab[0]; S.tab = tab + 16; S.A = (const char*)(ws + WS_HN); S.astep = 0;
    S.B = (const char*)(ws + WS_MGU) + (size_t)hh * 14 * 256 * DM * 2; S.bstep = (size_t)256 * DM * 2; S.estep = (size_t)2 * DFFE * DM * 2;
    EpiSwiglu E; E.O = (bf16_t*)(ws + WS_MACT); E.ldc = DFFH; E.pn_off = 0; E.SS = nullptr; E.rl = nullptr; E.tid = 0; pg8::gemm_phase<EpiSwiglu, SchedMoe, true>(F.lds, F.tid, DM, DM, DM, S, E, (const LAS unsigned*)(F.lds + LDS_GTAB));
}
template <bool ACCUM>
PHASE g_moe_down(int wv, unsigned char* ws_, int hh_) {
    unsigned char* ws = uni(ws_); const int hh = uni(hh_); const Frame F = mkframe(ws, wv); const LAS int* tab = (const LAS int*)(F.lds + LDS_TAB);
    const float* row_w = (const float*)((const int*)(ws + WS_TOK) + 6 * MTOK + MAXROWS);
    SchedMoe S; S.G = F.G; S.c = F.blk; S.ncol = 4; S.ntile = tab[0]; S.tab = tab + 16; S.A = (const char*)(ws + WS_MACT); S.astep = (size_t)256 * DFFH * 2;
    S.B = (const char*)(ws + WS_MD) + (size_t)hh * DFFH * 2; S.bstep = (size_t)256 * DFFE * 2; S.estep = (size_t)DM * DFFE * 2;
    EpiMoeOut<ACCUM> E; E.row_w = row_w; E.O = (bf16_t*)(ws + WS_OUT2); pg8::gemm_phase(F.lds, F.tid, DFFH, DFFH, DFFE, S, E);
}

typedef const __attribute__((address_space(4))) Params* KPtr;
__device__ __forceinline__ KPtr kargs() { KPtr k = (KPtr)__builtin_amdgcn_kernarg_segment_ptr(); asm volatile("" : "+s"(k)); return k; }
#define KIN(i) (kargs()->in[i])
#define KWS() (kargs()->ws)
struct TpState { unsigned long long tp0, tp1; int tpk; };
#define tp0 tps.tp0
#define tp1 tps.tp1
#define tpk tps.tpk
#define GRID_BAR() do { XcdBarrier b_ = bar; b_.bar = (unsigned*)(KWS() + WS_CTL) + CW_BAR; b_.x = xb_xcc_id(); xcd_barrier(b_); } while (0)
#ifdef TPH
#define TP(k) do { volatile LAS unsigned long long* tpl_ = (volatile LAS unsigned long long*)(lds_raw + LDSCTL_OFF + 48); if ((k) == TPH) tpl_[0] = __builtin_amdgcn_s_memrealtime(); if ((k) == TPH + TPN) tpl_[1] = __builtin_amdgcn_s_memrealtime(); } while (0)
#define TPM() do { ++tpk; TP(tpk); } while (0)
#else
#define TP(k) do { } while (0)
#define TPM() do { } while (0)
#endif
template <int layer>
__device__ __forceinline__ void layer_body(const int wv, const XcdBarrier& bar, TpState& tps) {
        g_inproj(wv, KWS(), layer);
        if constexpr (layer == 0) { if ((int)blockIdx.x >= DEFER_BLK0) f_defer_a(wv, KWS(), KIN(I_WQB), KIN(I_WBR), KIN(I_WO), KIN(I_FG), KIN(I_FU), KIN(I_FD), KIN(I_W2), KIN(I_A2), KIN(I_G2), KIN(I_WKVB), KIN(I_POS)); }
        GRID_BAR();
        TPM();
        f_prep(wv, KWS(), KIN(I_MU) + (size_t)layer * RWKV_COLS, KIN(I_QNORM) + layer * 256, KIN(I_KVNORM) + layer * 128, layer);
        GRID_BAR();
        TPM();
        f_ret_scan(wv, KWS());
        g_lora(wv, KWS(), KIN(I_W0) + layer * 512, KIN(I_A0) + layer * 512, layer);
        g_small(wv, KWS(), layer);
        GRID_BAR();
        TPM();
        f_ret_out(wv, KWS());
#ifdef SPLIT5
        GRID_BAR();
        TPM();
#endif
#ifndef RWKV_SEQ
        f_rwkv_pre(wv, KWS(), KIN(I_MU) + (size_t)layer * RWKV_COLS, KIN(I_KK) + layer * 512, KIN(I_KA) + layer * 512, KIN(I_RK) + layer * 512);
        GRID_BAR();
        TPM();
        if ((int)blockIdx.x < 16) f_rwkv_scan(wv, KWS());
#ifdef SPLIT6
        GRID_BAR();
        TPM();
#endif
#else
        GRID_BAR();
        TPM();
        if (blockIdx.x < 16) f_rwkv_seq(wv, KWS(), KIN(I_MU) + (size_t)layer * RWKV_COLS, KIN(I_KK) + layer * 512, KIN(I_KA) + layer * 512, KIN(I_RK) + layer * 512, KIN(I_LNX) + layer * 512, layer);
#endif
        f_attn(wv, KWS(), layer);
        GRID_BAR();
        TPM();
#ifndef RWKV_SEQ
        f_rwkv_out(wv, KWS(), KIN(I_LNX) + layer * 512);
#endif
        g_gate(wv, KWS(), layer);
#ifndef RWKV_SEQ
        GRID_BAR();
        TPM();
#endif
        g_merge(wv, KWS(), layer);
        GRID_BAR();
        TPM();
        g_wo<layer == 0, layer == 0>(wv, KWS(), layer == 0 ? (const void*)KIN(I_X) : (const void*)kargs()->out, (bf16_t*)kargs()->out, KIN(I_FNORM) + layer * DM, layer);
        GRID_BAR();
        TPM();
        if constexpr (layer == 0) {
            g_ffn_gu(wv, KWS());
            if ((int)blockIdx.x >= DEFER_BLK0) f_defer_b(wv, KWS(), KIN(I_WIN));
            GRID_BAR();
            TPM();
            g_ffn_down(wv, KWS(), (bf16_t*)kargs()->out, KIN(I_ANORM) + DM);
            GRID_BAR();
            TPM();
        } else {
            f_rms_moe(wv, KWS(), (const bf16_t*)kargs()->out, KIN(I_FNORM) + layer * DM, KIN(I_ROUTER));
            f_moe_convert<0>(wv, KWS(), KIN(I_MG), KIN(I_MU2), KIN(I_MD));
            GRID_BAR();
            TPM();
            f_moe_scatter(wv, KWS());
            GRID_BAR();
            TPM();
            g_moe_gu(wv, KWS(), 0);
            GRID_BAR();
            TPM();
            g_moe_down<false>(wv, KWS(), 0);
            f_moe_convert<1>(wv, KWS(), KIN(I_MG), KIN(I_MU2), KIN(I_MD));
            GRID_BAR();
            TPM();
            g_moe_gu(wv, KWS(), 1);
            GRID_BAR();
            TPM();
            g_moe_down<true>(wv, KWS(), 1);
            GRID_BAR();
            TPM();
        }
    }
__global__ void __launch_bounds__(NTHR, 2) mega(Params P_unused) {
    LAS unsigned char* lds = (LAS unsigned char*)lds_raw;
    const int wv = __builtin_amdgcn_readfirstlane((int)threadIdx.x >> 6);
    for (int u = threadIdx.x; u < (LDS_BYTES - LDSCTL_OFF) / 4; u += NTHR) ((LAS unsigned*)(lds + LDSCTL_OFF))[u] = 0u;
    __syncthreads();
    const XcdBarrier bar = xcd_barrier_post((unsigned*)(KWS() + WS_CTL) + CW_BAR, (volatile LAS unsigned*)(lds + LDSCTL_OFF), wv);
    TpState tps = {0ull, 0ull, 0};
    TP(0);
    {
        KPtr k = kargs(); unsigned char* ws = k->ws; const Frame F = mkframe(ws, wv);
        Params P; P.in[I_WIN] = k->in[I_WIN]; P.in[I_WQB] = k->in[I_WQB]; P.in[I_WBR] = k->in[I_WBR]; P.in[I_WO] = k->in[I_WO]; P.in[I_FG] = k->in[I_FG]; P.in[I_FU] = k->in[I_FU]; P.in[I_FD] = k->in[I_FD];
        P.in[I_W2] = k->in[I_W2]; P.in[I_A2] = k->in[I_A2]; P.in[I_G2] = k->in[I_G2]; P.in[I_WKVB] = k->in[I_WKVB]; P.in[I_POS] = k->in[I_POS]; P.in[I_X] = k->in[I_X]; P.in[I_ANORM] = k->in[I_ANORM];
        phase_prologue(F, P);
#ifdef PRO_SPIN
        { const unsigned long long t0_ = __builtin_amdgcn_s_memrealtime(); while (__builtin_amdgcn_s_memrealtime() - t0_ < (unsigned long long)PRO_SPIN) __builtin_amdgcn_s_sleep(8); }
#endif
    }
    GRID_BAR();
    TPM();
    layer_body<0>(wv, bar, tps);
    layer_body<1>(wv, bar, tps);
    f_final(wv, KWS(), kargs()->out, KIN(I_FINAL));
#ifdef PRE_T
    __syncthreads();
    { volatile LAS unsigned long long* tq_ = (volatile LAS unsigned long long*)(lds_raw + LDSCTL_OFF + 48); const unsigned long long te = __builtin_amdgcn_s_memrealtime(), span = tq_[1] * 8ull; while (__builtin_amdgcn_s_memrealtime() - te < span) __builtin_amdgcn_s_sleep(8); }
#endif
#ifdef TPH
    __syncthreads(); TPM();
    { volatile LAS unsigned long long* tpl_ = (volatile LAS unsigned long long*)(lds_raw + LDSCTL_OFF + 48); const unsigned long long te = __builtin_amdgcn_s_memrealtime(), span = (tpl_[1] - tpl_[0]) * (unsigned long long)TAMP; while (__builtin_amdgcn_s_memrealtime() - te < span) __builtin_amdgcn_s_sleep(8); }
#endif
}

extern "C" void kernel_launch(void* const* d_in, const int* in_sizes, int n_in, void* d_out, int out_size, void* d_ws, size_t ws_size, hipStream_t stream) {
    static int ready = 0;
    if (!ready) {
        if (n_in != 29 || out_size != MTOK * DM || ws_size < WS_END) { fprintf(stderr, "kernel_launch: unexpected shapes (n_in %d out %d ws %zu need %zu)\n", n_in, out_size, ws_size, (size_t)WS_END); ready = -1; return; }
        if (hipFuncSetAttribute((const void*)mega, hipFuncAttributeMaxDynamicSharedMemorySize, LDS_BYTES) != hipSuccess) { fprintf(stderr, "kernel_launch: hipFuncSetAttribute failed\n"); ready = -1; return; }
        int dev = 0, cus = 0, per_cu = 0; (void)hipGetDevice(&dev); (void)hipDeviceGetAttribute(&cus, hipDeviceAttributeMultiprocessorCount, dev);
        (void)hipOccupancyMaxActiveBlocksPerMultiprocessor(&per_cu, (const void*)mega, NTHR, LDS_BYTES);
        if (cus < 256 || per_cu < 1) { fprintf(stderr, "kernel_launch: needs 256 CUs with one resident workgroup each (cus %d, per_cu %d)\n", cus, per_cu); ready = -1; return; }
        ready = 1;
    }
    if (ready < 0) return;
    (void)hipMemsetAsync((char*)d_ws + WS_CTL, 0, CTL_BYTES, stream);
    Params p{}; for (int i = 0; i < 29; ++i) p.in[i] = (const float*)d_in[i]; p.out = (float*)d_out; p.ws = (unsigned char*)d_ws;
    hipLaunchKernelGGL(mega, dim3(256), dim3(NTHR), LDS_BYTES, stream, p);
}
```

```cpp
#include <hip/hip_runtime.h>
#include <cstdio>
#include <cstdint>

#define LAS __attribute__((address_space(3)))
#define GAS __attribute__((address_space(1)))
typedef unsigned short bf16_t;
typedef short bf16x8 __attribute__((ext_vector_type(8)));
typedef short bf16x4 __attribute__((ext_vector_type(4)));
typedef float f32x4 __attribute__((ext_vector_type(4)));
typedef float f32x2 __attribute__((ext_vector_type(2)));
typedef float f32x16 __attribute__((ext_vector_type(16)));
typedef unsigned u32x4 __attribute__((ext_vector_type(4)));
typedef unsigned u32x2 __attribute__((ext_vector_type(2)));

constexpr int NB = 2, SEQ = 8192, DM = 1024, MTOK = NB * SEQ, NLAYER = 2, CH = 64, NCHUNK = SEQ / CH;
constexpr int IN_COLS = 7360, PW = 4608;
constexpr int P_RQ = 0, P_RK = 512, P_RV = 1024, P_RG = 1536, P_RW = 2048, P_QA = 4096, P_KVA = 4352;
constexpr int WIN_ROWS = 7680;
constexpr int RWKV_COLS = 1824, LORA_K = 384, LO_W = 1536;
constexpr int DFF = 2816, DFFE = 3584, NEXP = 8;
constexpr int MT0 = 13, MT1 = 15, KH0 = MT0 * 128, KH1 = MT1 * 128;
constexpr int MAXROWS = 34816;
constexpr float NORM_EPS = 1e-6f;

constexpr size_t MiB = 1u << 20;
constexpr size_t WS_CTL = 0, CTL_BYTES = 1 * MiB;
constexpr size_t WS_WIN = 1 * MiB;
constexpr size_t WS_LORA = 31 * MiB;
constexpr size_t WS_QB = 34 * MiB;
constexpr size_t WS_KB = 35 * MiB;
constexpr size_t WS_VB = 35 * MiB + 512 * 1024;
constexpr size_t WS_BR = 36 * MiB;
constexpr size_t WS_WO = 42 * MiB;
constexpr size_t WS_FGU = 46 * MiB;
constexpr size_t WS_FD = 57 * MiB;
constexpr size_t WS_COSR = 63 * MiB, WS_SINR = 67 * MiB, WS_COSM = 71 * MiB, WS_SINM = 72 * MiB;
constexpr size_t WS_HN = 73 * MiB;
constexpr size_t WS_TOK = 105 * MiB;
constexpr size_t WS_T = 106 * MiB;
constexpr size_t WS_P = WS_T;
constexpr size_t WS_G = WS_T;
constexpr size_t WS_MRG = WS_T + 96 * MiB;
constexpr size_t WS_LO = WS_T + 144 * MiB;
constexpr size_t WS_Q = WS_T + 192 * MiB;
constexpr size_t WS_KN = WS_T + 216 * MiB;
constexpr size_t WS_VT = WS_T + 232 * MiB;
constexpr size_t WS_KPE = WS_T + 248 * MiB;
constexpr size_t WS_LIN = WS_T + 249 * MiB;
constexpr size_t WS_QN = WS_T + 261 * MiB;
constexpr size_t WS_CN = WS_T + 269 * MiB;
constexpr size_t WS_YRET = WS_T + 261 * MiB;
constexpr size_t WS_RS = WS_T + 277 * MiB;
constexpr size_t WS_YRW = WS_T + 277 * MiB;
constexpr size_t WS_YMLA = WS_T + 293 * MiB;
constexpr size_t WS_RC = WS_T + 309 * MiB;
constexpr size_t WS_ACT = WS_T;
constexpr size_t WS_MGU = WS_T;
constexpr size_t WS_MD = WS_T + 112 * MiB;
constexpr size_t WS_MACT = WS_T + 168 * MiB;
constexpr size_t WS_OUT2 = WS_T + 296 * MiB;
constexpr size_t WS_HN2 = WS_WIN;
constexpr size_t WS_SS = WS_T + 390 * MiB;
constexpr size_t WS_END = WS_T + 391 * MiB;
static_assert(WS_MACT + (size_t)MAXROWS * KH1 * 2 <= WS_OUT2 && WS_OUT2 + (size_t)MAXROWS * DM * 2 <= WS_SS && WS_HN2 + (size_t)MTOK * DM * 2 <= WS_FGU, "ws map");
constexpr int CW_BAR = 4096;
constexpr int CW_ECNT = 16384;
constexpr int CW_ATTQ = 20480;

__device__ __forceinline__ unsigned f2bf(float f) { unsigned u = __builtin_bit_cast(unsigned, f); return (u + 0x7fffu + ((u >> 16) & 1u)) >> 16; }
typedef __bf16 bf16n2 __attribute__((ext_vector_type(2)));
__device__ __forceinline__ unsigned pk2(float lo, float hi) { const f32x2 f = {lo, hi}; const bf16n2 v = __builtin_convertvector(f, bf16n2); return __builtin_bit_cast(unsigned, v); }
__device__ __forceinline__ float bf2f(unsigned short h) { return __builtin_bit_cast(float, (unsigned)h << 16); }
__device__ __forceinline__ float bflo(unsigned w) { return __builtin_bit_cast(float, w << 16); }
__device__ __forceinline__ float bfhi(unsigned w) { return __builtin_bit_cast(float, w & 0xffff0000u); }
template <int CTRL, int ROWMASK = 0xF>
__device__ __forceinline__ float dpp_add(float v) { const int t = __builtin_amdgcn_update_dpp(0, __builtin_bit_cast(int, v), CTRL, ROWMASK, 0xF, ROWMASK == 0xF); return v + __builtin_bit_cast(float, t); }
#ifdef NO_DPP
__device__ __forceinline__ float sum4(float v)  { v += __shfl_xor(v, 1); v += __shfl_xor(v, 2); return v; }
__device__ __forceinline__ float sum8(float v)  { v = sum4(v); v += __shfl_xor(v, 4); return v; }
__device__ __forceinline__ float sum16(float v) { v = sum8(v); v += __shfl_xor(v, 8); return v; }
__device__ __forceinline__ float wave_sum(float v) { v = sum16(v); v += __shfl_xor(v, 16); v += __shfl_xor(v, 32); return v; }
#else
__device__ __forceinline__ float sum4(float v)  { v = dpp_add<0xB1>(v); return dpp_add<0x4E>(v); }
__device__ __forceinline__ float sum8(float v)  { return dpp_add<0x141>(sum4(v)); }
__device__ __forceinline__ float sum16(float v) { return dpp_add<0x140>(sum8(v)); }
__device__ __forceinline__ float wave_sum(float v) {
    v = sum16(v); v = dpp_add<0x142, 0xA>(v); v = dpp_add<0x143, 0xC>(v);
    return __builtin_bit_cast(float, __builtin_amdgcn_readlane(__builtin_bit_cast(int, v), 63));
}
#endif
__device__ __forceinline__ float sigmoidf_(float x) { return 1.0f / (1.0f + __expf(-x)); }
#define LDS_WAIT() asm volatile("s_waitcnt lgkmcnt(0)" ::: "memory")
#define LBAR() do { asm volatile("s_waitcnt lgkmcnt(0)" ::: "memory"); __builtin_amdgcn_s_barrier(); asm volatile("" ::: "memory"); } while (0)
#define VM_WAIT() asm volatile("s_waitcnt vmcnt(0)" ::: "memory")

#define XB_TMO      128
#define XB_XCNT(j)  (256  + 64 * (j))
#define XB_XSUB(j)  (1280 + 64 * (j))
#define XB_XGEN(j)  (2304 + 64 * (j))
#define XB_TOP      3328
#define XB_TOPGEN   3392
#define XCD_BAR_WORDS 3456
#define XB_SPIN_CAP (1u << 18)
__device__ __forceinline__ unsigned xb_ld(unsigned* p)              { return __hip_atomic_load(p, __ATOMIC_RELAXED, __HIP_MEMORY_SCOPE_AGENT); }
__device__ __forceinline__ unsigned xb_add(unsigned* p, unsigned v) { return __hip_atomic_fetch_add(p, v, __ATOMIC_RELAXED, __HIP_MEMORY_SCOPE_AGENT); }
__device__ __forceinline__ unsigned xb_xcc_id() { return (unsigned)__builtin_amdgcn_s_getreg((3 << 11) | 20) & 0xFu; }
#define XB_SPIN(cond, bar) do { unsigned _sp = 0; while (cond) { __builtin_amdgcn_s_sleep(1); \
    if ((++_sp & 255u) == 0u) { if (xb_ld(&(bar)[XB_TMO])) break; if (_sp > XB_SPIN_CAP) { atomicAdd(&(bar)[XB_TMO], 1u); break; } } } } while (0)
struct XcdBarrier { unsigned* bar; unsigned x; volatile LAS unsigned* st; int wv; };
__device__ __forceinline__ int lane_id_fresh() { int l; asm volatile("v_mbcnt_lo_u32_b32 %0, -1, 0\n\tv_mbcnt_hi_u32_b32 %0, -1, %0" : "=v"(l)); return l; }
__device__ __forceinline__ bool xb_thread0(int wv) { return wv == 0 && lane_id_fresh() == 0; }
__device__ __forceinline__ XcdBarrier xcd_barrier_post(unsigned* bar, volatile LAS unsigned* st, int wv) {
    XcdBarrier b; b.bar = bar; b.x = xb_xcc_id(); b.st = st; b.wv = wv;
    if (xb_thread0(wv)) (void)xb_add(&bar[XB_XCNT(b.x)], 1u);
    return b;
}
__device__ __forceinline__ void xcd_barrier_complete(unsigned* bar, unsigned x, unsigned& nloc, unsigned& nx) {
    const unsigned G = gridDim.x * gridDim.y * gridDim.z;
    unsigned sum, cnt, mine, sp = 0u;
    for (;;) {
        sum = 0u; cnt = 0u; mine = 0u;
#pragma unroll
        for (unsigned j = 0; j < 16; ++j) { const unsigned c = xb_ld(&bar[XB_XCNT(j)]); sum += c; cnt += (c > 0u) ? 1u : 0u; mine = (j == x) ? c : mine; }
        if (sum == G) break;
        __builtin_amdgcn_s_sleep(1);
        if ((++sp & 255u) == 0u) { if (xb_ld(&bar[XB_TMO])) break; if (sp > XB_SPIN_CAP) { atomicAdd(&bar[XB_TMO], 1u); break; } }
    }
    nloc = mine > 0u ? mine : 1u; nx = cnt > 0u ? cnt : 1u;
}
__device__ __forceinline__ void xcd_barrier(const XcdBarrier& b) {
    asm volatile("s_waitcnt vmcnt(0)" ::: "memory");
    __syncthreads();
    if (xb_thread0(b.wv)) {
        unsigned* bar = b.bar;
        __builtin_amdgcn_s_waitcnt(0);
        unsigned nloc = b.st[0], nx = b.st[1];
        if (nloc == 0u) { xcd_barrier_complete(bar, b.x, nloc, nx); b.st[0] = nloc; b.st[1] = nx; }
        const unsigned old = xb_add(&bar[XB_XSUB(b.x)], 1u);
        const unsigned gen = old / nloc;
        if (old + 1u == (gen + 1u) * nloc) {
            __builtin_amdgcn_fence(__ATOMIC_RELEASE, "agent");
            asm volatile("s_waitcnt vmcnt(0)" ::: "memory");
            const unsigned og = xb_add(&bar[XB_TOP], 1u);
            const unsigned tg = og / nx;
            if (og + 1u == (tg + 1u) * nx) xb_add(&bar[XB_TOPGEN], 1u);
            else XB_SPIN(xb_ld(&bar[XB_TOPGEN]) == tg, bar);
            __builtin_amdgcn_fence(__ATOMIC_ACQUIRE, "agent");
            xb_add(&bar[XB_XGEN(b.x)], 1u);
            asm volatile("s_waitcnt vmcnt(0)" ::: "memory");
        } else {
            XB_SPIN(xb_ld(&bar[XB_XGEN(b.x)]) == gen, bar);
            __builtin_amdgcn_fence(__ATOMIC_ACQUIRE, "agent");
            asm volatile("s_waitcnt vmcnt(0)" ::: "memory");
        }
    }
    __syncthreads();
}

namespace pg8 {
constexpr int BM = 256, BK = 64, HALF = 128, HTB = HALF * BK * 2, STAGE_BYTES = 8 * HTB;
__device__ __forceinline__ int lds_byte(int r, int c) { const int st = (r >> 4) * 2 + (c >> 5), rr = r & 15, cc = c & 31, ob = rr * 64 + cc * 2; return st * 1024 + (ob ^ (((ob >> 9) & 1) << 5)); }
__device__ __forceinline__ void stage_rc(int b, int& R, int& C) { const int st = b / 1024, sb = b % 1024, swz = sb ^ (((sb >> 9) & 1) << 5); R = (st >> 1) * 16 + swz / 64; C = (st & 1) * 32 + (swz % 64) / 2; }
__device__ __forceinline__ int perm32(int rho) { const int n = rho >> 4, i = rho & 15; return 8 * (i >> 2) + 4 * n + (i & 3); }
struct Unit { int pm, pn, aux; const char* A; const char* B; };
__device__ __forceinline__ unsigned cvt_pk_bf16(float lo, float hi) { return pk2(lo, hi); }

template <class Epi, class Sched, bool GATHER = false>
__device__ __forceinline__ void gemm_phase(LAS unsigned char* lds, const int tid_in, const int K, const int lda, const int ldb, const Sched& S, const Epi& E, const LAS unsigned* gtab = nullptr) {
    int tid_ = tid_in; asm volatile("" : "+v"(tid_));
    const int tid = tid_, wid = __builtin_amdgcn_readfirstlane(tid >> 6), lane = tid & 63, wr = wid >> 2, wc = wid & 3, fr = lane & 15, fq = lane >> 4;
    const int nt = K / BK;
    unsigned voffA[2], voffB[2];
#pragma unroll
    for (int i = 0; i < 2; ++i) { int R, C; stage_rc(tid * 16 + i * 8192, R, C); const int Rb = Epi::PERM ? ((R & ~31) + perm32(R & 31)) : R;
        voffA[i] = (unsigned)(R * lda + C) * 2u; voffB[i] = (unsigned)(Rb * ldb + C) * 2u; }
    const size_t kstep = (size_t)(BK * 2);
    const size_t hstepA = GATHER ? (size_t)0 : (size_t)HALF * lda * 2, hstepB = (size_t)HALF * ldb * 2;
    int gR[2], gC[2]; unsigned gcur[2][2], gnxt[2][2];
    if constexpr (GATHER) {
#pragma unroll
        for (int i = 0; i < 2; ++i) { int R, C; stage_rc(tid * 16 + i * 8192, R, C); gR[i] = R; gC[i] = C * 2; }
    }
#define PG8_GLOAD(dst, u_) do { _Pragma("unroll") for (int _h = 0; _h < 2; ++_h) _Pragma("unroll") for (int _i = 0; _i < 2; ++_i) dst[_h][_i] = gtab[(u_) * 256 + _h * 128 + gR[_i]] + (unsigned)gC[_i]; } while (0)
    const unsigned ldsw = (unsigned)wid * 1024u;
    const int aoff = lds_byte(wr * 64 + fr, fq * 8), boff = lds_byte(wc * 32 + fr, fq * 8);
#define PG8_SA(b, h) (((b) * 2 + (h)) * HTB)
#define PG8_SB(b, h) ((4 + (b) * 2 + (h)) * HTB)
#define PG8_STAGE(bufoff, gbase, voff) do { _Pragma("unroll") for (int _i = 0; _i < 2; ++_i) \
        __builtin_amdgcn_global_load_lds((const unsigned*)((const char*)(gbase) + (voff)[_i]), (LAS unsigned*)(lds + (bufoff) + ldsw + _i * 8192), 16, 0, 0); } while (0)
#define PG8_STAGEA(bufoff, gbase, h, tab) do { if constexpr (GATHER) { PG8_STAGE(bufoff, gbase, tab[h]); } else { PG8_STAGE(bufoff, (gbase) + (h) * hstepA, voffA); } } while (0)
#define PG8_LDA(dst, b, h) do { _Pragma("unroll") for (int m = 0; m < 4; ++m) _Pragma("unroll") for (int k = 0; k < 2; ++k) dst[m][k] = *(const LAS bf16x8*)(lds + PG8_SA(b, h) + aoff + m * 2048 + k * 1024); } while (0)
#define PG8_LDB(dst, b, h) do { _Pragma("unroll") for (int n = 0; n < 2; ++n) _Pragma("unroll") for (int k = 0; k < 2; ++k) dst[n][k] = *(const LAS bf16x8*)(lds + PG8_SB(b, h) + boff + n * 2048 + k * 1024); } while (0)
#define PG8_MMA(ai, bj, At, Bt) do { __builtin_amdgcn_s_setprio(1); _Pragma("unroll") for (int m = 0; m < 4; ++m) _Pragma("unroll") for (int n = 0; n < 2; ++n) _Pragma("unroll") for (int k = 0; k < 2; ++k) \
        acc[ai][bj][m][n] = __builtin_amdgcn_mfma_f32_16x16x32_bf16(Bt[n][k], At[m][k], acc[ai][bj][m][n], 0, 0, 0); __builtin_amdgcn_s_setprio(0); } while (0)
#define PG8_WAIT_V(n) asm volatile("s_waitcnt vmcnt(" #n ")" ::: "memory")
#define PG8_WAIT_L(n) asm volatile("s_waitcnt lgkmcnt(" #n ")" ::: "memory")
#define PG8_BAR __builtin_amdgcn_s_barrier()
#define PG8_SCHED __builtin_amdgcn_sched_barrier(0)
    Unit cur, nxt; int ui = 0;
    if (!S.next(0, cur)) return;
    f32x4 acc[2][2][4][2];
#pragma unroll
    for (int a = 0; a < 2; ++a)
#pragma unroll
        for (int b = 0; b < 2; ++b)
#pragma unroll
            for (int m = 0; m < 4; ++m)
#pragma unroll
                for (int n = 0; n < 2; ++n) acc[a][b][m][n] = (f32x4){0.f, 0.f, 0.f, 0.f};
    bf16x8 At[4][2], B0[2][2], B1[2][2];
    const char* cA = cur.A; const char* cB = cur.B;
    if constexpr (GATHER) { PG8_GLOAD(gcur, 0); PG8_GLOAD(gnxt, 1); asm volatile("s_waitcnt lgkmcnt(0)" ::: "memory"); }
    PG8_STAGE(PG8_SB(0, 0), cB, voffB); PG8_STAGE(PG8_SB(0, 1), cB + hstepB, voffB); PG8_STAGEA(PG8_SA(0, 0), cA, 0, gcur); PG8_STAGEA(PG8_SA(0, 1), cA, 1, gcur);
    if (wr == 1) PG8_BAR;
    PG8_WAIT_V(2); PG8_BAR;
    PG8_STAGE(PG8_SB(1, 0), cB + kstep, voffB); PG8_STAGEA(PG8_SA(1, 0), cA + kstep, 0, gcur); PG8_STAGE(PG8_SB(1, 1), cB + hstepB + kstep, voffB);
    PG8_WAIT_V(6); PG8_BAR;
#pragma unroll 1
    for (;;) {
        const bool has_next = S.next(ui + 1, nxt);
        const char* nA = has_next ? nxt.A : cA; const char* nB = has_next ? nxt.B : cB;
#pragma unroll 1
        for (int t = 0; t < nt; t += 2) {
            const bool last = (t == nt - 2);
            const char* a1 = cA + (size_t)(t + 1) * kstep;
            const char* a2 = last ? nA : cA + (size_t)(t + 2) * kstep; const char* b2 = last ? nB : cB + (size_t)(t + 2) * kstep;
            const char* a3 = a2 + kstep; const char* b3 = b2 + kstep;
            unsigned g2[2][2];
            if constexpr (GATHER) {
#pragma unroll
                for (int _h = 0; _h < 2; ++_h)
#pragma unroll
                    for (int _i = 0; _i < 2; ++_i) g2[_h][_i] = last ? gnxt[_h][_i] : gcur[_h][_i]; }
            PG8_LDB(B0, 0, 0); PG8_LDB(B1, 0, 1); PG8_SCHED; PG8_LDA(At, 0, 0); PG8_STAGEA(PG8_SA(1, 1), a1, 1, gcur);
            PG8_WAIT_V(8); PG8_WAIT_L(0); PG8_BAR; PG8_MMA(0, 0, At, B0); PG8_MMA(0, 1, At, B1); PG8_BAR; PG8_SCHED;
            PG8_LDA(At, 0, 1); PG8_STAGE(PG8_SB(0, 0), b2, voffB); PG8_STAGE(PG8_SB(0, 1), b2 + hstepB, voffB); PG8_STAGEA(PG8_SA(0, 0), a2, 0, g2);
            PG8_WAIT_V(8); PG8_WAIT_L(0); PG8_BAR; PG8_MMA(1, 0, At, B0); PG8_MMA(1, 1, At, B1); PG8_BAR; PG8_SCHED;
            PG8_LDB(B0, 1, 0); PG8_LDB(B1, 1, 1); PG8_SCHED; PG8_LDA(At, 1, 0); PG8_STAGEA(PG8_SA(0, 1), a2, 1, g2);
            PG8_WAIT_V(8); PG8_WAIT_L(0); PG8_BAR; PG8_MMA(0, 0, At, B0); PG8_MMA(0, 1, At, B1); PG8_BAR; PG8_SCHED;
            PG8_LDA(At, 1, 1); PG8_STAGE(PG8_SB(1, 0), b3, voffB); PG8_STAGE(PG8_SB(1, 1), b3 + hstepB, voffB); PG8_STAGEA(PG8_SA(1, 0), a3, 0, g2);
            PG8_WAIT_V(8); PG8_WAIT_L(0); PG8_BAR; PG8_MMA(1, 0, At, B0); PG8_MMA(1, 1, At, B1); PG8_BAR; PG8_SCHED;
        }
        if (wr == 0) PG8_BAR;
        E(acc, cur, wr, wc, fr, fq);
        if (!has_next) break;
#pragma unroll
        for (int a = 0; a < 2; ++a)
#pragma unroll
            for (int b = 0; b < 2; ++b)
#pragma unroll
                for (int m = 0; m < 4; ++m)
#pragma unroll
                    for (int n = 0; n < 2; ++n) acc[a][b][m][n] = (f32x4){0.f, 0.f, 0.f, 0.f};
        cur = nxt; cA = nA; cB = nB; ++ui;
        if constexpr (GATHER) {
#pragma unroll
            for (int _h = 0; _h < 2; ++_h)
#pragma unroll
                for (int _i = 0; _i < 2; ++_i) gcur[_h][_i] = gnxt[_h][_i];
            PG8_GLOAD(gnxt, ui + 1); }
        if (wr == 1) PG8_BAR;
    }
    PG8_WAIT_V(0);
    PG8_BAR;
#undef PG8_SA
#undef PG8_SB
#undef PG8_STAGE
#undef PG8_STAGEA
#undef PG8_GLOAD
#undef PG8_LDA
#undef PG8_LDB
#undef PG8_MMA
#undef PG8_WAIT_V
#undef PG8_WAIT_L
#undef PG8_BAR
#undef PG8_SCHED
}
}
constexpr int NWAVES = 8, NTHR = 512;
constexpr int RING_BYTES = 131072, LDS_BYTES = 147456, LDSCTL_OFF = LDS_BYTES - 2048;
struct Params { const float* in[29]; float* out; unsigned char* ws; };
struct Frame {
    LAS unsigned char* lds; int tid, lane, wave, blk, G, vcu, gw, ngw; unsigned char* ws;
};
enum { I_X = 0, I_POS, I_ANORM, I_WIN, I_MU, I_W0, I_W2, I_A0, I_A2, I_G2, I_KK, I_KA, I_RK, I_LNX, I_QNORM, I_WQB, I_KVNORM, I_WKVB, I_WBR, I_WO, I_FNORM,
       I_FG, I_FU, I_FD, I_ROUTER, I_MG, I_MU2, I_MD, I_FINAL };

struct SchedGrid {
    int nM, nN, nwg, G, c; const char* A; const char* B; size_t astep, bstep;
    __device__ void init(int nM_, int nN_, int G_, int c_, const void* A_, size_t astep_, const void* B_, size_t bstep_) { nM = nM_; nN = nN_; nwg = nM * nN; G = G_; c = c_; A = (const char*)A_; B = (const char*)B_; astep = astep_; bstep = bstep_; }
    __device__ __forceinline__ bool next(int i, pg8::Unit& u) const {
        const long L = (long)i * G + c; if (L >= nwg) return false;
        int wgid = (int)L; { const int q = nwg / 8, r = nwg % 8, xcd = wgid % 8, off = wgid / 8; wgid = (xcd < r ? xcd * (q + 1) : r * (q + 1) + (xcd - r) * q) + off; }
        const int nig = 8 * nN, gid = wgid / nig, fm = gid * 8, gsz = (nM - fm) < 8 ? (nM - fm) : 8;
        u.pm = fm + ((wgid % nig) % gsz); u.pn = (wgid % nig) / gsz; u.aux = 0;
        u.A = A + (size_t)u.pm * astep; u.B = B + (size_t)u.pn * bstep; return true;
    }
};
struct SchedSmall {
    int G, c, layer; const char* ws;
    __device__ __forceinline__ bool next(int i, pg8::Unit& u) const {
        int L = i * G + c; if (L >= 448) return false;
        int s = 0; if (L >= 192) { L -= 192; s = 1; if (L >= 128) { L -= 128; s = 2; } }
        const int nn = s == 0 ? 3 : (s == 1 ? 2 : 64);
        u.pm = L / nn; u.pn = L % nn; u.aux = s;
        const size_t lw = (size_t)layer * 256 * 2;
        const size_t ao = s == 0 ? WS_QN : (s == 1 ? WS_CN : WS_VB + lw * 512), bo = s == 0 ? WS_QB + lw * 768 : (s == 1 ? WS_KB + lw * 512 : WS_CN);
        u.A = ws + ao + (size_t)u.pm * (256 * 256 * 2); u.B = ws + bo + (size_t)u.pn * (256 * 256 * 2); return true;
    }
};
struct SchedOwn3 {
    int c, G; const char* A; const char* B; size_t astep, bstep, a_n, b_n;
    __device__ __forceinline__ bool next(int i, pg8::Unit& u) const {
        const int t = c + (i / 3) * G; if (t >= 256) return false;
        const int n = i % 3; u.pm = t >> 2; u.pn = t & 3; u.aux = n; u.A = A + (size_t)u.pm * astep + (size_t)n * a_n; u.B = B + (size_t)u.pn * bstep + (size_t)n * b_n; return true;
    }
};
struct SchedMoe {
    int G, c, ncol, ntile; const LAS int* tab; const char* A; const char* B; size_t astep, bstep, estep;
    __device__ __forceinline__ bool next(int i, pg8::Unit& u) const {
        const int L = i * G + c; if (L >= ntile * ncol) return false;
        u.pm = L / ncol; u.pn = L % ncol; const int e = tab[u.pm]; u.aux = e;
        u.A = A + (size_t)u.pm * astep; u.B = B + (size_t)e * estep + (size_t)u.pn * bstep; return true;
    }
};

using pg8::Unit; using pg8::cvt_pk_bf16;
#define EPI_ARGS const f32x4 (&acc)[2][2][4][2], const Unit& u, int wr, int wc, int fr, int fq
__device__ __forceinline__ float row_rstd(const float* SS, int row) {
    const f32x4* s = (const f32x4*)(SS + (size_t)row * 16); const f32x4 a = s[0], b = s[1], c = s[2], d = s[3];
    const float t = ((a.x + a.y) + (a.z + a.w)) + ((b.x + b.y) + (b.z + b.w)) + ((c.x + c.y) + (c.z + c.w)) + ((d.x + d.y) + (d.z + d.w));
    return rsqrtf(t * (1.0f / DM) + NORM_EPS);
}
__device__ __forceinline__ void panel_rstd(const float* SS, int pm, int tid, LAS float* rl) {
    if (tid < 256) rl[tid] = row_rstd(SS, pm * 256 + tid);
    asm volatile("s_waitcnt lgkmcnt(0)" ::: "memory"); __builtin_amdgcn_s_barrier(); asm volatile("" ::: "memory");
}
struct EpiStore {
    static constexpr bool PERM = true;
    bf16_t* O; int ld; const float* SS; LAS float* rl; int tid;
    __device__ __forceinline__ void operator()(EPI_ARGS) const {
        const int row0 = u.pm * 256 + wr * 64 + fr, col0 = u.pn * 256 + wc * 32 + 8 * fq;
        if (SS) panel_rstd(SS, u.pm, tid, rl);
#pragma unroll
        for (int ai = 0; ai < 2; ++ai)
#pragma unroll
            for (int m = 0; m < 4; ++m) { bf16_t* rowp = O + (size_t)(row0 + ai * 128 + m * 16) * ld + col0; const float rs = SS ? rl[wr * 64 + fr + ai * 128 + m * 16] : 1.0f;
#pragma unroll
                for (int bj = 0; bj < 2; ++bj) { const f32x4 v0 = acc[ai][bj][m][0] * rs, v1 = acc[ai][bj][m][1] * rs;
                    u32x4 w; w.x = cvt_pk_bf16(v0[0], v0[1]); w.y = cvt_pk_bf16(v0[2], v0[3]); w.z = cvt_pk_bf16(v1[0], v1[1]); w.w = cvt_pk_bf16(v1[2], v1[3]);
                    *(u32x4*)(rowp + bj * 128) = w; } }
    }
};
struct EpiSmall {
    static constexpr bool PERM = true;
    unsigned char* ws;
    __device__ __forceinline__ void operator()(EPI_ARGS) const {
        bf16_t* base = (bf16_t*)(ws + (u.aux == 0 ? WS_Q : (u.aux == 1 ? WS_KN : WS_VT))); const int ld = u.aux == 0 ? 768 : (u.aux == 1 ? 512 : MTOK);
        const int row0 = u.pm * 256 + wr * 64 + fr, col0 = u.pn * 256 + wc * 32 + 8 * fq;
#pragma unroll
        for (int ai = 0; ai < 2; ++ai)
#pragma unroll
            for (int m = 0; m < 4; ++m) { bf16_t* rowp = base + (size_t)(row0 + ai * 128 + m * 16) * ld + col0;
#pragma unroll
                for (int bj = 0; bj < 2; ++bj) { const f32x4 v0 = acc[ai][bj][m][0], v1 = acc[ai][bj][m][1];
                    u32x4 w; w.x = cvt_pk_bf16(v0[0], v0[1]); w.y = cvt_pk_bf16(v0[2], v0[3]); w.z = cvt_pk_bf16(v1[0], v1[1]); w.w = cvt_pk_bf16(v1[2], v1[3]);
                    *(u32x4*)(rowp + bj * 128) = w; } }
    }
};
struct EpiLora {
    static constexpr bool PERM = true;
    bf16_t* O; const float* w0; const float* a0;
    __device__ __forceinline__ void operator()(EPI_ARGS) const {
        const int seg = u.pn >> 1;
        const int row0 = u.pm * 256 + wr * 64 + fr, col0 = u.pn * 256 + wc * 32 + 8 * fq, ch0 = (u.pn & 1) * 256 + wc * 32 + 8 * fq;
        const float* bias = seg == 0 ? w0 : a0; const float sc = seg == 0 ? -0.6065306597126334f : 1.0f;
#pragma unroll
        for (int bj = 0; bj < 2; ++bj) {
            f32x4 b0 = {0.f, 0.f, 0.f, 0.f}, b1 = {0.f, 0.f, 0.f, 0.f};
            if (seg < 2) { b0 = *(const f32x4*)(bias + ch0 + bj * 128); b1 = *(const f32x4*)(bias + ch0 + bj * 128 + 4); }
#pragma unroll
            for (int ai = 0; ai < 2; ++ai)
#pragma unroll
                for (int m = 0; m < 4; ++m) { bf16_t* rowp = O + (size_t)(row0 + ai * 128 + m * 16) * LO_W + col0 + bj * 128;
                    f32x4 v0 = acc[ai][bj][m][0] + b0, v1 = acc[ai][bj][m][1] + b1;
                    if (seg < 2) {
#pragma unroll
                        for (int j = 0; j < 4; ++j) { v0[j] = sc * sigmoidf_(v0[j]); v1[j] = sc * sigmoidf_(v1[j]); }
                    }
                    u32x4 w; w.x = cvt_pk_bf16(v0[0], v0[1]); w.y = cvt_pk_bf16(v0[2], v0[3]); w.z = cvt_pk_bf16(v1[0], v1[1]); w.w = cvt_pk_bf16(v1[2], v1[3]);
                    *(u32x4*)rowp = w; }
        }
    }
};
struct EpiGate {
    static constexpr bool PERM = true;
    bf16_t* O; const float* SS; LAS float* rl; int tid;
    __device__ __forceinline__ void operator()(EPI_ARGS) const {
        const int row0 = u.pm * 256 + wr * 64 + fr, col0 = u.aux * 1024 + u.pn * 256 + wc * 32 + 8 * fq;
        panel_rstd(SS, u.pm, tid, rl);
#pragma unroll
        for (int ai = 0; ai < 2; ++ai)
#pragma unroll
            for (int m = 0; m < 4; ++m) { bf16_t* rowp = O + (size_t)(row0 + ai * 128 + m * 16) * 3072 + col0; const float rs = rl[wr * 64 + fr + ai * 128 + m * 16];
#pragma unroll
                for (int bj = 0; bj < 2; ++bj) { f32x4 v0 = acc[ai][bj][m][0] * rs, v1 = acc[ai][bj][m][1] * rs;
#pragma unroll
                    for (int j = 0; j < 4; ++j) { v0[j] = sigmoidf_(v0[j]); v1[j] = sigmoidf_(v1[j]); }
                    u32x4 w; w.x = cvt_pk_bf16(v0[0], v0[1]); w.y = cvt_pk_bf16(v0[2], v0[3]); w.z = cvt_pk_bf16(v1[0], v1[1]); w.w = cvt_pk_bf16(v1[2], v1[3]);
                    *(u32x4*)(rowp + bj * 128) = w; } }
    }
};
struct EpiMerge {
    static constexpr bool PERM = true;
    const bf16_t* Gt; bf16_t* Mg;
    template <bool RMW>
    __device__ __forceinline__ void half(EPI_ARGS, int ai) const {
        const int n = u.aux;
        const int row0 = u.pm * 256 + wr * 64 + fr + ai * 128, col0 = u.pn * 256 + wc * 32 + 8 * fq;
        u32x4 g[4][2], p[4][2];
#pragma unroll
        for (int m = 0; m < 4; ++m)
#pragma unroll
            for (int bj = 0; bj < 2; ++bj) { const size_t r = (size_t)(row0 + m * 16); g[m][bj] = *(const u32x4*)(Gt + r * 3072 + n * 1024 + col0 + bj * 128); if (RMW) p[m][bj] = *(const u32x4*)(Mg + r * 1024 + col0 + bj * 128); }
        asm volatile("" ::: "memory");
#pragma unroll
        for (int m = 0; m < 4; ++m)
#pragma unroll
            for (int bj = 0; bj < 2; ++bj) { const size_t r = (size_t)(row0 + m * 16); const f32x4 v0 = acc[ai][bj][m][0], v1 = acc[ai][bj][m][1]; const u32x4 gg = g[m][bj];
                float o[8] = {bflo(gg.x) * v0[0], bfhi(gg.x) * v0[1], bflo(gg.y) * v0[2], bfhi(gg.y) * v0[3], bflo(gg.z) * v1[0], bfhi(gg.z) * v1[1], bflo(gg.w) * v1[2], bfhi(gg.w) * v1[3]};
                if (RMW) { const u32x4 q = p[m][bj]; o[0] += bflo(q.x); o[1] += bfhi(q.x); o[2] += bflo(q.y); o[3] += bfhi(q.y); o[4] += bflo(q.z); o[5] += bfhi(q.z); o[6] += bflo(q.w); o[7] += bfhi(q.w); }
                u32x4 w; w.x = cvt_pk_bf16(o[0], o[1]); w.y = cvt_pk_bf16(o[2], o[3]); w.z = cvt_pk_bf16(o[4], o[5]); w.w = cvt_pk_bf16(o[6], o[7]);
                *(u32x4*)(Mg + r * 1024 + col0 + bj * 128) = w; }
    }
    __device__ __forceinline__ void operator()(EPI_ARGS) const {
        if (u.aux > 0) { half<true>(acc, u, wr, wc, fr, fq, 0); half<true>(acc, u, wr, wc, fr, fq, 1); }
        else { half<false>(acc, u, wr, wc, fr, fq, 0); half<false>(acc, u, wr, wc, fr, fq, 1); }
    }
};
template <bool EMIT>
struct EpiResid {
    static constexpr bool PERM = true;
    bf16_t* H; float* SS;
    __device__ __forceinline__ void operator()(EPI_ARGS) const {
        const int row0 = u.pm * 256 + wr * 64 + fr, col0 = u.pn * 256 + wc * 32 + 8 * fq;
#pragma unroll
        for (int ai = 0; ai < 2; ++ai)
#pragma unroll
            for (int m = 0; m < 4; ++m) { const int row = row0 + ai * 128 + m * 16; float sq = 0.f;
#pragma unroll
                for (int bj = 0; bj < 2; ++bj) { bf16_t* hp = H + (size_t)row * DM + col0 + bj * 128;
                    const u32x4 p = *(const u32x4*)hp; f32x4 x0 = (f32x4){bflo(p.x), bfhi(p.x), bflo(p.y), bfhi(p.y)}, x1 = (f32x4){bflo(p.z), bfhi(p.z), bflo(p.w), bfhi(p.w)};
                    x0 += acc[ai][bj][m][0]; x1 += acc[ai][bj][m][1];
                    u32x4 w; w.x = cvt_pk_bf16(x0[0], x0[1]); w.y = cvt_pk_bf16(x0[2], x0[3]); w.z = cvt_pk_bf16(x1[0], x1[1]); w.w = cvt_pk_bf16(x1[2], x1[3]);
                    *(u32x4*)hp = w;
                    if (EMIT) sq += ((x0[0] * x0[0] + x0[1] * x0[1]) + (x0[2] * x0[2] + x0[3] * x0[3])) + ((x1[0] * x1[0] + x1[1] * x1[1]) + (x1[2] * x1[2] + x1[3] * x1[3])); }
                if (EMIT) { sq += __shfl_xor(sq, 16); sq += __shfl_xor(sq, 32); if (fq == 0) SS[(size_t)row * 16 + u.pn * 4 + wc] = sq; } }
    }
};
struct EpiSwiglu {
    static constexpr bool PERM = true;
    bf16_t* O; int ldc; int pn_off; const float* SS; LAS float* rl; int tid;
    __device__ __forceinline__ void operator()(EPI_ARGS) const {
        const int row0 = u.pm * 256 + wr * 64 + fr, col0 = (u.pn - pn_off) * 128 + wc * 32 + 8 * fq;
        if (SS) panel_rstd(SS, u.pm, tid, rl);
#pragma unroll
        for (int ai = 0; ai < 2; ++ai)
#pragma unroll
            for (int m = 0; m < 4; ++m) { bf16_t* rowp = O + (size_t)(row0 + ai * 128 + m * 16) * ldc + col0; const float rs = SS ? rl[wr * 64 + fr + ai * 128 + m * 16] : 1.0f;
                float o[8];
#pragma unroll
                for (int n = 0; n < 2; ++n)
#pragma unroll
                    for (int j = 0; j < 4; ++j) { const float g = acc[ai][0][m][n][j] * rs, up = acc[ai][1][m][n][j] * rs; o[n * 4 + j] = g * sigmoidf_(g) * up; }
                u32x4 w; w.x = cvt_pk_bf16(o[0], o[1]); w.y = cvt_pk_bf16(o[2], o[3]); w.z = cvt_pk_bf16(o[4], o[5]); w.w = cvt_pk_bf16(o[6], o[7]);
                *(u32x4*)rowp = w; }
    }
};
template <bool ACCUM>
struct EpiMoeOut {
    static constexpr bool PERM = true;
    const float* row_w; bf16_t* O;
    __device__ __forceinline__ void operator()(EPI_ARGS) const {
        const int row0 = u.pm * 256 + wr * 64 + fr, col0 = u.pn * 256 + wc * 32 + 8 * fq;
        float wt[2][4];
#pragma unroll
        for (int ai = 0; ai < 2; ++ai)
#pragma unroll
            for (int m = 0; m < 4; ++m) wt[ai][m] = row_w[row0 + ai * 128 + m * 16];
#pragma unroll
        for (int ai = 0; ai < 2; ++ai) {
            u32x4 p[4][2];
            if (ACCUM) {
#pragma unroll
                for (int m = 0; m < 4; ++m)
#pragma unroll
                    for (int bj = 0; bj < 2; ++bj) p[m][bj] = *(const u32x4*)(O + (size_t)(row0 + ai * 128 + m * 16) * DM + col0 + bj * 128); }
            asm volatile("" ::: "memory");
#pragma unroll
            for (int m = 0; m < 4; ++m) { const int r = row0 + ai * 128 + m * 16; bf16_t* rowp = O + (size_t)r * DM + col0;
#pragma unroll
                for (int bj = 0; bj < 2; ++bj) { f32x4 v0 = acc[ai][bj][m][0] * wt[ai][m], v1 = acc[ai][bj][m][1] * wt[ai][m];
                    if (ACCUM) { const u32x4 q = p[m][bj]; v0[0] += bflo(q.x); v0[1] += bfhi(q.x); v0[2] += bflo(q.y); v0[3] += bfhi(q.y); v1[0] += bflo(q.z); v1[1] += bfhi(q.z); v1[2] += bflo(q.w); v1[3] += bfhi(q.w); }
                    u32x4 w; w.x = cvt_pk_bf16(v0[0], v0[1]); w.y = cvt_pk_bf16(v0[2], v0[3]); w.z = cvt_pk_bf16(v1[0], v1[1]); w.w = cvt_pk_bf16(v1[2], v1[3]);
                    *(u32x4*)(rowp + bj * 128) = w; } }
        }
    }
};

__device__ __forceinline__ void transpose_tile64(const float* W, int ldn, int k0, int n0, bf16_t* WT, int ldk, int drow0, int drow1, int dk0, LAS float* scr, int lane) {
#ifdef SIMPLE_TR
    { const int c = lane & 7;
      for (int j = 0; j < 8; ++j) { const int n = (lane >> 3) + 8 * j; const float* s = W + (size_t)(k0 + 8 * c) * ldn + n0 + n;
        u32x4 o; o.x = pk2(s[0], s[(size_t)ldn]); o.y = pk2(s[(size_t)2 * ldn], s[(size_t)3 * ldn]); o.z = pk2(s[(size_t)4 * ldn], s[(size_t)5 * ldn]); o.w = pk2(s[(size_t)6 * ldn], s[(size_t)7 * ldn]);
        const int dr = n < 32 ? drow0 + n : drow1 + (n - 32);
        *(u32x4*)(WT + (size_t)dr * ldk + dk0 + k0 + 8 * c) = o; }
      return; }
#endif
    f32x4 v[16]; const int r4 = lane >> 4, c4 = (lane & 15) * 4;
#pragma unroll
    for (int i = 0; i < 16; ++i) v[i] = __builtin_nontemporal_load((const f32x4*)(W + (size_t)(k0 + 4 * i + r4) * ldn + n0 + c4));
#pragma unroll
    for (int i = 0; i < 16; ++i) { LAS float* d = scr + (4 * i + r4) * 65 + c4; d[0] = v[i][0]; d[1] = v[i][1]; d[2] = v[i][2]; d[3] = v[i][3]; }
    LDS_WAIT(); asm volatile("" ::: "memory");
    const int c = lane & 7;
#pragma unroll
    for (int j = 0; j < 8; ++j) { const int n = (lane >> 3) + 8 * j; const LAS float* s = scr + (8 * c) * 65 + n;
        u32x4 o; o.x = pk2(s[0 * 65], s[1 * 65]); o.y = pk2(s[2 * 65], s[3 * 65]); o.z = pk2(s[4 * 65], s[5 * 65]); o.w = pk2(s[6 * 65], s[7 * 65]);
        const int dr = n < 32 ? drow0 + n : drow1 + (n - 32);
        *(u32x4*)(WT + (size_t)dr * ldk + dk0 + k0 + 8 * c) = o; }
    LDS_WAIT(); asm volatile("" ::: "memory");
}
__device__ __forceinline__ void conv_plain(const float* W, int K, int N, bf16_t* WT, int ldk, int item, LAS float* scr, int lane) {
    const int nblk = N / 64, kb = item / nblk, nb = item % nblk;
    transpose_tile64(W, N, kb * 64, nb * 64, WT, ldk, nb * 64, nb * 64 + 32, 0, scr, lane);
}
__device__ __forceinline__ int win_drow(int n0) { return n0 < 3872 ? n0 : (n0 < 4128 ? 4096 + (n0 - 3872) : (n0 < 4288 ? 4352 + (n0 - 4128) : 4608 + (n0 - 4288))); }
__device__ __forceinline__ int gu_drow(int n0, int up) { return (n0 >> 7) * 256 + (n0 & 127) + up * 128; }

struct TrD { const float* src; bf16_t* d0; bf16_t* d1; int ldn, ldk; const float* gk; };
__device__ __forceinline__ TrD tr_desc(const float* W, int ldn, int k0, int n0, bf16_t* WT, int ldk, int drow0, int drow1, int dk0, const float* gain = nullptr) {
    TrD d; d.src = W + (size_t)k0 * ldn + n0; d.ldn = ldn; d.ldk = ldk; d.d0 = WT + (size_t)drow0 * ldk + dk0 + k0; d.d1 = WT + (size_t)drow1 * ldk + dk0 + k0; d.gk = gain ? gain + k0 : nullptr; return d;
}
__device__ __forceinline__ void tr_load(f32x4 (&v)[16], const TrD& d, int lane) {
    const float* s = d.src + (size_t)(lane >> 4) * d.ldn + (lane & 15) * 4;
#pragma unroll
    for (int i = 0; i < 16; ++i) v[i] = __builtin_nontemporal_load((const f32x4*)(s + (size_t)(4 * i) * d.ldn));
}
__device__ __forceinline__ void tr_store(const f32x4 (&v)[16], const TrD& d, LAS float* scr, int lane) {
    const int r4 = lane >> 4, c4 = (lane & 15) * 4;
#pragma unroll
    for (int i = 0; i < 16; ++i) { LAS float* q = scr + (4 * i + r4) * 65 + c4; q[0] = v[i][0]; q[1] = v[i][1]; q[2] = v[i][2]; q[3] = v[i][3]; }
    LDS_WAIT(); asm volatile("" ::: "memory");
    const int c = lane & 7;
    f32x4 g0 = {1.f, 1.f, 1.f, 1.f}, g1 = {1.f, 1.f, 1.f, 1.f};
    if (d.gk) { g0 = *(const f32x4*)(d.gk + 8 * c); g1 = *(const f32x4*)(d.gk + 8 * c + 4); }
#pragma unroll
    for (int j = 0; j < 8; ++j) { const int n = (lane >> 3) + 8 * j; const LAS float* s = scr + (8 * c) * 65 + n;
        u32x4 o; o.x = pk2(s[0 * 65] * g0.x, s[1 * 65] * g0.y); o.y = pk2(s[2 * 65] * g0.z, s[3 * 65] * g0.w); o.z = pk2(s[4 * 65] * g1.x, s[5 * 65] * g1.y); o.w = pk2(s[6 * 65] * g1.z, s[7 * 65] * g1.w);
        bf16_t* dr = n < 32 ? d.d0 + (size_t)n * d.ldk : d.d1 + (size_t)(n - 32) * d.ldk;
        *(u32x4*)(dr + 8 * c) = o; }
    LDS_WAIT(); asm volatile("" ::: "memory");
}
__device__ __forceinline__ TrD desc_plain(const float* W, int K, int N, bf16_t* WT, int ldk, int item) {
    const int nblk = N / 64, kb = item / nblk, nb = item % nblk; (void)K;
    return tr_desc(W, N, kb * 64, nb * 64, WT, ldk, nb * 64, nb * 64 + 32, 0);
}
#define TR_PIPE(DESC, IT0, STEP, NT, TAIL, SCR, LANE) do { \
    f32x4 v_[2][16]; TrD d_[2]; const int i0_ = (IT0), st_ = (STEP); const bool tail_ = (TAIL); \
    d_[0] = DESC(i0_); tr_load(v_[0], d_[0], LANE); \
    _Pragma("unroll") for (int k_ = 0; k_ < (NT); ++k_) { \
        if (k_ + 1 < (NT) || tail_) { d_[(k_ + 1) & 1] = DESC(i0_ + (k_ + 1) * st_); tr_load(v_[(k_ + 1) & 1], d_[(k_ + 1) & 1], LANE); } \
        asm volatile("" ::: "memory"); \
        tr_store(v_[k_ & 1], d_[k_ & 1], SCR, LANE); } \
    if (tail_) tr_store(v_[(NT) & 1], d_[(NT) & 1], SCR, LANE); } while (0)
namespace pro {
constexpr int I_IN = 16 * 115, I_QB = 4 * 12, I_BRn = 8 * 16, I_WOn = 16 * 16, I_G = 16 * 44, I_D = 44 * 16;
constexpr int NIT = NLAYER * (I_IN + I_QB + 3 * I_BRn + I_WOn) + 2 * I_G + I_D;
}
__device__ __forceinline__ TrD pro_desc(const Params& P, unsigned char* ws, int it) {
    using namespace pro;
    int r = it;
    if (r < NLAYER * I_IN) { const int l = r / I_IN; r %= I_IN; const int kb = r / 115, nb = r % 115;
        return tr_desc(P.in[I_WIN] + (size_t)l * DM * IN_COLS, IN_COLS, kb * 64, nb * 64, (bf16_t*)(ws + WS_WIN) + (size_t)l * WIN_ROWS * DM, DM, win_drow(nb * 64), win_drow(nb * 64 + 32), 0, P.in[I_ANORM] + (size_t)l * DM); }
    r -= NLAYER * I_IN;
    if (r < NLAYER * I_QB) { const int l = r / I_QB; r %= I_QB; return desc_plain(P.in[I_WQB] + (size_t)l * 256 * 768, 256, 768, (bf16_t*)(ws + WS_QB) + (size_t)l * 768 * 256, 256, r); }
    r -= NLAYER * I_QB;
    if (r < NLAYER * 3 * I_BRn) { const int ln = r / I_BRn; r %= I_BRn; return desc_plain(P.in[I_WBR] + (size_t)ln * 512 * 1024, 512, 1024, (bf16_t*)(ws + WS_BR) + (size_t)ln * 1024 * 512, 512, r); }
    r -= NLAYER * 3 * I_BRn;
    if (r < NLAYER * I_WOn) { const int l = r / I_WOn; r %= I_WOn; return desc_plain(P.in[I_WO] + (size_t)l * DM * DM, DM, DM, (bf16_t*)(ws + WS_WO) + (size_t)l * DM * DM, DM, r); }
    r -= NLAYER * I_WOn;
    if (r < 2 * I_G) { const int up = r / I_G; r %= I_G; const int kb = r / 44, nb = r % 44;
        return tr_desc(up ? P.in[I_FU] : P.in[I_FG], DFF, kb * 64, nb * 64, (bf16_t*)(ws + WS_FGU), DM, gu_drow(nb * 64, up), gu_drow(nb * 64 + 32, up), 0, P.in[I_FNORM]); }
    r -= 2 * I_G;
    return desc_plain(P.in[I_FD], DFF, DM, (bf16_t*)(ws + WS_FD), DFF, r);
}

#define PRO_DESC_(x) pro_desc(P, ws, (x))
template <int NT>
__device__ __forceinline__ void pro_tiles(const Frame& F, const Params& P, int lo, int w0, int nw, int tail) {
    LAS float* scr = (LAS float*)(F.lds + F.wave * 16640);
    unsigned char* ws = F.ws;
    if constexpr (NT == 0) { if (w0 < tail) { f32x4 v[16]; const TrD d = pro_desc(P, ws, lo + w0); tr_load(v, d, F.lane); tr_store(v, d, scr, F.lane); } }
    else TR_PIPE(PRO_DESC_, lo + w0, nw, NT, w0 < tail, scr, F.lane);
}
__device__ __forceinline__ void pro_small(const Frame& F, const Params& P, int gt, int ngt, int vb0, int nvb) {
    unsigned char* ws = F.ws;
    for (int i = gt; i < NLAYER * 3 * 48 * 512; i += ngt) { const int c = i & 511; int r = i >> 9; const int k = 8 * (r % 48); r /= 48; const int seg = r % 3, l = r / 3;
        const float* src = nullptr;
        if (seg == 0 && k < 64) src = P.in[I_W2] + ((size_t)l * 64 + k) * 512 + c;
        else if (seg == 1 && k >= 64 && k < 128) src = P.in[I_A2] + ((size_t)l * 64 + (k - 64)) * 512 + c;
        else if (seg == 2 && k >= 128 && k < 288) src = P.in[I_G2] + ((size_t)l * 160 + (k - 128)) * 512 + c;
        const bool live = src != nullptr; if (!live) src = P.in[I_W2] + c;
        float v[8];
#pragma unroll
        for (int q = 0; q < 8; ++q) v[q] = src[q * 512];
#pragma unroll
        for (int q = 0; q < 8; ++q) v[q] = live ? v[q] : 0.f;
        u32x4 o; o.x = pk2(v[0], v[1]); o.y = pk2(v[2], v[3]); o.z = pk2(v[4], v[5]); o.w = pk2(v[6], v[7]);
        *(u32x4*)((bf16_t*)(ws + WS_LORA) + ((size_t)l * 1536 + seg * 512 + c) * 384 + k) = o; }
    for (int i = gt; i < NLAYER * 32 * 512; i += ngt) { const int n = i & 511; int r = i >> 9; const int k = 8 * (r & 31), l = r >> 5; const int h = n >> 6, dd = n & 63;
        float vk[8], vv[8]; const float* w = P.in[I_WKVB] + ((size_t)l * 128 + (k < 128 ? k : 0)) * 1024 + h * 128 + dd;
#pragma unroll
        for (int q = 0; q < 8; ++q) { vk[q] = w[q * 1024]; vv[q] = w[q * 1024 + 64]; }
#pragma unroll
        for (int q = 0; q < 8; ++q) { vk[q] = k < 128 ? vk[q] : 0.f; vv[q] = k < 128 ? vv[q] : 0.f; }
        u32x4 o; o.x = pk2(vk[0], vk[1]); o.y = pk2(vk[2], vk[3]); o.z = pk2(vk[4], vk[5]); o.w = pk2(vk[6], vk[7]);
        *(u32x4*)((bf16_t*)(ws + WS_KB) + ((size_t)l * 512 + n) * 256 + k) = o;
        o.x = pk2(vv[0], vv[1]); o.y = pk2(vv[2], vv[3]); o.z = pk2(vv[4], vv[5]); o.w = pk2(vv[6], vv[7]);
        *(u32x4*)((bf16_t*)(ws + WS_VB) + ((size_t)l * 512 + n) * 256 + k) = o; }
    {
        const int j = F.tid & 127, r0 = F.tid >> 7;
        if (j < 80) { const int isr = j < 64; const int idx = isr ? j : j - 64; const double dim = isr ? 128.0 : 32.0;
            const float inv = (float)(1.0 / pow(10000.0, (2.0 * idx) / dim));
            for (int vb = vb0; vb < MTOK / 64; vb += nvb) {
                int pos[16];
#pragma unroll
                for (int k = 0; k < 16; ++k) pos[k] = ((const int*)P.in[I_POS])[vb * 64 + r0 + 4 * k];
                asm volatile("" ::: "memory");
#pragma unroll
                for (int k = 0; k < 16; ++k) { const int m = vb * 64 + r0 + 4 * k;
                    const float ang = (float)pos[k] * inv;
                    const double a = (double)ang, q = rint(a * 0.15915494309189535), rr = a - q * 6.283185307179586476925;
                    const float rf = (float)rr; const float cs = __cosf(rf), sn = __sinf(rf);
                    if (isr) { ((float*)(ws + WS_COSR))[(size_t)m * 64 + idx] = cs; ((float*)(ws + WS_SINR))[(size_t)m * 64 + idx] = sn; }
                    else { ((float*)(ws + WS_COSM))[(size_t)m * 16 + idx] = cs; ((float*)(ws + WS_SINM))[(size_t)m * 16 + idx] = sn; } } } }
    }
}
__device__ __forceinline__ void phase_prologue(const Frame& F, const Params& P) {
    unsigned char* ws = F.ws;
    pro_tiles<0>(F, P, 0, F.gw, 2048, pro::I_IN);
    for (int m = F.gw; m < MTOK; m += F.ngw) {
        const f32x4* xr = (const f32x4*)(P.in[I_X] + (size_t)m * DM) + F.lane; f32x4 v[4]; float s = 0.f;
#pragma unroll
        for (int j = 0; j < 4; ++j) { v[j] = __builtin_nontemporal_load(xr + 64 * j); s += (v[j].x * v[j].x + v[j].y * v[j].y) + (v[j].z * v[j].z + v[j].w * v[j].w); }
        s = wave_sum(s);
        u32x2* o8 = (u32x2*)((bf16_t*)(ws + WS_HN) + (size_t)m * DM) + F.lane;
#pragma unroll
        for (int j = 0; j < 4; ++j) { const f32x4 y = v[j]; u32x2 w; w.x = pk2(y.x, y.y); w.y = pk2(y.z, y.w); o8[64 * j] = w; }
        if (F.lane < 16) ((float*)(ws + WS_SS))[(size_t)m * 16 + F.lane] = F.lane == 0 ? s : 0.f;
    }
}
template <int PART>
__device__ __forceinline__ TrD moe_desc(const Params& P, unsigned char* ws, int it) {
    constexpr int NBH = PART == 0 ? MT0 * 2 : MT1 * 2, NB0 = PART == 0 ? 0 : MT0 * 2;
    constexpr int I_GH = 16 * NBH, I_D = 56 * 16;
    constexpr int PER_E = PART == 0 ? 2 * I_GH + I_D : 2 * I_GH;
    const int e = it / PER_E; int r = it % PER_E;
    if (r < 2 * I_GH) { const int up = r / I_GH; r %= I_GH; const int kb = r / NBH, nb = NB0 + r % NBH;
        return tr_desc((up ? P.in[I_MU2] : P.in[I_MG]) + (size_t)e * DM * DFFE, DFFE, kb * 64, nb * 64, (bf16_t*)(ws + WS_MGU) + (size_t)e * 2 * DFFE * DM, DM, gu_drow(nb * 64, up), gu_drow(nb * 64 + 32, up), 0); }
    r -= 2 * I_GH;
    return desc_plain(P.in[I_MD] + (size_t)e * DFFE * DM, DFFE, DM, (bf16_t*)(ws + WS_MD) + (size_t)e * DM * DFFE, DFFE, r);
}
template <int PART>
__device__ __forceinline__ void phase_moe_convert(const Frame& F, const Params& P, int w0, int nw) {
    LAS float* scr = (LAS float*)(F.lds + F.wave * 16640);
    unsigned char* ws = F.ws; (void)nw;
    constexpr int NITEM = NEXP * (PART == 0 ? 2 * 16 * MT0 * 2 + 56 * 16 : 2 * 16 * MT1 * 2);
    constexpr int NW = PART == 0 ? 2048 : 1792;
#define MOE_DESC_(x) moe_desc<PART>(P, ws, (x))
    TR_PIPE(MOE_DESC_, w0, NW, NITEM / NW, w0 < NITEM % NW, scr, F.lane);
#undef MOE_DESC_
}

template <bool MOE>
__device__ __forceinline__ void phase_rms(const Frame& F, const bf16_t* src, const float* gain, bf16_t* hn, const float* router, unsigned* ectl, int* tok_e, int* tok_slot, float* tok_w) {
    LAS int* lcnt = (LAS int*)(F.lds);
    if (MOE) { if (F.tid < 16) lcnt[F.tid] = 0; __syncthreads(); }
    int my_e0 = 0, my_e1 = 0, my_s0 = 0, my_s1 = 0; float my_w0 = 0.f, my_w1 = 0.f;
    f32x4 rw[MOE ? 32 : 1];
    if (MOE) {
#pragma unroll
        for (int j = 0; j < 4; ++j)
#pragma unroll
            for (int q = 0; q < 4; ++q) { const int c = 4 * F.lane + 256 * j + q; rw[(j * 4 + q) * 2] = *(const f32x4*)(router + (size_t)c * 8); rw[(j * 4 + q) * 2 + 1] = *(const f32x4*)(router + (size_t)c * 8 + 4); } }
    f32x4 gn[4];
#pragma unroll
    for (int j = 0; j < 4; ++j) gn[j] = ((const f32x4*)gain)[F.lane + 64 * j];
    for (int i0 = 0; i0 < 8; i0 += 4) {
    u32x2 raw[4][4];
#pragma unroll
    for (int r = 0; r < 4; ++r) { const u32x2* xr = (const u32x2*)(src + (size_t)(F.blk * 64 + F.wave * 8 + i0 + r) * DM) + F.lane;
#pragma unroll
        for (int j = 0; j < 4; ++j) raw[r][j] = xr[64 * j]; }
    asm volatile("" ::: "memory");
#pragma unroll
    for (int r = 0; r < 4; ++r) {
        const int i = i0 + r, m = F.blk * 64 + F.wave * 8 + i;
        f32x4 v[4]; float s = 0.f;
#pragma unroll
        for (int j = 0; j < 4; ++j) { const u32x2 p = raw[r][j]; v[j] = (f32x4){bflo(p.x), bfhi(p.x), bflo(p.y), bfhi(p.y)}; s += (v[j].x * v[j].x + v[j].y * v[j].y) + (v[j].z * v[j].z + v[j].w * v[j].w); }
        const float rstd = rsqrtf(wave_sum(s) * (1.0f / DM) + NORM_EPS);
#pragma unroll
        for (int j = 0; j < 4; ++j) v[j] = v[j] * rstd * gn[j];
        u32x2* o8 = (u32x2*)(hn + (size_t)m * DM) + F.lane;
#pragma unroll
        for (int j = 0; j < 4; ++j) { u32x2 w; w.x = pk2(v[j].x, v[j].y); w.y = pk2(v[j].z, v[j].w); o8[64 * j] = w; }
        if (MOE) {
            float lg[8];
#pragma unroll
            for (int e = 0; e < 8; ++e) lg[e] = 0.f;
#pragma unroll
            for (int j = 0; j < 4; ++j)
#pragma unroll
                for (int q = 0; q < 4; ++q) { const f32x4 r0 = rw[(j * 4 + q) * 2], r1 = rw[(j * 4 + q) * 2 + 1]; const float x = v[j][q];
                    lg[0] += x * r0.x; lg[1] += x * r0.y; lg[2] += x * r0.z; lg[3] += x * r0.w; lg[4] += x * r1.x; lg[5] += x * r1.y; lg[6] += x * r1.z; lg[7] += x * r1.w; }
#pragma unroll
            for (int e = 0; e < 8; ++e) lg[e] = wave_sum(lg[e]);
            int e0 = 0; float b0 = lg[0];
#pragma unroll
            for (int e = 1; e < 8; ++e) if (lg[e] > b0) { b0 = lg[e]; e0 = e; }
            int e1 = -1; float b1 = -3.0e38f;
#pragma unroll
            for (int e = 0; e < 8; ++e) if (e != e0 && lg[e] > b1) { b1 = lg[e]; e1 = e; }
            const float t = __expf(b1 - b0), w0 = 1.0f / (1.0f + t), w1 = t / (1.0f + t);
            int s0 = 0, s1 = 0;
            if (F.lane == 0) { s0 = atomicAdd((int*)&lcnt[e0], 1); s1 = atomicAdd((int*)&lcnt[e1], 1); }
            s0 = __shfl(s0, 0); s1 = __shfl(s1, 0);
            if (F.lane == i) { my_e0 = e0; my_e1 = e1; my_s0 = s0; my_s1 = s1; my_w0 = w0; my_w1 = w1; }
        }
    }
    }
    if (MOE) {
        __syncthreads();
        if (F.tid < 8) lcnt[8 + F.tid] = (int)atomicAdd(&ectl[F.tid], (unsigned)lcnt[F.tid]);
        __syncthreads();
        if (F.lane < 8) { const int m = F.blk * 64 + F.wave * 8 + F.lane;
            tok_e[2 * m] = my_e0; tok_e[2 * m + 1] = my_e1; tok_slot[2 * m] = lcnt[8 + my_e0] + my_s0; tok_slot[2 * m + 1] = lcnt[8 + my_e1] + my_s1; tok_w[2 * m] = my_w0; tok_w[2 * m + 1] = my_w1; }
        __syncthreads();
    }
}
__device__ __forceinline__ void phase_final(const Frame& F, float* h, const bf16_t* hb, const float* gain, const bf16_t* out2, const int* tok_pos) {
    int pos[8][2];
#pragma unroll
    for (int k = 0; k < 8; ++k) { const int m = F.gw + k * F.ngw; pos[k][0] = tok_pos[2 * m]; pos[k][1] = tok_pos[2 * m + 1]; }
    f32x4 gn[4];
#pragma unroll
    for (int j = 0; j < 4; ++j) gn[j] = ((const f32x4*)gain)[F.lane + 64 * j];
#pragma unroll
    for (int k0 = 0; k0 < 8; k0 += 4) {
        u32x2 hv[4][4], av[4][4], bv[4][4];
#pragma unroll
        for (int r = 0; r < 4; ++r) { const int m = F.gw + (k0 + r) * F.ngw;
            const u32x2* hr = (const u32x2*)(hb + (size_t)m * DM) + F.lane;
            const u32x2* o0 = (const u32x2*)(out2 + (size_t)pos[k0 + r][0] * DM) + F.lane; const u32x2* o1 = (const u32x2*)(out2 + (size_t)pos[k0 + r][1] * DM) + F.lane;
#pragma unroll
            for (int j = 0; j < 4; ++j) { hv[r][j] = hr[64 * j]; av[r][j] = o0[64 * j]; bv[r][j] = o1[64 * j]; } }
        asm volatile("" ::: "memory");
#pragma unroll
        for (int r = 0; r < 4; ++r) { const int m = F.gw + (k0 + r) * F.ngw;
            f32x4* xr = (f32x4*)(h + (size_t)m * DM) + F.lane;
            f32x4 v[4]; float s = 0.f;
#pragma unroll
            for (int j = 0; j < 4; ++j) { const u32x2 p = hv[r][j]; v[j] = (f32x4){bflo(p.x), bfhi(p.x), bflo(p.y), bfhi(p.y)}; const u32x2 a = av[r][j], b = bv[r][j];
                v[j].x += bflo(a.x) + bflo(b.x); v[j].y += bfhi(a.x) + bfhi(b.x); v[j].z += bflo(a.y) + bflo(b.y); v[j].w += bfhi(a.y) + bfhi(b.y);
                s += (v[j].x * v[j].x + v[j].y * v[j].y) + (v[j].z * v[j].z + v[j].w * v[j].w); }
            const float rstd = rsqrtf(wave_sum(s) * (1.0f / DM) + NORM_EPS);
#pragma unroll
            for (int j = 0; j < 4; ++j) xr[64 * j] = v[j] * rstd * gn[j]; }
    }
}
template <int KS>
__device__ __forceinline__ f32x4 mm_tile(const LAS bf16_t* P, int ldp, const LAS bf16_t* Q, int ldq, int ib, int jb, int lane, f32x4 acc) {
    const LAS bf16_t* pp = P + (ib * 16 + (lane & 15)) * ldp + 8 * (lane >> 4);
    const LAS bf16_t* qp = Q + (jb * 16 + (lane & 15)) * ldq + 8 * (lane >> 4);
#pragma unroll
    for (int ks = 0; ks < KS; ++ks) { const bf16x8 a = *(const LAS bf16x8*)(qp + ks * 32), b = *(const LAS bf16x8*)(pp + ks * 32); acc = __builtin_amdgcn_mfma_f32_16x16x32_bf16(a, b, acc, 0, 0, 0); }
    return acc;
}
__device__ __forceinline__ void st_bf4(LAS bf16_t* p, f32x4 v) { u32x2 w; w.x = pk2(v[0], v[1]); w.y = pk2(v[2], v[3]); *(LAS u32x2*)p = w; }
__device__ __forceinline__ float ret_lg(int h) { return __logf(1.0f - exp2f(-5.0f - (float)h)); }

__device__ __forceinline__ void phase_prep(const Frame& F, const Params& P, int layer) {
    unsigned char* ws = F.ws;
    const bf16_t* p = (const bf16_t*)(ws + WS_P);
    const float* mu = P.in[I_MU] + (size_t)layer * RWKV_COLS;
    float mu5[5];
#pragma unroll
    for (int jj = 0; jj < 5; ++jj) { const int c = F.lane + 64 * jj; mu5[jj] = mu[1536 + (c < 288 ? c : 0)]; }
    const f32x4 gq = *(const f32x4*)(P.in[I_QNORM] + layer * 256 + 4 * F.lane);
    const f32x2 gk = *(const f32x2*)(P.in[I_KVNORM] + layer * 128 + 2 * F.lane);
    for (int m0 = F.gw; m0 < MTOK; m0 += 4 * F.ngw) {
        unsigned short lx[4][5], lp[4][5], kx1[4], kx2[4]; u32x2 qa[4]; unsigned kva[4]; float kc[4], ks[4];
#pragma unroll
        for (int r = 0; r < 4; ++r) { const int m = m0 + r * F.ngw; const bf16_t* pr = p + (size_t)m * PW; const bool has_prev = (m % SEQ) != 0; const bf16_t* pp = has_prev ? pr - PW : pr;
#pragma unroll
            for (int jj = 0; jj < 5; ++jj) { const int c = F.lane + 64 * jj; const int off = 1536 + (c < 288 ? c : 0); lx[r][jj] = pr[P_RW + off]; lp[r][jj] = pp[P_RW + off]; }
            qa[r] = *(const u32x2*)(pr + P_QA + 4 * F.lane); kva[r] = *(const unsigned*)(pr + P_KVA + 2 * F.lane);
            const int l16 = F.lane & 15; kx1[r] = pr[P_KVA + 128 + l16]; kx2[r] = pr[P_KVA + 144 + l16];
            kc[r] = ((const float*)(ws + WS_COSM))[(size_t)m * 16 + l16]; ks[r] = ((const float*)(ws + WS_SINM))[(size_t)m * 16 + l16]; }
        asm volatile("" ::: "memory");
#pragma unroll
        for (int r = 0; r < 4; ++r) { const int m = m0 + r * F.ngw; const bool has_prev = (m % SEQ) != 0;
            bf16_t* lin = (bf16_t*)(ws + WS_LIN) + (size_t)m * LORA_K;
#pragma unroll
            for (int jj = 0; jj < 6; ++jj) { const int c = F.lane + 64 * jj; float o = 0.f;
                if (jj < 5) { const float x = bf2f(lx[r][jj < 5 ? jj : 0]), xp = has_prev ? bf2f(lp[r][jj < 5 ? jj : 0]) : 0.f; const float xs = x + (xp - x) * mu5[jj < 5 ? jj : 0];
                    const float oo = c < 64 ? tanhf(xs) : (c < 128 ? xs : sigmoidf_(xs)); o = c < 288 ? oo : 0.f; }
                lin[c] = (bf16_t)f2bf(o); }
            {
                const u32x2 w = qa[r]; float x[4] = {bflo(w.x), bfhi(w.x), bflo(w.y), bfhi(w.y)};
                const float ss = wave_sum(x[0] * x[0] + x[1] * x[1] + x[2] * x[2] + x[3] * x[3]); const float rs = rsqrtf(ss * (1.0f / 256.0f) + NORM_EPS);
                u32x2 o; o.x = pk2(x[0] * rs * gq.x, x[1] * rs * gq.y); o.y = pk2(x[2] * rs * gq.z, x[3] * rs * gq.w); *(u32x2*)((bf16_t*)(ws + WS_QN) + (size_t)m * 256 + 4 * F.lane) = o; }
            {
                const unsigned w = kva[r]; float x0 = bflo(w), x1 = bfhi(w);
                const float ss = wave_sum(x0 * x0 + x1 * x1); const float rs = rsqrtf(ss * (1.0f / 128.0f) + NORM_EPS);
                unsigned* cn = (unsigned*)((bf16_t*)(ws + WS_CN) + (size_t)m * 256); cn[F.lane] = pk2(x0 * rs * gk.x, x1 * rs * gk.y); cn[64 + F.lane] = 0u; }
            if (F.lane < 16) {
                const float x1 = bf2f(kx1[r]), x2 = bf2f(kx2[r]); const float c = kc[r], s = ks[r];
                bf16_t* kp = (bf16_t*)(ws + WS_KPE) + (size_t)m * 32; kp[F.lane] = (bf16_t)f2bf(x1 * c - x2 * s); kp[16 + F.lane] = (bf16_t)f2bf(x1 * s + x2 * c); } }
    }
    LAS bf16_t* kT = (LAS bf16_t*)F.lds;
    LAS bf16_t* vT = kT + 128 * 72;
    const int pc = F.tid & 7, j = F.tid >> 3;
    constexpr int NU = NB * NCHUNK * 4;
    u32x4 xa, xb, xva, xvb; f32x4 xc0, xc1, xs0, xs1;
#define PREP_LOAD(uu) do { const int h_ = (uu) & 3, n_ = ((uu) >> 2) & 127, b_ = (uu) >> 9; const int m_ = b_ * SEQ + n_ * 64 + j; \
        const bf16_t* kr_ = p + (size_t)m_ * PW + P_RK + h_ * 128 + pc * 8; xa = *(const u32x4*)kr_; xb = *(const u32x4*)(kr_ + 64); \
        const bf16_t* vr_ = p + (size_t)m_ * PW + P_RV + h_ * 128 + pc * 8; xva = *(const u32x4*)vr_; xvb = *(const u32x4*)(vr_ + 64); \
        const f32x4* cp_ = (const f32x4*)((const float*)(ws + WS_COSR) + (size_t)m_ * 64 + pc * 8); const f32x4* sp_ = (const f32x4*)((const float*)(ws + WS_SINR) + (size_t)m_ * 64 + pc * 8); \
        xc0 = cp_[0]; xc1 = cp_[1]; xs0 = sp_[0]; xs1 = sp_[1]; } while (0)
    if (F.blk < NU) PREP_LOAD(F.blk);
    for (int u = F.blk; u < NU; u += F.G) {
        const int h = u & 3;
        const float lg = ret_lg(h);
        __syncthreads();
        {
            const u32x4 a = xa, bq = xb;
            const float cp[8] = {xc0.x, xc0.y, xc0.z, xc0.w, xc1.x, xc1.y, xc1.z, xc1.w}, sp[8] = {xs0.x, xs0.y, xs0.z, xs0.w, xs1.x, xs1.y, xs1.z, xs1.w};
            const float sc = 0.08838834764831845f * __expf(lg * (float)(63 - j));
            const unsigned aw[4] = {a.x, a.y, a.z, a.w}, bw[4] = {bq.x, bq.y, bq.z, bq.w};
#pragma unroll
            for (int i = 0; i < 8; ++i) { const float x1 = (i & 1) ? bfhi(aw[i >> 1]) : bflo(aw[i >> 1]), x2 = (i & 1) ? bfhi(bw[i >> 1]) : bflo(bw[i >> 1]); const float c = cp[i], s = sp[i];
                kT[(pc * 8 + i) * 72 + j] = (bf16_t)f2bf((x1 * c - x2 * s) * sc); kT[(64 + pc * 8 + i) * 72 + j] = (bf16_t)f2bf((x1 * s + x2 * c) * sc); }
            const u32x4 va = xva, vb = xvb;
            const unsigned vaw[4] = {va.x, va.y, va.z, va.w}, vbw[4] = {vb.x, vb.y, vb.z, vb.w};
#pragma unroll
            for (int i = 0; i < 8; ++i) { vT[(pc * 8 + i) * 72 + j] = (bf16_t)((i & 1) ? (vaw[i >> 1] >> 16) : (vaw[i >> 1] & 0xffffu)); vT[(64 + pc * 8 + i) * 72 + j] = (bf16_t)((i & 1) ? (vbw[i >> 1] >> 16) : (vbw[i >> 1] & 0xffffu)); }
        }
        { const int un = u + F.G < NU ? u + F.G : u; PREP_LOAD(un); }
        __syncthreads();
        bf16_t* out = (bf16_t*)(ws + WS_RS) + (size_t)u * 16384;
#pragma unroll
        for (int jb = 0; jb < 8; ++jb) { f32x4 acc = {0.f, 0.f, 0.f, 0.f}; acc = mm_tile<2>(vT, 72, kT, 72, F.wave, jb, F.lane, acc);
            const int e = F.wave * 16 + (F.lane & 15), d = jb * 16 + 4 * (F.lane >> 4);
            u32x2 w; w.x = pk2(acc[0], acc[1]); w.y = pk2(acc[2], acc[3]); *(u32x2*)(out + e * 128 + d) = w; }
    }
    __syncthreads();
#undef PREP_LOAD
}

__device__ __forceinline__ void ret_scan(const Frame& F) {
    bf16_t* rs = (bf16_t*)(F.ws + WS_RS);
    for (int idx = F.blk * NTHR + F.tid; idx < NB * 4 * 16384; idx += F.G * NTHR) {
        const int b = idx >> 16, h = (idx >> 14) & 3, ed = idx & 16383; const float cd = __expf(ret_lg(h) * 64.0f);
        bf16_t* base = rs + ((size_t)(b * 128) * 4 + h) * 16384 + ed; float s = 0.f;
        for (int n0 = 0; n0 < NCHUNK; n0 += 64) { unsigned short t[64];
#pragma unroll
            for (int i = 0; i < 64; ++i) t[i] = base[(size_t)(n0 + i) * 65536];
            asm volatile("" ::: "memory");
#pragma unroll
            for (int i = 0; i < 64; ++i) { base[(size_t)(n0 + i) * 65536] = (bf16_t)f2bf(s); s = s * cd + bf2f(t[i]); } }
    }
}

__device__ __forceinline__ void ret_out(const Frame& F) {
    unsigned char* ws = F.ws; const bf16_t* p = (const bf16_t*)(ws + WS_P);
    LAS bf16_t* q = (LAS bf16_t*)F.lds;
    LAS bf16_t* k = q + 64 * 136;
    LAS bf16_t* vT = k + 64 * 136;
    LAS bf16_t* pT = vT + 128 * 72;
    LAS bf16_t* sc = pT + 128 * 136;
    LAS float* st = (LAS float*)(sc + 64 * 72);
    const int pc = F.tid & 7, j = F.tid >> 3;
    constexpr int NU = NB * NCHUNK * 4;
    f32x4 xc0, xc1, xs0, xs1; u32x4 xqa, xqb, xka, xkb, xva, xvb, xp0, xp1, xp2, xp3;
#define RET_LOAD(uu) do { const int h_ = (uu) & 3, n_ = ((uu) >> 2) & 127, b_ = (uu) >> 9; const int m_ = b_ * SEQ + n_ * 64 + j; \
        const f32x4* cp_ = (const f32x4*)((const float*)(ws + WS_COSR) + (size_t)m_ * 64 + pc * 8); const f32x4* sp_ = (const f32x4*)((const float*)(ws + WS_SINR) + (size_t)m_ * 64 + pc * 8); \
        xc0 = cp_[0]; xc1 = cp_[1]; xs0 = sp_[0]; xs1 = sp_[1]; \
        const bf16_t* r_ = p + (size_t)m_ * PW + h_ * 128 + pc * 8; xqa = *(const u32x4*)(r_ + P_RQ); xqb = *(const u32x4*)(r_ + P_RQ + 64); xka = *(const u32x4*)(r_ + P_RK); xkb = *(const u32x4*)(r_ + P_RK + 64); \
        xva = *(const u32x4*)(r_ + P_RV); xvb = *(const u32x4*)(r_ + P_RV + 64); \
        const bf16_t* ps_ = (const bf16_t*)(ws + WS_RS) + (size_t)(uu) * 16384 + (F.tid >> 4) * 128 + (F.tid & 15) * 8; \
        xp0 = *(const u32x4*)ps_; xp1 = *(const u32x4*)(ps_ + 32 * 128); xp2 = *(const u32x4*)(ps_ + 64 * 128); xp3 = *(const u32x4*)(ps_ + 96 * 128); } while (0)
    if (F.blk < NU) RET_LOAD(F.blk);
    for (int u = F.blk; u < NU; u += F.G) {
        const int h = u & 3, n = (u >> 2) & 127, b = u >> 9; const int m0 = b * SEQ + n * 64;
        const float lg = ret_lg(h);
        u32x2 gw4[4];
        LBAR();
        {
            const float cs[8] = {xc0.x, xc0.y, xc0.z, xc0.w, xc1.x, xc1.y, xc1.z, xc1.w}, sn[8] = {xs0.x, xs0.y, xs0.z, xs0.w, xs1.x, xs1.y, xs1.z, xs1.w};
#pragma unroll
            for (int which = 0; which < 2; ++which) {
                const u32x4 a = which ? xka : xqa, bq = which ? xkb : xqb;
                const unsigned aw[4] = {a.x, a.y, a.z, a.w}, bw[4] = {bq.x, bq.y, bq.z, bq.w}; const float sc_ = which ? 0.08838834764831845f : 1.0f;
                float o1[8], o2[8];
#pragma unroll
                for (int i = 0; i < 8; ++i) { const float x1 = (i & 1) ? bfhi(aw[i >> 1]) : bflo(aw[i >> 1]), x2 = (i & 1) ? bfhi(bw[i >> 1]) : bflo(bw[i >> 1]); o1[i] = (x1 * cs[i] - x2 * sn[i]) * sc_; o2[i] = (x1 * sn[i] + x2 * cs[i]) * sc_; }
                LAS bf16_t* dst = (which ? k : q) + j * 136 + pc * 8;
                u32x4 w1, w2; w1.x = pk2(o1[0], o1[1]); w1.y = pk2(o1[2], o1[3]); w1.z = pk2(o1[4], o1[5]); w1.w = pk2(o1[6], o1[7]); w2.x = pk2(o2[0], o2[1]); w2.y = pk2(o2[2], o2[3]); w2.z = pk2(o2[4], o2[5]); w2.w = pk2(o2[6], o2[7]);
                *(LAS u32x4*)dst = w1; *(LAS u32x4*)(dst + 64) = w2; }
            const u32x4 va = xva, vb = xvb;
            const unsigned vaw[4] = {va.x, va.y, va.z, va.w}, vbw[4] = {vb.x, vb.y, vb.z, vb.w};
#pragma unroll
            for (int i = 0; i < 8; ++i) { vT[(pc * 8 + i) * 72 + j] = (bf16_t)((i & 1) ? (vaw[i >> 1] >> 16) : (vaw[i >> 1] & 0xffffu)); vT[(64 + pc * 8 + i) * 72 + j] = (bf16_t)((i & 1) ? (vbw[i >> 1] >> 16) : (vbw[i >> 1] & 0xffffu)); }
            { const int e0 = F.tid >> 4, c = F.tid & 15; *(LAS u32x4*)(pT + e0 * 136 + c * 8) = xp0; *(LAS u32x4*)(pT + (e0 + 32) * 136 + c * 8) = xp1; *(LAS u32x4*)(pT + (e0 + 64) * 136 + c * 8) = xp2; *(LAS u32x4*)(pT + (e0 + 96) * 136 + c * 8) = xp3; }
            { const int mrow_ = m0 + (F.wave & 3) * 16 + (F.lane & 15);
#pragma unroll
              for (int t = 0; t < 4; ++t) gw4[t] = *(const u32x2*)(p + (size_t)mrow_ * PW + P_RG + h * 128 + ((F.wave >> 2) * 4 + t) * 16 + 4 * (F.lane >> 4)); }
            { const int un = u + F.G < NU ? u + F.G : u; RET_LOAD(un); }
        }
        LBAR();
        {
            const int ib = F.wave & 3;
#pragma unroll
            for (int t = 0; t < 2; ++t) { const int jb = 2 * (F.wave >> 2) + t; f32x4 acc = {0.f, 0.f, 0.f, 0.f}; acc = mm_tile<4>(q, 136, k, 136, ib, jb, F.lane, acc);
                const int i = ib * 16 + (F.lane & 15), j0 = jb * 16 + 4 * (F.lane >> 4);
#pragma unroll
                for (int r = 0; r < 4; ++r) { const int dd = i - (j0 + r); acc[r] *= __expf(lg * (float)(dd < 0 ? -dd : dd)); }
                st_bf4(sc + i * 72 + j0, acc); }
        }
        LBAR();
        {
            const int ib = F.wave & 3, eh = F.wave >> 2; const int i = ib * 16 + (F.lane & 15);
            const float qd = __expf(lg * (float)(i + 1));
            f32x4 o[4]; float s1 = 0.f, s2 = 0.f;
#pragma unroll
            for (int t = 0; t < 4; ++t) { const int eb = eh * 4 + t; f32x4 ai = {0.f, 0.f, 0.f, 0.f}, ac = {0.f, 0.f, 0.f, 0.f};
                ai = mm_tile<2>(sc, 72, vT, 72, ib, eb, F.lane, ai); ac = mm_tile<4>(q, 136, pT, 136, ib, eb, F.lane, ac);
                o[t] = ai + ac * qd;
#pragma unroll
                for (int r = 0; r < 4; ++r) { s1 += o[t][r]; s2 += o[t][r] * o[t][r]; } }
            s1 += __shfl_xor(s1, 16); s1 += __shfl_xor(s1, 32); s2 += __shfl_xor(s2, 16); s2 += __shfl_xor(s2, 32);
            if (F.lane < 16) { st[(eh * 64 + i) * 2] = s1; st[(eh * 64 + i) * 2 + 1] = s2; }
            LBAR();
            const float t1 = st[i * 2] + st[(64 + i) * 2], t2 = st[i * 2 + 1] + st[(64 + i) * 2 + 1];
            const float mean = t1 * (1.0f / 128.0f), var = fmaxf(t2 * (1.0f / 128.0f) - mean * mean, 0.f), rstd = rsqrtf(var + 1e-5f);
            const int mrow = m0 + i;
#pragma unroll
            for (int t = 0; t < 4; ++t) { const int e = (eh * 4 + t) * 16 + 4 * (F.lane >> 4);
                const u32x2 gw = gw4[t]; const float g[4] = {bflo(gw.x), bfhi(gw.x), bflo(gw.y), bfhi(gw.y)};
                float y[4];
#pragma unroll
                for (int r = 0; r < 4; ++r) y[r] = (o[t][r] - mean) * rstd * (g[r] * sigmoidf_(g[r]));
                u32x2 w; w.x = pk2(y[0], y[1]); w.y = pk2(y[2], y[3]); *(u32x2*)((bf16_t*)(ws + WS_YRET) + (size_t)mrow * 512 + h * 128 + e) = w; }
        }
    }
    __syncthreads();
#undef RET_LOAD
}

constexpr int ATT_KP = 104, ATT_VP = 72;
constexpr int ATT_KB = 64 * ATT_KP * 2, ATT_VB = 64 * ATT_VP * 2;
constexpr int ATT_K0 = 0, ATT_V0 = 2 * ATT_KB;
__device__ __forceinline__ void attn_unit(const Frame& F, int b, int h, int qt) {
    unsigned char* ws = F.ws;
    const bf16_t* Qg = (const bf16_t*)(ws + WS_Q); const bf16_t* Kn = (const bf16_t*)(ws + WS_KN); const bf16_t* Kp = (const bf16_t*)(ws + WS_KPE); const bf16_t* Vt = (const bf16_t*)(ws + WS_VT);
    const int lane = F.lane, w = F.wave, ql = lane & 31, hf = lane >> 5;
    const int mq = b * SEQ + qt * 256 + w * 32 + ql;
    const float qs = 0.10206207261596577f * 1.4426950408889634f;
    bf16x8 qf[6];
    {
        const bf16_t* qr = Qg + (size_t)mq * 768 + h * 96;
#pragma unroll
        for (int s = 0; s < 4; ++s) { const u32x4 x = *(const u32x4*)(qr + 16 * s + 8 * hf); const unsigned xw[4] = {x.x, x.y, x.z, x.w}; u32x4 o; unsigned ow[4];
#pragma unroll
            for (int i = 0; i < 4; ++i) ow[i] = pk2(bflo(xw[i]) * qs, bfhi(xw[i]) * qs);
            o.x = ow[0]; o.y = ow[1]; o.z = ow[2]; o.w = ow[3]; qf[s] = __builtin_bit_cast(bf16x8, o); }
        const u32x4 x1 = *(const u32x4*)(qr + 64 + 8 * hf), x2 = *(const u32x4*)(qr + 80 + 8 * hf);
        const float* cp = (const float*)(ws + WS_COSM) + (size_t)mq * 16 + 8 * hf; const float* sp = (const float*)(ws + WS_SINM) + (size_t)mq * 16 + 8 * hf;
        const unsigned a[4] = {x1.x, x1.y, x1.z, x1.w}, c[4] = {x2.x, x2.y, x2.z, x2.w}; unsigned o1[4], o2[4];
#pragma unroll
        for (int i = 0; i < 4; ++i) { const float u0 = bflo(a[i]), u1 = bfhi(a[i]), v0 = bflo(c[i]), v1 = bfhi(c[i]); const float c0 = cp[2 * i], c1 = cp[2 * i + 1], s0 = sp[2 * i], s1 = sp[2 * i + 1];
            o1[i] = pk2((u0 * c0 - v0 * s0) * qs, (u1 * c1 - v1 * s1) * qs); o2[i] = pk2((u0 * s0 + v0 * c0) * qs, (u1 * s1 + v1 * c1) * qs); }
        u32x4 t1, t2; t1.x = o1[0]; t1.y = o1[1]; t1.z = o1[2]; t1.w = o1[3]; t2.x = o2[0]; t2.y = o2[1]; t2.z = o2[2]; t2.w = o2[3];
        qf[4] = __builtin_bit_cast(bf16x8, t1); qf[5] = __builtin_bit_cast(bf16x8, t2);
    }
    f32x16 oacc[2];
#pragma unroll
    for (int i = 0; i < 16; ++i) { oacc[0][i] = 0.f; oacc[1][i] = 0.f; }
    float mrun = 0.f; f32x2 lsum = {0.f, 0.f};
    const int nkt = 4 * qt + 4, mylim = 4 * qt + (w >> 1);
    const int half = w >> 2;
    const int kkey = F.tid >> 3, kpc = F.tid & 7, rkey = (F.tid & 255) >> 2, rpc = F.tid & 3, ve = F.tid >> 3, vpc = F.tid & 7;
    const bf16_t* knp = Kn + (size_t)(b * SEQ + kkey) * 512 + h * 64 + kpc * 8;
    const bf16_t* kpp = Kp + (size_t)(b * SEQ + rkey) * 32 + rpc * 8;
    const bf16_t* vtp = Vt + (size_t)(h * 64 + ve) * MTOK + b * SEQ + vpc * 8;
    const int kofs = (kkey * ATT_KP + kpc * 8) * 2, rofs = (rkey * ATT_KP + 64 + rpc * 8) * 2, vofs = (ve * ATT_VP + vpc * 8) * 2;
    constexpr bool rp = true;
#define ATT_QK(sv, kbuf, init) do { _Pragma("unroll") for (int t_ = 0; t_ < 2; ++t_) { _Pragma("unroll") for (int i_ = 0; i_ < 16; ++i_) sv[t_][i_] = (init); } \
        const LAS bf16_t* kr_ = (kbuf) + ql * ATT_KP + 8 * hf; bf16x8 ka_ = *(const LAS bf16x8*)kr_, kb_ = *(const LAS bf16x8*)(kr_ + 32 * ATT_KP); \
        _Pragma("unroll") for (int st_ = 0; st_ < 6; ++st_) { bf16x8 na_ = ka_, nb_ = kb_; \
            if (st_ < 5) { na_ = *(const LAS bf16x8*)(kr_ + 16 * (st_ + 1)); nb_ = *(const LAS bf16x8*)(kr_ + 32 * ATT_KP + 16 * (st_ + 1)); } \
            sv[0] = __builtin_amdgcn_mfma_f32_32x32x16_bf16(ka_, qf[st_], sv[0], 0, 0, 0); sv[1] = __builtin_amdgcn_mfma_f32_32x32x16_bf16(kb_, qf[st_], sv[1], 0, 0, 0); \
            ka_ = na_; kb_ = nb_; __builtin_amdgcn_sched_barrier(0); } } while (0)
    u32x4 ak, ar, av, bk, br, bv;
#define ATT_LOAD(K_, R_, V_, t_) do { const int tt_ = (t_) < nkt ? (t_) : nkt - 1; \
        K_ = *(const u32x4*)(knp + (size_t)tt_ * 64 * 512); R_ = *(const u32x4*)(kpp + (size_t)tt_ * 64 * 32); V_ = *(const u32x4*)(vtp + (size_t)tt_ * 64); } while (0)
#define ATT_STAGE(K_, R_, V_, kt_) do { { LAS unsigned char* kb2_ = F.lds + ATT_K0 + (((kt_) + 1) & 1) * ATT_KB; *(LAS u32x4*)(kb2_ + kofs) = K_; *(LAS u32x4*)(kb2_ + rofs) = R_; } \
        *(LAS u32x4*)(F.lds + ATT_V0 + (((kt_) + 1) & 1) * ATT_VB + vofs) = V_; ATT_LOAD(K_, R_, V_, (kt_) + 3); } while (0)
    __syncthreads();
    {
        ak = *(const u32x4*)knp; ar = *(const u32x4*)kpp; av = *(const u32x4*)vtp;
        *(LAS u32x4*)(F.lds + ATT_K0 + kofs) = ak; *(LAS u32x4*)(F.lds + ATT_K0 + rofs) = ar; *(LAS u32x4*)(F.lds + ATT_V0 + vofs) = av;
        ATT_LOAD(ak, ar, av, 1); ATT_LOAD(bk, br, bv, 2);
    }
    __syncthreads();
    f32x16 sc[2];
    if (half == 1) LBAR();
#define ATT_SEG1(kt_, ALL) do { if ((ALL) || (kt_) <= mylim) ATT_QK(sc, (const LAS bf16_t*)(F.lds + ATT_K0 + ((kt_) & 1) * ATT_KB), -mrun); } while (0)
#define ATT_SEG2(kt_, ALL) do { if ((ALL) || (kt_) <= mylim) { \
            const LAS bf16_t* vb = (const LAS bf16_t*)(F.lds + ATT_V0 + ((kt_) & 1) * ATT_VB); \
            int mi = __builtin_bit_cast(int, sc[0][0]); \
            _Pragma("unroll") for (int i = 0; i < 16; ++i) { const int a_ = __builtin_bit_cast(int, sc[0][i]), b_ = __builtin_bit_cast(int, sc[1][i]); mi = max(max(mi, a_), b_); } \
            if ((kt_) == 0 || __builtin_amdgcn_ballot_w64(__builtin_bit_cast(float, mi) > 8.0f) != 0ull) { \
                float mx = fmaxf(sc[0][0], sc[1][0]); \
                _Pragma("unroll") for (int i = 1; i < 16; ++i) mx = fmaxf(mx, fmaxf(sc[0][i], sc[1][i])); \
                { const int mb = __builtin_bit_cast(int, mx); const auto sw2 = __builtin_amdgcn_permlane32_swap(mb, mb, false, false); mx = fmaxf(__builtin_bit_cast(float, (int)sw2[0]), __builtin_bit_cast(float, (int)sw2[1])); } \
                const float delta = ((kt_) == 0) ? mx : fmaxf(mx, 0.f); \
                const float alpha = ((kt_) == 0) ? 1.0f : __builtin_amdgcn_exp2f(-delta); mrun += delta; lsum *= alpha; \
                _Pragma("unroll") for (int i = 0; i < 16; ++i) { oacc[0][i] *= alpha; oacc[1][i] *= alpha; sc[0][i] -= delta; sc[1][i] -= delta; } } \
            _Pragma("unroll") for (int t = 0; t < 2; ++t) _Pragma("unroll") for (int i = 0; i < 16; i += 2) { const float p0 = __builtin_amdgcn_exp2f(sc[t][i]), p1 = __builtin_amdgcn_exp2f(sc[t][i + 1]); sc[t][i] = p0; sc[t][i + 1] = p1; lsum += (f32x2){p0, p1}; } \
            _Pragma("unroll") for (int t = 0; t < 2; ++t) _Pragma("unroll") for (int kbb = 0; kbb < 2; ++kbb) { \
                    u32x4 pw; pw.x = pk2(sc[t][8 * kbb + 0], sc[t][8 * kbb + 1]); pw.y = pk2(sc[t][8 * kbb + 2], sc[t][8 * kbb + 3]); pw.z = pk2(sc[t][8 * kbb + 4], sc[t][8 * kbb + 5]); pw.w = pk2(sc[t][8 * kbb + 6], sc[t][8 * kbb + 7]); \
                    const bf16x8 pf = __builtin_bit_cast(bf16x8, pw); const int key0 = t * 32 + kbb * 16 + 4 * hf; \
                    _Pragma("unroll") for (int eb = 0; eb < 2; ++eb) { const LAS bf16_t* vr = vb + (eb * 32 + ql) * ATT_VP + key0; \
                        const u32x2 lo = *(const LAS u32x2*)vr, hi = *(const LAS u32x2*)(vr + 8); u32x4 vv; vv.x = lo.x; vv.y = lo.y; vv.z = hi.x; vv.w = hi.y; \
                        oacc[eb] = __builtin_amdgcn_mfma_f32_32x32x16_bf16(__builtin_bit_cast(bf16x8, vv), pf, oacc[eb], 0, 0, 0); } } } } while (0)
    const int nall = 4 * qt;
#define ATT_TRIP_L(kt_, ALL) do { ATT_SEG1(kt_, ALL); LBAR(); ATT_STAGE(ak, ar, av, kt_); ATT_SEG2(kt_, ALL); LBAR(); \
                                  ATT_SEG1((kt_) + 1, ALL); LBAR(); ATT_STAGE(bk, br, bv, (kt_) + 1); ATT_SEG2((kt_) + 1, ALL); LBAR(); } while (0)
#define ATT_TRIP_T(kt_, ALL) do { ATT_STAGE(ak, ar, av, kt_); ATT_SEG1(kt_, ALL); LBAR(); ATT_SEG2(kt_, ALL); LBAR(); \
                                  ATT_STAGE(bk, br, bv, (kt_) + 1); ATT_SEG1((kt_) + 1, ALL); LBAR(); ATT_SEG2((kt_) + 1, ALL); LBAR(); } while (0)
    if (half == 0) {
#pragma unroll 1
        for (int kt = 0; kt < nall; kt += 2) ATT_TRIP_L(kt, true);
#pragma unroll 1
        for (int kt = nall; kt < nkt; kt += 2) ATT_TRIP_L(kt, false);
        LBAR();
    } else {
#pragma unroll 1
        for (int kt = 0; kt < nall; kt += 2) ATT_TRIP_T(kt, true);
#pragma unroll 1
        for (int kt = nall; kt < nkt; kt += 2) ATT_TRIP_T(kt, false);
    }
#undef ATT_TRIP_L
#undef ATT_TRIP_T
#undef ATT_QK
#undef ATT_LOAD
#undef ATT_STAGE
#undef ATT_SEG1
#undef ATT_SEG2
    float lrun = lsum[0] + lsum[1];
    const float lt = lrun + __shfl_xor(lrun, 32), inv = 1.0f / lt;
    bf16_t* yo = (bf16_t*)(ws + WS_YMLA) + (size_t)mq * 512 + h * 64;
#pragma unroll
    for (int eb = 0; eb < 2; ++eb)
#pragma unroll
        for (int g = 0; g < 4; ++g) { u32x2 wv; wv.x = pk2(oacc[eb][4 * g] * inv, oacc[eb][4 * g + 1] * inv); wv.y = pk2(oacc[eb][4 * g + 2] * inv, oacc[eb][4 * g + 3] * inv);
            *(u32x2*)(yo + eb * 32 + 8 * g + 4 * hf) = wv; }
}
constexpr int RP = 72;
constexpr int RMAT = 64 * RP;
constexpr size_t RC_UNIT = 40960;
constexpr size_t WS_RC2 = WS_RC + (size_t)2048 * RC_UNIT;

__device__ __forceinline__ void st_g4(bf16_t* p, f32x4 v) { u32x2 w; w.x = pk2(v[0], v[1]); w.y = pk2(v[2], v[3]); *(u32x2*)p = w; }
__device__ __forceinline__ f32x4 ld_l4(const LAS bf16_t* p) { const u32x2 w = *(const LAS u32x2*)p; return (f32x4){bflo(w.x), bfhi(w.x), bflo(w.y), bfhi(w.y)}; }

template <int KS>
__device__ __forceinline__ f32x16 mm32(const LAS bf16_t* P, const LAS bf16_t* Q, int ib, int jb, int lane, f32x16 acc) {
    const LAS bf16_t* pp = P + (ib * 32 + (lane & 31)) * RP + 8 * (lane >> 5);
    const LAS bf16_t* qp = Q + (jb * 32 + (lane & 31)) * RP + 8 * (lane >> 5);
#pragma unroll
    for (int ks = 0; ks < KS; ++ks) { const bf16x8 a = *(const LAS bf16x8*)(qp + ks * 16), b = *(const LAS bf16x8*)(pp + ks * 16); acc = __builtin_amdgcn_mfma_f32_32x32x16_bf16(a, b, acc, 0, 0, 0); }
    return acc;
}
__device__ __forceinline__ f32x16 zero16() { f32x16 z; for (int i = 0; i < 16; ++i) z[i] = 0.f; return z; }
__device__ __forceinline__ void st32_lds(LAS bf16_t* O, int ib, int jb, int lane, const f32x16& a) {
    LAS bf16_t* o = O + (ib * 32 + (lane & 31)) * RP + jb * 32 + 4 * (lane >> 5);
#pragma unroll
    for (int g = 0; g < 4; ++g) st_bf4(o + 8 * g, (f32x4){a[4 * g], a[4 * g + 1], a[4 * g + 2], a[4 * g + 3]});
}
__device__ __forceinline__ void st32_glb(bf16_t* O, int ib, int jb, int lane, const f32x16& a) {
    bf16_t* o = O + (ib * 32 + (lane & 31)) * 64 + jb * 32 + 4 * (lane >> 5);
#pragma unroll
    for (int g = 0; g < 4; ++g) st_g4(o + 8 * g, (f32x4){a[4 * g], a[4 * g + 1], a[4 * g + 2], a[4 * g + 3]});
}
struct PreIn { unsigned short r[8], rp[8], k[8], kp[8], v[8], vp[8], lw[8], a[8]; };
__device__ __forceinline__ void pre_load(PreIn& x, const bf16_t* p, const bf16_t* lo, int u, int w, int lane) {
    const int c = u & 127, h = (u >> 7) & 7, b = u >> 10; const int m0 = b * SEQ + c * 64, ch = h * 64 + lane;
#pragma unroll
    for (int i = 0; i < 8; ++i) { const int t = 8 * w + i, m = m0 + t; const bf16_t* pr = p + (size_t)m * PW + P_RW + ch; const bool hp = (c | t) != 0;
        x.r[i] = pr[0]; x.k[i] = pr[512]; x.v[i] = pr[1024];
        x.rp[i] = hp ? pr[-PW] : (unsigned short)0; x.kp[i] = hp ? pr[512 - PW] : (unsigned short)0; x.vp[i] = hp ? pr[1024 - PW] : (unsigned short)0;
        x.lw[i] = lo[(size_t)m * LO_W + ch]; x.a[i] = lo[(size_t)m * LO_W + 512 + ch]; }
}
#ifdef PRE_T
#define PRE_MARK(k) do { if (F.tid == 0) { volatile LAS unsigned long long* tq_ = (volatile LAS unsigned long long*)(F.lds + LDSCTL_OFF + 48); const unsigned long long now_ = __builtin_amdgcn_s_memrealtime(); \
        if ((k) == PRE_T) tq_[1] += now_ - tq_[2]; tq_[2] = now_; } } while (0)
#else
#define PRE_MARK(k) do { } while (0)
#endif
template <int DIAG = 0>
__device__ __forceinline__ void rwkv_chunk_pre(const Frame& F, const float* mu, const float* k_k_, const float* k_a_, const float* r_k_) {
    unsigned char* ws = F.ws; const bf16_t* p = (const bf16_t*)(ws + WS_P); const bf16_t* lo = (const bf16_t*)(ws + WS_LO);
    LAS bf16_t* M = (LAS bf16_t*)F.lds;
    LAS bf16_t *KKt = M, *Bt = M + RMAT, *Kt = M + 2 * RMAT, *Rt = M + 3 * RMAT, *KKtT = M + 4 * RMAT, *BhT = M + 5 * RMAT, *KhT = M + 6 * RMAT, *VcT = M + 7 * RMAT;
    LAS bf16_t *NA = M + 8 * RMAT, *NAT = M + 9 * RMAT, *TT = M + 10 * RMAT, *AkkT = M + 11 * RMAT, *AbrT = M + 12 * RMAT, *AkrT = M + 13 * RMAT;
    LAS float* SEG = (LAS float*)(M + 10 * RMAT);
    const int lane = F.lane, w = F.wave, pr_ = w >> 1, ib = w & 1;
    const int i0 = ib * 32 + (lane & 31), jq = 4 * (lane >> 5);
    PreIn cur;
    if (F.blk < NB * 8 * NCHUNK) pre_load(cur, p, lo, F.blk, w, lane);
    for (int u = F.blk; u < NB * 8 * NCHUNK; u += F.G) {
        const int h = (u >> 7) & 7; const int ch = h * 64 + lane;
        const float mu_r = mu[ch], mu_k = mu[512 + ch], mu_v = mu[1024 + ch], k_k = k_k_[ch], k_a = k_a_[ch], r_k = r_k_[ch];
        float* aux = DIAG ? (float*)(ws + WS_YMLA) + (size_t)(u & 255) * 128 : (float*)(ws + WS_RC2) + (size_t)u * 128;
        LBAR();
        PRE_MARK(0);
        if (DIAG != 2) {
        float rr[8], kk8[8], k28[8], vv[8], bb[8], lw8[8], cs8[8]; float cs = 0.f;
#pragma unroll
        for (int i = 0; i < 8; ++i) { const int t = 8 * w + i;
            const float xr = bf2f(cur.r[i]), xk = bf2f(cur.k[i]), xv = bf2f(cur.v[i]);
            const float r = xr + (bf2f(cur.rp[i]) - xr) * mu_r, k = xk + (bf2f(cur.kp[i]) - xk) * mu_k, v = xv + (bf2f(cur.vp[i]) - xv) * mu_v;
            const float lw = bf2f(cur.lw[i]), a = bf2f(cur.a[i]);
            float kk = k * k_k; const float ss = wave_sum(kk * kk); kk *= rsqrtf(ss + 1e-12f);
            const float k2 = k * (1.0f + (a - 1.0f) * k_a);
            rr[i] = r; kk8[i] = kk; k28[i] = k2; vv[i] = v; bb[i] = kk * a; lw8[i] = lw; cs += lw; cs8[i] = cs;
            (DIAG ? (bf16_t*)(ws + WS_YRW) + (size_t)(u & 255) * 4096 : (bf16_t*)(ws + WS_RC + (size_t)u * RC_UNIT) + 16384)[t * 64 + lane] = (bf16_t)f2bf(v);
            const float bon = wave_sum(r * k2 * r_k); if (lane == 0) aux[64 + t] = bon; }
        SEG[w * 64 + lane] = cs;
        if (u + F.G < NB * 8 * NCHUNK) pre_load(cur, p, lo, u + F.G, w, lane);
        LBAR();
        float off = 0.f, cumC = 0.f;
#pragma unroll
        for (int s = 0; s < 8; ++s) { const float sv = SEG[s * 64 + lane]; cumC += sv; off += (s < w) ? sv : 0.f; }
        if (w == 0) aux[lane] = __expf(cumC);
        LBAR();
        unsigned pkk[4], pbh[4], pkh[4], pvc[4];
#pragma unroll
        for (int i = 0; i < 8; i += 2) { float o_kk[2], o_bh[2], o_kh[2];
#pragma unroll
            for (int e = 0; e < 2; ++e) { const int t = 8 * w + i + e; const float cum = cs8[i + e] + off;
                const float om = __expf(cum), omx = __expf(cum - lw8[i + e]), iom = __expf(-cum), ih = __expf(cumC - cum);
                o_kk[e] = kk8[i + e] * omx; o_bh[e] = bb[i + e] * ih; o_kh[e] = k28[i + e] * ih;
                KKt[t * RP + lane] = (bf16_t)f2bf(o_kk[e]); Bt[t * RP + lane] = (bf16_t)f2bf(bb[i + e] * iom); Kt[t * RP + lane] = (bf16_t)f2bf(k28[i + e] * iom); Rt[t * RP + lane] = (bf16_t)f2bf(rr[i + e] * om); }
            pkk[i >> 1] = pk2(o_kk[0], o_kk[1]); pbh[i >> 1] = pk2(o_bh[0], o_bh[1]); pkh[i >> 1] = pk2(o_kh[0], o_kh[1]); pvc[i >> 1] = pk2(vv[i], vv[i + 1]); }
        *(LAS u32x4*)(KKtT + lane * RP + 8 * w) = (u32x4){pkk[0], pkk[1], pkk[2], pkk[3]}; *(LAS u32x4*)(BhT + lane * RP + 8 * w) = (u32x4){pbh[0], pbh[1], pbh[2], pbh[3]};
        *(LAS u32x4*)(KhT + lane * RP + 8 * w) = (u32x4){pkh[0], pkh[1], pkh[2], pkh[3]}; *(LAS u32x4*)(VcT + lane * RP + 8 * w) = (u32x4){pvc[0], pvc[1], pvc[2], pvc[3]};
        }
        LBAR();
        PRE_MARK(1);
        if (DIAG != 1) {
        {
            const LAS bf16_t* Pm = pr_ < 2 ? KKt : Rt; const LAS bf16_t* Qm = (pr_ == 0 || pr_ == 2) ? Bt : Kt; LAS bf16_t* Om = pr_ == 0 ? NAT : (pr_ == 1 ? AkkT : (pr_ == 2 ? AbrT : AkrT));
            const bool incl = pr_ >= 2; const float sgn = pr_ == 0 ? -1.0f : 1.0f;
#pragma unroll
            for (int jb = 0; jb < 2; ++jb) { f32x16 a = zero16(); if (jb <= ib) a = mm32<4>(Pm, Qm, ib, jb, lane, a);
#pragma unroll
                for (int g = 0; g < 4; ++g)
#pragma unroll
                    for (int r = 0; r < 4; ++r) { const int jj = jb * 32 + 8 * g + jq + r; const bool keep = incl ? (jj <= i0) : (jj < i0); a[4 * g + r] = keep ? sgn * a[4 * g + r] : 0.f; }
                st32_lds(Om, ib, jb, lane, a);
                if (pr_ == 0) {
#pragma unroll
                    for (int g = 0; g < 4; ++g)
#pragma unroll
                        for (int r = 0; r < 4; ++r) { const int jj = jb * 32 + 8 * g + jq + r; a[4 * g + r] += (jj == i0) ? 1.0f : 0.f; }
                    st32_lds(TT, ib, jb, lane, a); } }
            if (pr_ == 0) {
#pragma unroll
                for (int jb = 0; jb < 2; ++jb) { f32x16 a = zero16(); if (jb >= ib) a = mm32<4>(Bt, KKt, ib, jb, lane, a);
#pragma unroll
                    for (int g = 0; g < 4; ++g)
#pragma unroll
                        for (int r = 0; r < 4; ++r) { const int jj = jb * 32 + 8 * g + jq + r; a[4 * g + r] = (i0 < jj) ? -a[4 * g + r] : 0.f; }
                    st32_lds(NA, ib, jb, lane, a); } }
        }
        LBAR();
        PRE_MARK(2);
        LAS bf16_t* VA = Kt;
#pragma unroll 1
        for (int s = 1; s <= 6; ++s) {
            const LAS bf16_t* Yo = (s & 1) ? NAT : KKt; const LAS bf16_t* YoT = (s & 1) ? NA : Bt; LAS bf16_t* Yn = (s & 1) ? KKt : NAT; LAS bf16_t* YnT = (s & 1) ? Bt : NA;
            if (pr_ == 0) {
                if (s == 1) { const f32x16 a0 = mm32<4>(VcT, AkkT, ib, 0, lane, zero16()), a1 = mm32<4>(VcT, AkkT, ib, 1, lane, zero16()); st32_lds(VA, ib, 0, lane, a0); st32_lds(VA, ib, 1, lane, a1); }
                else {
                    f32x16 c0, c1; const LAS bf16_t* tr = TT + i0 * RP + jq;
#pragma unroll
                    for (int g = 0; g < 4; ++g) { const f32x4 x0 = ld_l4(tr + 8 * g), x1 = ld_l4(tr + 32 + 8 * g);
#pragma unroll
                        for (int r = 0; r < 4; ++r) { c0[4 * g + r] = x0[r]; c1[4 * g + r] = x1[r]; } }
                    c0 = mm32<4>(TT, YoT, ib, 0, lane, c0); c1 = mm32<4>(TT, YoT, ib, 1, lane, c1);
                    LDS_WAIT();
                    st32_lds(TT, ib, 0, lane, c0); st32_lds(TT, ib, 1, lane, c1); }
            } else if (pr_ <= 2 && s <= 5) {
                const LAS bf16_t* Pm = pr_ == 1 ? Yo : YoT; const LAS bf16_t* Qm = pr_ == 1 ? YoT : Yo; LAS bf16_t* Om = pr_ == 1 ? Yn : YnT;
                const f32x16 a0 = mm32<4>(Pm, Qm, ib, 0, lane, zero16()), a1 = mm32<4>(Pm, Qm, ib, 1, lane, zero16()); st32_lds(Om, ib, 0, lane, a0); st32_lds(Om, ib, 1, lane, a1);
            }
            LBAR();
        }
        PRE_MARK(3);
        LAS bf16_t* KT = NAT; LAS bf16_t* P1 = NA;
        if (pr_ < 2) { const LAS bf16_t* src = pr_ == 0 ? KKtT : VA; LAS bf16_t* dst = pr_ == 0 ? KT : P1;
            const f32x16 a0 = mm32<4>(src, TT, ib, 0, lane, zero16()), a1 = mm32<4>(src, TT, ib, 1, lane, zero16()); st32_lds(dst, ib, 0, lane, a0); st32_lds(dst, ib, 1, lane, a1); }
        LBAR();
        {
            bf16_t* og = DIAG ? (bf16_t*)(ws + WS_YRW) + (size_t)(u & 255) * 4096 : (bf16_t*)(ws + WS_RC + (size_t)u * RC_UNIT) + pr_ * 4096;
#pragma unroll
            for (int jb = 0; jb < 2; ++jb) { f32x16 o;
                if (pr_ == 0) o = mm32<4>(BhT, KT, ib, jb, lane, zero16());
                else if (pr_ == 1) { const f32x16 x = mm32<4>(VcT, KhT, ib, jb, lane, zero16()), y = mm32<4>(P1, BhT, ib, jb, lane, zero16()); o = x - y; }
                else if (pr_ == 2) { const f32x16 y = mm32<4>(AbrT, KT, ib, jb, lane, zero16()); const LAS bf16_t* rt = Rt + i0 * RP + jb * 32 + jq;
#pragma unroll
                    for (int g = 0; g < 4; ++g) { const f32x4 x = ld_l4(rt + 8 * g);
#pragma unroll
                        for (int r = 0; r < 4; ++r) o[4 * g + r] = x[r] - y[4 * g + r]; } }
                else { const f32x16 x = mm32<4>(VcT, AkrT, ib, jb, lane, zero16()), y = mm32<4>(P1, AbrT, ib, jb, lane, zero16()); o = x - y; }
                st32_glb(og, ib, jb, lane, o); }
        }
        }
        PRE_MARK(4);
    }
    __syncthreads();
}

struct ScanOps { u32x4 fa0, fa1; u32x2 ad0, ad1; f32x4 om; };
__device__ __forceinline__ ScanOps scan_load(const unsigned char* ws, size_t u, int sk, int vh, int l15, int l4) {
    ScanOps o; const bf16_t* base = (const bf16_t*)(ws + WS_RC + u * RC_UNIT);
    o.fa0 = *(const u32x4*)(base + (sk * 16 + l15) * 64 + 8 * l4); o.fa1 = *(const u32x4*)(base + (sk * 16 + l15) * 64 + 32 + 8 * l4);
    o.ad0 = *(const u32x2*)(base + 4096 + ((2 * vh) * 16 + l15) * 64 + sk * 16 + 4 * l4); o.ad1 = *(const u32x2*)(base + 4096 + ((2 * vh + 1) * 16 + l15) * 64 + sk * 16 + 4 * l4);
    o.om = *(const f32x4*)((const float*)(ws + WS_RC2) + u * 128 + sk * 16 + 4 * l4); return o;
}
template <bool STORE>
__device__ __forceinline__ void rwkv_scan(const Frame& F, int b, int h) {
    unsigned char* ws = F.ws;
    LAS bf16_t* Sb = (LAS bf16_t*)F.lds;
    const int lane = F.lane, w = F.wave, l15 = lane & 15, l4 = lane >> 4, sk = w & 3, vh = w >> 2;
    for (int i = F.tid; i < 2 * RMAT / 2; i += NTHR) ((LAS unsigned*)Sb)[i] = 0u;
    const size_t u0 = (size_t)(b * 8 + h) * 128;
    f32x4 st0 = {0.f, 0.f, 0.f, 0.f}, st1 = {0.f, 0.f, 0.f, 0.f};
    ScanOps r0 = scan_load(ws, u0 + 0, sk, vh, l15, l4), r1 = scan_load(ws, u0 + 1, sk, vh, l15, l4), r2 = scan_load(ws, u0 + 2, sk, vh, l15, l4), r3 = scan_load(ws, u0 + 3, sk, vh, l15, l4);
    __syncthreads();
#define SCAN_STEP(R, cc) do { const int c_ = (cc); \
        const LAS bf16_t* Sc = Sb + (c_ & 1) * RMAT; LAS bf16_t* Sn = Sb + ((c_ + 1) & 1) * RMAT; \
        const bf16x8 a0 = __builtin_bit_cast(bf16x8, R.fa0), a1 = __builtin_bit_cast(bf16x8, R.fa1); \
        const LAS bf16_t* sp0 = Sc + ((2 * vh) * 16 + l15) * RP + 8 * l4; const LAS bf16_t* sp1 = sp0 + 16 * RP; \
        const bf16x8 s00 = *(const LAS bf16x8*)sp0, s01 = *(const LAS bf16x8*)(sp0 + 32), s10 = *(const LAS bf16x8*)sp1, s11 = *(const LAS bf16x8*)(sp1 + 32); \
        bf16_t* sg = (bf16_t*)(ws + WS_RC + (u0 + c_ - 1) * RC_UNIT) + 4096;     \
        if (STORE && c_ > 0) *(u32x4*)(sg + (F.tid >> 3) * 64 + (F.tid & 7) * 8) = *(const LAS u32x4*)(Sc + (F.tid >> 3) * RP + (F.tid & 7) * 8);     \
        f32x4 t0 = {0.f, 0.f, 0.f, 0.f}, t1 = {0.f, 0.f, 0.f, 0.f}; \
        t0 = __builtin_amdgcn_mfma_f32_16x16x32_bf16(a0, s00, t0, 0, 0, 0); t1 = __builtin_amdgcn_mfma_f32_16x16x32_bf16(a0, s10, t1, 0, 0, 0); \
        t0 = __builtin_amdgcn_mfma_f32_16x16x32_bf16(a1, s01, t0, 0, 0, 0); t1 = __builtin_amdgcn_mfma_f32_16x16x32_bf16(a1, s11, t1, 0, 0, 0); \
        const f32x4 n0 = {bflo(R.ad0.x), bfhi(R.ad0.x), bflo(R.ad0.y), bfhi(R.ad0.y)}, n1 = {bflo(R.ad1.x), bfhi(R.ad1.x), bflo(R.ad1.y), bfhi(R.ad1.y)}; \
        st0 = st0 * R.om - t0 + n0; st1 = st1 * R.om - t1 + n1; \
        st_bf4(Sn + ((2 * vh) * 16 + l15) * RP + sk * 16 + 4 * l4, st0); st_bf4(Sn + ((2 * vh + 1) * 16 + l15) * RP + sk * 16 + 4 * l4, st1); \
        R = scan_load(ws, u0 + (c_ + 4 < NCHUNK ? c_ + 4 : NCHUNK - 1), sk, vh, l15, l4);     \
        LBAR(); } while (0)
#pragma unroll 1
    for (int c = 0; c < NCHUNK; c += 16) {
#pragma unroll
        for (int j = 0; j < 16; j += 4) { SCAN_STEP(r0, c + j); SCAN_STEP(r1, c + j + 1); SCAN_STEP(r2, c + j + 2); SCAN_STEP(r3, c + j + 3); } }
#undef SCAN_STEP
}

struct OutOps { bf16x8 q0, q1, s00, s01, s10, s11; u32x2 z0, z1; u32x4 cv, cg; float cbc; };
__device__ __forceinline__ OutOps out_load(const unsigned char* ws, int u, int tb, int vh, int l15, int l4, int tt, int c8) {
    OutOps o; const int c = u & 127, h = (u >> 7) & 7, b = u >> 10;
    const bf16_t* base = (const bf16_t*)(ws + WS_RC + (size_t)u * RC_UNIT);
    const bf16_t* Sg = (const bf16_t*)(ws + WS_RC + (size_t)(u > 0 ? u - 1 : 0) * RC_UNIT) + 4096; const bf16_t* QT = base + 8192; const bf16_t* Z = base + 12288;
    o.q0 = *(const bf16x8*)(QT + (tb * 16 + l15) * 64 + 8 * l4); o.q1 = *(const bf16x8*)(QT + (tb * 16 + l15) * 64 + 32 + 8 * l4);
    const bf16_t* sp0 = Sg + ((2 * vh) * 16 + l15) * 64 + 8 * l4; const bf16_t* sp1 = sp0 + 16 * 64;
    o.s00 = *(const bf16x8*)sp0; o.s01 = *(const bf16x8*)(sp0 + 32); o.s10 = *(const bf16x8*)sp1; o.s11 = *(const bf16x8*)(sp1 + 32);
    o.z0 = *(const u32x2*)(Z + ((2 * vh) * 16 + l15) * 64 + tb * 16 + 4 * l4); o.z1 = *(const u32x2*)(Z + ((2 * vh + 1) * 16 + l15) * 64 + tb * 16 + 4 * l4);
    const int m = b * SEQ + c * 64 + tt, chq = h * 64 + c8;
    o.cv = *(const u32x4*)(base + 16384 + tt * 64 + c8); o.cg = *(const u32x4*)((const bf16_t*)(ws + WS_LO) + (size_t)m * LO_W + 1024 + chq);
    o.cbc = ((const float*)(ws + WS_RC2))[(size_t)u * 128 + 64 + tt]; return o;
}
__device__ __forceinline__ void rwkv_out(const Frame& F, const float* lnx_) {
    unsigned char* ws = F.ws;
    LAS float* Yl = (LAS float*)F.lds;
    const int lane = F.lane, w = F.wave, l15 = lane & 15, l4 = lane >> 4, tb = w & 3, vh = w >> 2;
    const int tt = F.tid >> 3, c8 = (F.tid & 7) * 8;
    OutOps cur = out_load(ws, F.blk, tb, vh, l15, l4, tt, c8);
    for (int u = F.blk; u < NB * 8 * NCHUNK; u += F.G) {
        const int c = u & 127, h = (u >> 7) & 7, b = u >> 10;
        const OutOps o = cur;
        { const int un = u + F.G < NB * 8 * NCHUNK ? u + F.G : u; cur = out_load(ws, un, tb, vh, l15, l4, tt, c8); }
        f32x4 y0 = {bflo(o.z0.x), bfhi(o.z0.x), bflo(o.z0.y), bfhi(o.z0.y)}, y1 = {bflo(o.z1.x), bfhi(o.z1.x), bflo(o.z1.y), bfhi(o.z1.y)};
        if (c > 0) {
            y0 = __builtin_amdgcn_mfma_f32_16x16x32_bf16(o.q0, o.s00, y0, 0, 0, 0); y1 = __builtin_amdgcn_mfma_f32_16x16x32_bf16(o.q0, o.s10, y1, 0, 0, 0);
            y0 = __builtin_amdgcn_mfma_f32_16x16x32_bf16(o.q1, o.s01, y0, 0, 0, 0); y1 = __builtin_amdgcn_mfma_f32_16x16x32_bf16(o.q1, o.s11, y1, 0, 0, 0); }
        const int m = b * SEQ + c * 64 + tt, chq = h * 64 + c8;
        const f32x4 ln0 = *(const f32x4*)(lnx_ + chq), ln1 = *(const f32x4*)(lnx_ + chq + 4);
        LBAR();
#pragma unroll
        for (int r = 0; r < 4; ++r) { Yl[(tb * 16 + 4 * l4 + r) * 68 + (2 * vh) * 16 + l15] = y0[r]; Yl[(tb * 16 + 4 * l4 + r) * 68 + (2 * vh + 1) * 16 + l15] = y1[r]; }
        LBAR();
        const f32x4 ya = *(const LAS f32x4*)(Yl + tt * 68 + c8), yb = *(const LAS f32x4*)(Yl + tt * 68 + c8 + 4);
        float yy[8] = {ya[0], ya[1], ya[2], ya[3], yb[0], yb[1], yb[2], yb[3]};
        float s1 = ((yy[0] + yy[1]) + (yy[2] + yy[3])) + ((yy[4] + yy[5]) + (yy[6] + yy[7]));
        s1 = sum8(s1); const float mean = s1 * (1.0f / 64.0f); float s2 = 0.f;
#pragma unroll
        for (int i = 0; i < 8; ++i) { yy[i] -= mean; s2 += yy[i] * yy[i]; }
        s2 = sum8(s2); const float rstd = rsqrtf(s2 * (1.0f / 64.0f) + 64e-5f);
        const unsigned vw[4] = {o.cv.x, o.cv.y, o.cv.z, o.cv.w}, gw[4] = {o.cg.x, o.cg.y, o.cg.z, o.cg.w};
        const float lnx[8] = {ln0[0], ln0[1], ln0[2], ln0[3], ln1[0], ln1[1], ln1[2], ln1[3]};
        unsigned ow[4];
#pragma unroll
        for (int i = 0; i < 4; ++i) { float o2[2];
#pragma unroll
            for (int e = 0; e < 2; ++e) { const int ci = 2 * i + e; const float v = e ? bfhi(vw[i]) : bflo(vw[i]), g = e ? bfhi(gw[i]) : bflo(gw[i]);
                o2[e] = (yy[ci] * rstd * lnx[ci] + o.cbc * v) * g; }
            ow[i] = pk2(o2[0], o2[1]); }
        *(u32x4*)((bf16_t*)(ws + WS_YRW) + (size_t)m * 512 + chq) = (u32x4){ow[0], ow[1], ow[2], ow[3]};
    }
    __syncthreads();
}
__device__ __forceinline__ void rwkv_seq(const Frame& F, const Params& P, int layer, int b, int h) {
    unsigned char* ws = F.ws; const bf16_t* p = (const bf16_t*)(ws + WS_P); const bf16_t* lo = (const bf16_t*)(ws + WS_LO);
    LAS float* Lr = (LAS float*)F.lds; LAS float* Lw = Lr + 4096; LAS float* Lk = Lw + 4096; LAS float* Lv = Lk + 4096; LAS float* Lkk = Lv + 4096; LAS float* Lb = Lkk + 4096; LAS float* Ly = Lb + 4096;
    const int lane = F.lane, ch = h * 64 + lane;
    const float mu_r = P.in[I_MU][(size_t)layer * RWKV_COLS + ch], mu_k = P.in[I_MU][(size_t)layer * RWKV_COLS + 512 + ch], mu_v = P.in[I_MU][(size_t)layer * RWKV_COLS + 1024 + ch];
    const float k_k = P.in[I_KK][layer * 512 + ch], k_a = P.in[I_KA][layer * 512 + ch], r_k = P.in[I_RK][layer * 512 + ch], lnx = P.in[I_LNX][layer * 512 + ch];
    const int vrow = F.tid >> 3, q = F.tid & 7;
    float s[8];
#pragma unroll
    for (int i = 0; i < 8; ++i) s[i] = 0.f;
    for (int c = 0; c < NCHUNK; ++c) {
        const int m0 = b * SEQ + c * 64;
        __syncthreads();
#pragma unroll
        for (int i = 0; i < 8; ++i) { const int t = F.wave + 8 * i, m = m0 + t; const bf16_t* pr = p + (size_t)m * PW + P_RW + ch; const bool hp = (c | t) != 0;
            const float xr = bf2f(pr[0]), xk = bf2f(pr[512]), xv = bf2f(pr[1024]);
            const float pr_ = hp ? bf2f(pr[-PW]) : 0.f, pk_ = hp ? bf2f(pr[512 - PW]) : 0.f, pv_ = hp ? bf2f(pr[1024 - PW]) : 0.f;
            const float r = xr + (pr_ - xr) * mu_r, k = xk + (pk_ - xk) * mu_k, v = xv + (pv_ - xv) * mu_v;
            const float lw = bf2f(lo[(size_t)m * LO_W + ch]), a = bf2f(lo[(size_t)m * LO_W + 512 + ch]);
            float kk = k * k_k; const float ss = wave_sum(kk * kk); kk *= rsqrtf(ss + 1e-12f);
            Lr[t * 64 + lane] = r; Lw[t * 64 + lane] = __expf(lw); Lk[t * 64 + lane] = k * (1.0f + (a - 1.0f) * k_a); Lv[t * 64 + lane] = v; Lkk[t * 64 + lane] = kk; Lb[t * 64 + lane] = kk * a; }
        __syncthreads();
        for (int t = 0; t < 64; ++t) {
            const f32x4 ka = *(const LAS f32x4*)(Lkk + t * 64 + q * 8), kb = *(const LAS f32x4*)(Lkk + t * 64 + q * 8 + 4);
            const f32x4 wa = *(const LAS f32x4*)(Lw + t * 64 + q * 8), wb = *(const LAS f32x4*)(Lw + t * 64 + q * 8 + 4);
            const f32x4 ba = *(const LAS f32x4*)(Lb + t * 64 + q * 8), bb = *(const LAS f32x4*)(Lb + t * 64 + q * 8 + 4);
            const f32x4 k2a = *(const LAS f32x4*)(Lk + t * 64 + q * 8), k2b = *(const LAS f32x4*)(Lk + t * 64 + q * 8 + 4);
            const f32x4 ra = *(const LAS f32x4*)(Lr + t * 64 + q * 8), rb = *(const LAS f32x4*)(Lr + t * 64 + q * 8 + 4);
            const float vv = Lv[t * 64 + vrow];
            float sa = 0.f;
#pragma unroll
            for (int i = 0; i < 4; ++i) { sa += s[i] * ka[i]; sa += s[4 + i] * kb[i]; }
            sa = sum8(sa); sa = -sa;
            float y = 0.f;
#pragma unroll
            for (int i = 0; i < 4; ++i) { s[i] = s[i] * wa[i] + sa * ba[i] + vv * k2a[i]; s[4 + i] = s[4 + i] * wb[i] + sa * bb[i] + vv * k2b[i]; y += s[i] * ra[i]; y += s[4 + i] * rb[i]; }
            y = sum8(y);
            if (q == 0) Ly[t * 64 + vrow] = y;
        }
        __syncthreads();
#pragma unroll
        for (int i = 0; i < 8; ++i) { const int t = F.wave + 8 * i, m = m0 + t;
            const float y = Ly[t * 64 + lane]; const float mean = wave_sum(y) * (1.0f / 64.0f); const float d = y - mean; const float var = wave_sum(d * d) * (1.0f / 64.0f);
            const float bon = wave_sum(Lr[t * 64 + lane] * Lk[t * 64 + lane] * r_k);
            const float g = bf2f(lo[(size_t)m * LO_W + 1024 + ch]);
            const float o = (d * rsqrtf(var + 64e-5f) * lnx + bon * Lv[t * 64 + lane]) * g;
            ((bf16_t*)(ws + WS_YRW))[(size_t)m * 512 + ch] = (bf16_t)f2bf(o); }
    }
    __syncthreads();
}

constexpr int LDS_TAB = LDSCTL_OFF + 64;
__device__ __forceinline__ void moe_table(const Frame& F, const unsigned* ectl) {
    LAS int* tab = (LAS int*)(F.lds + LDS_TAB);
    if (F.tid < 64) {
        const int cl = (int)__hip_atomic_load(&ectl[F.tid & 7], __ATOMIC_RELAXED, __HIP_MEMORY_SCOPE_AGENT);
        int st = 0, nt = 0;
#pragma unroll
        for (int e = 0; e < 8; ++e) { const int c = __shfl(cl, e); const int t = (c + 255) >> 8;
            if (F.tid == 0) { tab[1 + e] = st; for (int i = 0; i < t; ++i) tab[16 + nt + i] = e; }
            nt += t; st += t * 256; }
        if (F.tid == 0) tab[0] = nt; }
    __syncthreads();
}
__device__ __forceinline__ void phase_moe_scatter(const Frame& F, const unsigned* ectl) {
    unsigned char* ws = F.ws; const LAS int* tab = (const LAS int*)(F.lds + LDS_TAB);
    const int* tok_e = (const int*)(ws + WS_TOK); int* tok_slot = (int*)tok_e + 2 * MTOK; const float* tok_w = (const float*)(tok_slot + 2 * MTOK);
    int* row_tok = (int*)(tok_w + 2 * MTOK); float* row_w = (float*)(row_tok + MAXROWS);
    for (int i = F.blk * NTHR + F.tid; i < 2 * MTOK; i += F.G * NTHR) { const int e = tok_e[i]; const int dest = tab[1 + e] + tok_slot[i]; row_tok[dest] = i >> 1; row_w[dest] = tok_w[i]; tok_slot[i] = dest; }
    const int gt = F.blk * NTHR + F.tid;
    if (gt < 2048) { const int e = gt >> 8; const int c = (int)__hip_atomic_load(&ectl[e], __ATOMIC_RELAXED, __HIP_MEMORY_SCOPE_AGENT); const int r = c + (gt & 255);
        if (r < ((c + 255) & ~255)) { row_tok[tab[1 + e] + r] = -1; row_w[tab[1 + e] + r] = 0.f; } }
}
constexpr int LDS_GTAB = RING_BYTES;
__device__ __forceinline__ void moe_gather_table(const Frame& F, int ncol) {
    const LAS int* tab = (const LAS int*)(F.lds + LDS_TAB); LAS unsigned* gt = (LAS unsigned*)(F.lds + LDS_GTAB);
    const int* row_tok = (const int*)(F.ws + WS_TOK) + 6 * MTOK; const int total = tab[0] * ncol;
    int tk5[5];
#pragma unroll
    for (int k = 0; k < 5; ++k) { const int i = F.tid + k * NTHR; const int u = i >> 8, r = i & 255; const int L = u * F.G + F.blk; const bool ok = i < 9 * 256 && L < total;
        tk5[k] = row_tok[ok ? (L / ncol) * 256 + r : 0]; tk5[k] = ok ? tk5[k] : 0; }
#pragma unroll
    for (int k = 0; k < 5; ++k) { const int i = F.tid + k * NTHR; if (i < 9 * 256) gt[i] = tk5[k] > 0 ? (unsigned)tk5[k] * (unsigned)(DM * 2) : 0u; }
    __syncthreads();
}

extern __shared__ __attribute__((aligned(16))) unsigned char lds_raw[];
template <class T> __device__ __forceinline__ T* uni(T* p) { const unsigned long long v = (unsigned long long)p; const unsigned lo = __builtin_amdgcn_readfirstlane((unsigned)v), hi = __builtin_amdgcn_readfirstlane((unsigned)(v >> 32)); return (T*)(((unsigned long long)hi << 32) | lo); }
__device__ __forceinline__ int uni(int v) { return __builtin_amdgcn_readfirstlane(v); }
__device__ __forceinline__ Frame mkframe(unsigned char* ws, int wv) {
    Frame F; F.lds = (LAS unsigned char*)lds_raw; int tid = wv * 64 + lane_id_fresh(); F.tid = tid; F.lane = F.tid & 63; F.wave = __builtin_amdgcn_readfirstlane(F.tid >> 6);
    int blk = blockIdx.x; asm volatile("" : "+s"(blk)); F.blk = blk; F.G = gridDim.x; F.vcu = (F.blk & 7) * (F.G >> 3) + (F.blk >> 3); F.gw = F.blk * NWAVES + F.wave; F.ngw = F.G * NWAVES; F.ws = ws; return F;
}
#define PHASE __device__ __forceinline__ void
template <int PART>
PHASE f_moe_convert(int wv, unsigned char* ws_, const float* mg, const float* mu, const float* md) {
    unsigned char* ws = uni(ws_); const Frame F = mkframe(ws, wv); Params P; P.in[I_MG] = uni(mg); P.in[I_MU2] = uni(mu); P.in[I_MD] = uni(md);
    if (PART == 0) { __syncthreads(); phase_moe_convert<0>(F, P, F.gw, F.ngw); }
    else if (F.blk >= 32) { __syncthreads(); phase_moe_convert<1>(F, P, (F.blk - 32) * NWAVES + F.wave, (F.G - 32) * NWAVES); }
}
PHASE f_rms_moe(int wv, unsigned char* ws_, const float* gain, const float* router) {
    unsigned char* ws = uni(ws_); const Frame F = mkframe(ws, wv); int* tok_e = (int*)(ws + WS_TOK); int* tok_slot = tok_e + 2 * MTOK; float* tok_w = (float*)(tok_slot + 2 * MTOK);
    phase_rms<true>(F, (const bf16_t*)(ws + WS_HN), uni(gain), (bf16_t*)(ws + WS_HN2), uni(router), (unsigned*)(ws + WS_CTL) + CW_ECNT, tok_e, tok_slot, tok_w);
}
PHASE f_prep(int wv, unsigned char* ws_, const float* mu, const float* qnorm, const float* kvnorm, int layer_) {
    unsigned char* ws = uni(ws_); const Frame F = mkframe(ws, wv); Params P; P.in[I_MU] = uni(mu); P.in[I_QNORM] = uni(qnorm); P.in[I_KVNORM] = uni(kvnorm); (void)layer_; phase_prep(F, P, 0);
}
PHASE f_ret_scan(int wv, unsigned char* ws_) { unsigned char* ws = uni(ws_); const Frame F = mkframe(ws, wv); ret_scan(F); }
PHASE f_ret_out(int wv, unsigned char* ws_) { unsigned char* ws = uni(ws_); const Frame F = mkframe(ws, wv); ret_out(F); }
PHASE f_rwkv_seq(int wv, unsigned char* ws_, const float* mu, const float* kk, const float* ka, const float* rk, const float* lnx, int layer_) {
    unsigned char* ws = uni(ws_); const Frame F = mkframe(ws, wv); Params P; P.in[I_MU] = uni(mu); P.in[I_KK] = uni(kk); P.in[I_KA] = uni(ka); P.in[I_RK] = uni(rk); P.in[I_LNX] = uni(lnx);
    (void)layer_; rwkv_seq(F, P, 0, F.blk >> 3, F.blk & 7);
}
PHASE f_rwkv_pre(int wv, unsigned char* ws_, const float* mu, const float* kk, const float* ka, const float* rk) { unsigned char* ws = uni(ws_); const Frame F = mkframe(ws, wv); rwkv_chunk_pre<0>(F, uni(mu), uni(kk), uni(ka), uni(rk));
#ifdef PRE_DIAG
    rwkv_chunk_pre<PRE_DIAG>(F, uni(mu), uni(kk), uni(ka), uni(rk));
#endif
}
PHASE f_rwkv_scan(int wv, unsigned char* ws_) { unsigned char* ws = uni(ws_); const Frame F = mkframe(ws, wv); rwkv_scan<true>(F, F.blk >> 3, F.blk & 7);
#ifdef SCAN_TWICE
    __syncthreads(); rwkv_scan<false>(F, F.blk >> 3, F.blk & 7);
#endif
}
PHASE f_rwkv_out(int wv, unsigned char* ws_, const float* lnx) { unsigned char* ws = uni(ws_); const Frame F = mkframe(ws, wv); rwkv_out(F, uni(lnx)); }
PHASE f_attn(int wv, unsigned char* ws_, int layer_) {
    unsigned char* ws = uni(ws_); const int layer = uni(layer_); const Frame F = mkframe(ws, wv);
    unsigned* qh = (unsigned*)(ws + WS_CTL) + CW_ATTQ + layer * 512; volatile LAS unsigned* slot = (volatile LAS unsigned*)(F.lds + LDSCTL_OFF + 32);
    const int my = (int)(xb_xcc_id() & 7u);
    volatile LAS unsigned* snap = (volatile LAS unsigned*)(F.lds + LDSCTL_OFF + 1024);
    for (int k = 0; k < 8; ++k) { const int q = (my + k) & 7;
        if (k == 1) { if (F.tid < 8) snap[F.tid] = __hip_atomic_load(qh + F.tid * 64, __ATOMIC_RELAXED, __HIP_MEMORY_SCOPE_AGENT); __syncthreads(); }
        if (k >= 1 && snap[q] >= 64u) continue;
        for (;;) {
            if (F.tid == 0) *slot = __hip_atomic_fetch_add(qh + q * 64, 1u, __ATOMIC_RELAXED, __HIP_MEMORY_SCOPE_AGENT);
            __syncthreads();
            const int idx = (int)*slot;
            __syncthreads();
            if (idx >= 64) break;
            const int bh = 2 * q + (idx & 1), qt = 31 - (idx >> 1);
            attn_unit(F, bh >> 3, bh & 7, qt);
        } }
}
PHASE f_moe_scatter(int wv, unsigned char* ws_) { unsigned char* ws = uni(ws_); const Frame F = mkframe(ws, wv); moe_table(F, (unsigned*)(ws + WS_CTL) + CW_ECNT); phase_moe_scatter(F, (unsigned*)(ws + WS_CTL) + CW_ECNT); }
PHASE f_final(int wv, unsigned char* ws_, float* h, const float* gain) { unsigned char* ws = uni(ws_); const Frame F = mkframe(ws, wv); phase_final(F, uni(h), (const bf16_t*)(ws + WS_HN), uni(gain), (const bf16_t*)(ws + WS_OUT2), (const int*)(ws + WS_TOK) + 2 * MTOK); }
constexpr int DEFER_BLK0 = 128;
PHASE f_defer_a(int wv, unsigned char* ws_, const float* wqb, const float* wbr, const float* wo, const float* fg, const float* fu, const float* fd, const float* w2, const float* a2, const float* g2, const float* wkvb, const float* pos, const float* fnorm) {
    unsigned char* ws = uni(ws_); const Frame F = mkframe(ws, wv); Params P; P.in[I_WIN] = nullptr; P.in[I_WQB] = uni(wqb); P.in[I_WBR] = uni(wbr); P.in[I_WO] = uni(wo); P.in[I_FG] = uni(fg); P.in[I_FU] = uni(fu); P.in[I_FD] = uni(fd);
    P.in[I_W2] = uni(w2); P.in[I_A2] = uni(a2); P.in[I_G2] = uni(g2); P.in[I_WKVB] = uni(wkvb); P.in[I_POS] = uni(pos); P.in[I_FNORM] = uni(fnorm); P.in[I_ANORM] = nullptr;
    __syncthreads();
    constexpr int NW = (256 - DEFER_BLK0) * NWAVES, NA = pro::NIT - 2 * pro::I_IN;
    pro_tiles<NA / NW>(F, P, 2 * pro::I_IN, (F.blk - DEFER_BLK0) * NWAVES + F.wave, NW, NA % NW);
    pro_small(F, P, (F.blk - DEFER_BLK0) * NTHR + F.tid, (256 - DEFER_BLK0) * NTHR, F.blk - DEFER_BLK0, 256 - DEFER_BLK0);
}
PHASE f_defer_b(int wv, unsigned char* ws_, const float* win, const float* anorm) {
    unsigned char* ws = uni(ws_); const Frame F = mkframe(ws, wv); Params P; P.in[I_WIN] = uni(win); P.in[I_ANORM] = uni(anorm); P.in[I_FNORM] = nullptr; P.in[I_WQB] = nullptr; P.in[I_WBR] = nullptr; P.in[I_WO] = nullptr; P.in[I_FG] = nullptr; P.in[I_FU] = nullptr; P.in[I_FD] = nullptr;
    __syncthreads();
    constexpr int NW = (256 - DEFER_BLK0) * NWAVES;
    pro_tiles<pro::I_IN / NW>(F, P, pro::I_IN, (F.blk - DEFER_BLK0) * NWAVES + F.wave, NW, pro::I_IN % NW);
}
PHASE g_inproj(int wv, unsigned char* ws_, int layer_) {
    unsigned char* ws = uni(ws_); const int layer = uni(layer_); const Frame F = mkframe(ws, wv);
    SchedGrid S; S.init(64, 18, F.G, F.blk, ws + WS_HN, (size_t)256 * DM * 2, (bf16_t*)(ws + WS_WIN) + (size_t)layer * WIN_ROWS * DM, (size_t)256 * DM * 2);
    EpiStore E; E.O = (bf16_t*)(ws + WS_P); E.ld = PW; E.SS = (const float*)(ws + WS_SS); E.rl = (LAS float*)(F.lds + RING_BYTES); E.tid = F.tid; pg8::gemm_phase(F.lds, F.tid, DM, DM, DM, S, E);
}
PHASE g_lora(int wv, unsigned char* ws_, const float* w0, const float* a0, int layer_) {
    unsigned char* ws = uni(ws_); const int layer = uni(layer_); const Frame F = mkframe(ws, wv);
    SchedGrid S; S.init(64, 6, F.G, F.blk, ws + WS_LIN, (size_t)256 * LORA_K * 2, (bf16_t*)(ws + WS_LORA) + (size_t)layer * 1536 * LORA_K, (size_t)256 * LORA_K * 2);
    EpiLora E; E.O = (bf16_t*)(ws + WS_LO); E.w0 = uni(w0); E.a0 = uni(a0); pg8::gemm_phase(F.lds, F.tid, LORA_K, LORA_K, LORA_K, S, E);
}
PHASE g_small(int wv, unsigned char* ws_, int layer_) {
    unsigned char* ws = uni(ws_); const Frame F = mkframe(ws, wv); SchedSmall S; S.G = F.G; S.c = F.blk; S.layer = uni(layer_); S.ws = (const char*)ws; EpiSmall E; E.ws = ws; pg8::gemm_phase(F.lds, F.tid, 256, 256, 256, S, E);
}
PHASE g_gate(int wv, unsigned char* ws_, int layer_) {
    unsigned char* ws = uni(ws_); const int layer = uni(layer_); const Frame F = mkframe(ws, wv);
    SchedOwn3 S; S.c = F.blk; S.G = F.G; S.A = (const char*)(ws + WS_HN); S.a_n = 0; S.astep = (size_t)256 * DM * 2; S.B = (const char*)((bf16_t*)(ws + WS_WIN) + ((size_t)layer * WIN_ROWS + PW) * DM); S.bstep = (size_t)256 * DM * 2; S.b_n = (size_t)1024 * DM * 2;
    EpiGate E; E.O = (bf16_t*)(ws + WS_G); E.SS = (const float*)(ws + WS_SS); E.rl = (LAS float*)(F.lds + RING_BYTES); E.tid = F.tid; pg8::gemm_phase(F.lds, F.tid, DM, DM, DM, S, E);
}
PHASE g_merge(int wv, unsigned char* ws_, int layer_) {
    unsigned char* ws = uni(ws_); const int layer = uni(layer_); const Frame F = mkframe(ws, wv);
    SchedOwn3 S; S.c = F.blk; S.G = F.G; S.A = (const char*)(ws + WS_YRET); S.a_n = (size_t)16 * MiB; S.astep = (size_t)256 * 512 * 2;
    S.B = (const char*)((bf16_t*)(ws + WS_BR) + (size_t)layer * 3 * 1024 * 512); S.bstep = (size_t)256 * 512 * 2; S.b_n = (size_t)1024 * 512 * 2;
    EpiMerge E; E.Gt = (const bf16_t*)(ws + WS_G); E.Mg = (bf16_t*)(ws + WS_MRG); pg8::gemm_phase(F.lds, F.tid, 512, 512, 512, S, E);
}
template <bool EMIT>
PHASE g_wo(int wv, unsigned char* ws_, int layer_) {
    unsigned char* ws = uni(ws_); const int layer = uni(layer_); const Frame F = mkframe(ws, wv);
    SchedGrid S; S.init(64, 4, F.G, F.blk, ws + WS_MRG, (size_t)256 * DM * 2, (bf16_t*)(ws + WS_WO) + (size_t)layer * DM * DM, (size_t)256 * DM * 2);
    EpiResid<EMIT> E; E.H = (bf16_t*)(ws + WS_HN); E.SS = (float*)(ws + WS_SS); pg8::gemm_phase(F.lds, F.tid, DM, DM, DM, S, E);
}
PHASE g_ffn_gu(int wv, unsigned char* ws_) {
    unsigned char* ws = uni(ws_); const Frame F = mkframe(ws, wv);
    SchedGrid S; S.init(64, 22, F.G, F.blk, ws + WS_HN, (size_t)256 * DM * 2, ws + WS_FGU, (size_t)256 * DM * 2);
    EpiSwiglu E; E.O = (bf16_t*)(ws + WS_ACT); E.ldc = DFF; E.pn_off = 0; E.SS = (const float*)(ws + WS_SS); E.rl = (LAS float*)(F.lds + RING_BYTES); E.tid = F.tid; pg8::gemm_phase(F.lds, F.tid, DM, DM, DM, S, E);
}
PHASE g_ffn_down(int wv, unsigned char* ws_) {
    unsigned char* ws = uni(ws_); const Frame F = mkframe(ws, wv);
    SchedGrid S; S.init(64, 4, F.G, F.blk, ws + WS_ACT, (size_t)256 * DFF * 2, ws + WS_FD, (size_t)256 * DFF * 2);
    EpiResid<true> E; E.H = (bf16_t*)(ws + WS_HN); E.SS = (float*)(ws + WS_SS); pg8::gemm_phase(F.lds, F.tid, DFF, DFF, DFF, S, E);
}
PHASE g_moe_gu(int wv, unsigned char* ws_, int hh_) {
    unsigned char* ws = uni(ws_); const int hh = uni(hh_); const Frame F = mkframe(ws, wv); const LAS int* tab = (const LAS int*)(F.lds + LDS_TAB);
    const int ncol = hh ? MT1 : MT0;
    moe_gather_table(F, ncol);
    SchedMoe S; S.G = F.G; S.c = F.blk; S.ncol = ncol; S.ntile = tab[0]; S.tab = tab + 16; S.A = (const char*)(ws + WS_HN2); S.astep = 0;
    S.B = (const char*)(ws + WS_MGU) + (size_t)(hh ? MT0 : 0) * 256 * DM * 2; S.bstep = (size_t)256 * DM * 2; S.estep = (size_t)2 * DFFE * DM * 2;
    EpiSwiglu E; E.O = (bf16_t*)(ws + WS_MACT); E.ldc = hh ? KH1 : KH0; E.pn_off = 0; E.SS = nullptr; E.rl = nullptr; E.tid = 0; pg8::gemm_phase<EpiSwiglu, SchedMoe, true>(F.lds, F.tid, DM, DM, DM, S, E, (const LAS unsigned*)(F.lds + LDS_GTAB));
}
template <bool ACCUM>
PHASE g_moe_down(int wv, unsigned char* ws_, int hh_) {
    unsigned char* ws = uni(ws_); const int hh = uni(hh_); const Frame F = mkframe(ws, wv); const LAS int* tab = (const LAS int*)(F.lds + LDS_TAB);
    const float* row_w = (const float*)((const int*)(ws + WS_TOK) + 6 * MTOK + MAXROWS);
    SchedMoe S; S.G = F.G; S.c = F.blk; S.ncol = 4; S.ntile = tab[0]; S.tab = tab + 16; const int kh = hh ? KH1 : KH0; S.A = (const char*)(ws + WS_MACT); S.astep = (size_t)256 * kh * 2;
    S.B = (const char*)(ws + WS_MD) + (size_t)(hh ? KH0 : 0) * 2; S.bstep = (size_t)256 * DFFE * 2; S.estep = (size_t)DM * DFFE * 2;
    EpiMoeOut<ACCUM> E; E.row_w = row_w; E.O = (bf16_t*)(ws + WS_OUT2); pg8::gemm_phase(F.lds, F.tid, kh, kh, DFFE, S, E);
}

typedef const __attribute__((address_space(4))) Params* KPtr;
__device__ __forceinline__ KPtr kargs() { KPtr k = (KPtr)__builtin_amdgcn_kernarg_segment_ptr(); asm volatile("" : "+s"(k)); return k; }
#define KIN(i) (kargs()->in[i])
#define KWS() (kargs()->ws)
struct TpState { unsigned long long tp0, tp1; int tpk; };
#define tp0 tps.tp0
#define tp1 tps.tp1
#define tpk tps.tpk
#define GRID_BAR() do { XcdBarrier b_ = bar; b_.bar = (unsigned*)(KWS() + WS_CTL) + CW_BAR; b_.x = xb_xcc_id(); xcd_barrier(b_); } while (0)
#ifdef TPH
#define TP(k) do { volatile LAS unsigned long long* tpl_ = (volatile LAS unsigned long long*)(lds_raw + LDSCTL_OFF + 48); if ((k) == TPH) tpl_[0] = __builtin_amdgcn_s_memrealtime(); if ((k) == TPH + TPN) tpl_[1] = __builtin_amdgcn_s_memrealtime(); } while (0)
#define TPM() do { ++tpk; TP(tpk); } while (0)
#else
#define TP(k) do { } while (0)
#define TPM() do { } while (0)
#endif
template <int layer>
__device__ __forceinline__ void layer_body(const int wv, const XcdBarrier& bar, TpState& tps) {
        g_inproj(wv, KWS(), layer);
        if constexpr (layer == 0) { if ((int)blockIdx.x >= DEFER_BLK0) f_defer_a(wv, KWS(), KIN(I_WQB), KIN(I_WBR), KIN(I_WO), KIN(I_FG), KIN(I_FU), KIN(I_FD), KIN(I_W2), KIN(I_A2), KIN(I_G2), KIN(I_WKVB), KIN(I_POS), KIN(I_FNORM)); }
        GRID_BAR();
        TPM();
        f_prep(wv, KWS(), KIN(I_MU) + (size_t)layer * RWKV_COLS, KIN(I_QNORM) + layer * 256, KIN(I_KVNORM) + layer * 128, layer);
        GRID_BAR();
        TPM();
        f_ret_scan(wv, KWS());
        g_lora(wv, KWS(), KIN(I_W0) + layer * 512, KIN(I_A0) + layer * 512, layer);
        g_small(wv, KWS(), layer);
        GRID_BAR();
        TPM();
        f_ret_out(wv, KWS());
#ifdef SPLIT5
        GRID_BAR();
        TPM();
#endif
#ifndef RWKV_SEQ
        f_rwkv_pre(wv, KWS(), KIN(I_MU) + (size_t)layer * RWKV_COLS, KIN(I_KK) + layer * 512, KIN(I_KA) + layer * 512, KIN(I_RK) + layer * 512);
        GRID_BAR();
        TPM();
        if ((int)blockIdx.x < 16) f_rwkv_scan(wv, KWS());
#ifdef SPLIT6
        GRID_BAR();
        TPM();
#endif
#else
        GRID_BAR();
        TPM();
        if (blockIdx.x < 16) f_rwkv_seq(wv, KWS(), KIN(I_MU) + (size_t)layer * RWKV_COLS, KIN(I_KK) + layer * 512, KIN(I_KA) + layer * 512, KIN(I_RK) + layer * 512, KIN(I_LNX) + layer * 512, layer);
#endif
        f_attn(wv, KWS(), layer);
        GRID_BAR();
        TPM();
#ifndef RWKV_SEQ
        f_rwkv_out(wv, KWS(), KIN(I_LNX) + layer * 512);
#endif
        g_gate(wv, KWS(), layer);
#ifndef RWKV_SEQ
        GRID_BAR();
        TPM();
#endif
        g_merge(wv, KWS(), layer);
        GRID_BAR();
        TPM();
        g_wo<layer == 0>(wv, KWS(), layer);
        GRID_BAR();
        TPM();
        if constexpr (layer == 0) {
            g_ffn_gu(wv, KWS());
            if ((int)blockIdx.x >= DEFER_BLK0) f_defer_b(wv, KWS(), KIN(I_WIN), KIN(I_ANORM));
            GRID_BAR();
            TPM();
            g_ffn_down(wv, KWS());
            GRID_BAR();
            TPM();
        } else {
            f_rms_moe(wv, KWS(), KIN(I_FNORM) + layer * DM, KIN(I_ROUTER));
            f_moe_convert<0>(wv, KWS(), KIN(I_MG), KIN(I_MU2), KIN(I_MD));
            GRID_BAR();
            TPM();
            f_moe_scatter(wv, KWS());
            GRID_BAR();
            TPM();
            g_moe_gu(wv, KWS(), 0);
            GRID_BAR();
            TPM();
            g_moe_down<false>(wv, KWS(), 0);
            f_moe_convert<1>(wv, KWS(), KIN(I_MG), KIN(I_MU2), KIN(I_MD));
            GRID_BAR();
            TPM();
            g_moe_gu(wv, KWS(), 1);
            GRID_BAR();
            TPM();
            g_moe_down<true>(wv, KWS(), 1);
            GRID_BAR();
            TPM();
        }
    }
__global__ void __launch_bounds__(NTHR, 2) mega(Params P_unused) {
    LAS unsigned char* lds = (LAS unsigned char*)lds_raw;
    const int wv = __builtin_amdgcn_readfirstlane((int)threadIdx.x >> 6);
    for (int u = threadIdx.x; u < (LDS_BYTES - LDSCTL_OFF) / 4; u += NTHR) ((LAS unsigned*)(lds + LDSCTL_OFF))[u] = 0u;
    __syncthreads();
    const XcdBarrier bar = xcd_barrier_post((unsigned*)(KWS() + WS_CTL) + CW_BAR, (volatile LAS unsigned*)(lds + LDSCTL_OFF), wv);
    TpState tps = {0ull, 0ull, 0};
    TP(0);
    {
        KPtr k = kargs(); unsigned char* ws = k->ws; const Frame F = mkframe(ws, wv);
        Params P; P.in[I_WIN] = k->in[I_WIN]; P.in[I_WQB] = k->in[I_WQB]; P.in[I_WBR] = k->in[I_WBR]; P.in[I_WO] = k->in[I_WO]; P.in[I_FG] = k->in[I_FG]; P.in[I_FU] = k->in[I_FU]; P.in[I_FD] = k->in[I_FD];
        P.in[I_W2] = k->in[I_W2]; P.in[I_A2] = k->in[I_A2]; P.in[I_G2] = k->in[I_G2]; P.in[I_WKVB] = k->in[I_WKVB]; P.in[I_POS] = k->in[I_POS]; P.in[I_X] = k->in[I_X]; P.in[I_ANORM] = k->in[I_ANORM]; P.in[I_FNORM] = k->in[I_FNORM];
        phase_prologue(F, P);
#ifdef PRO_SPIN
        { const unsigned long long t0_ = __builtin_amdgcn_s_memrealtime(); while (__builtin_amdgcn_s_memrealtime() - t0_ < (unsigned long long)PRO_SPIN) __builtin_amdgcn_s_sleep(8); }
#endif
    }
    GRID_BAR();
    TPM();
    layer_body<0>(wv, bar, tps);
    layer_body<1>(wv, bar, tps);
    f_final(wv, KWS(), kargs()->out, KIN(I_FINAL));
#ifdef PRE_T
    __syncthreads();
    { volatile LAS unsigned long long* tq_ = (volatile LAS unsigned long long*)(lds_raw + LDSCTL_OFF + 48); const unsigned long long te = __builtin_amdgcn_s_memrealtime(), span = tq_[1] * 8ull; while (__builtin_amdgcn_s_memrealtime() - te < span) __builtin_amdgcn_s_sleep(8); }
#endif
#ifdef TPH
    __syncthreads(); TPM();
    { volatile LAS unsigned long long* tpl_ = (volatile LAS unsigned long long*)(lds_raw + LDSCTL_OFF + 48); const unsigned long long te = __builtin_amdgcn_s_memrealtime(), span = (tpl_[1] - tpl_[0]) * (unsigned long long)TAMP; while (__builtin_amdgcn_s_memrealtime() - te < span) __builtin_amdgcn_s_sleep(8); }
#endif
}

extern "C" void kernel_launch(void* const* d_in, const int* in_sizes, int n_in, void* d_out, int out_size, void* d_ws, size_t ws_size, hipStream_t stream) {
    static int ready = 0;
    if (!ready) {
        if (n_in != 29 || out_size != MTOK * DM || ws_size < WS_END) { fprintf(stderr, "kernel_launch: unexpected shapes (n_in %d out %d ws %zu need %zu)\n", n_in, out_size, ws_size, (size_t)WS_END); ready = -1; return; }
        if (hipFuncSetAttribute((const void*)mega, hipFuncAttributeMaxDynamicSharedMemorySize, LDS_BYTES) != hipSuccess) { fprintf(stderr, "kernel_launch: hipFuncSetAttribute failed\n"); ready = -1; return; }
        int dev = 0, cus = 0, per_cu = 0; (void)hipGetDevice(&dev); (void)hipDeviceGetAttribute(&cus, hipDeviceAttributeMultiprocessorCount, dev);
        (void)hipOccupancyMaxActiveBlocksPerMultiprocessor(&per_cu, (const void*)mega, NTHR, LDS_BYTES);
        if (cus < 256 || per_cu < 1) { fprintf(stderr, "kernel_launch: needs 256 CUs with one resident workgroup each (cus %d, per_cu %d)\n", cus, per_cu); ready = -1; return; }
        ready = 1;
    }
    if (ready < 0) return;
    (void)hipMemsetAsync((char*)d_ws + WS_CTL, 0, CTL_BYTES, stream);
    Params p{}; for (int i = 0; i < 29; ++i) p.in[i] = (const float*)d_in[i]; p.out = (float*)d_out; p.ws = (unsigned char*)d_ws;
    hipLaunchKernelGGL(mega, dim3(256), dim3(NTHR), LDS_BYTES, stream, p);
}
```
